# Optimizing an MI355X kernel written in HIP

```python
import jax, jax.numpy as jnp
from jax import lax
import numpy as np

D_MODEL = 2048
BATCH = 4
SEQ = 4096
DEPTH = 2

HEAD_DIM = 128
MIX_WIDTH = D_MODEL
MEM_WIDTH = D_MODEL // 4
N_MEM_HEADS = MEM_WIDTH // HEAD_DIM
N_MEM = 256
LRU_WIDTH = MIX_WIDTH - MEM_WIDTH
N_LRU_BLOCKS = LRU_WIDTH // HEAD_DIM
FOX_WIDTH = MIX_WIDTH - MEM_WIDTH
N_FOX_HEADS = FOX_WIDTH // HEAD_DIM
CONV_WIDTH = 4
LRU_C = 8.0
BLOCK_Q = 128
PEER_HEADS = 8
N_KEYS = 128
N_EXPERTS = N_KEYS * N_KEYS
PEER_TOPK = 16
D_QUERY = 256
PEER_HALF = D_QUERY // 2
PEER_CHUNK = 128
N_A_LAYERS = (DEPTH + 1) // 2
N_B_LAYERS = DEPTH // 2
RMS_EPS = 1e-6

kernel_name = "yoco_rglru_fox_peer_memory"


def rmsnorm(x, g):
    xf = x.astype(jnp.float32)
    y = xf * lax.rsqrt(jnp.mean(xf * xf, axis=-1, keepdims=True) + RMS_EPS)
    return (y * g.astype(jnp.float32)).astype(x.dtype)


def causal_conv(x, w, b):
    c = x.shape[-1]
    y = lax.conv_general_dilated(x, w[:, None, :], window_strides=(1,), padding=((CONV_WIDTH - 1, 0),),
                                 dimension_numbers=('NWC', 'WIO', 'NWC'), feature_group_count=c)
    return y + b


def rg_lru(x, gate_w, gate_b, lam):
    b_, s_, c_ = x.shape
    xb = x.reshape(b_, s_, N_LRU_BLOCKS, HEAD_DIM)
    gates = (jnp.einsum('bsnc,ncg->bsng', xb, gate_w) + gate_b).astype(jnp.float32)
    r = jax.nn.sigmoid(gates[..., :HEAD_DIM]).reshape(b_, s_, c_)
    i = jax.nn.sigmoid(gates[..., HEAD_DIM:]).reshape(b_, s_, c_)
    log_a = -LRU_C * r * jax.nn.softplus(-lam.astype(jnp.float32))
    a = jnp.exp(log_a)
    u = jnp.sqrt(-jnp.expm1(2.0 * log_a)) * (i * x.astype(jnp.float32))

    def combine(left, right):
        a1, b1 = left
        a2, b2 = right
        return a1 * a2, a2 * b1 + b2

    _, h = lax.associative_scan(combine, (a, u), axis=1)
    return h.astype(x.dtype)


def mem_attention(qm, mem_n, w_kv, q_g, k_g):
    b_, s_, _ = qm.shape
    kv = mem_n @ w_kv
    k = rmsnorm(kv[..., :MEM_WIDTH].reshape(b_, N_MEM, N_MEM_HEADS, HEAD_DIM), k_g)
    v = kv[..., MEM_WIDTH:].reshape(b_, N_MEM, N_MEM_HEADS, HEAD_DIM)
    q = rmsnorm(qm.reshape(b_, s_, N_MEM_HEADS, HEAD_DIM), q_g)
    s = jnp.einsum('bshd,bmhd->bhsm', q, k).astype(jnp.float32) * (HEAD_DIM ** -0.5)
    p = jax.nn.softmax(s, axis=-1)
    o = jnp.einsum('bhsm,bmhd->bshd', p.astype(v.dtype), v)
    return o.reshape(b_, s_, MEM_WIDTH)


def shared_kv(x, norm_g, w_kvf, b_f, k_g):
    b_, s_, _ = x.shape
    z = rmsnorm(x, norm_g) @ w_kvf
    k = rmsnorm(z[..., :FOX_WIDTH].reshape(b_, s_, N_FOX_HEADS, HEAD_DIM), k_g)
    v = z[..., FOX_WIDTH:2 * FOX_WIDTH].reshape(b_, s_, N_FOX_HEADS, HEAD_DIM)
    log_f = jax.nn.log_sigmoid((z[..., 2 * FOX_WIDTH:] + b_f).astype(jnp.float32))
    c = jnp.cumsum(log_f, axis=1).transpose(0, 2, 1)
    return k, v, c


def forgetting_attention(q, k, v, c):
    b_, s_, h_, d_ = q.shape
    n_blocks = s_ // BLOCK_Q
    qb = q.reshape(b_, n_blocks, BLOCK_Q, h_, d_).transpose(1, 0, 2, 3, 4)
    cb = c.reshape(b_, h_, n_blocks, BLOCK_Q).transpose(2, 0, 1, 3)
    key_pos = jnp.arange(s_)

    def one_block(args):
        qi, ci, blk = args
        s = jnp.einsum('bqhd,bkhd->bhqk', qi, k).astype(jnp.float32) * (HEAD_DIM ** -0.5)
        s = s + ci[..., :, None] - c[:, :, None, :]
        q_pos = blk * BLOCK_Q + jnp.arange(BLOCK_Q)
        mask = key_pos[None, :] <= q_pos[:, None]
        s = jnp.where(mask, s, -jnp.inf)
        p = jax.nn.softmax(s, axis=-1)
        return jnp.einsum('bhqk,bkhd->bqhd', p.astype(v.dtype), v)

    out = lax.map(one_block, (qb, cb, jnp.arange(n_blocks)))
    return out.transpose(1, 0, 2, 3, 4).reshape(b_, s_, h_ * d_)


def peer(h, w_q, subkeys, u, v):
    b_, s_, d_ = h.shape
    t_ = b_ * s_
    hf = h.reshape(t_, d_)
    q = (hf @ w_q).reshape(t_, PEER_HEADS, 2, PEER_HALF)
    scores = jnp.einsum('thpc,hpkc->thpk', q, subkeys).astype(jnp.float32)
    top_s, top_i = lax.top_k(scores, PEER_TOPK)
    cand_s = top_s[:, :, 0, :, None] + top_s[:, :, 1, None, :]
    cand_i = top_i[:, :, 0, :, None] * N_KEYS + top_i[:, :, 1, None, :]
    best_s, best_j = lax.top_k(cand_s.reshape(t_, PEER_HEADS, PEER_TOPK * PEER_TOPK), PEER_TOPK)
    idx = jnp.take_along_axis(cand_i.reshape(t_, PEER_HEADS, PEER_TOPK * PEER_TOPK), best_j, axis=-1)
    g = jax.nn.softmax(best_s, axis=-1).astype(h.dtype)
    n_sel = PEER_HEADS * PEER_TOPK
    n_chunks = t_ // PEER_CHUNK

    def one_chunk(args):
        xc, ic, gc = args
        act = jax.nn.gelu(jnp.einsum('ced,cd->ce', u[ic], xc))
        return jnp.einsum('ce,ced->cd', gc * act, v[ic])

    out = lax.map(one_chunk, (hf.reshape(n_chunks, PEER_CHUNK, d_),
                              idx.reshape(n_chunks, PEER_CHUNK, n_sel),
                              g.reshape(n_chunks, PEER_CHUNK, n_sel)))
    return out.reshape(b_, s_, d_)


def setup_inputs(seed: int = 0) -> dict:
    key = jax.random.key(seed)
    ks = jax.random.split(key, 32)
    f32 = jnp.float32
    nrm = lambda k, shape, scale: jax.random.normal(k, shape, f32) * scale
    gain = lambda k, shape: 1.0 + 0.02 * jax.random.normal(k, shape, f32)
    a0 = jax.random.uniform(ks[8], (N_A_LAYERS, LRU_WIDTH), f32, 0.9, 0.999) ** (1.0 / LRU_C)
    return {
        "x": nrm(ks[0], (BATCH, SEQ, D_MODEL), 1.0),
        "mem": nrm(ks[1], (BATCH, N_MEM, D_MODEL), 1.0),
        "a_norm_g": gain(ks[2], (N_A_LAYERS, D_MODEL)),
        "a_w_in": nrm(ks[3], (N_A_LAYERS, D_MODEL, 2 * LRU_WIDTH + MEM_WIDTH), D_MODEL ** -0.5),
        "a_conv_w": nrm(ks[4], (N_A_LAYERS, CONV_WIDTH, LRU_WIDTH), CONV_WIDTH ** -0.5),
        "a_conv_b": nrm(ks[5], (N_A_LAYERS, LRU_WIDTH), 0.02),
        "a_gate_w": nrm(ks[6], (N_A_LAYERS, N_LRU_BLOCKS, HEAD_DIM, 2 * HEAD_DIM), HEAD_DIM ** -0.5),
        "a_gate_b": nrm(ks[7], (N_A_LAYERS, N_LRU_BLOCKS, 2 * HEAD_DIM), 0.02),
        "a_lambda": jnp.log(a0) - jnp.log1p(-a0),
        "a_w_out": nrm(ks[9], (N_A_LAYERS, MIX_WIDTH, D_MODEL), MIX_WIDTH ** -0.5),
        "s_norm_g": gain(ks[10], (D_MODEL,)),
        "s_w_kvf": nrm(ks[11], (D_MODEL, 2 * FOX_WIDTH + N_FOX_HEADS), D_MODEL ** -0.5),
        "s_b_f": 2.0 + 0.5 * jax.random.normal(ks[12], (N_FOX_HEADS,), f32),
        "s_k_norm_g": gain(ks[13], (HEAD_DIM,)),
        "b_norm_g": gain(ks[14], (N_B_LAYERS, D_MODEL)),
        "b_w_in": nrm(ks[15], (N_B_LAYERS, D_MODEL, FOX_WIDTH + MEM_WIDTH), D_MODEL ** -0.5),
        "b_q_norm_g": gain(ks[16], (N_B_LAYERS, HEAD_DIM)),
        "b_w_out": nrm(ks[17], (N_B_LAYERS, MIX_WIDTH, D_MODEL), MIX_WIDTH ** -0.5),
        "m_norm_g": gain(ks[18], (DEPTH, D_MODEL)),
        "m_w_kv": nrm(ks[19], (DEPTH, D_MODEL, 2 * MEM_WIDTH), D_MODEL ** -0.5),
        "m_q_norm_g": gain(ks[20], (DEPTH, HEAD_DIM)),
        "m_k_norm_g": gain(ks[21], (DEPTH, HEAD_DIM)),
        "p_norm_g": gain(ks[22], (DEPTH, D_MODEL)),
        "p_w_q": nrm(ks[23], (DEPTH, D_MODEL, PEER_HEADS * D_QUERY), D_MODEL ** -0.5),
        "p_subkeys": nrm(ks[24], (DEPTH, PEER_HEADS, 2, N_KEYS, PEER_HALF), PEER_HALF ** -0.5),
        "p_u": nrm(ks[25], (DEPTH, N_EXPERTS, D_MODEL), D_MODEL ** -0.5),
        "p_v": nrm(ks[26], (DEPTH, N_EXPERTS, D_MODEL), (PEER_HEADS * PEER_TOPK) ** -0.5),
    }


def reference(x, mem, a_norm_g, a_w_in, a_conv_w, a_conv_b, a_gate_w, a_gate_b, a_lambda, a_w_out,
              s_norm_g, s_w_kvf, s_b_f, s_k_norm_g, b_norm_g, b_w_in, b_q_norm_g, b_w_out,
              m_norm_g, m_w_kv, m_q_norm_g, m_k_norm_g, p_norm_g, p_w_q, p_subkeys, p_u, p_v):
    b_, s_, _ = x.shape
    k_sh = v_sh = c_sh = None
    for layer in range(DEPTH):
        mem_n = rmsnorm(mem, m_norm_g[layer])
        if layer < N_A_LAYERS:
            i = layer
            z = rmsnorm(x, a_norm_g[i]) @ a_w_in[i]
            xb = causal_conv(z[..., :LRU_WIDTH], a_conv_w[i], a_conv_b[i])
            yb = z[..., LRU_WIDTH:2 * LRU_WIDTH]
            qm = z[..., 2 * LRU_WIDTH:]
            main = rg_lru(xb, a_gate_w[i], a_gate_b[i], a_lambda[i]) * jax.nn.gelu(yb)
            w_out = a_w_out[i]
        else:
            if layer == N_A_LAYERS:
                k_sh, v_sh, c_sh = shared_kv(x, s_norm_g, s_w_kvf, s_b_f, s_k_norm_g)
            j = layer - N_A_LAYERS
            z = rmsnorm(x, b_norm_g[j]) @ b_w_in[j]
            q = rmsnorm(z[..., :FOX_WIDTH].reshape(b_, s_, N_FOX_HEADS, HEAD_DIM), b_q_norm_g[j])
            qm = z[..., FOX_WIDTH:]
            main = forgetting_attention(q, k_sh, v_sh, c_sh)
            w_out = b_w_out[j]
        mo = mem_attention(qm, mem_n, m_w_kv[layer], m_q_norm_g[layer], m_k_norm_g[layer])
        x = x + jnp.concatenate([main, mo], axis=-1) @ w_out
        x = x + peer(rmsnorm(x, p_norm_g[layer]), p_w_q[layer], p_subkeys[layer], p_u[layer], p_v[layer])
    return x
```

```cpp
#include <hip/hip_runtime.h>
#include <hip/hip_cooperative_groups.h>
#include <cstdio>
#include <cstdint>
namespace cg = cooperative_groups;

#define LAS __attribute__((address_space(3)))
#define GAS __attribute__((address_space(1)))
typedef unsigned short bf16_t;
typedef short bf16x8 __attribute__((ext_vector_type(8)));
typedef short s16x4 __attribute__((ext_vector_type(4)));
typedef float f32x4 __attribute__((ext_vector_type(4)));
typedef float f32x2 __attribute__((ext_vector_type(2)));
typedef float f32x16 __attribute__((ext_vector_type(16)));
typedef unsigned u32x4 __attribute__((ext_vector_type(4)));
typedef unsigned u32x2 __attribute__((ext_vector_type(2)));
typedef _Float16 h2 __attribute__((ext_vector_type(2)));

constexpr int NB = 4, SEQ = 4096, T = NB * SEQ, DM = 2048, LRU = 1536, MEMW = 512, NMEM = 256, NH = 12, HD = 128;
constexpr int NIN0 = 3584, NL1 = 5120, NEXP = 16384, NMROW = NB * NMEM;
constexpr float EPS = 1e-6f;
constexpr int NTHREADS = 512, NWAVES = 8;

constexpr size_t MiB = 1u << 20;
constexpr size_t O_CTL = 0;
constexpr size_t O_WIN0 = 1 * MiB;
constexpr size_t O_WOUT0 = O_WIN0 + 14 * MiB;
constexpr size_t O_WL1 = O_WOUT0 + 8 * MiB;
constexpr size_t O_WOUT1 = O_WL1 + 20 * MiB;
constexpr size_t O_WQ0 = O_WOUT1 + 8 * MiB;
constexpr size_t O_WQ1 = O_WQ0 + 8 * MiB;
constexpr size_t O_WMKV = O_WQ1 + 8 * MiB;
constexpr size_t O_WGATE = O_WMKV + 8 * MiB;
constexpr size_t O_SUBK = O_WGATE + 1 * MiB;
constexpr size_t O_WF = O_SUBK + 1 * MiB;
constexpr size_t O_SMALL = O_WF + 1 * MiB;
constexpr size_t O_RS1 = O_SMALL;
constexpr size_t O_LOGF = O_SMALL + 64 * 1024;
constexpr size_t O_CC = O_LOGF + 768 * 1024;
constexpr size_t O_GG = O_CC + 768 * 1024;
constexpr size_t O_SPL = O_GG + 4096;
constexpr size_t O_TSC = O_SPL + 8192;
constexpr size_t O_ROWSS = O_SMALL + 2 * MiB;
constexpr size_t O_RSP = O_ROWSS + 2 * MiB;
constexpr size_t O_QMSS = O_RSP;
constexpr size_t O_MKSS = O_QMSS + 1 * MiB;
constexpr size_t O_SSL1 = O_MKSS + 1 * MiB;
constexpr size_t O_CARRY = O_SSL1 + 7 * MiB;
constexpr size_t O_MEMN = O_CARRY + 3 * MiB;
constexpr size_t O_MKV = O_MEMN + 8 * MiB;
constexpr size_t O_IDX = O_MKV + 20 * MiB;
constexpr size_t O_GW = O_IDX + 8 * MiB;
constexpr size_t O_TAB = O_GW + 8 * MiB;
constexpr size_t TAB_NIB = (size_t)8 * 16384 * 128, TAB_ONE = TAB_NIB + (size_t)16384 * 16 + 786432;
constexpr size_t O_XS16 = O_TAB + 128 * MiB;
constexpr size_t O_CAT = O_XS16 + 64 * MiB;
constexpr size_t O_ZX = O_CAT + 64 * MiB;
constexpr size_t O_X8 = O_ZX;
constexpr size_t O_GY = O_ZX + 48 * MiB;
constexpr size_t O_LOGFP = O_GY + 48 * MiB;
constexpr size_t O_QM = O_LOGFP;
constexpr size_t O_XC = O_QM + 16 * MiB;
constexpr size_t O_X4 = O_XC;
constexpr size_t O_SX = O_XC + 32 * MiB;
constexpr size_t O_AA = O_XC + 48 * MiB;
constexpr size_t O_PART = O_AA;
constexpr size_t O_UU = O_AA + 96 * MiB;
constexpr size_t O_PK = O_UU;
constexpr size_t O_Q16 = O_UU + 96 * MiB;
constexpr size_t O_ZL1 = O_Q16 + 64 * MiB;
constexpr size_t WS_END = O_ZL1 + 160 * MiB;
static_assert(WS_END <= 1024 * MiB, "workspace map");

__device__ __forceinline__ unsigned cvtpk(float lo, float hi) { unsigned r; asm volatile("v_cvt_pk_bf16_f32 %0, %1, %2" : "=v"(r) : "v"(lo), "v"(hi)); return r; }
__device__ __forceinline__ float bf_lo(unsigned w) { return __uint_as_float(w << 16); }
__device__ __forceinline__ float bf_hi(unsigned w) { return __uint_as_float(w & 0xffff0000u); }
__device__ __forceinline__ float fast_exp(float x) { return __builtin_amdgcn_exp2f(x * 1.4426950408889634f); }
__device__ __forceinline__ float log1p_pos(float y) { const float ser = y * (1.f - y * (0.5f - y * (0.33333334f - 0.25f * y))); const float lg = __builtin_amdgcn_logf(1.f + y) * 0.6931471805599453f; return y < 0.03f ? ser : lg; }
__device__ __forceinline__ float one_minus_exp(float x) { const float ser = -x * (1.f + x * (0.5f + x * (0.16666667f + x * 0.041666668f))); const float big = 1.f - fast_exp(x); return x > -0.03f ? ser : big; }
__device__ __forceinline__ float sigmoidf_(float x) { return __builtin_amdgcn_rcpf(1.f + fast_exp(-x)); }
__device__ __forceinline__ float gelu_tanh(float x) { const float u = x * (1.f + 0.044715f * x * x); return x * __builtin_amdgcn_rcpf(1.f + __builtin_amdgcn_exp2f(u * (-2.f * 0.7978845608028654f * 1.4426950408889634f))); }
template <int CTRL> __device__ __forceinline__ float dppf(float v) { return __int_as_float(__builtin_amdgcn_update_dpp(0, __float_as_int(v), CTRL, 0xF, 0xF, true)); }
__device__ __forceinline__ float xsum16(float v) { auto r = __builtin_amdgcn_permlane16_swap(__float_as_uint(v), __float_as_uint(v), false, false); return __uint_as_float(r[0]) + __uint_as_float(r[1]); }
__device__ __forceinline__ float xsum32(float v) { auto r = __builtin_amdgcn_permlane32_swap(__float_as_uint(v), __float_as_uint(v), false, false); return __uint_as_float(r[0]) + __uint_as_float(r[1]); }
__device__ __forceinline__ float xmax16(float v) { auto r = __builtin_amdgcn_permlane16_swap(__float_as_uint(v), __float_as_uint(v), false, false); return fmaxf(__uint_as_float(r[0]), __uint_as_float(r[1])); }
__device__ __forceinline__ float xmax32(float v) { auto r = __builtin_amdgcn_permlane32_swap(__float_as_uint(v), __float_as_uint(v), false, false); return fmaxf(__uint_as_float(r[0]), __uint_as_float(r[1])); }
__device__ __forceinline__ float wave_sum(float v) {
    v += dppf<0xB1>(v); v += dppf<0x4E>(v); v += dppf<0x141>(v); v += dppf<0x140>(v);
    v = xsum16(v); v = xsum32(v); return v;
}
__device__ __forceinline__ float wave_max(float v) {
    v = fmaxf(v, dppf<0xB1>(v)); v = fmaxf(v, dppf<0x4E>(v)); v = fmaxf(v, dppf<0x141>(v)); v = fmaxf(v, dppf<0x140>(v));
    v = xmax16(v); v = xmax32(v); return v;
}

namespace pg8 {
constexpr int BM = 256, BK = 64, HALF = 128, HTB = HALF * BK * 2, STAGE_BYTES = 8 * HTB, NXCD = 8, WGM = 8;
__host__ __device__ __forceinline__ int lds_byte(int r, int c) { const int st = (r >> 4) * 2 + (c >> 5), rr = r & 15, cc = c & 31, ob = rr * 64 + cc * 2; return st * 1024 + (ob ^ (((ob >> 9) & 1) << 5)); }
__host__ __device__ __forceinline__ void stage_rc(int b, int& R, int& C) { const int st = b / 1024, sb = b % 1024, swz = sb ^ (((sb >> 9) & 1) << 5); R = (st >> 1) * 16 + swz / 64; C = (st & 1) * 32 + (swz % 64) / 2; }
__host__ __device__ __forceinline__ int perm32(int rho) { const int n = rho >> 4, i = rho & 15; return 8 * (i >> 2) + 4 * n + (i & 3); }

struct Unit { int pm, pn; };
struct Gemm { const GAS bf16_t* A; const GAS bf16_t* Bt; int M, N, K, lda, ldb, acol; };

struct StaticOrder {
    int nM, nN, nwg, G, c;
    __device__ void init(int M, int N, int G_, int c_) { nM = M / BM; nN = N / BM; nwg = nM * nN; G = G_; c = c_; }
    __device__ bool next(int i, Unit& u) const {
        const long L = (long)i * G + c; if (L >= nwg) return false;
        int wgid = (int)L; { const int q = nwg / NXCD, r = nwg % NXCD, xcd = wgid % NXCD, off = wgid / NXCD; wgid = (xcd < r ? xcd * (q + 1) : r * (q + 1) + (xcd - r) * q) + off; }
        const int nig = WGM * nN, gid = wgid / nig, fm = gid * WGM, gsz = (nM - fm) < WGM ? (nM - fm) : WGM;
        u.pm = fm + ((wgid % nig) % gsz); u.pn = (wgid % nig) / gsz; return true;
    }
};

typedef int v8i_t __attribute__((ext_vector_type(8)));
typedef int v4i_t __attribute__((ext_vector_type(4)));
template <class Epi, bool FP8>
__device__ __forceinline__ void gemm_phase(LAS unsigned char* lds, const Gemm g, const StaticOrder& S, const Epi& E, const int tid) {
    const int wid = __builtin_amdgcn_readfirstlane(tid >> 6), lane = tid & 63, wr = wid >> 2, wc = wid & 3, fr = lane & 15, fq = lane >> 4;
    const int K = g.K, nt = K / BK;
    unsigned voffA[2], voffB[2];
#pragma unroll
    for (int i = 0; i < 2; ++i) { int R, C; stage_rc(tid * 16 + i * 8192, R, C); const int Rb = (R & ~31) + perm32(R & 31);
        voffA[i] = (unsigned)(R * g.lda + C) * 2u; voffB[i] = (unsigned)(Rb * g.ldb + C) * 2u; }
    const size_t kstep = (size_t)(BK * 2);
    const size_t hstepA = (size_t)HALF * g.lda * 2, hstepB = (size_t)HALF * g.ldb * 2;
    const size_t tstepA = 2 * hstepA, tstepB = 2 * hstepB;
    const unsigned ldsw = (unsigned)wid * 1024u;
    const int aoff = lds_byte(wr * 64 + fr, fq * 8), boff = lds_byte(wc * 32 + fr, fq * 8);
#define PG8_SA(b, h) (((b) * 2 + (h)) * HTB)
#define PG8_SB(b, h) ((4 + (b) * 2 + (h)) * HTB)
#define PG8_STAGE(bufoff, gbase, voff) do { _Pragma("unroll") for (int _i = 0; _i < 2; ++_i) \
        __builtin_amdgcn_global_load_lds((const GAS unsigned*)((gbase) + (voff)[_i]), (LAS unsigned*)(lds + (bufoff) + ldsw + _i * 8192), 16, 0, 0); } while (0)
#define PG8_LD2(dst, off_) do { const u32x4 lo_ = *(const LAS u32x4*)(lds + (off_)), hi_ = *(const LAS u32x4*)(lds + (off_) + 1024); \
        dst = (v8i_t){(int)lo_.x, (int)lo_.y, (int)lo_.z, (int)lo_.w, (int)hi_.x, (int)hi_.y, (int)hi_.z, (int)hi_.w}; } while (0)
#define PG8_LDA(dst, b, h) do { _Pragma("unroll") for (int m = 0; m < 4; ++m) PG8_LD2(dst[m], PG8_SA(b, h) + aoff + m * 2048); } while (0)
#define PG8_LDB(dst, b, h) do { _Pragma("unroll") for (int n = 0; n < 2; ++n) PG8_LD2(dst[n], PG8_SB(b, h) + boff + n * 2048); } while (0)
#define PG8_HALF(v, k) ((k) ? __builtin_shufflevector(v, v, 4, 5, 6, 7) : __builtin_shufflevector(v, v, 0, 1, 2, 3))
#define PG8_MMA(ai, bj, At, Bt) do { __builtin_amdgcn_s_setprio(1); _Pragma("unroll") for (int m = 0; m < 4; ++m) _Pragma("unroll") for (int n = 0; n < 2; ++n) { \
        if constexpr (FP8) asm volatile("v_mfma_scale_f32_16x16x128_f8f6f4 %0, %1, %2, %0, %3, %4 op_sel_hi:[0,0,0]" : "+v"(acc[ai][bj][m][n]) : "v"(Bt[n]), "v"(At[m]), "v"(sc_w), "v"(sc_x));     \
        else { _Pragma("unroll") for (int k = 0; k < 2; ++k) { const v4i_t bh_ = PG8_HALF(Bt[n], k), ah_ = PG8_HALF(At[m], k); \
                acc[ai][bj][m][n] = __builtin_amdgcn_mfma_f32_16x16x32_bf16(__builtin_bit_cast(bf16x8, bh_), __builtin_bit_cast(bf16x8, ah_), acc[ai][bj][m][n], 0, 0, 0); } } } \
        __builtin_amdgcn_s_setprio(0); } while (0)
#define PG8_WAIT_V(n) asm volatile("s_waitcnt vmcnt(" #n ")" ::: "memory")
#define PG8_WAIT_L(n) asm volatile("s_waitcnt lgkmcnt(" #n ")" ::: "memory")
#define PG8_BAR __builtin_amdgcn_s_barrier()
#define PG8_SCHED __builtin_amdgcn_sched_barrier(0)
    Unit cur, nxt; int ui = 0;
    if (!S.next(0, cur)) return;
    f32x4 acc[2][2][4][2];
#pragma unroll
    for (int a = 0; a < 2; ++a)
#pragma unroll
        for (int b = 0; b < 2; ++b)
#pragma unroll
            for (int m = 0; m < 4; ++m)
#pragma unroll
                for (int n = 0; n < 2; ++n) acc[a][b][m][n] = (f32x4){0.f, 0.f, 0.f, 0.f};
    v8i_t At[4], B0[2], B1[2];
    const int sc_w = 121, sc_x = 127;
    const GAS char* cA = (const GAS char*)g.A + (size_t)cur.pm * tstepA + (size_t)cur.pn * g.acol * 2; const GAS char* cB = (const GAS char*)g.Bt + (size_t)cur.pn * tstepB;
    PG8_STAGE(PG8_SB(0, 0), cB, voffB); PG8_STAGE(PG8_SB(0, 1), cB + hstepB, voffB); PG8_STAGE(PG8_SA(0, 0), cA, voffA); PG8_STAGE(PG8_SA(0, 1), cA + hstepA, voffA);
    if (wr == 1) PG8_BAR;
    PG8_WAIT_V(2); PG8_BAR;
    PG8_STAGE(PG8_SB(1, 0), cB + kstep, voffB); PG8_STAGE(PG8_SA(1, 0), cA + kstep, voffA); PG8_STAGE(PG8_SB(1, 1), cB + hstepB + kstep, voffB);
    PG8_WAIT_V(6); PG8_BAR;
    for (;;) {
        const bool has_next = S.next(ui + 1, nxt);
        const GAS char* nA = has_next ? (const GAS char*)g.A + (size_t)nxt.pm * tstepA + (size_t)nxt.pn * g.acol * 2 : cA; const GAS char* nB = has_next ? (const GAS char*)g.Bt + (size_t)nxt.pn * tstepB : cB;
        for (int t = 0; t < nt; t += 2) {
            const bool last = (t == nt - 2);
            const GAS char* a1 = cA + (size_t)(t + 1) * kstep;
            const GAS char* a2 = last ? nA : cA + (size_t)(t + 2) * kstep; const GAS char* b2 = last ? nB : cB + (size_t)(t + 2) * kstep;
            const GAS char* a3 = a2 + kstep; const GAS char* b3 = b2 + kstep;
            PG8_LDB(B0, 0, 0); PG8_LDB(B1, 0, 1); PG8_SCHED; PG8_LDA(At, 0, 0); PG8_STAGE(PG8_SA(1, 1), a1 + hstepA, voffA);
            PG8_WAIT_V(8); PG8_WAIT_L(0); PG8_BAR; PG8_MMA(0, 0, At, B0); PG8_MMA(0, 1, At, B1); PG8_BAR; PG8_SCHED;
            PG8_LDA(At, 0, 1); PG8_STAGE(PG8_SB(0, 0), b2, voffB); PG8_STAGE(PG8_SB(0, 1), b2 + hstepB, voffB); PG8_STAGE(PG8_SA(0, 0), a2, voffA);
            PG8_WAIT_V(8); PG8_WAIT_L(0); PG8_BAR; PG8_MMA(1, 0, At, B0); PG8_MMA(1, 1, At, B1); PG8_BAR; PG8_SCHED;
            PG8_LDB(B0, 1, 0); PG8_LDB(B1, 1, 1); PG8_SCHED; PG8_LDA(At, 1, 0); PG8_STAGE(PG8_SA(0, 1), a2 + hstepA, voffA);
            PG8_WAIT_V(8); PG8_WAIT_L(0); PG8_BAR; PG8_MMA(0, 0, At, B0); PG8_MMA(0, 1, At, B1); PG8_BAR; PG8_SCHED;
            PG8_LDA(At, 1, 1); PG8_STAGE(PG8_SB(1, 0), b3, voffB); PG8_STAGE(PG8_SB(1, 1), b3 + hstepB, voffB); PG8_STAGE(PG8_SA(1, 0), a3, voffA);
            PG8_WAIT_V(8); PG8_WAIT_L(0); PG8_BAR; PG8_MMA(1, 0, At, B0); PG8_MMA(1, 1, At, B1); PG8_BAR; PG8_SCHED;
        }
        if (wr == 0) PG8_BAR;
        { int ln_; asm volatile("v_mbcnt_lo_u32_b32 %0, -1, 0\n\tv_mbcnt_hi_u32_b32 %0, -1, %0" : "=v"(ln_));
          E(acc, cur, wr, wc, ln_ & 15, ln_ >> 4); }
        if (!has_next) break;
#pragma unroll
        for (int a = 0; a < 2; ++a)
#pragma unroll
            for (int b = 0; b < 2; ++b)
#pragma unroll
                for (int m = 0; m < 4; ++m)
#pragma unroll
                    for (int n = 0; n < 2; ++n) acc[a][b][m][n] = (f32x4){0.f, 0.f, 0.f, 0.f};
        cur = nxt; cA = nA; cB = nB; ++ui;
        if (wr == 1) PG8_BAR;
    }
    PG8_WAIT_V(0);
    PG8_BAR;
#undef PG8_SA
#undef PG8_SB
#undef PG8_STAGE
#undef PG8_LDA
#undef PG8_LDB
#undef PG8_LD2
#undef PG8_HALF
#undef PG8_MMA
#undef PG8_WAIT_V
#undef PG8_WAIT_L
#undef PG8_BAR
#undef PG8_SCHED
}
}

enum { EM_IN0 = 0, EM_MKV = 1, EM_GATE = 2, EM_RES = 3, EM_PQ = 4, EM_L1 = 5 };
struct Epi {
    int mode;
    GAS unsigned char* ws;
    const GAS float* resid;
    GAS float* outf;
    GAS bf16_t* o16;
    GAS float* ssq;
    const GAS float* gate_b;
    typedef pg8::Unit Unit;
    __device__ __forceinline__ static void st8(GAS bf16_t* p, f32x4 v0, f32x4 v1) {
        u32x4 w; w.x = cvtpk(v0[0], v0[1]); w.y = cvtpk(v0[2], v0[3]); w.z = cvtpk(v1[0], v1[1]); w.w = cvtpk(v1[2], v1[3]); *(GAS u32x4*)p = w; }
    __device__ __forceinline__ static float sq8(f32x4 a, f32x4 b) { return (a[0] * a[0] + a[1] * a[1]) + (a[2] * a[2] + a[3] * a[3]) + (b[0] * b[0] + b[1] * b[1]) + (b[2] * b[2] + b[3] * b[3]); }
    __device__ __forceinline__ void operator()(f32x4 (&acc)[2][2][4][2], const Unit& u, int wr, int wc, int fr, int fq) const {
        const int row0 = u.pm * 256 + wr * 64 + fr;
        const int cin = wc * 32 + 8 * fq;
        if (mode == EM_IN0) {
            GAS bf16_t* base; int ld, colt; int kind;
            if (u.pn < 6) { base = (GAS bf16_t*)(ws + O_ZX); ld = LRU; colt = u.pn * 256; kind = 0; }
            else if (u.pn < 12) { base = (GAS bf16_t*)(ws + O_GY); ld = LRU; colt = (u.pn - 6) * 256; kind = 1; }
            else { base = (GAS bf16_t*)(ws + O_ZL1); ld = NL1; colt = 4608 + (u.pn - 12) * 256; kind = 2; }
            GAS float* qmss = (GAS float*)(ws + O_SSL1);
#pragma unroll
            for (int ai = 0; ai < 2; ++ai)
#pragma unroll
                for (int m = 0; m < 4; ++m) { const int row = row0 + ai * 128 + m * 16;
#pragma unroll
                    for (int bj = 0; bj < 2; ++bj) { f32x4 v0 = acc[ai][bj][m][0], v1 = acc[ai][bj][m][1];
                        if (kind == 1) {
#pragma unroll
                            for (int j = 0; j < 4; ++j) { v0[j] = gelu_tanh(v0[j]); v1[j] = gelu_tanh(v1[j]); } }
                        st8(base + (size_t)row * ld + colt + bj * 128 + cin, v0, v1);
                        if (kind == 2) { float s = sq8(v0, v1); s = xsum16(s); s = xsum32(s);
                            if (fq == 0) qmss[(size_t)row * 112 + (24 + (u.pn - 12) * 2 + bj) * 4 + wc] = s; } } }
        } else if (mode == EM_MKV) {
#pragma unroll
            for (int ai = 0; ai < 2; ++ai)
#pragma unroll
                for (int m = 0; m < 4; ++m) { const int row = row0 + ai * 128 + m * 16;
#pragma unroll
                    for (int bj = 0; bj < 2; ++bj) { const f32x4 v0 = acc[ai][bj][m][0], v1 = acc[ai][bj][m][1];
                        st8(o16 + (size_t)row * NL1 + u.pn * 256 + bj * 128 + cin, v0, v1);
                        if (u.pn < 2) { float s = sq8(v0, v1); s = xsum16(s); s = xsum32(s);
                            if (fq == 0) ssq[(size_t)row * 112 + (u.pn * 2 + bj) * 4 + wc] = s; } } }
        } else if (mode == EM_GATE) {
            const int ch = u.pn * 128 + cin;
            const GAS bf16_t* xc = (const GAS bf16_t*)(ws + O_XC); GAS float* AA = (GAS float*)(ws + O_AA); GAS float* UU = (GAS float*)(ws + O_UU);
            const GAS float* spl = (const GAS float*)(ws + O_SPL) + ch; const GAS float* gb = gate_b + u.pn * 256 + cin;
#pragma unroll
            for (int n = 0; n < 2; ++n) {
                const f32x4 sp = *(const GAS f32x4*)(spl + 4 * n), br = *(const GAS f32x4*)(gb + 4 * n), bi = *(const GAS f32x4*)(gb + 128 + 4 * n);
#pragma unroll
                for (int ai = 0; ai < 2; ++ai)
#pragma unroll
                    for (int m = 0; m < 4; ++m) { const int row = row0 + ai * 128 + m * 16;
                        const u32x2 xw = *(const GAS u32x2*)(xc + (size_t)row * LRU + ch + 4 * n);
                        const f32x4 xv = {bf_lo(xw.x), bf_hi(xw.x), bf_lo(xw.y), bf_hi(xw.y)};
                        f32x4 av, uv;
#pragma unroll
                        for (int j = 0; j < 4; ++j) { const float r = sigmoidf_(acc[ai][0][m][n][j] + br[j]), ig = sigmoidf_(acc[ai][1][m][n][j] + bi[j]);
                            const float la = -8.f * r * sp[j];
                            av[j] = fast_exp(la); uv[j] = __builtin_amdgcn_sqrtf(one_minus_exp(2.f * la)) * (ig * xv[j]); }
                        *(GAS f32x4*)(AA + (size_t)row * LRU + ch + 4 * n) = av; *(GAS f32x4*)(UU + (size_t)row * LRU + ch + 4 * n) = uv; }
            }
        } else if (mode == EM_RES) {
            GAS bf16_t* xs = (GAS bf16_t*)(ws + O_XS16); GAS float* rowss = (GAS float*)(ws + O_ROWSS);
#pragma unroll
            for (int ai = 0; ai < 2; ++ai)
#pragma unroll
                for (int m = 0; m < 4; ++m) { const int row = row0 + ai * 128 + m * 16; float s = 0.f;
#pragma unroll
                    for (int bj = 0; bj < 2; ++bj) { const size_t off = (size_t)row * DM + u.pn * 256 + bj * 128 + cin;
                        const f32x4 r0 = *(const GAS f32x4*)(resid + off), r1 = *(const GAS f32x4*)(resid + off + 4);
                        const f32x4 v0 = acc[ai][bj][m][0] + r0, v1 = acc[ai][bj][m][1] + r1;
                        *(GAS f32x4*)(outf + off) = v0; *(GAS f32x4*)(outf + off + 4) = v1;
                        st8(xs + off, v0, v1); s += sq8(v0, v1); }
                    s = xsum16(s); s = xsum32(s);
                    if (fq == 0) rowss[(size_t)row * 32 + u.pn * 4 + wc] = s; }
        } else if (mode == EM_PQ) {
            const GAS float* rowss = (const GAS float*)(ws + O_ROWSS);
#pragma unroll
            for (int ai = 0; ai < 2; ++ai)
#pragma unroll
                for (int m = 0; m < 4; ++m) { const int row = row0 + ai * 128 + m * 16;
                    const f32x4 p0 = *(const GAS f32x4*)(rowss + (size_t)row * 32 + fq * 8), p1 = *(const GAS f32x4*)(rowss + (size_t)row * 32 + fq * 8 + 4);
                    float s = (p0[0] + p0[1]) + (p0[2] + p0[3]) + (p1[0] + p1[1]) + (p1[2] + p1[3]); s = xsum16(s); s = xsum32(s);
                    const float r = rsqrtf(s * (1.f / DM) + EPS);
#pragma unroll
                    for (int bj = 0; bj < 2; ++bj) st8(o16 + (size_t)row * DM + u.pn * 256 + bj * 128 + cin, acc[ai][bj][m][0] * r, acc[ai][bj][m][1] * r); }
        } else {
            const GAS float* rsp = (const GAS float*)(ws + O_RSP); GAS bf16_t* zl1 = (GAS bf16_t*)(ws + O_ZL1); GAS float* ssl1 = (GAS float*)(ws + O_SSL1);
            const int slot0 = u.pn < 6 ? u.pn * 2 : (u.pn >= 12 ? 12 + (u.pn - 12) * 2 : -1);
#pragma unroll
            for (int ai = 0; ai < 2; ++ai)
#pragma unroll
                for (int m = 0; m < 4; ++m) { const int row = row0 + ai * 128 + m * 16;
                    const f32x4 q0 = *(const GAS f32x4*)(rsp + (size_t)row * 8), q1 = *(const GAS f32x4*)(rsp + (size_t)row * 8 + 4);
                    const float r = rsqrtf(((q0[0] + q0[1]) + (q0[2] + q0[3]) + (q1[0] + q1[1]) + (q1[2] + q1[3])) * (1.f / DM) + EPS);
#pragma unroll
                    for (int bj = 0; bj < 2; ++bj) { const f32x4 v0 = acc[ai][bj][m][0] * r, v1 = acc[ai][bj][m][1] * r;
                        st8(zl1 + (size_t)row * NL1 + u.pn * 256 + bj * 128 + cin, v0, v1);
                        if (slot0 >= 0) { float s = sq8(v0, v1); s = xsum16(s); s = xsum32(s);
                            if (fq == 0) ssl1[(size_t)row * 112 + (slot0 + bj) * 4 + wc] = s; } } }
        }
    }
};

namespace att {
constexpr float SCALE = 0.08838834764831845f;
constexpr int NW = 8, QBLK = 32, KVBLK = 64, QB = NW * QBLK, D = 128;
constexpr int SHM_V = KVBLK * D * 2, SHM_K = KVBLK * D * 2;
constexpr int OFF_WS = 2 * SHM_V + 2 * SHM_K;
constexpr int OFF_KS = OFF_WS + 2048;
constexpr int OFF_BS = OFF_KS + 16384;
constexpr int LDS_END = OFF_BS + 16384;
constexpr int WBIG = 1 << 28;

#define KSWZ(row, colB) ((row) * 256 + ((colB) ^ (((row) & 7) << 4)))
#define SBAR() __builtin_amdgcn_sched_barrier(0)
__device__ __forceinline__ int v_st(int k, int c) { const int kk = (k & ~0xC) | ((k & 4) << 1) | ((k & 8) >> 1); return ((kk >> 3) * 4 + (c >> 5)) * 512 + ((kk & 7) * 32 + (c & 31)) * 2; }
__device__ __forceinline__ int v_rd_base(int lane) { return ((lane & 3) << 3) | (((lane >> 2) & 3) << 6) | (((lane >> 4) & 1) << 5) | (((lane >> 5) & 1) << 8); }
constexpr int v_rd_off(int d0, int ks, int half) { return d0 * 512 + ks * 4096 + half * 2048; }
__device__ __forceinline__ int crow(int r, int hi) { return (r & 3) + 8 * (r >> 2) + 4 * hi; }
__device__ __forceinline__ bf16x8 load8(const GAS bf16_t* p) { return *(const GAS bf16x8*)p; }
__device__ __forceinline__ bf16x8 scale8(bf16x8 v, float s) { const u32x4 w = *reinterpret_cast<u32x4*>(&v); u32x4 o;
    o.x = cvtpk(bf_lo(w.x) * s, bf_hi(w.x) * s); o.y = cvtpk(bf_lo(w.y) * s, bf_hi(w.y) * s); o.z = cvtpk(bf_lo(w.z) * s, bf_hi(w.z) * s); o.w = cvtpk(bf_lo(w.w) * s, bf_hi(w.w) * s);
    return *reinterpret_cast<bf16x8*>(&o); }
__device__ __forceinline__ void mask_tile(f32x16& p0, f32x16& p1, int dq, unsigned W) {
    const float NEG = -__builtin_inff();
#pragma unroll
    for (int r = 0; r < 16; ++r) {
        const int c = (r & 3) + 8 * (r >> 2);
        if ((unsigned)(dq - c) >= W) p0[r] = NEG;
        if ((unsigned)(dq - c - 32) >= W) p1[r] = NEG;
    }
}
constexpr float THR = 8.f;
__device__ __forceinline__ void partialSM(f32x16& p0, f32x16& p1, float& m_reg, float& mn, float& alpha) {
    float pmax = p0[0]; for (int r = 1; r < 16; ++r) pmax = fmaxf(pmax, p0[r]); for (int r = 0; r < 16; ++r) pmax = fmaxf(pmax, p1[r]);
    { auto rr = __builtin_amdgcn_permlane32_swap(__float_as_uint(pmax), __float_as_uint(pmax), false, false);
      pmax = fmaxf(__uint_as_float(rr[0]), __uint_as_float(rr[1])); }
    constexpr float C2 = 1.4426950408889634f * SCALE;
    if (__builtin_expect(__all((pmax - m_reg) * SCALE <= THR), 1)) { mn = m_reg; alpha = 1.f; }
    else { mn = fmaxf(m_reg, pmax); alpha = __builtin_amdgcn_exp2f((m_reg - mn) * C2); m_reg = mn; }
    const float mnL = -mn * C2;
    for (int r = 0; r < 16; ++r) p0[r] = fmaf(p0[r], C2, mnL); for (int r = 0; r < 16; ++r) p1[r] = fmaf(p1[r], C2, mnL);
    for (int r = 0; r < 16; ++r) p0[r] = __builtin_amdgcn_exp2f(p0[r]);
}
__device__ __forceinline__ void finishSM(f32x16& p0, f32x16& p1, float alpha, float& l_reg, bf16x8& pa0, bf16x8& pa1, bf16x8& pa2, bf16x8& pa3) {
    for (int r = 0; r < 16; ++r) p1[r] = __builtin_amdgcn_exp2f(p1[r]);
    float ps = 0; for (int r = 0; r < 16; ++r) ps += p0[r]; for (int r = 0; r < 16; ++r) ps += p1[r];
    { auto rr = __builtin_amdgcn_permlane32_swap(__float_as_uint(ps), __float_as_uint(ps), false, false);
      ps = __uint_as_float(rr[0]) + __uint_as_float(rr[1]); }
    l_reg = l_reg * alpha + ps;
#define PK4(P, B_, OUT) do { unsigned a0 = cvtpk(P[B_+0], P[B_+1]), a1 = cvtpk(P[B_+2], P[B_+3]);                          \
        unsigned b0 = cvtpk(P[B_+4], P[B_+5]), b1 = cvtpk(P[B_+6], P[B_+7]);                                             \
        auto r0 = __builtin_amdgcn_permlane32_swap(a0, b0, false, false); auto r1 = __builtin_amdgcn_permlane32_swap(a1, b1, false, false); \
        u32x4 w = {r0[0], r1[0], r0[1], r1[1]}; OUT = *reinterpret_cast<bf16x8*>(&w); } while (0)
    PK4(p0, 0, pa0); PK4(p0, 8, pa1); PK4(p1, 0, pa2); PK4(p1, 8, pa3);
#undef PK4
}
template <int KB>
__device__ __forceinline__ void qkt(f32x16& p0, f32x16& p1, const char* K_lds, int r32, int hi, const bf16x8* qr, const float* bp  ) {
    { const f32x4 a = *(const f32x4*)(bp), b = *(const f32x4*)(bp + 8), c = *(const f32x4*)(bp + 16), d = *(const f32x4*)(bp + 24);
      p0 = (f32x16){a[0], a[1], a[2], a[3], b[0], b[1], b[2], b[3], c[0], c[1], c[2], c[3], d[0], d[1], d[2], d[3]}; }
    { const f32x4 a = *(const f32x4*)(bp + 32), b = *(const f32x4*)(bp + 40), c = *(const f32x4*)(bp + 48), d = *(const f32x4*)(bp + 56);
      p1 = (f32x16){a[0], a[1], a[2], a[3], b[0], b[1], b[2], b[3], c[0], c[1], c[2], c[3], d[0], d[1], d[2], d[3]}; }
    const char* kb[4];
#pragma unroll
    for (int dd = 0; dd < 4; ++dd) kb[dd] = K_lds + KB * SHM_K + KSWZ(r32, (dd * 16 + hi * 8) * 2);
#pragma unroll
    for (int d0 = 0; d0 < 8; ++d0) { const char* a = kb[d0 & 3] + (d0 >> 2) * 128;
        bf16x8 b0 = *reinterpret_cast<const bf16x8*>(a);
        bf16x8 b1 = *reinterpret_cast<const bf16x8*>(a + 32 * 256);
        p0 = __builtin_amdgcn_mfma_f32_32x32x16_bf16(b0, qr[d0], p0, 0, 0, 0);
        p1 = __builtin_amdgcn_mfma_f32_32x32x16_bf16(b1, qr[d0], p1, 0, 0, 0); }
}
template <int VB>
__device__ __forceinline__ void pv_tile(f32x16* o, int vb0, bf16x8 pa0, bf16x8 pa1, bf16x8 pa2, bf16x8 pa3) {
#define TRRD(dst, off) asm volatile("ds_read_b64_tr_b16 %0, %1 offset:%2" : "=&v"(dst) : "v"(vb0), "i"(off) : "memory")
#define PV_D0(d0) do { s16x4 l0, l1, l2, l3, h0, h1, h2_, h3; constexpr int b_ = VB * SHM_V + v_rd_off(d0, 0, 0); \
        TRRD(l0, b_); TRRD(h0, b_ + 2048); TRRD(l1, b_ + 4096); TRRD(h1, b_ + 6144); TRRD(l2, b_ + 8192); TRRD(h2_, b_ + 10240); TRRD(l3, b_ + 12288); TRRD(h3, b_ + 14336); \
        asm volatile("s_waitcnt lgkmcnt(0)" ::: "memory"); SBAR();   \
        o[d0] = __builtin_amdgcn_mfma_f32_32x32x16_bf16(pa0, (bf16x8){l0[0], l0[1], l0[2], l0[3], h0[0], h0[1], h0[2], h0[3]}, o[d0], 0, 0, 0);   \
        o[d0] = __builtin_amdgcn_mfma_f32_32x32x16_bf16(pa1, (bf16x8){l1[0], l1[1], l1[2], l1[3], h1[0], h1[1], h1[2], h1[3]}, o[d0], 0, 0, 0);   \
        o[d0] = __builtin_amdgcn_mfma_f32_32x32x16_bf16(pa2, (bf16x8){l2[0], l2[1], l2[2], l2[3], h2_[0], h2_[1], h2_[2], h2_[3]}, o[d0], 0, 0, 0);   \
        o[d0] = __builtin_amdgcn_mfma_f32_32x32x16_bf16(pa3, (bf16x8){l3[0], l3[1], l3[2], l3[3], h3[0], h3[1], h3[2], h3[3]}, o[d0], 0, 0, 0); } while (0)
    PV_D0(0); PV_D0(1); PV_D0(2); PV_D0(3);
#undef PV_D0
#undef TRRD
}

struct BlockRef { const GAS bf16_t* Q; const GAS bf16_t* K; const GAS bf16_t* V; GAS bf16_t* O; const GAS float* qss; const GAS float* kss; const GAS float* cc; const GAS float* gg;
                  int P0, skv; };
constexpr int LDQ = 5120, LDK = 5120, LDO = 2048, LDSS = 112;
struct Seam { bf16x8 qr[8]; bf16x8 st_v0, st_v1, st_k0, st_k1; int jlo; };
#define ROWK(p, k0, rr) ((p) + (size_t)((k0) + (rr)) * LDK + sc)
#define VMW() asm volatile("s_waitcnt vmcnt(0)" ::: "memory")
#define VMWN(n) asm volatile("s_waitcnt vmcnt(%0)" :: "i"(n) : "memory")
#define SLOAD_H(Kp, Vp, k0) do { S.st_v0 = load8(ROWK(Vp, k0, sr)); S.st_v1 = load8(ROWK(Vp, k0, 32 + sr));              \
                         S.st_k0 = load8(ROWK(Kp, k0, sr)); S.st_k1 = load8(ROWK(Kp, k0, 32 + sr)); } while (0)
#define SWRITE_HK(bf, k0) do { *(bf16x8*)(K_lds + (bf) * SHM_K + kws) = scale8(S.st_k0, ksr[(k0)]); *(bf16x8*)(K_lds + (bf) * SHM_K + kws + 32 * 256) = scale8(S.st_k1, ksr[(k0) + 32]); } while (0)
#define SWRITE_HV(bf) do { *(bf16x8*)(V_lds + (bf) * SHM_V + vst0) = S.st_v0; *(bf16x8*)(V_lds + (bf) * SHM_V + vst1) = S.st_v1; } while (0)
#define SWRITE_H(bf, k0) do { SWRITE_HV(bf); SWRITE_HK(bf, k0); } while (0)

__device__ __forceinline__ void attn_prime(const BlockRef& cur, char* lds, Seam& S, const int tid) {
    const int wid = __builtin_amdgcn_readfirstlane(tid >> 6), lane = tid & 63, r32 = lane & 31, hi = lane >> 5;
    const int sr = tid >> 4, sc = (tid & 15) * 8, kws = KSWZ(sr, sc * 2); char* K_lds = lds + 2 * SHM_V;
    float* ks_l = (float*)(lds + OFF_KS); float* bs_l = (float*)(lds + OFF_BS); const float* ksr = ks_l + sr;
    int j_hi = (cur.P0 + QB - 1) / KVBLK + 1; if (j_hi > cur.skv / KVBLK) j_hi = cur.skv / KVBLK;
    const int nkeys = j_hi * KVBLK;
    const float c0 = cur.cc ? cur.cc[cur.P0] : 0.f;
    int jlo = 0;
    if (cur.cc) { const float thr = cur.gg[128]; const int jd = cur.P0 / KVBLK;
        const float cv = lane <= jd ? cur.cc[lane * KVBLK + KVBLK - 1] : 0.f;
        const bool keep = lane > jd || (c0 - cv > -thr);
        jlo = __ffsll((long long)__ballot(keep)) - 1; }
    S.jlo = jlo;
    for (int s = jlo * KVBLK + tid; s < nkeys; s += NTHREADS) {
        const f32x4 p = *(const GAS f32x4*)(cur.kss + (size_t)s * LDSS);
        ks_l[s] = rsqrtf(((p[0] + p[1]) + (p[2] + p[3])) * (1.f / 128.f) + EPS);
        bs_l[s] = cur.cc ? (c0 - cur.cc[s]) * (1.f / SCALE) : 0.f;
    }
    __syncthreads();
    const int qrow = wid * QBLK + r32;
    const f32x4 qp = *(const GAS f32x4*)(cur.qss + (size_t)qrow * LDSS);
    const float rq = rsqrtf(((qp[0] + qp[1]) + (qp[2] + qp[3])) * (1.f / 128.f) + EPS);
#pragma unroll
    for (int d0 = 0; d0 < 8; ++d0) {
        const u32x4 w = *(const GAS u32x4*)(cur.Q + (size_t)qrow * LDQ + d0 * 16 + hi * 8);
        const f32x4 g0 = *(const GAS f32x4*)(cur.gg + d0 * 16 + hi * 8), g1 = *(const GAS f32x4*)(cur.gg + d0 * 16 + hi * 8 + 4);
        u32x4 o; o.x = cvtpk(bf_lo(w.x) * rq * g0[0], bf_hi(w.x) * rq * g0[1]); o.y = cvtpk(bf_lo(w.y) * rq * g0[2], bf_hi(w.y) * rq * g0[3]);
        o.z = cvtpk(bf_lo(w.z) * rq * g1[0], bf_hi(w.z) * rq * g1[1]); o.w = cvtpk(bf_lo(w.w) * rq * g1[2], bf_hi(w.w) * rq * g1[3]);
        S.qr[d0] = *reinterpret_cast<bf16x8*>(&o);
    }
    SLOAD_H(cur.K, cur.V, jlo * KVBLK); VMW(); SWRITE_HK(0, jlo * KVBLK);
    __syncthreads();
}
__device__ __forceinline__ void attn_block(const BlockRef& cur, char* lds, Seam& S, const int tid) {
    const int wid = __builtin_amdgcn_readfirstlane(tid >> 6), lane = tid & 63, r32 = lane & 31, hi = lane >> 5;
    const int W = WBIG;
    int j_hi = (cur.P0 + QB - 1) / KVBLK + 1; if (j_hi > cur.skv / KVBLK) j_hi = cur.skv / KVBLK;
    const int j_lo = S.jlo; const int NT = j_hi - j_lo;
    const int qlo = cur.P0 - j_lo * KVBLK + wid * QBLK, qm = qlo + r32 - 4 * hi;
    char* V_lds = lds; char* K_lds = lds + 2 * SHM_V;
    float* ws = (float*)(lds + OFF_WS) + wid * 64; float* li_l = ws, * al_l = ws + 32;
    const float* bs_l = (const float*)(lds + OFF_BS) + j_lo * KVBLK + 4 * hi;
    float m_reg = -1e30f, l_reg = 0; f32x16 o[4] = {};
    const int sr = tid >> 4, sc = (tid & 15) * 8, vst0 = v_st(sr, sc), vst1 = v_st(32 + sr, sc), kws = KSWZ(sr, sc * 2);
    const float* ksr = (const float*)(lds + OFF_KS) + j_lo * KVBLK + sr;
    const int vb0 = (int)(uintptr_t)V_lds + v_rd_base(lane);
    const GAS bf16_t* Kh = cur.K + (size_t)j_lo * KVBLK * LDK; const GAS bf16_t* Vh = cur.V + (size_t)j_lo * KVBLK * LDK;
#define RESC(a) do { if (__any((a) < 1.f)) { if (hi == 0) al_l[r32] = (a); asm volatile("s_waitcnt lgkmcnt(0)" ::: "memory");              \
                     for (int d_ = 0; d_ < 4; ++d_) for (int r = 0; r < 16; ++r) o[d_][r] *= al_l[crow(r, hi)]; } } while (0)
#define KBASE(t) ((t) * KVBLK)
#define MASKT(P0_, P1_, t) do { const int kb_ = KBASE(t); if (kb_ + KVBLK - 1 > qlo) mask_tile(P0_, P1_, qm - kb_, (unsigned)W); } while (0)
    f32x16 pA0, pA1, pB0, pB1; float mnA, mnB, alA, alB; bf16x8 pa0, pa1, pa2, pa3;
    SWRITE_HV(0); SBAR();
    if (NT > 1) { SLOAD_H(Kh, Vh, KBASE(1)); }
    SBAR(); qkt<0>(pA0, pA1, K_lds, r32, hi, S.qr, bs_l + KBASE(0));
    MASKT(pA0, pA1, 0); partialSM(pA0, pA1, m_reg, mnA, alA);
    if (NT > 1) { VMW(); SWRITE_H(1, KBASE(1)); }
    __syncthreads();
#define HALF_STEP(PX0, PX1, mnX, alX, PY0, PY1, alY, t, KB, VB, SB) do {                                                      \
        SBAR(); qkt<KB>(PX0, PX1, K_lds, r32, hi, S.qr, bs_l + KBASE(t));                                                         \
        finishSM(PY0, PY1, alY, l_reg, pa0, pa1, pa2, pa3); SBAR();                                                           \
        if ((t) + 1 < NT) { SLOAD_H(Kh, Vh, KBASE((t) + 1)); SBAR(); }                                               \
        pv_tile<VB>(o, vb0, pa0, pa1, pa2, pa3); MASKT(PX0, PX1, (t)); partialSM(PX0, PX1, m_reg, mnX, alX);                                        \
        __syncthreads();                                                                                                      \
        if ((t) + 1 < NT) { VMW(); SWRITE_H(SB, KBASE((t) + 1)); }                                                                          \
        RESC(alX); __syncthreads(); } while (0)
    for (int t = 1; t + 1 < NT; t += 2) {
        HALF_STEP(pB0, pB1, mnB, alB, pA0, pA1, alA, t, 1, 0, 0);
        HALF_STEP(pA0, pA1, mnA, alA, pB0, pB1, alB, t + 1, 0, 1, 1);
    }
    const bool even = (NT & 1) == 0;
    if (even) { SBAR(); qkt<1>(pB0, pB1, K_lds, r32, hi, S.qr, bs_l + KBASE(NT - 1)); SBAR(); }
    finishSM(pA0, pA1, alA, l_reg, pa0, pa1, pa2, pa3); SBAR();
    pv_tile<0>(o, vb0, pa0, pa1, pa2, pa3);
    if (even) { MASKT(pB0, pB1, NT - 1); partialSM(pB0, pB1, m_reg, mnB, alB); __syncthreads(); RESC(alB);
        finishSM(pB0, pB1, alB, l_reg, pa0, pa1, pa2, pa3); SBAR(); pv_tile<1>(o, vb0, pa0, pa1, pa2, pa3); }
    SBAR();
    if (hi == 0) li_l[r32] = l_reg; asm volatile("s_waitcnt lgkmcnt(0)" ::: "memory");
    float rli[16];
#pragma unroll
    for (int r = 0; r < 16; ++r) rli[r] = __builtin_amdgcn_rcpf(li_l[crow(r, hi)]);
    GAS bf16_t* Ow = cur.O + (size_t)(wid * QBLK) * LDO;
#pragma unroll
    for (int r = 0; r < 16; ++r) { const int orow = crow(r, hi);
#pragma unroll
        for (int d0 = 0; d0 < 4; ++d0) { const float v = o[d0][r] * rli[r];
            const float vn = dppf<0xB1>(v);
            if ((r32 & 1) == 0) *(GAS unsigned*)(Ow + (size_t)orow * LDO + d0 * 32 + r32) = cvtpk(v, vn); } }
    __syncthreads();
#undef RESC
#undef KBASE
#undef MASKT
#undef HALF_STEP
}
#undef ROWK
#undef VMW
#undef VMWN
#undef SLOAD_H
#undef SWRITE_HK
#undef SWRITE_HV
#undef SWRITE_H
#undef KSWZ
#undef SBAR
}


struct Frame {
    GAS unsigned char* ws; const float* const* in_; GAS float* out;
    __device__ __forceinline__ const GAS float* in(int i) const { return (const GAS float*)in_[i]; }
    int tid, lane, wave, gw, ngw, gtid, ngt;
};
enum { I_X = 0, I_MEM, I_ANORM, I_AWIN, I_ACONVW, I_ACONVB, I_AGATEW, I_AGATEB, I_ALAMBDA, I_AWOUT, I_SNORM, I_SWKVF, I_SBF, I_SKNORM, I_BNORM, I_BWIN, I_BQNORM, I_BWOUT,
       I_MNORM, I_MWKV, I_MQNORM, I_MKNORM, I_PNORM, I_PWQ, I_PSUBK, I_PU, I_PV, N_IN };

__device__ __forceinline__ void transpose_item(const GAS float* W, int ldw, int coff, const GAS float* gain, GAS bf16_t* WT, int ldt, int row_off, LAS float* scr, int nblk, int item, int lane) {
    const int kb = item / nblk, nb = item % nblk, k0 = 64 * kb, n0 = 32 * nb;
    float wv[32];
#pragma unroll
    for (int i = 0; i < 32; ++i) wv[i] = W[(size_t)(k0 + 2 * i + (lane >> 5)) * ldw + coff + n0 + (lane & 31)];
    if (gain) {
#pragma unroll
        for (int i = 0; i < 32; ++i) wv[i] *= gain[k0 + 2 * i + (lane >> 5)]; }
#pragma unroll
    for (int i = 0; i < 32; ++i) scr[(2 * i + (lane >> 5)) * 33 + (lane & 31)] = wv[i];
    asm volatile("s_waitcnt lgkmcnt(0)" ::: "memory");
    const int c = lane & 7;
#pragma unroll
    for (int j = 0; j < 4; ++j) { const int n = (lane >> 3) + 8 * j; const LAS float* s = scr + (8 * c) * 33 + n;
        u32x4 o; o.x = cvtpk(s[0 * 33], s[1 * 33]); o.y = cvtpk(s[2 * 33], s[3 * 33]); o.z = cvtpk(s[4 * 33], s[5 * 33]); o.w = cvtpk(s[6 * 33], s[7 * 33]);
        *(GAS u32x4*)(WT + (size_t)(row_off + n0 + n) * ldt + k0 + 8 * c) = o; }
    asm volatile("s_waitcnt lgkmcnt(0)" ::: "memory");
}
__device__ __forceinline__ void transpose_item_fp8(const GAS float* W, int ldw, const GAS float* gain, GAS unsigned char* WT, int ldt, LAS float* scr, int nblk, int item, int lane) {
    const int kb = item / nblk, nb = item % nblk, k0 = 64 * kb, n0 = 32 * nb;
    float wv[32];
#pragma unroll
    for (int i = 0; i < 32; ++i) wv[i] = W[(size_t)(k0 + 2 * i + (lane >> 5)) * ldw + n0 + (lane & 31)];
#pragma unroll
    for (int i = 0; i < 32; ++i) wv[i] *= gain[k0 + 2 * i + (lane >> 5)] * 64.f;
#pragma unroll
    for (int i = 0; i < 32; ++i) scr[(2 * i + (lane >> 5)) * 33 + (lane & 31)] = wv[i];
    asm volatile("s_waitcnt lgkmcnt(0)" ::: "memory");
    const int c = lane & 3;
#pragma unroll
    for (int j = 0; j < 2; ++j) { const int n = (lane >> 2) + 16 * j; const LAS float* sp = scr + (16 * c) * 33 + n; u32x4 o;
#pragma unroll
        for (int w = 0; w < 4; ++w) { int pk = __builtin_amdgcn_cvt_pk_fp8_f32(sp[(4 * w) * 33], sp[(4 * w + 1) * 33], 0, false); pk = __builtin_amdgcn_cvt_pk_fp8_f32(sp[(4 * w + 2) * 33], sp[(4 * w + 3) * 33], pk, true); o[w] = (unsigned)pk; }
        *(GAS u32x4*)(WT + (size_t)(n0 + n) * ldt + k0 + 16 * c) = o; }
    asm volatile("s_waitcnt lgkmcnt(0)" ::: "memory");
}
__device__ __forceinline__ void convert_tables(Frame& F, int layer, int ibeg, int iend, int wk, int nwk) {
    for (int it0 = ibeg + wk; it0 < iend; it0 += 2 * nwk) {
        f32x4 v[2][8]; GAS unsigned char* dst[2]; int rowq[2], whichq[2];
#pragma unroll
        for (int q = 0; q < 2; ++q) { const int it = it0 + q * nwk < iend ? it0 + q * nwk : it0; const int which = it & 1, row = it >> 1; rowq[q] = row; whichq[q] = which;
            const GAS float* src = F.in(which ? I_PV : I_PU) + ((size_t)layer * NEXP + row) * DM + F.lane * 4;
            const GAS float* gn = F.in(I_PNORM) + layer * DM + F.lane * 4;
            dst[q] = F.ws + O_TAB + (size_t)(layer * 2 + which) * TAB_ONE;
#pragma unroll
            for (int c = 0; c < 8; ++c) { v[q][c] = *(const GAS f32x4*)(src + c * 256); if (!which) v[q][c] = v[q][c] * *(const GAS f32x4*)(gn + c * 256); } }
#pragma unroll
        for (int q = 0; q < 2; ++q) { _Float16 shv = (_Float16)0.f;
#pragma unroll
            for (int c = 0; c < 8; ++c) { const f32x4 x = v[q][c];
                float amax = fmaxf(fmaxf(fabsf(x[0]), fabsf(x[1])), fmaxf(fabsf(x[2]), fabsf(x[3])));
                amax = fmaxf(amax, dppf<0xB1>(amax)); amax = fmaxf(amax, dppf<0x4E>(amax)); amax = fmaxf(amax, dppf<0x141>(amax)); amax = fmaxf(amax, dppf<0x140>(amax));
                amax = xmax16(amax); amax = xmax32(amax);
                const _Float16 sh = (_Float16)fmaxf(amax * (whichq[q] ? 1.f / 6.f : 1.f / 7.f), 1e-6f);
                const float qs = 1.f / (float)sh;
                unsigned pk;
                if (whichq[q]) { pk = __builtin_amdgcn_cvt_scalef32_pk_fp4_f32(0u, x[0] * qs, x[1] * qs, 1.0f, 0); pk = __builtin_amdgcn_cvt_scalef32_pk_fp4_f32(pk, x[2] * qs, x[3] * qs, 1.0f, 1); }
                else { const int q0 = (int)fminf(fmaxf(rintf(x[0] * qs), -7.f), 7.f), q1 = (int)fminf(fmaxf(rintf(x[1] * qs), -7.f), 7.f), q2 = (int)fminf(fmaxf(rintf(x[2] * qs), -7.f), 7.f), q3 = (int)fminf(fmaxf(rintf(x[3] * qs), -7.f), 7.f);
                       pk = (unsigned)(q0 & 15) | ((unsigned)(q1 & 15) << 4) | ((unsigned)(q2 & 15) << 8) | ((unsigned)(q3 & 15) << 12); }
                *(GAS unsigned short*)(dst[q] + ((size_t)c * NEXP + rowq[q]) * 128 + F.lane * 2) = (unsigned short)pk;
                shv = (F.lane == c) ? sh : shv; }
            if (F.lane < 8) *(GAS unsigned short*)(dst[q] + TAB_NIB + ((size_t)rowq[q] * 8 + F.lane) * 2) = __builtin_bit_cast(unsigned short, shv); }
    }
}
__device__ __forceinline__ void norm_row_bf16(const GAS float* xrow, const GAS float* gain, GAS bf16_t* orow, int lane) {
    f32x4 v[8]; float s = 0.f;
#pragma unroll
    for (int j = 0; j < 8; ++j) { v[j] = *(const GAS f32x4*)(xrow + j * 256 + lane * 4); s += (v[j][0] * v[j][0] + v[j][1] * v[j][1]) + (v[j][2] * v[j][2] + v[j][3] * v[j][3]); }
    const float r = rsqrtf(wave_sum(s) * (1.f / DM) + EPS);
#pragma unroll
    for (int j = 0; j < 8; ++j) { f32x4 g = gain ? *(const GAS f32x4*)(gain + j * 256 + lane * 4) : (f32x4){1.f, 1.f, 1.f, 1.f};
        u32x2 o; o.x = cvtpk(v[j][0] * r * g[0], v[j][1] * r * g[1]); o.y = cvtpk(v[j][2] * r * g[2], v[j][3] * r * g[3]);
        *(GAS u32x2*)(orow + j * 256 + lane * 4) = o; }
}
__device__ __forceinline__ void step_prologue(Frame& F, LAS unsigned char* lds) {
    LAS float* scr = (LAS float*)(lds + F.wave * 16384);
    GAS unsigned char* ws = F.ws;
    constexpr int I0 = 32 * (NIN0 / 32), I1 = 32 * 64, I2 = 32 * 96, I3 = 32 * 64, I4 = 32 * 64, I5 = 32 * 64, I6 = 32 * 64, I7 = 32 * 32, I8 = 32 * 32, I9 = 12 * 16;
    constexpr int NITEMS = I0 + I1 + I2 + I3 + I4 + I5 + I6 + I7 + I8 + I9;
    for (int it = F.gw; it < NITEMS; it += F.ngw) {
        int r = it;
        if (r < I0) { transpose_item(F.in(I_AWIN), NIN0, 0, F.in(I_ANORM), (GAS bf16_t*)(ws + O_WIN0), DM, 0, scr, NIN0 / 32, r, F.lane); continue; } r -= I0;
        if (r < I1) { transpose_item(F.in(I_AWOUT), DM, 0, nullptr, (GAS bf16_t*)(ws + O_WOUT0), DM, 0, scr, 64, r, F.lane); continue; } r -= I1;
        if (r < I2) { transpose_item(F.in(I_SWKVF), 3084, 0, F.in(I_SNORM), (GAS bf16_t*)(ws + O_WL1), DM, 0, scr, 96, r, F.lane); continue; } r -= I2;
        if (r < I3) { transpose_item(F.in(I_BWIN), DM, 0, F.in(I_BNORM), (GAS bf16_t*)(ws + O_WL1), DM, 3072, scr, 64, r, F.lane); continue; } r -= I3;
        if (r < I4) { transpose_item(F.in(I_BWOUT), DM, 0, nullptr, (GAS bf16_t*)(ws + O_WOUT1), DM, 0, scr, 64, r, F.lane); continue; } r -= I4;
        if (r < I5) { transpose_item(F.in(I_PWQ), DM, 0, F.in(I_PNORM), (GAS bf16_t*)(ws + O_WQ0), DM, 0, scr, 64, r, F.lane); continue; } r -= I5;
        if (r < I6) { transpose_item(F.in(I_PWQ) + (size_t)DM * DM, DM, 0, F.in(I_PNORM) + DM, (GAS bf16_t*)(ws + O_WQ1), DM, 0, scr, 64, r, F.lane); continue; } r -= I6;
        if (r < I7) { transpose_item(F.in(I_MWKV), 1024, 0, nullptr, (GAS bf16_t*)(ws + O_WMKV), DM, 0, scr, 32, r, F.lane); continue; } r -= I7;
        if (r < I8) { transpose_item(F.in(I_MWKV) + (size_t)DM * 1024, 1024, 0, nullptr, (GAS bf16_t*)(ws + O_WMKV) + (size_t)1024 * DM, DM, 0, scr, 32, r, F.lane); continue; } r -= I8;
        { const int blk = r / 16, sub = r % 16;
          transpose_item(F.in(I_AGATEW) + (size_t)blk * 128 * 256, 256, 0, nullptr, (GAS bf16_t*)(ws + O_WGATE), 128, blk * 256, scr, 8, sub, F.lane); }
    }
    { const GAS float* sk = F.in(I_PSUBK); GAS bf16_t* o = (GAS bf16_t*)(ws + O_SUBK);
      for (int i = F.gtid; i < 2 * 16 * 128 * 128 / 2; i += F.ngt) *(GAS unsigned*)(o + 2 * i) = cvtpk(sk[2 * i], sk[2 * i + 1]); }
    { GAS float* wf = (GAS float*)(ws + O_WF); const GAS float* w = F.in(I_SWKVF); const GAS float* g = F.in(I_SNORM);
      for (int i = F.gtid; i < 12 * DM; i += F.ngt) { const int j = i / DM, k = i % DM; wf[i] = w[(size_t)k * 3084 + 3072 + j] * g[k]; } }
    { GAS float* spl = (GAS float*)(ws + O_SPL); const GAS float* lam = F.in(I_ALAMBDA);
      for (int i = F.gtid; i < LRU; i += F.ngt) { const float z = -lam[i]; spl[i] = fmaxf(z, 0.f) + log1p_pos(fast_exp(-fabsf(z))); } }
    if (F.gw == 0) {
        float m = 0.f; for (int d = F.lane; d < 128; d += 64) m = fmaxf(m, fabsf(F.in(I_BQNORM)[d] * F.in(I_SKNORM)[d]));
        m = wave_max(m);
        if (F.lane == 0) ((GAS float*)(ws + O_GG))[512] = 2.f * 11.3137085f * m + 40.f; }
    { GAS float* gg = (GAS float*)(ws + O_GG);
      for (int i = F.gtid; i < 384; i += F.ngt) { const int a = i / 128, d = i % 128;
          gg[a == 0 ? 384 + d : i] = a == 0 ? F.in(I_BQNORM)[d] * F.in(I_SKNORM)[d] : F.in(I_MQNORM)[(a - 1) * 128 + d] * F.in(I_MKNORM)[(a - 1) * 128 + d]; } }
    for (int m = F.gw; m < T; m += 2 * F.ngw) {
        const int m1 = m + F.ngw < T ? m + F.ngw : m;
        const GAS float* x0 = F.in(I_X) + (size_t)m * DM + F.lane * 4; const GAS float* x1 = F.in(I_X) + (size_t)m1 * DM + F.lane * 4;
        f32x4 v0[8], v1[8]; float s0 = 0.f, s1 = 0.f;
#pragma unroll
        for (int j = 0; j < 8; ++j) { v0[j] = *(const GAS f32x4*)(x0 + j * 256); v1[j] = *(const GAS f32x4*)(x1 + j * 256); }
#pragma unroll
        for (int j = 0; j < 8; ++j) { s0 += (v0[j][0] * v0[j][0] + v0[j][1] * v0[j][1]) + (v0[j][2] * v0[j][2] + v0[j][3] * v0[j][3]); s1 += (v1[j][0] * v1[j][0] + v1[j][1] * v1[j][1]) + (v1[j][2] * v1[j][2] + v1[j][3] * v1[j][3]); }
        const float r0 = rsqrtf(wave_sum(s0) * (1.f / DM) + EPS), r1 = rsqrtf(wave_sum(s1) * (1.f / DM) + EPS);
        GAS bf16_t* o0 = (GAS bf16_t*)(ws + O_XS16) + (size_t)m * DM + F.lane * 4; GAS bf16_t* o1 = (GAS bf16_t*)(ws + O_XS16) + (size_t)m1 * DM + F.lane * 4;
#pragma unroll
        for (int j = 0; j < 8; ++j) { u32x2 a; a.x = cvtpk(v0[j][0] * r0, v0[j][1] * r0); a.y = cvtpk(v0[j][2] * r0, v0[j][3] * r0); *(GAS u32x2*)(o0 + j * 256) = a;
            u32x2 b; b.x = cvtpk(v1[j][0] * r1, v1[j][1] * r1); b.y = cvtpk(v1[j][2] * r1, v1[j][3] * r1); *(GAS u32x2*)(o1 + j * 256) = b; }
    }
    for (int m = F.gw; m < 2 * NMROW; m += F.ngw) { const int l = m / NMROW, r = m % NMROW;
        norm_row_bf16(F.in(I_MEM) + (size_t)r * DM, F.in(I_MNORM) + l * DM, (GAS bf16_t*)(ws + O_MEMN) + (size_t)m * DM, F.lane); }
    convert_tables(F, 0, 0, 2 * NEXP, F.gw, F.ngw);
}
__device__ __forceinline__ void step_conv(Frame& F) {
    const GAS bf16_t* zx = (const GAS bf16_t*)(F.ws + O_ZX); GAS bf16_t* xc = (GAS bf16_t*)(F.ws + O_XC);
    const GAS float* cw = F.in(I_ACONVW); const GAS float* cb = F.in(I_ACONVB);
    for (int it = F.gtid; it < T * (LRU / 8); it += F.ngt) {
        const int t = it / (LRU / 8), c8 = (it % (LRU / 8)) * 8, pos = t & (SEQ - 1);
        float a[8];
#pragma unroll
        for (int j = 0; j < 8; ++j) a[j] = cb[c8 + j];
#pragma unroll
        for (int k = 0; k < 4; ++k) { if (pos - 3 + k >= 0) { const u32x4 w = *(const GAS u32x4*)(zx + (size_t)(t - 3 + k) * LRU + c8);
            const float xv[8] = {bf_lo(w.x), bf_hi(w.x), bf_lo(w.y), bf_hi(w.y), bf_lo(w.z), bf_hi(w.z), bf_lo(w.w), bf_hi(w.w)};
#pragma unroll
            for (int j = 0; j < 8; ++j) a[j] = fmaf(cw[k * LRU + c8 + j], xv[j], a[j]); } }
        u32x4 o; o.x = cvtpk(a[0], a[1]); o.y = cvtpk(a[2], a[3]); o.z = cvtpk(a[4], a[5]); o.w = cvtpk(a[6], a[7]);
        *(GAS u32x4*)(xc + (size_t)t * LRU + c8) = o;
    }
}
__device__ __forceinline__ void step_scan1(Frame& F) {
    const GAS float* AA = (const GAS float*)(F.ws + O_AA); const GAS float* UU = (const GAS float*)(F.ws + O_UU);
    GAS float* CA = (GAS float*)(F.ws + O_CARRY); GAS float* CH = CA + (size_t)NB * 64 * LRU;
    if (F.tid >= LRU / 4) return;
    for (int it = blockIdx.x; it < NB * 64; it += gridDim.x) {
        const int b = it >> 6, ck = it & 63; const size_t base = ((size_t)b * SEQ + ck * 64) * LRU + F.tid * 4;
        f32x4 ap = {1.f, 1.f, 1.f, 1.f}, h = {0.f, 0.f, 0.f, 0.f};
#pragma unroll 8
        for (int i = 0; i < 64; ++i) { const f32x4 a = *(const GAS f32x4*)(AA + base + (size_t)i * LRU), u = *(const GAS f32x4*)(UU + base + (size_t)i * LRU);
            ap = ap * a; h = a * h + u; }
        *(GAS f32x4*)(CA + (size_t)it * LRU + F.tid * 4) = ap; *(GAS f32x4*)(CH + (size_t)it * LRU + F.tid * 4) = h;
    }
}
__device__ __forceinline__ void step_scan2(Frame& F) {
    const GAS float* AA = (const GAS float*)(F.ws + O_AA); const GAS float* UU = (const GAS float*)(F.ws + O_UU);
    const GAS float* CA = (const GAS float*)(F.ws + O_CARRY); const GAS float* CH = CA + (size_t)NB * 64 * LRU;
    const GAS bf16_t* gy = (const GAS bf16_t*)(F.ws + O_GY); GAS bf16_t* cat = (GAS bf16_t*)(F.ws + O_CAT);
    if (F.tid >= LRU / 4) return;
    for (int it = blockIdx.x; it < NB * 64; it += gridDim.x) {
        const int b = it >> 6, ck = it & 63; const size_t base = ((size_t)b * SEQ + ck * 64) * LRU + F.tid * 4;
        f32x4 h = {0.f, 0.f, 0.f, 0.f};
        for (int k = 0; k < ck; ++k) { const size_t o = (size_t)(b * 64 + k) * LRU + F.tid * 4; h = *(const GAS f32x4*)(CA + o) * h + *(const GAS f32x4*)(CH + o); }
#pragma unroll 8
        for (int i = 0; i < 64; ++i) { const f32x4 a = *(const GAS f32x4*)(AA + base + (size_t)i * LRU), u = *(const GAS f32x4*)(UU + base + (size_t)i * LRU);
            h = a * h + u;
            const size_t row = (size_t)b * SEQ + ck * 64 + i;
            const u32x2 g = *(const GAS u32x2*)(gy + row * LRU + F.tid * 4);
            u32x2 o; o.x = cvtpk(h[0] * bf_lo(g.x), h[1] * bf_hi(g.x)); o.y = cvtpk(h[2] * bf_lo(g.y), h[3] * bf_hi(g.y));
            *(GAS u32x2*)(cat + row * DM + F.tid * 4) = o; }
    }
}
__device__ __forceinline__ void step_cprefix(Frame& F, LAS unsigned char* lds) {
    const GAS float* lf = (const GAS float*)(F.ws + O_LOGF); GAS float* cc = (GAS float*)(F.ws + O_CC);
    LAS double* scr = (LAS double*)(lds + F.wave * 16384);
    for (int it = F.gw; it < NB * NH; it += F.ngw) {
        const GAS float* p = lf + (size_t)it * SEQ + F.lane * 64; GAS float* q = cc + (size_t)it * SEQ + F.lane * 64;
        double s = 0.0;
        for (int i = 0; i < 64; ++i) s += (double)p[i];
        scr[F.lane] = s;
        asm volatile("s_waitcnt lgkmcnt(0)" ::: "memory");
        double run = 0.0;
        for (int l = 0; l < 64; ++l) { const double v = scr[l]; if (l < F.lane) run += v; }
        for (int i = 0; i < 64; ++i) { run += (double)p[i]; q[i] = (float)run; }
        asm volatile("s_waitcnt lgkmcnt(0)" ::: "memory");
    }
}

__device__ __forceinline__ int ord_i(float f) { const int b = __float_as_int(f); return b ^ ((b >> 31) & 0x7fffffff); }
__device__ __forceinline__ float unord_f(int k) { return __int_as_float(k ^ ((k >> 31) & 0x7fffffff)); }
template <int N> __device__ __forceinline__ void bitonic_sort_desc(int (&a)[N]) {
#pragma unroll
    for (int k = 2; k <= N; k <<= 1) {
#pragma unroll
        for (int j = k >> 1; j > 0; j >>= 1) {
#pragma unroll
            for (int i = 0; i < N; ++i) { const int l = i ^ j;
                if (l > i) { const bool desc = ((i & k) == 0); const int mx = max(a[i], a[l]), mn = min(a[i], a[l]); a[i] = desc ? mx : mn; a[l] = desc ? mn : mx; } }
        }
    }
}
__device__ __forceinline__ void bitonic_merge16_desc(int (&a)[16]) {
#pragma unroll
    for (int j = 8; j > 0; j >>= 1) {
#pragma unroll
        for (int i = 0; i < 16; ++i) { const int l = i ^ j; if (l > i) { const int mx = max(a[i], a[l]), mn = min(a[i], a[l]); a[i] = mx; a[l] = mn; } }
    }
}
__device__ __forceinline__ void subkey_top16(const GAS bf16_t* qrow  , const GAS bf16_t* sk  , int r32, int hi, int (&top)[16]) {
    bf16x8 qf[8];
#pragma unroll
    for (int ks = 0; ks < 8; ++ks) qf[ks] = *(const GAS bf16x8*)(qrow + ks * 16 + hi * 8);
    unsigned loff = (unsigned)(r32 * 128 + hi * 8) * 2u; asm volatile("" : "+v"(loff));
    int key[64];
#pragma unroll
    for (int kb = 0; kb < 4; ++kb) {
        f32x16 acc = {};
#pragma unroll
        for (int ks = 0; ks < 8; ++ks) { const bf16x8 af = *(const GAS bf16x8*)((const GAS char*)(sk + kb * 32 * 128 + ks * 16) + loff);
            acc = __builtin_amdgcn_mfma_f32_32x32x16_bf16(af, qf[ks], acc, 0, 0, 0); }
#pragma unroll
        for (int r = 0; r < 16; ++r) { const int id = kb * 32 + (r & 3) + 8 * (r >> 2) + 4 * hi; key[kb * 16 + r] = (ord_i(acc[r]) & ~127) | (127 - id); }
        __builtin_amdgcn_sched_barrier(0);
    }
    bitonic_sort_desc<64>(key);
#pragma unroll
    for (int i = 0; i < 16; ++i) { auto r = __builtin_amdgcn_permlane32_swap((unsigned)key[15 - i], (unsigned)key[15 - i], false, false);
        const int pk = hi ? (int)r[0] : (int)r[1]; top[i] = max(key[i], pk); }
    bitonic_merge16_desc(top);
}
__device__ __forceinline__ void step_topk(Frame& F, LAS unsigned char* lds, int layer) {
    const GAS bf16_t* q16 = (const GAS bf16_t*)(F.ws + O_Q16); const GAS bf16_t* subk = (const GAS bf16_t*)(F.ws + O_SUBK) + (size_t)layer * 16 * 128 * 128;
    GAS int* IDX = (GAS int*)(F.ws + O_IDX); GAS float* GW = (GAS float*)(F.ws + O_GW);
    LAS int* scr = (LAS int*)(lds + F.wave * 16384) + F.lane * 33;
    const int r32 = F.lane & 31, hi = F.lane >> 5;
    for (int task = F.gw; task < (T / 32) * 8; task += F.ngw) {
        const int tb = task >> 3, h = task & 7; const int tok = tb * 32 + r32;
        const GAS bf16_t* qrow = q16 + (size_t)tok * DM + h * 256;
        int ta[16], tb16[16];
        subkey_top16(qrow, subk + (size_t)(h * 2 + 0) * 128 * 128, r32, hi, ta);
        subkey_top16(qrow + 128, subk + (size_t)(h * 2 + 1) * 128 * 128, r32, hi, tb16);
        float va[16], vb[16];
#pragma unroll
        for (int i = 0; i < 16; ++i) { va[i] = unord_f(ta[i] & ~127); vb[i] = unord_f(tb16[i] & ~127); scr[i] = 127 - (ta[i] & 127); scr[16 + i] = 127 - (tb16[i] & 127); }
        int c2[64]; int n = 0;
#pragma unroll
        for (int i = 0; i < 16; ++i)
#pragma unroll
            for (int j = 0; j < 16; ++j) if ((i + 1) * (j + 1) <= 16) { c2[n] = (ord_i(va[i] + vb[j]) & ~255) | (255 - (i * 16 + j)); ++n; }
#pragma unroll
        for (int i = 50; i < 64; ++i) c2[i] = (int)0x80000000;
        bitonic_sort_desc<64>(c2);
        asm volatile("s_waitcnt lgkmcnt(0)" ::: "memory");
        float sv[16], ex[16]; int ev[16]; float Z = 0.f;
#pragma unroll
        for (int r = 0; r < 16; ++r) { const int flat = 255 - (c2[r] & 255); sv[r] = unord_f(c2[r] & ~255); ev[r] = scr[flat >> 4] * 128 + scr[16 + (flat & 15)]; }
#pragma unroll
        for (int r = 0; r < 16; ++r) { ex[r] = fast_exp(sv[r] - sv[0]); Z += ex[r]; }
        const float iz = 1.f / Z;
        GAS int* ip = IDX + (size_t)tok * 128 + h * 16 + hi * 8; GAS float* gp = GW + (size_t)tok * 128 + h * 16 + hi * 8;
        int eo[8]; float go[8];
#pragma unroll
        for (int j = 0; j < 8; ++j) { eo[j] = hi ? ev[8 + j] : ev[j]; go[j] = (hi ? ex[8 + j] : ex[j]) * iz; }
        *(GAS u32x4*)ip = (u32x4){(unsigned)eo[0], (unsigned)eo[1], (unsigned)eo[2], (unsigned)eo[3]}; *(GAS u32x4*)(ip + 4) = (u32x4){(unsigned)eo[4], (unsigned)eo[5], (unsigned)eo[6], (unsigned)eo[7]};
        *(GAS f32x4*)gp = (f32x4){go[0], go[1], go[2], go[3]}; *(GAS f32x4*)(gp + 4) = (f32x4){go[4], go[5], go[6], go[7]};
        asm volatile("s_waitcnt lgkmcnt(0)" ::: "memory");
    }
}
__device__ __forceinline__ h2 as_h2(unsigned w) { return __builtin_bit_cast(h2, w); }
#define F4(W, s) __builtin_amdgcn_cvt_scalef32_pk_f16_fp4((W), 1.0f, (s))
#define H2F(us) ((float)__builtin_bit_cast(_Float16, (unsigned short)(us)))
__device__ __forceinline__ float sum8(float v) { v += dppf<0xB1>(v); v += dppf<0x4E>(v); v += dppf<0x141>(v); return v; }
__device__ __forceinline__ void step_xplanes(Frame& F) {
    const GAS bf16_t* xs = (const GAS bf16_t*)(F.ws + O_XS16); GAS unsigned char* x4 = F.ws + O_X4; GAS float* sx = (GAS float*)(F.ws + O_SX);
    for (int t = F.gw; t < T; t += F.ngw) {
        const GAS bf16_t* xr = xs + (size_t)t * DM + F.lane * 32;
        u32x4 w[4]; float xv[32]; float amax = 0.f;
#pragma unroll
        for (int c = 0; c < 4; ++c) w[c] = *(const GAS u32x4*)(xr + 8 * c);
#pragma unroll
        for (int c = 0; c < 4; ++c)
#pragma unroll
            for (int k = 0; k < 4; ++k) { xv[8 * c + 2 * k] = bf_lo(w[c][k]); xv[8 * c + 2 * k + 1] = bf_hi(w[c][k]); amax = fmaxf(amax, fmaxf(fabsf(xv[8 * c + 2 * k]), fabsf(xv[8 * c + 2 * k + 1]))); }
        amax = fmaxf(amax, dppf<0xB1>(amax)); amax = fmaxf(amax, dppf<0x4E>(amax)); amax = fmaxf(amax, dppf<0x141>(amax));
        const float sc = fmaxf(amax, 1e-20f) * (1.f / 119.f), qs = 1.f / sc;
        u32x4 hp, lp;
#pragma unroll
        for (int d = 0; d < 4; ++d) { unsigned hw = 0u, lw = 0u;
#pragma unroll
            for (int k = 0; k < 8; ++k) { const int q = (int)rintf(xv[8 * d + k] * qs); const int h = (q + 8) >> 4, l = q - 16 * h; hw |= (unsigned)(h & 15) << (4 * k); lw |= (unsigned)(l & 15) << (4 * k); }
            hp[d] = hw; lp[d] = lw; }
        *(GAS u32x4*)(x4 + ((size_t)t * 64 + F.lane) * 32) = hp; *(GAS u32x4*)(x4 + ((size_t)t * 64 + F.lane) * 32 + 16) = lp;
        if ((F.lane & 7) == 0) sx[(size_t)t * 8 + (F.lane >> 3)] = sc;
    }
}
__device__ __forceinline__ void step_upass(Frame& F, int layer, int G) {
    const int s = blockIdx.x & 7, wk = (blockIdx.x >> 3) * NWAVES + F.wave, nwk = (G >> 3) * NWAVES;
    const GAS unsigned char* UN = F.ws + O_TAB + (size_t)(layer * 2) * TAB_ONE + (size_t)s * NEXP * 128;
    const GAS int* IDX = (const GAS int*)(F.ws + O_IDX); const GAS unsigned char* x4 = F.ws + O_X4 + s * 256; const GAS float* sxp = (const GAS float*)(F.ws + O_SX) + s;
    GAS float* part = (GAS float*)(F.ws + O_PART) + (size_t)s * T * 128;
    unsigned lo = (unsigned)F.lane; asm volatile("" : "+v"(lo));
    const unsigned j = lo >> 3, p = lo & 7;
    const int tlast = wk + ((T - 1 - wk) / nwk) * nwk;
#define U_LOADID(ID, t_, q_) do { const int tt_ = (t_) <= tlast ? (t_) : tlast; _Pragma("unroll") for (int b = 0; b < 4; ++b) ID[b] = IDX[(size_t)tt_ * 128 + (q_) * 32 + 8 * b + j]; } while (0)
#define U_LOADX(t_) do { const int tt_ = (t_) <= tlast ? (t_) : tlast; xhn = *(const GAS u32x4*)(x4 + (size_t)tt_ * 2048 + p * 32); xln = *(const GAS u32x4*)(x4 + (size_t)tt_ * 2048 + p * 32 + 16); sxn = sxp[(size_t)tt_ * 8]; } while (0)
#define U_ISSUE(UB, ID) do { _Pragma("unroll") for (int b = 0; b < 4; ++b) UB[b] = *(const GAS u32x4*)(UN + (unsigned)(ID[b] * 128 + (int)p * 16)); } while (0)
#define U_QUARTER(UB, vout, q_) do { _Pragma("unroll") for (int b = 0; b < 4; ++b) { int ah = 0, al = 0; \
            ah = __builtin_amdgcn_sdot8((int)UB[b].x, (int)xh.x, ah, false); al = __builtin_amdgcn_sdot8((int)UB[b].x, (int)xl.x, al, false); \
            ah = __builtin_amdgcn_sdot8((int)UB[b].y, (int)xh.y, ah, false); al = __builtin_amdgcn_sdot8((int)UB[b].y, (int)xl.y, al, false); \
            ah = __builtin_amdgcn_sdot8((int)UB[b].z, (int)xh.z, ah, false); al = __builtin_amdgcn_sdot8((int)UB[b].z, (int)xl.z, al, false); \
            ah = __builtin_amdgcn_sdot8((int)UB[b].w, (int)xh.w, ah, false); al = __builtin_amdgcn_sdot8((int)UB[b].w, (int)xl.w, al, false); \
            const float d = sum8((float)(16 * ah + al)) * sxc; vout = (p == (unsigned)(4 * ((q_) & 1) + b)) ? d : vout; } } while (0)
    int idA[4], idB[4]; u32x4 u0[4], u1[4], u2[4], u3[4]; u32x4 xh, xl, xhn, xln; float sxc, sxn;
    U_LOADID(idA, wk, 0); U_LOADID(idB, wk, 1); U_LOADX(wk);
    U_ISSUE(u0, idA); U_LOADID(idA, wk, 2);
    U_ISSUE(u1, idB); U_LOADID(idB, wk, 3);
    U_ISSUE(u2, idA); U_LOADID(idA, wk + nwk, 0);
    xh = xhn; xl = xln; sxc = sxn;
    for (int t = wk; t < T; t += nwk) {
        float v0 = 0.f, v1 = 0.f;
        U_ISSUE(u3, idB); U_LOADID(idB, t + nwk, 1); U_LOADX(t + nwk);
        U_QUARTER(u0, v0, 0);
        U_ISSUE(u0, idA); U_LOADID(idA, t + nwk, 2);
        U_QUARTER(u1, v0, 1);
        U_ISSUE(u1, idB); U_LOADID(idB, t + nwk, 3);
        U_QUARTER(u2, v1, 2);
        U_ISSUE(u2, idA); U_LOADID(idA, t + 2 * nwk, 0);
        U_QUARTER(u3, v1, 3);
        part[(size_t)t * 128 + 8 * p + j] = v0; part[(size_t)t * 128 + 64 + 8 * p + j] = v1;
        xh = xhn; xl = xln; sxc = sxn;
    }
#undef U_LOADID
#undef U_LOADX
#undef U_ISSUE
#undef U_QUARTER
}
__device__ __forceinline__ void step_peer_reduce(Frame& F, int layer) {
    const GAS float* part = (const GAS float*)(F.ws + O_PART); const GAS float* GW = (const GAS float*)(F.ws + O_GW); const GAS int* IDX = (const GAS int*)(F.ws + O_IDX);
    const GAS float* rowss = (const GAS float*)(F.ws + O_ROWSS); GAS unsigned* PK = (GAS unsigned*)(F.ws + O_PK);
    const GAS unsigned char* SU = F.ws + O_TAB + (size_t)(layer * 2) * TAB_ONE + TAB_NIB; const GAS unsigned char* SV = SU + TAB_ONE;
    for (int it = F.gw; it < T * 2; it += F.ngw) { const int t = it >> 1; const size_t i = (size_t)it * 64 + F.lane;
        const float r = rsqrtf(wave_sum(rowss[(size_t)t * 32 + (F.lane & 31)]) * (0.5f / DM) + EPS);
        const int id = IDX[i];
        const u32x4 su = *(const GAS u32x4*)(SU + (size_t)id * 16), sv = *(const GAS u32x4*)(SV + (size_t)id * 16);
        float d = 0.f;
#pragma unroll
        for (int s = 0; s < 8; ++s) d += part[(size_t)s * T * 128 + i] * (float)__builtin_bit_cast(_Float16, (unsigned short)(su[s >> 1] >> (16 * (s & 1))));
        const float w = GW[i] * gelu_tanh(d * r);
#pragma unroll
        for (int s = 0; s < 8; ++s) { const _Float16 ws = (_Float16)(w * (float)__builtin_bit_cast(_Float16, (unsigned short)(sv[s >> 1] >> (16 * (s & 1)))));
            PK[(size_t)s * T * 128 + i] = ((unsigned)id << 16) | (unsigned)__builtin_bit_cast(unsigned short, ws); } }
}
__device__ __forceinline__ void step_vpass(Frame& F, int layer, int G, bool dry) {
    const int s = blockIdx.x & 7, wk = (blockIdx.x >> 3) * NWAVES + F.wave, nwk = (G >> 3) * NWAVES;
    const GAS unsigned char* VN = F.ws + O_TAB + (size_t)(layer * 2 + 1) * TAB_ONE + (size_t)s * NEXP * 128;
    const GAS unsigned* PK = (const GAS unsigned*)(F.ws + O_PK) + (size_t)s * T * 128;
    GAS bf16_t* xs = (GAS bf16_t*)(F.ws + O_XS16); GAS float* rsp = (GAS float*)(F.ws + O_RSP);
    unsigned lo = (unsigned)F.lane; asm volatile("" : "+v"(lo));
    const unsigned j = lo >> 3, p = lo & 7;
    const int tlast = wk + ((T - 1 - wk) / nwk) * nwk;
#define V_LOADPK(PKV, t_, q_) do { const int tt_ = (t_) <= tlast ? (t_) : tlast; _Pragma("unroll") for (int b = 0; b < 4; ++b) PKV[b] = PK[(size_t)tt_ * 128 + (q_) * 32 + 8 * b + j]; } while (0)
#define V_ISSUE(VB, PKV) do { _Pragma("unroll") for (int b = 0; b < 4; ++b) VB[b] = *(const GAS u32x4*)(VN + ((PKV[b] >> 16) * 128u + p * 16u)); } while (0)
#define V_CVT4(W, base) do { c_[(base)] = F4(W, 0); c_[(base) + 1] = F4(W, 1); c_[(base) + 2] = F4(W, 2); c_[(base) + 3] = F4(W, 3); } while (0)
#define V_QUARTER(VB, PKV) do { _Pragma("unroll") for (int b = 0; b < 4; ++b) { const _Float16 wl = __builtin_bit_cast(_Float16, (unsigned short)(PKV[b] & 0xffffu)); const h2 wl2 = {wl, wl}; h2 c_[16]; \
            V_CVT4(VB[b].x, 0); V_CVT4(VB[b].y, 4); V_CVT4(VB[b].z, 8); V_CVT4(VB[b].w, 12); \
            __builtin_amdgcn_sched_barrier(0); \
            _Pragma("unroll") for (int k = 0; k < 16; ++k) oh[k] = wl2 * c_[k] + oh[k]; \
            __builtin_amdgcn_sched_barrier(0); } } while (0)
    unsigned pk0[4], pk1[4], pk2[4], pk3[4], pkn[4]; u32x4 v0[4], v1[4], v2[4], v3[4];
    V_LOADPK(pk0, wk, 0); V_LOADPK(pk1, wk, 1); V_LOADPK(pk2, wk, 2); V_LOADPK(pkn, wk, 3);
    V_ISSUE(v0, pk0); V_ISSUE(v1, pk1); V_ISSUE(v2, pk2);
    for (int t = wk; t < T; t += nwk) {
#pragma unroll
        for (int b = 0; b < 4; ++b) pk3[b] = pkn[b];
        V_ISSUE(v3, pk3); V_LOADPK(pkn, t + nwk, 0);
        GAS float* xr = F.out + (size_t)t * DM + s * 256 + p * 32 + j * 4; f32x4 x2 = *(const GAS f32x4*)xr;
        h2 oh[16];
#pragma unroll
        for (int i = 0; i < 16; ++i) oh[i] = (h2){(_Float16)0.f, (_Float16)0.f};
        V_QUARTER(v0, pk0);
#pragma unroll
        for (int b = 0; b < 4; ++b) pk0[b] = pkn[b];
        V_ISSUE(v0, pk0); V_LOADPK(pkn, t + nwk, 1);
        V_QUARTER(v1, pk1);
#pragma unroll
        for (int b = 0; b < 4; ++b) pk1[b] = pkn[b];
        V_ISSUE(v1, pk1); V_LOADPK(pkn, t + nwk, 2);
        V_QUARTER(v2, pk2);
#pragma unroll
        for (int b = 0; b < 4; ++b) pk2[b] = pkn[b];
        V_ISSUE(v2, pk2); V_LOADPK(pkn, t + nwk, 3);
        V_QUARTER(v3, pk3);
#pragma unroll
        for (int i = 0; i < 16; ++i) { unsigned u = __builtin_bit_cast(unsigned, oh[i]);
            h2 a = as_h2(u) + as_h2((unsigned)__builtin_amdgcn_update_dpp(0, (int)u, 0x128, 0xF, 0xF, true)); u = __builtin_bit_cast(unsigned, a);
            { auto r = __builtin_amdgcn_permlane16_swap(u, u, false, false); a = as_h2(r[0]) + as_h2(r[1]); u = __builtin_bit_cast(unsigned, a); }
            { auto r = __builtin_amdgcn_permlane32_swap(u, u, false, false); a = as_h2(r[0]) + as_h2(r[1]); }
            oh[i] = a; }
        h2 o0 = oh[0], o1 = oh[1];
#pragma unroll
        for (int c = 1; c < 8; ++c) { o0 = (j == (unsigned)c) ? oh[2 * c] : o0; o1 = (j == (unsigned)c) ? oh[2 * c + 1] : o1; }
        x2[0] += (float)o0.x; x2[1] += (float)o0.y; x2[2] += (float)o1.x; x2[3] += (float)o1.y;
        if (!dry) *(GAS f32x4*)xr = x2;
        if (layer == 0 && !dry) {
            { u32x2 o; o.x = cvtpk(x2[0], x2[1]); o.y = cvtpk(x2[2], x2[3]); *(GAS u32x2*)(xs + (size_t)t * DM + s * 256 + p * 32 + j * 4) = o; }
            const float sst = wave_sum((x2[0] * x2[0] + x2[1] * x2[1]) + (x2[2] * x2[2] + x2[3] * x2[3]));
            if (lo == 0) rsp[(size_t)t * 8 + s] = sst;
        }
    }
#undef V_LOADPK
#undef V_ISSUE
#undef V_CVT4
#undef V_QUARTER
}
#undef F4
#undef H2F
__device__ __forceinline__ void step_logf(Frame& F) {
    const GAS bf16_t* xs = (const GAS bf16_t*)(F.ws + O_XS16); const GAS float* rsp = (const GAS float*)(F.ws + O_RSP); GAS float* logf = (GAS float*)(F.ws + O_LOGF);
    const GAS float* wf = (const GAS float*)(F.ws + O_WF);
    for (int t = F.gw; t < T; t += F.ngw) {
        unsigned lo = (unsigned)F.lane; asm volatile("" : "+v"(lo));
        float xv[32];
#pragma unroll
        for (int c = 0; c < 4; ++c) { const u32x4 w = *(const GAS u32x4*)(xs + (size_t)t * DM + c * 512 + lo * 8);
#pragma unroll
            for (int k = 0; k < 4; ++k) { xv[8 * c + 2 * k] = bf_lo(w[k]); xv[8 * c + 2 * k + 1] = bf_hi(w[k]); } }
        const float q = wave_sum(lo < 8 ? rsp[(size_t)t * 8 + lo] : 0.f);
        const float r1 = rsqrtf(q * (1.f / DM) + EPS);
        float mine = 0.f;
        for (int h = 0; h < NH; ++h) { float d = 0.f;
#pragma unroll
            for (int c = 0; c < 4; ++c) { const f32x4 w0 = *(const GAS f32x4*)(wf + (size_t)h * DM + c * 512 + lo * 8), w1 = *(const GAS f32x4*)(wf + (size_t)h * DM + c * 512 + lo * 8 + 4);
                d += (xv[8 * c] * w0[0] + xv[8 * c + 1] * w0[1]) + (xv[8 * c + 2] * w0[2] + xv[8 * c + 3] * w0[3]) + (xv[8 * c + 4] * w1[0] + xv[8 * c + 5] * w1[1]) + (xv[8 * c + 6] * w1[2] + xv[8 * c + 7] * w1[3]); }
            d = wave_sum(d); mine = (lo == (unsigned)h) ? d : mine; }
        if (lo < (unsigned)NH) { const float z = mine * r1 + F.in(I_SBF)[lo];
            logf[((size_t)(t / SEQ) * NH + lo) * SEQ + (t % SEQ)] = fminf(z, 0.f) - log1p_pos(fast_exp(-fabsf(z))); }
    }
}

#define XB_TMO      128
#define XB_XCNT(j)  (256  + 64 * (j))
#define XB_XSUB(j)  (1280 + 64 * (j))
#define XB_XGEN(j)  (2304 + 64 * (j))
#define XB_TOP      3328
#define XB_TOPGEN   3392
#define XCD_BAR_WORDS 3456
#define XB_SPIN_CAP (1u << 20)
__device__ __forceinline__ unsigned xb_ld(unsigned* p)              { return __hip_atomic_load(p, __ATOMIC_RELAXED, __HIP_MEMORY_SCOPE_AGENT); }
__device__ __forceinline__ unsigned xb_add(unsigned* p, unsigned v) { return __hip_atomic_fetch_add(p, v, __ATOMIC_RELAXED, __HIP_MEMORY_SCOPE_AGENT); }
__device__ __forceinline__ unsigned xb_xcc_id() { return (unsigned)__builtin_amdgcn_s_getreg((3 << 11) | 20) & 0xFu; }
#define XB_SPIN(cond, bar) do { unsigned _sp = 0; while (cond) { __builtin_amdgcn_s_sleep(1); \
    if ((++_sp & 255u) == 0u) { if (xb_ld(&(bar)[XB_TMO])) break; if (_sp > XB_SPIN_CAP) { atomicAdd(&(bar)[XB_TMO], 1u); break; } } } } while (0)
struct XcdBarrier { unsigned* bar; unsigned x; volatile LAS unsigned* st; };
__device__ __forceinline__ XcdBarrier xcd_barrier_post(unsigned* bar, volatile LAS unsigned* st) {
    XcdBarrier b; b.bar = bar; b.x = xb_xcc_id(); b.st = st;
    if (threadIdx.x == 0) (void)xb_add(&bar[XB_XCNT(b.x)], 1u);
    return b;
}
__device__ __forceinline__ void xcd_barrier_complete(unsigned* bar, unsigned x, unsigned& nloc, unsigned& nx) {
    const unsigned G = gridDim.x * gridDim.y * gridDim.z;
    unsigned sum, cnt, mine, sp = 0u;
    for (;;) {
        sum = 0u; cnt = 0u; mine = 0u;
#pragma unroll
        for (unsigned j = 0; j < 16; ++j) { const unsigned c = xb_ld(&bar[XB_XCNT(j)]); sum += c; cnt += (c > 0u) ? 1u : 0u; mine = (j == x) ? c : mine; }
        if (sum == G) break;
        __builtin_amdgcn_s_sleep(1);
        if ((++sp & 255u) == 0u) { if (xb_ld(&bar[XB_TMO])) break; if (sp > XB_SPIN_CAP) { atomicAdd(&bar[XB_TMO], 1u); break; } }
    }
    nloc = mine > 0u ? mine : 1u; nx = cnt > 0u ? cnt : 1u;
}
__device__ __forceinline__ void xcd_barrier(const XcdBarrier& b, int wave_s) {
    asm volatile("s_waitcnt vmcnt(0)" ::: "memory");
    __syncthreads();
    int ln_; asm volatile("v_mbcnt_lo_u32_b32 %0, -1, 0\n\tv_mbcnt_hi_u32_b32 %0, -1, %0" : "=v"(ln_));
    if (wave_s == 0 && ln_ == 0) {
        unsigned* bar = b.bar;
        __builtin_amdgcn_s_waitcnt(0);
        unsigned nloc = b.st[0], nx = b.st[1];
        if (nloc == 0u) { xcd_barrier_complete(bar, b.x, nloc, nx); b.st[0] = nloc; b.st[1] = nx; }
        const unsigned old = xb_add(&bar[XB_XSUB(b.x)], 1u);
        const unsigned gen = old / nloc;
        if (old + 1u == (gen + 1u) * nloc) {
            __builtin_amdgcn_fence(__ATOMIC_RELEASE, "agent");
            asm volatile("s_waitcnt vmcnt(0)" ::: "memory");
            const unsigned og = xb_add(&bar[XB_TOP], 1u);
            const unsigned tg = og / nx;
            if (og + 1u == (tg + 1u) * nx) xb_add(&bar[XB_TOPGEN], 1u);
            else XB_SPIN(xb_ld(&bar[XB_TOPGEN]) == tg, bar);
            __builtin_amdgcn_fence(__ATOMIC_ACQUIRE, "agent");
            xb_add(&bar[XB_XGEN(b.x)], 1u);
            asm volatile("s_waitcnt vmcnt(0)" ::: "memory");
        } else {
            XB_SPIN(xb_ld(&bar[XB_XGEN(b.x)]) == gen, bar);
            __builtin_amdgcn_fence(__ATOMIC_ACQUIRE, "agent");
            asm volatile("s_waitcnt vmcnt(0)" ::: "memory");
        }
    }
    __syncthreads();
}

constexpr int CONV1_SPLIT = 2 * 3584;
constexpr int BAR_LDS_OFF = 147456 - 64;
constexpr int LDS_BYTES = 147456;
enum { ST_PROLOGUE = 0, ST_G_IN0, ST_G_MKV0, ST_G_MKV1, ST_CONV, ST_G_GATE, ST_A_MEM0, ST_SCAN1, ST_SCAN2, ST_G_OUT0, ST_G_PQ0, ST_TOPK0, ST_UPASS0, ST_PRED0, ST_VPASS0,
       ST_G_L1, ST_CPREFIX, ST_A_FOX, ST_A_MEM1, ST_G_OUT1, ST_G_PQ1, ST_TOPK1, ST_UPASS1, ST_PRED1, ST_VPASS1, N_STEPS };
constexpr unsigned SYNC_AFTER = (1u << ST_PROLOGUE) | (1u << ST_G_MKV1) | (1u << ST_CONV) | (1u << ST_A_MEM0) | (1u << ST_SCAN1) | (1u << ST_SCAN2) | (1u << ST_G_OUT0) | (1u << ST_G_PQ0) |
                                (1u << ST_TOPK0) | (1u << ST_UPASS0) | (1u << ST_PRED0) | (1u << ST_VPASS0) | (1u << ST_G_L1) | (1u << ST_CPREFIX) | (1u << ST_A_MEM1) | (1u << ST_G_OUT1) | (1u << ST_G_PQ1) | (1u << ST_TOPK1) | (1u << ST_UPASS1) | (1u << ST_PRED1);
constexpr unsigned GEMM_STEPS = (1u << ST_G_IN0) | (1u << ST_G_MKV0) | (1u << ST_G_MKV1) | (1u << ST_G_GATE) | (1u << ST_G_OUT0) | (1u << ST_G_PQ0) | (1u << ST_G_L1) | (1u << ST_G_OUT1) | (1u << ST_G_PQ1);
constexpr unsigned ATTN_STEPS = (1u << ST_A_MEM0) | (1u << ST_A_FOX) | (1u << ST_A_MEM1);

struct Args { const float* in[N_IN]; float* out; unsigned char* ws; int lo, hi; };

__global__ void __launch_bounds__(NTHREADS, 2) yoco_fwd(Args args) {
    extern __shared__ __attribute__((aligned(16))) unsigned char lds[];
    volatile LAS unsigned* bst = (volatile LAS unsigned*)((LAS unsigned char*)lds + BAR_LDS_OFF);
    if (threadIdx.x == 0) { bst[0] = 0u; bst[1] = 0u; }
    __syncthreads();
    const XcdBarrier gbar = xcd_barrier_post((unsigned*)(args.ws + O_CTL), bst);
    const int G = gridDim.x;
    const int wave_s = __builtin_amdgcn_readfirstlane(threadIdx.x >> 6);
#ifndef DUP_MASK
#define DUP_MASK 0u
#endif
    for (int st = args.lo; st < args.hi; ++st) {
      const int nrep = ((DUP_MASK >> st) & 1u) ? 2 : 1;
      for (int rep = 0; rep < nrep; ++rep) {
        unsigned char* ws0 = args.ws; asm volatile("" : "+s"(ws0));
        GAS unsigned char* ws = (GAS unsigned char*)ws0;
#define LANE_ID(v) asm volatile("v_mbcnt_lo_u32_b32 %0, -1, 0\n\tv_mbcnt_hi_u32_b32 %0, -1, %0" : "=v"(v))
#define MAKE_TID(v) do { LANE_ID(v); v += wave_s * 64; } while (0)
#define MAKE_FRAME(F) Frame F; F.ws = ws; F.in_ = args.in; F.out = (GAS float*)args.out; { int t0_; MAKE_TID(t0_); F.tid = t0_; } F.lane = F.tid & 63; F.wave = wave_s; \
        F.gw = blockIdx.x * NWAVES + F.wave; F.ngw = gridDim.x * NWAVES; F.gtid = blockIdx.x * NTHREADS + F.tid; F.ngt = gridDim.x * NTHREADS
        if (st == ST_G_L1) { MAKE_FRAME(F); step_logf(F); }
        if ((GEMM_STEPS >> st) & 1u) {
            pg8::Gemm g; Epi E; E.ws = ws; E.resid = nullptr; E.outf = nullptr; E.o16 = nullptr; E.ssq = nullptr; E.gate_b = nullptr; int shift = 0;
            switch (st) {
            case ST_G_IN0:  g = {(const GAS bf16_t*)(ws + O_XS16), (const GAS bf16_t*)(ws + O_WIN0), T, NIN0, DM, DM, DM, 0}; E.mode = EM_IN0; break;
            case ST_G_MKV0: g = {(const GAS bf16_t*)(ws + O_MEMN), (const GAS bf16_t*)(ws + O_WMKV), NMROW, 1024, DM, DM, DM, 0}; E.mode = EM_MKV; E.o16 = (GAS bf16_t*)(ws + O_MKV); E.ssq = (GAS float*)(ws + O_MKSS); shift = 128; break;
            case ST_G_MKV1: g = {(const GAS bf16_t*)(ws + O_MEMN) + (size_t)NMROW * DM, (const GAS bf16_t*)(ws + O_WMKV) + (size_t)1024 * DM, NMROW, 1024, DM, DM, DM, 0}; E.mode = EM_MKV;
                            E.o16 = (GAS bf16_t*)(ws + O_MKV) + (size_t)NMROW * NL1; E.ssq = (GAS float*)(ws + O_MKSS) + NMROW * 112; shift = 144; break;
            case ST_G_GATE: g = {(const GAS bf16_t*)(ws + O_XC), (const GAS bf16_t*)(ws + O_WGATE), T, 12 * 256, 128, LRU, 128, 128}; E.mode = EM_GATE; E.gate_b = (const GAS float*)args.in[I_AGATEB]; break;
            case ST_G_OUT0: g = {(const GAS bf16_t*)(ws + O_CAT), (const GAS bf16_t*)(ws + O_WOUT0), T, DM, DM, DM, DM, 0}; E.mode = EM_RES; E.resid = (const GAS float*)args.in[I_X]; E.outf = (GAS float*)args.out; break;
            case ST_G_PQ0:  g = {(const GAS bf16_t*)(ws + O_XS16), (const GAS bf16_t*)(ws + O_WQ0), T, DM, DM, DM, DM, 0}; E.mode = EM_PQ; E.o16 = (GAS bf16_t*)(ws + O_Q16); break;
            case ST_G_L1:   g = {(const GAS bf16_t*)(ws + O_XS16), (const GAS bf16_t*)(ws + O_WL1), T, NL1, DM, DM, DM, 0}; E.mode = EM_L1; break;
            case ST_G_OUT1: g = {(const GAS bf16_t*)(ws + O_CAT), (const GAS bf16_t*)(ws + O_WOUT1), T, DM, DM, DM, DM, 0}; E.mode = EM_RES; E.resid = (const GAS float*)args.out; E.outf = (GAS float*)args.out; break;
            default:        g = {(const GAS bf16_t*)(ws + O_XS16), (const GAS bf16_t*)(ws + O_WQ1), T, DM, DM, DM, DM, 0}; E.mode = EM_PQ; E.o16 = (GAS bf16_t*)(ws + O_Q16); break;
            }
            pg8::StaticOrder S; S.init(g.M, g.N, G, (int)((blockIdx.x + G - shift) % G));
#ifndef DIS_GEMM
            { int tg_; MAKE_TID(tg_);
              pg8::gemm_phase<Epi, false>((LAS unsigned char*)lds, g, S, E, tg_); }
#endif
            if (st == ST_G_MKV1 && blockIdx.x >= 160) { MAKE_FRAME(F); convert_tables(F, 1, 0, CONV1_SPLIT, (blockIdx.x - 160) * NWAVES + F.wave, (G - 160) * NWAVES); }
        } else if ((ATTN_STEPS >> st) & 1u) {
            const int nun = st == ST_A_FOX ? 3 : 1;
            for (int ui = 0; ui < nun; ++ui) {
                att::BlockRef r;
                if (st == ST_A_FOX) {
                    const int i = blockIdx.x, x = i & 15, bh = (i >> 4) + 16 * ui, qb = ui == 0 ? x : (ui == 1 ? 15 - x : ((x * 5 + 3) & 15));
                    const int b = bh / NH, h = bh % NH; const size_t row0 = (size_t)b * SEQ + qb * 256;
                    const GAS bf16_t* z = (const GAS bf16_t*)(ws + O_ZL1);
                    r.Q = z + row0 * NL1 + 3072 + h * 128; r.K = z + (size_t)b * SEQ * NL1 + h * 128; r.V = z + (size_t)b * SEQ * NL1 + 1536 + h * 128;
                    r.O = (GAS bf16_t*)(ws + O_CAT) + row0 * DM + h * 128;
                    const GAS float* ss = (const GAS float*)(ws + O_SSL1);
                    r.qss = ss + row0 * 112 + (12 + h) * 4; r.kss = ss + (size_t)b * SEQ * 112 + h * 4; r.cc = (const GAS float*)(ws + O_CC) + (size_t)bh * SEQ; r.gg = (const GAS float*)(ws + O_GG) + 384;
                    r.P0 = qb * 256; r.skv = SEQ;
                } else {
                    const int l = st == ST_A_MEM0 ? 0 : 1; const int i = blockIdx.x, qblk = i >> 2, h = i & 3, b = qblk >> 4; const size_t row0 = (size_t)qblk * 256;
                    r.Q = (const GAS bf16_t*)(ws + O_ZL1) + row0 * NL1 + 4608 + h * 128; r.qss = (const GAS float*)(ws + O_SSL1) + row0 * 112 + (24 + h) * 4;
                    const GAS bf16_t* kv = (const GAS bf16_t*)(ws + O_MKV) + ((size_t)l * NMROW + b * NMEM) * NL1;
                    r.K = kv + h * 128; r.V = kv + 512 + h * 128; r.kss = (const GAS float*)(ws + O_MKSS) + ((size_t)l * NMROW + b * NMEM) * 112 + h * 4;
                    r.O = (GAS bf16_t*)(ws + O_CAT) + row0 * DM + LRU + h * 128; r.cc = nullptr; r.gg = (const GAS float*)(ws + O_GG) + 128 * (1 + l);
                    r.P0 = SEQ; r.skv = NMEM;
                }
                att::Seam S;
                int tid_u; MAKE_TID(tid_u);
#ifndef DIS_ATTN
                att::attn_prime(r, (char*)lds, S, tid_u);
                att::attn_block(r, (char*)lds, S, tid_u);
#endif
            }
        } else {
            MAKE_FRAME(F);
            switch (st) {
#ifndef DIS_MISC
            case ST_PROLOGUE: step_prologue(F, (LAS unsigned char*)lds); break;
            case ST_CONV: step_conv(F); break;
            case ST_SCAN1: step_scan1(F); break;
            case ST_SCAN2: step_scan2(F); break;
#endif
#ifndef DIS_TOPK
            case ST_TOPK0: step_topk(F, (LAS unsigned char*)lds, 0); step_xplanes(F); break;
            case ST_TOPK1: step_topk(F, (LAS unsigned char*)lds, 1); step_xplanes(F); break;
#endif
#ifndef DIS_GATHER
            case ST_UPASS0: step_upass(F, 0, G); break;
            case ST_UPASS1: step_upass(F, 1, G); break;
            case ST_PRED0: step_peer_reduce(F, 0); break;
            case ST_PRED1: step_peer_reduce(F, 1); break;
            case ST_VPASS0: step_vpass(F, 0, G, rep + 1 < nrep); break;
            case ST_VPASS1: step_vpass(F, 1, G, rep + 1 < nrep); break;
#endif
#ifndef DIS_MISC
            case ST_CPREFIX: step_cprefix(F, (LAS unsigned char*)lds); convert_tables(F, 1, G > 160 ? CONV1_SPLIT : 0, 2 * NEXP, F.gw, F.ngw); break;
#endif
            default: break;
            }
        }
        if (rep + 1 < nrep) xcd_barrier(gbar, wave_s);
      }
        if (((SYNC_AFTER >> st) & 1u) && st + 1 < args.hi) xcd_barrier(gbar, wave_s);
    }
}

#ifndef N_LAUNCH_MODE
#define N_LAUNCH_MODE 1
#endif
extern "C" void kernel_launch(void* const* d_in, const int* in_sizes, int n_in, void* d_out, int out_size, void* d_ws, size_t ws_size, hipStream_t stream) {
    static int grid = 0;
    if (grid == 0) {
        if (n_in != N_IN || in_sizes[0] != T * DM || out_size != T * DM || ws_size < WS_END) {
            fprintf(stderr, "kernel_launch: unexpected shapes (n_in %d, in0 %d, out %d, ws %zu, need %zu)\n", n_in, n_in > 0 ? in_sizes[0] : -1, out_size, ws_size, (size_t)WS_END); grid = -1; return; }
        int dev = 0, cus = 0, per_cu = 0;
        hipGetDevice(&dev); hipDeviceGetAttribute(&cus, hipDeviceAttributeMultiprocessorCount, dev);
        hipFuncSetAttribute((const void*)yoco_fwd, hipFuncAttributeMaxDynamicSharedMemorySize, LDS_BYTES);
        hipOccupancyMaxActiveBlocksPerMultiprocessor(&per_cu, (const void*)yoco_fwd, NTHREADS, LDS_BYTES);
        if (per_cu < 1) { fprintf(stderr, "kernel_launch: occupancy query says %d blocks per CU\n", per_cu); grid = -1; return; }
        grid = cus - cus % 8;
        (void)hipGetLastError();
    }
    if (grid < 0) return;
    Args a{};
    for (int i = 0; i < N_IN; ++i) a.in[i] = (const float*)d_in[i];
    a.out = (float*)d_out; a.ws = (unsigned char*)d_ws;
    if (hipMemsetAsync((char*)d_ws + O_CTL, 0, 65536, stream) != hipSuccess) { fprintf(stderr, "kernel_launch: memset of the barrier words failed\n"); return; }
    if (N_LAUNCH_MODE == 1) {
        a.lo = 0; a.hi = N_STEPS;
        hipLaunchKernelGGL(yoco_fwd, dim3(grid), dim3(NTHREADS), LDS_BYTES, stream, a);
        hipError_t e = hipPeekAtLastError();
        if (e != hipSuccess) fprintf(stderr, "launch failed: %s (grid %d)\n", hipGetErrorString(e), grid);
    } else {
        int lo = 0;
        for (int s = 0; s < N_STEPS; ++s) {
            if (((SYNC_AFTER >> s) & 1u) || s == N_STEPS - 1) {
                a.lo = lo; a.hi = s + 1; lo = s + 1;
                void* params[] = {&a};
                hipError_t e = hipLaunchCooperativeKernel((const void*)yoco_fwd, dim3(grid), dim3(NTHREADS), params, LDS_BYTES, stream);
                if (e != hipSuccess) { fprintf(stderr, "launch failed: %s\n", hipGetErrorString(e)); break; }
            }
        }
    }
}
```

```cpp
#include <hip/hip_runtime.h>
#include <hip/hip_cooperative_groups.h>
#include <cstdio>
#include <cstdint>
namespace cg = cooperative_groups;

#define LAS __attribute__((address_space(3)))
#define GAS __attribute__((address_space(1)))
typedef unsigned short bf16_t;
typedef short bf16x8 __attribute__((ext_vector_type(8)));
typedef short s16x4 __attribute__((ext_vector_type(4)));
typedef float f32x4 __attribute__((ext_vector_type(4)));
typedef float f32x2 __attribute__((ext_vector_type(2)));
typedef float f32x16 __attribute__((ext_vector_type(16)));
typedef unsigned u32x4 __attribute__((ext_vector_type(4)));
typedef unsigned u32x2 __attribute__((ext_vector_type(2)));
typedef _Float16 h2 __attribute__((ext_vector_type(2)));

constexpr int NB = 4, SEQ = 4096, T = NB * SEQ, DM = 2048, LRU = 1536, MEMW = 512, NMEM = 256, NH = 12, HD = 128;
constexpr int NIN0 = 3584, NL1 = 5120, NEXP = 16384, NMROW = NB * NMEM;
constexpr float EPS = 1e-6f;
constexpr int NTHREADS = 512, NWAVES = 8;

constexpr size_t MiB = 1u << 20;
constexpr size_t O_CTL = 0;
constexpr size_t O_WIN0 = 1 * MiB;
constexpr size_t O_WOUT0 = O_WIN0 + 14 * MiB;
constexpr size_t O_WL1 = O_WOUT0 + 8 * MiB;
constexpr size_t O_WOUT1 = O_WL1 + 20 * MiB;
constexpr size_t O_WQ0 = O_WOUT1 + 8 * MiB;
constexpr size_t O_WQ1 = O_WQ0 + 8 * MiB;
constexpr size_t O_WMKV = O_WQ1 + 8 * MiB;
constexpr size_t O_WGATE = O_WMKV + 8 * MiB;
constexpr size_t O_SUBK = O_WGATE + 1 * MiB;
constexpr size_t O_WF = O_SUBK + 1 * MiB;
constexpr size_t O_SMALL = O_WF + 1 * MiB;
constexpr size_t O_RS1 = O_SMALL;
constexpr size_t O_LOGF = O_SMALL + 64 * 1024;
constexpr size_t O_CC = O_LOGF + 768 * 1024;
constexpr size_t O_GG = O_CC + 768 * 1024;
constexpr size_t O_SPL = O_GG + 4096;
constexpr size_t O_TSC = O_SPL + 8192;
constexpr size_t O_ROWSS = O_SMALL + 2 * MiB;
constexpr size_t O_RSP = O_ROWSS + 2 * MiB;
constexpr size_t O_QMSS = O_RSP;
constexpr size_t O_MKSS = O_QMSS + 1 * MiB;
constexpr size_t O_SSL1 = O_MKSS + 1 * MiB;
constexpr size_t O_CARRY = O_SSL1 + 7 * MiB;
constexpr size_t O_MEMN = O_CARRY + 3 * MiB;
constexpr size_t O_MKV = O_MEMN + 8 * MiB;
constexpr size_t O_IDX = O_MKV + 20 * MiB;
constexpr size_t O_GW = O_IDX + 8 * MiB;
constexpr size_t O_TAB = O_GW + 8 * MiB;
constexpr size_t TAB_NIB = (size_t)8 * 16384 * 128, TAB_ONE = TAB_NIB + (size_t)16384 * 16 + 786432;
constexpr size_t O_XS16 = O_TAB + 128 * MiB;
constexpr size_t O_CAT = O_XS16 + 64 * MiB;
constexpr size_t O_ZX = O_CAT + 64 * MiB;
constexpr size_t O_X8 = O_ZX;
constexpr size_t O_GY = O_ZX + 48 * MiB;
constexpr size_t O_LOGFP = O_GY + 48 * MiB;
constexpr size_t O_QM = O_LOGFP;
constexpr size_t O_XC = O_QM + 16 * MiB;
constexpr size_t O_X4 = O_XC;
constexpr size_t O_SX = O_XC + 32 * MiB;
constexpr size_t O_AA = O_XC + 48 * MiB;
constexpr size_t O_PART = O_AA;
constexpr size_t O_UU = O_AA + 96 * MiB;
constexpr size_t O_PK = O_UU;
constexpr size_t O_Q16 = O_UU + 96 * MiB;
constexpr size_t O_ZL1 = O_Q16 + 64 * MiB;
constexpr size_t WS_END = O_ZL1 + 160 * MiB;
static_assert(WS_END <= 1024 * MiB, "workspace map");

__device__ __forceinline__ unsigned cvtpk(float lo, float hi) { unsigned r; asm volatile("v_cvt_pk_bf16_f32 %0, %1, %2" : "=v"(r) : "v"(lo), "v"(hi)); return r; }
__device__ __forceinline__ float bf_lo(unsigned w) { return __uint_as_float(w << 16); }
__device__ __forceinline__ float bf_hi(unsigned w) { return __uint_as_float(w & 0xffff0000u); }
__device__ __forceinline__ float fast_exp(float x) { return __builtin_amdgcn_exp2f(x * 1.4426950408889634f); }
__device__ __forceinline__ float log1p_pos(float y) { const float ser = y * (1.f - y * (0.5f - y * (0.33333334f - 0.25f * y))); const float lg = __builtin_amdgcn_logf(1.f + y) * 0.6931471805599453f; return y < 0.03f ? ser : lg; }
__device__ __forceinline__ float one_minus_exp(float x) { const float ser = -x * (1.f + x * (0.5f + x * (0.16666667f + x * 0.041666668f))); const float big = 1.f - fast_exp(x); return x > -0.03f ? ser : big; }
__device__ __forceinline__ float sigmoidf_(float x) { return __builtin_amdgcn_rcpf(1.f + fast_exp(-x)); }
__device__ __forceinline__ float gelu_tanh(float x) { const float u = x * (1.f + 0.044715f * x * x); return x * __builtin_amdgcn_rcpf(1.f + __builtin_amdgcn_exp2f(u * (-2.f * 0.7978845608028654f * 1.4426950408889634f))); }
template <int CTRL> __device__ __forceinline__ float dppf(float v) { return __int_as_float(__builtin_amdgcn_update_dpp(0, __float_as_int(v), CTRL, 0xF, 0xF, true)); }
__device__ __forceinline__ float xsum16(float v) { auto r = __builtin_amdgcn_permlane16_swap(__float_as_uint(v), __float_as_uint(v), false, false); return __uint_as_float(r[0]) + __uint_as_float(r[1]); }
__device__ __forceinline__ float xsum32(float v) { auto r = __builtin_amdgcn_permlane32_swap(__float_as_uint(v), __float_as_uint(v), false, false); return __uint_as_float(r[0]) + __uint_as_float(r[1]); }
__device__ __forceinline__ float xmax16(float v) { auto r = __builtin_amdgcn_permlane16_swap(__float_as_uint(v), __float_as_uint(v), false, false); return fmaxf(__uint_as_float(r[0]), __uint_as_float(r[1])); }
__device__ __forceinline__ float xmax32(float v) { auto r = __builtin_amdgcn_permlane32_swap(__float_as_uint(v), __float_as_uint(v), false, false); return fmaxf(__uint_as_float(r[0]), __uint_as_float(r[1])); }
__device__ __forceinline__ float wave_sum(float v) {
    v += dppf<0xB1>(v); v += dppf<0x4E>(v); v += dppf<0x141>(v); v += dppf<0x140>(v);
    v = xsum16(v); v = xsum32(v); return v;
}
__device__ __forceinline__ float wave_max(float v) {
    v = fmaxf(v, dppf<0xB1>(v)); v = fmaxf(v, dppf<0x4E>(v)); v = fmaxf(v, dppf<0x141>(v)); v = fmaxf(v, dppf<0x140>(v));
    v = xmax16(v); v = xmax32(v); return v;
}

namespace pg8 {
constexpr int BM = 256, BK = 64, HALF = 128, HTB = HALF * BK * 2, STAGE_BYTES = 8 * HTB, NXCD = 8, WGM = 8;
__host__ __device__ __forceinline__ int lds_byte(int r, int c) { const int st = (r >> 4) * 2 + (c >> 5), rr = r & 15, cc = c & 31, ob = rr * 64 + cc * 2; return st * 1024 + (ob ^ (((ob >> 9) & 1) << 5)); }
__host__ __device__ __forceinline__ void stage_rc(int b, int& R, int& C) { const int st = b / 1024, sb = b % 1024, swz = sb ^ (((sb >> 9) & 1) << 5); R = (st >> 1) * 16 + swz / 64; C = (st & 1) * 32 + (swz % 64) / 2; }
__host__ __device__ __forceinline__ int perm32(int rho) { const int n = rho >> 4, i = rho & 15; return 8 * (i >> 2) + 4 * n + (i & 3); }

struct Unit { int pm, pn; };
struct Gemm { const GAS bf16_t* A; const GAS bf16_t* Bt; int M, N, K, lda, ldb, acol; };

struct StaticOrder {
    int nM, nN, nwg, G, c;
    __device__ void init(int M, int N, int G_, int c_) { nM = M / BM; nN = N / BM; nwg = nM * nN; G = G_; c = c_; }
    __device__ bool next(int i, Unit& u) const {
        const long L = (long)i * G + c; if (L >= nwg) return false;
        int wgid = (int)L; { const int q = nwg / NXCD, r = nwg % NXCD, xcd = wgid % NXCD, off = wgid / NXCD; wgid = (xcd < r ? xcd * (q + 1) : r * (q + 1) + (xcd - r) * q) + off; }
        const int nig = WGM * nN, gid = wgid / nig, fm = gid * WGM, gsz = (nM - fm) < WGM ? (nM - fm) : WGM;
        u.pm = fm + ((wgid % nig) % gsz); u.pn = (wgid % nig) / gsz; return true;
    }
};

typedef int v8i_t __attribute__((ext_vector_type(8)));
typedef int v4i_t __attribute__((ext_vector_type(4)));
template <class Epi, bool FP8>
__device__ __forceinline__ void gemm_phase(LAS unsigned char* lds, const Gemm g, const StaticOrder& S, const Epi& E, const int tid) {
    const int wid = __builtin_amdgcn_readfirstlane(tid >> 6), lane = tid & 63, wr = wid >> 2, wc = wid & 3, fr = lane & 15, fq = lane >> 4;
    const int K = g.K, nt = K / BK;
    unsigned voffA[2], voffB[2];
#pragma unroll
    for (int i = 0; i < 2; ++i) { int R, C; stage_rc(tid * 16 + i * 8192, R, C); const int Rb = (R & ~31) + perm32(R & 31);
        voffA[i] = (unsigned)(R * g.lda + C) * 2u; voffB[i] = (unsigned)(Rb * g.ldb + C) * 2u; }
    const size_t kstep = (size_t)(BK * 2);
    const size_t hstepA = (size_t)HALF * g.lda * 2, hstepB = (size_t)HALF * g.ldb * 2;
    const size_t tstepA = 2 * hstepA, tstepB = 2 * hstepB;
    const unsigned ldsw = (unsigned)wid * 1024u;
    const int aoff = lds_byte(wr * 64 + fr, fq * 8), boff = lds_byte(wc * 32 + fr, fq * 8);
#define PG8_SA(b, h) (((b) * 2 + (h)) * HTB)
#define PG8_SB(b, h) ((4 + (b) * 2 + (h)) * HTB)
#define PG8_STAGE(bufoff, gbase, voff) do { _Pragma("unroll") for (int _i = 0; _i < 2; ++_i) \
        __builtin_amdgcn_global_load_lds((const GAS unsigned*)((gbase) + (voff)[_i]), (LAS unsigned*)(lds + (bufoff) + ldsw + _i * 8192), 16, 0, 0); } while (0)
#define PG8_LD2(dst, off_) do { const u32x4 lo_ = *(const LAS u32x4*)(lds + (off_)), hi_ = *(const LAS u32x4*)(lds + (off_) + 1024); \
        dst = (v8i_t){(int)lo_.x, (int)lo_.y, (int)lo_.z, (int)lo_.w, (int)hi_.x, (int)hi_.y, (int)hi_.z, (int)hi_.w}; } while (0)
#define PG8_LDA(dst, b, h) do { _Pragma("unroll") for (int m = 0; m < 4; ++m) PG8_LD2(dst[m], PG8_SA(b, h) + aoff + m * 2048); } while (0)
#define PG8_LDB(dst, b, h) do { _Pragma("unroll") for (int n = 0; n < 2; ++n) PG8_LD2(dst[n], PG8_SB(b, h) + boff + n * 2048); } while (0)
#define PG8_HALF(v, k) ((k) ? __builtin_shufflevector(v, v, 4, 5, 6, 7) : __builtin_shufflevector(v, v, 0, 1, 2, 3))
#define PG8_MMA(ai, bj, At, Bt) do { __builtin_amdgcn_s_setprio(1); _Pragma("unroll") for (int m = 0; m < 4; ++m) _Pragma("unroll") for (int n = 0; n < 2; ++n) { \
        if constexpr (FP8) asm volatile("v_mfma_scale_f32_16x16x128_f8f6f4 %0, %1, %2, %0, %3, %4 op_sel_hi:[0,0,0]" : "+v"(acc[ai][bj][m][n]) : "v"(Bt[n]), "v"(At[m]), "v"(sc_w), "v"(sc_x));     \
        else { _Pragma("unroll") for (int k = 0; k < 2; ++k) { const v4i_t bh_ = PG8_HALF(Bt[n], k), ah_ = PG8_HALF(At[m], k); \
                acc[ai][bj][m][n] = __builtin_amdgcn_mfma_f32_16x16x32_bf16(__builtin_bit_cast(bf16x8, bh_), __builtin_bit_cast(bf16x8, ah_), acc[ai][bj][m][n], 0, 0, 0); } } } \
        __builtin_amdgcn_s_setprio(0); } while (0)
#define PG8_WAIT_V(n) asm volatile("s_waitcnt vmcnt(" #n ")" ::: "memory")
#define PG8_WAIT_L(n) asm volatile("s_waitcnt lgkmcnt(" #n ")" ::: "memory")
#define PG8_BAR __builtin_amdgcn_s_barrier()
#define PG8_SCHED __builtin_amdgcn_sched_barrier(0)
    Unit cur, nxt; int ui = 0;
    if (!S.next(0, cur)) return;
    f32x4 acc[2][2][4][2];
#pragma unroll
    for (int a = 0; a < 2; ++a)
#pragma unroll
        for (int b = 0; b < 2; ++b)
#pragma unroll
            for (int m = 0; m < 4; ++m)
#pragma unroll
                for (int n = 0; n < 2; ++n) acc[a][b][m][n] = (f32x4){0.f, 0.f, 0.f, 0.f};
    v8i_t At[4], B0[2], B1[2];
    const int sc_w = 121, sc_x = 127;
    const GAS char* cA = (const GAS char*)g.A + (size_t)cur.pm * tstepA + (size_t)cur.pn * g.acol * 2; const GAS char* cB = (const GAS char*)g.Bt + (size_t)cur.pn * tstepB;
    PG8_STAGE(PG8_SB(0, 0), cB, voffB); PG8_STAGE(PG8_SB(0, 1), cB + hstepB, voffB); PG8_STAGE(PG8_SA(0, 0), cA, voffA); PG8_STAGE(PG8_SA(0, 1), cA + hstepA, voffA);
    if (wr == 1) PG8_BAR;
    PG8_WAIT_V(2); PG8_BAR;
    PG8_STAGE(PG8_SB(1, 0), cB + kstep, voffB); PG8_STAGE(PG8_SA(1, 0), cA + kstep, voffA); PG8_STAGE(PG8_SB(1, 1), cB + hstepB + kstep, voffB);
    PG8_WAIT_V(6); PG8_BAR;
    for (;;) {
        const bool has_next = S.next(ui + 1, nxt);
        const GAS char* nA = has_next ? (const GAS char*)g.A + (size_t)nxt.pm * tstepA + (size_t)nxt.pn * g.acol * 2 : cA; const GAS char* nB = has_next ? (const GAS char*)g.Bt + (size_t)nxt.pn * tstepB : cB;
        for (int t = 0; t < nt; t += 2) {
            const bool last = (t == nt - 2);
            const GAS char* a1 = cA + (size_t)(t + 1) * kstep;
            const GAS char* a2 = last ? nA : cA + (size_t)(t + 2) * kstep; const GAS char* b2 = last ? nB : cB + (size_t)(t + 2) * kstep;
            const GAS char* a3 = a2 + kstep; const GAS char* b3 = b2 + kstep;
            PG8_LDB(B0, 0, 0); PG8_LDB(B1, 0, 1); PG8_SCHED; PG8_LDA(At, 0, 0); PG8_STAGE(PG8_SA(1, 1), a1 + hstepA, voffA);
            PG8_WAIT_V(8); PG8_WAIT_L(0); PG8_BAR; PG8_MMA(0, 0, At, B0); PG8_MMA(0, 1, At, B1); PG8_BAR; PG8_SCHED;
            PG8_LDA(At, 0, 1); PG8_STAGE(PG8_SB(0, 0), b2, voffB); PG8_STAGE(PG8_SB(0, 1), b2 + hstepB, voffB); PG8_STAGE(PG8_SA(0, 0), a2, voffA);
            PG8_WAIT_V(8); PG8_WAIT_L(0); PG8_BAR; PG8_MMA(1, 0, At, B0); PG8_MMA(1, 1, At, B1); PG8_BAR; PG8_SCHED;
            PG8_LDB(B0, 1, 0); PG8_LDB(B1, 1, 1); PG8_SCHED; PG8_LDA(At, 1, 0); PG8_STAGE(PG8_SA(0, 1), a2 + hstepA, voffA);
            PG8_WAIT_V(8); PG8_WAIT_L(0); PG8_BAR; PG8_MMA(0, 0, At, B0); PG8_MMA(0, 1, At, B1); PG8_BAR; PG8_SCHED;
            PG8_LDA(At, 1, 1); PG8_STAGE(PG8_SB(1, 0), b3, voffB); PG8_STAGE(PG8_SB(1, 1), b3 + hstepB, voffB); PG8_STAGE(PG8_SA(1, 0), a3, voffA);
            PG8_WAIT_V(8); PG8_WAIT_L(0); PG8_BAR; PG8_MMA(1, 0, At, B0); PG8_MMA(1, 1, At, B1); PG8_BAR; PG8_SCHED;
        }
        if (wr == 0) PG8_BAR;
        { int ln_; asm volatile("v_mbcnt_lo_u32_b32 %0, -1, 0\n\tv_mbcnt_hi_u32_b32 %0, -1, %0" : "=v"(ln_));
          E(acc, cur, wr, wc, ln_ & 15, ln_ >> 4); }
        if (!has_next) break;
#pragma unroll
        for (int a = 0; a < 2; ++a)
#pragma unroll
            for (int b = 0; b < 2; ++b)
#pragma unroll
                for (int m = 0; m < 4; ++m)
#pragma unroll
                    for (int n = 0; n < 2; ++n) acc[a][b][m][n] = (f32x4){0.f, 0.f, 0.f, 0.f};
        cur = nxt; cA = nA; cB = nB; ++ui;
        if (wr == 1) PG8_BAR;
    }
    PG8_WAIT_V(0);
    PG8_BAR;
#undef PG8_SA
#undef PG8_SB
#undef PG8_STAGE
#undef PG8_LDA
#undef PG8_LDB
#undef PG8_LD2
#undef PG8_HALF
#undef PG8_MMA
#undef PG8_WAIT_V
#undef PG8_WAIT_L
#undef PG8_BAR
#undef PG8_SCHED
}
}

enum { EM_IN0 = 0, EM_MKV = 1, EM_GATE = 2, EM_RES = 3, EM_PQ = 4, EM_L1 = 5 };
struct Epi {
    int mode;
    GAS unsigned char* ws;
    const GAS float* resid;
    GAS float* outf;
    GAS bf16_t* o16;
    GAS float* ssq;
    const GAS float* gate_b;
    typedef pg8::Unit Unit;
    __device__ __forceinline__ static void st8(GAS bf16_t* p, f32x4 v0, f32x4 v1) {
        u32x4 w; w.x = cvtpk(v0[0], v0[1]); w.y = cvtpk(v0[2], v0[3]); w.z = cvtpk(v1[0], v1[1]); w.w = cvtpk(v1[2], v1[3]); *(GAS u32x4*)p = w; }
    __device__ __forceinline__ static float sq8(f32x4 a, f32x4 b) { return (a[0] * a[0] + a[1] * a[1]) + (a[2] * a[2] + a[3] * a[3]) + (b[0] * b[0] + b[1] * b[1]) + (b[2] * b[2] + b[3] * b[3]); }
    __device__ __forceinline__ void operator()(f32x4 (&acc)[2][2][4][2], const Unit& u, int wr, int wc, int fr, int fq) const {
        const int row0 = u.pm * 256 + wr * 64 + fr;
        const int cin = wc * 32 + 8 * fq;
        if (mode == EM_IN0) {
            GAS bf16_t* base; int ld, colt; int kind;
            if (u.pn < 6) { base = (GAS bf16_t*)(ws + O_ZX); ld = LRU; colt = u.pn * 256; kind = 0; }
            else if (u.pn < 12) { base = (GAS bf16_t*)(ws + O_GY); ld = LRU; colt = (u.pn - 6) * 256; kind = 1; }
            else { base = (GAS bf16_t*)(ws + O_ZL1); ld = NL1; colt = 4608 + (u.pn - 12) * 256; kind = 2; }
            GAS float* qmss = (GAS float*)(ws + O_SSL1);
#pragma unroll
            for (int ai = 0; ai < 2; ++ai)
#pragma unroll
                for (int m = 0; m < 4; ++m) { const int row = row0 + ai * 128 + m * 16;
#pragma unroll
                    for (int bj = 0; bj < 2; ++bj) { f32x4 v0 = acc[ai][bj][m][0], v1 = acc[ai][bj][m][1];
                        if (kind == 1) {
#pragma unroll
                            for (int j = 0; j < 4; ++j) { v0[j] = gelu_tanh(v0[j]); v1[j] = gelu_tanh(v1[j]); } }
                        st8(base + (size_t)row * ld + colt + bj * 128 + cin, v0, v1);
                        if (kind == 2) { float s = sq8(v0, v1); s = xsum16(s); s = xsum32(s);
                            if (fq == 0) qmss[(size_t)row * 112 + (24 + (u.pn - 12) * 2 + bj) * 4 + wc] = s; } } }
        } else if (mode == EM_MKV) {
#pragma unroll
            for (int ai = 0; ai < 2; ++ai)
#pragma unroll
                for (int m = 0; m < 4; ++m) { const int row = row0 + ai * 128 + m * 16;
#pragma unroll
                    for (int bj = 0; bj < 2; ++bj) { const f32x4 v0 = acc[ai][bj][m][0], v1 = acc[ai][bj][m][1];
                        st8(o16 + (size_t)row * NL1 + u.pn * 256 + bj * 128 + cin, v0, v1);
                        if (u.pn < 2) { float s = sq8(v0, v1); s = xsum16(s); s = xsum32(s);
                            if (fq == 0) ssq[(size_t)row * 112 + (u.pn * 2 + bj) * 4 + wc] = s; } } }
        } else if (mode == EM_GATE) {
            const int ch = u.pn * 128 + cin;
            const GAS bf16_t* xc = (const GAS bf16_t*)(ws + O_XC); GAS _Float16* LA = (GAS _Float16*)(ws + O_AA); GAS _Float16* UH = (GAS _Float16*)(ws + O_UU);
            const GAS float* spl = (const GAS float*)(ws + O_SPL) + ch; const GAS float* gb = gate_b + u.pn * 256 + cin;
#pragma unroll
            for (int n = 0; n < 2; ++n) {
                const f32x4 sp = *(const GAS f32x4*)(spl + 4 * n), br = *(const GAS f32x4*)(gb + 4 * n), bi = *(const GAS f32x4*)(gb + 128 + 4 * n);
#pragma unroll
                for (int ai = 0; ai < 2; ++ai)
#pragma unroll
                    for (int m = 0; m < 4; ++m) { const int row = row0 + ai * 128 + m * 16;
                        const u32x2 xw = *(const GAS u32x2*)(xc + (size_t)row * LRU + ch + 4 * n);
                        const f32x4 xv = {bf_lo(xw.x), bf_hi(xw.x), bf_lo(xw.y), bf_hi(xw.y)};
                        float lav[4], uvv[4];
#pragma unroll
                        for (int j = 0; j < 4; ++j) { const float r = sigmoidf_(acc[ai][0][m][n][j] + br[j]), ig = sigmoidf_(acc[ai][1][m][n][j] + bi[j]);
                            const float la = -8.f * r * sp[j];
                            lav[j] = la; uvv[j] = __builtin_amdgcn_sqrtf(one_minus_exp(2.f * la)) * (ig * xv[j]); }
                        { const h2 l0 = {(_Float16)lav[0], (_Float16)lav[1]}, l1 = {(_Float16)lav[2], (_Float16)lav[3]}, u0 = {(_Float16)uvv[0], (_Float16)uvv[1]}, u1 = {(_Float16)uvv[2], (_Float16)uvv[3]};
                          *(GAS u32x2*)(LA + (size_t)row * LRU + ch + 4 * n) = (u32x2){__builtin_bit_cast(unsigned, l0), __builtin_bit_cast(unsigned, l1)};
                          *(GAS u32x2*)(UH + (size_t)row * LRU + ch + 4 * n) = (u32x2){__builtin_bit_cast(unsigned, u0), __builtin_bit_cast(unsigned, u1)}; } }
            }
        } else if (mode == EM_RES) {
            GAS bf16_t* xs = (GAS bf16_t*)(ws + O_XS16); GAS float* rowss = (GAS float*)(ws + O_ROWSS);
#pragma unroll
            for (int ai = 0; ai < 2; ++ai)
#pragma unroll
                for (int m = 0; m < 4; ++m) { const int row = row0 + ai * 128 + m * 16; float s = 0.f;
#pragma unroll
                    for (int bj = 0; bj < 2; ++bj) { const size_t off = (size_t)row * DM + u.pn * 256 + bj * 128 + cin;
                        const f32x4 r0 = *(const GAS f32x4*)(resid + off), r1 = *(const GAS f32x4*)(resid + off + 4);
                        const f32x4 v0 = acc[ai][bj][m][0] + r0, v1 = acc[ai][bj][m][1] + r1;
                        *(GAS f32x4*)(outf + off) = v0; *(GAS f32x4*)(outf + off + 4) = v1;
                        st8(xs + off, v0, v1); s += sq8(v0, v1); }
                    s = xsum16(s); s = xsum32(s);
                    if (fq == 0) rowss[(size_t)row * 32 + u.pn * 4 + wc] = s; }
        } else if (mode == EM_PQ) {
            const GAS float* rowss = (const GAS float*)(ws + O_ROWSS);
#pragma unroll
            for (int ai = 0; ai < 2; ++ai)
#pragma unroll
                for (int m = 0; m < 4; ++m) { const int row = row0 + ai * 128 + m * 16;
                    const f32x4 p0 = *(const GAS f32x4*)(rowss + (size_t)row * 32 + fq * 8), p1 = *(const GAS f32x4*)(rowss + (size_t)row * 32 + fq * 8 + 4);
                    float s = (p0[0] + p0[1]) + (p0[2] + p0[3]) + (p1[0] + p1[1]) + (p1[2] + p1[3]); s = xsum16(s); s = xsum32(s);
                    const float r = rsqrtf(s * (1.f / DM) + EPS);
#pragma unroll
                    for (int bj = 0; bj < 2; ++bj) st8(o16 + (size_t)row * DM + u.pn * 256 + bj * 128 + cin, acc[ai][bj][m][0] * r, acc[ai][bj][m][1] * r); }
        } else {
            const GAS float* rsp = (const GAS float*)(ws + O_RSP); GAS bf16_t* zl1 = (GAS bf16_t*)(ws + O_ZL1); GAS float* ssl1 = (GAS float*)(ws + O_SSL1);
            const int slot0 = u.pn < 6 ? u.pn * 2 : (u.pn >= 12 ? 12 + (u.pn - 12) * 2 : -1);
#pragma unroll
            for (int ai = 0; ai < 2; ++ai)
#pragma unroll
                for (int m = 0; m < 4; ++m) { const int row = row0 + ai * 128 + m * 16;
                    const f32x4 q0 = *(const GAS f32x4*)(rsp + (size_t)row * 8), q1 = *(const GAS f32x4*)(rsp + (size_t)row * 8 + 4);
                    const float r = rsqrtf(((q0[0] + q0[1]) + (q0[2] + q0[3]) + (q1[0] + q1[1]) + (q1[2] + q1[3])) * (1.f / DM) + EPS);
#pragma unroll
                    for (int bj = 0; bj < 2; ++bj) { const f32x4 v0 = acc[ai][bj][m][0] * r, v1 = acc[ai][bj][m][1] * r;
                        st8(zl1 + (size_t)row * NL1 + u.pn * 256 + bj * 128 + cin, v0, v1);
                        if (slot0 >= 0) { float s = sq8(v0, v1); s = xsum16(s); s = xsum32(s);
                            if (fq == 0) ssl1[(size_t)row * 112 + (slot0 + bj) * 4 + wc] = s; } } }
        }
    }
};

namespace att {
constexpr float SCALE = 0.08838834764831845f;
constexpr int NW = 8, QBLK = 32, KVBLK = 64, QB = NW * QBLK, D = 128;
constexpr int SHM_V = KVBLK * D * 2, SHM_K = KVBLK * D * 2;
constexpr int OFF_WS = 2 * SHM_V + 2 * SHM_K;
constexpr int OFF_KS = OFF_WS + 2048;
constexpr int OFF_BS = OFF_KS + 16384;
constexpr int LDS_END = OFF_BS + 16384;
constexpr int WBIG = 1 << 28;

#define KSWZ(row, colB) ((row) * 256 + ((colB) ^ (((row) & 7) << 4)))
#define SBAR() __builtin_amdgcn_sched_barrier(0)
__device__ __forceinline__ int v_st(int k, int c) { const int kk = (k & ~0xC) | ((k & 4) << 1) | ((k & 8) >> 1); return ((kk >> 3) * 4 + (c >> 5)) * 512 + ((kk & 7) * 32 + (c & 31)) * 2; }
__device__ __forceinline__ int v_rd_base(int lane) { return ((lane & 3) << 3) | (((lane >> 2) & 3) << 6) | (((lane >> 4) & 1) << 5) | (((lane >> 5) & 1) << 8); }
constexpr int v_rd_off(int d0, int ks, int half) { return d0 * 512 + ks * 4096 + half * 2048; }
__device__ __forceinline__ int crow(int r, int hi) { return (r & 3) + 8 * (r >> 2) + 4 * hi; }
__device__ __forceinline__ bf16x8 load8(const GAS bf16_t* p) { return *(const GAS bf16x8*)p; }
__device__ __forceinline__ bf16x8 scale8(bf16x8 v, float s) { const u32x4 w = *reinterpret_cast<u32x4*>(&v); u32x4 o;
    o.x = cvtpk(bf_lo(w.x) * s, bf_hi(w.x) * s); o.y = cvtpk(bf_lo(w.y) * s, bf_hi(w.y) * s); o.z = cvtpk(bf_lo(w.z) * s, bf_hi(w.z) * s); o.w = cvtpk(bf_lo(w.w) * s, bf_hi(w.w) * s);
    return *reinterpret_cast<bf16x8*>(&o); }
__device__ __forceinline__ void mask_tile(f32x16& p0, f32x16& p1, int dq, unsigned W) {
    const float NEG = -__builtin_inff();
#pragma unroll
    for (int r = 0; r < 16; ++r) {
        const int c = (r & 3) + 8 * (r >> 2);
        if ((unsigned)(dq - c) >= W) p0[r] = NEG;
        if ((unsigned)(dq - c - 32) >= W) p1[r] = NEG;
    }
}
constexpr float THR = 8.f;
__device__ __forceinline__ void partialSM(f32x16& p0, f32x16& p1, float& m_reg, float& mn, float& alpha) {
    float pmax = p0[0]; for (int r = 1; r < 16; ++r) pmax = fmaxf(pmax, p0[r]); for (int r = 0; r < 16; ++r) pmax = fmaxf(pmax, p1[r]);
    { auto rr = __builtin_amdgcn_permlane32_swap(__float_as_uint(pmax), __float_as_uint(pmax), false, false);
      pmax = fmaxf(__uint_as_float(rr[0]), __uint_as_float(rr[1])); }
    constexpr float C2 = 1.4426950408889634f * SCALE;
    if (__builtin_expect(__all((pmax - m_reg) * SCALE <= THR), 1)) { mn = m_reg; alpha = 1.f; }
    else { mn = fmaxf(m_reg, pmax); alpha = __builtin_amdgcn_exp2f((m_reg - mn) * C2); m_reg = mn; }
    const float mnL = -mn * C2;
    for (int r = 0; r < 16; ++r) p0[r] = fmaf(p0[r], C2, mnL); for (int r = 0; r < 16; ++r) p1[r] = fmaf(p1[r], C2, mnL);
    for (int r = 0; r < 16; ++r) p0[r] = __builtin_amdgcn_exp2f(p0[r]);
}
__device__ __forceinline__ void finishSM(f32x16& p0, f32x16& p1, float alpha, float& l_reg, bf16x8& pa0, bf16x8& pa1, bf16x8& pa2, bf16x8& pa3) {
    for (int r = 0; r < 16; ++r) p1[r] = __builtin_amdgcn_exp2f(p1[r]);
    float ps = 0; for (int r = 0; r < 16; ++r) ps += p0[r]; for (int r = 0; r < 16; ++r) ps += p1[r];
    { auto rr = __builtin_amdgcn_permlane32_swap(__float_as_uint(ps), __float_as_uint(ps), false, false);
      ps = __uint_as_float(rr[0]) + __uint_as_float(rr[1]); }
    l_reg = l_reg * alpha + ps;
#define PK4(P, B_, OUT) do { unsigned a0 = cvtpk(P[B_+0], P[B_+1]), a1 = cvtpk(P[B_+2], P[B_+3]);                          \
        unsigned b0 = cvtpk(P[B_+4], P[B_+5]), b1 = cvtpk(P[B_+6], P[B_+7]);                                             \
        auto r0 = __builtin_amdgcn_permlane32_swap(a0, b0, false, false); auto r1 = __builtin_amdgcn_permlane32_swap(a1, b1, false, false); \
        u32x4 w = {r0[0], r1[0], r0[1], r1[1]}; OUT = *reinterpret_cast<bf16x8*>(&w); } while (0)
    PK4(p0, 0, pa0); PK4(p0, 8, pa1); PK4(p1, 0, pa2); PK4(p1, 8, pa3);
#undef PK4
}
template <int KB>
__device__ __forceinline__ void qkt(f32x16& p0, f32x16& p1, const char* K_lds, int r32, int hi, const bf16x8* qr, const float* bp  ) {
    { const f32x4 a = *(const f32x4*)(bp), b = *(const f32x4*)(bp + 8), c = *(const f32x4*)(bp + 16), d = *(const f32x4*)(bp + 24);
      p0 = (f32x16){a[0], a[1], a[2], a[3], b[0], b[1], b[2], b[3], c[0], c[1], c[2], c[3], d[0], d[1], d[2], d[3]}; }
    { const f32x4 a = *(const f32x4*)(bp + 32), b = *(const f32x4*)(bp + 40), c = *(const f32x4*)(bp + 48), d = *(const f32x4*)(bp + 56);
      p1 = (f32x16){a[0], a[1], a[2], a[3], b[0], b[1], b[2], b[3], c[0], c[1], c[2], c[3], d[0], d[1], d[2], d[3]}; }
    const char* kb[4];
#pragma unroll
    for (int dd = 0; dd < 4; ++dd) kb[dd] = K_lds + KB * SHM_K + KSWZ(r32, (dd * 16 + hi * 8) * 2);
#pragma unroll
    for (int d0 = 0; d0 < 8; ++d0) { const char* a = kb[d0 & 3] + (d0 >> 2) * 128;
        bf16x8 b0 = *reinterpret_cast<const bf16x8*>(a);
        bf16x8 b1 = *reinterpret_cast<const bf16x8*>(a + 32 * 256);
        p0 = __builtin_amdgcn_mfma_f32_32x32x16_bf16(b0, qr[d0], p0, 0, 0, 0);
        p1 = __builtin_amdgcn_mfma_f32_32x32x16_bf16(b1, qr[d0], p1, 0, 0, 0); }
}
template <int VB>
__device__ __forceinline__ void pv_tile(f32x16* o, int vb0, bf16x8 pa0, bf16x8 pa1, bf16x8 pa2, bf16x8 pa3) {
#define TRRD(dst, off) asm volatile("ds_read_b64_tr_b16 %0, %1 offset:%2" : "=&v"(dst) : "v"(vb0), "i"(off) : "memory")
#define PV_D0(d0) do { s16x4 l0, l1, l2, l3, h0, h1, h2_, h3; constexpr int b_ = VB * SHM_V + v_rd_off(d0, 0, 0); \
        TRRD(l0, b_); TRRD(h0, b_ + 2048); TRRD(l1, b_ + 4096); TRRD(h1, b_ + 6144); TRRD(l2, b_ + 8192); TRRD(h2_, b_ + 10240); TRRD(l3, b_ + 12288); TRRD(h3, b_ + 14336); \
        asm volatile("s_waitcnt lgkmcnt(0)" ::: "memory"); SBAR();   \
        o[d0] = __builtin_amdgcn_mfma_f32_32x32x16_bf16(pa0, (bf16x8){l0[0], l0[1], l0[2], l0[3], h0[0], h0[1], h0[2], h0[3]}, o[d0], 0, 0, 0);   \
        o[d0] = __builtin_amdgcn_mfma_f32_32x32x16_bf16(pa1, (bf16x8){l1[0], l1[1], l1[2], l1[3], h1[0], h1[1], h1[2], h1[3]}, o[d0], 0, 0, 0);   \
        o[d0] = __builtin_amdgcn_mfma_f32_32x32x16_bf16(pa2, (bf16x8){l2[0], l2[1], l2[2], l2[3], h2_[0], h2_[1], h2_[2], h2_[3]}, o[d0], 0, 0, 0);   \
        o[d0] = __builtin_amdgcn_mfma_f32_32x32x16_bf16(pa3, (bf16x8){l3[0], l3[1], l3[2], l3[3], h3[0], h3[1], h3[2], h3[3]}, o[d0], 0, 0, 0); } while (0)
    PV_D0(0); PV_D0(1); PV_D0(2); PV_D0(3);
#undef PV_D0
#undef TRRD
}

struct BlockRef { const GAS bf16_t* Q; const GAS bf16_t* K; const GAS bf16_t* V; GAS bf16_t* O; const GAS float* qss; const GAS float* kss; const GAS float* cc; const GAS float* gg;
                  int P0, skv; };
constexpr int LDQ = 5120, LDK = 5120, LDO = 2048, LDSS = 112;
struct Seam { bf16x8 qr[8]; bf16x8 st_v0, st_v1, st_k0, st_k1; int jlo; };
#define ROWK(p, k0, rr) ((p) + (size_t)((k0) + (rr)) * LDK + sc)
#define VMW() asm volatile("s_waitcnt vmcnt(0)" ::: "memory")
#define VMWN(n) asm volatile("s_waitcnt vmcnt(%0)" :: "i"(n) : "memory")
#define SLOAD_H(Kp, Vp, k0) do { S.st_v0 = load8(ROWK(Vp, k0, sr)); S.st_v1 = load8(ROWK(Vp, k0, 32 + sr));              \
                         S.st_k0 = load8(ROWK(Kp, k0, sr)); S.st_k1 = load8(ROWK(Kp, k0, 32 + sr)); } while (0)
#define SWRITE_HK(bf, k0) do { *(bf16x8*)(K_lds + (bf) * SHM_K + kws) = scale8(S.st_k0, ksr[(k0)]); *(bf16x8*)(K_lds + (bf) * SHM_K + kws + 32 * 256) = scale8(S.st_k1, ksr[(k0) + 32]); } while (0)
#define SWRITE_HV(bf) do { *(bf16x8*)(V_lds + (bf) * SHM_V + vst0) = S.st_v0; *(bf16x8*)(V_lds + (bf) * SHM_V + vst1) = S.st_v1; } while (0)
#define SWRITE_H(bf, k0) do { SWRITE_HV(bf); SWRITE_HK(bf, k0); } while (0)

__device__ __forceinline__ void attn_prime(const BlockRef& cur, char* lds, Seam& S, const int tid) {
    const int wid = __builtin_amdgcn_readfirstlane(tid >> 6), lane = tid & 63, r32 = lane & 31, hi = lane >> 5;
    const int sr = tid >> 4, sc = (tid & 15) * 8, kws = KSWZ(sr, sc * 2); char* K_lds = lds + 2 * SHM_V;
    float* ks_l = (float*)(lds + OFF_KS); float* bs_l = (float*)(lds + OFF_BS); const float* ksr = ks_l + sr;
    int j_hi = (cur.P0 + QB - 1) / KVBLK + 1; if (j_hi > cur.skv / KVBLK) j_hi = cur.skv / KVBLK;
    const int nkeys = j_hi * KVBLK;
    const float c0 = cur.cc ? cur.cc[cur.P0] : 0.f;
    int jlo = 0;
    if (cur.cc) { const float thr = cur.gg[128]; const int jd = cur.P0 / KVBLK;
        const float cv = lane <= jd ? cur.cc[lane * KVBLK + KVBLK - 1] : 0.f;
        const bool keep = lane > jd || (c0 - cv > -thr);
        jlo = __ffsll((long long)__ballot(keep)) - 1; }
    S.jlo = jlo;
    for (int s = jlo * KVBLK + tid; s < nkeys; s += NTHREADS) {
        const f32x4 p = *(const GAS f32x4*)(cur.kss + (size_t)s * LDSS);
        ks_l[s] = rsqrtf(((p[0] + p[1]) + (p[2] + p[3])) * (1.f / 128.f) + EPS);
        bs_l[s] = cur.cc ? (c0 - cur.cc[s]) * (1.f / SCALE) : 0.f;
    }
    __syncthreads();
    const int qrow = wid * QBLK + r32;
    const f32x4 qp = *(const GAS f32x4*)(cur.qss + (size_t)qrow * LDSS);
    const float rq = rsqrtf(((qp[0] + qp[1]) + (qp[2] + qp[3])) * (1.f / 128.f) + EPS);
#pragma unroll
    for (int d0 = 0; d0 < 8; ++d0) {
        const u32x4 w = *(const GAS u32x4*)(cur.Q + (size_t)qrow * LDQ + d0 * 16 + hi * 8);
        const f32x4 g0 = *(const GAS f32x4*)(cur.gg + d0 * 16 + hi * 8), g1 = *(const GAS f32x4*)(cur.gg + d0 * 16 + hi * 8 + 4);
        u32x4 o; o.x = cvtpk(bf_lo(w.x) * rq * g0[0], bf_hi(w.x) * rq * g0[1]); o.y = cvtpk(bf_lo(w.y) * rq * g0[2], bf_hi(w.y) * rq * g0[3]);
        o.z = cvtpk(bf_lo(w.z) * rq * g1[0], bf_hi(w.z) * rq * g1[1]); o.w = cvtpk(bf_lo(w.w) * rq * g1[2], bf_hi(w.w) * rq * g1[3]);
        S.qr[d0] = *reinterpret_cast<bf16x8*>(&o);
    }
    SLOAD_H(cur.K, cur.V, jlo * KVBLK); VMW(); SWRITE_HK(0, jlo * KVBLK);
    __syncthreads();
}
__device__ __forceinline__ void attn_block(const BlockRef& cur, char* lds, Seam& S, const int tid) {
    const int wid = __builtin_amdgcn_readfirstlane(tid >> 6), lane = tid & 63, r32 = lane & 31, hi = lane >> 5;
    const int W = WBIG;
    int j_hi = (cur.P0 + QB - 1) / KVBLK + 1; if (j_hi > cur.skv / KVBLK) j_hi = cur.skv / KVBLK;
    const int j_lo = S.jlo; const int NT = j_hi - j_lo;
    const int qlo = cur.P0 - j_lo * KVBLK + wid * QBLK, qm = qlo + r32 - 4 * hi;
    char* V_lds = lds; char* K_lds = lds + 2 * SHM_V;
    float* ws = (float*)(lds + OFF_WS) + wid * 64; float* li_l = ws, * al_l = ws + 32;
    const float* bs_l = (const float*)(lds + OFF_BS) + j_lo * KVBLK + 4 * hi;
    float m_reg = -1e30f, l_reg = 0; f32x16 o[4] = {};
    const int sr = tid >> 4, sc = (tid & 15) * 8, vst0 = v_st(sr, sc), vst1 = v_st(32 + sr, sc), kws = KSWZ(sr, sc * 2);
    const float* ksr = (const float*)(lds + OFF_KS) + j_lo * KVBLK + sr;
    const int vb0 = (int)(uintptr_t)V_lds + v_rd_base(lane);
    const GAS bf16_t* Kh = cur.K + (size_t)j_lo * KVBLK * LDK; const GAS bf16_t* Vh = cur.V + (size_t)j_lo * KVBLK * LDK;
#define RESC(a) do { if (__any((a) < 1.f)) { if (hi == 0) al_l[r32] = (a); asm volatile("s_waitcnt lgkmcnt(0)" ::: "memory");              \
                     for (int d_ = 0; d_ < 4; ++d_) for (int r = 0; r < 16; ++r) o[d_][r] *= al_l[crow(r, hi)]; } } while (0)
#define KBASE(t) ((t) * KVBLK)
#define MASKT(P0_, P1_, t) do { const int kb_ = KBASE(t); if (kb_ + KVBLK - 1 > qlo) mask_tile(P0_, P1_, qm - kb_, (unsigned)W); } while (0)
    f32x16 pA0, pA1, pB0, pB1; float mnA, mnB, alA, alB; bf16x8 pa0, pa1, pa2, pa3;
    SWRITE_HV(0); SBAR();
    if (NT > 1) { SLOAD_H(Kh, Vh, KBASE(1)); }
    SBAR(); qkt<0>(pA0, pA1, K_lds, r32, hi, S.qr, bs_l + KBASE(0));
    MASKT(pA0, pA1, 0); partialSM(pA0, pA1, m_reg, mnA, alA);
    if (NT > 1) { VMW(); SWRITE_H(1, KBASE(1)); }
    __syncthreads();
#define HALF_STEP(PX0, PX1, mnX, alX, PY0, PY1, alY, t, KB, VB, SB) do {                                                      \
        SBAR(); qkt<KB>(PX0, PX1, K_lds, r32, hi, S.qr, bs_l + KBASE(t));                                                         \
        finishSM(PY0, PY1, alY, l_reg, pa0, pa1, pa2, pa3); SBAR();                                                           \
        if ((t) + 1 < NT) { SLOAD_H(Kh, Vh, KBASE((t) + 1)); SBAR(); }                                               \
        pv_tile<VB>(o, vb0, pa0, pa1, pa2, pa3); MASKT(PX0, PX1, (t)); partialSM(PX0, PX1, m_reg, mnX, alX);                                        \
        __syncthreads();                                                                                                      \
        if ((t) + 1 < NT) { VMW(); SWRITE_H(SB, KBASE((t) + 1)); }                                                                          \
        RESC(alX); __syncthreads(); } while (0)
    for (int t = 1; t + 1 < NT; t += 2) {
        HALF_STEP(pB0, pB1, mnB, alB, pA0, pA1, alA, t, 1, 0, 0);
        HALF_STEP(pA0, pA1, mnA, alA, pB0, pB1, alB, t + 1, 0, 1, 1);
    }
    const bool even = (NT & 1) == 0;
    if (even) { SBAR(); qkt<1>(pB0, pB1, K_lds, r32, hi, S.qr, bs_l + KBASE(NT - 1)); SBAR(); }
    finishSM(pA0, pA1, alA, l_reg, pa0, pa1, pa2, pa3); SBAR();
    pv_tile<0>(o, vb0, pa0, pa1, pa2, pa3);
    if (even) { MASKT(pB0, pB1, NT - 1); partialSM(pB0, pB1, m_reg, mnB, alB); __syncthreads(); RESC(alB);
        finishSM(pB0, pB1, alB, l_reg, pa0, pa1, pa2, pa3); SBAR(); pv_tile<1>(o, vb0, pa0, pa1, pa2, pa3); }
    SBAR();
    if (hi == 0) li_l[r32] = l_reg; asm volatile("s_waitcnt lgkmcnt(0)" ::: "memory");
    float rli[16];
#pragma unroll
    for (int r = 0; r < 16; ++r) rli[r] = __builtin_amdgcn_rcpf(li_l[crow(r, hi)]);
    GAS bf16_t* Ow = cur.O + (size_t)(wid * QBLK) * LDO;
#pragma unroll
    for (int r = 0; r < 16; ++r) { const int orow = crow(r, hi);
#pragma unroll
        for (int d0 = 0; d0 < 4; ++d0) { const float v = o[d0][r] * rli[r];
            const float vn = dppf<0xB1>(v);
            if ((r32 & 1) == 0) *(GAS unsigned*)(Ow + (size_t)orow * LDO + d0 * 32 + r32) = cvtpk(v, vn); } }
    __syncthreads();
#undef RESC
#undef KBASE
#undef MASKT
#undef HALF_STEP
}
#undef ROWK
#undef VMW
#undef VMWN
#undef SLOAD_H
#undef SWRITE_HK
#undef SWRITE_HV
#undef SWRITE_H
#undef KSWZ
#undef SBAR
}


struct Frame {
    GAS unsigned char* ws; const float* const* in_; GAS float* out;
    __device__ __forceinline__ const GAS float* in(int i) const { return (const GAS float*)in_[i]; }
    int tid, lane, wave, gw, ngw, gtid, ngt;
};
enum { I_X = 0, I_MEM, I_ANORM, I_AWIN, I_ACONVW, I_ACONVB, I_AGATEW, I_AGATEB, I_ALAMBDA, I_AWOUT, I_SNORM, I_SWKVF, I_SBF, I_SKNORM, I_BNORM, I_BWIN, I_BQNORM, I_BWOUT,
       I_MNORM, I_MWKV, I_MQNORM, I_MKNORM, I_PNORM, I_PWQ, I_PSUBK, I_PU, I_PV, N_IN };

__device__ __forceinline__ void transpose_item(const GAS float* W, int ldw, int coff, const GAS float* gain, GAS bf16_t* WT, int ldt, int row_off, LAS float* scr, int nblk, int item, int lane) {
    const int kb = item / nblk, nb = item % nblk, k0 = 64 * kb, n0 = 32 * nb;
    float wv[32];
#pragma unroll
    for (int i = 0; i < 32; ++i) wv[i] = W[(size_t)(k0 + 2 * i + (lane >> 5)) * ldw + coff + n0 + (lane & 31)];
    if (gain) {
#pragma unroll
        for (int i = 0; i < 32; ++i) wv[i] *= gain[k0 + 2 * i + (lane >> 5)]; }
#pragma unroll
    for (int i = 0; i < 32; ++i) scr[(2 * i + (lane >> 5)) * 33 + (lane & 31)] = wv[i];
    asm volatile("s_waitcnt lgkmcnt(0)" ::: "memory");
    const int c = lane & 7;
#pragma unroll
    for (int j = 0; j < 4; ++j) { const int n = (lane >> 3) + 8 * j; const LAS float* s = scr + (8 * c) * 33 + n;
        u32x4 o; o.x = cvtpk(s[0 * 33], s[1 * 33]); o.y = cvtpk(s[2 * 33], s[3 * 33]); o.z = cvtpk(s[4 * 33], s[5 * 33]); o.w = cvtpk(s[6 * 33], s[7 * 33]);
        *(GAS u32x4*)(WT + (size_t)(row_off + n0 + n) * ldt + k0 + 8 * c) = o; }
    asm volatile("s_waitcnt lgkmcnt(0)" ::: "memory");
}
__device__ __forceinline__ void transpose_item_fp8(const GAS float* W, int ldw, const GAS float* gain, GAS unsigned char* WT, int ldt, LAS float* scr, int nblk, int item, int lane) {
    const int kb = item / nblk, nb = item % nblk, k0 = 64 * kb, n0 = 32 * nb;
    float wv[32];
#pragma unroll
    for (int i = 0; i < 32; ++i) wv[i] = W[(size_t)(k0 + 2 * i + (lane >> 5)) * ldw + n0 + (lane & 31)];
#pragma unroll
    for (int i = 0; i < 32; ++i) wv[i] *= gain[k0 + 2 * i + (lane >> 5)] * 64.f;
#pragma unroll
    for (int i = 0; i < 32; ++i) scr[(2 * i + (lane >> 5)) * 33 + (lane & 31)] = wv[i];
    asm volatile("s_waitcnt lgkmcnt(0)" ::: "memory");
    const int c = lane & 3;
#pragma unroll
    for (int j = 0; j < 2; ++j) { const int n = (lane >> 2) + 16 * j; const LAS float* sp = scr + (16 * c) * 33 + n; u32x4 o;
#pragma unroll
        for (int w = 0; w < 4; ++w) { int pk = __builtin_amdgcn_cvt_pk_fp8_f32(sp[(4 * w) * 33], sp[(4 * w + 1) * 33], 0, false); pk = __builtin_amdgcn_cvt_pk_fp8_f32(sp[(4 * w + 2) * 33], sp[(4 * w + 3) * 33], pk, true); o[w] = (unsigned)pk; }
        *(GAS u32x4*)(WT + (size_t)(n0 + n) * ldt + k0 + 16 * c) = o; }
    asm volatile("s_waitcnt lgkmcnt(0)" ::: "memory");
}
__device__ __forceinline__ void convert_tables(Frame& F, int layer, int ibeg, int iend, int wk, int nwk) {
    for (int it0 = ibeg + wk; it0 < iend; it0 += 2 * nwk) {
        f32x4 v[2][8]; GAS unsigned char* dst[2]; int rowq[2], whichq[2];
#pragma unroll
        for (int q = 0; q < 2; ++q) { const int it = it0 + q * nwk < iend ? it0 + q * nwk : it0; const int which = it & 1, row = it >> 1; rowq[q] = row; whichq[q] = which;
            const GAS float* src = F.in(which ? I_PV : I_PU) + ((size_t)layer * NEXP + row) * DM + F.lane * 4;
            const GAS float* gn = F.in(I_PNORM) + layer * DM + F.lane * 4;
            dst[q] = F.ws + O_TAB + (size_t)(layer * 2 + which) * TAB_ONE;
#pragma unroll
            for (int c = 0; c < 8; ++c) { v[q][c] = *(const GAS f32x4*)(src + c * 256); if (!which) v[q][c] = v[q][c] * *(const GAS f32x4*)(gn + c * 256); } }
#pragma unroll
        for (int q = 0; q < 2; ++q) { _Float16 shv = (_Float16)0.f;
#pragma unroll
            for (int c = 0; c < 8; ++c) { const f32x4 x = v[q][c];
                float amax = fmaxf(fmaxf(fabsf(x[0]), fabsf(x[1])), fmaxf(fabsf(x[2]), fabsf(x[3])));
                amax = fmaxf(amax, dppf<0xB1>(amax)); amax = fmaxf(amax, dppf<0x4E>(amax)); amax = fmaxf(amax, dppf<0x141>(amax)); amax = fmaxf(amax, dppf<0x140>(amax));
                amax = xmax16(amax); amax = xmax32(amax);
                const _Float16 sh = (_Float16)fmaxf(amax * (whichq[q] ? 1.f / 6.f : 1.f / 7.f), 1e-6f);
                const float qs = 1.f / (float)sh;
                unsigned pk;
                if (whichq[q]) { pk = __builtin_amdgcn_cvt_scalef32_pk_fp4_f32(0u, x[0] * qs, x[1] * qs, 1.0f, 0); pk = __builtin_amdgcn_cvt_scalef32_pk_fp4_f32(pk, x[2] * qs, x[3] * qs, 1.0f, 1); }
                else { const int q0 = (int)fminf(fmaxf(rintf(x[0] * qs), -7.f), 7.f), q1 = (int)fminf(fmaxf(rintf(x[1] * qs), -7.f), 7.f), q2 = (int)fminf(fmaxf(rintf(x[2] * qs), -7.f), 7.f), q3 = (int)fminf(fmaxf(rintf(x[3] * qs), -7.f), 7.f);
                       pk = (unsigned)(q0 & 15) | ((unsigned)(q1 & 15) << 4) | ((unsigned)(q2 & 15) << 8) | ((unsigned)(q3 & 15) << 12); }
                *(GAS unsigned short*)(dst[q] + ((size_t)c * NEXP + rowq[q]) * 128 + F.lane * 2) = (unsigned short)pk;
                shv = (F.lane == c) ? sh : shv; }
            if (F.lane < 8) *(GAS unsigned short*)(dst[q] + TAB_NIB + ((size_t)rowq[q] * 8 + F.lane) * 2) = __builtin_bit_cast(unsigned short, shv); }
    }
}
__device__ __forceinline__ void norm_row_bf16(const GAS float* xrow, const GAS float* gain, GAS bf16_t* orow, int lane) {
    f32x4 v[8]; float s = 0.f;
#pragma unroll
    for (int j = 0; j < 8; ++j) { v[j] = *(const GAS f32x4*)(xrow + j * 256 + lane * 4); s += (v[j][0] * v[j][0] + v[j][1] * v[j][1]) + (v[j][2] * v[j][2] + v[j][3] * v[j][3]); }
    const float r = rsqrtf(wave_sum(s) * (1.f / DM) + EPS);
#pragma unroll
    for (int j = 0; j < 8; ++j) { f32x4 g = gain ? *(const GAS f32x4*)(gain + j * 256 + lane * 4) : (f32x4){1.f, 1.f, 1.f, 1.f};
        u32x2 o; o.x = cvtpk(v[j][0] * r * g[0], v[j][1] * r * g[1]); o.y = cvtpk(v[j][2] * r * g[2], v[j][3] * r * g[3]);
        *(GAS u32x2*)(orow + j * 256 + lane * 4) = o; }
}
__device__ __forceinline__ void step_prologue(Frame& F, LAS unsigned char* lds) {
    LAS float* scr = (LAS float*)(lds + F.wave * 16384);
    GAS unsigned char* ws = F.ws;
    constexpr int I0 = 32 * (NIN0 / 32), I1 = 32 * 64, I2 = 32 * 96, I3 = 32 * 64, I4 = 32 * 64, I5 = 32 * 64, I6 = 32 * 64, I7 = 32 * 32, I8 = 32 * 32, I9 = 12 * 16;
    constexpr int NITEMS = I0 + I1 + I2 + I3 + I4 + I5 + I6 + I7 + I8 + I9;
    for (int it = F.gw; it < NITEMS; it += F.ngw) {
        int r = it;
        if (r < I0) { transpose_item(F.in(I_AWIN), NIN0, 0, F.in(I_ANORM), (GAS bf16_t*)(ws + O_WIN0), DM, 0, scr, NIN0 / 32, r, F.lane); continue; } r -= I0;
        if (r < I1) { transpose_item(F.in(I_AWOUT), DM, 0, nullptr, (GAS bf16_t*)(ws + O_WOUT0), DM, 0, scr, 64, r, F.lane); continue; } r -= I1;
        if (r < I2) { transpose_item(F.in(I_SWKVF), 3084, 0, F.in(I_SNORM), (GAS bf16_t*)(ws + O_WL1), DM, 0, scr, 96, r, F.lane); continue; } r -= I2;
        if (r < I3) { transpose_item(F.in(I_BWIN), DM, 0, F.in(I_BNORM), (GAS bf16_t*)(ws + O_WL1), DM, 3072, scr, 64, r, F.lane); continue; } r -= I3;
        if (r < I4) { transpose_item(F.in(I_BWOUT), DM, 0, nullptr, (GAS bf16_t*)(ws + O_WOUT1), DM, 0, scr, 64, r, F.lane); continue; } r -= I4;
        if (r < I5) { transpose_item(F.in(I_PWQ), DM, 0, F.in(I_PNORM), (GAS bf16_t*)(ws + O_WQ0), DM, 0, scr, 64, r, F.lane); continue; } r -= I5;
        if (r < I6) { transpose_item(F.in(I_PWQ) + (size_t)DM * DM, DM, 0, F.in(I_PNORM) + DM, (GAS bf16_t*)(ws + O_WQ1), DM, 0, scr, 64, r, F.lane); continue; } r -= I6;
        if (r < I7) { transpose_item(F.in(I_MWKV), 1024, 0, nullptr, (GAS bf16_t*)(ws + O_WMKV), DM, 0, scr, 32, r, F.lane); continue; } r -= I7;
        if (r < I8) { transpose_item(F.in(I_MWKV) + (size_t)DM * 1024, 1024, 0, nullptr, (GAS bf16_t*)(ws + O_WMKV) + (size_t)1024 * DM, DM, 0, scr, 32, r, F.lane); continue; } r -= I8;
        { const int blk = r / 16, sub = r % 16;
          transpose_item(F.in(I_AGATEW) + (size_t)blk * 128 * 256, 256, 0, nullptr, (GAS bf16_t*)(ws + O_WGATE), 128, blk * 256, scr, 8, sub, F.lane); }
    }
    { const GAS float* sk = F.in(I_PSUBK); GAS bf16_t* o = (GAS bf16_t*)(ws + O_SUBK);
      for (int i = F.gtid; i < 2 * 16 * 128 * 128 / 2; i += F.ngt) *(GAS unsigned*)(o + 2 * i) = cvtpk(sk[2 * i], sk[2 * i + 1]); }
    { GAS float* wf = (GAS float*)(ws + O_WF); const GAS float* w = F.in(I_SWKVF); const GAS float* g = F.in(I_SNORM);
      for (int i = F.gtid; i < 12 * DM; i += F.ngt) { const int j = i / DM, k = i % DM; wf[i] = w[(size_t)k * 3084 + 3072 + j] * g[k]; } }
    { GAS float* spl = (GAS float*)(ws + O_SPL); const GAS float* lam = F.in(I_ALAMBDA);
      for (int i = F.gtid; i < LRU; i += F.ngt) { const float z = -lam[i]; spl[i] = fmaxf(z, 0.f) + log1p_pos(fast_exp(-fabsf(z))); } }
    if (F.gw == 0) {
        float m = 0.f; for (int d = F.lane; d < 128; d += 64) m = fmaxf(m, fabsf(F.in(I_BQNORM)[d] * F.in(I_SKNORM)[d]));
        m = wave_max(m);
        if (F.lane == 0) ((GAS float*)(ws + O_GG))[512] = 2.f * 11.3137085f * m + 40.f; }
    { GAS float* gg = (GAS float*)(ws + O_GG);
      for (int i = F.gtid; i < 384; i += F.ngt) { const int a = i / 128, d = i % 128;
          gg[a == 0 ? 384 + d : i] = a == 0 ? F.in(I_BQNORM)[d] * F.in(I_SKNORM)[d] : F.in(I_MQNORM)[(a - 1) * 128 + d] * F.in(I_MKNORM)[(a - 1) * 128 + d]; } }
    for (int m = F.gw; m < T; m += 2 * F.ngw) {
        const int m1 = m + F.ngw < T ? m + F.ngw : m;
        const GAS float* x0 = F.in(I_X) + (size_t)m * DM + F.lane * 4; const GAS float* x1 = F.in(I_X) + (size_t)m1 * DM + F.lane * 4;
        f32x4 v0[8], v1[8]; float s0 = 0.f, s1 = 0.f;
#pragma unroll
        for (int j = 0; j < 8; ++j) { v0[j] = *(const GAS f32x4*)(x0 + j * 256); v1[j] = *(const GAS f32x4*)(x1 + j * 256); }
#pragma unroll
        for (int j = 0; j < 8; ++j) { s0 += (v0[j][0] * v0[j][0] + v0[j][1] * v0[j][1]) + (v0[j][2] * v0[j][2] + v0[j][3] * v0[j][3]); s1 += (v1[j][0] * v1[j][0] + v1[j][1] * v1[j][1]) + (v1[j][2] * v1[j][2] + v1[j][3] * v1[j][3]); }
        const float r0 = rsqrtf(wave_sum(s0) * (1.f / DM) + EPS), r1 = rsqrtf(wave_sum(s1) * (1.f / DM) + EPS);
        GAS bf16_t* o0 = (GAS bf16_t*)(ws + O_XS16) + (size_t)m * DM + F.lane * 4; GAS bf16_t* o1 = (GAS bf16_t*)(ws + O_XS16) + (size_t)m1 * DM + F.lane * 4;
#pragma unroll
        for (int j = 0; j < 8; ++j) { u32x2 a; a.x = cvtpk(v0[j][0] * r0, v0[j][1] * r0); a.y = cvtpk(v0[j][2] * r0, v0[j][3] * r0); *(GAS u32x2*)(o0 + j * 256) = a;
            u32x2 b; b.x = cvtpk(v1[j][0] * r1, v1[j][1] * r1); b.y = cvtpk(v1[j][2] * r1, v1[j][3] * r1); *(GAS u32x2*)(o1 + j * 256) = b; }
    }
    for (int m = F.gw; m < 2 * NMROW; m += F.ngw) { const int l = m / NMROW, r = m % NMROW;
        norm_row_bf16(F.in(I_MEM) + (size_t)r * DM, F.in(I_MNORM) + l * DM, (GAS bf16_t*)(ws + O_MEMN) + (size_t)m * DM, F.lane); }
    convert_tables(F, 0, 0, 2 * NEXP, F.gw, F.ngw);
}
__device__ __forceinline__ void step_conv(Frame& F) {
    const GAS bf16_t* zx = (const GAS bf16_t*)(F.ws + O_ZX); GAS bf16_t* xc = (GAS bf16_t*)(F.ws + O_XC);
    const GAS float* cw = F.in(I_ACONVW); const GAS float* cb = F.in(I_ACONVB);
    for (int it = F.gtid; it < T * (LRU / 8); it += F.ngt) {
        const int t = it / (LRU / 8), c8 = (it % (LRU / 8)) * 8, pos = t & (SEQ - 1);
        float a[8];
#pragma unroll
        for (int j = 0; j < 8; ++j) a[j] = cb[c8 + j];
#pragma unroll
        for (int k = 0; k < 4; ++k) { if (pos - 3 + k >= 0) { const u32x4 w = *(const GAS u32x4*)(zx + (size_t)(t - 3 + k) * LRU + c8);
            const float xv[8] = {bf_lo(w.x), bf_hi(w.x), bf_lo(w.y), bf_hi(w.y), bf_lo(w.z), bf_hi(w.z), bf_lo(w.w), bf_hi(w.w)};
#pragma unroll
            for (int j = 0; j < 8; ++j) a[j] = fmaf(cw[k * LRU + c8 + j], xv[j], a[j]); } }
        u32x4 o; o.x = cvtpk(a[0], a[1]); o.y = cvtpk(a[2], a[3]); o.z = cvtpk(a[4], a[5]); o.w = cvtpk(a[6], a[7]);
        *(GAS u32x4*)(xc + (size_t)t * LRU + c8) = o;
    }
}
typedef _Float16 h4_t __attribute__((ext_vector_type(4)));
__device__ __forceinline__ void scan_load4(const GAS _Float16* LA, const GAS _Float16* UH, size_t off, f32x4& a, f32x4& u) {
    const h4_t l = *(const GAS h4_t*)(LA + off), w = *(const GAS h4_t*)(UH + off);
    a = (f32x4){fast_exp((float)l.x), fast_exp((float)l.y), fast_exp((float)l.z), fast_exp((float)l.w)}; u = (f32x4){(float)w.x, (float)w.y, (float)w.z, (float)w.w};
}
__device__ __forceinline__ void step_scan1(Frame& F) {
    const GAS _Float16* LA = (const GAS _Float16*)(F.ws + O_AA); const GAS _Float16* UH = (const GAS _Float16*)(F.ws + O_UU);
    GAS float* CA = (GAS float*)(F.ws + O_CARRY); GAS float* CH = CA + (size_t)NB * 64 * LRU;
    if (F.tid >= LRU / 4) return;
    for (int it = blockIdx.x; it < NB * 64; it += gridDim.x) {
        const int b = it >> 6, ck = it & 63; const size_t base = ((size_t)b * SEQ + ck * 64) * LRU + F.tid * 4;
        f32x4 ap = {1.f, 1.f, 1.f, 1.f}, h = {0.f, 0.f, 0.f, 0.f};
#pragma unroll 8
        for (int i = 0; i < 64; ++i) { f32x4 a, u; scan_load4(LA, UH, base + (size_t)i * LRU, a, u);
            ap = ap * a; h = a * h + u; }
        *(GAS f32x4*)(CA + (size_t)it * LRU + F.tid * 4) = ap; *(GAS f32x4*)(CH + (size_t)it * LRU + F.tid * 4) = h;
    }
}
__device__ __forceinline__ void step_scan2(Frame& F) {
    const GAS _Float16* LA = (const GAS _Float16*)(F.ws + O_AA); const GAS _Float16* UH = (const GAS _Float16*)(F.ws + O_UU);
    const GAS float* CA = (const GAS float*)(F.ws + O_CARRY); const GAS float* CH = CA + (size_t)NB * 64 * LRU;
    const GAS bf16_t* gy = (const GAS bf16_t*)(F.ws + O_GY); GAS bf16_t* cat = (GAS bf16_t*)(F.ws + O_CAT);
    if (F.tid >= LRU / 4) return;
    for (int it = blockIdx.x; it < NB * 64; it += gridDim.x) {
        const int b = it >> 6, ck = it & 63; const size_t base = ((size_t)b * SEQ + ck * 64) * LRU + F.tid * 4;
        f32x4 h = {0.f, 0.f, 0.f, 0.f};
        for (int k = 0; k < ck; ++k) { const size_t o = (size_t)(b * 64 + k) * LRU + F.tid * 4; h = *(const GAS f32x4*)(CA + o) * h + *(const GAS f32x4*)(CH + o); }
#pragma unroll 8
        for (int i = 0; i < 64; ++i) { f32x4 a, u; scan_load4(LA, UH, base + (size_t)i * LRU, a, u);
            h = a * h + u;
            const size_t row = (size_t)b * SEQ + ck * 64 + i;
            const u32x2 g = *(const GAS u32x2*)(gy + row * LRU + F.tid * 4);
            u32x2 o; o.x = cvtpk(h[0] * bf_lo(g.x), h[1] * bf_hi(g.x)); o.y = cvtpk(h[2] * bf_lo(g.y), h[3] * bf_hi(g.y));
            *(GAS u32x2*)(cat + row * DM + F.tid * 4) = o; }
    }
}
__device__ __forceinline__ void step_cprefix(Frame& F, LAS unsigned char* lds) {
    const GAS float* lf = (const GAS float*)(F.ws + O_LOGF); GAS float* cc = (GAS float*)(F.ws + O_CC);
    LAS double* scr = (LAS double*)(lds + F.wave * 16384);
    for (int it = F.gw; it < NB * NH; it += F.ngw) {
        const GAS float* p = lf + (size_t)it * SEQ + F.lane * 64; GAS float* q = cc + (size_t)it * SEQ + F.lane * 64;
        double s = 0.0;
        for (int i = 0; i < 64; ++i) s += (double)p[i];
        scr[F.lane] = s;
        asm volatile("s_waitcnt lgkmcnt(0)" ::: "memory");
        double run = 0.0;
        for (int l = 0; l < 64; ++l) { const double v = scr[l]; if (l < F.lane) run += v; }
        for (int i = 0; i < 64; ++i) { run += (double)p[i]; q[i] = (float)run; }
        asm volatile("s_waitcnt lgkmcnt(0)" ::: "memory");
    }
}

__device__ __forceinline__ int ord_i(float f) { const int b = __float_as_int(f); return b ^ ((b >> 31) & 0x7fffffff); }
__device__ __forceinline__ float unord_f(int k) { return __int_as_float(k ^ ((k >> 31) & 0x7fffffff)); }
template <int N> __device__ __forceinline__ void bitonic_sort_desc(int (&a)[N]) {
#pragma unroll
    for (int k = 2; k <= N; k <<= 1) {
#pragma unroll
        for (int j = k >> 1; j > 0; j >>= 1) {
#pragma unroll
            for (int i = 0; i < N; ++i) { const int l = i ^ j;
                if (l > i) { const bool desc = ((i & k) == 0); const int mx = max(a[i], a[l]), mn = min(a[i], a[l]); a[i] = desc ? mx : mn; a[l] = desc ? mn : mx; } }
        }
    }
}
__device__ __forceinline__ void bitonic_merge16_desc(int (&a)[16]) {
#pragma unroll
    for (int j = 8; j > 0; j >>= 1) {
#pragma unroll
        for (int i = 0; i < 16; ++i) { const int l = i ^ j; if (l > i) { const int mx = max(a[i], a[l]), mn = min(a[i], a[l]); a[i] = mx; a[l] = mn; } }
    }
}
__device__ __forceinline__ void subkey_top16(const GAS bf16_t* qrow  , const GAS bf16_t* sk  , int r32, int hi, int (&top)[16]) {
    bf16x8 qf[8];
#pragma unroll
    for (int ks = 0; ks < 8; ++ks) qf[ks] = *(const GAS bf16x8*)(qrow + ks * 16 + hi * 8);
    unsigned loff = (unsigned)(r32 * 128 + hi * 8) * 2u; asm volatile("" : "+v"(loff));
    int key[64];
#pragma unroll
    for (int kb = 0; kb < 4; ++kb) {
        f32x16 acc = {};
#pragma unroll
        for (int ks = 0; ks < 8; ++ks) { const bf16x8 af = *(const GAS bf16x8*)((const GAS char*)(sk + kb * 32 * 128 + ks * 16) + loff);
            acc = __builtin_amdgcn_mfma_f32_32x32x16_bf16(af, qf[ks], acc, 0, 0, 0); }
#pragma unroll
        for (int r = 0; r < 16; ++r) { const int id = kb * 32 + (r & 3) + 8 * (r >> 2) + 4 * hi; key[kb * 16 + r] = (ord_i(acc[r]) & ~127) | (127 - id); }
        __builtin_amdgcn_sched_barrier(0);
    }
    bitonic_sort_desc<64>(key);
#pragma unroll
    for (int i = 0; i < 16; ++i) { auto r = __builtin_amdgcn_permlane32_swap((unsigned)key[15 - i], (unsigned)key[15 - i], false, false);
        const int pk = hi ? (int)r[0] : (int)r[1]; top[i] = max(key[i], pk); }
    bitonic_merge16_desc(top);
}
__device__ __forceinline__ void step_topk(Frame& F, LAS unsigned char* lds, int layer) {
    const GAS bf16_t* q16 = (const GAS bf16_t*)(F.ws + O_Q16); const GAS bf16_t* subk = (const GAS bf16_t*)(F.ws + O_SUBK) + (size_t)layer * 16 * 128 * 128;
    GAS int* IDX = (GAS int*)(F.ws + O_IDX); GAS float* GW = (GAS float*)(F.ws + O_GW);
    LAS int* scr = (LAS int*)(lds + F.wave * 16384) + F.lane * 33;
    const int r32 = F.lane & 31, hi = F.lane >> 5;
    for (int task = F.gw; task < (T / 32) * 8; task += F.ngw) {
        const int tb = task >> 3, h = task & 7; const int tok = tb * 32 + r32;
        const GAS bf16_t* qrow = q16 + (size_t)tok * DM + h * 256;
        int ta[16], tb16[16];
        subkey_top16(qrow, subk + (size_t)(h * 2 + 0) * 128 * 128, r32, hi, ta);
        subkey_top16(qrow + 128, subk + (size_t)(h * 2 + 1) * 128 * 128, r32, hi, tb16);
        float va[16], vb[16];
#pragma unroll
        for (int i = 0; i < 16; ++i) { va[i] = unord_f(ta[i] & ~127); vb[i] = unord_f(tb16[i] & ~127); scr[i] = 127 - (ta[i] & 127); scr[16 + i] = 127 - (tb16[i] & 127); }
        int c2[64]; int n = 0;
#pragma unroll
        for (int i = 0; i < 16; ++i)
#pragma unroll
            for (int j = 0; j < 16; ++j) if ((i + 1) * (j + 1) <= 16) { c2[n] = (ord_i(va[i] + vb[j]) & ~255) | (255 - (i * 16 + j)); ++n; }
#pragma unroll
        for (int i = 50; i < 64; ++i) c2[i] = (int)0x80000000;
        bitonic_sort_desc<64>(c2);
        asm volatile("s_waitcnt lgkmcnt(0)" ::: "memory");
        float sv[16], ex[16]; int ev[16]; float Z = 0.f;
#pragma unroll
        for (int r = 0; r < 16; ++r) { const int flat = 255 - (c2[r] & 255); sv[r] = unord_f(c2[r] & ~255); ev[r] = scr[flat >> 4] * 128 + scr[16 + (flat & 15)]; }
#pragma unroll
        for (int r = 0; r < 16; ++r) { ex[r] = fast_exp(sv[r] - sv[0]); Z += ex[r]; }
        const float iz = 1.f / Z;
        GAS int* ip = IDX + (size_t)tok * 128 + h * 16 + hi * 8; GAS float* gp = GW + (size_t)tok * 128 + h * 16 + hi * 8;
        int eo[8]; float go[8];
#pragma unroll
        for (int j = 0; j < 8; ++j) { eo[j] = hi ? ev[8 + j] : ev[j]; go[j] = (hi ? ex[8 + j] : ex[j]) * iz; }
        *(GAS u32x4*)ip = (u32x4){(unsigned)eo[0], (unsigned)eo[1], (unsigned)eo[2], (unsigned)eo[3]}; *(GAS u32x4*)(ip + 4) = (u32x4){(unsigned)eo[4], (unsigned)eo[5], (unsigned)eo[6], (unsigned)eo[7]};
        *(GAS f32x4*)gp = (f32x4){go[0], go[1], go[2], go[3]}; *(GAS f32x4*)(gp + 4) = (f32x4){go[4], go[5], go[6], go[7]};
        asm volatile("s_waitcnt lgkmcnt(0)" ::: "memory");
    }
}
__device__ __forceinline__ h2 as_h2(unsigned w) { return __builtin_bit_cast(h2, w); }
#define F4(W, s) __builtin_amdgcn_cvt_scalef32_pk_f16_fp4((W), 1.0f, (s))
#define H2F(us) ((float)__builtin_bit_cast(_Float16, (unsigned short)(us)))
__device__ __forceinline__ float sum8(float v) { v += dppf<0xB1>(v); v += dppf<0x4E>(v); v += dppf<0x141>(v); return v; }
__device__ __forceinline__ void step_xplanes(Frame& F) {
    const GAS bf16_t* xs = (const GAS bf16_t*)(F.ws + O_XS16); GAS unsigned char* x4 = F.ws + O_X4; GAS float* sx = (GAS float*)(F.ws + O_SX);
    for (int t = F.gw; t < T; t += F.ngw) {
        const GAS bf16_t* xr = xs + (size_t)t * DM + F.lane * 32;
        u32x4 w[4]; float xv[32]; float amax = 0.f;
#pragma unroll
        for (int c = 0; c < 4; ++c) w[c] = *(const GAS u32x4*)(xr + 8 * c);
#pragma unroll
        for (int c = 0; c < 4; ++c)
#pragma unroll
            for (int k = 0; k < 4; ++k) { xv[8 * c + 2 * k] = bf_lo(w[c][k]); xv[8 * c + 2 * k + 1] = bf_hi(w[c][k]); amax = fmaxf(amax, fmaxf(fabsf(xv[8 * c + 2 * k]), fabsf(xv[8 * c + 2 * k + 1]))); }
        amax = fmaxf(amax, dppf<0xB1>(amax)); amax = fmaxf(amax, dppf<0x4E>(amax)); amax = fmaxf(amax, dppf<0x141>(amax));
        const float sc = fmaxf(amax, 1e-20f) * (1.f / 119.f), qs = 1.f / sc;
        u32x4 hp, lp;
#pragma unroll
        for (int d = 0; d < 4; ++d) { unsigned hw = 0u, lw = 0u;
#pragma unroll
            for (int k = 0; k < 8; ++k) { const int q = (int)rintf(xv[8 * d + k] * qs); const int h = (q + 8) >> 4, l = q - 16 * h; hw |= (unsigned)(h & 15) << (4 * k); lw |= (unsigned)(l & 15) << (4 * k); }
            hp[d] = hw; lp[d] = lw; }
        *(GAS u32x4*)(x4 + ((size_t)t * 64 + F.lane) * 32) = hp; *(GAS u32x4*)(x4 + ((size_t)t * 64 + F.lane) * 32 + 16) = lp;
        if ((F.lane & 7) == 0) sx[(size_t)t * 8 + (F.lane >> 3)] = sc;
    }
}
__device__ __forceinline__ void step_upass(Frame& F, int layer, int G) {
    const int s = blockIdx.x & 7, wk = (blockIdx.x >> 3) * NWAVES + F.wave, nwk = (G >> 3) * NWAVES;
    const GAS unsigned char* UN = F.ws + O_TAB + (size_t)(layer * 2) * TAB_ONE + (size_t)s * NEXP * 128;
    const GAS int* IDX = (const GAS int*)(F.ws + O_IDX); const GAS unsigned char* x4 = F.ws + O_X4 + s * 256; const GAS float* sxp = (const GAS float*)(F.ws + O_SX) + s;
    GAS float* part = (GAS float*)(F.ws + O_PART) + (size_t)s * T * 128;
    unsigned lo = (unsigned)F.lane; asm volatile("" : "+v"(lo));
    const unsigned j = lo >> 3, p = lo & 7;
    const int tlast = wk + ((T - 1 - wk) / nwk) * nwk;
#define U_LOADID(ID, t_, q_) do { const int tt_ = (t_) <= tlast ? (t_) : tlast; _Pragma("unroll") for (int b = 0; b < 4; ++b) ID[b] = IDX[(size_t)tt_ * 128 + (q_) * 32 + 8 * b + j]; } while (0)
#define U_LOADX(t_) do { const int tt_ = (t_) <= tlast ? (t_) : tlast; xhn = *(const GAS u32x4*)(x4 + (size_t)tt_ * 2048 + p * 32); xln = *(const GAS u32x4*)(x4 + (size_t)tt_ * 2048 + p * 32 + 16); sxn = sxp[(size_t)tt_ * 8]; } while (0)
#define U_ISSUE(UB, ID) do { _Pragma("unroll") for (int b = 0; b < 4; ++b) UB[b] = *(const GAS u32x4*)(UN + (unsigned)(ID[b] * 128 + (int)p * 16)); } while (0)
#define U_QUARTER(UB, vout, q_) do { _Pragma("unroll") for (int b = 0; b < 4; ++b) { int ah = 0, al = 0; \
            ah = __builtin_amdgcn_sdot8((int)UB[b].x, (int)xh.x, ah, false); al = __builtin_amdgcn_sdot8((int)UB[b].x, (int)xl.x, al, false); \
            ah = __builtin_amdgcn_sdot8((int)UB[b].y, (int)xh.y, ah, false); al = __builtin_amdgcn_sdot8((int)UB[b].y, (int)xl.y, al, false); \
            ah = __builtin_amdgcn_sdot8((int)UB[b].z, (int)xh.z, ah, false); al = __builtin_amdgcn_sdot8((int)UB[b].z, (int)xl.z, al, false); \
            ah = __builtin_amdgcn_sdot8((int)UB[b].w, (int)xh.w, ah, false); al = __builtin_amdgcn_sdot8((int)UB[b].w, (int)xl.w, al, false); \
            const float d = sum8((float)(16 * ah + al)) * sxc; vout = (p == (unsigned)(4 * ((q_) & 1) + b)) ? d : vout; } } while (0)
    int idA[4], idB[4]; u32x4 u0[4], u1[4], u2[4], u3[4]; u32x4 xh, xl, xhn, xln; float sxc, sxn;
    U_LOADID(idA, wk, 0); U_LOADID(idB, wk, 1); U_LOADX(wk);
    U_ISSUE(u0, idA); U_LOADID(idA, wk, 2);
    U_ISSUE(u1, idB); U_LOADID(idB, wk, 3);
    U_ISSUE(u2, idA); U_LOADID(idA, wk + nwk, 0);
    xh = xhn; xl = xln; sxc = sxn;
    for (int t = wk; t < T; t += nwk) {
        float v0 = 0.f, v1 = 0.f;
        U_ISSUE(u3, idB); U_LOADID(idB, t + nwk, 1); U_LOADX(t + nwk);
        U_QUARTER(u0, v0, 0);
        U_ISSUE(u0, idA); U_LOADID(idA, t + nwk, 2);
        U_QUARTER(u1, v0, 1);
        U_ISSUE(u1, idB); U_LOADID(idB, t + nwk, 3);
        U_QUARTER(u2, v1, 2);
        U_ISSUE(u2, idA); U_LOADID(idA, t + 2 * nwk, 0);
        U_QUARTER(u3, v1, 3);
        part[(size_t)t * 128 + 8 * p + j] = v0; part[(size_t)t * 128 + 64 + 8 * p + j] = v1;
        xh = xhn; xl = xln; sxc = sxn;
    }
#undef U_LOADID
#undef U_LOADX
#undef U_ISSUE
#undef U_QUARTER
}
__device__ __forceinline__ void step_peer_reduce(Frame& F, int layer) {
    const GAS float* part = (const GAS float*)(F.ws + O_PART); const GAS float* GW = (const GAS float*)(F.ws + O_GW); const GAS int* IDX = (const GAS int*)(F.ws + O_IDX);
    const GAS float* rowss = (const GAS float*)(F.ws + O_ROWSS); GAS unsigned* PK = (GAS unsigned*)(F.ws + O_PK);
    const GAS unsigned char* SU = F.ws + O_TAB + (size_t)(layer * 2) * TAB_ONE + TAB_NIB; const GAS unsigned char* SV = SU + TAB_ONE;
    for (int it = F.gw; it < T * 2; it += F.ngw) { const int t = it >> 1; const size_t i = (size_t)it * 64 + F.lane;
        const float r = rsqrtf(wave_sum(rowss[(size_t)t * 32 + (F.lane & 31)]) * (0.5f / DM) + EPS);
        const int id = IDX[i];
        const u32x4 su = *(const GAS u32x4*)(SU + (size_t)id * 16), sv = *(const GAS u32x4*)(SV + (size_t)id * 16);
        float d = 0.f;
#pragma unroll
        for (int s = 0; s < 8; ++s) d += part[(size_t)s * T * 128 + i] * (float)__builtin_bit_cast(_Float16, (unsigned short)(su[s >> 1] >> (16 * (s & 1))));
        const float w = GW[i] * gelu_tanh(d * r);
#pragma unroll
        for (int s = 0; s < 8; ++s) { const _Float16 ws = (_Float16)(w * (float)__builtin_bit_cast(_Float16, (unsigned short)(sv[s >> 1] >> (16 * (s & 1)))));
            PK[(size_t)s * T * 128 + i] = ((unsigned)id << 16) | (unsigned)__builtin_bit_cast(unsigned short, ws); } }
}
__device__ __forceinline__ void step_vpass(Frame& F, int layer, int G, bool dry) {
    const int s = blockIdx.x & 7, wk = (blockIdx.x >> 3) * NWAVES + F.wave, nwk = (G >> 3) * NWAVES;
    const GAS unsigned char* VN = F.ws + O_TAB + (size_t)(layer * 2 + 1) * TAB_ONE + (size_t)s * NEXP * 128;
    const GAS unsigned* PK = (const GAS unsigned*)(F.ws + O_PK) + (size_t)s * T * 128;
    GAS bf16_t* xs = (GAS bf16_t*)(F.ws + O_XS16); GAS float* rsp = (GAS float*)(F.ws + O_RSP);
    unsigned lo = (unsigned)F.lane; asm volatile("" : "+v"(lo));
    const unsigned j = lo >> 3, p = lo & 7;
    const int tlast = wk + ((T - 1 - wk) / nwk) * nwk;
#define V_LOADPK(PKV, t_, q_) do { const int tt_ = (t_) <= tlast ? (t_) : tlast; _Pragma("unroll") for (int b = 0; b < 4; ++b) PKV[b] = PK[(size_t)tt_ * 128 + (q_) * 32 + 8 * b + j]; } while (0)
#define V_ISSUE(VB, PKV) do { _Pragma("unroll") for (int b = 0; b < 4; ++b) VB[b] = *(const GAS u32x4*)(VN + ((PKV[b] >> 16) * 128u + p * 16u)); } while (0)
#define V_CVT4(W, base) do { c_[(base)] = F4(W, 0); c_[(base) + 1] = F4(W, 1); c_[(base) + 2] = F4(W, 2); c_[(base) + 3] = F4(W, 3); } while (0)
#define V_QUARTER(VB, PKV) do { _Pragma("unroll") for (int b = 0; b < 4; ++b) { const _Float16 wl = __builtin_bit_cast(_Float16, (unsigned short)(PKV[b] & 0xffffu)); const h2 wl2 = {wl, wl}; h2 c_[16]; \
            V_CVT4(VB[b].x, 0); V_CVT4(VB[b].y, 4); V_CVT4(VB[b].z, 8); V_CVT4(VB[b].w, 12); \
            __builtin_amdgcn_sched_barrier(0); \
            _Pragma("unroll") for (int k = 0; k < 16; ++k) oh[k] = wl2 * c_[k] + oh[k]; \
            __builtin_amdgcn_sched_barrier(0); } } while (0)
    unsigned pk0[4], pk1[4], pk2[4], pk3[4], pkn[4]; u32x4 v0[4], v1[4], v2[4], v3[4];
    V_LOADPK(pk0, wk, 0); V_LOADPK(pk1, wk, 1); V_LOADPK(pk2, wk, 2); V_LOADPK(pkn, wk, 3);
    V_ISSUE(v0, pk0); V_ISSUE(v1, pk1); V_ISSUE(v2, pk2);
    for (int t = wk; t < T; t += nwk) {
#pragma unroll
        for (int b = 0; b < 4; ++b) pk3[b] = pkn[b];
        V_ISSUE(v3, pk3); V_LOADPK(pkn, t + nwk, 0);
        GAS float* xr = F.out + (size_t)t * DM + s * 256 + p * 32 + j * 4; f32x4 x2 = *(const GAS f32x4*)xr;
        h2 oh[16];
#pragma unroll
        for (int i = 0; i < 16; ++i) oh[i] = (h2){(_Float16)0.f, (_Float16)0.f};
        V_QUARTER(v0, pk0);
#pragma unroll
        for (int b = 0; b < 4; ++b) pk0[b] = pkn[b];
        V_ISSUE(v0, pk0); V_LOADPK(pkn, t + nwk, 1);
        V_QUARTER(v1, pk1);
#pragma unroll
        for (int b = 0; b < 4; ++b) pk1[b] = pkn[b];
        V_ISSUE(v1, pk1); V_LOADPK(pkn, t + nwk, 2);
        V_QUARTER(v2, pk2);
#pragma unroll
        for (int b = 0; b < 4; ++b) pk2[b] = pkn[b];
        V_ISSUE(v2, pk2); V_LOADPK(pkn, t + nwk, 3);
        V_QUARTER(v3, pk3);
#pragma unroll
        for (int i = 0; i < 16; ++i) { unsigned u = __builtin_bit_cast(unsigned, oh[i]);
            h2 a = as_h2(u) + as_h2((unsigned)__builtin_amdgcn_update_dpp(0, (int)u, 0x128, 0xF, 0xF, true)); u = __builtin_bit_cast(unsigned, a);
            { auto r = __builtin_amdgcn_permlane16_swap(u, u, false, false); a = as_h2(r[0]) + as_h2(r[1]); u = __builtin_bit_cast(unsigned, a); }
            { auto r = __builtin_amdgcn_permlane32_swap(u, u, false, false); a = as_h2(r[0]) + as_h2(r[1]); }
            oh[i] = a; }
        h2 o0 = oh[0], o1 = oh[1];
#pragma unroll
        for (int c = 1; c < 8; ++c) { o0 = (j == (unsigned)c) ? oh[2 * c] : o0; o1 = (j == (unsigned)c) ? oh[2 * c + 1] : o1; }
        x2[0] += (float)o0.x; x2[1] += (float)o0.y; x2[2] += (float)o1.x; x2[3] += (float)o1.y;
        if (!dry) *(GAS f32x4*)xr = x2;
        if (layer == 0 && !dry) {
            { u32x2 o; o.x = cvtpk(x2[0], x2[1]); o.y = cvtpk(x2[2], x2[3]); *(GAS u32x2*)(xs + (size_t)t * DM + s * 256 + p * 32 + j * 4) = o; }
            const float sst = wave_sum((x2[0] * x2[0] + x2[1] * x2[1]) + (x2[2] * x2[2] + x2[3] * x2[3]));
            if (lo == 0) rsp[(size_t)t * 8 + s] = sst;
        }
    }
#undef V_LOADPK
#undef V_ISSUE
#undef V_CVT4
#undef V_QUARTER
}
#undef F4
#undef H2F
__device__ __forceinline__ void step_logf(Frame& F) {
    const GAS bf16_t* xs = (const GAS bf16_t*)(F.ws + O_XS16); const GAS float* rsp = (const GAS float*)(F.ws + O_RSP); GAS float* logf = (GAS float*)(F.ws + O_LOGF);
    const GAS float* wf = (const GAS float*)(F.ws + O_WF);
    for (int t = F.gw; t < T; t += F.ngw) {
        unsigned lo = (unsigned)F.lane; asm volatile("" : "+v"(lo));
        float xv[32];
#pragma unroll
        for (int c = 0; c < 4; ++c) { const u32x4 w = *(const GAS u32x4*)(xs + (size_t)t * DM + c * 512 + lo * 8);
#pragma unroll
            for (int k = 0; k < 4; ++k) { xv[8 * c + 2 * k] = bf_lo(w[k]); xv[8 * c + 2 * k + 1] = bf_hi(w[k]); } }
        const float q = wave_sum(lo < 8 ? rsp[(size_t)t * 8 + lo] : 0.f);
        const float r1 = rsqrtf(q * (1.f / DM) + EPS);
        float mine = 0.f;
        for (int h = 0; h < NH; ++h) { float d = 0.f;
#pragma unroll
            for (int c = 0; c < 4; ++c) { const f32x4 w0 = *(const GAS f32x4*)(wf + (size_t)h * DM + c * 512 + lo * 8), w1 = *(const GAS f32x4*)(wf + (size_t)h * DM + c * 512 + lo * 8 + 4);
                d += (xv[8 * c] * w0[0] + xv[8 * c + 1] * w0[1]) + (xv[8 * c + 2] * w0[2] + xv[8 * c + 3] * w0[3]) + (xv[8 * c + 4] * w1[0] + xv[8 * c + 5] * w1[1]) + (xv[8 * c + 6] * w1[2] + xv[8 * c + 7] * w1[3]); }
            d = wave_sum(d); mine = (lo == (unsigned)h) ? d : mine; }
        if (lo < (unsigned)NH) { const float z = mine * r1 + F.in(I_SBF)[lo];
            logf[((size_t)(t / SEQ) * NH + lo) * SEQ + (t % SEQ)] = fminf(z, 0.f) - log1p_pos(fast_exp(-fabsf(z))); }
    }
}

#define XB_TMO      128
#define XB_XCNT(j)  (256  + 64 * (j))
#define XB_XSUB(j)  (1280 + 64 * (j))
#define XB_XGEN(j)  (2304 + 64 * (j))
#define XB_TOP      3328
#define XB_TOPGEN   3392
#define XCD_BAR_WORDS 3456
#define XB_SPIN_CAP (1u << 20)
__device__ __forceinline__ unsigned xb_ld(unsigned* p)              { return __hip_atomic_load(p, __ATOMIC_RELAXED, __HIP_MEMORY_SCOPE_AGENT); }
__device__ __forceinline__ unsigned xb_add(unsigned* p, unsigned v) { return __hip_atomic_fetch_add(p, v, __ATOMIC_RELAXED, __HIP_MEMORY_SCOPE_AGENT); }
__device__ __forceinline__ unsigned xb_xcc_id() { return (unsigned)__builtin_amdgcn_s_getreg((3 << 11) | 20) & 0xFu; }
#define XB_SPIN(cond, bar) do { unsigned _sp = 0; while (cond) { __builtin_amdgcn_s_sleep(1); \
    if ((++_sp & 255u) == 0u) { if (xb_ld(&(bar)[XB_TMO])) break; if (_sp > XB_SPIN_CAP) { atomicAdd(&(bar)[XB_TMO], 1u); break; } } } } while (0)
struct XcdBarrier { unsigned* bar; unsigned x; volatile LAS unsigned* st; };
__device__ __forceinline__ XcdBarrier xcd_barrier_post(unsigned* bar, volatile LAS unsigned* st) {
    XcdBarrier b; b.bar = bar; b.x = xb_xcc_id(); b.st = st;
    if (threadIdx.x == 0) (void)xb_add(&bar[XB_XCNT(b.x)], 1u);
    return b;
}
__device__ __forceinline__ void xcd_barrier_complete(unsigned* bar, unsigned x, unsigned& nloc, unsigned& nx) {
    const unsigned G = gridDim.x * gridDim.y * gridDim.z;
    unsigned sum, cnt, mine, sp = 0u;
    for (;;) {
        sum = 0u; cnt = 0u; mine = 0u;
#pragma unroll
        for (unsigned j = 0; j < 16; ++j) { const unsigned c = xb_ld(&bar[XB_XCNT(j)]); sum += c; cnt += (c > 0u) ? 1u : 0u; mine = (j == x) ? c : mine; }
        if (sum == G) break;
        __builtin_amdgcn_s_sleep(1);
        if ((++sp & 255u) == 0u) { if (xb_ld(&bar[XB_TMO])) break; if (sp > XB_SPIN_CAP) { atomicAdd(&bar[XB_TMO], 1u); break; } }
    }
    nloc = mine > 0u ? mine : 1u; nx = cnt > 0u ? cnt : 1u;
}
__device__ __forceinline__ void xcd_barrier(const XcdBarrier& b, int wave_s) {
    asm volatile("s_waitcnt vmcnt(0)" ::: "memory");
    __syncthreads();
    int ln_; asm volatile("v_mbcnt_lo_u32_b32 %0, -1, 0\n\tv_mbcnt_hi_u32_b32 %0, -1, %0" : "=v"(ln_));
    if (wave_s == 0 && ln_ == 0) {
        unsigned* bar = b.bar;
        __builtin_amdgcn_s_waitcnt(0);
        unsigned nloc = b.st[0], nx = b.st[1];
        if (nloc == 0u) { xcd_barrier_complete(bar, b.x, nloc, nx); b.st[0] = nloc; b.st[1] = nx; }
        const unsigned old = xb_add(&bar[XB_XSUB(b.x)], 1u);
        const unsigned gen = old / nloc;
        if (old + 1u == (gen + 1u) * nloc) {
            __builtin_amdgcn_fence(__ATOMIC_RELEASE, "agent");
            asm volatile("s_waitcnt vmcnt(0)" ::: "memory");
            const unsigned og = xb_add(&bar[XB_TOP], 1u);
            const unsigned tg = og / nx;
            if (og + 1u == (tg + 1u) * nx) xb_add(&bar[XB_TOPGEN], 1u);
            else XB_SPIN(xb_ld(&bar[XB_TOPGEN]) == tg, bar);
            __builtin_amdgcn_fence(__ATOMIC_ACQUIRE, "agent");
            xb_add(&bar[XB_XGEN(b.x)], 1u);
            asm volatile("s_waitcnt vmcnt(0)" ::: "memory");
        } else {
            XB_SPIN(xb_ld(&bar[XB_XGEN(b.x)]) == gen, bar);
            __builtin_amdgcn_fence(__ATOMIC_ACQUIRE, "agent");
            asm volatile("s_waitcnt vmcnt(0)" ::: "memory");
        }
    }
    __syncthreads();
}

constexpr int CONV1_SPLIT = 2 * 3584;
constexpr int BAR_LDS_OFF = 147456 - 64;
constexpr int LDS_BYTES = 147456;
enum { ST_PROLOGUE = 0, ST_G_IN0, ST_G_MKV0, ST_G_MKV1, ST_CONV, ST_G_GATE, ST_A_MEM0, ST_SCAN1, ST_SCAN2, ST_G_OUT0, ST_G_PQ0, ST_TOPK0, ST_UPASS0, ST_PRED0, ST_VPASS0,
       ST_G_L1, ST_CPREFIX, ST_A_FOX, ST_A_MEM1, ST_G_OUT1, ST_G_PQ1, ST_TOPK1, ST_UPASS1, ST_PRED1, ST_VPASS1, N_STEPS };
constexpr unsigned SYNC_AFTER = (1u << ST_PROLOGUE) | (1u << ST_G_MKV1) | (1u << ST_CONV) | (1u << ST_A_MEM0) | (1u << ST_SCAN1) | (1u << ST_SCAN2) | (1u << ST_G_OUT0) | (1u << ST_G_PQ0) |
                                (1u << ST_TOPK0) | (1u << ST_UPASS0) | (1u << ST_PRED0) | (1u << ST_VPASS0) | (1u << ST_G_L1) | (1u << ST_CPREFIX) | (1u << ST_A_MEM1) | (1u << ST_G_OUT1) | (1u << ST_G_PQ1) | (1u << ST_TOPK1) | (1u << ST_UPASS1) | (1u << ST_PRED1);
constexpr unsigned GEMM_STEPS = (1u << ST_G_IN0) | (1u << ST_G_MKV0) | (1u << ST_G_MKV1) | (1u << ST_G_GATE) | (1u << ST_G_OUT0) | (1u << ST_G_PQ0) | (1u << ST_G_L1) | (1u << ST_G_OUT1) | (1u << ST_G_PQ1);
constexpr unsigned ATTN_STEPS = (1u << ST_A_MEM0) | (1u << ST_A_FOX) | (1u << ST_A_MEM1);

struct Args { const float* in[N_IN]; float* out; unsigned char* ws; int lo, hi; };

__global__ void __launch_bounds__(NTHREADS, 2) yoco_fwd(Args args) {
    extern __shared__ __attribute__((aligned(16))) unsigned char lds[];
    volatile LAS unsigned* bst = (volatile LAS unsigned*)((LAS unsigned char*)lds + BAR_LDS_OFF);
    if (threadIdx.x == 0) { bst[0] = 0u; bst[1] = 0u; }
    __syncthreads();
    const XcdBarrier gbar = xcd_barrier_post((unsigned*)(args.ws + O_CTL), bst);
    const int G = gridDim.x;
    const int wave_s = __builtin_amdgcn_readfirstlane(threadIdx.x >> 6);
#ifndef DUP_MASK
#define DUP_MASK 0u
#endif
    for (int st = args.lo; st < args.hi; ++st) {
      const int nrep = ((DUP_MASK >> st) & 1u) ? 2 : 1;
      for (int rep = 0; rep < nrep; ++rep) {
        unsigned char* ws0 = args.ws; asm volatile("" : "+s"(ws0));
        GAS unsigned char* ws = (GAS unsigned char*)ws0;
#define LANE_ID(v) asm volatile("v_mbcnt_lo_u32_b32 %0, -1, 0\n\tv_mbcnt_hi_u32_b32 %0, -1, %0" : "=v"(v))
#define MAKE_TID(v) do { LANE_ID(v); v += wave_s * 64; } while (0)
#define MAKE_FRAME(F) Frame F; F.ws = ws; F.in_ = args.in; F.out = (GAS float*)args.out; { int t0_; MAKE_TID(t0_); F.tid = t0_; } F.lane = F.tid & 63; F.wave = wave_s; \
        F.gw = blockIdx.x * NWAVES + F.wave; F.ngw = gridDim.x * NWAVES; F.gtid = blockIdx.x * NTHREADS + F.tid; F.ngt = gridDim.x * NTHREADS
        if (st == ST_G_L1) { MAKE_FRAME(F); step_logf(F); }
        if ((GEMM_STEPS >> st) & 1u) {
            pg8::Gemm g; Epi E; E.ws = ws; E.resid = nullptr; E.outf = nullptr; E.o16 = nullptr; E.ssq = nullptr; E.gate_b = nullptr; int shift = 0;
            switch (st) {
            case ST_G_IN0:  g = {(const GAS bf16_t*)(ws + O_XS16), (const GAS bf16_t*)(ws + O_WIN0), T, NIN0, DM, DM, DM, 0}; E.mode = EM_IN0; break;
            case ST_G_MKV0: g = {(const GAS bf16_t*)(ws + O_MEMN), (const GAS bf16_t*)(ws + O_WMKV), NMROW, 1024, DM, DM, DM, 0}; E.mode = EM_MKV; E.o16 = (GAS bf16_t*)(ws + O_MKV); E.ssq = (GAS float*)(ws + O_MKSS); shift = 128; break;
            case ST_G_MKV1: g = {(const GAS bf16_t*)(ws + O_MEMN) + (size_t)NMROW * DM, (const GAS bf16_t*)(ws + O_WMKV) + (size_t)1024 * DM, NMROW, 1024, DM, DM, DM, 0}; E.mode = EM_MKV;
                            E.o16 = (GAS bf16_t*)(ws + O_MKV) + (size_t)NMROW * NL1; E.ssq = (GAS float*)(ws + O_MKSS) + NMROW * 112; shift = 144; break;
            case ST_G_GATE: g = {(const GAS bf16_t*)(ws + O_XC), (const GAS bf16_t*)(ws + O_WGATE), T, 12 * 256, 128, LRU, 128, 128}; E.mode = EM_GATE; E.gate_b = (const GAS float*)args.in[I_AGATEB]; break;
            case ST_G_OUT0: g = {(const GAS bf16_t*)(ws + O_CAT), (const GAS bf16_t*)(ws + O_WOUT0), T, DM, DM, DM, DM, 0}; E.mode = EM_RES; E.resid = (const GAS float*)args.in[I_X]; E.outf = (GAS float*)args.out; break;
            case ST_G_PQ0:  g = {(const GAS bf16_t*)(ws + O_XS16), (const GAS bf16_t*)(ws + O_WQ0), T, DM, DM, DM, DM, 0}; E.mode = EM_PQ; E.o16 = (GAS bf16_t*)(ws + O_Q16); break;
            case ST_G_L1:   g = {(const GAS bf16_t*)(ws + O_XS16), (const GAS bf16_t*)(ws + O_WL1), T, NL1, DM, DM, DM, 0}; E.mode = EM_L1; break;
            case ST_G_OUT1: g = {(const GAS bf16_t*)(ws + O_CAT), (const GAS bf16_t*)(ws + O_WOUT1), T, DM, DM, DM, DM, 0}; E.mode = EM_RES; E.resid = (const GAS float*)args.out; E.outf = (GAS float*)args.out; break;
            default:        g = {(const GAS bf16_t*)(ws + O_XS16), (const GAS bf16_t*)(ws + O_WQ1), T, DM, DM, DM, DM, 0}; E.mode = EM_PQ; E.o16 = (GAS bf16_t*)(ws + O_Q16); break;
            }
            pg8::StaticOrder S; S.init(g.M, g.N, G, (int)((blockIdx.x + G - shift) % G));
#ifndef DIS_GEMM
            { int tg_; MAKE_TID(tg_);
              pg8::gemm_phase<Epi, false>((LAS unsigned char*)lds, g, S, E, tg_); }
#endif
            if (st == ST_G_MKV1 && blockIdx.x >= 160) { MAKE_FRAME(F); convert_tables(F, 1, 0, CONV1_SPLIT, (blockIdx.x - 160) * NWAVES + F.wave, (G - 160) * NWAVES); }
        } else if ((ATTN_STEPS >> st) & 1u) {
            const int nun = st == ST_A_FOX ? 3 : 1;
            for (int ui = 0; ui < nun; ++ui) {
                att::BlockRef r;
                if (st == ST_A_FOX) {
                    const int i = blockIdx.x, x = i & 15, bh = (i >> 4) + 16 * ui, qb = ui == 0 ? x : (ui == 1 ? 15 - x : ((x * 5 + 3) & 15));
                    const int b = bh / NH, h = bh % NH; const size_t row0 = (size_t)b * SEQ + qb * 256;
                    const GAS bf16_t* z = (const GAS bf16_t*)(ws + O_ZL1);
                    r.Q = z + row0 * NL1 + 3072 + h * 128; r.K = z + (size_t)b * SEQ * NL1 + h * 128; r.V = z + (size_t)b * SEQ * NL1 + 1536 + h * 128;
                    r.O = (GAS bf16_t*)(ws + O_CAT) + row0 * DM + h * 128;
                    const GAS float* ss = (const GAS float*)(ws + O_SSL1);
                    r.qss = ss + row0 * 112 + (12 + h) * 4; r.kss = ss + (size_t)b * SEQ * 112 + h * 4; r.cc = (const GAS float*)(ws + O_CC) + (size_t)bh * SEQ; r.gg = (const GAS float*)(ws + O_GG) + 384;
                    r.P0 = qb * 256; r.skv = SEQ;
                } else {
                    const int l = st == ST_A_MEM0 ? 0 : 1; const int i = blockIdx.x, qblk = i >> 2, h = i & 3, b = qblk >> 4; const size_t row0 = (size_t)qblk * 256;
                    r.Q = (const GAS bf16_t*)(ws + O_ZL1) + row0 * NL1 + 4608 + h * 128; r.qss = (const GAS float*)(ws + O_SSL1) + row0 * 112 + (24 + h) * 4;
                    const GAS bf16_t* kv = (const GAS bf16_t*)(ws + O_MKV) + ((size_t)l * NMROW + b * NMEM) * NL1;
                    r.K = kv + h * 128; r.V = kv + 512 + h * 128; r.kss = (const GAS float*)(ws + O_MKSS) + ((size_t)l * NMROW + b * NMEM) * 112 + h * 4;
                    r.O = (GAS bf16_t*)(ws + O_CAT) + row0 * DM + LRU + h * 128; r.cc = nullptr; r.gg = (const GAS float*)(ws + O_GG) + 128 * (1 + l);
                    r.P0 = SEQ; r.skv = NMEM;
                }
                att::Seam S;
                int tid_u; MAKE_TID(tid_u);
#ifndef DIS_ATTN
                att::attn_prime(r, (char*)lds, S, tid_u);
                att::attn_block(r, (char*)lds, S, tid_u);
#endif
            }
        } else {
            MAKE_FRAME(F);
            switch (st) {
#ifndef DIS_MISC
            case ST_PROLOGUE: step_prologue(F, (LAS unsigned char*)lds); break;
            case ST_CONV: step_conv(F); break;
            case ST_SCAN1: step_scan1(F); break;
            case ST_SCAN2: step_scan2(F); break;
#endif
#ifndef DIS_TOPK
            case ST_TOPK0: step_topk(F, (LAS unsigned char*)lds, 0); step_xplanes(F); break;
            case ST_TOPK1: step_topk(F, (LAS unsigned char*)lds, 1); step_xplanes(F); break;
#endif
#ifndef DIS_GATHER
            case ST_UPASS0: step_upass(F, 0, G); break;
            case ST_UPASS1: step_upass(F, 1, G); break;
            case ST_PRED0: step_peer_reduce(F, 0); break;
            case ST_PRED1: step_peer_reduce(F, 1); break;
            case ST_VPASS0: step_vpass(F, 0, G, rep + 1 < nrep); break;
            case ST_VPASS1: step_vpass(F, 1, G, rep + 1 < nrep); break;
#endif
#ifndef DIS_MISC
            case ST_CPREFIX: step_cprefix(F, (LAS unsigned char*)lds); convert_tables(F, 1, G > 160 ? CONV1_SPLIT : 0, 2 * NEXP, F.gw, F.ngw); break;
#endif
            default: break;
            }
        }
        if (rep + 1 < nrep) xcd_barrier(gbar, wave_s);
      }
        if (((SYNC_AFTER >> st) & 1u) && st + 1 < args.hi) xcd_barrier(gbar, wave_s);
    }
}

#ifndef N_LAUNCH_MODE
#define N_LAUNCH_MODE 1
#endif
extern "C" void kernel_launch(void* const* d_in, const int* in_sizes, int n_in, void* d_out, int out_size, void* d_ws, size_t ws_size, hipStream_t stream) {
    static int grid = 0;
    if (grid == 0) {
        if (n_in != N_IN || in_sizes[0] != T * DM || out_size != T * DM || ws_size < WS_END) {
            fprintf(stderr, "kernel_launch: unexpected shapes (n_in %d, in0 %d, out %d, ws %zu, need %zu)\n", n_in, n_in > 0 ? in_sizes[0] : -1, out_size, ws_size, (size_t)WS_END); grid = -1; return; }
        int dev = 0, cus = 0, per_cu = 0;
        hipGetDevice(&dev); hipDeviceGetAttribute(&cus, hipDeviceAttributeMultiprocessorCount, dev);
        hipFuncSetAttribute((const void*)yoco_fwd, hipFuncAttributeMaxDynamicSharedMemorySize, LDS_BYTES);
        hipOccupancyMaxActiveBlocksPerMultiprocessor(&per_cu, (const void*)yoco_fwd, NTHREADS, LDS_BYTES);
        if (per_cu < 1) { fprintf(stderr, "kernel_launch: occupancy query says %d blocks per CU\n", per_cu); grid = -1; return; }
        grid = cus - cus % 8;
        (void)hipGetLastError();
    }
    if (grid < 0) return;
    Args a{};
    for (int i = 0; i < N_IN; ++i) a.in[i] = (const float*)d_in[i];
    a.out = (float*)d_out; a.ws = (unsigned char*)d_ws;
    if (hipMemsetAsync((char*)d_ws + O_CTL, 0, 65536, stream) != hipSuccess) { fprintf(stderr, "kernel_launch: memset of the barrier words failed\n"); return; }
    if (N_LAUNCH_MODE == 1) {
        a.lo = 0; a.hi = N_STEPS;
        hipLaunchKernelGGL(yoco_fwd, dim3(grid), dim3(NTHREADS), LDS_BYTES, stream, a);
        hipError_t e = hipPeekAtLastError();
        if (e != hipSuccess) fprintf(stderr, "launch failed: %s (grid %d)\n", hipGetErrorString(e), grid);
    } else {
        int lo = 0;
        for (int s = 0; s < N_STEPS; ++s) {
            if (((SYNC_AFTER >> s) & 1u) || s == N_STEPS - 1) {
                a.lo = lo; a.hi = s + 1; lo = s + 1;
                void* params[] = {&a};
                hipError_t e = hipLaunchCooperativeKernel((const void*)yoco_fwd, dim3(grid), dim3(NTHREADS), params, LDS_BYTES, stream);
                if (e != hipSuccess) { fprintf(stderr, "launch failed: %s\n", hipGetErrorString(e)); break; }
            }
        }
    }
}
```

```cpp
#include <hip/hip_runtime.h>
#include <hip/hip_cooperative_groups.h>
#include <cstdio>
#include <cstdint>
namespace cg = cooperative_groups;

#define LAS __attribute__((address_space(3)))
#define GAS __attribute__((address_space(1)))
typedef unsigned short bf16_t;
typedef short bf16x8 __attribute__((ext_vector_type(8)));
typedef short s16x4 __attribute__((ext_vector_type(4)));
typedef float f32x4 __attribute__((ext_vector_type(4)));
typedef float f32x2 __attribute__((ext_vector_type(2)));
typedef float f32x16 __attribute__((ext_vector_type(16)));
typedef unsigned u32x4 __attribute__((ext_vector_type(4)));
typedef unsigned u32x2 __attribute__((ext_vector_type(2)));
typedef _Float16 h2 __attribute__((ext_vector_type(2)));

constexpr int NB = 4, SEQ = 4096, T = NB * SEQ, DM = 2048, LRU = 1536, MEMW = 512, NMEM = 256, NH = 12, HD = 128;
constexpr int NIN0 = 3584, NL1 = 5120, NEXP = 16384, NMROW = NB * NMEM;
constexpr float EPS = 1e-6f;
constexpr int NTHREADS = 512, NWAVES = 8;

constexpr size_t MiB = 1u << 20;
constexpr size_t O_CTL = 0;
constexpr size_t O_WIN0 = 1 * MiB;
constexpr size_t O_WOUT0 = O_WIN0 + 14 * MiB;
constexpr size_t O_WL1 = O_WOUT0 + 8 * MiB;
constexpr size_t O_WOUT1 = O_WL1 + 20 * MiB;
constexpr size_t O_WQ0 = O_WOUT1 + 8 * MiB;
constexpr size_t O_WQ1 = O_WQ0 + 8 * MiB;
constexpr size_t O_WMKV = O_WQ1 + 8 * MiB;
constexpr size_t O_WGATE = O_WMKV + 8 * MiB;
constexpr size_t O_SUBK = O_WGATE + 1 * MiB;
constexpr size_t O_WF = O_SUBK + 1 * MiB;
constexpr size_t O_SMALL = O_WF + 1 * MiB;
constexpr size_t O_RS1 = O_SMALL;
constexpr size_t O_LOGF = O_SMALL + 64 * 1024;
constexpr size_t O_CC = O_LOGF + 768 * 1024;
constexpr size_t O_GG = O_CC + 768 * 1024;
constexpr size_t O_SPL = O_GG + 4096;
constexpr size_t O_TSC = O_SPL + 8192;
constexpr size_t O_ROWSS = O_SMALL + 2 * MiB;
constexpr size_t O_RSP = O_ROWSS + 2 * MiB;
constexpr size_t O_QMSS = O_RSP;
constexpr size_t O_MKSS = O_QMSS + 1 * MiB;
constexpr size_t O_SSL1 = O_MKSS + 1 * MiB;
constexpr size_t O_CARRY = O_SSL1 + 7 * MiB;
constexpr size_t O_MEMN = O_CARRY + 3 * MiB;
constexpr size_t O_MKV = O_MEMN + 8 * MiB;
constexpr size_t O_IDX = O_MKV + 20 * MiB;
constexpr size_t O_GW = O_IDX + 8 * MiB;
constexpr size_t O_TAB = O_GW + 8 * MiB;
constexpr size_t TAB_NIB = (size_t)8 * 16384 * 128, TAB_ONE = TAB_NIB + (size_t)16384 * 16 + 786432;
constexpr size_t O_XS16 = O_TAB + 128 * MiB;
constexpr size_t O_CAT = O_XS16 + 64 * MiB;
constexpr size_t O_ZX = O_CAT + 64 * MiB;
constexpr size_t O_X8 = O_ZX;
constexpr size_t O_GY = O_ZX + 48 * MiB;
constexpr size_t O_LOGFP = O_GY + 48 * MiB;
constexpr size_t O_QM = O_LOGFP;
constexpr size_t O_XC = O_QM + 16 * MiB;
constexpr size_t O_X4 = O_XC;
constexpr size_t O_SX = O_XC + 32 * MiB;
constexpr size_t O_AA = O_XC + 48 * MiB;
constexpr size_t O_PART = O_AA;
constexpr size_t O_UU = O_AA + 96 * MiB;
constexpr size_t O_PK = O_UU;
constexpr size_t O_Q16 = O_UU + 96 * MiB;
constexpr size_t O_ZL1 = O_Q16 + 64 * MiB;
constexpr size_t WS_END = O_ZL1 + 160 * MiB;
static_assert(WS_END <= 1024 * MiB, "workspace map");

__device__ __forceinline__ unsigned cvtpk(float lo, float hi) { unsigned r; asm volatile("v_cvt_pk_bf16_f32 %0, %1, %2" : "=v"(r) : "v"(lo), "v"(hi)); return r; }
__device__ __forceinline__ float bf_lo(unsigned w) { return __uint_as_float(w << 16); }
__device__ __forceinline__ float bf_hi(unsigned w) { return __uint_as_float(w & 0xffff0000u); }
__device__ __forceinline__ float fast_exp(float x) { return __builtin_amdgcn_exp2f(x * 1.4426950408889634f); }
__device__ __forceinline__ float log1p_pos(float y) { const float ser = y * (1.f - y * (0.5f - y * (0.33333334f - 0.25f * y))); const float lg = __builtin_amdgcn_logf(1.f + y) * 0.6931471805599453f; return y < 0.03f ? ser : lg; }
__device__ __forceinline__ float one_minus_exp(float x) { const float ser = -x * (1.f + x * (0.5f + x * (0.16666667f + x * 0.041666668f))); const float big = 1.f - fast_exp(x); return x > -0.03f ? ser : big; }
__device__ __forceinline__ float sigmoidf_(float x) { return __builtin_amdgcn_rcpf(1.f + fast_exp(-x)); }
__device__ __forceinline__ float gelu_tanh(float x) { const float u = x * (1.f + 0.044715f * x * x); return x * __builtin_amdgcn_rcpf(1.f + __builtin_amdgcn_exp2f(u * (-2.f * 0.7978845608028654f * 1.4426950408889634f))); }
template <int CTRL> __device__ __forceinline__ float dppf(float v) { return __int_as_float(__builtin_amdgcn_update_dpp(0, __float_as_int(v), CTRL, 0xF, 0xF, true)); }
__device__ __forceinline__ float xsum16(float v) { auto r = __builtin_amdgcn_permlane16_swap(__float_as_uint(v), __float_as_uint(v), false, false); return __uint_as_float(r[0]) + __uint_as_float(r[1]); }
__device__ __forceinline__ float xsum32(float v) { auto r = __builtin_amdgcn_permlane32_swap(__float_as_uint(v), __float_as_uint(v), false, false); return __uint_as_float(r[0]) + __uint_as_float(r[1]); }
__device__ __forceinline__ float xmax16(float v) { auto r = __builtin_amdgcn_permlane16_swap(__float_as_uint(v), __float_as_uint(v), false, false); return fmaxf(__uint_as_float(r[0]), __uint_as_float(r[1])); }
__device__ __forceinline__ float xmax32(float v) { auto r = __builtin_amdgcn_permlane32_swap(__float_as_uint(v), __float_as_uint(v), false, false); return fmaxf(__uint_as_float(r[0]), __uint_as_float(r[1])); }
__device__ __forceinline__ float wave_sum(float v) {
    v += dppf<0xB1>(v); v += dppf<0x4E>(v); v += dppf<0x141>(v); v += dppf<0x140>(v);
    v = xsum16(v); v = xsum32(v); return v;
}
__device__ __forceinline__ float wave_max(float v) {
    v = fmaxf(v, dppf<0xB1>(v)); v = fmaxf(v, dppf<0x4E>(v)); v = fmaxf(v, dppf<0x141>(v)); v = fmaxf(v, dppf<0x140>(v));
    v = xmax16(v); v = xmax32(v); return v;
}

namespace pg8 {
constexpr int BM = 256, BK = 64, HALF = 128, HTB = HALF * BK * 2, STAGE_BYTES = 8 * HTB, NXCD = 8, WGM = 8;
__host__ __device__ __forceinline__ int lds_byte(int r, int c) { const int st = (r >> 4) * 2 + (c >> 5), rr = r & 15, cc = c & 31, ob = rr * 64 + cc * 2; return st * 1024 + (ob ^ (((ob >> 9) & 1) << 5)); }
__host__ __device__ __forceinline__ void stage_rc(int b, int& R, int& C) { const int st = b / 1024, sb = b % 1024, swz = sb ^ (((sb >> 9) & 1) << 5); R = (st >> 1) * 16 + swz / 64; C = (st & 1) * 32 + (swz % 64) / 2; }
__host__ __device__ __forceinline__ int perm32(int rho) { const int n = rho >> 4, i = rho & 15; return 8 * (i >> 2) + 4 * n + (i & 3); }

struct Unit { int pm, pn; };
struct Gemm { const GAS bf16_t* A; const GAS bf16_t* Bt; int M, N, K, lda, ldb, acol; };

struct StaticOrder {
    int nM, nN, nwg, G, c;
    __device__ void init(int M, int N, int G_, int c_) { nM = M / BM; nN = N / BM; nwg = nM * nN; G = G_; c = c_; }
    __device__ bool next(int i, Unit& u) const {
        const long L = (long)i * G + c; if (L >= nwg) return false;
        int wgid = (int)L; { const int q = nwg / NXCD, r = nwg % NXCD, xcd = wgid % NXCD, off = wgid / NXCD; wgid = (xcd < r ? xcd * (q + 1) : r * (q + 1) + (xcd - r) * q) + off; }
        const int nig = WGM * nN, gid = wgid / nig, fm = gid * WGM, gsz = (nM - fm) < WGM ? (nM - fm) : WGM;
        u.pm = fm + ((wgid % nig) % gsz); u.pn = (wgid % nig) / gsz; return true;
    }
};

typedef int v8i_t __attribute__((ext_vector_type(8)));
typedef int v4i_t __attribute__((ext_vector_type(4)));
template <class Epi, bool FP8>
__device__ __forceinline__ void gemm_phase(LAS unsigned char* lds, const Gemm g, const StaticOrder& S, const Epi& E, const int tid) {
    const int wid = __builtin_amdgcn_readfirstlane(tid >> 6), lane = tid & 63, wr = wid >> 2, wc = wid & 3, fr = lane & 15, fq = lane >> 4;
    const int K = g.K, nt = K / BK;
    unsigned voffA[2], voffB[2];
#pragma unroll
    for (int i = 0; i < 2; ++i) { int R, C; stage_rc(tid * 16 + i * 8192, R, C); const int Rb = (R & ~31) + perm32(R & 31);
        voffA[i] = (unsigned)(R * g.lda + C) * 2u; voffB[i] = (unsigned)(Rb * g.ldb + C) * 2u; }
    const size_t kstep = (size_t)(BK * 2);
    const size_t hstepA = (size_t)HALF * g.lda * 2, hstepB = (size_t)HALF * g.ldb * 2;
    const size_t tstepA = 2 * hstepA, tstepB = 2 * hstepB;
    const unsigned ldsw = (unsigned)wid * 1024u;
    const int aoff = lds_byte(wr * 64 + fr, fq * 8), boff = lds_byte(wc * 32 + fr, fq * 8);
#define PG8_SA(b, h) (((b) * 2 + (h)) * HTB)
#define PG8_SB(b, h) ((4 + (b) * 2 + (h)) * HTB)
#define PG8_STAGE(bufoff, gbase, voff) do { _Pragma("unroll") for (int _i = 0; _i < 2; ++_i) \
        __builtin_amdgcn_global_load_lds((const GAS unsigned*)((gbase) + (voff)[_i]), (LAS unsigned*)(lds + (bufoff) + ldsw + _i * 8192), 16, 0, 0); } while (0)
#define PG8_LD2(dst, off_) do { const u32x4 lo_ = *(const LAS u32x4*)(lds + (off_)), hi_ = *(const LAS u32x4*)(lds + (off_) + 1024); \
        dst = (v8i_t){(int)lo_.x, (int)lo_.y, (int)lo_.z, (int)lo_.w, (int)hi_.x, (int)hi_.y, (int)hi_.z, (int)hi_.w}; } while (0)
#define PG8_LDA(dst, b, h) do { _Pragma("unroll") for (int m = 0; m < 4; ++m) PG8_LD2(dst[m], PG8_SA(b, h) + aoff + m * 2048); } while (0)
#define PG8_LDB(dst, b, h) do { _Pragma("unroll") for (int n = 0; n < 2; ++n) PG8_LD2(dst[n], PG8_SB(b, h) + boff + n * 2048); } while (0)
#define PG8_HALF(v, k) ((k) ? __builtin_shufflevector(v, v, 4, 5, 6, 7) : __builtin_shufflevector(v, v, 0, 1, 2, 3))
#define PG8_MMA(ai, bj, At, Bt) do { __builtin_amdgcn_s_setprio(1); _Pragma("unroll") for (int m = 0; m < 4; ++m) _Pragma("unroll") for (int n = 0; n < 2; ++n) { \
        if constexpr (FP8) asm volatile("v_mfma_scale_f32_16x16x128_f8f6f4 %0, %1, %2, %0, %3, %4 op_sel_hi:[0,0,0]" : "+v"(acc[ai][bj][m][n]) : "v"(Bt[n]), "v"(At[m]), "v"(sc_w), "v"(sc_x));     \
        else { _Pragma("unroll") for (int k = 0; k < 2; ++k) { const v4i_t bh_ = PG8_HALF(Bt[n], k), ah_ = PG8_HALF(At[m], k); \
                acc[ai][bj][m][n] = __builtin_amdgcn_mfma_f32_16x16x32_bf16(__builtin_bit_cast(bf16x8, bh_), __builtin_bit_cast(bf16x8, ah_), acc[ai][bj][m][n], 0, 0, 0); } } } \
        __builtin_amdgcn_s_setprio(0); } while (0)
#define PG8_WAIT_V(n) asm volatile("s_waitcnt vmcnt(" #n ")" ::: "memory")
#define PG8_WAIT_L(n) asm volatile("s_waitcnt lgkmcnt(" #n ")" ::: "memory")
#define PG8_BAR __builtin_amdgcn_s_barrier()
#define PG8_SCHED __builtin_amdgcn_sched_barrier(0)
    Unit cur, nxt; int ui = 0;
    if (!S.next(0, cur)) return;
    f32x4 acc[2][2][4][2];
#pragma unroll
    for (int a = 0; a < 2; ++a)
#pragma unroll
        for (int b = 0; b < 2; ++b)
#pragma unroll
            for (int m = 0; m < 4; ++m)
#pragma unroll
                for (int n = 0; n < 2; ++n) acc[a][b][m][n] = (f32x4){0.f, 0.f, 0.f, 0.f};
    v8i_t At[4], B0[2], B1[2];
    const int sc_w = 121, sc_x = 127;
    const GAS char* cA = (const GAS char*)g.A + (size_t)cur.pm * tstepA + (size_t)cur.pn * g.acol * 2; const GAS char* cB = (const GAS char*)g.Bt + (size_t)cur.pn * tstepB;
    PG8_STAGE(PG8_SB(0, 0), cB, voffB); PG8_STAGE(PG8_SB(0, 1), cB + hstepB, voffB); PG8_STAGE(PG8_SA(0, 0), cA, voffA); PG8_STAGE(PG8_SA(0, 1), cA + hstepA, voffA);
    if (wr == 1) PG8_BAR;
    PG8_WAIT_V(2); PG8_BAR;
    PG8_STAGE(PG8_SB(1, 0), cB + kstep, voffB); PG8_STAGE(PG8_SA(1, 0), cA + kstep, voffA); PG8_STAGE(PG8_SB(1, 1), cB + hstepB + kstep, voffB);
    PG8_WAIT_V(6); PG8_BAR;
    for (;;) {
        const bool has_next = S.next(ui + 1, nxt);
        const GAS char* nA = has_next ? (const GAS char*)g.A + (size_t)nxt.pm * tstepA + (size_t)nxt.pn * g.acol * 2 : cA; const GAS char* nB = has_next ? (const GAS char*)g.Bt + (size_t)nxt.pn * tstepB : cB;
        for (int t = 0; t < nt; t += 2) {
            const bool last = (t == nt - 2);
            const GAS char* a1 = cA + (size_t)(t + 1) * kstep;
            const GAS char* a2 = last ? nA : cA + (size_t)(t + 2) * kstep; const GAS char* b2 = last ? nB : cB + (size_t)(t + 2) * kstep;
            const GAS char* a3 = a2 + kstep; const GAS char* b3 = b2 + kstep;
            PG8_LDB(B0, 0, 0); PG8_LDB(B1, 0, 1); PG8_SCHED; PG8_LDA(At, 0, 0); PG8_STAGE(PG8_SA(1, 1), a1 + hstepA, voffA);
            PG8_WAIT_V(8); PG8_WAIT_L(0); PG8_BAR; PG8_MMA(0, 0, At, B0); PG8_MMA(0, 1, At, B1); PG8_BAR; PG8_SCHED;
            PG8_LDA(At, 0, 1); PG8_STAGE(PG8_SB(0, 0), b2, voffB); PG8_STAGE(PG8_SB(0, 1), b2 + hstepB, voffB); PG8_STAGE(PG8_SA(0, 0), a2, voffA);
            PG8_WAIT_V(8); PG8_WAIT_L(0); PG8_BAR; PG8_MMA(1, 0, At, B0); PG8_MMA(1, 1, At, B1); PG8_BAR; PG8_SCHED;
            PG8_LDB(B0, 1, 0); PG8_LDB(B1, 1, 1); PG8_SCHED; PG8_LDA(At, 1, 0); PG8_STAGE(PG8_SA(0, 1), a2 + hstepA, voffA);
            PG8_WAIT_V(8); PG8_WAIT_L(0); PG8_BAR; PG8_MMA(0, 0, At, B0); PG8_MMA(0, 1, At, B1); PG8_BAR; PG8_SCHED;
            PG8_LDA(At, 1, 1); PG8_STAGE(PG8_SB(1, 0), b3, voffB); PG8_STAGE(PG8_SB(1, 1), b3 + hstepB, voffB); PG8_STAGE(PG8_SA(1, 0), a3, voffA);
            PG8_WAIT_V(8); PG8_WAIT_L(0); PG8_BAR; PG8_MMA(1, 0, At, B0); PG8_MMA(1, 1, At, B1); PG8_BAR; PG8_SCHED;
        }
        if (wr == 0) PG8_BAR;
        { int ln_; asm volatile("v_mbcnt_lo_u32_b32 %0, -1, 0\n\tv_mbcnt_hi_u32_b32 %0, -1, %0" : "=v"(ln_));
          E(acc, cur, wr, wc, ln_ & 15, ln_ >> 4); }
        if (!has_next) break;
#pragma unroll
        for (int a = 0; a < 2; ++a)
#pragma unroll
            for (int b = 0; b < 2; ++b)
#pragma unroll
                for (int m = 0; m < 4; ++m)
#pragma unroll
                    for (int n = 0; n < 2; ++n) acc[a][b][m][n] = (f32x4){0.f, 0.f, 0.f, 0.f};
        cur = nxt; cA = nA; cB = nB; ++ui;
        if (wr == 1) PG8_BAR;
    }
    PG8_WAIT_V(0);
    PG8_BAR;
#undef PG8_SA
#undef PG8_SB
#undef PG8_STAGE
#undef PG8_LDA
#undef PG8_LDB
#undef PG8_LD2
#undef PG8_HALF
#undef PG8_MMA
#undef PG8_WAIT_V
#undef PG8_WAIT_L
#undef PG8_BAR
#undef PG8_SCHED
}
}

enum { EM_IN0 = 0, EM_MKV = 1, EM_GATE = 2, EM_RES = 3, EM_PQ = 4, EM_L1 = 5 };
struct Epi {
    int mode;
    GAS unsigned char* ws;
    const GAS float* resid;
    GAS float* outf;
    GAS bf16_t* o16;
    GAS float* ssq;
    const GAS float* gate_b;
    typedef pg8::Unit Unit;
    __device__ __forceinline__ static void st8(GAS bf16_t* p, f32x4 v0, f32x4 v1) {
        u32x4 w; w.x = cvtpk(v0[0], v0[1]); w.y = cvtpk(v0[2], v0[3]); w.z = cvtpk(v1[0], v1[1]); w.w = cvtpk(v1[2], v1[3]); *(GAS u32x4*)p = w; }
    __device__ __forceinline__ static float sq8(f32x4 a, f32x4 b) { return (a[0] * a[0] + a[1] * a[1]) + (a[2] * a[2] + a[3] * a[3]) + (b[0] * b[0] + b[1] * b[1]) + (b[2] * b[2] + b[3] * b[3]); }
    __device__ __forceinline__ void operator()(f32x4 (&acc)[2][2][4][2], const Unit& u, int wr, int wc, int fr, int fq) const {
        const int row0 = u.pm * 256 + wr * 64 + fr;
        const int cin = wc * 32 + 8 * fq;
        if (mode == EM_IN0) {
            GAS bf16_t* base; int ld, colt; int kind;
            if (u.pn < 6) { base = (GAS bf16_t*)(ws + O_ZX); ld = LRU; colt = u.pn * 256; kind = 0; }
            else if (u.pn < 12) { base = (GAS bf16_t*)(ws + O_GY); ld = LRU; colt = (u.pn - 6) * 256; kind = 1; }
            else { base = (GAS bf16_t*)(ws + O_ZL1); ld = NL1; colt = 4608 + (u.pn - 12) * 256; kind = 2; }
            GAS float* qmss = (GAS float*)(ws + O_SSL1);
#pragma unroll
            for (int ai = 0; ai < 2; ++ai)
#pragma unroll
                for (int m = 0; m < 4; ++m) { const int row = row0 + ai * 128 + m * 16;
#pragma unroll
                    for (int bj = 0; bj < 2; ++bj) { f32x4 v0 = acc[ai][bj][m][0], v1 = acc[ai][bj][m][1];
                        if (kind == 1) {
#pragma unroll
                            for (int j = 0; j < 4; ++j) { v0[j] = gelu_tanh(v0[j]); v1[j] = gelu_tanh(v1[j]); } }
                        st8(base + (size_t)row * ld + colt + bj * 128 + cin, v0, v1);
                        if (kind == 2) { float s = sq8(v0, v1); s = xsum16(s); s = xsum32(s);
                            if (fq == 0) qmss[(size_t)row * 112 + (24 + (u.pn - 12) * 2 + bj) * 4 + wc] = s; } } }
        } else if (mode == EM_MKV) {
#pragma unroll
            for (int ai = 0; ai < 2; ++ai)
#pragma unroll
                for (int m = 0; m < 4; ++m) { const int row = row0 + ai * 128 + m * 16;
#pragma unroll
                    for (int bj = 0; bj < 2; ++bj) { const f32x4 v0 = acc[ai][bj][m][0], v1 = acc[ai][bj][m][1];
                        st8(o16 + (size_t)row * NL1 + u.pn * 256 + bj * 128 + cin, v0, v1);
                        if (u.pn < 2) { float s = sq8(v0, v1); s = xsum16(s); s = xsum32(s);
                            if (fq == 0) ssq[(size_t)row * 112 + (u.pn * 2 + bj) * 4 + wc] = s; } } }
        } else if (mode == EM_GATE) {
            const int ch = u.pn * 128 + cin;
            const GAS bf16_t* xc = (const GAS bf16_t*)(ws + O_XC); GAS _Float16* LA = (GAS _Float16*)(ws + O_AA); GAS _Float16* UH = (GAS _Float16*)(ws + O_UU);
            const GAS float* spl = (const GAS float*)(ws + O_SPL) + ch; const GAS float* gb = gate_b + u.pn * 256 + cin;
#pragma unroll
            for (int n = 0; n < 2; ++n) {
                const f32x4 sp = *(const GAS f32x4*)(spl + 4 * n), br = *(const GAS f32x4*)(gb + 4 * n), bi = *(const GAS f32x4*)(gb + 128 + 4 * n);
#pragma unroll
                for (int ai = 0; ai < 2; ++ai)
#pragma unroll
                    for (int m = 0; m < 4; ++m) { const int row = row0 + ai * 128 + m * 16;
                        const u32x2 xw = *(const GAS u32x2*)(xc + (size_t)row * LRU + ch + 4 * n);
                        const f32x4 xv = {bf_lo(xw.x), bf_hi(xw.x), bf_lo(xw.y), bf_hi(xw.y)};
                        float lav[4], uvv[4];
#pragma unroll
                        for (int j = 0; j < 4; ++j) { const float r = sigmoidf_(acc[ai][0][m][n][j] + br[j]), ig = sigmoidf_(acc[ai][1][m][n][j] + bi[j]);
                            const float la = -8.f * r * sp[j];
                            lav[j] = la; uvv[j] = __builtin_amdgcn_sqrtf(one_minus_exp(2.f * la)) * (ig * xv[j]); }
                        { const h2 l0 = {(_Float16)lav[0], (_Float16)lav[1]}, l1 = {(_Float16)lav[2], (_Float16)lav[3]}, u0 = {(_Float16)uvv[0], (_Float16)uvv[1]}, u1 = {(_Float16)uvv[2], (_Float16)uvv[3]};
                          *(GAS u32x2*)(LA + (size_t)row * LRU + ch + 4 * n) = (u32x2){__builtin_bit_cast(unsigned, l0), __builtin_bit_cast(unsigned, l1)};
                          *(GAS u32x2*)(UH + (size_t)row * LRU + ch + 4 * n) = (u32x2){__builtin_bit_cast(unsigned, u0), __builtin_bit_cast(unsigned, u1)}; } }
            }
        } else if (mode == EM_RES) {
            GAS bf16_t* xs = (GAS bf16_t*)(ws + O_XS16); GAS float* rowss = (GAS float*)(ws + O_ROWSS);
#pragma unroll
            for (int ai = 0; ai < 2; ++ai)
#pragma unroll
                for (int m = 0; m < 4; ++m) { const int row = row0 + ai * 128 + m * 16; float s = 0.f;
#pragma unroll
                    for (int bj = 0; bj < 2; ++bj) { const size_t off = (size_t)row * DM + u.pn * 256 + bj * 128 + cin;
                        const f32x4 r0 = *(const GAS f32x4*)(resid + off), r1 = *(const GAS f32x4*)(resid + off + 4);
                        const f32x4 v0 = acc[ai][bj][m][0] + r0, v1 = acc[ai][bj][m][1] + r1;
                        *(GAS f32x4*)(outf + off) = v0; *(GAS f32x4*)(outf + off + 4) = v1;
                        st8(xs + off, v0, v1); s += sq8(v0, v1); }
                    s = xsum16(s); s = xsum32(s);
                    if (fq == 0) rowss[(size_t)row * 32 + u.pn * 4 + wc] = s; }
        } else if (mode == EM_PQ) {
            const GAS float* rowss = (const GAS float*)(ws + O_ROWSS);
#pragma unroll
            for (int ai = 0; ai < 2; ++ai)
#pragma unroll
                for (int m = 0; m < 4; ++m) { const int row = row0 + ai * 128 + m * 16;
                    const f32x4 p0 = *(const GAS f32x4*)(rowss + (size_t)row * 32 + fq * 8), p1 = *(const GAS f32x4*)(rowss + (size_t)row * 32 + fq * 8 + 4);
                    float s = (p0[0] + p0[1]) + (p0[2] + p0[3]) + (p1[0] + p1[1]) + (p1[2] + p1[3]); s = xsum16(s); s = xsum32(s);
                    const float r = rsqrtf(s * (1.f / DM) + EPS);
#pragma unroll
                    for (int bj = 0; bj < 2; ++bj) st8(o16 + (size_t)row * DM + u.pn * 256 + bj * 128 + cin, acc[ai][bj][m][0] * r, acc[ai][bj][m][1] * r); }
        } else {
            const GAS float* rsp = (const GAS float*)(ws + O_RSP); GAS bf16_t* zl1 = (GAS bf16_t*)(ws + O_ZL1); GAS float* ssl1 = (GAS float*)(ws + O_SSL1);
            const int slot0 = u.pn < 6 ? u.pn * 2 : (u.pn >= 12 ? 12 + (u.pn - 12) * 2 : -1);
#pragma unroll
            for (int ai = 0; ai < 2; ++ai)
#pragma unroll
                for (int m = 0; m < 4; ++m) { const int row = row0 + ai * 128 + m * 16;
                    const f32x4 q0 = *(const GAS f32x4*)(rsp + (size_t)row * 8), q1 = *(const GAS f32x4*)(rsp + (size_t)row * 8 + 4);
                    const float r = rsqrtf(((q0[0] + q0[1]) + (q0[2] + q0[3]) + (q1[0] + q1[1]) + (q1[2] + q1[3])) * (1.f / DM) + EPS);
#pragma unroll
                    for (int bj = 0; bj < 2; ++bj) { const f32x4 v0 = acc[ai][bj][m][0] * r, v1 = acc[ai][bj][m][1] * r;
                        st8(zl1 + (size_t)row * NL1 + u.pn * 256 + bj * 128 + cin, v0, v1);
                        if (slot0 >= 0) { float s = sq8(v0, v1); s = xsum16(s); s = xsum32(s);
                            if (fq == 0) ssl1[(size_t)row * 112 + (slot0 + bj) * 4 + wc] = s; } } }
        }
    }
};

namespace att {
constexpr float SCALE = 0.08838834764831845f;
constexpr int NW = 8, QBLK = 32, KVBLK = 64, QB = NW * QBLK, D = 128;
constexpr int SHM_V = KVBLK * D * 2, SHM_K = KVBLK * D * 2;
constexpr int OFF_WS = 2 * SHM_V + 2 * SHM_K;
constexpr int OFF_KS = OFF_WS + 2048;
constexpr int OFF_BS = OFF_KS + 16384;
constexpr int LDS_END = OFF_BS + 16384;
constexpr int WBIG = 1 << 28;

#define KSWZ(row, colB) ((row) * 256 + ((colB) ^ (((row) & 7) << 4)))
#define SBAR() __builtin_amdgcn_sched_barrier(0)
__device__ __forceinline__ int v_st(int k, int c) { const int kk = (k & ~0xC) | ((k & 4) << 1) | ((k & 8) >> 1); return ((kk >> 3) * 4 + (c >> 5)) * 512 + ((kk & 7) * 32 + (c & 31)) * 2; }
__device__ __forceinline__ int v_rd_base(int lane) { return ((lane & 3) << 3) | (((lane >> 2) & 3) << 6) | (((lane >> 4) & 1) << 5) | (((lane >> 5) & 1) << 8); }
constexpr int v_rd_off(int d0, int ks, int half) { return d0 * 512 + ks * 4096 + half * 2048; }
__device__ __forceinline__ int crow(int r, int hi) { return (r & 3) + 8 * (r >> 2) + 4 * hi; }
__device__ __forceinline__ bf16x8 load8(const GAS bf16_t* p) { return *(const GAS bf16x8*)p; }
__device__ __forceinline__ bf16x8 scale8(bf16x8 v, float s) { const u32x4 w = *reinterpret_cast<u32x4*>(&v); u32x4 o;
    o.x = cvtpk(bf_lo(w.x) * s, bf_hi(w.x) * s); o.y = cvtpk(bf_lo(w.y) * s, bf_hi(w.y) * s); o.z = cvtpk(bf_lo(w.z) * s, bf_hi(w.z) * s); o.w = cvtpk(bf_lo(w.w) * s, bf_hi(w.w) * s);
    return *reinterpret_cast<bf16x8*>(&o); }
__device__ __forceinline__ void mask_tile(f32x16& p0, f32x16& p1, int dq, unsigned W) {
    const float NEG = -__builtin_inff();
#pragma unroll
    for (int r = 0; r < 16; ++r) {
        const int c = (r & 3) + 8 * (r >> 2);
        if ((unsigned)(dq - c) >= W) p0[r] = NEG;
        if ((unsigned)(dq - c - 32) >= W) p1[r] = NEG;
    }
}
constexpr float THR = 8.f;
__device__ __forceinline__ void partialSM(f32x16& p0, f32x16& p1, float& m_reg, float& mn, float& alpha) {
    float pmax = p0[0]; for (int r = 1; r < 16; ++r) pmax = fmaxf(pmax, p0[r]); for (int r = 0; r < 16; ++r) pmax = fmaxf(pmax, p1[r]);
    { auto rr = __builtin_amdgcn_permlane32_swap(__float_as_uint(pmax), __float_as_uint(pmax), false, false);
      pmax = fmaxf(__uint_as_float(rr[0]), __uint_as_float(rr[1])); }
    constexpr float C2 = 1.4426950408889634f * SCALE;
    if (__builtin_expect(__all((pmax - m_reg) * SCALE <= THR), 1)) { mn = m_reg; alpha = 1.f; }
    else { mn = fmaxf(m_reg, pmax); alpha = __builtin_amdgcn_exp2f((m_reg - mn) * C2); m_reg = mn; }
    const float mnL = -mn * C2;
    for (int r = 0; r < 16; ++r) p0[r] = fmaf(p0[r], C2, mnL); for (int r = 0; r < 16; ++r) p1[r] = fmaf(p1[r], C2, mnL);
    for (int r = 0; r < 16; ++r) p0[r] = __builtin_amdgcn_exp2f(p0[r]);
}
__device__ __forceinline__ void finishSM(f32x16& p0, f32x16& p1, float alpha, float& l_reg, bf16x8& pa0, bf16x8& pa1, bf16x8& pa2, bf16x8& pa3) {
    for (int r = 0; r < 16; ++r) p1[r] = __builtin_amdgcn_exp2f(p1[r]);
    float ps = 0; for (int r = 0; r < 16; ++r) ps += p0[r]; for (int r = 0; r < 16; ++r) ps += p1[r];
    { auto rr = __builtin_amdgcn_permlane32_swap(__float_as_uint(ps), __float_as_uint(ps), false, false);
      ps = __uint_as_float(rr[0]) + __uint_as_float(rr[1]); }
    l_reg = l_reg * alpha + ps;
#define PK4(P, B_, OUT) do { unsigned a0 = cvtpk(P[B_+0], P[B_+1]), a1 = cvtpk(P[B_+2], P[B_+3]);                          \
        unsigned b0 = cvtpk(P[B_+4], P[B_+5]), b1 = cvtpk(P[B_+6], P[B_+7]);                                             \
        auto r0 = __builtin_amdgcn_permlane32_swap(a0, b0, false, false); auto r1 = __builtin_amdgcn_permlane32_swap(a1, b1, false, false); \
        u32x4 w = {r0[0], r1[0], r0[1], r1[1]}; OUT = *reinterpret_cast<bf16x8*>(&w); } while (0)
    PK4(p0, 0, pa0); PK4(p0, 8, pa1); PK4(p1, 0, pa2); PK4(p1, 8, pa3);
#undef PK4
}
template <int KB>
__device__ __forceinline__ void qkt(f32x16& p0, f32x16& p1, const char* K_lds, int r32, int hi, const bf16x8* qr, const float* bp  ) {
    { const f32x4 a = *(const f32x4*)(bp), b = *(const f32x4*)(bp + 8), c = *(const f32x4*)(bp + 16), d = *(const f32x4*)(bp + 24);
      p0 = (f32x16){a[0], a[1], a[2], a[3], b[0], b[1], b[2], b[3], c[0], c[1], c[2], c[3], d[0], d[1], d[2], d[3]}; }
    { const f32x4 a = *(const f32x4*)(bp + 32), b = *(const f32x4*)(bp + 40), c = *(const f32x4*)(bp + 48), d = *(const f32x4*)(bp + 56);
      p1 = (f32x16){a[0], a[1], a[2], a[3], b[0], b[1], b[2], b[3], c[0], c[1], c[2], c[3], d[0], d[1], d[2], d[3]}; }
    const char* kb[4];
#pragma unroll
    for (int dd = 0; dd < 4; ++dd) kb[dd] = K_lds + KB * SHM_K + KSWZ(r32, (dd * 16 + hi * 8) * 2);
#pragma unroll
    for (int d0 = 0; d0 < 8; ++d0) { const char* a = kb[d0 & 3] + (d0 >> 2) * 128;
        bf16x8 b0 = *reinterpret_cast<const bf16x8*>(a);
        bf16x8 b1 = *reinterpret_cast<const bf16x8*>(a + 32 * 256);
        p0 = __builtin_amdgcn_mfma_f32_32x32x16_bf16(b0, qr[d0], p0, 0, 0, 0);
        p1 = __builtin_amdgcn_mfma_f32_32x32x16_bf16(b1, qr[d0], p1, 0, 0, 0); }
}
template <int VB>
__device__ __forceinline__ void pv_tile(f32x16* o, int vb0, bf16x8 pa0, bf16x8 pa1, bf16x8 pa2, bf16x8 pa3) {
#define TRRD(dst, off) asm volatile("ds_read_b64_tr_b16 %0, %1 offset:%2" : "=&v"(dst) : "v"(vb0), "i"(off) : "memory")
#define PV_D0(d0) do { s16x4 l0, l1, l2, l3, h0, h1, h2_, h3; constexpr int b_ = VB * SHM_V + v_rd_off(d0, 0, 0); \
        TRRD(l0, b_); TRRD(h0, b_ + 2048); TRRD(l1, b_ + 4096); TRRD(h1, b_ + 6144); TRRD(l2, b_ + 8192); TRRD(h2_, b_ + 10240); TRRD(l3, b_ + 12288); TRRD(h3, b_ + 14336); \
        asm volatile("s_waitcnt lgkmcnt(0)" ::: "memory"); SBAR();   \
        o[d0] = __builtin_amdgcn_mfma_f32_32x32x16_bf16(pa0, (bf16x8){l0[0], l0[1], l0[2], l0[3], h0[0], h0[1], h0[2], h0[3]}, o[d0], 0, 0, 0);   \
        o[d0] = __builtin_amdgcn_mfma_f32_32x32x16_bf16(pa1, (bf16x8){l1[0], l1[1], l1[2], l1[3], h1[0], h1[1], h1[2], h1[3]}, o[d0], 0, 0, 0);   \
        o[d0] = __builtin_amdgcn_mfma_f32_32x32x16_bf16(pa2, (bf16x8){l2[0], l2[1], l2[2], l2[3], h2_[0], h2_[1], h2_[2], h2_[3]}, o[d0], 0, 0, 0);   \
        o[d0] = __builtin_amdgcn_mfma_f32_32x32x16_bf16(pa3, (bf16x8){l3[0], l3[1], l3[2], l3[3], h3[0], h3[1], h3[2], h3[3]}, o[d0], 0, 0, 0); } while (0)
    PV_D0(0); PV_D0(1); PV_D0(2); PV_D0(3);
#undef PV_D0
#undef TRRD
}

struct BlockRef { const GAS bf16_t* Q; const GAS bf16_t* K; const GAS bf16_t* V; GAS bf16_t* O; const GAS float* qss; const GAS float* kss; const GAS float* cc; const GAS float* gg;
                  int P0, skv; };
constexpr int LDQ = 5120, LDK = 5120, LDO = 2048, LDSS = 112;
struct Seam { bf16x8 qr[8]; bf16x8 st_v0, st_v1, st_k0, st_k1; int jlo; };
#define ROWK(p, k0, rr) ((p) + (size_t)((k0) + (rr)) * LDK + sc)
#define VMW() asm volatile("s_waitcnt vmcnt(0)" ::: "memory")
#define VMWN(n) asm volatile("s_waitcnt vmcnt(%0)" :: "i"(n) : "memory")
#define SLOAD_H(Kp, Vp, k0) do { S.st_v0 = load8(ROWK(Vp, k0, sr)); S.st_v1 = load8(ROWK(Vp, k0, 32 + sr));              \
                         S.st_k0 = load8(ROWK(Kp, k0, sr)); S.st_k1 = load8(ROWK(Kp, k0, 32 + sr)); } while (0)
#define SWRITE_HK(bf, k0) do { *(bf16x8*)(K_lds + (bf) * SHM_K + kws) = scale8(S.st_k0, ksr[(k0)]); *(bf16x8*)(K_lds + (bf) * SHM_K + kws + 32 * 256) = scale8(S.st_k1, ksr[(k0) + 32]); } while (0)
#define SWRITE_HV(bf) do { *(bf16x8*)(V_lds + (bf) * SHM_V + vst0) = S.st_v0; *(bf16x8*)(V_lds + (bf) * SHM_V + vst1) = S.st_v1; } while (0)
#define SWRITE_H(bf, k0) do { SWRITE_HV(bf); SWRITE_HK(bf, k0); } while (0)

__device__ __forceinline__ void attn_prime(const BlockRef& cur, char* lds, Seam& S, const int tid) {
    const int wid = __builtin_amdgcn_readfirstlane(tid >> 6), lane = tid & 63, r32 = lane & 31, hi = lane >> 5;
    const int sr = tid >> 4, sc = (tid & 15) * 8, kws = KSWZ(sr, sc * 2); char* K_lds = lds + 2 * SHM_V;
    float* ks_l = (float*)(lds + OFF_KS); float* bs_l = (float*)(lds + OFF_BS); const float* ksr = ks_l + sr;
    int j_hi = (cur.P0 + QB - 1) / KVBLK + 1; if (j_hi > cur.skv / KVBLK) j_hi = cur.skv / KVBLK;
    const int nkeys = j_hi * KVBLK;
    const float c0 = cur.cc ? cur.cc[cur.P0] : 0.f;
    int jlo = 0;
    if (cur.cc) { const float thr = cur.gg[128]; const int jd = cur.P0 / KVBLK;
        const float cv = lane <= jd ? cur.cc[lane * KVBLK + KVBLK - 1] : 0.f;
        const bool keep = lane > jd || (c0 - cv > -thr);
        jlo = __ffsll((long long)__ballot(keep)) - 1; }
    S.jlo = jlo;
    for (int s = jlo * KVBLK + tid; s < nkeys; s += NTHREADS) {
        const f32x4 p = *(const GAS f32x4*)(cur.kss + (size_t)s * LDSS);
        ks_l[s] = rsqrtf(((p[0] + p[1]) + (p[2] + p[3])) * (1.f / 128.f) + EPS);
        bs_l[s] = cur.cc ? (c0 - cur.cc[s]) * (1.f / SCALE) : 0.f;
    }
    __syncthreads();
    const int qrow = wid * QBLK + r32;
    const f32x4 qp = *(const GAS f32x4*)(cur.qss + (size_t)qrow * LDSS);
    const float rq = rsqrtf(((qp[0] + qp[1]) + (qp[2] + qp[3])) * (1.f / 128.f) + EPS);
#pragma unroll
    for (int d0 = 0; d0 < 8; ++d0) {
        const u32x4 w = *(const GAS u32x4*)(cur.Q + (size_t)qrow * LDQ + d0 * 16 + hi * 8);
        const f32x4 g0 = *(const GAS f32x4*)(cur.gg + d0 * 16 + hi * 8), g1 = *(const GAS f32x4*)(cur.gg + d0 * 16 + hi * 8 + 4);
        u32x4 o; o.x = cvtpk(bf_lo(w.x) * rq * g0[0], bf_hi(w.x) * rq * g0[1]); o.y = cvtpk(bf_lo(w.y) * rq * g0[2], bf_hi(w.y) * rq * g0[3]);
        o.z = cvtpk(bf_lo(w.z) * rq * g1[0], bf_hi(w.z) * rq * g1[1]); o.w = cvtpk(bf_lo(w.w) * rq * g1[2], bf_hi(w.w) * rq * g1[3]);
        S.qr[d0] = *reinterpret_cast<bf16x8*>(&o);
    }
    SLOAD_H(cur.K, cur.V, jlo * KVBLK); VMW(); SWRITE_HK(0, jlo * KVBLK);
    __syncthreads();
}
__device__ __forceinline__ void attn_block(const BlockRef& cur, char* lds, Seam& S, const int tid) {
    const int wid = __builtin_amdgcn_readfirstlane(tid >> 6), lane = tid & 63, r32 = lane & 31, hi = lane >> 5;
    const int W = WBIG;
    int j_hi = (cur.P0 + QB - 1) / KVBLK + 1; if (j_hi > cur.skv / KVBLK) j_hi = cur.skv / KVBLK;
    const int j_lo = S.jlo; const int NT = j_hi - j_lo;
    const int qlo = cur.P0 - j_lo * KVBLK + wid * QBLK, qm = qlo + r32 - 4 * hi;
    char* V_lds = lds; char* K_lds = lds + 2 * SHM_V;
    float* ws = (float*)(lds + OFF_WS) + wid * 64; float* li_l = ws, * al_l = ws + 32;
    const float* bs_l = (const float*)(lds + OFF_BS) + j_lo * KVBLK + 4 * hi;
    float m_reg = -1e30f, l_reg = 0; f32x16 o[4] = {};
    const int sr = tid >> 4, sc = (tid & 15) * 8, vst0 = v_st(sr, sc), vst1 = v_st(32 + sr, sc), kws = KSWZ(sr, sc * 2);
    const float* ksr = (const float*)(lds + OFF_KS) + j_lo * KVBLK + sr;
    const int vb0 = (int)(uintptr_t)V_lds + v_rd_base(lane);
    const GAS bf16_t* Kh = cur.K + (size_t)j_lo * KVBLK * LDK; const GAS bf16_t* Vh = cur.V + (size_t)j_lo * KVBLK * LDK;
#define RESC(a) do { if (__any((a) < 1.f)) { if (hi == 0) al_l[r32] = (a); asm volatile("s_waitcnt lgkmcnt(0)" ::: "memory");              \
                     for (int d_ = 0; d_ < 4; ++d_) for (int r = 0; r < 16; ++r) o[d_][r] *= al_l[crow(r, hi)]; } } while (0)
#define KBASE(t) ((t) * KVBLK)
#define MASKT(P0_, P1_, t) do { const int kb_ = KBASE(t); if (kb_ + KVBLK - 1 > qlo) mask_tile(P0_, P1_, qm - kb_, (unsigned)W); } while (0)
    f32x16 pA0, pA1, pB0, pB1; float mnA, mnB, alA, alB; bf16x8 pa0, pa1, pa2, pa3;
    SWRITE_HV(0); SBAR();
    if (NT > 1) { SLOAD_H(Kh, Vh, KBASE(1)); }
    SBAR(); qkt<0>(pA0, pA1, K_lds, r32, hi, S.qr, bs_l + KBASE(0));
    MASKT(pA0, pA1, 0); partialSM(pA0, pA1, m_reg, mnA, alA);
    if (NT > 1) { VMW(); SWRITE_H(1, KBASE(1)); }
    __syncthreads();
#define HALF_STEP(PX0, PX1, mnX, alX, PY0, PY1, alY, t, KB, VB, SB) do {                                                      \
        SBAR(); qkt<KB>(PX0, PX1, K_lds, r32, hi, S.qr, bs_l + KBASE(t));                                                         \
        finishSM(PY0, PY1, alY, l_reg, pa0, pa1, pa2, pa3); SBAR();                                                           \
        if ((t) + 1 < NT) { SLOAD_H(Kh, Vh, KBASE((t) + 1)); SBAR(); }                                               \
        pv_tile<VB>(o, vb0, pa0, pa1, pa2, pa3); MASKT(PX0, PX1, (t)); partialSM(PX0, PX1, m_reg, mnX, alX);                                        \
        __syncthreads();                                                                                                      \
        if ((t) + 1 < NT) { VMW(); SWRITE_H(SB, KBASE((t) + 1)); }                                                                          \
        RESC(alX); __syncthreads(); } while (0)
    for (int t = 1; t + 1 < NT; t += 2) {
        HALF_STEP(pB0, pB1, mnB, alB, pA0, pA1, alA, t, 1, 0, 0);
        HALF_STEP(pA0, pA1, mnA, alA, pB0, pB1, alB, t + 1, 0, 1, 1);
    }
    const bool even = (NT & 1) == 0;
    if (even) { SBAR(); qkt<1>(pB0, pB1, K_lds, r32, hi, S.qr, bs_l + KBASE(NT - 1)); SBAR(); }
    finishSM(pA0, pA1, alA, l_reg, pa0, pa1, pa2, pa3); SBAR();
    pv_tile<0>(o, vb0, pa0, pa1, pa2, pa3);
    if (even) { MASKT(pB0, pB1, NT - 1); partialSM(pB0, pB1, m_reg, mnB, alB); __syncthreads(); RESC(alB);
        finishSM(pB0, pB1, alB, l_reg, pa0, pa1, pa2, pa3); SBAR(); pv_tile<1>(o, vb0, pa0, pa1, pa2, pa3); }
    SBAR();
    if (hi == 0) li_l[r32] = l_reg; asm volatile("s_waitcnt lgkmcnt(0)" ::: "memory");
    float rli[16];
#pragma unroll
    for (int r = 0; r < 16; ++r) rli[r] = __builtin_amdgcn_rcpf(li_l[crow(r, hi)]);
    GAS bf16_t* Ow = cur.O + (size_t)(wid * QBLK) * LDO;
#pragma unroll
    for (int r = 0; r < 16; ++r) { const int orow = crow(r, hi);
#pragma unroll
        for (int d0 = 0; d0 < 4; ++d0) { const float v = o[d0][r] * rli[r];
            const float vn = dppf<0xB1>(v);
            if ((r32 & 1) == 0) *(GAS unsigned*)(Ow + (size_t)orow * LDO + d0 * 32 + r32) = cvtpk(v, vn); } }
    __syncthreads();
#undef RESC
#undef KBASE
#undef MASKT
#undef HALF_STEP
}
#undef ROWK
#undef VMW
#undef VMWN
#undef SLOAD_H
#undef SWRITE_HK
#undef SWRITE_HV
#undef SWRITE_H
#undef KSWZ
#undef SBAR
}


struct Frame {
    GAS unsigned char* ws; const float* const* in_; GAS float* out;
    __device__ __forceinline__ const GAS float* in(int i) const { return (const GAS float*)in_[i]; }
    int tid, lane, wave, gw, ngw, gtid, ngt;
};
enum { I_X = 0, I_MEM, I_ANORM, I_AWIN, I_ACONVW, I_ACONVB, I_AGATEW, I_AGATEB, I_ALAMBDA, I_AWOUT, I_SNORM, I_SWKVF, I_SBF, I_SKNORM, I_BNORM, I_BWIN, I_BQNORM, I_BWOUT,
       I_MNORM, I_MWKV, I_MQNORM, I_MKNORM, I_PNORM, I_PWQ, I_PSUBK, I_PU, I_PV, N_IN };

__device__ __forceinline__ void transpose_item(const GAS float* W, int ldw, int coff, const GAS float* gain, GAS bf16_t* WT, int ldt, int row_off, LAS float* scr, int nblk, int item, int lane) {
    const int kb = item / nblk, nb = item % nblk, k0 = 64 * kb, n0 = 32 * nb;
    float wv[32];
#pragma unroll
    for (int i = 0; i < 32; ++i) wv[i] = W[(size_t)(k0 + 2 * i + (lane >> 5)) * ldw + coff + n0 + (lane & 31)];
    if (gain) {
#pragma unroll
        for (int i = 0; i < 32; ++i) wv[i] *= gain[k0 + 2 * i + (lane >> 5)]; }
#pragma unroll
    for (int i = 0; i < 32; ++i) scr[(2 * i + (lane >> 5)) * 33 + (lane & 31)] = wv[i];
    asm volatile("s_waitcnt lgkmcnt(0)" ::: "memory");
    const int c = lane & 7;
#pragma unroll
    for (int j = 0; j < 4; ++j) { const int n = (lane >> 3) + 8 * j; const LAS float* s = scr + (8 * c) * 33 + n;
        u32x4 o; o.x = cvtpk(s[0 * 33], s[1 * 33]); o.y = cvtpk(s[2 * 33], s[3 * 33]); o.z = cvtpk(s[4 * 33], s[5 * 33]); o.w = cvtpk(s[6 * 33], s[7 * 33]);
        *(GAS u32x4*)(WT + (size_t)(row_off + n0 + n) * ldt + k0 + 8 * c) = o; }
    asm volatile("s_waitcnt lgkmcnt(0)" ::: "memory");
}
__device__ __forceinline__ void transpose_item_fp8(const GAS float* W, int ldw, const GAS float* gain, GAS unsigned char* WT, int ldt, LAS float* scr, int nblk, int item, int lane) {
    const int kb = item / nblk, nb = item % nblk, k0 = 64 * kb, n0 = 32 * nb;
    float wv[32];
#pragma unroll
    for (int i = 0; i < 32; ++i) wv[i] = W[(size_t)(k0 + 2 * i + (lane >> 5)) * ldw + n0 + (lane & 31)];
#pragma unroll
    for (int i = 0; i < 32; ++i) wv[i] *= gain[k0 + 2 * i + (lane >> 5)] * 64.f;
#pragma unroll
    for (int i = 0; i < 32; ++i) scr[(2 * i + (lane >> 5)) * 33 + (lane & 31)] = wv[i];
    asm volatile("s_waitcnt lgkmcnt(0)" ::: "memory");
    const int c = lane & 3;
#pragma unroll
    for (int j = 0; j < 2; ++j) { const int n = (lane >> 2) + 16 * j; const LAS float* sp = scr + (16 * c) * 33 + n; u32x4 o;
#pragma unroll
        for (int w = 0; w < 4; ++w) { int pk = __builtin_amdgcn_cvt_pk_fp8_f32(sp[(4 * w) * 33], sp[(4 * w + 1) * 33], 0, false); pk = __builtin_amdgcn_cvt_pk_fp8_f32(sp[(4 * w + 2) * 33], sp[(4 * w + 3) * 33], pk, true); o[w] = (unsigned)pk; }
        *(GAS u32x4*)(WT + (size_t)(n0 + n) * ldt + k0 + 16 * c) = o; }
    asm volatile("s_waitcnt lgkmcnt(0)" ::: "memory");
}
__device__ __forceinline__ void convert_tables(Frame& F, int layer, int ibeg, int iend, int wk, int nwk) {
    for (int it0 = ibeg + wk; it0 < iend; it0 += 2 * nwk) {
        f32x4 v[2][8]; GAS unsigned char* dst[2]; int rowq[2], whichq[2];
#pragma unroll
        for (int q = 0; q < 2; ++q) { const int it = it0 + q * nwk < iend ? it0 + q * nwk : it0; const int which = it & 1, row = it >> 1; rowq[q] = row; whichq[q] = which;
            const GAS float* src = F.in(which ? I_PV : I_PU) + ((size_t)layer * NEXP + row) * DM + F.lane * 4;
            const GAS float* gn = F.in(I_PNORM) + layer * DM + F.lane * 4;
            dst[q] = F.ws + O_TAB + (size_t)(layer * 2 + which) * TAB_ONE;
#pragma unroll
            for (int c = 0; c < 8; ++c) { v[q][c] = *(const GAS f32x4*)(src + c * 256); if (!which) v[q][c] = v[q][c] * *(const GAS f32x4*)(gn + c * 256); } }
#pragma unroll
        for (int q = 0; q < 2; ++q) { _Float16 shv = (_Float16)0.f;
#pragma unroll
            for (int c = 0; c < 8; ++c) { const f32x4 x = v[q][c];
                float amax = fmaxf(fmaxf(fabsf(x[0]), fabsf(x[1])), fmaxf(fabsf(x[2]), fabsf(x[3])));
                amax = fmaxf(amax, dppf<0xB1>(amax)); amax = fmaxf(amax, dppf<0x4E>(amax)); amax = fmaxf(amax, dppf<0x141>(amax)); amax = fmaxf(amax, dppf<0x140>(amax));
                amax = xmax16(amax); amax = xmax32(amax);
                const _Float16 sh = (_Float16)fmaxf(amax * (whichq[q] ? 1.f / 6.f : 1.f / 7.f), 1e-6f);
                const float qs = 1.f / (float)sh;
                unsigned pk;
                if (whichq[q]) { pk = __builtin_amdgcn_cvt_scalef32_pk_fp4_f32(0u, x[0] * qs, x[1] * qs, 1.0f, 0); pk = __builtin_amdgcn_cvt_scalef32_pk_fp4_f32(pk, x[2] * qs, x[3] * qs, 1.0f, 1); }
                else { const int q0 = (int)fminf(fmaxf(rintf(x[0] * qs), -7.f), 7.f), q1 = (int)fminf(fmaxf(rintf(x[1] * qs), -7.f), 7.f), q2 = (int)fminf(fmaxf(rintf(x[2] * qs), -7.f), 7.f), q3 = (int)fminf(fmaxf(rintf(x[3] * qs), -7.f), 7.f);
                       pk = (unsigned)(q0 & 15) | ((unsigned)(q1 & 15) << 4) | ((unsigned)(q2 & 15) << 8) | ((unsigned)(q3 & 15) << 12); }
                *(GAS unsigned short*)(dst[q] + ((size_t)c * NEXP + rowq[q]) * 128 + F.lane * 2) = (unsigned short)pk;
                shv = (F.lane == c) ? sh : shv; }
            if (F.lane < 8) *(GAS unsigned short*)(dst[q] + TAB_NIB + ((size_t)rowq[q] * 8 + F.lane) * 2) = __builtin_bit_cast(unsigned short, shv); }
    }
}
__device__ __forceinline__ void norm_row_bf16(const GAS float* xrow, const GAS float* gain, GAS bf16_t* orow, int lane) {
    f32x4 v[8]; float s = 0.f;
#pragma unroll
    for (int j = 0; j < 8; ++j) { v[j] = *(const GAS f32x4*)(xrow + j * 256 + lane * 4); s += (v[j][0] * v[j][0] + v[j][1] * v[j][1]) + (v[j][2] * v[j][2] + v[j][3] * v[j][3]); }
    const float r = rsqrtf(wave_sum(s) * (1.f / DM) + EPS);
#pragma unroll
    for (int j = 0; j < 8; ++j) { f32x4 g = gain ? *(const GAS f32x4*)(gain + j * 256 + lane * 4) : (f32x4){1.f, 1.f, 1.f, 1.f};
        u32x2 o; o.x = cvtpk(v[j][0] * r * g[0], v[j][1] * r * g[1]); o.y = cvtpk(v[j][2] * r * g[2], v[j][3] * r * g[3]);
        *(GAS u32x2*)(orow + j * 256 + lane * 4) = o; }
}
__device__ __forceinline__ void step_prologue(Frame& F, LAS unsigned char* lds) {
    LAS float* scr = (LAS float*)(lds + F.wave * 16384);
    GAS unsigned char* ws = F.ws;
    constexpr int I0 = 32 * (NIN0 / 32), I1 = 32 * 64, I2 = 32 * 96, I3 = 32 * 64, I4 = 32 * 64, I5 = 32 * 64, I6 = 32 * 64, I7 = 32 * 32, I8 = 32 * 32, I9 = 12 * 16;
    constexpr int NITEMS = I0 + I1 + I2 + I3 + I4 + I5 + I6 + I7 + I8 + I9;
    for (int it = F.gw; it < NITEMS; it += F.ngw) {
        int r = it;
        if (r < I0) { transpose_item(F.in(I_AWIN), NIN0, 0, F.in(I_ANORM), (GAS bf16_t*)(ws + O_WIN0), DM, 0, scr, NIN0 / 32, r, F.lane); continue; } r -= I0;
        if (r < I1) { transpose_item(F.in(I_AWOUT), DM, 0, nullptr, (GAS bf16_t*)(ws + O_WOUT0), DM, 0, scr, 64, r, F.lane); continue; } r -= I1;
        if (r < I2) { transpose_item(F.in(I_SWKVF), 3084, 0, F.in(I_SNORM), (GAS bf16_t*)(ws + O_WL1), DM, 0, scr, 96, r, F.lane); continue; } r -= I2;
        if (r < I3) { transpose_item(F.in(I_BWIN), DM, 0, F.in(I_BNORM), (GAS bf16_t*)(ws + O_WL1), DM, 3072, scr, 64, r, F.lane); continue; } r -= I3;
        if (r < I4) { transpose_item(F.in(I_BWOUT), DM, 0, nullptr, (GAS bf16_t*)(ws + O_WOUT1), DM, 0, scr, 64, r, F.lane); continue; } r -= I4;
        if (r < I5) { transpose_item(F.in(I_PWQ), DM, 0, F.in(I_PNORM), (GAS bf16_t*)(ws + O_WQ0), DM, 0, scr, 64, r, F.lane); continue; } r -= I5;
        if (r < I6) { transpose_item(F.in(I_PWQ) + (size_t)DM * DM, DM, 0, F.in(I_PNORM) + DM, (GAS bf16_t*)(ws + O_WQ1), DM, 0, scr, 64, r, F.lane); continue; } r -= I6;
        if (r < I7) { transpose_item(F.in(I_MWKV), 1024, 0, nullptr, (GAS bf16_t*)(ws + O_WMKV), DM, 0, scr, 32, r, F.lane); continue; } r -= I7;
        if (r < I8) { transpose_item(F.in(I_MWKV) + (size_t)DM * 1024, 1024, 0, nullptr, (GAS bf16_t*)(ws + O_WMKV) + (size_t)1024 * DM, DM, 0, scr, 32, r, F.lane); continue; } r -= I8;
        { const int blk = r / 16, sub = r % 16;
          transpose_item(F.in(I_AGATEW) + (size_t)blk * 128 * 256, 256, 0, nullptr, (GAS bf16_t*)(ws + O_WGATE), 128, blk * 256, scr, 8, sub, F.lane); }
    }
    { const GAS float* sk = F.in(I_PSUBK); GAS bf16_t* o = (GAS bf16_t*)(ws + O_SUBK);
      for (int i = F.gtid; i < 2 * 16 * 128 * 128 / 2; i += F.ngt) *(GAS unsigned*)(o + 2 * i) = cvtpk(sk[2 * i], sk[2 * i + 1]); }
    { GAS float* wf = (GAS float*)(ws + O_WF); const GAS float* w = F.in(I_SWKVF); const GAS float* g = F.in(I_SNORM);
      for (int i = F.gtid; i < 12 * DM; i += F.ngt) { const int j = i / DM, k = i % DM; wf[i] = w[(size_t)k * 3084 + 3072 + j] * g[k]; } }
    { GAS float* spl = (GAS float*)(ws + O_SPL); const GAS float* lam = F.in(I_ALAMBDA);
      for (int i = F.gtid; i < LRU; i += F.ngt) { const float z = -lam[i]; spl[i] = fmaxf(z, 0.f) + log1p_pos(fast_exp(-fabsf(z))); } }
    if (F.gw == 0) {
        float m = 0.f; for (int d = F.lane; d < 128; d += 64) m = fmaxf(m, fabsf(F.in(I_BQNORM)[d] * F.in(I_SKNORM)[d]));
        m = wave_max(m);
        if (F.lane == 0) ((GAS float*)(ws + O_GG))[512] = 2.f * 11.3137085f * m + 40.f; }
    { GAS float* gg = (GAS float*)(ws + O_GG);
      for (int i = F.gtid; i < 384; i += F.ngt) { const int a = i / 128, d = i % 128;
          gg[a == 0 ? 384 + d : i] = a == 0 ? F.in(I_BQNORM)[d] * F.in(I_SKNORM)[d] : F.in(I_MQNORM)[(a - 1) * 128 + d] * F.in(I_MKNORM)[(a - 1) * 128 + d]; } }
    for (int m = F.gw; m < T; m += 2 * F.ngw) {
        const int m1 = m + F.ngw < T ? m + F.ngw : m;
        const GAS float* x0 = F.in(I_X) + (size_t)m * DM + F.lane * 4; const GAS float* x1 = F.in(I_X) + (size_t)m1 * DM + F.lane * 4;
        f32x4 v0[8], v1[8]; float s0 = 0.f, s1 = 0.f;
#pragma unroll
        for (int j = 0; j < 8; ++j) { v0[j] = *(const GAS f32x4*)(x0 + j * 256); v1[j] = *(const GAS f32x4*)(x1 + j * 256); }
#pragma unroll
        for (int j = 0; j < 8; ++j) { s0 += (v0[j][0] * v0[j][0] + v0[j][1] * v0[j][1]) + (v0[j][2] * v0[j][2] + v0[j][3] * v0[j][3]); s1 += (v1[j][0] * v1[j][0] + v1[j][1] * v1[j][1]) + (v1[j][2] * v1[j][2] + v1[j][3] * v1[j][3]); }
        const float r0 = rsqrtf(wave_sum(s0) * (1.f / DM) + EPS), r1 = rsqrtf(wave_sum(s1) * (1.f / DM) + EPS);
        GAS bf16_t* o0 = (GAS bf16_t*)(ws + O_XS16) + (size_t)m * DM + F.lane * 4; GAS bf16_t* o1 = (GAS bf16_t*)(ws + O_XS16) + (size_t)m1 * DM + F.lane * 4;
#pragma unroll
        for (int j = 0; j < 8; ++j) { u32x2 a; a.x = cvtpk(v0[j][0] * r0, v0[j][1] * r0); a.y = cvtpk(v0[j][2] * r0, v0[j][3] * r0); *(GAS u32x2*)(o0 + j * 256) = a;
            u32x2 b; b.x = cvtpk(v1[j][0] * r1, v1[j][1] * r1); b.y = cvtpk(v1[j][2] * r1, v1[j][3] * r1); *(GAS u32x2*)(o1 + j * 256) = b; }
    }
    for (int m = F.gw; m < 2 * NMROW; m += F.ngw) { const int l = m / NMROW, r = m % NMROW;
        norm_row_bf16(F.in(I_MEM) + (size_t)r * DM, F.in(I_MNORM) + l * DM, (GAS bf16_t*)(ws + O_MEMN) + (size_t)m * DM, F.lane); }
    convert_tables(F, 0, 0, 2 * NEXP, F.gw, F.ngw);
}
__device__ __forceinline__ void step_conv(Frame& F) {
    const GAS bf16_t* zx = (const GAS bf16_t*)(F.ws + O_ZX); GAS bf16_t* xc = (GAS bf16_t*)(F.ws + O_XC);
    const GAS float* cw = F.in(I_ACONVW); const GAS float* cb = F.in(I_ACONVB);
    for (int it = F.gtid; it < T * (LRU / 8); it += F.ngt) {
        const int t = it / (LRU / 8), c8 = (it % (LRU / 8)) * 8, pos = t & (SEQ - 1);
        float a[8];
#pragma unroll
        for (int j = 0; j < 8; ++j) a[j] = cb[c8 + j];
#pragma unroll
        for (int k = 0; k < 4; ++k) { if (pos - 3 + k >= 0) { const u32x4 w = *(const GAS u32x4*)(zx + (size_t)(t - 3 + k) * LRU + c8);
            const float xv[8] = {bf_lo(w.x), bf_hi(w.x), bf_lo(w.y), bf_hi(w.y), bf_lo(w.z), bf_hi(w.z), bf_lo(w.w), bf_hi(w.w)};
#pragma unroll
            for (int j = 0; j < 8; ++j) a[j] = fmaf(cw[k * LRU + c8 + j], xv[j], a[j]); } }
        u32x4 o; o.x = cvtpk(a[0], a[1]); o.y = cvtpk(a[2], a[3]); o.z = cvtpk(a[4], a[5]); o.w = cvtpk(a[6], a[7]);
        *(GAS u32x4*)(xc + (size_t)t * LRU + c8) = o;
    }
}
constexpr int SCK = 32, NCK = SEQ / SCK;
typedef _Float16 h8_t __attribute__((ext_vector_type(8)));
__device__ __forceinline__ void scan_load(const GAS _Float16* LA, const GAS _Float16* UH, size_t off, float (&a)[8], float (&u)[8]) {
    const h8_t l = *(const GAS h8_t*)(LA + off), w = *(const GAS h8_t*)(UH + off);
#pragma unroll
    for (int k = 0; k < 8; ++k) { a[k] = fast_exp((float)l[k]); u[k] = (float)w[k]; }
}
__device__ __forceinline__ void step_scan1(Frame& F) {
    const GAS _Float16* LA = (const GAS _Float16*)(F.ws + O_AA); const GAS _Float16* UH = (const GAS _Float16*)(F.ws + O_UU);
    GAS float* CA = (GAS float*)(F.ws + O_LOGFP); GAS float* CH = CA + (size_t)NB * NCK * LRU;
    if (F.tid >= 384) return;
    const int grp = F.tid / 192, th = F.tid % 192;
    for (int it = blockIdx.x * 2 + grp; it < NB * NCK; it += gridDim.x * 2) {
        const int b = it / NCK, ck = it % NCK; const size_t base = ((size_t)b * SEQ + ck * SCK) * LRU + th * 8;
        float ap[8], h[8];
#pragma unroll
        for (int k = 0; k < 8; ++k) { ap[k] = 1.f; h[k] = 0.f; }
#pragma unroll 8
        for (int i = 0; i < SCK; ++i) { float a[8], u[8]; scan_load(LA, UH, base + (size_t)i * LRU, a, u);
#pragma unroll
            for (int k = 0; k < 8; ++k) { ap[k] *= a[k]; h[k] = a[k] * h[k] + u[k]; } }
        GAS float* ca = CA + (size_t)it * LRU + th * 8; GAS float* ch = CH + (size_t)it * LRU + th * 8;
        *(GAS f32x4*)ca = (f32x4){ap[0], ap[1], ap[2], ap[3]}; *(GAS f32x4*)(ca + 4) = (f32x4){ap[4], ap[5], ap[6], ap[7]};
        *(GAS f32x4*)ch = (f32x4){h[0], h[1], h[2], h[3]}; *(GAS f32x4*)(ch + 4) = (f32x4){h[4], h[5], h[6], h[7]};
    }
}
__device__ __forceinline__ void step_scan2(Frame& F) {
    const GAS _Float16* LA = (const GAS _Float16*)(F.ws + O_AA); const GAS _Float16* UH = (const GAS _Float16*)(F.ws + O_UU);
    const GAS float* CA = (const GAS float*)(F.ws + O_LOGFP); const GAS float* CH = CA + (size_t)NB * NCK * LRU;
    const GAS bf16_t* gy = (const GAS bf16_t*)(F.ws + O_GY); GAS bf16_t* cat = (GAS bf16_t*)(F.ws + O_CAT);
    if (F.tid >= 384) return;
    const int grp = F.tid / 192, th = F.tid % 192;
    for (int it = blockIdx.x * 2 + grp; it < NB * NCK; it += gridDim.x * 2) {
        const int b = it / NCK, ck = it % NCK; const size_t base = ((size_t)b * SEQ + ck * SCK) * LRU + th * 8;
        float h[8];
#pragma unroll
        for (int k = 0; k < 8; ++k) h[k] = 0.f;
        for (int k2 = 0; k2 < ck; ++k2) { const size_t o = (size_t)(b * NCK + k2) * LRU + th * 8;
            const f32x4 a0 = *(const GAS f32x4*)(CA + o), a1 = *(const GAS f32x4*)(CA + o + 4), c0 = *(const GAS f32x4*)(CH + o), c1 = *(const GAS f32x4*)(CH + o + 4);
#pragma unroll
            for (int k = 0; k < 4; ++k) { h[k] = a0[k] * h[k] + c0[k]; h[4 + k] = a1[k] * h[4 + k] + c1[k]; } }
#pragma unroll 8
        for (int i = 0; i < SCK; ++i) { float a[8], u[8]; scan_load(LA, UH, base + (size_t)i * LRU, a, u);
            const size_t row = (size_t)b * SEQ + ck * SCK + i;
            const u32x4 g = *(const GAS u32x4*)(gy + row * LRU + th * 8); u32x4 o;
#pragma unroll
            for (int k = 0; k < 8; ++k) h[k] = a[k] * h[k] + u[k];
#pragma unroll
            for (int k = 0; k < 4; ++k) o[k] = cvtpk(h[2 * k] * bf_lo(g[k]), h[2 * k + 1] * bf_hi(g[k]));
            *(GAS u32x4*)(cat + row * DM + th * 8) = o; }
    }
}
__device__ __forceinline__ void step_cprefix(Frame& F, LAS unsigned char* lds) {
    const GAS float* lf = (const GAS float*)(F.ws + O_LOGF); GAS float* cc = (GAS float*)(F.ws + O_CC);
    LAS double* scr = (LAS double*)(lds + F.wave * 16384);
    for (int it = F.gw; it < NB * NH; it += F.ngw) {
        const GAS float* p = lf + (size_t)it * SEQ + F.lane * 64; GAS float* q = cc + (size_t)it * SEQ + F.lane * 64;
        double s = 0.0;
        for (int i = 0; i < 64; ++i) s += (double)p[i];
        scr[F.lane] = s;
        asm volatile("s_waitcnt lgkmcnt(0)" ::: "memory");
        double run = 0.0;
        for (int l = 0; l < 64; ++l) { const double v = scr[l]; if (l < F.lane) run += v; }
        for (int i = 0; i < 64; ++i) { run += (double)p[i]; q[i] = (float)run; }
        asm volatile("s_waitcnt lgkmcnt(0)" ::: "memory");
    }
}

__device__ __forceinline__ int ord_i(float f) { const int b = __float_as_int(f); return b ^ ((b >> 31) & 0x7fffffff); }
__device__ __forceinline__ float unord_f(int k) { return __int_as_float(k ^ ((k >> 31) & 0x7fffffff)); }
template <int N> __device__ __forceinline__ void bitonic_sort_desc(int (&a)[N]) {
#pragma unroll
    for (int k = 2; k <= N; k <<= 1) {
#pragma unroll
        for (int j = k >> 1; j > 0; j >>= 1) {
#pragma unroll
            for (int i = 0; i < N; ++i) { const int l = i ^ j;
                if (l > i) { const bool desc = ((i & k) == 0); const int mx = max(a[i], a[l]), mn = min(a[i], a[l]); a[i] = desc ? mx : mn; a[l] = desc ? mn : mx; } }
        }
    }
}
__device__ __forceinline__ void bitonic_merge16_desc(int (&a)[16]) {
#pragma unroll
    for (int j = 8; j > 0; j >>= 1) {
#pragma unroll
        for (int i = 0; i < 16; ++i) { const int l = i ^ j; if (l > i) { const int mx = max(a[i], a[l]), mn = min(a[i], a[l]); a[i] = mx; a[l] = mn; } }
    }
}
__device__ __forceinline__ void subkey_top16(const GAS bf16_t* qrow  , const GAS bf16_t* sk  , int r32, int hi, int (&top)[16]) {
    bf16x8 qf[8];
#pragma unroll
    for (int ks = 0; ks < 8; ++ks) qf[ks] = *(const GAS bf16x8*)(qrow + ks * 16 + hi * 8);
    unsigned loff = (unsigned)(r32 * 128 + hi * 8) * 2u; asm volatile("" : "+v"(loff));
    int key[64];
#pragma unroll
    for (int kb = 0; kb < 4; ++kb) {
        f32x16 acc = {};
#pragma unroll
        for (int ks = 0; ks < 8; ++ks) { const bf16x8 af = *(const GAS bf16x8*)((const GAS char*)(sk + kb * 32 * 128 + ks * 16) + loff);
            acc = __builtin_amdgcn_mfma_f32_32x32x16_bf16(af, qf[ks], acc, 0, 0, 0); }
#pragma unroll
        for (int r = 0; r < 16; ++r) { const int id = kb * 32 + (r & 3) + 8 * (r >> 2) + 4 * hi; key[kb * 16 + r] = (ord_i(acc[r]) & ~127) | (127 - id); }
        __builtin_amdgcn_sched_barrier(0);
    }
    bitonic_sort_desc<64>(key);
#pragma unroll
    for (int i = 0; i < 16; ++i) { auto r = __builtin_amdgcn_permlane32_swap((unsigned)key[15 - i], (unsigned)key[15 - i], false, false);
        const int pk = hi ? (int)r[0] : (int)r[1]; top[i] = max(key[i], pk); }
    bitonic_merge16_desc(top);
}
__device__ __forceinline__ void step_topk(Frame& F, LAS unsigned char* lds, int layer) {
    const GAS bf16_t* q16 = (const GAS bf16_t*)(F.ws + O_Q16); const GAS bf16_t* subk = (const GAS bf16_t*)(F.ws + O_SUBK) + (size_t)layer * 16 * 128 * 128;
    GAS int* IDX = (GAS int*)(F.ws + O_IDX); GAS float* GW = (GAS float*)(F.ws + O_GW);
    LAS int* scr = (LAS int*)(lds + F.wave * 16384) + F.lane * 33;
    const int r32 = F.lane & 31, hi = F.lane >> 5;
    for (int task = F.gw; task < (T / 32) * 8; task += F.ngw) {
        const int tb = task >> 3, h = task & 7; const int tok = tb * 32 + r32;
        const GAS bf16_t* qrow = q16 + (size_t)tok * DM + h * 256;
        int ta[16], tb16[16];
        subkey_top16(qrow, subk + (size_t)(h * 2 + 0) * 128 * 128, r32, hi, ta);
        subkey_top16(qrow + 128, subk + (size_t)(h * 2 + 1) * 128 * 128, r32, hi, tb16);
        float va[16], vb[16];
#pragma unroll
        for (int i = 0; i < 16; ++i) { va[i] = unord_f(ta[i] & ~127); vb[i] = unord_f(tb16[i] & ~127); scr[i] = 127 - (ta[i] & 127); scr[16 + i] = 127 - (tb16[i] & 127); }
        int c2[64]; int n = 0;
#pragma unroll
        for (int i = 0; i < 16; ++i)
#pragma unroll
            for (int j = 0; j < 16; ++j) if ((i + 1) * (j + 1) <= 16) { c2[n] = (ord_i(va[i] + vb[j]) & ~255) | (255 - (i * 16 + j)); ++n; }
#pragma unroll
        for (int i = 50; i < 64; ++i) c2[i] = (int)0x80000000;
        bitonic_sort_desc<64>(c2);
        asm volatile("s_waitcnt lgkmcnt(0)" ::: "memory");
        float sv[16], ex[16]; int ev[16]; float Z = 0.f;
#pragma unroll
        for (int r = 0; r < 16; ++r) { const int flat = 255 - (c2[r] & 255); sv[r] = unord_f(c2[r] & ~255); ev[r] = scr[flat >> 4] * 128 + scr[16 + (flat & 15)]; }
#pragma unroll
        for (int r = 0; r < 16; ++r) { ex[r] = fast_exp(sv[r] - sv[0]); Z += ex[r]; }
        const float iz = 1.f / Z;
        GAS int* ip = IDX + (size_t)tok * 128 + h * 16 + hi * 8; GAS float* gp = GW + (size_t)tok * 128 + h * 16 + hi * 8;
        int eo[8]; float go[8];
#pragma unroll
        for (int j = 0; j < 8; ++j) { eo[j] = hi ? ev[8 + j] : ev[j]; go[j] = (hi ? ex[8 + j] : ex[j]) * iz; }
        *(GAS u32x4*)ip = (u32x4){(unsigned)eo[0], (unsigned)eo[1], (unsigned)eo[2], (unsigned)eo[3]}; *(GAS u32x4*)(ip + 4) = (u32x4){(unsigned)eo[4], (unsigned)eo[5], (unsigned)eo[6], (unsigned)eo[7]};
        *(GAS f32x4*)gp = (f32x4){go[0], go[1], go[2], go[3]}; *(GAS f32x4*)(gp + 4) = (f32x4){go[4], go[5], go[6], go[7]};
        asm volatile("s_waitcnt lgkmcnt(0)" ::: "memory");
    }
}
__device__ __forceinline__ h2 as_h2(unsigned w) { return __builtin_bit_cast(h2, w); }
#define F4(W, s) __builtin_amdgcn_cvt_scalef32_pk_f16_fp4((W), 1.0f, (s))
#define H2F(us) ((float)__builtin_bit_cast(_Float16, (unsigned short)(us)))
__device__ __forceinline__ float sum8(float v) { v += dppf<0xB1>(v); v += dppf<0x4E>(v); v += dppf<0x141>(v); return v; }
__device__ __forceinline__ void step_xplanes(Frame& F) {
    const GAS bf16_t* xs = (const GAS bf16_t*)(F.ws + O_XS16); GAS unsigned char* x4 = F.ws + O_X4; GAS float* sx = (GAS float*)(F.ws + O_SX);
    for (int t = F.gw; t < T; t += F.ngw) {
        const GAS bf16_t* xr = xs + (size_t)t * DM + F.lane * 32;
        u32x4 w[4]; float xv[32]; float amax = 0.f;
#pragma unroll
        for (int c = 0; c < 4; ++c) w[c] = *(const GAS u32x4*)(xr + 8 * c);
#pragma unroll
        for (int c = 0; c < 4; ++c)
#pragma unroll
            for (int k = 0; k < 4; ++k) { xv[8 * c + 2 * k] = bf_lo(w[c][k]); xv[8 * c + 2 * k + 1] = bf_hi(w[c][k]); amax = fmaxf(amax, fmaxf(fabsf(xv[8 * c + 2 * k]), fabsf(xv[8 * c + 2 * k + 1]))); }
        amax = fmaxf(amax, dppf<0xB1>(amax)); amax = fmaxf(amax, dppf<0x4E>(amax)); amax = fmaxf(amax, dppf<0x141>(amax));
        const float sc = fmaxf(amax, 1e-20f) * (1.f / 119.f), qs = 1.f / sc;
        u32x4 hp, lp;
#pragma unroll
        for (int d = 0; d < 4; ++d) { unsigned hw = 0u, lw = 0u;
#pragma unroll
            for (int k = 0; k < 8; ++k) { const int q = (int)rintf(xv[8 * d + k] * qs); const int h = (q + 8) >> 4, l = q - 16 * h; hw |= (unsigned)(h & 15) << (4 * k); lw |= (unsigned)(l & 15) << (4 * k); }
            hp[d] = hw; lp[d] = lw; }
        *(GAS u32x4*)(x4 + ((size_t)t * 64 + F.lane) * 32) = hp; *(GAS u32x4*)(x4 + ((size_t)t * 64 + F.lane) * 32 + 16) = lp;
        if ((F.lane & 7) == 0) sx[(size_t)t * 8 + (F.lane >> 3)] = sc;
    }
}
__device__ __forceinline__ void step_upass(Frame& F, int layer, int G) {
    const int s = blockIdx.x & 7, wk = (blockIdx.x >> 3) * NWAVES + F.wave, nwk = (G >> 3) * NWAVES;
    const GAS unsigned char* UN = F.ws + O_TAB + (size_t)(layer * 2) * TAB_ONE + (size_t)s * NEXP * 128;
    const GAS int* IDX = (const GAS int*)(F.ws + O_IDX); const GAS unsigned char* x4 = F.ws + O_X4 + s * 256; const GAS float* sxp = (const GAS float*)(F.ws + O_SX) + s;
    GAS float* part = (GAS float*)(F.ws + O_PART) + (size_t)s * T * 128;
    unsigned lo = (unsigned)F.lane; asm volatile("" : "+v"(lo));
    const unsigned j = lo >> 3, p = lo & 7;
    const int tlast = wk + ((T - 1 - wk) / nwk) * nwk;
#define U_LOADID(ID, t_, q_) do { const int tt_ = (t_) <= tlast ? (t_) : tlast; _Pragma("unroll") for (int b = 0; b < 4; ++b) ID[b] = IDX[(size_t)tt_ * 128 + (q_) * 32 + 8 * b + j]; } while (0)
#define U_LOADX(t_) do { const int tt_ = (t_) <= tlast ? (t_) : tlast; xhn = *(const GAS u32x4*)(x4 + (size_t)tt_ * 2048 + p * 32); xln = *(const GAS u32x4*)(x4 + (size_t)tt_ * 2048 + p * 32 + 16); sxn = sxp[(size_t)tt_ * 8]; } while (0)
#define U_ISSUE(UB, ID) do { _Pragma("unroll") for (int b = 0; b < 4; ++b) UB[b] = *(const GAS u32x4*)(UN + (unsigned)(ID[b] * 128 + (int)p * 16)); } while (0)
#define U_QUARTER(UB, vout, q_) do { _Pragma("unroll") for (int b = 0; b < 4; ++b) { int ah = 0, al = 0; \
            ah = __builtin_amdgcn_sdot8((int)UB[b].x, (int)xh.x, ah, false); al = __builtin_amdgcn_sdot8((int)UB[b].x, (int)xl.x, al, false); \
            ah = __builtin_amdgcn_sdot8((int)UB[b].y, (int)xh.y, ah, false); al = __builtin_amdgcn_sdot8((int)UB[b].y, (int)xl.y, al, false); \
            ah = __builtin_amdgcn_sdot8((int)UB[b].z, (int)xh.z, ah, false); al = __builtin_amdgcn_sdot8((int)UB[b].z, (int)xl.z, al, false); \
            ah = __builtin_amdgcn_sdot8((int)UB[b].w, (int)xh.w, ah, false); al = __builtin_amdgcn_sdot8((int)UB[b].w, (int)xl.w, al, false); \
            const float d = sum8((float)(16 * ah + al)) * sxc; vout = (p == (unsigned)(4 * ((q_) & 1) + b)) ? d : vout; } } while (0)
    int idA[4], idB[4]; u32x4 u0[4], u1[4], u2[4], u3[4]; u32x4 xh, xl, xhn, xln; float sxc, sxn;
    U_LOADID(idA, wk, 0); U_LOADID(idB, wk, 1); U_LOADX(wk);
    U_ISSUE(u0, idA); U_LOADID(idA, wk, 2);
    U_ISSUE(u1, idB); U_LOADID(idB, wk, 3);
    U_ISSUE(u2, idA); U_LOADID(idA, wk + nwk, 0);
    xh = xhn; xl = xln; sxc = sxn;
    for (int t = wk; t < T; t += nwk) {
        float v0 = 0.f, v1 = 0.f;
        U_ISSUE(u3, idB); U_LOADID(idB, t + nwk, 1); U_LOADX(t + nwk);
        U_QUARTER(u0, v0, 0);
        U_ISSUE(u0, idA); U_LOADID(idA, t + nwk, 2);
        U_QUARTER(u1, v0, 1);
        U_ISSUE(u1, idB); U_LOADID(idB, t + nwk, 3);
        U_QUARTER(u2, v1, 2);
        U_ISSUE(u2, idA); U_LOADID(idA, t + 2 * nwk, 0);
        U_QUARTER(u3, v1, 3);
        part[(size_t)t * 128 + 8 * p + j] = v0; part[(size_t)t * 128 + 64 + 8 * p + j] = v1;
        xh = xhn; xl = xln; sxc = sxn;
    }
#undef U_LOADID
#undef U_LOADX
#undef U_ISSUE
#undef U_QUARTER
}
__device__ __forceinline__ void step_peer_reduce(Frame& F, int layer) {
    const GAS float* part = (const GAS float*)(F.ws + O_PART); const GAS float* GW = (const GAS float*)(F.ws + O_GW); const GAS int* IDX = (const GAS int*)(F.ws + O_IDX);
    const GAS float* rowss = (const GAS float*)(F.ws + O_ROWSS); GAS unsigned* PK = (GAS unsigned*)(F.ws + O_PK);
    const GAS unsigned char* SU = F.ws + O_TAB + (size_t)(layer * 2) * TAB_ONE + TAB_NIB; const GAS unsigned char* SV = SU + TAB_ONE;
    for (int it = F.gw; it < T * 2; it += F.ngw) { const int t = it >> 1; const size_t i = (size_t)it * 64 + F.lane;
        const float r = rsqrtf(wave_sum(rowss[(size_t)t * 32 + (F.lane & 31)]) * (0.5f / DM) + EPS);
        const int id = IDX[i];
        const u32x4 su = *(const GAS u32x4*)(SU + (size_t)id * 16), sv = *(const GAS u32x4*)(SV + (size_t)id * 16);
        float d = 0.f;
#pragma unroll
        for (int s = 0; s < 8; ++s) d += part[(size_t)s * T * 128 + i] * (float)__builtin_bit_cast(_Float16, (unsigned short)(su[s >> 1] >> (16 * (s & 1))));
        const float w = GW[i] * gelu_tanh(d * r);
#pragma unroll
        for (int s = 0; s < 8; ++s) { const _Float16 ws = (_Float16)(w * (float)__builtin_bit_cast(_Float16, (unsigned short)(sv[s >> 1] >> (16 * (s & 1)))));
            PK[(size_t)s * T * 128 + i] = ((unsigned)id << 16) | (unsigned)__builtin_bit_cast(unsigned short, ws); } }
}
__device__ __forceinline__ void step_vpass(Frame& F, int layer, int G, bool dry) {
    const int s = blockIdx.x & 7, wk = (blockIdx.x >> 3) * NWAVES + F.wave, nwk = (G >> 3) * NWAVES;
    const GAS unsigned char* VN = F.ws + O_TAB + (size_t)(layer * 2 + 1) * TAB_ONE + (size_t)s * NEXP * 128;
    const GAS unsigned* PK = (const GAS unsigned*)(F.ws + O_PK) + (size_t)s * T * 128;
    GAS bf16_t* xs = (GAS bf16_t*)(F.ws + O_XS16); GAS float* rsp = (GAS float*)(F.ws + O_RSP);
    unsigned lo = (unsigned)F.lane; asm volatile("" : "+v"(lo));
    const unsigned j = lo >> 3, p = lo & 7;
    const int tlast = wk + ((T - 1 - wk) / nwk) * nwk;
#define V_LOADPK(PKV, t_, q_) do { const int tt_ = (t_) <= tlast ? (t_) : tlast; _Pragma("unroll") for (int b = 0; b < 4; ++b) PKV[b] = PK[(size_t)tt_ * 128 + (q_) * 32 + 8 * b + j]; } while (0)
#define V_ISSUE(VB, PKV) do { _Pragma("unroll") for (int b = 0; b < 4; ++b) VB[b] = *(const GAS u32x4*)(VN + ((PKV[b] >> 16) * 128u + p * 16u)); } while (0)
#define V_CVT4(W, base) do { c_[(base)] = F4(W, 0); c_[(base) + 1] = F4(W, 1); c_[(base) + 2] = F4(W, 2); c_[(base) + 3] = F4(W, 3); } while (0)
#define V_QUARTER(VB, PKV) do { _Pragma("unroll") for (int b = 0; b < 4; ++b) { const _Float16 wl = __builtin_bit_cast(_Float16, (unsigned short)(PKV[b] & 0xffffu)); const h2 wl2 = {wl, wl}; h2 c_[16]; \
            V_CVT4(VB[b].x, 0); V_CVT4(VB[b].y, 4); V_CVT4(VB[b].z, 8); V_CVT4(VB[b].w, 12); \
            __builtin_amdgcn_sched_barrier(0); \
            _Pragma("unroll") for (int k = 0; k < 16; ++k) oh[k] = wl2 * c_[k] + oh[k]; \
            __builtin_amdgcn_sched_barrier(0); } } while (0)
    unsigned pk0[4], pk1[4], pk2[4], pk3[4], pkn[4]; u32x4 v0[4], v1[4], v2[4], v3[4];
    V_LOADPK(pk0, wk, 0); V_LOADPK(pk1, wk, 1); V_LOADPK(pk2, wk, 2); V_LOADPK(pkn, wk, 3);
    V_ISSUE(v0, pk0); V_ISSUE(v1, pk1); V_ISSUE(v2, pk2);
    for (int t = wk; t < T; t += nwk) {
#pragma unroll
        for (int b = 0; b < 4; ++b) pk3[b] = pkn[b];
        V_ISSUE(v3, pk3); V_LOADPK(pkn, t + nwk, 0);
        GAS float* xr = F.out + (size_t)t * DM + s * 256 + p * 32 + j * 4; f32x4 x2 = *(const GAS f32x4*)xr;
        h2 oh[16];
#pragma unroll
        for (int i = 0; i < 16; ++i) oh[i] = (h2){(_Float16)0.f, (_Float16)0.f};
        V_QUARTER(v0, pk0);
#pragma unroll
        for (int b = 0; b < 4; ++b) pk0[b] = pkn[b];
        V_ISSUE(v0, pk0); V_LOADPK(pkn, t + nwk, 1);
        V_QUARTER(v1, pk1);
#pragma unroll
        for (int b = 0; b < 4; ++b) pk1[b] = pkn[b];
        V_ISSUE(v1, pk1); V_LOADPK(pkn, t + nwk, 2);
        V_QUARTER(v2, pk2);
#pragma unroll
        for (int b = 0; b < 4; ++b) pk2[b] = pkn[b];
        V_ISSUE(v2, pk2); V_LOADPK(pkn, t + nwk, 3);
        V_QUARTER(v3, pk3);
#pragma unroll
        for (int i = 0; i < 16; ++i) { unsigned u = __builtin_bit_cast(unsigned, oh[i]);
            h2 a = as_h2(u) + as_h2((unsigned)__builtin_amdgcn_update_dpp(0, (int)u, 0x128, 0xF, 0xF, true)); u = __builtin_bit_cast(unsigned, a);
            { auto r = __builtin_amdgcn_permlane16_swap(u, u, false, false); a = as_h2(r[0]) + as_h2(r[1]); u = __builtin_bit_cast(unsigned, a); }
            { auto r = __builtin_amdgcn_permlane32_swap(u, u, false, false); a = as_h2(r[0]) + as_h2(r[1]); }
            oh[i] = a; }
        h2 o0 = oh[0], o1 = oh[1];
#pragma unroll
        for (int c = 1; c < 8; ++c) { o0 = (j == (unsigned)c) ? oh[2 * c] : o0; o1 = (j == (unsigned)c) ? oh[2 * c + 1] : o1; }
        x2[0] += (float)o0.x; x2[1] += (float)o0.y; x2[2] += (float)o1.x; x2[3] += (float)o1.y;
        if (!dry) *(GAS f32x4*)xr = x2;
        if (layer == 0 && !dry) {
            { u32x2 o; o.x = cvtpk(x2[0], x2[1]); o.y = cvtpk(x2[2], x2[3]); *(GAS u32x2*)(xs + (size_t)t * DM + s * 256 + p * 32 + j * 4) = o; }
            const float sst = wave_sum((x2[0] * x2[0] + x2[1] * x2[1]) + (x2[2] * x2[2] + x2[3] * x2[3]));
            if (lo == 0) rsp[(size_t)t * 8 + s] = sst;
        }
    }
#undef V_LOADPK
#undef V_ISSUE
#undef V_CVT4
#undef V_QUARTER
}
#undef F4
#undef H2F
__device__ __forceinline__ void step_logf(Frame& F) {
    const GAS bf16_t* xs = (const GAS bf16_t*)(F.ws + O_XS16); const GAS float* rsp = (const GAS float*)(F.ws + O_RSP); GAS float* logf = (GAS float*)(F.ws + O_LOGF);
    const GAS float* wf = (const GAS float*)(F.ws + O_WF);
    for (int t = F.gw; t < T; t += F.ngw) {
        unsigned lo = (unsigned)F.lane; asm volatile("" : "+v"(lo));
        float xv[32];
#pragma unroll
        for (int c = 0; c < 4; ++c) { const u32x4 w = *(const GAS u32x4*)(xs + (size_t)t * DM + c * 512 + lo * 8);
#pragma unroll
            for (int k = 0; k < 4; ++k) { xv[8 * c + 2 * k] = bf_lo(w[k]); xv[8 * c + 2 * k + 1] = bf_hi(w[k]); } }
        const float q = wave_sum(lo < 8 ? rsp[(size_t)t * 8 + lo] : 0.f);
        const float r1 = rsqrtf(q * (1.f / DM) + EPS);
        float mine = 0.f;
        for (int h = 0; h < NH; ++h) { float d = 0.f;
#pragma unroll
            for (int c = 0; c < 4; ++c) { const f32x4 w0 = *(const GAS f32x4*)(wf + (size_t)h * DM + c * 512 + lo * 8), w1 = *(const GAS f32x4*)(wf + (size_t)h * DM + c * 512 + lo * 8 + 4);
                d += (xv[8 * c] * w0[0] + xv[8 * c + 1] * w0[1]) + (xv[8 * c + 2] * w0[2] + xv[8 * c + 3] * w0[3]) + (xv[8 * c + 4] * w1[0] + xv[8 * c + 5] * w1[1]) + (xv[8 * c + 6] * w1[2] + xv[8 * c + 7] * w1[3]); }
            d = wave_sum(d); mine = (lo == (unsigned)h) ? d : mine; }
        if (lo < (unsigned)NH) { const float z = mine * r1 + F.in(I_SBF)[lo];
            logf[((size_t)(t / SEQ) * NH + lo) * SEQ + (t % SEQ)] = fminf(z, 0.f) - log1p_pos(fast_exp(-fabsf(z))); }
    }
}

#define XB_TMO      128
#define XB_XCNT(j)  (256  + 64 * (j))
#define XB_XSUB(j)  (1280 + 64 * (j))
#define XB_XGEN(j)  (2304 + 64 * (j))
#define XB_TOP      3328
#define XB_TOPGEN   3392
#define XCD_BAR_WORDS 3456
#define XB_SPIN_CAP (1u << 20)
__device__ __forceinline__ unsigned xb_ld(unsigned* p)              { return __hip_atomic_load(p, __ATOMIC_RELAXED, __HIP_MEMORY_SCOPE_AGENT); }
__device__ __forceinline__ unsigned xb_add(unsigned* p, unsigned v) { return __hip_atomic_fetch_add(p, v, __ATOMIC_RELAXED, __HIP_MEMORY_SCOPE_AGENT); }
__device__ __forceinline__ unsigned xb_xcc_id() { return (unsigned)__builtin_amdgcn_s_getreg((3 << 11) | 20) & 0xFu; }
#define XB_SPIN(cond, bar) do { unsigned _sp = 0; while (cond) { __builtin_amdgcn_s_sleep(1); \
    if ((++_sp & 255u) == 0u) { if (xb_ld(&(bar)[XB_TMO])) break; if (_sp > XB_SPIN_CAP) { atomicAdd(&(bar)[XB_TMO], 1u); break; } } } } while (0)
struct XcdBarrier { unsigned* bar; unsigned x; volatile LAS unsigned* st; };
__device__ __forceinline__ XcdBarrier xcd_barrier_post(unsigned* bar, volatile LAS unsigned* st) {
    XcdBarrier b; b.bar = bar; b.x = xb_xcc_id(); b.st = st;
    if (threadIdx.x == 0) (void)xb_add(&bar[XB_XCNT(b.x)], 1u);
    return b;
}
__device__ __forceinline__ void xcd_barrier_complete(unsigned* bar, unsigned x, unsigned& nloc, unsigned& nx) {
    const unsigned G = gridDim.x * gridDim.y * gridDim.z;
    unsigned sum, cnt, mine, sp = 0u;
    for (;;) {
        sum = 0u; cnt = 0u; mine = 0u;
#pragma unroll
        for (unsigned j = 0; j < 16; ++j) { const unsigned c = xb_ld(&bar[XB_XCNT(j)]); sum += c; cnt += (c > 0u) ? 1u : 0u; mine = (j == x) ? c : mine; }
        if (sum == G) break;
        __builtin_amdgcn_s_sleep(1);
        if ((++sp & 255u) == 0u) { if (xb_ld(&bar[XB_TMO])) break; if (sp > XB_SPIN_CAP) { atomicAdd(&bar[XB_TMO], 1u); break; } }
    }
    nloc = mine > 0u ? mine : 1u; nx = cnt > 0u ? cnt : 1u;
}
__device__ __forceinline__ void xcd_barrier(const XcdBarrier& b, int wave_s) {
    asm volatile("s_waitcnt vmcnt(0)" ::: "memory");
    __syncthreads();
    int ln_; asm volatile("v_mbcnt_lo_u32_b32 %0, -1, 0\n\tv_mbcnt_hi_u32_b32 %0, -1, %0" : "=v"(ln_));
    if (wave_s == 0 && ln_ == 0) {
        unsigned* bar = b.bar;
        __builtin_amdgcn_s_waitcnt(0);
        unsigned nloc = b.st[0], nx = b.st[1];
        if (nloc == 0u) { xcd_barrier_complete(bar, b.x, nloc, nx); b.st[0] = nloc; b.st[1] = nx; }
        const unsigned old = xb_add(&bar[XB_XSUB(b.x)], 1u);
        const unsigned gen = old / nloc;
        if (old + 1u == (gen + 1u) * nloc) {
            __builtin_amdgcn_fence(__ATOMIC_RELEASE, "agent");
            asm volatile("s_waitcnt vmcnt(0)" ::: "memory");
            const unsigned og = xb_add(&bar[XB_TOP], 1u);
            const unsigned tg = og / nx;
            if (og + 1u == (tg + 1u) * nx) xb_add(&bar[XB_TOPGEN], 1u);
            else XB_SPIN(xb_ld(&bar[XB_TOPGEN]) == tg, bar);
            __builtin_amdgcn_fence(__ATOMIC_ACQUIRE, "agent");
            xb_add(&bar[XB_XGEN(b.x)], 1u);
            asm volatile("s_waitcnt vmcnt(0)" ::: "memory");
        } else {
            XB_SPIN(xb_ld(&bar[XB_XGEN(b.x)]) == gen, bar);
            __builtin_amdgcn_fence(__ATOMIC_ACQUIRE, "agent");
            asm volatile("s_waitcnt vmcnt(0)" ::: "memory");
        }
    }
    __syncthreads();
}

constexpr int CONV1_SPLIT = 2 * 3584;
constexpr int BAR_LDS_OFF = 147456 - 64;
constexpr int LDS_BYTES = 147456;
enum { ST_PROLOGUE = 0, ST_G_IN0, ST_G_MKV0, ST_G_MKV1, ST_CONV, ST_G_GATE, ST_A_MEM0, ST_SCAN1, ST_SCAN2, ST_G_OUT0, ST_G_PQ0, ST_TOPK0, ST_UPASS0, ST_PRED0, ST_VPASS0,
       ST_G_L1, ST_CPREFIX, ST_A_FOX, ST_A_MEM1, ST_G_OUT1, ST_G_PQ1, ST_TOPK1, ST_UPASS1, ST_PRED1, ST_VPASS1, N_STEPS };
constexpr unsigned SYNC_AFTER = (1u << ST_PROLOGUE) | (1u << ST_G_MKV1) | (1u << ST_CONV) | (1u << ST_A_MEM0) | (1u << ST_SCAN1) | (1u << ST_SCAN2) | (1u << ST_G_OUT0) | (1u << ST_G_PQ0) |
                                (1u << ST_TOPK0) | (1u << ST_UPASS0) | (1u << ST_PRED0) | (1u << ST_VPASS0) | (1u << ST_G_L1) | (1u << ST_CPREFIX) | (1u << ST_A_MEM1) | (1u << ST_G_OUT1) | (1u << ST_G_PQ1) | (1u << ST_TOPK1) | (1u << ST_UPASS1) | (1u << ST_PRED1);
constexpr unsigned GEMM_STEPS = (1u << ST_G_IN0) | (1u << ST_G_MKV0) | (1u << ST_G_MKV1) | (1u << ST_G_GATE) | (1u << ST_G_OUT0) | (1u << ST_G_PQ0) | (1u << ST_G_L1) | (1u << ST_G_OUT1) | (1u << ST_G_PQ1);
constexpr unsigned ATTN_STEPS = (1u << ST_A_MEM0) | (1u << ST_A_FOX) | (1u << ST_A_MEM1);

struct Args { const float* in[N_IN]; float* out; unsigned char* ws; int lo, hi; };

__global__ void __launch_bounds__(NTHREADS, 2) yoco_fwd(Args args) {
    extern __shared__ __attribute__((aligned(16))) unsigned char lds[];
    volatile LAS unsigned* bst = (volatile LAS unsigned*)((LAS unsigned char*)lds + BAR_LDS_OFF);
    if (threadIdx.x == 0) { bst[0] = 0u; bst[1] = 0u; }
    __syncthreads();
    const XcdBarrier gbar = xcd_barrier_post((unsigned*)(args.ws + O_CTL), bst);
    const int G = gridDim.x;
    const int wave_s = __builtin_amdgcn_readfirstlane(threadIdx.x >> 6);
#ifndef DUP_MASK
#define DUP_MASK 0u
#endif
    for (int st = args.lo; st < args.hi; ++st) {
      const int nrep = ((DUP_MASK >> st) & 1u) ? 2 : 1;
      for (int rep = 0; rep < nrep; ++rep) {
        unsigned char* ws0 = args.ws; asm volatile("" : "+s"(ws0));
        GAS unsigned char* ws = (GAS unsigned char*)ws0;
#define LANE_ID(v) asm volatile("v_mbcnt_lo_u32_b32 %0, -1, 0\n\tv_mbcnt_hi_u32_b32 %0, -1, %0" : "=v"(v))
#define MAKE_TID(v) do { LANE_ID(v); v += wave_s * 64; } while (0)
#define MAKE_FRAME(F) Frame F; F.ws = ws; F.in_ = args.in; F.out = (GAS float*)args.out; { int t0_; MAKE_TID(t0_); F.tid = t0_; } F.lane = F.tid & 63; F.wave = wave_s; \
        F.gw = blockIdx.x * NWAVES + F.wave; F.ngw = gridDim.x * NWAVES; F.gtid = blockIdx.x * NTHREADS + F.tid; F.ngt = gridDim.x * NTHREADS
        if (st == ST_G_L1) { MAKE_FRAME(F); step_logf(F); }
        if ((GEMM_STEPS >> st) & 1u) {
            pg8::Gemm g; Epi E; E.ws = ws; E.resid = nullptr; E.outf = nullptr; E.o16 = nullptr; E.ssq = nullptr; E.gate_b = nullptr; int shift = 0;
            switch (st) {
            case ST_G_IN0:  g = {(const GAS bf16_t*)(ws + O_XS16), (const GAS bf16_t*)(ws + O_WIN0), T, NIN0, DM, DM, DM, 0}; E.mode = EM_IN0; break;
            case ST_G_MKV0: g = {(const GAS bf16_t*)(ws + O_MEMN), (const GAS bf16_t*)(ws + O_WMKV), NMROW, 1024, DM, DM, DM, 0}; E.mode = EM_MKV; E.o16 = (GAS bf16_t*)(ws + O_MKV); E.ssq = (GAS float*)(ws + O_MKSS); shift = 128; break;
            case ST_G_MKV1: g = {(const GAS bf16_t*)(ws + O_MEMN) + (size_t)NMROW * DM, (const GAS bf16_t*)(ws + O_WMKV) + (size_t)1024 * DM, NMROW, 1024, DM, DM, DM, 0}; E.mode = EM_MKV;
                            E.o16 = (GAS bf16_t*)(ws + O_MKV) + (size_t)NMROW * NL1; E.ssq = (GAS float*)(ws + O_MKSS) + NMROW * 112; shift = 144; break;
            case ST_G_GATE: g = {(const GAS bf16_t*)(ws + O_XC), (const GAS bf16_t*)(ws + O_WGATE), T, 12 * 256, 128, LRU, 128, 128}; E.mode = EM_GATE; E.gate_b = (const GAS float*)args.in[I_AGATEB]; break;
            case ST_G_OUT0: g = {(const GAS bf16_t*)(ws + O_CAT), (const GAS bf16_t*)(ws + O_WOUT0), T, DM, DM, DM, DM, 0}; E.mode = EM_RES; E.resid = (const GAS float*)args.in[I_X]; E.outf = (GAS float*)args.out; break;
            case ST_G_PQ0:  g = {(const GAS bf16_t*)(ws + O_XS16), (const GAS bf16_t*)(ws + O_WQ0), T, DM, DM, DM, DM, 0}; E.mode = EM_PQ; E.o16 = (GAS bf16_t*)(ws + O_Q16); break;
            case ST_G_L1:   g = {(const GAS bf16_t*)(ws + O_XS16), (const GAS bf16_t*)(ws + O_WL1), T, NL1, DM, DM, DM, 0}; E.mode = EM_L1; break;
            case ST_G_OUT1: g = {(const GAS bf16_t*)(ws + O_CAT), (const GAS bf16_t*)(ws + O_WOUT1), T, DM, DM, DM, DM, 0}; E.mode = EM_RES; E.resid = (const GAS float*)args.out; E.outf = (GAS float*)args.out; break;
            default:        g = {(const GAS bf16_t*)(ws + O_XS16), (const GAS bf16_t*)(ws + O_WQ1), T, DM, DM, DM, DM, 0}; E.mode = EM_PQ; E.o16 = (GAS bf16_t*)(ws + O_Q16); break;
            }
            pg8::StaticOrder S; S.init(g.M, g.N, G, (int)((blockIdx.x + G - shift) % G));
#ifndef DIS_GEMM
            { int tg_; MAKE_TID(tg_);
              pg8::gemm_phase<Epi, false>((LAS unsigned char*)lds, g, S, E, tg_); }
#endif
            if (st == ST_G_MKV1 && blockIdx.x >= 160) { MAKE_FRAME(F); convert_tables(F, 1, 0, CONV1_SPLIT, (blockIdx.x - 160) * NWAVES + F.wave, (G - 160) * NWAVES); }
        } else if ((ATTN_STEPS >> st) & 1u) {
            const int nun = st == ST_A_FOX ? 3 : 1;
            for (int ui = 0; ui < nun; ++ui) {
                att::BlockRef r;
                if (st == ST_A_FOX) {
                    const int i = blockIdx.x, x = i & 15, bh = (i >> 4) + 16 * ui, qb = ui == 0 ? x : (ui == 1 ? 15 - x : ((x * 5 + 3) & 15));
                    const int b = bh / NH, h = bh % NH; const size_t row0 = (size_t)b * SEQ + qb * 256;
                    const GAS bf16_t* z = (const GAS bf16_t*)(ws + O_ZL1);
                    r.Q = z + row0 * NL1 + 3072 + h * 128; r.K = z + (size_t)b * SEQ * NL1 + h * 128; r.V = z + (size_t)b * SEQ * NL1 + 1536 + h * 128;
                    r.O = (GAS bf16_t*)(ws + O_CAT) + row0 * DM + h * 128;
                    const GAS float* ss = (const GAS float*)(ws + O_SSL1);
                    r.qss = ss + row0 * 112 + (12 + h) * 4; r.kss = ss + (size_t)b * SEQ * 112 + h * 4; r.cc = (const GAS float*)(ws + O_CC) + (size_t)bh * SEQ; r.gg = (const GAS float*)(ws + O_GG) + 384;
                    r.P0 = qb * 256; r.skv = SEQ;
                } else {
                    const int l = st == ST_A_MEM0 ? 0 : 1; const int i = blockIdx.x, qblk = i >> 2, h = i & 3, b = qblk >> 4; const size_t row0 = (size_t)qblk * 256;
                    r.Q = (const GAS bf16_t*)(ws + O_ZL1) + row0 * NL1 + 4608 + h * 128; r.qss = (const GAS float*)(ws + O_SSL1) + row0 * 112 + (24 + h) * 4;
                    const GAS bf16_t* kv = (const GAS bf16_t*)(ws + O_MKV) + ((size_t)l * NMROW + b * NMEM) * NL1;
                    r.K = kv + h * 128; r.V = kv + 512 + h * 128; r.kss = (const GAS float*)(ws + O_MKSS) + ((size_t)l * NMROW + b * NMEM) * 112 + h * 4;
                    r.O = (GAS bf16_t*)(ws + O_CAT) + row0 * DM + LRU + h * 128; r.cc = nullptr; r.gg = (const GAS float*)(ws + O_GG) + 128 * (1 + l);
                    r.P0 = SEQ; r.skv = NMEM;
                }
                att::Seam S;
                int tid_u; MAKE_TID(tid_u);
#ifndef DIS_ATTN
                att::attn_prime(r, (char*)lds, S, tid_u);
                att::attn_block(r, (char*)lds, S, tid_u);
#endif
            }
        } else {
            MAKE_FRAME(F);
            switch (st) {
#ifndef DIS_MISC
            case ST_PROLOGUE: step_prologue(F, (LAS unsigned char*)lds); break;
            case ST_CONV: step_conv(F); break;
            case ST_SCAN1: step_scan1(F); break;
            case ST_SCAN2: step_scan2(F); break;
#endif
#ifndef DIS_TOPK
            case ST_TOPK0: step_topk(F, (LAS unsigned char*)lds, 0); step_xplanes(F); break;
            case ST_TOPK1: step_topk(F, (LAS unsigned char*)lds, 1); step_xplanes(F); break;
#endif
#ifndef DIS_GATHER
            case ST_UPASS0: step_upass(F, 0, G); break;
            case ST_UPASS1: step_upass(F, 1, G); break;
            case ST_PRED0: step_peer_reduce(F, 0); break;
            case ST_PRED1: step_peer_reduce(F, 1); break;
            case ST_VPASS0: step_vpass(F, 0, G, rep + 1 < nrep); break;
            case ST_VPASS1: step_vpass(F, 1, G, rep + 1 < nrep); break;
#endif
#ifndef DIS_MISC
            case ST_CPREFIX: step_cprefix(F, (LAS unsigned char*)lds); convert_tables(F, 1, G > 160 ? CONV1_SPLIT : 0, 2 * NEXP, F.gw, F.ngw); break;
#endif
            default: break;
            }
        }
        if (rep + 1 < nrep) xcd_barrier(gbar, wave_s);
      }
        if (((SYNC_AFTER >> st) & 1u) && st + 1 < args.hi) xcd_barrier(gbar, wave_s);
    }
}

#ifndef N_LAUNCH_MODE
#define N_LAUNCH_MODE 1
#endif
extern "C" void kernel_launch(void* const* d_in, const int* in_sizes, int n_in, void* d_out, int out_size, void* d_ws, size_t ws_size, hipStream_t stream) {
    static int grid = 0;
    if (grid == 0) {
        if (n_in != N_IN || in_sizes[0] != T * DM || out_size != T * DM || ws_size < WS_END) {
            fprintf(stderr, "kernel_launch: unexpected shapes (n_in %d, in0 %d, out %d, ws %zu, need %zu)\n", n_in, n_in > 0 ? in_sizes[0] : -1, out_size, ws_size, (size_t)WS_END); grid = -1; return; }
        int dev = 0, cus = 0, per_cu = 0;
        hipGetDevice(&dev); hipDeviceGetAttribute(&cus, hipDeviceAttributeMultiprocessorCount, dev);
        hipFuncSetAttribute((const void*)yoco_fwd, hipFuncAttributeMaxDynamicSharedMemorySize, LDS_BYTES);
        hipOccupancyMaxActiveBlocksPerMultiprocessor(&per_cu, (const void*)yoco_fwd, NTHREADS, LDS_BYTES);
        if (per_cu < 1) { fprintf(stderr, "kernel_launch: occupancy query says %d blocks per CU\n", per_cu); grid = -1; return; }
        grid = cus - cus % 8;
        (void)hipGetLastError();
    }
    if (grid < 0) return;
    Args a{};
    for (int i = 0; i < N_IN; ++i) a.in[i] = (const float*)d_in[i];
    a.out = (float*)d_out; a.ws = (unsigned char*)d_ws;
    if (hipMemsetAsync((char*)d_ws + O_CTL, 0, 65536, stream) != hipSuccess) { fprintf(stderr, "kernel_launch: memset of the barrier words failed\n"); return; }
    if (N_LAUNCH_MODE == 1) {
        a.lo = 0; a.hi = N_STEPS;
        hipLaunchKernelGGL(yoco_fwd, dim3(grid), dim3(NTHREADS), LDS_BYTES, stream, a);
        hipError_t e = hipPeekAtLastError();
        if (e != hipSuccess) fprintf(stderr, "launch failed: %s (grid %d)\n", hipGetErrorString(e), grid);
    } else {
        int lo = 0;
        for (int s = 0; s < N_STEPS; ++s) {
            if (((SYNC_AFTER >> s) & 1u) || s == N_STEPS - 1) {
                a.lo = lo; a.hi = s + 1; lo = s + 1;
                void* params[] = {&a};
                hipError_t e = hipLaunchCooperativeKernel((const void*)yoco_fwd, dim3(grid), dim3(NTHREADS), params, LDS_BYTES, stream);
                if (e != hipSuccess) { fprintf(stderr, "launch failed: %s\n", hipGetErrorString(e)); break; }
            }
        }
    }
}
```

```cpp
#include <hip/hip_runtime.h>
#include <hip/hip_cooperative_groups.h>
#include <cstdio>
#include <cstdint>
namespace cg = cooperative_groups;

#define LAS __attribute__((address_space(3)))
#define GAS __attribute__((address_space(1)))
typedef unsigned short bf16_t;
typedef short bf16x8 __attribute__((ext_vector_type(8)));
typedef short s16x4 __attribute__((ext_vector_type(4)));
typedef float f32x4 __attribute__((ext_vector_type(4)));
typedef float f32x2 __attribute__((ext_vector_type(2)));
typedef float f32x16 __attribute__((ext_vector_type(16)));
typedef unsigned u32x4 __attribute__((ext_vector_type(4)));
typedef unsigned u32x2 __attribute__((ext_vector_type(2)));
typedef _Float16 h2 __attribute__((ext_vector_type(2)));

constexpr int NB = 4, SEQ = 4096, T = NB * SEQ, DM = 2048, LRU = 1536, MEMW = 512, NMEM = 256, NH = 12, HD = 128;
constexpr int NIN0 = 3584, NL1 = 5120, NEXP = 16384, NMROW = NB * NMEM;
constexpr float EPS = 1e-6f;
constexpr int NTHREADS = 512, NWAVES = 8;

constexpr size_t MiB = 1u << 20;
constexpr size_t O_CTL = 0;
constexpr size_t O_WIN0 = 1 * MiB;
constexpr size_t O_WOUT0 = O_WIN0 + 14 * MiB;
constexpr size_t O_WL1 = O_WOUT0 + 8 * MiB;
constexpr size_t O_WOUT1 = O_WL1 + 20 * MiB;
constexpr size_t O_WQ0 = O_WOUT1 + 8 * MiB;
constexpr size_t O_WQ1 = O_WQ0 + 8 * MiB;
constexpr size_t O_WMKV = O_WQ1 + 8 * MiB;
constexpr size_t O_WGATE = O_WMKV + 8 * MiB;
constexpr size_t O_SUBK = O_WGATE + 1 * MiB;
constexpr size_t O_WF = O_SUBK + 1 * MiB;
constexpr size_t O_SMALL = O_WF + 1 * MiB;
constexpr size_t O_RS1 = O_SMALL;
constexpr size_t O_LOGF = O_SMALL + 64 * 1024;
constexpr size_t O_CC = O_LOGF + 768 * 1024;
constexpr size_t O_GG = O_CC + 768 * 1024;
constexpr size_t O_SPL = O_GG + 4096;
constexpr size_t O_TSC = O_SPL + 8192;
constexpr size_t O_ROWSS = O_SMALL + 2 * MiB;
constexpr size_t O_RSP = O_ROWSS + 2 * MiB;
constexpr size_t O_QMSS = O_RSP;
constexpr size_t O_MKSS = O_QMSS + 1 * MiB;
constexpr size_t O_SSL1 = O_MKSS + 1 * MiB;
constexpr size_t O_CARRY = O_SSL1 + 7 * MiB;
constexpr size_t O_MEMN = O_CARRY + 3 * MiB;
constexpr size_t O_MKV = O_MEMN + 8 * MiB;
constexpr size_t O_IDX = O_MKV + 20 * MiB;
constexpr size_t O_GW = O_IDX + 8 * MiB;
constexpr size_t O_TAB = O_GW + 8 * MiB;
constexpr size_t TAB_NIB = (size_t)8 * 16384 * 128, TAB_ONE = TAB_NIB + (size_t)16384 * 16 + 786432;
constexpr size_t O_XS16 = O_TAB + 128 * MiB;
constexpr size_t O_CAT = O_XS16 + 64 * MiB;
constexpr size_t O_ZX = O_CAT + 64 * MiB;
constexpr size_t O_X8 = O_ZX;
constexpr size_t O_GY = O_ZX + 48 * MiB;
constexpr size_t O_LOGFP = O_GY + 48 * MiB;
constexpr size_t O_QM = O_LOGFP;
constexpr size_t O_XC = O_QM + 16 * MiB;
constexpr size_t O_X4 = O_XC;
constexpr size_t O_SX = O_XC + 32 * MiB;
constexpr size_t O_AA = O_XC + 48 * MiB;
constexpr size_t O_PART = O_AA;
constexpr size_t O_UU = O_AA + 96 * MiB;
constexpr size_t O_PK = O_UU;
constexpr size_t O_Q16 = O_UU + 96 * MiB;
constexpr size_t O_ZL1 = O_Q16 + 64 * MiB;
constexpr size_t WS_END = O_ZL1 + 160 * MiB;
static_assert(WS_END <= 1024 * MiB, "workspace map");

__device__ __forceinline__ unsigned cvtpk(float lo, float hi) { unsigned r; asm volatile("v_cvt_pk_bf16_f32 %0, %1, %2" : "=v"(r) : "v"(lo), "v"(hi)); return r; }
__device__ __forceinline__ float bf_lo(unsigned w) { return __uint_as_float(w << 16); }
__device__ __forceinline__ float bf_hi(unsigned w) { return __uint_as_float(w & 0xffff0000u); }
__device__ __forceinline__ float fast_exp(float x) { return __builtin_amdgcn_exp2f(x * 1.4426950408889634f); }
__device__ __forceinline__ float log1p_pos(float y) { const float ser = y * (1.f - y * (0.5f - y * (0.33333334f - 0.25f * y))); const float lg = __builtin_amdgcn_logf(1.f + y) * 0.6931471805599453f; return y < 0.03f ? ser : lg; }
__device__ __forceinline__ float one_minus_exp(float x) { const float ser = -x * (1.f + x * (0.5f + x * (0.16666667f + x * 0.041666668f))); const float big = 1.f - fast_exp(x); return x > -0.03f ? ser : big; }
__device__ __forceinline__ float sigmoidf_(float x) { return __builtin_amdgcn_rcpf(1.f + fast_exp(-x)); }
__device__ __forceinline__ float gelu_tanh(float x) { const float u = x * (1.f + 0.044715f * x * x); return x * __builtin_amdgcn_rcpf(1.f + __builtin_amdgcn_exp2f(u * (-2.f * 0.7978845608028654f * 1.4426950408889634f))); }
template <int CTRL> __device__ __forceinline__ float dppf(float v) { return __int_as_float(__builtin_amdgcn_update_dpp(0, __float_as_int(v), CTRL, 0xF, 0xF, true)); }
__device__ __forceinline__ float xsum16(float v) { auto r = __builtin_amdgcn_permlane16_swap(__float_as_uint(v), __float_as_uint(v), false, false); return __uint_as_float(r[0]) + __uint_as_float(r[1]); }
__device__ __forceinline__ float xsum32(float v) { auto r = __builtin_amdgcn_permlane32_swap(__float_as_uint(v), __float_as_uint(v), false, false); return __uint_as_float(r[0]) + __uint_as_float(r[1]); }
__device__ __forceinline__ float xmax16(float v) { auto r = __builtin_amdgcn_permlane16_swap(__float_as_uint(v), __float_as_uint(v), false, false); return fmaxf(__uint_as_float(r[0]), __uint_as_float(r[1])); }
__device__ __forceinline__ float xmax32(float v) { auto r = __builtin_amdgcn_permlane32_swap(__float_as_uint(v), __float_as_uint(v), false, false); return fmaxf(__uint_as_float(r[0]), __uint_as_float(r[1])); }
__device__ __forceinline__ float wave_sum(float v) {
    v += dppf<0xB1>(v); v += dppf<0x4E>(v); v += dppf<0x141>(v); v += dppf<0x140>(v);
    v = xsum16(v); v = xsum32(v); return v;
}
__device__ __forceinline__ float wave_max(float v) {
    v = fmaxf(v, dppf<0xB1>(v)); v = fmaxf(v, dppf<0x4E>(v)); v = fmaxf(v, dppf<0x141>(v)); v = fmaxf(v, dppf<0x140>(v));
    v = xmax16(v); v = xmax32(v); return v;
}

namespace pg8 {
constexpr int BM = 256, BK = 64, HALF = 128, HTB = HALF * BK * 2, STAGE_BYTES = 8 * HTB, NXCD = 8, WGM = 8;
__host__ __device__ __forceinline__ int lds_byte(int r, int c) { const int st = (r >> 4) * 2 + (c >> 5), rr = r & 15, cc = c & 31, ob = rr * 64 + cc * 2; return st * 1024 + (ob ^ (((ob >> 9) & 1) << 5)); }
__host__ __device__ __forceinline__ void stage_rc(int b, int& R, int& C) { const int st = b / 1024, sb = b % 1024, swz = sb ^ (((sb >> 9) & 1) << 5); R = (st >> 1) * 16 + swz / 64; C = (st & 1) * 32 + (swz % 64) / 2; }
__host__ __device__ __forceinline__ int perm32(int rho) { const int n = rho >> 4, i = rho & 15; return 8 * (i >> 2) + 4 * n + (i & 3); }

struct Unit { int pm, pn; };
struct Gemm { const GAS bf16_t* A; const GAS bf16_t* Bt; int M, N, K, lda, ldb, acol; };

struct StaticOrder {
    int nM, nN, nwg, G, c;
    __device__ void init(int M, int N, int G_, int c_) { nM = M / BM; nN = N / BM; nwg = nM * nN; G = G_; c = c_; }
    __device__ bool next(int i, Unit& u) const {
        const long L = (long)i * G + c; if (L >= nwg) return false;
        int wgid = (int)L; { const int q = nwg / NXCD, r = nwg % NXCD, xcd = wgid % NXCD, off = wgid / NXCD; wgid = (xcd < r ? xcd * (q + 1) : r * (q + 1) + (xcd - r) * q) + off; }
        const int nig = WGM * nN, gid = wgid / nig, fm = gid * WGM, gsz = (nM - fm) < WGM ? (nM - fm) : WGM;
        u.pm = fm + ((wgid % nig) % gsz); u.pn = (wgid % nig) / gsz; return true;
    }
};

typedef int v8i_t __attribute__((ext_vector_type(8)));
typedef int v4i_t __attribute__((ext_vector_type(4)));
template <class Epi, bool FP8>
__device__ __forceinline__ void gemm_phase(LAS unsigned char* lds, const Gemm g, const StaticOrder& S, const Epi& E, const int tid) {
    const int wid = __builtin_amdgcn_readfirstlane(tid >> 6), lane = tid & 63, wr = wid >> 2, wc = wid & 3, fr = lane & 15, fq = lane >> 4;
    const int K = g.K, nt = K / BK;
    unsigned voffA[2], voffB[2];
#pragma unroll
    for (int i = 0; i < 2; ++i) { int R, C; stage_rc(tid * 16 + i * 8192, R, C); const int Rb = (R & ~31) + perm32(R & 31);
        voffA[i] = (unsigned)(R * g.lda + C) * 2u; voffB[i] = (unsigned)(Rb * g.ldb + C) * 2u; }
    const size_t kstep = (size_t)(BK * 2);
    const size_t hstepA = (size_t)HALF * g.lda * 2, hstepB = (size_t)HALF * g.ldb * 2;
    const size_t tstepA = 2 * hstepA, tstepB = 2 * hstepB;
    const unsigned ldsw = (unsigned)wid * 1024u;
    const int aoff = lds_byte(wr * 64 + fr, fq * 8), boff = lds_byte(wc * 32 + fr, fq * 8);
#define PG8_SA(b, h) (((b) * 2 + (h)) * HTB)
#define PG8_SB(b, h) ((4 + (b) * 2 + (h)) * HTB)
#define PG8_STAGE(bufoff, gbase, voff) do { _Pragma("unroll") for (int _i = 0; _i < 2; ++_i) \
        __builtin_amdgcn_global_load_lds((const GAS unsigned*)((gbase) + (voff)[_i]), (LAS unsigned*)(lds + (bufoff) + ldsw + _i * 8192), 16, 0, 0); } while (0)
#define PG8_LD2(dst, off_) do { const u32x4 lo_ = *(const LAS u32x4*)(lds + (off_)), hi_ = *(const LAS u32x4*)(lds + (off_) + 1024); \
        dst = (v8i_t){(int)lo_.x, (int)lo_.y, (int)lo_.z, (int)lo_.w, (int)hi_.x, (int)hi_.y, (int)hi_.z, (int)hi_.w}; } while (0)
#define PG8_LDA(dst, b, h) do { _Pragma("unroll") for (int m = 0; m < 4; ++m) PG8_LD2(dst[m], PG8_SA(b, h) + aoff + m * 2048); } while (0)
#define PG8_LDB(dst, b, h) do { _Pragma("unroll") for (int n = 0; n < 2; ++n) PG8_LD2(dst[n], PG8_SB(b, h) + boff + n * 2048); } while (0)
#define PG8_HALF(v, k) ((k) ? __builtin_shufflevector(v, v, 4, 5, 6, 7) : __builtin_shufflevector(v, v, 0, 1, 2, 3))
#define PG8_MMA(ai, bj, At, Bt) do { __builtin_amdgcn_s_setprio(1); _Pragma("unroll") for (int m = 0; m < 4; ++m) _Pragma("unroll") for (int n = 0; n < 2; ++n) { \
        if constexpr (FP8) asm volatile("v_mfma_scale_f32_16x16x128_f8f6f4 %0, %1, %2, %0, %3, %4 op_sel_hi:[0,0,0]" : "+v"(acc[ai][bj][m][n]) : "v"(Bt[n]), "v"(At[m]), "v"(sc_w), "v"(sc_x));     \
        else { _Pragma("unroll") for (int k = 0; k < 2; ++k) { const v4i_t bh_ = PG8_HALF(Bt[n], k), ah_ = PG8_HALF(At[m], k); \
                acc[ai][bj][m][n] = __builtin_amdgcn_mfma_f32_16x16x32_bf16(__builtin_bit_cast(bf16x8, bh_), __builtin_bit_cast(bf16x8, ah_), acc[ai][bj][m][n], 0, 0, 0); } } } \
        __builtin_amdgcn_s_setprio(0); } while (0)
#define PG8_WAIT_V(n) asm volatile("s_waitcnt vmcnt(" #n ")" ::: "memory")
#define PG8_WAIT_L(n) asm volatile("s_waitcnt lgkmcnt(" #n ")" ::: "memory")
#define PG8_BAR __builtin_amdgcn_s_barrier()
#define PG8_SCHED __builtin_amdgcn_sched_barrier(0)
    Unit cur, nxt; int ui = 0;
    if (!S.next(0, cur)) return;
    f32x4 acc[2][2][4][2];
#pragma unroll
    for (int a = 0; a < 2; ++a)
#pragma unroll
        for (int b = 0; b < 2; ++b)
#pragma unroll
            for (int m = 0; m < 4; ++m)
#pragma unroll
                for (int n = 0; n < 2; ++n) acc[a][b][m][n] = (f32x4){0.f, 0.f, 0.f, 0.f};
    v8i_t At[4], B0[2], B1[2];
    const int sc_w = 121, sc_x = 127;
    const GAS char* cA = (const GAS char*)g.A + (size_t)cur.pm * tstepA + (size_t)cur.pn * g.acol * 2; const GAS char* cB = (const GAS char*)g.Bt + (size_t)cur.pn * tstepB;
    PG8_STAGE(PG8_SB(0, 0), cB, voffB); PG8_STAGE(PG8_SB(0, 1), cB + hstepB, voffB); PG8_STAGE(PG8_SA(0, 0), cA, voffA); PG8_STAGE(PG8_SA(0, 1), cA + hstepA, voffA);
    if (wr == 1) PG8_BAR;
    PG8_WAIT_V(2); PG8_BAR;
    PG8_STAGE(PG8_SB(1, 0), cB + kstep, voffB); PG8_STAGE(PG8_SA(1, 0), cA + kstep, voffA); PG8_STAGE(PG8_SB(1, 1), cB + hstepB + kstep, voffB);
    PG8_WAIT_V(6); PG8_BAR;
    for (;;) {
        const bool has_next = S.next(ui + 1, nxt);
        const GAS char* nA = has_next ? (const GAS char*)g.A + (size_t)nxt.pm * tstepA + (size_t)nxt.pn * g.acol * 2 : cA; const GAS char* nB = has_next ? (const GAS char*)g.Bt + (size_t)nxt.pn * tstepB : cB;
        for (int t = 0; t < nt; t += 2) {
            const bool last = (t == nt - 2);
            const GAS char* a1 = cA + (size_t)(t + 1) * kstep;
            const GAS char* a2 = last ? nA : cA + (size_t)(t + 2) * kstep; const GAS char* b2 = last ? nB : cB + (size_t)(t + 2) * kstep;
            const GAS char* a3 = a2 + kstep; const GAS char* b3 = b2 + kstep;
            PG8_LDB(B0, 0, 0); PG8_LDB(B1, 0, 1); PG8_SCHED; PG8_LDA(At, 0, 0); PG8_STAGE(PG8_SA(1, 1), a1 + hstepA, voffA);
            PG8_WAIT_V(8); PG8_WAIT_L(0); PG8_BAR; PG8_MMA(0, 0, At, B0); PG8_MMA(0, 1, At, B1); PG8_BAR; PG8_SCHED;
            PG8_LDA(At, 0, 1); PG8_STAGE(PG8_SB(0, 0), b2, voffB); PG8_STAGE(PG8_SB(0, 1), b2 + hstepB, voffB); PG8_STAGE(PG8_SA(0, 0), a2, voffA);
            PG8_WAIT_V(8); PG8_WAIT_L(0); PG8_BAR; PG8_MMA(1, 0, At, B0); PG8_MMA(1, 1, At, B1); PG8_BAR; PG8_SCHED;
            PG8_LDB(B0, 1, 0); PG8_LDB(B1, 1, 1); PG8_SCHED; PG8_LDA(At, 1, 0); PG8_STAGE(PG8_SA(0, 1), a2 + hstepA, voffA);
            PG8_WAIT_V(8); PG8_WAIT_L(0); PG8_BAR; PG8_MMA(0, 0, At, B0); PG8_MMA(0, 1, At, B1); PG8_BAR; PG8_SCHED;
            PG8_LDA(At, 1, 1); PG8_STAGE(PG8_SB(1, 0), b3, voffB); PG8_STAGE(PG8_SB(1, 1), b3 + hstepB, voffB); PG8_STAGE(PG8_SA(1, 0), a3, voffA);
            PG8_WAIT_V(8); PG8_WAIT_L(0); PG8_BAR; PG8_MMA(1, 0, At, B0); PG8_MMA(1, 1, At, B1); PG8_BAR; PG8_SCHED;
        }
        if (wr == 0) PG8_BAR;
        { int ln_; asm volatile("v_mbcnt_lo_u32_b32 %0, -1, 0\n\tv_mbcnt_hi_u32_b32 %0, -1, %0" : "=v"(ln_));
          E(acc, cur, wr, wc, ln_ & 15, ln_ >> 4); }
        if (!has_next) break;
#pragma unroll
        for (int a = 0; a < 2; ++a)
#pragma unroll
            for (int b = 0; b < 2; ++b)
#pragma unroll
                for (int m = 0; m < 4; ++m)
#pragma unroll
                    for (int n = 0; n < 2; ++n) acc[a][b][m][n] = (f32x4){0.f, 0.f, 0.f, 0.f};
        cur = nxt; cA = nA; cB = nB; ++ui;
        if (wr == 1) PG8_BAR;
    }
    PG8_WAIT_V(0);
    PG8_BAR;
#undef PG8_SA
#undef PG8_SB
#undef PG8_STAGE
#undef PG8_LDA
#undef PG8_LDB
#undef PG8_LD2
#undef PG8_HALF
#undef PG8_MMA
#undef PG8_WAIT_V
#undef PG8_WAIT_L
#undef PG8_BAR
#undef PG8_SCHED
}
}

enum { EM_IN0 = 0, EM_MKV = 1, EM_GATE = 2, EM_RES = 3, EM_PQ = 4, EM_L1 = 5 };
struct Epi {
    int mode;
    GAS unsigned char* ws;
    const GAS float* resid;
    GAS float* outf;
    GAS bf16_t* o16;
    GAS float* ssq;
    const GAS float* gate_b;
    typedef pg8::Unit Unit;
    __device__ __forceinline__ static void st8(GAS bf16_t* p, f32x4 v0, f32x4 v1) {
        u32x4 w; w.x = cvtpk(v0[0], v0[1]); w.y = cvtpk(v0[2], v0[3]); w.z = cvtpk(v1[0], v1[1]); w.w = cvtpk(v1[2], v1[3]); *(GAS u32x4*)p = w; }
    __device__ __forceinline__ static float sq8(f32x4 a, f32x4 b) { return (a[0] * a[0] + a[1] * a[1]) + (a[2] * a[2] + a[3] * a[3]) + (b[0] * b[0] + b[1] * b[1]) + (b[2] * b[2] + b[3] * b[3]); }
    __device__ __forceinline__ void operator()(f32x4 (&acc)[2][2][4][2], const Unit& u, int wr, int wc, int fr, int fq) const {
        const int row0 = u.pm * 256 + wr * 64 + fr;
        const int cin = wc * 32 + 8 * fq;
        if (mode == EM_IN0) {
            GAS bf16_t* base; int ld, colt; int kind;
            if (u.pn < 6) { base = (GAS bf16_t*)(ws + O_ZX); ld = LRU; colt = u.pn * 256; kind = 0; }
            else if (u.pn < 12) { base = (GAS bf16_t*)(ws + O_GY); ld = LRU; colt = (u.pn - 6) * 256; kind = 1; }
            else { base = (GAS bf16_t*)(ws + O_ZL1); ld = NL1; colt = 4608 + (u.pn - 12) * 256; kind = 2; }
            GAS float* qmss = (GAS float*)(ws + O_SSL1);
#pragma unroll
            for (int ai = 0; ai < 2; ++ai)
#pragma unroll
                for (int m = 0; m < 4; ++m) { const int row = row0 + ai * 128 + m * 16;
#pragma unroll
                    for (int bj = 0; bj < 2; ++bj) { f32x4 v0 = acc[ai][bj][m][0], v1 = acc[ai][bj][m][1];
                        if (kind == 1) {
#pragma unroll
                            for (int j = 0; j < 4; ++j) { v0[j] = gelu_tanh(v0[j]); v1[j] = gelu_tanh(v1[j]); } }
                        st8(base + (size_t)row * ld + colt + bj * 128 + cin, v0, v1);
                        if (kind == 2) { float s = sq8(v0, v1); s = xsum16(s); s = xsum32(s);
                            if (fq == 0) qmss[(size_t)row * 112 + (24 + (u.pn - 12) * 2 + bj) * 4 + wc] = s; } } }
        } else if (mode == EM_MKV) {
#pragma unroll
            for (int ai = 0; ai < 2; ++ai)
#pragma unroll
                for (int m = 0; m < 4; ++m) { const int row = row0 + ai * 128 + m * 16;
#pragma unroll
                    for (int bj = 0; bj < 2; ++bj) { const f32x4 v0 = acc[ai][bj][m][0], v1 = acc[ai][bj][m][1];
                        st8(o16 + (size_t)row * NL1 + u.pn * 256 + bj * 128 + cin, v0, v1);
                        if (u.pn < 2) { float s = sq8(v0, v1); s = xsum16(s); s = xsum32(s);
                            if (fq == 0) ssq[(size_t)row * 112 + (u.pn * 2 + bj) * 4 + wc] = s; } } }
        } else if (mode == EM_GATE) {
            const int ch = u.pn * 128 + cin;
            const GAS bf16_t* xc = (const GAS bf16_t*)(ws + O_XC); GAS _Float16* LA = (GAS _Float16*)(ws + O_AA); GAS _Float16* UH = (GAS _Float16*)(ws + O_UU);
            const GAS float* spl = (const GAS float*)(ws + O_SPL) + ch; const GAS float* gb = gate_b + u.pn * 256 + cin;
#pragma unroll
            for (int n = 0; n < 2; ++n) {
                const f32x4 sp = *(const GAS f32x4*)(spl + 4 * n), br = *(const GAS f32x4*)(gb + 4 * n), bi = *(const GAS f32x4*)(gb + 128 + 4 * n);
#pragma unroll
                for (int ai = 0; ai < 2; ++ai)
#pragma unroll
                    for (int m = 0; m < 4; ++m) { const int row = row0 + ai * 128 + m * 16;
                        const u32x2 xw = *(const GAS u32x2*)(xc + (size_t)row * LRU + ch + 4 * n);
                        const f32x4 xv = {bf_lo(xw.x), bf_hi(xw.x), bf_lo(xw.y), bf_hi(xw.y)};
                        float lav[4], uvv[4];
#pragma unroll
                        for (int j = 0; j < 4; ++j) { const float r = sigmoidf_(acc[ai][0][m][n][j] + br[j]), ig = sigmoidf_(acc[ai][1][m][n][j] + bi[j]);
                            const float la = -8.f * r * sp[j];
                            lav[j] = la; uvv[j] = __builtin_amdgcn_sqrtf(one_minus_exp(2.f * la)) * (ig * xv[j]); }
                        { const h2 l0 = {(_Float16)lav[0], (_Float16)lav[1]}, l1 = {(_Float16)lav[2], (_Float16)lav[3]}, u0 = {(_Float16)uvv[0], (_Float16)uvv[1]}, u1 = {(_Float16)uvv[2], (_Float16)uvv[3]};
                          *(GAS u32x2*)(LA + (size_t)row * LRU + ch + 4 * n) = (u32x2){__builtin_bit_cast(unsigned, l0), __builtin_bit_cast(unsigned, l1)};
                          *(GAS u32x2*)(UH + (size_t)row * LRU + ch + 4 * n) = (u32x2){__builtin_bit_cast(unsigned, u0), __builtin_bit_cast(unsigned, u1)}; } }
            }
        } else if (mode == EM_RES) {
            GAS bf16_t* xs = (GAS bf16_t*)(ws + O_XS16); GAS float* rowss = (GAS float*)(ws + O_ROWSS);
#pragma unroll
            for (int ai = 0; ai < 2; ++ai)
#pragma unroll
                for (int m = 0; m < 4; ++m) { const int row = row0 + ai * 128 + m * 16; float s = 0.f;
#pragma unroll
                    for (int bj = 0; bj < 2; ++bj) { const size_t off = (size_t)row * DM + u.pn * 256 + bj * 128 + cin;
                        const f32x4 r0 = *(const GAS f32x4*)(resid + off), r1 = *(const GAS f32x4*)(resid + off + 4);
                        const f32x4 v0 = acc[ai][bj][m][0] + r0, v1 = acc[ai][bj][m][1] + r1;
                        *(GAS f32x4*)(outf + off) = v0; *(GAS f32x4*)(outf + off + 4) = v1;
                        st8(xs + off, v0, v1); s += sq8(v0, v1); }
                    s = xsum16(s); s = xsum32(s);
                    if (fq == 0) rowss[(size_t)row * 32 + u.pn * 4 + wc] = s; }
        } else if (mode == EM_PQ) {
            const GAS float* rowss = (const GAS float*)(ws + O_ROWSS);
#pragma unroll
            for (int ai = 0; ai < 2; ++ai)
#pragma unroll
                for (int m = 0; m < 4; ++m) { const int row = row0 + ai * 128 + m * 16;
                    const f32x4 p0 = *(const GAS f32x4*)(rowss + (size_t)row * 32 + fq * 8), p1 = *(const GAS f32x4*)(rowss + (size_t)row * 32 + fq * 8 + 4);
                    float s = (p0[0] + p0[1]) + (p0[2] + p0[3]) + (p1[0] + p1[1]) + (p1[2] + p1[3]); s = xsum16(s); s = xsum32(s);
                    const float r = rsqrtf(s * (1.f / DM) + EPS);
#pragma unroll
                    for (int bj = 0; bj < 2; ++bj) st8(o16 + (size_t)row * DM + u.pn * 256 + bj * 128 + cin, acc[ai][bj][m][0] * r, acc[ai][bj][m][1] * r); }
        } else {
            const GAS float* rsp = (const GAS float*)(ws + O_RSP); GAS bf16_t* zl1 = (GAS bf16_t*)(ws + O_ZL1); GAS float* ssl1 = (GAS float*)(ws + O_SSL1);
            const int slot0 = u.pn < 6 ? u.pn * 2 : (u.pn >= 12 ? 12 + (u.pn - 12) * 2 : -1);
#pragma unroll
            for (int ai = 0; ai < 2; ++ai)
#pragma unroll
                for (int m = 0; m < 4; ++m) { const int row = row0 + ai * 128 + m * 16;
                    const f32x4 q0 = *(const GAS f32x4*)(rsp + (size_t)row * 8), q1 = *(const GAS f32x4*)(rsp + (size_t)row * 8 + 4);
                    const float r = rsqrtf(((q0[0] + q0[1]) + (q0[2] + q0[3]) + (q1[0] + q1[1]) + (q1[2] + q1[3])) * (1.f / DM) + EPS);
#pragma unroll
                    for (int bj = 0; bj < 2; ++bj) { const f32x4 v0 = acc[ai][bj][m][0] * r, v1 = acc[ai][bj][m][1] * r;
                        st8(zl1 + (size_t)row * NL1 + u.pn * 256 + bj * 128 + cin, v0, v1);
                        if (slot0 >= 0) { float s = sq8(v0, v1); s = xsum16(s); s = xsum32(s);
                            if (fq == 0) ssl1[(size_t)row * 112 + (slot0 + bj) * 4 + wc] = s; } } }
        }
    }
};

namespace att {
constexpr float SCALE = 0.08838834764831845f;
constexpr int NW = 8, QBLK = 32, KVBLK = 64, QB = NW * QBLK, D = 128;
constexpr int SHM_V = KVBLK * D * 2, SHM_K = KVBLK * D * 2;
constexpr int OFF_WS = 2 * SHM_V + 2 * SHM_K;
constexpr int OFF_KS = OFF_WS + 2048;
constexpr int OFF_BS = OFF_KS + 16384;
constexpr int LDS_END = OFF_BS + 16384;
constexpr int WBIG = 1 << 28;

#define KSWZ(row, colB) ((row) * 256 + ((colB) ^ (((row) & 7) << 4)))
#define SBAR() __builtin_amdgcn_sched_barrier(0)
__device__ __forceinline__ int v_st(int k, int c) { const int kk = (k & ~0xC) | ((k & 4) << 1) | ((k & 8) >> 1); return ((kk >> 3) * 4 + (c >> 5)) * 512 + ((kk & 7) * 32 + (c & 31)) * 2; }
__device__ __forceinline__ int v_rd_base(int lane) { return ((lane & 3) << 3) | (((lane >> 2) & 3) << 6) | (((lane >> 4) & 1) << 5) | (((lane >> 5) & 1) << 8); }
constexpr int v_rd_off(int d0, int ks, int half) { return d0 * 512 + ks * 4096 + half * 2048; }
__device__ __forceinline__ int crow(int r, int hi) { return (r & 3) + 8 * (r >> 2) + 4 * hi; }
__device__ __forceinline__ bf16x8 load8(const GAS bf16_t* p) { return *(const GAS bf16x8*)p; }
__device__ __forceinline__ bf16x8 scale8(bf16x8 v, float s) { const u32x4 w = *reinterpret_cast<u32x4*>(&v); u32x4 o;
    o.x = cvtpk(bf_lo(w.x) * s, bf_hi(w.x) * s); o.y = cvtpk(bf_lo(w.y) * s, bf_hi(w.y) * s); o.z = cvtpk(bf_lo(w.z) * s, bf_hi(w.z) * s); o.w = cvtpk(bf_lo(w.w) * s, bf_hi(w.w) * s);
    return *reinterpret_cast<bf16x8*>(&o); }
__device__ __forceinline__ void mask_tile(f32x16& p0, f32x16& p1, int dq, unsigned W) {
    const float NEG = -__builtin_inff();
#pragma unroll
    for (int r = 0; r < 16; ++r) {
        const int c = (r & 3) + 8 * (r >> 2);
        if ((unsigned)(dq - c) >= W) p0[r] = NEG;
        if ((unsigned)(dq - c - 32) >= W) p1[r] = NEG;
    }
}
constexpr float THR = 8.f;
__device__ __forceinline__ void partialSM(f32x16& p0, f32x16& p1, float& m_reg, float& mn, float& alpha) {
    float pmax = p0[0]; for (int r = 1; r < 16; ++r) pmax = fmaxf(pmax, p0[r]); for (int r = 0; r < 16; ++r) pmax = fmaxf(pmax, p1[r]);
    { auto rr = __builtin_amdgcn_permlane32_swap(__float_as_uint(pmax), __float_as_uint(pmax), false, false);
      pmax = fmaxf(__uint_as_float(rr[0]), __uint_as_float(rr[1])); }
    constexpr float C2 = 1.4426950408889634f * SCALE;
    if (__builtin_expect(__all((pmax - m_reg) * SCALE <= THR), 1)) { mn = m_reg; alpha = 1.f; }
    else { mn = fmaxf(m_reg, pmax); alpha = __builtin_amdgcn_exp2f((m_reg - mn) * C2); m_reg = mn; }
    const float mnL = -mn * C2;
    for (int r = 0; r < 16; ++r) p0[r] = fmaf(p0[r], C2, mnL); for (int r = 0; r < 16; ++r) p1[r] = fmaf(p1[r], C2, mnL);
    for (int r = 0; r < 16; ++r) p0[r] = __builtin_amdgcn_exp2f(p0[r]);
}
__device__ __forceinline__ void finishSM(f32x16& p0, f32x16& p1, float alpha, float& l_reg, bf16x8& pa0, bf16x8& pa1, bf16x8& pa2, bf16x8& pa3) {
    for (int r = 0; r < 16; ++r) p1[r] = __builtin_amdgcn_exp2f(p1[r]);
    float ps = 0; for (int r = 0; r < 16; ++r) ps += p0[r]; for (int r = 0; r < 16; ++r) ps += p1[r];
    { auto rr = __builtin_amdgcn_permlane32_swap(__float_as_uint(ps), __float_as_uint(ps), false, false);
      ps = __uint_as_float(rr[0]) + __uint_as_float(rr[1]); }
    l_reg = l_reg * alpha + ps;
#define PK4(P, B_, OUT) do { unsigned a0 = cvtpk(P[B_+0], P[B_+1]), a1 = cvtpk(P[B_+2], P[B_+3]);                          \
        unsigned b0 = cvtpk(P[B_+4], P[B_+5]), b1 = cvtpk(P[B_+6], P[B_+7]);                                             \
        auto r0 = __builtin_amdgcn_permlane32_swap(a0, b0, false, false); auto r1 = __builtin_amdgcn_permlane32_swap(a1, b1, false, false); \
        u32x4 w = {r0[0], r1[0], r0[1], r1[1]}; OUT = *reinterpret_cast<bf16x8*>(&w); } while (0)
    PK4(p0, 0, pa0); PK4(p0, 8, pa1); PK4(p1, 0, pa2); PK4(p1, 8, pa3);
#undef PK4
}
template <int KB>
__device__ __forceinline__ void qkt(f32x16& p0, f32x16& p1, const char* K_lds, int r32, int hi, const bf16x8* qr, const float* bp  ) {
    { const f32x4 a = *(const f32x4*)(bp), b = *(const f32x4*)(bp + 8), c = *(const f32x4*)(bp + 16), d = *(const f32x4*)(bp + 24);
      p0 = (f32x16){a[0], a[1], a[2], a[3], b[0], b[1], b[2], b[3], c[0], c[1], c[2], c[3], d[0], d[1], d[2], d[3]}; }
    { const f32x4 a = *(const f32x4*)(bp + 32), b = *(const f32x4*)(bp + 40), c = *(const f32x4*)(bp + 48), d = *(const f32x4*)(bp + 56);
      p1 = (f32x16){a[0], a[1], a[2], a[3], b[0], b[1], b[2], b[3], c[0], c[1], c[2], c[3], d[0], d[1], d[2], d[3]}; }
    const char* kb[4];
#pragma unroll
    for (int dd = 0; dd < 4; ++dd) kb[dd] = K_lds + KB * SHM_K + KSWZ(r32, (dd * 16 + hi * 8) * 2);
#pragma unroll
    for (int d0 = 0; d0 < 8; ++d0) { const char* a = kb[d0 & 3] + (d0 >> 2) * 128;
        bf16x8 b0 = *reinterpret_cast<const bf16x8*>(a);
        bf16x8 b1 = *reinterpret_cast<const bf16x8*>(a + 32 * 256);
        p0 = __builtin_amdgcn_mfma_f32_32x32x16_bf16(b0, qr[d0], p0, 0, 0, 0);
        p1 = __builtin_amdgcn_mfma_f32_32x32x16_bf16(b1, qr[d0], p1, 0, 0, 0); }
}
template <int VB>
__device__ __forceinline__ void pv_tile(f32x16* o, int vb0, bf16x8 pa0, bf16x8 pa1, bf16x8 pa2, bf16x8 pa3) {
#define TRRD(dst, off) asm volatile("ds_read_b64_tr_b16 %0, %1 offset:%2" : "=&v"(dst) : "v"(vb0), "i"(off) : "memory")
#define PV_D0(d0) do { s16x4 l0, l1, l2, l3, h0, h1, h2_, h3; constexpr int b_ = VB * SHM_V + v_rd_off(d0, 0, 0); \
        TRRD(l0, b_); TRRD(h0, b_ + 2048); TRRD(l1, b_ + 4096); TRRD(h1, b_ + 6144); TRRD(l2, b_ + 8192); TRRD(h2_, b_ + 10240); TRRD(l3, b_ + 12288); TRRD(h3, b_ + 14336); \
        asm volatile("s_waitcnt lgkmcnt(0)" ::: "memory"); SBAR();   \
        o[d0] = __builtin_amdgcn_mfma_f32_32x32x16_bf16(pa0, (bf16x8){l0[0], l0[1], l0[2], l0[3], h0[0], h0[1], h0[2], h0[3]}, o[d0], 0, 0, 0);   \
        o[d0] = __builtin_amdgcn_mfma_f32_32x32x16_bf16(pa1, (bf16x8){l1[0], l1[1], l1[2], l1[3], h1[0], h1[1], h1[2], h1[3]}, o[d0], 0, 0, 0);   \
        o[d0] = __builtin_amdgcn_mfma_f32_32x32x16_bf16(pa2, (bf16x8){l2[0], l2[1], l2[2], l2[3], h2_[0], h2_[1], h2_[2], h2_[3]}, o[d0], 0, 0, 0);   \
        o[d0] = __builtin_amdgcn_mfma_f32_32x32x16_bf16(pa3, (bf16x8){l3[0], l3[1], l3[2], l3[3], h3[0], h3[1], h3[2], h3[3]}, o[d0], 0, 0, 0); } while (0)
    PV_D0(0); PV_D0(1); PV_D0(2); PV_D0(3);
#undef PV_D0
#undef TRRD
}

struct BlockRef { const GAS bf16_t* Q; const GAS bf16_t* K; const GAS bf16_t* V; GAS bf16_t* O; const GAS float* qss; const GAS float* kss; const GAS float* cc; const GAS float* gg;
                  int P0, skv; };
constexpr int LDQ = 5120, LDK = 5120, LDO = 2048, LDSS = 112;
struct Seam { bf16x8 qr[8]; bf16x8 st_v0, st_v1, st_k0, st_k1; int jlo; };
#define ROWK(p, k0, rr) ((p) + (size_t)((k0) + (rr)) * LDK + sc)
#define VMW() asm volatile("s_waitcnt vmcnt(0)" ::: "memory")
#define VMWN(n) asm volatile("s_waitcnt vmcnt(%0)" :: "i"(n) : "memory")
#define SLOAD_H(Kp, Vp, k0) do { S.st_v0 = load8(ROWK(Vp, k0, sr)); S.st_v1 = load8(ROWK(Vp, k0, 32 + sr));              \
                         S.st_k0 = load8(ROWK(Kp, k0, sr)); S.st_k1 = load8(ROWK(Kp, k0, 32 + sr)); } while (0)
#define SWRITE_HK(bf, k0) do { *(bf16x8*)(K_lds + (bf) * SHM_K + kws) = scale8(S.st_k0, ksr[(k0)]); *(bf16x8*)(K_lds + (bf) * SHM_K + kws + 32 * 256) = scale8(S.st_k1, ksr[(k0) + 32]); } while (0)
#define SWRITE_HV(bf) do { *(bf16x8*)(V_lds + (bf) * SHM_V + vst0) = S.st_v0; *(bf16x8*)(V_lds + (bf) * SHM_V + vst1) = S.st_v1; } while (0)
#define SWRITE_H(bf, k0) do { SWRITE_HV(bf); SWRITE_HK(bf, k0); } while (0)

__device__ __forceinline__ void attn_prime(const BlockRef& cur, char* lds, Seam& S, const int tid) {
    const int wid = __builtin_amdgcn_readfirstlane(tid >> 6), lane = tid & 63, r32 = lane & 31, hi = lane >> 5;
    const int sr = tid >> 4, sc = (tid & 15) * 8, kws = KSWZ(sr, sc * 2); char* K_lds = lds + 2 * SHM_V;
    float* ks_l = (float*)(lds + OFF_KS); float* bs_l = (float*)(lds + OFF_BS); const float* ksr = ks_l + sr;
    int j_hi = (cur.P0 + QB - 1) / KVBLK + 1; if (j_hi > cur.skv / KVBLK) j_hi = cur.skv / KVBLK;
    const int nkeys = j_hi * KVBLK;
    const float c0 = cur.cc ? cur.cc[cur.P0] : 0.f;
    int jlo = 0;
    if (cur.cc) { const float thr = cur.gg[128]; const int jd = cur.P0 / KVBLK;
        const float cv = lane <= jd ? cur.cc[lane * KVBLK + KVBLK - 1] : 0.f;
        const bool keep = lane > jd || (c0 - cv > -thr);
        jlo = __ffsll((long long)__ballot(keep)) - 1; }
    S.jlo = jlo;
    for (int s = jlo * KVBLK + tid; s < nkeys; s += NTHREADS) {
        const f32x4 p = *(const GAS f32x4*)(cur.kss + (size_t)s * LDSS);
        ks_l[s] = rsqrtf(((p[0] + p[1]) + (p[2] + p[3])) * (1.f / 128.f) + EPS);
        bs_l[s] = cur.cc ? (c0 - cur.cc[s]) * (1.f / SCALE) : 0.f;
    }
    __syncthreads();
    const int qrow = wid * QBLK + r32;
    const f32x4 qp = *(const GAS f32x4*)(cur.qss + (size_t)qrow * LDSS);
    const float rq = rsqrtf(((qp[0] + qp[1]) + (qp[2] + qp[3])) * (1.f / 128.f) + EPS);
#pragma unroll
    for (int d0 = 0; d0 < 8; ++d0) {
        const u32x4 w = *(const GAS u32x4*)(cur.Q + (size_t)qrow * LDQ + d0 * 16 + hi * 8);
        const f32x4 g0 = *(const GAS f32x4*)(cur.gg + d0 * 16 + hi * 8), g1 = *(const GAS f32x4*)(cur.gg + d0 * 16 + hi * 8 + 4);
        u32x4 o; o.x = cvtpk(bf_lo(w.x) * rq * g0[0], bf_hi(w.x) * rq * g0[1]); o.y = cvtpk(bf_lo(w.y) * rq * g0[2], bf_hi(w.y) * rq * g0[3]);
        o.z = cvtpk(bf_lo(w.z) * rq * g1[0], bf_hi(w.z) * rq * g1[1]); o.w = cvtpk(bf_lo(w.w) * rq * g1[2], bf_hi(w.w) * rq * g1[3]);
        S.qr[d0] = *reinterpret_cast<bf16x8*>(&o);
    }
    SLOAD_H(cur.K, cur.V, jlo * KVBLK); VMW(); SWRITE_HK(0, jlo * KVBLK);
    __syncthreads();
}
__device__ __forceinline__ void attn_block(const BlockRef& cur, char* lds, Seam& S, const int tid) {
    const int wid = __builtin_amdgcn_readfirstlane(tid >> 6), lane = tid & 63, r32 = lane & 31, hi = lane >> 5;
    const int W = WBIG;
    int j_hi = (cur.P0 + QB - 1) / KVBLK + 1; if (j_hi > cur.skv / KVBLK) j_hi = cur.skv / KVBLK;
    const int j_lo = S.jlo; const int NT = j_hi - j_lo;
    const int qlo = cur.P0 - j_lo * KVBLK + wid * QBLK, qm = qlo + r32 - 4 * hi;
    char* V_lds = lds; char* K_lds = lds + 2 * SHM_V;
    float* ws = (float*)(lds + OFF_WS) + wid * 64; float* li_l = ws, * al_l = ws + 32;
    const float* bs_l = (const float*)(lds + OFF_BS) + j_lo * KVBLK + 4 * hi;
    float m_reg = -1e30f, l_reg = 0; f32x16 o[4] = {};
    const int sr = tid >> 4, sc = (tid & 15) * 8, vst0 = v_st(sr, sc), vst1 = v_st(32 + sr, sc), kws = KSWZ(sr, sc * 2);
    const float* ksr = (const float*)(lds + OFF_KS) + j_lo * KVBLK + sr;
    const int vb0 = (int)(uintptr_t)V_lds + v_rd_base(lane);
    const GAS bf16_t* Kh = cur.K + (size_t)j_lo * KVBLK * LDK; const GAS bf16_t* Vh = cur.V + (size_t)j_lo * KVBLK * LDK;
#define RESC(a) do { if (__any((a) < 1.f)) { if (hi == 0) al_l[r32] = (a); asm volatile("s_waitcnt lgkmcnt(0)" ::: "memory");              \
                     for (int d_ = 0; d_ < 4; ++d_) for (int r = 0; r < 16; ++r) o[d_][r] *= al_l[crow(r, hi)]; } } while (0)
#define KBASE(t) ((t) * KVBLK)
#define MASKT(P0_, P1_, t) do { const int kb_ = KBASE(t); if (kb_ + KVBLK - 1 > qlo) mask_tile(P0_, P1_, qm - kb_, (unsigned)W); } while (0)
    f32x16 pA0, pA1, pB0, pB1; float mnA, mnB, alA, alB; bf16x8 pa0, pa1, pa2, pa3;
    SWRITE_HV(0); SBAR();
    if (NT > 1) { SLOAD_H(Kh, Vh, KBASE(1)); }
    SBAR(); qkt<0>(pA0, pA1, K_lds, r32, hi, S.qr, bs_l + KBASE(0));
    MASKT(pA0, pA1, 0); partialSM(pA0, pA1, m_reg, mnA, alA);
    if (NT > 1) { VMW(); SWRITE_H(1, KBASE(1)); }
    __syncthreads();
#define HALF_STEP(PX0, PX1, mnX, alX, PY0, PY1, alY, t, KB, VB, SB) do {                                                      \
        SBAR(); qkt<KB>(PX0, PX1, K_lds, r32, hi, S.qr, bs_l + KBASE(t));                                                         \
        finishSM(PY0, PY1, alY, l_reg, pa0, pa1, pa2, pa3); SBAR();                                                           \
        if ((t) + 1 < NT) { SLOAD_H(Kh, Vh, KBASE((t) + 1)); SBAR(); }                                               \
        pv_tile<VB>(o, vb0, pa0, pa1, pa2, pa3); MASKT(PX0, PX1, (t)); partialSM(PX0, PX1, m_reg, mnX, alX);                                        \
        __syncthreads();                                                                                                      \
        if ((t) + 1 < NT) { VMW(); SWRITE_H(SB, KBASE((t) + 1)); }                                                                          \
        RESC(alX); __syncthreads(); } while (0)
    for (int t = 1; t + 1 < NT; t += 2) {
        HALF_STEP(pB0, pB1, mnB, alB, pA0, pA1, alA, t, 1, 0, 0);
        HALF_STEP(pA0, pA1, mnA, alA, pB0, pB1, alB, t + 1, 0, 1, 1);
    }
    const bool even = (NT & 1) == 0;
    if (even) { SBAR(); qkt<1>(pB0, pB1, K_lds, r32, hi, S.qr, bs_l + KBASE(NT - 1)); SBAR(); }
    finishSM(pA0, pA1, alA, l_reg, pa0, pa1, pa2, pa3); SBAR();
    pv_tile<0>(o, vb0, pa0, pa1, pa2, pa3);
    if (even) { MASKT(pB0, pB1, NT - 1); partialSM(pB0, pB1, m_reg, mnB, alB); __syncthreads(); RESC(alB);
        finishSM(pB0, pB1, alB, l_reg, pa0, pa1, pa2, pa3); SBAR(); pv_tile<1>(o, vb0, pa0, pa1, pa2, pa3); }
    SBAR();
    if (hi == 0) li_l[r32] = l_reg; asm volatile("s_waitcnt lgkmcnt(0)" ::: "memory");
    float rli[16];
#pragma unroll
    for (int r = 0; r < 16; ++r) rli[r] = __builtin_amdgcn_rcpf(li_l[crow(r, hi)]);
    GAS bf16_t* Ow = cur.O + (size_t)(wid * QBLK) * LDO;
#pragma unroll
    for (int r = 0; r < 16; ++r) { const int orow = crow(r, hi);
#pragma unroll
        for (int d0 = 0; d0 < 4; ++d0) { const float v = o[d0][r] * rli[r];
            const float vn = dppf<0xB1>(v);
            if ((r32 & 1) == 0) *(GAS unsigned*)(Ow + (size_t)orow * LDO + d0 * 32 + r32) = cvtpk(v, vn); } }
    __syncthreads();
#undef RESC
#undef KBASE
#undef MASKT
#undef HALF_STEP
}
#undef ROWK
#undef VMW
#undef VMWN
#undef SLOAD_H
#undef SWRITE_HK
#undef SWRITE_HV
#undef SWRITE_H
#undef KSWZ
#undef SBAR
}


struct Frame {
    GAS unsigned char* ws; const float* const* in_; GAS float* out;
    __device__ __forceinline__ const GAS float* in(int i) const { return (const GAS float*)in_[i]; }
    int tid, lane, wave, gw, ngw, gtid, ngt;
};
enum { I_X = 0, I_MEM, I_ANORM, I_AWIN, I_ACONVW, I_ACONVB, I_AGATEW, I_AGATEB, I_ALAMBDA, I_AWOUT, I_SNORM, I_SWKVF, I_SBF, I_SKNORM, I_BNORM, I_BWIN, I_BQNORM, I_BWOUT,
       I_MNORM, I_MWKV, I_MQNORM, I_MKNORM, I_PNORM, I_PWQ, I_PSUBK, I_PU, I_PV, N_IN };

__device__ __forceinline__ void transpose_item(const GAS float* W, int ldw, int coff, const GAS float* gain, GAS bf16_t* WT, int ldt, int row_off, LAS float* scr, int nblk, int item, int lane) {
    const int kb = item / nblk, nb = item % nblk, k0 = 64 * kb, n0 = 32 * nb;
    float wv[32];
#pragma unroll
    for (int i = 0; i < 32; ++i) wv[i] = W[(size_t)(k0 + 2 * i + (lane >> 5)) * ldw + coff + n0 + (lane & 31)];
    if (gain) {
#pragma unroll
        for (int i = 0; i < 32; ++i) wv[i] *= gain[k0 + 2 * i + (lane >> 5)]; }
#pragma unroll
    for (int i = 0; i < 32; ++i) scr[(2 * i + (lane >> 5)) * 33 + (lane & 31)] = wv[i];
    asm volatile("s_waitcnt lgkmcnt(0)" ::: "memory");
    const int c = lane & 7;
#pragma unroll
    for (int j = 0; j < 4; ++j) { const int n = (lane >> 3) + 8 * j; const LAS float* s = scr + (8 * c) * 33 + n;
        u32x4 o; o.x = cvtpk(s[0 * 33], s[1 * 33]); o.y = cvtpk(s[2 * 33], s[3 * 33]); o.z = cvtpk(s[4 * 33], s[5 * 33]); o.w = cvtpk(s[6 * 33], s[7 * 33]);
        *(GAS u32x4*)(WT + (size_t)(row_off + n0 + n) * ldt + k0 + 8 * c) = o; }
    asm volatile("s_waitcnt lgkmcnt(0)" ::: "memory");
}
__device__ __forceinline__ void transpose_item_fp8(const GAS float* W, int ldw, const GAS float* gain, GAS unsigned char* WT, int ldt, LAS float* scr, int nblk, int item, int lane) {
    const int kb = item / nblk, nb = item % nblk, k0 = 64 * kb, n0 = 32 * nb;
    float wv[32];
#pragma unroll
    for (int i = 0; i < 32; ++i) wv[i] = W[(size_t)(k0 + 2 * i + (lane >> 5)) * ldw + n0 + (lane & 31)];
#pragma unroll
    for (int i = 0; i < 32; ++i) wv[i] *= gain[k0 + 2 * i + (lane >> 5)] * 64.f;
#pragma unroll
    for (int i = 0; i < 32; ++i) scr[(2 * i + (lane >> 5)) * 33 + (lane & 31)] = wv[i];
    asm volatile("s_waitcnt lgkmcnt(0)" ::: "memory");
    const int c = lane & 3;
#pragma unroll
    for (int j = 0; j < 2; ++j) { const int n = (lane >> 2) + 16 * j; const LAS float* sp = scr + (16 * c) * 33 + n; u32x4 o;
#pragma unroll
        for (int w = 0; w < 4; ++w) { int pk = __builtin_amdgcn_cvt_pk_fp8_f32(sp[(4 * w) * 33], sp[(4 * w + 1) * 33], 0, false); pk = __builtin_amdgcn_cvt_pk_fp8_f32(sp[(4 * w + 2) * 33], sp[(4 * w + 3) * 33], pk, true); o[w] = (unsigned)pk; }
        *(GAS u32x4*)(WT + (size_t)(n0 + n) * ldt + k0 + 16 * c) = o; }
    asm volatile("s_waitcnt lgkmcnt(0)" ::: "memory");
}
__device__ __forceinline__ void convert_tables(Frame& F, int layer, int ibeg, int iend, int wk, int nwk) {
    for (int it0 = ibeg + wk; it0 < iend; it0 += 2 * nwk) {
        f32x4 v[2][8]; GAS unsigned char* dst[2]; int rowq[2], whichq[2];
#pragma unroll
        for (int q = 0; q < 2; ++q) { const int it = it0 + q * nwk < iend ? it0 + q * nwk : it0; const int which = it & 1, row = it >> 1; rowq[q] = row; whichq[q] = which;
            const GAS float* src = F.in(which ? I_PV : I_PU) + ((size_t)layer * NEXP + row) * DM + F.lane * 4;
            const GAS float* gn = F.in(I_PNORM) + layer * DM + F.lane * 4;
            dst[q] = F.ws + O_TAB + (size_t)(layer * 2 + which) * TAB_ONE;
#pragma unroll
            for (int c = 0; c < 8; ++c) { v[q][c] = __builtin_nontemporal_load((const GAS f32x4*)(src + c * 256)); if (!which) v[q][c] = v[q][c] * *(const GAS f32x4*)(gn + c * 256); } }
#pragma unroll
        for (int q = 0; q < 2; ++q) { _Float16 shv = (_Float16)0.f;
#pragma unroll
            for (int c = 0; c < 8; ++c) { const f32x4 x = v[q][c];
                float amax = fmaxf(fmaxf(fabsf(x[0]), fabsf(x[1])), fmaxf(fabsf(x[2]), fabsf(x[3])));
                amax = fmaxf(amax, dppf<0xB1>(amax)); amax = fmaxf(amax, dppf<0x4E>(amax)); amax = fmaxf(amax, dppf<0x141>(amax)); amax = fmaxf(amax, dppf<0x140>(amax));
                amax = xmax16(amax); amax = xmax32(amax);
                const _Float16 sh = (_Float16)fmaxf(amax * (whichq[q] ? 1.f / 6.f : 1.f / 7.f), 1e-6f);
                const float qs = 1.f / (float)sh;
                unsigned pk;
                if (whichq[q]) { pk = __builtin_amdgcn_cvt_scalef32_pk_fp4_f32(0u, x[0] * qs, x[1] * qs, 1.0f, 0); pk = __builtin_amdgcn_cvt_scalef32_pk_fp4_f32(pk, x[2] * qs, x[3] * qs, 1.0f, 1); }
                else { const int q0 = (int)fminf(fmaxf(rintf(x[0] * qs), -7.f), 7.f), q1 = (int)fminf(fmaxf(rintf(x[1] * qs), -7.f), 7.f), q2 = (int)fminf(fmaxf(rintf(x[2] * qs), -7.f), 7.f), q3 = (int)fminf(fmaxf(rintf(x[3] * qs), -7.f), 7.f);
                       pk = (unsigned)(q0 & 15) | ((unsigned)(q1 & 15) << 4) | ((unsigned)(q2 & 15) << 8) | ((unsigned)(q3 & 15) << 12); }
                *(GAS unsigned short*)(dst[q] + ((size_t)c * NEXP + rowq[q]) * 128 + F.lane * 2) = (unsigned short)pk;
                shv = (F.lane == c) ? sh : shv; }
            if (F.lane < 8) *(GAS unsigned short*)(dst[q] + TAB_NIB + ((size_t)rowq[q] * 8 + F.lane) * 2) = __builtin_bit_cast(unsigned short, shv); }
    }
}
__device__ __forceinline__ void norm_row_bf16(const GAS float* xrow, const GAS float* gain, GAS bf16_t* orow, int lane) {
    f32x4 v[8]; float s = 0.f;
#pragma unroll
    for (int j = 0; j < 8; ++j) { v[j] = *(const GAS f32x4*)(xrow + j * 256 + lane * 4); s += (v[j][0] * v[j][0] + v[j][1] * v[j][1]) + (v[j][2] * v[j][2] + v[j][3] * v[j][3]); }
    const float r = rsqrtf(wave_sum(s) * (1.f / DM) + EPS);
#pragma unroll
    for (int j = 0; j < 8; ++j) { f32x4 g = gain ? *(const GAS f32x4*)(gain + j * 256 + lane * 4) : (f32x4){1.f, 1.f, 1.f, 1.f};
        u32x2 o; o.x = cvtpk(v[j][0] * r * g[0], v[j][1] * r * g[1]); o.y = cvtpk(v[j][2] * r * g[2], v[j][3] * r * g[3]);
        *(GAS u32x2*)(orow + j * 256 + lane * 4) = o; }
}
__device__ __forceinline__ void step_prologue(Frame& F, LAS unsigned char* lds) {
    LAS float* scr = (LAS float*)(lds + F.wave * 16384);
    GAS unsigned char* ws = F.ws;
    constexpr int I0 = 32 * (NIN0 / 32), I1 = 32 * 64, I2 = 32 * 96, I3 = 32 * 64, I4 = 32 * 64, I5 = 32 * 64, I6 = 32 * 64, I7 = 32 * 32, I8 = 32 * 32, I9 = 12 * 16;
    constexpr int NITEMS = I0 + I1 + I2 + I3 + I4 + I5 + I6 + I7 + I8 + I9;
    for (int it = F.gw; it < NITEMS; it += F.ngw) {
        int r = it;
        if (r < I0) { transpose_item(F.in(I_AWIN), NIN0, 0, F.in(I_ANORM), (GAS bf16_t*)(ws + O_WIN0), DM, 0, scr, NIN0 / 32, r, F.lane); continue; } r -= I0;
        if (r < I1) { transpose_item(F.in(I_AWOUT), DM, 0, nullptr, (GAS bf16_t*)(ws + O_WOUT0), DM, 0, scr, 64, r, F.lane); continue; } r -= I1;
        if (r < I2) { transpose_item(F.in(I_SWKVF), 3084, 0, F.in(I_SNORM), (GAS bf16_t*)(ws + O_WL1), DM, 0, scr, 96, r, F.lane); continue; } r -= I2;
        if (r < I3) { transpose_item(F.in(I_BWIN), DM, 0, F.in(I_BNORM), (GAS bf16_t*)(ws + O_WL1), DM, 3072, scr, 64, r, F.lane); continue; } r -= I3;
        if (r < I4) { transpose_item(F.in(I_BWOUT), DM, 0, nullptr, (GAS bf16_t*)(ws + O_WOUT1), DM, 0, scr, 64, r, F.lane); continue; } r -= I4;
        if (r < I5) { transpose_item(F.in(I_PWQ), DM, 0, F.in(I_PNORM), (GAS bf16_t*)(ws + O_WQ0), DM, 0, scr, 64, r, F.lane); continue; } r -= I5;
        if (r < I6) { transpose_item(F.in(I_PWQ) + (size_t)DM * DM, DM, 0, F.in(I_PNORM) + DM, (GAS bf16_t*)(ws + O_WQ1), DM, 0, scr, 64, r, F.lane); continue; } r -= I6;
        if (r < I7) { transpose_item(F.in(I_MWKV), 1024, 0, nullptr, (GAS bf16_t*)(ws + O_WMKV), DM, 0, scr, 32, r, F.lane); continue; } r -= I7;
        if (r < I8) { transpose_item(F.in(I_MWKV) + (size_t)DM * 1024, 1024, 0, nullptr, (GAS bf16_t*)(ws + O_WMKV) + (size_t)1024 * DM, DM, 0, scr, 32, r, F.lane); continue; } r -= I8;
        { const int blk = r / 16, sub = r % 16;
          transpose_item(F.in(I_AGATEW) + (size_t)blk * 128 * 256, 256, 0, nullptr, (GAS bf16_t*)(ws + O_WGATE), 128, blk * 256, scr, 8, sub, F.lane); }
    }
    { const GAS float* sk = F.in(I_PSUBK); GAS bf16_t* o = (GAS bf16_t*)(ws + O_SUBK);
      for (int i = F.gtid; i < 2 * 16 * 128 * 128 / 2; i += F.ngt) *(GAS unsigned*)(o + 2 * i) = cvtpk(sk[2 * i], sk[2 * i + 1]); }
    { GAS float* wf = (GAS float*)(ws + O_WF); const GAS float* w = F.in(I_SWKVF); const GAS float* g = F.in(I_SNORM);
      for (int i = F.gtid; i < 12 * DM; i += F.ngt) { const int j = i / DM, k = i % DM; wf[i] = w[(size_t)k * 3084 + 3072 + j] * g[k]; } }
    { GAS float* spl = (GAS float*)(ws + O_SPL); const GAS float* lam = F.in(I_ALAMBDA);
      for (int i = F.gtid; i < LRU; i += F.ngt) { const float z = -lam[i]; spl[i] = fmaxf(z, 0.f) + log1p_pos(fast_exp(-fabsf(z))); } }
    if (F.gw == 0) {
        float m = 0.f; for (int d = F.lane; d < 128; d += 64) m = fmaxf(m, fabsf(F.in(I_BQNORM)[d] * F.in(I_SKNORM)[d]));
        m = wave_max(m);
        if (F.lane == 0) ((GAS float*)(ws + O_GG))[512] = 2.f * 11.3137085f * m + 30.f; }
    { GAS float* gg = (GAS float*)(ws + O_GG);
      for (int i = F.gtid; i < 384; i += F.ngt) { const int a = i / 128, d = i % 128;
          gg[a == 0 ? 384 + d : i] = a == 0 ? F.in(I_BQNORM)[d] * F.in(I_SKNORM)[d] : F.in(I_MQNORM)[(a - 1) * 128 + d] * F.in(I_MKNORM)[(a - 1) * 128 + d]; } }
    for (int m = F.gw; m < T; m += 2 * F.ngw) {
        const int m1 = m + F.ngw < T ? m + F.ngw : m;
        const GAS float* x0 = F.in(I_X) + (size_t)m * DM + F.lane * 4; const GAS float* x1 = F.in(I_X) + (size_t)m1 * DM + F.lane * 4;
        f32x4 v0[8], v1[8]; float s0 = 0.f, s1 = 0.f;
#pragma unroll
        for (int j = 0; j < 8; ++j) { v0[j] = *(const GAS f32x4*)(x0 + j * 256); v1[j] = *(const GAS f32x4*)(x1 + j * 256); }
#pragma unroll
        for (int j = 0; j < 8; ++j) { s0 += (v0[j][0] * v0[j][0] + v0[j][1] * v0[j][1]) + (v0[j][2] * v0[j][2] + v0[j][3] * v0[j][3]); s1 += (v1[j][0] * v1[j][0] + v1[j][1] * v1[j][1]) + (v1[j][2] * v1[j][2] + v1[j][3] * v1[j][3]); }
        const float r0 = rsqrtf(wave_sum(s0) * (1.f / DM) + EPS), r1 = rsqrtf(wave_sum(s1) * (1.f / DM) + EPS);
        GAS bf16_t* o0 = (GAS bf16_t*)(ws + O_XS16) + (size_t)m * DM + F.lane * 4; GAS bf16_t* o1 = (GAS bf16_t*)(ws + O_XS16) + (size_t)m1 * DM + F.lane * 4;
#pragma unroll
        for (int j = 0; j < 8; ++j) { u32x2 a; a.x = cvtpk(v0[j][0] * r0, v0[j][1] * r0); a.y = cvtpk(v0[j][2] * r0, v0[j][3] * r0); *(GAS u32x2*)(o0 + j * 256) = a;
            u32x2 b; b.x = cvtpk(v1[j][0] * r1, v1[j][1] * r1); b.y = cvtpk(v1[j][2] * r1, v1[j][3] * r1); *(GAS u32x2*)(o1 + j * 256) = b; }
    }
    for (int m = F.gw; m < 2 * NMROW; m += F.ngw) { const int l = m / NMROW, r = m % NMROW;
        norm_row_bf16(F.in(I_MEM) + (size_t)r * DM, F.in(I_MNORM) + l * DM, (GAS bf16_t*)(ws + O_MEMN) + (size_t)m * DM, F.lane); }
    convert_tables(F, 0, 0, 2 * NEXP, F.gw, F.ngw);
}
__device__ __forceinline__ void step_conv(Frame& F) {
    const GAS bf16_t* zx = (const GAS bf16_t*)(F.ws + O_ZX); GAS bf16_t* xc = (GAS bf16_t*)(F.ws + O_XC);
    const GAS float* cw = F.in(I_ACONVW); const GAS float* cb = F.in(I_ACONVB);
    for (int it = F.gtid; it < T * (LRU / 8); it += F.ngt) {
        const int t = it / (LRU / 8), c8 = (it % (LRU / 8)) * 8, pos = t & (SEQ - 1);
        float a[8];
#pragma unroll
        for (int j = 0; j < 8; ++j) a[j] = cb[c8 + j];
#pragma unroll
        for (int k = 0; k < 4; ++k) { if (pos - 3 + k >= 0) { const u32x4 w = *(const GAS u32x4*)(zx + (size_t)(t - 3 + k) * LRU + c8);
            const float xv[8] = {bf_lo(w.x), bf_hi(w.x), bf_lo(w.y), bf_hi(w.y), bf_lo(w.z), bf_hi(w.z), bf_lo(w.w), bf_hi(w.w)};
#pragma unroll
            for (int j = 0; j < 8; ++j) a[j] = fmaf(cw[k * LRU + c8 + j], xv[j], a[j]); } }
        u32x4 o; o.x = cvtpk(a[0], a[1]); o.y = cvtpk(a[2], a[3]); o.z = cvtpk(a[4], a[5]); o.w = cvtpk(a[6], a[7]);
        *(GAS u32x4*)(xc + (size_t)t * LRU + c8) = o;
    }
}
constexpr int SCK = 32, NCK = SEQ / SCK;
typedef _Float16 h8_t __attribute__((ext_vector_type(8)));
__device__ __forceinline__ void scan_load(const GAS _Float16* LA, const GAS _Float16* UH, size_t off, float (&a)[8], float (&u)[8]) {
    const h8_t l = *(const GAS h8_t*)(LA + off), w = *(const GAS h8_t*)(UH + off);
#pragma unroll
    for (int k = 0; k < 8; ++k) { a[k] = fast_exp((float)l[k]); u[k] = (float)w[k]; }
}
__device__ __forceinline__ void step_scan1(Frame& F) {
    const GAS _Float16* LA = (const GAS _Float16*)(F.ws + O_AA); const GAS _Float16* UH = (const GAS _Float16*)(F.ws + O_UU);
    GAS float* CA = (GAS float*)(F.ws + O_LOGFP); GAS float* CH = CA + (size_t)NB * NCK * LRU;
    if (F.tid >= 384) return;
    const int grp = F.tid / 192, th = F.tid % 192;
    for (int it = blockIdx.x * 2 + grp; it < NB * NCK; it += gridDim.x * 2) {
        const int b = it / NCK, ck = it % NCK; const size_t base = ((size_t)b * SEQ + ck * SCK) * LRU + th * 8;
        float ap[8], h[8];
#pragma unroll
        for (int k = 0; k < 8; ++k) { ap[k] = 1.f; h[k] = 0.f; }
#pragma unroll 8
        for (int i = 0; i < SCK; ++i) { float a[8], u[8]; scan_load(LA, UH, base + (size_t)i * LRU, a, u);
#pragma unroll
            for (int k = 0; k < 8; ++k) { ap[k] *= a[k]; h[k] = a[k] * h[k] + u[k]; } }
        GAS float* ca = CA + (size_t)it * LRU + th * 8; GAS float* ch = CH + (size_t)it * LRU + th * 8;
        *(GAS f32x4*)ca = (f32x4){ap[0], ap[1], ap[2], ap[3]}; *(GAS f32x4*)(ca + 4) = (f32x4){ap[4], ap[5], ap[6], ap[7]};
        *(GAS f32x4*)ch = (f32x4){h[0], h[1], h[2], h[3]}; *(GAS f32x4*)(ch + 4) = (f32x4){h[4], h[5], h[6], h[7]};
    }
}
__device__ __forceinline__ void step_scan2(Frame& F) {
    const GAS _Float16* LA = (const GAS _Float16*)(F.ws + O_AA); const GAS _Float16* UH = (const GAS _Float16*)(F.ws + O_UU);
    const GAS float* CA = (const GAS float*)(F.ws + O_LOGFP); const GAS float* CH = CA + (size_t)NB * NCK * LRU;
    const GAS bf16_t* gy = (const GAS bf16_t*)(F.ws + O_GY); GAS bf16_t* cat = (GAS bf16_t*)(F.ws + O_CAT);
    if (F.tid >= 384) return;
    const int grp = F.tid / 192, th = F.tid % 192;
    for (int it = blockIdx.x * 2 + grp; it < NB * NCK; it += gridDim.x * 2) {
        const int b = it / NCK, ck = it % NCK; const size_t base = ((size_t)b * SEQ + ck * SCK) * LRU + th * 8;
        float h[8];
#pragma unroll
        for (int k = 0; k < 8; ++k) h[k] = 0.f;
        for (int k2 = 0; k2 < ck; ++k2) { const size_t o = (size_t)(b * NCK + k2) * LRU + th * 8;
            const f32x4 a0 = *(const GAS f32x4*)(CA + o), a1 = *(const GAS f32x4*)(CA + o + 4), c0 = *(const GAS f32x4*)(CH + o), c1 = *(const GAS f32x4*)(CH + o + 4);
#pragma unroll
            for (int k = 0; k < 4; ++k) { h[k] = a0[k] * h[k] + c0[k]; h[4 + k] = a1[k] * h[4 + k] + c1[k]; } }
#pragma unroll 8
        for (int i = 0; i < SCK; ++i) { float a[8], u[8]; scan_load(LA, UH, base + (size_t)i * LRU, a, u);
            const size_t row = (size_t)b * SEQ + ck * SCK + i;
            const u32x4 g = *(const GAS u32x4*)(gy + row * LRU + th * 8); u32x4 o;
#pragma unroll
            for (int k = 0; k < 8; ++k) h[k] = a[k] * h[k] + u[k];
#pragma unroll
            for (int k = 0; k < 4; ++k) o[k] = cvtpk(h[2 * k] * bf_lo(g[k]), h[2 * k + 1] * bf_hi(g[k]));
            *(GAS u32x4*)(cat + row * DM + th * 8) = o; }
    }
}
__device__ __forceinline__ void step_cprefix(Frame& F, LAS unsigned char* lds) {
    const GAS float* lf = (const GAS float*)(F.ws + O_LOGF); GAS float* cc = (GAS float*)(F.ws + O_CC);
    LAS double* scr = (LAS double*)(lds + F.wave * 16384);
    for (int it = F.gw; it < NB * NH; it += F.ngw) {
        const GAS float* p = lf + (size_t)it * SEQ + F.lane * 64; GAS float* q = cc + (size_t)it * SEQ + F.lane * 64;
        double s = 0.0;
        for (int i = 0; i < 64; ++i) s += (double)p[i];
        scr[F.lane] = s;
        asm volatile("s_waitcnt lgkmcnt(0)" ::: "memory");
        double run = 0.0;
        for (int l = 0; l < 64; ++l) { const double v = scr[l]; if (l < F.lane) run += v; }
        for (int i = 0; i < 64; ++i) { run += (double)p[i]; q[i] = (float)run; }
        asm volatile("s_waitcnt lgkmcnt(0)" ::: "memory");
    }
}

__device__ __forceinline__ int ord_i(float f) { const int b = __float_as_int(f); return b ^ ((b >> 31) & 0x7fffffff); }
__device__ __forceinline__ float unord_f(int k) { return __int_as_float(k ^ ((k >> 31) & 0x7fffffff)); }
template <int N> __device__ __forceinline__ void bitonic_sort_desc(int (&a)[N]) {
#pragma unroll
    for (int k = 2; k <= N; k <<= 1) {
#pragma unroll
        for (int j = k >> 1; j > 0; j >>= 1) {
#pragma unroll
            for (int i = 0; i < N; ++i) { const int l = i ^ j;
                if (l > i) { const bool desc = ((i & k) == 0); const int mx = max(a[i], a[l]), mn = min(a[i], a[l]); a[i] = desc ? mx : mn; a[l] = desc ? mn : mx; } }
        }
    }
}
__device__ __forceinline__ void bitonic_merge16_desc(int (&a)[16]) {
#pragma unroll
    for (int j = 8; j > 0; j >>= 1) {
#pragma unroll
        for (int i = 0; i < 16; ++i) { const int l = i ^ j; if (l > i) { const int mx = max(a[i], a[l]), mn = min(a[i], a[l]); a[i] = mx; a[l] = mn; } }
    }
}
__device__ __forceinline__ void top16_of_64(int (&a)[64]) {
    int g[4][16];
#pragma unroll
    for (int q = 0; q < 4; ++q) {
#pragma unroll
        for (int i = 0; i < 16; ++i) g[q][i] = a[16 * q + i];
        bitonic_sort_desc<16>(g[q]); }
#pragma unroll
    for (int i = 0; i < 16; ++i) { g[0][i] = max(g[0][i], g[1][15 - i]); g[2][i] = max(g[2][i], g[3][15 - i]); }
    bitonic_merge16_desc(g[0]); bitonic_merge16_desc(g[2]);
#pragma unroll
    for (int i = 0; i < 16; ++i) g[0][i] = max(g[0][i], g[2][15 - i]);
    bitonic_merge16_desc(g[0]);
#pragma unroll
    for (int i = 0; i < 16; ++i) a[i] = g[0][i];
}
__device__ __forceinline__ void subkey_top16(const GAS bf16_t* qrow  , const GAS bf16_t* sk  , int r32, int hi, int (&top)[16]) {
    bf16x8 qf[8];
#pragma unroll
    for (int ks = 0; ks < 8; ++ks) qf[ks] = *(const GAS bf16x8*)(qrow + ks * 16 + hi * 8);
    unsigned loff = (unsigned)(r32 * 128 + hi * 8) * 2u; asm volatile("" : "+v"(loff));
    int key[64];
#pragma unroll
    for (int kb = 0; kb < 4; ++kb) {
        f32x16 acc = {};
#pragma unroll
        for (int ks = 0; ks < 8; ++ks) { const bf16x8 af = *(const GAS bf16x8*)((const GAS char*)(sk + kb * 32 * 128 + ks * 16) + loff);
            acc = __builtin_amdgcn_mfma_f32_32x32x16_bf16(af, qf[ks], acc, 0, 0, 0); }
#pragma unroll
        for (int r = 0; r < 16; ++r) { const int id = kb * 32 + (r & 3) + 8 * (r >> 2) + 4 * hi; key[kb * 16 + r] = (ord_i(acc[r]) & ~127) | (127 - id); }
        __builtin_amdgcn_sched_barrier(0);
    }
    top16_of_64(key);
#pragma unroll
    for (int i = 0; i < 16; ++i) { auto r = __builtin_amdgcn_permlane32_swap((unsigned)key[15 - i], (unsigned)key[15 - i], false, false);
        const int pk = hi ? (int)r[0] : (int)r[1]; top[i] = max(key[i], pk); }
    bitonic_merge16_desc(top);
}
__device__ __forceinline__ void step_topk(Frame& F, LAS unsigned char* lds, int layer) {
    const GAS bf16_t* q16 = (const GAS bf16_t*)(F.ws + O_Q16); const GAS bf16_t* subk = (const GAS bf16_t*)(F.ws + O_SUBK) + (size_t)layer * 16 * 128 * 128;
    GAS int* IDX = (GAS int*)(F.ws + O_IDX); GAS float* GW = (GAS float*)(F.ws + O_GW);
    LAS int* scr = (LAS int*)(lds + F.wave * 16384) + F.lane * 33;
    const int r32 = F.lane & 31, hi = F.lane >> 5;
    for (int task = F.gw; task < (T / 32) * 8; task += F.ngw) {
        const int tb = task >> 3, h = task & 7; const int tok = tb * 32 + r32;
        const GAS bf16_t* qrow = q16 + (size_t)tok * DM + h * 256;
        int ta[16], tb16[16];
        subkey_top16(qrow, subk + (size_t)(h * 2 + 0) * 128 * 128, r32, hi, ta);
        subkey_top16(qrow + 128, subk + (size_t)(h * 2 + 1) * 128 * 128, r32, hi, tb16);
        float va[16], vb[16];
#pragma unroll
        for (int i = 0; i < 16; ++i) { va[i] = unord_f(ta[i] & ~127); vb[i] = unord_f(tb16[i] & ~127); scr[i] = 127 - (ta[i] & 127); scr[16 + i] = 127 - (tb16[i] & 127); }
        int c2[64]; int n = 0;
#pragma unroll
        for (int i = 0; i < 16; ++i)
#pragma unroll
            for (int j = 0; j < 16; ++j) if ((i + 1) * (j + 1) <= 16) { c2[n] = (ord_i(va[i] + vb[j]) & ~255) | (255 - (i * 16 + j)); ++n; }
#pragma unroll
        for (int i = 50; i < 64; ++i) c2[i] = (int)0x80000000;
        top16_of_64(c2);
        asm volatile("s_waitcnt lgkmcnt(0)" ::: "memory");
        float sv[16], ex[16]; int ev[16]; float Z = 0.f;
#pragma unroll
        for (int r = 0; r < 16; ++r) { const int flat = 255 - (c2[r] & 255); sv[r] = unord_f(c2[r] & ~255); ev[r] = scr[flat >> 4] * 128 + scr[16 + (flat & 15)]; }
#pragma unroll
        for (int r = 0; r < 16; ++r) { ex[r] = fast_exp(sv[r] - sv[0]); Z += ex[r]; }
        const float iz = 1.f / Z;
        GAS int* ip = IDX + (size_t)tok * 128 + h * 16 + hi * 8; GAS float* gp = GW + (size_t)tok * 128 + h * 16 + hi * 8;
        int eo[8]; float go[8];
#pragma unroll
        for (int j = 0; j < 8; ++j) { eo[j] = hi ? ev[8 + j] : ev[j]; go[j] = (hi ? ex[8 + j] : ex[j]) * iz; }
        *(GAS u32x4*)ip = (u32x4){(unsigned)eo[0], (unsigned)eo[1], (unsigned)eo[2], (unsigned)eo[3]}; *(GAS u32x4*)(ip + 4) = (u32x4){(unsigned)eo[4], (unsigned)eo[5], (unsigned)eo[6], (unsigned)eo[7]};
        *(GAS f32x4*)gp = (f32x4){go[0], go[1], go[2], go[3]}; *(GAS f32x4*)(gp + 4) = (f32x4){go[4], go[5], go[6], go[7]};
        asm volatile("s_waitcnt lgkmcnt(0)" ::: "memory");
    }
}
__device__ __forceinline__ h2 as_h2(unsigned w) { return __builtin_bit_cast(h2, w); }
#define F4(W, s) __builtin_amdgcn_cvt_scalef32_pk_f16_fp4((W), 1.0f, (s))
#define H2F(us) ((float)__builtin_bit_cast(_Float16, (unsigned short)(us)))
__device__ __forceinline__ float sum8(float v) { v += dppf<0xB1>(v); v += dppf<0x4E>(v); v += dppf<0x141>(v); return v; }
__device__ __forceinline__ void step_xplanes(Frame& F) {
    const GAS bf16_t* xs = (const GAS bf16_t*)(F.ws + O_XS16); GAS unsigned char* x4 = F.ws + O_X4; GAS float* sx = (GAS float*)(F.ws + O_SX);
    for (int t = F.gw; t < T; t += F.ngw) {
        const GAS bf16_t* xr = xs + (size_t)t * DM + F.lane * 32;
        u32x4 w[4]; float xv[32]; float amax = 0.f;
#pragma unroll
        for (int c = 0; c < 4; ++c) w[c] = *(const GAS u32x4*)(xr + 8 * c);
#pragma unroll
        for (int c = 0; c < 4; ++c)
#pragma unroll
            for (int k = 0; k < 4; ++k) { xv[8 * c + 2 * k] = bf_lo(w[c][k]); xv[8 * c + 2 * k + 1] = bf_hi(w[c][k]); amax = fmaxf(amax, fmaxf(fabsf(xv[8 * c + 2 * k]), fabsf(xv[8 * c + 2 * k + 1]))); }
        amax = fmaxf(amax, dppf<0xB1>(amax)); amax = fmaxf(amax, dppf<0x4E>(amax)); amax = fmaxf(amax, dppf<0x141>(amax));
        const float sc = fmaxf(amax, 1e-20f) * (1.f / 119.f), qs = 1.f / sc;
        u32x4 hp, lp;
#pragma unroll
        for (int d = 0; d < 4; ++d) { unsigned hw = 0u, lw = 0u;
#pragma unroll
            for (int k = 0; k < 8; ++k) { const int q = (int)rintf(xv[8 * d + k] * qs); const int h = (q + 8) >> 4, l = q - 16 * h; hw |= (unsigned)(h & 15) << (4 * k); lw |= (unsigned)(l & 15) << (4 * k); }
            hp[d] = hw; lp[d] = lw; }
        *(GAS u32x4*)(x4 + ((size_t)t * 64 + F.lane) * 32) = hp; *(GAS u32x4*)(x4 + ((size_t)t * 64 + F.lane) * 32 + 16) = lp;
        if ((F.lane & 7) == 0) sx[(size_t)t * 8 + (F.lane >> 3)] = sc;
    }
}
__device__ __forceinline__ void step_upass(Frame& F, int layer, int G) {
    const int s = blockIdx.x & 7, wk = (blockIdx.x >> 3) * NWAVES + F.wave, nwk = (G >> 3) * NWAVES;
    const GAS unsigned char* UN = F.ws + O_TAB + (size_t)(layer * 2) * TAB_ONE + (size_t)s * NEXP * 128;
    const GAS int* IDX = (const GAS int*)(F.ws + O_IDX); const GAS unsigned char* x4 = F.ws + O_X4 + s * 256; const GAS float* sxp = (const GAS float*)(F.ws + O_SX) + s;
    GAS float* part = (GAS float*)(F.ws + O_PART) + (size_t)s * T * 128;
    unsigned lo = (unsigned)F.lane; asm volatile("" : "+v"(lo));
    const unsigned j = lo >> 3, p = lo & 7;
    const int tlast = wk + ((T - 1 - wk) / nwk) * nwk;
#define U_LOADID(ID, t_, q_) do { const int tt_ = (t_) <= tlast ? (t_) : tlast; _Pragma("unroll") for (int b = 0; b < 4; ++b) ID[b] = IDX[(size_t)tt_ * 128 + (q_) * 32 + 8 * b + j]; } while (0)
#define U_LOADX(t_) do { const int tt_ = (t_) <= tlast ? (t_) : tlast; xhn = *(const GAS u32x4*)(x4 + (size_t)tt_ * 2048 + p * 32); xln = *(const GAS u32x4*)(x4 + (size_t)tt_ * 2048 + p * 32 + 16); sxn = sxp[(size_t)tt_ * 8]; } while (0)
#define U_ISSUE(UB, ID) do { _Pragma("unroll") for (int b = 0; b < 4; ++b) UB[b] = *(const GAS u32x4*)(UN + (unsigned)(ID[b] * 128 + (int)p * 16)); } while (0)
#define U_QUARTER(UB, vout, q_) do { _Pragma("unroll") for (int b = 0; b < 4; ++b) { int ah = 0, al = 0; \
            ah = __builtin_amdgcn_sdot8((int)UB[b].x, (int)xh.x, ah, false); al = __builtin_amdgcn_sdot8((int)UB[b].x, (int)xl.x, al, false); \
            ah = __builtin_amdgcn_sdot8((int)UB[b].y, (int)xh.y, ah, false); al = __builtin_amdgcn_sdot8((int)UB[b].y, (int)xl.y, al, false); \
            ah = __builtin_amdgcn_sdot8((int)UB[b].z, (int)xh.z, ah, false); al = __builtin_amdgcn_sdot8((int)UB[b].z, (int)xl.z, al, false); \
            ah = __builtin_amdgcn_sdot8((int)UB[b].w, (int)xh.w, ah, false); al = __builtin_amdgcn_sdot8((int)UB[b].w, (int)xl.w, al, false); \
            const float d = sum8((float)(16 * ah + al)) * sxc; vout = (p == (unsigned)(4 * ((q_) & 1) + b)) ? d : vout; } } while (0)
    int idA[4], idB[4]; u32x4 u0[4], u1[4], u2[4], u3[4]; u32x4 xh, xl, xhn, xln; float sxc, sxn;
    U_LOADID(idA, wk, 0); U_LOADID(idB, wk, 1); U_LOADX(wk);
    U_ISSUE(u0, idA); U_LOADID(idA, wk, 2);
    U_ISSUE(u1, idB); U_LOADID(idB, wk, 3);
    U_ISSUE(u2, idA); U_LOADID(idA, wk + nwk, 0);
    xh = xhn; xl = xln; sxc = sxn;
    for (int t = wk; t < T; t += nwk) {
        float v0 = 0.f, v1 = 0.f;
        U_ISSUE(u3, idB); U_LOADID(idB, t + nwk, 1); U_LOADX(t + nwk);
        U_QUARTER(u0, v0, 0);
        U_ISSUE(u0, idA); U_LOADID(idA, t + nwk, 2);
        U_QUARTER(u1, v0, 1);
        U_ISSUE(u1, idB); U_LOADID(idB, t + nwk, 3);
        U_QUARTER(u2, v1, 2);
        U_ISSUE(u2, idA); U_LOADID(idA, t + 2 * nwk, 0);
        U_QUARTER(u3, v1, 3);
        part[(size_t)t * 128 + 8 * p + j] = v0; part[(size_t)t * 128 + 64 + 8 * p + j] = v1;
        xh = xhn; xl = xln; sxc = sxn;
    }
#undef U_LOADID
#undef U_LOADX
#undef U_ISSUE
#undef U_QUARTER
}
__device__ __forceinline__ void step_peer_reduce(Frame& F, int layer) {
    const GAS float* part = (const GAS float*)(F.ws + O_PART); const GAS float* GW = (const GAS float*)(F.ws + O_GW); const GAS int* IDX = (const GAS int*)(F.ws + O_IDX);
    const GAS float* rowss = (const GAS float*)(F.ws + O_ROWSS); GAS unsigned* PK = (GAS unsigned*)(F.ws + O_PK);
    const GAS unsigned char* SU = F.ws + O_TAB + (size_t)(layer * 2) * TAB_ONE + TAB_NIB; const GAS unsigned char* SV = SU + TAB_ONE;
    for (int it = F.gw; it < T * 2; it += F.ngw) { const int t = it >> 1; const size_t i = (size_t)it * 64 + F.lane;
        const float r = rsqrtf(wave_sum(rowss[(size_t)t * 32 + (F.lane & 31)]) * (0.5f / DM) + EPS);
        const int id = IDX[i];
        const u32x4 su = *(const GAS u32x4*)(SU + (size_t)id * 16), sv = *(const GAS u32x4*)(SV + (size_t)id * 16);
        float d = 0.f;
#pragma unroll
        for (int s = 0; s < 8; ++s) d += part[(size_t)s * T * 128 + i] * (float)__builtin_bit_cast(_Float16, (unsigned short)(su[s >> 1] >> (16 * (s & 1))));
        const float w = GW[i] * gelu_tanh(d * r);
#pragma unroll
        for (int s = 0; s < 8; ++s) { const _Float16 ws = (_Float16)(w * (float)__builtin_bit_cast(_Float16, (unsigned short)(sv[s >> 1] >> (16 * (s & 1)))));
            PK[(size_t)s * T * 128 + i] = ((unsigned)id << 16) | (unsigned)__builtin_bit_cast(unsigned short, ws); } }
}
__device__ __forceinline__ void step_vpass(Frame& F, int layer, int G, bool dry) {
    const int s = blockIdx.x & 7, wk = (blockIdx.x >> 3) * NWAVES + F.wave, nwk = (G >> 3) * NWAVES;
    const GAS unsigned char* VN = F.ws + O_TAB + (size_t)(layer * 2 + 1) * TAB_ONE + (size_t)s * NEXP * 128;
    const GAS unsigned* PK = (const GAS unsigned*)(F.ws + O_PK) + (size_t)s * T * 128;
    GAS bf16_t* xs = (GAS bf16_t*)(F.ws + O_XS16); GAS float* rsp = (GAS float*)(F.ws + O_RSP);
    unsigned lo = (unsigned)F.lane; asm volatile("" : "+v"(lo));
    const unsigned j = lo >> 3, p = lo & 7;
    const int tlast = wk + ((T - 1 - wk) / nwk) * nwk;
#define V_LOADPK(PKV, t_, q_) do { const int tt_ = (t_) <= tlast ? (t_) : tlast; _Pragma("unroll") for (int b = 0; b < 4; ++b) PKV[b] = PK[(size_t)tt_ * 128 + (q_) * 32 + 8 * b + j]; } while (0)
#define V_ISSUE(VB, PKV) do { _Pragma("unroll") for (int b = 0; b < 4; ++b) VB[b] = *(const GAS u32x4*)(VN + ((PKV[b] >> 16) * 128u + p * 16u)); } while (0)
#define V_CVT4(W, base) do { c_[(base)] = F4(W, 0); c_[(base) + 1] = F4(W, 1); c_[(base) + 2] = F4(W, 2); c_[(base) + 3] = F4(W, 3); } while (0)
#define V_QUARTER(VB, PKV) do { _Pragma("unroll") for (int b = 0; b < 4; ++b) { const _Float16 wl = __builtin_bit_cast(_Float16, (unsigned short)(PKV[b] & 0xffffu)); const h2 wl2 = {wl, wl}; h2 c_[16]; \
            V_CVT4(VB[b].x, 0); V_CVT4(VB[b].y, 4); V_CVT4(VB[b].z, 8); V_CVT4(VB[b].w, 12); \
            __builtin_amdgcn_sched_barrier(0); \
            _Pragma("unroll") for (int k = 0; k < 16; ++k) oh[k] = wl2 * c_[k] + oh[k]; \
            __builtin_amdgcn_sched_barrier(0); } } while (0)
    unsigned pk0[4], pk1[4], pk2[4], pk3[4], pkn[4]; u32x4 v0[4], v1[4], v2[4], v3[4];
    V_LOADPK(pk0, wk, 0); V_LOADPK(pk1, wk, 1); V_LOADPK(pk2, wk, 2); V_LOADPK(pkn, wk, 3);
    V_ISSUE(v0, pk0); V_ISSUE(v1, pk1); V_ISSUE(v2, pk2);
    for (int t = wk; t < T; t += nwk) {
#pragma unroll
        for (int b = 0; b < 4; ++b) pk3[b] = pkn[b];
        V_ISSUE(v3, pk3); V_LOADPK(pkn, t + nwk, 0);
        GAS float* xr = F.out + (size_t)t * DM + s * 256 + p * 32 + j * 4; f32x4 x2 = *(const GAS f32x4*)xr;
        h2 oh[16];
#pragma unroll
        for (int i = 0; i < 16; ++i) oh[i] = (h2){(_Float16)0.f, (_Float16)0.f};
        V_QUARTER(v0, pk0);
#pragma unroll
        for (int b = 0; b < 4; ++b) pk0[b] = pkn[b];
        V_ISSUE(v0, pk0); V_LOADPK(pkn, t + nwk, 1);
        V_QUARTER(v1, pk1);
#pragma unroll
        for (int b = 0; b < 4; ++b) pk1[b] = pkn[b];
        V_ISSUE(v1, pk1); V_LOADPK(pkn, t + nwk, 2);
        V_QUARTER(v2, pk2);
#pragma unroll
        for (int b = 0; b < 4; ++b) pk2[b] = pkn[b];
        V_ISSUE(v2, pk2); V_LOADPK(pkn, t + nwk, 3);
        V_QUARTER(v3, pk3);
#pragma unroll
        for (int i = 0; i < 16; ++i) { unsigned u = __builtin_bit_cast(unsigned, oh[i]);
            h2 a = as_h2(u) + as_h2((unsigned)__builtin_amdgcn_update_dpp(0, (int)u, 0x128, 0xF, 0xF, true)); u = __builtin_bit_cast(unsigned, a);
            { auto r = __builtin_amdgcn_permlane16_swap(u, u, false, false); a = as_h2(r[0]) + as_h2(r[1]); u = __builtin_bit_cast(unsigned, a); }
            { auto r = __builtin_amdgcn_permlane32_swap(u, u, false, false); a = as_h2(r[0]) + as_h2(r[1]); }
            oh[i] = a; }
        h2 o0 = oh[0], o1 = oh[1];
#pragma unroll
        for (int c = 1; c < 8; ++c) { o0 = (j == (unsigned)c) ? oh[2 * c] : o0; o1 = (j == (unsigned)c) ? oh[2 * c + 1] : o1; }
        x2[0] += (float)o0.x; x2[1] += (float)o0.y; x2[2] += (float)o1.x; x2[3] += (float)o1.y;
        if (!dry) *(GAS f32x4*)xr = x2;
        if (layer == 0 && !dry) {
            { u32x2 o; o.x = cvtpk(x2[0], x2[1]); o.y = cvtpk(x2[2], x2[3]); *(GAS u32x2*)(xs + (size_t)t * DM + s * 256 + p * 32 + j * 4) = o; }
            const float sst = wave_sum((x2[0] * x2[0] + x2[1] * x2[1]) + (x2[2] * x2[2] + x2[3] * x2[3]));
            if (lo == 0) rsp[(size_t)t * 8 + s] = sst;
        }
    }
#undef V_LOADPK
#undef V_ISSUE
#undef V_CVT4
#undef V_QUARTER
}
#undef F4
#undef H2F
__device__ __forceinline__ void step_logf(Frame& F) {
    const GAS bf16_t* xs = (const GAS bf16_t*)(F.ws + O_XS16); const GAS float* rsp = (const GAS float*)(F.ws + O_RSP); GAS float* logf = (GAS float*)(F.ws + O_LOGF);
    const GAS float* wf = (const GAS float*)(F.ws + O_WF);
    for (int t = F.gw; t < T; t += F.ngw) {
        unsigned lo = (unsigned)F.lane; asm volatile("" : "+v"(lo));
        float xv[32];
#pragma unroll
        for (int c = 0; c < 4; ++c) { const u32x4 w = *(const GAS u32x4*)(xs + (size_t)t * DM + c * 512 + lo * 8);
#pragma unroll
            for (int k = 0; k < 4; ++k) { xv[8 * c + 2 * k] = bf_lo(w[k]); xv[8 * c + 2 * k + 1] = bf_hi(w[k]); } }
        const float q = wave_sum(lo < 8 ? rsp[(size_t)t * 8 + lo] : 0.f);
        const float r1 = rsqrtf(q * (1.f / DM) + EPS);
        float mine = 0.f;
        for (int h = 0; h < NH; ++h) { float d = 0.f;
#pragma unroll
            for (int c = 0; c < 4; ++c) { const f32x4 w0 = *(const GAS f32x4*)(wf + (size_t)h * DM + c * 512 + lo * 8), w1 = *(const GAS f32x4*)(wf + (size_t)h * DM + c * 512 + lo * 8 + 4);
                d += (xv[8 * c] * w0[0] + xv[8 * c + 1] * w0[1]) + (xv[8 * c + 2] * w0[2] + xv[8 * c + 3] * w0[3]) + (xv[8 * c + 4] * w1[0] + xv[8 * c + 5] * w1[1]) + (xv[8 * c + 6] * w1[2] + xv[8 * c + 7] * w1[3]); }
            d = wave_sum(d); mine = (lo == (unsigned)h) ? d : mine; }
        if (lo < (unsigned)NH) { const float z = mine * r1 + F.in(I_SBF)[lo];
            logf[((size_t)(t / SEQ) * NH + lo) * SEQ + (t % SEQ)] = fminf(z, 0.f) - log1p_pos(fast_exp(-fabsf(z))); }
    }
}

#define XB_TMO      128
#define XB_XCNT(j)  (256  + 64 * (j))
#define XB_XSUB(j)  (1280 + 64 * (j))
#define XB_XGEN(j)  (2304 + 64 * (j))
#define XB_TOP      3328
#define XB_TOPGEN   3392
#define XCD_BAR_WORDS 3456
#define XB_SPIN_CAP (1u << 20)
__device__ __forceinline__ unsigned xb_ld(unsigned* p)              { return __hip_atomic_load(p, __ATOMIC_RELAXED, __HIP_MEMORY_SCOPE_AGENT); }
__device__ __forceinline__ unsigned xb_add(unsigned* p, unsigned v) { return __hip_atomic_fetch_add(p, v, __ATOMIC_RELAXED, __HIP_MEMORY_SCOPE_AGENT); }
__device__ __forceinline__ unsigned xb_xcc_id() { return (unsigned)__builtin_amdgcn_s_getreg((3 << 11) | 20) & 0xFu; }
#define XB_SPIN(cond, bar) do { unsigned _sp = 0; while (cond) { __builtin_amdgcn_s_sleep(1); \
    if ((++_sp & 255u) == 0u) { if (xb_ld(&(bar)[XB_TMO])) break; if (_sp > XB_SPIN_CAP) { atomicAdd(&(bar)[XB_TMO], 1u); break; } } } } while (0)
struct XcdBarrier { unsigned* bar; unsigned x; volatile LAS unsigned* st; };
__device__ __forceinline__ XcdBarrier xcd_barrier_post(unsigned* bar, volatile LAS unsigned* st) {
    XcdBarrier b; b.bar = bar; b.x = xb_xcc_id(); b.st = st;
    if (threadIdx.x == 0) (void)xb_add(&bar[XB_XCNT(b.x)], 1u);
    return b;
}
__device__ __forceinline__ void xcd_barrier_complete(unsigned* bar, unsigned x, unsigned& nloc, unsigned& nx) {
    const unsigned G = gridDim.x * gridDim.y * gridDim.z;
    unsigned sum, cnt, mine, sp = 0u;
    for (;;) {
        sum = 0u; cnt = 0u; mine = 0u;
#pragma unroll
        for (unsigned j = 0; j < 16; ++j) { const unsigned c = xb_ld(&bar[XB_XCNT(j)]); sum += c; cnt += (c > 0u) ? 1u : 0u; mine = (j == x) ? c : mine; }
        if (sum == G) break;
        __builtin_amdgcn_s_sleep(1);
        if ((++sp & 255u) == 0u) { if (xb_ld(&bar[XB_TMO])) break; if (sp > XB_SPIN_CAP) { atomicAdd(&bar[XB_TMO], 1u); break; } }
    }
    nloc = mine > 0u ? mine : 1u; nx = cnt > 0u ? cnt : 1u;
}
__device__ __forceinline__ void xcd_barrier(const XcdBarrier& b, int wave_s) {
    asm volatile("s_waitcnt vmcnt(0)" ::: "memory");
    __syncthreads();
    int ln_; asm volatile("v_mbcnt_lo_u32_b32 %0, -1, 0\n\tv_mbcnt_hi_u32_b32 %0, -1, %0" : "=v"(ln_));
    if (wave_s == 0 && ln_ == 0) {
        unsigned* bar = b.bar;
        __builtin_amdgcn_s_waitcnt(0);
        unsigned nloc = b.st[0], nx = b.st[1];
        if (nloc == 0u) { xcd_barrier_complete(bar, b.x, nloc, nx); b.st[0] = nloc; b.st[1] = nx; }
        const unsigned old = xb_add(&bar[XB_XSUB(b.x)], 1u);
        const unsigned gen = old / nloc;
        if (old + 1u == (gen + 1u) * nloc) {
            __builtin_amdgcn_fence(__ATOMIC_RELEASE, "agent");
            asm volatile("s_waitcnt vmcnt(0)" ::: "memory");
            const unsigned og = xb_add(&bar[XB_TOP], 1u);
            const unsigned tg = og / nx;
            if (og + 1u == (tg + 1u) * nx) xb_add(&bar[XB_TOPGEN], 1u);
            else XB_SPIN(xb_ld(&bar[XB_TOPGEN]) == tg, bar);
            __builtin_amdgcn_fence(__ATOMIC_ACQUIRE, "agent");
            xb_add(&bar[XB_XGEN(b.x)], 1u);
            asm volatile("s_waitcnt vmcnt(0)" ::: "memory");
        } else {
            XB_SPIN(xb_ld(&bar[XB_XGEN(b.x)]) == gen, bar);
            __builtin_amdgcn_fence(__ATOMIC_ACQUIRE, "agent");
            asm volatile("s_waitcnt vmcnt(0)" ::: "memory");
        }
    }
    __syncthreads();
}

constexpr int CONV1_SPLIT = 2 * 3584;
constexpr int BAR_LDS_OFF = 147456 - 64;
constexpr int LDS_BYTES = 147456;
enum { ST_PROLOGUE = 0, ST_G_IN0, ST_G_MKV0, ST_G_MKV1, ST_CONV, ST_G_GATE, ST_A_MEM0, ST_SCAN1, ST_SCAN2, ST_G_OUT0, ST_G_PQ0, ST_TOPK0, ST_UPASS0, ST_PRED0, ST_VPASS0,
       ST_G_L1, ST_CPREFIX, ST_A_FOX, ST_A_MEM1, ST_G_OUT1, ST_G_PQ1, ST_TOPK1, ST_UPASS1, ST_PRED1, ST_VPASS1, N_STEPS };
constexpr unsigned SYNC_AFTER = (1u << ST_PROLOGUE) | (1u << ST_G_MKV1) | (1u << ST_CONV) | (1u << ST_A_MEM0) | (1u << ST_SCAN1) | (1u << ST_SCAN2) | (1u << ST_G_OUT0) | (1u << ST_G_PQ0) |
                                (1u << ST_TOPK0) | (1u << ST_UPASS0) | (1u << ST_PRED0) | (1u << ST_VPASS0) | (1u << ST_G_L1) | (1u << ST_CPREFIX) | (1u << ST_A_MEM1) | (1u << ST_G_OUT1) | (1u << ST_G_PQ1) | (1u << ST_TOPK1) | (1u << ST_UPASS1) | (1u << ST_PRED1);
constexpr unsigned GEMM_STEPS = (1u << ST_G_IN0) | (1u << ST_G_MKV0) | (1u << ST_G_MKV1) | (1u << ST_G_GATE) | (1u << ST_G_OUT0) | (1u << ST_G_PQ0) | (1u << ST_G_L1) | (1u << ST_G_OUT1) | (1u << ST_G_PQ1);
constexpr unsigned ATTN_STEPS = (1u << ST_A_MEM0) | (1u << ST_A_FOX) | (1u << ST_A_MEM1);

struct Args { const float* in[N_IN]; float* out; unsigned char* ws; int lo, hi; };

__global__ void __launch_bounds__(NTHREADS, 2) yoco_fwd(Args args) {
    extern __shared__ __attribute__((aligned(16))) unsigned char lds[];
    volatile LAS unsigned* bst = (volatile LAS unsigned*)((LAS unsigned char*)lds + BAR_LDS_OFF);
    if (threadIdx.x == 0) { bst[0] = 0u; bst[1] = 0u; }
    __syncthreads();
    const XcdBarrier gbar = xcd_barrier_post((unsigned*)(args.ws + O_CTL), bst);
    const int G = gridDim.x;
    const int wave_s = __builtin_amdgcn_readfirstlane(threadIdx.x >> 6);
#ifndef DUP_MASK
#define DUP_MASK 0u
#endif
    for (int st = args.lo; st < args.hi; ++st) {
      const int nrep = ((DUP_MASK >> st) & 1u) ? 2 : 1;
      for (int rep = 0; rep < nrep; ++rep) {
        unsigned char* ws0 = args.ws; asm volatile("" : "+s"(ws0));
        GAS unsigned char* ws = (GAS unsigned char*)ws0;
#define LANE_ID(v) asm volatile("v_mbcnt_lo_u32_b32 %0, -1, 0\n\tv_mbcnt_hi_u32_b32 %0, -1, %0" : "=v"(v))
#define MAKE_TID(v) do { LANE_ID(v); v += wave_s * 64; } while (0)
#define MAKE_FRAME(F) Frame F; F.ws = ws; F.in_ = args.in; F.out = (GAS float*)args.out; { int t0_; MAKE_TID(t0_); F.tid = t0_; } F.lane = F.tid & 63; F.wave = wave_s; \
        F.gw = blockIdx.x * NWAVES + F.wave; F.ngw = gridDim.x * NWAVES; F.gtid = blockIdx.x * NTHREADS + F.tid; F.ngt = gridDim.x * NTHREADS
        if (st == ST_G_L1) { MAKE_FRAME(F); step_logf(F); }
        if ((GEMM_STEPS >> st) & 1u) {
            pg8::Gemm g; Epi E; E.ws = ws; E.resid = nullptr; E.outf = nullptr; E.o16 = nullptr; E.ssq = nullptr; E.gate_b = nullptr; int shift = 0;
            switch (st) {
            case ST_G_IN0:  g = {(const GAS bf16_t*)(ws + O_XS16), (const GAS bf16_t*)(ws + O_WIN0), T, NIN0, DM, DM, DM, 0}; E.mode = EM_IN0; break;
            case ST_G_MKV0: g = {(const GAS bf16_t*)(ws + O_MEMN), (const GAS bf16_t*)(ws + O_WMKV), NMROW, 1024, DM, DM, DM, 0}; E.mode = EM_MKV; E.o16 = (GAS bf16_t*)(ws + O_MKV); E.ssq = (GAS float*)(ws + O_MKSS); shift = 128; break;
            case ST_G_MKV1: g = {(const GAS bf16_t*)(ws + O_MEMN) + (size_t)NMROW * DM, (const GAS bf16_t*)(ws + O_WMKV) + (size_t)1024 * DM, NMROW, 1024, DM, DM, DM, 0}; E.mode = EM_MKV;
                            E.o16 = (GAS bf16_t*)(ws + O_MKV) + (size_t)NMROW * NL1; E.ssq = (GAS float*)(ws + O_MKSS) + NMROW * 112; shift = 144; break;
            case ST_G_GATE: g = {(const GAS bf16_t*)(ws + O_XC), (const GAS bf16_t*)(ws + O_WGATE), T, 12 * 256, 128, LRU, 128, 128}; E.mode = EM_GATE; E.gate_b = (const GAS float*)args.in[I_AGATEB]; break;
            case ST_G_OUT0: g = {(const GAS bf16_t*)(ws + O_CAT), (const GAS bf16_t*)(ws + O_WOUT0), T, DM, DM, DM, DM, 0}; E.mode = EM_RES; E.resid = (const GAS float*)args.in[I_X]; E.outf = (GAS float*)args.out; break;
            case ST_G_PQ0:  g = {(const GAS bf16_t*)(ws + O_XS16), (const GAS bf16_t*)(ws + O_WQ0), T, DM, DM, DM, DM, 0}; E.mode = EM_PQ; E.o16 = (GAS bf16_t*)(ws + O_Q16); break;
            case ST_G_L1:   g = {(const GAS bf16_t*)(ws + O_XS16), (const GAS bf16_t*)(ws + O_WL1), T, NL1, DM, DM, DM, 0}; E.mode = EM_L1; break;
            case ST_G_OUT1: g = {(const GAS bf16_t*)(ws + O_CAT), (const GAS bf16_t*)(ws + O_WOUT1), T, DM, DM, DM, DM, 0}; E.mode = EM_RES; E.resid = (const GAS float*)args.out; E.outf = (GAS float*)args.out; break;
            default:        g = {(const GAS bf16_t*)(ws + O_XS16), (const GAS bf16_t*)(ws + O_WQ1), T, DM, DM, DM, DM, 0}; E.mode = EM_PQ; E.o16 = (GAS bf16_t*)(ws + O_Q16); break;
            }
            pg8::StaticOrder S; S.init(g.M, g.N, G, (int)((blockIdx.x + G - shift) % G));
#ifndef DIS_GEMM
            { int tg_; MAKE_TID(tg_);
              pg8::gemm_phase<Epi, false>((LAS unsigned char*)lds, g, S, E, tg_); }
#endif
            if (st == ST_G_MKV1 && blockIdx.x >= 160) { MAKE_FRAME(F); convert_tables(F, 1, 0, CONV1_SPLIT, (blockIdx.x - 160) * NWAVES + F.wave, (G - 160) * NWAVES); }
        } else if ((ATTN_STEPS >> st) & 1u) {
            const int nun = st == ST_A_FOX ? 3 : 1;
            for (int ui = 0; ui < nun; ++ui) {
                att::BlockRef r;
                if (st == ST_A_FOX) {
                    const int i = blockIdx.x, x = i & 15, bh = (i >> 4) + 16 * ui, qb = ui == 0 ? x : (ui == 1 ? 15 - x : ((x * 5 + 3) & 15));
                    const int b = bh / NH, h = bh % NH; const size_t row0 = (size_t)b * SEQ + qb * 256;
                    const GAS bf16_t* z = (const GAS bf16_t*)(ws + O_ZL1);
                    r.Q = z + row0 * NL1 + 3072 + h * 128; r.K = z + (size_t)b * SEQ * NL1 + h * 128; r.V = z + (size_t)b * SEQ * NL1 + 1536 + h * 128;
                    r.O = (GAS bf16_t*)(ws + O_CAT) + row0 * DM + h * 128;
                    const GAS float* ss = (const GAS float*)(ws + O_SSL1);
                    r.qss = ss + row0 * 112 + (12 + h) * 4; r.kss = ss + (size_t)b * SEQ * 112 + h * 4; r.cc = (const GAS float*)(ws + O_CC) + (size_t)bh * SEQ; r.gg = (const GAS float*)(ws + O_GG) + 384;
                    r.P0 = qb * 256; r.skv = SEQ;
                } else {
                    const int l = st == ST_A_MEM0 ? 0 : 1; const int i = blockIdx.x, qblk = i >> 2, h = i & 3, b = qblk >> 4; const size_t row0 = (size_t)qblk * 256;
                    r.Q = (const GAS bf16_t*)(ws + O_ZL1) + row0 * NL1 + 4608 + h * 128; r.qss = (const GAS float*)(ws + O_SSL1) + row0 * 112 + (24 + h) * 4;
                    const GAS bf16_t* kv = (const GAS bf16_t*)(ws + O_MKV) + ((size_t)l * NMROW + b * NMEM) * NL1;
                    r.K = kv + h * 128; r.V = kv + 512 + h * 128; r.kss = (const GAS float*)(ws + O_MKSS) + ((size_t)l * NMROW + b * NMEM) * 112 + h * 4;
                    r.O = (GAS bf16_t*)(ws + O_CAT) + row0 * DM + LRU + h * 128; r.cc = nullptr; r.gg = (const GAS float*)(ws + O_GG) + 128 * (1 + l);
                    r.P0 = SEQ; r.skv = NMEM;
                }
                att::Seam S;
                int tid_u; MAKE_TID(tid_u);
#ifndef DIS_ATTN
                att::attn_prime(r, (char*)lds, S, tid_u);
                att::attn_block(r, (char*)lds, S, tid_u);
#endif
            }
        } else {
            MAKE_FRAME(F);
            switch (st) {
#ifndef DIS_MISC
            case ST_PROLOGUE: step_prologue(F, (LAS unsigned char*)lds); break;
            case ST_CONV: step_conv(F); break;
            case ST_SCAN1: step_scan1(F); break;
            case ST_SCAN2: step_scan2(F); break;
#endif
#ifndef DIS_TOPK
            case ST_TOPK0: step_topk(F, (LAS unsigned char*)lds, 0); step_xplanes(F); break;
            case ST_TOPK1: step_topk(F, (LAS unsigned char*)lds, 1); step_xplanes(F); break;
#endif
#ifndef DIS_GATHER
            case ST_UPASS0: step_upass(F, 0, G); break;
            case ST_UPASS1: step_upass(F, 1, G); break;
            case ST_PRED0: step_peer_reduce(F, 0); break;
            case ST_PRED1: step_peer_reduce(F, 1); break;
            case ST_VPASS0: step_vpass(F, 0, G, rep + 1 < nrep); break;
            case ST_VPASS1: step_vpass(F, 1, G, rep + 1 < nrep); break;
#endif
#ifndef DIS_MISC
            case ST_CPREFIX: step_cprefix(F, (LAS unsigned char*)lds); convert_tables(F, 1, G > 160 ? CONV1_SPLIT : 0, 2 * NEXP, F.gw, F.ngw); break;
#endif
            default: break;
            }
        }
        if (rep + 1 < nrep) xcd_barrier(gbar, wave_s);
      }
        if (((SYNC_AFTER >> st) & 1u) && st + 1 < args.hi) xcd_barrier(gbar, wave_s);
    }
}

#ifndef N_LAUNCH_MODE
#define N_LAUNCH_MODE 1
#endif
extern "C" void kernel_launch(void* const* d_in, const int* in_sizes, int n_in, void* d_out, int out_size, void* d_ws, size_t ws_size, hipStream_t stream) {
    static int grid = 0;
    if (grid == 0) {
        if (n_in != N_IN || in_sizes[0] != T * DM || out_size != T * DM || ws_size < WS_END) {
            fprintf(stderr, "kernel_launch: unexpected shapes (n_in %d, in0 %d, out %d, ws %zu, need %zu)\n", n_in, n_in > 0 ? in_sizes[0] : -1, out_size, ws_size, (size_t)WS_END); grid = -1; return; }
        int dev = 0, cus = 0, per_cu = 0;
        hipGetDevice(&dev); hipDeviceGetAttribute(&cus, hipDeviceAttributeMultiprocessorCount, dev);
        hipFuncSetAttribute((const void*)yoco_fwd, hipFuncAttributeMaxDynamicSharedMemorySize, LDS_BYTES);
        hipOccupancyMaxActiveBlocksPerMultiprocessor(&per_cu, (const void*)yoco_fwd, NTHREADS, LDS_BYTES);
        if (per_cu < 1) { fprintf(stderr, "kernel_launch: occupancy query says %d blocks per CU\n", per_cu); grid = -1; return; }
        grid = cus - cus % 8;
        (void)hipGetLastError();
    }
    if (grid < 0) return;
    Args a{};
    for (int i = 0; i < N_IN; ++i) a.in[i] = (const float*)d_in[i];
    a.out = (float*)d_out; a.ws = (unsigned char*)d_ws;
    if (hipMemsetAsync((char*)d_ws + O_CTL, 0, 65536, stream) != hipSuccess) { fprintf(stderr, "kernel_launch: memset of the barrier words failed\n"); return; }
    if (N_LAUNCH_MODE == 1) {
        a.lo = 0; a.hi = N_STEPS;
        hipLaunchKernelGGL(yoco_fwd, dim3(grid), dim3(NTHREADS), LDS_BYTES, stream, a);
        hipError_t e = hipPeekAtLastError();
        if (e != hipSuccess) fprintf(stderr, "launch failed: %s (grid %d)\n", hipGetErrorString(e), grid);
    } else {
        int lo = 0;
        for (int s = 0; s < N_STEPS; ++s) {
            if (((SYNC_AFTER >> s) & 1u) || s == N_STEPS - 1) {
                a.lo = lo; a.hi = s + 1; lo = s + 1;
                void* params[] = {&a};
                hipError_t e = hipLaunchCooperativeKernel((const void*)yoco_fwd, dim3(grid), dim3(NTHREADS), params, LDS_BYTES, stream);
                if (e != hipSuccess) { fprintf(stderr, "launch failed: %s\n", hipGetErrorString(e)); break; }
            }
        }
    }
}
```

```cpp
#include <hip/hip_runtime.h>
#include <hip/hip_cooperative_groups.h>
#include <cstdio>
#include <cstdint>
namespace cg = cooperative_groups;

#define LAS __attribute__((address_space(3)))
#define GAS __attribute__((address_space(1)))
typedef unsigned short bf16_t;
typedef short bf16x8 __attribute__((ext_vector_type(8)));
typedef short s16x4 __attribute__((ext_vector_type(4)));
typedef float f32x4 __attribute__((ext_vector_type(4)));
typedef float f32x2 __attribute__((ext_vector_type(2)));
typedef float f32x16 __attribute__((ext_vector_type(16)));
typedef unsigned u32x4 __attribute__((ext_vector_type(4)));
typedef unsigned u32x2 __attribute__((ext_vector_type(2)));
typedef _Float16 h2 __attribute__((ext_vector_type(2)));

constexpr int NB = 4, SEQ = 4096, T = NB * SEQ, DM = 2048, LRU = 1536, MEMW = 512, NMEM = 256, NH = 12, HD = 128;
constexpr int NIN0 = 3584, NL1 = 5120, NEXP = 16384, NMROW = NB * NMEM;
constexpr float EPS = 1e-6f;
constexpr int NTHREADS = 512, NWAVES = 8;

constexpr size_t MiB = 1u << 20;
constexpr size_t O_CTL = 0;
constexpr size_t O_WIN0 = 1 * MiB;
constexpr size_t O_WOUT0 = O_WIN0 + 14 * MiB;
constexpr size_t O_WL1 = O_WOUT0 + 8 * MiB;
constexpr size_t O_WOUT1 = O_WL1 + 20 * MiB;
constexpr size_t O_WQ0 = O_WOUT1 + 8 * MiB;
constexpr size_t O_WQ1 = O_WQ0 + 8 * MiB;
constexpr size_t O_WMKV = O_WQ1 + 8 * MiB;
constexpr size_t O_WGATE = O_WMKV + 8 * MiB;
constexpr size_t O_SUBK = O_WGATE + 1 * MiB;
constexpr size_t O_WF = O_SUBK + 1 * MiB;
constexpr size_t O_SMALL = O_WF + 1 * MiB;
constexpr size_t O_RS1 = O_SMALL;
constexpr size_t O_LOGF = O_SMALL + 64 * 1024;
constexpr size_t O_CC = O_LOGF + 768 * 1024;
constexpr size_t O_GG = O_CC + 768 * 1024;
constexpr size_t O_SPL = O_GG + 4096;
constexpr size_t O_TSC = O_SPL + 8192;
constexpr size_t O_ROWSS = O_SMALL + 2 * MiB;
constexpr size_t O_RSP = O_ROWSS + 2 * MiB;
constexpr size_t O_QMSS = O_RSP;
constexpr size_t O_MKSS = O_QMSS + 1 * MiB;
constexpr size_t O_SSL1 = O_MKSS + 1 * MiB;
constexpr size_t O_CARRY = O_SSL1 + 7 * MiB;
constexpr size_t O_MEMN = O_CARRY + 3 * MiB;
constexpr size_t O_MKV = O_MEMN + 8 * MiB;
constexpr size_t O_IDX = O_MKV + 20 * MiB;
constexpr size_t O_GW = O_IDX + 8 * MiB;
constexpr size_t O_TAB = O_GW + 8 * MiB;
constexpr size_t TAB_NIB = (size_t)8 * 16384 * 128, TAB_ONE = TAB_NIB + (size_t)16384 * 16 + 786432;
constexpr size_t O_XS16 = O_TAB + 128 * MiB;
constexpr size_t O_CAT = O_XS16 + 64 * MiB;
constexpr size_t O_ZX = O_CAT + 64 * MiB;
constexpr size_t O_X8 = O_ZX;
constexpr size_t O_GY = O_ZX + 48 * MiB;
constexpr size_t O_LOGFP = O_GY + 48 * MiB;
constexpr size_t O_QM = O_LOGFP;
constexpr size_t O_XC = O_QM + 16 * MiB;
constexpr size_t O_X4 = O_XC;
constexpr size_t O_SX = O_XC + 32 * MiB;
constexpr size_t O_AA = O_XC + 48 * MiB;
constexpr size_t O_PART = O_AA;
constexpr size_t O_UU = O_AA + 96 * MiB;
constexpr size_t O_PK = O_UU;
constexpr size_t O_Q16 = O_UU + 96 * MiB;
constexpr size_t O_ZL1 = O_Q16 + 64 * MiB;
constexpr size_t WS_END = O_ZL1 + 160 * MiB;
static_assert(WS_END <= 1024 * MiB, "workspace map");

__device__ __forceinline__ unsigned cvtpk(float lo, float hi) { unsigned r; asm volatile("v_cvt_pk_bf16_f32 %0, %1, %2" : "=v"(r) : "v"(lo), "v"(hi)); return r; }
__device__ __forceinline__ float bf_lo(unsigned w) { return __uint_as_float(w << 16); }
__device__ __forceinline__ float bf_hi(unsigned w) { return __uint_as_float(w & 0xffff0000u); }
__device__ __forceinline__ float fast_exp(float x) { return __builtin_amdgcn_exp2f(x * 1.4426950408889634f); }
__device__ __forceinline__ float log1p_pos(float y) { const float ser = y * (1.f - y * (0.5f - y * (0.33333334f - 0.25f * y))); const float lg = __builtin_amdgcn_logf(1.f + y) * 0.6931471805599453f; return y < 0.03f ? ser : lg; }
__device__ __forceinline__ float one_minus_exp(float x) { const float ser = -x * (1.f + x * (0.5f + x * (0.16666667f + x * 0.041666668f))); const float big = 1.f - fast_exp(x); return x > -0.03f ? ser : big; }
__device__ __forceinline__ float sigmoidf_(float x) { return __builtin_amdgcn_rcpf(1.f + fast_exp(-x)); }
__device__ __forceinline__ float gelu_tanh(float x) { const float u = x * (1.f + 0.044715f * x * x); return x * __builtin_amdgcn_rcpf(1.f + __builtin_amdgcn_exp2f(u * (-2.f * 0.7978845608028654f * 1.4426950408889634f))); }
template <int CTRL> __device__ __forceinline__ float dppf(float v) { return __int_as_float(__builtin_amdgcn_update_dpp(0, __float_as_int(v), CTRL, 0xF, 0xF, true)); }
__device__ __forceinline__ float xsum16(float v) { auto r = __builtin_amdgcn_permlane16_swap(__float_as_uint(v), __float_as_uint(v), false, false); return __uint_as_float(r[0]) + __uint_as_float(r[1]); }
__device__ __forceinline__ float xsum32(float v) { auto r = __builtin_amdgcn_permlane32_swap(__float_as_uint(v), __float_as_uint(v), false, false); return __uint_as_float(r[0]) + __uint_as_float(r[1]); }
__device__ __forceinline__ float xmax16(float v) { auto r = __builtin_amdgcn_permlane16_swap(__float_as_uint(v), __float_as_uint(v), false, false); return fmaxf(__uint_as_float(r[0]), __uint_as_float(r[1])); }
__device__ __forceinline__ float xmax32(float v) { auto r = __builtin_amdgcn_permlane32_swap(__float_as_uint(v), __float_as_uint(v), false, false); return fmaxf(__uint_as_float(r[0]), __uint_as_float(r[1])); }
__device__ __forceinline__ float wave_sum(float v) {
    v += dppf<0xB1>(v); v += dppf<0x4E>(v); v += dppf<0x141>(v); v += dppf<0x140>(v);
    v = xsum16(v); v = xsum32(v); return v;
}
__device__ __forceinline__ float wave_max(float v) {
    v = fmaxf(v, dppf<0xB1>(v)); v = fmaxf(v, dppf<0x4E>(v)); v = fmaxf(v, dppf<0x141>(v)); v = fmaxf(v, dppf<0x140>(v));
    v = xmax16(v); v = xmax32(v); return v;
}

namespace pg8 {
constexpr int BM = 256, BK = 64, HALF = 128, HTB = HALF * BK * 2, STAGE_BYTES = 8 * HTB, NXCD = 8, WGM = 8;
__host__ __device__ __forceinline__ int lds_byte(int r, int c) { const int st = (r >> 4) * 2 + (c >> 5), rr = r & 15, cc = c & 31, ob = rr * 64 + cc * 2; return st * 1024 + (ob ^ (((ob >> 9) & 1) << 5)); }
__host__ __device__ __forceinline__ void stage_rc(int b, int& R, int& C) { const int st = b / 1024, sb = b % 1024, swz = sb ^ (((sb >> 9) & 1) << 5); R = (st >> 1) * 16 + swz / 64; C = (st & 1) * 32 + (swz % 64) / 2; }
__host__ __device__ __forceinline__ int perm32(int rho) { const int n = rho >> 4, i = rho & 15; return 8 * (i >> 2) + 4 * n + (i & 3); }

struct Unit { int pm, pn; };
struct Gemm { const GAS bf16_t* A; const GAS bf16_t* Bt; int M, N, K, lda, ldb, acol; };

struct StaticOrder {
    int nM, nN, nwg, G, c;
    __device__ void init(int M, int N, int G_, int c_) { nM = M / BM; nN = N / BM; nwg = nM * nN; G = G_; c = c_; }
    __device__ bool next(int i, Unit& u) const {
        const long L = (long)i * G + c; if (L >= nwg) return false;
        int wgid = (int)L; { const int q = nwg / NXCD, r = nwg % NXCD, xcd = wgid % NXCD, off = wgid / NXCD; wgid = (xcd < r ? xcd * (q + 1) : r * (q + 1) + (xcd - r) * q) + off; }
        const int nig = WGM * nN, gid = wgid / nig, fm = gid * WGM, gsz = (nM - fm) < WGM ? (nM - fm) : WGM;
        u.pm = fm + ((wgid % nig) % gsz); u.pn = (wgid % nig) / gsz; return true;
    }
};

typedef int v8i_t __attribute__((ext_vector_type(8)));
typedef int v4i_t __attribute__((ext_vector_type(4)));
template <class Epi, bool FP8>
__device__ __forceinline__ void gemm_phase(LAS unsigned char* lds, const Gemm g, const StaticOrder& S, const Epi& E, const int tid) {
    const int wid = __builtin_amdgcn_readfirstlane(tid >> 6), lane = tid & 63, wr = wid >> 2, wc = wid & 3, fr = lane & 15, fq = lane >> 4;
    const int K = g.K, nt = K / BK;
    unsigned voffA[2], voffB[2];
#pragma unroll
    for (int i = 0; i < 2; ++i) { int R, C; stage_rc(tid * 16 + i * 8192, R, C); const int Rb = (R & ~31) + perm32(R & 31);
        voffA[i] = (unsigned)(R * g.lda + C) * 2u; voffB[i] = (unsigned)(Rb * g.ldb + C) * 2u; }
    const size_t kstep = (size_t)(BK * 2);
    const size_t hstepA = (size_t)HALF * g.lda * 2, hstepB = (size_t)HALF * g.ldb * 2;
    const size_t tstepA = 2 * hstepA, tstepB = 2 * hstepB;
    const unsigned ldsw = (unsigned)wid * 1024u;
    const int aoff = lds_byte(wr * 64 + fr, fq * 8), boff = lds_byte(wc * 32 + fr, fq * 8);
#define PG8_SA(b, h) (((b) * 2 + (h)) * HTB)
#define PG8_SB(b, h) ((4 + (b) * 2 + (h)) * HTB)
#define PG8_STAGE(bufoff, gbase, voff) do { _Pragma("unroll") for (int _i = 0; _i < 2; ++_i) \
        __builtin_amdgcn_global_load_lds((const GAS unsigned*)((gbase) + (voff)[_i]), (LAS unsigned*)(lds + (bufoff) + ldsw + _i * 8192), 16, 0, 0); } while (0)
#define PG8_LD2(dst, off_) do { const u32x4 lo_ = *(const LAS u32x4*)(lds + (off_)), hi_ = *(const LAS u32x4*)(lds + (off_) + 1024); \
        dst = (v8i_t){(int)lo_.x, (int)lo_.y, (int)lo_.z, (int)lo_.w, (int)hi_.x, (int)hi_.y, (int)hi_.z, (int)hi_.w}; } while (0)
#define PG8_LDA(dst, b, h) do { _Pragma("unroll") for (int m = 0; m < 4; ++m) PG8_LD2(dst[m], PG8_SA(b, h) + aoff + m * 2048); } while (0)
#define PG8_LDB(dst, b, h) do { _Pragma("unroll") for (int n = 0; n < 2; ++n) PG8_LD2(dst[n], PG8_SB(b, h) + boff + n * 2048); } while (0)
#define PG8_HALF(v, k) ((k) ? __builtin_shufflevector(v, v, 4, 5, 6, 7) : __builtin_shufflevector(v, v, 0, 1, 2, 3))
#define PG8_MMA(ai, bj, At, Bt) do { __builtin_amdgcn_s_setprio(1); _Pragma("unroll") for (int m = 0; m < 4; ++m) _Pragma("unroll") for (int n = 0; n < 2; ++n) { \
        if constexpr (FP8) asm volatile("v_mfma_scale_f32_16x16x128_f8f6f4 %0, %1, %2, %0, %3, %4 op_sel_hi:[0,0,0]" : "+v"(acc[ai][bj][m][n]) : "v"(Bt[n]), "v"(At[m]), "v"(sc_w), "v"(sc_x));     \
        else { _Pragma("unroll") for (int k = 0; k < 2; ++k) { const v4i_t bh_ = PG8_HALF(Bt[n], k), ah_ = PG8_HALF(At[m], k); \
                acc[ai][bj][m][n] = __builtin_amdgcn_mfma_f32_16x16x32_bf16(__builtin_bit_cast(bf16x8, bh_), __builtin_bit_cast(bf16x8, ah_), acc[ai][bj][m][n], 0, 0, 0); } } } \
        __builtin_amdgcn_s_setprio(0); } while (0)
#define PG8_WAIT_V(n) asm volatile("s_waitcnt vmcnt(" #n ")" ::: "memory")
#define PG8_WAIT_L(n) asm volatile("s_waitcnt lgkmcnt(" #n ")" ::: "memory")
#define PG8_BAR __builtin_amdgcn_s_barrier()
#define PG8_SCHED __builtin_amdgcn_sched_barrier(0)
    Unit cur, nxt; int ui = 0;
    if (!S.next(0, cur)) return;
    f32x4 acc[2][2][4][2];
#pragma unroll
    for (int a = 0; a < 2; ++a)
#pragma unroll
        for (int b = 0; b < 2; ++b)
#pragma unroll
            for (int m = 0; m < 4; ++m)
#pragma unroll
                for (int n = 0; n < 2; ++n) acc[a][b][m][n] = (f32x4){0.f, 0.f, 0.f, 0.f};
    v8i_t At[4], B0[2], B1[2];
    const int sc_w = 121, sc_x = 127;
    const GAS char* cA = (const GAS char*)g.A + (size_t)cur.pm * tstepA + (size_t)cur.pn * g.acol * 2; const GAS char* cB = (const GAS char*)g.Bt + (size_t)cur.pn * tstepB;
    PG8_STAGE(PG8_SB(0, 0), cB, voffB); PG8_STAGE(PG8_SB(0, 1), cB + hstepB, voffB); PG8_STAGE(PG8_SA(0, 0), cA, voffA); PG8_STAGE(PG8_SA(0, 1), cA + hstepA, voffA);
    if (wr == 1) PG8_BAR;
    PG8_WAIT_V(2); PG8_BAR;
    PG8_STAGE(PG8_SB(1, 0), cB + kstep, voffB); PG8_STAGE(PG8_SA(1, 0), cA + kstep, voffA); PG8_STAGE(PG8_SB(1, 1), cB + hstepB + kstep, voffB);
    PG8_WAIT_V(6); PG8_BAR;
    for (;;) {
        const bool has_next = S.next(ui + 1, nxt);
        const GAS char* nA = has_next ? (const GAS char*)g.A + (size_t)nxt.pm * tstepA + (size_t)nxt.pn * g.acol * 2 : cA; const GAS char* nB = has_next ? (const GAS char*)g.Bt + (size_t)nxt.pn * tstepB : cB;
        for (int t = 0; t < nt; t += 2) {
            const bool last = (t == nt - 2);
            const GAS char* a1 = cA + (size_t)(t + 1) * kstep;
            const GAS char* a2 = last ? nA : cA + (size_t)(t + 2) * kstep; const GAS char* b2 = last ? nB : cB + (size_t)(t + 2) * kstep;
            const GAS char* a3 = a2 + kstep; const GAS char* b3 = b2 + kstep;
            PG8_LDB(B0, 0, 0); PG8_LDB(B1, 0, 1); PG8_SCHED; PG8_LDA(At, 0, 0); PG8_STAGE(PG8_SA(1, 1), a1 + hstepA, voffA);
            PG8_WAIT_V(8); PG8_WAIT_L(0); PG8_BAR; PG8_MMA(0, 0, At, B0); PG8_MMA(0, 1, At, B1); PG8_BAR; PG8_SCHED;
            PG8_LDA(At, 0, 1); PG8_STAGE(PG8_SB(0, 0), b2, voffB); PG8_STAGE(PG8_SB(0, 1), b2 + hstepB, voffB); PG8_STAGE(PG8_SA(0, 0), a2, voffA);
            PG8_WAIT_V(8); PG8_WAIT_L(0); PG8_BAR; PG8_MMA(1, 0, At, B0); PG8_MMA(1, 1, At, B1); PG8_BAR; PG8_SCHED;
            PG8_LDB(B0, 1, 0); PG8_LDB(B1, 1, 1); PG8_SCHED; PG8_LDA(At, 1, 0); PG8_STAGE(PG8_SA(0, 1), a2 + hstepA, voffA);
            PG8_WAIT_V(8); PG8_WAIT_L(0); PG8_BAR; PG8_MMA(0, 0, At, B0); PG8_MMA(0, 1, At, B1); PG8_BAR; PG8_SCHED;
            PG8_LDA(At, 1, 1); PG8_STAGE(PG8_SB(1, 0), b3, voffB); PG8_STAGE(PG8_SB(1, 1), b3 + hstepB, voffB); PG8_STAGE(PG8_SA(1, 0), a3, voffA);
            PG8_WAIT_V(8); PG8_WAIT_L(0); PG8_BAR; PG8_MMA(1, 0, At, B0); PG8_MMA(1, 1, At, B1); PG8_BAR; PG8_SCHED;
        }
        if (wr == 0) PG8_BAR;
        { int ln_; asm volatile("v_mbcnt_lo_u32_b32 %0, -1, 0\n\tv_mbcnt_hi_u32_b32 %0, -1, %0" : "=v"(ln_));
          E(acc, cur, wr, wc, ln_ & 15, ln_ >> 4); }
        if (!has_next) break;
#pragma unroll
        for (int a = 0; a < 2; ++a)
#pragma unroll
            for (int b = 0; b < 2; ++b)
#pragma unroll
                for (int m = 0; m < 4; ++m)
#pragma unroll
                    for (int n = 0; n < 2; ++n) acc[a][b][m][n] = (f32x4){0.f, 0.f, 0.f, 0.f};
        cur = nxt; cA = nA; cB = nB; ++ui;
        if (wr == 1) PG8_BAR;
    }
    PG8_WAIT_V(0);
    PG8_BAR;
#undef PG8_SA
#undef PG8_SB
#undef PG8_STAGE
#undef PG8_LDA
#undef PG8_LDB
#undef PG8_LD2
#undef PG8_HALF
#undef PG8_MMA
#undef PG8_WAIT_V
#undef PG8_WAIT_L
#undef PG8_BAR
#undef PG8_SCHED
}
}

enum { EM_IN0 = 0, EM_MKV = 1, EM_GATE = 2, EM_RES = 3, EM_PQ = 4, EM_L1 = 5 };
struct Epi {
    int mode;
    GAS unsigned char* ws;
    const GAS float* resid;
    GAS float* outf;
    GAS bf16_t* o16;
    GAS float* ssq;
    const GAS float* gate_b;
    typedef pg8::Unit Unit;
    __device__ __forceinline__ static void st8(GAS bf16_t* p, f32x4 v0, f32x4 v1) {
        u32x4 w; w.x = cvtpk(v0[0], v0[1]); w.y = cvtpk(v0[2], v0[3]); w.z = cvtpk(v1[0], v1[1]); w.w = cvtpk(v1[2], v1[3]); *(GAS u32x4*)p = w; }
    __device__ __forceinline__ static float sq8(f32x4 a, f32x4 b) { return (a[0] * a[0] + a[1] * a[1]) + (a[2] * a[2] + a[3] * a[3]) + (b[0] * b[0] + b[1] * b[1]) + (b[2] * b[2] + b[3] * b[3]); }
    __device__ __forceinline__ void operator()(f32x4 (&acc)[2][2][4][2], const Unit& u, int wr, int wc, int fr, int fq) const {
        const int row0 = u.pm * 256 + wr * 64 + fr;
        const int cin = wc * 32 + 8 * fq;
        if (mode == EM_IN0) {
            GAS bf16_t* base; int ld, colt; int kind;
            if (u.pn < 6) { base = (GAS bf16_t*)(ws + O_ZX); ld = LRU; colt = u.pn * 256; kind = 0; }
            else if (u.pn < 12) { base = (GAS bf16_t*)(ws + O_GY); ld = LRU; colt = (u.pn - 6) * 256; kind = 1; }
            else { base = (GAS bf16_t*)(ws + O_ZL1); ld = NL1; colt = 4608 + (u.pn - 12) * 256; kind = 2; }
            GAS float* qmss = (GAS float*)(ws + O_SSL1);
#pragma unroll
            for (int ai = 0; ai < 2; ++ai)
#pragma unroll
                for (int m = 0; m < 4; ++m) { const int row = row0 + ai * 128 + m * 16;
#pragma unroll
                    for (int bj = 0; bj < 2; ++bj) { f32x4 v0 = acc[ai][bj][m][0], v1 = acc[ai][bj][m][1];
                        if (kind == 1) {
#pragma unroll
                            for (int j = 0; j < 4; ++j) { v0[j] = gelu_tanh(v0[j]); v1[j] = gelu_tanh(v1[j]); } }
                        st8(base + (size_t)row * ld + colt + bj * 128 + cin, v0, v1);
                        if (kind == 2) { float s = sq8(v0, v1); s = xsum16(s); s = xsum32(s);
                            if (fq == 0) qmss[(size_t)row * 112 + (24 + (u.pn - 12) * 2 + bj) * 4 + wc] = s; } } }
        } else if (mode == EM_MKV) {
#pragma unroll
            for (int ai = 0; ai < 2; ++ai)
#pragma unroll
                for (int m = 0; m < 4; ++m) { const int row = row0 + ai * 128 + m * 16;
#pragma unroll
                    for (int bj = 0; bj < 2; ++bj) { const f32x4 v0 = acc[ai][bj][m][0], v1 = acc[ai][bj][m][1];
                        st8(o16 + (size_t)row * NL1 + u.pn * 256 + bj * 128 + cin, v0, v1);
                        if (u.pn < 2) { float s = sq8(v0, v1); s = xsum16(s); s = xsum32(s);
                            if (fq == 0) ssq[(size_t)row * 112 + (u.pn * 2 + bj) * 4 + wc] = s; } } }
        } else if (mode == EM_GATE) {
            const int ch = u.pn * 128 + cin;
            const GAS bf16_t* xc = (const GAS bf16_t*)(ws + O_XC); GAS _Float16* LA = (GAS _Float16*)(ws + O_AA); GAS _Float16* UH = (GAS _Float16*)(ws + O_UU);
            const GAS float* spl = (const GAS float*)(ws + O_SPL) + ch; const GAS float* gb = gate_b + u.pn * 256 + cin;
#pragma unroll
            for (int n = 0; n < 2; ++n) {
                const f32x4 sp = *(const GAS f32x4*)(spl + 4 * n), br = *(const GAS f32x4*)(gb + 4 * n), bi = *(const GAS f32x4*)(gb + 128 + 4 * n);
#pragma unroll
                for (int ai = 0; ai < 2; ++ai)
#pragma unroll
                    for (int m = 0; m < 4; ++m) { const int row = row0 + ai * 128 + m * 16;
                        const u32x2 xw = *(const GAS u32x2*)(xc + (size_t)row * LRU + ch + 4 * n);
                        const f32x4 xv = {bf_lo(xw.x), bf_hi(xw.x), bf_lo(xw.y), bf_hi(xw.y)};
                        float lav[4], uvv[4];
#pragma unroll
                        for (int j = 0; j < 4; ++j) { const float r = sigmoidf_(acc[ai][0][m][n][j] + br[j]), ig = sigmoidf_(acc[ai][1][m][n][j] + bi[j]);
                            const float la = -8.f * r * sp[j];
                            lav[j] = la; uvv[j] = __builtin_amdgcn_sqrtf(one_minus_exp(2.f * la)) * (ig * xv[j]); }
                        { const h2 l0 = {(_Float16)lav[0], (_Float16)lav[1]}, l1 = {(_Float16)lav[2], (_Float16)lav[3]}, u0 = {(_Float16)uvv[0], (_Float16)uvv[1]}, u1 = {(_Float16)uvv[2], (_Float16)uvv[3]};
                          *(GAS u32x2*)(LA + (size_t)row * LRU + ch + 4 * n) = (u32x2){__builtin_bit_cast(unsigned, l0), __builtin_bit_cast(unsigned, l1)};
                          *(GAS u32x2*)(UH + (size_t)row * LRU + ch + 4 * n) = (u32x2){__builtin_bit_cast(unsigned, u0), __builtin_bit_cast(unsigned, u1)}; } }
            }
        } else if (mode == EM_RES) {
            GAS bf16_t* xs = (GAS bf16_t*)(ws + O_XS16); GAS float* rowss = (GAS float*)(ws + O_ROWSS);
#pragma unroll
            for (int ai = 0; ai < 2; ++ai)
#pragma unroll
                for (int m = 0; m < 4; ++m) { const int row = row0 + ai * 128 + m * 16; float s = 0.f;
#pragma unroll
                    for (int bj = 0; bj < 2; ++bj) { const size_t off = (size_t)row * DM + u.pn * 256 + bj * 128 + cin;
                        const f32x4 r0 = *(const GAS f32x4*)(resid + off), r1 = *(const GAS f32x4*)(resid + off + 4);
                        const f32x4 v0 = acc[ai][bj][m][0] + r0, v1 = acc[ai][bj][m][1] + r1;
                        *(GAS f32x4*)(outf + off) = v0; *(GAS f32x4*)(outf + off + 4) = v1;
                        st8(xs + off, v0, v1); s += sq8(v0, v1); }
                    s = xsum16(s); s = xsum32(s);
                    if (fq == 0) rowss[(size_t)row * 32 + u.pn * 4 + wc] = s; }
        } else if (mode == EM_PQ) {
            const GAS float* rowss = (const GAS float*)(ws + O_ROWSS);
#pragma unroll
            for (int ai = 0; ai < 2; ++ai)
#pragma unroll
                for (int m = 0; m < 4; ++m) { const int row = row0 + ai * 128 + m * 16;
                    const f32x4 p0 = *(const GAS f32x4*)(rowss + (size_t)row * 32 + fq * 8), p1 = *(const GAS f32x4*)(rowss + (size_t)row * 32 + fq * 8 + 4);
                    float s = (p0[0] + p0[1]) + (p0[2] + p0[3]) + (p1[0] + p1[1]) + (p1[2] + p1[3]); s = xsum16(s); s = xsum32(s);
                    const float r = rsqrtf(s * (1.f / DM) + EPS);
#pragma unroll
                    for (int bj = 0; bj < 2; ++bj) st8(o16 + (size_t)row * DM + u.pn * 256 + bj * 128 + cin, acc[ai][bj][m][0] * r, acc[ai][bj][m][1] * r); }
        } else {
            const GAS float* rsp = (const GAS float*)(ws + O_RSP); GAS bf16_t* zl1 = (GAS bf16_t*)(ws + O_ZL1); GAS float* ssl1 = (GAS float*)(ws + O_SSL1);
            const int slot0 = u.pn < 6 ? u.pn * 2 : (u.pn >= 12 ? 12 + (u.pn - 12) * 2 : -1);
#pragma unroll
            for (int ai = 0; ai < 2; ++ai)
#pragma unroll
                for (int m = 0; m < 4; ++m) { const int row = row0 + ai * 128 + m * 16;
                    const f32x4 q0 = *(const GAS f32x4*)(rsp + (size_t)row * 8), q1 = *(const GAS f32x4*)(rsp + (size_t)row * 8 + 4);
                    const float r = rsqrtf(((q0[0] + q0[1]) + (q0[2] + q0[3]) + (q1[0] + q1[1]) + (q1[2] + q1[3])) * (1.f / DM) + EPS);
#pragma unroll
                    for (int bj = 0; bj < 2; ++bj) { const f32x4 v0 = acc[ai][bj][m][0] * r, v1 = acc[ai][bj][m][1] * r;
                        st8(zl1 + (size_t)row * NL1 + u.pn * 256 + bj * 128 + cin, v0, v1);
                        if (slot0 >= 0) { float s = sq8(v0, v1); s = xsum16(s); s = xsum32(s);
                            if (fq == 0) ssl1[(size_t)row * 112 + (slot0 + bj) * 4 + wc] = s; } } }
        }
    }
};

namespace att {
constexpr float SCALE = 0.08838834764831845f;
constexpr int NW = 8, QBLK = 32, KVBLK = 64, QB = NW * QBLK, D = 128;
constexpr int SHM_V = KVBLK * D * 2, SHM_K = KVBLK * D * 2;
constexpr int OFF_WS = 2 * SHM_V + 2 * SHM_K;
constexpr int OFF_KS = OFF_WS + 2048;
constexpr int OFF_BS = OFF_KS + 16384;
constexpr int LDS_END = OFF_BS + 16384;
constexpr int WBIG = 1 << 28;

#define KSWZ(row, colB) ((row) * 256 + ((colB) ^ (((row) & 7) << 4)))
#define SBAR() __builtin_amdgcn_sched_barrier(0)
__device__ __forceinline__ int v_st(int k, int c) { const int kk = (k & ~0xC) | ((k & 4) << 1) | ((k & 8) >> 1); return ((kk >> 3) * 4 + (c >> 5)) * 512 + ((kk & 7) * 32 + (c & 31)) * 2; }
__device__ __forceinline__ int v_rd_base(int lane) { return ((lane & 3) << 3) | (((lane >> 2) & 3) << 6) | (((lane >> 4) & 1) << 5) | (((lane >> 5) & 1) << 8); }
constexpr int v_rd_off(int d0, int ks, int half) { return d0 * 512 + ks * 4096 + half * 2048; }
__device__ __forceinline__ int crow(int r, int hi) { return (r & 3) + 8 * (r >> 2) + 4 * hi; }
__device__ __forceinline__ bf16x8 load8(const GAS bf16_t* p) { return *(const GAS bf16x8*)p; }
__device__ __forceinline__ bf16x8 scale8(bf16x8 v, float s) { const u32x4 w = *reinterpret_cast<u32x4*>(&v); u32x4 o;
    o.x = cvtpk(bf_lo(w.x) * s, bf_hi(w.x) * s); o.y = cvtpk(bf_lo(w.y) * s, bf_hi(w.y) * s); o.z = cvtpk(bf_lo(w.z) * s, bf_hi(w.z) * s); o.w = cvtpk(bf_lo(w.w) * s, bf_hi(w.w) * s);
    return *reinterpret_cast<bf16x8*>(&o); }
__device__ __forceinline__ void mask_tile(f32x16& p0, f32x16& p1, int dq, unsigned W) {
    const float NEG = -__builtin_inff();
#pragma unroll
    for (int r = 0; r < 16; ++r) {
        const int c = (r & 3) + 8 * (r >> 2);
        if ((unsigned)(dq - c) >= W) p0[r] = NEG;
        if ((unsigned)(dq - c - 32) >= W) p1[r] = NEG;
    }
}
constexpr float THR = 8.f;
__device__ __forceinline__ void partialSM(f32x16& p0, f32x16& p1, float& m_reg, float& mn, float& alpha) {
    float pmax = p0[0]; for (int r = 1; r < 16; ++r) pmax = fmaxf(pmax, p0[r]); for (int r = 0; r < 16; ++r) pmax = fmaxf(pmax, p1[r]);
    { auto rr = __builtin_amdgcn_permlane32_swap(__float_as_uint(pmax), __float_as_uint(pmax), false, false);
      pmax = fmaxf(__uint_as_float(rr[0]), __uint_as_float(rr[1])); }
    constexpr float C2 = 1.4426950408889634f * SCALE;
    if (__builtin_expect(__all((pmax - m_reg) * SCALE <= THR), 1)) { mn = m_reg; alpha = 1.f; }
    else { mn = fmaxf(m_reg, pmax); alpha = __builtin_amdgcn_exp2f((m_reg - mn) * C2); m_reg = mn; }
    const float mnL = -mn * C2;
    for (int r = 0; r < 16; ++r) p0[r] = fmaf(p0[r], C2, mnL); for (int r = 0; r < 16; ++r) p1[r] = fmaf(p1[r], C2, mnL);
    for (int r = 0; r < 16; ++r) p0[r] = __builtin_amdgcn_exp2f(p0[r]);
}
__device__ __forceinline__ void finishSM(f32x16& p0, f32x16& p1, float alpha, float& l_reg, bf16x8& pa0, bf16x8& pa1, bf16x8& pa2, bf16x8& pa3) {
    for (int r = 0; r < 16; ++r) p1[r] = __builtin_amdgcn_exp2f(p1[r]);
    float ps = 0; for (int r = 0; r < 16; ++r) ps += p0[r]; for (int r = 0; r < 16; ++r) ps += p1[r];
    { auto rr = __builtin_amdgcn_permlane32_swap(__float_as_uint(ps), __float_as_uint(ps), false, false);
      ps = __uint_as_float(rr[0]) + __uint_as_float(rr[1]); }
    l_reg = l_reg * alpha + ps;
#define PK4(P, B_, OUT) do { unsigned a0 = cvtpk(P[B_+0], P[B_+1]), a1 = cvtpk(P[B_+2], P[B_+3]);                          \
        unsigned b0 = cvtpk(P[B_+4], P[B_+5]), b1 = cvtpk(P[B_+6], P[B_+7]);                                             \
        auto r0 = __builtin_amdgcn_permlane32_swap(a0, b0, false, false); auto r1 = __builtin_amdgcn_permlane32_swap(a1, b1, false, false); \
        u32x4 w = {r0[0], r1[0], r0[1], r1[1]}; OUT = *reinterpret_cast<bf16x8*>(&w); } while (0)
    PK4(p0, 0, pa0); PK4(p0, 8, pa1); PK4(p1, 0, pa2); PK4(p1, 8, pa3);
#undef PK4
}
template <int KB>
__device__ __forceinline__ void qkt(f32x16& p0, f32x16& p1, const char* K_lds, int r32, int hi, const bf16x8* qr, const float* bp  ) {
    { const f32x4 a = *(const f32x4*)(bp), b = *(const f32x4*)(bp + 8), c = *(const f32x4*)(bp + 16), d = *(const f32x4*)(bp + 24);
      p0 = (f32x16){a[0], a[1], a[2], a[3], b[0], b[1], b[2], b[3], c[0], c[1], c[2], c[3], d[0], d[1], d[2], d[3]}; }
    { const f32x4 a = *(const f32x4*)(bp + 32), b = *(const f32x4*)(bp + 40), c = *(const f32x4*)(bp + 48), d = *(const f32x4*)(bp + 56);
      p1 = (f32x16){a[0], a[1], a[2], a[3], b[0], b[1], b[2], b[3], c[0], c[1], c[2], c[3], d[0], d[1], d[2], d[3]}; }
    const char* kb[4];
#pragma unroll
    for (int dd = 0; dd < 4; ++dd) kb[dd] = K_lds + KB * SHM_K + KSWZ(r32, (dd * 16 + hi * 8) * 2);
#pragma unroll
    for (int d0 = 0; d0 < 8; ++d0) { const char* a = kb[d0 & 3] + (d0 >> 2) * 128;
        bf16x8 b0 = *reinterpret_cast<const bf16x8*>(a);
        bf16x8 b1 = *reinterpret_cast<const bf16x8*>(a + 32 * 256);
        p0 = __builtin_amdgcn_mfma_f32_32x32x16_bf16(b0, qr[d0], p0, 0, 0, 0);
        p1 = __builtin_amdgcn_mfma_f32_32x32x16_bf16(b1, qr[d0], p1, 0, 0, 0); }
}
template <int VB>
__device__ __forceinline__ void pv_tile(f32x16* o, int vb0, bf16x8 pa0, bf16x8 pa1, bf16x8 pa2, bf16x8 pa3) {
#define TRRD(dst, off) asm volatile("ds_read_b64_tr_b16 %0, %1 offset:%2" : "=&v"(dst) : "v"(vb0), "i"(off) : "memory")
#define PV_D0(d0) do { s16x4 l0, l1, l2, l3, h0, h1, h2_, h3; constexpr int b_ = VB * SHM_V + v_rd_off(d0, 0, 0); \
        TRRD(l0, b_); TRRD(h0, b_ + 2048); TRRD(l1, b_ + 4096); TRRD(h1, b_ + 6144); TRRD(l2, b_ + 8192); TRRD(h2_, b_ + 10240); TRRD(l3, b_ + 12288); TRRD(h3, b_ + 14336); \
        asm volatile("s_waitcnt lgkmcnt(0)" ::: "memory"); SBAR();   \
        o[d0] = __builtin_amdgcn_mfma_f32_32x32x16_bf16(pa0, (bf16x8){l0[0], l0[1], l0[2], l0[3], h0[0], h0[1], h0[2], h0[3]}, o[d0], 0, 0, 0);   \
        o[d0] = __builtin_amdgcn_mfma_f32_32x32x16_bf16(pa1, (bf16x8){l1[0], l1[1], l1[2], l1[3], h1[0], h1[1], h1[2], h1[3]}, o[d0], 0, 0, 0);   \
        o[d0] = __builtin_amdgcn_mfma_f32_32x32x16_bf16(pa2, (bf16x8){l2[0], l2[1], l2[2], l2[3], h2_[0], h2_[1], h2_[2], h2_[3]}, o[d0], 0, 0, 0);   \
        o[d0] = __builtin_amdgcn_mfma_f32_32x32x16_bf16(pa3, (bf16x8){l3[0], l3[1], l3[2], l3[3], h3[0], h3[1], h3[2], h3[3]}, o[d0], 0, 0, 0); } while (0)
    PV_D0(0); PV_D0(1); PV_D0(2); PV_D0(3);
#undef PV_D0
#undef TRRD
}

struct BlockRef { const GAS bf16_t* Q; const GAS bf16_t* K; const GAS bf16_t* V; GAS bf16_t* O; const GAS float* qss; const GAS float* kss; const GAS float* cc; const GAS float* gg;
                  int P0, skv; };
constexpr int LDQ = 5120, LDK = 5120, LDO = 2048, LDSS = 112;
struct Seam { bf16x8 qr[8]; bf16x8 st_v0, st_v1, st_k0, st_k1; int jlo; };
#define ROWK(p, k0, rr) ((p) + (size_t)((k0) + (rr)) * LDK + sc)
#define VMW() asm volatile("s_waitcnt vmcnt(0)" ::: "memory")
#define VMWN(n) asm volatile("s_waitcnt vmcnt(%0)" :: "i"(n) : "memory")
#define SLOAD_H(Kp, Vp, k0) do { S.st_v0 = load8(ROWK(Vp, k0, sr)); S.st_v1 = load8(ROWK(Vp, k0, 32 + sr));              \
                         S.st_k0 = load8(ROWK(Kp, k0, sr)); S.st_k1 = load8(ROWK(Kp, k0, 32 + sr)); } while (0)
#define SWRITE_HK(bf, k0) do { *(bf16x8*)(K_lds + (bf) * SHM_K + kws) = scale8(S.st_k0, ksr[(k0)]); *(bf16x8*)(K_lds + (bf) * SHM_K + kws + 32 * 256) = scale8(S.st_k1, ksr[(k0) + 32]); } while (0)
#define SWRITE_HV(bf) do { *(bf16x8*)(V_lds + (bf) * SHM_V + vst0) = S.st_v0; *(bf16x8*)(V_lds + (bf) * SHM_V + vst1) = S.st_v1; } while (0)
#define SWRITE_H(bf, k0) do { SWRITE_HV(bf); SWRITE_HK(bf, k0); } while (0)

__device__ __forceinline__ void attn_prime(const BlockRef& cur, char* lds, Seam& S, const int tid) {
    const int wid = __builtin_amdgcn_readfirstlane(tid >> 6), lane = tid & 63, r32 = lane & 31, hi = lane >> 5;
    const int sr = tid >> 4, sc = (tid & 15) * 8, kws = KSWZ(sr, sc * 2); char* K_lds = lds + 2 * SHM_V;
    float* ks_l = (float*)(lds + OFF_KS); float* bs_l = (float*)(lds + OFF_BS); const float* ksr = ks_l + sr;
    int j_hi = (cur.P0 + QB - 1) / KVBLK + 1; if (j_hi > cur.skv / KVBLK) j_hi = cur.skv / KVBLK;
    const int nkeys = j_hi * KVBLK;
    const float c0 = cur.cc ? cur.cc[cur.P0] : 0.f;
    int jlo = 0;
    if (cur.cc) { const float thr = cur.gg[128]; const int jd = cur.P0 / KVBLK;
        const float cv = lane <= jd ? cur.cc[lane * KVBLK + KVBLK - 1] : 0.f;
        const bool keep = lane > jd || (c0 - cv > -thr);
        jlo = __ffsll((long long)__ballot(keep)) - 1; }
    S.jlo = jlo;
    for (int s = jlo * KVBLK + tid; s < nkeys; s += NTHREADS) {
        const f32x4 p = *(const GAS f32x4*)(cur.kss + (size_t)s * LDSS);
        ks_l[s] = rsqrtf(((p[0] + p[1]) + (p[2] + p[3])) * (1.f / 128.f) + EPS);
        bs_l[s] = cur.cc ? (c0 - cur.cc[s]) * (1.f / SCALE) : 0.f;
    }
    __syncthreads();
    const int qrow = wid * QBLK + r32;
    const f32x4 qp = *(const GAS f32x4*)(cur.qss + (size_t)qrow * LDSS);
    const float rq = rsqrtf(((qp[0] + qp[1]) + (qp[2] + qp[3])) * (1.f / 128.f) + EPS);
#pragma unroll
    for (int d0 = 0; d0 < 8; ++d0) {
        const u32x4 w = *(const GAS u32x4*)(cur.Q + (size_t)qrow * LDQ + d0 * 16 + hi * 8);
        const f32x4 g0 = *(const GAS f32x4*)(cur.gg + d0 * 16 + hi * 8), g1 = *(const GAS f32x4*)(cur.gg + d0 * 16 + hi * 8 + 4);
        u32x4 o; o.x = cvtpk(bf_lo(w.x) * rq * g0[0], bf_hi(w.x) * rq * g0[1]); o.y = cvtpk(bf_lo(w.y) * rq * g0[2], bf_hi(w.y) * rq * g0[3]);
        o.z = cvtpk(bf_lo(w.z) * rq * g1[0], bf_hi(w.z) * rq * g1[1]); o.w = cvtpk(bf_lo(w.w) * rq * g1[2], bf_hi(w.w) * rq * g1[3]);
        S.qr[d0] = *reinterpret_cast<bf16x8*>(&o);
    }
    SLOAD_H(cur.K, cur.V, jlo * KVBLK); VMW(); SWRITE_HK(0, jlo * KVBLK);
    __syncthreads();
}
__device__ __forceinline__ void attn_block(const BlockRef& cur, char* lds, Seam& S, const int tid) {
    const int wid = __builtin_amdgcn_readfirstlane(tid >> 6), lane = tid & 63, r32 = lane & 31, hi = lane >> 5;
    const int W = WBIG;
    int j_hi = (cur.P0 + QB - 1) / KVBLK + 1; if (j_hi > cur.skv / KVBLK) j_hi = cur.skv / KVBLK;
    const int j_lo = S.jlo; const int NT = j_hi - j_lo;
    const int qlo = cur.P0 - j_lo * KVBLK + wid * QBLK, qm = qlo + r32 - 4 * hi;
    char* V_lds = lds; char* K_lds = lds + 2 * SHM_V;
    float* ws = (float*)(lds + OFF_WS) + wid * 64; float* li_l = ws, * al_l = ws + 32;
    const float* bs_l = (const float*)(lds + OFF_BS) + j_lo * KVBLK + 4 * hi;
    float m_reg = -1e30f, l_reg = 0; f32x16 o[4] = {};
    const int sr = tid >> 4, sc = (tid & 15) * 8, vst0 = v_st(sr, sc), vst1 = v_st(32 + sr, sc), kws = KSWZ(sr, sc * 2);
    const float* ksr = (const float*)(lds + OFF_KS) + j_lo * KVBLK + sr;
    const int vb0 = (int)(uintptr_t)V_lds + v_rd_base(lane);
    const GAS bf16_t* Kh = cur.K + (size_t)j_lo * KVBLK * LDK; const GAS bf16_t* Vh = cur.V + (size_t)j_lo * KVBLK * LDK;
#define RESC(a) do { if (__any((a) < 1.f)) { if (hi == 0) al_l[r32] = (a); asm volatile("s_waitcnt lgkmcnt(0)" ::: "memory");              \
                     for (int d_ = 0; d_ < 4; ++d_) for (int r = 0; r < 16; ++r) o[d_][r] *= al_l[crow(r, hi)]; } } while (0)
#define KBASE(t) ((t) * KVBLK)
#define MASKT(P0_, P1_, t) do { const int kb_ = KBASE(t); if (kb_ + KVBLK - 1 > qlo) mask_tile(P0_, P1_, qm - kb_, (unsigned)W); } while (0)
    f32x16 pA0, pA1, pB0, pB1; float mnA, mnB, alA, alB; bf16x8 pa0, pa1, pa2, pa3;
    SWRITE_HV(0); SBAR();
    if (NT > 1) { SLOAD_H(Kh, Vh, KBASE(1)); }
    SBAR(); qkt<0>(pA0, pA1, K_lds, r32, hi, S.qr, bs_l + KBASE(0));
    MASKT(pA0, pA1, 0); partialSM(pA0, pA1, m_reg, mnA, alA);
    if (NT > 1) { VMW(); SWRITE_H(1, KBASE(1)); }
    __syncthreads();
#define HALF_STEP(PX0, PX1, mnX, alX, PY0, PY1, alY, t, KB, VB, SB) do {                                                      \
        SBAR(); qkt<KB>(PX0, PX1, K_lds, r32, hi, S.qr, bs_l + KBASE(t));                                                         \
        finishSM(PY0, PY1, alY, l_reg, pa0, pa1, pa2, pa3); SBAR();                                                           \
        if ((t) + 1 < NT) { SLOAD_H(Kh, Vh, KBASE((t) + 1)); SBAR(); }                                               \
        pv_tile<VB>(o, vb0, pa0, pa1, pa2, pa3); MASKT(PX0, PX1, (t)); partialSM(PX0, PX1, m_reg, mnX, alX);                                        \
        __syncthreads();                                                                                                      \
        if ((t) + 1 < NT) { VMW(); SWRITE_H(SB, KBASE((t) + 1)); }                                                                          \
        RESC(alX); __syncthreads(); } while (0)
    for (int t = 1; t + 1 < NT; t += 2) {
        HALF_STEP(pB0, pB1, mnB, alB, pA0, pA1, alA, t, 1, 0, 0);
        HALF_STEP(pA0, pA1, mnA, alA, pB0, pB1, alB, t + 1, 0, 1, 1);
    }
    const bool even = (NT & 1) == 0;
    if (even) { SBAR(); qkt<1>(pB0, pB1, K_lds, r32, hi, S.qr, bs_l + KBASE(NT - 1)); SBAR(); }
    finishSM(pA0, pA1, alA, l_reg, pa0, pa1, pa2, pa3); SBAR();
    pv_tile<0>(o, vb0, pa0, pa1, pa2, pa3);
    if (even) { MASKT(pB0, pB1, NT - 1); partialSM(pB0, pB1, m_reg, mnB, alB); __syncthreads(); RESC(alB);
        finishSM(pB0, pB1, alB, l_reg, pa0, pa1, pa2, pa3); SBAR(); pv_tile<1>(o, vb0, pa0, pa1, pa2, pa3); }
    SBAR();
    if (hi == 0) li_l[r32] = l_reg; asm volatile("s_waitcnt lgkmcnt(0)" ::: "memory");
    float rli[16];
#pragma unroll
    for (int r = 0; r < 16; ++r) rli[r] = __builtin_amdgcn_rcpf(li_l[crow(r, hi)]);
    GAS bf16_t* Ow = cur.O + (size_t)(wid * QBLK) * LDO;
#pragma unroll
    for (int r = 0; r < 16; ++r) { const int orow = crow(r, hi);
#pragma unroll
        for (int d0 = 0; d0 < 4; ++d0) { const float v = o[d0][r] * rli[r];
            const float vn = dppf<0xB1>(v);
            if ((r32 & 1) == 0) *(GAS unsigned*)(Ow + (size_t)orow * LDO + d0 * 32 + r32) = cvtpk(v, vn); } }
    __syncthreads();
#undef RESC
#undef KBASE
#undef MASKT
#undef HALF_STEP
}
#undef ROWK
#undef VMW
#undef VMWN
#undef SLOAD_H
#undef SWRITE_HK
#undef SWRITE_HV
#undef SWRITE_H
#undef KSWZ
#undef SBAR
}


struct Frame {
    GAS unsigned char* ws; const float* const* in_; GAS float* out;
    __device__ __forceinline__ const GAS float* in(int i) const { return (const GAS float*)in_[i]; }
    int tid, lane, wave, gw, ngw, gtid, ngt;
};
enum { I_X = 0, I_MEM, I_ANORM, I_AWIN, I_ACONVW, I_ACONVB, I_AGATEW, I_AGATEB, I_ALAMBDA, I_AWOUT, I_SNORM, I_SWKVF, I_SBF, I_SKNORM, I_BNORM, I_BWIN, I_BQNORM, I_BWOUT,
       I_MNORM, I_MWKV, I_MQNORM, I_MKNORM, I_PNORM, I_PWQ, I_PSUBK, I_PU, I_PV, N_IN };

struct TrItem { const GAS float* W; const GAS float* gain; GAS bf16_t* WT; int ldw, ldt, row_off, k0, n0; };
__device__ __forceinline__ void tr_load(const TrItem& d, float (&wv)[32], int lane) {
#pragma unroll
    for (int i = 0; i < 32; ++i) wv[i] = __builtin_nontemporal_load(d.W + (size_t)(d.k0 + 2 * i + (lane >> 5)) * d.ldw + d.n0 + (lane & 31));
}
__device__ __forceinline__ void tr_proc(const TrItem& d, float (&wv)[32], LAS float* scr, int lane) {
    if (d.gain) {
#pragma unroll
        for (int i = 0; i < 32; ++i) wv[i] *= d.gain[d.k0 + 2 * i + (lane >> 5)]; }
#pragma unroll
    for (int i = 0; i < 32; ++i) scr[(2 * i + (lane >> 5)) * 33 + (lane & 31)] = wv[i];
    asm volatile("s_waitcnt lgkmcnt(0)" ::: "memory");
    const int c = lane & 7;
#pragma unroll
    for (int j = 0; j < 4; ++j) { const int n = (lane >> 3) + 8 * j; const LAS float* s = scr + (8 * c) * 33 + n;
        u32x4 o; o.x = cvtpk(s[0 * 33], s[1 * 33]); o.y = cvtpk(s[2 * 33], s[3 * 33]); o.z = cvtpk(s[4 * 33], s[5 * 33]); o.w = cvtpk(s[6 * 33], s[7 * 33]);
        *(GAS u32x4*)(d.WT + (size_t)(d.row_off + d.n0 + n) * d.ldt + d.k0 + 8 * c) = o; }
    asm volatile("s_waitcnt lgkmcnt(0)" ::: "memory");
}
__device__ __forceinline__ void transpose_item_fp8(const GAS float* W, int ldw, const GAS float* gain, GAS unsigned char* WT, int ldt, LAS float* scr, int nblk, int item, int lane) {
    const int kb = item / nblk, nb = item % nblk, k0 = 64 * kb, n0 = 32 * nb;
    float wv[32];
#pragma unroll
    for (int i = 0; i < 32; ++i) wv[i] = W[(size_t)(k0 + 2 * i + (lane >> 5)) * ldw + n0 + (lane & 31)];
#pragma unroll
    for (int i = 0; i < 32; ++i) wv[i] *= gain[k0 + 2 * i + (lane >> 5)] * 64.f;
#pragma unroll
    for (int i = 0; i < 32; ++i) scr[(2 * i + (lane >> 5)) * 33 + (lane & 31)] = wv[i];
    asm volatile("s_waitcnt lgkmcnt(0)" ::: "memory");
    const int c = lane & 3;
#pragma unroll
    for (int j = 0; j < 2; ++j) { const int n = (lane >> 2) + 16 * j; const LAS float* sp = scr + (16 * c) * 33 + n; u32x4 o;
#pragma unroll
        for (int w = 0; w < 4; ++w) { int pk = __builtin_amdgcn_cvt_pk_fp8_f32(sp[(4 * w) * 33], sp[(4 * w + 1) * 33], 0, false); pk = __builtin_amdgcn_cvt_pk_fp8_f32(sp[(4 * w + 2) * 33], sp[(4 * w + 3) * 33], pk, true); o[w] = (unsigned)pk; }
        *(GAS u32x4*)(WT + (size_t)(n0 + n) * ldt + k0 + 16 * c) = o; }
    asm volatile("s_waitcnt lgkmcnt(0)" ::: "memory");
}
struct CtRow { f32x4 v[8]; GAS unsigned char* dst; int row, which; };
__device__ __forceinline__ void ct_load(Frame& F, int layer, int it, CtRow& R) {
    R.which = it & 1; R.row = it >> 1;
    const GAS float* src = F.in(R.which ? I_PV : I_PU) + ((size_t)layer * NEXP + R.row) * DM + F.lane * 4;
    R.dst = F.ws + O_TAB + (size_t)(layer * 2 + R.which) * TAB_ONE;
#pragma unroll
    for (int c = 0; c < 8; ++c) R.v[c] = __builtin_nontemporal_load((const GAS f32x4*)(src + c * 256));
}
__device__ __forceinline__ void ct_proc(Frame& F, int layer, CtRow& R) {
    const GAS float* gn = F.in(I_PNORM) + layer * DM + F.lane * 4;
    _Float16 shv = (_Float16)0.f;
#pragma unroll
    for (int c = 0; c < 8; ++c) { f32x4 x = R.v[c]; if (!R.which) x = x * *(const GAS f32x4*)(gn + c * 256);
        float amax = fmaxf(fmaxf(fabsf(x[0]), fabsf(x[1])), fmaxf(fabsf(x[2]), fabsf(x[3])));
        amax = wave_max(amax);
        const _Float16 sh = (_Float16)fmaxf(amax * (R.which ? 1.f / 6.f : 1.f / 7.f), 1e-6f);
        const float qs = __builtin_amdgcn_rcpf((float)sh);
        unsigned pk;
        if (R.which) { pk = __builtin_amdgcn_cvt_scalef32_pk_fp4_f32(0u, x[0] * qs, x[1] * qs, 1.0f, 0); pk = __builtin_amdgcn_cvt_scalef32_pk_fp4_f32(pk, x[2] * qs, x[3] * qs, 1.0f, 1); }
        else { const int q0 = (int)fminf(fmaxf(rintf(x[0] * qs), -7.f), 7.f), q1 = (int)fminf(fmaxf(rintf(x[1] * qs), -7.f), 7.f), q2 = (int)fminf(fmaxf(rintf(x[2] * qs), -7.f), 7.f), q3 = (int)fminf(fmaxf(rintf(x[3] * qs), -7.f), 7.f);
               pk = (unsigned)(q0 & 15) | ((unsigned)(q1 & 15) << 4) | ((unsigned)(q2 & 15) << 8) | ((unsigned)(q3 & 15) << 12); }
        *(GAS unsigned short*)(R.dst + ((size_t)c * NEXP + R.row) * 128 + F.lane * 2) = (unsigned short)pk;
        shv = (F.lane == c) ? sh : shv; }
    if (F.lane < 8) *(GAS unsigned short*)(R.dst + TAB_NIB + ((size_t)R.row * 8 + F.lane) * 2) = __builtin_bit_cast(unsigned short, shv);
}
__device__ __forceinline__ void convert_tables(Frame& F, int layer, int ibeg, int iend, int wk, int nwk) {
    if (ibeg + wk >= iend) return;
    const int ilast = ibeg + wk + ((iend - 1 - ibeg - wk) / nwk) * nwk;
    CtRow A, B;
    ct_load(F, layer, ibeg + wk, A);
    for (int it = ibeg + wk; it < iend; it += 2 * nwk) {
        ct_load(F, layer, it + nwk <= ilast ? it + nwk : ilast, B);
        ct_proc(F, layer, A);
        ct_load(F, layer, it + 2 * nwk <= ilast ? it + 2 * nwk : ilast, A);
        if (it + nwk < iend) ct_proc(F, layer, B);
    }
}
__device__ __forceinline__ void norm_row_bf16(const GAS float* xrow, const GAS float* gain, GAS bf16_t* orow, int lane) {
    f32x4 v[8]; float s = 0.f;
#pragma unroll
    for (int j = 0; j < 8; ++j) { v[j] = *(const GAS f32x4*)(xrow + j * 256 + lane * 4); s += (v[j][0] * v[j][0] + v[j][1] * v[j][1]) + (v[j][2] * v[j][2] + v[j][3] * v[j][3]); }
    const float r = rsqrtf(wave_sum(s) * (1.f / DM) + EPS);
#pragma unroll
    for (int j = 0; j < 8; ++j) { f32x4 g = gain ? *(const GAS f32x4*)(gain + j * 256 + lane * 4) : (f32x4){1.f, 1.f, 1.f, 1.f};
        u32x2 o; o.x = cvtpk(v[j][0] * r * g[0], v[j][1] * r * g[1]); o.y = cvtpk(v[j][2] * r * g[2], v[j][3] * r * g[3]);
        *(GAS u32x2*)(orow + j * 256 + lane * 4) = o; }
}
__device__ __forceinline__ void step_prologue(Frame& F, LAS unsigned char* lds) {
    LAS float* scr = (LAS float*)(lds + F.wave * 16384);
    GAS unsigned char* ws = F.ws;
    constexpr int I0 = 32 * (NIN0 / 32), I1 = 32 * 64, I2 = 32 * 96, I3 = 32 * 64, I4 = 32 * 64, I5 = 32 * 64, I6 = 32 * 64, I7 = 32 * 32, I8 = 32 * 32, I9 = 12 * 16;
    constexpr int NITEMS = I0 + I1 + I2 + I3 + I4 + I5 + I6 + I7 + I8 + I9;
#define TR_DESC(D, it_) do { int r = (it_) < NITEMS ? (it_) : NITEMS - 1; int nblk; \
        if (r < I0) { D = {F.in(I_AWIN), F.in(I_ANORM), (GAS bf16_t*)(ws + O_WIN0), NIN0, DM, 0, 0, 0}; nblk = NIN0 / 32; } else { r -= I0; \
        if (r < I1) { D = {F.in(I_AWOUT), nullptr, (GAS bf16_t*)(ws + O_WOUT0), DM, DM, 0, 0, 0}; nblk = 64; } else { r -= I1; \
        if (r < I2) { D = {F.in(I_SWKVF), F.in(I_SNORM), (GAS bf16_t*)(ws + O_WL1), 3084, DM, 0, 0, 0}; nblk = 96; } else { r -= I2; \
        if (r < I3) { D = {F.in(I_BWIN), F.in(I_BNORM), (GAS bf16_t*)(ws + O_WL1), DM, DM, 3072, 0, 0}; nblk = 64; } else { r -= I3; \
        if (r < I4) { D = {F.in(I_BWOUT), nullptr, (GAS bf16_t*)(ws + O_WOUT1), DM, DM, 0, 0, 0}; nblk = 64; } else { r -= I4; \
        if (r < I5) { D = {F.in(I_PWQ), F.in(I_PNORM), (GAS bf16_t*)(ws + O_WQ0), DM, DM, 0, 0, 0}; nblk = 64; } else { r -= I5; \
        if (r < I6) { D = {F.in(I_PWQ) + (size_t)DM * DM, F.in(I_PNORM) + DM, (GAS bf16_t*)(ws + O_WQ1), DM, DM, 0, 0, 0}; nblk = 64; } else { r -= I6; \
        if (r < I7) { D = {F.in(I_MWKV), nullptr, (GAS bf16_t*)(ws + O_WMKV), 1024, DM, 0, 0, 0}; nblk = 32; } else { r -= I7; \
        if (r < I8) { D = {F.in(I_MWKV) + (size_t)DM * 1024, nullptr, (GAS bf16_t*)(ws + O_WMKV) + (size_t)1024 * DM, 1024, DM, 0, 0, 0}; nblk = 32; } else { r -= I8; \
          const int blk = r / 16; r = r % 16; D = {F.in(I_AGATEW) + (size_t)blk * 128 * 256, nullptr, (GAS bf16_t*)(ws + O_WGATE), 256, 128, blk * 256, 0, 0}; nblk = 8; } } } } } } } } } \
        D.k0 = 64 * (r / nblk); D.n0 = 32 * (r % nblk); } while (0)
    for (int it = F.gw; it < NITEMS; it += F.ngw) { float wv[32]; TrItem d; TR_DESC(d, it); tr_load(d, wv, F.lane); tr_proc(d, wv, scr, F.lane); }
#undef TR_DESC
    { const GAS float* sk = F.in(I_PSUBK); GAS bf16_t* o = (GAS bf16_t*)(ws + O_SUBK);
      for (int i = F.gtid; i < 2 * 16 * 128 * 128 / 2; i += F.ngt) *(GAS unsigned*)(o + 2 * i) = cvtpk(sk[2 * i], sk[2 * i + 1]); }
    { GAS float* wf = (GAS float*)(ws + O_WF); const GAS float* w = F.in(I_SWKVF); const GAS float* g = F.in(I_SNORM);
      for (int i = F.gtid; i < 12 * DM; i += F.ngt) { const int j = i / DM, k = i % DM; wf[i] = w[(size_t)k * 3084 + 3072 + j] * g[k]; } }
    { GAS float* spl = (GAS float*)(ws + O_SPL); const GAS float* lam = F.in(I_ALAMBDA);
      for (int i = F.gtid; i < LRU; i += F.ngt) { const float z = -lam[i]; spl[i] = fmaxf(z, 0.f) + log1p_pos(fast_exp(-fabsf(z))); } }
    if (F.gw == 0) {
        float m = 0.f; for (int d = F.lane; d < 128; d += 64) m = fmaxf(m, fabsf(F.in(I_BQNORM)[d] * F.in(I_SKNORM)[d]));
        m = wave_max(m);
        if (F.lane == 0) ((GAS float*)(ws + O_GG))[512] = 2.f * 11.3137085f * m + 30.f; }
    { GAS float* gg = (GAS float*)(ws + O_GG);
      for (int i = F.gtid; i < 384; i += F.ngt) { const int a = i / 128, d = i % 128;
          gg[a == 0 ? 384 + d : i] = a == 0 ? F.in(I_BQNORM)[d] * F.in(I_SKNORM)[d] : F.in(I_MQNORM)[(a - 1) * 128 + d] * F.in(I_MKNORM)[(a - 1) * 128 + d]; } }
    {
        const GAS float* xin = F.in(I_X) + F.lane * 4; GAS bf16_t* xo = (GAS bf16_t*)(ws + O_XS16) + F.lane * 4;
        const int mlast = F.gw + ((T - 1 - F.gw) / F.ngw) * F.ngw;
#define XN_LOAD(V, m_) do { const int mm_ = (m_) <= mlast ? (m_) : mlast; _Pragma("unroll") for (int j = 0; j < 8; ++j) V[j] = __builtin_nontemporal_load((const GAS f32x4*)(xin + (size_t)mm_ * DM + j * 256)); } while (0)
#define XN_PROC(V, m_) do { if ((m_) < T) { float s0 = 0.f; _Pragma("unroll") for (int j = 0; j < 8; ++j) s0 += (V[j][0] * V[j][0] + V[j][1] * V[j][1]) + (V[j][2] * V[j][2] + V[j][3] * V[j][3]); \
            const float r0 = rsqrtf(wave_sum(s0) * (1.f / DM) + EPS); \
            _Pragma("unroll") for (int j = 0; j < 8; ++j) { u32x2 a; a.x = cvtpk(V[j][0] * r0, V[j][1] * r0); a.y = cvtpk(V[j][2] * r0, V[j][3] * r0); *(GAS u32x2*)(xo + (size_t)(m_) * DM + j * 256) = a; } } } while (0)
        f32x4 va[8], vb[8];
        XN_LOAD(va, F.gw);
        for (int m = F.gw; m < T; m += 2 * F.ngw) { XN_LOAD(vb, m + F.ngw); XN_PROC(va, m); XN_LOAD(va, m + 2 * F.ngw); XN_PROC(vb, m + F.ngw); }
#undef XN_LOAD
#undef XN_PROC
    }
    for (int m = F.gw; m < 2 * NMROW; m += F.ngw) { const int l = m / NMROW, r = m % NMROW;
        norm_row_bf16(F.in(I_MEM) + (size_t)r * DM, F.in(I_MNORM) + l * DM, (GAS bf16_t*)(ws + O_MEMN) + (size_t)m * DM, F.lane); }
    convert_tables(F, 0, 0, 2 * NEXP, F.gw, F.ngw);
}
__device__ __forceinline__ void step_conv(Frame& F) {
    const GAS bf16_t* zx = (const GAS bf16_t*)(F.ws + O_ZX); GAS bf16_t* xc = (GAS bf16_t*)(F.ws + O_XC);
    const GAS float* cw = F.in(I_ACONVW); const GAS float* cb = F.in(I_ACONVB);
    for (int it = F.gtid; it < T * (LRU / 8); it += F.ngt) {
        const int t = it / (LRU / 8), c8 = (it % (LRU / 8)) * 8, pos = t & (SEQ - 1);
        float a[8];
#pragma unroll
        for (int j = 0; j < 8; ++j) a[j] = cb[c8 + j];
#pragma unroll
        for (int k = 0; k < 4; ++k) { if (pos - 3 + k >= 0) { const u32x4 w = *(const GAS u32x4*)(zx + (size_t)(t - 3 + k) * LRU + c8);
            const float xv[8] = {bf_lo(w.x), bf_hi(w.x), bf_lo(w.y), bf_hi(w.y), bf_lo(w.z), bf_hi(w.z), bf_lo(w.w), bf_hi(w.w)};
#pragma unroll
            for (int j = 0; j < 8; ++j) a[j] = fmaf(cw[k * LRU + c8 + j], xv[j], a[j]); } }
        u32x4 o; o.x = cvtpk(a[0], a[1]); o.y = cvtpk(a[2], a[3]); o.z = cvtpk(a[4], a[5]); o.w = cvtpk(a[6], a[7]);
        *(GAS u32x4*)(xc + (size_t)t * LRU + c8) = o;
    }
}
constexpr int SCK = 32, NCK = SEQ / SCK;
typedef _Float16 h8_t __attribute__((ext_vector_type(8)));
__device__ __forceinline__ void scan_load(const GAS _Float16* LA, const GAS _Float16* UH, size_t off, float (&a)[8], float (&u)[8]) {
    const h8_t l = *(const GAS h8_t*)(LA + off), w = *(const GAS h8_t*)(UH + off);
#pragma unroll
    for (int k = 0; k < 8; ++k) { a[k] = fast_exp((float)l[k]); u[k] = (float)w[k]; }
}
__device__ __forceinline__ void step_scan1(Frame& F) {
    const GAS _Float16* LA = (const GAS _Float16*)(F.ws + O_AA); const GAS _Float16* UH = (const GAS _Float16*)(F.ws + O_UU);
    GAS float* CA = (GAS float*)(F.ws + O_LOGFP); GAS float* CH = CA + (size_t)NB * NCK * LRU;
    if (F.tid >= 384) return;
    const int grp = F.tid / 192, th = F.tid % 192;
    for (int it = blockIdx.x * 2 + grp; it < NB * NCK; it += gridDim.x * 2) {
        const int b = it / NCK, ck = it % NCK; const size_t base = ((size_t)b * SEQ + ck * SCK) * LRU + th * 8;
        float ap[8], h[8];
#pragma unroll
        for (int k = 0; k < 8; ++k) { ap[k] = 1.f; h[k] = 0.f; }
#pragma unroll 8
        for (int i = 0; i < SCK; ++i) { float a[8], u[8]; scan_load(LA, UH, base + (size_t)i * LRU, a, u);
#pragma unroll
            for (int k = 0; k < 8; ++k) { ap[k] *= a[k]; h[k] = a[k] * h[k] + u[k]; } }
        GAS float* ca = CA + (size_t)it * LRU + th * 8; GAS float* ch = CH + (size_t)it * LRU + th * 8;
        *(GAS f32x4*)ca = (f32x4){ap[0], ap[1], ap[2], ap[3]}; *(GAS f32x4*)(ca + 4) = (f32x4){ap[4], ap[5], ap[6], ap[7]};
        *(GAS f32x4*)ch = (f32x4){h[0], h[1], h[2], h[3]}; *(GAS f32x4*)(ch + 4) = (f32x4){h[4], h[5], h[6], h[7]};
    }
}
__device__ __forceinline__ void step_scan2(Frame& F) {
    const GAS _Float16* LA = (const GAS _Float16*)(F.ws + O_AA); const GAS _Float16* UH = (const GAS _Float16*)(F.ws + O_UU);
    const GAS float* CA = (const GAS float*)(F.ws + O_LOGFP); const GAS float* CH = CA + (size_t)NB * NCK * LRU;
    const GAS bf16_t* gy = (const GAS bf16_t*)(F.ws + O_GY); GAS bf16_t* cat = (GAS bf16_t*)(F.ws + O_CAT);
    if (F.tid >= 384) return;
    const int grp = F.tid / 192, th = F.tid % 192;
    for (int it = blockIdx.x * 2 + grp; it < NB * NCK; it += gridDim.x * 2) {
        const int b = it / NCK, ck = it % NCK; const size_t base = ((size_t)b * SEQ + ck * SCK) * LRU + th * 8;
        float h[8];
#pragma unroll
        for (int k = 0; k < 8; ++k) h[k] = 0.f;
        for (int k2 = 0; k2 < ck; ++k2) { const size_t o = (size_t)(b * NCK + k2) * LRU + th * 8;
            const f32x4 a0 = *(const GAS f32x4*)(CA + o), a1 = *(const GAS f32x4*)(CA + o + 4), c0 = *(const GAS f32x4*)(CH + o), c1 = *(const GAS f32x4*)(CH + o + 4);
#pragma unroll
            for (int k = 0; k < 4; ++k) { h[k] = a0[k] * h[k] + c0[k]; h[4 + k] = a1[k] * h[4 + k] + c1[k]; } }
#pragma unroll 8
        for (int i = 0; i < SCK; ++i) { float a[8], u[8]; scan_load(LA, UH, base + (size_t)i * LRU, a, u);
            const size_t row = (size_t)b * SEQ + ck * SCK + i;
            const u32x4 g = *(const GAS u32x4*)(gy + row * LRU + th * 8); u32x4 o;
#pragma unroll
            for (int k = 0; k < 8; ++k) h[k] = a[k] * h[k] + u[k];
#pragma unroll
            for (int k = 0; k < 4; ++k) o[k] = cvtpk(h[2 * k] * bf_lo(g[k]), h[2 * k + 1] * bf_hi(g[k]));
            *(GAS u32x4*)(cat + row * DM + th * 8) = o; }
    }
}
__device__ __forceinline__ void step_cprefix(Frame& F, LAS unsigned char* lds) {
    const GAS float* lf = (const GAS float*)(F.ws + O_LOGF); GAS float* cc = (GAS float*)(F.ws + O_CC);
    LAS double* scr = (LAS double*)(lds + F.wave * 16384);
    for (int it = F.gw; it < NB * NH; it += F.ngw) {
        const GAS float* p = lf + (size_t)it * SEQ + F.lane * 64; GAS float* q = cc + (size_t)it * SEQ + F.lane * 64;
        double s = 0.0;
        for (int i = 0; i < 64; ++i) s += (double)p[i];
        scr[F.lane] = s;
        asm volatile("s_waitcnt lgkmcnt(0)" ::: "memory");
        double run = 0.0;
        for (int l = 0; l < 64; ++l) { const double v = scr[l]; if (l < F.lane) run += v; }
        for (int i = 0; i < 64; ++i) { run += (double)p[i]; q[i] = (float)run; }
        asm volatile("s_waitcnt lgkmcnt(0)" ::: "memory");
    }
}

__device__ __forceinline__ int ord_i(float f) { const int b = __float_as_int(f); return b ^ ((b >> 31) & 0x7fffffff); }
__device__ __forceinline__ float unord_f(int k) { return __int_as_float(k ^ ((k >> 31) & 0x7fffffff)); }
template <int N> __device__ __forceinline__ void bitonic_sort_desc(int (&a)[N]) {
#pragma unroll
    for (int k = 2; k <= N; k <<= 1) {
#pragma unroll
        for (int j = k >> 1; j > 0; j >>= 1) {
#pragma unroll
            for (int i = 0; i < N; ++i) { const int l = i ^ j;
                if (l > i) { const bool desc = ((i & k) == 0); const int mx = max(a[i], a[l]), mn = min(a[i], a[l]); a[i] = desc ? mx : mn; a[l] = desc ? mn : mx; } }
        }
    }
}
__device__ __forceinline__ void bitonic_merge16_desc(int (&a)[16]) {
#pragma unroll
    for (int j = 8; j > 0; j >>= 1) {
#pragma unroll
        for (int i = 0; i < 16; ++i) { const int l = i ^ j; if (l > i) { const int mx = max(a[i], a[l]), mn = min(a[i], a[l]); a[i] = mx; a[l] = mn; } }
    }
}
__device__ __forceinline__ void top16_of_64(int (&a)[64]) {
    int g[4][16];
#pragma unroll
    for (int q = 0; q < 4; ++q) {
#pragma unroll
        for (int i = 0; i < 16; ++i) g[q][i] = a[16 * q + i];
        bitonic_sort_desc<16>(g[q]); }
#pragma unroll
    for (int i = 0; i < 16; ++i) { g[0][i] = max(g[0][i], g[1][15 - i]); g[2][i] = max(g[2][i], g[3][15 - i]); }
    bitonic_merge16_desc(g[0]); bitonic_merge16_desc(g[2]);
#pragma unroll
    for (int i = 0; i < 16; ++i) g[0][i] = max(g[0][i], g[2][15 - i]);
    bitonic_merge16_desc(g[0]);
#pragma unroll
    for (int i = 0; i < 16; ++i) a[i] = g[0][i];
}
__device__ __forceinline__ void subkey_top16(const GAS bf16_t* qrow  , const GAS bf16_t* sk  , int r32, int hi, int (&top)[16]) {
    bf16x8 qf[8];
#pragma unroll
    for (int ks = 0; ks < 8; ++ks) qf[ks] = *(const GAS bf16x8*)(qrow + ks * 16 + hi * 8);
    unsigned loff = (unsigned)(r32 * 128 + hi * 8) * 2u; asm volatile("" : "+v"(loff));
    int key[64];
#pragma unroll
    for (int kb = 0; kb < 4; ++kb) {
        f32x16 acc = {};
#pragma unroll
        for (int ks = 0; ks < 8; ++ks) { const bf16x8 af = *(const GAS bf16x8*)((const GAS char*)(sk + kb * 32 * 128 + ks * 16) + loff);
            acc = __builtin_amdgcn_mfma_f32_32x32x16_bf16(af, qf[ks], acc, 0, 0, 0); }
#pragma unroll
        for (int r = 0; r < 16; ++r) { const int id = kb * 32 + (r & 3) + 8 * (r >> 2) + 4 * hi; key[kb * 16 + r] = (ord_i(acc[r]) & ~127) | (127 - id); }
        __builtin_amdgcn_sched_barrier(0);
    }
    top16_of_64(key);
#pragma unroll
    for (int i = 0; i < 16; ++i) { auto r = __builtin_amdgcn_permlane32_swap((unsigned)key[15 - i], (unsigned)key[15 - i], false, false);
        const int pk = hi ? (int)r[0] : (int)r[1]; top[i] = max(key[i], pk); }
    bitonic_merge16_desc(top);
}
__device__ __forceinline__ void step_topk(Frame& F, LAS unsigned char* lds, int layer) {
    const GAS bf16_t* q16 = (const GAS bf16_t*)(F.ws + O_Q16); const GAS bf16_t* subk = (const GAS bf16_t*)(F.ws + O_SUBK) + (size_t)layer * 16 * 128 * 128;
    GAS int* IDX = (GAS int*)(F.ws + O_IDX); GAS float* GW = (GAS float*)(F.ws + O_GW);
    LAS int* scr = (LAS int*)(lds + F.wave * 16384) + F.lane * 33;
    const int r32 = F.lane & 31, hi = F.lane >> 5;
    for (int task = F.gw; task < (T / 32) * 8; task += F.ngw) {
        const int tb = task >> 3, h = task & 7; const int tok = tb * 32 + r32;
        const GAS bf16_t* qrow = q16 + (size_t)tok * DM + h * 256;
        int ta[16], tb16[16];
        subkey_top16(qrow, subk + (size_t)(h * 2 + 0) * 128 * 128, r32, hi, ta);
        subkey_top16(qrow + 128, subk + (size_t)(h * 2 + 1) * 128 * 128, r32, hi, tb16);
        float va[16], vb[16];
#pragma unroll
        for (int i = 0; i < 16; ++i) { va[i] = unord_f(ta[i] & ~127); vb[i] = unord_f(tb16[i] & ~127); scr[i] = 127 - (ta[i] & 127); scr[16 + i] = 127 - (tb16[i] & 127); }
        int c2[64]; int n = 0;
#pragma unroll
        for (int i = 0; i < 16; ++i)
#pragma unroll
            for (int j = 0; j < 16; ++j) if ((i + 1) * (j + 1) <= 16) { c2[n] = (ord_i(va[i] + vb[j]) & ~255) | (255 - (i * 16 + j)); ++n; }
#pragma unroll
        for (int i = 50; i < 64; ++i) c2[i] = (int)0x80000000;
        top16_of_64(c2);
        asm volatile("s_waitcnt lgkmcnt(0)" ::: "memory");
        float sv[16], ex[16]; int ev[16]; float Z = 0.f;
#pragma unroll
        for (int r = 0; r < 16; ++r) { const int flat = 255 - (c2[r] & 255); sv[r] = unord_f(c2[r] & ~255); ev[r] = scr[flat >> 4] * 128 + scr[16 + (flat & 15)]; }
#pragma unroll
        for (int r = 0; r < 16; ++r) { ex[r] = fast_exp(sv[r] - sv[0]); Z += ex[r]; }
        const float iz = 1.f / Z;
        GAS int* ip = IDX + (size_t)tok * 128 + h * 16 + hi * 8; GAS float* gp = GW + (size_t)tok * 128 + h * 16 + hi * 8;
        int eo[8]; float go[8];
#pragma unroll
        for (int j = 0; j < 8; ++j) { eo[j] = hi ? ev[8 + j] : ev[j]; go[j] = (hi ? ex[8 + j] : ex[j]) * iz; }
        *(GAS u32x4*)ip = (u32x4){(unsigned)eo[0], (unsigned)eo[1], (unsigned)eo[2], (unsigned)eo[3]}; *(GAS u32x4*)(ip + 4) = (u32x4){(unsigned)eo[4], (unsigned)eo[5], (unsigned)eo[6], (unsigned)eo[7]};
        *(GAS f32x4*)gp = (f32x4){go[0], go[1], go[2], go[3]}; *(GAS f32x4*)(gp + 4) = (f32x4){go[4], go[5], go[6], go[7]};
        asm volatile("s_waitcnt lgkmcnt(0)" ::: "memory");
    }
}
__device__ __forceinline__ h2 as_h2(unsigned w) { return __builtin_bit_cast(h2, w); }
#define F4(W, s) __builtin_amdgcn_cvt_scalef32_pk_f16_fp4((W), 1.0f, (s))
#define H2F(us) ((float)__builtin_bit_cast(_Float16, (unsigned short)(us)))
__device__ __forceinline__ float sum8(float v) { v += dppf<0xB1>(v); v += dppf<0x4E>(v); v += dppf<0x141>(v); return v; }
__device__ __forceinline__ void step_xplanes(Frame& F) {
    const GAS bf16_t* xs = (const GAS bf16_t*)(F.ws + O_XS16); GAS unsigned char* x4 = F.ws + O_X4; GAS float* sx = (GAS float*)(F.ws + O_SX);
    for (int t = F.gw; t < T; t += F.ngw) {
        const GAS bf16_t* xr = xs + (size_t)t * DM + F.lane * 32;
        u32x4 w[4]; float xv[32]; float amax = 0.f;
#pragma unroll
        for (int c = 0; c < 4; ++c) w[c] = *(const GAS u32x4*)(xr + 8 * c);
#pragma unroll
        for (int c = 0; c < 4; ++c)
#pragma unroll
            for (int k = 0; k < 4; ++k) { xv[8 * c + 2 * k] = bf_lo(w[c][k]); xv[8 * c + 2 * k + 1] = bf_hi(w[c][k]); amax = fmaxf(amax, fmaxf(fabsf(xv[8 * c + 2 * k]), fabsf(xv[8 * c + 2 * k + 1]))); }
        amax = fmaxf(amax, dppf<0xB1>(amax)); amax = fmaxf(amax, dppf<0x4E>(amax)); amax = fmaxf(amax, dppf<0x141>(amax));
        const float sc = fmaxf(amax, 1e-20f) * (1.f / 119.f), qs = 1.f / sc;
        u32x4 hp, lp;
#pragma unroll
        for (int d = 0; d < 4; ++d) { unsigned hw = 0u, lw = 0u;
#pragma unroll
            for (int k = 0; k < 8; ++k) { const int q = (int)rintf(xv[8 * d + k] * qs); const int h = (q + 8) >> 4, l = q - 16 * h; hw |= (unsigned)(h & 15) << (4 * k); lw |= (unsigned)(l & 15) << (4 * k); }
            hp[d] = hw; lp[d] = lw; }
        *(GAS u32x4*)(x4 + ((size_t)t * 64 + F.lane) * 32) = hp; *(GAS u32x4*)(x4 + ((size_t)t * 64 + F.lane) * 32 + 16) = lp;
        if ((F.lane & 7) == 0) sx[(size_t)t * 8 + (F.lane >> 3)] = sc;
    }
}
__device__ __forceinline__ void step_upass(Frame& F, int layer, int G) {
    const int s = blockIdx.x & 7, wk = (blockIdx.x >> 3) * NWAVES + F.wave, nwk = (G >> 3) * NWAVES;
    const GAS unsigned char* UN = F.ws + O_TAB + (size_t)(layer * 2) * TAB_ONE + (size_t)s * NEXP * 128;
    const GAS int* IDX = (const GAS int*)(F.ws + O_IDX); const GAS unsigned char* x4 = F.ws + O_X4 + s * 256; const GAS float* sxp = (const GAS float*)(F.ws + O_SX) + s;
    GAS float* part = (GAS float*)(F.ws + O_PART) + (size_t)s * T * 128;
    unsigned lo = (unsigned)F.lane; asm volatile("" : "+v"(lo));
    const unsigned j = lo >> 3, p = lo & 7;
    const int tlast = wk + ((T - 1 - wk) / nwk) * nwk;
#define U_LOADID(ID, t_, q_) do { const int tt_ = (t_) <= tlast ? (t_) : tlast; _Pragma("unroll") for (int b = 0; b < 4; ++b) ID[b] = IDX[(size_t)tt_ * 128 + (q_) * 32 + 8 * b + j]; } while (0)
#define U_LOADX(t_) do { const int tt_ = (t_) <= tlast ? (t_) : tlast; xhn = *(const GAS u32x4*)(x4 + (size_t)tt_ * 2048 + p * 32); xln = *(const GAS u32x4*)(x4 + (size_t)tt_ * 2048 + p * 32 + 16); sxn = sxp[(size_t)tt_ * 8]; } while (0)
#define U_ISSUE(UB, ID) do { _Pragma("unroll") for (int b = 0; b < 4; ++b) UB[b] = *(const GAS u32x4*)(UN + (unsigned)(ID[b] * 128 + (int)p * 16)); } while (0)
#define U_QUARTER(UB, vout, q_) do { _Pragma("unroll") for (int b = 0; b < 4; ++b) { int ah = 0, al = 0; \
            ah = __builtin_amdgcn_sdot8((int)UB[b].x, (int)xh.x, ah, false); al = __builtin_amdgcn_sdot8((int)UB[b].x, (int)xl.x, al, false); \
            ah = __builtin_amdgcn_sdot8((int)UB[b].y, (int)xh.y, ah, false); al = __builtin_amdgcn_sdot8((int)UB[b].y, (int)xl.y, al, false); \
            ah = __builtin_amdgcn_sdot8((int)UB[b].z, (int)xh.z, ah, false); al = __builtin_amdgcn_sdot8((int)UB[b].z, (int)xl.z, al, false); \
            ah = __builtin_amdgcn_sdot8((int)UB[b].w, (int)xh.w, ah, false); al = __builtin_amdgcn_sdot8((int)UB[b].w, (int)xl.w, al, false); \
            const float d = sum8((float)(16 * ah + al)) * sxc; vout = (p == (unsigned)(4 * ((q_) & 1) + b)) ? d : vout; } } while (0)
    int idA[4], idB[4]; u32x4 u0[4], u1[4], u2[4], u3[4]; u32x4 xh, xl, xhn, xln; float sxc, sxn;
    U_LOADID(idA, wk, 0); U_LOADID(idB, wk, 1); U_LOADX(wk);
    U_ISSUE(u0, idA); U_LOADID(idA, wk, 2);
    U_ISSUE(u1, idB); U_LOADID(idB, wk, 3);
    U_ISSUE(u2, idA); U_LOADID(idA, wk + nwk, 0);
    xh = xhn; xl = xln; sxc = sxn;
    for (int t = wk; t < T; t += nwk) {
        float v0 = 0.f, v1 = 0.f;
        U_ISSUE(u3, idB); U_LOADID(idB, t + nwk, 1); U_LOADX(t + nwk);
        U_QUARTER(u0, v0, 0);
        U_ISSUE(u0, idA); U_LOADID(idA, t + nwk, 2);
        U_QUARTER(u1, v0, 1);
        U_ISSUE(u1, idB); U_LOADID(idB, t + nwk, 3);
        U_QUARTER(u2, v1, 2);
        U_ISSUE(u2, idA); U_LOADID(idA, t + 2 * nwk, 0);
        U_QUARTER(u3, v1, 3);
        part[(size_t)t * 128 + 8 * p + j] = v0; part[(size_t)t * 128 + 64 + 8 * p + j] = v1;
        xh = xhn; xl = xln; sxc = sxn;
    }
#undef U_LOADID
#undef U_LOADX
#undef U_ISSUE
#undef U_QUARTER
}
__device__ __forceinline__ void step_peer_reduce(Frame& F, int layer) {
    const GAS float* part = (const GAS float*)(F.ws + O_PART); const GAS float* GW = (const GAS float*)(F.ws + O_GW); const GAS int* IDX = (const GAS int*)(F.ws + O_IDX);
    const GAS float* rowss = (const GAS float*)(F.ws + O_ROWSS); GAS unsigned* PK = (GAS unsigned*)(F.ws + O_PK);
    const GAS unsigned char* SU = F.ws + O_TAB + (size_t)(layer * 2) * TAB_ONE + TAB_NIB; const GAS unsigned char* SV = SU + TAB_ONE;
    for (int it = F.gw; it < T * 2; it += F.ngw) { const int t = it >> 1; const size_t i = (size_t)it * 64 + F.lane;
        const float r = rsqrtf(wave_sum(rowss[(size_t)t * 32 + (F.lane & 31)]) * (0.5f / DM) + EPS);
        const int id = IDX[i];
        const u32x4 su = *(const GAS u32x4*)(SU + (size_t)id * 16), sv = *(const GAS u32x4*)(SV + (size_t)id * 16);
        float d = 0.f;
#pragma unroll
        for (int s = 0; s < 8; ++s) d += part[(size_t)s * T * 128 + i] * (float)__builtin_bit_cast(_Float16, (unsigned short)(su[s >> 1] >> (16 * (s & 1))));
        const float w = GW[i] * gelu_tanh(d * r);
#pragma unroll
        for (int s = 0; s < 8; ++s) { const _Float16 ws = (_Float16)(w * (float)__builtin_bit_cast(_Float16, (unsigned short)(sv[s >> 1] >> (16 * (s & 1)))));
            PK[(size_t)s * T * 128 + i] = ((unsigned)id << 16) | (unsigned)__builtin_bit_cast(unsigned short, ws); } }
}
__device__ __forceinline__ void step_vpass(Frame& F, int layer, int G, bool dry) {
    const int s = blockIdx.x & 7, wk = (blockIdx.x >> 3) * NWAVES + F.wave, nwk = (G >> 3) * NWAVES;
    const GAS unsigned char* VN = F.ws + O_TAB + (size_t)(layer * 2 + 1) * TAB_ONE + (size_t)s * NEXP * 128;
    const GAS unsigned* PK = (const GAS unsigned*)(F.ws + O_PK) + (size_t)s * T * 128;
    GAS bf16_t* xs = (GAS bf16_t*)(F.ws + O_XS16); GAS float* rsp = (GAS float*)(F.ws + O_RSP);
    unsigned lo = (unsigned)F.lane; asm volatile("" : "+v"(lo));
    const unsigned j = lo >> 3, p = lo & 7;
    const int tlast = wk + ((T - 1 - wk) / nwk) * nwk;
#define V_LOADPK(PKV, t_, q_) do { const int tt_ = (t_) <= tlast ? (t_) : tlast; _Pragma("unroll") for (int b = 0; b < 4; ++b) PKV[b] = PK[(size_t)tt_ * 128 + (q_) * 32 + 8 * b + j]; } while (0)
#define V_ISSUE(VB, PKV) do { _Pragma("unroll") for (int b = 0; b < 4; ++b) VB[b] = *(const GAS u32x4*)(VN + ((PKV[b] >> 16) * 128u + p * 16u)); } while (0)
#define V_CVT4(W, base) do { c_[(base)] = F4(W, 0); c_[(base) + 1] = F4(W, 1); c_[(base) + 2] = F4(W, 2); c_[(base) + 3] = F4(W, 3); } while (0)
#define V_QUARTER(VB, PKV) do { _Pragma("unroll") for (int b = 0; b < 4; ++b) { const _Float16 wl = __builtin_bit_cast(_Float16, (unsigned short)(PKV[b] & 0xffffu)); const h2 wl2 = {wl, wl}; h2 c_[16]; \
            V_CVT4(VB[b].x, 0); V_CVT4(VB[b].y, 4); V_CVT4(VB[b].z, 8); V_CVT4(VB[b].w, 12); \
            __builtin_amdgcn_sched_barrier(0); \
            _Pragma("unroll") for (int k = 0; k < 16; ++k) oh[k] = wl2 * c_[k] + oh[k]; \
            __builtin_amdgcn_sched_barrier(0); } } while (0)
    unsigned pk0[4], pk1[4], pk2[4], pk3[4], pkn[4]; u32x4 v0[4], v1[4], v2[4], v3[4];
    V_LOADPK(pk0, wk, 0); V_LOADPK(pk1, wk, 1); V_LOADPK(pk2, wk, 2); V_LOADPK(pkn, wk, 3);
    V_ISSUE(v0, pk0); V_ISSUE(v1, pk1); V_ISSUE(v2, pk2);
    for (int t = wk; t < T; t += nwk) {
#pragma unroll
        for (int b = 0; b < 4; ++b) pk3[b] = pkn[b];
        V_ISSUE(v3, pk3); V_LOADPK(pkn, t + nwk, 0);
        GAS float* xr = F.out + (size_t)t * DM + s * 256 + p * 32 + j * 4; f32x4 x2 = *(const GAS f32x4*)xr;
        h2 oh[16];
#pragma unroll
        for (int i = 0; i < 16; ++i) oh[i] = (h2){(_Float16)0.f, (_Float16)0.f};
        V_QUARTER(v0, pk0);
#pragma unroll
        for (int b = 0; b < 4; ++b) pk0[b] = pkn[b];
        V_ISSUE(v0, pk0); V_LOADPK(pkn, t + nwk, 1);
        V_QUARTER(v1, pk1);
#pragma unroll
        for (int b = 0; b < 4; ++b) pk1[b] = pkn[b];
        V_ISSUE(v1, pk1); V_LOADPK(pkn, t + nwk, 2);
        V_QUARTER(v2, pk2);
#pragma unroll
        for (int b = 0; b < 4; ++b) pk2[b] = pkn[b];
        V_ISSUE(v2, pk2); V_LOADPK(pkn, t + nwk, 3);
        V_QUARTER(v3, pk3);
#pragma unroll
        for (int i = 0; i < 16; ++i) { unsigned u = __builtin_bit_cast(unsigned, oh[i]);
            h2 a = as_h2(u) + as_h2((unsigned)__builtin_amdgcn_update_dpp(0, (int)u, 0x128, 0xF, 0xF, true)); u = __builtin_bit_cast(unsigned, a);
            { auto r = __builtin_amdgcn_permlane16_swap(u, u, false, false); a = as_h2(r[0]) + as_h2(r[1]); u = __builtin_bit_cast(unsigned, a); }
            { auto r = __builtin_amdgcn_permlane32_swap(u, u, false, false); a = as_h2(r[0]) + as_h2(r[1]); }
            oh[i] = a; }
        h2 o0 = oh[0], o1 = oh[1];
#pragma unroll
        for (int c = 1; c < 8; ++c) { o0 = (j == (unsigned)c) ? oh[2 * c] : o0; o1 = (j == (unsigned)c) ? oh[2 * c + 1] : o1; }
        x2[0] += (float)o0.x; x2[1] += (float)o0.y; x2[2] += (float)o1.x; x2[3] += (float)o1.y;
        if (!dry) *(GAS f32x4*)xr = x2;
        if (layer == 0 && !dry) {
            { u32x2 o; o.x = cvtpk(x2[0], x2[1]); o.y = cvtpk(x2[2], x2[3]); *(GAS u32x2*)(xs + (size_t)t * DM + s * 256 + p * 32 + j * 4) = o; }
            const float sst = wave_sum((x2[0] * x2[0] + x2[1] * x2[1]) + (x2[2] * x2[2] + x2[3] * x2[3]));
            if (lo == 0) rsp[(size_t)t * 8 + s] = sst;
        }
    }
#undef V_LOADPK
#undef V_ISSUE
#undef V_CVT4
#undef V_QUARTER
}
#undef F4
#undef H2F
__device__ __forceinline__ void step_logf(Frame& F) {
    const GAS bf16_t* xs = (const GAS bf16_t*)(F.ws + O_XS16); const GAS float* rsp = (const GAS float*)(F.ws + O_RSP); GAS float* logf = (GAS float*)(F.ws + O_LOGF);
    const GAS float* wf = (const GAS float*)(F.ws + O_WF);
    for (int t = F.gw; t < T; t += F.ngw) {
        unsigned lo = (unsigned)F.lane; asm volatile("" : "+v"(lo));
        float xv[32];
#pragma unroll
        for (int c = 0; c < 4; ++c) { const u32x4 w = *(const GAS u32x4*)(xs + (size_t)t * DM + c * 512 + lo * 8);
#pragma unroll
            for (int k = 0; k < 4; ++k) { xv[8 * c + 2 * k] = bf_lo(w[k]); xv[8 * c + 2 * k + 1] = bf_hi(w[k]); } }
        const float q = wave_sum(lo < 8 ? rsp[(size_t)t * 8 + lo] : 0.f);
        const float r1 = rsqrtf(q * (1.f / DM) + EPS);
        float mine = 0.f;
        for (int h = 0; h < NH; ++h) { float d = 0.f;
#pragma unroll
            for (int c = 0; c < 4; ++c) { const f32x4 w0 = *(const GAS f32x4*)(wf + (size_t)h * DM + c * 512 + lo * 8), w1 = *(const GAS f32x4*)(wf + (size_t)h * DM + c * 512 + lo * 8 + 4);
                d += (xv[8 * c] * w0[0] + xv[8 * c + 1] * w0[1]) + (xv[8 * c + 2] * w0[2] + xv[8 * c + 3] * w0[3]) + (xv[8 * c + 4] * w1[0] + xv[8 * c + 5] * w1[1]) + (xv[8 * c + 6] * w1[2] + xv[8 * c + 7] * w1[3]); }
            d = wave_sum(d); mine = (lo == (unsigned)h) ? d : mine; }
        if (lo < (unsigned)NH) { const float z = mine * r1 + F.in(I_SBF)[lo];
            logf[((size_t)(t / SEQ) * NH + lo) * SEQ + (t % SEQ)] = fminf(z, 0.f) - log1p_pos(fast_exp(-fabsf(z))); }
    }
}

#define XB_TMO      128
#define XB_XCNT(j)  (256  + 64 * (j))
#define XB_XSUB(j)  (1280 + 64 * (j))
#define XB_XGEN(j)  (2304 + 64 * (j))
#define XB_TOP      3328
#define XB_TOPGEN   3392
#define XCD_BAR_WORDS 3456
#define XB_SPIN_CAP (1u << 20)
__device__ __forceinline__ unsigned xb_ld(unsigned* p)              { return __hip_atomic_load(p, __ATOMIC_RELAXED, __HIP_MEMORY_SCOPE_AGENT); }
__device__ __forceinline__ unsigned xb_add(unsigned* p, unsigned v) { return __hip_atomic_fetch_add(p, v, __ATOMIC_RELAXED, __HIP_MEMORY_SCOPE_AGENT); }
__device__ __forceinline__ unsigned xb_xcc_id() { return (unsigned)__builtin_amdgcn_s_getreg((3 << 11) | 20) & 0xFu; }
#define XB_SPIN(cond, bar) do { unsigned _sp = 0; while (cond) { __builtin_amdgcn_s_sleep(1); \
    if ((++_sp & 255u) == 0u) { if (xb_ld(&(bar)[XB_TMO])) break; if (_sp > XB_SPIN_CAP) { atomicAdd(&(bar)[XB_TMO], 1u); break; } } } } while (0)
struct XcdBarrier { unsigned* bar; unsigned x; volatile LAS unsigned* st; };
__device__ __forceinline__ XcdBarrier xcd_barrier_post(unsigned* bar, volatile LAS unsigned* st) {
    XcdBarrier b; b.bar = bar; b.x = xb_xcc_id(); b.st = st;
    if (threadIdx.x == 0) (void)xb_add(&bar[XB_XCNT(b.x)], 1u);
    return b;
}
__device__ __forceinline__ void xcd_barrier_complete(unsigned* bar, unsigned x, unsigned& nloc, unsigned& nx) {
    const unsigned G = gridDim.x * gridDim.y * gridDim.z;
    unsigned sum, cnt, mine, sp = 0u;
    for (;;) {
        sum = 0u; cnt = 0u; mine = 0u;
#pragma unroll
        for (unsigned j = 0; j < 16; ++j) { const unsigned c = xb_ld(&bar[XB_XCNT(j)]); sum += c; cnt += (c > 0u) ? 1u : 0u; mine = (j == x) ? c : mine; }
        if (sum == G) break;
        __builtin_amdgcn_s_sleep(1);
        if ((++sp & 255u) == 0u) { if (xb_ld(&bar[XB_TMO])) break; if (sp > XB_SPIN_CAP) { atomicAdd(&bar[XB_TMO], 1u); break; } }
    }
    nloc = mine > 0u ? mine : 1u; nx = cnt > 0u ? cnt : 1u;
}
__device__ __forceinline__ void xcd_barrier(const XcdBarrier& b, int wave_s) {
    asm volatile("s_waitcnt vmcnt(0)" ::: "memory");
    __syncthreads();
    int ln_; asm volatile("v_mbcnt_lo_u32_b32 %0, -1, 0\n\tv_mbcnt_hi_u32_b32 %0, -1, %0" : "=v"(ln_));
    if (wave_s == 0 && ln_ == 0) {
        unsigned* bar = b.bar;
        __builtin_amdgcn_s_waitcnt(0);
        unsigned nloc = b.st[0], nx = b.st[1];
        if (nloc == 0u) { xcd_barrier_complete(bar, b.x, nloc, nx); b.st[0] = nloc; b.st[1] = nx; }
        const unsigned old = xb_add(&bar[XB_XSUB(b.x)], 1u);
        const unsigned gen = old / nloc;
        if (old + 1u == (gen + 1u) * nloc) {
            __builtin_amdgcn_fence(__ATOMIC_RELEASE, "agent");
            asm volatile("s_waitcnt vmcnt(0)" ::: "memory");
            const unsigned og = xb_add(&bar[XB_TOP], 1u);
            const unsigned tg = og / nx;
            if (og + 1u == (tg + 1u) * nx) xb_add(&bar[XB_TOPGEN], 1u);
            else XB_SPIN(xb_ld(&bar[XB_TOPGEN]) == tg, bar);
            __builtin_amdgcn_fence(__ATOMIC_ACQUIRE, "agent");
            xb_add(&bar[XB_XGEN(b.x)], 1u);
            asm volatile("s_waitcnt vmcnt(0)" ::: "memory");
        } else {
            XB_SPIN(xb_ld(&bar[XB_XGEN(b.x)]) == gen, bar);
            __builtin_amdgcn_fence(__ATOMIC_ACQUIRE, "agent");
            asm volatile("s_waitcnt vmcnt(0)" ::: "memory");
        }
    }
    __syncthreads();
}

constexpr int CONV1_SPLIT = 2 * 4608;
constexpr int BAR_LDS_OFF = 147456 - 64;
constexpr int LDS_BYTES = 147456;
enum { ST_PROLOGUE = 0, ST_G_IN0, ST_G_MKV0, ST_G_MKV1, ST_CONV, ST_G_GATE, ST_A_MEM0, ST_SCAN1, ST_SCAN2, ST_G_OUT0, ST_G_PQ0, ST_TOPK0, ST_UPASS0, ST_PRED0, ST_VPASS0,
       ST_G_L1, ST_CPREFIX, ST_A_FOX, ST_A_MEM1, ST_G_OUT1, ST_G_PQ1, ST_TOPK1, ST_UPASS1, ST_PRED1, ST_VPASS1, N_STEPS };
constexpr unsigned SYNC_AFTER = (1u << ST_PROLOGUE) | (1u << ST_G_MKV1) | (1u << ST_CONV) | (1u << ST_A_MEM0) | (1u << ST_SCAN1) | (1u << ST_SCAN2) | (1u << ST_G_OUT0) | (1u << ST_G_PQ0) |
                                (1u << ST_TOPK0) | (1u << ST_UPASS0) | (1u << ST_PRED0) | (1u << ST_VPASS0) | (1u << ST_G_L1) | (1u << ST_CPREFIX) | (1u << ST_A_MEM1) | (1u << ST_G_OUT1) | (1u << ST_G_PQ1) | (1u << ST_TOPK1) | (1u << ST_UPASS1) | (1u << ST_PRED1);
constexpr unsigned GEMM_STEPS = (1u << ST_G_IN0) | (1u << ST_G_MKV0) | (1u << ST_G_MKV1) | (1u << ST_G_GATE) | (1u << ST_G_OUT0) | (1u << ST_G_PQ0) | (1u << ST_G_L1) | (1u << ST_G_OUT1) | (1u << ST_G_PQ1);
constexpr unsigned ATTN_STEPS = (1u << ST_A_MEM0) | (1u << ST_A_FOX) | (1u << ST_A_MEM1);

struct Args { const float* in[N_IN]; float* out; unsigned char* ws; int lo, hi; };

__global__ void __launch_bounds__(NTHREADS, 2) yoco_fwd(Args args) {
    extern __shared__ __attribute__((aligned(16))) unsigned char lds[];
    volatile LAS unsigned* bst = (volatile LAS unsigned*)((LAS unsigned char*)lds + BAR_LDS_OFF);
    if (threadIdx.x == 0) { bst[0] = 0u; bst[1] = 0u; }
    __syncthreads();
    const XcdBarrier gbar = xcd_barrier_post((unsigned*)(args.ws + O_CTL), bst);
    const int G = gridDim.x;
    const int wave_s = __builtin_amdgcn_readfirstlane(threadIdx.x >> 6);
#ifndef DUP_MASK
#define DUP_MASK 0u
#endif
    for (int st = args.lo; st < args.hi; ++st) {
      const int nrep = ((DUP_MASK >> st) & 1u) ? 2 : 1;
      for (int rep = 0; rep < nrep; ++rep) {
        unsigned char* ws0 = args.ws; asm volatile("" : "+s"(ws0));
        GAS unsigned char* ws = (GAS unsigned char*)ws0;
#define LANE_ID(v) asm volatile("v_mbcnt_lo_u32_b32 %0, -1, 0\n\tv_mbcnt_hi_u32_b32 %0, -1, %0" : "=v"(v))
#define MAKE_TID(v) do { LANE_ID(v); v += wave_s * 64; } while (0)
#define MAKE_FRAME(F) Frame F; F.ws = ws; F.in_ = args.in; F.out = (GAS float*)args.out; { int t0_; MAKE_TID(t0_); F.tid = t0_; } F.lane = F.tid & 63; F.wave = wave_s; \
        F.gw = blockIdx.x * NWAVES + F.wave; F.ngw = gridDim.x * NWAVES; F.gtid = blockIdx.x * NTHREADS + F.tid; F.ngt = gridDim.x * NTHREADS
        if (st == ST_G_L1) { MAKE_FRAME(F); step_logf(F); }
        if ((GEMM_STEPS >> st) & 1u) {
            pg8::Gemm g; Epi E; E.ws = ws; E.resid = nullptr; E.outf = nullptr; E.o16 = nullptr; E.ssq = nullptr; E.gate_b = nullptr; int shift = 0;
            switch (st) {
            case ST_G_IN0:  g = {(const GAS bf16_t*)(ws + O_XS16), (const GAS bf16_t*)(ws + O_WIN0), T, NIN0, DM, DM, DM, 0}; E.mode = EM_IN0; break;
            case ST_G_MKV0: g = {(const GAS bf16_t*)(ws + O_MEMN), (const GAS bf16_t*)(ws + O_WMKV), NMROW, 1024, DM, DM, DM, 0}; E.mode = EM_MKV; E.o16 = (GAS bf16_t*)(ws + O_MKV); E.ssq = (GAS float*)(ws + O_MKSS); shift = 128; break;
            case ST_G_MKV1: g = {(const GAS bf16_t*)(ws + O_MEMN) + (size_t)NMROW * DM, (const GAS bf16_t*)(ws + O_WMKV) + (size_t)1024 * DM, NMROW, 1024, DM, DM, DM, 0}; E.mode = EM_MKV;
                            E.o16 = (GAS bf16_t*)(ws + O_MKV) + (size_t)NMROW * NL1; E.ssq = (GAS float*)(ws + O_MKSS) + NMROW * 112; shift = 144; break;
            case ST_G_GATE: g = {(const GAS bf16_t*)(ws + O_XC), (const GAS bf16_t*)(ws + O_WGATE), T, 12 * 256, 128, LRU, 128, 128}; E.mode = EM_GATE; E.gate_b = (const GAS float*)args.in[I_AGATEB]; break;
            case ST_G_OUT0: g = {(const GAS bf16_t*)(ws + O_CAT), (const GAS bf16_t*)(ws + O_WOUT0), T, DM, DM, DM, DM, 0}; E.mode = EM_RES; E.resid = (const GAS float*)args.in[I_X]; E.outf = (GAS float*)args.out; break;
            case ST_G_PQ0:  g = {(const GAS bf16_t*)(ws + O_XS16), (const GAS bf16_t*)(ws + O_WQ0), T, DM, DM, DM, DM, 0}; E.mode = EM_PQ; E.o16 = (GAS bf16_t*)(ws + O_Q16); break;
            case ST_G_L1:   g = {(const GAS bf16_t*)(ws + O_XS16), (const GAS bf16_t*)(ws + O_WL1), T, NL1, DM, DM, DM, 0}; E.mode = EM_L1; break;
            case ST_G_OUT1: g = {(const GAS bf16_t*)(ws + O_CAT), (const GAS bf16_t*)(ws + O_WOUT1), T, DM, DM, DM, DM, 0}; E.mode = EM_RES; E.resid = (const GAS float*)args.out; E.outf = (GAS float*)args.out; break;
            default:        g = {(const GAS bf16_t*)(ws + O_XS16), (const GAS bf16_t*)(ws + O_WQ1), T, DM, DM, DM, DM, 0}; E.mode = EM_PQ; E.o16 = (GAS bf16_t*)(ws + O_Q16); break;
            }
            pg8::StaticOrder S; S.init(g.M, g.N, G, (int)((blockIdx.x + G - shift) % G));
#ifndef DIS_GEMM
            { int tg_; MAKE_TID(tg_);
              pg8::gemm_phase<Epi, false>((LAS unsigned char*)lds, g, S, E, tg_); }
#endif
            if (st == ST_G_MKV1 && blockIdx.x >= 160) { MAKE_FRAME(F); convert_tables(F, 1, 0, CONV1_SPLIT, (blockIdx.x - 160) * NWAVES + F.wave, (G - 160) * NWAVES); }
        } else if ((ATTN_STEPS >> st) & 1u) {
            const int nun = st == ST_A_FOX ? 3 : 1;
            for (int ui = 0; ui < nun; ++ui) {
                att::BlockRef r;
                if (st == ST_A_FOX) {
                    const int i = blockIdx.x, x = i & 15, bh = (i >> 4) + 16 * ui, qb = ui == 0 ? x : (ui == 1 ? 15 - x : ((x * 5 + 3) & 15));
                    const int b = bh / NH, h = bh % NH; const size_t row0 = (size_t)b * SEQ + qb * 256;
                    const GAS bf16_t* z = (const GAS bf16_t*)(ws + O_ZL1);
                    r.Q = z + row0 * NL1 + 3072 + h * 128; r.K = z + (size_t)b * SEQ * NL1 + h * 128; r.V = z + (size_t)b * SEQ * NL1 + 1536 + h * 128;
                    r.O = (GAS bf16_t*)(ws + O_CAT) + row0 * DM + h * 128;
                    const GAS float* ss = (const GAS float*)(ws + O_SSL1);
                    r.qss = ss + row0 * 112 + (12 + h) * 4; r.kss = ss + (size_t)b * SEQ * 112 + h * 4; r.cc = (const GAS float*)(ws + O_CC) + (size_t)bh * SEQ; r.gg = (const GAS float*)(ws + O_GG) + 384;
                    r.P0 = qb * 256; r.skv = SEQ;
                } else {
                    const int l = st == ST_A_MEM0 ? 0 : 1; const int i = blockIdx.x, qblk = i >> 2, h = i & 3, b = qblk >> 4; const size_t row0 = (size_t)qblk * 256;
                    r.Q = (const GAS bf16_t*)(ws + O_ZL1) + row0 * NL1 + 4608 + h * 128; r.qss = (const GAS float*)(ws + O_SSL1) + row0 * 112 + (24 + h) * 4;
                    const GAS bf16_t* kv = (const GAS bf16_t*)(ws + O_MKV) + ((size_t)l * NMROW + b * NMEM) * NL1;
                    r.K = kv + h * 128; r.V = kv + 512 + h * 128; r.kss = (const GAS float*)(ws + O_MKSS) + ((size_t)l * NMROW + b * NMEM) * 112 + h * 4;
                    r.O = (GAS bf16_t*)(ws + O_CAT) + row0 * DM + LRU + h * 128; r.cc = nullptr; r.gg = (const GAS float*)(ws + O_GG) + 128 * (1 + l);
                    r.P0 = SEQ; r.skv = NMEM;
                }
                att::Seam S;
                int tid_u; MAKE_TID(tid_u);
#ifndef DIS_ATTN
                att::attn_prime(r, (char*)lds, S, tid_u);
                att::attn_block(r, (char*)lds, S, tid_u);
#endif
            }
        } else {
            MAKE_FRAME(F);
            switch (st) {
#ifndef DIS_MISC
            case ST_PROLOGUE: step_prologue(F, (LAS unsigned char*)lds); break;
            case ST_CONV: step_conv(F); break;
            case ST_SCAN1: step_scan1(F); break;
            case ST_SCAN2: step_scan2(F); break;
#endif
#ifndef DIS_TOPK
            case ST_TOPK0: step_topk(F, (LAS unsigned char*)lds, 0); step_xplanes(F); break;
            case ST_TOPK1: step_topk(F, (LAS unsigned char*)lds, 1); step_xplanes(F); break;
#endif
#ifndef DIS_GATHER
            case ST_UPASS0: step_upass(F, 0, G); break;
            case ST_UPASS1: step_upass(F, 1, G); break;
            case ST_PRED0: step_peer_reduce(F, 0); break;
            case ST_PRED1: step_peer_reduce(F, 1); break;
            case ST_VPASS0: step_vpass(F, 0, G, rep + 1 < nrep); break;
            case ST_VPASS1: step_vpass(F, 1, G, rep + 1 < nrep); break;
#endif
#ifndef DIS_MISC
            case ST_CPREFIX: step_cprefix(F, (LAS unsigned char*)lds); convert_tables(F, 1, G > 160 ? CONV1_SPLIT : 0, 2 * NEXP, F.gw, F.ngw); break;
#endif
            default: break;
            }
        }
        if (rep + 1 < nrep) xcd_barrier(gbar, wave_s);
      }
        if (((SYNC_AFTER >> st) & 1u) && st + 1 < args.hi) xcd_barrier(gbar, wave_s);
    }
}

#ifndef N_LAUNCH_MODE
#define N_LAUNCH_MODE 1
#endif
extern "C" void kernel_launch(void* const* d_in, const int* in_sizes, int n_in, void* d_out, int out_size, void* d_ws, size_t ws_size, hipStream_t stream) {
    static int grid = 0;
    if (grid == 0) {
        if (n_in != N_IN || in_sizes[0] != T * DM || out_size != T * DM || ws_size < WS_END) {
            fprintf(stderr, "kernel_launch: unexpected shapes (n_in %d, in0 %d, out %d, ws %zu, need %zu)\n", n_in, n_in > 0 ? in_sizes[0] : -1, out_size, ws_size, (size_t)WS_END); grid = -1; return; }
        int dev = 0, cus = 0, per_cu = 0;
        hipGetDevice(&dev); hipDeviceGetAttribute(&cus, hipDeviceAttributeMultiprocessorCount, dev);
        hipFuncSetAttribute((const void*)yoco_fwd, hipFuncAttributeMaxDynamicSharedMemorySize, LDS_BYTES);
        hipOccupancyMaxActiveBlocksPerMultiprocessor(&per_cu, (const void*)yoco_fwd, NTHREADS, LDS_BYTES);
        if (per_cu < 1) { fprintf(stderr, "kernel_launch: occupancy query says %d blocks per CU\n", per_cu); grid = -1; return; }
        grid = cus - cus % 8;
        (void)hipGetLastError();
    }
    if (grid < 0) return;
    Args a{};
    for (int i = 0; i < N_IN; ++i) a.in[i] = (const float*)d_in[i];
    a.out = (float*)d_out; a.ws = (unsigned char*)d_ws;
    if (hipMemsetAsync((char*)d_ws + O_CTL, 0, 65536, stream) != hipSuccess) { fprintf(stderr, "kernel_launch: memset of the barrier words failed\n"); return; }
    if (N_LAUNCH_MODE == 1) {
        a.lo = 0; a.hi = N_STEPS;
        hipLaunchKernelGGL(yoco_fwd, dim3(grid), dim3(NTHREADS), LDS_BYTES, stream, a);
        hipError_t e = hipPeekAtLastError();
        if (e != hipSuccess) fprintf(stderr, "launch failed: %s (grid %d)\n", hipGetErrorString(e), grid);
    } else {
        int lo = 0;
        for (int s = 0; s < N_STEPS; ++s) {
            if (((SYNC_AFTER >> s) & 1u) || s == N_STEPS - 1) {
                a.lo = lo; a.hi = s + 1; lo = s + 1;
                void* params[] = {&a};
                hipError_t e = hipLaunchCooperativeKernel((const void*)yoco_fwd, dim3(grid), dim3(NTHREADS), params, LDS_BYTES, stream);
                if (e != hipSuccess) { fprintf(stderr, "launch failed: %s\n", hipGetErrorString(e)); break; }
            }
        }
    }
}
```

```cpp
#include <hip/hip_runtime.h>
#include <hip/hip_cooperative_groups.h>
#include <cstdio>
#include <cstdint>
namespace cg = cooperative_groups;

#define LAS __attribute__((address_space(3)))
#define GAS __attribute__((address_space(1)))
typedef unsigned short bf16_t;
typedef short bf16x8 __attribute__((ext_vector_type(8)));
typedef short s16x4 __attribute__((ext_vector_type(4)));
typedef float f32x4 __attribute__((ext_vector_type(4)));
typedef float f32x2 __attribute__((ext_vector_type(2)));
typedef float f32x16 __attribute__((ext_vector_type(16)));
typedef unsigned u32x4 __attribute__((ext_vector_type(4)));
typedef unsigned u32x2 __attribute__((ext_vector_type(2)));
typedef _Float16 h2 __attribute__((ext_vector_type(2)));

constexpr int NB = 4, SEQ = 4096, T = NB * SEQ, DM = 2048, LRU = 1536, MEMW = 512, NMEM = 256, NH = 12, HD = 128;
constexpr int NIN0 = 3584, NL1 = 5120, NEXP = 16384, NMROW = NB * NMEM;
constexpr float EPS = 1e-6f;
constexpr int NTHREADS = 512, NWAVES = 8;

constexpr size_t MiB = 1u << 20;
constexpr size_t O_CTL = 0;
constexpr size_t O_WIN0 = 1 * MiB;
constexpr size_t O_WOUT0 = O_WIN0 + 14 * MiB;
constexpr size_t O_WL1 = O_WOUT0 + 8 * MiB;
constexpr size_t O_WOUT1 = O_WL1 + 20 * MiB;
constexpr size_t O_WQ0 = O_WOUT1 + 8 * MiB;
constexpr size_t O_WQ1 = O_WQ0 + 8 * MiB;
constexpr size_t O_WMKV = O_WQ1 + 8 * MiB;
constexpr size_t O_WGATE = O_WMKV + 8 * MiB;
constexpr size_t O_SUBK = O_WGATE + 1 * MiB;
constexpr size_t O_WF = O_SUBK + 1 * MiB;
constexpr size_t O_SMALL = O_WF + 1 * MiB;
constexpr size_t O_RS1 = O_SMALL;
constexpr size_t O_LOGF = O_SMALL + 64 * 1024;
constexpr size_t O_CC = O_LOGF + 768 * 1024;
constexpr size_t O_GG = O_CC + 768 * 1024;
constexpr size_t O_SPL = O_GG + 4096;
constexpr size_t O_TSC = O_SPL + 8192;
constexpr size_t O_ROWSS = O_SMALL + 2 * MiB;
constexpr size_t O_RSP = O_ROWSS + 2 * MiB;
constexpr size_t O_QMSS = O_RSP;
constexpr size_t O_MKSS = O_QMSS + 1 * MiB;
constexpr size_t O_SSL1 = O_MKSS + 1 * MiB;
constexpr size_t O_CARRY = O_SSL1 + 7 * MiB;
constexpr size_t O_MEMN = O_CARRY + 3 * MiB;
constexpr size_t O_MKV = O_MEMN + 8 * MiB;
constexpr size_t O_IDX = O_MKV + 20 * MiB;
constexpr size_t O_GW = O_IDX + 8 * MiB;
constexpr size_t O_TAB = O_GW + 8 * MiB;
constexpr size_t TAB_NIB = (size_t)8 * 16384 * 128, TAB_ONE = TAB_NIB + (size_t)16384 * 16 + 786432;
constexpr size_t O_XS16 = O_TAB + 128 * MiB;
constexpr size_t O_CAT = O_XS16 + 64 * MiB;
constexpr size_t O_ZX = O_CAT + 64 * MiB;
constexpr size_t O_X8 = O_ZX;
constexpr size_t O_GY = O_ZX + 48 * MiB;
constexpr size_t O_LOGFP = O_GY + 48 * MiB;
constexpr size_t O_QM = O_LOGFP;
constexpr size_t O_XC = O_QM + 16 * MiB;
constexpr size_t O_X4 = O_XC;
constexpr size_t O_SX = O_XC + 32 * MiB;
constexpr size_t O_AA = O_XC + 48 * MiB;
constexpr size_t O_PART = O_AA;
constexpr size_t O_UU = O_AA + 96 * MiB;
constexpr size_t O_PK = O_UU;
constexpr size_t O_Q16 = O_UU + 96 * MiB;
constexpr size_t O_ZL1 = O_Q16 + 64 * MiB;
constexpr size_t WS_END = O_ZL1 + 160 * MiB;
static_assert(WS_END <= 1024 * MiB, "workspace map");

__device__ __forceinline__ unsigned cvtpk(float lo, float hi) { unsigned r; asm volatile("v_cvt_pk_bf16_f32 %0, %1, %2" : "=v"(r) : "v"(lo), "v"(hi)); return r; }
__device__ __forceinline__ float bf_lo(unsigned w) { return __uint_as_float(w << 16); }
__device__ __forceinline__ float bf_hi(unsigned w) { return __uint_as_float(w & 0xffff0000u); }
__device__ __forceinline__ float fast_exp(float x) { return __builtin_amdgcn_exp2f(x * 1.4426950408889634f); }
__device__ __forceinline__ float log1p_pos(float y) { const float ser = y * (1.f - y * (0.5f - y * (0.33333334f - 0.25f * y))); const float lg = __builtin_amdgcn_logf(1.f + y) * 0.6931471805599453f; return y < 0.03f ? ser : lg; }
__device__ __forceinline__ float one_minus_exp(float x) { const float ser = -x * (1.f + x * (0.5f + x * (0.16666667f + x * 0.041666668f))); const float big = 1.f - fast_exp(x); return x > -0.03f ? ser : big; }
__device__ __forceinline__ float sigmoidf_(float x) { return __builtin_amdgcn_rcpf(1.f + fast_exp(-x)); }
__device__ __forceinline__ float gelu_tanh(float x) { const float u = x * (1.f + 0.044715f * x * x); return x * __builtin_amdgcn_rcpf(1.f + __builtin_amdgcn_exp2f(u * (-2.f * 0.7978845608028654f * 1.4426950408889634f))); }
template <int CTRL> __device__ __forceinline__ float dppf(float v) { return __int_as_float(__builtin_amdgcn_update_dpp(0, __float_as_int(v), CTRL, 0xF, 0xF, true)); }
__device__ __forceinline__ float xsum16(float v) { auto r = __builtin_amdgcn_permlane16_swap(__float_as_uint(v), __float_as_uint(v), false, false); return __uint_as_float(r[0]) + __uint_as_float(r[1]); }
__device__ __forceinline__ float xsum32(float v) { auto r = __builtin_amdgcn_permlane32_swap(__float_as_uint(v), __float_as_uint(v), false, false); return __uint_as_float(r[0]) + __uint_as_float(r[1]); }
__device__ __forceinline__ float xmax16(float v) { auto r = __builtin_amdgcn_permlane16_swap(__float_as_uint(v), __float_as_uint(v), false, false); return fmaxf(__uint_as_float(r[0]), __uint_as_float(r[1])); }
__device__ __forceinline__ float xmax32(float v) { auto r = __builtin_amdgcn_permlane32_swap(__float_as_uint(v), __float_as_uint(v), false, false); return fmaxf(__uint_as_float(r[0]), __uint_as_float(r[1])); }
__device__ __forceinline__ float wave_sum(float v) {
    v += dppf<0xB1>(v); v += dppf<0x4E>(v); v += dppf<0x141>(v); v += dppf<0x140>(v);
    v = xsum16(v); v = xsum32(v); return v;
}
__device__ __forceinline__ float wave_max(float v) {
    v = fmaxf(v, dppf<0xB1>(v)); v = fmaxf(v, dppf<0x4E>(v)); v = fmaxf(v, dppf<0x141>(v)); v = fmaxf(v, dppf<0x140>(v));
    v = xmax16(v); v = xmax32(v); return v;
}

namespace pg8 {
constexpr int BM = 256, BK = 64, HALF = 128, HTB = HALF * BK * 2, STAGE_BYTES = 8 * HTB, NXCD = 8, WGM = 8;
__host__ __device__ __forceinline__ int lds_byte(int r, int c) { const int st = (r >> 4) * 2 + (c >> 5), rr = r & 15, cc = c & 31, ob = rr * 64 + cc * 2; return st * 1024 + (ob ^ (((ob >> 9) & 1) << 5)); }
__host__ __device__ __forceinline__ void stage_rc(int b, int& R, int& C) { const int st = b / 1024, sb = b % 1024, swz = sb ^ (((sb >> 9) & 1) << 5); R = (st >> 1) * 16 + swz / 64; C = (st & 1) * 32 + (swz % 64) / 2; }
__host__ __device__ __forceinline__ int perm32(int rho) { const int n = rho >> 4, i = rho & 15; return 8 * (i >> 2) + 4 * n + (i & 3); }

struct Unit { int pm, pn; };
struct Gemm { const GAS bf16_t* A; const GAS bf16_t* Bt; int M, N, K, lda, ldb, acol; };

struct StaticOrder {
    int nM, nN, nwg, G, c;
    __device__ void init(int M, int N, int G_, int c_) { nM = M / BM; nN = N / BM; nwg = nM * nN; G = G_; c = c_; }
    __device__ bool next(int i, Unit& u) const {
        const long L = (long)i * G + c; if (L >= nwg) return false;
        int wgid = (int)L; { const int q = nwg / NXCD, r = nwg % NXCD, xcd = wgid % NXCD, off = wgid / NXCD; wgid = (xcd < r ? xcd * (q + 1) : r * (q + 1) + (xcd - r) * q) + off; }
        const int nig = WGM * nN, gid = wgid / nig, fm = gid * WGM, gsz = (nM - fm) < WGM ? (nM - fm) : WGM;
        u.pm = fm + ((wgid % nig) % gsz); u.pn = (wgid % nig) / gsz; return true;
    }
};

typedef int v8i_t __attribute__((ext_vector_type(8)));
typedef int v4i_t __attribute__((ext_vector_type(4)));
template <class Epi, bool FP8>
__device__ __forceinline__ void gemm_phase(LAS unsigned char* lds, const Gemm g, const StaticOrder& S, const Epi& E, const int tid) {
    const int wid = __builtin_amdgcn_readfirstlane(tid >> 6), lane = tid & 63, wr = wid >> 2, wc = wid & 3, fr = lane & 15, fq = lane >> 4;
    const int K = g.K, nt = K / BK;
    unsigned voffA[2], voffB[2];
#pragma unroll
    for (int i = 0; i < 2; ++i) { int R, C; stage_rc(tid * 16 + i * 8192, R, C); const int Rb = (R & ~31) + perm32(R & 31);
        voffA[i] = (unsigned)(R * g.lda + C) * 2u; voffB[i] = (unsigned)(Rb * g.ldb + C) * 2u; }
    const size_t kstep = (size_t)(BK * 2);
    const size_t hstepA = (size_t)HALF * g.lda * 2, hstepB = (size_t)HALF * g.ldb * 2;
    const size_t tstepA = 2 * hstepA, tstepB = 2 * hstepB;
    const unsigned ldsw = (unsigned)wid * 1024u;
    const int aoff = lds_byte(wr * 64 + fr, fq * 8), boff = lds_byte(wc * 32 + fr, fq * 8);
#define PG8_SA(b, h) (((b) * 2 + (h)) * HTB)
#define PG8_SB(b, h) ((4 + (b) * 2 + (h)) * HTB)
#define PG8_STAGE(bufoff, gbase, voff) do { _Pragma("unroll") for (int _i = 0; _i < 2; ++_i) \
        __builtin_amdgcn_global_load_lds((const GAS unsigned*)((gbase) + (voff)[_i]), (LAS unsigned*)(lds + (bufoff) + ldsw + _i * 8192), 16, 0, 0); } while (0)
#define PG8_LD2(dst, off_) do { const u32x4 lo_ = *(const LAS u32x4*)(lds + (off_)), hi_ = *(const LAS u32x4*)(lds + (off_) + 1024); \
        dst = (v8i_t){(int)lo_.x, (int)lo_.y, (int)lo_.z, (int)lo_.w, (int)hi_.x, (int)hi_.y, (int)hi_.z, (int)hi_.w}; } while (0)
#define PG8_LDA(dst, b, h) do { _Pragma("unroll") for (int m = 0; m < 4; ++m) PG8_LD2(dst[m], PG8_SA(b, h) + aoff + m * 2048); } while (0)
#define PG8_LDB(dst, b, h) do { _Pragma("unroll") for (int n = 0; n < 2; ++n) PG8_LD2(dst[n], PG8_SB(b, h) + boff + n * 2048); } while (0)
#define PG8_HALF(v, k) ((k) ? __builtin_shufflevector(v, v, 4, 5, 6, 7) : __builtin_shufflevector(v, v, 0, 1, 2, 3))
#define PG8_MMA(ai, bj, At, Bt) do { __builtin_amdgcn_s_setprio(1); _Pragma("unroll") for (int m = 0; m < 4; ++m) _Pragma("unroll") for (int n = 0; n < 2; ++n) { \
        if constexpr (FP8) asm volatile("v_mfma_scale_f32_16x16x128_f8f6f4 %0, %1, %2, %0, %3, %4 op_sel_hi:[0,0,0]" : "+v"(acc[ai][bj][m][n]) : "v"(Bt[n]), "v"(At[m]), "v"(sc_w), "v"(sc_x));     \
        else { _Pragma("unroll") for (int k = 0; k < 2; ++k) { const v4i_t bh_ = PG8_HALF(Bt[n], k), ah_ = PG8_HALF(At[m], k); \
                acc[ai][bj][m][n] = __builtin_amdgcn_mfma_f32_16x16x32_bf16(__builtin_bit_cast(bf16x8, bh_), __builtin_bit_cast(bf16x8, ah_), acc[ai][bj][m][n], 0, 0, 0); } } } \
        __builtin_amdgcn_s_setprio(0); } while (0)
#define PG8_WAIT_V(n) asm volatile("s_waitcnt vmcnt(" #n ")" ::: "memory")
#define PG8_WAIT_L(n) asm volatile("s_waitcnt lgkmcnt(" #n ")" ::: "memory")
#define PG8_BAR __builtin_amdgcn_s_barrier()
#define PG8_SCHED __builtin_amdgcn_sched_barrier(0)
    Unit cur, nxt; int ui = 0;
    if (!S.next(0, cur)) return;
    f32x4 acc[2][2][4][2];
#pragma unroll
    for (int a = 0; a < 2; ++a)
#pragma unroll
        for (int b = 0; b < 2; ++b)
#pragma unroll
            for (int m = 0; m < 4; ++m)
#pragma unroll
                for (int n = 0; n < 2; ++n) acc[a][b][m][n] = (f32x4){0.f, 0.f, 0.f, 0.f};
    v8i_t At[4], B0[2], B1[2];
    const int sc_w = 121, sc_x = 127;
    const GAS char* cA = (const GAS char*)g.A + (size_t)cur.pm * tstepA + (size_t)cur.pn * g.acol * 2; const GAS char* cB = (const GAS char*)g.Bt + (size_t)cur.pn * tstepB;
    PG8_STAGE(PG8_SB(0, 0), cB, voffB); PG8_STAGE(PG8_SB(0, 1), cB + hstepB, voffB); PG8_STAGE(PG8_SA(0, 0), cA, voffA); PG8_STAGE(PG8_SA(0, 1), cA + hstepA, voffA);
    if (wr == 1) PG8_BAR;
    PG8_WAIT_V(2); PG8_BAR;
    PG8_STAGE(PG8_SB(1, 0), cB + kstep, voffB); PG8_STAGE(PG8_SA(1, 0), cA + kstep, voffA); PG8_STAGE(PG8_SB(1, 1), cB + hstepB + kstep, voffB);
    PG8_WAIT_V(6); PG8_BAR;
    for (;;) {
        const bool has_next = S.next(ui + 1, nxt);
        const GAS char* nA = has_next ? (const GAS char*)g.A + (size_t)nxt.pm * tstepA + (size_t)nxt.pn * g.acol * 2 : cA; const GAS char* nB = has_next ? (const GAS char*)g.Bt + (size_t)nxt.pn * tstepB : cB;
        for (int t = 0; t < nt; t += 2) {
            const bool last = (t == nt - 2);
            const GAS char* a1 = cA + (size_t)(t + 1) * kstep;
            const GAS char* a2 = last ? nA : cA + (size_t)(t + 2) * kstep; const GAS char* b2 = last ? nB : cB + (size_t)(t + 2) * kstep;
            const GAS char* a3 = a2 + kstep; const GAS char* b3 = b2 + kstep;
            PG8_LDB(B0, 0, 0); PG8_LDB(B1, 0, 1); PG8_SCHED; PG8_LDA(At, 0, 0); PG8_STAGE(PG8_SA(1, 1), a1 + hstepA, voffA);
            PG8_WAIT_V(8); PG8_WAIT_L(0); PG8_BAR; PG8_MMA(0, 0, At, B0); PG8_MMA(0, 1, At, B1); PG8_BAR; PG8_SCHED;
            PG8_LDA(At, 0, 1); PG8_STAGE(PG8_SB(0, 0), b2, voffB); PG8_STAGE(PG8_SB(0, 1), b2 + hstepB, voffB); PG8_STAGE(PG8_SA(0, 0), a2, voffA);
            PG8_WAIT_V(8); PG8_WAIT_L(0); PG8_BAR; PG8_MMA(1, 0, At, B0); PG8_MMA(1, 1, At, B1); PG8_BAR; PG8_SCHED;
            PG8_LDB(B0, 1, 0); PG8_LDB(B1, 1, 1); PG8_SCHED; PG8_LDA(At, 1, 0); PG8_STAGE(PG8_SA(0, 1), a2 + hstepA, voffA);
            PG8_WAIT_V(8); PG8_WAIT_L(0); PG8_BAR; PG8_MMA(0, 0, At, B0); PG8_MMA(0, 1, At, B1); PG8_BAR; PG8_SCHED;
            PG8_LDA(At, 1, 1); PG8_STAGE(PG8_SB(1, 0), b3, voffB); PG8_STAGE(PG8_SB(1, 1), b3 + hstepB, voffB); PG8_STAGE(PG8_SA(1, 0), a3, voffA);
            PG8_WAIT_V(8); PG8_WAIT_L(0); PG8_BAR; PG8_MMA(1, 0, At, B0); PG8_MMA(1, 1, At, B1); PG8_BAR; PG8_SCHED;
        }
        if (wr == 0) PG8_BAR;
        { int ln_; asm volatile("v_mbcnt_lo_u32_b32 %0, -1, 0\n\tv_mbcnt_hi_u32_b32 %0, -1, %0" : "=v"(ln_));
          E(acc, cur, wr, wc, ln_ & 15, ln_ >> 4); }
        if (!has_next) break;
#pragma unroll
        for (int a = 0; a < 2; ++a)
#pragma unroll
            for (int b = 0; b < 2; ++b)
#pragma unroll
                for (int m = 0; m < 4; ++m)
#pragma unroll
                    for (int n = 0; n < 2; ++n) acc[a][b][m][n] = (f32x4){0.f, 0.f, 0.f, 0.f};
        cur = nxt; cA = nA; cB = nB; ++ui;
        if (wr == 1) PG8_BAR;
    }
    PG8_WAIT_V(0);
    PG8_BAR;
#undef PG8_SA
#undef PG8_SB
#undef PG8_STAGE
#undef PG8_LDA
#undef PG8_LDB
#undef PG8_LD2
#undef PG8_HALF
#undef PG8_MMA
#undef PG8_WAIT_V
#undef PG8_WAIT_L
#undef PG8_BAR
#undef PG8_SCHED
}
}

enum { EM_IN0 = 0, EM_MKV = 1, EM_GATE = 2, EM_RES = 3, EM_PQ = 4, EM_L1 = 5 };
struct Epi {
    int mode;
    GAS unsigned char* ws;
    const GAS float* resid;
    GAS float* outf;
    GAS bf16_t* o16;
    GAS float* ssq;
    const GAS float* gate_b;
    typedef pg8::Unit Unit;
    __device__ __forceinline__ static void st8(GAS bf16_t* p, f32x4 v0, f32x4 v1) {
        u32x4 w; w.x = cvtpk(v0[0], v0[1]); w.y = cvtpk(v0[2], v0[3]); w.z = cvtpk(v1[0], v1[1]); w.w = cvtpk(v1[2], v1[3]); *(GAS u32x4*)p = w; }
    __device__ __forceinline__ static float sq8(f32x4 a, f32x4 b) { return (a[0] * a[0] + a[1] * a[1]) + (a[2] * a[2] + a[3] * a[3]) + (b[0] * b[0] + b[1] * b[1]) + (b[2] * b[2] + b[3] * b[3]); }
    __device__ __forceinline__ void operator()(f32x4 (&acc)[2][2][4][2], const Unit& u, int wr, int wc, int fr, int fq) const {
        const int row0 = u.pm * 256 + wr * 64 + fr;
        const int cin = wc * 32 + 8 * fq;
        if (mode == EM_IN0) {
            GAS bf16_t* base; int ld, colt; int kind;
            if (u.pn < 6) { base = (GAS bf16_t*)(ws + O_ZX); ld = LRU; colt = u.pn * 256; kind = 0; }
            else if (u.pn < 12) { base = (GAS bf16_t*)(ws + O_GY); ld = LRU; colt = (u.pn - 6) * 256; kind = 1; }
            else { base = (GAS bf16_t*)(ws + O_ZL1); ld = NL1; colt = 4608 + (u.pn - 12) * 256; kind = 2; }
            GAS float* qmss = (GAS float*)(ws + O_SSL1);
#pragma unroll
            for (int ai = 0; ai < 2; ++ai)
#pragma unroll
                for (int m = 0; m < 4; ++m) { const int row = row0 + ai * 128 + m * 16;
#pragma unroll
                    for (int bj = 0; bj < 2; ++bj) { f32x4 v0 = acc[ai][bj][m][0], v1 = acc[ai][bj][m][1];
                        if (kind == 1) {
#pragma unroll
                            for (int j = 0; j < 4; ++j) { v0[j] = gelu_tanh(v0[j]); v1[j] = gelu_tanh(v1[j]); } }
                        st8(base + (size_t)row * ld + colt + bj * 128 + cin, v0, v1);
                        if (kind == 2) { float s = sq8(v0, v1); s = xsum16(s); s = xsum32(s);
                            if (fq == 0) qmss[(size_t)row * 112 + (24 + (u.pn - 12) * 2 + bj) * 4 + wc] = s; } } }
        } else if (mode == EM_MKV) {
#pragma unroll
            for (int ai = 0; ai < 2; ++ai)
#pragma unroll
                for (int m = 0; m < 4; ++m) { const int row = row0 + ai * 128 + m * 16;
#pragma unroll
                    for (int bj = 0; bj < 2; ++bj) { const f32x4 v0 = acc[ai][bj][m][0], v1 = acc[ai][bj][m][1];
                        st8(o16 + (size_t)row * NL1 + u.pn * 256 + bj * 128 + cin, v0, v1);
                        if (u.pn < 2) { float s = sq8(v0, v1); s = xsum16(s); s = xsum32(s);
                            if (fq == 0) ssq[(size_t)row * 112 + (u.pn * 2 + bj) * 4 + wc] = s; } } }
        } else if (mode == EM_GATE) {
            const int ch = u.pn * 128 + cin;
            const GAS bf16_t* xc = (const GAS bf16_t*)(ws + O_XC); GAS _Float16* LA = (GAS _Float16*)(ws + O_AA); GAS _Float16* UH = (GAS _Float16*)(ws + O_UU);
            const GAS float* spl = (const GAS float*)(ws + O_SPL) + ch; const GAS float* gb = gate_b + u.pn * 256 + cin;
#pragma unroll
            for (int n = 0; n < 2; ++n) {
                const f32x4 sp = *(const GAS f32x4*)(spl + 4 * n), br = *(const GAS f32x4*)(gb + 4 * n), bi = *(const GAS f32x4*)(gb + 128 + 4 * n);
#pragma unroll
                for (int ai = 0; ai < 2; ++ai)
#pragma unroll
                    for (int m = 0; m < 4; ++m) { const int row = row0 + ai * 128 + m * 16;
                        const u32x2 xw = *(const GAS u32x2*)(xc + (size_t)row * LRU + ch + 4 * n);
                        const f32x4 xv = {bf_lo(xw.x), bf_hi(xw.x), bf_lo(xw.y), bf_hi(xw.y)};
                        float lav[4], uvv[4];
#pragma unroll
                        for (int j = 0; j < 4; ++j) { const float r = sigmoidf_(acc[ai][0][m][n][j] + br[j]), ig = sigmoidf_(acc[ai][1][m][n][j] + bi[j]);
                            const float la = -8.f * r * sp[j];
                            lav[j] = la; uvv[j] = __builtin_amdgcn_sqrtf(one_minus_exp(2.f * la)) * (ig * xv[j]); }
                        { const h2 l0 = {(_Float16)lav[0], (_Float16)lav[1]}, l1 = {(_Float16)lav[2], (_Float16)lav[3]}, u0 = {(_Float16)uvv[0], (_Float16)uvv[1]}, u1 = {(_Float16)uvv[2], (_Float16)uvv[3]};
                          *(GAS u32x2*)(LA + (size_t)row * LRU + ch + 4 * n) = (u32x2){__builtin_bit_cast(unsigned, l0), __builtin_bit_cast(unsigned, l1)};
                          *(GAS u32x2*)(UH + (size_t)row * LRU + ch + 4 * n) = (u32x2){__builtin_bit_cast(unsigned, u0), __builtin_bit_cast(unsigned, u1)}; } }
            }
        } else if (mode == EM_RES) {
            GAS bf16_t* xs = (GAS bf16_t*)(ws + O_XS16); GAS float* rowss = (GAS float*)(ws + O_ROWSS);
#pragma unroll
            for (int ai = 0; ai < 2; ++ai)
#pragma unroll
                for (int m = 0; m < 4; ++m) { const int row = row0 + ai * 128 + m * 16; float s = 0.f;
#pragma unroll
                    for (int bj = 0; bj < 2; ++bj) { const size_t off = (size_t)row * DM + u.pn * 256 + bj * 128 + cin;
                        const f32x4 r0 = *(const GAS f32x4*)(resid + off), r1 = *(const GAS f32x4*)(resid + off + 4);
                        const f32x4 v0 = acc[ai][bj][m][0] + r0, v1 = acc[ai][bj][m][1] + r1;
                        *(GAS f32x4*)(outf + off) = v0; *(GAS f32x4*)(outf + off + 4) = v1;
                        st8(xs + off, v0, v1); s += sq8(v0, v1); }
                    s = xsum16(s); s = xsum32(s);
                    if (fq == 0) rowss[(size_t)row * 32 + u.pn * 4 + wc] = s; }
        } else if (mode == EM_PQ) {
            const GAS float* rowss = (const GAS float*)(ws + O_ROWSS);
#pragma unroll
            for (int ai = 0; ai < 2; ++ai)
#pragma unroll
                for (int m = 0; m < 4; ++m) { const int row = row0 + ai * 128 + m * 16;
                    const f32x4 p0 = *(const GAS f32x4*)(rowss + (size_t)row * 32 + fq * 8), p1 = *(const GAS f32x4*)(rowss + (size_t)row * 32 + fq * 8 + 4);
                    float s = (p0[0] + p0[1]) + (p0[2] + p0[3]) + (p1[0] + p1[1]) + (p1[2] + p1[3]); s = xsum16(s); s = xsum32(s);
                    const float r = rsqrtf(s * (1.f / DM) + EPS);
#pragma unroll
                    for (int bj = 0; bj < 2; ++bj) st8(o16 + (size_t)row * DM + u.pn * 256 + bj * 128 + cin, acc[ai][bj][m][0] * r, acc[ai][bj][m][1] * r); }
        } else {
            const GAS float* rsp = (const GAS float*)(ws + O_RSP); GAS bf16_t* zl1 = (GAS bf16_t*)(ws + O_ZL1); GAS float* ssl1 = (GAS float*)(ws + O_SSL1);
            const int slot0 = u.pn < 6 ? u.pn * 2 : (u.pn >= 12 ? 12 + (u.pn - 12) * 2 : -1);
#pragma unroll
            for (int ai = 0; ai < 2; ++ai)
#pragma unroll
                for (int m = 0; m < 4; ++m) { const int row = row0 + ai * 128 + m * 16;
                    const f32x4 q0 = *(const GAS f32x4*)(rsp + (size_t)row * 8), q1 = *(const GAS f32x4*)(rsp + (size_t)row * 8 + 4);
                    const float r = rsqrtf(((q0[0] + q0[1]) + (q0[2] + q0[3]) + (q1[0] + q1[1]) + (q1[2] + q1[3])) * (1.f / DM) + EPS);
#pragma unroll
                    for (int bj = 0; bj < 2; ++bj) { const f32x4 v0 = acc[ai][bj][m][0] * r, v1 = acc[ai][bj][m][1] * r;
                        st8(zl1 + (size_t)row * NL1 + u.pn * 256 + bj * 128 + cin, v0, v1);
                        if (slot0 >= 0) { float s = sq8(v0, v1); s = xsum16(s); s = xsum32(s);
                            if (fq == 0) ssl1[(size_t)row * 112 + (slot0 + bj) * 4 + wc] = s; } } }
        }
    }
};

namespace att {
constexpr float SCALE = 0.08838834764831845f;
constexpr int NW = 8, QBLK = 32, KVBLK = 64, QB = NW * QBLK, D = 128;
constexpr int SHM_V = KVBLK * D * 2, SHM_K = KVBLK * D * 2;
constexpr int OFF_WS = 2 * SHM_V + 2 * SHM_K;
constexpr int OFF_KS = OFF_WS + 2048;
constexpr int OFF_BS = OFF_KS + 16384;
constexpr int LDS_END = OFF_BS + 16384;
constexpr int WBIG = 1 << 28;

#define KSWZ(row, colB) ((row) * 256 + ((colB) ^ (((row) & 7) << 4)))
#define SBAR() __builtin_amdgcn_sched_barrier(0)
__device__ __forceinline__ int v_st(int k, int c) { const int kk = (k & ~0xC) | ((k & 4) << 1) | ((k & 8) >> 1); return ((kk >> 3) * 4 + (c >> 5)) * 512 + ((kk & 7) * 32 + (c & 31)) * 2; }
__device__ __forceinline__ int v_rd_base(int lane) { return ((lane & 3) << 3) | (((lane >> 2) & 3) << 6) | (((lane >> 4) & 1) << 5) | (((lane >> 5) & 1) << 8); }
constexpr int v_rd_off(int d0, int ks, int half) { return d0 * 512 + ks * 4096 + half * 2048; }
__device__ __forceinline__ int crow(int r, int hi) { return (r & 3) + 8 * (r >> 2) + 4 * hi; }
__device__ __forceinline__ bf16x8 load8(const GAS bf16_t* p) { return *(const GAS bf16x8*)p; }
__device__ __forceinline__ bf16x8 scale8(bf16x8 v, float s) { const u32x4 w = *reinterpret_cast<u32x4*>(&v); u32x4 o;
    o.x = cvtpk(bf_lo(w.x) * s, bf_hi(w.x) * s); o.y = cvtpk(bf_lo(w.y) * s, bf_hi(w.y) * s); o.z = cvtpk(bf_lo(w.z) * s, bf_hi(w.z) * s); o.w = cvtpk(bf_lo(w.w) * s, bf_hi(w.w) * s);
    return *reinterpret_cast<bf16x8*>(&o); }
__device__ __forceinline__ void mask_tile(f32x16& p0, f32x16& p1, int dq, unsigned W) {
    const float NEG = -__builtin_inff();
#pragma unroll
    for (int r = 0; r < 16; ++r) {
        const int c = (r & 3) + 8 * (r >> 2);
        if ((unsigned)(dq - c) >= W) p0[r] = NEG;
        if ((unsigned)(dq - c - 32) >= W) p1[r] = NEG;
    }
}
constexpr float THR = 8.f;
__device__ __forceinline__ void partialSM(f32x16& p0, f32x16& p1, float& m_reg, float& mn, float& alpha) {
    float pmax = p0[0]; for (int r = 1; r < 16; ++r) pmax = fmaxf(pmax, p0[r]); for (int r = 0; r < 16; ++r) pmax = fmaxf(pmax, p1[r]);
    { auto rr = __builtin_amdgcn_permlane32_swap(__float_as_uint(pmax), __float_as_uint(pmax), false, false);
      pmax = fmaxf(__uint_as_float(rr[0]), __uint_as_float(rr[1])); }
    constexpr float C2 = 1.4426950408889634f * SCALE;
    if (__builtin_expect(__all((pmax - m_reg) * SCALE <= THR), 1)) { mn = m_reg; alpha = 1.f; }
    else { mn = fmaxf(m_reg, pmax); alpha = __builtin_amdgcn_exp2f((m_reg - mn) * C2); m_reg = mn; }
    const float mnL = -mn * C2;
    for (int r = 0; r < 16; ++r) p0[r] = fmaf(p0[r], C2, mnL); for (int r = 0; r < 16; ++r) p1[r] = fmaf(p1[r], C2, mnL);
    for (int r = 0; r < 16; ++r) p0[r] = __builtin_amdgcn_exp2f(p0[r]);
}
__device__ __forceinline__ void finishSM(f32x16& p0, f32x16& p1, float alpha, float& l_reg, bf16x8& pa0, bf16x8& pa1, bf16x8& pa2, bf16x8& pa3) {
    for (int r = 0; r < 16; ++r) p1[r] = __builtin_amdgcn_exp2f(p1[r]);
    float ps = 0; for (int r = 0; r < 16; ++r) ps += p0[r]; for (int r = 0; r < 16; ++r) ps += p1[r];
    { auto rr = __builtin_amdgcn_permlane32_swap(__float_as_uint(ps), __float_as_uint(ps), false, false);
      ps = __uint_as_float(rr[0]) + __uint_as_float(rr[1]); }
    l_reg = l_reg * alpha + ps;
#define PK4(P, B_, OUT) do { unsigned a0 = cvtpk(P[B_+0], P[B_+1]), a1 = cvtpk(P[B_+2], P[B_+3]);                          \
        unsigned b0 = cvtpk(P[B_+4], P[B_+5]), b1 = cvtpk(P[B_+6], P[B_+7]);                                             \
        auto r0 = __builtin_amdgcn_permlane32_swap(a0, b0, false, false); auto r1 = __builtin_amdgcn_permlane32_swap(a1, b1, false, false); \
        u32x4 w = {r0[0], r1[0], r0[1], r1[1]}; OUT = *reinterpret_cast<bf16x8*>(&w); } while (0)
    PK4(p0, 0, pa0); PK4(p0, 8, pa1); PK4(p1, 0, pa2); PK4(p1, 8, pa3);
#undef PK4
}
template <int KB>
__device__ __forceinline__ void qkt(f32x16& p0, f32x16& p1, const char* K_lds, int r32, int hi, const bf16x8* qr, const float* bp  ) {
    { const f32x4 a = *(const f32x4*)(bp), b = *(const f32x4*)(bp + 8), c = *(const f32x4*)(bp + 16), d = *(const f32x4*)(bp + 24);
      p0 = (f32x16){a[0], a[1], a[2], a[3], b[0], b[1], b[2], b[3], c[0], c[1], c[2], c[3], d[0], d[1], d[2], d[3]}; }
    { const f32x4 a = *(const f32x4*)(bp + 32), b = *(const f32x4*)(bp + 40), c = *(const f32x4*)(bp + 48), d = *(const f32x4*)(bp + 56);
      p1 = (f32x16){a[0], a[1], a[2], a[3], b[0], b[1], b[2], b[3], c[0], c[1], c[2], c[3], d[0], d[1], d[2], d[3]}; }
    const char* kb[4];
#pragma unroll
    for (int dd = 0; dd < 4; ++dd) kb[dd] = K_lds + KB * SHM_K + KSWZ(r32, (dd * 16 + hi * 8) * 2);
#pragma unroll
    for (int d0 = 0; d0 < 8; ++d0) { const char* a = kb[d0 & 3] + (d0 >> 2) * 128;
        bf16x8 b0 = *reinterpret_cast<const bf16x8*>(a);
        bf16x8 b1 = *reinterpret_cast<const bf16x8*>(a + 32 * 256);
        p0 = __builtin_amdgcn_mfma_f32_32x32x16_bf16(b0, qr[d0], p0, 0, 0, 0);
        p1 = __builtin_amdgcn_mfma_f32_32x32x16_bf16(b1, qr[d0], p1, 0, 0, 0); }
}
template <int VB>
__device__ __forceinline__ void pv_tile(f32x16* o, int vb0, bf16x8 pa0, bf16x8 pa1, bf16x8 pa2, bf16x8 pa3) {
#define TRRD(dst, off) asm volatile("ds_read_b64_tr_b16 %0, %1 offset:%2" : "=&v"(dst) : "v"(vb0), "i"(off) : "memory")
#define PV_D0(d0) do { s16x4 l0, l1, l2, l3, h0, h1, h2_, h3; constexpr int b_ = VB * SHM_V + v_rd_off(d0, 0, 0); \
        TRRD(l0, b_); TRRD(h0, b_ + 2048); TRRD(l1, b_ + 4096); TRRD(h1, b_ + 6144); TRRD(l2, b_ + 8192); TRRD(h2_, b_ + 10240); TRRD(l3, b_ + 12288); TRRD(h3, b_ + 14336); \
        asm volatile("s_waitcnt lgkmcnt(0)" ::: "memory"); SBAR();   \
        o[d0] = __builtin_amdgcn_mfma_f32_32x32x16_bf16(pa0, (bf16x8){l0[0], l0[1], l0[2], l0[3], h0[0], h0[1], h0[2], h0[3]}, o[d0], 0, 0, 0);   \
        o[d0] = __builtin_amdgcn_mfma_f32_32x32x16_bf16(pa1, (bf16x8){l1[0], l1[1], l1[2], l1[3], h1[0], h1[1], h1[2], h1[3]}, o[d0], 0, 0, 0);   \
        o[d0] = __builtin_amdgcn_mfma_f32_32x32x16_bf16(pa2, (bf16x8){l2[0], l2[1], l2[2], l2[3], h2_[0], h2_[1], h2_[2], h2_[3]}, o[d0], 0, 0, 0);   \
        o[d0] = __builtin_amdgcn_mfma_f32_32x32x16_bf16(pa3, (bf16x8){l3[0], l3[1], l3[2], l3[3], h3[0], h3[1], h3[2], h3[3]}, o[d0], 0, 0, 0); } while (0)
    PV_D0(0); PV_D0(1); PV_D0(2); PV_D0(3);
#undef PV_D0
#undef TRRD
}

struct BlockRef { const GAS bf16_t* Q; const GAS bf16_t* K; const GAS bf16_t* V; GAS bf16_t* O; const GAS float* qss; const GAS float* kss; const GAS float* cc; const GAS float* gg;
                  int P0, skv; };
constexpr int LDQ = 5120, LDK = 5120, LDO = 2048, LDSS = 112;
struct Seam { bf16x8 qr[8]; bf16x8 st_v0, st_v1, st_k0, st_k1; int jlo; };
#define ROWK(p, k0, rr) ((p) + (size_t)((k0) + (rr)) * LDK + sc)
#define VMW() asm volatile("s_waitcnt vmcnt(0)" ::: "memory")
#define VMWN(n) asm volatile("s_waitcnt vmcnt(%0)" :: "i"(n) : "memory")
#define SLOAD_H(Kp, Vp, k0) do { S.st_v0 = load8(ROWK(Vp, k0, sr)); S.st_v1 = load8(ROWK(Vp, k0, 32 + sr));              \
                         S.st_k0 = load8(ROWK(Kp, k0, sr)); S.st_k1 = load8(ROWK(Kp, k0, 32 + sr)); } while (0)
#define SWRITE_HK(bf, k0) do { *(bf16x8*)(K_lds + (bf) * SHM_K + kws) = scale8(S.st_k0, ksr[(k0)]); *(bf16x8*)(K_lds + (bf) * SHM_K + kws + 32 * 256) = scale8(S.st_k1, ksr[(k0) + 32]); } while (0)
#define SWRITE_HV(bf) do { *(bf16x8*)(V_lds + (bf) * SHM_V + vst0) = S.st_v0; *(bf16x8*)(V_lds + (bf) * SHM_V + vst1) = S.st_v1; } while (0)
#define SWRITE_H(bf, k0) do { SWRITE_HV(bf); SWRITE_HK(bf, k0); } while (0)

__device__ __forceinline__ void attn_prime(const BlockRef& cur, char* lds, Seam& S, const int tid) {
    const int wid = __builtin_amdgcn_readfirstlane(tid >> 6), lane = tid & 63, r32 = lane & 31, hi = lane >> 5;
    const int sr = tid >> 4, sc = (tid & 15) * 8, kws = KSWZ(sr, sc * 2); char* K_lds = lds + 2 * SHM_V;
    float* ks_l = (float*)(lds + OFF_KS); float* bs_l = (float*)(lds + OFF_BS); const float* ksr = ks_l + sr;
    int j_hi = (cur.P0 + QB - 1) / KVBLK + 1; if (j_hi > cur.skv / KVBLK) j_hi = cur.skv / KVBLK;
    const int nkeys = j_hi * KVBLK;
    const float c0 = cur.cc ? cur.cc[cur.P0] : 0.f;
    int jlo = 0;
    if (cur.cc) { const float thr = cur.gg[128]; const int jd = cur.P0 / KVBLK;
        const float cv = lane <= jd ? cur.cc[lane * KVBLK + KVBLK - 1] : 0.f;
        const bool keep = lane > jd || (c0 - cv > -thr);
        jlo = __ffsll((long long)__ballot(keep)) - 1; }
    S.jlo = jlo;
    for (int s = jlo * KVBLK + tid; s < nkeys; s += NTHREADS) {
        const f32x4 p = *(const GAS f32x4*)(cur.kss + (size_t)s * LDSS);
        ks_l[s] = rsqrtf(((p[0] + p[1]) + (p[2] + p[3])) * (1.f / 128.f) + EPS);
        bs_l[s] = cur.cc ? (c0 - cur.cc[s]) * (1.f / SCALE) : 0.f;
    }
    __syncthreads();
    const int qrow = wid * QBLK + r32;
    const f32x4 qp = *(const GAS f32x4*)(cur.qss + (size_t)qrow * LDSS);
    const float rq = rsqrtf(((qp[0] + qp[1]) + (qp[2] + qp[3])) * (1.f / 128.f) + EPS);
#pragma unroll
    for (int d0 = 0; d0 < 8; ++d0) {
        const u32x4 w = *(const GAS u32x4*)(cur.Q + (size_t)qrow * LDQ + d0 * 16 + hi * 8);
        const f32x4 g0 = *(const GAS f32x4*)(cur.gg + d0 * 16 + hi * 8), g1 = *(const GAS f32x4*)(cur.gg + d0 * 16 + hi * 8 + 4);
        u32x4 o; o.x = cvtpk(bf_lo(w.x) * rq * g0[0], bf_hi(w.x) * rq * g0[1]); o.y = cvtpk(bf_lo(w.y) * rq * g0[2], bf_hi(w.y) * rq * g0[3]);
        o.z = cvtpk(bf_lo(w.z) * rq * g1[0], bf_hi(w.z) * rq * g1[1]); o.w = cvtpk(bf_lo(w.w) * rq * g1[2], bf_hi(w.w) * rq * g1[3]);
        S.qr[d0] = *reinterpret_cast<bf16x8*>(&o);
    }
    SLOAD_H(cur.K, cur.V, jlo * KVBLK); VMW(); SWRITE_HK(0, jlo * KVBLK);
    __syncthreads();
}
__device__ __forceinline__ void attn_block(const BlockRef& cur, char* lds, Seam& S, const int tid) {
    const int wid = __builtin_amdgcn_readfirstlane(tid >> 6), lane = tid & 63, r32 = lane & 31, hi = lane >> 5;
    const int W = WBIG;
    int j_hi = (cur.P0 + QB - 1) / KVBLK + 1; if (j_hi > cur.skv / KVBLK) j_hi = cur.skv / KVBLK;
    const int j_lo = S.jlo; const int NT = j_hi - j_lo;
    const int qlo = cur.P0 - j_lo * KVBLK + wid * QBLK, qm = qlo + r32 - 4 * hi;
    char* V_lds = lds; char* K_lds = lds + 2 * SHM_V;
    float* ws = (float*)(lds + OFF_WS) + wid * 64; float* li_l = ws, * al_l = ws + 32;
    const float* bs_l = (const float*)(lds + OFF_BS) + j_lo * KVBLK + 4 * hi;
    float m_reg = -1e30f, l_reg = 0; f32x16 o[4] = {};
    const int sr = tid >> 4, sc = (tid & 15) * 8, vst0 = v_st(sr, sc), vst1 = v_st(32 + sr, sc), kws = KSWZ(sr, sc * 2);
    const float* ksr = (const float*)(lds + OFF_KS) + j_lo * KVBLK + sr;
    const int vb0 = (int)(uintptr_t)V_lds + v_rd_base(lane);
    const GAS bf16_t* Kh = cur.K + (size_t)j_lo * KVBLK * LDK; const GAS bf16_t* Vh = cur.V + (size_t)j_lo * KVBLK * LDK;
#define RESC(a) do { if (__any((a) < 1.f)) { if (hi == 0) al_l[r32] = (a); asm volatile("s_waitcnt lgkmcnt(0)" ::: "memory");              \
                     for (int d_ = 0; d_ < 4; ++d_) for (int r = 0; r < 16; ++r) o[d_][r] *= al_l[crow(r, hi)]; } } while (0)
#define KBASE(t) ((t) * KVBLK)
#define MASKT(P0_, P1_, t) do { const int kb_ = KBASE(t); if (kb_ + KVBLK - 1 > qlo) mask_tile(P0_, P1_, qm - kb_, (unsigned)W); } while (0)
    f32x16 pA0, pA1, pB0, pB1; float mnA, mnB, alA, alB; bf16x8 pa0, pa1, pa2, pa3;
    SWRITE_HV(0); SBAR();
    if (NT > 1) { SLOAD_H(Kh, Vh, KBASE(1)); }
    SBAR(); qkt<0>(pA0, pA1, K_lds, r32, hi, S.qr, bs_l + KBASE(0));
    MASKT(pA0, pA1, 0); partialSM(pA0, pA1, m_reg, mnA, alA);
    if (NT > 1) { VMW(); SWRITE_H(1, KBASE(1)); }
    __syncthreads();
#define HALF_STEP(PX0, PX1, mnX, alX, PY0, PY1, alY, t, KB, VB, SB) do {                                                      \
        SBAR(); qkt<KB>(PX0, PX1, K_lds, r32, hi, S.qr, bs_l + KBASE(t));                                                         \
        finishSM(PY0, PY1, alY, l_reg, pa0, pa1, pa2, pa3); SBAR();                                                           \
        if ((t) + 1 < NT) { SLOAD_H(Kh, Vh, KBASE((t) + 1)); SBAR(); }                                               \
        pv_tile<VB>(o, vb0, pa0, pa1, pa2, pa3); MASKT(PX0, PX1, (t)); partialSM(PX0, PX1, m_reg, mnX, alX);                                        \
        __syncthreads();                                                                                                      \
        if ((t) + 1 < NT) { VMW(); SWRITE_H(SB, KBASE((t) + 1)); }                                                                          \
        RESC(alX); __syncthreads(); } while (0)
    for (int t = 1; t + 1 < NT; t += 2) {
        HALF_STEP(pB0, pB1, mnB, alB, pA0, pA1, alA, t, 1, 0, 0);
        HALF_STEP(pA0, pA1, mnA, alA, pB0, pB1, alB, t + 1, 0, 1, 1);
    }
    const bool even = (NT & 1) == 0;
    if (even) { SBAR(); qkt<1>(pB0, pB1, K_lds, r32, hi, S.qr, bs_l + KBASE(NT - 1)); SBAR(); }
    finishSM(pA0, pA1, alA, l_reg, pa0, pa1, pa2, pa3); SBAR();
    pv_tile<0>(o, vb0, pa0, pa1, pa2, pa3);
    if (even) { MASKT(pB0, pB1, NT - 1); partialSM(pB0, pB1, m_reg, mnB, alB); __syncthreads(); RESC(alB);
        finishSM(pB0, pB1, alB, l_reg, pa0, pa1, pa2, pa3); SBAR(); pv_tile<1>(o, vb0, pa0, pa1, pa2, pa3); }
    SBAR();
    if (hi == 0) li_l[r32] = l_reg; asm volatile("s_waitcnt lgkmcnt(0)" ::: "memory");
    float rli[16];
#pragma unroll
    for (int r = 0; r < 16; ++r) rli[r] = __builtin_amdgcn_rcpf(li_l[crow(r, hi)]);
    GAS bf16_t* Ow = cur.O + (size_t)(wid * QBLK) * LDO;
#pragma unroll
    for (int r = 0; r < 16; ++r) { const int orow = crow(r, hi);
#pragma unroll
        for (int d0 = 0; d0 < 4; ++d0) { const float v = o[d0][r] * rli[r];
            const float vn = dppf<0xB1>(v);
            if ((r32 & 1) == 0) *(GAS unsigned*)(Ow + (size_t)orow * LDO + d0 * 32 + r32) = cvtpk(v, vn); } }
    __syncthreads();
#undef RESC
#undef KBASE
#undef MASKT
#undef HALF_STEP
}
#undef ROWK
#undef VMW
#undef VMWN
#undef SLOAD_H
#undef SWRITE_HK
#undef SWRITE_HV
#undef SWRITE_H
#undef KSWZ
#undef SBAR
}


struct Frame {
    GAS unsigned char* ws; const float* const* in_; GAS float* out;
    __device__ __forceinline__ const GAS float* in(int i) const { return (const GAS float*)in_[i]; }
    int tid, lane, wave, gw, ngw, gtid, ngt;
};
enum { I_X = 0, I_MEM, I_ANORM, I_AWIN, I_ACONVW, I_ACONVB, I_AGATEW, I_AGATEB, I_ALAMBDA, I_AWOUT, I_SNORM, I_SWKVF, I_SBF, I_SKNORM, I_BNORM, I_BWIN, I_BQNORM, I_BWOUT,
       I_MNORM, I_MWKV, I_MQNORM, I_MKNORM, I_PNORM, I_PWQ, I_PSUBK, I_PU, I_PV, N_IN };

struct TrItem { const GAS float* W; const GAS float* gain; GAS bf16_t* WT; int ldw, ldt, row_off, k0, n0; };
__device__ __forceinline__ void tr_load(const TrItem& d, float (&wv)[32], int lane) {
#pragma unroll
    for (int i = 0; i < 32; ++i) wv[i] = __builtin_nontemporal_load(d.W + (size_t)(d.k0 + 2 * i + (lane >> 5)) * d.ldw + d.n0 + (lane & 31));
}
__device__ __forceinline__ void tr_proc(const TrItem& d, float (&wv)[32], LAS float* scr, int lane) {
    if (d.gain) {
#pragma unroll
        for (int i = 0; i < 32; ++i) wv[i] *= d.gain[d.k0 + 2 * i + (lane >> 5)]; }
#pragma unroll
    for (int i = 0; i < 32; ++i) scr[(2 * i + (lane >> 5)) * 33 + (lane & 31)] = wv[i];
    asm volatile("s_waitcnt lgkmcnt(0)" ::: "memory");
    const int c = lane & 7;
#pragma unroll
    for (int j = 0; j < 4; ++j) { const int n = (lane >> 3) + 8 * j; const LAS float* s = scr + (8 * c) * 33 + n;
        u32x4 o; o.x = cvtpk(s[0 * 33], s[1 * 33]); o.y = cvtpk(s[2 * 33], s[3 * 33]); o.z = cvtpk(s[4 * 33], s[5 * 33]); o.w = cvtpk(s[6 * 33], s[7 * 33]);
        *(GAS u32x4*)(d.WT + (size_t)(d.row_off + d.n0 + n) * d.ldt + d.k0 + 8 * c) = o; }
    asm volatile("s_waitcnt lgkmcnt(0)" ::: "memory");
}
__device__ __forceinline__ void transpose_item_fp8(const GAS float* W, int ldw, const GAS float* gain, GAS unsigned char* WT, int ldt, LAS float* scr, int nblk, int item, int lane) {
    const int kb = item / nblk, nb = item % nblk, k0 = 64 * kb, n0 = 32 * nb;
    float wv[32];
#pragma unroll
    for (int i = 0; i < 32; ++i) wv[i] = W[(size_t)(k0 + 2 * i + (lane >> 5)) * ldw + n0 + (lane & 31)];
#pragma unroll
    for (int i = 0; i < 32; ++i) wv[i] *= gain[k0 + 2 * i + (lane >> 5)] * 64.f;
#pragma unroll
    for (int i = 0; i < 32; ++i) scr[(2 * i + (lane >> 5)) * 33 + (lane & 31)] = wv[i];
    asm volatile("s_waitcnt lgkmcnt(0)" ::: "memory");
    const int c = lane & 3;
#pragma unroll
    for (int j = 0; j < 2; ++j) { const int n = (lane >> 2) + 16 * j; const LAS float* sp = scr + (16 * c) * 33 + n; u32x4 o;
#pragma unroll
        for (int w = 0; w < 4; ++w) { int pk = __builtin_amdgcn_cvt_pk_fp8_f32(sp[(4 * w) * 33], sp[(4 * w + 1) * 33], 0, false); pk = __builtin_amdgcn_cvt_pk_fp8_f32(sp[(4 * w + 2) * 33], sp[(4 * w + 3) * 33], pk, true); o[w] = (unsigned)pk; }
        *(GAS u32x4*)(WT + (size_t)(n0 + n) * ldt + k0 + 16 * c) = o; }
    asm volatile("s_waitcnt lgkmcnt(0)" ::: "memory");
}
struct CtRow { f32x4 v[8]; GAS unsigned char* dst; int row, which; };
__device__ __forceinline__ void ct_load(Frame& F, int layer, int it, CtRow& R) {
    R.which = it & 1; R.row = it >> 1;
    const GAS float* src = F.in(R.which ? I_PV : I_PU) + ((size_t)layer * NEXP + R.row) * DM + F.lane * 4;
    R.dst = F.ws + O_TAB + (size_t)(layer * 2 + R.which) * TAB_ONE;
#pragma unroll
    for (int c = 0; c < 8; ++c) R.v[c] = __builtin_nontemporal_load((const GAS f32x4*)(src + c * 256));
}
__device__ __forceinline__ void ct_proc(Frame& F, int layer, CtRow& R) {
    const GAS float* gn = F.in(I_PNORM) + layer * DM + F.lane * 4;
    _Float16 shv = (_Float16)0.f;
#pragma unroll
    for (int c = 0; c < 8; ++c) { f32x4 x = R.v[c]; if (!R.which) x = x * *(const GAS f32x4*)(gn + c * 256);
        float amax = fmaxf(fmaxf(fabsf(x[0]), fabsf(x[1])), fmaxf(fabsf(x[2]), fabsf(x[3])));
        amax = wave_max(amax);
        const _Float16 sh = (_Float16)fmaxf(amax * (R.which ? 1.f / 6.f : 1.f / 7.f), 1e-6f);
        const float qs = __builtin_amdgcn_rcpf((float)sh);
        unsigned pk;
        if (R.which) { pk = __builtin_amdgcn_cvt_scalef32_pk_fp4_f32(0u, x[0] * qs, x[1] * qs, 1.0f, 0); pk = __builtin_amdgcn_cvt_scalef32_pk_fp4_f32(pk, x[2] * qs, x[3] * qs, 1.0f, 1); }
        else { const int q0 = (int)fminf(fmaxf(rintf(x[0] * qs), -7.f), 7.f), q1 = (int)fminf(fmaxf(rintf(x[1] * qs), -7.f), 7.f), q2 = (int)fminf(fmaxf(rintf(x[2] * qs), -7.f), 7.f), q3 = (int)fminf(fmaxf(rintf(x[3] * qs), -7.f), 7.f);
               pk = (unsigned)(q0 & 15) | ((unsigned)(q1 & 15) << 4) | ((unsigned)(q2 & 15) << 8) | ((unsigned)(q3 & 15) << 12); }
        *(GAS unsigned short*)(R.dst + ((size_t)c * NEXP + R.row) * 128 + F.lane * 2) = (unsigned short)pk;
        shv = (F.lane == c) ? sh : shv; }
    if (F.lane < 8) *(GAS unsigned short*)(R.dst + TAB_NIB + ((size_t)R.row * 8 + F.lane) * 2) = __builtin_bit_cast(unsigned short, shv);
}
__device__ __forceinline__ void convert_tables(Frame& F, int layer, int ibeg, int iend, int wk, int nwk) {
    if (ibeg + wk >= iend) return;
    const int ilast = ibeg + wk + ((iend - 1 - ibeg - wk) / nwk) * nwk;
    CtRow A, B;
    ct_load(F, layer, ibeg + wk, A);
    for (int it = ibeg + wk; it < iend; it += 2 * nwk) {
        ct_load(F, layer, it + nwk <= ilast ? it + nwk : ilast, B);
        ct_proc(F, layer, A);
        ct_load(F, layer, it + 2 * nwk <= ilast ? it + 2 * nwk : ilast, A);
        if (it + nwk < iend) ct_proc(F, layer, B);
    }
}
__device__ __forceinline__ void norm_row_bf16(const GAS float* xrow, const GAS float* gain, GAS bf16_t* orow, int lane) {
    f32x4 v[8]; float s = 0.f;
#pragma unroll
    for (int j = 0; j < 8; ++j) { v[j] = *(const GAS f32x4*)(xrow + j * 256 + lane * 4); s += (v[j][0] * v[j][0] + v[j][1] * v[j][1]) + (v[j][2] * v[j][2] + v[j][3] * v[j][3]); }
    const float r = rsqrtf(wave_sum(s) * (1.f / DM) + EPS);
#pragma unroll
    for (int j = 0; j < 8; ++j) { f32x4 g = gain ? *(const GAS f32x4*)(gain + j * 256 + lane * 4) : (f32x4){1.f, 1.f, 1.f, 1.f};
        u32x2 o; o.x = cvtpk(v[j][0] * r * g[0], v[j][1] * r * g[1]); o.y = cvtpk(v[j][2] * r * g[2], v[j][3] * r * g[3]);
        *(GAS u32x2*)(orow + j * 256 + lane * 4) = o; }
}
__device__ __forceinline__ void step_prologue(Frame& F, LAS unsigned char* lds) {
    LAS float* scr = (LAS float*)(lds + F.wave * 16384);
    GAS unsigned char* ws = F.ws;
    constexpr int I0 = 32 * (NIN0 / 32), I1 = 32 * 64, I2 = 32 * 96, I3 = 32 * 64, I4 = 32 * 64, I5 = 32 * 64, I6 = 32 * 64, I7 = 32 * 32, I8 = 32 * 32, I9 = 12 * 16;
    constexpr int NITEMS = I0 + I1 + I2 + I3 + I4 + I5 + I6 + I7 + I8 + I9;
#define TR_DESC(D, it_) do { int r = (it_) < NITEMS ? (it_) : NITEMS - 1; int nblk; \
        if (r < I0) { D = {F.in(I_AWIN), F.in(I_ANORM), (GAS bf16_t*)(ws + O_WIN0), NIN0, DM, 0, 0, 0}; nblk = NIN0 / 32; } else { r -= I0; \
        if (r < I1) { D = {F.in(I_AWOUT), nullptr, (GAS bf16_t*)(ws + O_WOUT0), DM, DM, 0, 0, 0}; nblk = 64; } else { r -= I1; \
        if (r < I2) { D = {F.in(I_SWKVF), F.in(I_SNORM), (GAS bf16_t*)(ws + O_WL1), 3084, DM, 0, 0, 0}; nblk = 96; } else { r -= I2; \
        if (r < I3) { D = {F.in(I_BWIN), F.in(I_BNORM), (GAS bf16_t*)(ws + O_WL1), DM, DM, 3072, 0, 0}; nblk = 64; } else { r -= I3; \
        if (r < I4) { D = {F.in(I_BWOUT), nullptr, (GAS bf16_t*)(ws + O_WOUT1), DM, DM, 0, 0, 0}; nblk = 64; } else { r -= I4; \
        if (r < I5) { D = {F.in(I_PWQ), F.in(I_PNORM), (GAS bf16_t*)(ws + O_WQ0), DM, DM, 0, 0, 0}; nblk = 64; } else { r -= I5; \
        if (r < I6) { D = {F.in(I_PWQ) + (size_t)DM * DM, F.in(I_PNORM) + DM, (GAS bf16_t*)(ws + O_WQ1), DM, DM, 0, 0, 0}; nblk = 64; } else { r -= I6; \
        if (r < I7) { D = {F.in(I_MWKV), nullptr, (GAS bf16_t*)(ws + O_WMKV), 1024, DM, 0, 0, 0}; nblk = 32; } else { r -= I7; \
        if (r < I8) { D = {F.in(I_MWKV) + (size_t)DM * 1024, nullptr, (GAS bf16_t*)(ws + O_WMKV) + (size_t)1024 * DM, 1024, DM, 0, 0, 0}; nblk = 32; } else { r -= I8; \
          const int blk = r / 16; r = r % 16; D = {F.in(I_AGATEW) + (size_t)blk * 128 * 256, nullptr, (GAS bf16_t*)(ws + O_WGATE), 256, 128, blk * 256, 0, 0}; nblk = 8; } } } } } } } } } \
        D.k0 = 64 * (r / nblk); D.n0 = 32 * (r % nblk); } while (0)
    for (int it = F.gw; it < NITEMS; it += F.ngw) { float wv[32]; TrItem d; TR_DESC(d, it); tr_load(d, wv, F.lane); tr_proc(d, wv, scr, F.lane); }
#undef TR_DESC
    { const GAS float* sk = F.in(I_PSUBK); GAS bf16_t* o = (GAS bf16_t*)(ws + O_SUBK);
      for (int i = F.gtid; i < 2 * 16 * 128 * 128 / 2; i += F.ngt) *(GAS unsigned*)(o + 2 * i) = cvtpk(sk[2 * i], sk[2 * i + 1]); }
    { GAS float* wf = (GAS float*)(ws + O_WF); const GAS float* w = F.in(I_SWKVF); const GAS float* g = F.in(I_SNORM);
      for (int i = F.gtid; i < 12 * DM; i += F.ngt) { const int j = i / DM, k = i % DM; wf[i] = w[(size_t)k * 3084 + 3072 + j] * g[k]; } }
    { GAS float* spl = (GAS float*)(ws + O_SPL); const GAS float* lam = F.in(I_ALAMBDA);
      for (int i = F.gtid; i < LRU; i += F.ngt) { const float z = -lam[i]; spl[i] = fmaxf(z, 0.f) + log1p_pos(fast_exp(-fabsf(z))); } }
    if (F.gw == 0) {
        float m = 0.f; for (int d = F.lane; d < 128; d += 64) m = fmaxf(m, fabsf(F.in(I_BQNORM)[d] * F.in(I_SKNORM)[d]));
        m = wave_max(m);
        if (F.lane == 0) ((GAS float*)(ws + O_GG))[512] = 2.f * 11.3137085f * m + 30.f; }
    { GAS float* gg = (GAS float*)(ws + O_GG);
      for (int i = F.gtid; i < 384; i += F.ngt) { const int a = i / 128, d = i % 128;
          gg[a == 0 ? 384 + d : i] = a == 0 ? F.in(I_BQNORM)[d] * F.in(I_SKNORM)[d] : F.in(I_MQNORM)[(a - 1) * 128 + d] * F.in(I_MKNORM)[(a - 1) * 128 + d]; } }
    {
        const GAS float* xin = F.in(I_X) + F.lane * 4; GAS bf16_t* xo = (GAS bf16_t*)(ws + O_XS16) + F.lane * 4;
        const int mlast = F.gw + ((T - 1 - F.gw) / F.ngw) * F.ngw;
#define XN_LOAD(V, m_) do { const int mm_ = (m_) <= mlast ? (m_) : mlast; _Pragma("unroll") for (int j = 0; j < 8; ++j) V[j] = __builtin_nontemporal_load((const GAS f32x4*)(xin + (size_t)mm_ * DM + j * 256)); } while (0)
#define XN_PROC(V, m_) do { if ((m_) < T) { float s0 = 0.f; _Pragma("unroll") for (int j = 0; j < 8; ++j) s0 += (V[j][0] * V[j][0] + V[j][1] * V[j][1]) + (V[j][2] * V[j][2] + V[j][3] * V[j][3]); \
            const float r0 = rsqrtf(wave_sum(s0) * (1.f / DM) + EPS); \
            _Pragma("unroll") for (int j = 0; j < 8; ++j) { u32x2 a; a.x = cvtpk(V[j][0] * r0, V[j][1] * r0); a.y = cvtpk(V[j][2] * r0, V[j][3] * r0); *(GAS u32x2*)(xo + (size_t)(m_) * DM + j * 256) = a; } } } while (0)
        f32x4 va[8], vb[8];
        XN_LOAD(va, F.gw);
        for (int m = F.gw; m < T; m += 2 * F.ngw) { XN_LOAD(vb, m + F.ngw); XN_PROC(va, m); XN_LOAD(va, m + 2 * F.ngw); XN_PROC(vb, m + F.ngw); }
#undef XN_LOAD
#undef XN_PROC
    }
    for (int m = F.gw; m < 2 * NMROW; m += F.ngw) { const int l = m / NMROW, r = m % NMROW;
        norm_row_bf16(F.in(I_MEM) + (size_t)r * DM, F.in(I_MNORM) + l * DM, (GAS bf16_t*)(ws + O_MEMN) + (size_t)m * DM, F.lane); }
    convert_tables(F, 0, 0, 2 * NEXP, F.gw, F.ngw);
}
__device__ __forceinline__ void step_conv(Frame& F) {
    const GAS bf16_t* zx = (const GAS bf16_t*)(F.ws + O_ZX); GAS bf16_t* xc = (GAS bf16_t*)(F.ws + O_XC);
    const GAS float* cw = F.in(I_ACONVW); const GAS float* cb = F.in(I_ACONVB);
    constexpr int NIT = T * (LRU / 8);
#define CV_LOAD(W, it_) do { const int ii_ = (it_) < NIT ? (it_) : NIT - 1; const int t_ = ii_ / (LRU / 8), c8_ = (ii_ % (LRU / 8)) * 8, pos_ = t_ & (SEQ - 1); \
        _Pragma("unroll") for (int k = 0; k < 4; ++k) W[k] = (pos_ - 3 + k >= 0) ? *(const GAS u32x4*)(zx + (size_t)(t_ - 3 + k) * LRU + c8_) : (u32x4){0u, 0u, 0u, 0u}; } while (0)
#define CV_PROC(W, it_) do { if ((it_) < NIT) { const int t_ = (it_) / (LRU / 8), c8_ = ((it_) % (LRU / 8)) * 8; float a[8]; \
        { const f32x4 b0 = *(const GAS f32x4*)(cb + c8_), b1 = *(const GAS f32x4*)(cb + c8_ + 4); a[0] = b0[0]; a[1] = b0[1]; a[2] = b0[2]; a[3] = b0[3]; a[4] = b1[0]; a[5] = b1[1]; a[6] = b1[2]; a[7] = b1[3]; } \
        _Pragma("unroll") for (int k = 0; k < 4; ++k) { const f32x4 w0 = *(const GAS f32x4*)(cw + k * LRU + c8_), w1 = *(const GAS f32x4*)(cw + k * LRU + c8_ + 4); \
            a[0] = fmaf(w0[0], bf_lo(W[k].x), a[0]); a[1] = fmaf(w0[1], bf_hi(W[k].x), a[1]); a[2] = fmaf(w0[2], bf_lo(W[k].y), a[2]); a[3] = fmaf(w0[3], bf_hi(W[k].y), a[3]); \
            a[4] = fmaf(w1[0], bf_lo(W[k].z), a[4]); a[5] = fmaf(w1[1], bf_hi(W[k].z), a[5]); a[6] = fmaf(w1[2], bf_lo(W[k].w), a[6]); a[7] = fmaf(w1[3], bf_hi(W[k].w), a[7]); } \
        u32x4 o; o.x = cvtpk(a[0], a[1]); o.y = cvtpk(a[2], a[3]); o.z = cvtpk(a[4], a[5]); o.w = cvtpk(a[6], a[7]); \
        *(GAS u32x4*)(xc + (size_t)t_ * LRU + c8_) = o; } } while (0)
    u32x4 wa[4], wb[4];
    CV_LOAD(wa, F.gtid);
    for (int it = F.gtid; it < NIT; it += 2 * F.ngt) { CV_LOAD(wb, it + F.ngt); CV_PROC(wa, it); CV_LOAD(wa, it + 2 * F.ngt); CV_PROC(wb, it + F.ngt); }
#undef CV_LOAD
#undef CV_PROC
}
constexpr int SCK = 32, NCK = SEQ / SCK;
typedef _Float16 h8_t __attribute__((ext_vector_type(8)));
__device__ __forceinline__ void scan_load(const GAS _Float16* LA, const GAS _Float16* UH, size_t off, float (&a)[8], float (&u)[8]) {
    const h8_t l = *(const GAS h8_t*)(LA + off), w = *(const GAS h8_t*)(UH + off);
#pragma unroll
    for (int k = 0; k < 8; ++k) { a[k] = fast_exp((float)l[k]); u[k] = (float)w[k]; }
}
__device__ __forceinline__ void step_scan1(Frame& F) {
    const GAS _Float16* LA = (const GAS _Float16*)(F.ws + O_AA); const GAS _Float16* UH = (const GAS _Float16*)(F.ws + O_UU);
    GAS float* CA = (GAS float*)(F.ws + O_LOGFP); GAS float* CH = CA + (size_t)NB * NCK * LRU;
    if (F.tid >= 384) return;
    const int grp = F.tid / 192, th = F.tid % 192;
    for (int it = blockIdx.x * 2 + grp; it < NB * NCK; it += gridDim.x * 2) {
        const int b = it / NCK, ck = it % NCK; const size_t base = ((size_t)b * SEQ + ck * SCK) * LRU + th * 8;
        float ap[8], h[8];
#pragma unroll
        for (int k = 0; k < 8; ++k) { ap[k] = 1.f; h[k] = 0.f; }
#pragma unroll 8
        for (int i = 0; i < SCK; ++i) { float a[8], u[8]; scan_load(LA, UH, base + (size_t)i * LRU, a, u);
#pragma unroll
            for (int k = 0; k < 8; ++k) { ap[k] *= a[k]; h[k] = a[k] * h[k] + u[k]; } }
        GAS float* ca = CA + (size_t)it * LRU + th * 8; GAS float* ch = CH + (size_t)it * LRU + th * 8;
        *(GAS f32x4*)ca = (f32x4){ap[0], ap[1], ap[2], ap[3]}; *(GAS f32x4*)(ca + 4) = (f32x4){ap[4], ap[5], ap[6], ap[7]};
        *(GAS f32x4*)ch = (f32x4){h[0], h[1], h[2], h[3]}; *(GAS f32x4*)(ch + 4) = (f32x4){h[4], h[5], h[6], h[7]};
    }
}
__device__ __forceinline__ void step_scan2(Frame& F) {
    const GAS _Float16* LA = (const GAS _Float16*)(F.ws + O_AA); const GAS _Float16* UH = (const GAS _Float16*)(F.ws + O_UU);
    const GAS float* CA = (const GAS float*)(F.ws + O_LOGFP); const GAS float* CH = CA + (size_t)NB * NCK * LRU;
    const GAS bf16_t* gy = (const GAS bf16_t*)(F.ws + O_GY); GAS bf16_t* cat = (GAS bf16_t*)(F.ws + O_CAT);
    if (F.tid >= 384) return;
    const int grp = F.tid / 192, th = F.tid % 192;
    for (int it = blockIdx.x * 2 + grp; it < NB * NCK; it += gridDim.x * 2) {
        const int b = it / NCK, ck = it % NCK; const size_t base = ((size_t)b * SEQ + ck * SCK) * LRU + th * 8;
        float h[8];
#pragma unroll
        for (int k = 0; k < 8; ++k) h[k] = 0.f;
        for (int k2 = 0; k2 < ck; ++k2) { const size_t o = (size_t)(b * NCK + k2) * LRU + th * 8;
            const f32x4 a0 = *(const GAS f32x4*)(CA + o), a1 = *(const GAS f32x4*)(CA + o + 4), c0 = *(const GAS f32x4*)(CH + o), c1 = *(const GAS f32x4*)(CH + o + 4);
#pragma unroll
            for (int k = 0; k < 4; ++k) { h[k] = a0[k] * h[k] + c0[k]; h[4 + k] = a1[k] * h[4 + k] + c1[k]; } }
#pragma unroll 8
        for (int i = 0; i < SCK; ++i) { float a[8], u[8]; scan_load(LA, UH, base + (size_t)i * LRU, a, u);
            const size_t row = (size_t)b * SEQ + ck * SCK + i;
            const u32x4 g = *(const GAS u32x4*)(gy + row * LRU + th * 8); u32x4 o;
#pragma unroll
            for (int k = 0; k < 8; ++k) h[k] = a[k] * h[k] + u[k];
#pragma unroll
            for (int k = 0; k < 4; ++k) o[k] = cvtpk(h[2 * k] * bf_lo(g[k]), h[2 * k + 1] * bf_hi(g[k]));
            *(GAS u32x4*)(cat + row * DM + th * 8) = o; }
    }
}
__device__ __forceinline__ void step_cprefix(Frame& F, LAS unsigned char* lds) {
    const GAS float* lf = (const GAS float*)(F.ws + O_LOGF); GAS float* cc = (GAS float*)(F.ws + O_CC);
    LAS double* scr = (LAS double*)(lds + F.wave * 16384);
    for (int it = F.gw; it < NB * NH; it += F.ngw) {
        const GAS float* p = lf + (size_t)it * SEQ + F.lane * 64; GAS float* q = cc + (size_t)it * SEQ + F.lane * 64;
        double s = 0.0;
        for (int i = 0; i < 64; ++i) s += (double)p[i];
        scr[F.lane] = s;
        asm volatile("s_waitcnt lgkmcnt(0)" ::: "memory");
        double run = 0.0;
        for (int l = 0; l < 64; ++l) { const double v = scr[l]; if (l < F.lane) run += v; }
        for (int i = 0; i < 64; ++i) { run += (double)p[i]; q[i] = (float)run; }
        asm volatile("s_waitcnt lgkmcnt(0)" ::: "memory");
    }
}

__device__ __forceinline__ int ord_i(float f) { const int b = __float_as_int(f); return b ^ ((b >> 31) & 0x7fffffff); }
__device__ __forceinline__ float unord_f(int k) { return __int_as_float(k ^ ((k >> 31) & 0x7fffffff)); }
template <int N> __device__ __forceinline__ void bitonic_sort_desc(int (&a)[N]) {
#pragma unroll
    for (int k = 2; k <= N; k <<= 1) {
#pragma unroll
        for (int j = k >> 1; j > 0; j >>= 1) {
#pragma unroll
            for (int i = 0; i < N; ++i) { const int l = i ^ j;
                if (l > i) { const bool desc = ((i & k) == 0); const int mx = max(a[i], a[l]), mn = min(a[i], a[l]); a[i] = desc ? mx : mn; a[l] = desc ? mn : mx; } }
        }
    }
}
__device__ __forceinline__ void bitonic_merge16_desc(int (&a)[16]) {
#pragma unroll
    for (int j = 8; j > 0; j >>= 1) {
#pragma unroll
        for (int i = 0; i < 16; ++i) { const int l = i ^ j; if (l > i) { const int mx = max(a[i], a[l]), mn = min(a[i], a[l]); a[i] = mx; a[l] = mn; } }
    }
}
__device__ __forceinline__ void top16_of_64(int (&a)[64]) {
    int g[4][16];
#pragma unroll
    for (int q = 0; q < 4; ++q) {
#pragma unroll
        for (int i = 0; i < 16; ++i) g[q][i] = a[16 * q + i];
        bitonic_sort_desc<16>(g[q]); }
#pragma unroll
    for (int i = 0; i < 16; ++i) { g[0][i] = max(g[0][i], g[1][15 - i]); g[2][i] = max(g[2][i], g[3][15 - i]); }
    bitonic_merge16_desc(g[0]); bitonic_merge16_desc(g[2]);
#pragma unroll
    for (int i = 0; i < 16; ++i) g[0][i] = max(g[0][i], g[2][15 - i]);
    bitonic_merge16_desc(g[0]);
#pragma unroll
    for (int i = 0; i < 16; ++i) a[i] = g[0][i];
}
__device__ __forceinline__ void subkey_top16(const GAS bf16_t* qrow  , const GAS bf16_t* sk  , int r32, int hi, int (&top)[16]) {
    bf16x8 qf[8];
#pragma unroll
    for (int ks = 0; ks < 8; ++ks) qf[ks] = *(const GAS bf16x8*)(qrow + ks * 16 + hi * 8);
    unsigned loff = (unsigned)(r32 * 128 + hi * 8) * 2u; asm volatile("" : "+v"(loff));
    int key[64];
#pragma unroll
    for (int kb = 0; kb < 4; ++kb) {
        f32x16 acc = {};
#pragma unroll
        for (int ks = 0; ks < 8; ++ks) { const bf16x8 af = *(const GAS bf16x8*)((const GAS char*)(sk + kb * 32 * 128 + ks * 16) + loff);
            acc = __builtin_amdgcn_mfma_f32_32x32x16_bf16(af, qf[ks], acc, 0, 0, 0); }
#pragma unroll
        for (int r = 0; r < 16; ++r) { const int id = kb * 32 + (r & 3) + 8 * (r >> 2) + 4 * hi; key[kb * 16 + r] = (ord_i(acc[r]) & ~127) | (127 - id); }
        __builtin_amdgcn_sched_barrier(0);
    }
    top16_of_64(key);
#pragma unroll
    for (int i = 0; i < 16; ++i) { auto r = __builtin_amdgcn_permlane32_swap((unsigned)key[15 - i], (unsigned)key[15 - i], false, false);
        const int pk = hi ? (int)r[0] : (int)r[1]; top[i] = max(key[i], pk); }
    bitonic_merge16_desc(top);
}
__device__ __forceinline__ void step_topk(Frame& F, LAS unsigned char* lds, int layer) {
    const GAS bf16_t* q16 = (const GAS bf16_t*)(F.ws + O_Q16); const GAS bf16_t* subk = (const GAS bf16_t*)(F.ws + O_SUBK) + (size_t)layer * 16 * 128 * 128;
    GAS int* IDX = (GAS int*)(F.ws + O_IDX); GAS float* GW = (GAS float*)(F.ws + O_GW);
    LAS int* scr = (LAS int*)(lds + F.wave * 16384) + F.lane * 33;
    const int r32 = F.lane & 31, hi = F.lane >> 5;
    for (int task = F.gw; task < (T / 32) * 8; task += F.ngw) {
        const int tb = task >> 3, h = task & 7; const int tok = tb * 32 + r32;
        const GAS bf16_t* qrow = q16 + (size_t)tok * DM + h * 256;
        int ta[16], tb16[16];
        subkey_top16(qrow, subk + (size_t)(h * 2 + 0) * 128 * 128, r32, hi, ta);
        subkey_top16(qrow + 128, subk + (size_t)(h * 2 + 1) * 128 * 128, r32, hi, tb16);
        float va[16], vb[16];
#pragma unroll
        for (int i = 0; i < 16; ++i) { va[i] = unord_f(ta[i] & ~127); vb[i] = unord_f(tb16[i] & ~127); scr[i] = 127 - (ta[i] & 127); scr[16 + i] = 127 - (tb16[i] & 127); }
        int c2[64]; int n = 0;
#pragma unroll
        for (int i = 0; i < 16; ++i)
#pragma unroll
            for (int j = 0; j < 16; ++j) if ((i + 1) * (j + 1) <= 16) { c2[n] = (ord_i(va[i] + vb[j]) & ~255) | (255 - (i * 16 + j)); ++n; }
#pragma unroll
        for (int i = 50; i < 64; ++i) c2[i] = (int)0x80000000;
        top16_of_64(c2);
        asm volatile("s_waitcnt lgkmcnt(0)" ::: "memory");
        float sv[16], ex[16]; int ev[16]; float Z = 0.f;
#pragma unroll
        for (int r = 0; r < 16; ++r) { const int flat = 255 - (c2[r] & 255); sv[r] = unord_f(c2[r] & ~255); ev[r] = scr[flat >> 4] * 128 + scr[16 + (flat & 15)]; }
#pragma unroll
        for (int r = 0; r < 16; ++r) { ex[r] = fast_exp(sv[r] - sv[0]); Z += ex[r]; }
        const float iz = 1.f / Z;
        GAS int* ip = IDX + (size_t)tok * 128 + h * 16 + hi * 8; GAS float* gp = GW + (size_t)tok * 128 + h * 16 + hi * 8;
        int eo[8]; float go[8];
#pragma unroll
        for (int j = 0; j < 8; ++j) { eo[j] = hi ? ev[8 + j] : ev[j]; go[j] = (hi ? ex[8 + j] : ex[j]) * iz; }
        *(GAS u32x4*)ip = (u32x4){(unsigned)eo[0], (unsigned)eo[1], (unsigned)eo[2], (unsigned)eo[3]}; *(GAS u32x4*)(ip + 4) = (u32x4){(unsigned)eo[4], (unsigned)eo[5], (unsigned)eo[6], (unsigned)eo[7]};
        *(GAS f32x4*)gp = (f32x4){go[0], go[1], go[2], go[3]}; *(GAS f32x4*)(gp + 4) = (f32x4){go[4], go[5], go[6], go[7]};
        asm volatile("s_waitcnt lgkmcnt(0)" ::: "memory");
    }
}
__device__ __forceinline__ h2 as_h2(unsigned w) { return __builtin_bit_cast(h2, w); }
#define F4(W, s) __builtin_amdgcn_cvt_scalef32_pk_f16_fp4((W), 1.0f, (s))
#define H2F(us) ((float)__builtin_bit_cast(_Float16, (unsigned short)(us)))
__device__ __forceinline__ float sum8(float v) { v += dppf<0xB1>(v); v += dppf<0x4E>(v); v += dppf<0x141>(v); return v; }
__device__ __forceinline__ void step_xplanes(Frame& F) {
    const GAS bf16_t* xs = (const GAS bf16_t*)(F.ws + O_XS16); GAS unsigned char* x4 = F.ws + O_X4; GAS float* sx = (GAS float*)(F.ws + O_SX);
    const int tlast = F.gw + ((T - 1 - F.gw) / F.ngw) * F.ngw;
#define XP_LOAD(W, t_) do { const int tt_ = (t_) <= tlast ? (t_) : tlast; _Pragma("unroll") for (int c = 0; c < 4; ++c) W[c] = *(const GAS u32x4*)(xs + (size_t)tt_ * DM + F.lane * 32 + 8 * c); } while (0)
    u32x4 w[4], wn[4];
    XP_LOAD(w, F.gw);
    for (int t = F.gw; t < T; t += F.ngw) {
        XP_LOAD(wn, t + F.ngw);
        float xv[32]; float amax = 0.f;
#pragma unroll
        for (int c = 0; c < 4; ++c)
#pragma unroll
            for (int k = 0; k < 4; ++k) { xv[8 * c + 2 * k] = bf_lo(w[c][k]); xv[8 * c + 2 * k + 1] = bf_hi(w[c][k]); amax = fmaxf(amax, fmaxf(fabsf(xv[8 * c + 2 * k]), fabsf(xv[8 * c + 2 * k + 1]))); }
        amax = fmaxf(amax, dppf<0xB1>(amax)); amax = fmaxf(amax, dppf<0x4E>(amax)); amax = fmaxf(amax, dppf<0x141>(amax));
        const float sc = fmaxf(amax, 1e-20f) * (1.f / 119.f), qs = 1.f / sc;
        u32x4 hp, lp;
#pragma unroll
        for (int d = 0; d < 4; ++d) { unsigned hw = 0u, lw = 0u;
#pragma unroll
            for (int k = 0; k < 8; ++k) { const int q = (int)rintf(xv[8 * d + k] * qs); const int h = (q + 8) >> 4, l = q - 16 * h; hw |= (unsigned)(h & 15) << (4 * k); lw |= (unsigned)(l & 15) << (4 * k); }
            hp[d] = hw; lp[d] = lw; }
        *(GAS u32x4*)(x4 + ((size_t)t * 64 + F.lane) * 32) = hp; *(GAS u32x4*)(x4 + ((size_t)t * 64 + F.lane) * 32 + 16) = lp;
        if ((F.lane & 7) == 0) sx[(size_t)t * 8 + (F.lane >> 3)] = sc;
#pragma unroll
        for (int c = 0; c < 4; ++c) w[c] = wn[c];
    }
#undef XP_LOAD
}
__device__ __forceinline__ void step_upass(Frame& F, int layer, int G) {
    const int s = blockIdx.x & 7, wk = (blockIdx.x >> 3) * NWAVES + F.wave, nwk = (G >> 3) * NWAVES;
    const GAS unsigned char* UN = F.ws + O_TAB + (size_t)(layer * 2) * TAB_ONE + (size_t)s * NEXP * 128;
    const GAS int* IDX = (const GAS int*)(F.ws + O_IDX); const GAS unsigned char* x4 = F.ws + O_X4 + s * 256; const GAS float* sxp = (const GAS float*)(F.ws + O_SX) + s;
    GAS float* part = (GAS float*)(F.ws + O_PART) + (size_t)s * T * 128;
    unsigned lo = (unsigned)F.lane; asm volatile("" : "+v"(lo));
    const unsigned j = lo >> 3, p = lo & 7;
    const int tlast = wk + ((T - 1 - wk) / nwk) * nwk;
#define U_LOADID(ID, t_, q_) do { const int tt_ = (t_) <= tlast ? (t_) : tlast; _Pragma("unroll") for (int b = 0; b < 4; ++b) ID[b] = IDX[(size_t)tt_ * 128 + (q_) * 32 + 8 * b + j]; } while (0)
#define U_LOADX(t_) do { const int tt_ = (t_) <= tlast ? (t_) : tlast; xhn = *(const GAS u32x4*)(x4 + (size_t)tt_ * 2048 + p * 32); xln = *(const GAS u32x4*)(x4 + (size_t)tt_ * 2048 + p * 32 + 16); sxn = sxp[(size_t)tt_ * 8]; } while (0)
#define U_ISSUE(UB, ID) do { _Pragma("unroll") for (int b = 0; b < 4; ++b) UB[b] = *(const GAS u32x4*)(UN + (unsigned)(ID[b] * 128 + (int)p * 16)); } while (0)
#define U_QUARTER(UB, vout, q_) do { _Pragma("unroll") for (int b = 0; b < 4; ++b) { int ah = 0, al = 0; \
            ah = __builtin_amdgcn_sdot8((int)UB[b].x, (int)xh.x, ah, false); al = __builtin_amdgcn_sdot8((int)UB[b].x, (int)xl.x, al, false); \
            ah = __builtin_amdgcn_sdot8((int)UB[b].y, (int)xh.y, ah, false); al = __builtin_amdgcn_sdot8((int)UB[b].y, (int)xl.y, al, false); \
            ah = __builtin_amdgcn_sdot8((int)UB[b].z, (int)xh.z, ah, false); al = __builtin_amdgcn_sdot8((int)UB[b].z, (int)xl.z, al, false); \
            ah = __builtin_amdgcn_sdot8((int)UB[b].w, (int)xh.w, ah, false); al = __builtin_amdgcn_sdot8((int)UB[b].w, (int)xl.w, al, false); \
            const float d = sum8((float)(16 * ah + al)) * sxc; vout = (p == (unsigned)(4 * ((q_) & 1) + b)) ? d : vout; } } while (0)
    int idA[4], idB[4]; u32x4 u0[4], u1[4], u2[4], u3[4]; u32x4 xh, xl, xhn, xln; float sxc, sxn;
    U_LOADID(idA, wk, 0); U_LOADID(idB, wk, 1); U_LOADX(wk);
    U_ISSUE(u0, idA); U_LOADID(idA, wk, 2);
    U_ISSUE(u1, idB); U_LOADID(idB, wk, 3);
    U_ISSUE(u2, idA); U_LOADID(idA, wk + nwk, 0);
    xh = xhn; xl = xln; sxc = sxn;
    for (int t = wk; t < T; t += nwk) {
        float v0 = 0.f, v1 = 0.f;
        U_ISSUE(u3, idB); U_LOADID(idB, t + nwk, 1); U_LOADX(t + nwk);
        U_QUARTER(u0, v0, 0);
        U_ISSUE(u0, idA); U_LOADID(idA, t + nwk, 2);
        U_QUARTER(u1, v0, 1);
        U_ISSUE(u1, idB); U_LOADID(idB, t + nwk, 3);
        U_QUARTER(u2, v1, 2);
        U_ISSUE(u2, idA); U_LOADID(idA, t + 2 * nwk, 0);
        U_QUARTER(u3, v1, 3);
        part[(size_t)t * 128 + 8 * p + j] = v0; part[(size_t)t * 128 + 64 + 8 * p + j] = v1;
        xh = xhn; xl = xln; sxc = sxn;
    }
#undef U_LOADID
#undef U_LOADX
#undef U_ISSUE
#undef U_QUARTER
}
__device__ __forceinline__ void step_peer_reduce(Frame& F, int layer) {
    const GAS float* part = (const GAS float*)(F.ws + O_PART); const GAS float* GW = (const GAS float*)(F.ws + O_GW); const GAS int* IDX = (const GAS int*)(F.ws + O_IDX);
    const GAS float* rowss = (const GAS float*)(F.ws + O_ROWSS); GAS unsigned* PK = (GAS unsigned*)(F.ws + O_PK);
    const GAS unsigned char* SU = F.ws + O_TAB + (size_t)(layer * 2) * TAB_ONE + TAB_NIB; const GAS unsigned char* SV = SU + TAB_ONE;
    constexpr int NIT = T * 2;
    struct SA { int id; float gw, rs; float p[8]; }; struct SB { u32x4 su, sv; };
#define RA(X, it_) do { const int ii_ = (it_) < NIT ? (it_) : NIT - 1; const size_t i_ = (size_t)ii_ * 64 + F.lane; X.id = IDX[i_]; X.gw = GW[i_]; X.rs = rowss[(size_t)(ii_ >> 1) * 32 + (F.lane & 31)]; \
        _Pragma("unroll") for (int s = 0; s < 8; ++s) X.p[s] = part[(size_t)s * T * 128 + i_]; } while (0)
#define RB(Y, X) do { Y.su = *(const GAS u32x4*)(SU + (size_t)X.id * 16); Y.sv = *(const GAS u32x4*)(SV + (size_t)X.id * 16); } while (0)
#define RC(X, Y, it_) do { if ((it_) < NIT) { const size_t i_ = (size_t)(it_) * 64 + F.lane; const float r = rsqrtf(wave_sum(X.rs) * (0.5f / DM) + EPS); float d = 0.f; \
        _Pragma("unroll") for (int s = 0; s < 8; ++s) d += X.p[s] * (float)__builtin_bit_cast(_Float16, (unsigned short)(Y.su[s >> 1] >> (16 * (s & 1)))); \
        const float w = X.gw * gelu_tanh(d * r); \
        _Pragma("unroll") for (int s = 0; s < 8; ++s) { const _Float16 ws = (_Float16)(w * (float)__builtin_bit_cast(_Float16, (unsigned short)(Y.sv[s >> 1] >> (16 * (s & 1))))); \
            PK[(size_t)s * T * 128 + i_] = ((unsigned)X.id << 16) | (unsigned)__builtin_bit_cast(unsigned short, ws); } } } while (0)
    SA a0, a1, a2; SB b0, b1;
    RA(a0, F.gw); RA(a1, F.gw + F.ngw); RB(b0, a0);
    for (int it = F.gw; it < NIT; it += F.ngw) {
        RA(a2, it + 2 * F.ngw); RB(b1, a1);
        RC(a0, b0, it);
        a0 = a1; a1 = a2; b0 = b1;
    }
#undef RA
#undef RB
#undef RC
}
__device__ __forceinline__ void step_vpass(Frame& F, int layer, int G, bool dry) {
    const int s = blockIdx.x & 7, wk = (blockIdx.x >> 3) * NWAVES + F.wave, nwk = (G >> 3) * NWAVES;
    const GAS unsigned char* VN = F.ws + O_TAB + (size_t)(layer * 2 + 1) * TAB_ONE + (size_t)s * NEXP * 128;
    const GAS unsigned* PK = (const GAS unsigned*)(F.ws + O_PK) + (size_t)s * T * 128;
    GAS bf16_t* xs = (GAS bf16_t*)(F.ws + O_XS16); GAS float* rsp = (GAS float*)(F.ws + O_RSP);
    unsigned lo = (unsigned)F.lane; asm volatile("" : "+v"(lo));
    const unsigned j = lo >> 3, p = lo & 7;
    const int tlast = wk + ((T - 1 - wk) / nwk) * nwk;
#define V_LOADPK(PKV, t_, q_) do { const int tt_ = (t_) <= tlast ? (t_) : tlast; _Pragma("unroll") for (int b = 0; b < 4; ++b) PKV[b] = PK[(size_t)tt_ * 128 + (q_) * 32 + 8 * b + j]; } while (0)
#define V_ISSUE(VB, PKV) do { _Pragma("unroll") for (int b = 0; b < 4; ++b) VB[b] = *(const GAS u32x4*)(VN + ((PKV[b] >> 16) * 128u + p * 16u)); } while (0)
#define V_CVT4(W, base) do { c_[(base)] = F4(W, 0); c_[(base) + 1] = F4(W, 1); c_[(base) + 2] = F4(W, 2); c_[(base) + 3] = F4(W, 3); } while (0)
#define V_QUARTER(VB, PKV) do { _Pragma("unroll") for (int b = 0; b < 4; ++b) { const _Float16 wl = __builtin_bit_cast(_Float16, (unsigned short)(PKV[b] & 0xffffu)); const h2 wl2 = {wl, wl}; h2 c_[16]; \
            V_CVT4(VB[b].x, 0); V_CVT4(VB[b].y, 4); V_CVT4(VB[b].z, 8); V_CVT4(VB[b].w, 12); \
            __builtin_amdgcn_sched_barrier(0); \
            _Pragma("unroll") for (int k = 0; k < 16; ++k) oh[k] = wl2 * c_[k] + oh[k]; \
            __builtin_amdgcn_sched_barrier(0); } } while (0)
    unsigned pk0[4], pk1[4], pk2[4], pk3[4], pkn[4]; u32x4 v0[4], v1[4], v2[4], v3[4];
    V_LOADPK(pk0, wk, 0); V_LOADPK(pk1, wk, 1); V_LOADPK(pk2, wk, 2); V_LOADPK(pkn, wk, 3);
    V_ISSUE(v0, pk0); V_ISSUE(v1, pk1); V_ISSUE(v2, pk2);
    for (int t = wk; t < T; t += nwk) {
#pragma unroll
        for (int b = 0; b < 4; ++b) pk3[b] = pkn[b];
        V_ISSUE(v3, pk3); V_LOADPK(pkn, t + nwk, 0);
        GAS float* xr = F.out + (size_t)t * DM + s * 256 + p * 32 + j * 4; f32x4 x2 = *(const GAS f32x4*)xr;
        h2 oh[16];
#pragma unroll
        for (int i = 0; i < 16; ++i) oh[i] = (h2){(_Float16)0.f, (_Float16)0.f};
        V_QUARTER(v0, pk0);
#pragma unroll
        for (int b = 0; b < 4; ++b) pk0[b] = pkn[b];
        V_ISSUE(v0, pk0); V_LOADPK(pkn, t + nwk, 1);
        V_QUARTER(v1, pk1);
#pragma unroll
        for (int b = 0; b < 4; ++b) pk1[b] = pkn[b];
        V_ISSUE(v1, pk1); V_LOADPK(pkn, t + nwk, 2);
        V_QUARTER(v2, pk2);
#pragma unroll
        for (int b = 0; b < 4; ++b) pk2[b] = pkn[b];
        V_ISSUE(v2, pk2); V_LOADPK(pkn, t + nwk, 3);
        V_QUARTER(v3, pk3);
#pragma unroll
        for (int i = 0; i < 16; ++i) { unsigned u = __builtin_bit_cast(unsigned, oh[i]);
            h2 a = as_h2(u) + as_h2((unsigned)__builtin_amdgcn_update_dpp(0, (int)u, 0x128, 0xF, 0xF, true)); u = __builtin_bit_cast(unsigned, a);
            { auto r = __builtin_amdgcn_permlane16_swap(u, u, false, false); a = as_h2(r[0]) + as_h2(r[1]); u = __builtin_bit_cast(unsigned, a); }
            { auto r = __builtin_amdgcn_permlane32_swap(u, u, false, false); a = as_h2(r[0]) + as_h2(r[1]); }
            oh[i] = a; }
        h2 o0 = oh[0], o1 = oh[1];
#pragma unroll
        for (int c = 1; c < 8; ++c) { o0 = (j == (unsigned)c) ? oh[2 * c] : o0; o1 = (j == (unsigned)c) ? oh[2 * c + 1] : o1; }
        x2[0] += (float)o0.x; x2[1] += (float)o0.y; x2[2] += (float)o1.x; x2[3] += (float)o1.y;
        if (!dry) *(GAS f32x4*)xr = x2;
        if (layer == 0 && !dry) {
            { u32x2 o; o.x = cvtpk(x2[0], x2[1]); o.y = cvtpk(x2[2], x2[3]); *(GAS u32x2*)(xs + (size_t)t * DM + s * 256 + p * 32 + j * 4) = o; }
            const float sst = wave_sum((x2[0] * x2[0] + x2[1] * x2[1]) + (x2[2] * x2[2] + x2[3] * x2[3]));
            if (lo == 0) rsp[(size_t)t * 8 + s] = sst;
        }
    }
#undef V_LOADPK
#undef V_ISSUE
#undef V_CVT4
#undef V_QUARTER
}
#undef F4
#undef H2F
__device__ __forceinline__ void step_logf(Frame& F, LAS unsigned char* lds) {
    const GAS bf16_t* xs = (const GAS bf16_t*)(F.ws + O_XS16); const GAS float* rsp = (const GAS float*)(F.ws + O_RSP); GAS float* logf = (GAS float*)(F.ws + O_LOGF);
    const GAS float* wf = (const GAS float*)(F.ws + O_WF); LAS float* wl = (LAS float*)lds;
    for (int i = F.tid; i < NH * DM / 4; i += NTHREADS) *(LAS f32x4*)(wl + 4 * i) = *(const GAS f32x4*)(wf + 4 * i);
    __syncthreads();
    const int tlast = F.gw + ((T - 1 - F.gw) / F.ngw) * F.ngw;
    unsigned lo = (unsigned)F.lane; asm volatile("" : "+v"(lo));
#define LF_LOAD(W, Q, t_) do { const int tt_ = (t_) <= tlast ? (t_) : tlast; _Pragma("unroll") for (int c = 0; c < 8; ++c) W[c] = *(const GAS u32x2*)(xs + (size_t)tt_ * DM + c * 256 + lo * 4); Q = lo < 8 ? rsp[(size_t)tt_ * 8 + lo] : 0.f; } while (0)
    u32x2 w[8], wn[8]; float q, qn;
    LF_LOAD(w, q, F.gw);
    for (int t = F.gw; t < T; t += F.ngw) {
        LF_LOAD(wn, qn, t + F.ngw);
        asm volatile("" : "+v"(lo));
        const float r1 = rsqrtf(wave_sum(q) * (1.f / DM) + EPS);
        float mine = 0.f;
#pragma unroll 2
        for (int h = 0; h < NH; ++h) { float d = 0.f;
#pragma unroll
            for (int c = 0; c < 8; ++c) { const f32x4 g = *(const LAS f32x4*)(wl + h * DM + c * 256 + lo * 4);
                d += (bf_lo(w[c].x) * g[0] + bf_hi(w[c].x) * g[1]) + (bf_lo(w[c].y) * g[2] + bf_hi(w[c].y) * g[3]); }
            d = wave_sum(d); mine = (lo == (unsigned)h) ? d : mine; }
        if (lo < (unsigned)NH) { const float z = mine * r1 + F.in(I_SBF)[lo];
            logf[((size_t)(t / SEQ) * NH + lo) * SEQ + (t % SEQ)] = fminf(z, 0.f) - log1p_pos(fast_exp(-fabsf(z))); }
#pragma unroll
        for (int c = 0; c < 8; ++c) w[c] = wn[c];
        q = qn;
    }
#undef LF_LOAD
    __syncthreads();
}

#define XB_TMO      128
#define XB_XCNT(j)  (256  + 64 * (j))
#define XB_XSUB(j)  (1280 + 64 * (j))
#define XB_XGEN(j)  (2304 + 64 * (j))
#define XB_TOP      3328
#define XB_TOPGEN   3392
#define XCD_BAR_WORDS 3456
#define XB_SPIN_CAP (1u << 20)
__device__ __forceinline__ unsigned xb_ld(unsigned* p)              { return __hip_atomic_load(p, __ATOMIC_RELAXED, __HIP_MEMORY_SCOPE_AGENT); }
__device__ __forceinline__ unsigned xb_add(unsigned* p, unsigned v) { return __hip_atomic_fetch_add(p, v, __ATOMIC_RELAXED, __HIP_MEMORY_SCOPE_AGENT); }
__device__ __forceinline__ unsigned xb_xcc_id() { return (unsigned)__builtin_amdgcn_s_getreg((3 << 11) | 20) & 0xFu; }
#define XB_SPIN(cond, bar) do { unsigned _sp = 0; while (cond) { __builtin_amdgcn_s_sleep(1); \
    if ((++_sp & 255u) == 0u) { if (xb_ld(&(bar)[XB_TMO])) break; if (_sp > XB_SPIN_CAP) { atomicAdd(&(bar)[XB_TMO], 1u); break; } } } } while (0)
struct XcdBarrier { unsigned* bar; unsigned x; volatile LAS unsigned* st; };
__device__ __forceinline__ XcdBarrier xcd_barrier_post(unsigned* bar, volatile LAS unsigned* st) {
    XcdBarrier b; b.bar = bar; b.x = xb_xcc_id(); b.st = st;
    if (threadIdx.x == 0) (void)xb_add(&bar[XB_XCNT(b.x)], 1u);
    return b;
}
__device__ __forceinline__ void xcd_barrier_complete(unsigned* bar, unsigned x, unsigned& nloc, unsigned& nx) {
    const unsigned G = gridDim.x * gridDim.y * gridDim.z;
    unsigned sum, cnt, mine, sp = 0u;
    for (;;) {
        sum = 0u; cnt = 0u; mine = 0u;
#pragma unroll
        for (unsigned j = 0; j < 16; ++j) { const unsigned c = xb_ld(&bar[XB_XCNT(j)]); sum += c; cnt += (c > 0u) ? 1u : 0u; mine = (j == x) ? c : mine; }
        if (sum == G) break;
        __builtin_amdgcn_s_sleep(1);
        if ((++sp & 255u) == 0u) { if (xb_ld(&bar[XB_TMO])) break; if (sp > XB_SPIN_CAP) { atomicAdd(&bar[XB_TMO], 1u); break; } }
    }
    nloc = mine > 0u ? mine : 1u; nx = cnt > 0u ? cnt : 1u;
}
__device__ __forceinline__ void xcd_barrier(const XcdBarrier& b, int wave_s) {
    asm volatile("s_waitcnt vmcnt(0)" ::: "memory");
    __syncthreads();
    int ln_; asm volatile("v_mbcnt_lo_u32_b32 %0, -1, 0\n\tv_mbcnt_hi_u32_b32 %0, -1, %0" : "=v"(ln_));
    if (wave_s == 0 && ln_ == 0) {
        unsigned* bar = b.bar;
        __builtin_amdgcn_s_waitcnt(0);
        unsigned nloc = b.st[0], nx = b.st[1];
        if (nloc == 0u) { xcd_barrier_complete(bar, b.x, nloc, nx); b.st[0] = nloc; b.st[1] = nx; }
        const unsigned old = xb_add(&bar[XB_XSUB(b.x)], 1u);
        const unsigned gen = old / nloc;
        if (old + 1u == (gen + 1u) * nloc) {
            __builtin_amdgcn_fence(__ATOMIC_RELEASE, "agent");
            asm volatile("s_waitcnt vmcnt(0)" ::: "memory");
            const unsigned og = xb_add(&bar[XB_TOP], 1u);
            const unsigned tg = og / nx;
            if (og + 1u == (tg + 1u) * nx) xb_add(&bar[XB_TOPGEN], 1u);
            else XB_SPIN(xb_ld(&bar[XB_TOPGEN]) == tg, bar);
            __builtin_amdgcn_fence(__ATOMIC_ACQUIRE, "agent");
            xb_add(&bar[XB_XGEN(b.x)], 1u);
            asm volatile("s_waitcnt vmcnt(0)" ::: "memory");
        } else {
            XB_SPIN(xb_ld(&bar[XB_XGEN(b.x)]) == gen, bar);
            __builtin_amdgcn_fence(__ATOMIC_ACQUIRE, "agent");
            asm volatile("s_waitcnt vmcnt(0)" ::: "memory");
        }
    }
    __syncthreads();
}

constexpr int CONV1_SPLIT = 2 * 4608;
constexpr int BAR_LDS_OFF = 147456 - 64;
constexpr int LDS_BYTES = 147456;
enum { ST_PROLOGUE = 0, ST_G_IN0, ST_G_MKV0, ST_G_MKV1, ST_CONV, ST_G_GATE, ST_A_MEM0, ST_SCAN1, ST_SCAN2, ST_G_OUT0, ST_G_PQ0, ST_TOPK0, ST_UPASS0, ST_PRED0, ST_VPASS0,
       ST_G_L1, ST_CPREFIX, ST_A_FOX, ST_A_MEM1, ST_G_OUT1, ST_G_PQ1, ST_TOPK1, ST_UPASS1, ST_PRED1, ST_VPASS1, N_STEPS };
constexpr unsigned SYNC_AFTER = (1u << ST_PROLOGUE) | (1u << ST_G_MKV1) | (1u << ST_CONV) | (1u << ST_A_MEM0) | (1u << ST_SCAN1) | (1u << ST_SCAN2) | (1u << ST_G_OUT0) | (1u << ST_G_PQ0) |
                                (1u << ST_TOPK0) | (1u << ST_UPASS0) | (1u << ST_PRED0) | (1u << ST_VPASS0) | (1u << ST_G_L1) | (1u << ST_CPREFIX) | (1u << ST_A_MEM1) | (1u << ST_G_OUT1) | (1u << ST_G_PQ1) | (1u << ST_TOPK1) | (1u << ST_UPASS1) | (1u << ST_PRED1);
constexpr unsigned GEMM_STEPS = (1u << ST_G_IN0) | (1u << ST_G_MKV0) | (1u << ST_G_MKV1) | (1u << ST_G_GATE) | (1u << ST_G_OUT0) | (1u << ST_G_PQ0) | (1u << ST_G_L1) | (1u << ST_G_OUT1) | (1u << ST_G_PQ1);
constexpr unsigned ATTN_STEPS = (1u << ST_A_MEM0) | (1u << ST_A_FOX) | (1u << ST_A_MEM1);

struct Args { const float* in[N_IN]; float* out; unsigned char* ws; int lo, hi; };

__global__ void __launch_bounds__(NTHREADS, 2) yoco_fwd(Args args) {
    extern __shared__ __attribute__((aligned(16))) unsigned char lds[];
    volatile LAS unsigned* bst = (volatile LAS unsigned*)((LAS unsigned char*)lds + BAR_LDS_OFF);
    if (threadIdx.x == 0) { bst[0] = 0u; bst[1] = 0u; }
    __syncthreads();
    const XcdBarrier gbar = xcd_barrier_post((unsigned*)(args.ws + O_CTL), bst);
    const int G = gridDim.x;
    const int wave_s = __builtin_amdgcn_readfirstlane(threadIdx.x >> 6);
#ifndef DUP_MASK
#define DUP_MASK 0u
#endif
    for (int st = args.lo; st < args.hi; ++st) {
      const int nrep = ((DUP_MASK >> st) & 1u) ? 2 : 1;
      for (int rep = 0; rep < nrep; ++rep) {
        unsigned char* ws0 = args.ws; asm volatile("" : "+s"(ws0));
        GAS unsigned char* ws = (GAS unsigned char*)ws0;
#define LANE_ID(v) asm volatile("v_mbcnt_lo_u32_b32 %0, -1, 0\n\tv_mbcnt_hi_u32_b32 %0, -1, %0" : "=v"(v))
#define MAKE_TID(v) do { LANE_ID(v); v += wave_s * 64; } while (0)
#define MAKE_FRAME(F) Frame F; F.ws = ws; F.in_ = args.in; F.out = (GAS float*)args.out; { int t0_; MAKE_TID(t0_); F.tid = t0_; } F.lane = F.tid & 63; F.wave = wave_s; \
        F.gw = blockIdx.x * NWAVES + F.wave; F.ngw = gridDim.x * NWAVES; F.gtid = blockIdx.x * NTHREADS + F.tid; F.ngt = gridDim.x * NTHREADS
        if (st == ST_G_L1) { MAKE_FRAME(F); step_logf(F, (LAS unsigned char*)lds); }
        if ((GEMM_STEPS >> st) & 1u) {
            pg8::Gemm g; Epi E; E.ws = ws; E.resid = nullptr; E.outf = nullptr; E.o16 = nullptr; E.ssq = nullptr; E.gate_b = nullptr; int shift = 0;
            switch (st) {
            case ST_G_IN0:  g = {(const GAS bf16_t*)(ws + O_XS16), (const GAS bf16_t*)(ws + O_WIN0), T, NIN0, DM, DM, DM, 0}; E.mode = EM_IN0; break;
            case ST_G_MKV0: g = {(const GAS bf16_t*)(ws + O_MEMN), (const GAS bf16_t*)(ws + O_WMKV), NMROW, 1024, DM, DM, DM, 0}; E.mode = EM_MKV; E.o16 = (GAS bf16_t*)(ws + O_MKV); E.ssq = (GAS float*)(ws + O_MKSS); shift = 128; break;
            case ST_G_MKV1: g = {(const GAS bf16_t*)(ws + O_MEMN) + (size_t)NMROW * DM, (const GAS bf16_t*)(ws + O_WMKV) + (size_t)1024 * DM, NMROW, 1024, DM, DM, DM, 0}; E.mode = EM_MKV;
                            E.o16 = (GAS bf16_t*)(ws + O_MKV) + (size_t)NMROW * NL1; E.ssq = (GAS float*)(ws + O_MKSS) + NMROW * 112; shift = 144; break;
            case ST_G_GATE: g = {(const GAS bf16_t*)(ws + O_XC), (const GAS bf16_t*)(ws + O_WGATE), T, 12 * 256, 128, LRU, 128, 128}; E.mode = EM_GATE; E.gate_b = (const GAS float*)args.in[I_AGATEB]; break;
            case ST_G_OUT0: g = {(const GAS bf16_t*)(ws + O_CAT), (const GAS bf16_t*)(ws + O_WOUT0), T, DM, DM, DM, DM, 0}; E.mode = EM_RES; E.resid = (const GAS float*)args.in[I_X]; E.outf = (GAS float*)args.out; break;
            case ST_G_PQ0:  g = {(const GAS bf16_t*)(ws + O_XS16), (const GAS bf16_t*)(ws + O_WQ0), T, DM, DM, DM, DM, 0}; E.mode = EM_PQ; E.o16 = (GAS bf16_t*)(ws + O_Q16); break;
            case ST_G_L1:   g = {(const GAS bf16_t*)(ws + O_XS16), (const GAS bf16_t*)(ws + O_WL1), T, NL1, DM, DM, DM, 0}; E.mode = EM_L1; break;
            case ST_G_OUT1: g = {(const GAS bf16_t*)(ws + O_CAT), (const GAS bf16_t*)(ws + O_WOUT1), T, DM, DM, DM, DM, 0}; E.mode = EM_RES; E.resid = (const GAS float*)args.out; E.outf = (GAS float*)args.out; break;
            default:        g = {(const GAS bf16_t*)(ws + O_XS16), (const GAS bf16_t*)(ws + O_WQ1), T, DM, DM, DM, DM, 0}; E.mode = EM_PQ; E.o16 = (GAS bf16_t*)(ws + O_Q16); break;
            }
            pg8::StaticOrder S; S.init(g.M, g.N, G, (int)((blockIdx.x + G - shift) % G));
#ifndef DIS_GEMM
            { int tg_; MAKE_TID(tg_);
              pg8::gemm_phase<Epi, false>((LAS unsigned char*)lds, g, S, E, tg_); }
#endif
            if (st == ST_G_MKV1 && blockIdx.x >= 160) { MAKE_FRAME(F); convert_tables(F, 1, 0, CONV1_SPLIT, (blockIdx.x - 160) * NWAVES + F.wave, (G - 160) * NWAVES); }
        } else if ((ATTN_STEPS >> st) & 1u) {
            const int nun = st == ST_A_FOX ? 3 : 1;
            for (int ui = 0; ui < nun; ++ui) {
                att::BlockRef r;
                if (st == ST_A_FOX) {
                    const int i = blockIdx.x, x = i & 15, bh = (i >> 4) + 16 * ui, qb = ui == 0 ? x : (ui == 1 ? 15 - x : ((x * 5 + 3) & 15));
                    const int b = bh / NH, h = bh % NH; const size_t row0 = (size_t)b * SEQ + qb * 256;
                    const GAS bf16_t* z = (const GAS bf16_t*)(ws + O_ZL1);
                    r.Q = z + row0 * NL1 + 3072 + h * 128; r.K = z + (size_t)b * SEQ * NL1 + h * 128; r.V = z + (size_t)b * SEQ * NL1 + 1536 + h * 128;
                    r.O = (GAS bf16_t*)(ws + O_CAT) + row0 * DM + h * 128;
                    const GAS float* ss = (const GAS float*)(ws + O_SSL1);
                    r.qss = ss + row0 * 112 + (12 + h) * 4; r.kss = ss + (size_t)b * SEQ * 112 + h * 4; r.cc = (const GAS float*)(ws + O_CC) + (size_t)bh * SEQ; r.gg = (const GAS float*)(ws + O_GG) + 384;
                    r.P0 = qb * 256; r.skv = SEQ;
                } else {
                    const int l = st == ST_A_MEM0 ? 0 : 1; const int i = blockIdx.x, qblk = i >> 2, h = i & 3, b = qblk >> 4; const size_t row0 = (size_t)qblk * 256;
                    r.Q = (const GAS bf16_t*)(ws + O_ZL1) + row0 * NL1 + 4608 + h * 128; r.qss = (const GAS float*)(ws + O_SSL1) + row0 * 112 + (24 + h) * 4;
                    const GAS bf16_t* kv = (const GAS bf16_t*)(ws + O_MKV) + ((size_t)l * NMROW + b * NMEM) * NL1;
                    r.K = kv + h * 128; r.V = kv + 512 + h * 128; r.kss = (const GAS float*)(ws + O_MKSS) + ((size_t)l * NMROW + b * NMEM) * 112 + h * 4;
                    r.O = (GAS bf16_t*)(ws + O_CAT) + row0 * DM + LRU + h * 128; r.cc = nullptr; r.gg = (const GAS float*)(ws + O_GG) + 128 * (1 + l);
                    r.P0 = SEQ; r.skv = NMEM;
                }
                att::Seam S;
                int tid_u; MAKE_TID(tid_u);
#ifndef DIS_ATTN
                att::attn_prime(r, (char*)lds, S, tid_u);
                att::attn_block(r, (char*)lds, S, tid_u);
#endif
            }
        } else {
            MAKE_FRAME(F);
            switch (st) {
#ifndef DIS_MISC
            case ST_PROLOGUE: step_prologue(F, (LAS unsigned char*)lds); break;
            case ST_CONV: step_conv(F); break;
            case ST_SCAN1: step_scan1(F); break;
            case ST_SCAN2: step_scan2(F); break;
#endif
#ifndef DIS_TOPK
            case ST_TOPK0: step_topk(F, (LAS unsigned char*)lds, 0); step_xplanes(F); break;
            case ST_TOPK1: step_topk(F, (LAS unsigned char*)lds, 1); step_xplanes(F); break;
#endif
#ifndef DIS_GATHER
            case ST_UPASS0: step_upass(F, 0, G); break;
            case ST_UPASS1: step_upass(F, 1, G); break;
            case ST_PRED0: step_peer_reduce(F, 0); break;
            case ST_PRED1: step_peer_reduce(F, 1); break;
            case ST_VPASS0: step_vpass(F, 0, G, rep + 1 < nrep); break;
            case ST_VPASS1: step_vpass(F, 1, G, rep + 1 < nrep); break;
#endif
#ifndef DIS_MISC
            case ST_CPREFIX: step_cprefix(F, (LAS unsigned char*)lds); convert_tables(F, 1, G > 160 ? CONV1_SPLIT : 0, 2 * NEXP, F.gw, F.ngw); break;
#endif
            default: break;
            }
        }
        if (rep + 1 < nrep) xcd_barrier(gbar, wave_s);
      }
        if (((SYNC_AFTER >> st) & 1u) && st + 1 < args.hi) xcd_barrier(gbar, wave_s);
    }
}

#ifndef N_LAUNCH_MODE
#define N_LAUNCH_MODE 1
#endif
extern "C" void kernel_launch(void* const* d_in, const int* in_sizes, int n_in, void* d_out, int out_size, void* d_ws, size_t ws_size, hipStream_t stream) {
    static int grid = 0;
    if (grid == 0) {
        if (n_in != N_IN || in_sizes[0] != T * DM || out_size != T * DM || ws_size < WS_END) {
            fprintf(stderr, "kernel_launch: unexpected shapes (n_in %d, in0 %d, out %d, ws %zu, need %zu)\n", n_in, n_in > 0 ? in_sizes[0] : -1, out_size, ws_size, (size_t)WS_END); grid = -1; return; }
        int dev = 0, cus = 0, per_cu = 0;
        hipGetDevice(&dev); hipDeviceGetAttribute(&cus, hipDeviceAttributeMultiprocessorCount, dev);
        hipFuncSetAttribute((const void*)yoco_fwd, hipFuncAttributeMaxDynamicSharedMemorySize, LDS_BYTES);
        hipOccupancyMaxActiveBlocksPerMultiprocessor(&per_cu, (const void*)yoco_fwd, NTHREADS, LDS_BYTES);
        if (per_cu < 1) { fprintf(stderr, "kernel_launch: occupancy query says %d blocks per CU\n", per_cu); grid = -1; return; }
        grid = cus - cus % 8;
        (void)hipGetLastError();
    }
    if (grid < 0) return;
    Args a{};
    for (int i = 0; i < N_IN; ++i) a.in[i] = (const float*)d_in[i];
    a.out = (float*)d_out; a.ws = (unsigned char*)d_ws;
    if (hipMemsetAsync((char*)d_ws + O_CTL, 0, 65536, stream) != hipSuccess) { fprintf(stderr, "kernel_launch: memset of the barrier words failed\n"); return; }
    if (N_LAUNCH_MODE == 1) {
        a.lo = 0; a.hi = N_STEPS;
        hipLaunchKernelGGL(yoco_fwd, dim3(grid), dim3(NTHREADS), LDS_BYTES, stream, a);
        hipError_t e = hipPeekAtLastError();
        if (e != hipSuccess) fprintf(stderr, "launch failed: %s (grid %d)\n", hipGetErrorString(e), grid);
    } else {
        int lo = 0;
        for (int s = 0; s < N_STEPS; ++s) {
            if (((SYNC_AFTER >> s) & 1u) || s == N_STEPS - 1) {
                a.lo = lo; a.hi = s + 1; lo = s + 1;
                void* params[] = {&a};
                hipError_t e = hipLaunchCooperativeKernel((const void*)yoco_fwd, dim3(grid), dim3(NTHREADS), params, LDS_BYTES, stream);
                if (e != hipSuccess) { fprintf(stderr, "launch failed: %s\n", hipGetErrorString(e)); break; }
            }
        }
    }
}
```

```cpp
#include <hip/hip_runtime.h>
#include <hip/hip_cooperative_groups.h>
#include <cstdio>
#include <cstdint>
namespace cg = cooperative_groups;

#define LAS __attribute__((address_space(3)))
#define GAS __attribute__((address_space(1)))
typedef unsigned short bf16_t;
typedef short bf16x8 __attribute__((ext_vector_type(8)));
typedef short s16x4 __attribute__((ext_vector_type(4)));
typedef float f32x4 __attribute__((ext_vector_type(4)));
typedef float f32x2 __attribute__((ext_vector_type(2)));
typedef float f32x16 __attribute__((ext_vector_type(16)));
typedef unsigned u32x4 __attribute__((ext_vector_type(4)));
typedef unsigned u32x2 __attribute__((ext_vector_type(2)));
typedef _Float16 h2 __attribute__((ext_vector_type(2)));

constexpr int NB = 4, SEQ = 4096, T = NB * SEQ, DM = 2048, LRU = 1536, MEMW = 512, NMEM = 256, NH = 12, HD = 128;
constexpr int NIN0 = 3584, NL1 = 5120, NEXP = 16384, NMROW = NB * NMEM;
constexpr float EPS = 1e-6f;
constexpr int NTHREADS = 512, NWAVES = 8;

constexpr size_t MiB = 1u << 20;
constexpr size_t O_CTL = 0;
constexpr size_t O_WIN0 = 1 * MiB;
constexpr size_t O_WOUT0 = O_WIN0 + 14 * MiB;
constexpr size_t O_WL1 = O_WOUT0 + 8 * MiB;
constexpr size_t O_WOUT1 = O_WL1 + 20 * MiB;
constexpr size_t O_WQ0 = O_WOUT1 + 8 * MiB;
constexpr size_t O_WQ1 = O_WQ0 + 8 * MiB;
constexpr size_t O_WMKV = O_WQ1 + 8 * MiB;
constexpr size_t O_WGATE = O_WMKV + 8 * MiB;
constexpr size_t O_SUBK = O_WGATE + 1 * MiB;
constexpr size_t O_WF = O_SUBK + 1 * MiB;
constexpr size_t O_SMALL = O_WF + 1 * MiB;
constexpr size_t O_RS1 = O_SMALL;
constexpr size_t O_LOGF = O_SMALL + 64 * 1024;
constexpr size_t O_CC = O_LOGF + 768 * 1024;
constexpr size_t O_GG = O_CC + 768 * 1024;
constexpr size_t O_SPL = O_GG + 4096;
constexpr size_t O_TSC = O_SPL + 8192;
constexpr size_t O_ROWSS = O_SMALL + 2 * MiB;
constexpr size_t O_RSP = O_ROWSS + 2 * MiB;
constexpr size_t O_QMSS = O_RSP;
constexpr size_t O_MKSS = O_QMSS + 1 * MiB;
constexpr size_t O_SSL1 = O_MKSS + 1 * MiB;
constexpr size_t O_CARRY = O_SSL1 + 7 * MiB;
constexpr size_t O_MEMN = O_CARRY + 3 * MiB;
constexpr size_t O_MKV = O_MEMN + 8 * MiB;
constexpr size_t O_IDX = O_MKV + 20 * MiB;
constexpr size_t O_GW = O_IDX + 8 * MiB;
constexpr size_t O_TAB = O_GW + 8 * MiB;
constexpr size_t TAB_NIB = (size_t)8 * 16384 * 128, TAB_ONE = TAB_NIB + (size_t)16384 * 16 + 786432;
constexpr size_t O_XS16 = O_TAB + 128 * MiB;
constexpr size_t O_CAT = O_XS16 + 64 * MiB;
constexpr size_t O_ZX = O_CAT + 64 * MiB;
constexpr size_t O_X8 = O_ZX;
constexpr size_t O_GY = O_ZX + 48 * MiB;
constexpr size_t O_LOGFP = O_GY + 48 * MiB;
constexpr size_t O_QM = O_LOGFP;
constexpr size_t O_XC = O_QM + 16 * MiB;
constexpr size_t O_X4 = O_XC;
constexpr size_t O_SX = O_XC + 32 * MiB;
constexpr size_t O_AA = O_XC + 48 * MiB;
constexpr size_t O_PART = O_AA;
constexpr size_t O_UU = O_AA + 96 * MiB;
constexpr size_t O_PK = O_UU;
constexpr size_t O_Q16 = O_UU + 96 * MiB;
constexpr size_t O_ZL1 = O_Q16 + 64 * MiB;
constexpr size_t WS_END = O_ZL1 + 160 * MiB;
static_assert(WS_END <= 1024 * MiB, "workspace map");

__device__ __forceinline__ unsigned cvtpk(float lo, float hi) { unsigned r; asm volatile("v_cvt_pk_bf16_f32 %0, %1, %2" : "=v"(r) : "v"(lo), "v"(hi)); return r; }
__device__ __forceinline__ float bf_lo(unsigned w) { return __uint_as_float(w << 16); }
__device__ __forceinline__ float bf_hi(unsigned w) { return __uint_as_float(w & 0xffff0000u); }
__device__ __forceinline__ float fast_exp(float x) { return __builtin_amdgcn_exp2f(x * 1.4426950408889634f); }
__device__ __forceinline__ float log1p_pos(float y) { const float ser = y * (1.f - y * (0.5f - y * (0.33333334f - 0.25f * y))); const float lg = __builtin_amdgcn_logf(1.f + y) * 0.6931471805599453f; return y < 0.03f ? ser : lg; }
__device__ __forceinline__ float one_minus_exp(float x) { const float ser = -x * (1.f + x * (0.5f + x * (0.16666667f + x * 0.041666668f))); const float big = 1.f - fast_exp(x); return x > -0.03f ? ser : big; }
__device__ __forceinline__ float sigmoidf_(float x) { return __builtin_amdgcn_rcpf(1.f + fast_exp(-x)); }
__device__ __forceinline__ float gelu_tanh(float x) { const float u = x * (1.f + 0.044715f * x * x); return x * __builtin_amdgcn_rcpf(1.f + __builtin_amdgcn_exp2f(u * (-2.f * 0.7978845608028654f * 1.4426950408889634f))); }
template <int CTRL> __device__ __forceinline__ float dppf(float v) { return __int_as_float(__builtin_amdgcn_update_dpp(0, __float_as_int(v), CTRL, 0xF, 0xF, true)); }
__device__ __forceinline__ float xsum16(float v) { auto r = __builtin_amdgcn_permlane16_swap(__float_as_uint(v), __float_as_uint(v), false, false); return __uint_as_float(r[0]) + __uint_as_float(r[1]); }
__device__ __forceinline__ float xsum32(float v) { auto r = __builtin_amdgcn_permlane32_swap(__float_as_uint(v), __float_as_uint(v), false, false); return __uint_as_float(r[0]) + __uint_as_float(r[1]); }
__device__ __forceinline__ float xmax16(float v) { auto r = __builtin_amdgcn_permlane16_swap(__float_as_uint(v), __float_as_uint(v), false, false); return fmaxf(__uint_as_float(r[0]), __uint_as_float(r[1])); }
__device__ __forceinline__ float xmax32(float v) { auto r = __builtin_amdgcn_permlane32_swap(__float_as_uint(v), __float_as_uint(v), false, false); return fmaxf(__uint_as_float(r[0]), __uint_as_float(r[1])); }
__device__ __forceinline__ float wave_sum(float v) {
    v += dppf<0xB1>(v); v += dppf<0x4E>(v); v += dppf<0x141>(v); v += dppf<0x140>(v);
    v = xsum16(v); v = xsum32(v); return v;
}
__device__ __forceinline__ float wave_max(float v) {
    v = fmaxf(v, dppf<0xB1>(v)); v = fmaxf(v, dppf<0x4E>(v)); v = fmaxf(v, dppf<0x141>(v)); v = fmaxf(v, dppf<0x140>(v));
    v = xmax16(v); v = xmax32(v); return v;
}

namespace pg8 {
constexpr int BM = 256, BK = 64, HALF = 128, HTB = HALF * BK * 2, STAGE_BYTES = 8 * HTB, NXCD = 8, WGM = 8;
__host__ __device__ __forceinline__ int lds_byte(int r, int c) { const int st = (r >> 4) * 2 + (c >> 5), rr = r & 15, cc = c & 31, ob = rr * 64 + cc * 2; return st * 1024 + (ob ^ (((ob >> 9) & 1) << 5)); }
__host__ __device__ __forceinline__ void stage_rc(int b, int& R, int& C) { const int st = b / 1024, sb = b % 1024, swz = sb ^ (((sb >> 9) & 1) << 5); R = (st >> 1) * 16 + swz / 64; C = (st & 1) * 32 + (swz % 64) / 2; }
__host__ __device__ __forceinline__ int perm32(int rho) { const int n = rho >> 4, i = rho & 15; return 8 * (i >> 2) + 4 * n + (i & 3); }

struct Unit { int pm, pn; };
struct Gemm { const GAS bf16_t* A; const GAS bf16_t* Bt; int M, N, K, lda, ldb, acol; };

struct StaticOrder {
    int nM, nN, nwg, G, c;
    __device__ void init(int M, int N, int G_, int c_) { nM = M / BM; nN = N / BM; nwg = nM * nN; G = G_; c = c_; }
    __device__ bool next(int i, Unit& u) const {
        const long L = (long)i * G + c; if (L >= nwg) return false;
        int wgid = (int)L; { const int q = nwg / NXCD, r = nwg % NXCD, xcd = wgid % NXCD, off = wgid / NXCD; wgid = (xcd < r ? xcd * (q + 1) : r * (q + 1) + (xcd - r) * q) + off; }
        const int nig = WGM * nN, gid = wgid / nig, fm = gid * WGM, gsz = (nM - fm) < WGM ? (nM - fm) : WGM;
        u.pm = fm + ((wgid % nig) % gsz); u.pn = (wgid % nig) / gsz; return true;
    }
};

typedef int v8i_t __attribute__((ext_vector_type(8)));
typedef int v4i_t __attribute__((ext_vector_type(4)));
template <class Epi, bool FP8>
__device__ __forceinline__ void gemm_phase(LAS unsigned char* lds, const Gemm g, const StaticOrder& S, const Epi& E, const int tid) {
    const int wid = __builtin_amdgcn_readfirstlane(tid >> 6), lane = tid & 63, wr = wid >> 2, wc = wid & 3, fr = lane & 15, fq = lane >> 4;
    const int K = g.K, nt = K / BK;
    unsigned voffA[2], voffB[2];
#pragma unroll
    for (int i = 0; i < 2; ++i) { int R, C; stage_rc(tid * 16 + i * 8192, R, C); const int Rb = (R & ~31) + perm32(R & 31);
        voffA[i] = (unsigned)(R * g.lda + C) * 2u; voffB[i] = (unsigned)(Rb * g.ldb + C) * 2u; }
    const size_t kstep = (size_t)(BK * 2);
    const size_t hstepA = (size_t)HALF * g.lda * 2, hstepB = (size_t)HALF * g.ldb * 2;
    const size_t tstepA = 2 * hstepA, tstepB = 2 * hstepB;
    const unsigned ldsw = (unsigned)wid * 1024u;
    const int aoff = lds_byte(wr * 64 + fr, fq * 8), boff = lds_byte(wc * 32 + fr, fq * 8);
#define PG8_SA(b, h) (((b) * 2 + (h)) * HTB)
#define PG8_SB(b, h) ((4 + (b) * 2 + (h)) * HTB)
#define PG8_STAGE(bufoff, gbase, voff) do { _Pragma("unroll") for (int _i = 0; _i < 2; ++_i) \
        __builtin_amdgcn_global_load_lds((const GAS unsigned*)((gbase) + (voff)[_i]), (LAS unsigned*)(lds + (bufoff) + ldsw + _i * 8192), 16, 0, 0); } while (0)
#define PG8_LD2(dst, off_) do { const u32x4 lo_ = *(const LAS u32x4*)(lds + (off_)), hi_ = *(const LAS u32x4*)(lds + (off_) + 1024); \
        dst = (v8i_t){(int)lo_.x, (int)lo_.y, (int)lo_.z, (int)lo_.w, (int)hi_.x, (int)hi_.y, (int)hi_.z, (int)hi_.w}; } while (0)
#define PG8_LDA(dst, b, h) do { _Pragma("unroll") for (int m = 0; m < 4; ++m) PG8_LD2(dst[m], PG8_SA(b, h) + aoff + m * 2048); } while (0)
#define PG8_LDB(dst, b, h) do { _Pragma("unroll") for (int n = 0; n < 2; ++n) PG8_LD2(dst[n], PG8_SB(b, h) + boff + n * 2048); } while (0)
#define PG8_HALF(v, k) ((k) ? __builtin_shufflevector(v, v, 4, 5, 6, 7) : __builtin_shufflevector(v, v, 0, 1, 2, 3))
#define PG8_MMA(ai, bj, At, Bt) do { __builtin_amdgcn_s_setprio(1); _Pragma("unroll") for (int m = 0; m < 4; ++m) _Pragma("unroll") for (int n = 0; n < 2; ++n) { \
        if constexpr (FP8) asm volatile("v_mfma_scale_f32_16x16x128_f8f6f4 %0, %1, %2, %0, %3, %4 op_sel_hi:[0,0,0]" : "+v"(acc[ai][bj][m][n]) : "v"(Bt[n]), "v"(At[m]), "v"(sc_w), "v"(sc_x));     \
        else { _Pragma("unroll") for (int k = 0; k < 2; ++k) { const v4i_t bh_ = PG8_HALF(Bt[n], k), ah_ = PG8_HALF(At[m], k); \
                acc[ai][bj][m][n] = __builtin_amdgcn_mfma_f32_16x16x32_bf16(__builtin_bit_cast(bf16x8, bh_), __builtin_bit_cast(bf16x8, ah_), acc[ai][bj][m][n], 0, 0, 0); } } } \
        __builtin_amdgcn_s_setprio(0); } while (0)
#define PG8_WAIT_V(n) asm volatile("s_waitcnt vmcnt(" #n ")" ::: "memory")
#define PG8_WAIT_L(n) asm volatile("s_waitcnt lgkmcnt(" #n ")" ::: "memory")
#define PG8_BAR __builtin_amdgcn_s_barrier()
#define PG8_SCHED __builtin_amdgcn_sched_barrier(0)
    Unit cur, nxt; int ui = 0;
    if (!S.next(0, cur)) return;
    f32x4 acc[2][2][4][2];
#pragma unroll
    for (int a = 0; a < 2; ++a)
#pragma unroll
        for (int b = 0; b < 2; ++b)
#pragma unroll
            for (int m = 0; m < 4; ++m)
#pragma unroll
                for (int n = 0; n < 2; ++n) acc[a][b][m][n] = (f32x4){0.f, 0.f, 0.f, 0.f};
    v8i_t At[4], B0[2], B1[2];
    const int sc_w = 121, sc_x = 127;
    const GAS char* cA = (const GAS char*)g.A + (size_t)cur.pm * tstepA + (size_t)cur.pn * g.acol * 2; const GAS char* cB = (const GAS char*)g.Bt + (size_t)cur.pn * tstepB;
    PG8_STAGE(PG8_SB(0, 0), cB, voffB); PG8_STAGE(PG8_SB(0, 1), cB + hstepB, voffB); PG8_STAGE(PG8_SA(0, 0), cA, voffA); PG8_STAGE(PG8_SA(0, 1), cA + hstepA, voffA);
    if (wr == 1) PG8_BAR;
    PG8_WAIT_V(2); PG8_BAR;
    PG8_STAGE(PG8_SB(1, 0), cB + kstep, voffB); PG8_STAGE(PG8_SA(1, 0), cA + kstep, voffA); PG8_STAGE(PG8_SB(1, 1), cB + hstepB + kstep, voffB);
    PG8_WAIT_V(6); PG8_BAR;
    for (;;) {
        const bool has_next = S.next(ui + 1, nxt);
        const GAS char* nA = has_next ? (const GAS char*)g.A + (size_t)nxt.pm * tstepA + (size_t)nxt.pn * g.acol * 2 : cA; const GAS char* nB = has_next ? (const GAS char*)g.Bt + (size_t)nxt.pn * tstepB : cB;
        for (int t = 0; t < nt; t += 2) {
            const bool last = (t == nt - 2);
            const GAS char* a1 = cA + (size_t)(t + 1) * kstep;
            const GAS char* a2 = last ? nA : cA + (size_t)(t + 2) * kstep; const GAS char* b2 = last ? nB : cB + (size_t)(t + 2) * kstep;
            const GAS char* a3 = a2 + kstep; const GAS char* b3 = b2 + kstep;
            PG8_LDB(B0, 0, 0); PG8_LDB(B1, 0, 1); PG8_SCHED; PG8_LDA(At, 0, 0); PG8_STAGE(PG8_SA(1, 1), a1 + hstepA, voffA);
            PG8_WAIT_V(8); PG8_WAIT_L(0); PG8_BAR; PG8_MMA(0, 0, At, B0); PG8_MMA(0, 1, At, B1); PG8_BAR; PG8_SCHED;
            PG8_LDA(At, 0, 1); PG8_STAGE(PG8_SB(0, 0), b2, voffB); PG8_STAGE(PG8_SB(0, 1), b2 + hstepB, voffB); PG8_STAGE(PG8_SA(0, 0), a2, voffA);
            PG8_WAIT_V(8); PG8_WAIT_L(0); PG8_BAR; PG8_MMA(1, 0, At, B0); PG8_MMA(1, 1, At, B1); PG8_BAR; PG8_SCHED;
            PG8_LDB(B0, 1, 0); PG8_LDB(B1, 1, 1); PG8_SCHED; PG8_LDA(At, 1, 0); PG8_STAGE(PG8_SA(0, 1), a2 + hstepA, voffA);
            PG8_WAIT_V(8); PG8_WAIT_L(0); PG8_BAR; PG8_MMA(0, 0, At, B0); PG8_MMA(0, 1, At, B1); PG8_BAR; PG8_SCHED;
            PG8_LDA(At, 1, 1); PG8_STAGE(PG8_SB(1, 0), b3, voffB); PG8_STAGE(PG8_SB(1, 1), b3 + hstepB, voffB); PG8_STAGE(PG8_SA(1, 0), a3, voffA);
            PG8_WAIT_V(8); PG8_WAIT_L(0); PG8_BAR; PG8_MMA(1, 0, At, B0); PG8_MMA(1, 1, At, B1); PG8_BAR; PG8_SCHED;
        }
        if (wr == 0) PG8_BAR;
        { int ln_; asm volatile("v_mbcnt_lo_u32_b32 %0, -1, 0\n\tv_mbcnt_hi_u32_b32 %0, -1, %0" : "=v"(ln_));
          E(acc, cur, wr, wc, ln_ & 15, ln_ >> 4); }
        if (!has_next) break;
#pragma unroll
        for (int a = 0; a < 2; ++a)
#pragma unroll
            for (int b = 0; b < 2; ++b)
#pragma unroll
                for (int m = 0; m < 4; ++m)
#pragma unroll
                    for (int n = 0; n < 2; ++n) acc[a][b][m][n] = (f32x4){0.f, 0.f, 0.f, 0.f};
        cur = nxt; cA = nA; cB = nB; ++ui;
        if (wr == 1) PG8_BAR;
    }
    PG8_WAIT_V(0);
    PG8_BAR;
#undef PG8_SA
#undef PG8_SB
#undef PG8_STAGE
#undef PG8_LDA
#undef PG8_LDB
#undef PG8_LD2
#undef PG8_HALF
#undef PG8_MMA
#undef PG8_WAIT_V
#undef PG8_WAIT_L
#undef PG8_BAR
#undef PG8_SCHED
}
}

enum { EM_IN0 = 0, EM_MKV = 1, EM_GATE = 2, EM_RES = 3, EM_PQ = 4, EM_L1 = 5 };
struct Epi {
    int mode;
    GAS unsigned char* ws;
    const GAS float* resid;
    GAS float* outf;
    GAS bf16_t* o16;
    GAS float* ssq;
    const GAS float* gate_b;
    typedef pg8::Unit Unit;
    __device__ __forceinline__ static void st8(GAS bf16_t* p, f32x4 v0, f32x4 v1) {
        u32x4 w; w.x = cvtpk(v0[0], v0[1]); w.y = cvtpk(v0[2], v0[3]); w.z = cvtpk(v1[0], v1[1]); w.w = cvtpk(v1[2], v1[3]); *(GAS u32x4*)p = w; }
    __device__ __forceinline__ static float sq8(f32x4 a, f32x4 b) { return (a[0] * a[0] + a[1] * a[1]) + (a[2] * a[2] + a[3] * a[3]) + (b[0] * b[0] + b[1] * b[1]) + (b[2] * b[2] + b[3] * b[3]); }
    __device__ __forceinline__ void operator()(f32x4 (&acc)[2][2][4][2], const Unit& u, int wr, int wc, int fr, int fq) const {
        const int row0 = u.pm * 256 + wr * 64 + fr;
        const int cin = wc * 32 + 8 * fq;
        if (mode == EM_IN0) {
            GAS bf16_t* base; int ld, colt; int kind;
            if (u.pn < 6) { base = (GAS bf16_t*)(ws + O_ZX); ld = LRU; colt = u.pn * 256; kind = 0; }
            else if (u.pn < 12) { base = (GAS bf16_t*)(ws + O_GY); ld = LRU; colt = (u.pn - 6) * 256; kind = 1; }
            else { base = (GAS bf16_t*)(ws + O_ZL1); ld = NL1; colt = 4608 + (u.pn - 12) * 256; kind = 2; }
            GAS float* qmss = (GAS float*)(ws + O_SSL1);
#pragma unroll
            for (int ai = 0; ai < 2; ++ai)
#pragma unroll
                for (int m = 0; m < 4; ++m) { const int row = row0 + ai * 128 + m * 16;
#pragma unroll
                    for (int bj = 0; bj < 2; ++bj) { f32x4 v0 = acc[ai][bj][m][0], v1 = acc[ai][bj][m][1];
                        if (kind == 1) {
#pragma unroll
                            for (int j = 0; j < 4; ++j) { v0[j] = gelu_tanh(v0[j]); v1[j] = gelu_tanh(v1[j]); } }
                        st8(base + (size_t)row * ld + colt + bj * 128 + cin, v0, v1);
                        if (kind == 2) { float s = sq8(v0, v1); s = xsum16(s); s = xsum32(s);
                            if (fq == 0) qmss[(size_t)row * 112 + (24 + (u.pn - 12) * 2 + bj) * 4 + wc] = s; } } }
        } else if (mode == EM_MKV) {
#pragma unroll
            for (int ai = 0; ai < 2; ++ai)
#pragma unroll
                for (int m = 0; m < 4; ++m) { const int row = row0 + ai * 128 + m * 16;
#pragma unroll
                    for (int bj = 0; bj < 2; ++bj) { const f32x4 v0 = acc[ai][bj][m][0], v1 = acc[ai][bj][m][1];
                        st8(o16 + (size_t)row * NL1 + u.pn * 256 + bj * 128 + cin, v0, v1);
                        if (u.pn < 2) { float s = sq8(v0, v1); s = xsum16(s); s = xsum32(s);
                            if (fq == 0) ssq[(size_t)row * 112 + (u.pn * 2 + bj) * 4 + wc] = s; } } }
        } else if (mode == EM_GATE) {
            const int ch = u.pn * 128 + cin;
            const GAS bf16_t* xc = (const GAS bf16_t*)(ws + O_XC); GAS _Float16* LA = (GAS _Float16*)(ws + O_AA); GAS _Float16* UH = (GAS _Float16*)(ws + O_UU);
            const GAS float* spl = (const GAS float*)(ws + O_SPL) + ch; const GAS float* gb = gate_b + u.pn * 256 + cin;
#pragma unroll
            for (int n = 0; n < 2; ++n) {
                const f32x4 sp = *(const GAS f32x4*)(spl + 4 * n), br = *(const GAS f32x4*)(gb + 4 * n), bi = *(const GAS f32x4*)(gb + 128 + 4 * n);
#pragma unroll
                for (int ai = 0; ai < 2; ++ai)
#pragma unroll
                    for (int m = 0; m < 4; ++m) { const int row = row0 + ai * 128 + m * 16;
                        const u32x2 xw = *(const GAS u32x2*)(xc + (size_t)row * LRU + ch + 4 * n);
                        const f32x4 xv = {bf_lo(xw.x), bf_hi(xw.x), bf_lo(xw.y), bf_hi(xw.y)};
                        float lav[4], uvv[4];
#pragma unroll
                        for (int j = 0; j < 4; ++j) { const float r = sigmoidf_(acc[ai][0][m][n][j] + br[j]), ig = sigmoidf_(acc[ai][1][m][n][j] + bi[j]);
                            const float la = -8.f * r * sp[j];
                            lav[j] = la; uvv[j] = __builtin_amdgcn_sqrtf(one_minus_exp(2.f * la)) * (ig * xv[j]); }
                        { const h2 l0 = {(_Float16)lav[0], (_Float16)lav[1]}, l1 = {(_Float16)lav[2], (_Float16)lav[3]}, u0 = {(_Float16)uvv[0], (_Float16)uvv[1]}, u1 = {(_Float16)uvv[2], (_Float16)uvv[3]};
                          *(GAS u32x2*)(LA + (size_t)row * LRU + ch + 4 * n) = (u32x2){__builtin_bit_cast(unsigned, l0), __builtin_bit_cast(unsigned, l1)};
                          *(GAS u32x2*)(UH + (size_t)row * LRU + ch + 4 * n) = (u32x2){__builtin_bit_cast(unsigned, u0), __builtin_bit_cast(unsigned, u1)}; } }
            }
        } else if (mode == EM_RES) {
            GAS bf16_t* xs = (GAS bf16_t*)(ws + O_XS16); GAS float* rowss = (GAS float*)(ws + O_ROWSS);
#pragma unroll
            for (int ai = 0; ai < 2; ++ai)
#pragma unroll
                for (int m = 0; m < 4; ++m) { const int row = row0 + ai * 128 + m * 16; float s = 0.f;
#pragma unroll
                    for (int bj = 0; bj < 2; ++bj) { const size_t off = (size_t)row * DM + u.pn * 256 + bj * 128 + cin;
                        f32x4 r0, r1;
                        if (resid) { r0 = *(const GAS f32x4*)(resid + off); r1 = *(const GAS f32x4*)(resid + off + 4); }
                        else { const u32x4 w = *(const GAS u32x4*)(xs + off); r0 = (f32x4){bf_lo(w.x), bf_hi(w.x), bf_lo(w.y), bf_hi(w.y)}; r1 = (f32x4){bf_lo(w.z), bf_hi(w.z), bf_lo(w.w), bf_hi(w.w)}; }
                        const f32x4 v0 = acc[ai][bj][m][0] + r0, v1 = acc[ai][bj][m][1] + r1;
                        st8(xs + off, v0, v1); s += sq8(v0, v1); }
                    s = xsum16(s); s = xsum32(s);
                    if (fq == 0) rowss[(size_t)row * 32 + u.pn * 4 + wc] = s; }
        } else if (mode == EM_PQ) {
            const GAS float* rowss = (const GAS float*)(ws + O_ROWSS);
#pragma unroll
            for (int ai = 0; ai < 2; ++ai)
#pragma unroll
                for (int m = 0; m < 4; ++m) { const int row = row0 + ai * 128 + m * 16;
                    const f32x4 p0 = *(const GAS f32x4*)(rowss + (size_t)row * 32 + fq * 8), p1 = *(const GAS f32x4*)(rowss + (size_t)row * 32 + fq * 8 + 4);
                    float s = (p0[0] + p0[1]) + (p0[2] + p0[3]) + (p1[0] + p1[1]) + (p1[2] + p1[3]); s = xsum16(s); s = xsum32(s);
                    const float r = rsqrtf(s * (1.f / DM) + EPS);
#pragma unroll
                    for (int bj = 0; bj < 2; ++bj) st8(o16 + (size_t)row * DM + u.pn * 256 + bj * 128 + cin, acc[ai][bj][m][0] * r, acc[ai][bj][m][1] * r); }
        } else {
            const GAS float* rsp = (const GAS float*)(ws + O_RSP); GAS bf16_t* zl1 = (GAS bf16_t*)(ws + O_ZL1); GAS float* ssl1 = (GAS float*)(ws + O_SSL1);
            const int slot0 = u.pn < 6 ? u.pn * 2 : (u.pn >= 12 ? 12 + (u.pn - 12) * 2 : -1);
#pragma unroll
            for (int ai = 0; ai < 2; ++ai)
#pragma unroll
                for (int m = 0; m < 4; ++m) { const int row = row0 + ai * 128 + m * 16;
                    const f32x4 q0 = *(const GAS f32x4*)(rsp + (size_t)row * 8), q1 = *(const GAS f32x4*)(rsp + (size_t)row * 8 + 4);
                    const float r = rsqrtf(((q0[0] + q0[1]) + (q0[2] + q0[3]) + (q1[0] + q1[1]) + (q1[2] + q1[3])) * (1.f / DM) + EPS);
#pragma unroll
                    for (int bj = 0; bj < 2; ++bj) { const f32x4 v0 = acc[ai][bj][m][0] * r, v1 = acc[ai][bj][m][1] * r;
                        st8(zl1 + (size_t)row * NL1 + u.pn * 256 + bj * 128 + cin, v0, v1);
                        if (slot0 >= 0) { float s = sq8(v0, v1); s = xsum16(s); s = xsum32(s);
                            if (fq == 0) ssl1[(size_t)row * 112 + (slot0 + bj) * 4 + wc] = s; } } }
        }
    }
};

namespace att {
constexpr float SCALE = 0.08838834764831845f;
constexpr int NW = 8, QBLK = 32, KVBLK = 64, QB = NW * QBLK, D = 128;
constexpr int SHM_V = KVBLK * D * 2, SHM_K = KVBLK * D * 2;
constexpr int OFF_WS = 2 * SHM_V + 2 * SHM_K;
constexpr int OFF_KS = OFF_WS + 2048;
constexpr int OFF_BS = OFF_KS + 16384;
constexpr int LDS_END = OFF_BS + 16384;
constexpr int WBIG = 1 << 28;

#define KSWZ(row, colB) ((row) * 256 + ((colB) ^ (((row) & 7) << 4)))
#define SBAR() __builtin_amdgcn_sched_barrier(0)
__device__ __forceinline__ int v_st(int k, int c) { const int kk = (k & ~0xC) | ((k & 4) << 1) | ((k & 8) >> 1); return ((kk >> 3) * 4 + (c >> 5)) * 512 + ((kk & 7) * 32 + (c & 31)) * 2; }
__device__ __forceinline__ int v_rd_base(int lane) { return ((lane & 3) << 3) | (((lane >> 2) & 3) << 6) | (((lane >> 4) & 1) << 5) | (((lane >> 5) & 1) << 8); }
constexpr int v_rd_off(int d0, int ks, int half) { return d0 * 512 + ks * 4096 + half * 2048; }
__device__ __forceinline__ int crow(int r, int hi) { return (r & 3) + 8 * (r >> 2) + 4 * hi; }
__device__ __forceinline__ bf16x8 load8(const GAS bf16_t* p) { return *(const GAS bf16x8*)p; }
__device__ __forceinline__ bf16x8 scale8(bf16x8 v, float s) { const u32x4 w = *reinterpret_cast<u32x4*>(&v); u32x4 o;
    o.x = cvtpk(bf_lo(w.x) * s, bf_hi(w.x) * s); o.y = cvtpk(bf_lo(w.y) * s, bf_hi(w.y) * s); o.z = cvtpk(bf_lo(w.z) * s, bf_hi(w.z) * s); o.w = cvtpk(bf_lo(w.w) * s, bf_hi(w.w) * s);
    return *reinterpret_cast<bf16x8*>(&o); }
__device__ __forceinline__ void mask_tile(f32x16& p0, f32x16& p1, int dq, unsigned W) {
    const float NEG = -__builtin_inff();
#pragma unroll
    for (int r = 0; r < 16; ++r) {
        const int c = (r & 3) + 8 * (r >> 2);
        if ((unsigned)(dq - c) >= W) p0[r] = NEG;
        if ((unsigned)(dq - c - 32) >= W) p1[r] = NEG;
    }
}
constexpr float THR = 8.f;
__device__ __forceinline__ void partialSM(f32x16& p0, f32x16& p1, float& m_reg, float& mn, float& alpha) {
    float pmax = p0[0]; for (int r = 1; r < 16; ++r) pmax = fmaxf(pmax, p0[r]); for (int r = 0; r < 16; ++r) pmax = fmaxf(pmax, p1[r]);
    { auto rr = __builtin_amdgcn_permlane32_swap(__float_as_uint(pmax), __float_as_uint(pmax), false, false);
      pmax = fmaxf(__uint_as_float(rr[0]), __uint_as_float(rr[1])); }
    constexpr float C2 = 1.4426950408889634f * SCALE;
    if (__builtin_expect(__all((pmax - m_reg) * SCALE <= THR), 1)) { mn = m_reg; alpha = 1.f; }
    else { mn = fmaxf(m_reg, pmax); alpha = __builtin_amdgcn_exp2f((m_reg - mn) * C2); m_reg = mn; }
    const float mnL = -mn * C2;
    for (int r = 0; r < 16; ++r) p0[r] = fmaf(p0[r], C2, mnL); for (int r = 0; r < 16; ++r) p1[r] = fmaf(p1[r], C2, mnL);
    for (int r = 0; r < 16; ++r) p0[r] = __builtin_amdgcn_exp2f(p0[r]);
}
__device__ __forceinline__ void finishSM(f32x16& p0, f32x16& p1, float alpha, float& l_reg, bf16x8& pa0, bf16x8& pa1, bf16x8& pa2, bf16x8& pa3) {
    for (int r = 0; r < 16; ++r) p1[r] = __builtin_amdgcn_exp2f(p1[r]);
    float ps = 0; for (int r = 0; r < 16; ++r) ps += p0[r]; for (int r = 0; r < 16; ++r) ps += p1[r];
    { auto rr = __builtin_amdgcn_permlane32_swap(__float_as_uint(ps), __float_as_uint(ps), false, false);
      ps = __uint_as_float(rr[0]) + __uint_as_float(rr[1]); }
    l_reg = l_reg * alpha + ps;
#define PK4(P, B_, OUT) do { unsigned a0 = cvtpk(P[B_+0], P[B_+1]), a1 = cvtpk(P[B_+2], P[B_+3]);                          \
        unsigned b0 = cvtpk(P[B_+4], P[B_+5]), b1 = cvtpk(P[B_+6], P[B_+7]);                                             \
        auto r0 = __builtin_amdgcn_permlane32_swap(a0, b0, false, false); auto r1 = __builtin_amdgcn_permlane32_swap(a1, b1, false, false); \
        u32x4 w = {r0[0], r1[0], r0[1], r1[1]}; OUT = *reinterpret_cast<bf16x8*>(&w); } while (0)
    PK4(p0, 0, pa0); PK4(p0, 8, pa1); PK4(p1, 0, pa2); PK4(p1, 8, pa3);
#undef PK4
}
template <int KB>
__device__ __forceinline__ void qkt(f32x16& p0, f32x16& p1, const char* K_lds, int r32, int hi, const bf16x8* qr, const float* bp  ) {
    { const f32x4 a = *(const f32x4*)(bp), b = *(const f32x4*)(bp + 8), c = *(const f32x4*)(bp + 16), d = *(const f32x4*)(bp + 24);
      p0 = (f32x16){a[0], a[1], a[2], a[3], b[0], b[1], b[2], b[3], c[0], c[1], c[2], c[3], d[0], d[1], d[2], d[3]}; }
    { const f32x4 a = *(const f32x4*)(bp + 32), b = *(const f32x4*)(bp + 40), c = *(const f32x4*)(bp + 48), d = *(const f32x4*)(bp + 56);
      p1 = (f32x16){a[0], a[1], a[2], a[3], b[0], b[1], b[2], b[3], c[0], c[1], c[2], c[3], d[0], d[1], d[2], d[3]}; }
    const char* kb[4];
#pragma unroll
    for (int dd = 0; dd < 4; ++dd) kb[dd] = K_lds + KB * SHM_K + KSWZ(r32, (dd * 16 + hi * 8) * 2);
#pragma unroll
    for (int d0 = 0; d0 < 8; ++d0) { const char* a = kb[d0 & 3] + (d0 >> 2) * 128;
        bf16x8 b0 = *reinterpret_cast<const bf16x8*>(a);
        bf16x8 b1 = *reinterpret_cast<const bf16x8*>(a + 32 * 256);
        p0 = __builtin_amdgcn_mfma_f32_32x32x16_bf16(b0, qr[d0], p0, 0, 0, 0);
        p1 = __builtin_amdgcn_mfma_f32_32x32x16_bf16(b1, qr[d0], p1, 0, 0, 0); }
}
template <int VB>
__device__ __forceinline__ void pv_tile(f32x16* o, int vb0, bf16x8 pa0, bf16x8 pa1, bf16x8 pa2, bf16x8 pa3) {
#define TRRD(dst, off) asm volatile("ds_read_b64_tr_b16 %0, %1 offset:%2" : "=&v"(dst) : "v"(vb0), "i"(off) : "memory")
#define PV_D0(d0) do { s16x4 l0, l1, l2, l3, h0, h1, h2_, h3; constexpr int b_ = VB * SHM_V + v_rd_off(d0, 0, 0); \
        TRRD(l0, b_); TRRD(h0, b_ + 2048); TRRD(l1, b_ + 4096); TRRD(h1, b_ + 6144); TRRD(l2, b_ + 8192); TRRD(h2_, b_ + 10240); TRRD(l3, b_ + 12288); TRRD(h3, b_ + 14336); \
        asm volatile("s_waitcnt lgkmcnt(0)" ::: "memory"); SBAR();   \
        o[d0] = __builtin_amdgcn_mfma_f32_32x32x16_bf16(pa0, (bf16x8){l0[0], l0[1], l0[2], l0[3], h0[0], h0[1], h0[2], h0[3]}, o[d0], 0, 0, 0);   \
        o[d0] = __builtin_amdgcn_mfma_f32_32x32x16_bf16(pa1, (bf16x8){l1[0], l1[1], l1[2], l1[3], h1[0], h1[1], h1[2], h1[3]}, o[d0], 0, 0, 0);   \
        o[d0] = __builtin_amdgcn_mfma_f32_32x32x16_bf16(pa2, (bf16x8){l2[0], l2[1], l2[2], l2[3], h2_[0], h2_[1], h2_[2], h2_[3]}, o[d0], 0, 0, 0);   \
        o[d0] = __builtin_amdgcn_mfma_f32_32x32x16_bf16(pa3, (bf16x8){l3[0], l3[1], l3[2], l3[3], h3[0], h3[1], h3[2], h3[3]}, o[d0], 0, 0, 0); } while (0)
    PV_D0(0); PV_D0(1); PV_D0(2); PV_D0(3);
#undef PV_D0
#undef TRRD
}

struct BlockRef { const GAS bf16_t* Q; const GAS bf16_t* K; const GAS bf16_t* V; GAS bf16_t* O; const GAS float* qss; const GAS float* kss; const GAS float* cc; const GAS float* gg;
                  int P0, skv; };
constexpr int LDQ = 5120, LDK = 5120, LDO = 2048, LDSS = 112;
struct Seam { bf16x8 qr[8]; bf16x8 st_v0, st_v1, st_k0, st_k1; int jlo; };
#define ROWK(p, k0, rr) ((p) + (size_t)((k0) + (rr)) * LDK + sc)
#define VMW() asm volatile("s_waitcnt vmcnt(0)" ::: "memory")
#define VMWN(n) asm volatile("s_waitcnt vmcnt(%0)" :: "i"(n) : "memory")
#define SLOAD_H(Kp, Vp, k0) do { S.st_v0 = load8(ROWK(Vp, k0, sr)); S.st_v1 = load8(ROWK(Vp, k0, 32 + sr));              \
                         S.st_k0 = load8(ROWK(Kp, k0, sr)); S.st_k1 = load8(ROWK(Kp, k0, 32 + sr)); } while (0)
#define SWRITE_HK(bf, k0) do { *(bf16x8*)(K_lds + (bf) * SHM_K + kws) = scale8(S.st_k0, ksr[(k0)]); *(bf16x8*)(K_lds + (bf) * SHM_K + kws + 32 * 256) = scale8(S.st_k1, ksr[(k0) + 32]); } while (0)
#define SWRITE_HV(bf) do { *(bf16x8*)(V_lds + (bf) * SHM_V + vst0) = S.st_v0; *(bf16x8*)(V_lds + (bf) * SHM_V + vst1) = S.st_v1; } while (0)
#define SWRITE_H(bf, k0) do { SWRITE_HV(bf); SWRITE_HK(bf, k0); } while (0)

__device__ __forceinline__ void attn_prime(const BlockRef& cur, char* lds, Seam& S, const int tid) {
    const int wid = __builtin_amdgcn_readfirstlane(tid >> 6), lane = tid & 63, r32 = lane & 31, hi = lane >> 5;
    const int sr = tid >> 4, sc = (tid & 15) * 8, kws = KSWZ(sr, sc * 2); char* K_lds = lds + 2 * SHM_V;
    float* ks_l = (float*)(lds + OFF_KS); float* bs_l = (float*)(lds + OFF_BS); const float* ksr = ks_l + sr;
    int j_hi = (cur.P0 + QB - 1) / KVBLK + 1; if (j_hi > cur.skv / KVBLK) j_hi = cur.skv / KVBLK;
    const int nkeys = j_hi * KVBLK;
    const float c0 = cur.cc ? cur.cc[cur.P0] : 0.f;
    int jlo = 0;
    if (cur.cc) { const float thr = cur.gg[128]; const int jd = cur.P0 / KVBLK;
        const float cv = lane <= jd ? cur.cc[lane * KVBLK + KVBLK - 1] : 0.f;
        const bool keep = lane > jd || (c0 - cv > -thr);
        jlo = __ffsll((long long)__ballot(keep)) - 1; }
    S.jlo = jlo;
    for (int s = jlo * KVBLK + tid; s < nkeys; s += NTHREADS) {
        const f32x4 p = *(const GAS f32x4*)(cur.kss + (size_t)s * LDSS);
        ks_l[s] = rsqrtf(((p[0] + p[1]) + (p[2] + p[3])) * (1.f / 128.f) + EPS);
        bs_l[s] = cur.cc ? (c0 - cur.cc[s]) * (1.f / SCALE) : 0.f;
    }
    __syncthreads();
    const int qrow = wid * QBLK + r32;
    const f32x4 qp = *(const GAS f32x4*)(cur.qss + (size_t)qrow * LDSS);
    const float rq = rsqrtf(((qp[0] + qp[1]) + (qp[2] + qp[3])) * (1.f / 128.f) + EPS);
#pragma unroll
    for (int d0 = 0; d0 < 8; ++d0) {
        const u32x4 w = *(const GAS u32x4*)(cur.Q + (size_t)qrow * LDQ + d0 * 16 + hi * 8);
        const f32x4 g0 = *(const GAS f32x4*)(cur.gg + d0 * 16 + hi * 8), g1 = *(const GAS f32x4*)(cur.gg + d0 * 16 + hi * 8 + 4);
        u32x4 o; o.x = cvtpk(bf_lo(w.x) * rq * g0[0], bf_hi(w.x) * rq * g0[1]); o.y = cvtpk(bf_lo(w.y) * rq * g0[2], bf_hi(w.y) * rq * g0[3]);
        o.z = cvtpk(bf_lo(w.z) * rq * g1[0], bf_hi(w.z) * rq * g1[1]); o.w = cvtpk(bf_lo(w.w) * rq * g1[2], bf_hi(w.w) * rq * g1[3]);
        S.qr[d0] = *reinterpret_cast<bf16x8*>(&o);
    }
    SLOAD_H(cur.K, cur.V, jlo * KVBLK); VMW(); SWRITE_HK(0, jlo * KVBLK);
    __syncthreads();
}
__device__ __forceinline__ void attn_block(const BlockRef& cur, char* lds, Seam& S, const int tid) {
    const int wid = __builtin_amdgcn_readfirstlane(tid >> 6), lane = tid & 63, r32 = lane & 31, hi = lane >> 5;
    const int W = WBIG;
    int j_hi = (cur.P0 + QB - 1) / KVBLK + 1; if (j_hi > cur.skv / KVBLK) j_hi = cur.skv / KVBLK;
    const int j_lo = S.jlo; const int NT = j_hi - j_lo;
    const int qlo = cur.P0 - j_lo * KVBLK + wid * QBLK, qm = qlo + r32 - 4 * hi;
    char* V_lds = lds; char* K_lds = lds + 2 * SHM_V;
    float* ws = (float*)(lds + OFF_WS) + wid * 64; float* li_l = ws, * al_l = ws + 32;
    const float* bs_l = (const float*)(lds + OFF_BS) + j_lo * KVBLK + 4 * hi;
    float m_reg = -1e30f, l_reg = 0; f32x16 o[4] = {};
    const int sr = tid >> 4, sc = (tid & 15) * 8, vst0 = v_st(sr, sc), vst1 = v_st(32 + sr, sc), kws = KSWZ(sr, sc * 2);
    const float* ksr = (const float*)(lds + OFF_KS) + j_lo * KVBLK + sr;
    const int vb0 = (int)(uintptr_t)V_lds + v_rd_base(lane);
    const GAS bf16_t* Kh = cur.K + (size_t)j_lo * KVBLK * LDK; const GAS bf16_t* Vh = cur.V + (size_t)j_lo * KVBLK * LDK;
#define RESC(a) do { if (__any((a) < 1.f)) { if (hi == 0) al_l[r32] = (a); asm volatile("s_waitcnt lgkmcnt(0)" ::: "memory");              \
                     for (int d_ = 0; d_ < 4; ++d_) for (int r = 0; r < 16; ++r) o[d_][r] *= al_l[crow(r, hi)]; } } while (0)
#define KBASE(t) ((t) * KVBLK)
#define MASKT(P0_, P1_, t) do { const int kb_ = KBASE(t); if (kb_ + KVBLK - 1 > qlo) mask_tile(P0_, P1_, qm - kb_, (unsigned)W); } while (0)
    f32x16 pA0, pA1, pB0, pB1; float mnA, mnB, alA, alB; bf16x8 pa0, pa1, pa2, pa3;
    SWRITE_HV(0); SBAR();
    if (NT > 1) { SLOAD_H(Kh, Vh, KBASE(1)); }
    SBAR(); qkt<0>(pA0, pA1, K_lds, r32, hi, S.qr, bs_l + KBASE(0));
    MASKT(pA0, pA1, 0); partialSM(pA0, pA1, m_reg, mnA, alA);
    if (NT > 1) { VMW(); SWRITE_H(1, KBASE(1)); }
    __syncthreads();
#define HALF_STEP(PX0, PX1, mnX, alX, PY0, PY1, alY, t, KB, VB, SB) do {                                                      \
        SBAR(); qkt<KB>(PX0, PX1, K_lds, r32, hi, S.qr, bs_l + KBASE(t));                                                         \
        finishSM(PY0, PY1, alY, l_reg, pa0, pa1, pa2, pa3); SBAR();                                                           \
        if ((t) + 1 < NT) { SLOAD_H(Kh, Vh, KBASE((t) + 1)); SBAR(); }                                               \
        pv_tile<VB>(o, vb0, pa0, pa1, pa2, pa3); MASKT(PX0, PX1, (t)); partialSM(PX0, PX1, m_reg, mnX, alX);                                        \
        __syncthreads();                                                                                                      \
        if ((t) + 1 < NT) { VMW(); SWRITE_H(SB, KBASE((t) + 1)); }                                                                          \
        RESC(alX); __syncthreads(); } while (0)
    for (int t = 1; t + 1 < NT; t += 2) {
        HALF_STEP(pB0, pB1, mnB, alB, pA0, pA1, alA, t, 1, 0, 0);
        HALF_STEP(pA0, pA1, mnA, alA, pB0, pB1, alB, t + 1, 0, 1, 1);
    }
    const bool even = (NT & 1) == 0;
    if (even) { SBAR(); qkt<1>(pB0, pB1, K_lds, r32, hi, S.qr, bs_l + KBASE(NT - 1)); SBAR(); }
    finishSM(pA0, pA1, alA, l_reg, pa0, pa1, pa2, pa3); SBAR();
    pv_tile<0>(o, vb0, pa0, pa1, pa2, pa3);
    if (even) { MASKT(pB0, pB1, NT - 1); partialSM(pB0, pB1, m_reg, mnB, alB); __syncthreads(); RESC(alB);
        finishSM(pB0, pB1, alB, l_reg, pa0, pa1, pa2, pa3); SBAR(); pv_tile<1>(o, vb0, pa0, pa1, pa2, pa3); }
    SBAR();
    if (hi == 0) li_l[r32] = l_reg; asm volatile("s_waitcnt lgkmcnt(0)" ::: "memory");
    float rli[16];
#pragma unroll
    for (int r = 0; r < 16; ++r) rli[r] = __builtin_amdgcn_rcpf(li_l[crow(r, hi)]);
    GAS bf16_t* Ow = cur.O + (size_t)(wid * QBLK) * LDO;
#pragma unroll
    for (int r = 0; r < 16; ++r) { const int orow = crow(r, hi);
#pragma unroll
        for (int d0 = 0; d0 < 4; ++d0) { const float v = o[d0][r] * rli[r];
            const float vn = dppf<0xB1>(v);
            if ((r32 & 1) == 0) *(GAS unsigned*)(Ow + (size_t)orow * LDO + d0 * 32 + r32) = cvtpk(v, vn); } }
    __syncthreads();
#undef RESC
#undef KBASE
#undef MASKT
#undef HALF_STEP
}
#undef ROWK
#undef VMW
#undef VMWN
#undef SLOAD_H
#undef SWRITE_HK
#undef SWRITE_HV
#undef SWRITE_H
#undef KSWZ
#undef SBAR
}


struct Frame {
    GAS unsigned char* ws; const float* const* in_; GAS float* out;
    __device__ __forceinline__ const GAS float* in(int i) const { return (const GAS float*)in_[i]; }
    int tid, lane, wave, gw, ngw, gtid, ngt;
};
enum { I_X = 0, I_MEM, I_ANORM, I_AWIN, I_ACONVW, I_ACONVB, I_AGATEW, I_AGATEB, I_ALAMBDA, I_AWOUT, I_SNORM, I_SWKVF, I_SBF, I_SKNORM, I_BNORM, I_BWIN, I_BQNORM, I_BWOUT,
       I_MNORM, I_MWKV, I_MQNORM, I_MKNORM, I_PNORM, I_PWQ, I_PSUBK, I_PU, I_PV, N_IN };

struct TrItem { const GAS float* W; const GAS float* gain; GAS bf16_t* WT; int ldw, ldt, row_off, k0, n0; };
__device__ __forceinline__ void tr_load(const TrItem& d, float (&wv)[32], int lane) {
#pragma unroll
    for (int i = 0; i < 32; ++i) wv[i] = __builtin_nontemporal_load(d.W + (size_t)(d.k0 + 2 * i + (lane >> 5)) * d.ldw + d.n0 + (lane & 31));
}
__device__ __forceinline__ void tr_proc(const TrItem& d, float (&wv)[32], LAS float* scr, int lane) {
    if (d.gain) {
#pragma unroll
        for (int i = 0; i < 32; ++i) wv[i] *= d.gain[d.k0 + 2 * i + (lane >> 5)]; }
#pragma unroll
    for (int i = 0; i < 32; ++i) scr[(2 * i + (lane >> 5)) * 33 + (lane & 31)] = wv[i];
    asm volatile("s_waitcnt lgkmcnt(0)" ::: "memory");
    const int c = lane & 7;
#pragma unroll
    for (int j = 0; j < 4; ++j) { const int n = (lane >> 3) + 8 * j; const LAS float* s = scr + (8 * c) * 33 + n;
        u32x4 o; o.x = cvtpk(s[0 * 33], s[1 * 33]); o.y = cvtpk(s[2 * 33], s[3 * 33]); o.z = cvtpk(s[4 * 33], s[5 * 33]); o.w = cvtpk(s[6 * 33], s[7 * 33]);
        *(GAS u32x4*)(d.WT + (size_t)(d.row_off + d.n0 + n) * d.ldt + d.k0 + 8 * c) = o; }
    asm volatile("s_waitcnt lgkmcnt(0)" ::: "memory");
}
__device__ __forceinline__ void transpose_item_fp8(const GAS float* W, int ldw, const GAS float* gain, GAS unsigned char* WT, int ldt, LAS float* scr, int nblk, int item, int lane) {
    const int kb = item / nblk, nb = item % nblk, k0 = 64 * kb, n0 = 32 * nb;
    float wv[32];
#pragma unroll
    for (int i = 0; i < 32; ++i) wv[i] = W[(size_t)(k0 + 2 * i + (lane >> 5)) * ldw + n0 + (lane & 31)];
#pragma unroll
    for (int i = 0; i < 32; ++i) wv[i] *= gain[k0 + 2 * i + (lane >> 5)] * 64.f;
#pragma unroll
    for (int i = 0; i < 32; ++i) scr[(2 * i + (lane >> 5)) * 33 + (lane & 31)] = wv[i];
    asm volatile("s_waitcnt lgkmcnt(0)" ::: "memory");
    const int c = lane & 3;
#pragma unroll
    for (int j = 0; j < 2; ++j) { const int n = (lane >> 2) + 16 * j; const LAS float* sp = scr + (16 * c) * 33 + n; u32x4 o;
#pragma unroll
        for (int w = 0; w < 4; ++w) { int pk = __builtin_amdgcn_cvt_pk_fp8_f32(sp[(4 * w) * 33], sp[(4 * w + 1) * 33], 0, false); pk = __builtin_amdgcn_cvt_pk_fp8_f32(sp[(4 * w + 2) * 33], sp[(4 * w + 3) * 33], pk, true); o[w] = (unsigned)pk; }
        *(GAS u32x4*)(WT + (size_t)(n0 + n) * ldt + k0 + 16 * c) = o; }
    asm volatile("s_waitcnt lgkmcnt(0)" ::: "memory");
}
struct CtRow { f32x4 v[8]; GAS unsigned char* dst; int row, which; };
__device__ __forceinline__ void ct_load(Frame& F, int layer, int it, CtRow& R) {
    R.which = it & 1; R.row = it >> 1;
    const GAS float* src = F.in(R.which ? I_PV : I_PU) + ((size_t)layer * NEXP + R.row) * DM + F.lane * 4;
    R.dst = F.ws + O_TAB + (size_t)(layer * 2 + R.which) * TAB_ONE;
#pragma unroll
    for (int c = 0; c < 8; ++c) R.v[c] = __builtin_nontemporal_load((const GAS f32x4*)(src + c * 256));
}
__device__ __forceinline__ void ct_proc(Frame& F, int layer, CtRow& R) {
    const GAS float* gn = F.in(I_PNORM) + layer * DM + F.lane * 4;
    _Float16 shv = (_Float16)0.f;
#pragma unroll
    for (int c = 0; c < 8; ++c) { f32x4 x = R.v[c]; if (!R.which) x = x * *(const GAS f32x4*)(gn + c * 256);
        float amax = fmaxf(fmaxf(fabsf(x[0]), fabsf(x[1])), fmaxf(fabsf(x[2]), fabsf(x[3])));
        amax = wave_max(amax);
        const _Float16 sh = (_Float16)fmaxf(amax * (R.which ? 1.f / 6.f : 1.f / 7.f), 1e-6f);
        const float qs = __builtin_amdgcn_rcpf((float)sh);
        unsigned pk;
        if (R.which) { pk = __builtin_amdgcn_cvt_scalef32_pk_fp4_f32(0u, x[0] * qs, x[1] * qs, 1.0f, 0); pk = __builtin_amdgcn_cvt_scalef32_pk_fp4_f32(pk, x[2] * qs, x[3] * qs, 1.0f, 1); }
        else { const int q0 = (int)fminf(fmaxf(rintf(x[0] * qs), -7.f), 7.f), q1 = (int)fminf(fmaxf(rintf(x[1] * qs), -7.f), 7.f), q2 = (int)fminf(fmaxf(rintf(x[2] * qs), -7.f), 7.f), q3 = (int)fminf(fmaxf(rintf(x[3] * qs), -7.f), 7.f);
               pk = (unsigned)(q0 & 15) | ((unsigned)(q1 & 15) << 4) | ((unsigned)(q2 & 15) << 8) | ((unsigned)(q3 & 15) << 12); }
        *(GAS unsigned short*)(R.dst + ((size_t)c * NEXP + R.row) * 128 + F.lane * 2) = (unsigned short)pk;
        shv = (F.lane == c) ? sh : shv; }
    if (F.lane < 8) *(GAS unsigned short*)(R.dst + TAB_NIB + ((size_t)R.row * 8 + F.lane) * 2) = __builtin_bit_cast(unsigned short, shv);
}
__device__ __forceinline__ void convert_tables(Frame& F, int layer, int ibeg, int iend, int wk, int nwk) {
    if (ibeg + wk >= iend) return;
    const int ilast = ibeg + wk + ((iend - 1 - ibeg - wk) / nwk) * nwk;
    CtRow A, B;
    ct_load(F, layer, ibeg + wk, A);
    for (int it = ibeg + wk; it < iend; it += 2 * nwk) {
        ct_load(F, layer, it + nwk <= ilast ? it + nwk : ilast, B);
        ct_proc(F, layer, A);
        ct_load(F, layer, it + 2 * nwk <= ilast ? it + 2 * nwk : ilast, A);
        if (it + nwk < iend) ct_proc(F, layer, B);
    }
}
__device__ __forceinline__ void norm_row_bf16(const GAS float* xrow, const GAS float* gain, GAS bf16_t* orow, int lane) {
    f32x4 v[8]; float s = 0.f;
#pragma unroll
    for (int j = 0; j < 8; ++j) { v[j] = *(const GAS f32x4*)(xrow + j * 256 + lane * 4); s += (v[j][0] * v[j][0] + v[j][1] * v[j][1]) + (v[j][2] * v[j][2] + v[j][3] * v[j][3]); }
    const float r = rsqrtf(wave_sum(s) * (1.f / DM) + EPS);
#pragma unroll
    for (int j = 0; j < 8; ++j) { f32x4 g = gain ? *(const GAS f32x4*)(gain + j * 256 + lane * 4) : (f32x4){1.f, 1.f, 1.f, 1.f};
        u32x2 o; o.x = cvtpk(v[j][0] * r * g[0], v[j][1] * r * g[1]); o.y = cvtpk(v[j][2] * r * g[2], v[j][3] * r * g[3]);
        *(GAS u32x2*)(orow + j * 256 + lane * 4) = o; }
}
__device__ __forceinline__ void step_prologue(Frame& F, LAS unsigned char* lds) {
    LAS float* scr = (LAS float*)(lds + F.wave * 16384);
    GAS unsigned char* ws = F.ws;
    constexpr int I0 = 32 * (NIN0 / 32), I1 = 32 * 64, I2 = 32 * 96, I3 = 32 * 64, I4 = 32 * 64, I5 = 32 * 64, I6 = 32 * 64, I7 = 32 * 32, I8 = 32 * 32, I9 = 12 * 16;
    constexpr int NITEMS = I0 + I1 + I2 + I3 + I4 + I5 + I6 + I7 + I8 + I9;
#define TR_DESC(D, it_) do { int r = (it_) < NITEMS ? (it_) : NITEMS - 1; int nblk; \
        if (r < I0) { D = {F.in(I_AWIN), F.in(I_ANORM), (GAS bf16_t*)(ws + O_WIN0), NIN0, DM, 0, 0, 0}; nblk = NIN0 / 32; } else { r -= I0; \
        if (r < I1) { D = {F.in(I_AWOUT), nullptr, (GAS bf16_t*)(ws + O_WOUT0), DM, DM, 0, 0, 0}; nblk = 64; } else { r -= I1; \
        if (r < I2) { D = {F.in(I_SWKVF), F.in(I_SNORM), (GAS bf16_t*)(ws + O_WL1), 3084, DM, 0, 0, 0}; nblk = 96; } else { r -= I2; \
        if (r < I3) { D = {F.in(I_BWIN), F.in(I_BNORM), (GAS bf16_t*)(ws + O_WL1), DM, DM, 3072, 0, 0}; nblk = 64; } else { r -= I3; \
        if (r < I4) { D = {F.in(I_BWOUT), nullptr, (GAS bf16_t*)(ws + O_WOUT1), DM, DM, 0, 0, 0}; nblk = 64; } else { r -= I4; \
        if (r < I5) { D = {F.in(I_PWQ), F.in(I_PNORM), (GAS bf16_t*)(ws + O_WQ0), DM, DM, 0, 0, 0}; nblk = 64; } else { r -= I5; \
        if (r < I6) { D = {F.in(I_PWQ) + (size_t)DM * DM, F.in(I_PNORM) + DM, (GAS bf16_t*)(ws + O_WQ1), DM, DM, 0, 0, 0}; nblk = 64; } else { r -= I6; \
        if (r < I7) { D = {F.in(I_MWKV), nullptr, (GAS bf16_t*)(ws + O_WMKV), 1024, DM, 0, 0, 0}; nblk = 32; } else { r -= I7; \
        if (r < I8) { D = {F.in(I_MWKV) + (size_t)DM * 1024, nullptr, (GAS bf16_t*)(ws + O_WMKV) + (size_t)1024 * DM, 1024, DM, 0, 0, 0}; nblk = 32; } else { r -= I8; \
          const int blk = r / 16; r = r % 16; D = {F.in(I_AGATEW) + (size_t)blk * 128 * 256, nullptr, (GAS bf16_t*)(ws + O_WGATE), 256, 128, blk * 256, 0, 0}; nblk = 8; } } } } } } } } } \
        D.k0 = 64 * (r / nblk); D.n0 = 32 * (r % nblk); } while (0)
    for (int it = F.gw; it < NITEMS; it += F.ngw) { float wv[32]; TrItem d; TR_DESC(d, it); tr_load(d, wv, F.lane); tr_proc(d, wv, scr, F.lane); }
#undef TR_DESC
    { const GAS float* sk = F.in(I_PSUBK); GAS bf16_t* o = (GAS bf16_t*)(ws + O_SUBK);
      for (int i = F.gtid; i < 2 * 16 * 128 * 128 / 2; i += F.ngt) *(GAS unsigned*)(o + 2 * i) = cvtpk(sk[2 * i], sk[2 * i + 1]); }
    { GAS float* wf = (GAS float*)(ws + O_WF); const GAS float* w = F.in(I_SWKVF); const GAS float* g = F.in(I_SNORM);
      for (int i = F.gtid; i < 12 * DM; i += F.ngt) { const int j = i / DM, k = i % DM; wf[i] = w[(size_t)k * 3084 + 3072 + j] * g[k]; } }
    { GAS float* spl = (GAS float*)(ws + O_SPL); const GAS float* lam = F.in(I_ALAMBDA);
      for (int i = F.gtid; i < LRU; i += F.ngt) { const float z = -lam[i]; spl[i] = fmaxf(z, 0.f) + log1p_pos(fast_exp(-fabsf(z))); } }
    if (F.gw == 0) {
        float m = 0.f; for (int d = F.lane; d < 128; d += 64) m = fmaxf(m, fabsf(F.in(I_BQNORM)[d] * F.in(I_SKNORM)[d]));
        m = wave_max(m);
        if (F.lane == 0) ((GAS float*)(ws + O_GG))[512] = 2.f * 11.3137085f * m + 30.f; }
    { GAS float* gg = (GAS float*)(ws + O_GG);
      for (int i = F.gtid; i < 384; i += F.ngt) { const int a = i / 128, d = i % 128;
          gg[a == 0 ? 384 + d : i] = a == 0 ? F.in(I_BQNORM)[d] * F.in(I_SKNORM)[d] : F.in(I_MQNORM)[(a - 1) * 128 + d] * F.in(I_MKNORM)[(a - 1) * 128 + d]; } }
    {
        const GAS float* xin = F.in(I_X) + F.lane * 4; GAS bf16_t* xo = (GAS bf16_t*)(ws + O_XS16) + F.lane * 4;
        const int mlast = F.gw + ((T - 1 - F.gw) / F.ngw) * F.ngw;
#define XN_LOAD(V, m_) do { const int mm_ = (m_) <= mlast ? (m_) : mlast; _Pragma("unroll") for (int j = 0; j < 8; ++j) V[j] = __builtin_nontemporal_load((const GAS f32x4*)(xin + (size_t)mm_ * DM + j * 256)); } while (0)
#define XN_PROC(V, m_) do { if ((m_) < T) { float s0 = 0.f; _Pragma("unroll") for (int j = 0; j < 8; ++j) s0 += (V[j][0] * V[j][0] + V[j][1] * V[j][1]) + (V[j][2] * V[j][2] + V[j][3] * V[j][3]); \
            const float r0 = rsqrtf(wave_sum(s0) * (1.f / DM) + EPS); \
            _Pragma("unroll") for (int j = 0; j < 8; ++j) { u32x2 a; a.x = cvtpk(V[j][0] * r0, V[j][1] * r0); a.y = cvtpk(V[j][2] * r0, V[j][3] * r0); *(GAS u32x2*)(xo + (size_t)(m_) * DM + j * 256) = a; } } } while (0)
        f32x4 va[8], vb[8];
        XN_LOAD(va, F.gw);
        for (int m = F.gw; m < T; m += 2 * F.ngw) { XN_LOAD(vb, m + F.ngw); XN_PROC(va, m); XN_LOAD(va, m + 2 * F.ngw); XN_PROC(vb, m + F.ngw); }
#undef XN_LOAD
#undef XN_PROC
    }
    for (int m = F.gw; m < 2 * NMROW; m += F.ngw) { const int l = m / NMROW, r = m % NMROW;
        norm_row_bf16(F.in(I_MEM) + (size_t)r * DM, F.in(I_MNORM) + l * DM, (GAS bf16_t*)(ws + O_MEMN) + (size_t)m * DM, F.lane); }
    convert_tables(F, 0, 0, 2 * NEXP, F.gw, F.ngw);
}
__device__ __forceinline__ void step_conv(Frame& F) {
    const GAS bf16_t* zx = (const GAS bf16_t*)(F.ws + O_ZX); GAS bf16_t* xc = (GAS bf16_t*)(F.ws + O_XC);
    const GAS float* cw = F.in(I_ACONVW); const GAS float* cb = F.in(I_ACONVB);
    constexpr int NIT = T * (LRU / 8);
#define CV_LOAD(W, it_) do { const int ii_ = (it_) < NIT ? (it_) : NIT - 1; const int t_ = ii_ / (LRU / 8), c8_ = (ii_ % (LRU / 8)) * 8, pos_ = t_ & (SEQ - 1); \
        _Pragma("unroll") for (int k = 0; k < 4; ++k) W[k] = (pos_ - 3 + k >= 0) ? *(const GAS u32x4*)(zx + (size_t)(t_ - 3 + k) * LRU + c8_) : (u32x4){0u, 0u, 0u, 0u}; } while (0)
#define CV_PROC(W, it_) do { if ((it_) < NIT) { const int t_ = (it_) / (LRU / 8), c8_ = ((it_) % (LRU / 8)) * 8; float a[8]; \
        { const f32x4 b0 = *(const GAS f32x4*)(cb + c8_), b1 = *(const GAS f32x4*)(cb + c8_ + 4); a[0] = b0[0]; a[1] = b0[1]; a[2] = b0[2]; a[3] = b0[3]; a[4] = b1[0]; a[5] = b1[1]; a[6] = b1[2]; a[7] = b1[3]; } \
        _Pragma("unroll") for (int k = 0; k < 4; ++k) { const f32x4 w0 = *(const GAS f32x4*)(cw + k * LRU + c8_), w1 = *(const GAS f32x4*)(cw + k * LRU + c8_ + 4); \
            a[0] = fmaf(w0[0], bf_lo(W[k].x), a[0]); a[1] = fmaf(w0[1], bf_hi(W[k].x), a[1]); a[2] = fmaf(w0[2], bf_lo(W[k].y), a[2]); a[3] = fmaf(w0[3], bf_hi(W[k].y), a[3]); \
            a[4] = fmaf(w1[0], bf_lo(W[k].z), a[4]); a[5] = fmaf(w1[1], bf_hi(W[k].z), a[5]); a[6] = fmaf(w1[2], bf_lo(W[k].w), a[6]); a[7] = fmaf(w1[3], bf_hi(W[k].w), a[7]); } \
        u32x4 o; o.x = cvtpk(a[0], a[1]); o.y = cvtpk(a[2], a[3]); o.z = cvtpk(a[4], a[5]); o.w = cvtpk(a[6], a[7]); \
        *(GAS u32x4*)(xc + (size_t)t_ * LRU + c8_) = o; } } while (0)
    u32x4 wa[4], wb[4];
    CV_LOAD(wa, F.gtid);
    for (int it = F.gtid; it < NIT; it += 2 * F.ngt) { CV_LOAD(wb, it + F.ngt); CV_PROC(wa, it); CV_LOAD(wa, it + 2 * F.ngt); CV_PROC(wb, it + F.ngt); }
#undef CV_LOAD
#undef CV_PROC
}
constexpr int SCK = 32, NCK = SEQ / SCK;
typedef _Float16 h8_t __attribute__((ext_vector_type(8)));
__device__ __forceinline__ void scan_load(const GAS _Float16* LA, const GAS _Float16* UH, size_t off, float (&a)[8], float (&u)[8]) {
    const h8_t l = *(const GAS h8_t*)(LA + off), w = *(const GAS h8_t*)(UH + off);
#pragma unroll
    for (int k = 0; k < 8; ++k) { a[k] = fast_exp((float)l[k]); u[k] = (float)w[k]; }
}
__device__ __forceinline__ void step_scan1(Frame& F) {
    const GAS _Float16* LA = (const GAS _Float16*)(F.ws + O_AA); const GAS _Float16* UH = (const GAS _Float16*)(F.ws + O_UU);
    GAS float* CA = (GAS float*)(F.ws + O_LOGFP); GAS float* CH = CA + (size_t)NB * NCK * LRU;
    if (F.tid >= 384) return;
    const int grp = F.tid / 192, th = F.tid % 192;
    for (int it = blockIdx.x * 2 + grp; it < NB * NCK; it += gridDim.x * 2) {
        const int b = it / NCK, ck = it % NCK; const size_t base = ((size_t)b * SEQ + ck * SCK) * LRU + th * 8;
        float ap[8], h[8];
#pragma unroll
        for (int k = 0; k < 8; ++k) { ap[k] = 1.f; h[k] = 0.f; }
#pragma unroll 8
        for (int i = 0; i < SCK; ++i) { float a[8], u[8]; scan_load(LA, UH, base + (size_t)i * LRU, a, u);
#pragma unroll
            for (int k = 0; k < 8; ++k) { ap[k] *= a[k]; h[k] = a[k] * h[k] + u[k]; } }
        GAS float* ca = CA + (size_t)it * LRU + th * 8; GAS float* ch = CH + (size_t)it * LRU + th * 8;
        *(GAS f32x4*)ca = (f32x4){ap[0], ap[1], ap[2], ap[3]}; *(GAS f32x4*)(ca + 4) = (f32x4){ap[4], ap[5], ap[6], ap[7]};
        *(GAS f32x4*)ch = (f32x4){h[0], h[1], h[2], h[3]}; *(GAS f32x4*)(ch + 4) = (f32x4){h[4], h[5], h[6], h[7]};
    }
}
__device__ __forceinline__ void step_scan2(Frame& F) {
    const GAS _Float16* LA = (const GAS _Float16*)(F.ws + O_AA); const GAS _Float16* UH = (const GAS _Float16*)(F.ws + O_UU);
    const GAS float* CA = (const GAS float*)(F.ws + O_LOGFP); const GAS float* CH = CA + (size_t)NB * NCK * LRU;
    const GAS bf16_t* gy = (const GAS bf16_t*)(F.ws + O_GY); GAS bf16_t* cat = (GAS bf16_t*)(F.ws + O_CAT);
    if (F.tid >= 384) return;
    const int grp = F.tid / 192, th = F.tid % 192;
    for (int it = blockIdx.x * 2 + grp; it < NB * NCK; it += gridDim.x * 2) {
        const int b = it / NCK, ck = it % NCK; const size_t base = ((size_t)b * SEQ + ck * SCK) * LRU + th * 8;
        float h[8];
#pragma unroll
        for (int k = 0; k < 8; ++k) h[k] = 0.f;
        for (int k2 = 0; k2 < ck; ++k2) { const size_t o = (size_t)(b * NCK + k2) * LRU + th * 8;
            const f32x4 a0 = *(const GAS f32x4*)(CA + o), a1 = *(const GAS f32x4*)(CA + o + 4), c0 = *(const GAS f32x4*)(CH + o), c1 = *(const GAS f32x4*)(CH + o + 4);
#pragma unroll
            for (int k = 0; k < 4; ++k) { h[k] = a0[k] * h[k] + c0[k]; h[4 + k] = a1[k] * h[4 + k] + c1[k]; } }
#pragma unroll 8
        for (int i = 0; i < SCK; ++i) { float a[8], u[8]; scan_load(LA, UH, base + (size_t)i * LRU, a, u);
            const size_t row = (size_t)b * SEQ + ck * SCK + i;
            const u32x4 g = *(const GAS u32x4*)(gy + row * LRU + th * 8); u32x4 o;
#pragma unroll
            for (int k = 0; k < 8; ++k) h[k] = a[k] * h[k] + u[k];
#pragma unroll
            for (int k = 0; k < 4; ++k) o[k] = cvtpk(h[2 * k] * bf_lo(g[k]), h[2 * k + 1] * bf_hi(g[k]));
            *(GAS u32x4*)(cat + row * DM + th * 8) = o; }
    }
}
__device__ __forceinline__ void step_cprefix(Frame& F, LAS unsigned char* lds) {
    const GAS float* lf = (const GAS float*)(F.ws + O_LOGF); GAS float* cc = (GAS float*)(F.ws + O_CC);
    LAS double* scr = (LAS double*)(lds + F.wave * 16384);
    for (int it = F.gw; it < NB * NH; it += F.ngw) {
        const GAS float* p = lf + (size_t)it * SEQ + F.lane * 64; GAS float* q = cc + (size_t)it * SEQ + F.lane * 64;
        double s = 0.0;
        for (int i = 0; i < 64; ++i) s += (double)p[i];
        scr[F.lane] = s;
        asm volatile("s_waitcnt lgkmcnt(0)" ::: "memory");
        double run = 0.0;
        for (int l = 0; l < 64; ++l) { const double v = scr[l]; if (l < F.lane) run += v; }
        for (int i = 0; i < 64; ++i) { run += (double)p[i]; q[i] = (float)run; }
        asm volatile("s_waitcnt lgkmcnt(0)" ::: "memory");
    }
}

__device__ __forceinline__ int ord_i(float f) { const int b = __float_as_int(f); return b ^ ((b >> 31) & 0x7fffffff); }
__device__ __forceinline__ float unord_f(int k) { return __int_as_float(k ^ ((k >> 31) & 0x7fffffff)); }
template <int N> __device__ __forceinline__ void bitonic_sort_desc(int (&a)[N]) {
#pragma unroll
    for (int k = 2; k <= N; k <<= 1) {
#pragma unroll
        for (int j = k >> 1; j > 0; j >>= 1) {
#pragma unroll
            for (int i = 0; i < N; ++i) { const int l = i ^ j;
                if (l > i) { const bool desc = ((i & k) == 0); const int mx = max(a[i], a[l]), mn = min(a[i], a[l]); a[i] = desc ? mx : mn; a[l] = desc ? mn : mx; } }
        }
    }
}
__device__ __forceinline__ void bitonic_merge16_desc(int (&a)[16]) {
#pragma unroll
    for (int j = 8; j > 0; j >>= 1) {
#pragma unroll
        for (int i = 0; i < 16; ++i) { const int l = i ^ j; if (l > i) { const int mx = max(a[i], a[l]), mn = min(a[i], a[l]); a[i] = mx; a[l] = mn; } }
    }
}
__device__ __forceinline__ void top16_of_64(int (&a)[64]) {
    int g[4][16];
#pragma unroll
    for (int q = 0; q < 4; ++q) {
#pragma unroll
        for (int i = 0; i < 16; ++i) g[q][i] = a[16 * q + i];
        bitonic_sort_desc<16>(g[q]); }
#pragma unroll
    for (int i = 0; i < 16; ++i) { g[0][i] = max(g[0][i], g[1][15 - i]); g[2][i] = max(g[2][i], g[3][15 - i]); }
    bitonic_merge16_desc(g[0]); bitonic_merge16_desc(g[2]);
#pragma unroll
    for (int i = 0; i < 16; ++i) g[0][i] = max(g[0][i], g[2][15 - i]);
    bitonic_merge16_desc(g[0]);
#pragma unroll
    for (int i = 0; i < 16; ++i) a[i] = g[0][i];
}
__device__ __forceinline__ void subkey_top16(const GAS bf16_t* qrow  , const GAS bf16_t* sk  , int r32, int hi, int (&top)[16]) {
    bf16x8 qf[8];
#pragma unroll
    for (int ks = 0; ks < 8; ++ks) qf[ks] = *(const GAS bf16x8*)(qrow + ks * 16 + hi * 8);
    unsigned loff = (unsigned)(r32 * 128 + hi * 8) * 2u; asm volatile("" : "+v"(loff));
    int key[64];
#pragma unroll
    for (int kb = 0; kb < 4; ++kb) {
        f32x16 acc = {};
#pragma unroll
        for (int ks = 0; ks < 8; ++ks) { const bf16x8 af = *(const GAS bf16x8*)((const GAS char*)(sk + kb * 32 * 128 + ks * 16) + loff);
            acc = __builtin_amdgcn_mfma_f32_32x32x16_bf16(af, qf[ks], acc, 0, 0, 0); }
#pragma unroll
        for (int r = 0; r < 16; ++r) { const int id = kb * 32 + (r & 3) + 8 * (r >> 2) + 4 * hi; key[kb * 16 + r] = (ord_i(acc[r]) & ~127) | (127 - id); }
        __builtin_amdgcn_sched_barrier(0);
    }
    top16_of_64(key);
#pragma unroll
    for (int i = 0; i < 16; ++i) { auto r = __builtin_amdgcn_permlane32_swap((unsigned)key[15 - i], (unsigned)key[15 - i], false, false);
        const int pk = hi ? (int)r[0] : (int)r[1]; top[i] = max(key[i], pk); }
    bitonic_merge16_desc(top);
}
__device__ __forceinline__ void step_topk(Frame& F, LAS unsigned char* lds, int layer) {
    const GAS bf16_t* q16 = (const GAS bf16_t*)(F.ws + O_Q16); const GAS bf16_t* subk = (const GAS bf16_t*)(F.ws + O_SUBK) + (size_t)layer * 16 * 128 * 128;
    GAS int* IDX = (GAS int*)(F.ws + O_IDX); GAS float* GW = (GAS float*)(F.ws + O_GW);
    LAS int* scr = (LAS int*)(lds + F.wave * 16384) + F.lane * 33;
    const int r32 = F.lane & 31, hi = F.lane >> 5;
    for (int task = F.gw; task < (T / 32) * 8; task += F.ngw) {
        const int tb = task >> 3, h = task & 7; const int tok = tb * 32 + r32;
        const GAS bf16_t* qrow = q16 + (size_t)tok * DM + h * 256;
        int ta[16], tb16[16];
        subkey_top16(qrow, subk + (size_t)(h * 2 + 0) * 128 * 128, r32, hi, ta);
        subkey_top16(qrow + 128, subk + (size_t)(h * 2 + 1) * 128 * 128, r32, hi, tb16);
        float va[16], vb[16];
#pragma unroll
        for (int i = 0; i < 16; ++i) { va[i] = unord_f(ta[i] & ~127); vb[i] = unord_f(tb16[i] & ~127); scr[i] = 127 - (ta[i] & 127); scr[16 + i] = 127 - (tb16[i] & 127); }
        int c2[64]; int n = 0;
#pragma unroll
        for (int i = 0; i < 16; ++i)
#pragma unroll
            for (int j = 0; j < 16; ++j) if ((i + 1) * (j + 1) <= 16) { c2[n] = (ord_i(va[i] + vb[j]) & ~255) | (255 - (i * 16 + j)); ++n; }
#pragma unroll
        for (int i = 50; i < 64; ++i) c2[i] = (int)0x80000000;
        top16_of_64(c2);
        asm volatile("s_waitcnt lgkmcnt(0)" ::: "memory");
        float sv[16], ex[16]; int ev[16]; float Z = 0.f;
#pragma unroll
        for (int r = 0; r < 16; ++r) { const int flat = 255 - (c2[r] & 255); sv[r] = unord_f(c2[r] & ~255); ev[r] = scr[flat >> 4] * 128 + scr[16 + (flat & 15)]; }
#pragma unroll
        for (int r = 0; r < 16; ++r) { ex[r] = fast_exp(sv[r] - sv[0]); Z += ex[r]; }
        const float iz = 1.f / Z;
        GAS int* ip = IDX + (size_t)tok * 128 + h * 16 + hi * 8; GAS float* gp = GW + (size_t)tok * 128 + h * 16 + hi * 8;
        int eo[8]; float go[8];
#pragma unroll
        for (int j = 0; j < 8; ++j) { eo[j] = hi ? ev[8 + j] : ev[j]; go[j] = (hi ? ex[8 + j] : ex[j]) * iz; }
        *(GAS u32x4*)ip = (u32x4){(unsigned)eo[0], (unsigned)eo[1], (unsigned)eo[2], (unsigned)eo[3]}; *(GAS u32x4*)(ip + 4) = (u32x4){(unsigned)eo[4], (unsigned)eo[5], (unsigned)eo[6], (unsigned)eo[7]};
        *(GAS f32x4*)gp = (f32x4){go[0], go[1], go[2], go[3]}; *(GAS f32x4*)(gp + 4) = (f32x4){go[4], go[5], go[6], go[7]};
        asm volatile("s_waitcnt lgkmcnt(0)" ::: "memory");
    }
}
__device__ __forceinline__ h2 as_h2(unsigned w) { return __builtin_bit_cast(h2, w); }
#define F4(W, s) __builtin_amdgcn_cvt_scalef32_pk_f16_fp4((W), 1.0f, (s))
#define H2F(us) ((float)__builtin_bit_cast(_Float16, (unsigned short)(us)))
__device__ __forceinline__ float sum8(float v) { v += dppf<0xB1>(v); v += dppf<0x4E>(v); v += dppf<0x141>(v); return v; }
__device__ __forceinline__ void step_xplanes(Frame& F) {
    const GAS bf16_t* xs = (const GAS bf16_t*)(F.ws + O_XS16); GAS unsigned char* x4 = F.ws + O_X4; GAS float* sx = (GAS float*)(F.ws + O_SX);
    const int tlast = F.gw + ((T - 1 - F.gw) / F.ngw) * F.ngw;
#define XP_LOAD(W, t_) do { const int tt_ = (t_) <= tlast ? (t_) : tlast; _Pragma("unroll") for (int c = 0; c < 4; ++c) W[c] = *(const GAS u32x4*)(xs + (size_t)tt_ * DM + F.lane * 32 + 8 * c); } while (0)
    u32x4 w[4], wn[4];
    XP_LOAD(w, F.gw);
    for (int t = F.gw; t < T; t += F.ngw) {
        XP_LOAD(wn, t + F.ngw);
        float xv[32]; float amax = 0.f;
#pragma unroll
        for (int c = 0; c < 4; ++c)
#pragma unroll
            for (int k = 0; k < 4; ++k) { xv[8 * c + 2 * k] = bf_lo(w[c][k]); xv[8 * c + 2 * k + 1] = bf_hi(w[c][k]); amax = fmaxf(amax, fmaxf(fabsf(xv[8 * c + 2 * k]), fabsf(xv[8 * c + 2 * k + 1]))); }
        amax = fmaxf(amax, dppf<0xB1>(amax)); amax = fmaxf(amax, dppf<0x4E>(amax)); amax = fmaxf(amax, dppf<0x141>(amax));
        const float sc = fmaxf(amax, 1e-20f) * (1.f / 119.f), qs = 1.f / sc;
        u32x4 hp, lp;
#pragma unroll
        for (int d = 0; d < 4; ++d) { unsigned hw = 0u, lw = 0u;
#pragma unroll
            for (int k = 0; k < 8; ++k) { const int q = (int)rintf(xv[8 * d + k] * qs); const int h = (q + 8) >> 4, l = q - 16 * h; hw |= (unsigned)(h & 15) << (4 * k); lw |= (unsigned)(l & 15) << (4 * k); }
            hp[d] = hw; lp[d] = lw; }
        *(GAS u32x4*)(x4 + ((size_t)t * 64 + F.lane) * 32) = hp; *(GAS u32x4*)(x4 + ((size_t)t * 64 + F.lane) * 32 + 16) = lp;
        if ((F.lane & 7) == 0) sx[(size_t)t * 8 + (F.lane >> 3)] = sc;
#pragma unroll
        for (int c = 0; c < 4; ++c) w[c] = wn[c];
    }
#undef XP_LOAD
}
__device__ __forceinline__ void step_upass(Frame& F, int layer, int G) {
    const int s = blockIdx.x & 7, wk = (blockIdx.x >> 3) * NWAVES + F.wave, nwk = (G >> 3) * NWAVES;
    const GAS unsigned char* UN = F.ws + O_TAB + (size_t)(layer * 2) * TAB_ONE + (size_t)s * NEXP * 128;
    const GAS int* IDX = (const GAS int*)(F.ws + O_IDX); const GAS unsigned char* x4 = F.ws + O_X4 + s * 256; const GAS float* sxp = (const GAS float*)(F.ws + O_SX) + s;
    GAS float* part = (GAS float*)(F.ws + O_PART) + (size_t)s * T * 128;
    unsigned lo = (unsigned)F.lane; asm volatile("" : "+v"(lo));
    const unsigned j = lo >> 3, p = lo & 7;
    const int tlast = wk + ((T - 1 - wk) / nwk) * nwk;
#define U_LOADID(ID, t_, q_) do { const int tt_ = (t_) <= tlast ? (t_) : tlast; _Pragma("unroll") for (int b = 0; b < 4; ++b) ID[b] = IDX[(size_t)tt_ * 128 + (q_) * 32 + 8 * b + j]; } while (0)
#define U_LOADX(t_) do { const int tt_ = (t_) <= tlast ? (t_) : tlast; xhn = *(const GAS u32x4*)(x4 + (size_t)tt_ * 2048 + p * 32); xln = *(const GAS u32x4*)(x4 + (size_t)tt_ * 2048 + p * 32 + 16); sxn = sxp[(size_t)tt_ * 8]; } while (0)
#define U_ISSUE(UB, ID) do { _Pragma("unroll") for (int b = 0; b < 4; ++b) UB[b] = *(const GAS u32x4*)(UN + (unsigned)(ID[b] * 128 + (int)p * 16)); } while (0)
#define U_QUARTER(UB, vout, q_) do { _Pragma("unroll") for (int b = 0; b < 4; ++b) { int ah = 0, al = 0; \
            ah = __builtin_amdgcn_sdot8((int)UB[b].x, (int)xh.x, ah, false); al = __builtin_amdgcn_sdot8((int)UB[b].x, (int)xl.x, al, false); \
            ah = __builtin_amdgcn_sdot8((int)UB[b].y, (int)xh.y, ah, false); al = __builtin_amdgcn_sdot8((int)UB[b].y, (int)xl.y, al, false); \
            ah = __builtin_amdgcn_sdot8((int)UB[b].z, (int)xh.z, ah, false); al = __builtin_amdgcn_sdot8((int)UB[b].z, (int)xl.z, al, false); \
            ah = __builtin_amdgcn_sdot8((int)UB[b].w, (int)xh.w, ah, false); al = __builtin_amdgcn_sdot8((int)UB[b].w, (int)xl.w, al, false); \
            const float d = sum8((float)(16 * ah + al)) * sxc; vout = (p == (unsigned)(4 * ((q_) & 1) + b)) ? d : vout; } } while (0)
    int idA[4], idB[4]; u32x4 u0[4], u1[4], u2[4], u3[4]; u32x4 xh, xl, xhn, xln; float sxc, sxn;
    U_LOADID(idA, wk, 0); U_LOADID(idB, wk, 1); U_LOADX(wk);
    U_ISSUE(u0, idA); U_LOADID(idA, wk, 2);
    U_ISSUE(u1, idB); U_LOADID(idB, wk, 3);
    U_ISSUE(u2, idA); U_LOADID(idA, wk + nwk, 0);
    xh = xhn; xl = xln; sxc = sxn;
    for (int t = wk; t < T; t += nwk) {
        float v0 = 0.f, v1 = 0.f;
        U_ISSUE(u3, idB); U_LOADID(idB, t + nwk, 1); U_LOADX(t + nwk);
        U_QUARTER(u0, v0, 0);
        U_ISSUE(u0, idA); U_LOADID(idA, t + nwk, 2);
        U_QUARTER(u1, v0, 1);
        U_ISSUE(u1, idB); U_LOADID(idB, t + nwk, 3);
        U_QUARTER(u2, v1, 2);
        U_ISSUE(u2, idA); U_LOADID(idA, t + 2 * nwk, 0);
        U_QUARTER(u3, v1, 3);
        part[(size_t)t * 128 + 8 * p + j] = v0; part[(size_t)t * 128 + 64 + 8 * p + j] = v1;
        xh = xhn; xl = xln; sxc = sxn;
    }
#undef U_LOADID
#undef U_LOADX
#undef U_ISSUE
#undef U_QUARTER
}
__device__ __forceinline__ void step_peer_reduce(Frame& F, int layer) {
    const GAS float* part = (const GAS float*)(F.ws + O_PART); const GAS float* GW = (const GAS float*)(F.ws + O_GW); const GAS int* IDX = (const GAS int*)(F.ws + O_IDX);
    const GAS float* rowss = (const GAS float*)(F.ws + O_ROWSS); GAS unsigned* PK = (GAS unsigned*)(F.ws + O_PK);
    const GAS unsigned char* SU = F.ws + O_TAB + (size_t)(layer * 2) * TAB_ONE + TAB_NIB; const GAS unsigned char* SV = SU + TAB_ONE;
    constexpr int NIT = T * 2;
    struct SA { int id; float gw, rs; float p[8]; }; struct SB { u32x4 su, sv; };
#define RA(X, it_) do { const int ii_ = (it_) < NIT ? (it_) : NIT - 1; const size_t i_ = (size_t)ii_ * 64 + F.lane; X.id = IDX[i_]; X.gw = GW[i_]; X.rs = rowss[(size_t)(ii_ >> 1) * 32 + (F.lane & 31)]; \
        _Pragma("unroll") for (int s = 0; s < 8; ++s) X.p[s] = part[(size_t)s * T * 128 + i_]; } while (0)
#define RB(Y, X) do { Y.su = *(const GAS u32x4*)(SU + (size_t)X.id * 16); Y.sv = *(const GAS u32x4*)(SV + (size_t)X.id * 16); } while (0)
#define RC(X, Y, it_) do { if ((it_) < NIT) { const size_t i_ = (size_t)(it_) * 64 + F.lane; const float r = rsqrtf(wave_sum(X.rs) * (0.5f / DM) + EPS); float d = 0.f; \
        _Pragma("unroll") for (int s = 0; s < 8; ++s) d += X.p[s] * (float)__builtin_bit_cast(_Float16, (unsigned short)(Y.su[s >> 1] >> (16 * (s & 1)))); \
        const float w = X.gw * gelu_tanh(d * r); \
        _Pragma("unroll") for (int s = 0; s < 8; ++s) { const _Float16 ws = (_Float16)(w * (float)__builtin_bit_cast(_Float16, (unsigned short)(Y.sv[s >> 1] >> (16 * (s & 1))))); \
            PK[(size_t)s * T * 128 + i_] = ((unsigned)X.id << 16) | (unsigned)__builtin_bit_cast(unsigned short, ws); } } } while (0)
    SA a0, a1, a2; SB b0, b1;
    RA(a0, F.gw); RA(a1, F.gw + F.ngw); RB(b0, a0);
    for (int it = F.gw; it < NIT; it += F.ngw) {
        RA(a2, it + 2 * F.ngw); RB(b1, a1);
        RC(a0, b0, it);
        a0 = a1; a1 = a2; b0 = b1;
    }
#undef RA
#undef RB
#undef RC
}
__device__ __forceinline__ void step_vpass(Frame& F, int layer, int G, bool dry) {
    const int s = blockIdx.x & 7, wk = (blockIdx.x >> 3) * NWAVES + F.wave, nwk = (G >> 3) * NWAVES;
    const GAS unsigned char* VN = F.ws + O_TAB + (size_t)(layer * 2 + 1) * TAB_ONE + (size_t)s * NEXP * 128;
    const GAS unsigned* PK = (const GAS unsigned*)(F.ws + O_PK) + (size_t)s * T * 128;
    GAS bf16_t* xs = (GAS bf16_t*)(F.ws + O_XS16); GAS float* rsp = (GAS float*)(F.ws + O_RSP);
    unsigned lo = (unsigned)F.lane; asm volatile("" : "+v"(lo));
    const unsigned j = lo >> 3, p = lo & 7;
    const int tlast = wk + ((T - 1 - wk) / nwk) * nwk;
#define V_LOADPK(PKV, t_, q_) do { const int tt_ = (t_) <= tlast ? (t_) : tlast; _Pragma("unroll") for (int b = 0; b < 4; ++b) PKV[b] = PK[(size_t)tt_ * 128 + (q_) * 32 + 8 * b + j]; } while (0)
#define V_ISSUE(VB, PKV) do { _Pragma("unroll") for (int b = 0; b < 4; ++b) VB[b] = *(const GAS u32x4*)(VN + ((PKV[b] >> 16) * 128u + p * 16u)); } while (0)
#define V_CVT4(W, base) do { c_[(base)] = F4(W, 0); c_[(base) + 1] = F4(W, 1); c_[(base) + 2] = F4(W, 2); c_[(base) + 3] = F4(W, 3); } while (0)
#define V_QUARTER(VB, PKV) do { _Pragma("unroll") for (int b = 0; b < 4; ++b) { const _Float16 wl = __builtin_bit_cast(_Float16, (unsigned short)(PKV[b] & 0xffffu)); const h2 wl2 = {wl, wl}; h2 c_[16]; \
            V_CVT4(VB[b].x, 0); V_CVT4(VB[b].y, 4); V_CVT4(VB[b].z, 8); V_CVT4(VB[b].w, 12); \
            __builtin_amdgcn_sched_barrier(0); \
            _Pragma("unroll") for (int k = 0; k < 16; ++k) oh[k] = wl2 * c_[k] + oh[k]; \
            __builtin_amdgcn_sched_barrier(0); } } while (0)
    unsigned pk0[4], pk1[4], pk2[4], pk3[4], pkn[4]; u32x4 v0[4], v1[4], v2[4], v3[4];
    V_LOADPK(pk0, wk, 0); V_LOADPK(pk1, wk, 1); V_LOADPK(pk2, wk, 2); V_LOADPK(pkn, wk, 3);
    V_ISSUE(v0, pk0); V_ISSUE(v1, pk1); V_ISSUE(v2, pk2);
    for (int t = wk; t < T; t += nwk) {
#pragma unroll
        for (int b = 0; b < 4; ++b) pk3[b] = pkn[b];
        V_ISSUE(v3, pk3); V_LOADPK(pkn, t + nwk, 0);
        GAS bf16_t* xb = xs + (size_t)t * DM + s * 256 + p * 32 + j * 4;
        f32x4 x2; { const u32x2 w = *(const GAS u32x2*)xb; x2 = (f32x4){bf_lo(w.x), bf_hi(w.x), bf_lo(w.y), bf_hi(w.y)}; }
        h2 oh[16];
#pragma unroll
        for (int i = 0; i < 16; ++i) oh[i] = (h2){(_Float16)0.f, (_Float16)0.f};
        V_QUARTER(v0, pk0);
#pragma unroll
        for (int b = 0; b < 4; ++b) pk0[b] = pkn[b];
        V_ISSUE(v0, pk0); V_LOADPK(pkn, t + nwk, 1);
        V_QUARTER(v1, pk1);
#pragma unroll
        for (int b = 0; b < 4; ++b) pk1[b] = pkn[b];
        V_ISSUE(v1, pk1); V_LOADPK(pkn, t + nwk, 2);
        V_QUARTER(v2, pk2);
#pragma unroll
        for (int b = 0; b < 4; ++b) pk2[b] = pkn[b];
        V_ISSUE(v2, pk2); V_LOADPK(pkn, t + nwk, 3);
        V_QUARTER(v3, pk3);
#pragma unroll
        for (int i = 0; i < 16; ++i) { unsigned u = __builtin_bit_cast(unsigned, oh[i]);
            h2 a = as_h2(u) + as_h2((unsigned)__builtin_amdgcn_update_dpp(0, (int)u, 0x128, 0xF, 0xF, true)); u = __builtin_bit_cast(unsigned, a);
            { auto r = __builtin_amdgcn_permlane16_swap(u, u, false, false); a = as_h2(r[0]) + as_h2(r[1]); u = __builtin_bit_cast(unsigned, a); }
            { auto r = __builtin_amdgcn_permlane32_swap(u, u, false, false); a = as_h2(r[0]) + as_h2(r[1]); }
            oh[i] = a; }
        h2 o0 = oh[0], o1 = oh[1];
#pragma unroll
        for (int c = 1; c < 8; ++c) { o0 = (j == (unsigned)c) ? oh[2 * c] : o0; o1 = (j == (unsigned)c) ? oh[2 * c + 1] : o1; }
        x2[0] += (float)o0.x; x2[1] += (float)o0.y; x2[2] += (float)o1.x; x2[3] += (float)o1.y;
        if (layer == 1 && !dry) *(GAS f32x4*)(F.out + (size_t)t * DM + s * 256 + p * 32 + j * 4) = x2;
        if (layer == 0 && !dry) {
            { u32x2 o; o.x = cvtpk(x2[0], x2[1]); o.y = cvtpk(x2[2], x2[3]); *(GAS u32x2*)xb = o; }
            const float sst = wave_sum((x2[0] * x2[0] + x2[1] * x2[1]) + (x2[2] * x2[2] + x2[3] * x2[3]));
            if (lo == 0) rsp[(size_t)t * 8 + s] = sst;
        }
    }
#undef V_LOADPK
#undef V_ISSUE
#undef V_CVT4
#undef V_QUARTER
}
#undef F4
#undef H2F
__device__ __forceinline__ void step_logf(Frame& F, LAS unsigned char* lds) {
    const GAS bf16_t* xs = (const GAS bf16_t*)(F.ws + O_XS16); const GAS float* rsp = (const GAS float*)(F.ws + O_RSP); GAS float* logf = (GAS float*)(F.ws + O_LOGF);
    const GAS float* wf = (const GAS float*)(F.ws + O_WF); LAS float* wl = (LAS float*)lds;
    for (int i = F.tid; i < NH * DM / 4; i += NTHREADS) *(LAS f32x4*)(wl + 4 * i) = *(const GAS f32x4*)(wf + 4 * i);
    __syncthreads();
    const int tlast = F.gw + ((T - 1 - F.gw) / F.ngw) * F.ngw;
    unsigned lo = (unsigned)F.lane; asm volatile("" : "+v"(lo));
#define LF_LOAD(W, Q, t_) do { const int tt_ = (t_) <= tlast ? (t_) : tlast; _Pragma("unroll") for (int c = 0; c < 8; ++c) W[c] = *(const GAS u32x2*)(xs + (size_t)tt_ * DM + c * 256 + lo * 4); Q = lo < 8 ? rsp[(size_t)tt_ * 8 + lo] : 0.f; } while (0)
    u32x2 w[8], wn[8]; float q, qn;
    LF_LOAD(w, q, F.gw);
    for (int t = F.gw; t < T; t += F.ngw) {
        LF_LOAD(wn, qn, t + F.ngw);
        asm volatile("" : "+v"(lo));
        const float r1 = rsqrtf(wave_sum(q) * (1.f / DM) + EPS);
        float mine = 0.f;
#pragma unroll 2
        for (int h = 0; h < NH; ++h) { float d = 0.f;
#pragma unroll
            for (int c = 0; c < 8; ++c) { const f32x4 g = *(const LAS f32x4*)(wl + h * DM + c * 256 + lo * 4);
                d += (bf_lo(w[c].x) * g[0] + bf_hi(w[c].x) * g[1]) + (bf_lo(w[c].y) * g[2] + bf_hi(w[c].y) * g[3]); }
            d = wave_sum(d); mine = (lo == (unsigned)h) ? d : mine; }
        if (lo < (unsigned)NH) { const float z = mine * r1 + F.in(I_SBF)[lo];
            logf[((size_t)(t / SEQ) * NH + lo) * SEQ + (t % SEQ)] = fminf(z, 0.f) - log1p_pos(fast_exp(-fabsf(z))); }
#pragma unroll
        for (int c = 0; c < 8; ++c) w[c] = wn[c];
        q = qn;
    }
#undef LF_LOAD
    __syncthreads();
}

#define XB_TMO      128
#define XB_XCNT(j)  (256  + 64 * (j))
#define XB_XSUB(j)  (1280 + 64 * (j))
#define XB_XGEN(j)  (2304 + 64 * (j))
#define XB_TOP      3328
#define XB_TOPGEN   3392
#define XCD_BAR_WORDS 3456
#define XB_SPIN_CAP (1u << 20)
__device__ __forceinline__ unsigned xb_ld(unsigned* p)              { return __hip_atomic_load(p, __ATOMIC_RELAXED, __HIP_MEMORY_SCOPE_AGENT); }
__device__ __forceinline__ unsigned xb_add(unsigned* p, unsigned v) { return __hip_atomic_fetch_add(p, v, __ATOMIC_RELAXED, __HIP_MEMORY_SCOPE_AGENT); }
__device__ __forceinline__ unsigned xb_xcc_id() { return (unsigned)__builtin_amdgcn_s_getreg((3 << 11) | 20) & 0xFu; }
#define XB_SPIN(cond, bar) do { unsigned _sp = 0; while (cond) { __builtin_amdgcn_s_sleep(1); \
    if ((++_sp & 255u) == 0u) { if (xb_ld(&(bar)[XB_TMO])) break; if (_sp > XB_SPIN_CAP) { atomicAdd(&(bar)[XB_TMO], 1u); break; } } } } while (0)
struct XcdBarrier { unsigned* bar; unsigned x; volatile LAS unsigned* st; };
__device__ __forceinline__ XcdBarrier xcd_barrier_post(unsigned* bar, volatile LAS unsigned* st) {
    XcdBarrier b; b.bar = bar; b.x = xb_xcc_id(); b.st = st;
    if (threadIdx.x == 0) (void)xb_add(&bar[XB_XCNT(b.x)], 1u);
    return b;
}
__device__ __forceinline__ void xcd_barrier_complete(unsigned* bar, unsigned x, unsigned& nloc, unsigned& nx) {
    const unsigned G = gridDim.x * gridDim.y * gridDim.z;
    unsigned sum, cnt, mine, sp = 0u;
    for (;;) {
        sum = 0u; cnt = 0u; mine = 0u;
#pragma unroll
        for (unsigned j = 0; j < 16; ++j) { const unsigned c = xb_ld(&bar[XB_XCNT(j)]); sum += c; cnt += (c > 0u) ? 1u : 0u; mine = (j == x) ? c : mine; }
        if (sum == G) break;
        __builtin_amdgcn_s_sleep(1);
        if ((++sp & 255u) == 0u) { if (xb_ld(&bar[XB_TMO])) break; if (sp > XB_SPIN_CAP) { atomicAdd(&bar[XB_TMO], 1u); break; } }
    }
    nloc = mine > 0u ? mine : 1u; nx = cnt > 0u ? cnt : 1u;
}
__device__ __forceinline__ void xcd_barrier(const XcdBarrier& b, int wave_s) {
    asm volatile("s_waitcnt vmcnt(0)" ::: "memory");
    __syncthreads();
    int ln_; asm volatile("v_mbcnt_lo_u32_b32 %0, -1, 0\n\tv_mbcnt_hi_u32_b32 %0, -1, %0" : "=v"(ln_));
    if (wave_s == 0 && ln_ == 0) {
        unsigned* bar = b.bar;
        __builtin_amdgcn_s_waitcnt(0);
        unsigned nloc = b.st[0], nx = b.st[1];
        if (nloc == 0u) { xcd_barrier_complete(bar, b.x, nloc, nx); b.st[0] = nloc; b.st[1] = nx; }
        const unsigned old = xb_add(&bar[XB_XSUB(b.x)], 1u);
        const unsigned gen = old / nloc;
        if (old + 1u == (gen + 1u) * nloc) {
            __builtin_amdgcn_fence(__ATOMIC_RELEASE, "agent");
            asm volatile("s_waitcnt vmcnt(0)" ::: "memory");
            const unsigned og = xb_add(&bar[XB_TOP], 1u);
            const unsigned tg = og / nx;
            if (og + 1u == (tg + 1u) * nx) xb_add(&bar[XB_TOPGEN], 1u);
            else XB_SPIN(xb_ld(&bar[XB_TOPGEN]) == tg, bar);
            __builtin_amdgcn_fence(__ATOMIC_ACQUIRE, "agent");
            xb_add(&bar[XB_XGEN(b.x)], 1u);
            asm volatile("s_waitcnt vmcnt(0)" ::: "memory");
        } else {
            XB_SPIN(xb_ld(&bar[XB_XGEN(b.x)]) == gen, bar);
            __builtin_amdgcn_fence(__ATOMIC_ACQUIRE, "agent");
            asm volatile("s_waitcnt vmcnt(0)" ::: "memory");
        }
    }
    __syncthreads();
}

constexpr int CONV1_SPLIT = 2 * 4608;
constexpr int BAR_LDS_OFF = 147456 - 64;
constexpr int LDS_BYTES = 147456;
enum { ST_PROLOGUE = 0, ST_G_IN0, ST_G_MKV0, ST_G_MKV1, ST_CONV, ST_G_GATE, ST_A_MEM0, ST_SCAN1, ST_SCAN2, ST_G_OUT0, ST_G_PQ0, ST_TOPK0, ST_UPASS0, ST_PRED0, ST_VPASS0,
       ST_G_L1, ST_CPREFIX, ST_A_FOX, ST_A_MEM1, ST_G_OUT1, ST_G_PQ1, ST_TOPK1, ST_UPASS1, ST_PRED1, ST_VPASS1, N_STEPS };
constexpr unsigned SYNC_AFTER = (1u << ST_PROLOGUE) | (1u << ST_G_MKV1) | (1u << ST_CONV) | (1u << ST_A_MEM0) | (1u << ST_SCAN1) | (1u << ST_SCAN2) | (1u << ST_G_OUT0) | (1u << ST_G_PQ0) |
                                (1u << ST_TOPK0) | (1u << ST_UPASS0) | (1u << ST_PRED0) | (1u << ST_VPASS0) | (1u << ST_G_L1) | (1u << ST_CPREFIX) | (1u << ST_A_MEM1) | (1u << ST_G_OUT1) | (1u << ST_G_PQ1) | (1u << ST_TOPK1) | (1u << ST_UPASS1) | (1u << ST_PRED1);
constexpr unsigned GEMM_STEPS = (1u << ST_G_IN0) | (1u << ST_G_MKV0) | (1u << ST_G_MKV1) | (1u << ST_G_GATE) | (1u << ST_G_OUT0) | (1u << ST_G_PQ0) | (1u << ST_G_L1) | (1u << ST_G_OUT1) | (1u << ST_G_PQ1);
constexpr unsigned ATTN_STEPS = (1u << ST_A_MEM0) | (1u << ST_A_FOX) | (1u << ST_A_MEM1);

struct Args { const float* in[N_IN]; float* out; unsigned char* ws; int lo, hi; };

__global__ void __launch_bounds__(NTHREADS, 2) yoco_fwd(Args args) {
    extern __shared__ __attribute__((aligned(16))) unsigned char lds[];
    volatile LAS unsigned* bst = (volatile LAS unsigned*)((LAS unsigned char*)lds + BAR_LDS_OFF);
    if (threadIdx.x == 0) { bst[0] = 0u; bst[1] = 0u; }
    __syncthreads();
    const XcdBarrier gbar = xcd_barrier_post((unsigned*)(args.ws + O_CTL), bst);
    const int G = gridDim.x;
    const int wave_s = __builtin_amdgcn_readfirstlane(threadIdx.x >> 6);
#ifndef DUP_MASK
#define DUP_MASK 0u
#endif
    for (int st = args.lo; st < args.hi; ++st) {
      const int nrep = ((DUP_MASK >> st) & 1u) ? 2 : 1;
      for (int rep = 0; rep < nrep; ++rep) {
        unsigned char* ws0 = args.ws; asm volatile("" : "+s"(ws0));
        GAS unsigned char* ws = (GAS unsigned char*)ws0;
#define LANE_ID(v) asm volatile("v_mbcnt_lo_u32_b32 %0, -1, 0\n\tv_mbcnt_hi_u32_b32 %0, -1, %0" : "=v"(v))
#define MAKE_TID(v) do { LANE_ID(v); v += wave_s * 64; } while (0)
#define MAKE_FRAME(F) Frame F; F.ws = ws; F.in_ = args.in; F.out = (GAS float*)args.out; { int t0_; MAKE_TID(t0_); F.tid = t0_; } F.lane = F.tid & 63; F.wave = wave_s; \
        F.gw = blockIdx.x * NWAVES + F.wave; F.ngw = gridDim.x * NWAVES; F.gtid = blockIdx.x * NTHREADS + F.tid; F.ngt = gridDim.x * NTHREADS
        if (st == ST_G_L1) { MAKE_FRAME(F); step_logf(F, (LAS unsigned char*)lds); }
        if ((GEMM_STEPS >> st) & 1u) {
            pg8::Gemm g; Epi E; E.ws = ws; E.resid = nullptr; E.outf = nullptr; E.o16 = nullptr; E.ssq = nullptr; E.gate_b = nullptr; int shift = 0;
            switch (st) {
            case ST_G_IN0:  g = {(const GAS bf16_t*)(ws + O_XS16), (const GAS bf16_t*)(ws + O_WIN0), T, NIN0, DM, DM, DM, 0}; E.mode = EM_IN0; break;
            case ST_G_MKV0: g = {(const GAS bf16_t*)(ws + O_MEMN), (const GAS bf16_t*)(ws + O_WMKV), NMROW, 1024, DM, DM, DM, 0}; E.mode = EM_MKV; E.o16 = (GAS bf16_t*)(ws + O_MKV); E.ssq = (GAS float*)(ws + O_MKSS); shift = 128; break;
            case ST_G_MKV1: g = {(const GAS bf16_t*)(ws + O_MEMN) + (size_t)NMROW * DM, (const GAS bf16_t*)(ws + O_WMKV) + (size_t)1024 * DM, NMROW, 1024, DM, DM, DM, 0}; E.mode = EM_MKV;
                            E.o16 = (GAS bf16_t*)(ws + O_MKV) + (size_t)NMROW * NL1; E.ssq = (GAS float*)(ws + O_MKSS) + NMROW * 112; shift = 144; break;
            case ST_G_GATE: g = {(const GAS bf16_t*)(ws + O_XC), (const GAS bf16_t*)(ws + O_WGATE), T, 12 * 256, 128, LRU, 128, 128}; E.mode = EM_GATE; E.gate_b = (const GAS float*)args.in[I_AGATEB]; break;
            case ST_G_OUT0: g = {(const GAS bf16_t*)(ws + O_CAT), (const GAS bf16_t*)(ws + O_WOUT0), T, DM, DM, DM, DM, 0}; E.mode = EM_RES; E.resid = (const GAS float*)args.in[I_X]; E.outf = (GAS float*)args.out; break;
            case ST_G_PQ0:  g = {(const GAS bf16_t*)(ws + O_XS16), (const GAS bf16_t*)(ws + O_WQ0), T, DM, DM, DM, DM, 0}; E.mode = EM_PQ; E.o16 = (GAS bf16_t*)(ws + O_Q16); break;
            case ST_G_L1:   g = {(const GAS bf16_t*)(ws + O_XS16), (const GAS bf16_t*)(ws + O_WL1), T, NL1, DM, DM, DM, 0}; E.mode = EM_L1; break;
            case ST_G_OUT1: g = {(const GAS bf16_t*)(ws + O_CAT), (const GAS bf16_t*)(ws + O_WOUT1), T, DM, DM, DM, DM, 0}; E.mode = EM_RES; E.resid = nullptr; break;
            default:        g = {(const GAS bf16_t*)(ws + O_XS16), (const GAS bf16_t*)(ws + O_WQ1), T, DM, DM, DM, DM, 0}; E.mode = EM_PQ; E.o16 = (GAS bf16_t*)(ws + O_Q16); break;
            }
            pg8::StaticOrder S; S.init(g.M, g.N, G, (int)((blockIdx.x + G - shift) % G));
#ifndef DIS_GEMM
            { int tg_; MAKE_TID(tg_);
              pg8::gemm_phase<Epi, false>((LAS unsigned char*)lds, g, S, E, tg_); }
#endif
            if (st == ST_G_MKV1 && blockIdx.x >= 160) { MAKE_FRAME(F); convert_tables(F, 1, 0, CONV1_SPLIT, (blockIdx.x - 160) * NWAVES + F.wave, (G - 160) * NWAVES); }
        } else if ((ATTN_STEPS >> st) & 1u) {
            const int nun = st == ST_A_FOX ? 3 : 1;
            for (int ui = 0; ui < nun; ++ui) {
                att::BlockRef r;
                if (st == ST_A_FOX) {
                    const int i = blockIdx.x, x = i & 15, bh = (i >> 4) + 16 * ui, qb = ui == 0 ? x : (ui == 1 ? 15 - x : ((x * 5 + 3) & 15));
                    const int b = bh / NH, h = bh % NH; const size_t row0 = (size_t)b * SEQ + qb * 256;
                    const GAS bf16_t* z = (const GAS bf16_t*)(ws + O_ZL1);
                    r.Q = z + row0 * NL1 + 3072 + h * 128; r.K = z + (size_t)b * SEQ * NL1 + h * 128; r.V = z + (size_t)b * SEQ * NL1 + 1536 + h * 128;
                    r.O = (GAS bf16_t*)(ws + O_CAT) + row0 * DM + h * 128;
                    const GAS float* ss = (const GAS float*)(ws + O_SSL1);
                    r.qss = ss + row0 * 112 + (12 + h) * 4; r.kss = ss + (size_t)b * SEQ * 112 + h * 4; r.cc = (const GAS float*)(ws + O_CC) + (size_t)bh * SEQ; r.gg = (const GAS float*)(ws + O_GG) + 384;
                    r.P0 = qb * 256; r.skv = SEQ;
                } else {
                    const int l = st == ST_A_MEM0 ? 0 : 1; const int i = blockIdx.x, qblk = i >> 2, h = i & 3, b = qblk >> 4; const size_t row0 = (size_t)qblk * 256;
                    r.Q = (const GAS bf16_t*)(ws + O_ZL1) + row0 * NL1 + 4608 + h * 128; r.qss = (const GAS float*)(ws + O_SSL1) + row0 * 112 + (24 + h) * 4;
                    const GAS bf16_t* kv = (const GAS bf16_t*)(ws + O_MKV) + ((size_t)l * NMROW + b * NMEM) * NL1;
                    r.K = kv + h * 128; r.V = kv + 512 + h * 128; r.kss = (const GAS float*)(ws + O_MKSS) + ((size_t)l * NMROW + b * NMEM) * 112 + h * 4;
                    r.O = (GAS bf16_t*)(ws + O_CAT) + row0 * DM + LRU + h * 128; r.cc = nullptr; r.gg = (const GAS float*)(ws + O_GG) + 128 * (1 + l);
                    r.P0 = SEQ; r.skv = NMEM;
                }
                att::Seam S;
                int tid_u; MAKE_TID(tid_u);
#ifndef DIS_ATTN
                att::attn_prime(r, (char*)lds, S, tid_u);
                att::attn_block(r, (char*)lds, S, tid_u);
#endif
            }
        } else {
            MAKE_FRAME(F);
            switch (st) {
#ifndef DIS_MISC
            case ST_PROLOGUE: step_prologue(F, (LAS unsigned char*)lds); break;
            case ST_CONV: step_conv(F); break;
            case ST_SCAN1: step_scan1(F); break;
            case ST_SCAN2: step_scan2(F); break;
#endif
#ifndef DIS_TOPK
            case ST_TOPK0: step_topk(F, (LAS unsigned char*)lds, 0); step_xplanes(F); break;
            case ST_TOPK1: step_topk(F, (LAS unsigned char*)lds, 1); step_xplanes(F); break;
#endif
#ifndef DIS_GATHER
            case ST_UPASS0: step_upass(F, 0, G); break;
            case ST_UPASS1: step_upass(F, 1, G); break;
            case ST_PRED0: step_peer_reduce(F, 0); break;
            case ST_PRED1: step_peer_reduce(F, 1); break;
            case ST_VPASS0: step_vpass(F, 0, G, rep + 1 < nrep); break;
            case ST_VPASS1: step_vpass(F, 1, G, rep + 1 < nrep); break;
#endif
#ifndef DIS_MISC
            case ST_CPREFIX: step_cprefix(F, (LAS unsigned char*)lds); convert_tables(F, 1, G > 160 ? CONV1_SPLIT : 0, 2 * NEXP, F.gw, F.ngw); break;
#endif
            default: break;
            }
        }
        if (rep + 1 < nrep) xcd_barrier(gbar, wave_s);
      }
        if (((SYNC_AFTER >> st) & 1u) && st + 1 < args.hi) xcd_barrier(gbar, wave_s);
    }
}

#ifndef N_LAUNCH_MODE
#define N_LAUNCH_MODE 1
#endif
extern "C" void kernel_launch(void* const* d_in, const int* in_sizes, int n_in, void* d_out, int out_size, void* d_ws, size_t ws_size, hipStream_t stream) {
    static int grid = 0;
    if (grid == 0) {
        if (n_in != N_IN || in_sizes[0] != T * DM || out_size != T * DM || ws_size < WS_END) {
            fprintf(stderr, "kernel_launch: unexpected shapes (n_in %d, in0 %d, out %d, ws %zu, need %zu)\n", n_in, n_in > 0 ? in_sizes[0] : -1, out_size, ws_size, (size_t)WS_END); grid = -1; return; }
        int dev = 0, cus = 0, per_cu = 0;
        hipGetDevice(&dev); hipDeviceGetAttribute(&cus, hipDeviceAttributeMultiprocessorCount, dev);
        hipFuncSetAttribute((const void*)yoco_fwd, hipFuncAttributeMaxDynamicSharedMemorySize, LDS_BYTES);
        hipOccupancyMaxActiveBlocksPerMultiprocessor(&per_cu, (const void*)yoco_fwd, NTHREADS, LDS_BYTES);
        if (per_cu < 1) { fprintf(stderr, "kernel_launch: occupancy query says %d blocks per CU\n", per_cu); grid = -1; return; }
        grid = cus - cus % 8;
        (void)hipGetLastError();
    }
    if (grid < 0) return;
    Args a{};
    for (int i = 0; i < N_IN; ++i) a.in[i] = (const float*)d_in[i];
    a.out = (float*)d_out; a.ws = (unsigned char*)d_ws;
    if (hipMemsetAsync((char*)d_ws + O_CTL, 0, 65536, stream) != hipSuccess) { fprintf(stderr, "kernel_launch: memset of the barrier words failed\n"); return; }
    if (N_LAUNCH_MODE == 1) {
        a.lo = 0; a.hi = N_STEPS;
        hipLaunchKernelGGL(yoco_fwd, dim3(grid), dim3(NTHREADS), LDS_BYTES, stream, a);
        hipError_t e = hipPeekAtLastError();
        if (e != hipSuccess) fprintf(stderr, "launch failed: %s (grid %d)\n", hipGetErrorString(e), grid);
    } else {
        int lo = 0;
        for (int s = 0; s < N_STEPS; ++s) {
            if (((SYNC_AFTER >> s) & 1u) || s == N_STEPS - 1) {
                a.lo = lo; a.hi = s + 1; lo = s + 1;
                void* params[] = {&a};
                hipError_t e = hipLaunchCooperativeKernel((const void*)yoco_fwd, dim3(grid), dim3(NTHREADS), params, LDS_BYTES, stream);
                if (e != hipSuccess) { fprintf(stderr, "launch failed: %s\n", hipGetErrorString(e)); break; }
            }
        }
    }
}
```

```cpp
#include <hip/hip_runtime.h>
#include <hip/hip_cooperative_groups.h>
#include <cstdio>
#include <cstdint>
namespace cg = cooperative_groups;

#define LAS __attribute__((address_space(3)))
#define GAS __attribute__((address_space(1)))
typedef unsigned short bf16_t;
typedef short bf16x8 __attribute__((ext_vector_type(8)));
typedef short s16x4 __attribute__((ext_vector_type(4)));
typedef float f32x4 __attribute__((ext_vector_type(4)));
typedef float f32x2 __attribute__((ext_vector_type(2)));
typedef float f32x16 __attribute__((ext_vector_type(16)));
typedef unsigned u32x4 __attribute__((ext_vector_type(4)));
typedef unsigned u32x2 __attribute__((ext_vector_type(2)));
typedef _Float16 h2 __attribute__((ext_vector_type(2)));

constexpr int NB = 4, SEQ = 4096, T = NB * SEQ, DM = 2048, LRU = 1536, MEMW = 512, NMEM = 256, NH = 12, HD = 128;
constexpr int NIN0 = 3584, NL1 = 5120, NEXP = 16384, NMROW = NB * NMEM;
constexpr float EPS = 1e-6f;
constexpr int NTHREADS = 512, NWAVES = 8;

constexpr size_t MiB = 1u << 20;
constexpr size_t O_CTL = 0;
constexpr size_t O_WIN0 = 1 * MiB;
constexpr size_t O_WOUT0 = O_WIN0 + 14 * MiB;
constexpr size_t O_WL1 = O_WOUT0 + 8 * MiB;
constexpr size_t O_WOUT1 = O_WL1 + 20 * MiB;
constexpr size_t O_WQ0 = O_WOUT1 + 8 * MiB;
constexpr size_t O_WQ1 = O_WQ0 + 8 * MiB;
constexpr size_t O_WMKV = O_WQ1 + 8 * MiB;
constexpr size_t O_WGATE = O_WMKV + 8 * MiB;
constexpr size_t O_SUBK = O_WGATE + 1 * MiB;
constexpr size_t O_WF = O_SUBK + 1 * MiB;
constexpr size_t O_SMALL = O_WF + 1 * MiB;
constexpr size_t O_RS1 = O_SMALL;
constexpr size_t O_LOGF = O_SMALL + 64 * 1024;
constexpr size_t O_CC = O_LOGF + 768 * 1024;
constexpr size_t O_GG = O_CC + 768 * 1024;
constexpr size_t O_SPL = O_GG + 4096;
constexpr size_t O_TSC = O_SPL + 8192;
constexpr size_t O_ROWSS = O_SMALL + 2 * MiB;
constexpr size_t O_RSP = O_ROWSS + 2 * MiB;
constexpr size_t O_QMSS = O_RSP;
constexpr size_t O_MKSS = O_QMSS + 1 * MiB;
constexpr size_t O_SSL1 = O_MKSS + 1 * MiB;
constexpr size_t O_CARRY = O_SSL1 + 7 * MiB;
constexpr size_t O_MEMN = O_CARRY + 3 * MiB;
constexpr size_t O_MKV = O_MEMN + 8 * MiB;
constexpr size_t O_IDX = O_MKV + 20 * MiB;
constexpr size_t O_GW = O_IDX + 8 * MiB;
constexpr size_t O_TAB = O_GW + 8 * MiB;
constexpr size_t TAB_NIB = (size_t)8 * 16384 * 128, TAB_ONE = TAB_NIB + (size_t)16384 * 16 + 786432;
constexpr size_t O_XS16 = O_TAB + 128 * MiB;
constexpr size_t O_CAT = O_XS16 + 64 * MiB;
constexpr size_t O_ZX = O_CAT + 64 * MiB;
constexpr size_t O_X8 = O_ZX;
constexpr size_t O_GY = O_ZX + 48 * MiB;
constexpr size_t O_LOGFP = O_GY + 48 * MiB;
constexpr size_t O_QM = O_LOGFP;
constexpr size_t O_XC = O_QM + 16 * MiB;
constexpr size_t O_X4 = O_XC;
constexpr size_t O_SX = O_XC + 32 * MiB;
constexpr size_t O_AA = O_XC + 48 * MiB;
constexpr size_t O_PART = O_AA;
constexpr size_t O_UU = O_AA + 96 * MiB;
constexpr size_t O_PK = O_UU;
constexpr size_t O_Q16 = O_UU + 96 * MiB;
constexpr size_t O_ZL1 = O_Q16 + 64 * MiB;
constexpr size_t WS_END = O_ZL1 + 160 * MiB;
static_assert(WS_END <= 1024 * MiB, "workspace map");

__device__ __forceinline__ unsigned cvtpk(float lo, float hi) { unsigned r; asm volatile("v_cvt_pk_bf16_f32 %0, %1, %2" : "=v"(r) : "v"(lo), "v"(hi)); return r; }
__device__ __forceinline__ float bf_lo(unsigned w) { return __uint_as_float(w << 16); }
__device__ __forceinline__ float bf_hi(unsigned w) { return __uint_as_float(w & 0xffff0000u); }
__device__ __forceinline__ float fast_exp(float x) { return __builtin_amdgcn_exp2f(x * 1.4426950408889634f); }
__device__ __forceinline__ float log1p_pos(float y) { const float ser = y * (1.f - y * (0.5f - y * (0.33333334f - 0.25f * y))); const float lg = __builtin_amdgcn_logf(1.f + y) * 0.6931471805599453f; return y < 0.03f ? ser : lg; }
__device__ __forceinline__ float one_minus_exp(float x) { const float ser = -x * (1.f + x * (0.5f + x * (0.16666667f + x * 0.041666668f))); const float big = 1.f - fast_exp(x); return x > -0.03f ? ser : big; }
__device__ __forceinline__ float sigmoidf_(float x) { return __builtin_amdgcn_rcpf(1.f + fast_exp(-x)); }
__device__ __forceinline__ float gelu_tanh(float x) { const float u = x * (1.f + 0.044715f * x * x); return x * __builtin_amdgcn_rcpf(1.f + __builtin_amdgcn_exp2f(u * (-2.f * 0.7978845608028654f * 1.4426950408889634f))); }
template <int CTRL> __device__ __forceinline__ float dppf(float v) { return __int_as_float(__builtin_amdgcn_update_dpp(0, __float_as_int(v), CTRL, 0xF, 0xF, true)); }
__device__ __forceinline__ float xsum16(float v) { auto r = __builtin_amdgcn_permlane16_swap(__float_as_uint(v), __float_as_uint(v), false, false); return __uint_as_float(r[0]) + __uint_as_float(r[1]); }
__device__ __forceinline__ float xsum32(float v) { auto r = __builtin_amdgcn_permlane32_swap(__float_as_uint(v), __float_as_uint(v), false, false); return __uint_as_float(r[0]) + __uint_as_float(r[1]); }
__device__ __forceinline__ float xmax16(float v) { auto r = __builtin_amdgcn_permlane16_swap(__float_as_uint(v), __float_as_uint(v), false, false); return fmaxf(__uint_as_float(r[0]), __uint_as_float(r[1])); }
__device__ __forceinline__ float xmax32(float v) { auto r = __builtin_amdgcn_permlane32_swap(__float_as_uint(v), __float_as_uint(v), false, false); return fmaxf(__uint_as_float(r[0]), __uint_as_float(r[1])); }
__device__ __forceinline__ float wave_sum(float v) {
    v += dppf<0xB1>(v); v += dppf<0x4E>(v); v += dppf<0x141>(v); v += dppf<0x140>(v);
    v = xsum16(v); v = xsum32(v); return v;
}
__device__ __forceinline__ float wave_max(float v) {
    v = fmaxf(v, dppf<0xB1>(v)); v = fmaxf(v, dppf<0x4E>(v)); v = fmaxf(v, dppf<0x141>(v)); v = fmaxf(v, dppf<0x140>(v));
    v = xmax16(v); v = xmax32(v); return v;
}

namespace pg8 {
constexpr int BM = 256, BK = 64, HALF = 128, HTB = HALF * BK * 2, STAGE_BYTES = 8 * HTB, NXCD = 8, WGM = 8;
__host__ __device__ __forceinline__ int lds_byte(int r, int c) { const int st = (r >> 4) * 2 + (c >> 5), rr = r & 15, cc = c & 31, ob = rr * 64 + cc * 2; return st * 1024 + (ob ^ (((ob >> 9) & 1) << 5)); }
__host__ __device__ __forceinline__ void stage_rc(int b, int& R, int& C) { const int st = b / 1024, sb = b % 1024, swz = sb ^ (((sb >> 9) & 1) << 5); R = (st >> 1) * 16 + swz / 64; C = (st & 1) * 32 + (swz % 64) / 2; }
__host__ __device__ __forceinline__ int perm32(int rho) { const int n = rho >> 4, i = rho & 15; return 8 * (i >> 2) + 4 * n + (i & 3); }

struct Unit { int pm, pn; };
struct Gemm { const GAS bf16_t* A; const GAS bf16_t* Bt; int M, N, K, lda, ldb, acol; };

struct StaticOrder {
    int nM, nN, nwg, G, c;
    __device__ void init(int M, int N, int G_, int c_) { nM = M / BM; nN = N / BM; nwg = nM * nN; G = G_; c = c_; }
    __device__ bool next(int i, Unit& u) const {
        const long L = (long)i * G + c; if (L >= nwg) return false;
        int wgid = (int)L; { const int q = nwg / NXCD, r = nwg % NXCD, xcd = wgid % NXCD, off = wgid / NXCD; wgid = (xcd < r ? xcd * (q + 1) : r * (q + 1) + (xcd - r) * q) + off; }
        const int nig = WGM * nN, gid = wgid / nig, fm = gid * WGM, gsz = (nM - fm) < WGM ? (nM - fm) : WGM;
        u.pm = fm + ((wgid % nig) % gsz); u.pn = (wgid % nig) / gsz; return true;
    }
};

typedef int v8i_t __attribute__((ext_vector_type(8)));
typedef int v4i_t __attribute__((ext_vector_type(4)));
template <class Epi, bool FP8>
__device__ __forceinline__ void gemm_phase(LAS unsigned char* lds, const Gemm g, const StaticOrder& S, const Epi& E, const int tid) {
    const int wid = __builtin_amdgcn_readfirstlane(tid >> 6), lane = tid & 63, wr = wid >> 2, wc = wid & 3, fr = lane & 15, fq = lane >> 4;
    const int K = g.K, nt = K / BK;
    unsigned voffA[2], voffB[2];
#pragma unroll
    for (int i = 0; i < 2; ++i) { int R, C; stage_rc(tid * 16 + i * 8192, R, C); const int Rb = (R & ~31) + perm32(R & 31);
        voffA[i] = (unsigned)(R * g.lda + C) * 2u; voffB[i] = (unsigned)(Rb * g.ldb + C) * 2u; }
    const size_t kstep = (size_t)(BK * 2);
    const size_t hstepA = (size_t)HALF * g.lda * 2, hstepB = (size_t)HALF * g.ldb * 2;
    const size_t tstepA = 2 * hstepA, tstepB = 2 * hstepB;
    const unsigned ldsw = (unsigned)wid * 1024u;
    const int aoff = lds_byte(wr * 64 + fr, fq * 8), boff = lds_byte(wc * 32 + fr, fq * 8);
#define PG8_SA(b, h) (((b) * 2 + (h)) * HTB)
#define PG8_SB(b, h) ((4 + (b) * 2 + (h)) * HTB)
#define PG8_STAGE(bufoff, gbase, voff) do { _Pragma("unroll") for (int _i = 0; _i < 2; ++_i) \
        __builtin_amdgcn_global_load_lds((const GAS unsigned*)((gbase) + (voff)[_i]), (LAS unsigned*)(lds + (bufoff) + ldsw + _i * 8192), 16, 0, 0); } while (0)
#define PG8_LD2(dst, off_) do { const u32x4 lo_ = *(const LAS u32x4*)(lds + (off_)), hi_ = *(const LAS u32x4*)(lds + (off_) + 1024); \
        dst = (v8i_t){(int)lo_.x, (int)lo_.y, (int)lo_.z, (int)lo_.w, (int)hi_.x, (int)hi_.y, (int)hi_.z, (int)hi_.w}; } while (0)
#define PG8_LDA(dst, b, h) do { _Pragma("unroll") for (int m = 0; m < 4; ++m) PG8_LD2(dst[m], PG8_SA(b, h) + aoff + m * 2048); } while (0)
#define PG8_LDB(dst, b, h) do { _Pragma("unroll") for (int n = 0; n < 2; ++n) PG8_LD2(dst[n], PG8_SB(b, h) + boff + n * 2048); } while (0)
#define PG8_HALF(v, k) ((k) ? __builtin_shufflevector(v, v, 4, 5, 6, 7) : __builtin_shufflevector(v, v, 0, 1, 2, 3))
#define PG8_MMA(ai, bj, At, Bt) do { __builtin_amdgcn_s_setprio(1); _Pragma("unroll") for (int m = 0; m < 4; ++m) _Pragma("unroll") for (int n = 0; n < 2; ++n) { \
        if constexpr (FP8) asm volatile("v_mfma_scale_f32_16x16x128_f8f6f4 %0, %1, %2, %0, %3, %4 op_sel_hi:[0,0,0]" : "+v"(acc[ai][bj][m][n]) : "v"(Bt[n]), "v"(At[m]), "v"(sc_w), "v"(sc_x));     \
        else { _Pragma("unroll") for (int k = 0; k < 2; ++k) { const v4i_t bh_ = PG8_HALF(Bt[n], k), ah_ = PG8_HALF(At[m], k); \
                acc[ai][bj][m][n] = __builtin_amdgcn_mfma_f32_16x16x32_bf16(__builtin_bit_cast(bf16x8, bh_), __builtin_bit_cast(bf16x8, ah_), acc[ai][bj][m][n], 0, 0, 0); } } } \
        __builtin_amdgcn_s_setprio(0); } while (0)
#define PG8_WAIT_V(n) asm volatile("s_waitcnt vmcnt(" #n ")" ::: "memory")
#define PG8_WAIT_L(n) asm volatile("s_waitcnt lgkmcnt(" #n ")" ::: "memory")
#define PG8_BAR __builtin_amdgcn_s_barrier()
#define PG8_SCHED __builtin_amdgcn_sched_barrier(0)
    Unit cur, nxt; int ui = 0;
    if (!S.next(0, cur)) return;
    f32x4 acc[2][2][4][2];
#pragma unroll
    for (int a = 0; a < 2; ++a)
#pragma unroll
        for (int b = 0; b < 2; ++b)
#pragma unroll
            for (int m = 0; m < 4; ++m)
#pragma unroll
                for (int n = 0; n < 2; ++n) acc[a][b][m][n] = (f32x4){0.f, 0.f, 0.f, 0.f};
    v8i_t At[4], B0[2], B1[2];
    const int sc_w = 121, sc_x = 127;
    const GAS char* cA = (const GAS char*)g.A + (size_t)cur.pm * tstepA + (size_t)cur.pn * g.acol * 2; const GAS char* cB = (const GAS char*)g.Bt + (size_t)cur.pn * tstepB;
    PG8_STAGE(PG8_SB(0, 0), cB, voffB); PG8_STAGE(PG8_SB(0, 1), cB + hstepB, voffB); PG8_STAGE(PG8_SA(0, 0), cA, voffA); PG8_STAGE(PG8_SA(0, 1), cA + hstepA, voffA);
    if (wr == 1) PG8_BAR;
    PG8_WAIT_V(2); PG8_BAR;
    PG8_STAGE(PG8_SB(1, 0), cB + kstep, voffB); PG8_STAGE(PG8_SA(1, 0), cA + kstep, voffA); PG8_STAGE(PG8_SB(1, 1), cB + hstepB + kstep, voffB);
    PG8_WAIT_V(6); PG8_BAR;
    for (;;) {
        const bool has_next = S.next(ui + 1, nxt);
        const GAS char* nA = has_next ? (const GAS char*)g.A + (size_t)nxt.pm * tstepA + (size_t)nxt.pn * g.acol * 2 : cA; const GAS char* nB = has_next ? (const GAS char*)g.Bt + (size_t)nxt.pn * tstepB : cB;
        for (int t = 0; t < nt; t += 2) {
            const bool last = (t == nt - 2);
            const GAS char* a1 = cA + (size_t)(t + 1) * kstep;
            const GAS char* a2 = last ? nA : cA + (size_t)(t + 2) * kstep; const GAS char* b2 = last ? nB : cB + (size_t)(t + 2) * kstep;
            const GAS char* a3 = a2 + kstep; const GAS char* b3 = b2 + kstep;
            PG8_LDB(B0, 0, 0); PG8_LDB(B1, 0, 1); PG8_SCHED; PG8_LDA(At, 0, 0); PG8_STAGE(PG8_SA(1, 1), a1 + hstepA, voffA);
            PG8_WAIT_V(8); PG8_WAIT_L(0); PG8_BAR; PG8_MMA(0, 0, At, B0); PG8_MMA(0, 1, At, B1); PG8_BAR; PG8_SCHED;
            PG8_LDA(At, 0, 1); PG8_STAGE(PG8_SB(0, 0), b2, voffB); PG8_STAGE(PG8_SB(0, 1), b2 + hstepB, voffB); PG8_STAGE(PG8_SA(0, 0), a2, voffA);
            PG8_WAIT_V(8); PG8_WAIT_L(0); PG8_BAR; PG8_MMA(1, 0, At, B0); PG8_MMA(1, 1, At, B1); PG8_BAR; PG8_SCHED;
            PG8_LDB(B0, 1, 0); PG8_LDB(B1, 1, 1); PG8_SCHED; PG8_LDA(At, 1, 0); PG8_STAGE(PG8_SA(0, 1), a2 + hstepA, voffA);
            PG8_WAIT_V(8); PG8_WAIT_L(0); PG8_BAR; PG8_MMA(0, 0, At, B0); PG8_MMA(0, 1, At, B1); PG8_BAR; PG8_SCHED;
            PG8_LDA(At, 1, 1); PG8_STAGE(PG8_SB(1, 0), b3, voffB); PG8_STAGE(PG8_SB(1, 1), b3 + hstepB, voffB); PG8_STAGE(PG8_SA(1, 0), a3, voffA);
            PG8_WAIT_V(8); PG8_WAIT_L(0); PG8_BAR; PG8_MMA(1, 0, At, B0); PG8_MMA(1, 1, At, B1); PG8_BAR; PG8_SCHED;
        }
        if (wr == 0) PG8_BAR;
        { int ln_; asm volatile("v_mbcnt_lo_u32_b32 %0, -1, 0\n\tv_mbcnt_hi_u32_b32 %0, -1, %0" : "=v"(ln_));
          E(acc, cur, wr, wc, ln_ & 15, ln_ >> 4); }
        if (!has_next) break;
#pragma unroll
        for (int a = 0; a < 2; ++a)
#pragma unroll
            for (int b = 0; b < 2; ++b)
#pragma unroll
                for (int m = 0; m < 4; ++m)
#pragma unroll
                    for (int n = 0; n < 2; ++n) acc[a][b][m][n] = (f32x4){0.f, 0.f, 0.f, 0.f};
        cur = nxt; cA = nA; cB = nB; ++ui;
        if (wr == 1) PG8_BAR;
    }
    PG8_WAIT_V(0);
    PG8_BAR;
#undef PG8_SA
#undef PG8_SB
#undef PG8_STAGE
#undef PG8_LDA
#undef PG8_LDB
#undef PG8_LD2
#undef PG8_HALF
#undef PG8_MMA
#undef PG8_WAIT_V
#undef PG8_WAIT_L
#undef PG8_BAR
#undef PG8_SCHED
}
}

enum { EM_IN0 = 0, EM_MKV = 1, EM_GATE = 2, EM_RES = 3, EM_PQ = 4, EM_L1 = 5 };
struct Epi {
    int mode;
    GAS unsigned char* ws;
    const GAS float* resid;
    GAS float* outf;
    GAS bf16_t* o16;
    GAS float* ssq;
    const GAS float* gate_b;
    typedef pg8::Unit Unit;
    __device__ __forceinline__ static void st8(GAS bf16_t* p, f32x4 v0, f32x4 v1) {
        u32x4 w; w.x = cvtpk(v0[0], v0[1]); w.y = cvtpk(v0[2], v0[3]); w.z = cvtpk(v1[0], v1[1]); w.w = cvtpk(v1[2], v1[3]); *(GAS u32x4*)p = w; }
    __device__ __forceinline__ static float sq8(f32x4 a, f32x4 b) { return (a[0] * a[0] + a[1] * a[1]) + (a[2] * a[2] + a[3] * a[3]) + (b[0] * b[0] + b[1] * b[1]) + (b[2] * b[2] + b[3] * b[3]); }
    __device__ __forceinline__ void operator()(f32x4 (&acc)[2][2][4][2], const Unit& u, int wr, int wc, int fr, int fq) const {
        const int row0 = u.pm * 256 + wr * 64 + fr;
        const int cin = wc * 32 + 8 * fq;
        if (mode == EM_IN0) {
            GAS bf16_t* base; int ld, colt; int kind;
            if (u.pn < 6) { base = (GAS bf16_t*)(ws + O_ZX); ld = LRU; colt = u.pn * 256; kind = 0; }
            else if (u.pn < 12) { base = (GAS bf16_t*)(ws + O_GY); ld = LRU; colt = (u.pn - 6) * 256; kind = 1; }
            else { base = (GAS bf16_t*)(ws + O_ZL1); ld = NL1; colt = 4608 + (u.pn - 12) * 256; kind = 2; }
            GAS float* qmss = (GAS float*)(ws + O_SSL1);
#pragma unroll
            for (int ai = 0; ai < 2; ++ai)
#pragma unroll
                for (int m = 0; m < 4; ++m) { const int row = row0 + ai * 128 + m * 16;
#pragma unroll
                    for (int bj = 0; bj < 2; ++bj) { f32x4 v0 = acc[ai][bj][m][0], v1 = acc[ai][bj][m][1];
                        if (kind == 1) {
#pragma unroll
                            for (int j = 0; j < 4; ++j) { v0[j] = gelu_tanh(v0[j]); v1[j] = gelu_tanh(v1[j]); } }
                        st8(base + (size_t)row * ld + colt + bj * 128 + cin, v0, v1);
                        if (kind == 2) { float s = sq8(v0, v1); s = xsum16(s); s = xsum32(s);
                            if (fq == 0) qmss[(size_t)row * 112 + (24 + (u.pn - 12) * 2 + bj) * 4 + wc] = s; } } }
        } else if (mode == EM_MKV) {
#pragma unroll
            for (int ai = 0; ai < 2; ++ai)
#pragma unroll
                for (int m = 0; m < 4; ++m) { const int row = row0 + ai * 128 + m * 16;
#pragma unroll
                    for (int bj = 0; bj < 2; ++bj) { const f32x4 v0 = acc[ai][bj][m][0], v1 = acc[ai][bj][m][1];
                        st8(o16 + (size_t)row * NL1 + u.pn * 256 + bj * 128 + cin, v0, v1);
                        if (u.pn < 2) { float s = sq8(v0, v1); s = xsum16(s); s = xsum32(s);
                            if (fq == 0) ssq[(size_t)row * 112 + (u.pn * 2 + bj) * 4 + wc] = s; } } }
        } else if (mode == EM_GATE) {
            const int ch = u.pn * 128 + cin;
            const GAS bf16_t* xc = (const GAS bf16_t*)(ws + O_XC); GAS _Float16* LA = (GAS _Float16*)(ws + O_AA); GAS _Float16* UH = (GAS _Float16*)(ws + O_UU);
            const GAS float* spl = (const GAS float*)(ws + O_SPL) + ch; const GAS float* gb = gate_b + u.pn * 256 + cin;
#pragma unroll
            for (int n = 0; n < 2; ++n) {
                const f32x4 sp = *(const GAS f32x4*)(spl + 4 * n), br = *(const GAS f32x4*)(gb + 4 * n), bi = *(const GAS f32x4*)(gb + 128 + 4 * n);
#pragma unroll
                for (int ai = 0; ai < 2; ++ai)
#pragma unroll
                    for (int m = 0; m < 4; ++m) { const int row = row0 + ai * 128 + m * 16;
                        const u32x2 xw = *(const GAS u32x2*)(xc + (size_t)row * LRU + ch + 4 * n);
                        const f32x4 xv = {bf_lo(xw.x), bf_hi(xw.x), bf_lo(xw.y), bf_hi(xw.y)};
                        float lav[4], uvv[4];
#pragma unroll
                        for (int j = 0; j < 4; ++j) { const float r = sigmoidf_(acc[ai][0][m][n][j] + br[j]), ig = sigmoidf_(acc[ai][1][m][n][j] + bi[j]);
                            const float la = -8.f * r * sp[j];
                            lav[j] = la; uvv[j] = __builtin_amdgcn_sqrtf(one_minus_exp(2.f * la)) * (ig * xv[j]); }
                        { const h2 l0 = {(_Float16)lav[0], (_Float16)lav[1]}, l1 = {(_Float16)lav[2], (_Float16)lav[3]}, u0 = {(_Float16)uvv[0], (_Float16)uvv[1]}, u1 = {(_Float16)uvv[2], (_Float16)uvv[3]};
                          *(GAS u32x2*)(LA + (size_t)row * LRU + ch + 4 * n) = (u32x2){__builtin_bit_cast(unsigned, l0), __builtin_bit_cast(unsigned, l1)};
                          *(GAS u32x2*)(UH + (size_t)row * LRU + ch + 4 * n) = (u32x2){__builtin_bit_cast(unsigned, u0), __builtin_bit_cast(unsigned, u1)}; } }
            }
        } else if (mode == EM_RES) {
            GAS bf16_t* xs = (GAS bf16_t*)(ws + O_XS16); GAS float* rowss = (GAS float*)(ws + O_ROWSS);
#pragma unroll
            for (int ai = 0; ai < 2; ++ai)
#pragma unroll
                for (int m = 0; m < 4; ++m) { const int row = row0 + ai * 128 + m * 16; float s = 0.f;
#pragma unroll
                    for (int bj = 0; bj < 2; ++bj) { const size_t off = (size_t)row * DM + u.pn * 256 + bj * 128 + cin;
                        f32x4 r0, r1;
                        if (resid) { r0 = *(const GAS f32x4*)(resid + off); r1 = *(const GAS f32x4*)(resid + off + 4); }
                        else { const u32x4 w = *(const GAS u32x4*)(xs + off); r0 = (f32x4){bf_lo(w.x), bf_hi(w.x), bf_lo(w.y), bf_hi(w.y)}; r1 = (f32x4){bf_lo(w.z), bf_hi(w.z), bf_lo(w.w), bf_hi(w.w)}; }
                        const f32x4 v0 = acc[ai][bj][m][0] + r0, v1 = acc[ai][bj][m][1] + r1;
                        st8(xs + off, v0, v1); s += sq8(v0, v1); }
                    s = xsum16(s); s = xsum32(s);
                    if (fq == 0) rowss[(size_t)row * 32 + u.pn * 4 + wc] = s; }
        } else if (mode == EM_PQ) {
            const GAS float* rowss = (const GAS float*)(ws + O_ROWSS);
#pragma unroll
            for (int ai = 0; ai < 2; ++ai)
#pragma unroll
                for (int m = 0; m < 4; ++m) { const int row = row0 + ai * 128 + m * 16;
                    const f32x4 p0 = *(const GAS f32x4*)(rowss + (size_t)row * 32 + fq * 8), p1 = *(const GAS f32x4*)(rowss + (size_t)row * 32 + fq * 8 + 4);
                    float s = (p0[0] + p0[1]) + (p0[2] + p0[3]) + (p1[0] + p1[1]) + (p1[2] + p1[3]); s = xsum16(s); s = xsum32(s);
                    const float r = rsqrtf(s * (1.f / DM) + EPS);
#pragma unroll
                    for (int bj = 0; bj < 2; ++bj) st8(o16 + (size_t)row * DM + u.pn * 256 + bj * 128 + cin, acc[ai][bj][m][0] * r, acc[ai][bj][m][1] * r); }
        } else {
            const GAS float* rsp = (const GAS float*)(ws + O_RSP); GAS bf16_t* zl1 = (GAS bf16_t*)(ws + O_ZL1); GAS float* ssl1 = (GAS float*)(ws + O_SSL1);
            const int slot0 = u.pn < 6 ? u.pn * 2 : (u.pn >= 12 ? 12 + (u.pn - 12) * 2 : -1);
#pragma unroll
            for (int ai = 0; ai < 2; ++ai)
#pragma unroll
                for (int m = 0; m < 4; ++m) { const int row = row0 + ai * 128 + m * 16;
                    const f32x4 q0 = *(const GAS f32x4*)(rsp + (size_t)row * 8), q1 = *(const GAS f32x4*)(rsp + (size_t)row * 8 + 4);
                    const float r = rsqrtf(((q0[0] + q0[1]) + (q0[2] + q0[3]) + (q1[0] + q1[1]) + (q1[2] + q1[3])) * (1.f / DM) + EPS);
#pragma unroll
                    for (int bj = 0; bj < 2; ++bj) { const f32x4 v0 = acc[ai][bj][m][0] * r, v1 = acc[ai][bj][m][1] * r;
                        st8(zl1 + (size_t)row * NL1 + u.pn * 256 + bj * 128 + cin, v0, v1);
                        if (slot0 >= 0) { float s = sq8(v0, v1); s = xsum16(s); s = xsum32(s);
                            if (fq == 0) ssl1[(size_t)row * 112 + (slot0 + bj) * 4 + wc] = s; } } }
        }
    }
};

namespace att {
constexpr float SCALE = 0.08838834764831845f;
constexpr int NW = 8, QBLK = 32, KVBLK = 64, QB = NW * QBLK, D = 128;
constexpr int SHM_V = KVBLK * D * 2, SHM_K = KVBLK * D * 2;
constexpr int OFF_WS = 2 * SHM_V + 2 * SHM_K;
constexpr int OFF_KS = OFF_WS + 2048;
constexpr int OFF_BS = OFF_KS + 16384;
constexpr int LDS_END = OFF_BS + 16384;
constexpr int WBIG = 1 << 28;

#define KSWZ(row, colB) ((row) * 256 + ((colB) ^ (((row) & 7) << 4)))
#define SBAR() __builtin_amdgcn_sched_barrier(0)
__device__ __forceinline__ int v_st(int k, int c) { const int kk = (k & ~0xC) | ((k & 4) << 1) | ((k & 8) >> 1); return ((kk >> 3) * 4 + (c >> 5)) * 512 + ((kk & 7) * 32 + (c & 31)) * 2; }
__device__ __forceinline__ int v_rd_base(int lane) { return ((lane & 3) << 3) | (((lane >> 2) & 3) << 6) | (((lane >> 4) & 1) << 5) | (((lane >> 5) & 1) << 8); }
constexpr int v_rd_off(int d0, int ks, int half) { return d0 * 512 + ks * 4096 + half * 2048; }
__device__ __forceinline__ int crow(int r, int hi) { return (r & 3) + 8 * (r >> 2) + 4 * hi; }
__device__ __forceinline__ bf16x8 load8(const GAS bf16_t* p) { return *(const GAS bf16x8*)p; }
__device__ __forceinline__ bf16x8 scale8(bf16x8 v, float s) { const u32x4 w = *reinterpret_cast<u32x4*>(&v); u32x4 o;
    o.x = cvtpk(bf_lo(w.x) * s, bf_hi(w.x) * s); o.y = cvtpk(bf_lo(w.y) * s, bf_hi(w.y) * s); o.z = cvtpk(bf_lo(w.z) * s, bf_hi(w.z) * s); o.w = cvtpk(bf_lo(w.w) * s, bf_hi(w.w) * s);
    return *reinterpret_cast<bf16x8*>(&o); }
__device__ __forceinline__ void mask_tile(f32x16& p0, f32x16& p1, int dq, unsigned W) {
    const float NEG = -__builtin_inff();
#pragma unroll
    for (int r = 0; r < 16; ++r) {
        const int c = (r & 3) + 8 * (r >> 2);
        if ((unsigned)(dq - c) >= W) p0[r] = NEG;
        if ((unsigned)(dq - c - 32) >= W) p1[r] = NEG;
    }
}
constexpr float THR = 8.f;
__device__ __forceinline__ void partialSM(f32x16& p0, f32x16& p1, float& m_reg, float& mn, float& alpha) {
    float pmax = p0[0]; for (int r = 1; r < 16; ++r) pmax = fmaxf(pmax, p0[r]); for (int r = 0; r < 16; ++r) pmax = fmaxf(pmax, p1[r]);
    { auto rr = __builtin_amdgcn_permlane32_swap(__float_as_uint(pmax), __float_as_uint(pmax), false, false);
      pmax = fmaxf(__uint_as_float(rr[0]), __uint_as_float(rr[1])); }
    constexpr float C2 = 1.4426950408889634f * SCALE;
    if (__builtin_expect(__all((pmax - m_reg) * SCALE <= THR), 1)) { mn = m_reg; alpha = 1.f; }
    else { mn = fmaxf(m_reg, pmax); alpha = __builtin_amdgcn_exp2f((m_reg - mn) * C2); m_reg = mn; }
    const float mnL = -mn * C2;
    for (int r = 0; r < 16; ++r) p0[r] = fmaf(p0[r], C2, mnL); for (int r = 0; r < 16; ++r) p1[r] = fmaf(p1[r], C2, mnL);
    for (int r = 0; r < 16; ++r) p0[r] = __builtin_amdgcn_exp2f(p0[r]);
}
__device__ __forceinline__ void finishSM(f32x16& p0, f32x16& p1, float alpha, float& l_reg, bf16x8& pa0, bf16x8& pa1, bf16x8& pa2, bf16x8& pa3) {
    for (int r = 0; r < 16; ++r) p1[r] = __builtin_amdgcn_exp2f(p1[r]);
    float ps = 0; for (int r = 0; r < 16; ++r) ps += p0[r]; for (int r = 0; r < 16; ++r) ps += p1[r];
    { auto rr = __builtin_amdgcn_permlane32_swap(__float_as_uint(ps), __float_as_uint(ps), false, false);
      ps = __uint_as_float(rr[0]) + __uint_as_float(rr[1]); }
    l_reg = l_reg * alpha + ps;
#define PK4(P, B_, OUT) do { unsigned a0 = cvtpk(P[B_+0], P[B_+1]), a1 = cvtpk(P[B_+2], P[B_+3]);                          \
        unsigned b0 = cvtpk(P[B_+4], P[B_+5]), b1 = cvtpk(P[B_+6], P[B_+7]);                                             \
        auto r0 = __builtin_amdgcn_permlane32_swap(a0, b0, false, false); auto r1 = __builtin_amdgcn_permlane32_swap(a1, b1, false, false); \
        u32x4 w = {r0[0], r1[0], r0[1], r1[1]}; OUT = *reinterpret_cast<bf16x8*>(&w); } while (0)
    PK4(p0, 0, pa0); PK4(p0, 8, pa1); PK4(p1, 0, pa2); PK4(p1, 8, pa3);
#undef PK4
}
template <int KB>
__device__ __forceinline__ void qkt(f32x16& p0, f32x16& p1, const char* K_lds, int r32, int hi, const bf16x8* qr, const float* bp  ) {
    { const f32x4 a = *(const f32x4*)(bp), b = *(const f32x4*)(bp + 8), c = *(const f32x4*)(bp + 16), d = *(const f32x4*)(bp + 24);
      p0 = (f32x16){a[0], a[1], a[2], a[3], b[0], b[1], b[2], b[3], c[0], c[1], c[2], c[3], d[0], d[1], d[2], d[3]}; }
    { const f32x4 a = *(const f32x4*)(bp + 32), b = *(const f32x4*)(bp + 40), c = *(const f32x4*)(bp + 48), d = *(const f32x4*)(bp + 56);
      p1 = (f32x16){a[0], a[1], a[2], a[3], b[0], b[1], b[2], b[3], c[0], c[1], c[2], c[3], d[0], d[1], d[2], d[3]}; }
    const char* kb[4];
#pragma unroll
    for (int dd = 0; dd < 4; ++dd) kb[dd] = K_lds + KB * SHM_K + KSWZ(r32, (dd * 16 + hi * 8) * 2);
#pragma unroll
    for (int d0 = 0; d0 < 8; ++d0) { const char* a = kb[d0 & 3] + (d0 >> 2) * 128;
        bf16x8 b0 = *reinterpret_cast<const bf16x8*>(a);
        bf16x8 b1 = *reinterpret_cast<const bf16x8*>(a + 32 * 256);
        p0 = __builtin_amdgcn_mfma_f32_32x32x16_bf16(b0, qr[d0], p0, 0, 0, 0);
        p1 = __builtin_amdgcn_mfma_f32_32x32x16_bf16(b1, qr[d0], p1, 0, 0, 0); }
}
template <int VB>
__device__ __forceinline__ void pv_tile(f32x16* o, int vb0, bf16x8 pa0, bf16x8 pa1, bf16x8 pa2, bf16x8 pa3) {
#define TRRD(dst, off) asm volatile("ds_read_b64_tr_b16 %0, %1 offset:%2" : "=&v"(dst) : "v"(vb0), "i"(off) : "memory")
#define PV_D0(d0) do { s16x4 l0, l1, l2, l3, h0, h1, h2_, h3; constexpr int b_ = VB * SHM_V + v_rd_off(d0, 0, 0); \
        TRRD(l0, b_); TRRD(h0, b_ + 2048); TRRD(l1, b_ + 4096); TRRD(h1, b_ + 6144); TRRD(l2, b_ + 8192); TRRD(h2_, b_ + 10240); TRRD(l3, b_ + 12288); TRRD(h3, b_ + 14336); \
        asm volatile("s_waitcnt lgkmcnt(0)" ::: "memory"); SBAR();   \
        o[d0] = __builtin_amdgcn_mfma_f32_32x32x16_bf16(pa0, (bf16x8){l0[0], l0[1], l0[2], l0[3], h0[0], h0[1], h0[2], h0[3]}, o[d0], 0, 0, 0);   \
        o[d0] = __builtin_amdgcn_mfma_f32_32x32x16_bf16(pa1, (bf16x8){l1[0], l1[1], l1[2], l1[3], h1[0], h1[1], h1[2], h1[3]}, o[d0], 0, 0, 0);   \
        o[d0] = __builtin_amdgcn_mfma_f32_32x32x16_bf16(pa2, (bf16x8){l2[0], l2[1], l2[2], l2[3], h2_[0], h2_[1], h2_[2], h2_[3]}, o[d0], 0, 0, 0);   \
        o[d0] = __builtin_amdgcn_mfma_f32_32x32x16_bf16(pa3, (bf16x8){l3[0], l3[1], l3[2], l3[3], h3[0], h3[1], h3[2], h3[3]}, o[d0], 0, 0, 0); } while (0)
    PV_D0(0); PV_D0(1); PV_D0(2); PV_D0(3);
#undef PV_D0
#undef TRRD
}

struct BlockRef { const GAS bf16_t* Q; const GAS bf16_t* K; const GAS bf16_t* V; GAS bf16_t* O; const GAS float* qss; const GAS float* kss; const GAS float* cc; const GAS float* gg;
                  int P0, skv; };
constexpr int LDQ = 5120, LDK = 5120, LDO = 2048, LDSS = 112;
struct Seam { bf16x8 qr[8]; bf16x8 st_v0, st_v1, st_k0, st_k1; int jlo; };
#define ROWK(p, k0, rr) ((p) + (size_t)((k0) + (rr)) * LDK + sc)
#define VMW() asm volatile("s_waitcnt vmcnt(0)" ::: "memory")
#define VMWN(n) asm volatile("s_waitcnt vmcnt(%0)" :: "i"(n) : "memory")
#define SLOAD_H(Kp, Vp, k0) do { S.st_v0 = load8(ROWK(Vp, k0, sr)); S.st_v1 = load8(ROWK(Vp, k0, 32 + sr));              \
                         S.st_k0 = load8(ROWK(Kp, k0, sr)); S.st_k1 = load8(ROWK(Kp, k0, 32 + sr)); } while (0)
#define SWRITE_HK(bf, k0) do { *(bf16x8*)(K_lds + (bf) * SHM_K + kws) = scale8(S.st_k0, ksr[(k0)]); *(bf16x8*)(K_lds + (bf) * SHM_K + kws + 32 * 256) = scale8(S.st_k1, ksr[(k0) + 32]); } while (0)
#define SWRITE_HV(bf) do { *(bf16x8*)(V_lds + (bf) * SHM_V + vst0) = S.st_v0; *(bf16x8*)(V_lds + (bf) * SHM_V + vst1) = S.st_v1; } while (0)
#define SWRITE_H(bf, k0) do { SWRITE_HV(bf); SWRITE_HK(bf, k0); } while (0)

__device__ __forceinline__ void attn_prime(const BlockRef& cur, char* lds, Seam& S, const int tid) {
    const int wid = __builtin_amdgcn_readfirstlane(tid >> 6), lane = tid & 63, r32 = lane & 31, hi = lane >> 5;
    const int sr = tid >> 4, sc = (tid & 15) * 8, kws = KSWZ(sr, sc * 2); char* K_lds = lds + 2 * SHM_V;
    float* ks_l = (float*)(lds + OFF_KS); float* bs_l = (float*)(lds + OFF_BS); const float* ksr = ks_l + sr;
    int j_hi = (cur.P0 + QB - 1) / KVBLK + 1; if (j_hi > cur.skv / KVBLK) j_hi = cur.skv / KVBLK;
    const int nkeys = j_hi * KVBLK;
    const float c0 = cur.cc ? cur.cc[cur.P0] : 0.f;
    int jlo = 0;
    if (cur.cc) { const float thr = cur.gg[128]; const int jd = cur.P0 / KVBLK;
        const float cv = lane <= jd ? cur.cc[lane * KVBLK + KVBLK - 1] : 0.f;
        const bool keep = lane > jd || (c0 - cv > -thr);
        jlo = __ffsll((long long)__ballot(keep)) - 1; }
    S.jlo = jlo;
    for (int s = jlo * KVBLK + tid; s < nkeys; s += NTHREADS) {
        const f32x4 p = *(const GAS f32x4*)(cur.kss + (size_t)s * LDSS);
        ks_l[s] = rsqrtf(((p[0] + p[1]) + (p[2] + p[3])) * (1.f / 128.f) + EPS);
        bs_l[s] = cur.cc ? (c0 - cur.cc[s]) * (1.f / SCALE) : 0.f;
    }
    __syncthreads();
    const int qrow = wid * QBLK + r32;
    const f32x4 qp = *(const GAS f32x4*)(cur.qss + (size_t)qrow * LDSS);
    const float rq = rsqrtf(((qp[0] + qp[1]) + (qp[2] + qp[3])) * (1.f / 128.f) + EPS);
#pragma unroll
    for (int d0 = 0; d0 < 8; ++d0) {
        const u32x4 w = *(const GAS u32x4*)(cur.Q + (size_t)qrow * LDQ + d0 * 16 + hi * 8);
        const f32x4 g0 = *(const GAS f32x4*)(cur.gg + d0 * 16 + hi * 8), g1 = *(const GAS f32x4*)(cur.gg + d0 * 16 + hi * 8 + 4);
        u32x4 o; o.x = cvtpk(bf_lo(w.x) * rq * g0[0], bf_hi(w.x) * rq * g0[1]); o.y = cvtpk(bf_lo(w.y) * rq * g0[2], bf_hi(w.y) * rq * g0[3]);
        o.z = cvtpk(bf_lo(w.z) * rq * g1[0], bf_hi(w.z) * rq * g1[1]); o.w = cvtpk(bf_lo(w.w) * rq * g1[2], bf_hi(w.w) * rq * g1[3]);
        S.qr[d0] = *reinterpret_cast<bf16x8*>(&o);
    }
    SLOAD_H(cur.K, cur.V, jlo * KVBLK); VMW(); SWRITE_HK(0, jlo * KVBLK);
    __syncthreads();
}
__device__ __forceinline__ void attn_block(const BlockRef& cur, char* lds, Seam& S, const int tid) {
    const int wid = __builtin_amdgcn_readfirstlane(tid >> 6), lane = tid & 63, r32 = lane & 31, hi = lane >> 5;
    const int W = WBIG;
    int j_hi = (cur.P0 + QB - 1) / KVBLK + 1; if (j_hi > cur.skv / KVBLK) j_hi = cur.skv / KVBLK;
    const int j_lo = S.jlo; const int NT = j_hi - j_lo;
    const int qlo = cur.P0 - j_lo * KVBLK + wid * QBLK, qm = qlo + r32 - 4 * hi;
    char* V_lds = lds; char* K_lds = lds + 2 * SHM_V;
    float* ws = (float*)(lds + OFF_WS) + wid * 64; float* li_l = ws, * al_l = ws + 32;
    const float* bs_l = (const float*)(lds + OFF_BS) + j_lo * KVBLK + 4 * hi;
    float m_reg = -1e30f, l_reg = 0; f32x16 o[4] = {};
    const int sr = tid >> 4, sc = (tid & 15) * 8, vst0 = v_st(sr, sc), vst1 = v_st(32 + sr, sc), kws = KSWZ(sr, sc * 2);
    const float* ksr = (const float*)(lds + OFF_KS) + j_lo * KVBLK + sr;
    const int vb0 = (int)(uintptr_t)V_lds + v_rd_base(lane);
    const GAS bf16_t* Kh = cur.K + (size_t)j_lo * KVBLK * LDK; const GAS bf16_t* Vh = cur.V + (size_t)j_lo * KVBLK * LDK;
#define RESC(a) do { if (__any((a) < 1.f)) { if (hi == 0) al_l[r32] = (a); asm volatile("s_waitcnt lgkmcnt(0)" ::: "memory");              \
                     for (int d_ = 0; d_ < 4; ++d_) for (int r = 0; r < 16; ++r) o[d_][r] *= al_l[crow(r, hi)]; } } while (0)
#define KBASE(t) ((t) * KVBLK)
#define MASKT(P0_, P1_, t) do { const int kb_ = KBASE(t); if (kb_ + KVBLK - 1 > qlo) mask_tile(P0_, P1_, qm - kb_, (unsigned)W); } while (0)
    f32x16 pA0, pA1, pB0, pB1; float mnA, mnB, alA, alB; bf16x8 pa0, pa1, pa2, pa3;
    SWRITE_HV(0); SBAR();
    if (NT > 1) { SLOAD_H(Kh, Vh, KBASE(1)); }
    SBAR(); qkt<0>(pA0, pA1, K_lds, r32, hi, S.qr, bs_l + KBASE(0));
    MASKT(pA0, pA1, 0); partialSM(pA0, pA1, m_reg, mnA, alA);
    if (NT > 1) { VMW(); SWRITE_H(1, KBASE(1)); }
    __syncthreads();
#define HALF_STEP(PX0, PX1, mnX, alX, PY0, PY1, alY, t, KB, VB, SB) do {                                                      \
        SBAR(); qkt<KB>(PX0, PX1, K_lds, r32, hi, S.qr, bs_l + KBASE(t));                                                         \
        finishSM(PY0, PY1, alY, l_reg, pa0, pa1, pa2, pa3); SBAR();                                                           \
        if ((t) + 1 < NT) { SLOAD_H(Kh, Vh, KBASE((t) + 1)); SBAR(); }                                               \
        pv_tile<VB>(o, vb0, pa0, pa1, pa2, pa3); MASKT(PX0, PX1, (t)); partialSM(PX0, PX1, m_reg, mnX, alX);                                        \
        __syncthreads();                                                                                                      \
        if ((t) + 1 < NT) { VMW(); SWRITE_H(SB, KBASE((t) + 1)); }                                                                          \
        RESC(alX); __syncthreads(); } while (0)
    for (int t = 1; t + 1 < NT; t += 2) {
        HALF_STEP(pB0, pB1, mnB, alB, pA0, pA1, alA, t, 1, 0, 0);
        HALF_STEP(pA0, pA1, mnA, alA, pB0, pB1, alB, t + 1, 0, 1, 1);
    }
    const bool even = (NT & 1) == 0;
    if (even) { SBAR(); qkt<1>(pB0, pB1, K_lds, r32, hi, S.qr, bs_l + KBASE(NT - 1)); SBAR(); }
    finishSM(pA0, pA1, alA, l_reg, pa0, pa1, pa2, pa3); SBAR();
    pv_tile<0>(o, vb0, pa0, pa1, pa2, pa3);
    if (even) { MASKT(pB0, pB1, NT - 1); partialSM(pB0, pB1, m_reg, mnB, alB); __syncthreads(); RESC(alB);
        finishSM(pB0, pB1, alB, l_reg, pa0, pa1, pa2, pa3); SBAR(); pv_tile<1>(o, vb0, pa0, pa1, pa2, pa3); }
    SBAR();
    if (hi == 0) li_l[r32] = l_reg; asm volatile("s_waitcnt lgkmcnt(0)" ::: "memory");
    float rli[16];
#pragma unroll
    for (int r = 0; r < 16; ++r) rli[r] = __builtin_amdgcn_rcpf(li_l[crow(r, hi)]);
    GAS bf16_t* Ow = cur.O + (size_t)(wid * QBLK) * LDO;
#pragma unroll
    for (int r = 0; r < 16; ++r) { const int orow = crow(r, hi);
#pragma unroll
        for (int d0 = 0; d0 < 4; ++d0) { const float v = o[d0][r] * rli[r];
            const float vn = dppf<0xB1>(v);
            if ((r32 & 1) == 0) *(GAS unsigned*)(Ow + (size_t)orow * LDO + d0 * 32 + r32) = cvtpk(v, vn); } }
    __syncthreads();
#undef RESC
#undef KBASE
#undef MASKT
#undef HALF_STEP
}
#undef ROWK
#undef VMW
#undef VMWN
#undef SLOAD_H
#undef SWRITE_HK
#undef SWRITE_HV
#undef SWRITE_H
#undef KSWZ
#undef SBAR
}


struct Frame {
    GAS unsigned char* ws; const float* const* in_; GAS float* out;
    __device__ __forceinline__ const GAS float* in(int i) const { return (const GAS float*)in_[i]; }
    int tid, lane, wave, gw, ngw, gtid, ngt;
};
enum { I_X = 0, I_MEM, I_ANORM, I_AWIN, I_ACONVW, I_ACONVB, I_AGATEW, I_AGATEB, I_ALAMBDA, I_AWOUT, I_SNORM, I_SWKVF, I_SBF, I_SKNORM, I_BNORM, I_BWIN, I_BQNORM, I_BWOUT,
       I_MNORM, I_MWKV, I_MQNORM, I_MKNORM, I_PNORM, I_PWQ, I_PSUBK, I_PU, I_PV, N_IN };

struct TrItem { const GAS float* W; const GAS float* gain; GAS bf16_t* WT; int ldw, ldt, row_off, k0, n0; };
__device__ __forceinline__ void tr_load(const TrItem& d, float (&wv)[32], int lane) {
#pragma unroll
    for (int i = 0; i < 32; ++i) wv[i] = __builtin_nontemporal_load(d.W + (size_t)(d.k0 + 2 * i + (lane >> 5)) * d.ldw + d.n0 + (lane & 31));
}
__device__ __forceinline__ void tr_proc(const TrItem& d, float (&wv)[32], LAS float* scr, int lane) {
    if (d.gain) {
#pragma unroll
        for (int i = 0; i < 32; ++i) wv[i] *= d.gain[d.k0 + 2 * i + (lane >> 5)]; }
#pragma unroll
    for (int i = 0; i < 32; ++i) scr[(2 * i + (lane >> 5)) * 33 + (lane & 31)] = wv[i];
    asm volatile("s_waitcnt lgkmcnt(0)" ::: "memory");
    const int c = lane & 7;
#pragma unroll
    for (int j = 0; j < 4; ++j) { const int n = (lane >> 3) + 8 * j; const LAS float* s = scr + (8 * c) * 33 + n;
        u32x4 o; o.x = cvtpk(s[0 * 33], s[1 * 33]); o.y = cvtpk(s[2 * 33], s[3 * 33]); o.z = cvtpk(s[4 * 33], s[5 * 33]); o.w = cvtpk(s[6 * 33], s[7 * 33]);
        *(GAS u32x4*)(d.WT + (size_t)(d.row_off + d.n0 + n) * d.ldt + d.k0 + 8 * c) = o; }
    asm volatile("s_waitcnt lgkmcnt(0)" ::: "memory");
}
__device__ __forceinline__ void transpose_item_fp8(const GAS float* W, int ldw, const GAS float* gain, GAS unsigned char* WT, int ldt, LAS float* scr, int nblk, int item, int lane) {
    const int kb = item / nblk, nb = item % nblk, k0 = 64 * kb, n0 = 32 * nb;
    float wv[32];
#pragma unroll
    for (int i = 0; i < 32; ++i) wv[i] = W[(size_t)(k0 + 2 * i + (lane >> 5)) * ldw + n0 + (lane & 31)];
#pragma unroll
    for (int i = 0; i < 32; ++i) wv[i] *= gain[k0 + 2 * i + (lane >> 5)] * 64.f;
#pragma unroll
    for (int i = 0; i < 32; ++i) scr[(2 * i + (lane >> 5)) * 33 + (lane & 31)] = wv[i];
    asm volatile("s_waitcnt lgkmcnt(0)" ::: "memory");
    const int c = lane & 3;
#pragma unroll
    for (int j = 0; j < 2; ++j) { const int n = (lane >> 2) + 16 * j; const LAS float* sp = scr + (16 * c) * 33 + n; u32x4 o;
#pragma unroll
        for (int w = 0; w < 4; ++w) { int pk = __builtin_amdgcn_cvt_pk_fp8_f32(sp[(4 * w) * 33], sp[(4 * w + 1) * 33], 0, false); pk = __builtin_amdgcn_cvt_pk_fp8_f32(sp[(4 * w + 2) * 33], sp[(4 * w + 3) * 33], pk, true); o[w] = (unsigned)pk; }
        *(GAS u32x4*)(WT + (size_t)(n0 + n) * ldt + k0 + 16 * c) = o; }
    asm volatile("s_waitcnt lgkmcnt(0)" ::: "memory");
}
struct CtRow { f32x4 v[8]; GAS unsigned char* dst; int row, which; };
__device__ __forceinline__ void ct_load(Frame& F, int layer, int it, CtRow& R) {
    R.which = it & 1; R.row = it >> 1;
    const GAS float* src = F.in(R.which ? I_PV : I_PU) + ((size_t)layer * NEXP + R.row) * DM + F.lane * 4;
    R.dst = F.ws + O_TAB + (size_t)(layer * 2 + R.which) * TAB_ONE;
#pragma unroll
    for (int c = 0; c < 8; ++c) R.v[c] = __builtin_nontemporal_load((const GAS f32x4*)(src + c * 256));
}
__device__ __forceinline__ void ct_proc(Frame& F, int layer, CtRow& R) {
    const GAS float* gn = F.in(I_PNORM) + layer * DM + F.lane * 4;
    _Float16 shv = (_Float16)0.f;
#pragma unroll
    for (int c = 0; c < 8; ++c) { f32x4 x = R.v[c]; if (!R.which) x = x * *(const GAS f32x4*)(gn + c * 256);
        float amax = fmaxf(fmaxf(fabsf(x[0]), fabsf(x[1])), fmaxf(fabsf(x[2]), fabsf(x[3])));
        amax = wave_max(amax);
        const _Float16 sh = (_Float16)fmaxf(amax * (R.which ? 1.f / 6.f : 1.f / 7.f), 1e-6f);
        const float qs = __builtin_amdgcn_rcpf((float)sh);
        unsigned pk;
        if (R.which) { pk = __builtin_amdgcn_cvt_scalef32_pk_fp4_f32(0u, x[0] * qs, x[1] * qs, 1.0f, 0); pk = __builtin_amdgcn_cvt_scalef32_pk_fp4_f32(pk, x[2] * qs, x[3] * qs, 1.0f, 1); }
        else { const int q0 = (int)fminf(fmaxf(rintf(x[0] * qs), -7.f), 7.f), q1 = (int)fminf(fmaxf(rintf(x[1] * qs), -7.f), 7.f), q2 = (int)fminf(fmaxf(rintf(x[2] * qs), -7.f), 7.f), q3 = (int)fminf(fmaxf(rintf(x[3] * qs), -7.f), 7.f);
               pk = (unsigned)(q0 & 15) | ((unsigned)(q1 & 15) << 4) | ((unsigned)(q2 & 15) << 8) | ((unsigned)(q3 & 15) << 12); }
        *(GAS unsigned short*)(R.dst + ((size_t)c * NEXP + R.row) * 128 + F.lane * 2) = (unsigned short)pk;
        shv = (F.lane == c) ? sh : shv; }
    if (F.lane < 8) *(GAS unsigned short*)(R.dst + TAB_NIB + ((size_t)R.row * 8 + F.lane) * 2) = __builtin_bit_cast(unsigned short, shv);
}
__device__ __forceinline__ void convert_tables(Frame& F, int layer, int ibeg, int iend, int wk, int nwk) {
    if (ibeg + wk >= iend) return;
    const int ilast = ibeg + wk + ((iend - 1 - ibeg - wk) / nwk) * nwk;
    CtRow A, B;
    ct_load(F, layer, ibeg + wk, A);
    for (int it = ibeg + wk; it < iend; it += 2 * nwk) {
        ct_load(F, layer, it + nwk <= ilast ? it + nwk : ilast, B);
        ct_proc(F, layer, A);
        ct_load(F, layer, it + 2 * nwk <= ilast ? it + 2 * nwk : ilast, A);
        if (it + nwk < iend) ct_proc(F, layer, B);
    }
}
__device__ __forceinline__ void norm_row_bf16(const GAS float* xrow, const GAS float* gain, GAS bf16_t* orow, int lane) {
    f32x4 v[8]; float s = 0.f;
#pragma unroll
    for (int j = 0; j < 8; ++j) { v[j] = *(const GAS f32x4*)(xrow + j * 256 + lane * 4); s += (v[j][0] * v[j][0] + v[j][1] * v[j][1]) + (v[j][2] * v[j][2] + v[j][3] * v[j][3]); }
    const float r = rsqrtf(wave_sum(s) * (1.f / DM) + EPS);
#pragma unroll
    for (int j = 0; j < 8; ++j) { f32x4 g = gain ? *(const GAS f32x4*)(gain + j * 256 + lane * 4) : (f32x4){1.f, 1.f, 1.f, 1.f};
        u32x2 o; o.x = cvtpk(v[j][0] * r * g[0], v[j][1] * r * g[1]); o.y = cvtpk(v[j][2] * r * g[2], v[j][3] * r * g[3]);
        *(GAS u32x2*)(orow + j * 256 + lane * 4) = o; }
}
__device__ __forceinline__ void step_prologue(Frame& F, LAS unsigned char* lds) {
    LAS float* scr = (LAS float*)(lds + F.wave * 16384);
    GAS unsigned char* ws = F.ws;
    constexpr int I0 = 32 * (NIN0 / 32), I1 = 32 * 64, I2 = 32 * 96, I3 = 32 * 64, I4 = 32 * 64, I5 = 32 * 64, I6 = 32 * 64, I7 = 32 * 32, I8 = 32 * 32, I9 = 12 * 16;
    constexpr int NITEMS = I0 + I1 + I2 + I3 + I4 + I5 + I6 + I7 + I8 + I9;
#define TR_DESC(D, it_) do { int r = (it_) < NITEMS ? (it_) : NITEMS - 1; int nblk; \
        if (r < I0) { D = {F.in(I_AWIN), F.in(I_ANORM), (GAS bf16_t*)(ws + O_WIN0), NIN0, DM, 0, 0, 0}; nblk = NIN0 / 32; } else { r -= I0; \
        if (r < I1) { D = {F.in(I_AWOUT), nullptr, (GAS bf16_t*)(ws + O_WOUT0), DM, DM, 0, 0, 0}; nblk = 64; } else { r -= I1; \
        if (r < I2) { D = {F.in(I_SWKVF), F.in(I_SNORM), (GAS bf16_t*)(ws + O_WL1), 3084, DM, 0, 0, 0}; nblk = 96; } else { r -= I2; \
        if (r < I3) { D = {F.in(I_BWIN), F.in(I_BNORM), (GAS bf16_t*)(ws + O_WL1), DM, DM, 3072, 0, 0}; nblk = 64; } else { r -= I3; \
        if (r < I4) { D = {F.in(I_BWOUT), nullptr, (GAS bf16_t*)(ws + O_WOUT1), DM, DM, 0, 0, 0}; nblk = 64; } else { r -= I4; \
        if (r < I5) { D = {F.in(I_PWQ), F.in(I_PNORM), (GAS bf16_t*)(ws + O_WQ0), DM, DM, 0, 0, 0}; nblk = 64; } else { r -= I5; \
        if (r < I6) { D = {F.in(I_PWQ) + (size_t)DM * DM, F.in(I_PNORM) + DM, (GAS bf16_t*)(ws + O_WQ1), DM, DM, 0, 0, 0}; nblk = 64; } else { r -= I6; \
        if (r < I7) { D = {F.in(I_MWKV), nullptr, (GAS bf16_t*)(ws + O_WMKV), 1024, DM, 0, 0, 0}; nblk = 32; } else { r -= I7; \
        if (r < I8) { D = {F.in(I_MWKV) + (size_t)DM * 1024, nullptr, (GAS bf16_t*)(ws + O_WMKV) + (size_t)1024 * DM, 1024, DM, 0, 0, 0}; nblk = 32; } else { r -= I8; \
          const int blk = r / 16; r = r % 16; D = {F.in(I_AGATEW) + (size_t)blk * 128 * 256, nullptr, (GAS bf16_t*)(ws + O_WGATE), 256, 128, blk * 256, 0, 0}; nblk = 8; } } } } } } } } } \
        D.k0 = 64 * (r / nblk); D.n0 = 32 * (r % nblk); } while (0)
    for (int it = F.gw; it < NITEMS; it += F.ngw) { float wv[32]; TrItem d; TR_DESC(d, it); tr_load(d, wv, F.lane); tr_proc(d, wv, scr, F.lane); }
#undef TR_DESC
    { const GAS float* sk = F.in(I_PSUBK); GAS bf16_t* o = (GAS bf16_t*)(ws + O_SUBK);
      for (int i = F.gtid; i < 2 * 16 * 128 * 128 / 2; i += F.ngt) *(GAS unsigned*)(o + 2 * i) = cvtpk(sk[2 * i], sk[2 * i + 1]); }
    { GAS float* wf = (GAS float*)(ws + O_WF); const GAS float* w = F.in(I_SWKVF); const GAS float* g = F.in(I_SNORM);
      for (int i = F.gtid; i < 12 * DM; i += F.ngt) { const int j = i / DM, k = i % DM; wf[i] = w[(size_t)k * 3084 + 3072 + j] * g[k]; } }
    { GAS float* spl = (GAS float*)(ws + O_SPL); const GAS float* lam = F.in(I_ALAMBDA);
      for (int i = F.gtid; i < LRU; i += F.ngt) { const float z = -lam[i]; spl[i] = fmaxf(z, 0.f) + log1p_pos(fast_exp(-fabsf(z))); } }
    if (F.gw == 0) {
        float m = 0.f; for (int d = F.lane; d < 128; d += 64) m = fmaxf(m, fabsf(F.in(I_BQNORM)[d] * F.in(I_SKNORM)[d]));
        m = wave_max(m);
        if (F.lane == 0) ((GAS float*)(ws + O_GG))[512] = 2.f * 11.3137085f * m + 30.f; }
    { GAS float* gg = (GAS float*)(ws + O_GG);
      for (int i = F.gtid; i < 384; i += F.ngt) { const int a = i / 128, d = i % 128;
          gg[a == 0 ? 384 + d : i] = a == 0 ? F.in(I_BQNORM)[d] * F.in(I_SKNORM)[d] : F.in(I_MQNORM)[(a - 1) * 128 + d] * F.in(I_MKNORM)[(a - 1) * 128 + d]; } }
    {
        const GAS float* xin = F.in(I_X) + F.lane * 4; GAS bf16_t* xo = (GAS bf16_t*)(ws + O_XS16) + F.lane * 4;
        const int mlast = F.gw + ((T - 1 - F.gw) / F.ngw) * F.ngw;
#define XN_LOAD(V, m_) do { const int mm_ = (m_) <= mlast ? (m_) : mlast; _Pragma("unroll") for (int j = 0; j < 8; ++j) V[j] = __builtin_nontemporal_load((const GAS f32x4*)(xin + (size_t)mm_ * DM + j * 256)); } while (0)
#define XN_PROC(V, m_) do { if ((m_) < T) { float s0 = 0.f; _Pragma("unroll") for (int j = 0; j < 8; ++j) s0 += (V[j][0] * V[j][0] + V[j][1] * V[j][1]) + (V[j][2] * V[j][2] + V[j][3] * V[j][3]); \
            const float r0 = rsqrtf(wave_sum(s0) * (1.f / DM) + EPS); \
            _Pragma("unroll") for (int j = 0; j < 8; ++j) { u32x2 a; a.x = cvtpk(V[j][0] * r0, V[j][1] * r0); a.y = cvtpk(V[j][2] * r0, V[j][3] * r0); *(GAS u32x2*)(xo + (size_t)(m_) * DM + j * 256) = a; } } } while (0)
        f32x4 va[8], vb[8];
        XN_LOAD(va, F.gw);
        for (int m = F.gw; m < T; m += 2 * F.ngw) { XN_LOAD(vb, m + F.ngw); XN_PROC(va, m); XN_LOAD(va, m + 2 * F.ngw); XN_PROC(vb, m + F.ngw); }
#undef XN_LOAD
#undef XN_PROC
    }
    for (int m = F.gw; m < 2 * NMROW; m += F.ngw) { const int l = m / NMROW, r = m % NMROW;
        norm_row_bf16(F.in(I_MEM) + (size_t)r * DM, F.in(I_MNORM) + l * DM, (GAS bf16_t*)(ws + O_MEMN) + (size_t)m * DM, F.lane); }
    convert_tables(F, 0, 0, 2 * NEXP, F.gw, F.ngw);
}
__device__ __forceinline__ void step_conv(Frame& F) {
    const GAS bf16_t* zx = (const GAS bf16_t*)(F.ws + O_ZX); GAS bf16_t* xc = (GAS bf16_t*)(F.ws + O_XC);
    const GAS float* cw = F.in(I_ACONVW); const GAS float* cb = F.in(I_ACONVB);
    constexpr int NIT = T * (LRU / 8);
#define CV_LOAD(W, it_) do { const int ii_ = (it_) < NIT ? (it_) : NIT - 1; const int t_ = ii_ / (LRU / 8), c8_ = (ii_ % (LRU / 8)) * 8, pos_ = t_ & (SEQ - 1); \
        _Pragma("unroll") for (int k = 0; k < 4; ++k) W[k] = (pos_ - 3 + k >= 0) ? *(const GAS u32x4*)(zx + (size_t)(t_ - 3 + k) * LRU + c8_) : (u32x4){0u, 0u, 0u, 0u}; } while (0)
#define CV_PROC(W, it_) do { if ((it_) < NIT) { const int t_ = (it_) / (LRU / 8), c8_ = ((it_) % (LRU / 8)) * 8; float a[8]; \
        { const f32x4 b0 = *(const GAS f32x4*)(cb + c8_), b1 = *(const GAS f32x4*)(cb + c8_ + 4); a[0] = b0[0]; a[1] = b0[1]; a[2] = b0[2]; a[3] = b0[3]; a[4] = b1[0]; a[5] = b1[1]; a[6] = b1[2]; a[7] = b1[3]; } \
        _Pragma("unroll") for (int k = 0; k < 4; ++k) { const f32x4 w0 = *(const GAS f32x4*)(cw + k * LRU + c8_), w1 = *(const GAS f32x4*)(cw + k * LRU + c8_ + 4); \
            a[0] = fmaf(w0[0], bf_lo(W[k].x), a[0]); a[1] = fmaf(w0[1], bf_hi(W[k].x), a[1]); a[2] = fmaf(w0[2], bf_lo(W[k].y), a[2]); a[3] = fmaf(w0[3], bf_hi(W[k].y), a[3]); \
            a[4] = fmaf(w1[0], bf_lo(W[k].z), a[4]); a[5] = fmaf(w1[1], bf_hi(W[k].z), a[5]); a[6] = fmaf(w1[2], bf_lo(W[k].w), a[6]); a[7] = fmaf(w1[3], bf_hi(W[k].w), a[7]); } \
        u32x4 o; o.x = cvtpk(a[0], a[1]); o.y = cvtpk(a[2], a[3]); o.z = cvtpk(a[4], a[5]); o.w = cvtpk(a[6], a[7]); \
        *(GAS u32x4*)(xc + (size_t)t_ * LRU + c8_) = o; } } while (0)
    u32x4 wa[4], wb[4];
    CV_LOAD(wa, F.gtid);
    for (int it = F.gtid; it < NIT; it += 2 * F.ngt) { CV_LOAD(wb, it + F.ngt); CV_PROC(wa, it); CV_LOAD(wa, it + 2 * F.ngt); CV_PROC(wb, it + F.ngt); }
#undef CV_LOAD
#undef CV_PROC
}
constexpr int SCK = 32, NCK = SEQ / SCK;
typedef _Float16 h8_t __attribute__((ext_vector_type(8)));
__device__ __forceinline__ void scan_load(const GAS _Float16* LA, const GAS _Float16* UH, size_t off, float (&a)[8], float (&u)[8]) {
    const h8_t l = *(const GAS h8_t*)(LA + off), w = *(const GAS h8_t*)(UH + off);
#pragma unroll
    for (int k = 0; k < 8; ++k) { a[k] = fast_exp((float)l[k]); u[k] = (float)w[k]; }
}
__device__ __forceinline__ void step_scan1(Frame& F) {
    const GAS _Float16* LA = (const GAS _Float16*)(F.ws + O_AA); const GAS _Float16* UH = (const GAS _Float16*)(F.ws + O_UU);
    GAS float* CA = (GAS float*)(F.ws + O_LOGFP); GAS float* CH = CA + (size_t)NB * NCK * LRU;
    if (F.tid >= 384) return;
    const int grp = F.tid / 192, th = F.tid % 192;
    for (int it = blockIdx.x * 2 + grp; it < NB * NCK; it += gridDim.x * 2) {
        const int b = it / NCK, ck = it % NCK; const size_t base = ((size_t)b * SEQ + ck * SCK) * LRU + th * 8;
        float ap[8], h[8];
#pragma unroll
        for (int k = 0; k < 8; ++k) { ap[k] = 1.f; h[k] = 0.f; }
#pragma unroll 8
        for (int i = 0; i < SCK; ++i) { float a[8], u[8]; scan_load(LA, UH, base + (size_t)i * LRU, a, u);
#pragma unroll
            for (int k = 0; k < 8; ++k) { ap[k] *= a[k]; h[k] = a[k] * h[k] + u[k]; } }
        GAS float* ca = CA + (size_t)it * LRU + th * 8; GAS float* ch = CH + (size_t)it * LRU + th * 8;
        *(GAS f32x4*)ca = (f32x4){ap[0], ap[1], ap[2], ap[3]}; *(GAS f32x4*)(ca + 4) = (f32x4){ap[4], ap[5], ap[6], ap[7]};
        *(GAS f32x4*)ch = (f32x4){h[0], h[1], h[2], h[3]}; *(GAS f32x4*)(ch + 4) = (f32x4){h[4], h[5], h[6], h[7]};
    }
}
__device__ __forceinline__ void step_scan2(Frame& F) {
    const GAS _Float16* LA = (const GAS _Float16*)(F.ws + O_AA); const GAS _Float16* UH = (const GAS _Float16*)(F.ws + O_UU);
    const GAS float* CA = (const GAS float*)(F.ws + O_LOGFP); const GAS float* CH = CA + (size_t)NB * NCK * LRU;
    const GAS bf16_t* gy = (const GAS bf16_t*)(F.ws + O_GY); GAS bf16_t* cat = (GAS bf16_t*)(F.ws + O_CAT);
    if (F.tid >= 384) return;
    const int grp = F.tid / 192, th = F.tid % 192;
    for (int it = blockIdx.x * 2 + grp; it < NB * NCK; it += gridDim.x * 2) {
        const int b = it / NCK, ck = it % NCK; const size_t base = ((size_t)b * SEQ + ck * SCK) * LRU + th * 8;
        float h[8];
#pragma unroll
        for (int k = 0; k < 8; ++k) h[k] = 0.f;
        for (int k2 = 0; k2 < ck; ++k2) { const size_t o = (size_t)(b * NCK + k2) * LRU + th * 8;
            const f32x4 a0 = *(const GAS f32x4*)(CA + o), a1 = *(const GAS f32x4*)(CA + o + 4), c0 = *(const GAS f32x4*)(CH + o), c1 = *(const GAS f32x4*)(CH + o + 4);
#pragma unroll
            for (int k = 0; k < 4; ++k) { h[k] = a0[k] * h[k] + c0[k]; h[4 + k] = a1[k] * h[4 + k] + c1[k]; } }
#pragma unroll 8
        for (int i = 0; i < SCK; ++i) { float a[8], u[8]; scan_load(LA, UH, base + (size_t)i * LRU, a, u);
            const size_t row = (size_t)b * SEQ + ck * SCK + i;
            const u32x4 g = *(const GAS u32x4*)(gy + row * LRU + th * 8); u32x4 o;
#pragma unroll
            for (int k = 0; k < 8; ++k) h[k] = a[k] * h[k] + u[k];
#pragma unroll
            for (int k = 0; k < 4; ++k) o[k] = cvtpk(h[2 * k] * bf_lo(g[k]), h[2 * k + 1] * bf_hi(g[k]));
            *(GAS u32x4*)(cat + row * DM + th * 8) = o; }
    }
}
__device__ __forceinline__ void step_cprefix(Frame& F, LAS unsigned char* lds) {
    const GAS float* lf = (const GAS float*)(F.ws + O_LOGF); GAS float* cc = (GAS float*)(F.ws + O_CC);
    LAS double* scr = (LAS double*)(lds + F.wave * 16384);
    for (int it = F.gw; it < NB * NH; it += F.ngw) {
        const GAS float* p = lf + (size_t)it * SEQ + F.lane * 64; GAS float* q = cc + (size_t)it * SEQ + F.lane * 64;
        double s = 0.0;
        for (int i = 0; i < 64; ++i) s += (double)p[i];
        scr[F.lane] = s;
        asm volatile("s_waitcnt lgkmcnt(0)" ::: "memory");
        double run = 0.0;
        for (int l = 0; l < 64; ++l) { const double v = scr[l]; if (l < F.lane) run += v; }
        for (int i = 0; i < 64; ++i) { run += (double)p[i]; q[i] = (float)run; }
        asm volatile("s_waitcnt lgkmcnt(0)" ::: "memory");
    }
}

__device__ __forceinline__ int ord_i(float f) { const int b = __float_as_int(f); return b ^ ((b >> 31) & 0x7fffffff); }
__device__ __forceinline__ float unord_f(int k) { return __int_as_float(k ^ ((k >> 31) & 0x7fffffff)); }
template <int N> __device__ __forceinline__ void bitonic_sort_desc(int (&a)[N]) {
#pragma unroll
    for (int k = 2; k <= N; k <<= 1) {
#pragma unroll
        for (int j = k >> 1; j > 0; j >>= 1) {
#pragma unroll
            for (int i = 0; i < N; ++i) { const int l = i ^ j;
                if (l > i) { const bool desc = ((i & k) == 0); const int mx = max(a[i], a[l]), mn = min(a[i], a[l]); a[i] = desc ? mx : mn; a[l] = desc ? mn : mx; } }
        }
    }
}
__device__ __forceinline__ void bitonic_merge16_desc(int (&a)[16]) {
#pragma unroll
    for (int j = 8; j > 0; j >>= 1) {
#pragma unroll
        for (int i = 0; i < 16; ++i) { const int l = i ^ j; if (l > i) { const int mx = max(a[i], a[l]), mn = min(a[i], a[l]); a[i] = mx; a[l] = mn; } }
    }
}
__device__ __forceinline__ void top16_of_64(int (&a)[64]) {
    int g[4][16];
#pragma unroll
    for (int q = 0; q < 4; ++q) {
#pragma unroll
        for (int i = 0; i < 16; ++i) g[q][i] = a[16 * q + i];
        bitonic_sort_desc<16>(g[q]); }
#pragma unroll
    for (int i = 0; i < 16; ++i) { g[0][i] = max(g[0][i], g[1][15 - i]); g[2][i] = max(g[2][i], g[3][15 - i]); }
    bitonic_merge16_desc(g[0]); bitonic_merge16_desc(g[2]);
#pragma unroll
    for (int i = 0; i < 16; ++i) g[0][i] = max(g[0][i], g[2][15 - i]);
    bitonic_merge16_desc(g[0]);
#pragma unroll
    for (int i = 0; i < 16; ++i) a[i] = g[0][i];
}
__device__ __forceinline__ void subkey_top16(const GAS bf16_t* qrow  , const GAS bf16_t* sk  , int r32, int hi, int (&top)[16]) {
    bf16x8 qf[8];
#pragma unroll
    for (int ks = 0; ks < 8; ++ks) qf[ks] = *(const GAS bf16x8*)(qrow + ks * 16 + hi * 8);
    unsigned loff = (unsigned)(r32 * 128 + hi * 8) * 2u; asm volatile("" : "+v"(loff));
    int key[64];
#pragma unroll
    for (int kb = 0; kb < 4; ++kb) {
        f32x16 acc = {};
#pragma unroll
        for (int ks = 0; ks < 8; ++ks) { const bf16x8 af = *(const GAS bf16x8*)((const GAS char*)(sk + kb * 32 * 128 + ks * 16) + loff);
            acc = __builtin_amdgcn_mfma_f32_32x32x16_bf16(af, qf[ks], acc, 0, 0, 0); }
#pragma unroll
        for (int r = 0; r < 16; ++r) { const int id = kb * 32 + (r & 3) + 8 * (r >> 2) + 4 * hi; key[kb * 16 + r] = (ord_i(acc[r]) & ~127) | (127 - id); }
        __builtin_amdgcn_sched_barrier(0);
    }
    top16_of_64(key);
#pragma unroll
    for (int i = 0; i < 16; ++i) { auto r = __builtin_amdgcn_permlane32_swap((unsigned)key[15 - i], (unsigned)key[15 - i], false, false);
        const int pk = hi ? (int)r[0] : (int)r[1]; top[i] = max(key[i], pk); }
    bitonic_merge16_desc(top);
}
__device__ __forceinline__ void step_topk(Frame& F, LAS unsigned char* lds, int layer) {
    const GAS bf16_t* q16 = (const GAS bf16_t*)(F.ws + O_Q16); const GAS bf16_t* subk = (const GAS bf16_t*)(F.ws + O_SUBK) + (size_t)layer * 16 * 128 * 128;
    GAS int* IDX = (GAS int*)(F.ws + O_IDX); GAS float* GW = (GAS float*)(F.ws + O_GW);
    LAS int* scr = (LAS int*)(lds + F.wave * 16384) + F.lane * 33;
    const int r32 = F.lane & 31, hi = F.lane >> 5;
    for (int task = F.gw; task < (T / 32) * 8; task += F.ngw) {
        const int tb = task >> 3, h = task & 7; const int tok = tb * 32 + r32;
        const GAS bf16_t* qrow = q16 + (size_t)tok * DM + h * 256;
        int ta[16], tb16[16];
        subkey_top16(qrow, subk + (size_t)(h * 2 + 0) * 128 * 128, r32, hi, ta);
        subkey_top16(qrow + 128, subk + (size_t)(h * 2 + 1) * 128 * 128, r32, hi, tb16);
        float va[16], vb[16];
#pragma unroll
        for (int i = 0; i < 16; ++i) { va[i] = unord_f(ta[i] & ~127); vb[i] = unord_f(tb16[i] & ~127); scr[i] = 127 - (ta[i] & 127); scr[16 + i] = 127 - (tb16[i] & 127); }
        int c2[64]; int n = 0;
#pragma unroll
        for (int i = 0; i < 16; ++i)
#pragma unroll
            for (int j = 0; j < 16; ++j) if ((i + 1) * (j + 1) <= 16) { c2[n] = (ord_i(va[i] + vb[j]) & ~255) | (255 - (i * 16 + j)); ++n; }
#pragma unroll
        for (int i = 50; i < 64; ++i) c2[i] = (int)0x80000000;
        top16_of_64(c2);
        asm volatile("s_waitcnt lgkmcnt(0)" ::: "memory");
        float sv[16], ex[16]; int ev[16]; float Z = 0.f;
#pragma unroll
        for (int r = 0; r < 16; ++r) { const int flat = 255 - (c2[r] & 255); sv[r] = unord_f(c2[r] & ~255); ev[r] = scr[flat >> 4] * 128 + scr[16 + (flat & 15)]; }
#pragma unroll
        for (int r = 0; r < 16; ++r) { ex[r] = fast_exp(sv[r] - sv[0]); Z += ex[r]; }
        const float iz = 1.f / Z;
        GAS int* ip = IDX + (size_t)tok * 128 + h * 16 + hi * 8; GAS float* gp = GW + (size_t)tok * 128 + h * 16 + hi * 8;
        int eo[8]; float go[8];
#pragma unroll
        for (int j = 0; j < 8; ++j) { eo[j] = hi ? ev[8 + j] : ev[j]; go[j] = (hi ? ex[8 + j] : ex[j]) * iz; }
        *(GAS u32x4*)ip = (u32x4){(unsigned)eo[0], (unsigned)eo[1], (unsigned)eo[2], (unsigned)eo[3]}; *(GAS u32x4*)(ip + 4) = (u32x4){(unsigned)eo[4], (unsigned)eo[5], (unsigned)eo[6], (unsigned)eo[7]};
        *(GAS f32x4*)gp = (f32x4){go[0], go[1], go[2], go[3]}; *(GAS f32x4*)(gp + 4) = (f32x4){go[4], go[5], go[6], go[7]};
        asm volatile("s_waitcnt lgkmcnt(0)" ::: "memory");
    }
}
__device__ __forceinline__ h2 as_h2(unsigned w) { return __builtin_bit_cast(h2, w); }
#define F4(W, s) __builtin_amdgcn_cvt_scalef32_pk_f16_fp4((W), 1.0f, (s))
#define H2F(us) ((float)__builtin_bit_cast(_Float16, (unsigned short)(us)))
__device__ __forceinline__ float sum8(float v) { v += dppf<0xB1>(v); v += dppf<0x4E>(v); v += dppf<0x141>(v); return v; }
__device__ __forceinline__ void step_xplanes(Frame& F) {
    const GAS bf16_t* xs = (const GAS bf16_t*)(F.ws + O_XS16); GAS unsigned char* x4 = F.ws + O_X4; GAS float* sx = (GAS float*)(F.ws + O_SX);
    const int tlast = F.gw + ((T - 1 - F.gw) / F.ngw) * F.ngw;
#define XP_LOAD(W, t_) do { const int tt_ = (t_) <= tlast ? (t_) : tlast; _Pragma("unroll") for (int c = 0; c < 4; ++c) W[c] = *(const GAS u32x4*)(xs + (size_t)tt_ * DM + F.lane * 32 + 8 * c); } while (0)
    u32x4 w[4], wn[4];
    XP_LOAD(w, F.gw);
    for (int t = F.gw; t < T; t += F.ngw) {
        XP_LOAD(wn, t + F.ngw);
        float xv[32]; float amax = 0.f;
#pragma unroll
        for (int c = 0; c < 4; ++c)
#pragma unroll
            for (int k = 0; k < 4; ++k) { xv[8 * c + 2 * k] = bf_lo(w[c][k]); xv[8 * c + 2 * k + 1] = bf_hi(w[c][k]); amax = fmaxf(amax, fmaxf(fabsf(xv[8 * c + 2 * k]), fabsf(xv[8 * c + 2 * k + 1]))); }
        amax = fmaxf(amax, dppf<0xB1>(amax)); amax = fmaxf(amax, dppf<0x4E>(amax)); amax = fmaxf(amax, dppf<0x141>(amax));
        const float sc = fmaxf(amax, 1e-20f) * (1.f / 119.f), qs = 1.f / sc;
        u32x4 hp, lp;
#pragma unroll
        for (int d = 0; d < 4; ++d) { unsigned hw = 0u, lw = 0u;
#pragma unroll
            for (int k = 0; k < 8; ++k) { const int q = (int)rintf(xv[8 * d + k] * qs); const int h = (q + 8) >> 4, l = q - 16 * h; hw |= (unsigned)(h & 15) << (4 * k); lw |= (unsigned)(l & 15) << (4 * k); }
            hp[d] = hw; lp[d] = lw; }
        *(GAS u32x4*)(x4 + ((size_t)t * 64 + F.lane) * 32) = hp; *(GAS u32x4*)(x4 + ((size_t)t * 64 + F.lane) * 32 + 16) = lp;
        if ((F.lane & 7) == 0) sx[(size_t)t * 8 + (F.lane >> 3)] = sc;
#pragma unroll
        for (int c = 0; c < 4; ++c) w[c] = wn[c];
    }
#undef XP_LOAD
}
__device__ __forceinline__ void step_upass(Frame& F, int layer, int G) {
    const int s = blockIdx.x & 7, wk = (blockIdx.x >> 3) * NWAVES + F.wave, nwk = (G >> 3) * NWAVES;
    const GAS unsigned char* UN = F.ws + O_TAB + (size_t)(layer * 2) * TAB_ONE + (size_t)s * NEXP * 128;
    const GAS int* IDX = (const GAS int*)(F.ws + O_IDX); const GAS unsigned char* x4 = F.ws + O_X4 + s * 256; const GAS float* sxp = (const GAS float*)(F.ws + O_SX) + s;
    GAS _Float16* part = (GAS _Float16*)(F.ws + O_PART) + (size_t)s * T * 128;
    unsigned lo = (unsigned)F.lane; asm volatile("" : "+v"(lo));
    const unsigned j = lo >> 3, p = lo & 7;
    const int tlast = wk + ((T - 1 - wk) / nwk) * nwk;
#define U_LOADID(ID, t_, q_) do { const int tt_ = (t_) <= tlast ? (t_) : tlast; _Pragma("unroll") for (int b = 0; b < 4; ++b) ID[b] = IDX[(size_t)tt_ * 128 + (q_) * 32 + 8 * b + j]; } while (0)
#define U_LOADX(t_) do { const int tt_ = (t_) <= tlast ? (t_) : tlast; xhn = *(const GAS u32x4*)(x4 + (size_t)tt_ * 2048 + p * 32); xln = *(const GAS u32x4*)(x4 + (size_t)tt_ * 2048 + p * 32 + 16); sxn = sxp[(size_t)tt_ * 8]; } while (0)
#define U_ISSUE(UB, ID) do { _Pragma("unroll") for (int b = 0; b < 4; ++b) UB[b] = *(const GAS u32x4*)(UN + (unsigned)(ID[b] * 128 + (int)p * 16)); } while (0)
#define U_QUARTER(UB, vout, q_) do { _Pragma("unroll") for (int b = 0; b < 4; ++b) { int ah = 0, al = 0; \
            ah = __builtin_amdgcn_sdot8((int)UB[b].x, (int)xh.x, ah, false); al = __builtin_amdgcn_sdot8((int)UB[b].x, (int)xl.x, al, false); \
            ah = __builtin_amdgcn_sdot8((int)UB[b].y, (int)xh.y, ah, false); al = __builtin_amdgcn_sdot8((int)UB[b].y, (int)xl.y, al, false); \
            ah = __builtin_amdgcn_sdot8((int)UB[b].z, (int)xh.z, ah, false); al = __builtin_amdgcn_sdot8((int)UB[b].z, (int)xl.z, al, false); \
            ah = __builtin_amdgcn_sdot8((int)UB[b].w, (int)xh.w, ah, false); al = __builtin_amdgcn_sdot8((int)UB[b].w, (int)xl.w, al, false); \
            const float d = sum8((float)(16 * ah + al)) * sxc; vout = (p == (unsigned)(4 * ((q_) & 1) + b)) ? d : vout; } } while (0)
    int idA[4], idB[4]; u32x4 u0[4], u1[4], u2[4], u3[4]; u32x4 xh, xl, xhn, xln; float sxc, sxn;
    U_LOADID(idA, wk, 0); U_LOADID(idB, wk, 1); U_LOADX(wk);
    U_ISSUE(u0, idA); U_LOADID(idA, wk, 2);
    U_ISSUE(u1, idB); U_LOADID(idB, wk, 3);
    U_ISSUE(u2, idA); U_LOADID(idA, wk + nwk, 0);
    xh = xhn; xl = xln; sxc = sxn;
    for (int t = wk; t < T; t += nwk) {
        float v0 = 0.f, v1 = 0.f;
        U_ISSUE(u3, idB); U_LOADID(idB, t + nwk, 1); U_LOADX(t + nwk);
        U_QUARTER(u0, v0, 0);
        U_ISSUE(u0, idA); U_LOADID(idA, t + nwk, 2);
        U_QUARTER(u1, v0, 1);
        U_ISSUE(u1, idB); U_LOADID(idB, t + nwk, 3);
        U_QUARTER(u2, v1, 2);
        U_ISSUE(u2, idA); U_LOADID(idA, t + 2 * nwk, 0);
        U_QUARTER(u3, v1, 3);
        part[(size_t)t * 128 + 8 * p + j] = (_Float16)v0; part[(size_t)t * 128 + 64 + 8 * p + j] = (_Float16)v1;
        xh = xhn; xl = xln; sxc = sxn;
    }
#undef U_LOADID
#undef U_LOADX
#undef U_ISSUE
#undef U_QUARTER
}
__device__ __forceinline__ void step_peer_reduce(Frame& F, int layer) {
    const GAS _Float16* part = (const GAS _Float16*)(F.ws + O_PART); const GAS float* GW = (const GAS float*)(F.ws + O_GW); const GAS int* IDX = (const GAS int*)(F.ws + O_IDX);
    const GAS float* rowss = (const GAS float*)(F.ws + O_ROWSS); GAS unsigned* PK = (GAS unsigned*)(F.ws + O_PK);
    const GAS unsigned char* SU = F.ws + O_TAB + (size_t)(layer * 2) * TAB_ONE + TAB_NIB; const GAS unsigned char* SV = SU + TAB_ONE;
    constexpr int NIT = T * 2;
    struct SA { int id; float gw, rs; float p[8]; }; struct SB { u32x4 su, sv; };
#define RA(X, it_) do { const int ii_ = (it_) < NIT ? (it_) : NIT - 1; const size_t i_ = (size_t)ii_ * 64 + F.lane; X.id = IDX[i_]; X.gw = GW[i_]; X.rs = rowss[(size_t)(ii_ >> 1) * 32 + (F.lane & 31)]; \
        _Pragma("unroll") for (int s = 0; s < 8; ++s) X.p[s] = (float)part[(size_t)s * T * 128 + i_]; } while (0)
#define RB(Y, X) do { Y.su = *(const GAS u32x4*)(SU + (size_t)X.id * 16); Y.sv = *(const GAS u32x4*)(SV + (size_t)X.id * 16); } while (0)
#define RC(X, Y, it_) do { if ((it_) < NIT) { const size_t i_ = (size_t)(it_) * 64 + F.lane; const float r = rsqrtf(wave_sum(X.rs) * (0.5f / DM) + EPS); float d = 0.f; \
        _Pragma("unroll") for (int s = 0; s < 8; ++s) d += X.p[s] * (float)__builtin_bit_cast(_Float16, (unsigned short)(Y.su[s >> 1] >> (16 * (s & 1)))); \
        const float w = X.gw * gelu_tanh(d * r); \
        _Pragma("unroll") for (int s = 0; s < 8; ++s) { const _Float16 ws = (_Float16)(w * (float)__builtin_bit_cast(_Float16, (unsigned short)(Y.sv[s >> 1] >> (16 * (s & 1))))); \
            PK[(size_t)s * T * 128 + i_] = ((unsigned)X.id << 16) | (unsigned)__builtin_bit_cast(unsigned short, ws); } } } while (0)
    SA a0, a1, a2; SB b0, b1;
    RA(a0, F.gw); RA(a1, F.gw + F.ngw); RB(b0, a0);
    for (int it = F.gw; it < NIT; it += F.ngw) {
        RA(a2, it + 2 * F.ngw); RB(b1, a1);
        RC(a0, b0, it);
        a0 = a1; a1 = a2; b0 = b1;
    }
#undef RA
#undef RB
#undef RC
}
__device__ __forceinline__ void step_vpass(Frame& F, int layer, int G, bool dry) {
    const int s = blockIdx.x & 7, wk = (blockIdx.x >> 3) * NWAVES + F.wave, nwk = (G >> 3) * NWAVES;
    const GAS unsigned char* VN = F.ws + O_TAB + (size_t)(layer * 2 + 1) * TAB_ONE + (size_t)s * NEXP * 128;
    const GAS unsigned* PK = (const GAS unsigned*)(F.ws + O_PK) + (size_t)s * T * 128;
    GAS bf16_t* xs = (GAS bf16_t*)(F.ws + O_XS16); GAS float* rsp = (GAS float*)(F.ws + O_RSP);
    unsigned lo = (unsigned)F.lane; asm volatile("" : "+v"(lo));
    const unsigned j = lo >> 3, p = lo & 7;
    const int tlast = wk + ((T - 1 - wk) / nwk) * nwk;
#define V_LOADPK(PKV, t_, q_) do { const int tt_ = (t_) <= tlast ? (t_) : tlast; _Pragma("unroll") for (int b = 0; b < 4; ++b) PKV[b] = PK[(size_t)tt_ * 128 + (q_) * 32 + 8 * b + j]; } while (0)
#define V_ISSUE(VB, PKV) do { _Pragma("unroll") for (int b = 0; b < 4; ++b) VB[b] = *(const GAS u32x4*)(VN + ((PKV[b] >> 16) * 128u + p * 16u)); } while (0)
#define V_CVT4(W, base) do { c_[(base)] = F4(W, 0); c_[(base) + 1] = F4(W, 1); c_[(base) + 2] = F4(W, 2); c_[(base) + 3] = F4(W, 3); } while (0)
#define V_QUARTER(VB, PKV) do { _Pragma("unroll") for (int b = 0; b < 4; ++b) { const _Float16 wl = __builtin_bit_cast(_Float16, (unsigned short)(PKV[b] & 0xffffu)); const h2 wl2 = {wl, wl}; h2 c_[16]; \
            V_CVT4(VB[b].x, 0); V_CVT4(VB[b].y, 4); V_CVT4(VB[b].z, 8); V_CVT4(VB[b].w, 12); \
            __builtin_amdgcn_sched_barrier(0); \
            _Pragma("unroll") for (int k = 0; k < 16; ++k) oh[k] = wl2 * c_[k] + oh[k]; \
            __builtin_amdgcn_sched_barrier(0); } } while (0)
    unsigned pk0[4], pk1[4], pk2[4], pk3[4], pkn[4]; u32x4 v0[4], v1[4], v2[4], v3[4];
    V_LOADPK(pk0, wk, 0); V_LOADPK(pk1, wk, 1); V_LOADPK(pk2, wk, 2); V_LOADPK(pkn, wk, 3);
    V_ISSUE(v0, pk0); V_ISSUE(v1, pk1); V_ISSUE(v2, pk2);
    for (int t = wk; t < T; t += nwk) {
#pragma unroll
        for (int b = 0; b < 4; ++b) pk3[b] = pkn[b];
        V_ISSUE(v3, pk3); V_LOADPK(pkn, t + nwk, 0);
        GAS bf16_t* xb = xs + (size_t)t * DM + s * 256 + p * 32 + j * 4;
        f32x4 x2; { const u32x2 w = *(const GAS u32x2*)xb; x2 = (f32x4){bf_lo(w.x), bf_hi(w.x), bf_lo(w.y), bf_hi(w.y)}; }
        h2 oh[16];
#pragma unroll
        for (int i = 0; i < 16; ++i) oh[i] = (h2){(_Float16)0.f, (_Float16)0.f};
        V_QUARTER(v0, pk0);
#pragma unroll
        for (int b = 0; b < 4; ++b) pk0[b] = pkn[b];
        V_ISSUE(v0, pk0); V_LOADPK(pkn, t + nwk, 1);
        V_QUARTER(v1, pk1);
#pragma unroll
        for (int b = 0; b < 4; ++b) pk1[b] = pkn[b];
        V_ISSUE(v1, pk1); V_LOADPK(pkn, t + nwk, 2);
        V_QUARTER(v2, pk2);
#pragma unroll
        for (int b = 0; b < 4; ++b) pk2[b] = pkn[b];
        V_ISSUE(v2, pk2); V_LOADPK(pkn, t + nwk, 3);
        V_QUARTER(v3, pk3);
#pragma unroll
        for (int i = 0; i < 16; ++i) { unsigned u = __builtin_bit_cast(unsigned, oh[i]);
            h2 a = as_h2(u) + as_h2((unsigned)__builtin_amdgcn_update_dpp(0, (int)u, 0x128, 0xF, 0xF, true)); u = __builtin_bit_cast(unsigned, a);
            { auto r = __builtin_amdgcn_permlane16_swap(u, u, false, false); a = as_h2(r[0]) + as_h2(r[1]); u = __builtin_bit_cast(unsigned, a); }
            { auto r = __builtin_amdgcn_permlane32_swap(u, u, false, false); a = as_h2(r[0]) + as_h2(r[1]); }
            oh[i] = a; }
        h2 o0 = oh[0], o1 = oh[1];
#pragma unroll
        for (int c = 1; c < 8; ++c) { o0 = (j == (unsigned)c) ? oh[2 * c] : o0; o1 = (j == (unsigned)c) ? oh[2 * c + 1] : o1; }
        x2[0] += (float)o0.x; x2[1] += (float)o0.y; x2[2] += (float)o1.x; x2[3] += (float)o1.y;
        if (layer == 1 && !dry) *(GAS f32x4*)(F.out + (size_t)t * DM + s * 256 + p * 32 + j * 4) = x2;
        if (layer == 0 && !dry) {
            { u32x2 o; o.x = cvtpk(x2[0], x2[1]); o.y = cvtpk(x2[2], x2[3]); *(GAS u32x2*)xb = o; }
            const float sst = wave_sum((x2[0] * x2[0] + x2[1] * x2[1]) + (x2[2] * x2[2] + x2[3] * x2[3]));
            if (lo == 0) rsp[(size_t)t * 8 + s] = sst;
        }
    }
#undef V_LOADPK
#undef V_ISSUE
#undef V_CVT4
#undef V_QUARTER
}
#undef F4
#undef H2F
__device__ __forceinline__ void step_logf(Frame& F, LAS unsigned char* lds) {
    const GAS bf16_t* xs = (const GAS bf16_t*)(F.ws + O_XS16); const GAS float* rsp = (const GAS float*)(F.ws + O_RSP); GAS float* logf = (GAS float*)(F.ws + O_LOGF);
    const GAS float* wf = (const GAS float*)(F.ws + O_WF); LAS float* wl = (LAS float*)lds;
    for (int i = F.tid; i < NH * DM / 4; i += NTHREADS) *(LAS f32x4*)(wl + 4 * i) = *(const GAS f32x4*)(wf + 4 * i);
    __syncthreads();
    const int tlast = F.gw + ((T - 1 - F.gw) / F.ngw) * F.ngw;
    unsigned lo = (unsigned)F.lane; asm volatile("" : "+v"(lo));
#define LF_LOAD(W, Q, t_) do { const int tt_ = (t_) <= tlast ? (t_) : tlast; _Pragma("unroll") for (int c = 0; c < 8; ++c) W[c] = *(const GAS u32x2*)(xs + (size_t)tt_ * DM + c * 256 + lo * 4); Q = lo < 8 ? rsp[(size_t)tt_ * 8 + lo] : 0.f; } while (0)
    u32x2 w[8], wn[8]; float q, qn;
    LF_LOAD(w, q, F.gw);
    for (int t = F.gw; t < T; t += F.ngw) {
        LF_LOAD(wn, qn, t + F.ngw);
        asm volatile("" : "+v"(lo));
        const float r1 = rsqrtf(wave_sum(q) * (1.f / DM) + EPS);
        float mine = 0.f;
#pragma unroll 2
        for (int h = 0; h < NH; ++h) { float d = 0.f;
#pragma unroll
            for (int c = 0; c < 8; ++c) { const f32x4 g = *(const LAS f32x4*)(wl + h * DM + c * 256 + lo * 4);
                d += (bf_lo(w[c].x) * g[0] + bf_hi(w[c].x) * g[1]) + (bf_lo(w[c].y) * g[2] + bf_hi(w[c].y) * g[3]); }
            d = wave_sum(d); mine = (lo == (unsigned)h) ? d : mine; }
        if (lo < (unsigned)NH) { const float z = mine * r1 + F.in(I_SBF)[lo];
            logf[((size_t)(t / SEQ) * NH + lo) * SEQ + (t % SEQ)] = fminf(z, 0.f) - log1p_pos(fast_exp(-fabsf(z))); }
#pragma unroll
        for (int c = 0; c < 8; ++c) w[c] = wn[c];
        q = qn;
    }
#undef LF_LOAD
    __syncthreads();
}

#define XB_TMO      128
#define XB_XCNT(j)  (256  + 64 * (j))
#define XB_XSUB(j)  (1280 + 64 * (j))
#define XB_XGEN(j)  (2304 + 64 * (j))
#define XB_TOP      3328
#define XB_TOPGEN   3392
#define XCD_BAR_WORDS 3456
#define XB_SPIN_CAP (1u << 20)
__device__ __forceinline__ unsigned xb_ld(unsigned* p)              { return __hip_atomic_load(p, __ATOMIC_RELAXED, __HIP_MEMORY_SCOPE_AGENT); }
__device__ __forceinline__ unsigned xb_add(unsigned* p, unsigned v) { return __hip_atomic_fetch_add(p, v, __ATOMIC_RELAXED, __HIP_MEMORY_SCOPE_AGENT); }
__device__ __forceinline__ unsigned xb_xcc_id() { return (unsigned)__builtin_amdgcn_s_getreg((3 << 11) | 20) & 0xFu; }
#define XB_SPIN(cond, bar) do { unsigned _sp = 0; while (cond) { __builtin_amdgcn_s_sleep(1); \
    if ((++_sp & 255u) == 0u) { if (xb_ld(&(bar)[XB_TMO])) break; if (_sp > XB_SPIN_CAP) { atomicAdd(&(bar)[XB_TMO], 1u); break; } } } } while (0)
struct XcdBarrier { unsigned* bar; unsigned x; volatile LAS unsigned* st; };
__device__ __forceinline__ XcdBarrier xcd_barrier_post(unsigned* bar, volatile LAS unsigned* st) {
    XcdBarrier b; b.bar = bar; b.x = xb_xcc_id(); b.st = st;
    if (threadIdx.x == 0) (void)xb_add(&bar[XB_XCNT(b.x)], 1u);
    return b;
}
__device__ __forceinline__ void xcd_barrier_complete(unsigned* bar, unsigned x, unsigned& nloc, unsigned& nx) {
    const unsigned G = gridDim.x * gridDim.y * gridDim.z;
    unsigned sum, cnt, mine, sp = 0u;
    for (;;) {
        sum = 0u; cnt = 0u; mine = 0u;
#pragma unroll
        for (unsigned j = 0; j < 16; ++j) { const unsigned c = xb_ld(&bar[XB_XCNT(j)]); sum += c; cnt += (c > 0u) ? 1u : 0u; mine = (j == x) ? c : mine; }
        if (sum == G) break;
        __builtin_amdgcn_s_sleep(1);
        if ((++sp & 255u) == 0u) { if (xb_ld(&bar[XB_TMO])) break; if (sp > XB_SPIN_CAP) { atomicAdd(&bar[XB_TMO], 1u); break; } }
    }
    nloc = mine > 0u ? mine : 1u; nx = cnt > 0u ? cnt : 1u;
}
__device__ __forceinline__ void xcd_barrier(const XcdBarrier& b, int wave_s) {
    asm volatile("s_waitcnt vmcnt(0)" ::: "memory");
    __syncthreads();
    int ln_; asm volatile("v_mbcnt_lo_u32_b32 %0, -1, 0\n\tv_mbcnt_hi_u32_b32 %0, -1, %0" : "=v"(ln_));
    if (wave_s == 0 && ln_ == 0) {
        unsigned* bar = b.bar;
        __builtin_amdgcn_s_waitcnt(0);
        unsigned nloc = b.st[0], nx = b.st[1];
        if (nloc == 0u) { xcd_barrier_complete(bar, b.x, nloc, nx); b.st[0] = nloc; b.st[1] = nx; }
        const unsigned old = xb_add(&bar[XB_XSUB(b.x)], 1u);
        const unsigned gen = old / nloc;
        if (old + 1u == (gen + 1u) * nloc) {
            __builtin_amdgcn_fence(__ATOMIC_RELEASE, "agent");
            asm volatile("s_waitcnt vmcnt(0)" ::: "memory");
            const unsigned og = xb_add(&bar[XB_TOP], 1u);
            const unsigned tg = og / nx;
            if (og + 1u == (tg + 1u) * nx) xb_add(&bar[XB_TOPGEN], 1u);
            else XB_SPIN(xb_ld(&bar[XB_TOPGEN]) == tg, bar);
            __builtin_amdgcn_fence(__ATOMIC_ACQUIRE, "agent");
            xb_add(&bar[XB_XGEN(b.x)], 1u);
            asm volatile("s_waitcnt vmcnt(0)" ::: "memory");
        } else {
            XB_SPIN(xb_ld(&bar[XB_XGEN(b.x)]) == gen, bar);
            __builtin_amdgcn_fence(__ATOMIC_ACQUIRE, "agent");
            asm volatile("s_waitcnt vmcnt(0)" ::: "memory");
        }
    }
    __syncthreads();
}

constexpr int CONV1_SPLIT = 2 * 4608;
constexpr int BAR_LDS_OFF = 147456 - 64;
constexpr int LDS_BYTES = 147456;
enum { ST_PROLOGUE = 0, ST_G_IN0, ST_G_MKV0, ST_G_MKV1, ST_CONV, ST_G_GATE, ST_A_MEM0, ST_SCAN1, ST_SCAN2, ST_G_OUT0, ST_G_PQ0, ST_TOPK0, ST_UPASS0, ST_PRED0, ST_VPASS0,
       ST_G_L1, ST_CPREFIX, ST_A_FOX, ST_A_MEM1, ST_G_OUT1, ST_G_PQ1, ST_TOPK1, ST_UPASS1, ST_PRED1, ST_VPASS1, N_STEPS };
constexpr unsigned SYNC_AFTER = (1u << ST_PROLOGUE) | (1u << ST_G_MKV1) | (1u << ST_CONV) | (1u << ST_A_MEM0) | (1u << ST_SCAN1) | (1u << ST_SCAN2) | (1u << ST_G_OUT0) | (1u << ST_G_PQ0) |
                                (1u << ST_TOPK0) | (1u << ST_UPASS0) | (1u << ST_PRED0) | (1u << ST_VPASS0) | (1u << ST_G_L1) | (1u << ST_CPREFIX) | (1u << ST_A_MEM1) | (1u << ST_G_OUT1) | (1u << ST_G_PQ1) | (1u << ST_TOPK1) | (1u << ST_UPASS1) | (1u << ST_PRED1);
constexpr unsigned GEMM_STEPS = (1u << ST_G_IN0) | (1u << ST_G_MKV0) | (1u << ST_G_MKV1) | (1u << ST_G_GATE) | (1u << ST_G_OUT0) | (1u << ST_G_PQ0) | (1u << ST_G_L1) | (1u << ST_G_OUT1) | (1u << ST_G_PQ1);
constexpr unsigned ATTN_STEPS = (1u << ST_A_MEM0) | (1u << ST_A_FOX) | (1u << ST_A_MEM1);

struct Args { const float* in[N_IN]; float* out; unsigned char* ws; int lo, hi; };

__global__ void __launch_bounds__(NTHREADS, 2) yoco_fwd(Args args) {
    extern __shared__ __attribute__((aligned(16))) unsigned char lds[];
    volatile LAS unsigned* bst = (volatile LAS unsigned*)((LAS unsigned char*)lds + BAR_LDS_OFF);
    if (threadIdx.x == 0) { bst[0] = 0u; bst[1] = 0u; }
    __syncthreads();
    const XcdBarrier gbar = xcd_barrier_post((unsigned*)(args.ws + O_CTL), bst);
    const int G = gridDim.x;
    const int wave_s = __builtin_amdgcn_readfirstlane(threadIdx.x >> 6);
#ifndef DUP_MASK
#define DUP_MASK 0u
#endif
    for (int st = args.lo; st < args.hi; ++st) {
      const int nrep = ((DUP_MASK >> st) & 1u) ? 2 : 1;
      for (int rep = 0; rep < nrep; ++rep) {
        unsigned char* ws0 = args.ws; asm volatile("" : "+s"(ws0));
        GAS unsigned char* ws = (GAS unsigned char*)ws0;
#define LANE_ID(v) asm volatile("v_mbcnt_lo_u32_b32 %0, -1, 0\n\tv_mbcnt_hi_u32_b32 %0, -1, %0" : "=v"(v))
#define MAKE_TID(v) do { LANE_ID(v); v += wave_s * 64; } while (0)
#define MAKE_FRAME(F) Frame F; F.ws = ws; F.in_ = args.in; F.out = (GAS float*)args.out; { int t0_; MAKE_TID(t0_); F.tid = t0_; } F.lane = F.tid & 63; F.wave = wave_s; \
        F.gw = blockIdx.x * NWAVES + F.wave; F.ngw = gridDim.x * NWAVES; F.gtid = blockIdx.x * NTHREADS + F.tid; F.ngt = gridDim.x * NTHREADS
        if (st == ST_G_L1) { MAKE_FRAME(F); step_logf(F, (LAS unsigned char*)lds); }
        if ((GEMM_STEPS >> st) & 1u) {
            pg8::Gemm g; Epi E; E.ws = ws; E.resid = nullptr; E.outf = nullptr; E.o16 = nullptr; E.ssq = nullptr; E.gate_b = nullptr; int shift = 0;
            switch (st) {
            case ST_G_IN0:  g = {(const GAS bf16_t*)(ws + O_XS16), (const GAS bf16_t*)(ws + O_WIN0), T, NIN0, DM, DM, DM, 0}; E.mode = EM_IN0; break;
            case ST_G_MKV0: g = {(const GAS bf16_t*)(ws + O_MEMN), (const GAS bf16_t*)(ws + O_WMKV), NMROW, 1024, DM, DM, DM, 0}; E.mode = EM_MKV; E.o16 = (GAS bf16_t*)(ws + O_MKV); E.ssq = (GAS float*)(ws + O_MKSS); shift = 128; break;
            case ST_G_MKV1: g = {(const GAS bf16_t*)(ws + O_MEMN) + (size_t)NMROW * DM, (const GAS bf16_t*)(ws + O_WMKV) + (size_t)1024 * DM, NMROW, 1024, DM, DM, DM, 0}; E.mode = EM_MKV;
                            E.o16 = (GAS bf16_t*)(ws + O_MKV) + (size_t)NMROW * NL1; E.ssq = (GAS float*)(ws + O_MKSS) + NMROW * 112; shift = 144; break;
            case ST_G_GATE: g = {(const GAS bf16_t*)(ws + O_XC), (const GAS bf16_t*)(ws + O_WGATE), T, 12 * 256, 128, LRU, 128, 128}; E.mode = EM_GATE; E.gate_b = (const GAS float*)args.in[I_AGATEB]; break;
            case ST_G_OUT0: g = {(const GAS bf16_t*)(ws + O_CAT), (const GAS bf16_t*)(ws + O_WOUT0), T, DM, DM, DM, DM, 0}; E.mode = EM_RES; E.resid = (const GAS float*)args.in[I_X]; E.outf = (GAS float*)args.out; break;
            case ST_G_PQ0:  g = {(const GAS bf16_t*)(ws + O_XS16), (const GAS bf16_t*)(ws + O_WQ0), T, DM, DM, DM, DM, 0}; E.mode = EM_PQ; E.o16 = (GAS bf16_t*)(ws + O_Q16); break;
            case ST_G_L1:   g = {(const GAS bf16_t*)(ws + O_XS16), (const GAS bf16_t*)(ws + O_WL1), T, NL1, DM, DM, DM, 0}; E.mode = EM_L1; break;
            case ST_G_OUT1: g = {(const GAS bf16_t*)(ws + O_CAT), (const GAS bf16_t*)(ws + O_WOUT1), T, DM, DM, DM, DM, 0}; E.mode = EM_RES; E.resid = nullptr; break;
            default:        g = {(const GAS bf16_t*)(ws + O_XS16), (const GAS bf16_t*)(ws + O_WQ1), T, DM, DM, DM, DM, 0}; E.mode = EM_PQ; E.o16 = (GAS bf16_t*)(ws + O_Q16); break;
            }
            pg8::StaticOrder S; S.init(g.M, g.N, G, (int)((blockIdx.x + G - shift) % G));
#ifndef DIS_GEMM
            { int tg_; MAKE_TID(tg_);
              pg8::gemm_phase<Epi, false>((LAS unsigned char*)lds, g, S, E, tg_); }
#endif
            if (st == ST_G_MKV1 && blockIdx.x >= 160) { MAKE_FRAME(F); convert_tables(F, 1, 0, CONV1_SPLIT, (blockIdx.x - 160) * NWAVES + F.wave, (G - 160) * NWAVES); }
        } else if ((ATTN_STEPS >> st) & 1u) {
            const int nun = st == ST_A_FOX ? 3 : 1;
            for (int ui = 0; ui < nun; ++ui) {
                att::BlockRef r;
                if (st == ST_A_FOX) {
                    const int i = blockIdx.x, x = i & 15, bh = (i >> 4) + 16 * ui, qb = ui == 0 ? x : (ui == 1 ? 15 - x : ((x * 5 + 3) & 15));
                    const int b = bh / NH, h = bh % NH; const size_t row0 = (size_t)b * SEQ + qb * 256;
                    const GAS bf16_t* z = (const GAS bf16_t*)(ws + O_ZL1);
                    r.Q = z + row0 * NL1 + 3072 + h * 128; r.K = z + (size_t)b * SEQ * NL1 + h * 128; r.V = z + (size_t)b * SEQ * NL1 + 1536 + h * 128;
                    r.O = (GAS bf16_t*)(ws + O_CAT) + row0 * DM + h * 128;
                    const GAS float* ss = (const GAS float*)(ws + O_SSL1);
                    r.qss = ss + row0 * 112 + (12 + h) * 4; r.kss = ss + (size_t)b * SEQ * 112 + h * 4; r.cc = (const GAS float*)(ws + O_CC) + (size_t)bh * SEQ; r.gg = (const GAS float*)(ws + O_GG) + 384;
                    r.P0 = qb * 256; r.skv = SEQ;
                } else {
                    const int l = st == ST_A_MEM0 ? 0 : 1; const int i = blockIdx.x, qblk = i >> 2, h = i & 3, b = qblk >> 4; const size_t row0 = (size_t)qblk * 256;
                    r.Q = (const GAS bf16_t*)(ws + O_ZL1) + row0 * NL1 + 4608 + h * 128; r.qss = (const GAS float*)(ws + O_SSL1) + row0 * 112 + (24 + h) * 4;
                    const GAS bf16_t* kv = (const GAS bf16_t*)(ws + O_MKV) + ((size_t)l * NMROW + b * NMEM) * NL1;
                    r.K = kv + h * 128; r.V = kv + 512 + h * 128; r.kss = (const GAS float*)(ws + O_MKSS) + ((size_t)l * NMROW + b * NMEM) * 112 + h * 4;
                    r.O = (GAS bf16_t*)(ws + O_CAT) + row0 * DM + LRU + h * 128; r.cc = nullptr; r.gg = (const GAS float*)(ws + O_GG) + 128 * (1 + l);
                    r.P0 = SEQ; r.skv = NMEM;
                }
                att::Seam S;
                int tid_u; MAKE_TID(tid_u);
#ifndef DIS_ATTN
                att::attn_prime(r, (char*)lds, S, tid_u);
                att::attn_block(r, (char*)lds, S, tid_u);
#endif
            }
        } else {
            MAKE_FRAME(F);
            switch (st) {
#ifndef DIS_MISC
            case ST_PROLOGUE: step_prologue(F, (LAS unsigned char*)lds); break;
            case ST_CONV: step_conv(F); break;
            case ST_SCAN1: step_scan1(F); break;
            case ST_SCAN2: step_scan2(F); break;
#endif
#ifndef DIS_TOPK
            case ST_TOPK0: step_topk(F, (LAS unsigned char*)lds, 0); step_xplanes(F); break;
            case ST_TOPK1: step_topk(F, (LAS unsigned char*)lds, 1); step_xplanes(F); break;
#endif
#ifndef DIS_GATHER
            case ST_UPASS0: step_upass(F, 0, G); break;
            case ST_UPASS1: step_upass(F, 1, G); break;
            case ST_PRED0: step_peer_reduce(F, 0); break;
            case ST_PRED1: step_peer_reduce(F, 1); break;
            case ST_VPASS0: step_vpass(F, 0, G, rep + 1 < nrep); break;
            case ST_VPASS1: step_vpass(F, 1, G, rep + 1 < nrep); break;
#endif
#ifndef DIS_MISC
            case ST_CPREFIX: step_cprefix(F, (LAS unsigned char*)lds); convert_tables(F, 1, G > 160 ? CONV1_SPLIT : 0, 2 * NEXP, F.gw, F.ngw); break;
#endif
            default: break;
            }
        }
        if (rep + 1 < nrep) xcd_barrier(gbar, wave_s);
      }
        if (((SYNC_AFTER >> st) & 1u) && st + 1 < args.hi) xcd_barrier(gbar, wave_s);
    }
}

#ifndef N_LAUNCH_MODE
#define N_LAUNCH_MODE 1
#endif
extern "C" void kernel_launch(void* const* d_in, const int* in_sizes, int n_in, void* d_out, int out_size, void* d_ws, size_t ws_size, hipStream_t stream) {
    static int grid = 0;
    if (grid == 0) {
        if (n_in != N_IN || in_sizes[0] != T * DM || out_size != T * DM || ws_size < WS_END) {
            fprintf(stderr, "kernel_launch: unexpected shapes (n_in %d, in0 %d, out %d, ws %zu, need %zu)\n", n_in, n_in > 0 ? in_sizes[0] : -1, out_size, ws_size, (size_t)WS_END); grid = -1; return; }
        int dev = 0, cus = 0, per_cu = 0;
        hipGetDevice(&dev); hipDeviceGetAttribute(&cus, hipDeviceAttributeMultiprocessorCount, dev);
        hipFuncSetAttribute((const void*)yoco_fwd, hipFuncAttributeMaxDynamicSharedMemorySize, LDS_BYTES);
        hipOccupancyMaxActiveBlocksPerMultiprocessor(&per_cu, (const void*)yoco_fwd, NTHREADS, LDS_BYTES);
        if (per_cu < 1) { fprintf(stderr, "kernel_launch: occupancy query says %d blocks per CU\n", per_cu); grid = -1; return; }
        grid = cus - cus % 8;
        (void)hipGetLastError();
    }
    if (grid < 0) return;
    Args a{};
    for (int i = 0; i < N_IN; ++i) a.in[i] = (const float*)d_in[i];
    a.out = (float*)d_out; a.ws = (unsigned char*)d_ws;
    if (hipMemsetAsync((char*)d_ws + O_CTL, 0, 65536, stream) != hipSuccess) { fprintf(stderr, "kernel_launch: memset of the barrier words failed\n"); return; }
    if (N_LAUNCH_MODE == 1) {
        a.lo = 0; a.hi = N_STEPS;
        hipLaunchKernelGGL(yoco_fwd, dim3(grid), dim3(NTHREADS), LDS_BYTES, stream, a);
        hipError_t e = hipPeekAtLastError();
        if (e != hipSuccess) fprintf(stderr, "launch failed: %s (grid %d)\n", hipGetErrorString(e), grid);
    } else {
        int lo = 0;
        for (int s = 0; s < N_STEPS; ++s) {
            if (((SYNC_AFTER >> s) & 1u) || s == N_STEPS - 1) {
                a.lo = lo; a.hi = s + 1; lo = s + 1;
                void* params[] = {&a};
                hipError_t e = hipLaunchCooperativeKernel((const void*)yoco_fwd, dim3(grid), dim3(NTHREADS), params, LDS_BYTES, stream);
                if (e != hipSuccess) { fprintf(stderr, "launch failed: %s\n", hipGetErrorString(e)); break; }
            }
        }
    }
}
```

```cpp
#include <hip/hip_runtime.h>
#include <hip/hip_cooperative_groups.h>
#include <cstdio>
#include <cstdint>
namespace cg = cooperative_groups;

#define LAS __attribute__((address_space(3)))
#define GAS __attribute__((address_space(1)))
typedef unsigned short bf16_t;
typedef short bf16x8 __attribute__((ext_vector_type(8)));
typedef short s16x4 __attribute__((ext_vector_type(4)));
typedef float f32x4 __attribute__((ext_vector_type(4)));
typedef float f32x2 __attribute__((ext_vector_type(2)));
typedef float f32x16 __attribute__((ext_vector_type(16)));
typedef unsigned u32x4 __attribute__((ext_vector_type(4)));
typedef unsigned u32x2 __attribute__((ext_vector_type(2)));
typedef _Float16 h2 __attribute__((ext_vector_type(2)));

constexpr int NB = 4, SEQ = 4096, T = NB * SEQ, DM = 2048, LRU = 1536, MEMW = 512, NMEM = 256, NH = 12, HD = 128;
constexpr int NIN0 = 3584, NL1 = 5120, NEXP = 16384, NMROW = NB * NMEM;
constexpr float EPS = 1e-6f;
constexpr int NTHREADS = 512, NWAVES = 8;

constexpr size_t MiB = 1u << 20;
constexpr size_t O_CTL = 0;
constexpr size_t O_WIN0 = 1 * MiB;
constexpr size_t O_WOUT0 = O_WIN0 + 14 * MiB;
constexpr size_t O_WL1 = O_WOUT0 + 8 * MiB;
constexpr size_t O_WOUT1 = O_WL1 + 20 * MiB;
constexpr size_t O_WQ0 = O_WOUT1 + 8 * MiB;
constexpr size_t O_WQ1 = O_WQ0 + 8 * MiB;
constexpr size_t O_WMKV = O_WQ1 + 8 * MiB;
constexpr size_t O_WGATE = O_WMKV + 8 * MiB;
constexpr size_t O_SUBK = O_WGATE + 1 * MiB;
constexpr size_t O_WF = O_SUBK + 1 * MiB;
constexpr size_t O_SMALL = O_WF + 1 * MiB;
constexpr size_t O_RS1 = O_SMALL;
constexpr size_t O_LOGF = O_SMALL + 64 * 1024;
constexpr size_t O_CC = O_LOGF + 768 * 1024;
constexpr size_t O_GG = O_CC + 768 * 1024;
constexpr size_t O_SPL = O_GG + 4096;
constexpr size_t O_TSC = O_SPL + 8192;
constexpr size_t O_ROWSS = O_SMALL + 2 * MiB;
constexpr size_t O_RSP = O_ROWSS + 2 * MiB;
constexpr size_t O_QMSS = O_RSP;
constexpr size_t O_MKSS = O_QMSS + 1 * MiB;
constexpr size_t O_SSL1 = O_MKSS + 1 * MiB;
constexpr size_t O_CARRY = O_SSL1 + 7 * MiB;
constexpr size_t O_MEMN = O_CARRY + 3 * MiB;
constexpr size_t O_MKV = O_MEMN + 8 * MiB;
constexpr size_t O_IDX = O_MKV + 20 * MiB;
constexpr size_t O_GW = O_IDX + 8 * MiB;
constexpr size_t O_TAB = O_GW + 8 * MiB;
constexpr size_t TAB_NIB = (size_t)8 * 16384 * 128, TAB_ONE = TAB_NIB + (size_t)16384 * 16 + 786432;
constexpr size_t O_XS16 = O_TAB + 128 * MiB;
constexpr size_t O_CAT = O_XS16 + 64 * MiB;
constexpr size_t O_ZX = O_CAT + 64 * MiB;
constexpr size_t O_X8 = O_ZX;
constexpr size_t O_GY = O_ZX + 48 * MiB;
constexpr size_t O_LOGFP = O_GY + 48 * MiB;
constexpr size_t O_QM = O_LOGFP;
constexpr size_t O_XC = O_QM + 16 * MiB;
constexpr size_t O_X4 = O_XC;
constexpr size_t O_SX = O_XC + 32 * MiB;
constexpr size_t O_AA = O_XC + 48 * MiB;
constexpr size_t O_PART = O_AA;
constexpr size_t O_UU = O_AA + 96 * MiB;
constexpr size_t O_PK = O_UU;
constexpr size_t O_Q16 = O_UU + 96 * MiB;
constexpr size_t O_ZL1 = O_Q16 + 64 * MiB;
constexpr size_t WS_END = O_ZL1 + 160 * MiB;
static_assert(WS_END <= 1024 * MiB, "workspace map");

__device__ __forceinline__ unsigned cvtpk(float lo, float hi) { unsigned r; asm volatile("v_cvt_pk_bf16_f32 %0, %1, %2" : "=v"(r) : "v"(lo), "v"(hi)); return r; }
__device__ __forceinline__ float bf_lo(unsigned w) { return __uint_as_float(w << 16); }
__device__ __forceinline__ float bf_hi(unsigned w) { return __uint_as_float(w & 0xffff0000u); }
__device__ __forceinline__ float fast_exp(float x) { return __builtin_amdgcn_exp2f(x * 1.4426950408889634f); }
__device__ __forceinline__ float log1p_pos(float y) { const float ser = y * (1.f - y * (0.5f - y * (0.33333334f - 0.25f * y))); const float lg = __builtin_amdgcn_logf(1.f + y) * 0.6931471805599453f; return y < 0.03f ? ser : lg; }
__device__ __forceinline__ float one_minus_exp(float x) { const float ser = -x * (1.f + x * (0.5f + x * (0.16666667f + x * 0.041666668f))); const float big = 1.f - fast_exp(x); return x > -0.03f ? ser : big; }
__device__ __forceinline__ float sigmoidf_(float x) { return __builtin_amdgcn_rcpf(1.f + fast_exp(-x)); }
__device__ __forceinline__ float gelu_tanh(float x) { const float u = x * (1.f + 0.044715f * x * x); return x * __builtin_amdgcn_rcpf(1.f + __builtin_amdgcn_exp2f(u * (-2.f * 0.7978845608028654f * 1.4426950408889634f))); }
template <int CTRL> __device__ __forceinline__ float dppf(float v) { return __int_as_float(__builtin_amdgcn_update_dpp(0, __float_as_int(v), CTRL, 0xF, 0xF, true)); }
__device__ __forceinline__ float xsum16(float v) { auto r = __builtin_amdgcn_permlane16_swap(__float_as_uint(v), __float_as_uint(v), false, false); return __uint_as_float(r[0]) + __uint_as_float(r[1]); }
__device__ __forceinline__ float xsum32(float v) { auto r = __builtin_amdgcn_permlane32_swap(__float_as_uint(v), __float_as_uint(v), false, false); return __uint_as_float(r[0]) + __uint_as_float(r[1]); }
__device__ __forceinline__ float xmax16(float v) { auto r = __builtin_amdgcn_permlane16_swap(__float_as_uint(v), __float_as_uint(v), false, false); return fmaxf(__uint_as_float(r[0]), __uint_as_float(r[1])); }
__device__ __forceinline__ float xmax32(float v) { auto r = __builtin_amdgcn_permlane32_swap(__float_as_uint(v), __float_as_uint(v), false, false); return fmaxf(__uint_as_float(r[0]), __uint_as_float(r[1])); }
__device__ __forceinline__ float wave_sum(float v) {
    v += dppf<0xB1>(v); v += dppf<0x4E>(v); v += dppf<0x141>(v); v += dppf<0x140>(v);
    v = xsum16(v); v = xsum32(v); return v;
}
__device__ __forceinline__ float wave_max(float v) {
    v = fmaxf(v, dppf<0xB1>(v)); v = fmaxf(v, dppf<0x4E>(v)); v = fmaxf(v, dppf<0x141>(v)); v = fmaxf(v, dppf<0x140>(v));
    v = xmax16(v); v = xmax32(v); return v;
}

namespace pg8 {
constexpr int BM = 256, BK = 64, HALF = 128, HTB = HALF * BK * 2, STAGE_BYTES = 8 * HTB, NXCD = 8, WGM = 8;
__host__ __device__ __forceinline__ int lds_byte(int r, int c) { const int st = (r >> 4) * 2 + (c >> 5), rr = r & 15, cc = c & 31, ob = rr * 64 + cc * 2; return st * 1024 + (ob ^ (((ob >> 9) & 1) << 5)); }
__host__ __device__ __forceinline__ void stage_rc(int b, int& R, int& C) { const int st = b / 1024, sb = b % 1024, swz = sb ^ (((sb >> 9) & 1) << 5); R = (st >> 1) * 16 + swz / 64; C = (st & 1) * 32 + (swz % 64) / 2; }
__host__ __device__ __forceinline__ int perm32(int rho) { const int n = rho >> 4, i = rho & 15; return 8 * (i >> 2) + 4 * n + (i & 3); }

struct Unit { int pm, pn; };
struct Gemm { const GAS bf16_t* A; const GAS bf16_t* Bt; int M, N, K, lda, ldb, acol; };

struct StaticOrder {
    int nM, nN, nwg, G, c;
    __device__ void init(int M, int N, int G_, int c_) { nM = M / BM; nN = N / BM; nwg = nM * nN; G = G_; c = c_; }
    __device__ bool next(int i, Unit& u) const {
        const long L = (long)i * G + c; if (L >= nwg) return false;
        int wgid = (int)L; { const int q = nwg / NXCD, r = nwg % NXCD, xcd = wgid % NXCD, off = wgid / NXCD; wgid = (xcd < r ? xcd * (q + 1) : r * (q + 1) + (xcd - r) * q) + off; }
        const int nig = WGM * nN, gid = wgid / nig, fm = gid * WGM, gsz = (nM - fm) < WGM ? (nM - fm) : WGM;
        u.pm = fm + ((wgid % nig) % gsz); u.pn = (wgid % nig) / gsz; return true;
    }
};

typedef int v8i_t __attribute__((ext_vector_type(8)));
typedef int v4i_t __attribute__((ext_vector_type(4)));
template <class Epi, bool FP8>
__device__ __forceinline__ void gemm_phase(LAS unsigned char* lds, const Gemm g, const StaticOrder& S, const Epi& E, const int tid) {
    const int wid = __builtin_amdgcn_readfirstlane(tid >> 6), lane = tid & 63, wr = wid >> 2, wc = wid & 3, fr = lane & 15, fq = lane >> 4;
    const int K = g.K, nt = K / BK;
    unsigned voffA[2], voffB[2];
#pragma unroll
    for (int i = 0; i < 2; ++i) { int R, C; stage_rc(tid * 16 + i * 8192, R, C); const int Rb = (R & ~31) + perm32(R & 31);
        voffA[i] = (unsigned)(R * g.lda + C) * 2u; voffB[i] = (unsigned)(Rb * g.ldb + C) * 2u; }
    const size_t kstep = (size_t)(BK * 2);
    const size_t hstepA = (size_t)HALF * g.lda * 2, hstepB = (size_t)HALF * g.ldb * 2;
    const size_t tstepA = 2 * hstepA, tstepB = 2 * hstepB;
    const unsigned ldsw = (unsigned)wid * 1024u;
    const int aoff = lds_byte(wr * 64 + fr, fq * 8), boff = lds_byte(wc * 32 + fr, fq * 8);
#define PG8_SA(b, h) (((b) * 2 + (h)) * HTB)
#define PG8_SB(b, h) ((4 + (b) * 2 + (h)) * HTB)
#define PG8_STAGE(bufoff, gbase, voff) do { _Pragma("unroll") for (int _i = 0; _i < 2; ++_i) \
        __builtin_amdgcn_global_load_lds((const GAS unsigned*)((gbase) + (voff)[_i]), (LAS unsigned*)(lds + (bufoff) + ldsw + _i * 8192), 16, 0, 0); } while (0)
#define PG8_LD2(dst, off_) do { const u32x4 lo_ = *(const LAS u32x4*)(lds + (off_)), hi_ = *(const LAS u32x4*)(lds + (off_) + 1024); \
        dst = (v8i_t){(int)lo_.x, (int)lo_.y, (int)lo_.z, (int)lo_.w, (int)hi_.x, (int)hi_.y, (int)hi_.z, (int)hi_.w}; } while (0)
#define PG8_LDA(dst, b, h) do { _Pragma("unroll") for (int m = 0; m < 4; ++m) PG8_LD2(dst[m], PG8_SA(b, h) + aoff + m * 2048); } while (0)
#define PG8_LDB(dst, b, h) do { _Pragma("unroll") for (int n = 0; n < 2; ++n) PG8_LD2(dst[n], PG8_SB(b, h) + boff + n * 2048); } while (0)
#define PG8_HALF(v, k) ((k) ? __builtin_shufflevector(v, v, 4, 5, 6, 7) : __builtin_shufflevector(v, v, 0, 1, 2, 3))
#define PG8_MMA(ai, bj, At, Bt) do { __builtin_amdgcn_s_setprio(1); _Pragma("unroll") for (int m = 0; m < 4; ++m) _Pragma("unroll") for (int n = 0; n < 2; ++n) { \
        if constexpr (FP8) asm volatile("v_mfma_scale_f32_16x16x128_f8f6f4 %0, %1, %2, %0, %3, %4 op_sel_hi:[0,0,0]" : "+v"(acc[ai][bj][m][n]) : "v"(Bt[n]), "v"(At[m]), "v"(sc_w), "v"(sc_x));     \
        else { _Pragma("unroll") for (int k = 0; k < 2; ++k) { const v4i_t bh_ = PG8_HALF(Bt[n], k), ah_ = PG8_HALF(At[m], k); \
                acc[ai][bj][m][n] = __builtin_amdgcn_mfma_f32_16x16x32_bf16(__builtin_bit_cast(bf16x8, bh_), __builtin_bit_cast(bf16x8, ah_), acc[ai][bj][m][n], 0, 0, 0); } } } \
        __builtin_amdgcn_s_setprio(0); } while (0)
#define PG8_WAIT_V(n) asm volatile("s_waitcnt vmcnt(" #n ")" ::: "memory")
#define PG8_WAIT_L(n) asm volatile("s_waitcnt lgkmcnt(" #n ")" ::: "memory")
#define PG8_BAR __builtin_amdgcn_s_barrier()
#define PG8_SCHED __builtin_amdgcn_sched_barrier(0)
    Unit cur, nxt; int ui = 0;
    if (!S.next(0, cur)) return;
    f32x4 acc[2][2][4][2];
#pragma unroll
    for (int a = 0; a < 2; ++a)
#pragma unroll
        for (int b = 0; b < 2; ++b)
#pragma unroll
            for (int m = 0; m < 4; ++m)
#pragma unroll
                for (int n = 0; n < 2; ++n) acc[a][b][m][n] = (f32x4){0.f, 0.f, 0.f, 0.f};
    v8i_t At[4], B0[2], B1[2];
    const int sc_w = 121, sc_x = 127;
    const GAS char* cA = (const GAS char*)g.A + (size_t)cur.pm * tstepA + (size_t)cur.pn * g.acol * 2; const GAS char* cB = (const GAS char*)g.Bt + (size_t)cur.pn * tstepB;
    PG8_STAGE(PG8_SB(0, 0), cB, voffB); PG8_STAGE(PG8_SB(0, 1), cB + hstepB, voffB); PG8_STAGE(PG8_SA(0, 0), cA, voffA); PG8_STAGE(PG8_SA(0, 1), cA + hstepA, voffA);
    if (wr == 1) PG8_BAR;
    PG8_WAIT_V(2); PG8_BAR;
    PG8_STAGE(PG8_SB(1, 0), cB + kstep, voffB); PG8_STAGE(PG8_SA(1, 0), cA + kstep, voffA); PG8_STAGE(PG8_SB(1, 1), cB + hstepB + kstep, voffB);
    PG8_WAIT_V(6); PG8_BAR;
    for (;;) {
        const bool has_next = S.next(ui + 1, nxt);
        const GAS char* nA = has_next ? (const GAS char*)g.A + (size_t)nxt.pm * tstepA + (size_t)nxt.pn * g.acol * 2 : cA; const GAS char* nB = has_next ? (const GAS char*)g.Bt + (size_t)nxt.pn * tstepB : cB;
        for (int t = 0; t < nt; t += 2) {
            const bool last = (t == nt - 2);
            const GAS char* a1 = cA + (size_t)(t + 1) * kstep;
            const GAS char* a2 = last ? nA : cA + (size_t)(t + 2) * kstep; const GAS char* b2 = last ? nB : cB + (size_t)(t + 2) * kstep;
            const GAS char* a3 = a2 + kstep; const GAS char* b3 = b2 + kstep;
            PG8_LDB(B0, 0, 0); PG8_LDB(B1, 0, 1); PG8_SCHED; PG8_LDA(At, 0, 0); PG8_STAGE(PG8_SA(1, 1), a1 + hstepA, voffA);
            PG8_WAIT_V(8); PG8_WAIT_L(0); PG8_BAR; PG8_MMA(0, 0, At, B0); PG8_MMA(0, 1, At, B1); PG8_BAR; PG8_SCHED;
            PG8_LDA(At, 0, 1); PG8_STAGE(PG8_SB(0, 0), b2, voffB); PG8_STAGE(PG8_SB(0, 1), b2 + hstepB, voffB); PG8_STAGE(PG8_SA(0, 0), a2, voffA);
            PG8_WAIT_V(8); PG8_WAIT_L(0); PG8_BAR; PG8_MMA(1, 0, At, B0); PG8_MMA(1, 1, At, B1); PG8_BAR; PG8_SCHED;
            PG8_LDB(B0, 1, 0); PG8_LDB(B1, 1, 1); PG8_SCHED; PG8_LDA(At, 1, 0); PG8_STAGE(PG8_SA(0, 1), a2 + hstepA, voffA);
            PG8_WAIT_V(8); PG8_WAIT_L(0); PG8_BAR; PG8_MMA(0, 0, At, B0); PG8_MMA(0, 1, At, B1); PG8_BAR; PG8_SCHED;
            PG8_LDA(At, 1, 1); PG8_STAGE(PG8_SB(1, 0), b3, voffB); PG8_STAGE(PG8_SB(1, 1), b3 + hstepB, voffB); PG8_STAGE(PG8_SA(1, 0), a3, voffA);
            PG8_WAIT_V(8); PG8_WAIT_L(0); PG8_BAR; PG8_MMA(1, 0, At, B0); PG8_MMA(1, 1, At, B1); PG8_BAR; PG8_SCHED;
        }
        if (wr == 0) PG8_BAR;
        { int ln_; asm volatile("v_mbcnt_lo_u32_b32 %0, -1, 0\n\tv_mbcnt_hi_u32_b32 %0, -1, %0" : "=v"(ln_));
          E(acc, cur, wr, wc, ln_ & 15, ln_ >> 4); }
        if (!has_next) break;
#pragma unroll
        for (int a = 0; a < 2; ++a)
#pragma unroll
            for (int b = 0; b < 2; ++b)
#pragma unroll
                for (int m = 0; m < 4; ++m)
#pragma unroll
                    for (int n = 0; n < 2; ++n) acc[a][b][m][n] = (f32x4){0.f, 0.f, 0.f, 0.f};
        cur = nxt; cA = nA; cB = nB; ++ui;
        if (wr == 1) PG8_BAR;
    }
    PG8_WAIT_V(0);
    PG8_BAR;
#undef PG8_SA
#undef PG8_SB
#undef PG8_STAGE
#undef PG8_LDA
#undef PG8_LDB
#undef PG8_LD2
#undef PG8_HALF
#undef PG8_MMA
#undef PG8_WAIT_V
#undef PG8_WAIT_L
#undef PG8_BAR
#undef PG8_SCHED
}
}

enum { EM_IN0 = 0, EM_MKV = 1, EM_GATE = 2, EM_RES = 3, EM_PQ = 4, EM_L1 = 5 };
struct Epi {
    int mode;
    GAS unsigned char* ws;
    const GAS float* resid;
    GAS float* outf;
    GAS bf16_t* o16;
    GAS float* ssq;
    const GAS float* gate_b;
    typedef pg8::Unit Unit;
    __device__ __forceinline__ static void st8(GAS bf16_t* p, f32x4 v0, f32x4 v1) {
        u32x4 w; w.x = cvtpk(v0[0], v0[1]); w.y = cvtpk(v0[2], v0[3]); w.z = cvtpk(v1[0], v1[1]); w.w = cvtpk(v1[2], v1[3]); *(GAS u32x4*)p = w; }
    __device__ __forceinline__ static float sq8(f32x4 a, f32x4 b) { return (a[0] * a[0] + a[1] * a[1]) + (a[2] * a[2] + a[3] * a[3]) + (b[0] * b[0] + b[1] * b[1]) + (b[2] * b[2] + b[3] * b[3]); }
    __device__ __forceinline__ void operator()(f32x4 (&acc)[2][2][4][2], const Unit& u, int wr, int wc, int fr, int fq) const {
        const int row0 = u.pm * 256 + wr * 64 + fr;
        const int cin = wc * 32 + 8 * fq;
        if (mode == EM_IN0) {
            GAS bf16_t* base; int ld, colt; int kind;
            if (u.pn < 6) { base = (GAS bf16_t*)(ws + O_ZX); ld = LRU; colt = u.pn * 256; kind = 0; }
            else if (u.pn < 12) { base = (GAS bf16_t*)(ws + O_GY); ld = LRU; colt = (u.pn - 6) * 256; kind = 1; }
            else { base = (GAS bf16_t*)(ws + O_ZL1); ld = NL1; colt = 4608 + (u.pn - 12) * 256; kind = 2; }
            GAS float* qmss = (GAS float*)(ws + O_SSL1);
#pragma unroll
            for (int ai = 0; ai < 2; ++ai)
#pragma unroll
                for (int m = 0; m < 4; ++m) { const int row = row0 + ai * 128 + m * 16;
#pragma unroll
                    for (int bj = 0; bj < 2; ++bj) { f32x4 v0 = acc[ai][bj][m][0], v1 = acc[ai][bj][m][1];
                        if (kind == 1) {
#pragma unroll
                            for (int j = 0; j < 4; ++j) { v0[j] = gelu_tanh(v0[j]); v1[j] = gelu_tanh(v1[j]); } }
                        st8(base + (size_t)row * ld + colt + bj * 128 + cin, v0, v1);
                        if (kind == 2) { float s = sq8(v0, v1); s = xsum16(s); s = xsum32(s);
                            if (fq == 0) qmss[(size_t)row * 112 + (24 + (u.pn - 12) * 2 + bj) * 4 + wc] = s; } } }
        } else if (mode == EM_MKV) {
#pragma unroll
            for (int ai = 0; ai < 2; ++ai)
#pragma unroll
                for (int m = 0; m < 4; ++m) { const int row = row0 + ai * 128 + m * 16;
#pragma unroll
                    for (int bj = 0; bj < 2; ++bj) { const f32x4 v0 = acc[ai][bj][m][0], v1 = acc[ai][bj][m][1];
                        st8(o16 + (size_t)row * NL1 + u.pn * 256 + bj * 128 + cin, v0, v1);
                        if (u.pn < 2) { float s = sq8(v0, v1); s = xsum16(s); s = xsum32(s);
                            if (fq == 0) ssq[(size_t)row * 112 + (u.pn * 2 + bj) * 4 + wc] = s; } } }
        } else if (mode == EM_GATE) {
            const int ch = u.pn * 128 + cin;
            const GAS bf16_t* xc = (const GAS bf16_t*)(ws + O_XC); GAS _Float16* LA = (GAS _Float16*)(ws + O_AA); GAS _Float16* UH = (GAS _Float16*)(ws + O_UU);
            const GAS float* spl = (const GAS float*)(ws + O_SPL) + ch; const GAS float* gb = gate_b + u.pn * 256 + cin;
#pragma unroll
            for (int n = 0; n < 2; ++n) {
                const f32x4 sp = *(const GAS f32x4*)(spl + 4 * n), br = *(const GAS f32x4*)(gb + 4 * n), bi = *(const GAS f32x4*)(gb + 128 + 4 * n);
#pragma unroll
                for (int ai = 0; ai < 2; ++ai)
#pragma unroll
                    for (int m = 0; m < 4; ++m) { const int row = row0 + ai * 128 + m * 16;
                        const u32x2 xw = *(const GAS u32x2*)(xc + (size_t)row * LRU + ch + 4 * n);
                        const f32x4 xv = {bf_lo(xw.x), bf_hi(xw.x), bf_lo(xw.y), bf_hi(xw.y)};
                        float lav[4], uvv[4];
#pragma unroll
                        for (int j = 0; j < 4; ++j) { const float r = sigmoidf_(acc[ai][0][m][n][j] + br[j]), ig = sigmoidf_(acc[ai][1][m][n][j] + bi[j]);
                            const float la = -8.f * r * sp[j];
                            lav[j] = la; uvv[j] = __builtin_amdgcn_sqrtf(one_minus_exp(2.f * la)) * (ig * xv[j]); }
                        { const h2 l0 = {(_Float16)lav[0], (_Float16)lav[1]}, l1 = {(_Float16)lav[2], (_Float16)lav[3]}, u0 = {(_Float16)uvv[0], (_Float16)uvv[1]}, u1 = {(_Float16)uvv[2], (_Float16)uvv[3]};
                          *(GAS u32x2*)(LA + (size_t)row * LRU + ch + 4 * n) = (u32x2){__builtin_bit_cast(unsigned, l0), __builtin_bit_cast(unsigned, l1)};
                          *(GAS u32x2*)(UH + (size_t)row * LRU + ch + 4 * n) = (u32x2){__builtin_bit_cast(unsigned, u0), __builtin_bit_cast(unsigned, u1)}; } }
            }
        } else if (mode == EM_RES) {
            GAS bf16_t* xs = (GAS bf16_t*)(ws + O_XS16); GAS float* rowss = (GAS float*)(ws + O_ROWSS); GAS unsigned char* x4p = ws + O_X4; GAS float* sxa = (GAS float*)(ws + O_SX);
#pragma unroll
            for (int ai = 0; ai < 2; ++ai)
#pragma unroll
                for (int m = 0; m < 4; ++m) { const int row = row0 + ai * 128 + m * 16; float s = 0.f;
#pragma unroll
                    for (int bj = 0; bj < 2; ++bj) { const size_t off = (size_t)row * DM + u.pn * 256 + bj * 128 + cin;
                        f32x4 r0, r1;
                        if (resid) { r0 = *(const GAS f32x4*)(resid + off); r1 = *(const GAS f32x4*)(resid + off + 4); }
                        else { const u32x4 w = *(const GAS u32x4*)(xs + off); r0 = (f32x4){bf_lo(w.x), bf_hi(w.x), bf_lo(w.y), bf_hi(w.y)}; r1 = (f32x4){bf_lo(w.z), bf_hi(w.z), bf_lo(w.w), bf_hi(w.w)}; }
                        const f32x4 v0 = acc[ai][bj][m][0] + r0, v1 = acc[ai][bj][m][1] + r1;
                        st8(xs + off, v0, v1); s += sq8(v0, v1);
                        float am = fmaxf(fmaxf(fmaxf(fabsf(v0[0]), fabsf(v0[1])), fmaxf(fabsf(v0[2]), fabsf(v0[3]))), fmaxf(fmaxf(fabsf(v1[0]), fabsf(v1[1])), fmaxf(fabsf(v1[2]), fabsf(v1[3]))));
                        am = xmax16(am); am = xmax32(am);
                        const float sc = fmaxf(am, 1e-20f) * (1.f / 119.f), qs = __builtin_amdgcn_rcpf(sc);
                        unsigned hw = 0u, lw = 0u;
#pragma unroll
                        for (int k = 0; k < 8; ++k) { const int b = __float_as_int(fmaf(k < 4 ? v0[k & 3] : v1[k & 3], qs, 12582912.f));
                            lw |= (unsigned)(b & 15) << (4 * k); hw |= (unsigned)(((b + 8) >> 4) & 15) << (4 * k); }
                        *(GAS u32x2*)(x4p + ((size_t)row * 64 + u.pn * 8 + bj * 4 + wc) * 32 + fq * 8) = (u32x2){hw, lw};
                        if (fq == 0) sxa[(size_t)(u.pn * 8 + bj * 4 + wc) * T + row] = sc; }
                    s = xsum16(s); s = xsum32(s);
                    if (fq == 0) rowss[(size_t)row * 32 + u.pn * 4 + wc] = s; }
        } else if (mode == EM_PQ) {
            const GAS float* rowss = (const GAS float*)(ws + O_ROWSS);
#pragma unroll
            for (int ai = 0; ai < 2; ++ai)
#pragma unroll
                for (int m = 0; m < 4; ++m) { const int row = row0 + ai * 128 + m * 16;
                    const f32x4 p0 = *(const GAS f32x4*)(rowss + (size_t)row * 32 + fq * 8), p1 = *(const GAS f32x4*)(rowss + (size_t)row * 32 + fq * 8 + 4);
                    float s = (p0[0] + p0[1]) + (p0[2] + p0[3]) + (p1[0] + p1[1]) + (p1[2] + p1[3]); s = xsum16(s); s = xsum32(s);
                    const float r = rsqrtf(s * (1.f / DM) + EPS);
#pragma unroll
                    for (int bj = 0; bj < 2; ++bj) st8(o16 + (size_t)row * DM + u.pn * 256 + bj * 128 + cin, acc[ai][bj][m][0] * r, acc[ai][bj][m][1] * r); }
        } else {
            const GAS float* rsp = (const GAS float*)(ws + O_RSP); GAS bf16_t* zl1 = (GAS bf16_t*)(ws + O_ZL1); GAS float* ssl1 = (GAS float*)(ws + O_SSL1);
            const int slot0 = u.pn < 6 ? u.pn * 2 : (u.pn >= 12 ? 12 + (u.pn - 12) * 2 : -1);
#pragma unroll
            for (int ai = 0; ai < 2; ++ai)
#pragma unroll
                for (int m = 0; m < 4; ++m) { const int row = row0 + ai * 128 + m * 16;
                    const f32x4 q0 = *(const GAS f32x4*)(rsp + (size_t)row * 8), q1 = *(const GAS f32x4*)(rsp + (size_t)row * 8 + 4);
                    const float r = rsqrtf(((q0[0] + q0[1]) + (q0[2] + q0[3]) + (q1[0] + q1[1]) + (q1[2] + q1[3])) * (1.f / DM) + EPS);
#pragma unroll
                    for (int bj = 0; bj < 2; ++bj) { const f32x4 v0 = acc[ai][bj][m][0] * r, v1 = acc[ai][bj][m][1] * r;
                        st8(zl1 + (size_t)row * NL1 + u.pn * 256 + bj * 128 + cin, v0, v1);
                        if (slot0 >= 0) { float s = sq8(v0, v1); s = xsum16(s); s = xsum32(s);
                            if (fq == 0) ssl1[(size_t)row * 112 + (slot0 + bj) * 4 + wc] = s; } } }
        }
    }
};

namespace att {
constexpr float SCALE = 0.08838834764831845f;
constexpr int NW = 8, QBLK = 32, KVBLK = 64, QB = NW * QBLK, D = 128;
constexpr int SHM_V = KVBLK * D * 2, SHM_K = KVBLK * D * 2;
constexpr int OFF_WS = 2 * SHM_V + 2 * SHM_K;
constexpr int OFF_KS = OFF_WS + 2048;
constexpr int OFF_BS = OFF_KS + 16384;
constexpr int LDS_END = OFF_BS + 16384;
constexpr int WBIG = 1 << 28;

#define KSWZ(row, colB) ((row) * 256 + ((colB) ^ (((row) & 7) << 4)))
#define SBAR() __builtin_amdgcn_sched_barrier(0)
__device__ __forceinline__ int v_st(int k, int c) { const int kk = (k & ~0xC) | ((k & 4) << 1) | ((k & 8) >> 1); return ((kk >> 3) * 4 + (c >> 5)) * 512 + ((kk & 7) * 32 + (c & 31)) * 2; }
__device__ __forceinline__ int v_rd_base(int lane) { return ((lane & 3) << 3) | (((lane >> 2) & 3) << 6) | (((lane >> 4) & 1) << 5) | (((lane >> 5) & 1) << 8); }
constexpr int v_rd_off(int d0, int ks, int half) { return d0 * 512 + ks * 4096 + half * 2048; }
__device__ __forceinline__ int crow(int r, int hi) { return (r & 3) + 8 * (r >> 2) + 4 * hi; }
__device__ __forceinline__ bf16x8 load8(const GAS bf16_t* p) { return *(const GAS bf16x8*)p; }
__device__ __forceinline__ bf16x8 scale8(bf16x8 v, float s) { const u32x4 w = *reinterpret_cast<u32x4*>(&v); u32x4 o;
    o.x = cvtpk(bf_lo(w.x) * s, bf_hi(w.x) * s); o.y = cvtpk(bf_lo(w.y) * s, bf_hi(w.y) * s); o.z = cvtpk(bf_lo(w.z) * s, bf_hi(w.z) * s); o.w = cvtpk(bf_lo(w.w) * s, bf_hi(w.w) * s);
    return *reinterpret_cast<bf16x8*>(&o); }
__device__ __forceinline__ void mask_tile(f32x16& p0, f32x16& p1, int dq, unsigned W) {
    const float NEG = -__builtin_inff();
#pragma unroll
    for (int r = 0; r < 16; ++r) {
        const int c = (r & 3) + 8 * (r >> 2);
        if ((unsigned)(dq - c) >= W) p0[r] = NEG;
        if ((unsigned)(dq - c - 32) >= W) p1[r] = NEG;
    }
}
constexpr float THR = 8.f;
__device__ __forceinline__ void partialSM(f32x16& p0, f32x16& p1, float& m_reg, float& mn, float& alpha) {
    float pmax = p0[0]; for (int r = 1; r < 16; ++r) pmax = fmaxf(pmax, p0[r]); for (int r = 0; r < 16; ++r) pmax = fmaxf(pmax, p1[r]);
    { auto rr = __builtin_amdgcn_permlane32_swap(__float_as_uint(pmax), __float_as_uint(pmax), false, false);
      pmax = fmaxf(__uint_as_float(rr[0]), __uint_as_float(rr[1])); }
    constexpr float C2 = 1.4426950408889634f * SCALE;
    if (__builtin_expect(__all((pmax - m_reg) * SCALE <= THR), 1)) { mn = m_reg; alpha = 1.f; }
    else { mn = fmaxf(m_reg, pmax); alpha = __builtin_amdgcn_exp2f((m_reg - mn) * C2); m_reg = mn; }
    const float mnL = -mn * C2;
    for (int r = 0; r < 16; ++r) p0[r] = fmaf(p0[r], C2, mnL); for (int r = 0; r < 16; ++r) p1[r] = fmaf(p1[r], C2, mnL);
    for (int r = 0; r < 16; ++r) p0[r] = __builtin_amdgcn_exp2f(p0[r]);
}
__device__ __forceinline__ void finishSM(f32x16& p0, f32x16& p1, float alpha, float& l_reg, bf16x8& pa0, bf16x8& pa1, bf16x8& pa2, bf16x8& pa3) {
    for (int r = 0; r < 16; ++r) p1[r] = __builtin_amdgcn_exp2f(p1[r]);
    float ps = 0; for (int r = 0; r < 16; ++r) ps += p0[r]; for (int r = 0; r < 16; ++r) ps += p1[r];
    { auto rr = __builtin_amdgcn_permlane32_swap(__float_as_uint(ps), __float_as_uint(ps), false, false);
      ps = __uint_as_float(rr[0]) + __uint_as_float(rr[1]); }
    l_reg = l_reg * alpha + ps;
#define PK4(P, B_, OUT) do { unsigned a0 = cvtpk(P[B_+0], P[B_+1]), a1 = cvtpk(P[B_+2], P[B_+3]);                          \
        unsigned b0 = cvtpk(P[B_+4], P[B_+5]), b1 = cvtpk(P[B_+6], P[B_+7]);                                             \
        auto r0 = __builtin_amdgcn_permlane32_swap(a0, b0, false, false); auto r1 = __builtin_amdgcn_permlane32_swap(a1, b1, false, false); \
        u32x4 w = {r0[0], r1[0], r0[1], r1[1]}; OUT = *reinterpret_cast<bf16x8*>(&w); } while (0)
    PK4(p0, 0, pa0); PK4(p0, 8, pa1); PK4(p1, 0, pa2); PK4(p1, 8, pa3);
#undef PK4
}
template <int KB>
__device__ __forceinline__ void qkt(f32x16& p0, f32x16& p1, const char* K_lds, int r32, int hi, const bf16x8* qr, const float* bp  ) {
    { const f32x4 a = *(const f32x4*)(bp), b = *(const f32x4*)(bp + 8), c = *(const f32x4*)(bp + 16), d = *(const f32x4*)(bp + 24);
      p0 = (f32x16){a[0], a[1], a[2], a[3], b[0], b[1], b[2], b[3], c[0], c[1], c[2], c[3], d[0], d[1], d[2], d[3]}; }
    { const f32x4 a = *(const f32x4*)(bp + 32), b = *(const f32x4*)(bp + 40), c = *(const f32x4*)(bp + 48), d = *(const f32x4*)(bp + 56);
      p1 = (f32x16){a[0], a[1], a[2], a[3], b[0], b[1], b[2], b[3], c[0], c[1], c[2], c[3], d[0], d[1], d[2], d[3]}; }
    const char* kb[4];
#pragma unroll
    for (int dd = 0; dd < 4; ++dd) kb[dd] = K_lds + KB * SHM_K + KSWZ(r32, (dd * 16 + hi * 8) * 2);
#pragma unroll
    for (int d0 = 0; d0 < 8; ++d0) { const char* a = kb[d0 & 3] + (d0 >> 2) * 128;
        bf16x8 b0 = *reinterpret_cast<const bf16x8*>(a);
        bf16x8 b1 = *reinterpret_cast<const bf16x8*>(a + 32 * 256);
        p0 = __builtin_amdgcn_mfma_f32_32x32x16_bf16(b0, qr[d0], p0, 0, 0, 0);
        p1 = __builtin_amdgcn_mfma_f32_32x32x16_bf16(b1, qr[d0], p1, 0, 0, 0); }
}
template <int KB>
__device__ __forceinline__ void qkt0(f32x16& p0, f32x16& p1, const char* K_lds, int r32, int hi, const bf16x8* qr) {
    p0 = f32x16{}; p1 = f32x16{};
    const char* kb[4];
#pragma unroll
    for (int dd = 0; dd < 4; ++dd) kb[dd] = K_lds + KB * SHM_K + KSWZ(r32, (dd * 16 + hi * 8) * 2);
#pragma unroll
    for (int d0 = 0; d0 < 8; ++d0) { const char* a = kb[d0 & 3] + (d0 >> 2) * 128;
        bf16x8 b0 = *reinterpret_cast<const bf16x8*>(a);
        bf16x8 b1 = *reinterpret_cast<const bf16x8*>(a + 32 * 256);
        p0 = __builtin_amdgcn_mfma_f32_32x32x16_bf16(b0, qr[d0], p0, 0, 0, 0);
        p1 = __builtin_amdgcn_mfma_f32_32x32x16_bf16(b1, qr[d0], p1, 0, 0, 0); }
}
template <int VB>
__device__ __forceinline__ void pv_tile(f32x16* o, int vb0, bf16x8 pa0, bf16x8 pa1, bf16x8 pa2, bf16x8 pa3) {
#define TRRD(dst, off) asm volatile("ds_read_b64_tr_b16 %0, %1 offset:%2" : "=&v"(dst) : "v"(vb0), "i"(off) : "memory")
#define PV_D0(d0) do { s16x4 l0, l1, l2, l3, h0, h1, h2_, h3; constexpr int b_ = VB * SHM_V + v_rd_off(d0, 0, 0); \
        TRRD(l0, b_); TRRD(h0, b_ + 2048); TRRD(l1, b_ + 4096); TRRD(h1, b_ + 6144); TRRD(l2, b_ + 8192); TRRD(h2_, b_ + 10240); TRRD(l3, b_ + 12288); TRRD(h3, b_ + 14336); \
        asm volatile("s_waitcnt lgkmcnt(0)" ::: "memory"); SBAR();   \
        o[d0] = __builtin_amdgcn_mfma_f32_32x32x16_bf16(pa0, (bf16x8){l0[0], l0[1], l0[2], l0[3], h0[0], h0[1], h0[2], h0[3]}, o[d0], 0, 0, 0);   \
        o[d0] = __builtin_amdgcn_mfma_f32_32x32x16_bf16(pa1, (bf16x8){l1[0], l1[1], l1[2], l1[3], h1[0], h1[1], h1[2], h1[3]}, o[d0], 0, 0, 0);   \
        o[d0] = __builtin_amdgcn_mfma_f32_32x32x16_bf16(pa2, (bf16x8){l2[0], l2[1], l2[2], l2[3], h2_[0], h2_[1], h2_[2], h2_[3]}, o[d0], 0, 0, 0);   \
        o[d0] = __builtin_amdgcn_mfma_f32_32x32x16_bf16(pa3, (bf16x8){l3[0], l3[1], l3[2], l3[3], h3[0], h3[1], h3[2], h3[3]}, o[d0], 0, 0, 0); } while (0)
    PV_D0(0); PV_D0(1); PV_D0(2); PV_D0(3);
#undef PV_D0
#undef TRRD
}

struct BlockRef { const GAS bf16_t* Q; const GAS bf16_t* K; const GAS bf16_t* V; GAS bf16_t* O; const GAS float* qss; const GAS float* kss; const GAS float* cc; const GAS float* gg;
                  int P0, skv; };
constexpr int LDQ = 5120, LDK = 5120, LDO = 2048, LDSS = 112;
struct Seam { bf16x8 qr[8]; bf16x8 st_v0, st_v1, st_k0, st_k1; int jlo; };
#define ROWK(p, k0, rr) ((p) + (size_t)((k0) + (rr)) * LDK + sc)
#define VMW() asm volatile("s_waitcnt vmcnt(0)" ::: "memory")
#define VMWN(n) asm volatile("s_waitcnt vmcnt(%0)" :: "i"(n) : "memory")
#define SLOAD_H(Kp, Vp, k0) do { S.st_v0 = load8(ROWK(Vp, k0, sr)); S.st_v1 = load8(ROWK(Vp, k0, 32 + sr));              \
                         S.st_k0 = load8(ROWK(Kp, k0, sr)); S.st_k1 = load8(ROWK(Kp, k0, 32 + sr)); } while (0)
#define SWRITE_HK(bf, k0) do { *(bf16x8*)(K_lds + (bf) * SHM_K + kws) = scale8(S.st_k0, ksr[(k0)]); *(bf16x8*)(K_lds + (bf) * SHM_K + kws + 32 * 256) = scale8(S.st_k1, ksr[(k0) + 32]); } while (0)
#define SWRITE_HV(bf) do { *(bf16x8*)(V_lds + (bf) * SHM_V + vst0) = S.st_v0; *(bf16x8*)(V_lds + (bf) * SHM_V + vst1) = S.st_v1; } while (0)
#define SWRITE_H(bf, k0) do { SWRITE_HV(bf); SWRITE_HK(bf, k0); } while (0)

__device__ __forceinline__ void attn_prime(const BlockRef& cur, char* lds, Seam& S, const int tid) {
    const int wid = __builtin_amdgcn_readfirstlane(tid >> 6), lane = tid & 63, r32 = lane & 31, hi = lane >> 5;
    const int sr = tid >> 4, sc = (tid & 15) * 8, kws = KSWZ(sr, sc * 2); char* K_lds = lds + 2 * SHM_V;
    float* ks_l = (float*)(lds + OFF_KS); float* bs_l = (float*)(lds + OFF_BS); const float* ksr = ks_l + sr;
    int j_hi = (cur.P0 + QB - 1) / KVBLK + 1; if (j_hi > cur.skv / KVBLK) j_hi = cur.skv / KVBLK;
    const int nkeys = j_hi * KVBLK;
    const float c0 = cur.cc ? cur.cc[cur.P0] : 0.f;
    int jlo = 0;
    if (cur.cc) { const float thr = cur.gg[128]; const int jd = cur.P0 / KVBLK;
        const float cv = lane <= jd ? cur.cc[lane * KVBLK + KVBLK - 1] : 0.f;
        const bool keep = lane > jd || (c0 - cv > -thr);
        jlo = __ffsll((long long)__ballot(keep)) - 1; }
    S.jlo = jlo;
    for (int s = jlo * KVBLK + tid; s < nkeys; s += NTHREADS) {
        const f32x4 p = *(const GAS f32x4*)(cur.kss + (size_t)s * LDSS);
        ks_l[s] = rsqrtf(((p[0] + p[1]) + (p[2] + p[3])) * (1.f / 128.f) + EPS);
        bs_l[s] = cur.cc ? (c0 - cur.cc[s]) * (1.f / SCALE) : 0.f;
    }
    __syncthreads();
    const int qrow = wid * QBLK + r32;
    const f32x4 qp = *(const GAS f32x4*)(cur.qss + (size_t)qrow * LDSS);
    const float rq = rsqrtf(((qp[0] + qp[1]) + (qp[2] + qp[3])) * (1.f / 128.f) + EPS);
#pragma unroll
    for (int d0 = 0; d0 < 8; ++d0) {
        const u32x4 w = *(const GAS u32x4*)(cur.Q + (size_t)qrow * LDQ + d0 * 16 + hi * 8);
        const f32x4 g0 = *(const GAS f32x4*)(cur.gg + d0 * 16 + hi * 8), g1 = *(const GAS f32x4*)(cur.gg + d0 * 16 + hi * 8 + 4);
        u32x4 o; o.x = cvtpk(bf_lo(w.x) * rq * g0[0], bf_hi(w.x) * rq * g0[1]); o.y = cvtpk(bf_lo(w.y) * rq * g0[2], bf_hi(w.y) * rq * g0[3]);
        o.z = cvtpk(bf_lo(w.z) * rq * g1[0], bf_hi(w.z) * rq * g1[1]); o.w = cvtpk(bf_lo(w.w) * rq * g1[2], bf_hi(w.w) * rq * g1[3]);
        S.qr[d0] = *reinterpret_cast<bf16x8*>(&o);
    }
    SLOAD_H(cur.K, cur.V, jlo * KVBLK); VMW(); SWRITE_HK(0, jlo * KVBLK);
    __syncthreads();
}
__device__ __forceinline__ void attn_block(const BlockRef& cur, char* lds, Seam& S, const int tid) {
    const int wid = __builtin_amdgcn_readfirstlane(tid >> 6), lane = tid & 63, r32 = lane & 31, hi = lane >> 5;
    const int W = WBIG;
    int j_hi = (cur.P0 + QB - 1) / KVBLK + 1; if (j_hi > cur.skv / KVBLK) j_hi = cur.skv / KVBLK;
    const int j_lo = S.jlo; const int NT = j_hi - j_lo;
    const int qlo = cur.P0 - j_lo * KVBLK + wid * QBLK, qm = qlo + r32 - 4 * hi;
    char* V_lds = lds; char* K_lds = lds + 2 * SHM_V;
    float* ws = (float*)(lds + OFF_WS) + wid * 64; float* li_l = ws, * al_l = ws + 32;
    const float* bs_l = (const float*)(lds + OFF_BS) + j_lo * KVBLK + 4 * hi;
    float m_reg = -1e30f, l_reg = 0; f32x16 o[4] = {};
    const int sr = tid >> 4, sc = (tid & 15) * 8, vst0 = v_st(sr, sc), vst1 = v_st(32 + sr, sc), kws = KSWZ(sr, sc * 2);
    const float* ksr = (const float*)(lds + OFF_KS) + j_lo * KVBLK + sr;
    const int vb0 = (int)(uintptr_t)V_lds + v_rd_base(lane);
    const GAS bf16_t* Kh = cur.K + (size_t)j_lo * KVBLK * LDK; const GAS bf16_t* Vh = cur.V + (size_t)j_lo * KVBLK * LDK;
#define RESC(a) do { if (__any((a) < 1.f)) { if (hi == 0) al_l[r32] = (a); asm volatile("s_waitcnt lgkmcnt(0)" ::: "memory");              \
                     for (int d_ = 0; d_ < 4; ++d_) for (int r = 0; r < 16; ++r) o[d_][r] *= al_l[crow(r, hi)]; } } while (0)
#define KBASE(t) ((t) * KVBLK)
#define MASKT(P0_, P1_, t) do { const int kb_ = KBASE(t); if (kb_ + KVBLK - 1 > qlo) mask_tile(P0_, P1_, qm - kb_, (unsigned)W); } while (0)
    f32x16 pA0, pA1, pB0, pB1; float mnA, mnB, alA, alB; bf16x8 pa0, pa1, pa2, pa3;
    SWRITE_HV(0); SBAR();
    if (NT > 1) { SLOAD_H(Kh, Vh, KBASE(1)); }
    SBAR(); qkt<0>(pA0, pA1, K_lds, r32, hi, S.qr, bs_l + KBASE(0));
    MASKT(pA0, pA1, 0); partialSM(pA0, pA1, m_reg, mnA, alA);
    if (NT > 1) { VMW(); SWRITE_H(1, KBASE(1)); }
    __syncthreads();
#define HALF_STEP(PX0, PX1, mnX, alX, PY0, PY1, alY, t, KB, VB, SB) do {                                                      \
        SBAR(); qkt<KB>(PX0, PX1, K_lds, r32, hi, S.qr, bs_l + KBASE(t));                                                         \
        finishSM(PY0, PY1, alY, l_reg, pa0, pa1, pa2, pa3); SBAR();                                                           \
        if ((t) + 1 < NT) { SLOAD_H(Kh, Vh, KBASE((t) + 1)); SBAR(); }                                               \
        pv_tile<VB>(o, vb0, pa0, pa1, pa2, pa3); MASKT(PX0, PX1, (t)); partialSM(PX0, PX1, m_reg, mnX, alX);                                        \
        __syncthreads();                                                                                                      \
        if ((t) + 1 < NT) { VMW(); SWRITE_H(SB, KBASE((t) + 1)); }                                                                          \
        RESC(alX); __syncthreads(); } while (0)
    for (int t = 1; t + 1 < NT; t += 2) {
        HALF_STEP(pB0, pB1, mnB, alB, pA0, pA1, alA, t, 1, 0, 0);
        HALF_STEP(pA0, pA1, mnA, alA, pB0, pB1, alB, t + 1, 0, 1, 1);
    }
    const bool even = (NT & 1) == 0;
    if (even) { SBAR(); qkt<1>(pB0, pB1, K_lds, r32, hi, S.qr, bs_l + KBASE(NT - 1)); SBAR(); }
    finishSM(pA0, pA1, alA, l_reg, pa0, pa1, pa2, pa3); SBAR();
    pv_tile<0>(o, vb0, pa0, pa1, pa2, pa3);
    if (even) { MASKT(pB0, pB1, NT - 1); partialSM(pB0, pB1, m_reg, mnB, alB); __syncthreads(); RESC(alB);
        finishSM(pB0, pB1, alB, l_reg, pa0, pa1, pa2, pa3); SBAR(); pv_tile<1>(o, vb0, pa0, pa1, pa2, pa3); }
    SBAR();
    if (hi == 0) li_l[r32] = l_reg; asm volatile("s_waitcnt lgkmcnt(0)" ::: "memory");
    float rli[16];
#pragma unroll
    for (int r = 0; r < 16; ++r) rli[r] = __builtin_amdgcn_rcpf(li_l[crow(r, hi)]);
    GAS bf16_t* Ow = cur.O + (size_t)(wid * QBLK) * LDO;
#pragma unroll
    for (int r = 0; r < 16; ++r) { const int orow = crow(r, hi);
#pragma unroll
        for (int d0 = 0; d0 < 4; ++d0) { const float v = o[d0][r] * rli[r];
            const float vn = dppf<0xB1>(v);
            if ((r32 & 1) == 0) *(GAS unsigned*)(Ow + (size_t)orow * LDO + d0 * 32 + r32) = cvtpk(v, vn); } }
    __syncthreads();
#undef RESC
#undef KBASE
#undef MASKT
#undef HALF_STEP
}
constexpr int MOFF_K = 4 * SHM_V, MOFF_WS = MOFF_K + 4 * SHM_K, MOFF_KS = MOFF_WS + 2048;
__device__ __forceinline__ void mem_attn_unit(const BlockRef& cur, char* lds, const int tid) {
    const int wid = __builtin_amdgcn_readfirstlane(tid >> 6), lane = tid & 63, r32 = lane & 31, hi = lane >> 5;
    const int sr = tid >> 4, sc = (tid & 15) * 8, kws = KSWZ(sr, sc * 2), vst0 = v_st(sr, sc), vst1 = v_st(32 + sr, sc);
    char* V_lds = lds; char* K_lds = lds + MOFF_K; float* ks_l = (float*)(lds + MOFF_KS);
    float* ws = (float*)(lds + MOFF_WS) + wid * 64; float* li_l = ws, * al_l = ws + 32;
    float ksv = 0.f;
    if (tid < 256) { const f32x4 p = *(const GAS f32x4*)(cur.kss + (size_t)tid * LDSS); ksv = rsqrtf(((p[0] + p[1]) + (p[2] + p[3])) * (1.f / 128.f) + EPS); }
    bf16x8 kk[4][2], vv[4][2];
#pragma unroll
    for (int t = 0; t < 4; ++t) { kk[t][0] = load8(ROWK(cur.K, t * KVBLK, sr)); kk[t][1] = load8(ROWK(cur.K, t * KVBLK, 32 + sr)); vv[t][0] = load8(ROWK(cur.V, t * KVBLK, sr)); vv[t][1] = load8(ROWK(cur.V, t * KVBLK, 32 + sr)); }
    const int qrow = wid * QBLK + r32;
    const f32x4 qp = *(const GAS f32x4*)(cur.qss + (size_t)qrow * LDSS);
    u32x4 qw[8];
#pragma unroll
    for (int d0 = 0; d0 < 8; ++d0) qw[d0] = *(const GAS u32x4*)(cur.Q + (size_t)qrow * LDQ + d0 * 16 + hi * 8);
    if (tid < 256) ks_l[tid] = ksv;
    __syncthreads();
#pragma unroll
    for (int t = 0; t < 4; ++t) { *(bf16x8*)(K_lds + t * SHM_K + kws) = scale8(kk[t][0], ks_l[t * KVBLK + sr]); *(bf16x8*)(K_lds + t * SHM_K + kws + 32 * 256) = scale8(kk[t][1], ks_l[t * KVBLK + 32 + sr]);
        *(bf16x8*)(V_lds + t * SHM_V + vst0) = vv[t][0]; *(bf16x8*)(V_lds + t * SHM_V + vst1) = vv[t][1]; }
    const float rq = rsqrtf(((qp[0] + qp[1]) + (qp[2] + qp[3])) * (1.f / 128.f) + EPS);
    bf16x8 qr[8];
#pragma unroll
    for (int d0 = 0; d0 < 8; ++d0) { const u32x4 w = qw[d0];
        const f32x4 g0 = *(const GAS f32x4*)(cur.gg + d0 * 16 + hi * 8), g1 = *(const GAS f32x4*)(cur.gg + d0 * 16 + hi * 8 + 4);
        u32x4 o; o.x = cvtpk(bf_lo(w.x) * rq * g0[0], bf_hi(w.x) * rq * g0[1]); o.y = cvtpk(bf_lo(w.y) * rq * g0[2], bf_hi(w.y) * rq * g0[3]);
        o.z = cvtpk(bf_lo(w.z) * rq * g1[0], bf_hi(w.z) * rq * g1[1]); o.w = cvtpk(bf_lo(w.w) * rq * g1[2], bf_hi(w.w) * rq * g1[3]);
        qr[d0] = *reinterpret_cast<bf16x8*>(&o); }
    __syncthreads();
    const int vb0 = (int)(uintptr_t)V_lds + v_rd_base(lane);
    float m_reg = -1e30f, l_reg = 0; f32x16 o[4] = {};
#define MEM_TILE(t) do { f32x16 p0, p1; float mn, al; bf16x8 pa0, pa1, pa2, pa3; \
        qkt0<t>(p0, p1, K_lds, r32, hi, qr); partialSM(p0, p1, m_reg, mn, al); \
        if (__any(al < 1.f)) { if (hi == 0) al_l[r32] = al; asm volatile("s_waitcnt lgkmcnt(0)" ::: "memory"); for (int d_ = 0; d_ < 4; ++d_) for (int r = 0; r < 16; ++r) o[d_][r] *= al_l[crow(r, hi)]; } \
        finishSM(p0, p1, al, l_reg, pa0, pa1, pa2, pa3); SBAR(); pv_tile<t>(o, vb0, pa0, pa1, pa2, pa3); SBAR(); } while (0)
    MEM_TILE(0); MEM_TILE(1); MEM_TILE(2); MEM_TILE(3);
#undef MEM_TILE
    if (hi == 0) li_l[r32] = l_reg; asm volatile("s_waitcnt lgkmcnt(0)" ::: "memory");
    float rli[16];
#pragma unroll
    for (int r = 0; r < 16; ++r) rli[r] = __builtin_amdgcn_rcpf(li_l[crow(r, hi)]);
    GAS bf16_t* Ow = cur.O + (size_t)(wid * QBLK) * LDO;
#pragma unroll
    for (int r = 0; r < 16; ++r) { const int orow = crow(r, hi);
#pragma unroll
        for (int d0 = 0; d0 < 4; ++d0) { const float v = o[d0][r] * rli[r];
            const float vn = dppf<0xB1>(v);
            if ((r32 & 1) == 0) *(GAS unsigned*)(Ow + (size_t)orow * LDO + d0 * 32 + r32) = cvtpk(v, vn); } }
    __syncthreads();
}
#undef ROWK
#undef VMW
#undef VMWN
#undef SLOAD_H
#undef SWRITE_HK
#undef SWRITE_HV
#undef SWRITE_H
#undef KSWZ
#undef SBAR
}


struct Frame {
    GAS unsigned char* ws; const float* const* in_; GAS float* out;
    __device__ __forceinline__ const GAS float* in(int i) const { return (const GAS float*)in_[i]; }
    int tid, lane, wave, gw, ngw, gtid, ngt;
};
enum { I_X = 0, I_MEM, I_ANORM, I_AWIN, I_ACONVW, I_ACONVB, I_AGATEW, I_AGATEB, I_ALAMBDA, I_AWOUT, I_SNORM, I_SWKVF, I_SBF, I_SKNORM, I_BNORM, I_BWIN, I_BQNORM, I_BWOUT,
       I_MNORM, I_MWKV, I_MQNORM, I_MKNORM, I_PNORM, I_PWQ, I_PSUBK, I_PU, I_PV, N_IN };

struct TrItem { const GAS float* W; const GAS float* gain; GAS bf16_t* WT; int ldw, ldt, row_off, k0, n0; };
__device__ __forceinline__ void tr_load(const TrItem& d, float (&wv)[32], int lane) {
#pragma unroll
    for (int i = 0; i < 32; ++i) wv[i] = __builtin_nontemporal_load(d.W + (size_t)(d.k0 + 2 * i + (lane >> 5)) * d.ldw + d.n0 + (lane & 31));
}
__device__ __forceinline__ void tr_proc(const TrItem& d, float (&wv)[32], LAS float* scr, int lane) {
    if (d.gain) {
#pragma unroll
        for (int i = 0; i < 32; ++i) wv[i] *= d.gain[d.k0 + 2 * i + (lane >> 5)]; }
#pragma unroll
    for (int i = 0; i < 32; ++i) scr[(2 * i + (lane >> 5)) * 33 + (lane & 31)] = wv[i];
    asm volatile("s_waitcnt lgkmcnt(0)" ::: "memory");
    const int c = lane & 7;
#pragma unroll
    for (int j = 0; j < 4; ++j) { const int n = (lane >> 3) + 8 * j; const LAS float* s = scr + (8 * c) * 33 + n;
        u32x4 o; o.x = cvtpk(s[0 * 33], s[1 * 33]); o.y = cvtpk(s[2 * 33], s[3 * 33]); o.z = cvtpk(s[4 * 33], s[5 * 33]); o.w = cvtpk(s[6 * 33], s[7 * 33]);
        *(GAS u32x4*)(d.WT + (size_t)(d.row_off + d.n0 + n) * d.ldt + d.k0 + 8 * c) = o; }
    asm volatile("s_waitcnt lgkmcnt(0)" ::: "memory");
}
__device__ __forceinline__ void transpose_item_fp8(const GAS float* W, int ldw, const GAS float* gain, GAS unsigned char* WT, int ldt, LAS float* scr, int nblk, int item, int lane) {
    const int kb = item / nblk, nb = item % nblk, k0 = 64 * kb, n0 = 32 * nb;
    float wv[32];
#pragma unroll
    for (int i = 0; i < 32; ++i) wv[i] = W[(size_t)(k0 + 2 * i + (lane >> 5)) * ldw + n0 + (lane & 31)];
#pragma unroll
    for (int i = 0; i < 32; ++i) wv[i] *= gain[k0 + 2 * i + (lane >> 5)] * 64.f;
#pragma unroll
    for (int i = 0; i < 32; ++i) scr[(2 * i + (lane >> 5)) * 33 + (lane & 31)] = wv[i];
    asm volatile("s_waitcnt lgkmcnt(0)" ::: "memory");
    const int c = lane & 3;
#pragma unroll
    for (int j = 0; j < 2; ++j) { const int n = (lane >> 2) + 16 * j; const LAS float* sp = scr + (16 * c) * 33 + n; u32x4 o;
#pragma unroll
        for (int w = 0; w < 4; ++w) { int pk = __builtin_amdgcn_cvt_pk_fp8_f32(sp[(4 * w) * 33], sp[(4 * w + 1) * 33], 0, false); pk = __builtin_amdgcn_cvt_pk_fp8_f32(sp[(4 * w + 2) * 33], sp[(4 * w + 3) * 33], pk, true); o[w] = (unsigned)pk; }
        *(GAS u32x4*)(WT + (size_t)(n0 + n) * ldt + k0 + 16 * c) = o; }
    asm volatile("s_waitcnt lgkmcnt(0)" ::: "memory");
}
struct CtRow { f32x4 v[8]; GAS unsigned char* dst; int row, which; };
__device__ __forceinline__ void ct_load(Frame& F, int layer, int it, CtRow& R) {
    R.which = it & 1; R.row = it >> 1;
    const GAS float* src = F.in(R.which ? I_PV : I_PU) + ((size_t)layer * NEXP + R.row) * DM + F.lane * 4;
    R.dst = F.ws + O_TAB + (size_t)(layer * 2 + R.which) * TAB_ONE;
#pragma unroll
    for (int c = 0; c < 8; ++c) R.v[c] = __builtin_nontemporal_load((const GAS f32x4*)(src + c * 256));
}
__device__ __forceinline__ void ct_proc(Frame& F, int layer, CtRow& R) {
    const GAS float* gn = F.in(I_PNORM) + layer * DM + F.lane * 4;
    _Float16 shv = (_Float16)0.f;
#pragma unroll
    for (int c = 0; c < 8; ++c) { f32x4 x = R.v[c]; if (!R.which) x = x * *(const GAS f32x4*)(gn + c * 256);
        float amax = fmaxf(fmaxf(fabsf(x[0]), fabsf(x[1])), fmaxf(fabsf(x[2]), fabsf(x[3])));
        amax = wave_max(amax);
        const _Float16 sh = (_Float16)fmaxf(amax * (R.which ? 1.f / 6.f : 1.f / 7.f), 1e-6f);
        const float qs = __builtin_amdgcn_rcpf((float)sh);
        unsigned pk;
        if (R.which) { pk = __builtin_amdgcn_cvt_scalef32_pk_fp4_f32(0u, x[0] * qs, x[1] * qs, 1.0f, 0); pk = __builtin_amdgcn_cvt_scalef32_pk_fp4_f32(pk, x[2] * qs, x[3] * qs, 1.0f, 1); }
        else { const int q0 = (int)fminf(fmaxf(rintf(x[0] * qs), -7.f), 7.f), q1 = (int)fminf(fmaxf(rintf(x[1] * qs), -7.f), 7.f), q2 = (int)fminf(fmaxf(rintf(x[2] * qs), -7.f), 7.f), q3 = (int)fminf(fmaxf(rintf(x[3] * qs), -7.f), 7.f);
               pk = (unsigned)(q0 & 15) | ((unsigned)(q1 & 15) << 4) | ((unsigned)(q2 & 15) << 8) | ((unsigned)(q3 & 15) << 12); }
        *(GAS unsigned short*)(R.dst + ((size_t)c * NEXP + R.row) * 128 + F.lane * 2) = (unsigned short)pk;
        shv = (F.lane == c) ? sh : shv; }
    if (F.lane < 8) *(GAS unsigned short*)(R.dst + TAB_NIB + ((size_t)R.row * 8 + F.lane) * 2) = __builtin_bit_cast(unsigned short, shv);
}
__device__ __forceinline__ void convert_tables(Frame& F, int layer, int ibeg, int iend, int wk, int nwk) {
    if (ibeg + wk >= iend) return;
    const int ilast = ibeg + wk + ((iend - 1 - ibeg - wk) / nwk) * nwk;
    CtRow A, B;
    ct_load(F, layer, ibeg + wk, A);
    for (int it = ibeg + wk; it < iend; it += 2 * nwk) {
        ct_load(F, layer, it + nwk <= ilast ? it + nwk : ilast, B);
        ct_proc(F, layer, A);
        ct_load(F, layer, it + 2 * nwk <= ilast ? it + 2 * nwk : ilast, A);
        if (it + nwk < iend) ct_proc(F, layer, B);
    }
}
__device__ __forceinline__ void norm_row_bf16(const GAS float* xrow, const GAS float* gain, GAS bf16_t* orow, int lane) {
    f32x4 v[8]; float s = 0.f;
#pragma unroll
    for (int j = 0; j < 8; ++j) { v[j] = *(const GAS f32x4*)(xrow + j * 256 + lane * 4); s += (v[j][0] * v[j][0] + v[j][1] * v[j][1]) + (v[j][2] * v[j][2] + v[j][3] * v[j][3]); }
    const float r = rsqrtf(wave_sum(s) * (1.f / DM) + EPS);
#pragma unroll
    for (int j = 0; j < 8; ++j) { f32x4 g = gain ? *(const GAS f32x4*)(gain + j * 256 + lane * 4) : (f32x4){1.f, 1.f, 1.f, 1.f};
        u32x2 o; o.x = cvtpk(v[j][0] * r * g[0], v[j][1] * r * g[1]); o.y = cvtpk(v[j][2] * r * g[2], v[j][3] * r * g[3]);
        *(GAS u32x2*)(orow + j * 256 + lane * 4) = o; }
}
__device__ __forceinline__ void step_prologue(Frame& F, LAS unsigned char* lds) {
    LAS float* scr = (LAS float*)(lds + F.wave * 16384);
    GAS unsigned char* ws = F.ws;
    constexpr int I0 = 32 * (NIN0 / 32), I1 = 32 * 64, I2 = 32 * 96, I3 = 32 * 64, I4 = 32 * 64, I5 = 32 * 64, I6 = 32 * 64, I7 = 32 * 32, I8 = 32 * 32, I9 = 12 * 16;
    constexpr int NITEMS = I0 + I1 + I2 + I3 + I4 + I5 + I6 + I7 + I8 + I9;
#define TR_DESC(D, it_) do { int r = (it_) < NITEMS ? (it_) : NITEMS - 1; int nblk; \
        if (r < I0) { D = {F.in(I_AWIN), F.in(I_ANORM), (GAS bf16_t*)(ws + O_WIN0), NIN0, DM, 0, 0, 0}; nblk = NIN0 / 32; } else { r -= I0; \
        if (r < I1) { D = {F.in(I_AWOUT), nullptr, (GAS bf16_t*)(ws + O_WOUT0), DM, DM, 0, 0, 0}; nblk = 64; } else { r -= I1; \
        if (r < I2) { D = {F.in(I_SWKVF), F.in(I_SNORM), (GAS bf16_t*)(ws + O_WL1), 3084, DM, 0, 0, 0}; nblk = 96; } else { r -= I2; \
        if (r < I3) { D = {F.in(I_BWIN), F.in(I_BNORM), (GAS bf16_t*)(ws + O_WL1), DM, DM, 3072, 0, 0}; nblk = 64; } else { r -= I3; \
        if (r < I4) { D = {F.in(I_BWOUT), nullptr, (GAS bf16_t*)(ws + O_WOUT1), DM, DM, 0, 0, 0}; nblk = 64; } else { r -= I4; \
        if (r < I5) { D = {F.in(I_PWQ), F.in(I_PNORM), (GAS bf16_t*)(ws + O_WQ0), DM, DM, 0, 0, 0}; nblk = 64; } else { r -= I5; \
        if (r < I6) { D = {F.in(I_PWQ) + (size_t)DM * DM, F.in(I_PNORM) + DM, (GAS bf16_t*)(ws + O_WQ1), DM, DM, 0, 0, 0}; nblk = 64; } else { r -= I6; \
        if (r < I7) { D = {F.in(I_MWKV), nullptr, (GAS bf16_t*)(ws + O_WMKV), 1024, DM, 0, 0, 0}; nblk = 32; } else { r -= I7; \
        if (r < I8) { D = {F.in(I_MWKV) + (size_t)DM * 1024, nullptr, (GAS bf16_t*)(ws + O_WMKV) + (size_t)1024 * DM, 1024, DM, 0, 0, 0}; nblk = 32; } else { r -= I8; \
          const int blk = r / 16; r = r % 16; D = {F.in(I_AGATEW) + (size_t)blk * 128 * 256, nullptr, (GAS bf16_t*)(ws + O_WGATE), 256, 128, blk * 256, 0, 0}; nblk = 8; } } } } } } } } } \
        D.k0 = 64 * (r / nblk); D.n0 = 32 * (r % nblk); } while (0)
    for (int it = F.gw; it < NITEMS; it += F.ngw) { float wv[32]; TrItem d; TR_DESC(d, it); tr_load(d, wv, F.lane); tr_proc(d, wv, scr, F.lane); }
#undef TR_DESC
    { const GAS float* sk = F.in(I_PSUBK); GAS bf16_t* o = (GAS bf16_t*)(ws + O_SUBK);
      for (int i = F.gtid; i < 2 * 16 * 128 * 128 / 2; i += F.ngt) *(GAS unsigned*)(o + 2 * i) = cvtpk(sk[2 * i], sk[2 * i + 1]); }
    { GAS float* wf = (GAS float*)(ws + O_WF); const GAS float* w = F.in(I_SWKVF); const GAS float* g = F.in(I_SNORM);
      for (int i = F.gtid; i < 12 * DM; i += F.ngt) { const int j = i / DM, k = i % DM; wf[i] = w[(size_t)k * 3084 + 3072 + j] * g[k]; } }
    { GAS float* spl = (GAS float*)(ws + O_SPL); const GAS float* lam = F.in(I_ALAMBDA);
      for (int i = F.gtid; i < LRU; i += F.ngt) { const float z = -lam[i]; spl[i] = fmaxf(z, 0.f) + log1p_pos(fast_exp(-fabsf(z))); } }
    if (F.gw == 0) {
        float m = 0.f; for (int d = F.lane; d < 128; d += 64) m = fmaxf(m, fabsf(F.in(I_BQNORM)[d] * F.in(I_SKNORM)[d]));
        m = wave_max(m);
        if (F.lane == 0) ((GAS float*)(ws + O_GG))[512] = 2.f * 11.3137085f * m + 30.f; }
    { GAS float* gg = (GAS float*)(ws + O_GG);
      for (int i = F.gtid; i < 384; i += F.ngt) { const int a = i / 128, d = i % 128;
          gg[a == 0 ? 384 + d : i] = a == 0 ? F.in(I_BQNORM)[d] * F.in(I_SKNORM)[d] : F.in(I_MQNORM)[(a - 1) * 128 + d] * F.in(I_MKNORM)[(a - 1) * 128 + d]; } }
    {
        const GAS float* xin = F.in(I_X) + F.lane * 4; GAS bf16_t* xo = (GAS bf16_t*)(ws + O_XS16) + F.lane * 4;
        const int mlast = F.gw + ((T - 1 - F.gw) / F.ngw) * F.ngw;
#define XN_LOAD(V, m_) do { const int mm_ = (m_) <= mlast ? (m_) : mlast; _Pragma("unroll") for (int j = 0; j < 8; ++j) V[j] = __builtin_nontemporal_load((const GAS f32x4*)(xin + (size_t)mm_ * DM + j * 256)); } while (0)
#define XN_PROC(V, m_) do { if ((m_) < T) { float s0 = 0.f; _Pragma("unroll") for (int j = 0; j < 8; ++j) s0 += (V[j][0] * V[j][0] + V[j][1] * V[j][1]) + (V[j][2] * V[j][2] + V[j][3] * V[j][3]); \
            const float r0 = rsqrtf(wave_sum(s0) * (1.f / DM) + EPS); \
            _Pragma("unroll") for (int j = 0; j < 8; ++j) { u32x2 a; a.x = cvtpk(V[j][0] * r0, V[j][1] * r0); a.y = cvtpk(V[j][2] * r0, V[j][3] * r0); *(GAS u32x2*)(xo + (size_t)(m_) * DM + j * 256) = a; } } } while (0)
        f32x4 va[8], vb[8];
        XN_LOAD(va, F.gw);
        for (int m = F.gw; m < T; m += 2 * F.ngw) { XN_LOAD(vb, m + F.ngw); XN_PROC(va, m); XN_LOAD(va, m + 2 * F.ngw); XN_PROC(vb, m + F.ngw); }
#undef XN_LOAD
#undef XN_PROC
    }
    for (int m = F.gw; m < 2 * NMROW; m += F.ngw) { const int l = m / NMROW, r = m % NMROW;
        norm_row_bf16(F.in(I_MEM) + (size_t)r * DM, F.in(I_MNORM) + l * DM, (GAS bf16_t*)(ws + O_MEMN) + (size_t)m * DM, F.lane); }
    convert_tables(F, 0, 0, 2 * NEXP, F.gw, F.ngw);
}
__device__ __forceinline__ void step_conv(Frame& F) {
    const GAS bf16_t* zx = (const GAS bf16_t*)(F.ws + O_ZX); GAS bf16_t* xc = (GAS bf16_t*)(F.ws + O_XC);
    const GAS float* cw = F.in(I_ACONVW); const GAS float* cb = F.in(I_ACONVB);
    constexpr int NIT = T * (LRU / 8);
#define CV_LOAD(W, it_) do { const int ii_ = (it_) < NIT ? (it_) : NIT - 1; const int t_ = ii_ / (LRU / 8), c8_ = (ii_ % (LRU / 8)) * 8, pos_ = t_ & (SEQ - 1); \
        _Pragma("unroll") for (int k = 0; k < 4; ++k) W[k] = (pos_ - 3 + k >= 0) ? *(const GAS u32x4*)(zx + (size_t)(t_ - 3 + k) * LRU + c8_) : (u32x4){0u, 0u, 0u, 0u}; } while (0)
#define CV_PROC(W, it_) do { if ((it_) < NIT) { const int t_ = (it_) / (LRU / 8), c8_ = ((it_) % (LRU / 8)) * 8; float a[8]; \
        { const f32x4 b0 = *(const GAS f32x4*)(cb + c8_), b1 = *(const GAS f32x4*)(cb + c8_ + 4); a[0] = b0[0]; a[1] = b0[1]; a[2] = b0[2]; a[3] = b0[3]; a[4] = b1[0]; a[5] = b1[1]; a[6] = b1[2]; a[7] = b1[3]; } \
        _Pragma("unroll") for (int k = 0; k < 4; ++k) { const f32x4 w0 = *(const GAS f32x4*)(cw + k * LRU + c8_), w1 = *(const GAS f32x4*)(cw + k * LRU + c8_ + 4); \
            a[0] = fmaf(w0[0], bf_lo(W[k].x), a[0]); a[1] = fmaf(w0[1], bf_hi(W[k].x), a[1]); a[2] = fmaf(w0[2], bf_lo(W[k].y), a[2]); a[3] = fmaf(w0[3], bf_hi(W[k].y), a[3]); \
            a[4] = fmaf(w1[0], bf_lo(W[k].z), a[4]); a[5] = fmaf(w1[1], bf_hi(W[k].z), a[5]); a[6] = fmaf(w1[2], bf_lo(W[k].w), a[6]); a[7] = fmaf(w1[3], bf_hi(W[k].w), a[7]); } \
        u32x4 o; o.x = cvtpk(a[0], a[1]); o.y = cvtpk(a[2], a[3]); o.z = cvtpk(a[4], a[5]); o.w = cvtpk(a[6], a[7]); \
        *(GAS u32x4*)(xc + (size_t)t_ * LRU + c8_) = o; } } while (0)
    u32x4 wa[4], wb[4];
    CV_LOAD(wa, F.gtid);
    for (int it = F.gtid; it < NIT; it += 2 * F.ngt) { CV_LOAD(wb, it + F.ngt); CV_PROC(wa, it); CV_LOAD(wa, it + 2 * F.ngt); CV_PROC(wb, it + F.ngt); }
#undef CV_LOAD
#undef CV_PROC
}
constexpr int SCK = 32, NCK = SEQ / SCK;
typedef _Float16 h8_t __attribute__((ext_vector_type(8)));
__device__ __forceinline__ void scan_load(const GAS _Float16* LA, const GAS _Float16* UH, size_t off, float (&a)[8], float (&u)[8]) {
    const h8_t l = *(const GAS h8_t*)(LA + off), w = *(const GAS h8_t*)(UH + off);
#pragma unroll
    for (int k = 0; k < 8; ++k) { a[k] = fast_exp((float)l[k]); u[k] = (float)w[k]; }
}
__device__ __forceinline__ void step_scan1(Frame& F) {
    const GAS _Float16* LA = (const GAS _Float16*)(F.ws + O_AA); const GAS _Float16* UH = (const GAS _Float16*)(F.ws + O_UU);
    GAS float* CA = (GAS float*)(F.ws + O_LOGFP); GAS float* CH = CA + (size_t)NB * NCK * LRU;
    if (F.tid >= 384) return;
    const int grp = F.tid / 192, th = F.tid % 192;
    for (int it = blockIdx.x * 2 + grp; it < NB * NCK; it += gridDim.x * 2) {
        const int b = it / NCK, ck = it % NCK; const size_t base = ((size_t)b * SEQ + ck * SCK) * LRU + th * 8;
        float ap[8], h[8];
#pragma unroll
        for (int k = 0; k < 8; ++k) { ap[k] = 1.f; h[k] = 0.f; }
#pragma unroll 8
        for (int i = 0; i < SCK; ++i) { float a[8], u[8]; scan_load(LA, UH, base + (size_t)i * LRU, a, u);
#pragma unroll
            for (int k = 0; k < 8; ++k) { ap[k] *= a[k]; h[k] = a[k] * h[k] + u[k]; } }
        GAS float* ca = CA + (size_t)it * LRU + th * 8; GAS float* ch = CH + (size_t)it * LRU + th * 8;
        *(GAS f32x4*)ca = (f32x4){ap[0], ap[1], ap[2], ap[3]}; *(GAS f32x4*)(ca + 4) = (f32x4){ap[4], ap[5], ap[6], ap[7]};
        *(GAS f32x4*)ch = (f32x4){h[0], h[1], h[2], h[3]}; *(GAS f32x4*)(ch + 4) = (f32x4){h[4], h[5], h[6], h[7]};
    }
}
__device__ __forceinline__ void step_scan2(Frame& F) {
    const GAS _Float16* LA = (const GAS _Float16*)(F.ws + O_AA); const GAS _Float16* UH = (const GAS _Float16*)(F.ws + O_UU);
    const GAS float* CA = (const GAS float*)(F.ws + O_LOGFP); const GAS float* CH = CA + (size_t)NB * NCK * LRU;
    const GAS bf16_t* gy = (const GAS bf16_t*)(F.ws + O_GY); GAS bf16_t* cat = (GAS bf16_t*)(F.ws + O_CAT);
    if (F.tid >= 384) return;
    const int grp = F.tid / 192, th = F.tid % 192;
    for (int it = blockIdx.x * 2 + grp; it < NB * NCK; it += gridDim.x * 2) {
        const int b = it / NCK, ck = it % NCK; const size_t base = ((size_t)b * SEQ + ck * SCK) * LRU + th * 8;
        float h[8];
#pragma unroll
        for (int k = 0; k < 8; ++k) h[k] = 0.f;
        for (int k2 = 0; k2 < ck; ++k2) { const size_t o = (size_t)(b * NCK + k2) * LRU + th * 8;
            const f32x4 a0 = *(const GAS f32x4*)(CA + o), a1 = *(const GAS f32x4*)(CA + o + 4), c0 = *(const GAS f32x4*)(CH + o), c1 = *(const GAS f32x4*)(CH + o + 4);
#pragma unroll
            for (int k = 0; k < 4; ++k) { h[k] = a0[k] * h[k] + c0[k]; h[4 + k] = a1[k] * h[4 + k] + c1[k]; } }
#pragma unroll 8
        for (int i = 0; i < SCK; ++i) { float a[8], u[8]; scan_load(LA, UH, base + (size_t)i * LRU, a, u);
            const size_t row = (size_t)b * SEQ + ck * SCK + i;
            const u32x4 g = *(const GAS u32x4*)(gy + row * LRU + th * 8); u32x4 o;
#pragma unroll
            for (int k = 0; k < 8; ++k) h[k] = a[k] * h[k] + u[k];
#pragma unroll
            for (int k = 0; k < 4; ++k) o[k] = cvtpk(h[2 * k] * bf_lo(g[k]), h[2 * k + 1] * bf_hi(g[k]));
            *(GAS u32x4*)(cat + row * DM + th * 8) = o; }
    }
}
__device__ __forceinline__ void step_cprefix(Frame& F, LAS unsigned char* lds) {
    const GAS float* lf = (const GAS float*)(F.ws + O_LOGF); GAS float* cc = (GAS float*)(F.ws + O_CC);
    LAS double* scr = (LAS double*)(lds + F.wave * 16384);
    for (int it = F.gw; it < NB * NH; it += F.ngw) {
        const GAS float* p = lf + (size_t)it * SEQ + F.lane * 64; GAS float* q = cc + (size_t)it * SEQ + F.lane * 64;
        double s = 0.0;
        for (int i = 0; i < 64; ++i) s += (double)p[i];
        scr[F.lane] = s;
        asm volatile("s_waitcnt lgkmcnt(0)" ::: "memory");
        double run = 0.0;
        for (int l = 0; l < 64; ++l) { const double v = scr[l]; if (l < F.lane) run += v; }
        for (int i = 0; i < 64; ++i) { run += (double)p[i]; q[i] = (float)run; }
        asm volatile("s_waitcnt lgkmcnt(0)" ::: "memory");
    }
}

__device__ __forceinline__ int ord_i(float f) { const int b = __float_as_int(f); return b ^ ((b >> 31) & 0x7fffffff); }
__device__ __forceinline__ float unord_f(int k) { return __int_as_float(k ^ ((k >> 31) & 0x7fffffff)); }
template <int N> __device__ __forceinline__ void bitonic_sort_desc(int (&a)[N]) {
#pragma unroll
    for (int k = 2; k <= N; k <<= 1) {
#pragma unroll
        for (int j = k >> 1; j > 0; j >>= 1) {
#pragma unroll
            for (int i = 0; i < N; ++i) { const int l = i ^ j;
                if (l > i) { const bool desc = ((i & k) == 0); const int mx = max(a[i], a[l]), mn = min(a[i], a[l]); a[i] = desc ? mx : mn; a[l] = desc ? mn : mx; } }
        }
    }
}
__device__ __forceinline__ void bitonic_merge16_desc(int (&a)[16]) {
#pragma unroll
    for (int j = 8; j > 0; j >>= 1) {
#pragma unroll
        for (int i = 0; i < 16; ++i) { const int l = i ^ j; if (l > i) { const int mx = max(a[i], a[l]), mn = min(a[i], a[l]); a[i] = mx; a[l] = mn; } }
    }
}
__device__ __forceinline__ void top16_of_64(int (&a)[64]) {
    int g[4][16];
#pragma unroll
    for (int q = 0; q < 4; ++q) {
#pragma unroll
        for (int i = 0; i < 16; ++i) g[q][i] = a[16 * q + i];
        bitonic_sort_desc<16>(g[q]); }
#pragma unroll
    for (int i = 0; i < 16; ++i) { g[0][i] = max(g[0][i], g[1][15 - i]); g[2][i] = max(g[2][i], g[3][15 - i]); }
    bitonic_merge16_desc(g[0]); bitonic_merge16_desc(g[2]);
#pragma unroll
    for (int i = 0; i < 16; ++i) g[0][i] = max(g[0][i], g[2][15 - i]);
    bitonic_merge16_desc(g[0]);
#pragma unroll
    for (int i = 0; i < 16; ++i) a[i] = g[0][i];
}
__device__ __forceinline__ void subkey_top16(const GAS bf16_t* qrow  , const GAS bf16_t* sk  , int r32, int hi, int (&top)[16]) {
    bf16x8 qf[8];
#pragma unroll
    for (int ks = 0; ks < 8; ++ks) qf[ks] = *(const GAS bf16x8*)(qrow + ks * 16 + hi * 8);
    unsigned loff = (unsigned)(r32 * 128 + hi * 8) * 2u; asm volatile("" : "+v"(loff));
    int key[64];
#pragma unroll
    for (int kb = 0; kb < 4; ++kb) {
        f32x16 acc = {};
#pragma unroll
        for (int ks = 0; ks < 8; ++ks) { const bf16x8 af = *(const GAS bf16x8*)((const GAS char*)(sk + kb * 32 * 128 + ks * 16) + loff);
            acc = __builtin_amdgcn_mfma_f32_32x32x16_bf16(af, qf[ks], acc, 0, 0, 0); }
#pragma unroll
        for (int r = 0; r < 16; ++r) { const int id = kb * 32 + (r & 3) + 8 * (r >> 2) + 4 * hi; key[kb * 16 + r] = (ord_i(acc[r]) & ~127) | (127 - id); }
        __builtin_amdgcn_sched_barrier(0);
    }
    top16_of_64(key);
#pragma unroll
    for (int i = 0; i < 16; ++i) { auto r = __builtin_amdgcn_permlane32_swap((unsigned)key[15 - i], (unsigned)key[15 - i], false, false);
        const int pk = hi ? (int)r[0] : (int)r[1]; top[i] = max(key[i], pk); }
    bitonic_merge16_desc(top);
}
__device__ __forceinline__ void step_topk(Frame& F, LAS unsigned char* lds, int layer) {
    const GAS bf16_t* q16 = (const GAS bf16_t*)(F.ws + O_Q16); const GAS bf16_t* subk = (const GAS bf16_t*)(F.ws + O_SUBK) + (size_t)layer * 16 * 128 * 128;
    GAS int* IDX = (GAS int*)(F.ws + O_IDX); GAS float* GW = (GAS float*)(F.ws + O_GW);
    LAS int* scr = (LAS int*)(lds + F.wave * 16384) + F.lane * 33;
    const int r32 = F.lane & 31, hi = F.lane >> 5;
    for (int task = F.gw; task < (T / 32) * 8; task += F.ngw) {
        const int tb = task >> 3, h = task & 7; const int tok = tb * 32 + r32;
        const GAS bf16_t* qrow = q16 + (size_t)tok * DM + h * 256;
        int ta[16], tb16[16];
        subkey_top16(qrow, subk + (size_t)(h * 2 + 0) * 128 * 128, r32, hi, ta);
        subkey_top16(qrow + 128, subk + (size_t)(h * 2 + 1) * 128 * 128, r32, hi, tb16);
        float va[16], vb[16];
#pragma unroll
        for (int i = 0; i < 16; ++i) { va[i] = unord_f(ta[i] & ~127); vb[i] = unord_f(tb16[i] & ~127); scr[i] = 127 - (ta[i] & 127); scr[16 + i] = 127 - (tb16[i] & 127); }
        int c2[64]; int n = 0;
#pragma unroll
        for (int i = 0; i < 16; ++i)
#pragma unroll
            for (int j = 0; j < 16; ++j) if ((i + 1) * (j + 1) <= 16) { c2[n] = (ord_i(va[i] + vb[j]) & ~255) | (255 - (i * 16 + j)); ++n; }
#pragma unroll
        for (int i = 50; i < 64; ++i) c2[i] = (int)0x80000000;
        top16_of_64(c2);
        asm volatile("s_waitcnt lgkmcnt(0)" ::: "memory");
        float sv[16], ex[16]; int ev[16]; float Z = 0.f;
#pragma unroll
        for (int r = 0; r < 16; ++r) { const int flat = 255 - (c2[r] & 255); sv[r] = unord_f(c2[r] & ~255); ev[r] = scr[flat >> 4] * 128 + scr[16 + (flat & 15)]; }
#pragma unroll
        for (int r = 0; r < 16; ++r) { ex[r] = fast_exp(sv[r] - sv[0]); Z += ex[r]; }
        const float iz = 1.f / Z;
        GAS int* ip = IDX + (size_t)tok * 128 + h * 16 + hi * 8; GAS float* gp = GW + (size_t)tok * 128 + h * 16 + hi * 8;
        int eo[8]; float go[8];
#pragma unroll
        for (int j = 0; j < 8; ++j) { eo[j] = hi ? ev[8 + j] : ev[j]; go[j] = (hi ? ex[8 + j] : ex[j]) * iz; }
        *(GAS u32x4*)ip = (u32x4){(unsigned)eo[0], (unsigned)eo[1], (unsigned)eo[2], (unsigned)eo[3]}; *(GAS u32x4*)(ip + 4) = (u32x4){(unsigned)eo[4], (unsigned)eo[5], (unsigned)eo[6], (unsigned)eo[7]};
        *(GAS f32x4*)gp = (f32x4){go[0], go[1], go[2], go[3]}; *(GAS f32x4*)(gp + 4) = (f32x4){go[4], go[5], go[6], go[7]};
        asm volatile("s_waitcnt lgkmcnt(0)" ::: "memory");
    }
}
__device__ __forceinline__ h2 as_h2(unsigned w) { return __builtin_bit_cast(h2, w); }
#define F4(W, s) __builtin_amdgcn_cvt_scalef32_pk_f16_fp4((W), 1.0f, (s))
#define H2F(us) ((float)__builtin_bit_cast(_Float16, (unsigned short)(us)))
__device__ __forceinline__ float sum8(float v) { v += dppf<0xB1>(v); v += dppf<0x4E>(v); v += dppf<0x141>(v); return v; }
__device__ __forceinline__ void step_xplanes(Frame& F) {
    const GAS bf16_t* xs = (const GAS bf16_t*)(F.ws + O_XS16); GAS unsigned char* x4 = F.ws + O_X4; GAS float* sx = (GAS float*)(F.ws + O_SX);
    const int tlast = F.gw + ((T - 1 - F.gw) / F.ngw) * F.ngw;
#define XP_LOAD(W, t_) do { const int tt_ = (t_) <= tlast ? (t_) : tlast; _Pragma("unroll") for (int c = 0; c < 4; ++c) W[c] = *(const GAS u32x4*)(xs + (size_t)tt_ * DM + F.lane * 32 + 8 * c); } while (0)
    u32x4 w[4], wn[4];
    XP_LOAD(w, F.gw);
    for (int t = F.gw; t < T; t += F.ngw) {
        XP_LOAD(wn, t + F.ngw);
        float xv[32]; float amax = 0.f;
#pragma unroll
        for (int c = 0; c < 4; ++c)
#pragma unroll
            for (int k = 0; k < 4; ++k) { xv[8 * c + 2 * k] = bf_lo(w[c][k]); xv[8 * c + 2 * k + 1] = bf_hi(w[c][k]); amax = fmaxf(amax, fmaxf(fabsf(xv[8 * c + 2 * k]), fabsf(xv[8 * c + 2 * k + 1]))); }
        amax = fmaxf(amax, dppf<0xB1>(amax)); amax = fmaxf(amax, dppf<0x4E>(amax)); amax = fmaxf(amax, dppf<0x141>(amax));
        const float sc = fmaxf(amax, 1e-20f) * (1.f / 119.f), qs = 1.f / sc;
        u32x4 hp, lp;
#pragma unroll
        for (int d = 0; d < 4; ++d) { unsigned hw = 0u, lw = 0u;
#pragma unroll
            for (int k = 0; k < 8; ++k) { const int q = (int)rintf(xv[8 * d + k] * qs); const int h = (q + 8) >> 4, l = q - 16 * h; hw |= (unsigned)(h & 15) << (4 * k); lw |= (unsigned)(l & 15) << (4 * k); }
            hp[d] = hw; lp[d] = lw; }
        *(GAS u32x4*)(x4 + ((size_t)t * 64 + F.lane) * 32) = hp; *(GAS u32x4*)(x4 + ((size_t)t * 64 + F.lane) * 32 + 16) = lp;
        if ((F.lane & 7) == 0) sx[(size_t)t * 8 + (F.lane >> 3)] = sc;
#pragma unroll
        for (int c = 0; c < 4; ++c) w[c] = wn[c];
    }
#undef XP_LOAD
}
__device__ __forceinline__ void step_upass(Frame& F, int layer, int G) {
    const int s = blockIdx.x & 7, wk = (blockIdx.x >> 3) * NWAVES + F.wave, nwk = (G >> 3) * NWAVES;
    const GAS unsigned char* UN = F.ws + O_TAB + (size_t)(layer * 2) * TAB_ONE + (size_t)s * NEXP * 128;
    const GAS int* IDX = (const GAS int*)(F.ws + O_IDX); const GAS unsigned char* x4 = F.ws + O_X4 + s * 256; const GAS float* sxp = (const GAS float*)(F.ws + O_SX) + (size_t)s * 8 * T;
    GAS _Float16* part = (GAS _Float16*)(F.ws + O_PART) + (size_t)s * T * 128;
    unsigned lo = (unsigned)F.lane; asm volatile("" : "+v"(lo));
    const unsigned j = lo >> 3, p = lo & 7;
    const int tlast = wk + ((T - 1 - wk) / nwk) * nwk;
#define U_LOADID(ID, t_, q_) do { const int tt_ = (t_) <= tlast ? (t_) : tlast; _Pragma("unroll") for (int b = 0; b < 4; ++b) ID[b] = IDX[(size_t)tt_ * 128 + (q_) * 32 + 8 * b + j]; } while (0)
#define U_LOADX(t_) do { const int tt_ = (t_) <= tlast ? (t_) : tlast; xhn = *(const GAS u32x4*)(x4 + (size_t)tt_ * 2048 + p * 32); xln = *(const GAS u32x4*)(x4 + (size_t)tt_ * 2048 + p * 32 + 16); sxn = sxp[(size_t)p * T + tt_]; } while (0)
#define U_ISSUE(UB, ID) do { _Pragma("unroll") for (int b = 0; b < 4; ++b) UB[b] = *(const GAS u32x4*)(UN + (unsigned)(ID[b] * 128 + (int)p * 16)); } while (0)
#define U_QUARTER(UB, vout, q_) do { _Pragma("unroll") for (int b = 0; b < 4; ++b) { int ah = 0, al = 0; \
            ah = __builtin_amdgcn_sdot8((int)UB[b].x, (int)xh.x, ah, false); al = __builtin_amdgcn_sdot8((int)UB[b].x, (int)xh.y, al, false); \
            ah = __builtin_amdgcn_sdot8((int)UB[b].y, (int)xh.z, ah, false); al = __builtin_amdgcn_sdot8((int)UB[b].y, (int)xh.w, al, false); \
            ah = __builtin_amdgcn_sdot8((int)UB[b].z, (int)xl.x, ah, false); al = __builtin_amdgcn_sdot8((int)UB[b].z, (int)xl.y, al, false); \
            ah = __builtin_amdgcn_sdot8((int)UB[b].w, (int)xl.z, ah, false); al = __builtin_amdgcn_sdot8((int)UB[b].w, (int)xl.w, al, false); \
            const float d = sum8((float)(16 * ah + al) * sxc); vout = (p == (unsigned)(4 * ((q_) & 1) + b)) ? d : vout; } } while (0)
    int idA[4], idB[4]; u32x4 u0[4], u1[4], u2[4], u3[4]; u32x4 xh, xl, xhn, xln; float sxc, sxn;
    U_LOADID(idA, wk, 0); U_LOADID(idB, wk, 1); U_LOADX(wk);
    U_ISSUE(u0, idA); U_LOADID(idA, wk, 2);
    U_ISSUE(u1, idB); U_LOADID(idB, wk, 3);
    U_ISSUE(u2, idA); U_LOADID(idA, wk + nwk, 0);
    xh = xhn; xl = xln; sxc = sxn;
    for (int t = wk; t < T; t += nwk) {
        float v0 = 0.f, v1 = 0.f;
        U_ISSUE(u3, idB); U_LOADID(idB, t + nwk, 1); U_LOADX(t + nwk);
        U_QUARTER(u0, v0, 0);
        U_ISSUE(u0, idA); U_LOADID(idA, t + nwk, 2);
        U_QUARTER(u1, v0, 1);
        U_ISSUE(u1, idB); U_LOADID(idB, t + nwk, 3);
        U_QUARTER(u2, v1, 2);
        U_ISSUE(u2, idA); U_LOADID(idA, t + 2 * nwk, 0);
        U_QUARTER(u3, v1, 3);
        part[(size_t)t * 128 + 8 * p + j] = (_Float16)v0; part[(size_t)t * 128 + 64 + 8 * p + j] = (_Float16)v1;
        xh = xhn; xl = xln; sxc = sxn;
    }
#undef U_LOADID
#undef U_LOADX
#undef U_ISSUE
#undef U_QUARTER
}
__device__ __forceinline__ void step_peer_reduce(Frame& F, int layer) {
    const GAS _Float16* part = (const GAS _Float16*)(F.ws + O_PART); const GAS float* GW = (const GAS float*)(F.ws + O_GW); const GAS int* IDX = (const GAS int*)(F.ws + O_IDX);
    const GAS float* rowss = (const GAS float*)(F.ws + O_ROWSS); GAS unsigned* PK = (GAS unsigned*)(F.ws + O_PK);
    const GAS unsigned char* SU = F.ws + O_TAB + (size_t)(layer * 2) * TAB_ONE + TAB_NIB; const GAS unsigned char* SV = SU + TAB_ONE;
    constexpr int NIT = T * 2;
    struct SA { int id; float gw, rs; float p[8]; }; struct SB { u32x4 su, sv; };
#define RA(X, it_) do { const int ii_ = (it_) < NIT ? (it_) : NIT - 1; const size_t i_ = (size_t)ii_ * 64 + F.lane; X.id = IDX[i_]; X.gw = GW[i_]; X.rs = rowss[(size_t)(ii_ >> 1) * 32 + (F.lane & 31)]; \
        _Pragma("unroll") for (int s = 0; s < 8; ++s) X.p[s] = (float)part[(size_t)s * T * 128 + i_]; } while (0)
#define RB(Y, X) do { Y.su = *(const GAS u32x4*)(SU + (size_t)X.id * 16); Y.sv = *(const GAS u32x4*)(SV + (size_t)X.id * 16); } while (0)
#define RC(X, Y, it_) do { if ((it_) < NIT) { const size_t i_ = (size_t)(it_) * 64 + F.lane; const float r = rsqrtf(wave_sum(X.rs) * (0.5f / DM) + EPS); float d = 0.f; \
        _Pragma("unroll") for (int s = 0; s < 8; ++s) d += X.p[s] * (float)__builtin_bit_cast(_Float16, (unsigned short)(Y.su[s >> 1] >> (16 * (s & 1)))); \
        const float w = X.gw * gelu_tanh(d * r); \
        _Pragma("unroll") for (int s = 0; s < 8; ++s) { const _Float16 ws = (_Float16)(w * (float)__builtin_bit_cast(_Float16, (unsigned short)(Y.sv[s >> 1] >> (16 * (s & 1))))); \
            PK[(size_t)s * T * 128 + i_] = ((unsigned)X.id << 16) | (unsigned)__builtin_bit_cast(unsigned short, ws); } } } while (0)
    SA a0, a1, a2; SB b0, b1;
    RA(a0, F.gw); RA(a1, F.gw + F.ngw); RB(b0, a0);
    for (int it = F.gw; it < NIT; it += F.ngw) {
        RA(a2, it + 2 * F.ngw); RB(b1, a1);
        RC(a0, b0, it);
        a0 = a1; a1 = a2; b0 = b1;
    }
#undef RA
#undef RB
#undef RC
}
__device__ __forceinline__ void step_vpass(Frame& F, int layer, int G, bool dry) {
    const int s = blockIdx.x & 7, wk = (blockIdx.x >> 3) * NWAVES + F.wave, nwk = (G >> 3) * NWAVES;
    const GAS unsigned char* VN = F.ws + O_TAB + (size_t)(layer * 2 + 1) * TAB_ONE + (size_t)s * NEXP * 128;
    const GAS unsigned* PK = (const GAS unsigned*)(F.ws + O_PK) + (size_t)s * T * 128;
    GAS bf16_t* xs = (GAS bf16_t*)(F.ws + O_XS16); GAS float* rsp = (GAS float*)(F.ws + O_RSP);
    unsigned lo = (unsigned)F.lane; asm volatile("" : "+v"(lo));
    const unsigned j = lo >> 3, p = lo & 7;
    const int tlast = wk + ((T - 1 - wk) / nwk) * nwk;
#define V_LOADPK(PKV, t_, q_) do { const int tt_ = (t_) <= tlast ? (t_) : tlast; _Pragma("unroll") for (int b = 0; b < 4; ++b) PKV[b] = PK[(size_t)tt_ * 128 + (q_) * 32 + 8 * b + j]; } while (0)
#define V_ISSUE(VB, PKV) do { _Pragma("unroll") for (int b = 0; b < 4; ++b) VB[b] = *(const GAS u32x4*)(VN + ((PKV[b] >> 16) * 128u + p * 16u)); } while (0)
#define V_CVT4(W, base) do { c_[(base)] = F4(W, 0); c_[(base) + 1] = F4(W, 1); c_[(base) + 2] = F4(W, 2); c_[(base) + 3] = F4(W, 3); } while (0)
#define V_QUARTER(VB, PKV) do { _Pragma("unroll") for (int b = 0; b < 4; ++b) { const _Float16 wl = __builtin_bit_cast(_Float16, (unsigned short)(PKV[b] & 0xffffu)); const h2 wl2 = {wl, wl}; h2 c_[16]; \
            V_CVT4(VB[b].x, 0); V_CVT4(VB[b].y, 4); V_CVT4(VB[b].z, 8); V_CVT4(VB[b].w, 12); \
            __builtin_amdgcn_sched_barrier(0); \
            _Pragma("unroll") for (int k = 0; k < 16; ++k) oh[k] = wl2 * c_[k] + oh[k]; \
            __builtin_amdgcn_sched_barrier(0); } } while (0)
    unsigned pk0[4], pk1[4], pk2[4], pk3[4], pkn[4]; u32x4 v0[4], v1[4], v2[4], v3[4];
    V_LOADPK(pk0, wk, 0); V_LOADPK(pk1, wk, 1); V_LOADPK(pk2, wk, 2); V_LOADPK(pkn, wk, 3);
    V_ISSUE(v0, pk0); V_ISSUE(v1, pk1); V_ISSUE(v2, pk2);
    for (int t = wk; t < T; t += nwk) {
#pragma unroll
        for (int b = 0; b < 4; ++b) pk3[b] = pkn[b];
        V_ISSUE(v3, pk3); V_LOADPK(pkn, t + nwk, 0);
        GAS bf16_t* xb = xs + (size_t)t * DM + s * 256 + p * 32 + j * 4;
        f32x4 x2; { const u32x2 w = *(const GAS u32x2*)xb; x2 = (f32x4){bf_lo(w.x), bf_hi(w.x), bf_lo(w.y), bf_hi(w.y)}; }
        h2 oh[16];
#pragma unroll
        for (int i = 0; i < 16; ++i) oh[i] = (h2){(_Float16)0.f, (_Float16)0.f};
        V_QUARTER(v0, pk0);
#pragma unroll
        for (int b = 0; b < 4; ++b) pk0[b] = pkn[b];
        V_ISSUE(v0, pk0); V_LOADPK(pkn, t + nwk, 1);
        V_QUARTER(v1, pk1);
#pragma unroll
        for (int b = 0; b < 4; ++b) pk1[b] = pkn[b];
        V_ISSUE(v1, pk1); V_LOADPK(pkn, t + nwk, 2);
        V_QUARTER(v2, pk2);
#pragma unroll
        for (int b = 0; b < 4; ++b) pk2[b] = pkn[b];
        V_ISSUE(v2, pk2); V_LOADPK(pkn, t + nwk, 3);
        V_QUARTER(v3, pk3);
#pragma unroll
        for (int i = 0; i < 16; ++i) { unsigned u = __builtin_bit_cast(unsigned, oh[i]);
            h2 a = as_h2(u) + as_h2((unsigned)__builtin_amdgcn_update_dpp(0, (int)u, 0x128, 0xF, 0xF, true)); u = __builtin_bit_cast(unsigned, a);
            { auto r = __builtin_amdgcn_permlane16_swap(u, u, false, false); a = as_h2(r[0]) + as_h2(r[1]); u = __builtin_bit_cast(unsigned, a); }
            { auto r = __builtin_amdgcn_permlane32_swap(u, u, false, false); a = as_h2(r[0]) + as_h2(r[1]); }
            oh[i] = a; }
        h2 o0 = oh[0], o1 = oh[1];
#pragma unroll
        for (int c = 1; c < 8; ++c) { o0 = (j == (unsigned)c) ? oh[2 * c] : o0; o1 = (j == (unsigned)c) ? oh[2 * c + 1] : o1; }
        x2[0] += (float)o0.x; x2[1] += (float)o0.y; x2[2] += (float)o1.x; x2[3] += (float)o1.y;
        if (layer == 1 && !dry) *(GAS f32x4*)(F.out + (size_t)t * DM + s * 256 + p * 32 + j * 4) = x2;
        if (layer == 0 && !dry) {
            { u32x2 o; o.x = cvtpk(x2[0], x2[1]); o.y = cvtpk(x2[2], x2[3]); *(GAS u32x2*)xb = o; }
            const float sst = wave_sum((x2[0] * x2[0] + x2[1] * x2[1]) + (x2[2] * x2[2] + x2[3] * x2[3]));
            if (lo == 0) rsp[(size_t)t * 8 + s] = sst;
        }
    }
#undef V_LOADPK
#undef V_ISSUE
#undef V_CVT4
#undef V_QUARTER
}
#undef F4
#undef H2F
__device__ __forceinline__ void step_logf(Frame& F, LAS unsigned char* lds) {
    const GAS bf16_t* xs = (const GAS bf16_t*)(F.ws + O_XS16); const GAS float* rsp = (const GAS float*)(F.ws + O_RSP); GAS float* logf = (GAS float*)(F.ws + O_LOGF);
    const GAS float* wf = (const GAS float*)(F.ws + O_WF); LAS float* wl = (LAS float*)lds;
    for (int i = F.tid; i < NH * DM / 4; i += NTHREADS) *(LAS f32x4*)(wl + 4 * i) = *(const GAS f32x4*)(wf + 4 * i);
    __syncthreads();
    const int tlast = F.gw + ((T - 1 - F.gw) / F.ngw) * F.ngw;
    unsigned lo = (unsigned)F.lane; asm volatile("" : "+v"(lo));
#define LF_LOAD(W, Q, t_) do { const int tt_ = (t_) <= tlast ? (t_) : tlast; _Pragma("unroll") for (int c = 0; c < 8; ++c) W[c] = *(const GAS u32x2*)(xs + (size_t)tt_ * DM + c * 256 + lo * 4); Q = lo < 8 ? rsp[(size_t)tt_ * 8 + lo] : 0.f; } while (0)
    u32x2 w[8], wn[8]; float q, qn;
    LF_LOAD(w, q, F.gw);
    for (int t = F.gw; t < T; t += F.ngw) {
        LF_LOAD(wn, qn, t + F.ngw);
        asm volatile("" : "+v"(lo));
        const float r1 = rsqrtf(wave_sum(q) * (1.f / DM) + EPS);
        float mine = 0.f;
#pragma unroll 2
        for (int h = 0; h < NH; ++h) { float d = 0.f;
#pragma unroll
            for (int c = 0; c < 8; ++c) { const f32x4 g = *(const LAS f32x4*)(wl + h * DM + c * 256 + lo * 4);
                d += (bf_lo(w[c].x) * g[0] + bf_hi(w[c].x) * g[1]) + (bf_lo(w[c].y) * g[2] + bf_hi(w[c].y) * g[3]); }
            d = wave_sum(d); mine = (lo == (unsigned)h) ? d : mine; }
        if (lo < (unsigned)NH) { const float z = mine * r1 + F.in(I_SBF)[lo];
            logf[((size_t)(t / SEQ) * NH + lo) * SEQ + (t % SEQ)] = fminf(z, 0.f) - log1p_pos(fast_exp(-fabsf(z))); }
#pragma unroll
        for (int c = 0; c < 8; ++c) w[c] = wn[c];
        q = qn;
    }
#undef LF_LOAD
    __syncthreads();
}

#define XB_TMO      128
#define XB_XCNT(j)  (256  + 64 * (j))
#define XB_XSUB(j)  (1280 + 64 * (j))
#define XB_XGEN(j)  (2304 + 64 * (j))
#define XB_TOP      3328
#define XB_TOPGEN   3392
#define XCD_BAR_WORDS 3456
#define XB_SPIN_CAP (1u << 20)
__device__ __forceinline__ unsigned xb_ld(unsigned* p)              { return __hip_atomic_load(p, __ATOMIC_RELAXED, __HIP_MEMORY_SCOPE_AGENT); }
__device__ __forceinline__ unsigned xb_add(unsigned* p, unsigned v) { return __hip_atomic_fetch_add(p, v, __ATOMIC_RELAXED, __HIP_MEMORY_SCOPE_AGENT); }
__device__ __forceinline__ unsigned xb_xcc_id() { return (unsigned)__builtin_amdgcn_s_getreg((3 << 11) | 20) & 0xFu; }
#define XB_SPIN(cond, bar) do { unsigned _sp = 0; while (cond) { __builtin_amdgcn_s_sleep(1); \
    if ((++_sp & 255u) == 0u) { if (xb_ld(&(bar)[XB_TMO])) break; if (_sp > XB_SPIN_CAP) { atomicAdd(&(bar)[XB_TMO], 1u); break; } } } } while (0)
struct XcdBarrier { unsigned* bar; unsigned x; volatile LAS unsigned* st; };
__device__ __forceinline__ XcdBarrier xcd_barrier_post(unsigned* bar, volatile LAS unsigned* st) {
    XcdBarrier b; b.bar = bar; b.x = xb_xcc_id(); b.st = st;
    if (threadIdx.x == 0) (void)xb_add(&bar[XB_XCNT(b.x)], 1u);
    return b;
}
__device__ __forceinline__ void xcd_barrier_complete(unsigned* bar, unsigned x, unsigned& nloc, unsigned& nx) {
    const unsigned G = gridDim.x * gridDim.y * gridDim.z;
    unsigned sum, cnt, mine, sp = 0u;
    for (;;) {
        sum = 0u; cnt = 0u; mine = 0u;
#pragma unroll
        for (unsigned j = 0; j < 16; ++j) { const unsigned c = xb_ld(&bar[XB_XCNT(j)]); sum += c; cnt += (c > 0u) ? 1u : 0u; mine = (j == x) ? c : mine; }
        if (sum == G) break;
        __builtin_amdgcn_s_sleep(1);
        if ((++sp & 255u) == 0u) { if (xb_ld(&bar[XB_TMO])) break; if (sp > XB_SPIN_CAP) { atomicAdd(&bar[XB_TMO], 1u); break; } }
    }
    nloc = mine > 0u ? mine : 1u; nx = cnt > 0u ? cnt : 1u;
}
__device__ __forceinline__ void xcd_barrier(const XcdBarrier& b, int wave_s) {
    asm volatile("s_waitcnt vmcnt(0)" ::: "memory");
    __syncthreads();
    int ln_; asm volatile("v_mbcnt_lo_u32_b32 %0, -1, 0\n\tv_mbcnt_hi_u32_b32 %0, -1, %0" : "=v"(ln_));
    if (wave_s == 0 && ln_ == 0) {
        unsigned* bar = b.bar;
        __builtin_amdgcn_s_waitcnt(0);
        unsigned nloc = b.st[0], nx = b.st[1];
        if (nloc == 0u) { xcd_barrier_complete(bar, b.x, nloc, nx); b.st[0] = nloc; b.st[1] = nx; }
        const unsigned old = xb_add(&bar[XB_XSUB(b.x)], 1u);
        const unsigned gen = old / nloc;
        if (old + 1u == (gen + 1u) * nloc) {
            __builtin_amdgcn_fence(__ATOMIC_RELEASE, "agent");
            asm volatile("s_waitcnt vmcnt(0)" ::: "memory");
            const unsigned og = xb_add(&bar[XB_TOP], 1u);
            const unsigned tg = og / nx;
            if (og + 1u == (tg + 1u) * nx) xb_add(&bar[XB_TOPGEN], 1u);
            else XB_SPIN(xb_ld(&bar[XB_TOPGEN]) == tg, bar);
            __builtin_amdgcn_fence(__ATOMIC_ACQUIRE, "agent");
            xb_add(&bar[XB_XGEN(b.x)], 1u);
            asm volatile("s_waitcnt vmcnt(0)" ::: "memory");
        } else {
            XB_SPIN(xb_ld(&bar[XB_XGEN(b.x)]) == gen, bar);
            __builtin_amdgcn_fence(__ATOMIC_ACQUIRE, "agent");
            asm volatile("s_waitcnt vmcnt(0)" ::: "memory");
        }
    }
    __syncthreads();
}

constexpr int CONV1_SPLIT = 2 * 4608;
constexpr int BAR_LDS_OFF = 147456 - 64;
constexpr int LDS_BYTES = 147456;
enum { ST_PROLOGUE = 0, ST_G_IN0, ST_G_MKV0, ST_G_MKV1, ST_CONV, ST_G_GATE, ST_A_MEM0, ST_SCAN1, ST_SCAN2, ST_G_OUT0, ST_G_PQ0, ST_TOPK0, ST_UPASS0, ST_PRED0, ST_VPASS0,
       ST_G_L1, ST_CPREFIX, ST_A_FOX, ST_A_MEM1, ST_G_OUT1, ST_G_PQ1, ST_TOPK1, ST_UPASS1, ST_PRED1, ST_VPASS1, N_STEPS };
constexpr unsigned SYNC_AFTER = (1u << ST_PROLOGUE) | (1u << ST_G_MKV1) | (1u << ST_CONV) | (1u << ST_A_MEM0) | (1u << ST_SCAN1) | (1u << ST_SCAN2) | (1u << ST_G_OUT0) | (1u << ST_G_PQ0) |
                                (1u << ST_TOPK0) | (1u << ST_UPASS0) | (1u << ST_PRED0) | (1u << ST_VPASS0) | (1u << ST_G_L1) | (1u << ST_CPREFIX) | (1u << ST_A_MEM1) | (1u << ST_G_OUT1) | (1u << ST_G_PQ1) | (1u << ST_TOPK1) | (1u << ST_UPASS1) | (1u << ST_PRED1);
constexpr unsigned GEMM_STEPS = (1u << ST_G_IN0) | (1u << ST_G_MKV0) | (1u << ST_G_MKV1) | (1u << ST_G_GATE) | (1u << ST_G_OUT0) | (1u << ST_G_PQ0) | (1u << ST_G_L1) | (1u << ST_G_OUT1) | (1u << ST_G_PQ1);
constexpr unsigned ATTN_STEPS = (1u << ST_A_MEM0) | (1u << ST_A_FOX) | (1u << ST_A_MEM1);

struct Args { const float* in[N_IN]; float* out; unsigned char* ws; int lo, hi; };

__global__ void __launch_bounds__(NTHREADS, 2) yoco_fwd(Args args) {
    extern __shared__ __attribute__((aligned(16))) unsigned char lds[];
    volatile LAS unsigned* bst = (volatile LAS unsigned*)((LAS unsigned char*)lds + BAR_LDS_OFF);
    if (threadIdx.x == 0) { bst[0] = 0u; bst[1] = 0u; }
    __syncthreads();
    const XcdBarrier gbar = xcd_barrier_post((unsigned*)(args.ws + O_CTL), bst);
    const int G = gridDim.x;
    const int wave_s = __builtin_amdgcn_readfirstlane(threadIdx.x >> 6);
#ifndef DUP_MASK
#define DUP_MASK 0u
#endif
    for (int st = args.lo; st < args.hi; ++st) {
      const int nrep = ((DUP_MASK >> st) & 1u) ? 2 : 1;
      for (int rep = 0; rep < nrep; ++rep) {
        unsigned char* ws0 = args.ws; asm volatile("" : "+s"(ws0));
        GAS unsigned char* ws = (GAS unsigned char*)ws0;
#define LANE_ID(v) asm volatile("v_mbcnt_lo_u32_b32 %0, -1, 0\n\tv_mbcnt_hi_u32_b32 %0, -1, %0" : "=v"(v))
#define MAKE_TID(v) do { LANE_ID(v); v += wave_s * 64; } while (0)
#define MAKE_FRAME(F) Frame F; F.ws = ws; F.in_ = args.in; F.out = (GAS float*)args.out; { int t0_; MAKE_TID(t0_); F.tid = t0_; } F.lane = F.tid & 63; F.wave = wave_s; \
        F.gw = blockIdx.x * NWAVES + F.wave; F.ngw = gridDim.x * NWAVES; F.gtid = blockIdx.x * NTHREADS + F.tid; F.ngt = gridDim.x * NTHREADS
        if (st == ST_G_L1) { MAKE_FRAME(F); step_logf(F, (LAS unsigned char*)lds); }
        if ((GEMM_STEPS >> st) & 1u) {
            pg8::Gemm g; Epi E; E.ws = ws; E.resid = nullptr; E.outf = nullptr; E.o16 = nullptr; E.ssq = nullptr; E.gate_b = nullptr; int shift = 0;
            switch (st) {
            case ST_G_IN0:  g = {(const GAS bf16_t*)(ws + O_XS16), (const GAS bf16_t*)(ws + O_WIN0), T, NIN0, DM, DM, DM, 0}; E.mode = EM_IN0; break;
            case ST_G_MKV0: g = {(const GAS bf16_t*)(ws + O_MEMN), (const GAS bf16_t*)(ws + O_WMKV), NMROW, 1024, DM, DM, DM, 0}; E.mode = EM_MKV; E.o16 = (GAS bf16_t*)(ws + O_MKV); E.ssq = (GAS float*)(ws + O_MKSS); shift = 128; break;
            case ST_G_MKV1: g = {(const GAS bf16_t*)(ws + O_MEMN) + (size_t)NMROW * DM, (const GAS bf16_t*)(ws + O_WMKV) + (size_t)1024 * DM, NMROW, 1024, DM, DM, DM, 0}; E.mode = EM_MKV;
                            E.o16 = (GAS bf16_t*)(ws + O_MKV) + (size_t)NMROW * NL1; E.ssq = (GAS float*)(ws + O_MKSS) + NMROW * 112; shift = 144; break;
            case ST_G_GATE: g = {(const GAS bf16_t*)(ws + O_XC), (const GAS bf16_t*)(ws + O_WGATE), T, 12 * 256, 128, LRU, 128, 128}; E.mode = EM_GATE; E.gate_b = (const GAS float*)args.in[I_AGATEB]; break;
            case ST_G_OUT0: g = {(const GAS bf16_t*)(ws + O_CAT), (const GAS bf16_t*)(ws + O_WOUT0), T, DM, DM, DM, DM, 0}; E.mode = EM_RES; E.resid = (const GAS float*)args.in[I_X]; E.outf = (GAS float*)args.out; break;
            case ST_G_PQ0:  g = {(const GAS bf16_t*)(ws + O_XS16), (const GAS bf16_t*)(ws + O_WQ0), T, DM, DM, DM, DM, 0}; E.mode = EM_PQ; E.o16 = (GAS bf16_t*)(ws + O_Q16); break;
            case ST_G_L1:   g = {(const GAS bf16_t*)(ws + O_XS16), (const GAS bf16_t*)(ws + O_WL1), T, NL1, DM, DM, DM, 0}; E.mode = EM_L1; break;
            case ST_G_OUT1: g = {(const GAS bf16_t*)(ws + O_CAT), (const GAS bf16_t*)(ws + O_WOUT1), T, DM, DM, DM, DM, 0}; E.mode = EM_RES; E.resid = nullptr; break;
            default:        g = {(const GAS bf16_t*)(ws + O_XS16), (const GAS bf16_t*)(ws + O_WQ1), T, DM, DM, DM, DM, 0}; E.mode = EM_PQ; E.o16 = (GAS bf16_t*)(ws + O_Q16); break;
            }
            pg8::StaticOrder S; S.init(g.M, g.N, G, (int)((blockIdx.x + G - shift) % G));
#ifndef DIS_GEMM
            { int tg_; MAKE_TID(tg_);
              pg8::gemm_phase<Epi, false>((LAS unsigned char*)lds, g, S, E, tg_); }
#endif
            if (st == ST_G_MKV1 && blockIdx.x >= 160) { MAKE_FRAME(F); convert_tables(F, 1, 0, CONV1_SPLIT, (blockIdx.x - 160) * NWAVES + F.wave, (G - 160) * NWAVES); }
        } else if ((ATTN_STEPS >> st) & 1u) {
            const int nun = st == ST_A_FOX ? 3 : 1;
            for (int ui = 0; ui < nun; ++ui) {
                att::BlockRef r;
                if (st == ST_A_FOX) {
                    const int i = blockIdx.x, x = i & 15, bh = (i >> 4) + 16 * ui, qb = ui == 0 ? x : (ui == 1 ? 15 - x : ((x * 5 + 3) & 15));
                    const int b = bh / NH, h = bh % NH; const size_t row0 = (size_t)b * SEQ + qb * 256;
                    const GAS bf16_t* z = (const GAS bf16_t*)(ws + O_ZL1);
                    r.Q = z + row0 * NL1 + 3072 + h * 128; r.K = z + (size_t)b * SEQ * NL1 + h * 128; r.V = z + (size_t)b * SEQ * NL1 + 1536 + h * 128;
                    r.O = (GAS bf16_t*)(ws + O_CAT) + row0 * DM + h * 128;
                    const GAS float* ss = (const GAS float*)(ws + O_SSL1);
                    r.qss = ss + row0 * 112 + (12 + h) * 4; r.kss = ss + (size_t)b * SEQ * 112 + h * 4; r.cc = (const GAS float*)(ws + O_CC) + (size_t)bh * SEQ; r.gg = (const GAS float*)(ws + O_GG) + 384;
                    r.P0 = qb * 256; r.skv = SEQ;
                } else {
                    const int l = st == ST_A_MEM0 ? 0 : 1; const int i = blockIdx.x, qblk = i >> 2, h = i & 3, b = qblk >> 4; const size_t row0 = (size_t)qblk * 256;
                    r.Q = (const GAS bf16_t*)(ws + O_ZL1) + row0 * NL1 + 4608 + h * 128; r.qss = (const GAS float*)(ws + O_SSL1) + row0 * 112 + (24 + h) * 4;
                    const GAS bf16_t* kv = (const GAS bf16_t*)(ws + O_MKV) + ((size_t)l * NMROW + b * NMEM) * NL1;
                    r.K = kv + h * 128; r.V = kv + 512 + h * 128; r.kss = (const GAS float*)(ws + O_MKSS) + ((size_t)l * NMROW + b * NMEM) * 112 + h * 4;
                    r.O = (GAS bf16_t*)(ws + O_CAT) + row0 * DM + LRU + h * 128; r.cc = nullptr; r.gg = (const GAS float*)(ws + O_GG) + 128 * (1 + l);
                    r.P0 = SEQ; r.skv = NMEM;
                }
                att::Seam S;
                int tid_u; MAKE_TID(tid_u);
#ifndef DIS_ATTN
                if (st == ST_A_FOX) { att::attn_prime(r, (char*)lds, S, tid_u); att::attn_block(r, (char*)lds, S, tid_u); }
                else att::mem_attn_unit(r, (char*)lds, tid_u);
#endif
            }
        } else {
            MAKE_FRAME(F);
            switch (st) {
#ifndef DIS_MISC
            case ST_PROLOGUE: step_prologue(F, (LAS unsigned char*)lds); break;
            case ST_CONV: step_conv(F); break;
            case ST_SCAN1: step_scan1(F); break;
            case ST_SCAN2: step_scan2(F); break;
#endif
#ifndef DIS_TOPK
            case ST_TOPK0: step_topk(F, (LAS unsigned char*)lds, 0); break;
            case ST_TOPK1: step_topk(F, (LAS unsigned char*)lds, 1); break;
#endif
#ifndef DIS_GATHER
            case ST_UPASS0: step_upass(F, 0, G); break;
            case ST_UPASS1: step_upass(F, 1, G); break;
            case ST_PRED0: step_peer_reduce(F, 0); break;
            case ST_PRED1: step_peer_reduce(F, 1); break;
            case ST_VPASS0: step_vpass(F, 0, G, rep + 1 < nrep); break;
            case ST_VPASS1: step_vpass(F, 1, G, rep + 1 < nrep); break;
#endif
#ifndef DIS_MISC
            case ST_CPREFIX: step_cprefix(F, (LAS unsigned char*)lds); convert_tables(F, 1, G > 160 ? CONV1_SPLIT : 0, 2 * NEXP, F.gw, F.ngw); break;
#endif
            default: break;
            }
        }
        if (rep + 1 < nrep) xcd_barrier(gbar, wave_s);
      }
        if (((SYNC_AFTER >> st) & 1u) && st + 1 < args.hi) xcd_barrier(gbar, wave_s);
    }
}

#ifndef N_LAUNCH_MODE
#define N_LAUNCH_MODE 1
#endif
extern "C" void kernel_launch(void* const* d_in, const int* in_sizes, int n_in, void* d_out, int out_size, void* d_ws, size_t ws_size, hipStream_t stream) {
    static int grid = 0;
    if (grid == 0) {
        if (n_in != N_IN || in_sizes[0] != T * DM || out_size != T * DM || ws_size < WS_END) {
            fprintf(stderr, "kernel_launch: unexpected shapes (n_in %d, in0 %d, out %d, ws %zu, need %zu)\n", n_in, n_in > 0 ? in_sizes[0] : -1, out_size, ws_size, (size_t)WS_END); grid = -1; return; }
        int dev = 0, cus = 0, per_cu = 0;
        hipGetDevice(&dev); hipDeviceGetAttribute(&cus, hipDeviceAttributeMultiprocessorCount, dev);
        hipFuncSetAttribute((const void*)yoco_fwd, hipFuncAttributeMaxDynamicSharedMemorySize, LDS_BYTES);
        hipOccupancyMaxActiveBlocksPerMultiprocessor(&per_cu, (const void*)yoco_fwd, NTHREADS, LDS_BYTES);
        if (per_cu < 1) { fprintf(stderr, "kernel_launch: occupancy query says %d blocks per CU\n", per_cu); grid = -1; return; }
        grid = cus - cus % 8;
        (void)hipGetLastError();
    }
    if (grid < 0) return;
    Args a{};
    for (int i = 0; i < N_IN; ++i) a.in[i] = (const float*)d_in[i];
    a.out = (float*)d_out; a.ws = (unsigned char*)d_ws;
    if (hipMemsetAsync((char*)d_ws + O_CTL, 0, 65536, stream) != hipSuccess) { fprintf(stderr, "kernel_launch: memset of the barrier words failed\n"); return; }
    if (N_LAUNCH_MODE == 1) {
        a.lo = 0; a.hi = N_STEPS;
        hipLaunchKernelGGL(yoco_fwd, dim3(grid), dim3(NTHREADS), LDS_BYTES, stream, a);
        hipError_t e = hipPeekAtLastError();
        if (e != hipSuccess) fprintf(stderr, "launch failed: %s (grid %d)\n", hipGetErrorString(e), grid);
    } else {
        int lo = 0;
        for (int s = 0; s < N_STEPS; ++s) {
            if (((SYNC_AFTER >> s) & 1u) || s == N_STEPS - 1) {
                a.lo = lo; a.hi = s + 1; lo = s + 1;
                void* params[] = {&a};
                hipError_t e = hipLaunchCooperativeKernel((const void*)yoco_fwd, dim3(grid), dim3(NTHREADS), params, LDS_BYTES, stream);
                if (e != hipSuccess) { fprintf(stderr, "launch failed: %s\n", hipGetErrorString(e)); break; }
            }
        }
    }
}
```

```cpp
#include <hip/hip_runtime.h>
#include <hip/hip_cooperative_groups.h>
#include <cstdio>
#include <cstdint>
namespace cg = cooperative_groups;

#define LAS __attribute__((address_space(3)))
#define GAS __attribute__((address_space(1)))
typedef unsigned short bf16_t;
typedef short bf16x8 __attribute__((ext_vector_type(8)));
typedef short s16x4 __attribute__((ext_vector_type(4)));
typedef float f32x4 __attribute__((ext_vector_type(4)));
typedef float f32x2 __attribute__((ext_vector_type(2)));
typedef float f32x16 __attribute__((ext_vector_type(16)));
typedef unsigned u32x4 __attribute__((ext_vector_type(4)));
typedef unsigned u32x2 __attribute__((ext_vector_type(2)));
typedef _Float16 h2 __attribute__((ext_vector_type(2)));

constexpr int NB = 4, SEQ = 4096, T = NB * SEQ, DM = 2048, LRU = 1536, MEMW = 512, NMEM = 256, NH = 12, HD = 128;
constexpr int NIN0 = 3584, NL1 = 5120, NEXP = 16384, NMROW = NB * NMEM;
constexpr float EPS = 1e-6f;
constexpr int NTHREADS = 512, NWAVES = 8;

constexpr size_t MiB = 1u << 20;
constexpr size_t O_CTL = 0;
constexpr size_t O_WIN0 = 1 * MiB;
constexpr size_t O_WOUT0 = O_WIN0 + 14 * MiB;
constexpr size_t O_WL1 = O_WOUT0 + 8 * MiB;
constexpr size_t O_WOUT1 = O_WL1 + 20 * MiB;
constexpr size_t O_WQ0 = O_WOUT1 + 8 * MiB;
constexpr size_t O_WQ1 = O_WQ0 + 8 * MiB;
constexpr size_t O_WMKV = O_WQ1 + 8 * MiB;
constexpr size_t O_WGATE = O_WMKV + 8 * MiB;
constexpr size_t O_SUBK = O_WGATE + 1 * MiB;
constexpr size_t O_WF = O_SUBK + 1 * MiB;
constexpr size_t O_SMALL = O_WF + 1 * MiB;
constexpr size_t O_RS1 = O_SMALL;
constexpr size_t O_LOGF = O_SMALL + 64 * 1024;
constexpr size_t O_CC = O_LOGF + 768 * 1024;
constexpr size_t O_GG = O_CC + 768 * 1024;
constexpr size_t O_SPL = O_GG + 4096;
constexpr size_t O_TSC = O_SPL + 8192;
constexpr size_t O_ROWSS = O_SMALL + 2 * MiB;
constexpr size_t O_RSP = O_ROWSS + 2 * MiB;
constexpr size_t O_QMSS = O_RSP;
constexpr size_t O_MKSS = O_QMSS + 1 * MiB;
constexpr size_t O_SSL1 = O_MKSS + 1 * MiB;
constexpr size_t O_CARRY = O_SSL1 + 7 * MiB;
constexpr size_t O_MEMN = O_CARRY + 3 * MiB;
constexpr size_t O_MKV = O_MEMN + 8 * MiB;
constexpr size_t O_IDX = O_MKV + 20 * MiB;
constexpr size_t O_GW = O_IDX + 8 * MiB;
constexpr size_t O_TAB = O_GW + 8 * MiB;
constexpr size_t TAB_NIB = (size_t)8 * 16384 * 128, TAB_ONE = TAB_NIB + (size_t)16384 * 16 + 786432;
constexpr size_t O_XS16 = O_TAB + 128 * MiB;
constexpr size_t O_CAT = O_XS16 + 64 * MiB;
constexpr size_t O_ZX = O_CAT + 64 * MiB;
constexpr size_t O_X8 = O_ZX;
constexpr size_t O_GY = O_ZX + 48 * MiB;
constexpr size_t O_LOGFP = O_GY + 48 * MiB;
constexpr size_t O_QM = O_LOGFP;
constexpr size_t O_XC = O_QM + 16 * MiB;
constexpr size_t O_X4 = O_XC;
constexpr size_t O_SX = O_XC + 32 * MiB;
constexpr size_t O_AA = O_XC + 48 * MiB;
constexpr size_t O_PART = O_AA;
constexpr size_t O_UU = O_AA + 96 * MiB;
constexpr size_t O_W8 = O_UU;
constexpr size_t O_Q16 = O_UU + 96 * MiB;
constexpr size_t O_ZL1 = O_Q16 + 64 * MiB;
constexpr size_t WS_END = O_ZL1 + 160 * MiB;
static_assert(WS_END <= 1024 * MiB, "workspace map");

__device__ __forceinline__ unsigned cvtpk(float lo, float hi) { unsigned r; asm volatile("v_cvt_pk_bf16_f32 %0, %1, %2" : "=v"(r) : "v"(lo), "v"(hi)); return r; }
__device__ __forceinline__ float bf_lo(unsigned w) { return __uint_as_float(w << 16); }
__device__ __forceinline__ float bf_hi(unsigned w) { return __uint_as_float(w & 0xffff0000u); }
__device__ __forceinline__ float fast_exp(float x) { return __builtin_amdgcn_exp2f(x * 1.4426950408889634f); }
__device__ __forceinline__ float log1p_pos(float y) { const float ser = y * (1.f - y * (0.5f - y * (0.33333334f - 0.25f * y))); const float lg = __builtin_amdgcn_logf(1.f + y) * 0.6931471805599453f; return y < 0.03f ? ser : lg; }
__device__ __forceinline__ float one_minus_exp(float x) { const float ser = -x * (1.f + x * (0.5f + x * (0.16666667f + x * 0.041666668f))); const float big = 1.f - fast_exp(x); return x > -0.03f ? ser : big; }
__device__ __forceinline__ float sigmoidf_(float x) { return __builtin_amdgcn_rcpf(1.f + fast_exp(-x)); }
__device__ __forceinline__ float gelu_tanh(float x) { const float u = x * (1.f + 0.044715f * x * x); return x * __builtin_amdgcn_rcpf(1.f + __builtin_amdgcn_exp2f(u * (-2.f * 0.7978845608028654f * 1.4426950408889634f))); }
template <int CTRL> __device__ __forceinline__ float dppf(float v) { return __int_as_float(__builtin_amdgcn_update_dpp(0, __float_as_int(v), CTRL, 0xF, 0xF, true)); }
__device__ __forceinline__ float xsum16(float v) { auto r = __builtin_amdgcn_permlane16_swap(__float_as_uint(v), __float_as_uint(v), false, false); return __uint_as_float(r[0]) + __uint_as_float(r[1]); }
__device__ __forceinline__ float xsum32(float v) { auto r = __builtin_amdgcn_permlane32_swap(__float_as_uint(v), __float_as_uint(v), false, false); return __uint_as_float(r[0]) + __uint_as_float(r[1]); }
__device__ __forceinline__ float xmax16(float v) { auto r = __builtin_amdgcn_permlane16_swap(__float_as_uint(v), __float_as_uint(v), false, false); return fmaxf(__uint_as_float(r[0]), __uint_as_float(r[1])); }
__device__ __forceinline__ float xmax32(float v) { auto r = __builtin_amdgcn_permlane32_swap(__float_as_uint(v), __float_as_uint(v), false, false); return fmaxf(__uint_as_float(r[0]), __uint_as_float(r[1])); }
__device__ __forceinline__ float wave_sum(float v) {
    v += dppf<0xB1>(v); v += dppf<0x4E>(v); v += dppf<0x141>(v); v += dppf<0x140>(v);
    v = xsum16(v); v = xsum32(v); return v;
}
__device__ __forceinline__ float wave_max(float v) {
    v = fmaxf(v, dppf<0xB1>(v)); v = fmaxf(v, dppf<0x4E>(v)); v = fmaxf(v, dppf<0x141>(v)); v = fmaxf(v, dppf<0x140>(v));
    v = xmax16(v); v = xmax32(v); return v;
}

namespace pg8 {
constexpr int BM = 256, BK = 64, HALF = 128, HTB = HALF * BK * 2, STAGE_BYTES = 8 * HTB, NXCD = 8, WGM = 8;
__host__ __device__ __forceinline__ int lds_byte(int r, int c) { const int st = (r >> 4) * 2 + (c >> 5), rr = r & 15, cc = c & 31, ob = rr * 64 + cc * 2; return st * 1024 + (ob ^ (((ob >> 9) & 1) << 5)); }
__host__ __device__ __forceinline__ void stage_rc(int b, int& R, int& C) { const int st = b / 1024, sb = b % 1024, swz = sb ^ (((sb >> 9) & 1) << 5); R = (st >> 1) * 16 + swz / 64; C = (st & 1) * 32 + (swz % 64) / 2; }
__host__ __device__ __forceinline__ int perm32(int rho) { const int n = rho >> 4, i = rho & 15; return 8 * (i >> 2) + 4 * n + (i & 3); }

struct Unit { int pm, pn; };
struct Gemm { const GAS bf16_t* A; const GAS bf16_t* Bt; int M, N, K, lda, ldb, acol; };

struct StaticOrder {
    int nM, nN, nwg, G, c;
    __device__ void init(int M, int N, int G_, int c_) { nM = M / BM; nN = N / BM; nwg = nM * nN; G = G_; c = c_; }
    __device__ bool next(int i, Unit& u) const {
        const long L = (long)i * G + c; if (L >= nwg) return false;
        int wgid = (int)L; { const int q = nwg / NXCD, r = nwg % NXCD, xcd = wgid % NXCD, off = wgid / NXCD; wgid = (xcd < r ? xcd * (q + 1) : r * (q + 1) + (xcd - r) * q) + off; }
        const int nig = WGM * nN, gid = wgid / nig, fm = gid * WGM, gsz = (nM - fm) < WGM ? (nM - fm) : WGM;
        u.pm = fm + ((wgid % nig) % gsz); u.pn = (wgid % nig) / gsz; return true;
    }
};

typedef int v8i_t __attribute__((ext_vector_type(8)));
typedef int v4i_t __attribute__((ext_vector_type(4)));
template <class Epi, bool FP8>
__device__ __forceinline__ void gemm_phase(LAS unsigned char* lds, const Gemm g, const StaticOrder& S, const Epi& E, const int tid) {
    const int wid = __builtin_amdgcn_readfirstlane(tid >> 6), lane = tid & 63, wr = wid >> 2, wc = wid & 3, fr = lane & 15, fq = lane >> 4;
    const int K = g.K, nt = K / BK;
    unsigned voffA[2], voffB[2];
#pragma unroll
    for (int i = 0; i < 2; ++i) { int R, C; stage_rc(tid * 16 + i * 8192, R, C); const int Rb = (R & ~31) + perm32(R & 31);
        voffA[i] = (unsigned)(R * g.lda + C) * 2u; voffB[i] = (unsigned)(Rb * g.ldb + C) * 2u; }
    const size_t kstep = (size_t)(BK * 2);
    const size_t hstepA = (size_t)HALF * g.lda * 2, hstepB = (size_t)HALF * g.ldb * 2;
    const size_t tstepA = 2 * hstepA, tstepB = 2 * hstepB;
    const unsigned ldsw = (unsigned)wid * 1024u;
    const int aoff = lds_byte(wr * 64 + fr, fq * 8), boff = lds_byte(wc * 32 + fr, fq * 8);
#define PG8_SA(b, h) (((b) * 2 + (h)) * HTB)
#define PG8_SB(b, h) ((4 + (b) * 2 + (h)) * HTB)
#define PG8_STAGE(bufoff, gbase, voff) do { _Pragma("unroll") for (int _i = 0; _i < 2; ++_i) \
        __builtin_amdgcn_global_load_lds((const GAS unsigned*)((gbase) + (voff)[_i]), (LAS unsigned*)(lds + (bufoff) + ldsw + _i * 8192), 16, 0, 0); } while (0)
#define PG8_LD2(dst, off_) do { const u32x4 lo_ = *(const LAS u32x4*)(lds + (off_)), hi_ = *(const LAS u32x4*)(lds + (off_) + 1024); \
        dst = (v8i_t){(int)lo_.x, (int)lo_.y, (int)lo_.z, (int)lo_.w, (int)hi_.x, (int)hi_.y, (int)hi_.z, (int)hi_.w}; } while (0)
#define PG8_LDA(dst, b, h) do { _Pragma("unroll") for (int m = 0; m < 4; ++m) PG8_LD2(dst[m], PG8_SA(b, h) + aoff + m * 2048); } while (0)
#define PG8_LDB(dst, b, h) do { _Pragma("unroll") for (int n = 0; n < 2; ++n) PG8_LD2(dst[n], PG8_SB(b, h) + boff + n * 2048); } while (0)
#define PG8_HALF(v, k) ((k) ? __builtin_shufflevector(v, v, 4, 5, 6, 7) : __builtin_shufflevector(v, v, 0, 1, 2, 3))
#define PG8_MMA(ai, bj, At, Bt) do { __builtin_amdgcn_s_setprio(1); _Pragma("unroll") for (int m = 0; m < 4; ++m) _Pragma("unroll") for (int n = 0; n < 2; ++n) { \
        if constexpr (FP8) asm volatile("v_mfma_scale_f32_16x16x128_f8f6f4 %0, %1, %2, %0, %3, %4 op_sel_hi:[0,0,0]" : "+v"(acc[ai][bj][m][n]) : "v"(Bt[n]), "v"(At[m]), "v"(sc_w), "v"(sc_x));     \
        else { _Pragma("unroll") for (int k = 0; k < 2; ++k) { const v4i_t bh_ = PG8_HALF(Bt[n], k), ah_ = PG8_HALF(At[m], k); \
                acc[ai][bj][m][n] = __builtin_amdgcn_mfma_f32_16x16x32_bf16(__builtin_bit_cast(bf16x8, bh_), __builtin_bit_cast(bf16x8, ah_), acc[ai][bj][m][n], 0, 0, 0); } } } \
        __builtin_amdgcn_s_setprio(0); } while (0)
#define PG8_WAIT_V(n) asm volatile("s_waitcnt vmcnt(" #n ")" ::: "memory")
#define PG8_WAIT_L(n) asm volatile("s_waitcnt lgkmcnt(" #n ")" ::: "memory")
#define PG8_BAR __builtin_amdgcn_s_barrier()
#define PG8_SCHED __builtin_amdgcn_sched_barrier(0)
    Unit cur, nxt; int ui = 0;
    if (!S.next(0, cur)) return;
    f32x4 acc[2][2][4][2];
#pragma unroll
    for (int a = 0; a < 2; ++a)
#pragma unroll
        for (int b = 0; b < 2; ++b)
#pragma unroll
            for (int m = 0; m < 4; ++m)
#pragma unroll
                for (int n = 0; n < 2; ++n) acc[a][b][m][n] = (f32x4){0.f, 0.f, 0.f, 0.f};
    v8i_t At[4], B0[2], B1[2];
    const int sc_w = 121, sc_x = 127;
    const GAS char* cA = (const GAS char*)g.A + (size_t)cur.pm * tstepA + (size_t)cur.pn * g.acol * 2; const GAS char* cB = (const GAS char*)g.Bt + (size_t)cur.pn * tstepB;
    PG8_STAGE(PG8_SB(0, 0), cB, voffB); PG8_STAGE(PG8_SB(0, 1), cB + hstepB, voffB); PG8_STAGE(PG8_SA(0, 0), cA, voffA); PG8_STAGE(PG8_SA(0, 1), cA + hstepA, voffA);
    if (wr == 1) PG8_BAR;
    PG8_WAIT_V(2); PG8_BAR;
    PG8_STAGE(PG8_SB(1, 0), cB + kstep, voffB); PG8_STAGE(PG8_SA(1, 0), cA + kstep, voffA); PG8_STAGE(PG8_SB(1, 1), cB + hstepB + kstep, voffB);
    PG8_WAIT_V(6); PG8_BAR;
    for (;;) {
        const bool has_next = S.next(ui + 1, nxt);
        const GAS char* nA = has_next ? (const GAS char*)g.A + (size_t)nxt.pm * tstepA + (size_t)nxt.pn * g.acol * 2 : cA; const GAS char* nB = has_next ? (const GAS char*)g.Bt + (size_t)nxt.pn * tstepB : cB;
        for (int t = 0; t < nt; t += 2) {
            const bool last = (t == nt - 2);
            const GAS char* a1 = cA + (size_t)(t + 1) * kstep;
            const GAS char* a2 = last ? nA : cA + (size_t)(t + 2) * kstep; const GAS char* b2 = last ? nB : cB + (size_t)(t + 2) * kstep;
            const GAS char* a3 = a2 + kstep; const GAS char* b3 = b2 + kstep;
            PG8_LDB(B0, 0, 0); PG8_LDB(B1, 0, 1); PG8_SCHED; PG8_LDA(At, 0, 0); PG8_STAGE(PG8_SA(1, 1), a1 + hstepA, voffA);
            PG8_WAIT_V(8); PG8_WAIT_L(0); PG8_BAR; PG8_MMA(0, 0, At, B0); PG8_MMA(0, 1, At, B1); PG8_BAR; PG8_SCHED;
            PG8_LDA(At, 0, 1); PG8_STAGE(PG8_SB(0, 0), b2, voffB); PG8_STAGE(PG8_SB(0, 1), b2 + hstepB, voffB); PG8_STAGE(PG8_SA(0, 0), a2, voffA);
            PG8_WAIT_V(8); PG8_WAIT_L(0); PG8_BAR; PG8_MMA(1, 0, At, B0); PG8_MMA(1, 1, At, B1); PG8_BAR; PG8_SCHED;
            PG8_LDB(B0, 1, 0); PG8_LDB(B1, 1, 1); PG8_SCHED; PG8_LDA(At, 1, 0); PG8_STAGE(PG8_SA(0, 1), a2 + hstepA, voffA);
            PG8_WAIT_V(8); PG8_WAIT_L(0); PG8_BAR; PG8_MMA(0, 0, At, B0); PG8_MMA(0, 1, At, B1); PG8_BAR; PG8_SCHED;
            PG8_LDA(At, 1, 1); PG8_STAGE(PG8_SB(1, 0), b3, voffB); PG8_STAGE(PG8_SB(1, 1), b3 + hstepB, voffB); PG8_STAGE(PG8_SA(1, 0), a3, voffA);
            PG8_WAIT_V(8); PG8_WAIT_L(0); PG8_BAR; PG8_MMA(1, 0, At, B0); PG8_MMA(1, 1, At, B1); PG8_BAR; PG8_SCHED;
        }
        if (wr == 0) PG8_BAR;
        { int ln_; asm volatile("v_mbcnt_lo_u32_b32 %0, -1, 0\n\tv_mbcnt_hi_u32_b32 %0, -1, %0" : "=v"(ln_));
          E(acc, cur, wr, wc, ln_ & 15, ln_ >> 4); }
        if (!has_next) break;
#pragma unroll
        for (int a = 0; a < 2; ++a)
#pragma unroll
            for (int b = 0; b < 2; ++b)
#pragma unroll
                for (int m = 0; m < 4; ++m)
#pragma unroll
                    for (int n = 0; n < 2; ++n) acc[a][b][m][n] = (f32x4){0.f, 0.f, 0.f, 0.f};
        cur = nxt; cA = nA; cB = nB; ++ui;
        if (wr == 1) PG8_BAR;
    }
    PG8_WAIT_V(0);
    PG8_BAR;
#undef PG8_SA
#undef PG8_SB
#undef PG8_STAGE
#undef PG8_LDA
#undef PG8_LDB
#undef PG8_LD2
#undef PG8_HALF
#undef PG8_MMA
#undef PG8_WAIT_V
#undef PG8_WAIT_L
#undef PG8_BAR
#undef PG8_SCHED
}
}

enum { EM_IN0 = 0, EM_MKV = 1, EM_GATE = 2, EM_RES = 3, EM_PQ = 4, EM_L1 = 5 };
struct Epi {
    int mode;
    GAS unsigned char* ws;
    const GAS float* resid;
    GAS float* outf;
    GAS bf16_t* o16;
    GAS float* ssq;
    const GAS float* gate_b;
    typedef pg8::Unit Unit;
    __device__ __forceinline__ static void st8(GAS bf16_t* p, f32x4 v0, f32x4 v1) {
        u32x4 w; w.x = cvtpk(v0[0], v0[1]); w.y = cvtpk(v0[2], v0[3]); w.z = cvtpk(v1[0], v1[1]); w.w = cvtpk(v1[2], v1[3]); *(GAS u32x4*)p = w; }
    __device__ __forceinline__ static float sq8(f32x4 a, f32x4 b) { return (a[0] * a[0] + a[1] * a[1]) + (a[2] * a[2] + a[3] * a[3]) + (b[0] * b[0] + b[1] * b[1]) + (b[2] * b[2] + b[3] * b[3]); }
    __device__ __forceinline__ void operator()(f32x4 (&acc)[2][2][4][2], const Unit& u, int wr, int wc, int fr, int fq) const {
        const int row0 = u.pm * 256 + wr * 64 + fr;
        const int cin = wc * 32 + 8 * fq;
        if (mode == EM_IN0) {
            GAS bf16_t* base; int ld, colt; int kind;
            if (u.pn < 6) { base = (GAS bf16_t*)(ws + O_ZX); ld = LRU; colt = u.pn * 256; kind = 0; }
            else if (u.pn < 12) { base = (GAS bf16_t*)(ws + O_GY); ld = LRU; colt = (u.pn - 6) * 256; kind = 1; }
            else { base = (GAS bf16_t*)(ws + O_ZL1); ld = NL1; colt = 4608 + (u.pn - 12) * 256; kind = 2; }
            GAS float* qmss = (GAS float*)(ws + O_SSL1);
#pragma unroll
            for (int ai = 0; ai < 2; ++ai)
#pragma unroll
                for (int m = 0; m < 4; ++m) { const int row = row0 + ai * 128 + m * 16;
#pragma unroll
                    for (int bj = 0; bj < 2; ++bj) { f32x4 v0 = acc[ai][bj][m][0], v1 = acc[ai][bj][m][1];
                        if (kind == 1) {
#pragma unroll
                            for (int j = 0; j < 4; ++j) { v0[j] = gelu_tanh(v0[j]); v1[j] = gelu_tanh(v1[j]); } }
                        st8(base + (size_t)row * ld + colt + bj * 128 + cin, v0, v1);
                        if (kind == 2) { float s = sq8(v0, v1); s = xsum16(s); s = xsum32(s);
                            if (fq == 0) qmss[(size_t)row * 112 + (24 + (u.pn - 12) * 2 + bj) * 4 + wc] = s; } } }
        } else if (mode == EM_MKV) {
#pragma unroll
            for (int ai = 0; ai < 2; ++ai)
#pragma unroll
                for (int m = 0; m < 4; ++m) { const int row = row0 + ai * 128 + m * 16;
#pragma unroll
                    for (int bj = 0; bj < 2; ++bj) { const f32x4 v0 = acc[ai][bj][m][0], v1 = acc[ai][bj][m][1];
                        st8(o16 + (size_t)row * NL1 + u.pn * 256 + bj * 128 + cin, v0, v1);
                        if (u.pn < 2) { float s = sq8(v0, v1); s = xsum16(s); s = xsum32(s);
                            if (fq == 0) ssq[(size_t)row * 112 + (u.pn * 2 + bj) * 4 + wc] = s; } } }
        } else if (mode == EM_GATE) {
            const int ch = u.pn * 128 + cin;
            const GAS bf16_t* xc = (const GAS bf16_t*)(ws + O_XC); GAS _Float16* LA = (GAS _Float16*)(ws + O_AA); GAS _Float16* UH = (GAS _Float16*)(ws + O_UU);
            const GAS float* spl = (const GAS float*)(ws + O_SPL) + ch; const GAS float* gb = gate_b + u.pn * 256 + cin;
#pragma unroll
            for (int n = 0; n < 2; ++n) {
                const f32x4 sp = *(const GAS f32x4*)(spl + 4 * n), br = *(const GAS f32x4*)(gb + 4 * n), bi = *(const GAS f32x4*)(gb + 128 + 4 * n);
#pragma unroll
                for (int ai = 0; ai < 2; ++ai)
#pragma unroll
                    for (int m = 0; m < 4; ++m) { const int row = row0 + ai * 128 + m * 16;
                        const u32x2 xw = *(const GAS u32x2*)(xc + (size_t)row * LRU + ch + 4 * n);
                        const f32x4 xv = {bf_lo(xw.x), bf_hi(xw.x), bf_lo(xw.y), bf_hi(xw.y)};
                        float lav[4], uvv[4];
#pragma unroll
                        for (int j = 0; j < 4; ++j) { const float r = sigmoidf_(acc[ai][0][m][n][j] + br[j]), ig = sigmoidf_(acc[ai][1][m][n][j] + bi[j]);
                            const float la = -8.f * r * sp[j];
                            lav[j] = la; uvv[j] = __builtin_amdgcn_sqrtf(one_minus_exp(2.f * la)) * (ig * xv[j]); }
                        { const h2 l0 = {(_Float16)lav[0], (_Float16)lav[1]}, l1 = {(_Float16)lav[2], (_Float16)lav[3]}, u0 = {(_Float16)uvv[0], (_Float16)uvv[1]}, u1 = {(_Float16)uvv[2], (_Float16)uvv[3]};
                          *(GAS u32x2*)(LA + (size_t)row * LRU + ch + 4 * n) = (u32x2){__builtin_bit_cast(unsigned, l0), __builtin_bit_cast(unsigned, l1)};
                          *(GAS u32x2*)(UH + (size_t)row * LRU + ch + 4 * n) = (u32x2){__builtin_bit_cast(unsigned, u0), __builtin_bit_cast(unsigned, u1)}; } }
            }
        } else if (mode == EM_RES) {
            GAS bf16_t* xs = (GAS bf16_t*)(ws + O_XS16); GAS float* rowss = (GAS float*)(ws + O_ROWSS); GAS unsigned char* x4p = ws + O_X4; GAS float* sxa = (GAS float*)(ws + O_SX);
#pragma unroll
            for (int ai = 0; ai < 2; ++ai)
#pragma unroll
                for (int m = 0; m < 4; ++m) { const int row = row0 + ai * 128 + m * 16; float s = 0.f;
#pragma unroll
                    for (int bj = 0; bj < 2; ++bj) { const size_t off = (size_t)row * DM + u.pn * 256 + bj * 128 + cin;
                        f32x4 r0, r1;
                        if (resid) { r0 = *(const GAS f32x4*)(resid + off); r1 = *(const GAS f32x4*)(resid + off + 4); }
                        else { const u32x4 w = *(const GAS u32x4*)(xs + off); r0 = (f32x4){bf_lo(w.x), bf_hi(w.x), bf_lo(w.y), bf_hi(w.y)}; r1 = (f32x4){bf_lo(w.z), bf_hi(w.z), bf_lo(w.w), bf_hi(w.w)}; }
                        const f32x4 v0 = acc[ai][bj][m][0] + r0, v1 = acc[ai][bj][m][1] + r1;
                        st8(xs + off, v0, v1); s += sq8(v0, v1);
                        float am = fmaxf(fmaxf(fmaxf(fabsf(v0[0]), fabsf(v0[1])), fmaxf(fabsf(v0[2]), fabsf(v0[3]))), fmaxf(fmaxf(fabsf(v1[0]), fabsf(v1[1])), fmaxf(fabsf(v1[2]), fabsf(v1[3]))));
                        am = xmax16(am); am = xmax32(am);
                        const float sc = fmaxf(am, 1e-20f) * (1.f / 119.f), qs = __builtin_amdgcn_rcpf(sc);
                        unsigned hw = 0u, lw = 0u;
#pragma unroll
                        for (int k = 0; k < 8; ++k) { const int b = __float_as_int(fmaf(k < 4 ? v0[k & 3] : v1[k & 3], qs, 12582912.f));
                            lw |= (unsigned)(b & 15) << (4 * k); hw |= (unsigned)(((b + 8) >> 4) & 15) << (4 * k); }
                        *(GAS u32x2*)(x4p + ((size_t)row * 64 + u.pn * 8 + bj * 4 + wc) * 32 + fq * 8) = (u32x2){hw, lw};
                        if (fq == 0) sxa[(size_t)(u.pn * 8 + bj * 4 + wc) * T + row] = sc; }
                    s = xsum16(s); s = xsum32(s);
                    if (fq == 0) rowss[(size_t)row * 32 + u.pn * 4 + wc] = s; }
        } else if (mode == EM_PQ) {
            const GAS float* rowss = (const GAS float*)(ws + O_ROWSS);
#pragma unroll
            for (int ai = 0; ai < 2; ++ai)
#pragma unroll
                for (int m = 0; m < 4; ++m) { const int row = row0 + ai * 128 + m * 16;
                    const f32x4 p0 = *(const GAS f32x4*)(rowss + (size_t)row * 32 + fq * 8), p1 = *(const GAS f32x4*)(rowss + (size_t)row * 32 + fq * 8 + 4);
                    float s = (p0[0] + p0[1]) + (p0[2] + p0[3]) + (p1[0] + p1[1]) + (p1[2] + p1[3]); s = xsum16(s); s = xsum32(s);
                    const float r = rsqrtf(s * (1.f / DM) + EPS);
#pragma unroll
                    for (int bj = 0; bj < 2; ++bj) st8(o16 + (size_t)row * DM + u.pn * 256 + bj * 128 + cin, acc[ai][bj][m][0] * r, acc[ai][bj][m][1] * r); }
        } else {
            const GAS float* rsp = (const GAS float*)(ws + O_RSP); GAS bf16_t* zl1 = (GAS bf16_t*)(ws + O_ZL1); GAS float* ssl1 = (GAS float*)(ws + O_SSL1);
            const int slot0 = u.pn < 6 ? u.pn * 2 : (u.pn >= 12 ? 12 + (u.pn - 12) * 2 : -1);
#pragma unroll
            for (int ai = 0; ai < 2; ++ai)
#pragma unroll
                for (int m = 0; m < 4; ++m) { const int row = row0 + ai * 128 + m * 16;
                    const f32x4 q0 = *(const GAS f32x4*)(rsp + (size_t)row * 8), q1 = *(const GAS f32x4*)(rsp + (size_t)row * 8 + 4);
                    const float r = rsqrtf(((q0[0] + q0[1]) + (q0[2] + q0[3]) + (q1[0] + q1[1]) + (q1[2] + q1[3])) * (1.f / DM) + EPS);
#pragma unroll
                    for (int bj = 0; bj < 2; ++bj) { const f32x4 v0 = acc[ai][bj][m][0] * r, v1 = acc[ai][bj][m][1] * r;
                        st8(zl1 + (size_t)row * NL1 + u.pn * 256 + bj * 128 + cin, v0, v1);
                        if (slot0 >= 0) { float s = sq8(v0, v1); s = xsum16(s); s = xsum32(s);
                            if (fq == 0) ssl1[(size_t)row * 112 + (slot0 + bj) * 4 + wc] = s; } } }
        }
    }
};

namespace att {
constexpr float SCALE = 0.08838834764831845f;
constexpr int NW = 8, QBLK = 32, KVBLK = 64, QB = NW * QBLK, D = 128;
constexpr int SHM_V = KVBLK * D * 2, SHM_K = KVBLK * D * 2;
constexpr int OFF_WS = 2 * SHM_V + 2 * SHM_K;
constexpr int OFF_KS = OFF_WS + 2048;
constexpr int OFF_BS = OFF_KS + 16384;
constexpr int LDS_END = OFF_BS + 16384;
constexpr int WBIG = 1 << 28;

#define KSWZ(row, colB) ((row) * 256 + ((colB) ^ (((row) & 7) << 4)))
#define SBAR() __builtin_amdgcn_sched_barrier(0)
__device__ __forceinline__ int v_st(int k, int c) { const int kk = (k & ~0xC) | ((k & 4) << 1) | ((k & 8) >> 1); return ((kk >> 3) * 4 + (c >> 5)) * 512 + ((kk & 7) * 32 + (c & 31)) * 2; }
__device__ __forceinline__ int v_rd_base(int lane) { return ((lane & 3) << 3) | (((lane >> 2) & 3) << 6) | (((lane >> 4) & 1) << 5) | (((lane >> 5) & 1) << 8); }
constexpr int v_rd_off(int d0, int ks, int half) { return d0 * 512 + ks * 4096 + half * 2048; }
__device__ __forceinline__ int crow(int r, int hi) { return (r & 3) + 8 * (r >> 2) + 4 * hi; }
__device__ __forceinline__ bf16x8 load8(const GAS bf16_t* p) { return *(const GAS bf16x8*)p; }
__device__ __forceinline__ bf16x8 scale8(bf16x8 v, float s) { const u32x4 w = *reinterpret_cast<u32x4*>(&v); u32x4 o;
    o.x = cvtpk(bf_lo(w.x) * s, bf_hi(w.x) * s); o.y = cvtpk(bf_lo(w.y) * s, bf_hi(w.y) * s); o.z = cvtpk(bf_lo(w.z) * s, bf_hi(w.z) * s); o.w = cvtpk(bf_lo(w.w) * s, bf_hi(w.w) * s);
    return *reinterpret_cast<bf16x8*>(&o); }
__device__ __forceinline__ void mask_tile(f32x16& p0, f32x16& p1, int dq, unsigned W) {
    const float NEG = -__builtin_inff();
#pragma unroll
    for (int r = 0; r < 16; ++r) {
        const int c = (r & 3) + 8 * (r >> 2);
        if ((unsigned)(dq - c) >= W) p0[r] = NEG;
        if ((unsigned)(dq - c - 32) >= W) p1[r] = NEG;
    }
}
constexpr float THR = 8.f;
__device__ __forceinline__ void partialSM(f32x16& p0, f32x16& p1, float& m_reg, float& mn, float& alpha) {
    float pmax = p0[0]; for (int r = 1; r < 16; ++r) pmax = fmaxf(pmax, p0[r]); for (int r = 0; r < 16; ++r) pmax = fmaxf(pmax, p1[r]);
    { auto rr = __builtin_amdgcn_permlane32_swap(__float_as_uint(pmax), __float_as_uint(pmax), false, false);
      pmax = fmaxf(__uint_as_float(rr[0]), __uint_as_float(rr[1])); }
    constexpr float C2 = 1.4426950408889634f * SCALE;
    if (__builtin_expect(__all((pmax - m_reg) * SCALE <= THR), 1)) { mn = m_reg; alpha = 1.f; }
    else { mn = fmaxf(m_reg, pmax); alpha = __builtin_amdgcn_exp2f((m_reg - mn) * C2); m_reg = mn; }
    const float mnL = -mn * C2;
    for (int r = 0; r < 16; ++r) p0[r] = fmaf(p0[r], C2, mnL); for (int r = 0; r < 16; ++r) p1[r] = fmaf(p1[r], C2, mnL);
    for (int r = 0; r < 16; ++r) p0[r] = __builtin_amdgcn_exp2f(p0[r]);
}
__device__ __forceinline__ void finishSM(f32x16& p0, f32x16& p1, float alpha, float& l_reg, bf16x8& pa0, bf16x8& pa1, bf16x8& pa2, bf16x8& pa3) {
    for (int r = 0; r < 16; ++r) p1[r] = __builtin_amdgcn_exp2f(p1[r]);
    float ps = 0; for (int r = 0; r < 16; ++r) ps += p0[r]; for (int r = 0; r < 16; ++r) ps += p1[r];
    { auto rr = __builtin_amdgcn_permlane32_swap(__float_as_uint(ps), __float_as_uint(ps), false, false);
      ps = __uint_as_float(rr[0]) + __uint_as_float(rr[1]); }
    l_reg = l_reg * alpha + ps;
#define PK4(P, B_, OUT) do { unsigned a0 = cvtpk(P[B_+0], P[B_+1]), a1 = cvtpk(P[B_+2], P[B_+3]);                          \
        unsigned b0 = cvtpk(P[B_+4], P[B_+5]), b1 = cvtpk(P[B_+6], P[B_+7]);                                             \
        auto r0 = __builtin_amdgcn_permlane32_swap(a0, b0, false, false); auto r1 = __builtin_amdgcn_permlane32_swap(a1, b1, false, false); \
        u32x4 w = {r0[0], r1[0], r0[1], r1[1]}; OUT = *reinterpret_cast<bf16x8*>(&w); } while (0)
    PK4(p0, 0, pa0); PK4(p0, 8, pa1); PK4(p1, 0, pa2); PK4(p1, 8, pa3);
#undef PK4
}
template <int KB>
__device__ __forceinline__ void qkt(f32x16& p0, f32x16& p1, const char* K_lds, int r32, int hi, const bf16x8* qr, const float* bp  ) {
    { const f32x4 a = *(const f32x4*)(bp), b = *(const f32x4*)(bp + 8), c = *(const f32x4*)(bp + 16), d = *(const f32x4*)(bp + 24);
      p0 = (f32x16){a[0], a[1], a[2], a[3], b[0], b[1], b[2], b[3], c[0], c[1], c[2], c[3], d[0], d[1], d[2], d[3]}; }
    { const f32x4 a = *(const f32x4*)(bp + 32), b = *(const f32x4*)(bp + 40), c = *(const f32x4*)(bp + 48), d = *(const f32x4*)(bp + 56);
      p1 = (f32x16){a[0], a[1], a[2], a[3], b[0], b[1], b[2], b[3], c[0], c[1], c[2], c[3], d[0], d[1], d[2], d[3]}; }
    const char* kb[4];
#pragma unroll
    for (int dd = 0; dd < 4; ++dd) kb[dd] = K_lds + KB * SHM_K + KSWZ(r32, (dd * 16 + hi * 8) * 2);
#pragma unroll
    for (int d0 = 0; d0 < 8; ++d0) { const char* a = kb[d0 & 3] + (d0 >> 2) * 128;
        bf16x8 b0 = *reinterpret_cast<const bf16x8*>(a);
        bf16x8 b1 = *reinterpret_cast<const bf16x8*>(a + 32 * 256);
        p0 = __builtin_amdgcn_mfma_f32_32x32x16_bf16(b0, qr[d0], p0, 0, 0, 0);
        p1 = __builtin_amdgcn_mfma_f32_32x32x16_bf16(b1, qr[d0], p1, 0, 0, 0); }
}
template <int KB>
__device__ __forceinline__ void qkt0(f32x16& p0, f32x16& p1, const char* K_lds, int r32, int hi, const bf16x8* qr) {
    p0 = f32x16{}; p1 = f32x16{};
    const char* kb[4];
#pragma unroll
    for (int dd = 0; dd < 4; ++dd) kb[dd] = K_lds + KB * SHM_K + KSWZ(r32, (dd * 16 + hi * 8) * 2);
#pragma unroll
    for (int d0 = 0; d0 < 8; ++d0) { const char* a = kb[d0 & 3] + (d0 >> 2) * 128;
        bf16x8 b0 = *reinterpret_cast<const bf16x8*>(a);
        bf16x8 b1 = *reinterpret_cast<const bf16x8*>(a + 32 * 256);
        p0 = __builtin_amdgcn_mfma_f32_32x32x16_bf16(b0, qr[d0], p0, 0, 0, 0);
        p1 = __builtin_amdgcn_mfma_f32_32x32x16_bf16(b1, qr[d0], p1, 0, 0, 0); }
}
template <int VB>
__device__ __forceinline__ void pv_tile(f32x16* o, int vb0, bf16x8 pa0, bf16x8 pa1, bf16x8 pa2, bf16x8 pa3) {
#define TRRD(dst, off) asm volatile("ds_read_b64_tr_b16 %0, %1 offset:%2" : "=&v"(dst) : "v"(vb0), "i"(off) : "memory")
#define PV_D0(d0) do { s16x4 l0, l1, l2, l3, h0, h1, h2_, h3; constexpr int b_ = VB * SHM_V + v_rd_off(d0, 0, 0); \
        TRRD(l0, b_); TRRD(h0, b_ + 2048); TRRD(l1, b_ + 4096); TRRD(h1, b_ + 6144); TRRD(l2, b_ + 8192); TRRD(h2_, b_ + 10240); TRRD(l3, b_ + 12288); TRRD(h3, b_ + 14336); \
        asm volatile("s_waitcnt lgkmcnt(0)" ::: "memory"); SBAR();   \
        o[d0] = __builtin_amdgcn_mfma_f32_32x32x16_bf16(pa0, (bf16x8){l0[0], l0[1], l0[2], l0[3], h0[0], h0[1], h0[2], h0[3]}, o[d0], 0, 0, 0);   \
        o[d0] = __builtin_amdgcn_mfma_f32_32x32x16_bf16(pa1, (bf16x8){l1[0], l1[1], l1[2], l1[3], h1[0], h1[1], h1[2], h1[3]}, o[d0], 0, 0, 0);   \
        o[d0] = __builtin_amdgcn_mfma_f32_32x32x16_bf16(pa2, (bf16x8){l2[0], l2[1], l2[2], l2[3], h2_[0], h2_[1], h2_[2], h2_[3]}, o[d0], 0, 0, 0);   \
        o[d0] = __builtin_amdgcn_mfma_f32_32x32x16_bf16(pa3, (bf16x8){l3[0], l3[1], l3[2], l3[3], h3[0], h3[1], h3[2], h3[3]}, o[d0], 0, 0, 0); } while (0)
    PV_D0(0); PV_D0(1); PV_D0(2); PV_D0(3);
#undef PV_D0
#undef TRRD
}

struct BlockRef { const GAS bf16_t* Q; const GAS bf16_t* K; const GAS bf16_t* V; GAS bf16_t* O; const GAS float* qss; const GAS float* kss; const GAS float* cc; const GAS float* gg;
                  int P0, skv; };
constexpr int LDQ = 5120, LDK = 5120, LDO = 2048, LDSS = 112;
struct Seam { bf16x8 qr[8]; bf16x8 st_v0, st_v1, st_k0, st_k1; int jlo; };
#define ROWK(p, k0, rr) ((p) + (size_t)((k0) + (rr)) * LDK + sc)
#define VMW() asm volatile("s_waitcnt vmcnt(0)" ::: "memory")
#define VMWN(n) asm volatile("s_waitcnt vmcnt(%0)" :: "i"(n) : "memory")
#define SLOAD_H(Kp, Vp, k0) do { S.st_v0 = load8(ROWK(Vp, k0, sr)); S.st_v1 = load8(ROWK(Vp, k0, 32 + sr));              \
                         S.st_k0 = load8(ROWK(Kp, k0, sr)); S.st_k1 = load8(ROWK(Kp, k0, 32 + sr)); } while (0)
#define SWRITE_HK(bf, k0) do { *(bf16x8*)(K_lds + (bf) * SHM_K + kws) = scale8(S.st_k0, ksr[(k0)]); *(bf16x8*)(K_lds + (bf) * SHM_K + kws + 32 * 256) = scale8(S.st_k1, ksr[(k0) + 32]); } while (0)
#define SWRITE_HV(bf) do { *(bf16x8*)(V_lds + (bf) * SHM_V + vst0) = S.st_v0; *(bf16x8*)(V_lds + (bf) * SHM_V + vst1) = S.st_v1; } while (0)
#define SWRITE_H(bf, k0) do { SWRITE_HV(bf); SWRITE_HK(bf, k0); } while (0)

__device__ __forceinline__ void attn_prime(const BlockRef& cur, char* lds, Seam& S, const int tid) {
    const int wid = __builtin_amdgcn_readfirstlane(tid >> 6), lane = tid & 63, r32 = lane & 31, hi = lane >> 5;
    const int sr = tid >> 4, sc = (tid & 15) * 8, kws = KSWZ(sr, sc * 2); char* K_lds = lds + 2 * SHM_V;
    float* ks_l = (float*)(lds + OFF_KS); float* bs_l = (float*)(lds + OFF_BS); const float* ksr = ks_l + sr;
    int j_hi = (cur.P0 + QB - 1) / KVBLK + 1; if (j_hi > cur.skv / KVBLK) j_hi = cur.skv / KVBLK;
    const int nkeys = j_hi * KVBLK;
    const float c0 = cur.cc ? cur.cc[cur.P0] : 0.f;
    int jlo = 0;
    if (cur.cc) { const float thr = cur.gg[128]; const int jd = cur.P0 / KVBLK;
        const float cv = lane <= jd ? cur.cc[lane * KVBLK + KVBLK - 1] : 0.f;
        const bool keep = lane > jd || (c0 - cv > -thr);
        jlo = __ffsll((long long)__ballot(keep)) - 1; }
    S.jlo = jlo;
    for (int s = jlo * KVBLK + tid; s < nkeys; s += NTHREADS) {
        const f32x4 p = *(const GAS f32x4*)(cur.kss + (size_t)s * LDSS);
        ks_l[s] = rsqrtf(((p[0] + p[1]) + (p[2] + p[3])) * (1.f / 128.f) + EPS);
        bs_l[s] = cur.cc ? (c0 - cur.cc[s]) * (1.f / SCALE) : 0.f;
    }
    __syncthreads();
    const int qrow = wid * QBLK + r32;
    const f32x4 qp = *(const GAS f32x4*)(cur.qss + (size_t)qrow * LDSS);
    const float rq = rsqrtf(((qp[0] + qp[1]) + (qp[2] + qp[3])) * (1.f / 128.f) + EPS);
#pragma unroll
    for (int d0 = 0; d0 < 8; ++d0) {
        const u32x4 w = *(const GAS u32x4*)(cur.Q + (size_t)qrow * LDQ + d0 * 16 + hi * 8);
        const f32x4 g0 = *(const GAS f32x4*)(cur.gg + d0 * 16 + hi * 8), g1 = *(const GAS f32x4*)(cur.gg + d0 * 16 + hi * 8 + 4);
        u32x4 o; o.x = cvtpk(bf_lo(w.x) * rq * g0[0], bf_hi(w.x) * rq * g0[1]); o.y = cvtpk(bf_lo(w.y) * rq * g0[2], bf_hi(w.y) * rq * g0[3]);
        o.z = cvtpk(bf_lo(w.z) * rq * g1[0], bf_hi(w.z) * rq * g1[1]); o.w = cvtpk(bf_lo(w.w) * rq * g1[2], bf_hi(w.w) * rq * g1[3]);
        S.qr[d0] = *reinterpret_cast<bf16x8*>(&o);
    }
    SLOAD_H(cur.K, cur.V, jlo * KVBLK); VMW(); SWRITE_HK(0, jlo * KVBLK);
    __syncthreads();
}
__device__ __forceinline__ void attn_block(const BlockRef& cur, char* lds, Seam& S, const int tid) {
    const int wid = __builtin_amdgcn_readfirstlane(tid >> 6), lane = tid & 63, r32 = lane & 31, hi = lane >> 5;
    const int W = WBIG;
    int j_hi = (cur.P0 + QB - 1) / KVBLK + 1; if (j_hi > cur.skv / KVBLK) j_hi = cur.skv / KVBLK;
    const int j_lo = S.jlo; const int NT = j_hi - j_lo;
    const int qlo = cur.P0 - j_lo * KVBLK + wid * QBLK, qm = qlo + r32 - 4 * hi;
    char* V_lds = lds; char* K_lds = lds + 2 * SHM_V;
    float* ws = (float*)(lds + OFF_WS) + wid * 64; float* li_l = ws, * al_l = ws + 32;
    const float* bs_l = (const float*)(lds + OFF_BS) + j_lo * KVBLK + 4 * hi;
    float m_reg = -1e30f, l_reg = 0; f32x16 o[4] = {};
    const int sr = tid >> 4, sc = (tid & 15) * 8, vst0 = v_st(sr, sc), vst1 = v_st(32 + sr, sc), kws = KSWZ(sr, sc * 2);
    const float* ksr = (const float*)(lds + OFF_KS) + j_lo * KVBLK + sr;
    const int vb0 = (int)(uintptr_t)V_lds + v_rd_base(lane);
    const GAS bf16_t* Kh = cur.K + (size_t)j_lo * KVBLK * LDK; const GAS bf16_t* Vh = cur.V + (size_t)j_lo * KVBLK * LDK;
#define RESC(a) do { if (__any((a) < 1.f)) { if (hi == 0) al_l[r32] = (a); asm volatile("s_waitcnt lgkmcnt(0)" ::: "memory");              \
                     for (int d_ = 0; d_ < 4; ++d_) for (int r = 0; r < 16; ++r) o[d_][r] *= al_l[crow(r, hi)]; } } while (0)
#define KBASE(t) ((t) * KVBLK)
#define MASKT(P0_, P1_, t) do { const int kb_ = KBASE(t); if (kb_ + KVBLK - 1 > qlo) mask_tile(P0_, P1_, qm - kb_, (unsigned)W); } while (0)
    f32x16 pA0, pA1, pB0, pB1; float mnA, mnB, alA, alB; bf16x8 pa0, pa1, pa2, pa3;
    SWRITE_HV(0); SBAR();
    if (NT > 1) { SLOAD_H(Kh, Vh, KBASE(1)); }
    SBAR(); qkt<0>(pA0, pA1, K_lds, r32, hi, S.qr, bs_l + KBASE(0));
    MASKT(pA0, pA1, 0); partialSM(pA0, pA1, m_reg, mnA, alA);
    if (NT > 1) { VMW(); SWRITE_H(1, KBASE(1)); }
    __syncthreads();
#define HALF_STEP(PX0, PX1, mnX, alX, PY0, PY1, alY, t, KB, VB, SB) do {                                                      \
        SBAR(); qkt<KB>(PX0, PX1, K_lds, r32, hi, S.qr, bs_l + KBASE(t));                                                         \
        finishSM(PY0, PY1, alY, l_reg, pa0, pa1, pa2, pa3); SBAR();                                                           \
        if ((t) + 1 < NT) { SLOAD_H(Kh, Vh, KBASE((t) + 1)); SBAR(); }                                               \
        pv_tile<VB>(o, vb0, pa0, pa1, pa2, pa3); MASKT(PX0, PX1, (t)); partialSM(PX0, PX1, m_reg, mnX, alX);                                        \
        __syncthreads();                                                                                                      \
        if ((t) + 1 < NT) { VMW(); SWRITE_H(SB, KBASE((t) + 1)); }                                                                          \
        RESC(alX); __syncthreads(); } while (0)
    for (int t = 1; t + 1 < NT; t += 2) {
        HALF_STEP(pB0, pB1, mnB, alB, pA0, pA1, alA, t, 1, 0, 0);
        HALF_STEP(pA0, pA1, mnA, alA, pB0, pB1, alB, t + 1, 0, 1, 1);
    }
    const bool even = (NT & 1) == 0;
    if (even) { SBAR(); qkt<1>(pB0, pB1, K_lds, r32, hi, S.qr, bs_l + KBASE(NT - 1)); SBAR(); }
    finishSM(pA0, pA1, alA, l_reg, pa0, pa1, pa2, pa3); SBAR();
    pv_tile<0>(o, vb0, pa0, pa1, pa2, pa3);
    if (even) { MASKT(pB0, pB1, NT - 1); partialSM(pB0, pB1, m_reg, mnB, alB); __syncthreads(); RESC(alB);
        finishSM(pB0, pB1, alB, l_reg, pa0, pa1, pa2, pa3); SBAR(); pv_tile<1>(o, vb0, pa0, pa1, pa2, pa3); }
    SBAR();
    if (hi == 0) li_l[r32] = l_reg; asm volatile("s_waitcnt lgkmcnt(0)" ::: "memory");
    float rli[16];
#pragma unroll
    for (int r = 0; r < 16; ++r) rli[r] = __builtin_amdgcn_rcpf(li_l[crow(r, hi)]);
    GAS bf16_t* Ow = cur.O + (size_t)(wid * QBLK) * LDO;
#pragma unroll
    for (int r = 0; r < 16; ++r) { const int orow = crow(r, hi);
#pragma unroll
        for (int d0 = 0; d0 < 4; ++d0) { const float v = o[d0][r] * rli[r];
            const float vn = dppf<0xB1>(v);
            if ((r32 & 1) == 0) *(GAS unsigned*)(Ow + (size_t)orow * LDO + d0 * 32 + r32) = cvtpk(v, vn); } }
    __syncthreads();
#undef RESC
#undef KBASE
#undef MASKT
#undef HALF_STEP
}
constexpr int MOFF_K = 4 * SHM_V, MOFF_WS = MOFF_K + 4 * SHM_K, MOFF_KS = MOFF_WS + 2048;
__device__ __forceinline__ void mem_attn_unit(const BlockRef& cur, char* lds, const int tid) {
    const int wid = __builtin_amdgcn_readfirstlane(tid >> 6), lane = tid & 63, r32 = lane & 31, hi = lane >> 5;
    const int sr = tid >> 4, sc = (tid & 15) * 8, kws = KSWZ(sr, sc * 2), vst0 = v_st(sr, sc), vst1 = v_st(32 + sr, sc);
    char* V_lds = lds; char* K_lds = lds + MOFF_K; float* ks_l = (float*)(lds + MOFF_KS);
    float* ws = (float*)(lds + MOFF_WS) + wid * 64; float* li_l = ws, * al_l = ws + 32;
    float ksv = 0.f;
    if (tid < 256) { const f32x4 p = *(const GAS f32x4*)(cur.kss + (size_t)tid * LDSS); ksv = rsqrtf(((p[0] + p[1]) + (p[2] + p[3])) * (1.f / 128.f) + EPS); }
    bf16x8 kk[4][2], vv[4][2];
#pragma unroll
    for (int t = 0; t < 4; ++t) { kk[t][0] = load8(ROWK(cur.K, t * KVBLK, sr)); kk[t][1] = load8(ROWK(cur.K, t * KVBLK, 32 + sr)); vv[t][0] = load8(ROWK(cur.V, t * KVBLK, sr)); vv[t][1] = load8(ROWK(cur.V, t * KVBLK, 32 + sr)); }
    const int qrow = wid * QBLK + r32;
    const f32x4 qp = *(const GAS f32x4*)(cur.qss + (size_t)qrow * LDSS);
    u32x4 qw[8];
#pragma unroll
    for (int d0 = 0; d0 < 8; ++d0) qw[d0] = *(const GAS u32x4*)(cur.Q + (size_t)qrow * LDQ + d0 * 16 + hi * 8);
    if (tid < 256) ks_l[tid] = ksv;
    __syncthreads();
#pragma unroll
    for (int t = 0; t < 4; ++t) { *(bf16x8*)(K_lds + t * SHM_K + kws) = scale8(kk[t][0], ks_l[t * KVBLK + sr]); *(bf16x8*)(K_lds + t * SHM_K + kws + 32 * 256) = scale8(kk[t][1], ks_l[t * KVBLK + 32 + sr]);
        *(bf16x8*)(V_lds + t * SHM_V + vst0) = vv[t][0]; *(bf16x8*)(V_lds + t * SHM_V + vst1) = vv[t][1]; }
    const float rq = rsqrtf(((qp[0] + qp[1]) + (qp[2] + qp[3])) * (1.f / 128.f) + EPS);
    bf16x8 qr[8];
#pragma unroll
    for (int d0 = 0; d0 < 8; ++d0) { const u32x4 w = qw[d0];
        const f32x4 g0 = *(const GAS f32x4*)(cur.gg + d0 * 16 + hi * 8), g1 = *(const GAS f32x4*)(cur.gg + d0 * 16 + hi * 8 + 4);
        u32x4 o; o.x = cvtpk(bf_lo(w.x) * rq * g0[0], bf_hi(w.x) * rq * g0[1]); o.y = cvtpk(bf_lo(w.y) * rq * g0[2], bf_hi(w.y) * rq * g0[3]);
        o.z = cvtpk(bf_lo(w.z) * rq * g1[0], bf_hi(w.z) * rq * g1[1]); o.w = cvtpk(bf_lo(w.w) * rq * g1[2], bf_hi(w.w) * rq * g1[3]);
        qr[d0] = *reinterpret_cast<bf16x8*>(&o); }
    __syncthreads();
    const int vb0 = (int)(uintptr_t)V_lds + v_rd_base(lane);
    float m_reg = -1e30f, l_reg = 0; f32x16 o[4] = {};
#define MEM_TILE(t) do { f32x16 p0, p1; float mn, al; bf16x8 pa0, pa1, pa2, pa3; \
        qkt0<t>(p0, p1, K_lds, r32, hi, qr); partialSM(p0, p1, m_reg, mn, al); \
        if (__any(al < 1.f)) { if (hi == 0) al_l[r32] = al; asm volatile("s_waitcnt lgkmcnt(0)" ::: "memory"); for (int d_ = 0; d_ < 4; ++d_) for (int r = 0; r < 16; ++r) o[d_][r] *= al_l[crow(r, hi)]; } \
        finishSM(p0, p1, al, l_reg, pa0, pa1, pa2, pa3); SBAR(); pv_tile<t>(o, vb0, pa0, pa1, pa2, pa3); SBAR(); } while (0)
    MEM_TILE(0); MEM_TILE(1); MEM_TILE(2); MEM_TILE(3);
#undef MEM_TILE
    if (hi == 0) li_l[r32] = l_reg; asm volatile("s_waitcnt lgkmcnt(0)" ::: "memory");
    float rli[16];
#pragma unroll
    for (int r = 0; r < 16; ++r) rli[r] = __builtin_amdgcn_rcpf(li_l[crow(r, hi)]);
    GAS bf16_t* Ow = cur.O + (size_t)(wid * QBLK) * LDO;
#pragma unroll
    for (int r = 0; r < 16; ++r) { const int orow = crow(r, hi);
#pragma unroll
        for (int d0 = 0; d0 < 4; ++d0) { const float v = o[d0][r] * rli[r];
            const float vn = dppf<0xB1>(v);
            if ((r32 & 1) == 0) *(GAS unsigned*)(Ow + (size_t)orow * LDO + d0 * 32 + r32) = cvtpk(v, vn); } }
    __syncthreads();
}
#undef ROWK
#undef VMW
#undef VMWN
#undef SLOAD_H
#undef SWRITE_HK
#undef SWRITE_HV
#undef SWRITE_H
#undef KSWZ
#undef SBAR
}


struct Frame {
    GAS unsigned char* ws; const float* const* in_; GAS float* out;
    __device__ __forceinline__ const GAS float* in(int i) const { return (const GAS float*)in_[i]; }
    int tid, lane, wave, gw, ngw, gtid, ngt;
};
enum { I_X = 0, I_MEM, I_ANORM, I_AWIN, I_ACONVW, I_ACONVB, I_AGATEW, I_AGATEB, I_ALAMBDA, I_AWOUT, I_SNORM, I_SWKVF, I_SBF, I_SKNORM, I_BNORM, I_BWIN, I_BQNORM, I_BWOUT,
       I_MNORM, I_MWKV, I_MQNORM, I_MKNORM, I_PNORM, I_PWQ, I_PSUBK, I_PU, I_PV, N_IN };

struct TrItem { const GAS float* W; const GAS float* gain; GAS bf16_t* WT; int ldw, ldt, row_off, k0, n0; };
__device__ __forceinline__ void tr_load(const TrItem& d, float (&wv)[32], int lane) {
#pragma unroll
    for (int i = 0; i < 32; ++i) wv[i] = __builtin_nontemporal_load(d.W + (size_t)(d.k0 + 2 * i + (lane >> 5)) * d.ldw + d.n0 + (lane & 31));
}
__device__ __forceinline__ void tr_proc(const TrItem& d, float (&wv)[32], LAS float* scr, int lane) {
    if (d.gain) {
#pragma unroll
        for (int i = 0; i < 32; ++i) wv[i] *= d.gain[d.k0 + 2 * i + (lane >> 5)]; }
#pragma unroll
    for (int i = 0; i < 32; ++i) scr[(2 * i + (lane >> 5)) * 33 + (lane & 31)] = wv[i];
    asm volatile("s_waitcnt lgkmcnt(0)" ::: "memory");
    const int c = lane & 7;
#pragma unroll
    for (int j = 0; j < 4; ++j) { const int n = (lane >> 3) + 8 * j; const LAS float* s = scr + (8 * c) * 33 + n;
        u32x4 o; o.x = cvtpk(s[0 * 33], s[1 * 33]); o.y = cvtpk(s[2 * 33], s[3 * 33]); o.z = cvtpk(s[4 * 33], s[5 * 33]); o.w = cvtpk(s[6 * 33], s[7 * 33]);
        *(GAS u32x4*)(d.WT + (size_t)(d.row_off + d.n0 + n) * d.ldt + d.k0 + 8 * c) = o; }
    asm volatile("s_waitcnt lgkmcnt(0)" ::: "memory");
}
__device__ __forceinline__ void transpose_item_fp8(const GAS float* W, int ldw, const GAS float* gain, GAS unsigned char* WT, int ldt, LAS float* scr, int nblk, int item, int lane) {
    const int kb = item / nblk, nb = item % nblk, k0 = 64 * kb, n0 = 32 * nb;
    float wv[32];
#pragma unroll
    for (int i = 0; i < 32; ++i) wv[i] = W[(size_t)(k0 + 2 * i + (lane >> 5)) * ldw + n0 + (lane & 31)];
#pragma unroll
    for (int i = 0; i < 32; ++i) wv[i] *= gain[k0 + 2 * i + (lane >> 5)] * 64.f;
#pragma unroll
    for (int i = 0; i < 32; ++i) scr[(2 * i + (lane >> 5)) * 33 + (lane & 31)] = wv[i];
    asm volatile("s_waitcnt lgkmcnt(0)" ::: "memory");
    const int c = lane & 3;
#pragma unroll
    for (int j = 0; j < 2; ++j) { const int n = (lane >> 2) + 16 * j; const LAS float* sp = scr + (16 * c) * 33 + n; u32x4 o;
#pragma unroll
        for (int w = 0; w < 4; ++w) { int pk = __builtin_amdgcn_cvt_pk_fp8_f32(sp[(4 * w) * 33], sp[(4 * w + 1) * 33], 0, false); pk = __builtin_amdgcn_cvt_pk_fp8_f32(sp[(4 * w + 2) * 33], sp[(4 * w + 3) * 33], pk, true); o[w] = (unsigned)pk; }
        *(GAS u32x4*)(WT + (size_t)(n0 + n) * ldt + k0 + 16 * c) = o; }
    asm volatile("s_waitcnt lgkmcnt(0)" ::: "memory");
}
struct CtRow { f32x4 v[8]; GAS unsigned char* dst; int row, which; };
__device__ __forceinline__ void ct_load(Frame& F, int layer, int it, CtRow& R) {
    R.which = it & 1; R.row = it >> 1;
    const GAS float* src = F.in(R.which ? I_PV : I_PU) + ((size_t)layer * NEXP + R.row) * DM + F.lane * 4;
    R.dst = F.ws + O_TAB + (size_t)(layer * 2 + R.which) * TAB_ONE;
#pragma unroll
    for (int c = 0; c < 8; ++c) R.v[c] = __builtin_nontemporal_load((const GAS f32x4*)(src + c * 256));
}
__device__ __forceinline__ void ct_proc(Frame& F, int layer, CtRow& R) {
    const GAS float* gn = F.in(I_PNORM) + layer * DM + F.lane * 4;
    _Float16 shv = (_Float16)0.f;
#pragma unroll
    for (int c = 0; c < 8; ++c) { f32x4 x = R.v[c]; if (!R.which) x = x * *(const GAS f32x4*)(gn + c * 256);
        float amax = fmaxf(fmaxf(fabsf(x[0]), fabsf(x[1])), fmaxf(fabsf(x[2]), fabsf(x[3])));
        amax = wave_max(amax);
        const _Float16 sh = (_Float16)fmaxf(amax * (R.which ? 1.f / 6.f : 1.f / 7.f), 1e-6f);
        const float qs = __builtin_amdgcn_rcpf((float)sh);
        unsigned pk;
        if (R.which) { pk = __builtin_amdgcn_cvt_scalef32_pk_fp4_f32(0u, x[0] * qs, x[1] * qs, 1.0f, 0); pk = __builtin_amdgcn_cvt_scalef32_pk_fp4_f32(pk, x[2] * qs, x[3] * qs, 1.0f, 1); }
        else { const int q0 = (int)fminf(fmaxf(rintf(x[0] * qs), -7.f), 7.f), q1 = (int)fminf(fmaxf(rintf(x[1] * qs), -7.f), 7.f), q2 = (int)fminf(fmaxf(rintf(x[2] * qs), -7.f), 7.f), q3 = (int)fminf(fmaxf(rintf(x[3] * qs), -7.f), 7.f);
               pk = (unsigned)(q0 & 15) | ((unsigned)(q1 & 15) << 4) | ((unsigned)(q2 & 15) << 8) | ((unsigned)(q3 & 15) << 12); }
        *(GAS unsigned short*)(R.dst + ((size_t)c * NEXP + R.row) * 128 + F.lane * 2) = (unsigned short)pk;
        shv = (F.lane == c) ? sh : shv; }
    if (F.lane < 8) *(GAS unsigned short*)(R.dst + TAB_NIB + ((size_t)R.row * 8 + F.lane) * 2) = __builtin_bit_cast(unsigned short, shv);
}
__device__ __forceinline__ void convert_tables(Frame& F, int layer, int ibeg, int iend, int wk, int nwk) {
    if (ibeg + wk >= iend) return;
    const int ilast = ibeg + wk + ((iend - 1 - ibeg - wk) / nwk) * nwk;
    CtRow A, B;
    ct_load(F, layer, ibeg + wk, A);
    for (int it = ibeg + wk; it < iend; it += 2 * nwk) {
        ct_load(F, layer, it + nwk <= ilast ? it + nwk : ilast, B);
        ct_proc(F, layer, A);
        ct_load(F, layer, it + 2 * nwk <= ilast ? it + 2 * nwk : ilast, A);
        if (it + nwk < iend) ct_proc(F, layer, B);
    }
}
__device__ __forceinline__ void norm_row_bf16(const GAS float* xrow, const GAS float* gain, GAS bf16_t* orow, int lane) {
    f32x4 v[8]; float s = 0.f;
#pragma unroll
    for (int j = 0; j < 8; ++j) { v[j] = *(const GAS f32x4*)(xrow + j * 256 + lane * 4); s += (v[j][0] * v[j][0] + v[j][1] * v[j][1]) + (v[j][2] * v[j][2] + v[j][3] * v[j][3]); }
    const float r = rsqrtf(wave_sum(s) * (1.f / DM) + EPS);
#pragma unroll
    for (int j = 0; j < 8; ++j) { f32x4 g = gain ? *(const GAS f32x4*)(gain + j * 256 + lane * 4) : (f32x4){1.f, 1.f, 1.f, 1.f};
        u32x2 o; o.x = cvtpk(v[j][0] * r * g[0], v[j][1] * r * g[1]); o.y = cvtpk(v[j][2] * r * g[2], v[j][3] * r * g[3]);
        *(GAS u32x2*)(orow + j * 256 + lane * 4) = o; }
}
__device__ __forceinline__ void step_prologue(Frame& F, LAS unsigned char* lds) {
    LAS float* scr = (LAS float*)(lds + F.wave * 16384);
    GAS unsigned char* ws = F.ws;
    constexpr int I0 = 32 * (NIN0 / 32), I1 = 32 * 64, I2 = 32 * 96, I3 = 32 * 64, I4 = 32 * 64, I5 = 32 * 64, I6 = 32 * 64, I7 = 32 * 32, I8 = 32 * 32, I9 = 12 * 16;
    constexpr int NITEMS = I0 + I1 + I2 + I3 + I4 + I5 + I6 + I7 + I8 + I9;
#define TR_DESC(D, it_) do { int r = (it_) < NITEMS ? (it_) : NITEMS - 1; int nblk; \
        if (r < I0) { D = {F.in(I_AWIN), F.in(I_ANORM), (GAS bf16_t*)(ws + O_WIN0), NIN0, DM, 0, 0, 0}; nblk = NIN0 / 32; } else { r -= I0; \
        if (r < I1) { D = {F.in(I_AWOUT), nullptr, (GAS bf16_t*)(ws + O_WOUT0), DM, DM, 0, 0, 0}; nblk = 64; } else { r -= I1; \
        if (r < I2) { D = {F.in(I_SWKVF), F.in(I_SNORM), (GAS bf16_t*)(ws + O_WL1), 3084, DM, 0, 0, 0}; nblk = 96; } else { r -= I2; \
        if (r < I3) { D = {F.in(I_BWIN), F.in(I_BNORM), (GAS bf16_t*)(ws + O_WL1), DM, DM, 3072, 0, 0}; nblk = 64; } else { r -= I3; \
        if (r < I4) { D = {F.in(I_BWOUT), nullptr, (GAS bf16_t*)(ws + O_WOUT1), DM, DM, 0, 0, 0}; nblk = 64; } else { r -= I4; \
        if (r < I5) { D = {F.in(I_PWQ), F.in(I_PNORM), (GAS bf16_t*)(ws + O_WQ0), DM, DM, 0, 0, 0}; nblk = 64; } else { r -= I5; \
        if (r < I6) { D = {F.in(I_PWQ) + (size_t)DM * DM, F.in(I_PNORM) + DM, (GAS bf16_t*)(ws + O_WQ1), DM, DM, 0, 0, 0}; nblk = 64; } else { r -= I6; \
        if (r < I7) { D = {F.in(I_MWKV), nullptr, (GAS bf16_t*)(ws + O_WMKV), 1024, DM, 0, 0, 0}; nblk = 32; } else { r -= I7; \
        if (r < I8) { D = {F.in(I_MWKV) + (size_t)DM * 1024, nullptr, (GAS bf16_t*)(ws + O_WMKV) + (size_t)1024 * DM, 1024, DM, 0, 0, 0}; nblk = 32; } else { r -= I8; \
          const int blk = r / 16; r = r % 16; D = {F.in(I_AGATEW) + (size_t)blk * 128 * 256, nullptr, (GAS bf16_t*)(ws + O_WGATE), 256, 128, blk * 256, 0, 0}; nblk = 8; } } } } } } } } } \
        D.k0 = 64 * (r / nblk); D.n0 = 32 * (r % nblk); } while (0)
    for (int it = F.gw; it < NITEMS; it += F.ngw) { float wv[32]; TrItem d; TR_DESC(d, it); tr_load(d, wv, F.lane); tr_proc(d, wv, scr, F.lane); }
#undef TR_DESC
    { const GAS float* sk = F.in(I_PSUBK); GAS bf16_t* o = (GAS bf16_t*)(ws + O_SUBK);
      for (int i = F.gtid; i < 2 * 16 * 128 * 128 / 2; i += F.ngt) *(GAS unsigned*)(o + 2 * i) = cvtpk(sk[2 * i], sk[2 * i + 1]); }
    { GAS float* wf = (GAS float*)(ws + O_WF); const GAS float* w = F.in(I_SWKVF); const GAS float* g = F.in(I_SNORM);
      for (int i = F.gtid; i < 12 * DM; i += F.ngt) { const int j = i / DM, k = i % DM; wf[i] = w[(size_t)k * 3084 + 3072 + j] * g[k]; } }
    { GAS float* spl = (GAS float*)(ws + O_SPL); const GAS float* lam = F.in(I_ALAMBDA);
      for (int i = F.gtid; i < LRU; i += F.ngt) { const float z = -lam[i]; spl[i] = fmaxf(z, 0.f) + log1p_pos(fast_exp(-fabsf(z))); } }
    if (F.gw == 0) {
        float m = 0.f; for (int d = F.lane; d < 128; d += 64) m = fmaxf(m, fabsf(F.in(I_BQNORM)[d] * F.in(I_SKNORM)[d]));
        m = wave_max(m);
        if (F.lane == 0) ((GAS float*)(ws + O_GG))[512] = 2.f * 11.3137085f * m + 30.f; }
    { GAS float* gg = (GAS float*)(ws + O_GG);
      for (int i = F.gtid; i < 384; i += F.ngt) { const int a = i / 128, d = i % 128;
          gg[a == 0 ? 384 + d : i] = a == 0 ? F.in(I_BQNORM)[d] * F.in(I_SKNORM)[d] : F.in(I_MQNORM)[(a - 1) * 128 + d] * F.in(I_MKNORM)[(a - 1) * 128 + d]; } }
    {
        const GAS float* xin = F.in(I_X) + F.lane * 4; GAS bf16_t* xo = (GAS bf16_t*)(ws + O_XS16) + F.lane * 4;
        const int mlast = F.gw + ((T - 1 - F.gw) / F.ngw) * F.ngw;
#define XN_LOAD(V, m_) do { const int mm_ = (m_) <= mlast ? (m_) : mlast; _Pragma("unroll") for (int j = 0; j < 8; ++j) V[j] = __builtin_nontemporal_load((const GAS f32x4*)(xin + (size_t)mm_ * DM + j * 256)); } while (0)
#define XN_PROC(V, m_) do { if ((m_) < T) { float s0 = 0.f; _Pragma("unroll") for (int j = 0; j < 8; ++j) s0 += (V[j][0] * V[j][0] + V[j][1] * V[j][1]) + (V[j][2] * V[j][2] + V[j][3] * V[j][3]); \
            const float r0 = rsqrtf(wave_sum(s0) * (1.f / DM) + EPS); \
            _Pragma("unroll") for (int j = 0; j < 8; ++j) { u32x2 a; a.x = cvtpk(V[j][0] * r0, V[j][1] * r0); a.y = cvtpk(V[j][2] * r0, V[j][3] * r0); *(GAS u32x2*)(xo + (size_t)(m_) * DM + j * 256) = a; } } } while (0)
        f32x4 va[8], vb[8];
        XN_LOAD(va, F.gw);
        for (int m = F.gw; m < T; m += 2 * F.ngw) { XN_LOAD(vb, m + F.ngw); XN_PROC(va, m); XN_LOAD(va, m + 2 * F.ngw); XN_PROC(vb, m + F.ngw); }
#undef XN_LOAD
#undef XN_PROC
    }
    for (int m = F.gw; m < 2 * NMROW; m += F.ngw) { const int l = m / NMROW, r = m % NMROW;
        norm_row_bf16(F.in(I_MEM) + (size_t)r * DM, F.in(I_MNORM) + l * DM, (GAS bf16_t*)(ws + O_MEMN) + (size_t)m * DM, F.lane); }
    convert_tables(F, 0, 0, 2 * NEXP, F.gw, F.ngw);
}
__device__ __forceinline__ void step_conv(Frame& F) {
    const GAS bf16_t* zx = (const GAS bf16_t*)(F.ws + O_ZX); GAS bf16_t* xc = (GAS bf16_t*)(F.ws + O_XC);
    const GAS float* cw = F.in(I_ACONVW); const GAS float* cb = F.in(I_ACONVB);
    constexpr int NIT = T * (LRU / 8);
#define CV_LOAD(W, it_) do { const int ii_ = (it_) < NIT ? (it_) : NIT - 1; const int t_ = ii_ / (LRU / 8), c8_ = (ii_ % (LRU / 8)) * 8, pos_ = t_ & (SEQ - 1); \
        _Pragma("unroll") for (int k = 0; k < 4; ++k) W[k] = (pos_ - 3 + k >= 0) ? *(const GAS u32x4*)(zx + (size_t)(t_ - 3 + k) * LRU + c8_) : (u32x4){0u, 0u, 0u, 0u}; } while (0)
#define CV_PROC(W, it_) do { if ((it_) < NIT) { const int t_ = (it_) / (LRU / 8), c8_ = ((it_) % (LRU / 8)) * 8; float a[8]; \
        { const f32x4 b0 = *(const GAS f32x4*)(cb + c8_), b1 = *(const GAS f32x4*)(cb + c8_ + 4); a[0] = b0[0]; a[1] = b0[1]; a[2] = b0[2]; a[3] = b0[3]; a[4] = b1[0]; a[5] = b1[1]; a[6] = b1[2]; a[7] = b1[3]; } \
        _Pragma("unroll") for (int k = 0; k < 4; ++k) { const f32x4 w0 = *(const GAS f32x4*)(cw + k * LRU + c8_), w1 = *(const GAS f32x4*)(cw + k * LRU + c8_ + 4); \
            a[0] = fmaf(w0[0], bf_lo(W[k].x), a[0]); a[1] = fmaf(w0[1], bf_hi(W[k].x), a[1]); a[2] = fmaf(w0[2], bf_lo(W[k].y), a[2]); a[3] = fmaf(w0[3], bf_hi(W[k].y), a[3]); \
            a[4] = fmaf(w1[0], bf_lo(W[k].z), a[4]); a[5] = fmaf(w1[1], bf_hi(W[k].z), a[5]); a[6] = fmaf(w1[2], bf_lo(W[k].w), a[6]); a[7] = fmaf(w1[3], bf_hi(W[k].w), a[7]); } \
        u32x4 o; o.x = cvtpk(a[0], a[1]); o.y = cvtpk(a[2], a[3]); o.z = cvtpk(a[4], a[5]); o.w = cvtpk(a[6], a[7]); \
        *(GAS u32x4*)(xc + (size_t)t_ * LRU + c8_) = o; } } while (0)
    u32x4 wa[4], wb[4];
    CV_LOAD(wa, F.gtid);
    for (int it = F.gtid; it < NIT; it += 2 * F.ngt) { CV_LOAD(wb, it + F.ngt); CV_PROC(wa, it); CV_LOAD(wa, it + 2 * F.ngt); CV_PROC(wb, it + F.ngt); }
#undef CV_LOAD
#undef CV_PROC
}
constexpr int SCK = 32, NCK = SEQ / SCK;
typedef _Float16 h8_t __attribute__((ext_vector_type(8)));
__device__ __forceinline__ void scan_load(const GAS _Float16* LA, const GAS _Float16* UH, size_t off, float (&a)[8], float (&u)[8]) {
    const h8_t l = *(const GAS h8_t*)(LA + off), w = *(const GAS h8_t*)(UH + off);
#pragma unroll
    for (int k = 0; k < 8; ++k) { a[k] = fast_exp((float)l[k]); u[k] = (float)w[k]; }
}
__device__ __forceinline__ void step_scan1(Frame& F) {
    const GAS _Float16* LA = (const GAS _Float16*)(F.ws + O_AA); const GAS _Float16* UH = (const GAS _Float16*)(F.ws + O_UU);
    GAS float* CA = (GAS float*)(F.ws + O_LOGFP); GAS float* CH = CA + (size_t)NB * NCK * LRU;
    if (F.tid >= 384) return;
    const int grp = F.tid / 192, th = F.tid % 192;
    for (int it = blockIdx.x * 2 + grp; it < NB * NCK; it += gridDim.x * 2) {
        const int b = it / NCK, ck = it % NCK; const size_t base = ((size_t)b * SEQ + ck * SCK) * LRU + th * 8;
        float ap[8], h[8];
#pragma unroll
        for (int k = 0; k < 8; ++k) { ap[k] = 1.f; h[k] = 0.f; }
#pragma unroll 8
        for (int i = 0; i < SCK; ++i) { float a[8], u[8]; scan_load(LA, UH, base + (size_t)i * LRU, a, u);
#pragma unroll
            for (int k = 0; k < 8; ++k) { ap[k] *= a[k]; h[k] = a[k] * h[k] + u[k]; } }
        GAS float* ca = CA + (size_t)it * LRU + th * 8; GAS float* ch = CH + (size_t)it * LRU + th * 8;
        *(GAS f32x4*)ca = (f32x4){ap[0], ap[1], ap[2], ap[3]}; *(GAS f32x4*)(ca + 4) = (f32x4){ap[4], ap[5], ap[6], ap[7]};
        *(GAS f32x4*)ch = (f32x4){h[0], h[1], h[2], h[3]}; *(GAS f32x4*)(ch + 4) = (f32x4){h[4], h[5], h[6], h[7]};
    }
}
__device__ __forceinline__ void step_scan2(Frame& F) {
    const GAS _Float16* LA = (const GAS _Float16*)(F.ws + O_AA); const GAS _Float16* UH = (const GAS _Float16*)(F.ws + O_UU);
    const GAS float* CA = (const GAS float*)(F.ws + O_LOGFP); const GAS float* CH = CA + (size_t)NB * NCK * LRU;
    const GAS bf16_t* gy = (const GAS bf16_t*)(F.ws + O_GY); GAS bf16_t* cat = (GAS bf16_t*)(F.ws + O_CAT);
    if (F.tid >= 384) return;
    const int grp = F.tid / 192, th = F.tid % 192;
    for (int it = blockIdx.x * 2 + grp; it < NB * NCK; it += gridDim.x * 2) {
        const int b = it / NCK, ck = it % NCK; const size_t base = ((size_t)b * SEQ + ck * SCK) * LRU + th * 8;
        float h[8];
#pragma unroll
        for (int k = 0; k < 8; ++k) h[k] = 0.f;
        for (int k2 = 0; k2 < ck; ++k2) { const size_t o = (size_t)(b * NCK + k2) * LRU + th * 8;
            const f32x4 a0 = *(const GAS f32x4*)(CA + o), a1 = *(const GAS f32x4*)(CA + o + 4), c0 = *(const GAS f32x4*)(CH + o), c1 = *(const GAS f32x4*)(CH + o + 4);
#pragma unroll
            for (int k = 0; k < 4; ++k) { h[k] = a0[k] * h[k] + c0[k]; h[4 + k] = a1[k] * h[4 + k] + c1[k]; } }
#pragma unroll 8
        for (int i = 0; i < SCK; ++i) { float a[8], u[8]; scan_load(LA, UH, base + (size_t)i * LRU, a, u);
            const size_t row = (size_t)b * SEQ + ck * SCK + i;
            const u32x4 g = *(const GAS u32x4*)(gy + row * LRU + th * 8); u32x4 o;
#pragma unroll
            for (int k = 0; k < 8; ++k) h[k] = a[k] * h[k] + u[k];
#pragma unroll
            for (int k = 0; k < 4; ++k) o[k] = cvtpk(h[2 * k] * bf_lo(g[k]), h[2 * k + 1] * bf_hi(g[k]));
            *(GAS u32x4*)(cat + row * DM + th * 8) = o; }
    }
}
__device__ __forceinline__ void step_cprefix(Frame& F, LAS unsigned char* lds) {
    const GAS float* lf = (const GAS float*)(F.ws + O_LOGF); GAS float* cc = (GAS float*)(F.ws + O_CC);
    LAS double* scr = (LAS double*)(lds + F.wave * 16384);
    for (int it = F.gw; it < NB * NH; it += F.ngw) {
        const GAS float* p = lf + (size_t)it * SEQ + F.lane * 64; GAS float* q = cc + (size_t)it * SEQ + F.lane * 64;
        double s = 0.0;
        for (int i = 0; i < 64; ++i) s += (double)p[i];
        scr[F.lane] = s;
        asm volatile("s_waitcnt lgkmcnt(0)" ::: "memory");
        double run = 0.0;
        for (int l = 0; l < 64; ++l) { const double v = scr[l]; if (l < F.lane) run += v; }
        for (int i = 0; i < 64; ++i) { run += (double)p[i]; q[i] = (float)run; }
        asm volatile("s_waitcnt lgkmcnt(0)" ::: "memory");
    }
}

__device__ __forceinline__ int ord_i(float f) { const int b = __float_as_int(f); return b ^ ((b >> 31) & 0x7fffffff); }
__device__ __forceinline__ float unord_f(int k) { return __int_as_float(k ^ ((k >> 31) & 0x7fffffff)); }
template <int N> __device__ __forceinline__ void bitonic_sort_desc(int (&a)[N]) {
#pragma unroll
    for (int k = 2; k <= N; k <<= 1) {
#pragma unroll
        for (int j = k >> 1; j > 0; j >>= 1) {
#pragma unroll
            for (int i = 0; i < N; ++i) { const int l = i ^ j;
                if (l > i) { const bool desc = ((i & k) == 0); const int mx = max(a[i], a[l]), mn = min(a[i], a[l]); a[i] = desc ? mx : mn; a[l] = desc ? mn : mx; } }
        }
    }
}
__device__ __forceinline__ void bitonic_merge16_desc(int (&a)[16]) {
#pragma unroll
    for (int j = 8; j > 0; j >>= 1) {
#pragma unroll
        for (int i = 0; i < 16; ++i) { const int l = i ^ j; if (l > i) { const int mx = max(a[i], a[l]), mn = min(a[i], a[l]); a[i] = mx; a[l] = mn; } }
    }
}
__device__ __forceinline__ void top16_of_64(int (&a)[64]) {
    int g[4][16];
#pragma unroll
    for (int q = 0; q < 4; ++q) {
#pragma unroll
        for (int i = 0; i < 16; ++i) g[q][i] = a[16 * q + i];
        bitonic_sort_desc<16>(g[q]); }
#pragma unroll
    for (int i = 0; i < 16; ++i) { g[0][i] = max(g[0][i], g[1][15 - i]); g[2][i] = max(g[2][i], g[3][15 - i]); }
    bitonic_merge16_desc(g[0]); bitonic_merge16_desc(g[2]);
#pragma unroll
    for (int i = 0; i < 16; ++i) g[0][i] = max(g[0][i], g[2][15 - i]);
    bitonic_merge16_desc(g[0]);
#pragma unroll
    for (int i = 0; i < 16; ++i) a[i] = g[0][i];
}
__device__ __forceinline__ void subkey_top16(const GAS bf16_t* qrow  , const GAS bf16_t* sk  , int r32, int hi, int (&top)[16]) {
    bf16x8 qf[8];
#pragma unroll
    for (int ks = 0; ks < 8; ++ks) qf[ks] = *(const GAS bf16x8*)(qrow + ks * 16 + hi * 8);
    unsigned loff = (unsigned)(r32 * 128 + hi * 8) * 2u; asm volatile("" : "+v"(loff));
    int key[64];
#pragma unroll
    for (int kb = 0; kb < 4; ++kb) {
        f32x16 acc = {};
#pragma unroll
        for (int ks = 0; ks < 8; ++ks) { const bf16x8 af = *(const GAS bf16x8*)((const GAS char*)(sk + kb * 32 * 128 + ks * 16) + loff);
            acc = __builtin_amdgcn_mfma_f32_32x32x16_bf16(af, qf[ks], acc, 0, 0, 0); }
#pragma unroll
        for (int r = 0; r < 16; ++r) { const int id = kb * 32 + (r & 3) + 8 * (r >> 2) + 4 * hi; key[kb * 16 + r] = (ord_i(acc[r]) & ~127) | (127 - id); }
        __builtin_amdgcn_sched_barrier(0);
    }
    top16_of_64(key);
#pragma unroll
    for (int i = 0; i < 16; ++i) { auto r = __builtin_amdgcn_permlane32_swap((unsigned)key[15 - i], (unsigned)key[15 - i], false, false);
        const int pk = hi ? (int)r[0] : (int)r[1]; top[i] = max(key[i], pk); }
    bitonic_merge16_desc(top);
}
__device__ __forceinline__ void step_topk(Frame& F, LAS unsigned char* lds, int layer) {
    const GAS bf16_t* q16 = (const GAS bf16_t*)(F.ws + O_Q16); const GAS bf16_t* subk = (const GAS bf16_t*)(F.ws + O_SUBK) + (size_t)layer * 16 * 128 * 128;
    GAS int* IDX = (GAS int*)(F.ws + O_IDX); GAS float* GW = (GAS float*)(F.ws + O_GW);
    LAS int* scr = (LAS int*)(lds + F.wave * 16384) + F.lane * 33;
    const int r32 = F.lane & 31, hi = F.lane >> 5;
    for (int task = F.gw; task < (T / 32) * 8; task += F.ngw) {
        const int tb = task >> 3, h = task & 7; const int tok = tb * 32 + r32;
        const GAS bf16_t* qrow = q16 + (size_t)tok * DM + h * 256;
        int ta[16], tb16[16];
        subkey_top16(qrow, subk + (size_t)(h * 2 + 0) * 128 * 128, r32, hi, ta);
        subkey_top16(qrow + 128, subk + (size_t)(h * 2 + 1) * 128 * 128, r32, hi, tb16);
        float va[16], vb[16];
#pragma unroll
        for (int i = 0; i < 16; ++i) { va[i] = unord_f(ta[i] & ~127); vb[i] = unord_f(tb16[i] & ~127); scr[i] = 127 - (ta[i] & 127); scr[16 + i] = 127 - (tb16[i] & 127); }
        int c2[64]; int n = 0;
#pragma unroll
        for (int i = 0; i < 16; ++i)
#pragma unroll
            for (int j = 0; j < 16; ++j) if ((i + 1) * (j + 1) <= 16) { c2[n] = (ord_i(va[i] + vb[j]) & ~255) | (255 - (i * 16 + j)); ++n; }
#pragma unroll
        for (int i = 50; i < 64; ++i) c2[i] = (int)0x80000000;
        top16_of_64(c2);
        asm volatile("s_waitcnt lgkmcnt(0)" ::: "memory");
        float sv[16], ex[16]; int ev[16]; float Z = 0.f;
#pragma unroll
        for (int r = 0; r < 16; ++r) { const int flat = 255 - (c2[r] & 255); sv[r] = unord_f(c2[r] & ~255); ev[r] = scr[flat >> 4] * 128 + scr[16 + (flat & 15)]; }
#pragma unroll
        for (int r = 0; r < 16; ++r) { ex[r] = fast_exp(sv[r] - sv[0]); Z += ex[r]; }
        const float iz = 1.f / Z;
        GAS int* ip = IDX + (size_t)tok * 128 + h * 16 + hi * 8; GAS float* gp = GW + (size_t)tok * 128 + h * 16 + hi * 8;
        int eo[8]; float go[8];
#pragma unroll
        for (int j = 0; j < 8; ++j) { eo[j] = hi ? ev[8 + j] : ev[j]; go[j] = (hi ? ex[8 + j] : ex[j]) * iz; }
        *(GAS u32x4*)ip = (u32x4){(unsigned)eo[0], (unsigned)eo[1], (unsigned)eo[2], (unsigned)eo[3]}; *(GAS u32x4*)(ip + 4) = (u32x4){(unsigned)eo[4], (unsigned)eo[5], (unsigned)eo[6], (unsigned)eo[7]};
        *(GAS f32x4*)gp = (f32x4){go[0], go[1], go[2], go[3]}; *(GAS f32x4*)(gp + 4) = (f32x4){go[4], go[5], go[6], go[7]};
        asm volatile("s_waitcnt lgkmcnt(0)" ::: "memory");
    }
}
__device__ __forceinline__ h2 as_h2(unsigned w) { return __builtin_bit_cast(h2, w); }
#define F4(W, s) __builtin_amdgcn_cvt_scalef32_pk_f16_fp4((W), 1.0f, (s))
#define H2F(us) ((float)__builtin_bit_cast(_Float16, (unsigned short)(us)))
__device__ __forceinline__ float sum8(float v) { v += dppf<0xB1>(v); v += dppf<0x4E>(v); v += dppf<0x141>(v); return v; }
__device__ __forceinline__ void step_xplanes(Frame& F) {
    const GAS bf16_t* xs = (const GAS bf16_t*)(F.ws + O_XS16); GAS unsigned char* x4 = F.ws + O_X4; GAS float* sx = (GAS float*)(F.ws + O_SX);
    const int tlast = F.gw + ((T - 1 - F.gw) / F.ngw) * F.ngw;
#define XP_LOAD(W, t_) do { const int tt_ = (t_) <= tlast ? (t_) : tlast; _Pragma("unroll") for (int c = 0; c < 4; ++c) W[c] = *(const GAS u32x4*)(xs + (size_t)tt_ * DM + F.lane * 32 + 8 * c); } while (0)
    u32x4 w[4], wn[4];
    XP_LOAD(w, F.gw);
    for (int t = F.gw; t < T; t += F.ngw) {
        XP_LOAD(wn, t + F.ngw);
        float xv[32]; float amax = 0.f;
#pragma unroll
        for (int c = 0; c < 4; ++c)
#pragma unroll
            for (int k = 0; k < 4; ++k) { xv[8 * c + 2 * k] = bf_lo(w[c][k]); xv[8 * c + 2 * k + 1] = bf_hi(w[c][k]); amax = fmaxf(amax, fmaxf(fabsf(xv[8 * c + 2 * k]), fabsf(xv[8 * c + 2 * k + 1]))); }
        amax = fmaxf(amax, dppf<0xB1>(amax)); amax = fmaxf(amax, dppf<0x4E>(amax)); amax = fmaxf(amax, dppf<0x141>(amax));
        const float sc = fmaxf(amax, 1e-20f) * (1.f / 119.f), qs = 1.f / sc;
        u32x4 hp, lp;
#pragma unroll
        for (int d = 0; d < 4; ++d) { unsigned hw = 0u, lw = 0u;
#pragma unroll
            for (int k = 0; k < 8; ++k) { const int q = (int)rintf(xv[8 * d + k] * qs); const int h = (q + 8) >> 4, l = q - 16 * h; hw |= (unsigned)(h & 15) << (4 * k); lw |= (unsigned)(l & 15) << (4 * k); }
            hp[d] = hw; lp[d] = lw; }
        *(GAS u32x4*)(x4 + ((size_t)t * 64 + F.lane) * 32) = hp; *(GAS u32x4*)(x4 + ((size_t)t * 64 + F.lane) * 32 + 16) = lp;
        if ((F.lane & 7) == 0) sx[(size_t)t * 8 + (F.lane >> 3)] = sc;
#pragma unroll
        for (int c = 0; c < 4; ++c) w[c] = wn[c];
    }
#undef XP_LOAD
}
__device__ __forceinline__ void step_upass(Frame& F, int layer, int G) {
    const int s = blockIdx.x & 7, wk = (blockIdx.x >> 3) * NWAVES + F.wave, nwk = (G >> 3) * NWAVES;
    const GAS unsigned char* UN = F.ws + O_TAB + (size_t)(layer * 2) * TAB_ONE + (size_t)s * NEXP * 128;
    const GAS int* IDX = (const GAS int*)(F.ws + O_IDX); const GAS unsigned char* x4 = F.ws + O_X4 + s * 256; const GAS float* sxp = (const GAS float*)(F.ws + O_SX) + (size_t)s * 8 * T;
    GAS _Float16* part = (GAS _Float16*)(F.ws + O_PART) + (size_t)s * T * 128;
    unsigned lo = (unsigned)F.lane; asm volatile("" : "+v"(lo));
    const unsigned j = lo >> 3, p = lo & 7;
    const int tlast = wk + ((T - 1 - wk) / nwk) * nwk;
#define U_LOADID(ID, t_, q_) do { const int tt_ = (t_) <= tlast ? (t_) : tlast; _Pragma("unroll") for (int b = 0; b < 4; ++b) ID[b] = IDX[(size_t)tt_ * 128 + (q_) * 32 + 8 * b + j]; } while (0)
#define U_LOADX(t_) do { const int tt_ = (t_) <= tlast ? (t_) : tlast; xhn = *(const GAS u32x4*)(x4 + (size_t)tt_ * 2048 + p * 32); xln = *(const GAS u32x4*)(x4 + (size_t)tt_ * 2048 + p * 32 + 16); sxn = sxp[(size_t)p * T + tt_]; } while (0)
#define U_ISSUE(UB, ID) do { _Pragma("unroll") for (int b = 0; b < 4; ++b) UB[b] = *(const GAS u32x4*)(UN + (unsigned)(ID[b] * 128 + (int)p * 16)); } while (0)
#define U_QUARTER(UB, vout, q_) do { _Pragma("unroll") for (int b = 0; b < 4; ++b) { int ah = 0, al = 0; \
            ah = __builtin_amdgcn_sdot8((int)UB[b].x, (int)xh.x, ah, false); al = __builtin_amdgcn_sdot8((int)UB[b].x, (int)xh.y, al, false); \
            ah = __builtin_amdgcn_sdot8((int)UB[b].y, (int)xh.z, ah, false); al = __builtin_amdgcn_sdot8((int)UB[b].y, (int)xh.w, al, false); \
            ah = __builtin_amdgcn_sdot8((int)UB[b].z, (int)xl.x, ah, false); al = __builtin_amdgcn_sdot8((int)UB[b].z, (int)xl.y, al, false); \
            ah = __builtin_amdgcn_sdot8((int)UB[b].w, (int)xl.z, ah, false); al = __builtin_amdgcn_sdot8((int)UB[b].w, (int)xl.w, al, false); \
            const float d = sum8((float)(16 * ah + al) * sxc); vout = (p == (unsigned)(4 * ((q_) & 1) + b)) ? d : vout; } } while (0)
    int idA[4], idB[4]; u32x4 u0[4], u1[4], u2[4], u3[4]; u32x4 xh, xl, xhn, xln; float sxc, sxn;
    U_LOADID(idA, wk, 0); U_LOADID(idB, wk, 1); U_LOADX(wk);
    U_ISSUE(u0, idA); U_LOADID(idA, wk, 2);
    U_ISSUE(u1, idB); U_LOADID(idB, wk, 3);
    U_ISSUE(u2, idA); U_LOADID(idA, wk + nwk, 0);
    xh = xhn; xl = xln; sxc = sxn;
    for (int t = wk; t < T; t += nwk) {
        float v0 = 0.f, v1 = 0.f;
        U_ISSUE(u3, idB); U_LOADID(idB, t + nwk, 1); U_LOADX(t + nwk);
        U_QUARTER(u0, v0, 0);
        U_ISSUE(u0, idA); U_LOADID(idA, t + nwk, 2);
        U_QUARTER(u1, v0, 1);
        U_ISSUE(u1, idB); U_LOADID(idB, t + nwk, 3);
        U_QUARTER(u2, v1, 2);
        U_ISSUE(u2, idA); U_LOADID(idA, t + 2 * nwk, 0);
        U_QUARTER(u3, v1, 3);
        part[(size_t)t * 128 + 8 * p + j] = (_Float16)v0; part[(size_t)t * 128 + 64 + 8 * p + j] = (_Float16)v1;
        xh = xhn; xl = xln; sxc = sxn;
    }
#undef U_LOADID
#undef U_LOADX
#undef U_ISSUE
#undef U_QUARTER
}
__device__ __forceinline__ void step_peer_reduce(Frame& F, int layer) {
    const GAS _Float16* part = (const GAS _Float16*)(F.ws + O_PART); const GAS float* GW = (const GAS float*)(F.ws + O_GW); const GAS int* IDX = (const GAS int*)(F.ws + O_IDX);
    const GAS float* rowss = (const GAS float*)(F.ws + O_ROWSS); GAS unsigned char* W8 = F.ws + O_W8;
    const GAS unsigned char* SU = F.ws + O_TAB + (size_t)(layer * 2) * TAB_ONE + TAB_NIB; const GAS unsigned char* SV = SU + TAB_ONE;
    constexpr int NIT = T * 2;
    struct SA { int id; float gw, rs; float p[8]; }; struct SB { u32x4 su, sv; };
#define RA(X, it_) do { const int ii_ = (it_) < NIT ? (it_) : NIT - 1; const size_t i_ = (size_t)ii_ * 64 + F.lane; X.id = IDX[i_]; X.gw = GW[i_]; X.rs = rowss[(size_t)(ii_ >> 1) * 32 + (F.lane & 31)]; \
        _Pragma("unroll") for (int s = 0; s < 8; ++s) X.p[s] = (float)part[(size_t)s * T * 128 + i_]; } while (0)
#define RB(Y, X) do { Y.su = *(const GAS u32x4*)(SU + (size_t)X.id * 16); Y.sv = *(const GAS u32x4*)(SV + (size_t)X.id * 16); } while (0)
#define RC(X, Y, it_) do { if ((it_) < NIT) { const size_t i_ = (size_t)(it_) * 64 + F.lane; const float r = rsqrtf(wave_sum(X.rs) * (0.5f / DM) + EPS); float d = 0.f; \
        _Pragma("unroll") for (int s = 0; s < 8; ++s) d += X.p[s] * (float)__builtin_bit_cast(_Float16, (unsigned short)(Y.su[s >> 1] >> (16 * (s & 1)))); \
        const float w = X.gw * gelu_tanh(d * r) * 256.f; \
        _Pragma("unroll") for (int s = 0; s < 8; ++s) { const float ws = w * (float)__builtin_bit_cast(_Float16, (unsigned short)(Y.sv[s >> 1] >> (16 * (s & 1)))); \
            W8[(size_t)s * T * 128 + i_] = (unsigned char)(__builtin_amdgcn_cvt_pk_fp8_f32(ws, 0.f, 0, false) & 0xff); } } } while (0)
    SA a0, a1, a2; SB b0, b1;
    RA(a0, F.gw); RA(a1, F.gw + F.ngw); RB(b0, a0);
    for (int it = F.gw; it < NIT; it += F.ngw) {
        RA(a2, it + 2 * F.ngw); RB(b1, a1);
        RC(a0, b0, it);
        a0 = a1; a1 = a2; b0 = b1;
    }
#undef RA
#undef RB
#undef RC
}
__device__ __forceinline__ void step_vpass(Frame& F, int layer, int G, bool dry, LAS unsigned char* lds) {
    typedef pg8::v8i_t v8i_t;
    const int s = blockIdx.x & 7, wk = (blockIdx.x >> 3) * NWAVES + F.wave, nwk = (G >> 3) * NWAVES;
    const GAS unsigned char* VN = F.ws + O_TAB + (size_t)(layer * 2 + 1) * TAB_ONE + (size_t)s * NEXP * 128;
    const GAS int* IDX = (const GAS int*)(F.ws + O_IDX); const GAS unsigned char* W8 = F.ws + O_W8 + (size_t)s * T * 128;
    GAS bf16_t* xs = (GAS bf16_t*)(F.ws + O_XS16); GAS float* rsp = (GAS float*)(F.ws + O_RSP);
    unsigned lo = (unsigned)F.lane; asm volatile("" : "+v"(lo));
    const unsigned j = lo >> 3, p = lo & 7, c = lo & 15, kq = lo >> 4;
    LAS unsigned char* img = lds + F.wave * 16384;
    LAS unsigned char* wrp = img + j * 128 + ((p ^ j) << 4);
    const unsigned rdrow = (unsigned)(size_t)img + (32 * kq + c) * 128, csw = (c & 7) << 4;
    const int tlast = wk + ((T - 1 - wk) / nwk) * nwk;
#define V_LOADID(ID, t_, q_) do { const int tt_ = (t_) <= tlast ? (t_) : tlast; _Pragma("unroll") for (int b = 0; b < 4; ++b) ID[b] = IDX[(size_t)tt_ * 128 + (q_) * 32 + 8 * b + j]; } while (0)
#define V_LOADW(t_) do { const int tt_ = (t_) <= tlast ? (t_) : tlast; wn0 = *(const GAS u32x4*)(W8 + (size_t)tt_ * 128 + kq * 16); wn1 = *(const GAS u32x4*)(W8 + (size_t)tt_ * 128 + 64 + kq * 16); } while (0)
#define V_ISSUE(VB, ID) do { _Pragma("unroll") for (int b = 0; b < 4; ++b) VB[b] = *(const GAS u32x4*)(VN + (unsigned)(ID[b] * 128 + (int)p * 16)); } while (0)
#define V_WRITE(VB, q_) do { _Pragma("unroll") for (int b = 0; b < 4; ++b) *(LAS u32x4*)(wrp + (4 * (q_) + b) * 1024) = VB[b]; } while (0)
#define TR4(dst, va, off) asm volatile("ds_read_b64_tr_b4 %0, %1 offset:%2" : "=&v"(dst) : "v"(va), "i"(off) : "memory")
#define V_MM(cc) do { const unsigned va0 = rdrow + (((cc) << 4) ^ csw), va1 = rdrow + ((((cc) + 1) << 4) ^ csw); u32x2 t00, t01, t10, t11, t20, t21, t30, t31; \
        TR4(t00, va0, 0); TR4(t01, va0, 2048); TR4(t10, va0, 8); TR4(t11, va0, 2056); TR4(t20, va1, 0); TR4(t21, va1, 2048); TR4(t30, va1, 8); TR4(t31, va1, 2056); \
        asm volatile("s_waitcnt lgkmcnt(0)" ::: "memory"); __builtin_amdgcn_sched_barrier(0); \
        acc[2 * (cc)] = __builtin_amdgcn_mfma_scale_f32_16x16x128_f8f6f4((v8i_t){(int)t00.x, (int)t00.y, (int)t01.x, (int)t01.y, 0, 0, 0, 0}, bop, zero4, 4, 0, 0, 127, 0, 119); \
        acc[2 * (cc) + 1] = __builtin_amdgcn_mfma_scale_f32_16x16x128_f8f6f4((v8i_t){(int)t10.x, (int)t10.y, (int)t11.x, (int)t11.y, 0, 0, 0, 0}, bop, zero4, 4, 0, 0, 127, 0, 119); \
        acc[2 * (cc) + 2] = __builtin_amdgcn_mfma_scale_f32_16x16x128_f8f6f4((v8i_t){(int)t20.x, (int)t20.y, (int)t21.x, (int)t21.y, 0, 0, 0, 0}, bop, zero4, 4, 0, 0, 127, 0, 119); \
        acc[2 * (cc) + 3] = __builtin_amdgcn_mfma_scale_f32_16x16x128_f8f6f4((v8i_t){(int)t30.x, (int)t30.y, (int)t31.x, (int)t31.y, 0, 0, 0, 0}, bop, zero4, 4, 0, 0, 127, 0, 119); } while (0)
    int idA[4], idB[4]; u32x4 v0[4], v1[4], v2[4], v3[4]; u32x4 w0, w1, wn0, wn1;
    V_LOADID(idA, wk, 0); V_LOADID(idB, wk, 1); V_LOADW(wk);
    V_ISSUE(v0, idA); V_LOADID(idA, wk, 2);
    V_ISSUE(v1, idB); V_LOADID(idB, wk, 3);
    V_ISSUE(v2, idA); V_LOADID(idA, wk + nwk, 0);
    w0 = wn0; w1 = wn1;
    for (int t = wk; t < T; t += nwk) {
        V_ISSUE(v3, idB); V_LOADID(idB, t + nwk, 1); V_LOADW(t + nwk);
        GAS bf16_t* xb = xs + (size_t)t * DM + s * 256 + c * 16 + kq * 4;
        f32x4 x2; { const u32x2 w = *(const GAS u32x2*)xb; x2 = (f32x4){bf_lo(w.x), bf_hi(w.x), bf_lo(w.y), bf_hi(w.y)}; }
        V_WRITE(v0, 0);
        V_ISSUE(v0, idA); V_LOADID(idA, t + nwk, 2);
        V_WRITE(v1, 1);
        V_ISSUE(v1, idB); V_LOADID(idB, t + nwk, 3);
        V_WRITE(v2, 2);
        V_ISSUE(v2, idA); V_LOADID(idA, t + 2 * nwk, 0);
        V_WRITE(v3, 3);
        const v8i_t bop = {(int)w0.x, (int)w0.y, (int)w0.z, (int)w0.w, (int)w1.x, (int)w1.y, (int)w1.z, (int)w1.w};
        const f32x4 zero4 = {0.f, 0.f, 0.f, 0.f};
        f32x4 acc[16];
        V_MM(0); V_MM(2); V_MM(4); V_MM(6);
        f32x4 o = acc[0];
#pragma unroll
        for (int m = 1; m < 16; ++m) o = (c == (unsigned)m) ? acc[m] : o;
        x2 += o;
        if (layer == 1 && !dry) *(GAS f32x4*)(F.out + (size_t)t * DM + s * 256 + c * 16 + kq * 4) = x2;
        if (layer == 0 && !dry) {
            { u32x2 ow; ow.x = cvtpk(x2[0], x2[1]); ow.y = cvtpk(x2[2], x2[3]); *(GAS u32x2*)xb = ow; }
            const float sst = wave_sum((x2[0] * x2[0] + x2[1] * x2[1]) + (x2[2] * x2[2] + x2[3] * x2[3]));
            if (lo == 0) rsp[(size_t)t * 8 + s] = sst;
        }
        w0 = wn0; w1 = wn1;
    }
#undef V_LOADID
#undef V_LOADW
#undef V_ISSUE
#undef V_WRITE
#undef TR4
#undef V_MM
}
#undef F4
#undef H2F
__device__ __forceinline__ void step_logf(Frame& F, LAS unsigned char* lds) {
    const GAS bf16_t* xs = (const GAS bf16_t*)(F.ws + O_XS16); const GAS float* rsp = (const GAS float*)(F.ws + O_RSP); GAS float* logf = (GAS float*)(F.ws + O_LOGF);
    const GAS float* wf = (const GAS float*)(F.ws + O_WF); LAS float* wl = (LAS float*)lds;
    for (int i = F.tid; i < NH * DM / 4; i += NTHREADS) *(LAS f32x4*)(wl + 4 * i) = *(const GAS f32x4*)(wf + 4 * i);
    __syncthreads();
    const int tlast = F.gw + ((T - 1 - F.gw) / F.ngw) * F.ngw;
    unsigned lo = (unsigned)F.lane; asm volatile("" : "+v"(lo));
#define LF_LOAD(W, Q, t_) do { const int tt_ = (t_) <= tlast ? (t_) : tlast; _Pragma("unroll") for (int c = 0; c < 8; ++c) W[c] = *(const GAS u32x2*)(xs + (size_t)tt_ * DM + c * 256 + lo * 4); Q = lo < 8 ? rsp[(size_t)tt_ * 8 + lo] : 0.f; } while (0)
    u32x2 w[8], wn[8]; float q, qn;
    LF_LOAD(w, q, F.gw);
    for (int t = F.gw; t < T; t += F.ngw) {
        LF_LOAD(wn, qn, t + F.ngw);
        asm volatile("" : "+v"(lo));
        const float r1 = rsqrtf(wave_sum(q) * (1.f / DM) + EPS);
        float mine = 0.f;
#pragma unroll 2
        for (int h = 0; h < NH; ++h) { float d = 0.f;
#pragma unroll
            for (int c = 0; c < 8; ++c) { const f32x4 g = *(const LAS f32x4*)(wl + h * DM + c * 256 + lo * 4);
                d += (bf_lo(w[c].x) * g[0] + bf_hi(w[c].x) * g[1]) + (bf_lo(w[c].y) * g[2] + bf_hi(w[c].y) * g[3]); }
            d = wave_sum(d); mine = (lo == (unsigned)h) ? d : mine; }
        if (lo < (unsigned)NH) { const float z = mine * r1 + F.in(I_SBF)[lo];
            logf[((size_t)(t / SEQ) * NH + lo) * SEQ + (t % SEQ)] = fminf(z, 0.f) - log1p_pos(fast_exp(-fabsf(z))); }
#pragma unroll
        for (int c = 0; c < 8; ++c) w[c] = wn[c];
        q = qn;
    }
#undef LF_LOAD
    __syncthreads();
}

#define XB_TMO      128
#define XB_XCNT(j)  (256  + 64 * (j))
#define XB_XSUB(j)  (1280 + 64 * (j))
#define XB_XGEN(j)  (2304 + 64 * (j))
#define XB_TOP      3328
#define XB_TOPGEN   3392
#define XCD_BAR_WORDS 3456
#define XB_SPIN_CAP (1u << 20)
__device__ __forceinline__ unsigned xb_ld(unsigned* p)              { return __hip_atomic_load(p, __ATOMIC_RELAXED, __HIP_MEMORY_SCOPE_AGENT); }
__device__ __forceinline__ unsigned xb_add(unsigned* p, unsigned v) { return __hip_atomic_fetch_add(p, v, __ATOMIC_RELAXED, __HIP_MEMORY_SCOPE_AGENT); }
__device__ __forceinline__ unsigned xb_xcc_id() { return (unsigned)__builtin_amdgcn_s_getreg((3 << 11) | 20) & 0xFu; }
#define XB_SPIN(cond, bar) do { unsigned _sp = 0; while (cond) { __builtin_amdgcn_s_sleep(1); \
    if ((++_sp & 255u) == 0u) { if (xb_ld(&(bar)[XB_TMO])) break; if (_sp > XB_SPIN_CAP) { atomicAdd(&(bar)[XB_TMO], 1u); break; } } } } while (0)
struct XcdBarrier { unsigned* bar; unsigned x; volatile LAS unsigned* st; };
__device__ __forceinline__ XcdBarrier xcd_barrier_post(unsigned* bar, volatile LAS unsigned* st) {
    XcdBarrier b; b.bar = bar; b.x = xb_xcc_id(); b.st = st;
    if (threadIdx.x == 0) (void)xb_add(&bar[XB_XCNT(b.x)], 1u);
    return b;
}
__device__ __forceinline__ void xcd_barrier_complete(unsigned* bar, unsigned x, unsigned& nloc, unsigned& nx) {
    const unsigned G = gridDim.x * gridDim.y * gridDim.z;
    unsigned sum, cnt, mine, sp = 0u;
    for (;;) {
        sum = 0u; cnt = 0u; mine = 0u;
#pragma unroll
        for (unsigned j = 0; j < 16; ++j) { const unsigned c = xb_ld(&bar[XB_XCNT(j)]); sum += c; cnt += (c > 0u) ? 1u : 0u; mine = (j == x) ? c : mine; }
        if (sum == G) break;
        __builtin_amdgcn_s_sleep(1);
        if ((++sp & 255u) == 0u) { if (xb_ld(&bar[XB_TMO])) break; if (sp > XB_SPIN_CAP) { atomicAdd(&bar[XB_TMO], 1u); break; } }
    }
    nloc = mine > 0u ? mine : 1u; nx = cnt > 0u ? cnt : 1u;
}
__device__ __forceinline__ void xcd_barrier(const XcdBarrier& b, int wave_s) {
    asm volatile("s_waitcnt vmcnt(0)" ::: "memory");
    __syncthreads();
    int ln_; asm volatile("v_mbcnt_lo_u32_b32 %0, -1, 0\n\tv_mbcnt_hi_u32_b32 %0, -1, %0" : "=v"(ln_));
    if (wave_s == 0 && ln_ == 0) {
        unsigned* bar = b.bar;
        __builtin_amdgcn_s_waitcnt(0);
        unsigned nloc = b.st[0], nx = b.st[1];
        if (nloc == 0u) { xcd_barrier_complete(bar, b.x, nloc, nx); b.st[0] = nloc; b.st[1] = nx; }
        const unsigned old = xb_add(&bar[XB_XSUB(b.x)], 1u);
        const unsigned gen = old / nloc;
        if (old + 1u == (gen + 1u) * nloc) {
            __builtin_amdgcn_fence(__ATOMIC_RELEASE, "agent");
            asm volatile("s_waitcnt vmcnt(0)" ::: "memory");
            const unsigned og = xb_add(&bar[XB_TOP], 1u);
            const unsigned tg = og / nx;
            if (og + 1u == (tg + 1u) * nx) xb_add(&bar[XB_TOPGEN], 1u);
            else XB_SPIN(xb_ld(&bar[XB_TOPGEN]) == tg, bar);
            __builtin_amdgcn_fence(__ATOMIC_ACQUIRE, "agent");
            xb_add(&bar[XB_XGEN(b.x)], 1u);
            asm volatile("s_waitcnt vmcnt(0)" ::: "memory");
        } else {
            XB_SPIN(xb_ld(&bar[XB_XGEN(b.x)]) == gen, bar);
            __builtin_amdgcn_fence(__ATOMIC_ACQUIRE, "agent");
            asm volatile("s_waitcnt vmcnt(0)" ::: "memory");
        }
    }
    __syncthreads();
}

constexpr int CONV1_SPLIT = 2 * 4608;
constexpr int BAR_LDS_OFF = 147456 - 64;
constexpr int LDS_BYTES = 147456;
enum { ST_PROLOGUE = 0, ST_G_IN0, ST_G_MKV0, ST_G_MKV1, ST_CONV, ST_G_GATE, ST_A_MEM0, ST_SCAN1, ST_SCAN2, ST_G_OUT0, ST_G_PQ0, ST_TOPK0, ST_UPASS0, ST_PRED0, ST_VPASS0,
       ST_G_L1, ST_CPREFIX, ST_A_FOX, ST_A_MEM1, ST_G_OUT1, ST_G_PQ1, ST_TOPK1, ST_UPASS1, ST_PRED1, ST_VPASS1, N_STEPS };
constexpr unsigned SYNC_AFTER = (1u << ST_PROLOGUE) | (1u << ST_G_MKV1) | (1u << ST_CONV) | (1u << ST_A_MEM0) | (1u << ST_SCAN1) | (1u << ST_SCAN2) | (1u << ST_G_OUT0) | (1u << ST_G_PQ0) |
                                (1u << ST_TOPK0) | (1u << ST_UPASS0) | (1u << ST_PRED0) | (1u << ST_VPASS0) | (1u << ST_G_L1) | (1u << ST_CPREFIX) | (1u << ST_A_MEM1) | (1u << ST_G_OUT1) | (1u << ST_G_PQ1) | (1u << ST_TOPK1) | (1u << ST_UPASS1) | (1u << ST_PRED1);
constexpr unsigned GEMM_STEPS = (1u << ST_G_IN0) | (1u << ST_G_MKV0) | (1u << ST_G_MKV1) | (1u << ST_G_GATE) | (1u << ST_G_OUT0) | (1u << ST_G_PQ0) | (1u << ST_G_L1) | (1u << ST_G_OUT1) | (1u << ST_G_PQ1);
constexpr unsigned ATTN_STEPS = (1u << ST_A_MEM0) | (1u << ST_A_FOX) | (1u << ST_A_MEM1);

struct Args { const float* in[N_IN]; float* out; unsigned char* ws; int lo, hi; };

__global__ void __launch_bounds__(NTHREADS, 2) yoco_fwd(Args args) {
    extern __shared__ __attribute__((aligned(16))) unsigned char lds[];
    volatile LAS unsigned* bst = (volatile LAS unsigned*)((LAS unsigned char*)lds + BAR_LDS_OFF);
    if (threadIdx.x == 0) { bst[0] = 0u; bst[1] = 0u; }
    __syncthreads();
    const XcdBarrier gbar = xcd_barrier_post((unsigned*)(args.ws + O_CTL), bst);
    const int G = gridDim.x;
    const int wave_s = __builtin_amdgcn_readfirstlane(threadIdx.x >> 6);
#ifndef DUP_MASK
#define DUP_MASK 0u
#endif
    for (int st = args.lo; st < args.hi; ++st) {
      const int nrep = ((DUP_MASK >> st) & 1u) ? 2 : 1;
      for (int rep = 0; rep < nrep; ++rep) {
        unsigned char* ws0 = args.ws; asm volatile("" : "+s"(ws0));
        GAS unsigned char* ws = (GAS unsigned char*)ws0;
#define LANE_ID(v) asm volatile("v_mbcnt_lo_u32_b32 %0, -1, 0\n\tv_mbcnt_hi_u32_b32 %0, -1, %0" : "=v"(v))
#define MAKE_TID(v) do { LANE_ID(v); v += wave_s * 64; } while (0)
#define MAKE_FRAME(F) Frame F; F.ws = ws; F.in_ = args.in; F.out = (GAS float*)args.out; { int t0_; MAKE_TID(t0_); F.tid = t0_; } F.lane = F.tid & 63; F.wave = wave_s; \
        F.gw = blockIdx.x * NWAVES + F.wave; F.ngw = gridDim.x * NWAVES; F.gtid = blockIdx.x * NTHREADS + F.tid; F.ngt = gridDim.x * NTHREADS
        if (st == ST_G_L1) { MAKE_FRAME(F); step_logf(F, (LAS unsigned char*)lds); }
        if ((GEMM_STEPS >> st) & 1u) {
            pg8::Gemm g; Epi E; E.ws = ws; E.resid = nullptr; E.outf = nullptr; E.o16 = nullptr; E.ssq = nullptr; E.gate_b = nullptr; int shift = 0;
            switch (st) {
            case ST_G_IN0:  g = {(const GAS bf16_t*)(ws + O_XS16), (const GAS bf16_t*)(ws + O_WIN0), T, NIN0, DM, DM, DM, 0}; E.mode = EM_IN0; break;
            case ST_G_MKV0: g = {(const GAS bf16_t*)(ws + O_MEMN), (const GAS bf16_t*)(ws + O_WMKV), NMROW, 1024, DM, DM, DM, 0}; E.mode = EM_MKV; E.o16 = (GAS bf16_t*)(ws + O_MKV); E.ssq = (GAS float*)(ws + O_MKSS); shift = 128; break;
            case ST_G_MKV1: g = {(const GAS bf16_t*)(ws + O_MEMN) + (size_t)NMROW * DM, (const GAS bf16_t*)(ws + O_WMKV) + (size_t)1024 * DM, NMROW, 1024, DM, DM, DM, 0}; E.mode = EM_MKV;
                            E.o16 = (GAS bf16_t*)(ws + O_MKV) + (size_t)NMROW * NL1; E.ssq = (GAS float*)(ws + O_MKSS) + NMROW * 112; shift = 144; break;
            case ST_G_GATE: g = {(const GAS bf16_t*)(ws + O_XC), (const GAS bf16_t*)(ws + O_WGATE), T, 12 * 256, 128, LRU, 128, 128}; E.mode = EM_GATE; E.gate_b = (const GAS float*)args.in[I_AGATEB]; break;
            case ST_G_OUT0: g = {(const GAS bf16_t*)(ws + O_CAT), (const GAS bf16_t*)(ws + O_WOUT0), T, DM, DM, DM, DM, 0}; E.mode = EM_RES; E.resid = (const GAS float*)args.in[I_X]; E.outf = (GAS float*)args.out; break;
            case ST_G_PQ0:  g = {(const GAS bf16_t*)(ws + O_XS16), (const GAS bf16_t*)(ws + O_WQ0), T, DM, DM, DM, DM, 0}; E.mode = EM_PQ; E.o16 = (GAS bf16_t*)(ws + O_Q16); break;
            case ST_G_L1:   g = {(const GAS bf16_t*)(ws + O_XS16), (const GAS bf16_t*)(ws + O_WL1), T, NL1, DM, DM, DM, 0}; E.mode = EM_L1; break;
            case ST_G_OUT1: g = {(const GAS bf16_t*)(ws + O_CAT), (const GAS bf16_t*)(ws + O_WOUT1), T, DM, DM, DM, DM, 0}; E.mode = EM_RES; E.resid = nullptr; break;
            default:        g = {(const GAS bf16_t*)(ws + O_XS16), (const GAS bf16_t*)(ws + O_WQ1), T, DM, DM, DM, DM, 0}; E.mode = EM_PQ; E.o16 = (GAS bf16_t*)(ws + O_Q16); break;
            }
            pg8::StaticOrder S; S.init(g.M, g.N, G, (int)((blockIdx.x + G - shift) % G));
#ifndef DIS_GEMM
            { int tg_; MAKE_TID(tg_);
              pg8::gemm_phase<Epi, false>((LAS unsigned char*)lds, g, S, E, tg_); }
#endif
            if (st == ST_G_MKV1 && blockIdx.x >= 160) { MAKE_FRAME(F); convert_tables(F, 1, 0, CONV1_SPLIT, (blockIdx.x - 160) * NWAVES + F.wave, (G - 160) * NWAVES); }
        } else if ((ATTN_STEPS >> st) & 1u) {
            const int nun = st == ST_A_FOX ? 3 : 1;
            for (int ui = 0; ui < nun; ++ui) {
                att::BlockRef r;
                if (st == ST_A_FOX) {
                    const int i = blockIdx.x, x = i & 15, bh = (i >> 4) + 16 * ui, qb = ui == 0 ? x : (ui == 1 ? 15 - x : ((x * 5 + 3) & 15));
                    const int b = bh / NH, h = bh % NH; const size_t row0 = (size_t)b * SEQ + qb * 256;
                    const GAS bf16_t* z = (const GAS bf16_t*)(ws + O_ZL1);
                    r.Q = z + row0 * NL1 + 3072 + h * 128; r.K = z + (size_t)b * SEQ * NL1 + h * 128; r.V = z + (size_t)b * SEQ * NL1 + 1536 + h * 128;
                    r.O = (GAS bf16_t*)(ws + O_CAT) + row0 * DM + h * 128;
                    const GAS float* ss = (const GAS float*)(ws + O_SSL1);
                    r.qss = ss + row0 * 112 + (12 + h) * 4; r.kss = ss + (size_t)b * SEQ * 112 + h * 4; r.cc = (const GAS float*)(ws + O_CC) + (size_t)bh * SEQ; r.gg = (const GAS float*)(ws + O_GG) + 384;
                    r.P0 = qb * 256; r.skv = SEQ;
                } else {
                    const int l = st == ST_A_MEM0 ? 0 : 1; const int i = blockIdx.x, qblk = i >> 2, h = i & 3, b = qblk >> 4; const size_t row0 = (size_t)qblk * 256;
                    r.Q = (const GAS bf16_t*)(ws + O_ZL1) + row0 * NL1 + 4608 + h * 128; r.qss = (const GAS float*)(ws + O_SSL1) + row0 * 112 + (24 + h) * 4;
                    const GAS bf16_t* kv = (const GAS bf16_t*)(ws + O_MKV) + ((size_t)l * NMROW + b * NMEM) * NL1;
                    r.K = kv + h * 128; r.V = kv + 512 + h * 128; r.kss = (const GAS float*)(ws + O_MKSS) + ((size_t)l * NMROW + b * NMEM) * 112 + h * 4;
                    r.O = (GAS bf16_t*)(ws + O_CAT) + row0 * DM + LRU + h * 128; r.cc = nullptr; r.gg = (const GAS float*)(ws + O_GG) + 128 * (1 + l);
                    r.P0 = SEQ; r.skv = NMEM;
                }
                att::Seam S;
                int tid_u; MAKE_TID(tid_u);
#ifndef DIS_ATTN
                if (st == ST_A_FOX) { att::attn_prime(r, (char*)lds, S, tid_u); att::attn_block(r, (char*)lds, S, tid_u); }
                else att::mem_attn_unit(r, (char*)lds, tid_u);
#endif
            }
        } else {
            MAKE_FRAME(F);
            switch (st) {
#ifndef DIS_MISC
            case ST_PROLOGUE: step_prologue(F, (LAS unsigned char*)lds); break;
            case ST_CONV: step_conv(F); break;
            case ST_SCAN1: step_scan1(F); break;
            case ST_SCAN2: step_scan2(F); break;
#endif
#ifndef DIS_TOPK
            case ST_TOPK0: step_topk(F, (LAS unsigned char*)lds, 0); break;
            case ST_TOPK1: step_topk(F, (LAS unsigned char*)lds, 1); break;
#endif
#ifndef DIS_GATHER
            case ST_UPASS0: step_upass(F, 0, G); break;
            case ST_UPASS1: step_upass(F, 1, G); break;
            case ST_PRED0: step_peer_reduce(F, 0); break;
            case ST_PRED1: step_peer_reduce(F, 1); break;
            case ST_VPASS0: step_vpass(F, 0, G, rep + 1 < nrep, (LAS unsigned char*)lds); break;
            case ST_VPASS1: step_vpass(F, 1, G, rep + 1 < nrep, (LAS unsigned char*)lds); break;
#endif
#ifndef DIS_MISC
            case ST_CPREFIX: step_cprefix(F, (LAS unsigned char*)lds); convert_tables(F, 1, G > 160 ? CONV1_SPLIT : 0, 2 * NEXP, F.gw, F.ngw); break;
#endif
            default: break;
            }
        }
        if (rep + 1 < nrep) xcd_barrier(gbar, wave_s);
      }
        if (((SYNC_AFTER >> st) & 1u) && st + 1 < args.hi) xcd_barrier(gbar, wave_s);
    }
}

#ifndef N_LAUNCH_MODE
#define N_LAUNCH_MODE 1
#endif
extern "C" void kernel_launch(void* const* d_in, const int* in_sizes, int n_in, void* d_out, int out_size, void* d_ws, size_t ws_size, hipStream_t stream) {
    static int grid = 0;
    if (grid == 0) {
        if (n_in != N_IN || in_sizes[0] != T * DM || out_size != T * DM || ws_size < WS_END) {
            fprintf(stderr, "kernel_launch: unexpected shapes (n_in %d, in0 %d, out %d, ws %zu, need %zu)\n", n_in, n_in > 0 ? in_sizes[0] : -1, out_size, ws_size, (size_t)WS_END); grid = -1; return; }
        int dev = 0, cus = 0, per_cu = 0;
        hipGetDevice(&dev); hipDeviceGetAttribute(&cus, hipDeviceAttributeMultiprocessorCount, dev);
        hipFuncSetAttribute((const void*)yoco_fwd, hipFuncAttributeMaxDynamicSharedMemorySize, LDS_BYTES);
        hipOccupancyMaxActiveBlocksPerMultiprocessor(&per_cu, (const void*)yoco_fwd, NTHREADS, LDS_BYTES);
        if (per_cu < 1) { fprintf(stderr, "kernel_launch: occupancy query says %d blocks per CU\n", per_cu); grid = -1; return; }
        grid = cus - cus % 8;
        (void)hipGetLastError();
    }
    if (grid < 0) return;
    Args a{};
    for (int i = 0; i < N_IN; ++i) a.in[i] = (const float*)d_in[i];
    a.out = (float*)d_out; a.ws = (unsigned char*)d_ws;
    if (hipMemsetAsync((char*)d_ws + O_CTL, 0, 65536, stream) != hipSuccess) { fprintf(stderr, "kernel_launch: memset of the barrier words failed\n"); return; }
    if (N_LAUNCH_MODE == 1) {
        a.lo = 0; a.hi = N_STEPS;
        hipLaunchKernelGGL(yoco_fwd, dim3(grid), dim3(NTHREADS), LDS_BYTES, stream, a);
        hipError_t e = hipPeekAtLastError();
        if (e != hipSuccess) fprintf(stderr, "launch failed: %s (grid %d)\n", hipGetErrorString(e), grid);
    } else {
        int lo = 0;
        for (int s = 0; s < N_STEPS; ++s) {
            if (((SYNC_AFTER >> s) & 1u) || s == N_STEPS - 1) {
                a.lo = lo; a.hi = s + 1; lo = s + 1;
                void* params[] = {&a};
                hipError_t e = hipLaunchCooperativeKernel((const void*)yoco_fwd, dim3(grid), dim3(NTHREADS), params, LDS_BYTES, stream);
                if (e != hipSuccess) { fprintf(stderr, "launch failed: %s\n", hipGetErrorString(e)); break; }
            }
        }
    }
}
```

```cpp
#include <hip/hip_runtime.h>
#include <hip/hip_cooperative_groups.h>
#include <cstdio>
#include <cstdint>
namespace cg = cooperative_groups;

#define LAS __attribute__((address_space(3)))
#define GAS __attribute__((address_space(1)))
typedef unsigned short bf16_t;
typedef short bf16x8 __attribute__((ext_vector_type(8)));
typedef short s16x4 __attribute__((ext_vector_type(4)));
typedef float f32x4 __attribute__((ext_vector_type(4)));
typedef float f32x2 __attribute__((ext_vector_type(2)));
typedef float f32x16 __attribute__((ext_vector_type(16)));
typedef unsigned u32x4 __attribute__((ext_vector_type(4)));
typedef unsigned u32x2 __attribute__((ext_vector_type(2)));
typedef _Float16 h2 __attribute__((ext_vector_type(2)));

constexpr int NB = 4, SEQ = 4096, T = NB * SEQ, DM = 2048, LRU = 1536, MEMW = 512, NMEM = 256, NH = 12, HD = 128;
constexpr int NIN0 = 3584, NL1 = 5120, NEXP = 16384, NMROW = NB * NMEM;
constexpr float EPS = 1e-6f;
constexpr int NTHREADS = 512, NWAVES = 8;

constexpr size_t MiB = 1u << 20;
constexpr size_t O_CTL = 0;
constexpr size_t O_WIN0 = 1 * MiB;
constexpr size_t O_WOUT0 = O_WIN0 + 14 * MiB;
constexpr size_t O_WL1 = O_WOUT0 + 8 * MiB;
constexpr size_t O_WOUT1 = O_WL1 + 20 * MiB;
constexpr size_t O_WQ0 = O_WOUT1 + 8 * MiB;
constexpr size_t O_WQ1 = O_WQ0 + 8 * MiB;
constexpr size_t O_WMKV = O_WQ1 + 8 * MiB;
constexpr size_t O_WGATE = O_WMKV + 8 * MiB;
constexpr size_t O_SUBK = O_WGATE + 1 * MiB;
constexpr size_t O_WF = O_SUBK + 1 * MiB;
constexpr size_t O_SMALL = O_WF + 1 * MiB;
constexpr size_t O_RS1 = O_SMALL;
constexpr size_t O_LOGF = O_SMALL + 64 * 1024;
constexpr size_t O_CC = O_LOGF + 768 * 1024;
constexpr size_t O_GG = O_CC + 768 * 1024;
constexpr size_t O_SPL = O_GG + 4096;
constexpr size_t O_TSC = O_SPL + 8192;
constexpr size_t O_ROWSS = O_SMALL + 2 * MiB;
constexpr size_t O_RSP = O_ROWSS + 2 * MiB;
constexpr size_t O_QMSS = O_RSP;
constexpr size_t O_MKSS = O_QMSS + 1 * MiB;
constexpr size_t O_SSL1 = O_MKSS + 1 * MiB;
constexpr size_t O_CARRY = O_SSL1 + 7 * MiB;
constexpr size_t O_MEMN = O_CARRY + 3 * MiB;
constexpr size_t O_MKV = O_MEMN + 8 * MiB;
constexpr size_t O_IDX = O_MKV + 20 * MiB;
constexpr size_t O_GW = O_IDX + 8 * MiB;
constexpr size_t O_TAB = O_GW + 8 * MiB;
constexpr size_t TAB_NIB = (size_t)8 * 16384 * 128, TAB_ONE = TAB_NIB + (size_t)16384 * 16 + 786432;
constexpr size_t O_XS16 = O_TAB + 128 * MiB;
constexpr size_t O_CAT = O_XS16 + 64 * MiB;
constexpr size_t O_ZX = O_CAT + 64 * MiB;
constexpr size_t O_X8 = O_ZX;
constexpr size_t O_GY = O_ZX + 48 * MiB;
constexpr size_t O_LOGFP = O_GY + 48 * MiB;
constexpr size_t O_QM = O_LOGFP;
constexpr size_t O_XC = O_QM + 16 * MiB;
constexpr size_t O_X4 = O_XC;
constexpr size_t O_SX = O_XC + 32 * MiB;
constexpr size_t O_AA = O_XC + 48 * MiB;
constexpr size_t O_PART = O_AA;
constexpr size_t O_UU = O_AA + 96 * MiB;
constexpr size_t O_W8 = O_UU;
constexpr size_t O_Q16 = O_UU + 96 * MiB;
constexpr size_t O_ZL1 = O_Q16 + 64 * MiB;
constexpr size_t WS_END = O_ZL1 + 160 * MiB;
static_assert(WS_END <= 1024 * MiB, "workspace map");

__device__ __forceinline__ unsigned cvtpk(float lo, float hi) { unsigned r; asm volatile("v_cvt_pk_bf16_f32 %0, %1, %2" : "=v"(r) : "v"(lo), "v"(hi)); return r; }
__device__ __forceinline__ float bf_lo(unsigned w) { return __uint_as_float(w << 16); }
__device__ __forceinline__ float bf_hi(unsigned w) { return __uint_as_float(w & 0xffff0000u); }
__device__ __forceinline__ float fast_exp(float x) { return __builtin_amdgcn_exp2f(x * 1.4426950408889634f); }
__device__ __forceinline__ float log1p_pos(float y) { const float ser = y * (1.f - y * (0.5f - y * (0.33333334f - 0.25f * y))); const float lg = __builtin_amdgcn_logf(1.f + y) * 0.6931471805599453f; return y < 0.03f ? ser : lg; }
__device__ __forceinline__ float one_minus_exp(float x) { const float ser = -x * (1.f + x * (0.5f + x * (0.16666667f + x * 0.041666668f))); const float big = 1.f - fast_exp(x); return x > -0.03f ? ser : big; }
__device__ __forceinline__ float sigmoidf_(float x) { return __builtin_amdgcn_rcpf(1.f + fast_exp(-x)); }
__device__ __forceinline__ float gelu_tanh(float x) { const float u = x * (1.f + 0.044715f * x * x); return x * __builtin_amdgcn_rcpf(1.f + __builtin_amdgcn_exp2f(u * (-2.f * 0.7978845608028654f * 1.4426950408889634f))); }
template <int CTRL> __device__ __forceinline__ float dppf(float v) { return __int_as_float(__builtin_amdgcn_update_dpp(0, __float_as_int(v), CTRL, 0xF, 0xF, true)); }
__device__ __forceinline__ float xsum16(float v) { auto r = __builtin_amdgcn_permlane16_swap(__float_as_uint(v), __float_as_uint(v), false, false); return __uint_as_float(r[0]) + __uint_as_float(r[1]); }
__device__ __forceinline__ float xsum32(float v) { auto r = __builtin_amdgcn_permlane32_swap(__float_as_uint(v), __float_as_uint(v), false, false); return __uint_as_float(r[0]) + __uint_as_float(r[1]); }
__device__ __forceinline__ float xmax16(float v) { auto r = __builtin_amdgcn_permlane16_swap(__float_as_uint(v), __float_as_uint(v), false, false); return fmaxf(__uint_as_float(r[0]), __uint_as_float(r[1])); }
__device__ __forceinline__ float xmax32(float v) { auto r = __builtin_amdgcn_permlane32_swap(__float_as_uint(v), __float_as_uint(v), false, false); return fmaxf(__uint_as_float(r[0]), __uint_as_float(r[1])); }
__device__ __forceinline__ float wave_sum(float v) {
    v += dppf<0xB1>(v); v += dppf<0x4E>(v); v += dppf<0x141>(v); v += dppf<0x140>(v);
    v = xsum16(v); v = xsum32(v); return v;
}
__device__ __forceinline__ float wave_max(float v) {
    v = fmaxf(v, dppf<0xB1>(v)); v = fmaxf(v, dppf<0x4E>(v)); v = fmaxf(v, dppf<0x141>(v)); v = fmaxf(v, dppf<0x140>(v));
    v = xmax16(v); v = xmax32(v); return v;
}

namespace pg8 {
constexpr int BM = 256, BK = 64, HALF = 128, HTB = HALF * BK * 2, STAGE_BYTES = 8 * HTB, NXCD = 8, WGM = 8;
__host__ __device__ __forceinline__ int lds_byte(int r, int c) { const int st = (r >> 4) * 2 + (c >> 5), rr = r & 15, cc = c & 31, ob = rr * 64 + cc * 2; return st * 1024 + (ob ^ (((ob >> 9) & 1) << 5)); }
__host__ __device__ __forceinline__ void stage_rc(int b, int& R, int& C) { const int st = b / 1024, sb = b % 1024, swz = sb ^ (((sb >> 9) & 1) << 5); R = (st >> 1) * 16 + swz / 64; C = (st & 1) * 32 + (swz % 64) / 2; }
__host__ __device__ __forceinline__ int perm32(int rho) { const int n = rho >> 4, i = rho & 15; return 8 * (i >> 2) + 4 * n + (i & 3); }

struct Unit { int pm, pn; };
struct Gemm { const GAS bf16_t* A; const GAS bf16_t* Bt; int M, N, K, lda, ldb, acol; };

struct StaticOrder {
    int nM, nN, nwg, G, c;
    __device__ void init(int M, int N, int G_, int c_) { nM = M / BM; nN = N / BM; nwg = nM * nN; G = G_; c = c_; }
    __device__ bool next(int i, Unit& u) const {
        const long L = (long)i * G + c; if (L >= nwg) return false;
        int wgid = (int)L; { const int q = nwg / NXCD, r = nwg % NXCD, xcd = wgid % NXCD, off = wgid / NXCD; wgid = (xcd < r ? xcd * (q + 1) : r * (q + 1) + (xcd - r) * q) + off; }
        const int nig = WGM * nN, gid = wgid / nig, fm = gid * WGM, gsz = (nM - fm) < WGM ? (nM - fm) : WGM;
        u.pm = fm + ((wgid % nig) % gsz); u.pn = (wgid % nig) / gsz; return true;
    }
};

typedef int v8i_t __attribute__((ext_vector_type(8)));
typedef int v4i_t __attribute__((ext_vector_type(4)));
template <class Epi, bool FP8>
__device__ __forceinline__ void gemm_phase(LAS unsigned char* lds, const Gemm g, const StaticOrder& S, const Epi& E, const int tid) {
    const int wid = __builtin_amdgcn_readfirstlane(tid >> 6), lane = tid & 63, wr = wid >> 2, wc = wid & 3, fr = lane & 15, fq = lane >> 4;
    const int K = g.K, nt = K / BK;
    unsigned voffA[2], voffB[2];
#pragma unroll
    for (int i = 0; i < 2; ++i) { int R, C; stage_rc(tid * 16 + i * 8192, R, C); const int Rb = (R & ~31) + perm32(R & 31);
        voffA[i] = (unsigned)(R * g.lda + C) * 2u; voffB[i] = (unsigned)(Rb * g.ldb + C) * 2u; }
    const size_t kstep = (size_t)(BK * 2);
    const size_t hstepA = (size_t)HALF * g.lda * 2, hstepB = (size_t)HALF * g.ldb * 2;
    const size_t tstepA = 2 * hstepA, tstepB = 2 * hstepB;
    const unsigned ldsw = (unsigned)wid * 1024u;
    const int aoff = lds_byte(wr * 64 + fr, fq * 8), boff = lds_byte(wc * 32 + fr, fq * 8);
#define PG8_SA(b, h) (((b) * 2 + (h)) * HTB)
#define PG8_SB(b, h) ((4 + (b) * 2 + (h)) * HTB)
#define PG8_STAGE(bufoff, gbase, voff) do { _Pragma("unroll") for (int _i = 0; _i < 2; ++_i) \
        __builtin_amdgcn_global_load_lds((const GAS unsigned*)((gbase) + (voff)[_i]), (LAS unsigned*)(lds + (bufoff) + ldsw + _i * 8192), 16, 0, 0); } while (0)
#define PG8_LD2(dst, off_) do { const u32x4 lo_ = *(const LAS u32x4*)(lds + (off_)), hi_ = *(const LAS u32x4*)(lds + (off_) + 1024); \
        dst = (v8i_t){(int)lo_.x, (int)lo_.y, (int)lo_.z, (int)lo_.w, (int)hi_.x, (int)hi_.y, (int)hi_.z, (int)hi_.w}; } while (0)
#define PG8_LDA(dst, b, h) do { _Pragma("unroll") for (int m = 0; m < 4; ++m) PG8_LD2(dst[m], PG8_SA(b, h) + aoff + m * 2048); } while (0)
#define PG8_LDB(dst, b, h) do { _Pragma("unroll") for (int n = 0; n < 2; ++n) PG8_LD2(dst[n], PG8_SB(b, h) + boff + n * 2048); } while (0)
#define PG8_HALF(v, k) ((k) ? __builtin_shufflevector(v, v, 4, 5, 6, 7) : __builtin_shufflevector(v, v, 0, 1, 2, 3))
#define PG8_MMA(ai, bj, At, Bt) do { __builtin_amdgcn_s_setprio(1); _Pragma("unroll") for (int m = 0; m < 4; ++m) _Pragma("unroll") for (int n = 0; n < 2; ++n) { \
        if constexpr (FP8) asm volatile("v_mfma_scale_f32_16x16x128_f8f6f4 %0, %1, %2, %0, %3, %4 op_sel_hi:[0,0,0]" : "+v"(acc[ai][bj][m][n]) : "v"(Bt[n]), "v"(At[m]), "v"(sc_w), "v"(sc_x));     \
        else { _Pragma("unroll") for (int k = 0; k < 2; ++k) { const v4i_t bh_ = PG8_HALF(Bt[n], k), ah_ = PG8_HALF(At[m], k); \
                acc[ai][bj][m][n] = __builtin_amdgcn_mfma_f32_16x16x32_bf16(__builtin_bit_cast(bf16x8, bh_), __builtin_bit_cast(bf16x8, ah_), acc[ai][bj][m][n], 0, 0, 0); } } } \
        __builtin_amdgcn_s_setprio(0); } while (0)
#define PG8_WAIT_V(n) asm volatile("s_waitcnt vmcnt(" #n ")" ::: "memory")
#define PG8_WAIT_L(n) asm volatile("s_waitcnt lgkmcnt(" #n ")" ::: "memory")
#define PG8_BAR __builtin_amdgcn_s_barrier()
#define PG8_SCHED __builtin_amdgcn_sched_barrier(0)
    Unit cur, nxt; int ui = 0;
    if (!S.next(0, cur)) return;
    f32x4 acc[2][2][4][2];
#pragma unroll
    for (int a = 0; a < 2; ++a)
#pragma unroll
        for (int b = 0; b < 2; ++b)
#pragma unroll
            for (int m = 0; m < 4; ++m)
#pragma unroll
                for (int n = 0; n < 2; ++n) acc[a][b][m][n] = (f32x4){0.f, 0.f, 0.f, 0.f};
    v8i_t At[4], B0[2], B1[2];
    const int sc_w = 121, sc_x = 127;
    const GAS char* cA = (const GAS char*)g.A + (size_t)cur.pm * tstepA + (size_t)cur.pn * g.acol * 2; const GAS char* cB = (const GAS char*)g.Bt + (size_t)cur.pn * tstepB;
    PG8_STAGE(PG8_SB(0, 0), cB, voffB); PG8_STAGE(PG8_SB(0, 1), cB + hstepB, voffB); PG8_STAGE(PG8_SA(0, 0), cA, voffA); PG8_STAGE(PG8_SA(0, 1), cA + hstepA, voffA);
    if (wr == 1) PG8_BAR;
    PG8_WAIT_V(2); PG8_BAR;
    PG8_STAGE(PG8_SB(1, 0), cB + kstep, voffB); PG8_STAGE(PG8_SA(1, 0), cA + kstep, voffA); PG8_STAGE(PG8_SB(1, 1), cB + hstepB + kstep, voffB);
    PG8_WAIT_V(6); PG8_BAR;
    for (;;) {
        const bool has_next = S.next(ui + 1, nxt);
        const GAS char* nA = has_next ? (const GAS char*)g.A + (size_t)nxt.pm * tstepA + (size_t)nxt.pn * g.acol * 2 : cA; const GAS char* nB = has_next ? (const GAS char*)g.Bt + (size_t)nxt.pn * tstepB : cB;
        for (int t = 0; t < nt; t += 2) {
            const bool last = (t == nt - 2);
            const GAS char* a1 = cA + (size_t)(t + 1) * kstep;
            const GAS char* a2 = last ? nA : cA + (size_t)(t + 2) * kstep; const GAS char* b2 = last ? nB : cB + (size_t)(t + 2) * kstep;
            const GAS char* a3 = a2 + kstep; const GAS char* b3 = b2 + kstep;
            PG8_LDB(B0, 0, 0); PG8_LDB(B1, 0, 1); PG8_SCHED; PG8_LDA(At, 0, 0); PG8_STAGE(PG8_SA(1, 1), a1 + hstepA, voffA);
            PG8_WAIT_V(8); PG8_WAIT_L(0); PG8_BAR; PG8_MMA(0, 0, At, B0); PG8_MMA(0, 1, At, B1); PG8_BAR; PG8_SCHED;
            PG8_LDA(At, 0, 1); PG8_STAGE(PG8_SB(0, 0), b2, voffB); PG8_STAGE(PG8_SB(0, 1), b2 + hstepB, voffB); PG8_STAGE(PG8_SA(0, 0), a2, voffA);
            PG8_WAIT_V(8); PG8_WAIT_L(0); PG8_BAR; PG8_MMA(1, 0, At, B0); PG8_MMA(1, 1, At, B1); PG8_BAR; PG8_SCHED;
            PG8_LDB(B0, 1, 0); PG8_LDB(B1, 1, 1); PG8_SCHED; PG8_LDA(At, 1, 0); PG8_STAGE(PG8_SA(0, 1), a2 + hstepA, voffA);
            PG8_WAIT_V(8); PG8_WAIT_L(0); PG8_BAR; PG8_MMA(0, 0, At, B0); PG8_MMA(0, 1, At, B1); PG8_BAR; PG8_SCHED;
            PG8_LDA(At, 1, 1); PG8_STAGE(PG8_SB(1, 0), b3, voffB); PG8_STAGE(PG8_SB(1, 1), b3 + hstepB, voffB); PG8_STAGE(PG8_SA(1, 0), a3, voffA);
            PG8_WAIT_V(8); PG8_WAIT_L(0); PG8_BAR; PG8_MMA(1, 0, At, B0); PG8_MMA(1, 1, At, B1); PG8_BAR; PG8_SCHED;
        }
        if (wr == 0) PG8_BAR;
        { int ln_; asm volatile("v_mbcnt_lo_u32_b32 %0, -1, 0\n\tv_mbcnt_hi_u32_b32 %0, -1, %0" : "=v"(ln_));
          E(acc, cur, wr, wc, ln_ & 15, ln_ >> 4); }
        if (!has_next) break;
#pragma unroll
        for (int a = 0; a < 2; ++a)
#pragma unroll
            for (int b = 0; b < 2; ++b)
#pragma unroll
                for (int m = 0; m < 4; ++m)
#pragma unroll
                    for (int n = 0; n < 2; ++n) acc[a][b][m][n] = (f32x4){0.f, 0.f, 0.f, 0.f};
        cur = nxt; cA = nA; cB = nB; ++ui;
        if (wr == 1) PG8_BAR;
    }
    PG8_WAIT_V(0);
    PG8_BAR;
#undef PG8_SA
#undef PG8_SB
#undef PG8_STAGE
#undef PG8_LDA
#undef PG8_LDB
#undef PG8_LD2
#undef PG8_HALF
#undef PG8_MMA
#undef PG8_WAIT_V
#undef PG8_WAIT_L
#undef PG8_BAR
#undef PG8_SCHED
}
}

enum { EM_IN0 = 0, EM_MKV = 1, EM_GATE = 2, EM_RES = 3, EM_PQ = 4, EM_L1 = 5 };
struct Epi {
    int mode;
    GAS unsigned char* ws;
    const GAS float* resid;
    GAS float* outf;
    GAS bf16_t* o16;
    GAS float* ssq;
    const GAS float* gate_b;
    typedef pg8::Unit Unit;
    __device__ __forceinline__ static void st8(GAS bf16_t* p, f32x4 v0, f32x4 v1) {
        u32x4 w; w.x = cvtpk(v0[0], v0[1]); w.y = cvtpk(v0[2], v0[3]); w.z = cvtpk(v1[0], v1[1]); w.w = cvtpk(v1[2], v1[3]); *(GAS u32x4*)p = w; }
    __device__ __forceinline__ static float sq8(f32x4 a, f32x4 b) { return (a[0] * a[0] + a[1] * a[1]) + (a[2] * a[2] + a[3] * a[3]) + (b[0] * b[0] + b[1] * b[1]) + (b[2] * b[2] + b[3] * b[3]); }
    __device__ __forceinline__ void operator()(f32x4 (&acc)[2][2][4][2], const Unit& u, int wr, int wc, int fr, int fq) const {
        const int row0 = u.pm * 256 + wr * 64 + fr;
        const int cin = wc * 32 + 8 * fq;
        if (mode == EM_IN0) {
            GAS bf16_t* base; int ld, colt; int kind;
            if (u.pn < 6) { base = (GAS bf16_t*)(ws + O_ZX); ld = LRU; colt = u.pn * 256; kind = 0; }
            else if (u.pn < 12) { base = (GAS bf16_t*)(ws + O_GY); ld = LRU; colt = (u.pn - 6) * 256; kind = 1; }
            else { base = (GAS bf16_t*)(ws + O_ZL1); ld = NL1; colt = 4608 + (u.pn - 12) * 256; kind = 2; }
            GAS float* qmss = (GAS float*)(ws + O_SSL1);
#pragma unroll
            for (int ai = 0; ai < 2; ++ai)
#pragma unroll
                for (int m = 0; m < 4; ++m) { const int row = row0 + ai * 128 + m * 16;
#pragma unroll
                    for (int bj = 0; bj < 2; ++bj) { f32x4 v0 = acc[ai][bj][m][0], v1 = acc[ai][bj][m][1];
                        if (kind == 1) {
#pragma unroll
                            for (int j = 0; j < 4; ++j) { v0[j] = gelu_tanh(v0[j]); v1[j] = gelu_tanh(v1[j]); } }
                        st8(base + (size_t)row * ld + colt + bj * 128 + cin, v0, v1);
                        if (kind == 2) { float s = sq8(v0, v1); s = xsum16(s); s = xsum32(s);
                            if (fq == 0) qmss[(size_t)row * 112 + (24 + (u.pn - 12) * 2 + bj) * 4 + wc] = s; } } }
        } else if (mode == EM_MKV) {
#pragma unroll
            for (int ai = 0; ai < 2; ++ai)
#pragma unroll
                for (int m = 0; m < 4; ++m) { const int row = row0 + ai * 128 + m * 16;
#pragma unroll
                    for (int bj = 0; bj < 2; ++bj) { const f32x4 v0 = acc[ai][bj][m][0], v1 = acc[ai][bj][m][1];
                        st8(o16 + (size_t)row * NL1 + u.pn * 256 + bj * 128 + cin, v0, v1);
                        if (u.pn < 2) { float s = sq8(v0, v1); s = xsum16(s); s = xsum32(s);
                            if (fq == 0) ssq[(size_t)row * 112 + (u.pn * 2 + bj) * 4 + wc] = s; } } }
        } else if (mode == EM_GATE) {
            const int ch = u.pn * 128 + cin;
            const GAS bf16_t* xc = (const GAS bf16_t*)(ws + O_XC); GAS _Float16* LA = (GAS _Float16*)(ws + O_AA); GAS _Float16* UH = (GAS _Float16*)(ws + O_UU);
            const GAS float* spl = (const GAS float*)(ws + O_SPL) + ch; const GAS float* gb = gate_b + u.pn * 256 + cin;
#pragma unroll
            for (int n = 0; n < 2; ++n) {
                const f32x4 sp = *(const GAS f32x4*)(spl + 4 * n), br = *(const GAS f32x4*)(gb + 4 * n), bi = *(const GAS f32x4*)(gb + 128 + 4 * n);
#pragma unroll
                for (int ai = 0; ai < 2; ++ai)
#pragma unroll
                    for (int m = 0; m < 4; ++m) { const int row = row0 + ai * 128 + m * 16;
                        const u32x2 xw = *(const GAS u32x2*)(xc + (size_t)row * LRU + ch + 4 * n);
                        const f32x4 xv = {bf_lo(xw.x), bf_hi(xw.x), bf_lo(xw.y), bf_hi(xw.y)};
                        float lav[4], uvv[4];
#pragma unroll
                        for (int j = 0; j < 4; ++j) { const float r = sigmoidf_(acc[ai][0][m][n][j] + br[j]), ig = sigmoidf_(acc[ai][1][m][n][j] + bi[j]);
                            const float la = -8.f * r * sp[j];
                            lav[j] = la; uvv[j] = __builtin_amdgcn_sqrtf(one_minus_exp(2.f * la)) * (ig * xv[j]); }
                        { const h2 l0 = {(_Float16)lav[0], (_Float16)lav[1]}, l1 = {(_Float16)lav[2], (_Float16)lav[3]}, u0 = {(_Float16)uvv[0], (_Float16)uvv[1]}, u1 = {(_Float16)uvv[2], (_Float16)uvv[3]};
                          *(GAS u32x2*)(LA + (size_t)row * LRU + ch + 4 * n) = (u32x2){__builtin_bit_cast(unsigned, l0), __builtin_bit_cast(unsigned, l1)};
                          *(GAS u32x2*)(UH + (size_t)row * LRU + ch + 4 * n) = (u32x2){__builtin_bit_cast(unsigned, u0), __builtin_bit_cast(unsigned, u1)}; } }
            }
        } else if (mode == EM_RES) {
            GAS bf16_t* xs = (GAS bf16_t*)(ws + O_XS16); GAS float* rowss = (GAS float*)(ws + O_ROWSS);
#pragma unroll
            for (int ai = 0; ai < 2; ++ai)
#pragma unroll
                for (int m = 0; m < 4; ++m) { const int row = row0 + ai * 128 + m * 16; float s = 0.f;
#pragma unroll
                    for (int bj = 0; bj < 2; ++bj) { const size_t off = (size_t)row * DM + u.pn * 256 + bj * 128 + cin;
                        f32x4 r0, r1;
                        if (resid) { r0 = *(const GAS f32x4*)(resid + off); r1 = *(const GAS f32x4*)(resid + off + 4); }
                        else { const u32x4 w = *(const GAS u32x4*)(xs + off); r0 = (f32x4){bf_lo(w.x), bf_hi(w.x), bf_lo(w.y), bf_hi(w.y)}; r1 = (f32x4){bf_lo(w.z), bf_hi(w.z), bf_lo(w.w), bf_hi(w.w)}; }
                        const f32x4 v0 = acc[ai][bj][m][0] + r0, v1 = acc[ai][bj][m][1] + r1;
                        st8(xs + off, v0, v1); s += sq8(v0, v1); }
                    s = xsum16(s); s = xsum32(s);
                    if (fq == 0) rowss[(size_t)row * 32 + u.pn * 4 + wc] = s; }
        } else if (mode == EM_PQ) {
            const GAS float* rowss = (const GAS float*)(ws + O_ROWSS);
#pragma unroll
            for (int ai = 0; ai < 2; ++ai)
#pragma unroll
                for (int m = 0; m < 4; ++m) { const int row = row0 + ai * 128 + m * 16;
                    const f32x4 p0 = *(const GAS f32x4*)(rowss + (size_t)row * 32 + fq * 8), p1 = *(const GAS f32x4*)(rowss + (size_t)row * 32 + fq * 8 + 4);
                    float s = (p0[0] + p0[1]) + (p0[2] + p0[3]) + (p1[0] + p1[1]) + (p1[2] + p1[3]); s = xsum16(s); s = xsum32(s);
                    const float r = rsqrtf(s * (1.f / DM) + EPS);
#pragma unroll
                    for (int bj = 0; bj < 2; ++bj) st8(o16 + (size_t)row * DM + u.pn * 256 + bj * 128 + cin, acc[ai][bj][m][0] * r, acc[ai][bj][m][1] * r); }
        } else {
            const GAS float* rsp = (const GAS float*)(ws + O_RSP); GAS bf16_t* zl1 = (GAS bf16_t*)(ws + O_ZL1); GAS float* ssl1 = (GAS float*)(ws + O_SSL1);
            const int slot0 = u.pn < 6 ? u.pn * 2 : (u.pn >= 12 ? 12 + (u.pn - 12) * 2 : -1);
#pragma unroll
            for (int ai = 0; ai < 2; ++ai)
#pragma unroll
                for (int m = 0; m < 4; ++m) { const int row = row0 + ai * 128 + m * 16;
                    const f32x4 q0 = *(const GAS f32x4*)(rsp + (size_t)row * 8), q1 = *(const GAS f32x4*)(rsp + (size_t)row * 8 + 4);
                    const float r = rsqrtf(((q0[0] + q0[1]) + (q0[2] + q0[3]) + (q1[0] + q1[1]) + (q1[2] + q1[3])) * (1.f / DM) + EPS);
#pragma unroll
                    for (int bj = 0; bj < 2; ++bj) { const f32x4 v0 = acc[ai][bj][m][0] * r, v1 = acc[ai][bj][m][1] * r;
                        st8(zl1 + (size_t)row * NL1 + u.pn * 256 + bj * 128 + cin, v0, v1);
                        if (slot0 >= 0) { float s = sq8(v0, v1); s = xsum16(s); s = xsum32(s);
                            if (fq == 0) ssl1[(size_t)row * 112 + (slot0 + bj) * 4 + wc] = s; } } }
        }
    }
};

namespace att {
constexpr float SCALE = 0.08838834764831845f;
constexpr int NW = 8, QBLK = 32, KVBLK = 64, QB = NW * QBLK, D = 128;
constexpr int SHM_V = KVBLK * D * 2, SHM_K = KVBLK * D * 2;
constexpr int OFF_WS = 2 * SHM_V + 2 * SHM_K;
constexpr int OFF_KS = OFF_WS + 2048;
constexpr int OFF_BS = OFF_KS + 16384;
constexpr int LDS_END = OFF_BS + 16384;
constexpr int WBIG = 1 << 28;

#define KSWZ(row, colB) ((row) * 256 + ((colB) ^ (((row) & 7) << 4)))
#define SBAR() __builtin_amdgcn_sched_barrier(0)
__device__ __forceinline__ int v_st(int k, int c) { const int kk = (k & ~0xC) | ((k & 4) << 1) | ((k & 8) >> 1); return ((kk >> 3) * 4 + (c >> 5)) * 512 + ((kk & 7) * 32 + (c & 31)) * 2; }
__device__ __forceinline__ int v_rd_base(int lane) { return ((lane & 3) << 3) | (((lane >> 2) & 3) << 6) | (((lane >> 4) & 1) << 5) | (((lane >> 5) & 1) << 8); }
constexpr int v_rd_off(int d0, int ks, int half) { return d0 * 512 + ks * 4096 + half * 2048; }
__device__ __forceinline__ int crow(int r, int hi) { return (r & 3) + 8 * (r >> 2) + 4 * hi; }
__device__ __forceinline__ bf16x8 load8(const GAS bf16_t* p) { return *(const GAS bf16x8*)p; }
__device__ __forceinline__ bf16x8 scale8(bf16x8 v, float s) { const u32x4 w = *reinterpret_cast<u32x4*>(&v); u32x4 o;
    o.x = cvtpk(bf_lo(w.x) * s, bf_hi(w.x) * s); o.y = cvtpk(bf_lo(w.y) * s, bf_hi(w.y) * s); o.z = cvtpk(bf_lo(w.z) * s, bf_hi(w.z) * s); o.w = cvtpk(bf_lo(w.w) * s, bf_hi(w.w) * s);
    return *reinterpret_cast<bf16x8*>(&o); }
__device__ __forceinline__ void mask_tile(f32x16& p0, f32x16& p1, int dq, unsigned W) {
    const float NEG = -__builtin_inff();
#pragma unroll
    for (int r = 0; r < 16; ++r) {
        const int c = (r & 3) + 8 * (r >> 2);
        if ((unsigned)(dq - c) >= W) p0[r] = NEG;
        if ((unsigned)(dq - c - 32) >= W) p1[r] = NEG;
    }
}
constexpr float THR = 8.f;
__device__ __forceinline__ void partialSM(f32x16& p0, f32x16& p1, float& m_reg, float& mn, float& alpha) {
    float pmax = p0[0]; for (int r = 1; r < 16; ++r) pmax = fmaxf(pmax, p0[r]); for (int r = 0; r < 16; ++r) pmax = fmaxf(pmax, p1[r]);
    { auto rr = __builtin_amdgcn_permlane32_swap(__float_as_uint(pmax), __float_as_uint(pmax), false, false);
      pmax = fmaxf(__uint_as_float(rr[0]), __uint_as_float(rr[1])); }
    constexpr float C2 = 1.4426950408889634f * SCALE;
    if (__builtin_expect(__all((pmax - m_reg) * SCALE <= THR), 1)) { mn = m_reg; alpha = 1.f; }
    else { mn = fmaxf(m_reg, pmax); alpha = __builtin_amdgcn_exp2f((m_reg - mn) * C2); m_reg = mn; }
    const float mnL = -mn * C2;
    for (int r = 0; r < 16; ++r) p0[r] = fmaf(p0[r], C2, mnL); for (int r = 0; r < 16; ++r) p1[r] = fmaf(p1[r], C2, mnL);
    for (int r = 0; r < 16; ++r) p0[r] = __builtin_amdgcn_exp2f(p0[r]);
}
__device__ __forceinline__ void finishSM(f32x16& p0, f32x16& p1, float alpha, float& l_reg, bf16x8& pa0, bf16x8& pa1, bf16x8& pa2, bf16x8& pa3) {
    for (int r = 0; r < 16; ++r) p1[r] = __builtin_amdgcn_exp2f(p1[r]);
    float ps = 0; for (int r = 0; r < 16; ++r) ps += p0[r]; for (int r = 0; r < 16; ++r) ps += p1[r];
    { auto rr = __builtin_amdgcn_permlane32_swap(__float_as_uint(ps), __float_as_uint(ps), false, false);
      ps = __uint_as_float(rr[0]) + __uint_as_float(rr[1]); }
    l_reg = l_reg * alpha + ps;
#define PK4(P, B_, OUT) do { unsigned a0 = cvtpk(P[B_+0], P[B_+1]), a1 = cvtpk(P[B_+2], P[B_+3]);                          \
        unsigned b0 = cvtpk(P[B_+4], P[B_+5]), b1 = cvtpk(P[B_+6], P[B_+7]);                                             \
        auto r0 = __builtin_amdgcn_permlane32_swap(a0, b0, false, false); auto r1 = __builtin_amdgcn_permlane32_swap(a1, b1, false, false); \
        u32x4 w = {r0[0], r1[0], r0[1], r1[1]}; OUT = *reinterpret_cast<bf16x8*>(&w); } while (0)
    PK4(p0, 0, pa0); PK4(p0, 8, pa1); PK4(p1, 0, pa2); PK4(p1, 8, pa3);
#undef PK4
}
template <int KB>
__device__ __forceinline__ void qkt(f32x16& p0, f32x16& p1, const char* K_lds, int r32, int hi, const bf16x8* qr, const float* bp  ) {
    { const f32x4 a = *(const f32x4*)(bp), b = *(const f32x4*)(bp + 8), c = *(const f32x4*)(bp + 16), d = *(const f32x4*)(bp + 24);
      p0 = (f32x16){a[0], a[1], a[2], a[3], b[0], b[1], b[2], b[3], c[0], c[1], c[2], c[3], d[0], d[1], d[2], d[3]}; }
    { const f32x4 a = *(const f32x4*)(bp + 32), b = *(const f32x4*)(bp + 40), c = *(const f32x4*)(bp + 48), d = *(const f32x4*)(bp + 56);
      p1 = (f32x16){a[0], a[1], a[2], a[3], b[0], b[1], b[2], b[3], c[0], c[1], c[2], c[3], d[0], d[1], d[2], d[3]}; }
    const char* kb[4];
#pragma unroll
    for (int dd = 0; dd < 4; ++dd) kb[dd] = K_lds + KB * SHM_K + KSWZ(r32, (dd * 16 + hi * 8) * 2);
#pragma unroll
    for (int d0 = 0; d0 < 8; ++d0) { const char* a = kb[d0 & 3] + (d0 >> 2) * 128;
        bf16x8 b0 = *reinterpret_cast<const bf16x8*>(a);
        bf16x8 b1 = *reinterpret_cast<const bf16x8*>(a + 32 * 256);
        p0 = __builtin_amdgcn_mfma_f32_32x32x16_bf16(b0, qr[d0], p0, 0, 0, 0);
        p1 = __builtin_amdgcn_mfma_f32_32x32x16_bf16(b1, qr[d0], p1, 0, 0, 0); }
}
template <int KB>
__device__ __forceinline__ void qkt0(f32x16& p0, f32x16& p1, const char* K_lds, int r32, int hi, const bf16x8* qr) {
    p0 = f32x16{}; p1 = f32x16{};
    const char* kb[4];
#pragma unroll
    for (int dd = 0; dd < 4; ++dd) kb[dd] = K_lds + KB * SHM_K + KSWZ(r32, (dd * 16 + hi * 8) * 2);
#pragma unroll
    for (int d0 = 0; d0 < 8; ++d0) { const char* a = kb[d0 & 3] + (d0 >> 2) * 128;
        bf16x8 b0 = *reinterpret_cast<const bf16x8*>(a);
        bf16x8 b1 = *reinterpret_cast<const bf16x8*>(a + 32 * 256);
        p0 = __builtin_amdgcn_mfma_f32_32x32x16_bf16(b0, qr[d0], p0, 0, 0, 0);
        p1 = __builtin_amdgcn_mfma_f32_32x32x16_bf16(b1, qr[d0], p1, 0, 0, 0); }
}
template <int VB>
__device__ __forceinline__ void pv_tile(f32x16* o, int vb0, bf16x8 pa0, bf16x8 pa1, bf16x8 pa2, bf16x8 pa3) {
#define TRRD(dst, off) asm volatile("ds_read_b64_tr_b16 %0, %1 offset:%2" : "=&v"(dst) : "v"(vb0), "i"(off) : "memory")
#define PV_D0(d0) do { s16x4 l0, l1, l2, l3, h0, h1, h2_, h3; constexpr int b_ = VB * SHM_V + v_rd_off(d0, 0, 0); \
        TRRD(l0, b_); TRRD(h0, b_ + 2048); TRRD(l1, b_ + 4096); TRRD(h1, b_ + 6144); TRRD(l2, b_ + 8192); TRRD(h2_, b_ + 10240); TRRD(l3, b_ + 12288); TRRD(h3, b_ + 14336); \
        asm volatile("s_waitcnt lgkmcnt(0)" ::: "memory"); SBAR();   \
        o[d0] = __builtin_amdgcn_mfma_f32_32x32x16_bf16(pa0, (bf16x8){l0[0], l0[1], l0[2], l0[3], h0[0], h0[1], h0[2], h0[3]}, o[d0], 0, 0, 0);   \
        o[d0] = __builtin_amdgcn_mfma_f32_32x32x16_bf16(pa1, (bf16x8){l1[0], l1[1], l1[2], l1[3], h1[0], h1[1], h1[2], h1[3]}, o[d0], 0, 0, 0);   \
        o[d0] = __builtin_amdgcn_mfma_f32_32x32x16_bf16(pa2, (bf16x8){l2[0], l2[1], l2[2], l2[3], h2_[0], h2_[1], h2_[2], h2_[3]}, o[d0], 0, 0, 0);   \
        o[d0] = __builtin_amdgcn_mfma_f32_32x32x16_bf16(pa3, (bf16x8){l3[0], l3[1], l3[2], l3[3], h3[0], h3[1], h3[2], h3[3]}, o[d0], 0, 0, 0); } while (0)
    PV_D0(0); PV_D0(1); PV_D0(2); PV_D0(3);
#undef PV_D0
#undef TRRD
}

struct BlockRef { const GAS bf16_t* Q; const GAS bf16_t* K; const GAS bf16_t* V; GAS bf16_t* O; const GAS float* qss; const GAS float* kss; const GAS float* cc; const GAS float* gg;
                  int P0, skv; };
constexpr int LDQ = 5120, LDK = 5120, LDO = 2048, LDSS = 112;
struct Seam { bf16x8 qr[8]; bf16x8 st_v0, st_v1, st_k0, st_k1; int jlo; };
#define ROWK(p, k0, rr) ((p) + (size_t)((k0) + (rr)) * LDK + sc)
#define VMW() asm volatile("s_waitcnt vmcnt(0)" ::: "memory")
#define VMWN(n) asm volatile("s_waitcnt vmcnt(%0)" :: "i"(n) : "memory")
#define SLOAD_H(Kp, Vp, k0) do { S.st_v0 = load8(ROWK(Vp, k0, sr)); S.st_v1 = load8(ROWK(Vp, k0, 32 + sr));              \
                         S.st_k0 = load8(ROWK(Kp, k0, sr)); S.st_k1 = load8(ROWK(Kp, k0, 32 + sr)); } while (0)
#define SWRITE_HK(bf, k0) do { *(bf16x8*)(K_lds + (bf) * SHM_K + kws) = scale8(S.st_k0, ksr[(k0)]); *(bf16x8*)(K_lds + (bf) * SHM_K + kws + 32 * 256) = scale8(S.st_k1, ksr[(k0) + 32]); } while (0)
#define SWRITE_HV(bf) do { *(bf16x8*)(V_lds + (bf) * SHM_V + vst0) = S.st_v0; *(bf16x8*)(V_lds + (bf) * SHM_V + vst1) = S.st_v1; } while (0)
#define SWRITE_H(bf, k0) do { SWRITE_HV(bf); SWRITE_HK(bf, k0); } while (0)

__device__ __forceinline__ void attn_prime(const BlockRef& cur, char* lds, Seam& S, const int tid) {
    const int wid = __builtin_amdgcn_readfirstlane(tid >> 6), lane = tid & 63, r32 = lane & 31, hi = lane >> 5;
    const int sr = tid >> 4, sc = (tid & 15) * 8, kws = KSWZ(sr, sc * 2); char* K_lds = lds + 2 * SHM_V;
    float* ks_l = (float*)(lds + OFF_KS); float* bs_l = (float*)(lds + OFF_BS); const float* ksr = ks_l + sr;
    int j_hi = (cur.P0 + QB - 1) / KVBLK + 1; if (j_hi > cur.skv / KVBLK) j_hi = cur.skv / KVBLK;
    const int nkeys = j_hi * KVBLK;
    const float c0 = cur.cc ? cur.cc[cur.P0] : 0.f;
    int jlo = 0;
    if (cur.cc) { const float thr = cur.gg[128]; const int jd = cur.P0 / KVBLK;
        const float cv = lane <= jd ? cur.cc[lane * KVBLK + KVBLK - 1] : 0.f;
        const bool keep = lane > jd || (c0 - cv > -thr);
        jlo = __ffsll((long long)__ballot(keep)) - 1; }
    S.jlo = jlo;
    for (int s = jlo * KVBLK + tid; s < nkeys; s += NTHREADS) {
        const f32x4 p = *(const GAS f32x4*)(cur.kss + (size_t)s * LDSS);
        ks_l[s] = rsqrtf(((p[0] + p[1]) + (p[2] + p[3])) * (1.f / 128.f) + EPS);
        bs_l[s] = cur.cc ? (c0 - cur.cc[s]) * (1.f / SCALE) : 0.f;
    }
    __syncthreads();
    const int qrow = wid * QBLK + r32;
    const f32x4 qp = *(const GAS f32x4*)(cur.qss + (size_t)qrow * LDSS);
    const float rq = rsqrtf(((qp[0] + qp[1]) + (qp[2] + qp[3])) * (1.f / 128.f) + EPS);
#pragma unroll
    for (int d0 = 0; d0 < 8; ++d0) {
        const u32x4 w = *(const GAS u32x4*)(cur.Q + (size_t)qrow * LDQ + d0 * 16 + hi * 8);
        const f32x4 g0 = *(const GAS f32x4*)(cur.gg + d0 * 16 + hi * 8), g1 = *(const GAS f32x4*)(cur.gg + d0 * 16 + hi * 8 + 4);
        u32x4 o; o.x = cvtpk(bf_lo(w.x) * rq * g0[0], bf_hi(w.x) * rq * g0[1]); o.y = cvtpk(bf_lo(w.y) * rq * g0[2], bf_hi(w.y) * rq * g0[3]);
        o.z = cvtpk(bf_lo(w.z) * rq * g1[0], bf_hi(w.z) * rq * g1[1]); o.w = cvtpk(bf_lo(w.w) * rq * g1[2], bf_hi(w.w) * rq * g1[3]);
        S.qr[d0] = *reinterpret_cast<bf16x8*>(&o);
    }
    SLOAD_H(cur.K, cur.V, jlo * KVBLK); VMW(); SWRITE_HK(0, jlo * KVBLK);
    __syncthreads();
}
__device__ __forceinline__ void attn_block(const BlockRef& cur, char* lds, Seam& S, const int tid) {
    const int wid = __builtin_amdgcn_readfirstlane(tid >> 6), lane = tid & 63, r32 = lane & 31, hi = lane >> 5;
    const int W = WBIG;
    int j_hi = (cur.P0 + QB - 1) / KVBLK + 1; if (j_hi > cur.skv / KVBLK) j_hi = cur.skv / KVBLK;
    const int j_lo = S.jlo; const int NT = j_hi - j_lo;
    const int qlo = cur.P0 - j_lo * KVBLK + wid * QBLK, qm = qlo + r32 - 4 * hi;
    char* V_lds = lds; char* K_lds = lds + 2 * SHM_V;
    float* ws = (float*)(lds + OFF_WS) + wid * 64; float* li_l = ws, * al_l = ws + 32;
    const float* bs_l = (const float*)(lds + OFF_BS) + j_lo * KVBLK + 4 * hi;
    float m_reg = -1e30f, l_reg = 0; f32x16 o[4] = {};
    const int sr = tid >> 4, sc = (tid & 15) * 8, vst0 = v_st(sr, sc), vst1 = v_st(32 + sr, sc), kws = KSWZ(sr, sc * 2);
    const float* ksr = (const float*)(lds + OFF_KS) + j_lo * KVBLK + sr;
    const int vb0 = (int)(uintptr_t)V_lds + v_rd_base(lane);
    const GAS bf16_t* Kh = cur.K + (size_t)j_lo * KVBLK * LDK; const GAS bf16_t* Vh = cur.V + (size_t)j_lo * KVBLK * LDK;
#define RESC(a) do { if (__any((a) < 1.f)) { if (hi == 0) al_l[r32] = (a); asm volatile("s_waitcnt lgkmcnt(0)" ::: "memory");              \
                     for (int d_ = 0; d_ < 4; ++d_) for (int r = 0; r < 16; ++r) o[d_][r] *= al_l[crow(r, hi)]; } } while (0)
#define KBASE(t) ((t) * KVBLK)
#define MASKT(P0_, P1_, t) do { const int kb_ = KBASE(t); if (kb_ + KVBLK - 1 > qlo) mask_tile(P0_, P1_, qm - kb_, (unsigned)W); } while (0)
    f32x16 pA0, pA1, pB0, pB1; float mnA, mnB, alA, alB; bf16x8 pa0, pa1, pa2, pa3;
    SWRITE_HV(0); SBAR();
    if (NT > 1) { SLOAD_H(Kh, Vh, KBASE(1)); }
    SBAR(); qkt<0>(pA0, pA1, K_lds, r32, hi, S.qr, bs_l + KBASE(0));
    MASKT(pA0, pA1, 0); partialSM(pA0, pA1, m_reg, mnA, alA);
    if (NT > 1) { VMW(); SWRITE_H(1, KBASE(1)); }
    __syncthreads();
#define HALF_STEP(PX0, PX1, mnX, alX, PY0, PY1, alY, t, KB, VB, SB) do {                                                      \
        SBAR(); qkt<KB>(PX0, PX1, K_lds, r32, hi, S.qr, bs_l + KBASE(t));                                                         \
        finishSM(PY0, PY1, alY, l_reg, pa0, pa1, pa2, pa3); SBAR();                                                           \
        if ((t) + 1 < NT) { SLOAD_H(Kh, Vh, KBASE((t) + 1)); SBAR(); }                                               \
        pv_tile<VB>(o, vb0, pa0, pa1, pa2, pa3); MASKT(PX0, PX1, (t)); partialSM(PX0, PX1, m_reg, mnX, alX);                                        \
        __syncthreads();                                                                                                      \
        if ((t) + 1 < NT) { VMW(); SWRITE_H(SB, KBASE((t) + 1)); }                                                                          \
        RESC(alX); __syncthreads(); } while (0)
    for (int t = 1; t + 1 < NT; t += 2) {
        HALF_STEP(pB0, pB1, mnB, alB, pA0, pA1, alA, t, 1, 0, 0);
        HALF_STEP(pA0, pA1, mnA, alA, pB0, pB1, alB, t + 1, 0, 1, 1);
    }
    const bool even = (NT & 1) == 0;
    if (even) { SBAR(); qkt<1>(pB0, pB1, K_lds, r32, hi, S.qr, bs_l + KBASE(NT - 1)); SBAR(); }
    finishSM(pA0, pA1, alA, l_reg, pa0, pa1, pa2, pa3); SBAR();
    pv_tile<0>(o, vb0, pa0, pa1, pa2, pa3);
    if (even) { MASKT(pB0, pB1, NT - 1); partialSM(pB0, pB1, m_reg, mnB, alB); __syncthreads(); RESC(alB);
        finishSM(pB0, pB1, alB, l_reg, pa0, pa1, pa2, pa3); SBAR(); pv_tile<1>(o, vb0, pa0, pa1, pa2, pa3); }
    SBAR();
    if (hi == 0) li_l[r32] = l_reg; asm volatile("s_waitcnt lgkmcnt(0)" ::: "memory");
    float rli[16];
#pragma unroll
    for (int r = 0; r < 16; ++r) rli[r] = __builtin_amdgcn_rcpf(li_l[crow(r, hi)]);
    GAS bf16_t* Ow = cur.O + (size_t)(wid * QBLK) * LDO;
#pragma unroll
    for (int r = 0; r < 16; ++r) { const int orow = crow(r, hi);
#pragma unroll
        for (int d0 = 0; d0 < 4; ++d0) { const float v = o[d0][r] * rli[r];
            const float vn = dppf<0xB1>(v);
            if ((r32 & 1) == 0) *(GAS unsigned*)(Ow + (size_t)orow * LDO + d0 * 32 + r32) = cvtpk(v, vn); } }
    __syncthreads();
#undef RESC
#undef KBASE
#undef MASKT
#undef HALF_STEP
}
constexpr int MOFF_K = 4 * SHM_V, MOFF_WS = MOFF_K + 4 * SHM_K, MOFF_KS = MOFF_WS + 2048;
__device__ __forceinline__ void mem_attn_unit(const BlockRef& cur, char* lds, const int tid) {
    const int wid = __builtin_amdgcn_readfirstlane(tid >> 6), lane = tid & 63, r32 = lane & 31, hi = lane >> 5;
    const int sr = tid >> 4, sc = (tid & 15) * 8, kws = KSWZ(sr, sc * 2), vst0 = v_st(sr, sc), vst1 = v_st(32 + sr, sc);
    char* V_lds = lds; char* K_lds = lds + MOFF_K; float* ks_l = (float*)(lds + MOFF_KS);
    float* ws = (float*)(lds + MOFF_WS) + wid * 64; float* li_l = ws, * al_l = ws + 32;
    float ksv = 0.f;
    if (tid < 256) { const f32x4 p = *(const GAS f32x4*)(cur.kss + (size_t)tid * LDSS); ksv = rsqrtf(((p[0] + p[1]) + (p[2] + p[3])) * (1.f / 128.f) + EPS); }
    bf16x8 kk[4][2], vv[4][2];
#pragma unroll
    for (int t = 0; t < 4; ++t) { kk[t][0] = load8(ROWK(cur.K, t * KVBLK, sr)); kk[t][1] = load8(ROWK(cur.K, t * KVBLK, 32 + sr)); vv[t][0] = load8(ROWK(cur.V, t * KVBLK, sr)); vv[t][1] = load8(ROWK(cur.V, t * KVBLK, 32 + sr)); }
    const int qrow = wid * QBLK + r32;
    const f32x4 qp = *(const GAS f32x4*)(cur.qss + (size_t)qrow * LDSS);
    u32x4 qw[8];
#pragma unroll
    for (int d0 = 0; d0 < 8; ++d0) qw[d0] = *(const GAS u32x4*)(cur.Q + (size_t)qrow * LDQ + d0 * 16 + hi * 8);
    if (tid < 256) ks_l[tid] = ksv;
    __syncthreads();
#pragma unroll
    for (int t = 0; t < 4; ++t) { *(bf16x8*)(K_lds + t * SHM_K + kws) = scale8(kk[t][0], ks_l[t * KVBLK + sr]); *(bf16x8*)(K_lds + t * SHM_K + kws + 32 * 256) = scale8(kk[t][1], ks_l[t * KVBLK + 32 + sr]);
        *(bf16x8*)(V_lds + t * SHM_V + vst0) = vv[t][0]; *(bf16x8*)(V_lds + t * SHM_V + vst1) = vv[t][1]; }
    const float rq = rsqrtf(((qp[0] + qp[1]) + (qp[2] + qp[3])) * (1.f / 128.f) + EPS);
    bf16x8 qr[8];
#pragma unroll
    for (int d0 = 0; d0 < 8; ++d0) { const u32x4 w = qw[d0];
        const f32x4 g0 = *(const GAS f32x4*)(cur.gg + d0 * 16 + hi * 8), g1 = *(const GAS f32x4*)(cur.gg + d0 * 16 + hi * 8 + 4);
        u32x4 o; o.x = cvtpk(bf_lo(w.x) * rq * g0[0], bf_hi(w.x) * rq * g0[1]); o.y = cvtpk(bf_lo(w.y) * rq * g0[2], bf_hi(w.y) * rq * g0[3]);
        o.z = cvtpk(bf_lo(w.z) * rq * g1[0], bf_hi(w.z) * rq * g1[1]); o.w = cvtpk(bf_lo(w.w) * rq * g1[2], bf_hi(w.w) * rq * g1[3]);
        qr[d0] = *reinterpret_cast<bf16x8*>(&o); }
    __syncthreads();
    const int vb0 = (int)(uintptr_t)V_lds + v_rd_base(lane);
    float m_reg = -1e30f, l_reg = 0; f32x16 o[4] = {};
#define MEM_TILE(t) do { f32x16 p0, p1; float mn, al; bf16x8 pa0, pa1, pa2, pa3; \
        qkt0<t>(p0, p1, K_lds, r32, hi, qr); partialSM(p0, p1, m_reg, mn, al); \
        if (__any(al < 1.f)) { if (hi == 0) al_l[r32] = al; asm volatile("s_waitcnt lgkmcnt(0)" ::: "memory"); for (int d_ = 0; d_ < 4; ++d_) for (int r = 0; r < 16; ++r) o[d_][r] *= al_l[crow(r, hi)]; } \
        finishSM(p0, p1, al, l_reg, pa0, pa1, pa2, pa3); SBAR(); pv_tile<t>(o, vb0, pa0, pa1, pa2, pa3); SBAR(); } while (0)
    MEM_TILE(0); MEM_TILE(1); MEM_TILE(2); MEM_TILE(3);
#undef MEM_TILE
    if (hi == 0) li_l[r32] = l_reg; asm volatile("s_waitcnt lgkmcnt(0)" ::: "memory");
    float rli[16];
#pragma unroll
    for (int r = 0; r < 16; ++r) rli[r] = __builtin_amdgcn_rcpf(li_l[crow(r, hi)]);
    GAS bf16_t* Ow = cur.O + (size_t)(wid * QBLK) * LDO;
#pragma unroll
    for (int r = 0; r < 16; ++r) { const int orow = crow(r, hi);
#pragma unroll
        for (int d0 = 0; d0 < 4; ++d0) { const float v = o[d0][r] * rli[r];
            const float vn = dppf<0xB1>(v);
            if ((r32 & 1) == 0) *(GAS unsigned*)(Ow + (size_t)orow * LDO + d0 * 32 + r32) = cvtpk(v, vn); } }
    __syncthreads();
}
#undef ROWK
#undef VMW
#undef VMWN
#undef SLOAD_H
#undef SWRITE_HK
#undef SWRITE_HV
#undef SWRITE_H
#undef KSWZ
#undef SBAR
}


struct Frame {
    GAS unsigned char* ws; const float* const* in_; GAS float* out;
    __device__ __forceinline__ const GAS float* in(int i) const { return (const GAS float*)in_[i]; }
    int tid, lane, wave, gw, ngw, gtid, ngt;
};
enum { I_X = 0, I_MEM, I_ANORM, I_AWIN, I_ACONVW, I_ACONVB, I_AGATEW, I_AGATEB, I_ALAMBDA, I_AWOUT, I_SNORM, I_SWKVF, I_SBF, I_SKNORM, I_BNORM, I_BWIN, I_BQNORM, I_BWOUT,
       I_MNORM, I_MWKV, I_MQNORM, I_MKNORM, I_PNORM, I_PWQ, I_PSUBK, I_PU, I_PV, N_IN };

struct TrItem { const GAS float* W; const GAS float* gain; GAS bf16_t* WT; int ldw, ldt, row_off, k0, n0; };
__device__ __forceinline__ void tr_load(const TrItem& d, float (&wv)[32], int lane) {
#pragma unroll
    for (int i = 0; i < 32; ++i) wv[i] = __builtin_nontemporal_load(d.W + (size_t)(d.k0 + 2 * i + (lane >> 5)) * d.ldw + d.n0 + (lane & 31));
}
__device__ __forceinline__ void tr_proc(const TrItem& d, float (&wv)[32], LAS float* scr, int lane) {
    if (d.gain) {
#pragma unroll
        for (int i = 0; i < 32; ++i) wv[i] *= d.gain[d.k0 + 2 * i + (lane >> 5)]; }
#pragma unroll
    for (int i = 0; i < 32; ++i) scr[(2 * i + (lane >> 5)) * 33 + (lane & 31)] = wv[i];
    asm volatile("s_waitcnt lgkmcnt(0)" ::: "memory");
    const int c = lane & 7;
#pragma unroll
    for (int j = 0; j < 4; ++j) { const int n = (lane >> 3) + 8 * j; const LAS float* s = scr + (8 * c) * 33 + n;
        u32x4 o; o.x = cvtpk(s[0 * 33], s[1 * 33]); o.y = cvtpk(s[2 * 33], s[3 * 33]); o.z = cvtpk(s[4 * 33], s[5 * 33]); o.w = cvtpk(s[6 * 33], s[7 * 33]);
        *(GAS u32x4*)(d.WT + (size_t)(d.row_off + d.n0 + n) * d.ldt + d.k0 + 8 * c) = o; }
    asm volatile("s_waitcnt lgkmcnt(0)" ::: "memory");
}
__device__ __forceinline__ void transpose_item_fp8(const GAS float* W, int ldw, const GAS float* gain, GAS unsigned char* WT, int ldt, LAS float* scr, int nblk, int item, int lane) {
    const int kb = item / nblk, nb = item % nblk, k0 = 64 * kb, n0 = 32 * nb;
    float wv[32];
#pragma unroll
    for (int i = 0; i < 32; ++i) wv[i] = W[(size_t)(k0 + 2 * i + (lane >> 5)) * ldw + n0 + (lane & 31)];
#pragma unroll
    for (int i = 0; i < 32; ++i) wv[i] *= gain[k0 + 2 * i + (lane >> 5)] * 64.f;
#pragma unroll
    for (int i = 0; i < 32; ++i) scr[(2 * i + (lane >> 5)) * 33 + (lane & 31)] = wv[i];
    asm volatile("s_waitcnt lgkmcnt(0)" ::: "memory");
    const int c = lane & 3;
#pragma unroll
    for (int j = 0; j < 2; ++j) { const int n = (lane >> 2) + 16 * j; const LAS float* sp = scr + (16 * c) * 33 + n; u32x4 o;
#pragma unroll
        for (int w = 0; w < 4; ++w) { int pk = __builtin_amdgcn_cvt_pk_fp8_f32(sp[(4 * w) * 33], sp[(4 * w + 1) * 33], 0, false); pk = __builtin_amdgcn_cvt_pk_fp8_f32(sp[(4 * w + 2) * 33], sp[(4 * w + 3) * 33], pk, true); o[w] = (unsigned)pk; }
        *(GAS u32x4*)(WT + (size_t)(n0 + n) * ldt + k0 + 16 * c) = o; }
    asm volatile("s_waitcnt lgkmcnt(0)" ::: "memory");
}
struct CtRow { f32x4 v[8]; GAS unsigned char* dst; int row, which; };
__device__ __forceinline__ void ct_load(Frame& F, int layer, int it, CtRow& R) {
    R.which = it & 1; R.row = it >> 1;
    const GAS float* src = F.in(R.which ? I_PV : I_PU) + ((size_t)layer * NEXP + R.row) * DM + F.lane * 4;
    R.dst = F.ws + O_TAB + (size_t)(layer * 2 + R.which) * TAB_ONE;
#pragma unroll
    for (int c = 0; c < 8; ++c) R.v[c] = __builtin_nontemporal_load((const GAS f32x4*)(src + c * 256));
}
__device__ __forceinline__ void ct_proc(Frame& F, int layer, CtRow& R) {
    const GAS float* gn = F.in(I_PNORM) + layer * DM + F.lane * 4;
    _Float16 shv = (_Float16)0.f;
#pragma unroll
    for (int c = 0; c < 8; ++c) { f32x4 x = R.v[c]; if (!R.which) x = x * *(const GAS f32x4*)(gn + c * 256);
        float amax = fmaxf(fmaxf(fabsf(x[0]), fabsf(x[1])), fmaxf(fabsf(x[2]), fabsf(x[3])));
        amax = wave_max(amax);
        const _Float16 sh = (_Float16)fmaxf(amax * (1.f / 6.f), 1e-6f);
        const float qs = __builtin_amdgcn_rcpf((float)sh);
        unsigned pk = __builtin_amdgcn_cvt_scalef32_pk_fp4_f32(0u, x[0] * qs, x[1] * qs, 1.0f, 0); pk = __builtin_amdgcn_cvt_scalef32_pk_fp4_f32(pk, x[2] * qs, x[3] * qs, 1.0f, 1);
        *(GAS unsigned short*)(R.dst + ((size_t)c * NEXP + R.row) * 128 + F.lane * 2) = (unsigned short)pk;
        shv = (F.lane == c) ? sh : shv; }
    if (F.lane < 8) *(GAS unsigned short*)(R.dst + TAB_NIB + ((size_t)R.row * 8 + F.lane) * 2) = __builtin_bit_cast(unsigned short, shv);
}
__device__ __forceinline__ void convert_tables(Frame& F, int layer, int ibeg, int iend, int wk, int nwk) {
    if (ibeg + wk >= iend) return;
    const int ilast = ibeg + wk + ((iend - 1 - ibeg - wk) / nwk) * nwk;
    CtRow A, B;
    ct_load(F, layer, ibeg + wk, A);
    for (int it = ibeg + wk; it < iend; it += 2 * nwk) {
        ct_load(F, layer, it + nwk <= ilast ? it + nwk : ilast, B);
        ct_proc(F, layer, A);
        ct_load(F, layer, it + 2 * nwk <= ilast ? it + 2 * nwk : ilast, A);
        if (it + nwk < iend) ct_proc(F, layer, B);
    }
}
__device__ __forceinline__ void norm_row_bf16(const GAS float* xrow, const GAS float* gain, GAS bf16_t* orow, int lane) {
    f32x4 v[8]; float s = 0.f;
#pragma unroll
    for (int j = 0; j < 8; ++j) { v[j] = *(const GAS f32x4*)(xrow + j * 256 + lane * 4); s += (v[j][0] * v[j][0] + v[j][1] * v[j][1]) + (v[j][2] * v[j][2] + v[j][3] * v[j][3]); }
    const float r = rsqrtf(wave_sum(s) * (1.f / DM) + EPS);
#pragma unroll
    for (int j = 0; j < 8; ++j) { f32x4 g = gain ? *(const GAS f32x4*)(gain + j * 256 + lane * 4) : (f32x4){1.f, 1.f, 1.f, 1.f};
        u32x2 o; o.x = cvtpk(v[j][0] * r * g[0], v[j][1] * r * g[1]); o.y = cvtpk(v[j][2] * r * g[2], v[j][3] * r * g[3]);
        *(GAS u32x2*)(orow + j * 256 + lane * 4) = o; }
}
__device__ __forceinline__ void step_prologue(Frame& F, LAS unsigned char* lds) {
    LAS float* scr = (LAS float*)(lds + F.wave * 16384);
    GAS unsigned char* ws = F.ws;
    constexpr int I0 = 32 * (NIN0 / 32), I1 = 32 * 64, I2 = 32 * 96, I3 = 32 * 64, I4 = 32 * 64, I5 = 32 * 64, I6 = 32 * 64, I7 = 32 * 32, I8 = 32 * 32, I9 = 12 * 16;
    constexpr int NITEMS = I0 + I1 + I2 + I3 + I4 + I5 + I6 + I7 + I8 + I9;
#define TR_DESC(D, it_) do { int r = (it_) < NITEMS ? (it_) : NITEMS - 1; int nblk; \
        if (r < I0) { D = {F.in(I_AWIN), F.in(I_ANORM), (GAS bf16_t*)(ws + O_WIN0), NIN0, DM, 0, 0, 0}; nblk = NIN0 / 32; } else { r -= I0; \
        if (r < I1) { D = {F.in(I_AWOUT), nullptr, (GAS bf16_t*)(ws + O_WOUT0), DM, DM, 0, 0, 0}; nblk = 64; } else { r -= I1; \
        if (r < I2) { D = {F.in(I_SWKVF), F.in(I_SNORM), (GAS bf16_t*)(ws + O_WL1), 3084, DM, 0, 0, 0}; nblk = 96; } else { r -= I2; \
        if (r < I3) { D = {F.in(I_BWIN), F.in(I_BNORM), (GAS bf16_t*)(ws + O_WL1), DM, DM, 3072, 0, 0}; nblk = 64; } else { r -= I3; \
        if (r < I4) { D = {F.in(I_BWOUT), nullptr, (GAS bf16_t*)(ws + O_WOUT1), DM, DM, 0, 0, 0}; nblk = 64; } else { r -= I4; \
        if (r < I5) { D = {F.in(I_PWQ), F.in(I_PNORM), (GAS bf16_t*)(ws + O_WQ0), DM, DM, 0, 0, 0}; nblk = 64; } else { r -= I5; \
        if (r < I6) { D = {F.in(I_PWQ) + (size_t)DM * DM, F.in(I_PNORM) + DM, (GAS bf16_t*)(ws + O_WQ1), DM, DM, 0, 0, 0}; nblk = 64; } else { r -= I6; \
        if (r < I7) { D = {F.in(I_MWKV), nullptr, (GAS bf16_t*)(ws + O_WMKV), 1024, DM, 0, 0, 0}; nblk = 32; } else { r -= I7; \
        if (r < I8) { D = {F.in(I_MWKV) + (size_t)DM * 1024, nullptr, (GAS bf16_t*)(ws + O_WMKV) + (size_t)1024 * DM, 1024, DM, 0, 0, 0}; nblk = 32; } else { r -= I8; \
          const int blk = r / 16; r = r % 16; D = {F.in(I_AGATEW) + (size_t)blk * 128 * 256, nullptr, (GAS bf16_t*)(ws + O_WGATE), 256, 128, blk * 256, 0, 0}; nblk = 8; } } } } } } } } } \
        D.k0 = 64 * (r / nblk); D.n0 = 32 * (r % nblk); } while (0)
    for (int it = F.gw; it < NITEMS; it += F.ngw) { float wv[32]; TrItem d; TR_DESC(d, it); tr_load(d, wv, F.lane); tr_proc(d, wv, scr, F.lane); }
#undef TR_DESC
    { const GAS float* sk = F.in(I_PSUBK); GAS bf16_t* o = (GAS bf16_t*)(ws + O_SUBK);
      for (int i = F.gtid; i < 2 * 16 * 128 * 128 / 2; i += F.ngt) *(GAS unsigned*)(o + 2 * i) = cvtpk(sk[2 * i], sk[2 * i + 1]); }
    { GAS float* wf = (GAS float*)(ws + O_WF); const GAS float* w = F.in(I_SWKVF); const GAS float* g = F.in(I_SNORM);
      for (int i = F.gtid; i < 12 * DM; i += F.ngt) { const int j = i / DM, k = i % DM; wf[i] = w[(size_t)k * 3084 + 3072 + j] * g[k]; } }
    { GAS float* spl = (GAS float*)(ws + O_SPL); const GAS float* lam = F.in(I_ALAMBDA);
      for (int i = F.gtid; i < LRU; i += F.ngt) { const float z = -lam[i]; spl[i] = fmaxf(z, 0.f) + log1p_pos(fast_exp(-fabsf(z))); } }
    if (F.gw == 0) {
        float m = 0.f; for (int d = F.lane; d < 128; d += 64) m = fmaxf(m, fabsf(F.in(I_BQNORM)[d] * F.in(I_SKNORM)[d]));
        m = wave_max(m);
        if (F.lane == 0) ((GAS float*)(ws + O_GG))[512] = 2.f * 11.3137085f * m + 30.f; }
    { GAS float* gg = (GAS float*)(ws + O_GG);
      for (int i = F.gtid; i < 384; i += F.ngt) { const int a = i / 128, d = i % 128;
          gg[a == 0 ? 384 + d : i] = a == 0 ? F.in(I_BQNORM)[d] * F.in(I_SKNORM)[d] : F.in(I_MQNORM)[(a - 1) * 128 + d] * F.in(I_MKNORM)[(a - 1) * 128 + d]; } }
    {
        const GAS float* xin = F.in(I_X) + F.lane * 4; GAS bf16_t* xo = (GAS bf16_t*)(ws + O_XS16) + F.lane * 4;
        const int mlast = F.gw + ((T - 1 - F.gw) / F.ngw) * F.ngw;
#define XN_LOAD(V, m_) do { const int mm_ = (m_) <= mlast ? (m_) : mlast; _Pragma("unroll") for (int j = 0; j < 8; ++j) V[j] = __builtin_nontemporal_load((const GAS f32x4*)(xin + (size_t)mm_ * DM + j * 256)); } while (0)
#define XN_PROC(V, m_) do { if ((m_) < T) { float s0 = 0.f; _Pragma("unroll") for (int j = 0; j < 8; ++j) s0 += (V[j][0] * V[j][0] + V[j][1] * V[j][1]) + (V[j][2] * V[j][2] + V[j][3] * V[j][3]); \
            const float r0 = rsqrtf(wave_sum(s0) * (1.f / DM) + EPS); \
            _Pragma("unroll") for (int j = 0; j < 8; ++j) { u32x2 a; a.x = cvtpk(V[j][0] * r0, V[j][1] * r0); a.y = cvtpk(V[j][2] * r0, V[j][3] * r0); *(GAS u32x2*)(xo + (size_t)(m_) * DM + j * 256) = a; } } } while (0)
        f32x4 va[8], vb[8];
        XN_LOAD(va, F.gw);
        for (int m = F.gw; m < T; m += 2 * F.ngw) { XN_LOAD(vb, m + F.ngw); XN_PROC(va, m); XN_LOAD(va, m + 2 * F.ngw); XN_PROC(vb, m + F.ngw); }
#undef XN_LOAD
#undef XN_PROC
    }
    for (int m = F.gw; m < 2 * NMROW; m += F.ngw) { const int l = m / NMROW, r = m % NMROW;
        norm_row_bf16(F.in(I_MEM) + (size_t)r * DM, F.in(I_MNORM) + l * DM, (GAS bf16_t*)(ws + O_MEMN) + (size_t)m * DM, F.lane); }
    convert_tables(F, 0, 0, 2 * NEXP, F.gw, F.ngw);
}
__device__ __forceinline__ void step_conv(Frame& F) {
    const GAS bf16_t* zx = (const GAS bf16_t*)(F.ws + O_ZX); GAS bf16_t* xc = (GAS bf16_t*)(F.ws + O_XC);
    const GAS float* cw = F.in(I_ACONVW); const GAS float* cb = F.in(I_ACONVB);
    constexpr int NIT = T * (LRU / 8);
#define CV_LOAD(W, it_) do { const int ii_ = (it_) < NIT ? (it_) : NIT - 1; const int t_ = ii_ / (LRU / 8), c8_ = (ii_ % (LRU / 8)) * 8, pos_ = t_ & (SEQ - 1); \
        _Pragma("unroll") for (int k = 0; k < 4; ++k) W[k] = (pos_ - 3 + k >= 0) ? *(const GAS u32x4*)(zx + (size_t)(t_ - 3 + k) * LRU + c8_) : (u32x4){0u, 0u, 0u, 0u}; } while (0)
#define CV_PROC(W, it_) do { if ((it_) < NIT) { const int t_ = (it_) / (LRU / 8), c8_ = ((it_) % (LRU / 8)) * 8; float a[8]; \
        { const f32x4 b0 = *(const GAS f32x4*)(cb + c8_), b1 = *(const GAS f32x4*)(cb + c8_ + 4); a[0] = b0[0]; a[1] = b0[1]; a[2] = b0[2]; a[3] = b0[3]; a[4] = b1[0]; a[5] = b1[1]; a[6] = b1[2]; a[7] = b1[3]; } \
        _Pragma("unroll") for (int k = 0; k < 4; ++k) { const f32x4 w0 = *(const GAS f32x4*)(cw + k * LRU + c8_), w1 = *(const GAS f32x4*)(cw + k * LRU + c8_ + 4); \
            a[0] = fmaf(w0[0], bf_lo(W[k].x), a[0]); a[1] = fmaf(w0[1], bf_hi(W[k].x), a[1]); a[2] = fmaf(w0[2], bf_lo(W[k].y), a[2]); a[3] = fmaf(w0[3], bf_hi(W[k].y), a[3]); \
            a[4] = fmaf(w1[0], bf_lo(W[k].z), a[4]); a[5] = fmaf(w1[1], bf_hi(W[k].z), a[5]); a[6] = fmaf(w1[2], bf_lo(W[k].w), a[6]); a[7] = fmaf(w1[3], bf_hi(W[k].w), a[7]); } \
        u32x4 o; o.x = cvtpk(a[0], a[1]); o.y = cvtpk(a[2], a[3]); o.z = cvtpk(a[4], a[5]); o.w = cvtpk(a[6], a[7]); \
        *(GAS u32x4*)(xc + (size_t)t_ * LRU + c8_) = o; } } while (0)
    u32x4 wa[4], wb[4];
    CV_LOAD(wa, F.gtid);
    for (int it = F.gtid; it < NIT; it += 2 * F.ngt) { CV_LOAD(wb, it + F.ngt); CV_PROC(wa, it); CV_LOAD(wa, it + 2 * F.ngt); CV_PROC(wb, it + F.ngt); }
#undef CV_LOAD
#undef CV_PROC
}
constexpr int SCK = 32, NCK = SEQ / SCK;
typedef _Float16 h8_t __attribute__((ext_vector_type(8)));
__device__ __forceinline__ void scan_load(const GAS _Float16* LA, const GAS _Float16* UH, size_t off, float (&a)[8], float (&u)[8]) {
    const h8_t l = *(const GAS h8_t*)(LA + off), w = *(const GAS h8_t*)(UH + off);
#pragma unroll
    for (int k = 0; k < 8; ++k) { a[k] = fast_exp((float)l[k]); u[k] = (float)w[k]; }
}
__device__ __forceinline__ void step_scan1(Frame& F) {
    const GAS _Float16* LA = (const GAS _Float16*)(F.ws + O_AA); const GAS _Float16* UH = (const GAS _Float16*)(F.ws + O_UU);
    GAS float* CA = (GAS float*)(F.ws + O_LOGFP); GAS float* CH = CA + (size_t)NB * NCK * LRU;
    if (F.tid >= 384) return;
    const int grp = F.tid / 192, th = F.tid % 192;
    for (int it = blockIdx.x * 2 + grp; it < NB * NCK; it += gridDim.x * 2) {
        const int b = it / NCK, ck = it % NCK; const size_t base = ((size_t)b * SEQ + ck * SCK) * LRU + th * 8;
        float ap[8], h[8];
#pragma unroll
        for (int k = 0; k < 8; ++k) { ap[k] = 1.f; h[k] = 0.f; }
#pragma unroll 8
        for (int i = 0; i < SCK; ++i) { float a[8], u[8]; scan_load(LA, UH, base + (size_t)i * LRU, a, u);
#pragma unroll
            for (int k = 0; k < 8; ++k) { ap[k] *= a[k]; h[k] = a[k] * h[k] + u[k]; } }
        GAS float* ca = CA + (size_t)it * LRU + th * 8; GAS float* ch = CH + (size_t)it * LRU + th * 8;
        *(GAS f32x4*)ca = (f32x4){ap[0], ap[1], ap[2], ap[3]}; *(GAS f32x4*)(ca + 4) = (f32x4){ap[4], ap[5], ap[6], ap[7]};
        *(GAS f32x4*)ch = (f32x4){h[0], h[1], h[2], h[3]}; *(GAS f32x4*)(ch + 4) = (f32x4){h[4], h[5], h[6], h[7]};
    }
}
__device__ __forceinline__ void step_scan2(Frame& F) {
    const GAS _Float16* LA = (const GAS _Float16*)(F.ws + O_AA); const GAS _Float16* UH = (const GAS _Float16*)(F.ws + O_UU);
    const GAS float* CA = (const GAS float*)(F.ws + O_LOGFP); const GAS float* CH = CA + (size_t)NB * NCK * LRU;
    const GAS bf16_t* gy = (const GAS bf16_t*)(F.ws + O_GY); GAS bf16_t* cat = (GAS bf16_t*)(F.ws + O_CAT);
    if (F.tid >= 384) return;
    const int grp = F.tid / 192, th = F.tid % 192;
    for (int it = blockIdx.x * 2 + grp; it < NB * NCK; it += gridDim.x * 2) {
        const int b = it / NCK, ck = it % NCK; const size_t base = ((size_t)b * SEQ + ck * SCK) * LRU + th * 8;
        float h[8];
#pragma unroll
        for (int k = 0; k < 8; ++k) h[k] = 0.f;
        for (int k2 = 0; k2 < ck; ++k2) { const size_t o = (size_t)(b * NCK + k2) * LRU + th * 8;
            const f32x4 a0 = *(const GAS f32x4*)(CA + o), a1 = *(const GAS f32x4*)(CA + o + 4), c0 = *(const GAS f32x4*)(CH + o), c1 = *(const GAS f32x4*)(CH + o + 4);
#pragma unroll
            for (int k = 0; k < 4; ++k) { h[k] = a0[k] * h[k] + c0[k]; h[4 + k] = a1[k] * h[4 + k] + c1[k]; } }
#pragma unroll 8
        for (int i = 0; i < SCK; ++i) { float a[8], u[8]; scan_load(LA, UH, base + (size_t)i * LRU, a, u);
            const size_t row = (size_t)b * SEQ + ck * SCK + i;
            const u32x4 g = *(const GAS u32x4*)(gy + row * LRU + th * 8); u32x4 o;
#pragma unroll
            for (int k = 0; k < 8; ++k) h[k] = a[k] * h[k] + u[k];
#pragma unroll
            for (int k = 0; k < 4; ++k) o[k] = cvtpk(h[2 * k] * bf_lo(g[k]), h[2 * k + 1] * bf_hi(g[k]));
            *(GAS u32x4*)(cat + row * DM + th * 8) = o; }
    }
}
__device__ __forceinline__ void step_cprefix(Frame& F, LAS unsigned char* lds) {
    const GAS float* lf = (const GAS float*)(F.ws + O_LOGF); GAS float* cc = (GAS float*)(F.ws + O_CC);
    LAS double* scr = (LAS double*)(lds + F.wave * 16384);
    for (int it = F.gw; it < NB * NH; it += F.ngw) {
        const GAS float* p = lf + (size_t)it * SEQ + F.lane * 64; GAS float* q = cc + (size_t)it * SEQ + F.lane * 64;
        double s = 0.0;
        for (int i = 0; i < 64; ++i) s += (double)p[i];
        scr[F.lane] = s;
        asm volatile("s_waitcnt lgkmcnt(0)" ::: "memory");
        double run = 0.0;
        for (int l = 0; l < 64; ++l) { const double v = scr[l]; if (l < F.lane) run += v; }
        for (int i = 0; i < 64; ++i) { run += (double)p[i]; q[i] = (float)run; }
        asm volatile("s_waitcnt lgkmcnt(0)" ::: "memory");
    }
}

__device__ __forceinline__ int ord_i(float f) { const int b = __float_as_int(f); return b ^ ((b >> 31) & 0x7fffffff); }
__device__ __forceinline__ float unord_f(int k) { return __int_as_float(k ^ ((k >> 31) & 0x7fffffff)); }
template <int N> __device__ __forceinline__ void bitonic_sort_desc(int (&a)[N]) {
#pragma unroll
    for (int k = 2; k <= N; k <<= 1) {
#pragma unroll
        for (int j = k >> 1; j > 0; j >>= 1) {
#pragma unroll
            for (int i = 0; i < N; ++i) { const int l = i ^ j;
                if (l > i) { const bool desc = ((i & k) == 0); const int mx = max(a[i], a[l]), mn = min(a[i], a[l]); a[i] = desc ? mx : mn; a[l] = desc ? mn : mx; } }
        }
    }
}
__device__ __forceinline__ void bitonic_merge16_desc(int (&a)[16]) {
#pragma unroll
    for (int j = 8; j > 0; j >>= 1) {
#pragma unroll
        for (int i = 0; i < 16; ++i) { const int l = i ^ j; if (l > i) { const int mx = max(a[i], a[l]), mn = min(a[i], a[l]); a[i] = mx; a[l] = mn; } }
    }
}
__device__ __forceinline__ void top16_of_64(int (&a)[64]) {
    int g[4][16];
#pragma unroll
    for (int q = 0; q < 4; ++q) {
#pragma unroll
        for (int i = 0; i < 16; ++i) g[q][i] = a[16 * q + i];
        bitonic_sort_desc<16>(g[q]); }
#pragma unroll
    for (int i = 0; i < 16; ++i) { g[0][i] = max(g[0][i], g[1][15 - i]); g[2][i] = max(g[2][i], g[3][15 - i]); }
    bitonic_merge16_desc(g[0]); bitonic_merge16_desc(g[2]);
#pragma unroll
    for (int i = 0; i < 16; ++i) g[0][i] = max(g[0][i], g[2][15 - i]);
    bitonic_merge16_desc(g[0]);
#pragma unroll
    for (int i = 0; i < 16; ++i) a[i] = g[0][i];
}
__device__ __forceinline__ void subkey_top16(const GAS bf16_t* qrow  , const GAS bf16_t* sk  , int r32, int hi, int (&top)[16]) {
    bf16x8 qf[8];
#pragma unroll
    for (int ks = 0; ks < 8; ++ks) qf[ks] = *(const GAS bf16x8*)(qrow + ks * 16 + hi * 8);
    unsigned loff = (unsigned)(r32 * 128 + hi * 8) * 2u; asm volatile("" : "+v"(loff));
    int key[64];
#pragma unroll
    for (int kb = 0; kb < 4; ++kb) {
        f32x16 acc = {};
#pragma unroll
        for (int ks = 0; ks < 8; ++ks) { const bf16x8 af = *(const GAS bf16x8*)((const GAS char*)(sk + kb * 32 * 128 + ks * 16) + loff);
            acc = __builtin_amdgcn_mfma_f32_32x32x16_bf16(af, qf[ks], acc, 0, 0, 0); }
#pragma unroll
        for (int r = 0; r < 16; ++r) { const int id = kb * 32 + (r & 3) + 8 * (r >> 2) + 4 * hi; key[kb * 16 + r] = (ord_i(acc[r]) & ~127) | (127 - id); }
        __builtin_amdgcn_sched_barrier(0);
    }
    top16_of_64(key);
#pragma unroll
    for (int i = 0; i < 16; ++i) { auto r = __builtin_amdgcn_permlane32_swap((unsigned)key[15 - i], (unsigned)key[15 - i], false, false);
        const int pk = hi ? (int)r[0] : (int)r[1]; top[i] = max(key[i], pk); }
    bitonic_merge16_desc(top);
}
__device__ __forceinline__ void step_topk(Frame& F, LAS unsigned char* lds, int layer) {
    const GAS bf16_t* q16 = (const GAS bf16_t*)(F.ws + O_Q16); const GAS bf16_t* subk = (const GAS bf16_t*)(F.ws + O_SUBK) + (size_t)layer * 16 * 128 * 128;
    GAS int* IDX = (GAS int*)(F.ws + O_IDX); GAS float* GW = (GAS float*)(F.ws + O_GW);
    LAS int* scr = (LAS int*)(lds + F.wave * 16384) + F.lane * 33;
    const int r32 = F.lane & 31, hi = F.lane >> 5;
    for (int task = F.gw; task < (T / 32) * 8; task += F.ngw) {
        const int tb = task >> 3, h = task & 7; const int tok = tb * 32 + r32;
        const GAS bf16_t* qrow = q16 + (size_t)tok * DM + h * 256;
        int ta[16], tb16[16];
        subkey_top16(qrow, subk + (size_t)(h * 2 + 0) * 128 * 128, r32, hi, ta);
        subkey_top16(qrow + 128, subk + (size_t)(h * 2 + 1) * 128 * 128, r32, hi, tb16);
        float va[16], vb[16];
#pragma unroll
        for (int i = 0; i < 16; ++i) { va[i] = unord_f(ta[i] & ~127); vb[i] = unord_f(tb16[i] & ~127); scr[i] = 127 - (ta[i] & 127); scr[16 + i] = 127 - (tb16[i] & 127); }
        int c2[64]; int n = 0;
#pragma unroll
        for (int i = 0; i < 16; ++i)
#pragma unroll
            for (int j = 0; j < 16; ++j) if ((i + 1) * (j + 1) <= 16) { c2[n] = (ord_i(va[i] + vb[j]) & ~255) | (255 - (i * 16 + j)); ++n; }
#pragma unroll
        for (int i = 50; i < 64; ++i) c2[i] = (int)0x80000000;
        top16_of_64(c2);
        asm volatile("s_waitcnt lgkmcnt(0)" ::: "memory");
        float sv[16], ex[16]; int ev[16]; float Z = 0.f;
#pragma unroll
        for (int r = 0; r < 16; ++r) { const int flat = 255 - (c2[r] & 255); sv[r] = unord_f(c2[r] & ~255); ev[r] = scr[flat >> 4] * 128 + scr[16 + (flat & 15)]; }
#pragma unroll
        for (int r = 0; r < 16; ++r) { ex[r] = fast_exp(sv[r] - sv[0]); Z += ex[r]; }
        const float iz = 1.f / Z;
        GAS int* ip = IDX + (size_t)tok * 128 + h * 16 + hi * 8; GAS float* gp = GW + (size_t)tok * 128 + h * 16 + hi * 8;
        int eo[8]; float go[8];
#pragma unroll
        for (int j = 0; j < 8; ++j) { eo[j] = hi ? ev[8 + j] : ev[j]; go[j] = (hi ? ex[8 + j] : ex[j]) * iz; }
        *(GAS u32x4*)ip = (u32x4){(unsigned)eo[0], (unsigned)eo[1], (unsigned)eo[2], (unsigned)eo[3]}; *(GAS u32x4*)(ip + 4) = (u32x4){(unsigned)eo[4], (unsigned)eo[5], (unsigned)eo[6], (unsigned)eo[7]};
        *(GAS f32x4*)gp = (f32x4){go[0], go[1], go[2], go[3]}; *(GAS f32x4*)(gp + 4) = (f32x4){go[4], go[5], go[6], go[7]};
        asm volatile("s_waitcnt lgkmcnt(0)" ::: "memory");
    }
}
__device__ __forceinline__ h2 as_h2(unsigned w) { return __builtin_bit_cast(h2, w); }
#define F4(W, s) __builtin_amdgcn_cvt_scalef32_pk_f16_fp4((W), 1.0f, (s))
#define H2F(us) ((float)__builtin_bit_cast(_Float16, (unsigned short)(us)))
__device__ __forceinline__ float sum8(float v) { v += dppf<0xB1>(v); v += dppf<0x4E>(v); v += dppf<0x141>(v); return v; }
__device__ __forceinline__ void step_upass(Frame& F, int layer, int G, LAS unsigned char* lds) {
    typedef pg8::v8i_t v8i_t;
    const int s = blockIdx.x & 7, wk = (blockIdx.x >> 3) * NWAVES + F.wave, nwk = (G >> 3) * NWAVES;
    const GAS unsigned char* UN = F.ws + O_TAB + (size_t)(layer * 2) * TAB_ONE + (size_t)s * NEXP * 128;
    const GAS int* IDX = (const GAS int*)(F.ws + O_IDX); const GAS bf16_t* xs = (const GAS bf16_t*)(F.ws + O_XS16) + s * 256;
    GAS _Float16* part = (GAS _Float16*)(F.ws + O_PART) + (size_t)s * T * 128;
    unsigned lo = (unsigned)F.lane; asm volatile("" : "+v"(lo));
    const unsigned j = lo >> 3, p = lo & 7, c = lo & 15, kq = lo >> 4;
    LAS unsigned char* img = lds + F.wave * 16384; LAS unsigned char* xrow = lds + 131072 + F.wave * 256;
    LAS unsigned char* wrp = img + j * 128 + ((p ^ j) << 4);
    const LAS unsigned char* rd0 = img + c * 128 + ((kq ^ (c & 7)) << 4);
    const LAS unsigned char* rd1 = img + c * 128 + (((4 + kq) ^ (c & 7)) << 4);
    const int tlast = wk + ((T - 1 - wk) / nwk) * nwk;
#define U_LOADID(ID, t_, q_) do { const int tt_ = (t_) <= tlast ? (t_) : tlast; _Pragma("unroll") for (int b = 0; b < 4; ++b) ID[b] = IDX[(size_t)tt_ * 128 + (q_) * 32 + 8 * b + j]; } while (0)
#define U_LOADX(t_) do { const int tt_ = (t_) <= tlast ? (t_) : tlast; xn = *(const GAS u32x2*)(xs + (size_t)tt_ * DM + lo * 4); } while (0)
#define U_ISSUE(UB, ID) do { _Pragma("unroll") for (int b = 0; b < 4; ++b) UB[b] = *(const GAS u32x4*)(UN + (unsigned)(ID[b] * 128 + (int)p * 16)); } while (0)
#define U_WRITE(UB, q_) do { _Pragma("unroll") for (int b = 0; b < 4; ++b) *(LAS u32x4*)(wrp + (4 * (q_) + b) * 1024) = UB[b]; } while (0)
#define U_MM(g0) do { u32x4 a0[4], a1[4]; _Pragma("unroll") for (int g = 0; g < 4; ++g) { a0[g] = *(const LAS u32x4*)(rd0 + ((g0) + g) * 2048); a1[g] = *(const LAS u32x4*)(rd1 + ((g0) + g) * 2048); } \
        _Pragma("unroll") for (int g = 0; g < 4; ++g) { \
            f32x4 c_ = __builtin_amdgcn_mfma_scale_f32_16x16x128_f8f6f4((v8i_t){(int)a0[g].x, (int)a0[g].y, (int)a0[g].z, (int)a0[g].w, 0, 0, 0, 0}, bop0, zero4, 4, 0, 0, 127, 0, 127); \
            acc[(g0) + g] = __builtin_amdgcn_mfma_scale_f32_16x16x128_f8f6f4((v8i_t){(int)a1[g].x, (int)a1[g].y, (int)a1[g].z, (int)a1[g].w, 0, 0, 0, 0}, bop1, c_, 4, 0, 0, 127, 0, 127); } } while (0)
    int idA[4], idB[4]; u32x4 u0[4], u1[4], u2[4], u3[4]; u32x2 xc, xn;
    U_LOADID(idA, wk, 0); U_LOADID(idB, wk, 1); U_LOADX(wk);
    U_ISSUE(u0, idA); U_LOADID(idA, wk, 2);
    U_ISSUE(u1, idB); U_LOADID(idB, wk, 3);
    U_ISSUE(u2, idA); U_LOADID(idA, wk + nwk, 0);
    xc = xn;
    for (int t = wk; t < T; t += nwk) {
        U_ISSUE(u3, idB); U_LOADID(idB, t + nwk, 1); U_LOADX(t + nwk);
        const float x0 = bf_lo(xc.x), x1 = bf_hi(xc.x), x2 = bf_lo(xc.y), x3 = bf_hi(xc.y);
        const float amax = wave_max(fmaxf(fmaxf(fabsf(x0), fabsf(x1)), fmaxf(fabsf(x2), fabsf(x3))));
        const float sc = fmaxf(amax, 1e-20f) * (1.f / 448.f), qs = __builtin_amdgcn_rcpf(sc);
        { int pk = __builtin_amdgcn_cvt_pk_fp8_f32(x0 * qs, x1 * qs, 0, false); pk = __builtin_amdgcn_cvt_pk_fp8_f32(x2 * qs, x3 * qs, pk, true); *(LAS int*)(xrow + lo * 4) = pk; }
        U_WRITE(u0, 0);
        U_ISSUE(u0, idA); U_LOADID(idA, t + nwk, 2);
        U_WRITE(u1, 1);
        U_ISSUE(u1, idB); U_LOADID(idB, t + nwk, 3);
        U_WRITE(u2, 2);
        U_ISSUE(u2, idA); U_LOADID(idA, t + 2 * nwk, 0);
        U_WRITE(u3, 3);
        v8i_t bop0, bop1;
        { const u32x4 b00 = *(const LAS u32x4*)(xrow + kq * 16), b01 = *(const LAS u32x4*)(xrow + 64 + kq * 16), b10 = *(const LAS u32x4*)(xrow + 128 + kq * 16), b11 = *(const LAS u32x4*)(xrow + 192 + kq * 16);
          bop0 = (v8i_t){(int)b00.x, (int)b00.y, (int)b00.z, (int)b00.w, (int)b01.x, (int)b01.y, (int)b01.z, (int)b01.w};
          bop1 = (v8i_t){(int)b10.x, (int)b10.y, (int)b10.z, (int)b10.w, (int)b11.x, (int)b11.y, (int)b11.z, (int)b11.w}; }
        const f32x4 zero4 = {0.f, 0.f, 0.f, 0.f};
        f32x4 acc[8];
        U_MM(0); U_MM(4);
        f32x4 o = acc[0];
#pragma unroll
        for (int m = 1; m < 8; ++m) o = ((c & 7) == (unsigned)m) ? acc[m] : o;
        { const h2 o0 = {(_Float16)(o[0] * sc), (_Float16)(o[1] * sc)}, o1 = {(_Float16)(o[2] * sc), (_Float16)(o[3] * sc)};
          *(GAS u32x2*)(part + (size_t)t * 128 + 16 * (c & 7) + 4 * kq) = (u32x2){__builtin_bit_cast(unsigned, o0), __builtin_bit_cast(unsigned, o1)}; }
        xc = xn;
    }
#undef U_LOADID
#undef U_LOADX
#undef U_ISSUE
#undef U_WRITE
#undef U_MM
}
__device__ __forceinline__ void step_peer_reduce(Frame& F, int layer) {
    const GAS _Float16* part = (const GAS _Float16*)(F.ws + O_PART); const GAS float* GW = (const GAS float*)(F.ws + O_GW); const GAS int* IDX = (const GAS int*)(F.ws + O_IDX);
    const GAS float* rowss = (const GAS float*)(F.ws + O_ROWSS); GAS unsigned char* W8 = F.ws + O_W8;
    const GAS unsigned char* SU = F.ws + O_TAB + (size_t)(layer * 2) * TAB_ONE + TAB_NIB; const GAS unsigned char* SV = SU + TAB_ONE;
    constexpr int NIT = T * 2;
    struct SA { int id; float gw, rs; float p[8]; }; struct SB { u32x4 su, sv; };
#define RA(X, it_) do { const int ii_ = (it_) < NIT ? (it_) : NIT - 1; const size_t i_ = (size_t)ii_ * 64 + F.lane; X.id = IDX[i_]; X.gw = GW[i_]; X.rs = rowss[(size_t)(ii_ >> 1) * 32 + (F.lane & 31)]; \
        _Pragma("unroll") for (int s = 0; s < 8; ++s) X.p[s] = (float)part[(size_t)s * T * 128 + i_]; } while (0)
#define RB(Y, X) do { Y.su = *(const GAS u32x4*)(SU + (size_t)X.id * 16); Y.sv = *(const GAS u32x4*)(SV + (size_t)X.id * 16); } while (0)
#define RC(X, Y, it_) do { if ((it_) < NIT) { const size_t i_ = (size_t)(it_) * 64 + F.lane; const float r = rsqrtf(wave_sum(X.rs) * (0.5f / DM) + EPS); float d = 0.f; \
        _Pragma("unroll") for (int s = 0; s < 8; ++s) d += X.p[s] * (float)__builtin_bit_cast(_Float16, (unsigned short)(Y.su[s >> 1] >> (16 * (s & 1)))); \
        const float w = X.gw * gelu_tanh(d * r) * 256.f; \
        _Pragma("unroll") for (int s = 0; s < 8; ++s) { const float ws = w * (float)__builtin_bit_cast(_Float16, (unsigned short)(Y.sv[s >> 1] >> (16 * (s & 1)))); \
            W8[(size_t)s * T * 128 + i_] = (unsigned char)(__builtin_amdgcn_cvt_pk_fp8_f32(ws, 0.f, 0, false) & 0xff); } } } while (0)
    SA a0, a1, a2; SB b0, b1;
    RA(a0, F.gw); RA(a1, F.gw + F.ngw); RB(b0, a0);
    for (int it = F.gw; it < NIT; it += F.ngw) {
        RA(a2, it + 2 * F.ngw); RB(b1, a1);
        RC(a0, b0, it);
        a0 = a1; a1 = a2; b0 = b1;
    }
#undef RA
#undef RB
#undef RC
}
__device__ __forceinline__ void step_vpass(Frame& F, int layer, int G, bool dry, LAS unsigned char* lds) {
    typedef pg8::v8i_t v8i_t;
    const int s = blockIdx.x & 7, wk = (blockIdx.x >> 3) * NWAVES + F.wave, nwk = (G >> 3) * NWAVES;
    const GAS unsigned char* VN = F.ws + O_TAB + (size_t)(layer * 2 + 1) * TAB_ONE + (size_t)s * NEXP * 128;
    const GAS int* IDX = (const GAS int*)(F.ws + O_IDX); const GAS unsigned char* W8 = F.ws + O_W8 + (size_t)s * T * 128;
    GAS bf16_t* xs = (GAS bf16_t*)(F.ws + O_XS16); GAS float* rsp = (GAS float*)(F.ws + O_RSP);
    unsigned lo = (unsigned)F.lane; asm volatile("" : "+v"(lo));
    const unsigned j = lo >> 3, p = lo & 7, c = lo & 15, kq = lo >> 4;
    LAS unsigned char* img = lds + F.wave * 16384;
    LAS unsigned char* wrp = img + j * 128 + ((p ^ j) << 4);
    const unsigned rdrow = (unsigned)(size_t)img + (32 * kq + c) * 128, csw = (c & 7) << 4;
    const int tlast = wk + ((T - 1 - wk) / nwk) * nwk;
#define V_LOADID(ID, t_, q_) do { const int tt_ = (t_) <= tlast ? (t_) : tlast; _Pragma("unroll") for (int b = 0; b < 4; ++b) ID[b] = IDX[(size_t)tt_ * 128 + (q_) * 32 + 8 * b + j]; } while (0)
#define V_LOADW(t_) do { const int tt_ = (t_) <= tlast ? (t_) : tlast; wn0 = *(const GAS u32x4*)(W8 + (size_t)tt_ * 128 + kq * 16); wn1 = *(const GAS u32x4*)(W8 + (size_t)tt_ * 128 + 64 + kq * 16); } while (0)
#define V_ISSUE(VB, ID) do { _Pragma("unroll") for (int b = 0; b < 4; ++b) VB[b] = *(const GAS u32x4*)(VN + (unsigned)(ID[b] * 128 + (int)p * 16)); } while (0)
#define V_WRITE(VB, q_) do { _Pragma("unroll") for (int b = 0; b < 4; ++b) *(LAS u32x4*)(wrp + (4 * (q_) + b) * 1024) = VB[b]; } while (0)
#define TR4(dst, va, off) asm volatile("ds_read_b64_tr_b4 %0, %1 offset:%2" : "=&v"(dst) : "v"(va), "i"(off) : "memory")
#define V_MM(cc) do { const unsigned va0 = rdrow + (((cc) << 4) ^ csw), va1 = rdrow + ((((cc) + 1) << 4) ^ csw); u32x2 t00, t01, t10, t11, t20, t21, t30, t31; \
        TR4(t00, va0, 0); TR4(t01, va0, 2048); TR4(t10, va0, 8); TR4(t11, va0, 2056); TR4(t20, va1, 0); TR4(t21, va1, 2048); TR4(t30, va1, 8); TR4(t31, va1, 2056); \
        asm volatile("s_waitcnt lgkmcnt(0)" ::: "memory"); __builtin_amdgcn_sched_barrier(0); \
        acc[2 * (cc)] = __builtin_amdgcn_mfma_scale_f32_16x16x128_f8f6f4((v8i_t){(int)t00.x, (int)t00.y, (int)t01.x, (int)t01.y, 0, 0, 0, 0}, bop, zero4, 4, 0, 0, 127, 0, 119); \
        acc[2 * (cc) + 1] = __builtin_amdgcn_mfma_scale_f32_16x16x128_f8f6f4((v8i_t){(int)t10.x, (int)t10.y, (int)t11.x, (int)t11.y, 0, 0, 0, 0}, bop, zero4, 4, 0, 0, 127, 0, 119); \
        acc[2 * (cc) + 2] = __builtin_amdgcn_mfma_scale_f32_16x16x128_f8f6f4((v8i_t){(int)t20.x, (int)t20.y, (int)t21.x, (int)t21.y, 0, 0, 0, 0}, bop, zero4, 4, 0, 0, 127, 0, 119); \
        acc[2 * (cc) + 3] = __builtin_amdgcn_mfma_scale_f32_16x16x128_f8f6f4((v8i_t){(int)t30.x, (int)t30.y, (int)t31.x, (int)t31.y, 0, 0, 0, 0}, bop, zero4, 4, 0, 0, 127, 0, 119); } while (0)
    int idA[4], idB[4]; u32x4 v0[4], v1[4], v2[4], v3[4]; u32x4 w0, w1, wn0, wn1;
    V_LOADID(idA, wk, 0); V_LOADID(idB, wk, 1); V_LOADW(wk);
    V_ISSUE(v0, idA); V_LOADID(idA, wk, 2);
    V_ISSUE(v1, idB); V_LOADID(idB, wk, 3);
    V_ISSUE(v2, idA); V_LOADID(idA, wk + nwk, 0);
    w0 = wn0; w1 = wn1;
    for (int t = wk; t < T; t += nwk) {
        V_ISSUE(v3, idB); V_LOADID(idB, t + nwk, 1); V_LOADW(t + nwk);
        GAS bf16_t* xb = xs + (size_t)t * DM + s * 256 + c * 16 + kq * 4;
        f32x4 x2; { const u32x2 w = *(const GAS u32x2*)xb; x2 = (f32x4){bf_lo(w.x), bf_hi(w.x), bf_lo(w.y), bf_hi(w.y)}; }
        V_WRITE(v0, 0);
        V_ISSUE(v0, idA); V_LOADID(idA, t + nwk, 2);
        V_WRITE(v1, 1);
        V_ISSUE(v1, idB); V_LOADID(idB, t + nwk, 3);
        V_WRITE(v2, 2);
        V_ISSUE(v2, idA); V_LOADID(idA, t + 2 * nwk, 0);
        V_WRITE(v3, 3);
        const v8i_t bop = {(int)w0.x, (int)w0.y, (int)w0.z, (int)w0.w, (int)w1.x, (int)w1.y, (int)w1.z, (int)w1.w};
        const f32x4 zero4 = {0.f, 0.f, 0.f, 0.f};
        f32x4 acc[16];
        V_MM(0); V_MM(2); V_MM(4); V_MM(6);
        f32x4 o = acc[0];
#pragma unroll
        for (int m = 1; m < 16; ++m) o = (c == (unsigned)m) ? acc[m] : o;
        x2 += o;
        if (layer == 1 && !dry) *(GAS f32x4*)(F.out + (size_t)t * DM + s * 256 + c * 16 + kq * 4) = x2;
        if (layer == 0 && !dry) {
            { u32x2 ow; ow.x = cvtpk(x2[0], x2[1]); ow.y = cvtpk(x2[2], x2[3]); *(GAS u32x2*)xb = ow; }
            const float sst = wave_sum((x2[0] * x2[0] + x2[1] * x2[1]) + (x2[2] * x2[2] + x2[3] * x2[3]));
            if (lo == 0) rsp[(size_t)t * 8 + s] = sst;
        }
        w0 = wn0; w1 = wn1;
    }
#undef V_LOADID
#undef V_LOADW
#undef V_ISSUE
#undef V_WRITE
#undef TR4
#undef V_MM
}
#undef F4
#undef H2F
__device__ __forceinline__ void step_logf(Frame& F, LAS unsigned char* lds) {
    const GAS bf16_t* xs = (const GAS bf16_t*)(F.ws + O_XS16); const GAS float* rsp = (const GAS float*)(F.ws + O_RSP); GAS float* logf = (GAS float*)(F.ws + O_LOGF);
    const GAS float* wf = (const GAS float*)(F.ws + O_WF); LAS float* wl = (LAS float*)lds;
    for (int i = F.tid; i < NH * DM / 4; i += NTHREADS) *(LAS f32x4*)(wl + 4 * i) = *(const GAS f32x4*)(wf + 4 * i);
    __syncthreads();
    const int tlast = F.gw + ((T - 1 - F.gw) / F.ngw) * F.ngw;
    unsigned lo = (unsigned)F.lane; asm volatile("" : "+v"(lo));
#define LF_LOAD(W, Q, t_) do { const int tt_ = (t_) <= tlast ? (t_) : tlast; _Pragma("unroll") for (int c = 0; c < 8; ++c) W[c] = *(const GAS u32x2*)(xs + (size_t)tt_ * DM + c * 256 + lo * 4); Q = lo < 8 ? rsp[(size_t)tt_ * 8 + lo] : 0.f; } while (0)
    u32x2 w[8], wn[8]; float q, qn;
    LF_LOAD(w, q, F.gw);
    for (int t = F.gw; t < T; t += F.ngw) {
        LF_LOAD(wn, qn, t + F.ngw);
        asm volatile("" : "+v"(lo));
        const float r1 = rsqrtf(wave_sum(q) * (1.f / DM) + EPS);
        float mine = 0.f;
#pragma unroll 2
        for (int h = 0; h < NH; ++h) { float d = 0.f;
#pragma unroll
            for (int c = 0; c < 8; ++c) { const f32x4 g = *(const LAS f32x4*)(wl + h * DM + c * 256 + lo * 4);
                d += (bf_lo(w[c].x) * g[0] + bf_hi(w[c].x) * g[1]) + (bf_lo(w[c].y) * g[2] + bf_hi(w[c].y) * g[3]); }
            d = wave_sum(d); mine = (lo == (unsigned)h) ? d : mine; }
        if (lo < (unsigned)NH) { const float z = mine * r1 + F.in(I_SBF)[lo];
            logf[((size_t)(t / SEQ) * NH + lo) * SEQ + (t % SEQ)] = fminf(z, 0.f) - log1p_pos(fast_exp(-fabsf(z))); }
#pragma unroll
        for (int c = 0; c < 8; ++c) w[c] = wn[c];
        q = qn;
    }
#undef LF_LOAD
    __syncthreads();
}

#define XB_TMO      128
#define XB_XCNT(j)  (256  + 64 * (j))
#define XB_XSUB(j)  (1280 + 64 * (j))
#define XB_XGEN(j)  (2304 + 64 * (j))
#define XB_TOP      3328
#define XB_TOPGEN   3392
#define XCD_BAR_WORDS 3456
#define XB_SPIN_CAP (1u << 20)
__device__ __forceinline__ unsigned xb_ld(unsigned* p)              { return __hip_atomic_load(p, __ATOMIC_RELAXED, __HIP_MEMORY_SCOPE_AGENT); }
__device__ __forceinline__ unsigned xb_add(unsigned* p, unsigned v) { return __hip_atomic_fetch_add(p, v, __ATOMIC_RELAXED, __HIP_MEMORY_SCOPE_AGENT); }
__device__ __forceinline__ unsigned xb_xcc_id() { return (unsigned)__builtin_amdgcn_s_getreg((3 << 11) | 20) & 0xFu; }
#define XB_SPIN(cond, bar) do { unsigned _sp = 0; while (cond) { __builtin_amdgcn_s_sleep(1); \
    if ((++_sp & 255u) == 0u) { if (xb_ld(&(bar)[XB_TMO])) break; if (_sp > XB_SPIN_CAP) { atomicAdd(&(bar)[XB_TMO], 1u); break; } } } } while (0)
struct XcdBarrier { unsigned* bar; unsigned x; volatile LAS unsigned* st; };
__device__ __forceinline__ XcdBarrier xcd_barrier_post(unsigned* bar, volatile LAS unsigned* st) {
    XcdBarrier b; b.bar = bar; b.x = xb_xcc_id(); b.st = st;
    if (threadIdx.x == 0) (void)xb_add(&bar[XB_XCNT(b.x)], 1u);
    return b;
}
__device__ __forceinline__ void xcd_barrier_complete(unsigned* bar, unsigned x, unsigned& nloc, unsigned& nx) {
    const unsigned G = gridDim.x * gridDim.y * gridDim.z;
    unsigned sum, cnt, mine, sp = 0u;
    for (;;) {
        sum = 0u; cnt = 0u; mine = 0u;
#pragma unroll
        for (unsigned j = 0; j < 16; ++j) { const unsigned c = xb_ld(&bar[XB_XCNT(j)]); sum += c; cnt += (c > 0u) ? 1u : 0u; mine = (j == x) ? c : mine; }
        if (sum == G) break;
        __builtin_amdgcn_s_sleep(1);
        if ((++sp & 255u) == 0u) { if (xb_ld(&bar[XB_TMO])) break; if (sp > XB_SPIN_CAP) { atomicAdd(&bar[XB_TMO], 1u); break; } }
    }
    nloc = mine > 0u ? mine : 1u; nx = cnt > 0u ? cnt : 1u;
}
__device__ __forceinline__ void xcd_barrier(const XcdBarrier& b, int wave_s) {
    asm volatile("s_waitcnt vmcnt(0)" ::: "memory");
    __syncthreads();
    int ln_; asm volatile("v_mbcnt_lo_u32_b32 %0, -1, 0\n\tv_mbcnt_hi_u32_b32 %0, -1, %0" : "=v"(ln_));
    if (wave_s == 0 && ln_ == 0) {
        unsigned* bar = b.bar;
        __builtin_amdgcn_s_waitcnt(0);
        unsigned nloc = b.st[0], nx = b.st[1];
        if (nloc == 0u) { xcd_barrier_complete(bar, b.x, nloc, nx); b.st[0] = nloc; b.st[1] = nx; }
        const unsigned old = xb_add(&bar[XB_XSUB(b.x)], 1u);
        const unsigned gen = old / nloc;
        if (old + 1u == (gen + 1u) * nloc) {
            __builtin_amdgcn_fence(__ATOMIC_RELEASE, "agent");
            asm volatile("s_waitcnt vmcnt(0)" ::: "memory");
            const unsigned og = xb_add(&bar[XB_TOP], 1u);
            const unsigned tg = og / nx;
            if (og + 1u == (tg + 1u) * nx) xb_add(&bar[XB_TOPGEN], 1u);
            else XB_SPIN(xb_ld(&bar[XB_TOPGEN]) == tg, bar);
            __builtin_amdgcn_fence(__ATOMIC_ACQUIRE, "agent");
            xb_add(&bar[XB_XGEN(b.x)], 1u);
            asm volatile("s_waitcnt vmcnt(0)" ::: "memory");
        } else {
            XB_SPIN(xb_ld(&bar[XB_XGEN(b.x)]) == gen, bar);
            __builtin_amdgcn_fence(__ATOMIC_ACQUIRE, "agent");
            asm volatile("s_waitcnt vmcnt(0)" ::: "memory");
        }
    }
    __syncthreads();
}

constexpr int CONV1_SPLIT = 2 * 4608;
constexpr int BAR_LDS_OFF = 147456 - 64;
constexpr int LDS_BYTES = 147456;
enum { ST_PROLOGUE = 0, ST_G_IN0, ST_G_MKV0, ST_G_MKV1, ST_CONV, ST_G_GATE, ST_A_MEM0, ST_SCAN1, ST_SCAN2, ST_G_OUT0, ST_G_PQ0, ST_TOPK0, ST_UPASS0, ST_PRED0, ST_VPASS0,
       ST_G_L1, ST_CPREFIX, ST_A_FOX, ST_A_MEM1, ST_G_OUT1, ST_G_PQ1, ST_TOPK1, ST_UPASS1, ST_PRED1, ST_VPASS1, N_STEPS };
constexpr unsigned SYNC_AFTER = (1u << ST_PROLOGUE) | (1u << ST_G_MKV1) | (1u << ST_CONV) | (1u << ST_A_MEM0) | (1u << ST_SCAN1) | (1u << ST_SCAN2) | (1u << ST_G_OUT0) | (1u << ST_G_PQ0) |
                                (1u << ST_TOPK0) | (1u << ST_UPASS0) | (1u << ST_PRED0) | (1u << ST_VPASS0) | (1u << ST_G_L1) | (1u << ST_CPREFIX) | (1u << ST_A_MEM1) | (1u << ST_G_OUT1) | (1u << ST_G_PQ1) | (1u << ST_TOPK1) | (1u << ST_UPASS1) | (1u << ST_PRED1);
constexpr unsigned GEMM_STEPS = (1u << ST_G_IN0) | (1u << ST_G_MKV0) | (1u << ST_G_MKV1) | (1u << ST_G_GATE) | (1u << ST_G_OUT0) | (1u << ST_G_PQ0) | (1u << ST_G_L1) | (1u << ST_G_OUT1) | (1u << ST_G_PQ1);
constexpr unsigned ATTN_STEPS = (1u << ST_A_MEM0) | (1u << ST_A_FOX) | (1u << ST_A_MEM1);

struct Args { const float* in[N_IN]; float* out; unsigned char* ws; int lo, hi; };

__global__ void __launch_bounds__(NTHREADS, 2) yoco_fwd(Args args) {
    extern __shared__ __attribute__((aligned(16))) unsigned char lds[];
    volatile LAS unsigned* bst = (volatile LAS unsigned*)((LAS unsigned char*)lds + BAR_LDS_OFF);
    if (threadIdx.x == 0) { bst[0] = 0u; bst[1] = 0u; }
    __syncthreads();
    const XcdBarrier gbar = xcd_barrier_post((unsigned*)(args.ws + O_CTL), bst);
    const int G = gridDim.x;
    const int wave_s = __builtin_amdgcn_readfirstlane(threadIdx.x >> 6);
#ifndef DUP_MASK
#define DUP_MASK 0u
#endif
    for (int st = args.lo; st < args.hi; ++st) {
      const int nrep = ((DUP_MASK >> st) & 1u) ? 2 : 1;
      for (int rep = 0; rep < nrep; ++rep) {
        unsigned char* ws0 = args.ws; asm volatile("" : "+s"(ws0));
        GAS unsigned char* ws = (GAS unsigned char*)ws0;
#define LANE_ID(v) asm volatile("v_mbcnt_lo_u32_b32 %0, -1, 0\n\tv_mbcnt_hi_u32_b32 %0, -1, %0" : "=v"(v))
#define MAKE_TID(v) do { LANE_ID(v); v += wave_s * 64; } while (0)
#define MAKE_FRAME(F) Frame F; F.ws = ws; F.in_ = args.in; F.out = (GAS float*)args.out; { int t0_; MAKE_TID(t0_); F.tid = t0_; } F.lane = F.tid & 63; F.wave = wave_s; \
        F.gw = blockIdx.x * NWAVES + F.wave; F.ngw = gridDim.x * NWAVES; F.gtid = blockIdx.x * NTHREADS + F.tid; F.ngt = gridDim.x * NTHREADS
        if (st == ST_G_L1) { MAKE_FRAME(F); step_logf(F, (LAS unsigned char*)lds); }
        if ((GEMM_STEPS >> st) & 1u) {
            pg8::Gemm g; Epi E; E.ws = ws; E.resid = nullptr; E.outf = nullptr; E.o16 = nullptr; E.ssq = nullptr; E.gate_b = nullptr; int shift = 0;
            switch (st) {
            case ST_G_IN0:  g = {(const GAS bf16_t*)(ws + O_XS16), (const GAS bf16_t*)(ws + O_WIN0), T, NIN0, DM, DM, DM, 0}; E.mode = EM_IN0; break;
            case ST_G_MKV0: g = {(const GAS bf16_t*)(ws + O_MEMN), (const GAS bf16_t*)(ws + O_WMKV), NMROW, 1024, DM, DM, DM, 0}; E.mode = EM_MKV; E.o16 = (GAS bf16_t*)(ws + O_MKV); E.ssq = (GAS float*)(ws + O_MKSS); shift = 128; break;
            case ST_G_MKV1: g = {(const GAS bf16_t*)(ws + O_MEMN) + (size_t)NMROW * DM, (const GAS bf16_t*)(ws + O_WMKV) + (size_t)1024 * DM, NMROW, 1024, DM, DM, DM, 0}; E.mode = EM_MKV;
                            E.o16 = (GAS bf16_t*)(ws + O_MKV) + (size_t)NMROW * NL1; E.ssq = (GAS float*)(ws + O_MKSS) + NMROW * 112; shift = 144; break;
            case ST_G_GATE: g = {(const GAS bf16_t*)(ws + O_XC), (const GAS bf16_t*)(ws + O_WGATE), T, 12 * 256, 128, LRU, 128, 128}; E.mode = EM_GATE; E.gate_b = (const GAS float*)args.in[I_AGATEB]; break;
            case ST_G_OUT0: g = {(const GAS bf16_t*)(ws + O_CAT), (const GAS bf16_t*)(ws + O_WOUT0), T, DM, DM, DM, DM, 0}; E.mode = EM_RES; E.resid = (const GAS float*)args.in[I_X]; E.outf = (GAS float*)args.out; break;
            case ST_G_PQ0:  g = {(const GAS bf16_t*)(ws + O_XS16), (const GAS bf16_t*)(ws + O_WQ0), T, DM, DM, DM, DM, 0}; E.mode = EM_PQ; E.o16 = (GAS bf16_t*)(ws + O_Q16); break;
            case ST_G_L1:   g = {(const GAS bf16_t*)(ws + O_XS16), (const GAS bf16_t*)(ws + O_WL1), T, NL1, DM, DM, DM, 0}; E.mode = EM_L1; break;
            case ST_G_OUT1: g = {(const GAS bf16_t*)(ws + O_CAT), (const GAS bf16_t*)(ws + O_WOUT1), T, DM, DM, DM, DM, 0}; E.mode = EM_RES; E.resid = nullptr; break;
            default:        g = {(const GAS bf16_t*)(ws + O_XS16), (const GAS bf16_t*)(ws + O_WQ1), T, DM, DM, DM, DM, 0}; E.mode = EM_PQ; E.o16 = (GAS bf16_t*)(ws + O_Q16); break;
            }
            pg8::StaticOrder S; S.init(g.M, g.N, G, (int)((blockIdx.x + G - shift) % G));
#ifndef DIS_GEMM
            { int tg_; MAKE_TID(tg_);
              pg8::gemm_phase<Epi, false>((LAS unsigned char*)lds, g, S, E, tg_); }
#endif
            if (st == ST_G_MKV1 && blockIdx.x >= 160) { MAKE_FRAME(F); convert_tables(F, 1, 0, CONV1_SPLIT, (blockIdx.x - 160) * NWAVES + F.wave, (G - 160) * NWAVES); }
        } else if ((ATTN_STEPS >> st) & 1u) {
            const int nun = st == ST_A_FOX ? 3 : 1;
            for (int ui = 0; ui < nun; ++ui) {
                att::BlockRef r;
                if (st == ST_A_FOX) {
                    const int i = blockIdx.x, x = i & 15, bh = (i >> 4) + 16 * ui, qb = ui == 0 ? x : (ui == 1 ? 15 - x : ((x * 5 + 3) & 15));
                    const int b = bh / NH, h = bh % NH; const size_t row0 = (size_t)b * SEQ + qb * 256;
                    const GAS bf16_t* z = (const GAS bf16_t*)(ws + O_ZL1);
                    r.Q = z + row0 * NL1 + 3072 + h * 128; r.K = z + (size_t)b * SEQ * NL1 + h * 128; r.V = z + (size_t)b * SEQ * NL1 + 1536 + h * 128;
                    r.O = (GAS bf16_t*)(ws + O_CAT) + row0 * DM + h * 128;
                    const GAS float* ss = (const GAS float*)(ws + O_SSL1);
                    r.qss = ss + row0 * 112 + (12 + h) * 4; r.kss = ss + (size_t)b * SEQ * 112 + h * 4; r.cc = (const GAS float*)(ws + O_CC) + (size_t)bh * SEQ; r.gg = (const GAS float*)(ws + O_GG) + 384;
                    r.P0 = qb * 256; r.skv = SEQ;
                } else {
                    const int l = st == ST_A_MEM0 ? 0 : 1; const int i = blockIdx.x, qblk = i >> 2, h = i & 3, b = qblk >> 4; const size_t row0 = (size_t)qblk * 256;
                    r.Q = (const GAS bf16_t*)(ws + O_ZL1) + row0 * NL1 + 4608 + h * 128; r.qss = (const GAS float*)(ws + O_SSL1) + row0 * 112 + (24 + h) * 4;
                    const GAS bf16_t* kv = (const GAS bf16_t*)(ws + O_MKV) + ((size_t)l * NMROW + b * NMEM) * NL1;
                    r.K = kv + h * 128; r.V = kv + 512 + h * 128; r.kss = (const GAS float*)(ws + O_MKSS) + ((size_t)l * NMROW + b * NMEM) * 112 + h * 4;
                    r.O = (GAS bf16_t*)(ws + O_CAT) + row0 * DM + LRU + h * 128; r.cc = nullptr; r.gg = (const GAS float*)(ws + O_GG) + 128 * (1 + l);
                    r.P0 = SEQ; r.skv = NMEM;
                }
                att::Seam S;
                int tid_u; MAKE_TID(tid_u);
#ifndef DIS_ATTN
                if (st == ST_A_FOX) { att::attn_prime(r, (char*)lds, S, tid_u); att::attn_block(r, (char*)lds, S, tid_u); }
                else att::mem_attn_unit(r, (char*)lds, tid_u);
#endif
            }
        } else {
            MAKE_FRAME(F);
            switch (st) {
#ifndef DIS_MISC
            case ST_PROLOGUE: step_prologue(F, (LAS unsigned char*)lds); break;
            case ST_CONV: step_conv(F); break;
            case ST_SCAN1: step_scan1(F); break;
            case ST_SCAN2: step_scan2(F); break;
#endif
#ifndef DIS_TOPK
            case ST_TOPK0: step_topk(F, (LAS unsigned char*)lds, 0); break;
            case ST_TOPK1: step_topk(F, (LAS unsigned char*)lds, 1); break;
#endif
#ifndef DIS_GATHER
            case ST_UPASS0: step_upass(F, 0, G, (LAS unsigned char*)lds); break;
            case ST_UPASS1: step_upass(F, 1, G, (LAS unsigned char*)lds); break;
            case ST_PRED0: step_peer_reduce(F, 0); break;
            case ST_PRED1: step_peer_reduce(F, 1); break;
            case ST_VPASS0: step_vpass(F, 0, G, rep + 1 < nrep, (LAS unsigned char*)lds); break;
            case ST_VPASS1: step_vpass(F, 1, G, rep + 1 < nrep, (LAS unsigned char*)lds); break;
#endif
#ifndef DIS_MISC
            case ST_CPREFIX: step_cprefix(F, (LAS unsigned char*)lds); convert_tables(F, 1, G > 160 ? CONV1_SPLIT : 0, 2 * NEXP, F.gw, F.ngw); break;
#endif
            default: break;
            }
        }
        if (rep + 1 < nrep) xcd_barrier(gbar, wave_s);
      }
        if (((SYNC_AFTER >> st) & 1u) && st + 1 < args.hi) xcd_barrier(gbar, wave_s);
    }
}

#ifndef N_LAUNCH_MODE
#define N_LAUNCH_MODE 1
#endif
extern "C" void kernel_launch(void* const* d_in, const int* in_sizes, int n_in, void* d_out, int out_size, void* d_ws, size_t ws_size, hipStream_t stream) {
    static int grid = 0;
    if (grid == 0) {
        if (n_in != N_IN || in_sizes[0] != T * DM || out_size != T * DM || ws_size < WS_END) {
            fprintf(stderr, "kernel_launch: unexpected shapes (n_in %d, in0 %d, out %d, ws %zu, need %zu)\n", n_in, n_in > 0 ? in_sizes[0] : -1, out_size, ws_size, (size_t)WS_END); grid = -1; return; }
        int dev = 0, cus = 0, per_cu = 0;
        hipGetDevice(&dev); hipDeviceGetAttribute(&cus, hipDeviceAttributeMultiprocessorCount, dev);
        hipFuncSetAttribute((const void*)yoco_fwd, hipFuncAttributeMaxDynamicSharedMemorySize, LDS_BYTES);
        hipOccupancyMaxActiveBlocksPerMultiprocessor(&per_cu, (const void*)yoco_fwd, NTHREADS, LDS_BYTES);
        if (per_cu < 1) { fprintf(stderr, "kernel_launch: occupancy query says %d blocks per CU\n", per_cu); grid = -1; return; }
        grid = cus - cus % 8;
        (void)hipGetLastError();
    }
    if (grid < 0) return;
    Args a{};
    for (int i = 0; i < N_IN; ++i) a.in[i] = (const float*)d_in[i];
    a.out = (float*)d_out; a.ws = (unsigned char*)d_ws;
    if (hipMemsetAsync((char*)d_ws + O_CTL, 0, 65536, stream) != hipSuccess) { fprintf(stderr, "kernel_launch: memset of the barrier words failed\n"); return; }
    if (N_LAUNCH_MODE == 1) {
        a.lo = 0; a.hi = N_STEPS;
        hipLaunchKernelGGL(yoco_fwd, dim3(grid), dim3(NTHREADS), LDS_BYTES, stream, a);
        hipError_t e = hipPeekAtLastError();
        if (e != hipSuccess) fprintf(stderr, "launch failed: %s (grid %d)\n", hipGetErrorString(e), grid);
    } else {
        int lo = 0;
        for (int s = 0; s < N_STEPS; ++s) {
            if (((SYNC_AFTER >> s) & 1u) || s == N_STEPS - 1) {
                a.lo = lo; a.hi = s + 1; lo = s + 1;
                void* params[] = {&a};
                hipError_t e = hipLaunchCooperativeKernel((const void*)yoco_fwd, dim3(grid), dim3(NTHREADS), params, LDS_BYTES, stream);
                if (e != hipSuccess) { fprintf(stderr, "launch failed: %s\n", hipGetErrorString(e)); break; }
            }
        }
    }
}
```

```cpp
#include <hip/hip_runtime.h>
#include <hip/hip_cooperative_groups.h>
#include <cstdio>
#include <cstdint>
namespace cg = cooperative_groups;

#define LAS __attribute__((address_space(3)))
#define GAS __attribute__((address_space(1)))
typedef unsigned short bf16_t;
typedef short bf16x8 __attribute__((ext_vector_type(8)));
typedef short s16x4 __attribute__((ext_vector_type(4)));
typedef float f32x4 __attribute__((ext_vector_type(4)));
typedef float f32x2 __attribute__((ext_vector_type(2)));
typedef float f32x16 __attribute__((ext_vector_type(16)));
typedef unsigned u32x4 __attribute__((ext_vector_type(4)));
typedef unsigned u32x2 __attribute__((ext_vector_type(2)));
typedef _Float16 h2 __attribute__((ext_vector_type(2)));

constexpr int NB = 4, SEQ = 4096, T = NB * SEQ, DM = 2048, LRU = 1536, MEMW = 512, NMEM = 256, NH = 12, HD = 128;
constexpr int NIN0 = 3584, NL1 = 5120, NEXP = 16384, NMROW = NB * NMEM;
constexpr float EPS = 1e-6f;
constexpr int NTHREADS = 512, NWAVES = 8;

constexpr size_t MiB = 1u << 20;
constexpr size_t O_CTL = 0;
constexpr size_t O_WIN0 = 1 * MiB;
constexpr size_t O_WOUT0 = O_WIN0 + 14 * MiB;
constexpr size_t O_WL1 = O_WOUT0 + 8 * MiB;
constexpr size_t O_WOUT1 = O_WL1 + 20 * MiB;
constexpr size_t O_WQ0 = O_WOUT1 + 8 * MiB;
constexpr size_t O_WQ1 = O_WQ0 + 8 * MiB;
constexpr size_t O_WMKV = O_WQ1 + 8 * MiB;
constexpr size_t O_WGATE = O_WMKV + 8 * MiB;
constexpr size_t O_SUBK = O_WGATE + 1 * MiB;
constexpr size_t O_WF = O_SUBK + 1 * MiB;
constexpr size_t O_SMALL = O_WF + 1 * MiB;
constexpr size_t O_RS1 = O_SMALL;
constexpr size_t O_LOGF = O_SMALL + 64 * 1024;
constexpr size_t O_CC = O_LOGF + 768 * 1024;
constexpr size_t O_GG = O_CC + 768 * 1024;
constexpr size_t O_SPL = O_GG + 4096;
constexpr size_t O_TSC = O_SPL + 8192;
constexpr size_t O_ROWSS = O_SMALL + 2 * MiB;
constexpr size_t O_RSP = O_ROWSS + 2 * MiB;
constexpr size_t O_QMSS = O_RSP;
constexpr size_t O_MKSS = O_QMSS + 1 * MiB;
constexpr size_t O_SSL1 = O_MKSS + 1 * MiB;
constexpr size_t O_CARRY = O_SSL1 + 7 * MiB;
constexpr size_t O_MEMN = O_CARRY + 3 * MiB;
constexpr size_t O_MKV = O_MEMN + 8 * MiB;
constexpr size_t O_IDX = O_MKV + 20 * MiB;
constexpr size_t O_GW = O_IDX + 8 * MiB;
constexpr size_t O_TAB = O_GW + 8 * MiB;
constexpr size_t TAB_NIB = (size_t)8 * 16384 * 128, TAB_ONE = TAB_NIB + (size_t)16384 * 16 + 786432;
constexpr size_t O_XS16 = O_TAB + 128 * MiB;
constexpr size_t O_CAT = O_XS16 + 64 * MiB;
constexpr size_t O_ZX = O_CAT + 64 * MiB;
constexpr size_t O_X8 = O_ZX;
constexpr size_t O_GY = O_ZX + 48 * MiB;
constexpr size_t O_LOGFP = O_GY + 48 * MiB;
constexpr size_t O_QM = O_LOGFP;
constexpr size_t O_XC = O_QM + 16 * MiB;
constexpr size_t O_X4 = O_XC;
constexpr size_t O_SX = O_XC + 32 * MiB;
constexpr size_t O_AA = O_XC + 48 * MiB;
constexpr size_t O_PART = O_AA;
constexpr size_t O_UU = O_AA + 96 * MiB;
constexpr size_t O_W8 = O_UU;
constexpr size_t O_Q16 = O_UU + 96 * MiB;
constexpr size_t O_ZL1 = O_Q16 + 64 * MiB;
constexpr size_t WS_END = O_ZL1 + 160 * MiB;
static_assert(WS_END <= 1024 * MiB, "workspace map");

__device__ __forceinline__ unsigned cvtpk(float lo, float hi) { unsigned r; asm volatile("v_cvt_pk_bf16_f32 %0, %1, %2" : "=v"(r) : "v"(lo), "v"(hi)); return r; }
__device__ __forceinline__ float bf_lo(unsigned w) { return __uint_as_float(w << 16); }
__device__ __forceinline__ float bf_hi(unsigned w) { return __uint_as_float(w & 0xffff0000u); }
__device__ __forceinline__ float fast_exp(float x) { return __builtin_amdgcn_exp2f(x * 1.4426950408889634f); }
__device__ __forceinline__ float log1p_pos(float y) { const float ser = y * (1.f - y * (0.5f - y * (0.33333334f - 0.25f * y))); const float lg = __builtin_amdgcn_logf(1.f + y) * 0.6931471805599453f; return y < 0.03f ? ser : lg; }
__device__ __forceinline__ float one_minus_exp(float x) { const float ser = -x * (1.f + x * (0.5f + x * (0.16666667f + x * 0.041666668f))); const float big = 1.f - fast_exp(x); return x > -0.03f ? ser : big; }
__device__ __forceinline__ float sigmoidf_(float x) { return __builtin_amdgcn_rcpf(1.f + fast_exp(-x)); }
__device__ __forceinline__ float gelu_tanh(float x) { const float u = x * (1.f + 0.044715f * x * x); return x * __builtin_amdgcn_rcpf(1.f + __builtin_amdgcn_exp2f(u * (-2.f * 0.7978845608028654f * 1.4426950408889634f))); }
template <int CTRL> __device__ __forceinline__ float dppf(float v) { return __int_as_float(__builtin_amdgcn_update_dpp(0, __float_as_int(v), CTRL, 0xF, 0xF, true)); }
__device__ __forceinline__ float xsum16(float v) { auto r = __builtin_amdgcn_permlane16_swap(__float_as_uint(v), __float_as_uint(v), false, false); return __uint_as_float(r[0]) + __uint_as_float(r[1]); }
__device__ __forceinline__ float xsum32(float v) { auto r = __builtin_amdgcn_permlane32_swap(__float_as_uint(v), __float_as_uint(v), false, false); return __uint_as_float(r[0]) + __uint_as_float(r[1]); }
__device__ __forceinline__ float xmax16(float v) { auto r = __builtin_amdgcn_permlane16_swap(__float_as_uint(v), __float_as_uint(v), false, false); return fmaxf(__uint_as_float(r[0]), __uint_as_float(r[1])); }
__device__ __forceinline__ float xmax32(float v) { auto r = __builtin_amdgcn_permlane32_swap(__float_as_uint(v), __float_as_uint(v), false, false); return fmaxf(__uint_as_float(r[0]), __uint_as_float(r[1])); }
__device__ __forceinline__ float wave_sum(float v) {
    v += dppf<0xB1>(v); v += dppf<0x4E>(v); v += dppf<0x141>(v); v += dppf<0x140>(v);
    v = xsum16(v); v = xsum32(v); return v;
}
__device__ __forceinline__ float wave_max(float v) {
    v = fmaxf(v, dppf<0xB1>(v)); v = fmaxf(v, dppf<0x4E>(v)); v = fmaxf(v, dppf<0x141>(v)); v = fmaxf(v, dppf<0x140>(v));
    v = xmax16(v); v = xmax32(v); return v;
}

namespace pg8 {
constexpr int BM = 256, BK = 64, HALF = 128, HTB = HALF * BK * 2, STAGE_BYTES = 8 * HTB, NXCD = 8, WGM = 8;
__host__ __device__ __forceinline__ int lds_byte(int r, int c) { const int st = (r >> 4) * 2 + (c >> 5), rr = r & 15, cc = c & 31, ob = rr * 64 + cc * 2; return st * 1024 + (ob ^ (((ob >> 9) & 1) << 5)); }
__host__ __device__ __forceinline__ void stage_rc(int b, int& R, int& C) { const int st = b / 1024, sb = b % 1024, swz = sb ^ (((sb >> 9) & 1) << 5); R = (st >> 1) * 16 + swz / 64; C = (st & 1) * 32 + (swz % 64) / 2; }
__host__ __device__ __forceinline__ int perm32(int rho) { const int n = rho >> 4, i = rho & 15; return 8 * (i >> 2) + 4 * n + (i & 3); }

struct Unit { int pm, pn; };
struct Gemm { const GAS bf16_t* A; const GAS bf16_t* Bt; int M, N, K, lda, ldb, acol; };

struct StaticOrder {
    int nM, nN, nwg, G, c;
    __device__ void init(int M, int N, int G_, int c_) { nM = M / BM; nN = N / BM; nwg = nM * nN; G = G_; c = c_; }
    __device__ bool next(int i, Unit& u) const {
        const long L = (long)i * G + c; if (L >= nwg) return false;
        int wgid = (int)L; { const int q = nwg / NXCD, r = nwg % NXCD, xcd = wgid % NXCD, off = wgid / NXCD; wgid = (xcd < r ? xcd * (q + 1) : r * (q + 1) + (xcd - r) * q) + off; }
        const int nig = WGM * nN, gid = wgid / nig, fm = gid * WGM, gsz = (nM - fm) < WGM ? (nM - fm) : WGM;
        u.pm = fm + ((wgid % nig) % gsz); u.pn = (wgid % nig) / gsz; return true;
    }
};

typedef int v8i_t __attribute__((ext_vector_type(8)));
typedef int v4i_t __attribute__((ext_vector_type(4)));
template <class Epi, bool FP8>
__device__ __forceinline__ void gemm_phase(LAS unsigned char* lds, const Gemm g, const StaticOrder& S, const Epi& E, const int tid) {
    const int wid = __builtin_amdgcn_readfirstlane(tid >> 6), lane = tid & 63, wr = wid >> 2, wc = wid & 3, fr = lane & 15, fq = lane >> 4;
    const int K = g.K, nt = K / BK;
    unsigned voffA[2], voffB[2];
#pragma unroll
    for (int i = 0; i < 2; ++i) { int R, C; stage_rc(tid * 16 + i * 8192, R, C); const int Rb = (R & ~31) + perm32(R & 31);
        voffA[i] = (unsigned)(R * g.lda + C) * 2u; voffB[i] = (unsigned)(Rb * g.ldb + C) * 2u; }
    const size_t kstep = (size_t)(BK * 2);
    const size_t hstepA = (size_t)HALF * g.lda * 2, hstepB = (size_t)HALF * g.ldb * 2;
    const size_t tstepA = 2 * hstepA, tstepB = 2 * hstepB;
    const unsigned ldsw = (unsigned)wid * 1024u;
    const int aoff = lds_byte(wr * 64 + fr, fq * 8), boff = lds_byte(wc * 32 + fr, fq * 8);
#define PG8_SA(b, h) (((b) * 2 + (h)) * HTB)
#define PG8_SB(b, h) ((4 + (b) * 2 + (h)) * HTB)
#define PG8_STAGE(bufoff, gbase, voff) do { _Pragma("unroll") for (int _i = 0; _i < 2; ++_i) \
        __builtin_amdgcn_global_load_lds((const GAS unsigned*)((gbase) + (voff)[_i]), (LAS unsigned*)(lds + (bufoff) + ldsw + _i * 8192), 16, 0, 0); } while (0)
#define PG8_LD2(dst, off_) do { const u32x4 lo_ = *(const LAS u32x4*)(lds + (off_)), hi_ = *(const LAS u32x4*)(lds + (off_) + 1024); \
        dst = (v8i_t){(int)lo_.x, (int)lo_.y, (int)lo_.z, (int)lo_.w, (int)hi_.x, (int)hi_.y, (int)hi_.z, (int)hi_.w}; } while (0)
#define PG8_LDA(dst, b, h) do { _Pragma("unroll") for (int m = 0; m < 4; ++m) PG8_LD2(dst[m], PG8_SA(b, h) + aoff + m * 2048); } while (0)
#define PG8_LDB(dst, b, h) do { _Pragma("unroll") for (int n = 0; n < 2; ++n) PG8_LD2(dst[n], PG8_SB(b, h) + boff + n * 2048); } while (0)
#define PG8_HALF(v, k) ((k) ? __builtin_shufflevector(v, v, 4, 5, 6, 7) : __builtin_shufflevector(v, v, 0, 1, 2, 3))
#define PG8_MMA(ai, bj, At, Bt) do { __builtin_amdgcn_s_setprio(1); _Pragma("unroll") for (int m = 0; m < 4; ++m) _Pragma("unroll") for (int n = 0; n < 2; ++n) { \
        if constexpr (FP8) asm volatile("v_mfma_scale_f32_16x16x128_f8f6f4 %0, %1, %2, %0, %3, %4 op_sel_hi:[0,0,0]" : "+v"(acc[ai][bj][m][n]) : "v"(Bt[n]), "v"(At[m]), "v"(sc_w), "v"(sc_x));     \
        else { _Pragma("unroll") for (int k = 0; k < 2; ++k) { const v4i_t bh_ = PG8_HALF(Bt[n], k), ah_ = PG8_HALF(At[m], k); \
                acc[ai][bj][m][n] = __builtin_amdgcn_mfma_f32_16x16x32_bf16(__builtin_bit_cast(bf16x8, bh_), __builtin_bit_cast(bf16x8, ah_), acc[ai][bj][m][n], 0, 0, 0); } } } \
        __builtin_amdgcn_s_setprio(0); } while (0)
#define PG8_WAIT_V(n) asm volatile("s_waitcnt vmcnt(" #n ")" ::: "memory")
#define PG8_WAIT_L(n) asm volatile("s_waitcnt lgkmcnt(" #n ")" ::: "memory")
#define PG8_BAR __builtin_amdgcn_s_barrier()
#define PG8_SCHED __builtin_amdgcn_sched_barrier(0)
    Unit cur, nxt; int ui = 0;
    if (!S.next(0, cur)) return;
    f32x4 acc[2][2][4][2];
#pragma unroll
    for (int a = 0; a < 2; ++a)
#pragma unroll
        for (int b = 0; b < 2; ++b)
#pragma unroll
            for (int m = 0; m < 4; ++m)
#pragma unroll
                for (int n = 0; n < 2; ++n) acc[a][b][m][n] = (f32x4){0.f, 0.f, 0.f, 0.f};
    v8i_t At[4], B0[2], B1[2];
    const int sc_w = 121, sc_x = 127;
    const GAS char* cA = (const GAS char*)g.A + (size_t)cur.pm * tstepA + (size_t)cur.pn * g.acol * 2; const GAS char* cB = (const GAS char*)g.Bt + (size_t)cur.pn * tstepB;
    PG8_STAGE(PG8_SB(0, 0), cB, voffB); PG8_STAGE(PG8_SB(0, 1), cB + hstepB, voffB); PG8_STAGE(PG8_SA(0, 0), cA, voffA); PG8_STAGE(PG8_SA(0, 1), cA + hstepA, voffA);
    if (wr == 1) PG8_BAR;
    PG8_WAIT_V(2); PG8_BAR;
    PG8_STAGE(PG8_SB(1, 0), cB + kstep, voffB); PG8_STAGE(PG8_SA(1, 0), cA + kstep, voffA); PG8_STAGE(PG8_SB(1, 1), cB + hstepB + kstep, voffB);
    PG8_WAIT_V(6); PG8_BAR;
    for (;;) {
        const bool has_next = S.next(ui + 1, nxt);
        const GAS char* nA = has_next ? (const GAS char*)g.A + (size_t)nxt.pm * tstepA + (size_t)nxt.pn * g.acol * 2 : cA; const GAS char* nB = has_next ? (const GAS char*)g.Bt + (size_t)nxt.pn * tstepB : cB;
        for (int t = 0; t < nt; t += 2) {
            const bool last = (t == nt - 2);
            const GAS char* a1 = cA + (size_t)(t + 1) * kstep;
            const GAS char* a2 = last ? nA : cA + (size_t)(t + 2) * kstep; const GAS char* b2 = last ? nB : cB + (size_t)(t + 2) * kstep;
            const GAS char* a3 = a2 + kstep; const GAS char* b3 = b2 + kstep;
            PG8_LDB(B0, 0, 0); PG8_LDB(B1, 0, 1); PG8_SCHED; PG8_LDA(At, 0, 0); PG8_STAGE(PG8_SA(1, 1), a1 + hstepA, voffA);
            PG8_WAIT_V(8); PG8_WAIT_L(0); PG8_BAR; PG8_MMA(0, 0, At, B0); PG8_MMA(0, 1, At, B1); PG8_BAR; PG8_SCHED;
            PG8_LDA(At, 0, 1); PG8_STAGE(PG8_SB(0, 0), b2, voffB); PG8_STAGE(PG8_SB(0, 1), b2 + hstepB, voffB); PG8_STAGE(PG8_SA(0, 0), a2, voffA);
            PG8_WAIT_V(8); PG8_WAIT_L(0); PG8_BAR; PG8_MMA(1, 0, At, B0); PG8_MMA(1, 1, At, B1); PG8_BAR; PG8_SCHED;
            PG8_LDB(B0, 1, 0); PG8_LDB(B1, 1, 1); PG8_SCHED; PG8_LDA(At, 1, 0); PG8_STAGE(PG8_SA(0, 1), a2 + hstepA, voffA);
            PG8_WAIT_V(8); PG8_WAIT_L(0); PG8_BAR; PG8_MMA(0, 0, At, B0); PG8_MMA(0, 1, At, B1); PG8_BAR; PG8_SCHED;
            PG8_LDA(At, 1, 1); PG8_STAGE(PG8_SB(1, 0), b3, voffB); PG8_STAGE(PG8_SB(1, 1), b3 + hstepB, voffB); PG8_STAGE(PG8_SA(1, 0), a3, voffA);
            PG8_WAIT_V(8); PG8_WAIT_L(0); PG8_BAR; PG8_MMA(1, 0, At, B0); PG8_MMA(1, 1, At, B1); PG8_BAR; PG8_SCHED;
        }
        if (wr == 0) PG8_BAR;
        { int ln_; asm volatile("v_mbcnt_lo_u32_b32 %0, -1, 0\n\tv_mbcnt_hi_u32_b32 %0, -1, %0" : "=v"(ln_));
          E(acc, cur, wr, wc, ln_ & 15, ln_ >> 4); }
        if (!has_next) break;
#pragma unroll
        for (int a = 0; a < 2; ++a)
#pragma unroll
            for (int b = 0; b < 2; ++b)
#pragma unroll
                for (int m = 0; m < 4; ++m)
#pragma unroll
                    for (int n = 0; n < 2; ++n) acc[a][b][m][n] = (f32x4){0.f, 0.f, 0.f, 0.f};
        cur = nxt; cA = nA; cB = nB; ++ui;
        if (wr == 1) PG8_BAR;
    }
    PG8_WAIT_V(0);
    PG8_BAR;
#undef PG8_SA
#undef PG8_SB
#undef PG8_STAGE
#undef PG8_LDA
#undef PG8_LDB
#undef PG8_LD2
#undef PG8_HALF
#undef PG8_MMA
#undef PG8_WAIT_V
#undef PG8_WAIT_L
#undef PG8_BAR
#undef PG8_SCHED
}
}

enum { EM_IN0 = 0, EM_MKV = 1, EM_GATE = 2, EM_RES = 3, EM_PQ = 4, EM_L1 = 5 };
struct Epi {
    int mode;
    GAS unsigned char* ws;
    const GAS float* resid;
    GAS float* outf;
    GAS bf16_t* o16;
    GAS float* ssq;
    const GAS float* gate_b;
    typedef pg8::Unit Unit;
    __device__ __forceinline__ static void st8(GAS bf16_t* p, f32x4 v0, f32x4 v1) {
        u32x4 w; w.x = cvtpk(v0[0], v0[1]); w.y = cvtpk(v0[2], v0[3]); w.z = cvtpk(v1[0], v1[1]); w.w = cvtpk(v1[2], v1[3]); *(GAS u32x4*)p = w; }
    __device__ __forceinline__ static float sq8(f32x4 a, f32x4 b) { return (a[0] * a[0] + a[1] * a[1]) + (a[2] * a[2] + a[3] * a[3]) + (b[0] * b[0] + b[1] * b[1]) + (b[2] * b[2] + b[3] * b[3]); }
    __device__ __forceinline__ void operator()(f32x4 (&acc)[2][2][4][2], const Unit& u, int wr, int wc, int fr, int fq) const {
        const int row0 = u.pm * 256 + wr * 64 + fr;
        const int cin = wc * 32 + 8 * fq;
        if (mode == EM_IN0) {
            GAS bf16_t* base; int ld, colt; int kind;
            if (u.pn < 6) { base = (GAS bf16_t*)(ws + O_ZX); ld = LRU; colt = u.pn * 256; kind = 0; }
            else if (u.pn < 12) { base = (GAS bf16_t*)(ws + O_GY); ld = LRU; colt = (u.pn - 6) * 256; kind = 1; }
            else { base = (GAS bf16_t*)(ws + O_ZL1); ld = NL1; colt = 4608 + (u.pn - 12) * 256; kind = 2; }
            GAS float* qmss = (GAS float*)(ws + O_SSL1);
#pragma unroll
            for (int ai = 0; ai < 2; ++ai)
#pragma unroll
                for (int m = 0; m < 4; ++m) { const int row = row0 + ai * 128 + m * 16;
#pragma unroll
                    for (int bj = 0; bj < 2; ++bj) { f32x4 v0 = acc[ai][bj][m][0], v1 = acc[ai][bj][m][1];
                        if (kind == 1) {
#pragma unroll
                            for (int j = 0; j < 4; ++j) { v0[j] = gelu_tanh(v0[j]); v1[j] = gelu_tanh(v1[j]); } }
                        st8(base + (size_t)row * ld + colt + bj * 128 + cin, v0, v1);
                        if (kind == 2) { float s = sq8(v0, v1); s = xsum16(s); s = xsum32(s);
                            if (fq == 0) qmss[(size_t)row * 112 + (24 + (u.pn - 12) * 2 + bj) * 4 + wc] = s; } } }
        } else if (mode == EM_MKV) {
#pragma unroll
            for (int ai = 0; ai < 2; ++ai)
#pragma unroll
                for (int m = 0; m < 4; ++m) { const int row = row0 + ai * 128 + m * 16;
#pragma unroll
                    for (int bj = 0; bj < 2; ++bj) { const f32x4 v0 = acc[ai][bj][m][0], v1 = acc[ai][bj][m][1];
                        st8(o16 + (size_t)row * NL1 + u.pn * 256 + bj * 128 + cin, v0, v1);
                        if (u.pn < 2) { float s = sq8(v0, v1); s = xsum16(s); s = xsum32(s);
                            if (fq == 0) ssq[(size_t)row * 112 + (u.pn * 2 + bj) * 4 + wc] = s; } } }
        } else if (mode == EM_GATE) {
            const int ch = u.pn * 128 + cin;
            const GAS bf16_t* xc = (const GAS bf16_t*)(ws + O_XC); GAS _Float16* LA = (GAS _Float16*)(ws + O_AA); GAS _Float16* UH = (GAS _Float16*)(ws + O_UU);
            const GAS float* spl = (const GAS float*)(ws + O_SPL) + ch; const GAS float* gb = gate_b + u.pn * 256 + cin;
#pragma unroll
            for (int n = 0; n < 2; ++n) {
                const f32x4 sp = *(const GAS f32x4*)(spl + 4 * n), br = *(const GAS f32x4*)(gb + 4 * n), bi = *(const GAS f32x4*)(gb + 128 + 4 * n);
#pragma unroll
                for (int ai = 0; ai < 2; ++ai)
#pragma unroll
                    for (int m = 0; m < 4; ++m) { const int row = row0 + ai * 128 + m * 16;
                        const u32x2 xw = *(const GAS u32x2*)(xc + (size_t)row * LRU + ch + 4 * n);
                        const f32x4 xv = {bf_lo(xw.x), bf_hi(xw.x), bf_lo(xw.y), bf_hi(xw.y)};
                        float lav[4], uvv[4];
#pragma unroll
                        for (int j = 0; j < 4; ++j) { const float r = sigmoidf_(acc[ai][0][m][n][j] + br[j]), ig = sigmoidf_(acc[ai][1][m][n][j] + bi[j]);
                            const float la = -8.f * r * sp[j];
                            lav[j] = la; uvv[j] = __builtin_amdgcn_sqrtf(one_minus_exp(2.f * la)) * (ig * xv[j]); }
                        { const h2 l0 = {(_Float16)lav[0], (_Float16)lav[1]}, l1 = {(_Float16)lav[2], (_Float16)lav[3]}, u0 = {(_Float16)uvv[0], (_Float16)uvv[1]}, u1 = {(_Float16)uvv[2], (_Float16)uvv[3]};
                          *(GAS u32x2*)(LA + (size_t)row * LRU + ch + 4 * n) = (u32x2){__builtin_bit_cast(unsigned, l0), __builtin_bit_cast(unsigned, l1)};
                          *(GAS u32x2*)(UH + (size_t)row * LRU + ch + 4 * n) = (u32x2){__builtin_bit_cast(unsigned, u0), __builtin_bit_cast(unsigned, u1)}; } }
            }
        } else if (mode == EM_RES) {
            GAS bf16_t* xs = (GAS bf16_t*)(ws + O_XS16); GAS float* rowss = (GAS float*)(ws + O_ROWSS);
#pragma unroll
            for (int ai = 0; ai < 2; ++ai)
#pragma unroll
                for (int m = 0; m < 4; ++m) { const int row = row0 + ai * 128 + m * 16; float s = 0.f;
#pragma unroll
                    for (int bj = 0; bj < 2; ++bj) { const size_t off = (size_t)row * DM + u.pn * 256 + bj * 128 + cin;
                        f32x4 r0, r1;
                        if (resid) { r0 = *(const GAS f32x4*)(resid + off); r1 = *(const GAS f32x4*)(resid + off + 4); }
                        else { const u32x4 w = *(const GAS u32x4*)(xs + off); r0 = (f32x4){bf_lo(w.x), bf_hi(w.x), bf_lo(w.y), bf_hi(w.y)}; r1 = (f32x4){bf_lo(w.z), bf_hi(w.z), bf_lo(w.w), bf_hi(w.w)}; }
                        const f32x4 v0 = acc[ai][bj][m][0] + r0, v1 = acc[ai][bj][m][1] + r1;
                        st8(xs + off, v0, v1); s += sq8(v0, v1); }
                    s = xsum16(s); s = xsum32(s);
                    if (fq == 0) rowss[(size_t)row * 32 + u.pn * 4 + wc] = s; }
        } else if (mode == EM_PQ) {
            const GAS float* rowss = (const GAS float*)(ws + O_ROWSS);
#pragma unroll
            for (int ai = 0; ai < 2; ++ai)
#pragma unroll
                for (int m = 0; m < 4; ++m) { const int row = row0 + ai * 128 + m * 16;
                    const f32x4 p0 = *(const GAS f32x4*)(rowss + (size_t)row * 32 + fq * 8), p1 = *(const GAS f32x4*)(rowss + (size_t)row * 32 + fq * 8 + 4);
                    float s = (p0[0] + p0[1]) + (p0[2] + p0[3]) + (p1[0] + p1[1]) + (p1[2] + p1[3]); s = xsum16(s); s = xsum32(s);
                    const float r = rsqrtf(s * (1.f / DM) + EPS);
#pragma unroll
                    for (int bj = 0; bj < 2; ++bj) st8(o16 + (size_t)row * DM + u.pn * 256 + bj * 128 + cin, acc[ai][bj][m][0] * r, acc[ai][bj][m][1] * r); }
        } else {
            const GAS float* rsp = (const GAS float*)(ws + O_RSP); GAS bf16_t* zl1 = (GAS bf16_t*)(ws + O_ZL1); GAS float* ssl1 = (GAS float*)(ws + O_SSL1);
            const int slot0 = u.pn < 6 ? u.pn * 2 : (u.pn >= 12 ? 12 + (u.pn - 12) * 2 : -1);
#pragma unroll
            for (int ai = 0; ai < 2; ++ai)
#pragma unroll
                for (int m = 0; m < 4; ++m) { const int row = row0 + ai * 128 + m * 16;
                    const f32x4 q0 = *(const GAS f32x4*)(rsp + (size_t)row * 8), q1 = *(const GAS f32x4*)(rsp + (size_t)row * 8 + 4);
                    const float r = rsqrtf(((q0[0] + q0[1]) + (q0[2] + q0[3]) + (q1[0] + q1[1]) + (q1[2] + q1[3])) * (1.f / DM) + EPS);
#pragma unroll
                    for (int bj = 0; bj < 2; ++bj) { const f32x4 v0 = acc[ai][bj][m][0] * r, v1 = acc[ai][bj][m][1] * r;
                        st8(zl1 + (size_t)row * NL1 + u.pn * 256 + bj * 128 + cin, v0, v1);
                        if (slot0 >= 0) { float s = sq8(v0, v1); s = xsum16(s); s = xsum32(s);
                            if (fq == 0) ssl1[(size_t)row * 112 + (slot0 + bj) * 4 + wc] = s; } } }
        }
    }
};

namespace att {
constexpr float SCALE = 0.08838834764831845f;
constexpr int NW = 8, QBLK = 32, KVBLK = 64, QB = NW * QBLK, D = 128;
constexpr int SHM_V = KVBLK * D * 2, SHM_K = KVBLK * D * 2;
constexpr int OFF_WS = 2 * SHM_V + 2 * SHM_K;
constexpr int OFF_KS = OFF_WS + 2048;
constexpr int OFF_BS = OFF_KS + 16384;
constexpr int LDS_END = OFF_BS + 16384;
constexpr int WBIG = 1 << 28;

#define KSWZ(row, colB) ((row) * 256 + ((colB) ^ (((row) & 7) << 4)))
#define SBAR() __builtin_amdgcn_sched_barrier(0)
__device__ __forceinline__ int v_st(int k, int c) { const int kk = (k & ~0xC) | ((k & 4) << 1) | ((k & 8) >> 1); return ((kk >> 3) * 4 + (c >> 5)) * 512 + ((kk & 7) * 32 + (c & 31)) * 2; }
__device__ __forceinline__ int v_rd_base(int lane) { return ((lane & 3) << 3) | (((lane >> 2) & 3) << 6) | (((lane >> 4) & 1) << 5) | (((lane >> 5) & 1) << 8); }
constexpr int v_rd_off(int d0, int ks, int half) { return d0 * 512 + ks * 4096 + half * 2048; }
__device__ __forceinline__ int crow(int r, int hi) { return (r & 3) + 8 * (r >> 2) + 4 * hi; }
__device__ __forceinline__ bf16x8 load8(const GAS bf16_t* p) { return *(const GAS bf16x8*)p; }
__device__ __forceinline__ bf16x8 scale8(bf16x8 v, float s) { const u32x4 w = *reinterpret_cast<u32x4*>(&v); u32x4 o;
    o.x = cvtpk(bf_lo(w.x) * s, bf_hi(w.x) * s); o.y = cvtpk(bf_lo(w.y) * s, bf_hi(w.y) * s); o.z = cvtpk(bf_lo(w.z) * s, bf_hi(w.z) * s); o.w = cvtpk(bf_lo(w.w) * s, bf_hi(w.w) * s);
    return *reinterpret_cast<bf16x8*>(&o); }
__device__ __forceinline__ void mask_tile(f32x16& p0, f32x16& p1, int dq, unsigned W) {
    const float NEG = -__builtin_inff();
#pragma unroll
    for (int r = 0; r < 16; ++r) {
        const int c = (r & 3) + 8 * (r >> 2);
        if ((unsigned)(dq - c) >= W) p0[r] = NEG;
        if ((unsigned)(dq - c - 32) >= W) p1[r] = NEG;
    }
}
constexpr float THR = 8.f;
__device__ __forceinline__ void partialSM(f32x16& p0, f32x16& p1, float& m_reg, float& mn, float& alpha) {
    float pmax = p0[0]; for (int r = 1; r < 16; ++r) pmax = fmaxf(pmax, p0[r]); for (int r = 0; r < 16; ++r) pmax = fmaxf(pmax, p1[r]);
    { auto rr = __builtin_amdgcn_permlane32_swap(__float_as_uint(pmax), __float_as_uint(pmax), false, false);
      pmax = fmaxf(__uint_as_float(rr[0]), __uint_as_float(rr[1])); }
    constexpr float C2 = 1.4426950408889634f * SCALE;
    if (__builtin_expect(__all((pmax - m_reg) * SCALE <= THR), 1)) { mn = m_reg; alpha = 1.f; }
    else { mn = fmaxf(m_reg, pmax); alpha = __builtin_amdgcn_exp2f((m_reg - mn) * C2); m_reg = mn; }
    const float mnL = -mn * C2;
    for (int r = 0; r < 16; ++r) p0[r] = fmaf(p0[r], C2, mnL); for (int r = 0; r < 16; ++r) p1[r] = fmaf(p1[r], C2, mnL);
    for (int r = 0; r < 16; ++r) p0[r] = __builtin_amdgcn_exp2f(p0[r]);
}
__device__ __forceinline__ void finishSM(f32x16& p0, f32x16& p1, float alpha, float& l_reg, bf16x8& pa0, bf16x8& pa1, bf16x8& pa2, bf16x8& pa3) {
    for (int r = 0; r < 16; ++r) p1[r] = __builtin_amdgcn_exp2f(p1[r]);
    float ps = 0; for (int r = 0; r < 16; ++r) ps += p0[r]; for (int r = 0; r < 16; ++r) ps += p1[r];
    { auto rr = __builtin_amdgcn_permlane32_swap(__float_as_uint(ps), __float_as_uint(ps), false, false);
      ps = __uint_as_float(rr[0]) + __uint_as_float(rr[1]); }
    l_reg = l_reg * alpha + ps;
#define PK4(P, B_, OUT) do { unsigned a0 = cvtpk(P[B_+0], P[B_+1]), a1 = cvtpk(P[B_+2], P[B_+3]);                          \
        unsigned b0 = cvtpk(P[B_+4], P[B_+5]), b1 = cvtpk(P[B_+6], P[B_+7]);                                             \
        auto r0 = __builtin_amdgcn_permlane32_swap(a0, b0, false, false); auto r1 = __builtin_amdgcn_permlane32_swap(a1, b1, false, false); \
        u32x4 w = {r0[0], r1[0], r0[1], r1[1]}; OUT = *reinterpret_cast<bf16x8*>(&w); } while (0)
    PK4(p0, 0, pa0); PK4(p0, 8, pa1); PK4(p1, 0, pa2); PK4(p1, 8, pa3);
#undef PK4
}
template <int KB>
__device__ __forceinline__ void qkt(f32x16& p0, f32x16& p1, const char* K_lds, int r32, int hi, const bf16x8* qr, const float* bp  ) {
    { const f32x4 a = *(const f32x4*)(bp), b = *(const f32x4*)(bp + 8), c = *(const f32x4*)(bp + 16), d = *(const f32x4*)(bp + 24);
      p0 = (f32x16){a[0], a[1], a[2], a[3], b[0], b[1], b[2], b[3], c[0], c[1], c[2], c[3], d[0], d[1], d[2], d[3]}; }
    { const f32x4 a = *(const f32x4*)(bp + 32), b = *(const f32x4*)(bp + 40), c = *(const f32x4*)(bp + 48), d = *(const f32x4*)(bp + 56);
      p1 = (f32x16){a[0], a[1], a[2], a[3], b[0], b[1], b[2], b[3], c[0], c[1], c[2], c[3], d[0], d[1], d[2], d[3]}; }
    const char* kb[4];
#pragma unroll
    for (int dd = 0; dd < 4; ++dd) kb[dd] = K_lds + KB * SHM_K + KSWZ(r32, (dd * 16 + hi * 8) * 2);
#pragma unroll
    for (int d0 = 0; d0 < 8; ++d0) { const char* a = kb[d0 & 3] + (d0 >> 2) * 128;
        bf16x8 b0 = *reinterpret_cast<const bf16x8*>(a);
        bf16x8 b1 = *reinterpret_cast<const bf16x8*>(a + 32 * 256);
        p0 = __builtin_amdgcn_mfma_f32_32x32x16_bf16(b0, qr[d0], p0, 0, 0, 0);
        p1 = __builtin_amdgcn_mfma_f32_32x32x16_bf16(b1, qr[d0], p1, 0, 0, 0); }
}
template <int KB>
__device__ __forceinline__ void qkt0(f32x16& p0, f32x16& p1, const char* K_lds, int r32, int hi, const bf16x8* qr) {
    p0 = f32x16{}; p1 = f32x16{};
    const char* kb[4];
#pragma unroll
    for (int dd = 0; dd < 4; ++dd) kb[dd] = K_lds + KB * SHM_K + KSWZ(r32, (dd * 16 + hi * 8) * 2);
#pragma unroll
    for (int d0 = 0; d0 < 8; ++d0) { const char* a = kb[d0 & 3] + (d0 >> 2) * 128;
        bf16x8 b0 = *reinterpret_cast<const bf16x8*>(a);
        bf16x8 b1 = *reinterpret_cast<const bf16x8*>(a + 32 * 256);
        p0 = __builtin_amdgcn_mfma_f32_32x32x16_bf16(b0, qr[d0], p0, 0, 0, 0);
        p1 = __builtin_amdgcn_mfma_f32_32x32x16_bf16(b1, qr[d0], p1, 0, 0, 0); }
}
template <int VB>
__device__ __forceinline__ void pv_tile(f32x16* o, int vb0, bf16x8 pa0, bf16x8 pa1, bf16x8 pa2, bf16x8 pa3) {
#define TRRD(dst, off) asm volatile("ds_read_b64_tr_b16 %0, %1 offset:%2" : "=&v"(dst) : "v"(vb0), "i"(off) : "memory")
#define PV_D0(d0) do { s16x4 l0, l1, l2, l3, h0, h1, h2_, h3; constexpr int b_ = VB * SHM_V + v_rd_off(d0, 0, 0); \
        TRRD(l0, b_); TRRD(h0, b_ + 2048); TRRD(l1, b_ + 4096); TRRD(h1, b_ + 6144); TRRD(l2, b_ + 8192); TRRD(h2_, b_ + 10240); TRRD(l3, b_ + 12288); TRRD(h3, b_ + 14336); \
        asm volatile("s_waitcnt lgkmcnt(0)" ::: "memory"); SBAR();   \
        o[d0] = __builtin_amdgcn_mfma_f32_32x32x16_bf16(pa0, (bf16x8){l0[0], l0[1], l0[2], l0[3], h0[0], h0[1], h0[2], h0[3]}, o[d0], 0, 0, 0);   \
        o[d0] = __builtin_amdgcn_mfma_f32_32x32x16_bf16(pa1, (bf16x8){l1[0], l1[1], l1[2], l1[3], h1[0], h1[1], h1[2], h1[3]}, o[d0], 0, 0, 0);   \
        o[d0] = __builtin_amdgcn_mfma_f32_32x32x16_bf16(pa2, (bf16x8){l2[0], l2[1], l2[2], l2[3], h2_[0], h2_[1], h2_[2], h2_[3]}, o[d0], 0, 0, 0);   \
        o[d0] = __builtin_amdgcn_mfma_f32_32x32x16_bf16(pa3, (bf16x8){l3[0], l3[1], l3[2], l3[3], h3[0], h3[1], h3[2], h3[3]}, o[d0], 0, 0, 0); } while (0)
    PV_D0(0); PV_D0(1); PV_D0(2); PV_D0(3);
#undef PV_D0
#undef TRRD
}

struct BlockRef { const GAS bf16_t* Q; const GAS bf16_t* K; const GAS bf16_t* V; GAS bf16_t* O; const GAS float* qss; const GAS float* kss; const GAS float* cc; const GAS float* gg;
                  int P0, skv; };
constexpr int LDQ = 5120, LDK = 5120, LDO = 2048, LDSS = 112;
struct Seam { bf16x8 qr[8]; bf16x8 st_v0, st_v1, st_k0, st_k1; int jlo; };
#define ROWK(p, k0, rr) ((p) + (size_t)((k0) + (rr)) * LDK + sc)
#define VMW() asm volatile("s_waitcnt vmcnt(0)" ::: "memory")
#define VMWN(n) asm volatile("s_waitcnt vmcnt(%0)" :: "i"(n) : "memory")
#define SLOAD_H(Kp, Vp, k0) do { S.st_v0 = load8(ROWK(Vp, k0, sr)); S.st_v1 = load8(ROWK(Vp, k0, 32 + sr));              \
                         S.st_k0 = load8(ROWK(Kp, k0, sr)); S.st_k1 = load8(ROWK(Kp, k0, 32 + sr)); } while (0)
#define SWRITE_HK(bf, k0) do { *(bf16x8*)(K_lds + (bf) * SHM_K + kws) = scale8(S.st_k0, ksr[(k0)]); *(bf16x8*)(K_lds + (bf) * SHM_K + kws + 32 * 256) = scale8(S.st_k1, ksr[(k0) + 32]); } while (0)
#define SWRITE_HV(bf) do { *(bf16x8*)(V_lds + (bf) * SHM_V + vst0) = S.st_v0; *(bf16x8*)(V_lds + (bf) * SHM_V + vst1) = S.st_v1; } while (0)
#define SWRITE_H(bf, k0) do { SWRITE_HV(bf); SWRITE_HK(bf, k0); } while (0)

__device__ __forceinline__ void attn_prime(const BlockRef& cur, char* lds, Seam& S, const int tid) {
    const int wid = __builtin_amdgcn_readfirstlane(tid >> 6), lane = tid & 63, r32 = lane & 31, hi = lane >> 5;
    const int sr = tid >> 4, sc = (tid & 15) * 8, kws = KSWZ(sr, sc * 2); char* K_lds = lds + 2 * SHM_V;
    float* ks_l = (float*)(lds + OFF_KS); float* bs_l = (float*)(lds + OFF_BS); const float* ksr = ks_l + sr;
    int j_hi = (cur.P0 + QB - 1) / KVBLK + 1; if (j_hi > cur.skv / KVBLK) j_hi = cur.skv / KVBLK;
    const int nkeys = j_hi * KVBLK;
    const float c0 = cur.cc ? cur.cc[cur.P0] : 0.f;
    int jlo = 0;
    if (cur.cc) { const float thr = cur.gg[128]; const int jd = cur.P0 / KVBLK;
        const float cv = lane <= jd ? cur.cc[lane * KVBLK + KVBLK - 1] : 0.f;
        const bool keep = lane > jd || (c0 - cv > -thr);
        jlo = __ffsll((long long)__ballot(keep)) - 1; }
    S.jlo = jlo;
    for (int s = jlo * KVBLK + tid; s < nkeys; s += NTHREADS) {
        const f32x4 p = *(const GAS f32x4*)(cur.kss + (size_t)s * LDSS);
        ks_l[s] = rsqrtf(((p[0] + p[1]) + (p[2] + p[3])) * (1.f / 128.f) + EPS);
        bs_l[s] = cur.cc ? (c0 - cur.cc[s]) * (1.f / SCALE) : 0.f;
    }
    __syncthreads();
    const int qrow = wid * QBLK + r32;
    const f32x4 qp = *(const GAS f32x4*)(cur.qss + (size_t)qrow * LDSS);
    const float rq = rsqrtf(((qp[0] + qp[1]) + (qp[2] + qp[3])) * (1.f / 128.f) + EPS);
#pragma unroll
    for (int d0 = 0; d0 < 8; ++d0) {
        const u32x4 w = *(const GAS u32x4*)(cur.Q + (size_t)qrow * LDQ + d0 * 16 + hi * 8);
        const f32x4 g0 = *(const GAS f32x4*)(cur.gg + d0 * 16 + hi * 8), g1 = *(const GAS f32x4*)(cur.gg + d0 * 16 + hi * 8 + 4);
        u32x4 o; o.x = cvtpk(bf_lo(w.x) * rq * g0[0], bf_hi(w.x) * rq * g0[1]); o.y = cvtpk(bf_lo(w.y) * rq * g0[2], bf_hi(w.y) * rq * g0[3]);
        o.z = cvtpk(bf_lo(w.z) * rq * g1[0], bf_hi(w.z) * rq * g1[1]); o.w = cvtpk(bf_lo(w.w) * rq * g1[2], bf_hi(w.w) * rq * g1[3]);
        S.qr[d0] = *reinterpret_cast<bf16x8*>(&o);
    }
    SLOAD_H(cur.K, cur.V, jlo * KVBLK); VMW(); SWRITE_HK(0, jlo * KVBLK);
    __syncthreads();
}
__device__ __forceinline__ void attn_block(const BlockRef& cur, char* lds, Seam& S, const int tid) {
    const int wid = __builtin_amdgcn_readfirstlane(tid >> 6), lane = tid & 63, r32 = lane & 31, hi = lane >> 5;
    const int W = WBIG;
    int j_hi = (cur.P0 + QB - 1) / KVBLK + 1; if (j_hi > cur.skv / KVBLK) j_hi = cur.skv / KVBLK;
    const int j_lo = S.jlo; const int NT = j_hi - j_lo;
    const int qlo = cur.P0 - j_lo * KVBLK + wid * QBLK, qm = qlo + r32 - 4 * hi;
    char* V_lds = lds; char* K_lds = lds + 2 * SHM_V;
    float* ws = (float*)(lds + OFF_WS) + wid * 64; float* li_l = ws, * al_l = ws + 32;
    const float* bs_l = (const float*)(lds + OFF_BS) + j_lo * KVBLK + 4 * hi;
    float m_reg = -1e30f, l_reg = 0; f32x16 o[4] = {};
    const int sr = tid >> 4, sc = (tid & 15) * 8, vst0 = v_st(sr, sc), vst1 = v_st(32 + sr, sc), kws = KSWZ(sr, sc * 2);
    const float* ksr = (const float*)(lds + OFF_KS) + j_lo * KVBLK + sr;
    const int vb0 = (int)(uintptr_t)V_lds + v_rd_base(lane);
    const GAS bf16_t* Kh = cur.K + (size_t)j_lo * KVBLK * LDK; const GAS bf16_t* Vh = cur.V + (size_t)j_lo * KVBLK * LDK;
#define RESC(a) do { if (__any((a) < 1.f)) { if (hi == 0) al_l[r32] = (a); asm volatile("s_waitcnt lgkmcnt(0)" ::: "memory");              \
                     for (int d_ = 0; d_ < 4; ++d_) for (int r = 0; r < 16; ++r) o[d_][r] *= al_l[crow(r, hi)]; } } while (0)
#define KBASE(t) ((t) * KVBLK)
#define MASKT(P0_, P1_, t) do { const int kb_ = KBASE(t); if (kb_ + KVBLK - 1 > qlo) mask_tile(P0_, P1_, qm - kb_, (unsigned)W); } while (0)
    f32x16 pA0, pA1, pB0, pB1; float mnA, mnB, alA, alB; bf16x8 pa0, pa1, pa2, pa3;
    SWRITE_HV(0); SBAR();
    if (NT > 1) { SLOAD_H(Kh, Vh, KBASE(1)); }
    SBAR(); qkt<0>(pA0, pA1, K_lds, r32, hi, S.qr, bs_l + KBASE(0));
    MASKT(pA0, pA1, 0); partialSM(pA0, pA1, m_reg, mnA, alA);
    if (NT > 1) { VMW(); SWRITE_H(1, KBASE(1)); }
    __syncthreads();
#define HALF_STEP(PX0, PX1, mnX, alX, PY0, PY1, alY, t, KB, VB, SB) do {                                                      \
        SBAR(); qkt<KB>(PX0, PX1, K_lds, r32, hi, S.qr, bs_l + KBASE(t));                                                         \
        finishSM(PY0, PY1, alY, l_reg, pa0, pa1, pa2, pa3); SBAR();                                                           \
        if ((t) + 1 < NT) { SLOAD_H(Kh, Vh, KBASE((t) + 1)); SBAR(); }                                               \
        pv_tile<VB>(o, vb0, pa0, pa1, pa2, pa3); MASKT(PX0, PX1, (t)); partialSM(PX0, PX1, m_reg, mnX, alX);                                        \
        __syncthreads();                                                                                                      \
        if ((t) + 1 < NT) { VMW(); SWRITE_H(SB, KBASE((t) + 1)); }                                                                          \
        RESC(alX); __syncthreads(); } while (0)
    for (int t = 1; t + 1 < NT; t += 2) {
        HALF_STEP(pB0, pB1, mnB, alB, pA0, pA1, alA, t, 1, 0, 0);
        HALF_STEP(pA0, pA1, mnA, alA, pB0, pB1, alB, t + 1, 0, 1, 1);
    }
    const bool even = (NT & 1) == 0;
    if (even) { SBAR(); qkt<1>(pB0, pB1, K_lds, r32, hi, S.qr, bs_l + KBASE(NT - 1)); SBAR(); }
    finishSM(pA0, pA1, alA, l_reg, pa0, pa1, pa2, pa3); SBAR();
    pv_tile<0>(o, vb0, pa0, pa1, pa2, pa3);
    if (even) { MASKT(pB0, pB1, NT - 1); partialSM(pB0, pB1, m_reg, mnB, alB); __syncthreads(); RESC(alB);
        finishSM(pB0, pB1, alB, l_reg, pa0, pa1, pa2, pa3); SBAR(); pv_tile<1>(o, vb0, pa0, pa1, pa2, pa3); }
    SBAR();
    if (hi == 0) li_l[r32] = l_reg; asm volatile("s_waitcnt lgkmcnt(0)" ::: "memory");
    float rli[16];
#pragma unroll
    for (int r = 0; r < 16; ++r) rli[r] = __builtin_amdgcn_rcpf(li_l[crow(r, hi)]);
    GAS bf16_t* Ow = cur.O + (size_t)(wid * QBLK) * LDO;
#pragma unroll
    for (int r = 0; r < 16; ++r) { const int orow = crow(r, hi);
#pragma unroll
        for (int d0 = 0; d0 < 4; ++d0) { const float v = o[d0][r] * rli[r];
            const float vn = dppf<0xB1>(v);
            if ((r32 & 1) == 0) *(GAS unsigned*)(Ow + (size_t)orow * LDO + d0 * 32 + r32) = cvtpk(v, vn); } }
    __syncthreads();
#undef RESC
#undef KBASE
#undef MASKT
#undef HALF_STEP
}
constexpr int MOFF_K = 4 * SHM_V, MOFF_WS = MOFF_K + 4 * SHM_K, MOFF_KS = MOFF_WS + 2048;
__device__ __forceinline__ void mem_attn_unit(const BlockRef& cur, char* lds, const int tid) {
    const int wid = __builtin_amdgcn_readfirstlane(tid >> 6), lane = tid & 63, r32 = lane & 31, hi = lane >> 5;
    const int sr = tid >> 4, sc = (tid & 15) * 8, kws = KSWZ(sr, sc * 2), vst0 = v_st(sr, sc), vst1 = v_st(32 + sr, sc);
    char* V_lds = lds; char* K_lds = lds + MOFF_K; float* ks_l = (float*)(lds + MOFF_KS);
    float* ws = (float*)(lds + MOFF_WS) + wid * 64; float* li_l = ws, * al_l = ws + 32;
    float ksv = 0.f;
    if (tid < 256) { const f32x4 p = *(const GAS f32x4*)(cur.kss + (size_t)tid * LDSS); ksv = rsqrtf(((p[0] + p[1]) + (p[2] + p[3])) * (1.f / 128.f) + EPS); }
    bf16x8 kk[4][2], vv[4][2];
#pragma unroll
    for (int t = 0; t < 4; ++t) { kk[t][0] = load8(ROWK(cur.K, t * KVBLK, sr)); kk[t][1] = load8(ROWK(cur.K, t * KVBLK, 32 + sr)); vv[t][0] = load8(ROWK(cur.V, t * KVBLK, sr)); vv[t][1] = load8(ROWK(cur.V, t * KVBLK, 32 + sr)); }
    const int qrow = wid * QBLK + r32;
    const f32x4 qp = *(const GAS f32x4*)(cur.qss + (size_t)qrow * LDSS);
    u32x4 qw[8];
#pragma unroll
    for (int d0 = 0; d0 < 8; ++d0) qw[d0] = *(const GAS u32x4*)(cur.Q + (size_t)qrow * LDQ + d0 * 16 + hi * 8);
    if (tid < 256) ks_l[tid] = ksv;
    __syncthreads();
#pragma unroll
    for (int t = 0; t < 4; ++t) { *(bf16x8*)(K_lds + t * SHM_K + kws) = scale8(kk[t][0], ks_l[t * KVBLK + sr]); *(bf16x8*)(K_lds + t * SHM_K + kws + 32 * 256) = scale8(kk[t][1], ks_l[t * KVBLK + 32 + sr]);
        *(bf16x8*)(V_lds + t * SHM_V + vst0) = vv[t][0]; *(bf16x8*)(V_lds + t * SHM_V + vst1) = vv[t][1]; }
    const float rq = rsqrtf(((qp[0] + qp[1]) + (qp[2] + qp[3])) * (1.f / 128.f) + EPS);
    bf16x8 qr[8];
#pragma unroll
    for (int d0 = 0; d0 < 8; ++d0) { const u32x4 w = qw[d0];
        const f32x4 g0 = *(const GAS f32x4*)(cur.gg + d0 * 16 + hi * 8), g1 = *(const GAS f32x4*)(cur.gg + d0 * 16 + hi * 8 + 4);
        u32x4 o; o.x = cvtpk(bf_lo(w.x) * rq * g0[0], bf_hi(w.x) * rq * g0[1]); o.y = cvtpk(bf_lo(w.y) * rq * g0[2], bf_hi(w.y) * rq * g0[3]);
        o.z = cvtpk(bf_lo(w.z) * rq * g1[0], bf_hi(w.z) * rq * g1[1]); o.w = cvtpk(bf_lo(w.w) * rq * g1[2], bf_hi(w.w) * rq * g1[3]);
        qr[d0] = *reinterpret_cast<bf16x8*>(&o); }
    __syncthreads();
    const int vb0 = (int)(uintptr_t)V_lds + v_rd_base(lane);
    float m_reg = -1e30f, l_reg = 0; f32x16 o[4] = {};
#define MEM_TILE(t) do { f32x16 p0, p1; float mn, al; bf16x8 pa0, pa1, pa2, pa3; \
        qkt0<t>(p0, p1, K_lds, r32, hi, qr); partialSM(p0, p1, m_reg, mn, al); \
        if (__any(al < 1.f)) { if (hi == 0) al_l[r32] = al; asm volatile("s_waitcnt lgkmcnt(0)" ::: "memory"); for (int d_ = 0; d_ < 4; ++d_) for (int r = 0; r < 16; ++r) o[d_][r] *= al_l[crow(r, hi)]; } \
        finishSM(p0, p1, al, l_reg, pa0, pa1, pa2, pa3); SBAR(); pv_tile<t>(o, vb0, pa0, pa1, pa2, pa3); SBAR(); } while (0)
    MEM_TILE(0); MEM_TILE(1); MEM_TILE(2); MEM_TILE(3);
#undef MEM_TILE
    if (hi == 0) li_l[r32] = l_reg; asm volatile("s_waitcnt lgkmcnt(0)" ::: "memory");
    float rli[16];
#pragma unroll
    for (int r = 0; r < 16; ++r) rli[r] = __builtin_amdgcn_rcpf(li_l[crow(r, hi)]);
    GAS bf16_t* Ow = cur.O + (size_t)(wid * QBLK) * LDO;
#pragma unroll
    for (int r = 0; r < 16; ++r) { const int orow = crow(r, hi);
#pragma unroll
        for (int d0 = 0; d0 < 4; ++d0) { const float v = o[d0][r] * rli[r];
            const float vn = dppf<0xB1>(v);
            if ((r32 & 1) == 0) *(GAS unsigned*)(Ow + (size_t)orow * LDO + d0 * 32 + r32) = cvtpk(v, vn); } }
    __syncthreads();
}
#undef ROWK
#undef VMW
#undef VMWN
#undef SLOAD_H
#undef SWRITE_HK
#undef SWRITE_HV
#undef SWRITE_H
#undef KSWZ
#undef SBAR
}


struct Frame {
    GAS unsigned char* ws; const float* const* in_; GAS float* out;
    __device__ __forceinline__ const GAS float* in(int i) const { return (const GAS float*)in_[i]; }
    int tid, lane, wave, gw, ngw, gtid, ngt;
};
enum { I_X = 0, I_MEM, I_ANORM, I_AWIN, I_ACONVW, I_ACONVB, I_AGATEW, I_AGATEB, I_ALAMBDA, I_AWOUT, I_SNORM, I_SWKVF, I_SBF, I_SKNORM, I_BNORM, I_BWIN, I_BQNORM, I_BWOUT,
       I_MNORM, I_MWKV, I_MQNORM, I_MKNORM, I_PNORM, I_PWQ, I_PSUBK, I_PU, I_PV, N_IN };

struct TrItem { const GAS float* W; const GAS float* gain; GAS bf16_t* WT; int ldw, ldt, row_off, k0, n0; };
__device__ __forceinline__ void tr_load(const TrItem& d, float (&wv)[32], int lane) {
#pragma unroll
    for (int i = 0; i < 32; ++i) wv[i] = __builtin_nontemporal_load(d.W + (size_t)(d.k0 + 2 * i + (lane >> 5)) * d.ldw + d.n0 + (lane & 31));
}
__device__ __forceinline__ void tr_proc(const TrItem& d, float (&wv)[32], LAS float* scr, int lane) {
    if (d.gain) {
#pragma unroll
        for (int i = 0; i < 32; ++i) wv[i] *= d.gain[d.k0 + 2 * i + (lane >> 5)]; }
#pragma unroll
    for (int i = 0; i < 32; ++i) scr[(2 * i + (lane >> 5)) * 33 + (lane & 31)] = wv[i];
    asm volatile("s_waitcnt lgkmcnt(0)" ::: "memory");
    const int c = lane & 7;
#pragma unroll
    for (int j = 0; j < 4; ++j) { const int n = (lane >> 3) + 8 * j; const LAS float* s = scr + (8 * c) * 33 + n;
        u32x4 o; o.x = cvtpk(s[0 * 33], s[1 * 33]); o.y = cvtpk(s[2 * 33], s[3 * 33]); o.z = cvtpk(s[4 * 33], s[5 * 33]); o.w = cvtpk(s[6 * 33], s[7 * 33]);
        *(GAS u32x4*)(d.WT + (size_t)(d.row_off + d.n0 + n) * d.ldt + d.k0 + 8 * c) = o; }
    asm volatile("s_waitcnt lgkmcnt(0)" ::: "memory");
}
__device__ __forceinline__ void transpose_item_fp8(const GAS float* W, int ldw, const GAS float* gain, GAS unsigned char* WT, int ldt, LAS float* scr, int nblk, int item, int lane) {
    const int kb = item / nblk, nb = item % nblk, k0 = 64 * kb, n0 = 32 * nb;
    float wv[32];
#pragma unroll
    for (int i = 0; i < 32; ++i) wv[i] = W[(size_t)(k0 + 2 * i + (lane >> 5)) * ldw + n0 + (lane & 31)];
#pragma unroll
    for (int i = 0; i < 32; ++i) wv[i] *= gain[k0 + 2 * i + (lane >> 5)] * 64.f;
#pragma unroll
    for (int i = 0; i < 32; ++i) scr[(2 * i + (lane >> 5)) * 33 + (lane & 31)] = wv[i];
    asm volatile("s_waitcnt lgkmcnt(0)" ::: "memory");
    const int c = lane & 3;
#pragma unroll
    for (int j = 0; j < 2; ++j) { const int n = (lane >> 2) + 16 * j; const LAS float* sp = scr + (16 * c) * 33 + n; u32x4 o;
#pragma unroll
        for (int w = 0; w < 4; ++w) { int pk = __builtin_amdgcn_cvt_pk_fp8_f32(sp[(4 * w) * 33], sp[(4 * w + 1) * 33], 0, false); pk = __builtin_amdgcn_cvt_pk_fp8_f32(sp[(4 * w + 2) * 33], sp[(4 * w + 3) * 33], pk, true); o[w] = (unsigned)pk; }
        *(GAS u32x4*)(WT + (size_t)(n0 + n) * ldt + k0 + 16 * c) = o; }
    asm volatile("s_waitcnt lgkmcnt(0)" ::: "memory");
}
struct CtRow { f32x4 v[8]; GAS unsigned char* dst; int row, which; };
__device__ __forceinline__ void ct_load(Frame& F, int layer, int it, CtRow& R) {
    R.which = it & 1; R.row = it >> 1;
    const GAS float* src = F.in(R.which ? I_PV : I_PU) + ((size_t)layer * NEXP + R.row) * DM + F.lane * 4;
    R.dst = F.ws + O_TAB + (size_t)(layer * 2 + R.which) * TAB_ONE;
#pragma unroll
    for (int c = 0; c < 8; ++c) R.v[c] = __builtin_nontemporal_load((const GAS f32x4*)(src + c * 256));
}
__device__ __forceinline__ void ct_proc(Frame& F, int layer, CtRow& R) {
    const GAS float* gn = F.in(I_PNORM) + layer * DM + F.lane * 4;
    _Float16 shv = (_Float16)0.f;
#pragma unroll
    for (int c = 0; c < 8; ++c) { f32x4 x = R.v[c]; if (!R.which) x = x * *(const GAS f32x4*)(gn + c * 256);
        float amax = fmaxf(fmaxf(fabsf(x[0]), fabsf(x[1])), fmaxf(fabsf(x[2]), fabsf(x[3])));
        amax = wave_max(amax);
        const _Float16 sh = (_Float16)fmaxf(amax * (1.f / 6.f), 1e-6f);
        const float qs = __builtin_amdgcn_rcpf((float)sh);
        unsigned pk = __builtin_amdgcn_cvt_scalef32_pk_fp4_f32(0u, x[0] * qs, x[1] * qs, 1.0f, 0); pk = __builtin_amdgcn_cvt_scalef32_pk_fp4_f32(pk, x[2] * qs, x[3] * qs, 1.0f, 1);
        *(GAS unsigned short*)(R.dst + ((size_t)c * NEXP + R.row) * 128 + F.lane * 2) = (unsigned short)pk;
        shv = (F.lane == c) ? sh : shv; }
    if (F.lane < 8) *(GAS unsigned short*)(R.dst + TAB_NIB + ((size_t)R.row * 8 + F.lane) * 2) = __builtin_bit_cast(unsigned short, shv);
}
__device__ __forceinline__ void convert_tables(Frame& F, int layer, int ibeg, int iend, int wk, int nwk) {
    if (ibeg + wk >= iend) return;
    const int ilast = ibeg + wk + ((iend - 1 - ibeg - wk) / nwk) * nwk;
    CtRow A, B;
    ct_load(F, layer, ibeg + wk, A);
    for (int it = ibeg + wk; it < iend; it += 2 * nwk) {
        ct_load(F, layer, it + nwk <= ilast ? it + nwk : ilast, B);
        ct_proc(F, layer, A);
        ct_load(F, layer, it + 2 * nwk <= ilast ? it + 2 * nwk : ilast, A);
        if (it + nwk < iend) ct_proc(F, layer, B);
    }
}
__device__ __forceinline__ void norm_row_bf16(const GAS float* xrow, const GAS float* gain, GAS bf16_t* orow, int lane) {
    f32x4 v[8]; float s = 0.f;
#pragma unroll
    for (int j = 0; j < 8; ++j) { v[j] = *(const GAS f32x4*)(xrow + j * 256 + lane * 4); s += (v[j][0] * v[j][0] + v[j][1] * v[j][1]) + (v[j][2] * v[j][2] + v[j][3] * v[j][3]); }
    const float r = rsqrtf(wave_sum(s) * (1.f / DM) + EPS);
#pragma unroll
    for (int j = 0; j < 8; ++j) { f32x4 g = gain ? *(const GAS f32x4*)(gain + j * 256 + lane * 4) : (f32x4){1.f, 1.f, 1.f, 1.f};
        u32x2 o; o.x = cvtpk(v[j][0] * r * g[0], v[j][1] * r * g[1]); o.y = cvtpk(v[j][2] * r * g[2], v[j][3] * r * g[3]);
        *(GAS u32x2*)(orow + j * 256 + lane * 4) = o; }
}
__device__ __forceinline__ void step_prologue(Frame& F, LAS unsigned char* lds) {
    LAS float* scr = (LAS float*)(lds + F.wave * 16384);
    GAS unsigned char* ws = F.ws;
    constexpr int I0 = 32 * (NIN0 / 32), I1 = 32 * 64, I2 = 32 * 96, I3 = 32 * 64, I4 = 32 * 64, I5 = 32 * 64, I6 = 32 * 64, I7 = 32 * 32, I8 = 32 * 32, I9 = 12 * 16;
    constexpr int NITEMS = I0 + I1 + I2 + I3 + I4 + I5 + I6 + I7 + I8 + I9;
#define TR_DESC(D, it_) do { int r = (it_) < NITEMS ? (it_) : NITEMS - 1; int nblk; \
        if (r < I0) { D = {F.in(I_AWIN), F.in(I_ANORM), (GAS bf16_t*)(ws + O_WIN0), NIN0, DM, 0, 0, 0}; nblk = NIN0 / 32; } else { r -= I0; \
        if (r < I1) { D = {F.in(I_AWOUT), nullptr, (GAS bf16_t*)(ws + O_WOUT0), DM, DM, 0, 0, 0}; nblk = 64; } else { r -= I1; \
        if (r < I2) { D = {F.in(I_SWKVF), F.in(I_SNORM), (GAS bf16_t*)(ws + O_WL1), 3084, DM, 0, 0, 0}; nblk = 96; } else { r -= I2; \
        if (r < I3) { D = {F.in(I_BWIN), F.in(I_BNORM), (GAS bf16_t*)(ws + O_WL1), DM, DM, 3072, 0, 0}; nblk = 64; } else { r -= I3; \
        if (r < I4) { D = {F.in(I_BWOUT), nullptr, (GAS bf16_t*)(ws + O_WOUT1), DM, DM, 0, 0, 0}; nblk = 64; } else { r -= I4; \
        if (r < I5) { D = {F.in(I_PWQ), F.in(I_PNORM), (GAS bf16_t*)(ws + O_WQ0), DM, DM, 0, 0, 0}; nblk = 64; } else { r -= I5; \
        if (r < I6) { D = {F.in(I_PWQ) + (size_t)DM * DM, F.in(I_PNORM) + DM, (GAS bf16_t*)(ws + O_WQ1), DM, DM, 0, 0, 0}; nblk = 64; } else { r -= I6; \
        if (r < I7) { D = {F.in(I_MWKV), nullptr, (GAS bf16_t*)(ws + O_WMKV), 1024, DM, 0, 0, 0}; nblk = 32; } else { r -= I7; \
        if (r < I8) { D = {F.in(I_MWKV) + (size_t)DM * 1024, nullptr, (GAS bf16_t*)(ws + O_WMKV) + (size_t)1024 * DM, 1024, DM, 0, 0, 0}; nblk = 32; } else { r -= I8; \
          const int blk = r / 16; r = r % 16; D = {F.in(I_AGATEW) + (size_t)blk * 128 * 256, nullptr, (GAS bf16_t*)(ws + O_WGATE), 256, 128, blk * 256, 0, 0}; nblk = 8; } } } } } } } } } \
        D.k0 = 64 * (r / nblk); D.n0 = 32 * (r % nblk); } while (0)
    for (int it = F.gw; it < NITEMS; it += F.ngw) { float wv[32]; TrItem d; TR_DESC(d, it); tr_load(d, wv, F.lane); tr_proc(d, wv, scr, F.lane); }
#undef TR_DESC
    { const GAS float* sk = F.in(I_PSUBK); GAS bf16_t* o = (GAS bf16_t*)(ws + O_SUBK);
      for (int i = F.gtid; i < 2 * 16 * 128 * 128 / 2; i += F.ngt) *(GAS unsigned*)(o + 2 * i) = cvtpk(sk[2 * i], sk[2 * i + 1]); }
    { GAS float* wf = (GAS float*)(ws + O_WF); const GAS float* w = F.in(I_SWKVF); const GAS float* g = F.in(I_SNORM);
      for (int i = F.gtid; i < 12 * DM; i += F.ngt) { const int j = i / DM, k = i % DM; wf[i] = w[(size_t)k * 3084 + 3072 + j] * g[k]; } }
    { GAS float* spl = (GAS float*)(ws + O_SPL); const GAS float* lam = F.in(I_ALAMBDA);
      for (int i = F.gtid; i < LRU; i += F.ngt) { const float z = -lam[i]; spl[i] = fmaxf(z, 0.f) + log1p_pos(fast_exp(-fabsf(z))); } }
    if (F.gw == 0) {
        float m = 0.f; for (int d = F.lane; d < 128; d += 64) m = fmaxf(m, fabsf(F.in(I_BQNORM)[d] * F.in(I_SKNORM)[d]));
        m = wave_max(m);
        if (F.lane == 0) ((GAS float*)(ws + O_GG))[512] = 2.f * 11.3137085f * m + 30.f; }
    { GAS float* gg = (GAS float*)(ws + O_GG);
      for (int i = F.gtid; i < 384; i += F.ngt) { const int a = i / 128, d = i % 128;
          gg[a == 0 ? 384 + d : i] = a == 0 ? F.in(I_BQNORM)[d] * F.in(I_SKNORM)[d] : F.in(I_MQNORM)[(a - 1) * 128 + d] * F.in(I_MKNORM)[(a - 1) * 128 + d]; } }
    {
        const GAS float* xin = F.in(I_X) + F.lane * 4; GAS bf16_t* xo = (GAS bf16_t*)(ws + O_XS16) + F.lane * 4;
        const int mlast = F.gw + ((T - 1 - F.gw) / F.ngw) * F.ngw;
#define XN_LOAD(V, m_) do { const int mm_ = (m_) <= mlast ? (m_) : mlast; _Pragma("unroll") for (int j = 0; j < 8; ++j) V[j] = __builtin_nontemporal_load((const GAS f32x4*)(xin + (size_t)mm_ * DM + j * 256)); } while (0)
#define XN_PROC(V, m_) do { if ((m_) < T) { float s0 = 0.f; _Pragma("unroll") for (int j = 0; j < 8; ++j) s0 += (V[j][0] * V[j][0] + V[j][1] * V[j][1]) + (V[j][2] * V[j][2] + V[j][3] * V[j][3]); \
            const float r0 = rsqrtf(wave_sum(s0) * (1.f / DM) + EPS); \
            _Pragma("unroll") for (int j = 0; j < 8; ++j) { u32x2 a; a.x = cvtpk(V[j][0] * r0, V[j][1] * r0); a.y = cvtpk(V[j][2] * r0, V[j][3] * r0); *(GAS u32x2*)(xo + (size_t)(m_) * DM + j * 256) = a; } } } while (0)
        f32x4 va[8], vb[8];
        XN_LOAD(va, F.gw);
        for (int m = F.gw; m < T; m += 2 * F.ngw) { XN_LOAD(vb, m + F.ngw); XN_PROC(va, m); XN_LOAD(va, m + 2 * F.ngw); XN_PROC(vb, m + F.ngw); }
#undef XN_LOAD
#undef XN_PROC
    }
    for (int m = F.gw; m < 2 * NMROW; m += F.ngw) { const int l = m / NMROW, r = m % NMROW;
        norm_row_bf16(F.in(I_MEM) + (size_t)r * DM, F.in(I_MNORM) + l * DM, (GAS bf16_t*)(ws + O_MEMN) + (size_t)m * DM, F.lane); }
    convert_tables(F, 0, 0, 2 * NEXP, F.gw, F.ngw);
}
__device__ __forceinline__ void step_conv(Frame& F) {
    const GAS bf16_t* zx = (const GAS bf16_t*)(F.ws + O_ZX); GAS bf16_t* xc = (GAS bf16_t*)(F.ws + O_XC);
    const GAS float* cw = F.in(I_ACONVW); const GAS float* cb = F.in(I_ACONVB);
    constexpr int NIT = T * (LRU / 8);
#define CV_LOAD(W, it_) do { const int ii_ = (it_) < NIT ? (it_) : NIT - 1; const int t_ = ii_ / (LRU / 8), c8_ = (ii_ % (LRU / 8)) * 8, pos_ = t_ & (SEQ - 1); \
        _Pragma("unroll") for (int k = 0; k < 4; ++k) W[k] = (pos_ - 3 + k >= 0) ? *(const GAS u32x4*)(zx + (size_t)(t_ - 3 + k) * LRU + c8_) : (u32x4){0u, 0u, 0u, 0u}; } while (0)
#define CV_PROC(W, it_) do { if ((it_) < NIT) { const int t_ = (it_) / (LRU / 8), c8_ = ((it_) % (LRU / 8)) * 8; float a[8]; \
        { const f32x4 b0 = *(const GAS f32x4*)(cb + c8_), b1 = *(const GAS f32x4*)(cb + c8_ + 4); a[0] = b0[0]; a[1] = b0[1]; a[2] = b0[2]; a[3] = b0[3]; a[4] = b1[0]; a[5] = b1[1]; a[6] = b1[2]; a[7] = b1[3]; } \
        _Pragma("unroll") for (int k = 0; k < 4; ++k) { const f32x4 w0 = *(const GAS f32x4*)(cw + k * LRU + c8_), w1 = *(const GAS f32x4*)(cw + k * LRU + c8_ + 4); \
            a[0] = fmaf(w0[0], bf_lo(W[k].x), a[0]); a[1] = fmaf(w0[1], bf_hi(W[k].x), a[1]); a[2] = fmaf(w0[2], bf_lo(W[k].y), a[2]); a[3] = fmaf(w0[3], bf_hi(W[k].y), a[3]); \
            a[4] = fmaf(w1[0], bf_lo(W[k].z), a[4]); a[5] = fmaf(w1[1], bf_hi(W[k].z), a[5]); a[6] = fmaf(w1[2], bf_lo(W[k].w), a[6]); a[7] = fmaf(w1[3], bf_hi(W[k].w), a[7]); } \
        u32x4 o; o.x = cvtpk(a[0], a[1]); o.y = cvtpk(a[2], a[3]); o.z = cvtpk(a[4], a[5]); o.w = cvtpk(a[6], a[7]); \
        *(GAS u32x4*)(xc + (size_t)t_ * LRU + c8_) = o; } } while (0)
    u32x4 wa[4], wb[4];
    CV_LOAD(wa, F.gtid);
    for (int it = F.gtid; it < NIT; it += 2 * F.ngt) { CV_LOAD(wb, it + F.ngt); CV_PROC(wa, it); CV_LOAD(wa, it + 2 * F.ngt); CV_PROC(wb, it + F.ngt); }
#undef CV_LOAD
#undef CV_PROC
}
constexpr int SCK = 32, NCK = SEQ / SCK;
typedef _Float16 h8_t __attribute__((ext_vector_type(8)));
__device__ __forceinline__ void scan_load(const GAS _Float16* LA, const GAS _Float16* UH, size_t off, float (&a)[8], float (&u)[8]) {
    const h8_t l = *(const GAS h8_t*)(LA + off), w = *(const GAS h8_t*)(UH + off);
#pragma unroll
    for (int k = 0; k < 8; ++k) { a[k] = fast_exp((float)l[k]); u[k] = (float)w[k]; }
}
__device__ __forceinline__ void step_scan1(Frame& F) {
    const GAS _Float16* LA = (const GAS _Float16*)(F.ws + O_AA); const GAS _Float16* UH = (const GAS _Float16*)(F.ws + O_UU);
    GAS float* CA = (GAS float*)(F.ws + O_LOGFP); GAS float* CH = CA + (size_t)NB * NCK * LRU;
    if (F.tid >= 384) return;
    const int grp = F.tid / 192, th = F.tid % 192;
    for (int it = blockIdx.x * 2 + grp; it < NB * NCK; it += gridDim.x * 2) {
        const int b = it / NCK, ck = it % NCK; const size_t base = ((size_t)b * SEQ + ck * SCK) * LRU + th * 8;
        float ap[8], h[8];
#pragma unroll
        for (int k = 0; k < 8; ++k) { ap[k] = 1.f; h[k] = 0.f; }
#pragma unroll 8
        for (int i = 0; i < SCK; ++i) { float a[8], u[8]; scan_load(LA, UH, base + (size_t)i * LRU, a, u);
#pragma unroll
            for (int k = 0; k < 8; ++k) { ap[k] *= a[k]; h[k] = a[k] * h[k] + u[k]; } }
        GAS float* ca = CA + (size_t)it * LRU + th * 8; GAS float* ch = CH + (size_t)it * LRU + th * 8;
        *(GAS f32x4*)ca = (f32x4){ap[0], ap[1], ap[2], ap[3]}; *(GAS f32x4*)(ca + 4) = (f32x4){ap[4], ap[5], ap[6], ap[7]};
        *(GAS f32x4*)ch = (f32x4){h[0], h[1], h[2], h[3]}; *(GAS f32x4*)(ch + 4) = (f32x4){h[4], h[5], h[6], h[7]};
    }
}
__device__ __forceinline__ void step_scan2(Frame& F) {
    const GAS _Float16* LA = (const GAS _Float16*)(F.ws + O_AA); const GAS _Float16* UH = (const GAS _Float16*)(F.ws + O_UU);
    const GAS float* CA = (const GAS float*)(F.ws + O_LOGFP); const GAS float* CH = CA + (size_t)NB * NCK * LRU;
    const GAS bf16_t* gy = (const GAS bf16_t*)(F.ws + O_GY); GAS bf16_t* cat = (GAS bf16_t*)(F.ws + O_CAT);
    if (F.tid >= 384) return;
    const int grp = F.tid / 192, th = F.tid % 192;
    for (int it = blockIdx.x * 2 + grp; it < NB * NCK; it += gridDim.x * 2) {
        const int b = it / NCK, ck = it % NCK; const size_t base = ((size_t)b * SEQ + ck * SCK) * LRU + th * 8;
        float h[8];
#pragma unroll
        for (int k = 0; k < 8; ++k) h[k] = 0.f;
        for (int k2 = 0; k2 < ck; ++k2) { const size_t o = (size_t)(b * NCK + k2) * LRU + th * 8;
            const f32x4 a0 = *(const GAS f32x4*)(CA + o), a1 = *(const GAS f32x4*)(CA + o + 4), c0 = *(const GAS f32x4*)(CH + o), c1 = *(const GAS f32x4*)(CH + o + 4);
#pragma unroll
            for (int k = 0; k < 4; ++k) { h[k] = a0[k] * h[k] + c0[k]; h[4 + k] = a1[k] * h[4 + k] + c1[k]; } }
#pragma unroll 8
        for (int i = 0; i < SCK; ++i) { float a[8], u[8]; scan_load(LA, UH, base + (size_t)i * LRU, a, u);
            const size_t row = (size_t)b * SEQ + ck * SCK + i;
            const u32x4 g = *(const GAS u32x4*)(gy + row * LRU + th * 8); u32x4 o;
#pragma unroll
            for (int k = 0; k < 8; ++k) h[k] = a[k] * h[k] + u[k];
#pragma unroll
            for (int k = 0; k < 4; ++k) o[k] = cvtpk(h[2 * k] * bf_lo(g[k]), h[2 * k + 1] * bf_hi(g[k]));
            *(GAS u32x4*)(cat + row * DM + th * 8) = o; }
    }
}
__device__ __forceinline__ void step_cprefix(Frame& F, LAS unsigned char* lds) {
    const GAS float* lf = (const GAS float*)(F.ws + O_LOGF); GAS float* cc = (GAS float*)(F.ws + O_CC);
    LAS double* scr = (LAS double*)(lds + F.wave * 16384);
    for (int it = F.gw; it < NB * NH; it += F.ngw) {
        const GAS float* p = lf + (size_t)it * SEQ + F.lane * 64; GAS float* q = cc + (size_t)it * SEQ + F.lane * 64;
        double s = 0.0;
        for (int i = 0; i < 64; ++i) s += (double)p[i];
        scr[F.lane] = s;
        asm volatile("s_waitcnt lgkmcnt(0)" ::: "memory");
        double run = 0.0;
        for (int l = 0; l < 64; ++l) { const double v = scr[l]; if (l < F.lane) run += v; }
        for (int i = 0; i < 64; ++i) { run += (double)p[i]; q[i] = (float)run; }
        asm volatile("s_waitcnt lgkmcnt(0)" ::: "memory");
    }
}

__device__ __forceinline__ int ord_i(float f) { const int b = __float_as_int(f); return b ^ ((b >> 31) & 0x7fffffff); }
__device__ __forceinline__ float unord_f(int k) { return __int_as_float(k ^ ((k >> 31) & 0x7fffffff)); }
template <int N> __device__ __forceinline__ void bitonic_sort_desc(int (&a)[N]) {
#pragma unroll
    for (int k = 2; k <= N; k <<= 1) {
#pragma unroll
        for (int j = k >> 1; j > 0; j >>= 1) {
#pragma unroll
            for (int i = 0; i < N; ++i) { const int l = i ^ j;
                if (l > i) { const bool desc = ((i & k) == 0); const int mx = max(a[i], a[l]), mn = min(a[i], a[l]); a[i] = desc ? mx : mn; a[l] = desc ? mn : mx; } }
        }
    }
}
__device__ __forceinline__ void bitonic_merge16_desc(int (&a)[16]) {
#pragma unroll
    for (int j = 8; j > 0; j >>= 1) {
#pragma unroll
        for (int i = 0; i < 16; ++i) { const int l = i ^ j; if (l > i) { const int mx = max(a[i], a[l]), mn = min(a[i], a[l]); a[i] = mx; a[l] = mn; } }
    }
}
__device__ __forceinline__ void top16_of_64(int (&a)[64]) {
    int g[4][16];
#pragma unroll
    for (int q = 0; q < 4; ++q) {
#pragma unroll
        for (int i = 0; i < 16; ++i) g[q][i] = a[16 * q + i];
        bitonic_sort_desc<16>(g[q]); }
#pragma unroll
    for (int i = 0; i < 16; ++i) { g[0][i] = max(g[0][i], g[1][15 - i]); g[2][i] = max(g[2][i], g[3][15 - i]); }
    bitonic_merge16_desc(g[0]); bitonic_merge16_desc(g[2]);
#pragma unroll
    for (int i = 0; i < 16; ++i) g[0][i] = max(g[0][i], g[2][15 - i]);
    bitonic_merge16_desc(g[0]);
#pragma unroll
    for (int i = 0; i < 16; ++i) a[i] = g[0][i];
}
constexpr float KOFF = 64.f;
__device__ __forceinline__ void top16_of_32(int (&a)[32]) {
    int g0[16], g1[16];
#pragma unroll
    for (int i = 0; i < 16; ++i) { g0[i] = a[i]; g1[i] = a[16 + i]; }
    bitonic_sort_desc<16>(g0); bitonic_sort_desc<16>(g1);
#pragma unroll
    for (int i = 0; i < 16; ++i) g0[i] = max(g0[i], g1[15 - i]);
    bitonic_merge16_desc(g0);
#pragma unroll
    for (int i = 0; i < 16; ++i) a[i] = g0[i];
}
__device__ __forceinline__ void subkey_top16(const GAS bf16_t* qrow  , const GAS bf16_t* sk  , int r32, int hi, int (&top)[16]) {
    bf16x8 qf[8];
#pragma unroll
    for (int ks = 0; ks < 8; ++ks) qf[ks] = *(const GAS bf16x8*)(qrow + ks * 16 + hi * 8);
    unsigned loff = (unsigned)(r32 * 128 + hi * 8) * 2u; asm volatile("" : "+v"(loff));
    int key[64];
#pragma unroll
    for (int kb = 0; kb < 4; ++kb) {
        f32x16 acc;
#pragma unroll
        for (int r = 0; r < 16; ++r) acc[r] = KOFF;
#pragma unroll
        for (int ks = 0; ks < 8; ++ks) { const bf16x8 af = *(const GAS bf16x8*)((const GAS char*)(sk + kb * 32 * 128 + ks * 16) + loff);
            acc = __builtin_amdgcn_mfma_f32_32x32x16_bf16(af, qf[ks], acc, 0, 0, 0); }
#pragma unroll
        for (int r = 0; r < 16; ++r) { const int id = kb * 32 + (r & 3) + 8 * (r >> 2) + 4 * hi; key[kb * 16 + r] = (__float_as_int(acc[r]) & ~127) | (127 - id); }
        __builtin_amdgcn_sched_barrier(0);
    }
    top16_of_64(key);
#pragma unroll
    for (int i = 0; i < 16; ++i) { auto r = __builtin_amdgcn_permlane32_swap((unsigned)key[15 - i], (unsigned)key[15 - i], false, false);
        const int pk = hi ? (int)r[0] : (int)r[1]; top[i] = max(key[i], pk); }
    bitonic_merge16_desc(top);
}
__device__ __forceinline__ void step_topk(Frame& F, LAS unsigned char* lds, int layer) {
    const GAS bf16_t* q16 = (const GAS bf16_t*)(F.ws + O_Q16); const GAS bf16_t* subk = (const GAS bf16_t*)(F.ws + O_SUBK) + (size_t)layer * 16 * 128 * 128;
    GAS int* IDX = (GAS int*)(F.ws + O_IDX); GAS float* GW = (GAS float*)(F.ws + O_GW);
    LAS int* scr = (LAS int*)(lds + F.wave * 16384) + F.lane * 33;
    const int r32 = F.lane & 31, hi = F.lane >> 5;
    for (int task = F.gw; task < (T / 32) * 8; task += F.ngw) {
        const int tb = task >> 3, h = task & 7; const int tok = tb * 32 + r32;
        const GAS bf16_t* qrow = q16 + (size_t)tok * DM + h * 256;
        int ta[16], tb16[16];
        subkey_top16(qrow, subk + (size_t)(h * 2 + 0) * 128 * 128, r32, hi, ta);
        subkey_top16(qrow + 128, subk + (size_t)(h * 2 + 1) * 128 * 128, r32, hi, tb16);
        float va[16], vb[16];
#pragma unroll
        for (int i = 0; i < 16; ++i) { va[i] = __int_as_float(ta[i] & ~127); vb[i] = __int_as_float(tb16[i] & ~127) - KOFF; scr[i] = 127 - (ta[i] & 127); scr[16 + i] = 127 - (tb16[i] & 127); }
        int c2[32]; int n = 0;
#pragma unroll
        for (int i = 0; i < 16; ++i)
#pragma unroll
            for (int j = 0; j < 16; ++j) if ((i + 1) * (j + 1) <= 16) { const int k = (__float_as_int(va[i] + vb[j]) & ~255) | (255 - (i * 16 + j));
                if ((n & 1) == 0) c2[n >> 1] = k; else c2[n >> 1] = hi ? k : c2[n >> 1];
                ++n; }
#pragma unroll
        for (int i = 25; i < 32; ++i) c2[i] = (int)0x80000000;
        top16_of_32(c2);
        { int mg[16];
#pragma unroll
          for (int i = 0; i < 16; ++i) { auto r = __builtin_amdgcn_permlane32_swap((unsigned)c2[15 - i], (unsigned)c2[15 - i], false, false);
              const int pk = hi ? (int)r[0] : (int)r[1]; mg[i] = max(c2[i], pk); }
          bitonic_merge16_desc(mg);
#pragma unroll
          for (int i = 0; i < 16; ++i) c2[i] = mg[i]; }
        asm volatile("s_waitcnt lgkmcnt(0)" ::: "memory");
        float sv[16], ex[16]; int ev[16]; float Z = 0.f;
#pragma unroll
        for (int r = 0; r < 16; ++r) { const int flat = 255 - (c2[r] & 255); sv[r] = __int_as_float(c2[r] & ~255); ev[r] = scr[flat >> 4] * 128 + scr[16 + (flat & 15)]; }
#pragma unroll
        for (int r = 0; r < 16; ++r) { ex[r] = fast_exp(sv[r] - sv[0]); Z += ex[r]; }
        const float iz = 1.f / Z;
        GAS int* ip = IDX + (size_t)tok * 128 + h * 16 + hi * 8; GAS float* gp = GW + (size_t)tok * 128 + h * 16 + hi * 8;
        int eo[8]; float go[8];
#pragma unroll
        for (int j = 0; j < 8; ++j) { eo[j] = hi ? ev[8 + j] : ev[j]; go[j] = (hi ? ex[8 + j] : ex[j]) * iz; }
        *(GAS u32x4*)ip = (u32x4){(unsigned)eo[0], (unsigned)eo[1], (unsigned)eo[2], (unsigned)eo[3]}; *(GAS u32x4*)(ip + 4) = (u32x4){(unsigned)eo[4], (unsigned)eo[5], (unsigned)eo[6], (unsigned)eo[7]};
        *(GAS f32x4*)gp = (f32x4){go[0], go[1], go[2], go[3]}; *(GAS f32x4*)(gp + 4) = (f32x4){go[4], go[5], go[6], go[7]};
        asm volatile("s_waitcnt lgkmcnt(0)" ::: "memory");
    }
}
__device__ __forceinline__ h2 as_h2(unsigned w) { return __builtin_bit_cast(h2, w); }
#define F4(W, s) __builtin_amdgcn_cvt_scalef32_pk_f16_fp4((W), 1.0f, (s))
#define H2F(us) ((float)__builtin_bit_cast(_Float16, (unsigned short)(us)))
__device__ __forceinline__ float sum8(float v) { v += dppf<0xB1>(v); v += dppf<0x4E>(v); v += dppf<0x141>(v); return v; }
__device__ __forceinline__ void step_upass(Frame& F, int layer, int G, LAS unsigned char* lds) {
    typedef pg8::v8i_t v8i_t;
    const int s = blockIdx.x & 7, wk = (blockIdx.x >> 3) * NWAVES + F.wave, nwk = (G >> 3) * NWAVES;
    const GAS unsigned char* UN = F.ws + O_TAB + (size_t)(layer * 2) * TAB_ONE + (size_t)s * NEXP * 128;
    const GAS int* IDX = (const GAS int*)(F.ws + O_IDX); const GAS bf16_t* xs = (const GAS bf16_t*)(F.ws + O_XS16) + s * 256;
    GAS _Float16* part = (GAS _Float16*)(F.ws + O_PART) + (size_t)s * T * 128;
    unsigned lo = (unsigned)F.lane; asm volatile("" : "+v"(lo));
    const unsigned j = lo >> 3, p = lo & 7, c = lo & 15, kq = lo >> 4;
    LAS unsigned char* img = lds + F.wave * 16384; LAS unsigned char* xrow = lds + 131072 + F.wave * 256;
    LAS unsigned char* wrp = img + j * 128 + ((p ^ j) << 4);
    const LAS unsigned char* rd0 = img + c * 128 + ((kq ^ (c & 7)) << 4);
    const LAS unsigned char* rd1 = img + c * 128 + (((4 + kq) ^ (c & 7)) << 4);
    const int tlast = wk + ((T - 1 - wk) / nwk) * nwk;
#define U_LOADID(ID, t_, q_) do { const int tt_ = (t_) <= tlast ? (t_) : tlast; _Pragma("unroll") for (int b = 0; b < 4; ++b) ID[b] = IDX[(size_t)tt_ * 128 + (q_) * 32 + 8 * b + j]; } while (0)
#define U_LOADX(t_) do { const int tt_ = (t_) <= tlast ? (t_) : tlast; xn = *(const GAS u32x2*)(xs + (size_t)tt_ * DM + lo * 4); } while (0)
#define U_ISSUE(UB, ID) do { _Pragma("unroll") for (int b = 0; b < 4; ++b) UB[b] = *(const GAS u32x4*)(UN + (unsigned)(ID[b] * 128 + (int)p * 16)); } while (0)
#define U_WRITE(UB, q_) do { _Pragma("unroll") for (int b = 0; b < 4; ++b) *(LAS u32x4*)(wrp + (4 * (q_) + b) * 1024) = UB[b]; } while (0)
#define U_MM(g0) do { u32x4 a0[4], a1[4]; _Pragma("unroll") for (int g = 0; g < 4; ++g) { a0[g] = *(const LAS u32x4*)(rd0 + ((g0) + g) * 2048); a1[g] = *(const LAS u32x4*)(rd1 + ((g0) + g) * 2048); } \
        _Pragma("unroll") for (int g = 0; g < 4; ++g) { \
            f32x4 c_ = __builtin_amdgcn_mfma_scale_f32_16x16x128_f8f6f4((v8i_t){(int)a0[g].x, (int)a0[g].y, (int)a0[g].z, (int)a0[g].w, 0, 0, 0, 0}, bop0, zero4, 4, 0, 0, 127, 0, 127); \
            acc[(g0) + g] = __builtin_amdgcn_mfma_scale_f32_16x16x128_f8f6f4((v8i_t){(int)a1[g].x, (int)a1[g].y, (int)a1[g].z, (int)a1[g].w, 0, 0, 0, 0}, bop1, c_, 4, 0, 0, 127, 0, 127); } } while (0)
    int idA[4], idB[4]; u32x4 u0[4], u1[4], u2[4], u3[4]; u32x2 xc, xn;
    U_LOADID(idA, wk, 0); U_LOADID(idB, wk, 1); U_LOADX(wk);
    U_ISSUE(u0, idA); U_LOADID(idA, wk, 2);
    U_ISSUE(u1, idB); U_LOADID(idB, wk, 3);
    U_ISSUE(u2, idA); U_LOADID(idA, wk + nwk, 0);
    xc = xn;
    for (int t = wk; t < T; t += nwk) {
        U_ISSUE(u3, idB); U_LOADID(idB, t + nwk, 1); U_LOADX(t + nwk);
        const float x0 = bf_lo(xc.x), x1 = bf_hi(xc.x), x2 = bf_lo(xc.y), x3 = bf_hi(xc.y);
        const float amax = wave_max(fmaxf(fmaxf(fabsf(x0), fabsf(x1)), fmaxf(fabsf(x2), fabsf(x3))));
        const float sc = fmaxf(amax, 1e-20f) * (1.f / 448.f), qs = __builtin_amdgcn_rcpf(sc);
        { int pk = __builtin_amdgcn_cvt_pk_fp8_f32(x0 * qs, x1 * qs, 0, false); pk = __builtin_amdgcn_cvt_pk_fp8_f32(x2 * qs, x3 * qs, pk, true); *(LAS int*)(xrow + lo * 4) = pk; }
        U_WRITE(u0, 0);
        U_ISSUE(u0, idA); U_LOADID(idA, t + nwk, 2);
        U_WRITE(u1, 1);
        U_ISSUE(u1, idB); U_LOADID(idB, t + nwk, 3);
        U_WRITE(u2, 2);
        U_ISSUE(u2, idA); U_LOADID(idA, t + 2 * nwk, 0);
        U_WRITE(u3, 3);
        v8i_t bop0, bop1;
        { const u32x4 b00 = *(const LAS u32x4*)(xrow + kq * 16), b01 = *(const LAS u32x4*)(xrow + 64 + kq * 16), b10 = *(const LAS u32x4*)(xrow + 128 + kq * 16), b11 = *(const LAS u32x4*)(xrow + 192 + kq * 16);
          bop0 = (v8i_t){(int)b00.x, (int)b00.y, (int)b00.z, (int)b00.w, (int)b01.x, (int)b01.y, (int)b01.z, (int)b01.w};
          bop1 = (v8i_t){(int)b10.x, (int)b10.y, (int)b10.z, (int)b10.w, (int)b11.x, (int)b11.y, (int)b11.z, (int)b11.w}; }
        const f32x4 zero4 = {0.f, 0.f, 0.f, 0.f};
        f32x4 acc[8];
        U_MM(0); U_MM(4);
        f32x4 o = acc[0];
#pragma unroll
        for (int m = 1; m < 8; ++m) o = ((c & 7) == (unsigned)m) ? acc[m] : o;
        { const h2 o0 = {(_Float16)(o[0] * sc), (_Float16)(o[1] * sc)}, o1 = {(_Float16)(o[2] * sc), (_Float16)(o[3] * sc)};
          __builtin_nontemporal_store((u32x2){__builtin_bit_cast(unsigned, o0), __builtin_bit_cast(unsigned, o1)}, (GAS u32x2*)(part + (size_t)t * 128 + 16 * (c & 7) + 4 * kq)); }
        xc = xn;
    }
#undef U_LOADID
#undef U_LOADX
#undef U_ISSUE
#undef U_WRITE
#undef U_MM
}
__device__ __forceinline__ void step_peer_reduce(Frame& F, int layer) {
    const GAS _Float16* part = (const GAS _Float16*)(F.ws + O_PART); const GAS float* GW = (const GAS float*)(F.ws + O_GW); const GAS int* IDX = (const GAS int*)(F.ws + O_IDX);
    const GAS float* rowss = (const GAS float*)(F.ws + O_ROWSS); GAS unsigned char* W8 = F.ws + O_W8;
    const GAS unsigned char* SU = F.ws + O_TAB + (size_t)(layer * 2) * TAB_ONE + TAB_NIB; const GAS unsigned char* SV = SU + TAB_ONE;
    constexpr int NIT = T * 2;
    struct SA { int id; float gw, rs; float p[8]; }; struct SB { u32x4 su, sv; };
#define RA(X, it_) do { const int ii_ = (it_) < NIT ? (it_) : NIT - 1; const size_t i_ = (size_t)ii_ * 64 + F.lane; X.id = IDX[i_]; X.gw = GW[i_]; X.rs = rowss[(size_t)(ii_ >> 1) * 32 + (F.lane & 31)]; \
        _Pragma("unroll") for (int s = 0; s < 8; ++s) X.p[s] = (float)part[(size_t)s * T * 128 + i_]; } while (0)
#define RB(Y, X) do { Y.su = *(const GAS u32x4*)(SU + (size_t)X.id * 16); Y.sv = *(const GAS u32x4*)(SV + (size_t)X.id * 16); } while (0)
#define RC(X, Y, it_) do { if ((it_) < NIT) { const size_t i_ = (size_t)(it_) * 64 + F.lane; const float r = rsqrtf(wave_sum(X.rs) * (0.5f / DM) + EPS); float d = 0.f; \
        _Pragma("unroll") for (int s = 0; s < 8; ++s) d += X.p[s] * (float)__builtin_bit_cast(_Float16, (unsigned short)(Y.su[s >> 1] >> (16 * (s & 1)))); \
        const float w = X.gw * gelu_tanh(d * r) * 256.f; \
        _Pragma("unroll") for (int s = 0; s < 8; ++s) { const float ws = w * (float)__builtin_bit_cast(_Float16, (unsigned short)(Y.sv[s >> 1] >> (16 * (s & 1)))); \
            W8[(size_t)s * T * 128 + i_] = (unsigned char)(__builtin_amdgcn_cvt_pk_fp8_f32(ws, 0.f, 0, false) & 0xff); } } } while (0)
    SA a0, a1, a2; SB b0, b1;
    RA(a0, F.gw); RA(a1, F.gw + F.ngw); RB(b0, a0);
    for (int it = F.gw; it < NIT; it += F.ngw) {
        RA(a2, it + 2 * F.ngw); RB(b1, a1);
        RC(a0, b0, it);
        a0 = a1; a1 = a2; b0 = b1;
    }
#undef RA
#undef RB
#undef RC
}
__device__ __forceinline__ void step_vpass(Frame& F, int layer, int G, bool dry, LAS unsigned char* lds) {
    typedef pg8::v8i_t v8i_t;
    const int s = blockIdx.x & 7, wk = (blockIdx.x >> 3) * NWAVES + F.wave, nwk = (G >> 3) * NWAVES;
    const GAS unsigned char* VN = F.ws + O_TAB + (size_t)(layer * 2 + 1) * TAB_ONE + (size_t)s * NEXP * 128;
    const GAS int* IDX = (const GAS int*)(F.ws + O_IDX); const GAS unsigned char* W8 = F.ws + O_W8 + (size_t)s * T * 128;
    GAS bf16_t* xs = (GAS bf16_t*)(F.ws + O_XS16); GAS float* rsp = (GAS float*)(F.ws + O_RSP);
    unsigned lo = (unsigned)F.lane; asm volatile("" : "+v"(lo));
    const unsigned j = lo >> 3, p = lo & 7, c = lo & 15, kq = lo >> 4;
    LAS unsigned char* img = lds + F.wave * 16384;
    LAS unsigned char* wrp = img + j * 128 + ((p ^ j) << 4);
    const unsigned rdrow = (unsigned)(size_t)img + (32 * kq + c) * 128, csw = (c & 7) << 4;
    const int tlast = wk + ((T - 1 - wk) / nwk) * nwk;
#define V_LOADID(ID, t_, q_) do { const int tt_ = (t_) <= tlast ? (t_) : tlast; _Pragma("unroll") for (int b = 0; b < 4; ++b) ID[b] = IDX[(size_t)tt_ * 128 + (q_) * 32 + 8 * b + j]; } while (0)
#define V_LOADW(t_) do { const int tt_ = (t_) <= tlast ? (t_) : tlast; wn0 = *(const GAS u32x4*)(W8 + (size_t)tt_ * 128 + kq * 16); wn1 = *(const GAS u32x4*)(W8 + (size_t)tt_ * 128 + 64 + kq * 16); } while (0)
#define V_ISSUE(VB, ID) do { _Pragma("unroll") for (int b = 0; b < 4; ++b) VB[b] = *(const GAS u32x4*)(VN + (unsigned)(ID[b] * 128 + (int)p * 16)); } while (0)
#define V_WRITE(VB, q_) do { _Pragma("unroll") for (int b = 0; b < 4; ++b) *(LAS u32x4*)(wrp + (4 * (q_) + b) * 1024) = VB[b]; } while (0)
#define TR4(dst, va, off) asm volatile("ds_read_b64_tr_b4 %0, %1 offset:%2" : "=&v"(dst) : "v"(va), "i"(off) : "memory")
#define V_MM(cc) do { const unsigned va0 = rdrow + (((cc) << 4) ^ csw), va1 = rdrow + ((((cc) + 1) << 4) ^ csw); u32x2 t00, t01, t10, t11, t20, t21, t30, t31; \
        TR4(t00, va0, 0); TR4(t01, va0, 2048); TR4(t10, va0, 8); TR4(t11, va0, 2056); TR4(t20, va1, 0); TR4(t21, va1, 2048); TR4(t30, va1, 8); TR4(t31, va1, 2056); \
        asm volatile("s_waitcnt lgkmcnt(0)" ::: "memory"); __builtin_amdgcn_sched_barrier(0); \
        acc[2 * (cc)] = __builtin_amdgcn_mfma_scale_f32_16x16x128_f8f6f4((v8i_t){(int)t00.x, (int)t00.y, (int)t01.x, (int)t01.y, 0, 0, 0, 0}, bop, zero4, 4, 0, 0, 127, 0, 119); \
        acc[2 * (cc) + 1] = __builtin_amdgcn_mfma_scale_f32_16x16x128_f8f6f4((v8i_t){(int)t10.x, (int)t10.y, (int)t11.x, (int)t11.y, 0, 0, 0, 0}, bop, zero4, 4, 0, 0, 127, 0, 119); \
        acc[2 * (cc) + 2] = __builtin_amdgcn_mfma_scale_f32_16x16x128_f8f6f4((v8i_t){(int)t20.x, (int)t20.y, (int)t21.x, (int)t21.y, 0, 0, 0, 0}, bop, zero4, 4, 0, 0, 127, 0, 119); \
        acc[2 * (cc) + 3] = __builtin_amdgcn_mfma_scale_f32_16x16x128_f8f6f4((v8i_t){(int)t30.x, (int)t30.y, (int)t31.x, (int)t31.y, 0, 0, 0, 0}, bop, zero4, 4, 0, 0, 127, 0, 119); } while (0)
    int idA[4], idB[4]; u32x4 v0[4], v1[4], v2[4], v3[4]; u32x4 w0, w1, wn0, wn1;
    V_LOADID(idA, wk, 0); V_LOADID(idB, wk, 1); V_LOADW(wk);
    V_ISSUE(v0, idA); V_LOADID(idA, wk, 2);
    V_ISSUE(v1, idB); V_LOADID(idB, wk, 3);
    V_ISSUE(v2, idA); V_LOADID(idA, wk + nwk, 0);
    w0 = wn0; w1 = wn1;
    for (int t = wk; t < T; t += nwk) {
        V_ISSUE(v3, idB); V_LOADID(idB, t + nwk, 1); V_LOADW(t + nwk);
        GAS bf16_t* xb = xs + (size_t)t * DM + s * 256 + c * 16 + kq * 4;
        f32x4 x2; { const u32x2 w = *(const GAS u32x2*)xb; x2 = (f32x4){bf_lo(w.x), bf_hi(w.x), bf_lo(w.y), bf_hi(w.y)}; }
        V_WRITE(v0, 0);
        V_ISSUE(v0, idA); V_LOADID(idA, t + nwk, 2);
        V_WRITE(v1, 1);
        V_ISSUE(v1, idB); V_LOADID(idB, t + nwk, 3);
        V_WRITE(v2, 2);
        V_ISSUE(v2, idA); V_LOADID(idA, t + 2 * nwk, 0);
        V_WRITE(v3, 3);
        const v8i_t bop = {(int)w0.x, (int)w0.y, (int)w0.z, (int)w0.w, (int)w1.x, (int)w1.y, (int)w1.z, (int)w1.w};
        const f32x4 zero4 = {0.f, 0.f, 0.f, 0.f};
        f32x4 acc[16];
        V_MM(0); V_MM(2); V_MM(4); V_MM(6);
        f32x4 o = acc[0];
#pragma unroll
        for (int m = 1; m < 16; ++m) o = (c == (unsigned)m) ? acc[m] : o;
        x2 += o;
        if (layer == 1 && !dry) __builtin_nontemporal_store(x2, (GAS f32x4*)(F.out + (size_t)t * DM + s * 256 + c * 16 + kq * 4));
        if (layer == 0 && !dry) {
            { u32x2 ow; ow.x = cvtpk(x2[0], x2[1]); ow.y = cvtpk(x2[2], x2[3]); __builtin_nontemporal_store(ow, (GAS u32x2*)xb); }
            const float sst = wave_sum((x2[0] * x2[0] + x2[1] * x2[1]) + (x2[2] * x2[2] + x2[3] * x2[3]));
            if (lo == 0) rsp[(size_t)t * 8 + s] = sst;
        }
        w0 = wn0; w1 = wn1;
    }
#undef V_LOADID
#undef V_LOADW
#undef V_ISSUE
#undef V_WRITE
#undef TR4
#undef V_MM
}
#undef F4
#undef H2F
__device__ __forceinline__ void step_logf(Frame& F, LAS unsigned char* lds) {
    const GAS bf16_t* xs = (const GAS bf16_t*)(F.ws + O_XS16); const GAS float* rsp = (const GAS float*)(F.ws + O_RSP); GAS float* logf = (GAS float*)(F.ws + O_LOGF);
    const GAS float* wf = (const GAS float*)(F.ws + O_WF); LAS float* wl = (LAS float*)lds;
    for (int i = F.tid; i < NH * DM / 4; i += NTHREADS) *(LAS f32x4*)(wl + 4 * i) = *(const GAS f32x4*)(wf + 4 * i);
    __syncthreads();
    const int tlast = F.gw + ((T - 1 - F.gw) / F.ngw) * F.ngw;
    unsigned lo = (unsigned)F.lane; asm volatile("" : "+v"(lo));
#define LF_LOAD(W, Q, t_) do { const int tt_ = (t_) <= tlast ? (t_) : tlast; _Pragma("unroll") for (int c = 0; c < 8; ++c) W[c] = *(const GAS u32x2*)(xs + (size_t)tt_ * DM + c * 256 + lo * 4); Q = lo < 8 ? rsp[(size_t)tt_ * 8 + lo] : 0.f; } while (0)
    u32x2 w[8], wn[8]; float q, qn;
    LF_LOAD(w, q, F.gw);
    for (int t = F.gw; t < T; t += F.ngw) {
        LF_LOAD(wn, qn, t + F.ngw);
        asm volatile("" : "+v"(lo));
        const float r1 = rsqrtf(wave_sum(q) * (1.f / DM) + EPS);
        float mine = 0.f;
#pragma unroll 2
        for (int h = 0; h < NH; ++h) { float d = 0.f;
#pragma unroll
            for (int c = 0; c < 8; ++c) { const f32x4 g = *(const LAS f32x4*)(wl + h * DM + c * 256 + lo * 4);
                d += (bf_lo(w[c].x) * g[0] + bf_hi(w[c].x) * g[1]) + (bf_lo(w[c].y) * g[2] + bf_hi(w[c].y) * g[3]); }
            d = wave_sum(d); mine = (lo == (unsigned)h) ? d : mine; }
        if (lo < (unsigned)NH) { const float z = mine * r1 + F.in(I_SBF)[lo];
            logf[((size_t)(t / SEQ) * NH + lo) * SEQ + (t % SEQ)] = fminf(z, 0.f) - log1p_pos(fast_exp(-fabsf(z))); }
#pragma unroll
        for (int c = 0; c < 8; ++c) w[c] = wn[c];
        q = qn;
    }
#undef LF_LOAD
    __syncthreads();
}

#define XB_TMO      128
#define XB_XCNT(j)  (256  + 64 * (j))
#define XB_XSUB(j)  (1280 + 64 * (j))
#define XB_XGEN(j)  (2304 + 64 * (j))
#define XB_TOP      3328
#define XB_TOPGEN   3392
#define XCD_BAR_WORDS 3456
#define XB_SPIN_CAP (1u << 20)
__device__ __forceinline__ unsigned xb_ld(unsigned* p)              { return __hip_atomic_load(p, __ATOMIC_RELAXED, __HIP_MEMORY_SCOPE_AGENT); }
__device__ __forceinline__ unsigned xb_add(unsigned* p, unsigned v) { return __hip_atomic_fetch_add(p, v, __ATOMIC_RELAXED, __HIP_MEMORY_SCOPE_AGENT); }
__device__ __forceinline__ unsigned xb_xcc_id() { return (unsigned)__builtin_amdgcn_s_getreg((3 << 11) | 20) & 0xFu; }
#define XB_SPIN(cond, bar) do { unsigned _sp = 0; while (cond) { __builtin_amdgcn_s_sleep(1); \
    if ((++_sp & 255u) == 0u) { if (xb_ld(&(bar)[XB_TMO])) break; if (_sp > XB_SPIN_CAP) { atomicAdd(&(bar)[XB_TMO], 1u); break; } } } } while (0)
struct XcdBarrier { unsigned* bar; unsigned x; volatile LAS unsigned* st; };
__device__ __forceinline__ XcdBarrier xcd_barrier_post(unsigned* bar, volatile LAS unsigned* st) {
    XcdBarrier b; b.bar = bar; b.x = xb_xcc_id(); b.st = st;
    if (threadIdx.x == 0) (void)xb_add(&bar[XB_XCNT(b.x)], 1u);
    return b;
}
__device__ __forceinline__ void xcd_barrier_complete(unsigned* bar, unsigned x, unsigned& nloc, unsigned& nx) {
    const unsigned G = gridDim.x * gridDim.y * gridDim.z;
    unsigned sum, cnt, mine, sp = 0u;
    for (;;) {
        sum = 0u; cnt = 0u; mine = 0u;
#pragma unroll
        for (unsigned j = 0; j < 16; ++j) { const unsigned c = xb_ld(&bar[XB_XCNT(j)]); sum += c; cnt += (c > 0u) ? 1u : 0u; mine = (j == x) ? c : mine; }
        if (sum == G) break;
        __builtin_amdgcn_s_sleep(1);
        if ((++sp & 255u) == 0u) { if (xb_ld(&bar[XB_TMO])) break; if (sp > XB_SPIN_CAP) { atomicAdd(&bar[XB_TMO], 1u); break; } }
    }
    nloc = mine > 0u ? mine : 1u; nx = cnt > 0u ? cnt : 1u;
}
__device__ __forceinline__ void xcd_barrier(const XcdBarrier& b, int wave_s) {
    asm volatile("s_waitcnt vmcnt(0)" ::: "memory");
    __syncthreads();
    int ln_; asm volatile("v_mbcnt_lo_u32_b32 %0, -1, 0\n\tv_mbcnt_hi_u32_b32 %0, -1, %0" : "=v"(ln_));
    if (wave_s == 0 && ln_ == 0) {
        unsigned* bar = b.bar;
        __builtin_amdgcn_s_waitcnt(0);
        unsigned nloc = b.st[0], nx = b.st[1];
        if (nloc == 0u) { xcd_barrier_complete(bar, b.x, nloc, nx); b.st[0] = nloc; b.st[1] = nx; }
        const unsigned old = xb_add(&bar[XB_XSUB(b.x)], 1u);
        const unsigned gen = old / nloc;
        if (old + 1u == (gen + 1u) * nloc) {
            __builtin_amdgcn_fence(__ATOMIC_RELEASE, "agent");
            asm volatile("s_waitcnt vmcnt(0)" ::: "memory");
            const unsigned og = xb_add(&bar[XB_TOP], 1u);
            const unsigned tg = og / nx;
            if (og + 1u == (tg + 1u) * nx) xb_add(&bar[XB_TOPGEN], 1u);
            else XB_SPIN(xb_ld(&bar[XB_TOPGEN]) == tg, bar);
            __builtin_amdgcn_fence(__ATOMIC_ACQUIRE, "agent");
            xb_add(&bar[XB_XGEN(b.x)], 1u);
            asm volatile("s_waitcnt vmcnt(0)" ::: "memory");
        } else {
            XB_SPIN(xb_ld(&bar[XB_XGEN(b.x)]) == gen, bar);
            __builtin_amdgcn_fence(__ATOMIC_ACQUIRE, "agent");
            asm volatile("s_waitcnt vmcnt(0)" ::: "memory");
        }
    }
    __syncthreads();
}

constexpr int CONV1_SPLIT = 2 * 4608;
constexpr int BAR_LDS_OFF = 147456 - 64;
constexpr int LDS_BYTES = 147456;
enum { ST_PROLOGUE = 0, ST_G_IN0, ST_G_MKV0, ST_G_MKV1, ST_CONV, ST_G_GATE, ST_A_MEM0, ST_SCAN1, ST_SCAN2, ST_G_OUT0, ST_G_PQ0, ST_TOPK0, ST_UPASS0, ST_PRED0, ST_VPASS0,
       ST_G_L1, ST_CPREFIX, ST_A_FOX, ST_A_MEM1, ST_G_OUT1, ST_G_PQ1, ST_TOPK1, ST_UPASS1, ST_PRED1, ST_VPASS1, N_STEPS };
constexpr unsigned SYNC_AFTER = (1u << ST_PROLOGUE) | (1u << ST_G_MKV1) | (1u << ST_CONV) | (1u << ST_A_MEM0) | (1u << ST_SCAN1) | (1u << ST_SCAN2) | (1u << ST_G_OUT0) | (1u << ST_G_PQ0) |
                                (1u << ST_TOPK0) | (1u << ST_UPASS0) | (1u << ST_PRED0) | (1u << ST_VPASS0) | (1u << ST_G_L1) | (1u << ST_CPREFIX) | (1u << ST_A_MEM1) | (1u << ST_G_OUT1) | (1u << ST_G_PQ1) | (1u << ST_TOPK1) | (1u << ST_UPASS1) | (1u << ST_PRED1);
constexpr unsigned GEMM_STEPS = (1u << ST_G_IN0) | (1u << ST_G_MKV0) | (1u << ST_G_MKV1) | (1u << ST_G_GATE) | (1u << ST_G_OUT0) | (1u << ST_G_PQ0) | (1u << ST_G_L1) | (1u << ST_G_OUT1) | (1u << ST_G_PQ1);
constexpr unsigned ATTN_STEPS = (1u << ST_A_MEM0) | (1u << ST_A_FOX) | (1u << ST_A_MEM1);

struct Args { const float* in[N_IN]; float* out; unsigned char* ws; int lo, hi; };

__global__ void __launch_bounds__(NTHREADS, 2) yoco_fwd(Args args) {
    extern __shared__ __attribute__((aligned(16))) unsigned char lds[];
    volatile LAS unsigned* bst = (volatile LAS unsigned*)((LAS unsigned char*)lds + BAR_LDS_OFF);
    if (threadIdx.x == 0) { bst[0] = 0u; bst[1] = 0u; }
    __syncthreads();
    const XcdBarrier gbar = xcd_barrier_post((unsigned*)(args.ws + O_CTL), bst);
    const int G = gridDim.x;
    const int wave_s = __builtin_amdgcn_readfirstlane(threadIdx.x >> 6);
#ifndef DUP_MASK
#define DUP_MASK 0u
#endif
    for (int st = args.lo; st < args.hi; ++st) {
      const int nrep = ((DUP_MASK >> st) & 1u) ? 2 : 1;
      for (int rep = 0; rep < nrep; ++rep) {
        unsigned char* ws0 = args.ws; asm volatile("" : "+s"(ws0));
        GAS unsigned char* ws = (GAS unsigned char*)ws0;
#define LANE_ID(v) asm volatile("v_mbcnt_lo_u32_b32 %0, -1, 0\n\tv_mbcnt_hi_u32_b32 %0, -1, %0" : "=v"(v))
#define MAKE_TID(v) do { LANE_ID(v); v += wave_s * 64; } while (0)
#define MAKE_FRAME(F) Frame F; F.ws = ws; F.in_ = args.in; F.out = (GAS float*)args.out; { int t0_; MAKE_TID(t0_); F.tid = t0_; } F.lane = F.tid & 63; F.wave = wave_s; \
        F.gw = blockIdx.x * NWAVES + F.wave; F.ngw = gridDim.x * NWAVES; F.gtid = blockIdx.x * NTHREADS + F.tid; F.ngt = gridDim.x * NTHREADS
        if (st == ST_G_L1) { MAKE_FRAME(F); step_logf(F, (LAS unsigned char*)lds); }
        if ((GEMM_STEPS >> st) & 1u) {
            pg8::Gemm g; Epi E; E.ws = ws; E.resid = nullptr; E.outf = nullptr; E.o16 = nullptr; E.ssq = nullptr; E.gate_b = nullptr; int shift = 0;
            switch (st) {
            case ST_G_IN0:  g = {(const GAS bf16_t*)(ws + O_XS16), (const GAS bf16_t*)(ws + O_WIN0), T, NIN0, DM, DM, DM, 0}; E.mode = EM_IN0; break;
            case ST_G_MKV0: g = {(const GAS bf16_t*)(ws + O_MEMN), (const GAS bf16_t*)(ws + O_WMKV), NMROW, 1024, DM, DM, DM, 0}; E.mode = EM_MKV; E.o16 = (GAS bf16_t*)(ws + O_MKV); E.ssq = (GAS float*)(ws + O_MKSS); shift = 128; break;
            case ST_G_MKV1: g = {(const GAS bf16_t*)(ws + O_MEMN) + (size_t)NMROW * DM, (const GAS bf16_t*)(ws + O_WMKV) + (size_t)1024 * DM, NMROW, 1024, DM, DM, DM, 0}; E.mode = EM_MKV;
                            E.o16 = (GAS bf16_t*)(ws + O_MKV) + (size_t)NMROW * NL1; E.ssq = (GAS float*)(ws + O_MKSS) + NMROW * 112; shift = 144; break;
            case ST_G_GATE: g = {(const GAS bf16_t*)(ws + O_XC), (const GAS bf16_t*)(ws + O_WGATE), T, 12 * 256, 128, LRU, 128, 128}; E.mode = EM_GATE; E.gate_b = (const GAS float*)args.in[I_AGATEB]; break;
            case ST_G_OUT0: g = {(const GAS bf16_t*)(ws + O_CAT), (const GAS bf16_t*)(ws + O_WOUT0), T, DM, DM, DM, DM, 0}; E.mode = EM_RES; E.resid = (const GAS float*)args.in[I_X]; E.outf = (GAS float*)args.out; break;
            case ST_G_PQ0:  g = {(const GAS bf16_t*)(ws + O_XS16), (const GAS bf16_t*)(ws + O_WQ0), T, DM, DM, DM, DM, 0}; E.mode = EM_PQ; E.o16 = (GAS bf16_t*)(ws + O_Q16); break;
            case ST_G_L1:   g = {(const GAS bf16_t*)(ws + O_XS16), (const GAS bf16_t*)(ws + O_WL1), T, NL1, DM, DM, DM, 0}; E.mode = EM_L1; break;
            case ST_G_OUT1: g = {(const GAS bf16_t*)(ws + O_CAT), (const GAS bf16_t*)(ws + O_WOUT1), T, DM, DM, DM, DM, 0}; E.mode = EM_RES; E.resid = nullptr; break;
            default:        g = {(const GAS bf16_t*)(ws + O_XS16), (const GAS bf16_t*)(ws + O_WQ1), T, DM, DM, DM, DM, 0}; E.mode = EM_PQ; E.o16 = (GAS bf16_t*)(ws + O_Q16); break;
            }
            pg8::StaticOrder S; S.init(g.M, g.N, G, (int)((blockIdx.x + G - shift) % G));
#ifndef DIS_GEMM
            { int tg_; MAKE_TID(tg_);
              pg8::gemm_phase<Epi, false>((LAS unsigned char*)lds, g, S, E, tg_); }
#endif
            if (st == ST_G_MKV1 && blockIdx.x >= 160) { MAKE_FRAME(F); convert_tables(F, 1, 0, CONV1_SPLIT, (blockIdx.x - 160) * NWAVES + F.wave, (G - 160) * NWAVES); }
        } else if ((ATTN_STEPS >> st) & 1u) {
            const int nun = st == ST_A_FOX ? 3 : 1;
            for (int ui = 0; ui < nun; ++ui) {
                att::BlockRef r;
                if (st == ST_A_FOX) {
                    const int i = blockIdx.x, x = i & 15, bh = (i >> 4) + 16 * ui, qb = ui == 0 ? x : (ui == 1 ? 15 - x : ((x * 5 + 3) & 15));
                    const int b = bh / NH, h = bh % NH; const size_t row0 = (size_t)b * SEQ + qb * 256;
                    const GAS bf16_t* z = (const GAS bf16_t*)(ws + O_ZL1);
                    r.Q = z + row0 * NL1 + 3072 + h * 128; r.K = z + (size_t)b * SEQ * NL1 + h * 128; r.V = z + (size_t)b * SEQ * NL1 + 1536 + h * 128;
                    r.O = (GAS bf16_t*)(ws + O_CAT) + row0 * DM + h * 128;
                    const GAS float* ss = (const GAS float*)(ws + O_SSL1);
                    r.qss = ss + row0 * 112 + (12 + h) * 4; r.kss = ss + (size_t)b * SEQ * 112 + h * 4; r.cc = (const GAS float*)(ws + O_CC) + (size_t)bh * SEQ; r.gg = (const GAS float*)(ws + O_GG) + 384;
                    r.P0 = qb * 256; r.skv = SEQ;
                } else {
                    const int l = st == ST_A_MEM0 ? 0 : 1; const int i = blockIdx.x, qblk = i >> 2, h = i & 3, b = qblk >> 4; const size_t row0 = (size_t)qblk * 256;
                    r.Q = (const GAS bf16_t*)(ws + O_ZL1) + row0 * NL1 + 4608 + h * 128; r.qss = (const GAS float*)(ws + O_SSL1) + row0 * 112 + (24 + h) * 4;
                    const GAS bf16_t* kv = (const GAS bf16_t*)(ws + O_MKV) + ((size_t)l * NMROW + b * NMEM) * NL1;
                    r.K = kv + h * 128; r.V = kv + 512 + h * 128; r.kss = (const GAS float*)(ws + O_MKSS) + ((size_t)l * NMROW + b * NMEM) * 112 + h * 4;
                    r.O = (GAS bf16_t*)(ws + O_CAT) + row0 * DM + LRU + h * 128; r.cc = nullptr; r.gg = (const GAS float*)(ws + O_GG) + 128 * (1 + l);
                    r.P0 = SEQ; r.skv = NMEM;
                }
                att::Seam S;
                int tid_u; MAKE_TID(tid_u);
#ifndef DIS_ATTN
                if (st == ST_A_FOX) { att::attn_prime(r, (char*)lds, S, tid_u); att::attn_block(r, (char*)lds, S, tid_u); }
                else att::mem_attn_unit(r, (char*)lds, tid_u);
#endif
            }
        } else {
            MAKE_FRAME(F);
            switch (st) {
#ifndef DIS_MISC
            case ST_PROLOGUE: step_prologue(F, (LAS unsigned char*)lds); break;
            case ST_CONV: step_conv(F); break;
            case ST_SCAN1: step_scan1(F); break;
            case ST_SCAN2: step_scan2(F); break;
#endif
#ifndef DIS_TOPK
            case ST_TOPK0: step_topk(F, (LAS unsigned char*)lds, 0); break;
            case ST_TOPK1: step_topk(F, (LAS unsigned char*)lds, 1); break;
#endif
#ifndef DIS_GATHER
            case ST_UPASS0: step_upass(F, 0, G, (LAS unsigned char*)lds); break;
            case ST_UPASS1: step_upass(F, 1, G, (LAS unsigned char*)lds); break;
            case ST_PRED0: step_peer_reduce(F, 0); break;
            case ST_PRED1: step_peer_reduce(F, 1); break;
            case ST_VPASS0: step_vpass(F, 0, G, rep + 1 < nrep, (LAS unsigned char*)lds); break;
            case ST_VPASS1: step_vpass(F, 1, G, rep + 1 < nrep, (LAS unsigned char*)lds); break;
#endif
#ifndef DIS_MISC
            case ST_CPREFIX: step_cprefix(F, (LAS unsigned char*)lds); convert_tables(F, 1, G > 160 ? CONV1_SPLIT : 0, 2 * NEXP, F.gw, F.ngw); break;
#endif
            default: break;
            }
        }
        if (rep + 1 < nrep) xcd_barrier(gbar, wave_s);
      }
        if (((SYNC_AFTER >> st) & 1u) && st + 1 < args.hi) xcd_barrier(gbar, wave_s);
    }
}

#ifndef N_LAUNCH_MODE
#define N_LAUNCH_MODE 1
#endif
extern "C" void kernel_launch(void* const* d_in, const int* in_sizes, int n_in, void* d_out, int out_size, void* d_ws, size_t ws_size, hipStream_t stream) {
    static int grid = 0;
    if (grid == 0) {
        if (n_in != N_IN || in_sizes[0] != T * DM || out_size != T * DM || ws_size < WS_END) {
            fprintf(stderr, "kernel_launch: unexpected shapes (n_in %d, in0 %d, out %d, ws %zu, need %zu)\n", n_in, n_in > 0 ? in_sizes[0] : -1, out_size, ws_size, (size_t)WS_END); grid = -1; return; }
        int dev = 0, cus = 0, per_cu = 0;
        hipGetDevice(&dev); hipDeviceGetAttribute(&cus, hipDeviceAttributeMultiprocessorCount, dev);
        hipFuncSetAttribute((const void*)yoco_fwd, hipFuncAttributeMaxDynamicSharedMemorySize, LDS_BYTES);
        hipOccupancyMaxActiveBlocksPerMultiprocessor(&per_cu, (const void*)yoco_fwd, NTHREADS, LDS_BYTES);
        if (per_cu < 1) { fprintf(stderr, "kernel_launch: occupancy query says %d blocks per CU\n", per_cu); grid = -1; return; }
        grid = cus - cus % 8;
        (void)hipGetLastError();
    }
    if (grid < 0) return;
    Args a{};
    for (int i = 0; i < N_IN; ++i) a.in[i] = (const float*)d_in[i];
    a.out = (float*)d_out; a.ws = (unsigned char*)d_ws;
    if (hipMemsetAsync((char*)d_ws + O_CTL, 0, 65536, stream) != hipSuccess) { fprintf(stderr, "kernel_launch: memset of the barrier words failed\n"); return; }
    if (N_LAUNCH_MODE == 1) {
        a.lo = 0; a.hi = N_STEPS;
        hipLaunchKernelGGL(yoco_fwd, dim3(grid), dim3(NTHREADS), LDS_BYTES, stream, a);
        hipError_t e = hipPeekAtLastError();
        if (e != hipSuccess) fprintf(stderr, "launch failed: %s (grid %d)\n", hipGetErrorString(e), grid);
    } else {
        int lo = 0;
        for (int s = 0; s < N_STEPS; ++s) {
            if (((SYNC_AFTER >> s) & 1u) || s == N_STEPS - 1) {
                a.lo = lo; a.hi = s + 1; lo = s + 1;
                void* params[] = {&a};
                hipError_t e = hipLaunchCooperativeKernel((const void*)yoco_fwd, dim3(grid), dim3(NTHREADS), params, LDS_BYTES, stream);
                if (e != hipSuccess) { fprintf(stderr, "launch failed: %s\n", hipGetErrorString(e)); break; }
            }
        }
    }
}
```

```cpp
#include <hip/hip_runtime.h>
#include <hip/hip_cooperative_groups.h>
#include <cstdio>
#include <cstdint>
namespace cg = cooperative_groups;

#define LAS __attribute__((address_space(3)))
#define GAS __attribute__((address_space(1)))
typedef unsigned short bf16_t;
typedef short bf16x8 __attribute__((ext_vector_type(8)));
typedef short s16x4 __attribute__((ext_vector_type(4)));
typedef float f32x4 __attribute__((ext_vector_type(4)));
typedef float f32x2 __attribute__((ext_vector_type(2)));
typedef float f32x16 __attribute__((ext_vector_type(16)));
typedef unsigned u32x4 __attribute__((ext_vector_type(4)));
typedef unsigned u32x2 __attribute__((ext_vector_type(2)));
typedef _Float16 h2 __attribute__((ext_vector_type(2)));

constexpr int NB = 4, SEQ = 4096, T = NB * SEQ, DM = 2048, LRU = 1536, MEMW = 512, NMEM = 256, NH = 12, HD = 128;
constexpr int NIN0 = 3584, NL1 = 5120, NEXP = 16384, NMROW = NB * NMEM;
constexpr float EPS = 1e-6f;
constexpr int NTHREADS = 512, NWAVES = 8;

constexpr size_t MiB = 1u << 20;
constexpr size_t O_CTL = 0;
constexpr size_t O_WIN0 = 1 * MiB;
constexpr size_t O_WOUT0 = O_WIN0 + 14 * MiB;
constexpr size_t O_WL1 = O_WOUT0 + 8 * MiB;
constexpr size_t O_WOUT1 = O_WL1 + 20 * MiB;
constexpr size_t O_WQ0 = O_WOUT1 + 8 * MiB;
constexpr size_t O_WQ1 = O_WQ0 + 8 * MiB;
constexpr size_t O_WMKV = O_WQ1 + 8 * MiB;
constexpr size_t O_WGATE = O_WMKV + 8 * MiB;
constexpr size_t O_SUBK = O_WGATE + 1 * MiB;
constexpr size_t O_WF = O_SUBK + 1 * MiB;
constexpr size_t O_SMALL = O_WF + 1 * MiB;
constexpr size_t O_RS1 = O_SMALL;
constexpr size_t O_LOGF = O_SMALL + 64 * 1024;
constexpr size_t O_CC = O_LOGF + 768 * 1024;
constexpr size_t O_GG = O_CC + 768 * 1024;
constexpr size_t O_SPL = O_GG + 4096;
constexpr size_t O_TSC = O_SPL + 8192;
constexpr size_t O_ROWSS = O_SMALL + 2 * MiB;
constexpr size_t O_RSP = O_ROWSS + 2 * MiB;
constexpr size_t O_QMSS = O_RSP;
constexpr size_t O_MKSS = O_QMSS + 1 * MiB;
constexpr size_t O_SSL1 = O_MKSS + 1 * MiB;
constexpr size_t O_CARRY = O_SSL1 + 7 * MiB;
constexpr size_t O_MEMN = O_CARRY + 3 * MiB;
constexpr size_t O_MKV = O_MEMN + 8 * MiB;
constexpr size_t O_IDX = O_MKV + 20 * MiB;
constexpr size_t O_GW = O_IDX + 8 * MiB;
constexpr size_t O_TAB = O_GW + 8 * MiB;
constexpr size_t TAB_NIB = (size_t)8 * 16384 * 128, TAB_ONE = TAB_NIB + (size_t)16384 * 16 + 786432;
constexpr size_t O_XS16 = O_TAB + 128 * MiB;
constexpr size_t O_CAT = O_XS16 + 64 * MiB;
constexpr size_t O_ZX = O_CAT + 64 * MiB;
constexpr size_t O_X8 = O_ZX;
constexpr size_t O_GY = O_ZX + 48 * MiB;
constexpr size_t O_LOGFP = O_GY + 48 * MiB;
constexpr size_t O_QM = O_LOGFP;
constexpr size_t O_XC = O_QM + 16 * MiB;
constexpr size_t O_X4 = O_XC;
constexpr size_t O_SX = O_XC + 32 * MiB;
constexpr size_t O_AA = O_XC + 48 * MiB;
constexpr size_t O_PART = O_AA;
constexpr size_t O_UU = O_AA + 96 * MiB;
constexpr size_t O_W8 = O_UU;
constexpr size_t O_Q16 = O_UU + 96 * MiB;
constexpr size_t O_ZL1 = O_Q16 + 64 * MiB;
constexpr size_t WS_END = O_ZL1 + 160 * MiB;
static_assert(WS_END <= 1024 * MiB, "workspace map");

__device__ __forceinline__ unsigned cvtpk(float lo, float hi) { unsigned r; asm volatile("v_cvt_pk_bf16_f32 %0, %1, %2" : "=v"(r) : "v"(lo), "v"(hi)); return r; }
__device__ __forceinline__ float bf_lo(unsigned w) { return __uint_as_float(w << 16); }
__device__ __forceinline__ float bf_hi(unsigned w) { return __uint_as_float(w & 0xffff0000u); }
__device__ __forceinline__ float fast_exp(float x) { return __builtin_amdgcn_exp2f(x * 1.4426950408889634f); }
__device__ __forceinline__ float log1p_pos(float y) { const float ser = y * (1.f - y * (0.5f - y * (0.33333334f - 0.25f * y))); const float lg = __builtin_amdgcn_logf(1.f + y) * 0.6931471805599453f; return y < 0.03f ? ser : lg; }
__device__ __forceinline__ float one_minus_exp(float x) { const float ser = -x * (1.f + x * (0.5f + x * (0.16666667f + x * 0.041666668f))); const float big = 1.f - fast_exp(x); return x > -0.03f ? ser : big; }
__device__ __forceinline__ float sigmoidf_(float x) { return __builtin_amdgcn_rcpf(1.f + fast_exp(-x)); }
__device__ __forceinline__ float gelu_tanh(float x) { const float u = x * (1.f + 0.044715f * x * x); return x * __builtin_amdgcn_rcpf(1.f + __builtin_amdgcn_exp2f(u * (-2.f * 0.7978845608028654f * 1.4426950408889634f))); }
template <int CTRL> __device__ __forceinline__ float dppf(float v) { return __int_as_float(__builtin_amdgcn_update_dpp(0, __float_as_int(v), CTRL, 0xF, 0xF, true)); }
__device__ __forceinline__ float xsum16(float v) { auto r = __builtin_amdgcn_permlane16_swap(__float_as_uint(v), __float_as_uint(v), false, false); return __uint_as_float(r[0]) + __uint_as_float(r[1]); }
__device__ __forceinline__ float xsum32(float v) { auto r = __builtin_amdgcn_permlane32_swap(__float_as_uint(v), __float_as_uint(v), false, false); return __uint_as_float(r[0]) + __uint_as_float(r[1]); }
__device__ __forceinline__ float xmax16(float v) { auto r = __builtin_amdgcn_permlane16_swap(__float_as_uint(v), __float_as_uint(v), false, false); return fmaxf(__uint_as_float(r[0]), __uint_as_float(r[1])); }
__device__ __forceinline__ float xmax32(float v) { auto r = __builtin_amdgcn_permlane32_swap(__float_as_uint(v), __float_as_uint(v), false, false); return fmaxf(__uint_as_float(r[0]), __uint_as_float(r[1])); }
__device__ __forceinline__ float wave_sum(float v) {
    v += dppf<0xB1>(v); v += dppf<0x4E>(v); v += dppf<0x141>(v); v += dppf<0x140>(v);
    v = xsum16(v); v = xsum32(v); return v;
}
__device__ __forceinline__ float wave_max(float v) {
    v = fmaxf(v, dppf<0xB1>(v)); v = fmaxf(v, dppf<0x4E>(v)); v = fmaxf(v, dppf<0x141>(v)); v = fmaxf(v, dppf<0x140>(v));
    v = xmax16(v); v = xmax32(v); return v;
}

namespace pg8 {
constexpr int BM = 256, BK = 64, HALF = 128, HTB = HALF * BK * 2, STAGE_BYTES = 8 * HTB, NXCD = 8, WGM = 8;
__host__ __device__ __forceinline__ int lds_byte(int r, int c) { const int st = (r >> 4) * 2 + (c >> 5), rr = r & 15, cc = c & 31, ob = rr * 64 + cc * 2; return st * 1024 + (ob ^ (((ob >> 9) & 1) << 5)); }
__host__ __device__ __forceinline__ void stage_rc(int b, int& R, int& C) { const int st = b / 1024, sb = b % 1024, swz = sb ^ (((sb >> 9) & 1) << 5); R = (st >> 1) * 16 + swz / 64; C = (st & 1) * 32 + (swz % 64) / 2; }
__host__ __device__ __forceinline__ int perm32(int rho) { const int n = rho >> 4, i = rho & 15; return 8 * (i >> 2) + 4 * n + (i & 3); }

struct Unit { int pm, pn; };
struct Gemm { const GAS bf16_t* A; const GAS bf16_t* Bt; int M, N, K, lda, ldb, acol; };

struct StaticOrder {
    int nM, nN, nwg, G, c;
    __device__ void init(int M, int N, int G_, int c_) { nM = M / BM; nN = N / BM; nwg = nM * nN; G = G_; c = c_; }
    __device__ bool next(int i, Unit& u) const {
        const long L = (long)i * G + c; if (L >= nwg) return false;
        int wgid = (int)L; { const int q = nwg / NXCD, r = nwg % NXCD, xcd = wgid % NXCD, off = wgid / NXCD; wgid = (xcd < r ? xcd * (q + 1) : r * (q + 1) + (xcd - r) * q) + off; }
        const int nig = WGM * nN, gid = wgid / nig, fm = gid * WGM, gsz = (nM - fm) < WGM ? (nM - fm) : WGM;
        u.pm = fm + ((wgid % nig) % gsz); u.pn = (wgid % nig) / gsz; return true;
    }
};

typedef int v8i_t __attribute__((ext_vector_type(8)));
typedef int v4i_t __attribute__((ext_vector_type(4)));
template <class Epi, bool FP8>
__device__ __forceinline__ void gemm_phase(LAS unsigned char* lds, const Gemm g, const StaticOrder& S, const Epi& E, const int tid) {
    const int wid = __builtin_amdgcn_readfirstlane(tid >> 6), lane = tid & 63, wr = wid >> 2, wc = wid & 3, fr = lane & 15, fq = lane >> 4;
    const int K = g.K, nt = K / BK;
    unsigned voffA[2], voffB[2];
#pragma unroll
    for (int i = 0; i < 2; ++i) { int R, C; stage_rc(tid * 16 + i * 8192, R, C); const int Rb = (R & ~31) + perm32(R & 31);
        voffA[i] = (unsigned)(R * g.lda + C) * 2u; voffB[i] = (unsigned)(Rb * g.ldb + C) * 2u; }
    const size_t kstep = (size_t)(BK * 2);
    const size_t hstepA = (size_t)HALF * g.lda * 2, hstepB = (size_t)HALF * g.ldb * 2;
    const size_t tstepA = 2 * hstepA, tstepB = 2 * hstepB;
    const unsigned ldsw = (unsigned)wid * 1024u;
    const int aoff = lds_byte(wr * 64 + fr, fq * 8), boff = lds_byte(wc * 32 + fr, fq * 8);
#define PG8_SA(b, h) (((b) * 2 + (h)) * HTB)
#define PG8_SB(b, h) ((4 + (b) * 2 + (h)) * HTB)
#define PG8_STAGE(bufoff, gbase, voff) do { _Pragma("unroll") for (int _i = 0; _i < 2; ++_i) \
        __builtin_amdgcn_global_load_lds((const GAS unsigned*)((gbase) + (voff)[_i]), (LAS unsigned*)(lds + (bufoff) + ldsw + _i * 8192), 16, 0, 0); } while (0)
#define PG8_LD2(dst, off_) do { const u32x4 lo_ = *(const LAS u32x4*)(lds + (off_)), hi_ = *(const LAS u32x4*)(lds + (off_) + 1024); \
        dst = (v8i_t){(int)lo_.x, (int)lo_.y, (int)lo_.z, (int)lo_.w, (int)hi_.x, (int)hi_.y, (int)hi_.z, (int)hi_.w}; } while (0)
#define PG8_LDA(dst, b, h) do { _Pragma("unroll") for (int m = 0; m < 4; ++m) PG8_LD2(dst[m], PG8_SA(b, h) + aoff + m * 2048); } while (0)
#define PG8_LDB(dst, b, h) do { _Pragma("unroll") for (int n = 0; n < 2; ++n) PG8_LD2(dst[n], PG8_SB(b, h) + boff + n * 2048); } while (0)
#define PG8_HALF(v, k) ((k) ? __builtin_shufflevector(v, v, 4, 5, 6, 7) : __builtin_shufflevector(v, v, 0, 1, 2, 3))
#define PG8_MMA(ai, bj, At, Bt) do { __builtin_amdgcn_s_setprio(1); _Pragma("unroll") for (int m = 0; m < 4; ++m) _Pragma("unroll") for (int n = 0; n < 2; ++n) { \
        if constexpr (FP8) asm volatile("v_mfma_scale_f32_16x16x128_f8f6f4 %0, %1, %2, %0, %3, %4 op_sel_hi:[0,0,0]" : "+v"(acc[ai][bj][m][n]) : "v"(Bt[n]), "v"(At[m]), "v"(sc_w), "v"(sc_x));     \
        else { _Pragma("unroll") for (int k = 0; k < 2; ++k) { const v4i_t bh_ = PG8_HALF(Bt[n], k), ah_ = PG8_HALF(At[m], k); \
                acc[ai][bj][m][n] = __builtin_amdgcn_mfma_f32_16x16x32_bf16(__builtin_bit_cast(bf16x8, bh_), __builtin_bit_cast(bf16x8, ah_), acc[ai][bj][m][n], 0, 0, 0); } } } \
        __builtin_amdgcn_s_setprio(0); } while (0)
#define PG8_WAIT_V(n) asm volatile("s_waitcnt vmcnt(" #n ")" ::: "memory")
#define PG8_WAIT_L(n) asm volatile("s_waitcnt lgkmcnt(" #n ")" ::: "memory")
#define PG8_BAR __builtin_amdgcn_s_barrier()
#define PG8_SCHED __builtin_amdgcn_sched_barrier(0)
    Unit cur, nxt; int ui = 0;
    if (!S.next(0, cur)) return;
    f32x4 acc[2][2][4][2];
#pragma unroll
    for (int a = 0; a < 2; ++a)
#pragma unroll
        for (int b = 0; b < 2; ++b)
#pragma unroll
            for (int m = 0; m < 4; ++m)
#pragma unroll
                for (int n = 0; n < 2; ++n) acc[a][b][m][n] = (f32x4){0.f, 0.f, 0.f, 0.f};
    v8i_t At[4], B0[2], B1[2];
    const int sc_w = 121, sc_x = 127;
    const GAS char* cA = (const GAS char*)g.A + (size_t)cur.pm * tstepA + (size_t)cur.pn * g.acol * 2; const GAS char* cB = (const GAS char*)g.Bt + (size_t)cur.pn * tstepB;
    PG8_STAGE(PG8_SB(0, 0), cB, voffB); PG8_STAGE(PG8_SB(0, 1), cB + hstepB, voffB); PG8_STAGE(PG8_SA(0, 0), cA, voffA); PG8_STAGE(PG8_SA(0, 1), cA + hstepA, voffA);
    if (wr == 1) PG8_BAR;
    PG8_WAIT_V(2); PG8_BAR;
    PG8_STAGE(PG8_SB(1, 0), cB + kstep, voffB); PG8_STAGE(PG8_SA(1, 0), cA + kstep, voffA); PG8_STAGE(PG8_SB(1, 1), cB + hstepB + kstep, voffB);
    PG8_WAIT_V(6); PG8_BAR;
    for (;;) {
        const bool has_next = S.next(ui + 1, nxt);
        const GAS char* nA = has_next ? (const GAS char*)g.A + (size_t)nxt.pm * tstepA + (size_t)nxt.pn * g.acol * 2 : cA; const GAS char* nB = has_next ? (const GAS char*)g.Bt + (size_t)nxt.pn * tstepB : cB;
        for (int t = 0; t < nt; t += 2) {
            const bool last = (t == nt - 2);
            const GAS char* a1 = cA + (size_t)(t + 1) * kstep;
            const GAS char* a2 = last ? nA : cA + (size_t)(t + 2) * kstep; const GAS char* b2 = last ? nB : cB + (size_t)(t + 2) * kstep;
            const GAS char* a3 = a2 + kstep; const GAS char* b3 = b2 + kstep;
            PG8_LDB(B0, 0, 0); PG8_LDB(B1, 0, 1); PG8_SCHED; PG8_LDA(At, 0, 0); PG8_STAGE(PG8_SA(1, 1), a1 + hstepA, voffA);
            PG8_WAIT_V(8); PG8_WAIT_L(0); PG8_BAR; PG8_MMA(0, 0, At, B0); PG8_MMA(0, 1, At, B1); PG8_BAR; PG8_SCHED;
            PG8_LDA(At, 0, 1); PG8_STAGE(PG8_SB(0, 0), b2, voffB); PG8_STAGE(PG8_SB(0, 1), b2 + hstepB, voffB); PG8_STAGE(PG8_SA(0, 0), a2, voffA);
            PG8_WAIT_V(8); PG8_WAIT_L(0); PG8_BAR; PG8_MMA(1, 0, At, B0); PG8_MMA(1, 1, At, B1); PG8_BAR; PG8_SCHED;
            PG8_LDB(B0, 1, 0); PG8_LDB(B1, 1, 1); PG8_SCHED; PG8_LDA(At, 1, 0); PG8_STAGE(PG8_SA(0, 1), a2 + hstepA, voffA);
            PG8_WAIT_V(8); PG8_WAIT_L(0); PG8_BAR; PG8_MMA(0, 0, At, B0); PG8_MMA(0, 1, At, B1); PG8_BAR; PG8_SCHED;
            PG8_LDA(At, 1, 1); PG8_STAGE(PG8_SB(1, 0), b3, voffB); PG8_STAGE(PG8_SB(1, 1), b3 + hstepB, voffB); PG8_STAGE(PG8_SA(1, 0), a3, voffA);
            PG8_WAIT_V(8); PG8_WAIT_L(0); PG8_BAR; PG8_MMA(1, 0, At, B0); PG8_MMA(1, 1, At, B1); PG8_BAR; PG8_SCHED;
        }
        if (wr == 0) PG8_BAR;
        { int ln_; asm volatile("v_mbcnt_lo_u32_b32 %0, -1, 0\n\tv_mbcnt_hi_u32_b32 %0, -1, %0" : "=v"(ln_));
          E(acc, cur, wr, wc, ln_ & 15, ln_ >> 4); }
        if (!has_next) break;
#pragma unroll
        for (int a = 0; a < 2; ++a)
#pragma unroll
            for (int b = 0; b < 2; ++b)
#pragma unroll
                for (int m = 0; m < 4; ++m)
#pragma unroll
                    for (int n = 0; n < 2; ++n) acc[a][b][m][n] = (f32x4){0.f, 0.f, 0.f, 0.f};
        cur = nxt; cA = nA; cB = nB; ++ui;
        if (wr == 1) PG8_BAR;
    }
    PG8_WAIT_V(0);
    PG8_BAR;
#undef PG8_SA
#undef PG8_SB
#undef PG8_STAGE
#undef PG8_LDA
#undef PG8_LDB
#undef PG8_LD2
#undef PG8_HALF
#undef PG8_MMA
#undef PG8_WAIT_V
#undef PG8_WAIT_L
#undef PG8_BAR
#undef PG8_SCHED
}
}

enum { EM_IN0 = 0, EM_MKV = 1, EM_GATE = 2, EM_RES = 3, EM_PQ = 4, EM_L1 = 5 };
struct Epi {
    int mode;
    GAS unsigned char* ws;
    const GAS float* resid;
    GAS float* outf;
    GAS bf16_t* o16;
    GAS float* ssq;
    const GAS float* gate_b;
    typedef pg8::Unit Unit;
    __device__ __forceinline__ static void st8(GAS bf16_t* p, f32x4 v0, f32x4 v1) {
        u32x4 w; w.x = cvtpk(v0[0], v0[1]); w.y = cvtpk(v0[2], v0[3]); w.z = cvtpk(v1[0], v1[1]); w.w = cvtpk(v1[2], v1[3]); *(GAS u32x4*)p = w; }
    __device__ __forceinline__ static float sq8(f32x4 a, f32x4 b) { return (a[0] * a[0] + a[1] * a[1]) + (a[2] * a[2] + a[3] * a[3]) + (b[0] * b[0] + b[1] * b[1]) + (b[2] * b[2] + b[3] * b[3]); }
    __device__ __forceinline__ void operator()(f32x4 (&acc)[2][2][4][2], const Unit& u, int wr, int wc, int fr, int fq) const {
        const int row0 = u.pm * 256 + wr * 64 + fr;
        const int cin = wc * 32 + 8 * fq;
        if (mode == EM_IN0) {
            GAS bf16_t* base; int ld, colt; int kind;
            if (u.pn < 6) { base = (GAS bf16_t*)(ws + O_ZX); ld = LRU; colt = u.pn * 256; kind = 0; }
            else if (u.pn < 12) { base = (GAS bf16_t*)(ws + O_GY); ld = LRU; colt = (u.pn - 6) * 256; kind = 1; }
            else { base = (GAS bf16_t*)(ws + O_ZL1); ld = NL1; colt = 4608 + (u.pn - 12) * 256; kind = 2; }
            GAS float* qmss = (GAS float*)(ws + O_SSL1);
#pragma unroll
            for (int ai = 0; ai < 2; ++ai)
#pragma unroll
                for (int m = 0; m < 4; ++m) { const int row = row0 + ai * 128 + m * 16;
#pragma unroll
                    for (int bj = 0; bj < 2; ++bj) { f32x4 v0 = acc[ai][bj][m][0], v1 = acc[ai][bj][m][1];
                        if (kind == 1) {
#pragma unroll
                            for (int j = 0; j < 4; ++j) { v0[j] = gelu_tanh(v0[j]); v1[j] = gelu_tanh(v1[j]); } }
                        st8(base + (size_t)row * ld + colt + bj * 128 + cin, v0, v1);
                        if (kind == 2) { float s = sq8(v0, v1); s = xsum16(s); s = xsum32(s);
                            if (fq == 0) qmss[(size_t)row * 112 + (24 + (u.pn - 12) * 2 + bj) * 4 + wc] = s; } } }
        } else if (mode == EM_MKV) {
#pragma unroll
            for (int ai = 0; ai < 2; ++ai)
#pragma unroll
                for (int m = 0; m < 4; ++m) { const int row = row0 + ai * 128 + m * 16;
#pragma unroll
                    for (int bj = 0; bj < 2; ++bj) { const f32x4 v0 = acc[ai][bj][m][0], v1 = acc[ai][bj][m][1];
                        st8(o16 + (size_t)row * NL1 + u.pn * 256 + bj * 128 + cin, v0, v1);
                        if (u.pn < 2) { float s = sq8(v0, v1); s = xsum16(s); s = xsum32(s);
                            if (fq == 0) ssq[(size_t)row * 112 + (u.pn * 2 + bj) * 4 + wc] = s; } } }
        } else if (mode == EM_GATE) {
            const int ch = u.pn * 128 + cin;
            const GAS bf16_t* xc = (const GAS bf16_t*)(ws + O_XC); GAS _Float16* LA = (GAS _Float16*)(ws + O_AA); GAS _Float16* UH = (GAS _Float16*)(ws + O_UU);
            const GAS float* spl = (const GAS float*)(ws + O_SPL) + ch; const GAS float* gb = gate_b + u.pn * 256 + cin;
#pragma unroll
            for (int n = 0; n < 2; ++n) {
                const f32x4 sp = *(const GAS f32x4*)(spl + 4 * n), br = *(const GAS f32x4*)(gb + 4 * n), bi = *(const GAS f32x4*)(gb + 128 + 4 * n);
#pragma unroll
                for (int ai = 0; ai < 2; ++ai)
#pragma unroll
                    for (int m = 0; m < 4; ++m) { const int row = row0 + ai * 128 + m * 16;
                        const u32x2 xw = *(const GAS u32x2*)(xc + (size_t)row * LRU + ch + 4 * n);
                        const f32x4 xv = {bf_lo(xw.x), bf_hi(xw.x), bf_lo(xw.y), bf_hi(xw.y)};
                        float lav[4], uvv[4];
#pragma unroll
                        for (int j = 0; j < 4; ++j) { const float r = sigmoidf_(acc[ai][0][m][n][j] + br[j]), ig = sigmoidf_(acc[ai][1][m][n][j] + bi[j]);
                            const float la = -8.f * r * sp[j];
                            lav[j] = la; uvv[j] = __builtin_amdgcn_sqrtf(one_minus_exp(2.f * la)) * (ig * xv[j]); }
                        { const h2 l0 = {(_Float16)lav[0], (_Float16)lav[1]}, l1 = {(_Float16)lav[2], (_Float16)lav[3]}, u0 = {(_Float16)uvv[0], (_Float16)uvv[1]}, u1 = {(_Float16)uvv[2], (_Float16)uvv[3]};
                          *(GAS u32x2*)(LA + (size_t)row * LRU + ch + 4 * n) = (u32x2){__builtin_bit_cast(unsigned, l0), __builtin_bit_cast(unsigned, l1)};
                          *(GAS u32x2*)(UH + (size_t)row * LRU + ch + 4 * n) = (u32x2){__builtin_bit_cast(unsigned, u0), __builtin_bit_cast(unsigned, u1)}; } }
            }
        } else if (mode == EM_RES) {
            GAS bf16_t* xs = (GAS bf16_t*)(ws + O_XS16); GAS float* rowss = (GAS float*)(ws + O_ROWSS);
#pragma unroll
            for (int ai = 0; ai < 2; ++ai)
#pragma unroll
                for (int m = 0; m < 4; ++m) { const int row = row0 + ai * 128 + m * 16; float s = 0.f;
#pragma unroll
                    for (int bj = 0; bj < 2; ++bj) { const size_t off = (size_t)row * DM + u.pn * 256 + bj * 128 + cin;
                        f32x4 r0, r1;
                        if (resid) { r0 = *(const GAS f32x4*)(resid + off); r1 = *(const GAS f32x4*)(resid + off + 4); }
                        else { const u32x4 w = *(const GAS u32x4*)(xs + off); r0 = (f32x4){bf_lo(w.x), bf_hi(w.x), bf_lo(w.y), bf_hi(w.y)}; r1 = (f32x4){bf_lo(w.z), bf_hi(w.z), bf_lo(w.w), bf_hi(w.w)}; }
                        const f32x4 v0 = acc[ai][bj][m][0] + r0, v1 = acc[ai][bj][m][1] + r1;
                        st8(xs + off, v0, v1); s += sq8(v0, v1); }
                    s = xsum16(s); s = xsum32(s);
                    if (fq == 0) rowss[(size_t)row * 32 + u.pn * 4 + wc] = s; }
        } else if (mode == EM_PQ) {
            const GAS float* rowss = (const GAS float*)(ws + O_ROWSS);
#pragma unroll
            for (int ai = 0; ai < 2; ++ai)
#pragma unroll
                for (int m = 0; m < 4; ++m) { const int row = row0 + ai * 128 + m * 16;
                    const f32x4 p0 = *(const GAS f32x4*)(rowss + (size_t)row * 32 + fq * 8), p1 = *(const GAS f32x4*)(rowss + (size_t)row * 32 + fq * 8 + 4);
                    float s = (p0[0] + p0[1]) + (p0[2] + p0[3]) + (p1[0] + p1[1]) + (p1[2] + p1[3]); s = xsum16(s); s = xsum32(s);
                    const float r = rsqrtf(s * (1.f / DM) + EPS);
#pragma unroll
                    for (int bj = 0; bj < 2; ++bj) st8(o16 + (size_t)row * DM + u.pn * 256 + bj * 128 + cin, acc[ai][bj][m][0] * r, acc[ai][bj][m][1] * r); }
        } else {
            const GAS float* rsp = (const GAS float*)(ws + O_RSP); GAS bf16_t* zl1 = (GAS bf16_t*)(ws + O_ZL1); GAS float* ssl1 = (GAS float*)(ws + O_SSL1);
            const int slot0 = u.pn < 6 ? u.pn * 2 : (u.pn >= 12 ? 12 + (u.pn - 12) * 2 : -1);
#pragma unroll
            for (int ai = 0; ai < 2; ++ai)
#pragma unroll
                for (int m = 0; m < 4; ++m) { const int row = row0 + ai * 128 + m * 16;
                    const f32x4 q0 = *(const GAS f32x4*)(rsp + (size_t)row * 8), q1 = *(const GAS f32x4*)(rsp + (size_t)row * 8 + 4);
                    const float r = rsqrtf(((q0[0] + q0[1]) + (q0[2] + q0[3]) + (q1[0] + q1[1]) + (q1[2] + q1[3])) * (1.f / DM) + EPS);
#pragma unroll
                    for (int bj = 0; bj < 2; ++bj) { const f32x4 v0 = acc[ai][bj][m][0] * r, v1 = acc[ai][bj][m][1] * r;
                        st8(zl1 + (size_t)row * NL1 + u.pn * 256 + bj * 128 + cin, v0, v1);
                        if (slot0 >= 0) { float s = sq8(v0, v1); s = xsum16(s); s = xsum32(s);
                            if (fq == 0) ssl1[(size_t)row * 112 + (slot0 + bj) * 4 + wc] = s; } } }
        }
    }
};

namespace att {
constexpr float SCALE = 0.08838834764831845f;
constexpr int NW = 8, QBLK = 32, KVBLK = 64, QB = NW * QBLK, D = 128;
constexpr int SHM_V = KVBLK * D * 2, SHM_K = KVBLK * D * 2;
constexpr int OFF_WS = 2 * SHM_V + 2 * SHM_K;
constexpr int OFF_KS = OFF_WS + 2048;
constexpr int OFF_BS = OFF_KS + 16384;
constexpr int LDS_END = OFF_BS + 16384;
constexpr int WBIG = 1 << 28;

#define KSWZ(row, colB) ((row) * 256 + ((colB) ^ (((row) & 7) << 4)))
#define SBAR() __builtin_amdgcn_sched_barrier(0)
__device__ __forceinline__ int v_st(int k, int c) { const int kk = (k & ~0xC) | ((k & 4) << 1) | ((k & 8) >> 1); return ((kk >> 3) * 4 + (c >> 5)) * 512 + ((kk & 7) * 32 + (c & 31)) * 2; }
__device__ __forceinline__ int v_rd_base(int lane) { return ((lane & 3) << 3) | (((lane >> 2) & 3) << 6) | (((lane >> 4) & 1) << 5) | (((lane >> 5) & 1) << 8); }
constexpr int v_rd_off(int d0, int ks, int half) { return d0 * 512 + ks * 4096 + half * 2048; }
__device__ __forceinline__ int crow(int r, int hi) { return (r & 3) + 8 * (r >> 2) + 4 * hi; }
__device__ __forceinline__ bf16x8 load8(const GAS bf16_t* p) { return *(const GAS bf16x8*)p; }
__device__ __forceinline__ bf16x8 scale8(bf16x8 v, float s) { const u32x4 w = *reinterpret_cast<u32x4*>(&v); u32x4 o;
    o.x = cvtpk(bf_lo(w.x) * s, bf_hi(w.x) * s); o.y = cvtpk(bf_lo(w.y) * s, bf_hi(w.y) * s); o.z = cvtpk(bf_lo(w.z) * s, bf_hi(w.z) * s); o.w = cvtpk(bf_lo(w.w) * s, bf_hi(w.w) * s);
    return *reinterpret_cast<bf16x8*>(&o); }
__device__ __forceinline__ void mask_tile(f32x16& p0, f32x16& p1, int dq, unsigned W) {
    const float NEG = -__builtin_inff();
#pragma unroll
    for (int r = 0; r < 16; ++r) {
        const int c = (r & 3) + 8 * (r >> 2);
        if ((unsigned)(dq - c) >= W) p0[r] = NEG;
        if ((unsigned)(dq - c - 32) >= W) p1[r] = NEG;
    }
}
constexpr float THR = 8.f;
__device__ __forceinline__ void partialSM(f32x16& p0, f32x16& p1, float& m_reg, float& mn, float& alpha) {
    float pmax = p0[0]; for (int r = 1; r < 16; ++r) pmax = fmaxf(pmax, p0[r]); for (int r = 0; r < 16; ++r) pmax = fmaxf(pmax, p1[r]);
    { auto rr = __builtin_amdgcn_permlane32_swap(__float_as_uint(pmax), __float_as_uint(pmax), false, false);
      pmax = fmaxf(__uint_as_float(rr[0]), __uint_as_float(rr[1])); }
    constexpr float C2 = 1.4426950408889634f * SCALE;
    if (__builtin_expect(__all((pmax - m_reg) * SCALE <= THR), 1)) { mn = m_reg; alpha = 1.f; }
    else { mn = fmaxf(m_reg, pmax); alpha = __builtin_amdgcn_exp2f((m_reg - mn) * C2); m_reg = mn; }
    const float mnL = -mn * C2;
    for (int r = 0; r < 16; ++r) p0[r] = fmaf(p0[r], C2, mnL); for (int r = 0; r < 16; ++r) p1[r] = fmaf(p1[r], C2, mnL);
    for (int r = 0; r < 16; ++r) p0[r] = __builtin_amdgcn_exp2f(p0[r]);
}
__device__ __forceinline__ void finishSM(f32x16& p0, f32x16& p1, float alpha, float& l_reg, bf16x8& pa0, bf16x8& pa1, bf16x8& pa2, bf16x8& pa3) {
    for (int r = 0; r < 16; ++r) p1[r] = __builtin_amdgcn_exp2f(p1[r]);
    float ps = 0; for (int r = 0; r < 16; ++r) ps += p0[r]; for (int r = 0; r < 16; ++r) ps += p1[r];
    { auto rr = __builtin_amdgcn_permlane32_swap(__float_as_uint(ps), __float_as_uint(ps), false, false);
      ps = __uint_as_float(rr[0]) + __uint_as_float(rr[1]); }
    l_reg = l_reg * alpha + ps;
#define PK4(P, B_, OUT) do { unsigned a0 = cvtpk(P[B_+0], P[B_+1]), a1 = cvtpk(P[B_+2], P[B_+3]);                          \
        unsigned b0 = cvtpk(P[B_+4], P[B_+5]), b1 = cvtpk(P[B_+6], P[B_+7]);                                             \
        auto r0 = __builtin_amdgcn_permlane32_swap(a0, b0, false, false); auto r1 = __builtin_amdgcn_permlane32_swap(a1, b1, false, false); \
        u32x4 w = {r0[0], r1[0], r0[1], r1[1]}; OUT = *reinterpret_cast<bf16x8*>(&w); } while (0)
    PK4(p0, 0, pa0); PK4(p0, 8, pa1); PK4(p1, 0, pa2); PK4(p1, 8, pa3);
#undef PK4
}
template <int KB>
__device__ __forceinline__ void qkt(f32x16& p0, f32x16& p1, const char* K_lds, int r32, int hi, const bf16x8* qr, const float* bp  ) {
    { const f32x4 a = *(const f32x4*)(bp), b = *(const f32x4*)(bp + 8), c = *(const f32x4*)(bp + 16), d = *(const f32x4*)(bp + 24);
      p0 = (f32x16){a[0], a[1], a[2], a[3], b[0], b[1], b[2], b[3], c[0], c[1], c[2], c[3], d[0], d[1], d[2], d[3]}; }
    { const f32x4 a = *(const f32x4*)(bp + 32), b = *(const f32x4*)(bp + 40), c = *(const f32x4*)(bp + 48), d = *(const f32x4*)(bp + 56);
      p1 = (f32x16){a[0], a[1], a[2], a[3], b[0], b[1], b[2], b[3], c[0], c[1], c[2], c[3], d[0], d[1], d[2], d[3]}; }
    const char* kb[4];
#pragma unroll
    for (int dd = 0; dd < 4; ++dd) kb[dd] = K_lds + KB * SHM_K + KSWZ(r32, (dd * 16 + hi * 8) * 2);
#pragma unroll
    for (int d0 = 0; d0 < 8; ++d0) { const char* a = kb[d0 & 3] + (d0 >> 2) * 128;
        bf16x8 b0 = *reinterpret_cast<const bf16x8*>(a);
        bf16x8 b1 = *reinterpret_cast<const bf16x8*>(a + 32 * 256);
        p0 = __builtin_amdgcn_mfma_f32_32x32x16_bf16(b0, qr[d0], p0, 0, 0, 0);
        p1 = __builtin_amdgcn_mfma_f32_32x32x16_bf16(b1, qr[d0], p1, 0, 0, 0); }
}
template <int KB>
__device__ __forceinline__ void qkt0(f32x16& p0, f32x16& p1, const char* K_lds, int r32, int hi, const bf16x8* qr) {
    p0 = f32x16{}; p1 = f32x16{};
    const char* kb[4];
#pragma unroll
    for (int dd = 0; dd < 4; ++dd) kb[dd] = K_lds + KB * SHM_K + KSWZ(r32, (dd * 16 + hi * 8) * 2);
#pragma unroll
    for (int d0 = 0; d0 < 8; ++d0) { const char* a = kb[d0 & 3] + (d0 >> 2) * 128;
        bf16x8 b0 = *reinterpret_cast<const bf16x8*>(a);
        bf16x8 b1 = *reinterpret_cast<const bf16x8*>(a + 32 * 256);
        p0 = __builtin_amdgcn_mfma_f32_32x32x16_bf16(b0, qr[d0], p0, 0, 0, 0);
        p1 = __builtin_amdgcn_mfma_f32_32x32x16_bf16(b1, qr[d0], p1, 0, 0, 0); }
}
template <int VB>
__device__ __forceinline__ void pv_tile(f32x16* o, int vb0, bf16x8 pa0, bf16x8 pa1, bf16x8 pa2, bf16x8 pa3) {
#define TRRD(dst, off) asm volatile("ds_read_b64_tr_b16 %0, %1 offset:%2" : "=&v"(dst) : "v"(vb0), "i"(off) : "memory")
#define PV_D0(d0) do { s16x4 l0, l1, l2, l3, h0, h1, h2_, h3; constexpr int b_ = VB * SHM_V + v_rd_off(d0, 0, 0); \
        TRRD(l0, b_); TRRD(h0, b_ + 2048); TRRD(l1, b_ + 4096); TRRD(h1, b_ + 6144); TRRD(l2, b_ + 8192); TRRD(h2_, b_ + 10240); TRRD(l3, b_ + 12288); TRRD(h3, b_ + 14336); \
        asm volatile("s_waitcnt lgkmcnt(0)" ::: "memory"); SBAR();   \
        o[d0] = __builtin_amdgcn_mfma_f32_32x32x16_bf16(pa0, (bf16x8){l0[0], l0[1], l0[2], l0[3], h0[0], h0[1], h0[2], h0[3]}, o[d0], 0, 0, 0);   \
        o[d0] = __builtin_amdgcn_mfma_f32_32x32x16_bf16(pa1, (bf16x8){l1[0], l1[1], l1[2], l1[3], h1[0], h1[1], h1[2], h1[3]}, o[d0], 0, 0, 0);   \
        o[d0] = __builtin_amdgcn_mfma_f32_32x32x16_bf16(pa2, (bf16x8){l2[0], l2[1], l2[2], l2[3], h2_[0], h2_[1], h2_[2], h2_[3]}, o[d0], 0, 0, 0);   \
        o[d0] = __builtin_amdgcn_mfma_f32_32x32x16_bf16(pa3, (bf16x8){l3[0], l3[1], l3[2], l3[3], h3[0], h3[1], h3[2], h3[3]}, o[d0], 0, 0, 0); } while (0)
    PV_D0(0); PV_D0(1); PV_D0(2); PV_D0(3);
#undef PV_D0
#undef TRRD
}

struct BlockRef { const GAS bf16_t* Q; const GAS bf16_t* K; const GAS bf16_t* V; GAS bf16_t* O; const GAS float* qss; const GAS float* kss; const GAS float* cc; const GAS float* gg;
                  int P0, skv; };
constexpr int LDQ = 5120, LDK = 5120, LDO = 2048, LDSS = 112;
struct Seam { bf16x8 qr[8]; bf16x8 st_v0, st_v1, st_k0, st_k1; int jlo; };
#define ROWK(p, k0, rr) ((p) + (size_t)((k0) + (rr)) * LDK + sc)
#define VMW() asm volatile("s_waitcnt vmcnt(0)" ::: "memory")
#define VMWN(n) asm volatile("s_waitcnt vmcnt(%0)" :: "i"(n) : "memory")
#define SLOAD_H(Kp, Vp, k0) do { S.st_v0 = load8(ROWK(Vp, k0, sr)); S.st_v1 = load8(ROWK(Vp, k0, 32 + sr));              \
                         S.st_k0 = load8(ROWK(Kp, k0, sr)); S.st_k1 = load8(ROWK(Kp, k0, 32 + sr)); } while (0)
#define SWRITE_HK(bf, k0) do { *(bf16x8*)(K_lds + (bf) * SHM_K + kws) = scale8(S.st_k0, ksr[(k0)]); *(bf16x8*)(K_lds + (bf) * SHM_K + kws + 32 * 256) = scale8(S.st_k1, ksr[(k0) + 32]); } while (0)
#define SWRITE_HV(bf) do { *(bf16x8*)(V_lds + (bf) * SHM_V + vst0) = S.st_v0; *(bf16x8*)(V_lds + (bf) * SHM_V + vst1) = S.st_v1; } while (0)
#define SWRITE_H(bf, k0) do { SWRITE_HV(bf); SWRITE_HK(bf, k0); } while (0)

__device__ __forceinline__ void attn_prime(const BlockRef& cur, char* lds, Seam& S, const int tid) {
    const int wid = __builtin_amdgcn_readfirstlane(tid >> 6), lane = tid & 63, r32 = lane & 31, hi = lane >> 5;
    const int sr = tid >> 4, sc = (tid & 15) * 8, kws = KSWZ(sr, sc * 2); char* K_lds = lds + 2 * SHM_V;
    float* ks_l = (float*)(lds + OFF_KS); float* bs_l = (float*)(lds + OFF_BS); const float* ksr = ks_l + sr;
    int j_hi = (cur.P0 + QB - 1) / KVBLK + 1; if (j_hi > cur.skv / KVBLK) j_hi = cur.skv / KVBLK;
    const int nkeys = j_hi * KVBLK;
    const float c0 = cur.cc ? cur.cc[cur.P0] : 0.f;
    int jlo = 0;
    if (cur.cc) { const float thr = cur.gg[128]; const int jd = cur.P0 / KVBLK;
        const float cv = lane <= jd ? cur.cc[lane * KVBLK + KVBLK - 1] : 0.f;
        const bool keep = lane > jd || (c0 - cv > -thr);
        jlo = __ffsll((long long)__ballot(keep)) - 1; }
    S.jlo = jlo;
    for (int s = jlo * KVBLK + tid; s < nkeys; s += NTHREADS) {
        const f32x4 p = *(const GAS f32x4*)(cur.kss + (size_t)s * LDSS);
        ks_l[s] = rsqrtf(((p[0] + p[1]) + (p[2] + p[3])) * (1.f / 128.f) + EPS);
        bs_l[s] = cur.cc ? (c0 - cur.cc[s]) * (1.f / SCALE) : 0.f;
    }
    __syncthreads();
    const int qrow = wid * QBLK + r32;
    const f32x4 qp = *(const GAS f32x4*)(cur.qss + (size_t)qrow * LDSS);
    const float rq = rsqrtf(((qp[0] + qp[1]) + (qp[2] + qp[3])) * (1.f / 128.f) + EPS);
#pragma unroll
    for (int d0 = 0; d0 < 8; ++d0) {
        const u32x4 w = *(const GAS u32x4*)(cur.Q + (size_t)qrow * LDQ + d0 * 16 + hi * 8);
        const f32x4 g0 = *(const GAS f32x4*)(cur.gg + d0 * 16 + hi * 8), g1 = *(const GAS f32x4*)(cur.gg + d0 * 16 + hi * 8 + 4);
        u32x4 o; o.x = cvtpk(bf_lo(w.x) * rq * g0[0], bf_hi(w.x) * rq * g0[1]); o.y = cvtpk(bf_lo(w.y) * rq * g0[2], bf_hi(w.y) * rq * g0[3]);
        o.z = cvtpk(bf_lo(w.z) * rq * g1[0], bf_hi(w.z) * rq * g1[1]); o.w = cvtpk(bf_lo(w.w) * rq * g1[2], bf_hi(w.w) * rq * g1[3]);
        S.qr[d0] = *reinterpret_cast<bf16x8*>(&o);
    }
    SLOAD_H(cur.K, cur.V, jlo * KVBLK); VMW(); SWRITE_HK(0, jlo * KVBLK);
    __syncthreads();
}
__device__ __forceinline__ void attn_block(const BlockRef& cur, char* lds, Seam& S, const int tid) {
    const int wid = __builtin_amdgcn_readfirstlane(tid >> 6), lane = tid & 63, r32 = lane & 31, hi = lane >> 5;
    const int W = WBIG;
    int j_hi = (cur.P0 + QB - 1) / KVBLK + 1; if (j_hi > cur.skv / KVBLK) j_hi = cur.skv / KVBLK;
    const int j_lo = S.jlo; const int NT = j_hi - j_lo;
    const int qlo = cur.P0 - j_lo * KVBLK + wid * QBLK, qm = qlo + r32 - 4 * hi;
    char* V_lds = lds; char* K_lds = lds + 2 * SHM_V;
    float* ws = (float*)(lds + OFF_WS) + wid * 64; float* li_l = ws, * al_l = ws + 32;
    const float* bs_l = (const float*)(lds + OFF_BS) + j_lo * KVBLK + 4 * hi;
    float m_reg = -1e30f, l_reg = 0; f32x16 o[4] = {};
    const int sr = tid >> 4, sc = (tid & 15) * 8, vst0 = v_st(sr, sc), vst1 = v_st(32 + sr, sc), kws = KSWZ(sr, sc * 2);
    const float* ksr = (const float*)(lds + OFF_KS) + j_lo * KVBLK + sr;
    const int vb0 = (int)(uintptr_t)V_lds + v_rd_base(lane);
    const GAS bf16_t* Kh = cur.K + (size_t)j_lo * KVBLK * LDK; const GAS bf16_t* Vh = cur.V + (size_t)j_lo * KVBLK * LDK;
#define RESC(a) do { if (__any((a) < 1.f)) { if (hi == 0) al_l[r32] = (a); asm volatile("s_waitcnt lgkmcnt(0)" ::: "memory");              \
                     for (int d_ = 0; d_ < 4; ++d_) for (int r = 0; r < 16; ++r) o[d_][r] *= al_l[crow(r, hi)]; } } while (0)
#define KBASE(t) ((t) * KVBLK)
#define MASKT(P0_, P1_, t) do { const int kb_ = KBASE(t); if (kb_ + KVBLK - 1 > qlo) mask_tile(P0_, P1_, qm - kb_, (unsigned)W); } while (0)
    f32x16 pA0, pA1, pB0, pB1; float mnA, mnB, alA, alB; bf16x8 pa0, pa1, pa2, pa3;
    SWRITE_HV(0); SBAR();
    if (NT > 1) { SLOAD_H(Kh, Vh, KBASE(1)); }
    SBAR(); qkt<0>(pA0, pA1, K_lds, r32, hi, S.qr, bs_l + KBASE(0));
    MASKT(pA0, pA1, 0); partialSM(pA0, pA1, m_reg, mnA, alA);
    if (NT > 1) { VMW(); SWRITE_H(1, KBASE(1)); }
    __syncthreads();
#define HALF_STEP(PX0, PX1, mnX, alX, PY0, PY1, alY, t, KB, VB, SB) do {                                                      \
        SBAR(); qkt<KB>(PX0, PX1, K_lds, r32, hi, S.qr, bs_l + KBASE(t));                                                         \
        finishSM(PY0, PY1, alY, l_reg, pa0, pa1, pa2, pa3); SBAR();                                                           \
        if ((t) + 1 < NT) { SLOAD_H(Kh, Vh, KBASE((t) + 1)); SBAR(); }                                               \
        pv_tile<VB>(o, vb0, pa0, pa1, pa2, pa3); MASKT(PX0, PX1, (t)); partialSM(PX0, PX1, m_reg, mnX, alX);                                        \
        __syncthreads();                                                                                                      \
        if ((t) + 1 < NT) { VMW(); SWRITE_H(SB, KBASE((t) + 1)); }                                                                          \
        RESC(alX); __syncthreads(); } while (0)
    for (int t = 1; t + 1 < NT; t += 2) {
        HALF_STEP(pB0, pB1, mnB, alB, pA0, pA1, alA, t, 1, 0, 0);
        HALF_STEP(pA0, pA1, mnA, alA, pB0, pB1, alB, t + 1, 0, 1, 1);
    }
    const bool even = (NT & 1) == 0;
    if (even) { SBAR(); qkt<1>(pB0, pB1, K_lds, r32, hi, S.qr, bs_l + KBASE(NT - 1)); SBAR(); }
    finishSM(pA0, pA1, alA, l_reg, pa0, pa1, pa2, pa3); SBAR();
    pv_tile<0>(o, vb0, pa0, pa1, pa2, pa3);
    if (even) { MASKT(pB0, pB1, NT - 1); partialSM(pB0, pB1, m_reg, mnB, alB); __syncthreads(); RESC(alB);
        finishSM(pB0, pB1, alB, l_reg, pa0, pa1, pa2, pa3); SBAR(); pv_tile<1>(o, vb0, pa0, pa1, pa2, pa3); }
    SBAR();
    if (hi == 0) li_l[r32] = l_reg; asm volatile("s_waitcnt lgkmcnt(0)" ::: "memory");
    float rli[16];
#pragma unroll
    for (int r = 0; r < 16; ++r) rli[r] = __builtin_amdgcn_rcpf(li_l[crow(r, hi)]);
    GAS bf16_t* Ow = cur.O + (size_t)(wid * QBLK) * LDO;
#pragma unroll
    for (int r = 0; r < 16; ++r) { const int orow = crow(r, hi);
#pragma unroll
        for (int d0 = 0; d0 < 4; ++d0) { const float v = o[d0][r] * rli[r];
            const float vn = dppf<0xB1>(v);
            if ((r32 & 1) == 0) *(GAS unsigned*)(Ow + (size_t)orow * LDO + d0 * 32 + r32) = cvtpk(v, vn); } }
    __syncthreads();
#undef RESC
#undef KBASE
#undef MASKT
#undef HALF_STEP
}
constexpr int MOFF_K = 4 * SHM_V, MOFF_WS = MOFF_K + 4 * SHM_K, MOFF_KS = MOFF_WS + 2048;
__device__ __forceinline__ void mem_attn_unit(const BlockRef& cur, char* lds, const int tid) {
    const int wid = __builtin_amdgcn_readfirstlane(tid >> 6), lane = tid & 63, r32 = lane & 31, hi = lane >> 5;
    const int sr = tid >> 4, sc = (tid & 15) * 8, kws = KSWZ(sr, sc * 2), vst0 = v_st(sr, sc), vst1 = v_st(32 + sr, sc);
    char* V_lds = lds; char* K_lds = lds + MOFF_K; float* ks_l = (float*)(lds + MOFF_KS);
    float* ws = (float*)(lds + MOFF_WS) + wid * 64; float* li_l = ws, * al_l = ws + 32;
    float ksv = 0.f;
    if (tid < 256) { const f32x4 p = *(const GAS f32x4*)(cur.kss + (size_t)tid * LDSS); ksv = rsqrtf(((p[0] + p[1]) + (p[2] + p[3])) * (1.f / 128.f) + EPS); }
    bf16x8 kk[4][2], vv[4][2];
#pragma unroll
    for (int t = 0; t < 4; ++t) { kk[t][0] = load8(ROWK(cur.K, t * KVBLK, sr)); kk[t][1] = load8(ROWK(cur.K, t * KVBLK, 32 + sr)); vv[t][0] = load8(ROWK(cur.V, t * KVBLK, sr)); vv[t][1] = load8(ROWK(cur.V, t * KVBLK, 32 + sr)); }
    const int qrow = wid * QBLK + r32;
    const f32x4 qp = *(const GAS f32x4*)(cur.qss + (size_t)qrow * LDSS);
    u32x4 qw[8];
#pragma unroll
    for (int d0 = 0; d0 < 8; ++d0) qw[d0] = *(const GAS u32x4*)(cur.Q + (size_t)qrow * LDQ + d0 * 16 + hi * 8);
    if (tid < 256) ks_l[tid] = ksv;
    __syncthreads();
#pragma unroll
    for (int t = 0; t < 4; ++t) { *(bf16x8*)(K_lds + t * SHM_K + kws) = scale8(kk[t][0], ks_l[t * KVBLK + sr]); *(bf16x8*)(K_lds + t * SHM_K + kws + 32 * 256) = scale8(kk[t][1], ks_l[t * KVBLK + 32 + sr]);
        *(bf16x8*)(V_lds + t * SHM_V + vst0) = vv[t][0]; *(bf16x8*)(V_lds + t * SHM_V + vst1) = vv[t][1]; }
    const float rq = rsqrtf(((qp[0] + qp[1]) + (qp[2] + qp[3])) * (1.f / 128.f) + EPS);
    bf16x8 qr[8];
#pragma unroll
    for (int d0 = 0; d0 < 8; ++d0) { const u32x4 w = qw[d0];
        const f32x4 g0 = *(const GAS f32x4*)(cur.gg + d0 * 16 + hi * 8), g1 = *(const GAS f32x4*)(cur.gg + d0 * 16 + hi * 8 + 4);
        u32x4 o; o.x = cvtpk(bf_lo(w.x) * rq * g0[0], bf_hi(w.x) * rq * g0[1]); o.y = cvtpk(bf_lo(w.y) * rq * g0[2], bf_hi(w.y) * rq * g0[3]);
        o.z = cvtpk(bf_lo(w.z) * rq * g1[0], bf_hi(w.z) * rq * g1[1]); o.w = cvtpk(bf_lo(w.w) * rq * g1[2], bf_hi(w.w) * rq * g1[3]);
        qr[d0] = *reinterpret_cast<bf16x8*>(&o); }
    __syncthreads();
    const int vb0 = (int)(uintptr_t)V_lds + v_rd_base(lane);
    float m_reg = -1e30f, l_reg = 0; f32x16 o[4] = {};
#define MEM_TILE(t) do { f32x16 p0, p1; float mn, al; bf16x8 pa0, pa1, pa2, pa3; \
        qkt0<t>(p0, p1, K_lds, r32, hi, qr); partialSM(p0, p1, m_reg, mn, al); \
        if (__any(al < 1.f)) { if (hi == 0) al_l[r32] = al; asm volatile("s_waitcnt lgkmcnt(0)" ::: "memory"); for (int d_ = 0; d_ < 4; ++d_) for (int r = 0; r < 16; ++r) o[d_][r] *= al_l[crow(r, hi)]; } \
        finishSM(p0, p1, al, l_reg, pa0, pa1, pa2, pa3); SBAR(); pv_tile<t>(o, vb0, pa0, pa1, pa2, pa3); SBAR(); } while (0)
    MEM_TILE(0); MEM_TILE(1); MEM_TILE(2); MEM_TILE(3);
#undef MEM_TILE
    if (hi == 0) li_l[r32] = l_reg; asm volatile("s_waitcnt lgkmcnt(0)" ::: "memory");
    float rli[16];
#pragma unroll
    for (int r = 0; r < 16; ++r) rli[r] = __builtin_amdgcn_rcpf(li_l[crow(r, hi)]);
    GAS bf16_t* Ow = cur.O + (size_t)(wid * QBLK) * LDO;
#pragma unroll
    for (int r = 0; r < 16; ++r) { const int orow = crow(r, hi);
#pragma unroll
        for (int d0 = 0; d0 < 4; ++d0) { const float v = o[d0][r] * rli[r];
            const float vn = dppf<0xB1>(v);
            if ((r32 & 1) == 0) *(GAS unsigned*)(Ow + (size_t)orow * LDO + d0 * 32 + r32) = cvtpk(v, vn); } }
    __syncthreads();
}
#undef ROWK
#undef VMW
#undef VMWN
#undef SLOAD_H
#undef SWRITE_HK
#undef SWRITE_HV
#undef SWRITE_H
#undef KSWZ
#undef SBAR
}


struct Frame {
    GAS unsigned char* ws; const float* const* in_; GAS float* out;
    __device__ __forceinline__ const GAS float* in(int i) const { return (const GAS float*)in_[i]; }
    int tid, lane, wave, gw, ngw, gtid, ngt;
};
enum { I_X = 0, I_MEM, I_ANORM, I_AWIN, I_ACONVW, I_ACONVB, I_AGATEW, I_AGATEB, I_ALAMBDA, I_AWOUT, I_SNORM, I_SWKVF, I_SBF, I_SKNORM, I_BNORM, I_BWIN, I_BQNORM, I_BWOUT,
       I_MNORM, I_MWKV, I_MQNORM, I_MKNORM, I_PNORM, I_PWQ, I_PSUBK, I_PU, I_PV, N_IN };

struct TrItem { const GAS float* W; const GAS float* gain; GAS bf16_t* WT; int ldw, ldt, row_off, k0, n0; };
__device__ __forceinline__ void tr_load(const TrItem& d, float (&wv)[32], int lane) {
#pragma unroll
    for (int i = 0; i < 32; ++i) wv[i] = __builtin_nontemporal_load(d.W + (size_t)(d.k0 + 2 * i + (lane >> 5)) * d.ldw + d.n0 + (lane & 31));
}
__device__ __forceinline__ void tr_proc(const TrItem& d, float (&wv)[32], LAS float* scr, int lane) {
    if (d.gain) {
#pragma unroll
        for (int i = 0; i < 32; ++i) wv[i] *= d.gain[d.k0 + 2 * i + (lane >> 5)]; }
#pragma unroll
    for (int i = 0; i < 32; ++i) scr[(2 * i + (lane >> 5)) * 33 + (lane & 31)] = wv[i];
    asm volatile("s_waitcnt lgkmcnt(0)" ::: "memory");
    const int c = lane & 7;
#pragma unroll
    for (int j = 0; j < 4; ++j) { const int n = (lane >> 3) + 8 * j; const LAS float* s = scr + (8 * c) * 33 + n;
        u32x4 o; o.x = cvtpk(s[0 * 33], s[1 * 33]); o.y = cvtpk(s[2 * 33], s[3 * 33]); o.z = cvtpk(s[4 * 33], s[5 * 33]); o.w = cvtpk(s[6 * 33], s[7 * 33]);
        *(GAS u32x4*)(d.WT + (size_t)(d.row_off + d.n0 + n) * d.ldt + d.k0 + 8 * c) = o; }
    asm volatile("s_waitcnt lgkmcnt(0)" ::: "memory");
}
__device__ __forceinline__ void transpose_item_fp8(const GAS float* W, int ldw, const GAS float* gain, GAS unsigned char* WT, int ldt, LAS float* scr, int nblk, int item, int lane) {
    const int kb = item / nblk, nb = item % nblk, k0 = 64 * kb, n0 = 32 * nb;
    float wv[32];
#pragma unroll
    for (int i = 0; i < 32; ++i) wv[i] = W[(size_t)(k0 + 2 * i + (lane >> 5)) * ldw + n0 + (lane & 31)];
#pragma unroll
    for (int i = 0; i < 32; ++i) wv[i] *= gain[k0 + 2 * i + (lane >> 5)] * 64.f;
#pragma unroll
    for (int i = 0; i < 32; ++i) scr[(2 * i + (lane >> 5)) * 33 + (lane & 31)] = wv[i];
    asm volatile("s_waitcnt lgkmcnt(0)" ::: "memory");
    const int c = lane & 3;
#pragma unroll
    for (int j = 0; j < 2; ++j) { const int n = (lane >> 2) + 16 * j; const LAS float* sp = scr + (16 * c) * 33 + n; u32x4 o;
#pragma unroll
        for (int w = 0; w < 4; ++w) { int pk = __builtin_amdgcn_cvt_pk_fp8_f32(sp[(4 * w) * 33], sp[(4 * w + 1) * 33], 0, false); pk = __builtin_amdgcn_cvt_pk_fp8_f32(sp[(4 * w + 2) * 33], sp[(4 * w + 3) * 33], pk, true); o[w] = (unsigned)pk; }
        *(GAS u32x4*)(WT + (size_t)(n0 + n) * ldt + k0 + 16 * c) = o; }
    asm volatile("s_waitcnt lgkmcnt(0)" ::: "memory");
}
struct CtRow { f32x4 v[8]; GAS unsigned char* dst; int row, which; };
__device__ __forceinline__ void ct_load(Frame& F, int layer, int it, CtRow& R) {
    R.which = it & 1; R.row = it >> 1;
    const GAS float* src = F.in(R.which ? I_PV : I_PU) + ((size_t)layer * NEXP + R.row) * DM + F.lane * 4;
    R.dst = F.ws + O_TAB + (size_t)(layer * 2 + R.which) * TAB_ONE;
#pragma unroll
    for (int c = 0; c < 8; ++c) R.v[c] = __builtin_nontemporal_load((const GAS f32x4*)(src + c * 256));
}
__device__ __forceinline__ void ct_proc(Frame& F, int layer, CtRow& R) {
    const GAS float* gn = F.in(I_PNORM) + layer * DM + F.lane * 4;
    _Float16 shv = (_Float16)0.f;
#pragma unroll
    for (int c = 0; c < 8; ++c) { f32x4 x = R.v[c]; if (!R.which) x = x * *(const GAS f32x4*)(gn + c * 256);
        float amax = fmaxf(fmaxf(fabsf(x[0]), fabsf(x[1])), fmaxf(fabsf(x[2]), fabsf(x[3])));
        amax = wave_max(amax);
        const _Float16 sh = (_Float16)fmaxf(amax * (1.f / 6.f), 1e-6f);
        const float qs = __builtin_amdgcn_rcpf((float)sh);
        unsigned pk = __builtin_amdgcn_cvt_scalef32_pk_fp4_f32(0u, x[0] * qs, x[1] * qs, 1.0f, 0); pk = __builtin_amdgcn_cvt_scalef32_pk_fp4_f32(pk, x[2] * qs, x[3] * qs, 1.0f, 1);
        *(GAS unsigned short*)(R.dst + ((size_t)c * NEXP + R.row) * 128 + F.lane * 2) = (unsigned short)pk;
        shv = (F.lane == c) ? sh : shv; }
    if (F.lane < 8) *(GAS unsigned short*)(R.dst + TAB_NIB + ((size_t)R.row * 8 + F.lane) * 2) = __builtin_bit_cast(unsigned short, shv);
}
__device__ __forceinline__ void convert_tables(Frame& F, int layer, int ibeg, int iend, int wk, int nwk) {
    if (ibeg + wk >= iend) return;
    const int ilast = ibeg + wk + ((iend - 1 - ibeg - wk) / nwk) * nwk;
    CtRow A, B;
    ct_load(F, layer, ibeg + wk, A);
    for (int it = ibeg + wk; it < iend; it += 2 * nwk) {
        ct_load(F, layer, it + nwk <= ilast ? it + nwk : ilast, B);
        ct_proc(F, layer, A);
        ct_load(F, layer, it + 2 * nwk <= ilast ? it + 2 * nwk : ilast, A);
        if (it + nwk < iend) ct_proc(F, layer, B);
    }
}
__device__ __forceinline__ void norm_row_bf16(const GAS float* xrow, const GAS float* gain, GAS bf16_t* orow, int lane) {
    f32x4 v[8]; float s = 0.f;
#pragma unroll
    for (int j = 0; j < 8; ++j) { v[j] = *(const GAS f32x4*)(xrow + j * 256 + lane * 4); s += (v[j][0] * v[j][0] + v[j][1] * v[j][1]) + (v[j][2] * v[j][2] + v[j][3] * v[j][3]); }
    const float r = rsqrtf(wave_sum(s) * (1.f / DM) + EPS);
#pragma unroll
    for (int j = 0; j < 8; ++j) { f32x4 g = gain ? *(const GAS f32x4*)(gain + j * 256 + lane * 4) : (f32x4){1.f, 1.f, 1.f, 1.f};
        u32x2 o; o.x = cvtpk(v[j][0] * r * g[0], v[j][1] * r * g[1]); o.y = cvtpk(v[j][2] * r * g[2], v[j][3] * r * g[3]);
        *(GAS u32x2*)(orow + j * 256 + lane * 4) = o; }
}
__device__ __forceinline__ void step_prologue(Frame& F, LAS unsigned char* lds) {
    LAS float* scr = (LAS float*)(lds + F.wave * 16384);
    GAS unsigned char* ws = F.ws;
    constexpr int I0 = 32 * (NIN0 / 32), I1 = 32 * 64, I2 = 32 * 96, I3 = 32 * 64, I4 = 32 * 64, I5 = 32 * 64, I6 = 32 * 64, I7 = 32 * 32, I8 = 32 * 32, I9 = 12 * 16;
    constexpr int NITEMS = I0 + I1 + I2 + I3 + I4 + I5 + I6 + I7 + I8 + I9;
#define TR_DESC(D, it_) do { int r = (it_) < NITEMS ? (it_) : NITEMS - 1; int nblk; \
        if (r < I0) { D = {F.in(I_AWIN), F.in(I_ANORM), (GAS bf16_t*)(ws + O_WIN0), NIN0, DM, 0, 0, 0}; nblk = NIN0 / 32; } else { r -= I0; \
        if (r < I1) { D = {F.in(I_AWOUT), nullptr, (GAS bf16_t*)(ws + O_WOUT0), DM, DM, 0, 0, 0}; nblk = 64; } else { r -= I1; \
        if (r < I2) { D = {F.in(I_SWKVF), F.in(I_SNORM), (GAS bf16_t*)(ws + O_WL1), 3084, DM, 0, 0, 0}; nblk = 96; } else { r -= I2; \
        if (r < I3) { D = {F.in(I_BWIN), F.in(I_BNORM), (GAS bf16_t*)(ws + O_WL1), DM, DM, 3072, 0, 0}; nblk = 64; } else { r -= I3; \
        if (r < I4) { D = {F.in(I_BWOUT), nullptr, (GAS bf16_t*)(ws + O_WOUT1), DM, DM, 0, 0, 0}; nblk = 64; } else { r -= I4; \
        if (r < I5) { D = {F.in(I_PWQ), F.in(I_PNORM), (GAS bf16_t*)(ws + O_WQ0), DM, DM, 0, 0, 0}; nblk = 64; } else { r -= I5; \
        if (r < I6) { D = {F.in(I_PWQ) + (size_t)DM * DM, F.in(I_PNORM) + DM, (GAS bf16_t*)(ws + O_WQ1), DM, DM, 0, 0, 0}; nblk = 64; } else { r -= I6; \
        if (r < I7) { D = {F.in(I_MWKV), nullptr, (GAS bf16_t*)(ws + O_WMKV), 1024, DM, 0, 0, 0}; nblk = 32; } else { r -= I7; \
        if (r < I8) { D = {F.in(I_MWKV) + (size_t)DM * 1024, nullptr, (GAS bf16_t*)(ws + O_WMKV) + (size_t)1024 * DM, 1024, DM, 0, 0, 0}; nblk = 32; } else { r -= I8; \
          const int blk = r / 16; r = r % 16; D = {F.in(I_AGATEW) + (size_t)blk * 128 * 256, nullptr, (GAS bf16_t*)(ws + O_WGATE), 256, 128, blk * 256, 0, 0}; nblk = 8; } } } } } } } } } \
        D.k0 = 64 * (r / nblk); D.n0 = 32 * (r % nblk); } while (0)
    for (int it = F.gw; it < NITEMS; it += F.ngw) { float wv[32]; TrItem d; TR_DESC(d, it); tr_load(d, wv, F.lane); tr_proc(d, wv, scr, F.lane); }
#undef TR_DESC
    { const GAS float* sk = F.in(I_PSUBK); GAS bf16_t* o = (GAS bf16_t*)(ws + O_SUBK);
      for (int i = F.gtid; i < 2 * 16 * 128 * 128 / 2; i += F.ngt) *(GAS unsigned*)(o + 2 * i) = cvtpk(sk[2 * i], sk[2 * i + 1]); }
    { GAS float* wf = (GAS float*)(ws + O_WF); const GAS float* w = F.in(I_SWKVF); const GAS float* g = F.in(I_SNORM);
      for (int i = F.gtid; i < 12 * DM; i += F.ngt) { const int j = i / DM, k = i % DM; wf[i] = w[(size_t)k * 3084 + 3072 + j] * g[k]; } }
    { GAS float* spl = (GAS float*)(ws + O_SPL); const GAS float* lam = F.in(I_ALAMBDA);
      for (int i = F.gtid; i < LRU; i += F.ngt) { const float z = -lam[i]; spl[i] = fmaxf(z, 0.f) + log1p_pos(fast_exp(-fabsf(z))); } }
    if (F.gw == 0) {
        float m = 0.f; for (int d = F.lane; d < 128; d += 64) m = fmaxf(m, fabsf(F.in(I_BQNORM)[d] * F.in(I_SKNORM)[d]));
        m = wave_max(m);
        if (F.lane == 0) ((GAS float*)(ws + O_GG))[512] = 2.f * 11.3137085f * m + 30.f; }
    { GAS float* gg = (GAS float*)(ws + O_GG);
      for (int i = F.gtid; i < 384; i += F.ngt) { const int a = i / 128, d = i % 128;
          gg[a == 0 ? 384 + d : i] = a == 0 ? F.in(I_BQNORM)[d] * F.in(I_SKNORM)[d] : F.in(I_MQNORM)[(a - 1) * 128 + d] * F.in(I_MKNORM)[(a - 1) * 128 + d]; } }
    {
        const GAS float* xin = F.in(I_X) + F.lane * 4; GAS bf16_t* xo = (GAS bf16_t*)(ws + O_XS16) + F.lane * 4;
        const int mlast = F.gw + ((T - 1 - F.gw) / F.ngw) * F.ngw;
#define XN_LOAD(V, m_) do { const int mm_ = (m_) <= mlast ? (m_) : mlast; _Pragma("unroll") for (int j = 0; j < 8; ++j) V[j] = __builtin_nontemporal_load((const GAS f32x4*)(xin + (size_t)mm_ * DM + j * 256)); } while (0)
#define XN_PROC(V, m_) do { if ((m_) < T) { float s0 = 0.f; _Pragma("unroll") for (int j = 0; j < 8; ++j) s0 += (V[j][0] * V[j][0] + V[j][1] * V[j][1]) + (V[j][2] * V[j][2] + V[j][3] * V[j][3]); \
            const float r0 = rsqrtf(wave_sum(s0) * (1.f / DM) + EPS); \
            _Pragma("unroll") for (int j = 0; j < 8; ++j) { u32x2 a; a.x = cvtpk(V[j][0] * r0, V[j][1] * r0); a.y = cvtpk(V[j][2] * r0, V[j][3] * r0); *(GAS u32x2*)(xo + (size_t)(m_) * DM + j * 256) = a; } } } while (0)
        f32x4 va[8], vb[8];
        XN_LOAD(va, F.gw);
        for (int m = F.gw; m < T; m += 2 * F.ngw) { XN_LOAD(vb, m + F.ngw); XN_PROC(va, m); XN_LOAD(va, m + 2 * F.ngw); XN_PROC(vb, m + F.ngw); }
#undef XN_LOAD
#undef XN_PROC
    }
    for (int m = F.gw; m < 2 * NMROW; m += F.ngw) { const int l = m / NMROW, r = m % NMROW;
        norm_row_bf16(F.in(I_MEM) + (size_t)r * DM, F.in(I_MNORM) + l * DM, (GAS bf16_t*)(ws + O_MEMN) + (size_t)m * DM, F.lane); }
    convert_tables(F, 0, 0, 2 * NEXP, F.gw, F.ngw);
}
__device__ __forceinline__ void step_conv(Frame& F) {
    const GAS bf16_t* zx = (const GAS bf16_t*)(F.ws + O_ZX); GAS bf16_t* xc = (GAS bf16_t*)(F.ws + O_XC);
    const GAS float* cw = F.in(I_ACONVW); const GAS float* cb = F.in(I_ACONVB);
    constexpr int NIT = T * (LRU / 8);
#define CV_LOAD(W, it_) do { const int ii_ = (it_) < NIT ? (it_) : NIT - 1; const int t_ = ii_ / (LRU / 8), c8_ = (ii_ % (LRU / 8)) * 8, pos_ = t_ & (SEQ - 1); \
        _Pragma("unroll") for (int k = 0; k < 4; ++k) W[k] = (pos_ - 3 + k >= 0) ? *(const GAS u32x4*)(zx + (size_t)(t_ - 3 + k) * LRU + c8_) : (u32x4){0u, 0u, 0u, 0u}; } while (0)
#define CV_PROC(W, it_) do { if ((it_) < NIT) { const int t_ = (it_) / (LRU / 8), c8_ = ((it_) % (LRU / 8)) * 8; float a[8]; \
        { const f32x4 b0 = *(const GAS f32x4*)(cb + c8_), b1 = *(const GAS f32x4*)(cb + c8_ + 4); a[0] = b0[0]; a[1] = b0[1]; a[2] = b0[2]; a[3] = b0[3]; a[4] = b1[0]; a[5] = b1[1]; a[6] = b1[2]; a[7] = b1[3]; } \
        _Pragma("unroll") for (int k = 0; k < 4; ++k) { const f32x4 w0 = *(const GAS f32x4*)(cw + k * LRU + c8_), w1 = *(const GAS f32x4*)(cw + k * LRU + c8_ + 4); \
            a[0] = fmaf(w0[0], bf_lo(W[k].x), a[0]); a[1] = fmaf(w0[1], bf_hi(W[k].x), a[1]); a[2] = fmaf(w0[2], bf_lo(W[k].y), a[2]); a[3] = fmaf(w0[3], bf_hi(W[k].y), a[3]); \
            a[4] = fmaf(w1[0], bf_lo(W[k].z), a[4]); a[5] = fmaf(w1[1], bf_hi(W[k].z), a[5]); a[6] = fmaf(w1[2], bf_lo(W[k].w), a[6]); a[7] = fmaf(w1[3], bf_hi(W[k].w), a[7]); } \
        u32x4 o; o.x = cvtpk(a[0], a[1]); o.y = cvtpk(a[2], a[3]); o.z = cvtpk(a[4], a[5]); o.w = cvtpk(a[6], a[7]); \
        *(GAS u32x4*)(xc + (size_t)t_ * LRU + c8_) = o; } } while (0)
    u32x4 wa[4], wb[4];
    CV_LOAD(wa, F.gtid);
    for (int it = F.gtid; it < NIT; it += 2 * F.ngt) { CV_LOAD(wb, it + F.ngt); CV_PROC(wa, it); CV_LOAD(wa, it + 2 * F.ngt); CV_PROC(wb, it + F.ngt); }
#undef CV_LOAD
#undef CV_PROC
}
constexpr int SCK = 32, NCK = SEQ / SCK;
typedef _Float16 h8_t __attribute__((ext_vector_type(8)));
__device__ __forceinline__ void scan_load(const GAS _Float16* LA, const GAS _Float16* UH, size_t off, float (&a)[8], float (&u)[8]) {
    const h8_t l = *(const GAS h8_t*)(LA + off), w = *(const GAS h8_t*)(UH + off);
#pragma unroll
    for (int k = 0; k < 8; ++k) { a[k] = fast_exp((float)l[k]); u[k] = (float)w[k]; }
}
__device__ __forceinline__ void step_scan1(Frame& F) {
    const GAS _Float16* LA = (const GAS _Float16*)(F.ws + O_AA); const GAS _Float16* UH = (const GAS _Float16*)(F.ws + O_UU);
    GAS float* CA = (GAS float*)(F.ws + O_LOGFP); GAS float* CH = CA + (size_t)NB * NCK * LRU;
    if (F.tid >= 384) return;
    const int grp = F.tid / 192, th = F.tid % 192;
    for (int it = blockIdx.x * 2 + grp; it < NB * NCK; it += gridDim.x * 2) {
        const int b = it / NCK, ck = it % NCK; const size_t base = ((size_t)b * SEQ + ck * SCK) * LRU + th * 8;
        float ap[8], h[8];
#pragma unroll
        for (int k = 0; k < 8; ++k) { ap[k] = 1.f; h[k] = 0.f; }
#pragma unroll 8
        for (int i = 0; i < SCK; ++i) { float a[8], u[8]; scan_load(LA, UH, base + (size_t)i * LRU, a, u);
#pragma unroll
            for (int k = 0; k < 8; ++k) { ap[k] *= a[k]; h[k] = a[k] * h[k] + u[k]; } }
        GAS float* ca = CA + (size_t)it * LRU + th * 8; GAS float* ch = CH + (size_t)it * LRU + th * 8;
        *(GAS f32x4*)ca = (f32x4){ap[0], ap[1], ap[2], ap[3]}; *(GAS f32x4*)(ca + 4) = (f32x4){ap[4], ap[5], ap[6], ap[7]};
        *(GAS f32x4*)ch = (f32x4){h[0], h[1], h[2], h[3]}; *(GAS f32x4*)(ch + 4) = (f32x4){h[4], h[5], h[6], h[7]};
    }
}
__device__ __forceinline__ void step_scan2(Frame& F) {
    const GAS _Float16* LA = (const GAS _Float16*)(F.ws + O_AA); const GAS _Float16* UH = (const GAS _Float16*)(F.ws + O_UU);
    const GAS float* CA = (const GAS float*)(F.ws + O_LOGFP); const GAS float* CH = CA + (size_t)NB * NCK * LRU;
    const GAS bf16_t* gy = (const GAS bf16_t*)(F.ws + O_GY); GAS bf16_t* cat = (GAS bf16_t*)(F.ws + O_CAT);
    if (F.tid >= 384) return;
    const int grp = F.tid / 192, th = F.tid % 192;
    for (int it = blockIdx.x * 2 + grp; it < NB * NCK; it += gridDim.x * 2) {
        const int b = it / NCK, ck = it % NCK; const size_t base = ((size_t)b * SEQ + ck * SCK) * LRU + th * 8;
        float h[8];
#pragma unroll
        for (int k = 0; k < 8; ++k) h[k] = 0.f;
        for (int k2 = 0; k2 < ck; ++k2) { const size_t o = (size_t)(b * NCK + k2) * LRU + th * 8;
            const f32x4 a0 = *(const GAS f32x4*)(CA + o), a1 = *(const GAS f32x4*)(CA + o + 4), c0 = *(const GAS f32x4*)(CH + o), c1 = *(const GAS f32x4*)(CH + o + 4);
#pragma unroll
            for (int k = 0; k < 4; ++k) { h[k] = a0[k] * h[k] + c0[k]; h[4 + k] = a1[k] * h[4 + k] + c1[k]; } }
#pragma unroll 8
        for (int i = 0; i < SCK; ++i) { float a[8], u[8]; scan_load(LA, UH, base + (size_t)i * LRU, a, u);
            const size_t row = (size_t)b * SEQ + ck * SCK + i;
            const u32x4 g = *(const GAS u32x4*)(gy + row * LRU + th * 8); u32x4 o;
#pragma unroll
            for (int k = 0; k < 8; ++k) h[k] = a[k] * h[k] + u[k];
#pragma unroll
            for (int k = 0; k < 4; ++k) o[k] = cvtpk(h[2 * k] * bf_lo(g[k]), h[2 * k + 1] * bf_hi(g[k]));
            *(GAS u32x4*)(cat + row * DM + th * 8) = o; }
    }
}
__device__ __forceinline__ void step_cprefix(Frame& F, LAS unsigned char* lds) {
    const GAS float* lf = (const GAS float*)(F.ws + O_LOGF); GAS float* cc = (GAS float*)(F.ws + O_CC);
    LAS double* scr = (LAS double*)(lds + F.wave * 16384);
    for (int it = F.gw; it < NB * NH; it += F.ngw) {
        const GAS float* p = lf + (size_t)it * SEQ + F.lane * 64; GAS float* q = cc + (size_t)it * SEQ + F.lane * 64;
        double s = 0.0;
        for (int i = 0; i < 64; ++i) s += (double)p[i];
        scr[F.lane] = s;
        asm volatile("s_waitcnt lgkmcnt(0)" ::: "memory");
        double run = 0.0;
        for (int l = 0; l < 64; ++l) { const double v = scr[l]; if (l < F.lane) run += v; }
        for (int i = 0; i < 64; ++i) { run += (double)p[i]; q[i] = (float)run; }
        asm volatile("s_waitcnt lgkmcnt(0)" ::: "memory");
    }
}

__device__ __forceinline__ int ord_i(float f) { const int b = __float_as_int(f); return b ^ ((b >> 31) & 0x7fffffff); }
__device__ __forceinline__ float unord_f(int k) { return __int_as_float(k ^ ((k >> 31) & 0x7fffffff)); }
template <int N> __device__ __forceinline__ void bitonic_sort_desc(int (&a)[N]) {
#pragma unroll
    for (int k = 2; k <= N; k <<= 1) {
#pragma unroll
        for (int j = k >> 1; j > 0; j >>= 1) {
#pragma unroll
            for (int i = 0; i < N; ++i) { const int l = i ^ j;
                if (l > i) { const bool desc = ((i & k) == 0); const int mx = max(a[i], a[l]), mn = min(a[i], a[l]); a[i] = desc ? mx : mn; a[l] = desc ? mn : mx; } }
        }
    }
}
__device__ __forceinline__ void bitonic_merge16_desc(int (&a)[16]) {
#pragma unroll
    for (int j = 8; j > 0; j >>= 1) {
#pragma unroll
        for (int i = 0; i < 16; ++i) { const int l = i ^ j; if (l > i) { const int mx = max(a[i], a[l]), mn = min(a[i], a[l]); a[i] = mx; a[l] = mn; } }
    }
}
__device__ __forceinline__ void top16_of_64(int (&a)[64]) {
    int g[4][16];
#pragma unroll
    for (int q = 0; q < 4; ++q) {
#pragma unroll
        for (int i = 0; i < 16; ++i) g[q][i] = a[16 * q + i];
        bitonic_sort_desc<16>(g[q]); }
#pragma unroll
    for (int i = 0; i < 16; ++i) { g[0][i] = max(g[0][i], g[1][15 - i]); g[2][i] = max(g[2][i], g[3][15 - i]); }
    bitonic_merge16_desc(g[0]); bitonic_merge16_desc(g[2]);
#pragma unroll
    for (int i = 0; i < 16; ++i) g[0][i] = max(g[0][i], g[2][15 - i]);
    bitonic_merge16_desc(g[0]);
#pragma unroll
    for (int i = 0; i < 16; ++i) a[i] = g[0][i];
}
constexpr float KOFF = 64.f;
__device__ __forceinline__ void top16_of_32(int (&a)[32]) {
    int g0[16], g1[16];
#pragma unroll
    for (int i = 0; i < 16; ++i) { g0[i] = a[i]; g1[i] = a[16 + i]; }
    bitonic_sort_desc<16>(g0); bitonic_sort_desc<16>(g1);
#pragma unroll
    for (int i = 0; i < 16; ++i) g0[i] = max(g0[i], g1[15 - i]);
    bitonic_merge16_desc(g0);
#pragma unroll
    for (int i = 0; i < 16; ++i) a[i] = g0[i];
}
__device__ __forceinline__ void subkey_top16(const GAS bf16_t* qrow  , const GAS bf16_t* sk  , int r32, int hi, int (&top)[16]) {
    bf16x8 qf[8];
#pragma unroll
    for (int ks = 0; ks < 8; ++ks) qf[ks] = *(const GAS bf16x8*)(qrow + ks * 16 + hi * 8);
    unsigned loff = (unsigned)(r32 * 128 + hi * 8) * 2u; asm volatile("" : "+v"(loff));
    int key[64];
#pragma unroll
    for (int kb = 0; kb < 4; ++kb) {
        f32x16 acc;
#pragma unroll
        for (int r = 0; r < 16; ++r) acc[r] = KOFF;
#pragma unroll
        for (int ks = 0; ks < 8; ++ks) { const bf16x8 af = *(const GAS bf16x8*)((const GAS char*)(sk + kb * 32 * 128 + ks * 16) + loff);
            acc = __builtin_amdgcn_mfma_f32_32x32x16_bf16(af, qf[ks], acc, 0, 0, 0); }
#pragma unroll
        for (int r = 0; r < 16; ++r) { const int id = kb * 32 + (r & 3) + 8 * (r >> 2) + 4 * hi; key[kb * 16 + r] = (__float_as_int(acc[r]) & ~127) | (127 - id); }
        __builtin_amdgcn_sched_barrier(0);
    }
    top16_of_64(key);
#pragma unroll
    for (int i = 0; i < 16; ++i) { auto r = __builtin_amdgcn_permlane32_swap((unsigned)key[15 - i], (unsigned)key[15 - i], false, false);
        const int pk = hi ? (int)r[0] : (int)r[1]; top[i] = max(key[i], pk); }
    bitonic_merge16_desc(top);
}
__device__ __forceinline__ void step_topk(Frame& F, LAS unsigned char* lds, int layer) {
    const GAS bf16_t* q16 = (const GAS bf16_t*)(F.ws + O_Q16); const GAS bf16_t* subk = (const GAS bf16_t*)(F.ws + O_SUBK) + (size_t)layer * 16 * 128 * 128;
    GAS int* IDX = (GAS int*)(F.ws + O_IDX); GAS float* GW = (GAS float*)(F.ws + O_GW);
    LAS int* scr = (LAS int*)(lds + F.wave * 16384) + F.lane * 33;
    const int r32 = F.lane & 31, hi = F.lane >> 5;
    for (int task = F.gw; task < (T / 32) * 8; task += F.ngw) {
        const int tb = task >> 3, h = task & 7; const int tok = tb * 32 + r32;
        const GAS bf16_t* qrow = q16 + (size_t)tok * DM + h * 256;
        int ta[16], tb16[16];
        subkey_top16(qrow, subk + (size_t)(h * 2 + 0) * 128 * 128, r32, hi, ta);
        subkey_top16(qrow + 128, subk + (size_t)(h * 2 + 1) * 128 * 128, r32, hi, tb16);
        float va[16], vb[16];
#pragma unroll
        for (int i = 0; i < 16; ++i) { va[i] = __int_as_float(ta[i] & ~127); vb[i] = __int_as_float(tb16[i] & ~127) - KOFF; scr[i] = 127 - (ta[i] & 127); scr[16 + i] = 127 - (tb16[i] & 127); }
        int c2[32]; int n = 0;
#pragma unroll
        for (int i = 0; i < 16; ++i)
#pragma unroll
            for (int j = 0; j < 16; ++j) if ((i + 1) * (j + 1) <= 16) { const int k = (__float_as_int(va[i] + vb[j]) & ~255) | (255 - (i * 16 + j));
                if ((n & 1) == 0) c2[n >> 1] = k; else c2[n >> 1] = hi ? k : c2[n >> 1];
                ++n; }
#pragma unroll
        for (int i = 25; i < 32; ++i) c2[i] = (int)0x80000000;
        top16_of_32(c2);
        { int mg[16];
#pragma unroll
          for (int i = 0; i < 16; ++i) { auto r = __builtin_amdgcn_permlane32_swap((unsigned)c2[15 - i], (unsigned)c2[15 - i], false, false);
              const int pk = hi ? (int)r[0] : (int)r[1]; mg[i] = max(c2[i], pk); }
          bitonic_merge16_desc(mg);
#pragma unroll
          for (int i = 0; i < 16; ++i) c2[i] = mg[i]; }
        asm volatile("s_waitcnt lgkmcnt(0)" ::: "memory");
        float sv[16], ex[16]; int ev[16]; float Z = 0.f;
#pragma unroll
        for (int r = 0; r < 16; ++r) { const int flat = 255 - (c2[r] & 255); sv[r] = __int_as_float(c2[r] & ~255); ev[r] = scr[flat >> 4] * 128 + scr[16 + (flat & 15)]; }
#pragma unroll
        for (int r = 0; r < 16; ++r) { ex[r] = fast_exp(sv[r] - sv[0]); Z += ex[r]; }
        const float iz = 1.f / Z;
        GAS int* ip = IDX + (size_t)tok * 128 + h * 16 + hi * 8; GAS float* gp = GW + (size_t)tok * 128 + h * 16 + hi * 8;
        int eo[8]; float go[8];
#pragma unroll
        for (int j = 0; j < 8; ++j) { eo[j] = hi ? ev[8 + j] : ev[j]; go[j] = (hi ? ex[8 + j] : ex[j]) * iz; }
        *(GAS u32x4*)ip = (u32x4){(unsigned)eo[0], (unsigned)eo[1], (unsigned)eo[2], (unsigned)eo[3]}; *(GAS u32x4*)(ip + 4) = (u32x4){(unsigned)eo[4], (unsigned)eo[5], (unsigned)eo[6], (unsigned)eo[7]};
        *(GAS f32x4*)gp = (f32x4){go[0], go[1], go[2], go[3]}; *(GAS f32x4*)(gp + 4) = (f32x4){go[4], go[5], go[6], go[7]};
        asm volatile("s_waitcnt lgkmcnt(0)" ::: "memory");
    }
}
__device__ __forceinline__ h2 as_h2(unsigned w) { return __builtin_bit_cast(h2, w); }
#define F4(W, s) __builtin_amdgcn_cvt_scalef32_pk_f16_fp4((W), 1.0f, (s))
#define H2F(us) ((float)__builtin_bit_cast(_Float16, (unsigned short)(us)))
__device__ __forceinline__ float sum8(float v) { v += dppf<0xB1>(v); v += dppf<0x4E>(v); v += dppf<0x141>(v); return v; }
__device__ __forceinline__ void step_upass(Frame& F, int layer, int G, LAS unsigned char* lds) {
    typedef pg8::v8i_t v8i_t;
    const int s = blockIdx.x & 7, wk = (blockIdx.x >> 3) * NWAVES + F.wave, nwk = (G >> 3) * NWAVES;
    const GAS unsigned char* UN = F.ws + O_TAB + (size_t)(layer * 2) * TAB_ONE + (size_t)s * NEXP * 128;
    const GAS int* IDX = (const GAS int*)(F.ws + O_IDX); const GAS bf16_t* xs = (const GAS bf16_t*)(F.ws + O_XS16) + s * 256;
    GAS _Float16* part = (GAS _Float16*)(F.ws + O_PART) + (size_t)s * T * 128;
    unsigned lo = (unsigned)F.lane; asm volatile("" : "+v"(lo));
    const unsigned j = lo >> 3, p = lo & 7, c = lo & 15, kq = lo >> 4;
    LAS unsigned char* img = lds + F.wave * 16384; LAS unsigned char* xrow = lds + 131072 + F.wave * 256;
    LAS unsigned char* wrp = img + j * 128 + ((p ^ j) << 4);
    const LAS unsigned char* rd0 = img + c * 128 + ((kq ^ (c & 7)) << 4);
    const LAS unsigned char* rd1 = img + c * 128 + (((4 + kq) ^ (c & 7)) << 4);
    const int tlast = wk + ((T - 1 - wk) / nwk) * nwk;
#define U_LOADID(ID, t_, q_) do { const int tt_ = (t_) <= tlast ? (t_) : tlast; _Pragma("unroll") for (int b = 0; b < 4; ++b) ID[b] = IDX[(size_t)tt_ * 128 + (q_) * 32 + 8 * b + j]; } while (0)
#define U_LOADX(t_) do { const int tt_ = (t_) <= tlast ? (t_) : tlast; xn = *(const GAS u32x2*)(xs + (size_t)tt_ * DM + lo * 4); } while (0)
#define U_ISSUE(UB, ID) do { _Pragma("unroll") for (int b = 0; b < 4; ++b) UB[b] = *(const GAS u32x4*)(UN + (unsigned)(ID[b] * 128 + (int)p * 16)); } while (0)
#define U_WRITE(UB, q_) do { _Pragma("unroll") for (int b = 0; b < 4; ++b) *(LAS u32x4*)(wrp + (4 * (q_) + b) * 1024) = UB[b]; } while (0)
#define U_MM(g0) do { u32x4 a0[4], a1[4]; _Pragma("unroll") for (int g = 0; g < 4; ++g) { a0[g] = *(const LAS u32x4*)(rd0 + ((g0) + g) * 2048); a1[g] = *(const LAS u32x4*)(rd1 + ((g0) + g) * 2048); } \
        _Pragma("unroll") for (int g = 0; g < 4; ++g) { \
            f32x4 c_ = __builtin_amdgcn_mfma_scale_f32_16x16x128_f8f6f4((v8i_t){(int)a0[g].x, (int)a0[g].y, (int)a0[g].z, (int)a0[g].w, 0, 0, 0, 0}, bop0, zero4, 4, 0, 0, 127, 0, 127); \
            acc[(g0) + g] = __builtin_amdgcn_mfma_scale_f32_16x16x128_f8f6f4((v8i_t){(int)a1[g].x, (int)a1[g].y, (int)a1[g].z, (int)a1[g].w, 0, 0, 0, 0}, bop1, c_, 4, 0, 0, 127, 0, 127); } } while (0)
    int idA[4], idB[4]; u32x4 u0[4], u1[4], u2[4], u3[4]; u32x2 xc, xn;
    U_LOADID(idA, wk, 0); U_LOADID(idB, wk, 1); U_LOADX(wk);
    U_ISSUE(u0, idA); U_LOADID(idA, wk, 2);
    U_ISSUE(u1, idB); U_LOADID(idB, wk, 3);
    U_ISSUE(u2, idA); U_LOADID(idA, wk + nwk, 0);
    xc = xn;
    for (int t = wk; t < T; t += nwk) {
        U_ISSUE(u3, idB); U_LOADID(idB, t + nwk, 1); U_LOADX(t + nwk);
        const float x0 = bf_lo(xc.x), x1 = bf_hi(xc.x), x2 = bf_lo(xc.y), x3 = bf_hi(xc.y);
        const float amax = wave_max(fmaxf(fmaxf(fabsf(x0), fabsf(x1)), fmaxf(fabsf(x2), fabsf(x3))));
        const float sc = fmaxf(amax, 1e-20f) * (1.f / 448.f), qs = __builtin_amdgcn_rcpf(sc);
        { int pk = __builtin_amdgcn_cvt_pk_fp8_f32(x0 * qs, x1 * qs, 0, false); pk = __builtin_amdgcn_cvt_pk_fp8_f32(x2 * qs, x3 * qs, pk, true); *(LAS int*)(xrow + lo * 4) = pk; }
        U_WRITE(u0, 0);
        U_ISSUE(u0, idA); U_LOADID(idA, t + nwk, 2);
        U_WRITE(u1, 1);
        U_ISSUE(u1, idB); U_LOADID(idB, t + nwk, 3);
        U_WRITE(u2, 2);
        U_ISSUE(u2, idA); U_LOADID(idA, t + 2 * nwk, 0);
        U_WRITE(u3, 3);
        v8i_t bop0, bop1;
        { const u32x4 b00 = *(const LAS u32x4*)(xrow + kq * 16), b01 = *(const LAS u32x4*)(xrow + 64 + kq * 16), b10 = *(const LAS u32x4*)(xrow + 128 + kq * 16), b11 = *(const LAS u32x4*)(xrow + 192 + kq * 16);
          bop0 = (v8i_t){(int)b00.x, (int)b00.y, (int)b00.z, (int)b00.w, (int)b01.x, (int)b01.y, (int)b01.z, (int)b01.w};
          bop1 = (v8i_t){(int)b10.x, (int)b10.y, (int)b10.z, (int)b10.w, (int)b11.x, (int)b11.y, (int)b11.z, (int)b11.w}; }
        const f32x4 zero4 = {0.f, 0.f, 0.f, 0.f};
        f32x4 acc[8];
        U_MM(0); U_MM(4);
        f32x4 o = acc[0];
#pragma unroll
        for (int m = 1; m < 8; ++m) o = ((c & 7) == (unsigned)m) ? acc[m] : o;
        { const h2 o0 = {(_Float16)(o[0] * sc), (_Float16)(o[1] * sc)}, o1 = {(_Float16)(o[2] * sc), (_Float16)(o[3] * sc)};
          __builtin_nontemporal_store((u32x2){__builtin_bit_cast(unsigned, o0), __builtin_bit_cast(unsigned, o1)}, (GAS u32x2*)(part + (size_t)t * 128 + 16 * (c & 7) + 4 * kq)); }
        xc = xn;
    }
#undef U_LOADID
#undef U_LOADX
#undef U_ISSUE
#undef U_WRITE
#undef U_MM
}
__device__ __forceinline__ void step_peer_reduce(Frame& F, int layer) {
    const GAS _Float16* part = (const GAS _Float16*)(F.ws + O_PART); const GAS float* GW = (const GAS float*)(F.ws + O_GW); const GAS int* IDX = (const GAS int*)(F.ws + O_IDX);
    const GAS float* rowss = (const GAS float*)(F.ws + O_ROWSS); GAS unsigned char* W8 = F.ws + O_W8;
    const GAS unsigned char* SU = F.ws + O_TAB + (size_t)(layer * 2) * TAB_ONE + TAB_NIB; const GAS unsigned char* SV = SU + TAB_ONE;
    constexpr int NIT = T * 2;
    struct SA { int id; float gw, rs; float p[8]; }; struct SB { u32x4 su, sv; };
#define RA(X, it_) do { const int ii_ = (it_) < NIT ? (it_) : NIT - 1; const size_t i_ = (size_t)ii_ * 64 + F.lane; X.id = IDX[i_]; X.gw = GW[i_]; X.rs = rowss[(size_t)(ii_ >> 1) * 32 + (F.lane & 31)]; \
        _Pragma("unroll") for (int s = 0; s < 8; ++s) X.p[s] = (float)part[(size_t)s * T * 128 + i_]; } while (0)
#define RB(Y, X) do { Y.su = *(const GAS u32x4*)(SU + (size_t)X.id * 16); Y.sv = *(const GAS u32x4*)(SV + (size_t)X.id * 16); } while (0)
#define RC(X, Y, it_) do { if ((it_) < NIT) { const size_t i_ = (size_t)(it_) * 64 + F.lane; const float r = rsqrtf(wave_sum(X.rs) * (0.5f / DM) + EPS); float d = 0.f; \
        _Pragma("unroll") for (int s = 0; s < 8; ++s) d += X.p[s] * (float)__builtin_bit_cast(_Float16, (unsigned short)(Y.su[s >> 1] >> (16 * (s & 1)))); \
        const float w = X.gw * gelu_tanh(d * r) * 256.f; \
        _Pragma("unroll") for (int s = 0; s < 8; ++s) { const float ws = w * (float)__builtin_bit_cast(_Float16, (unsigned short)(Y.sv[s >> 1] >> (16 * (s & 1)))); \
            W8[(size_t)s * T * 128 + i_] = (unsigned char)(__builtin_amdgcn_cvt_pk_fp8_f32(ws, 0.f, 0, false) & 0xff); } } } while (0)
    SA a0, a1, a2; SB b0, b1;
    RA(a0, F.gw); RA(a1, F.gw + F.ngw); RB(b0, a0);
    for (int it = F.gw; it < NIT; it += F.ngw) {
        RA(a2, it + 2 * F.ngw); RB(b1, a1);
        RC(a0, b0, it);
        a0 = a1; a1 = a2; b0 = b1;
    }
#undef RA
#undef RB
#undef RC
}
__device__ __forceinline__ void step_vpass(Frame& F, int layer, int G, bool dry, LAS unsigned char* lds) {
    typedef pg8::v8i_t v8i_t;
    const int s = blockIdx.x & 7, wk = (blockIdx.x >> 3) * NWAVES + F.wave, nwk = (G >> 3) * NWAVES;
    const GAS unsigned char* VN = F.ws + O_TAB + (size_t)(layer * 2 + 1) * TAB_ONE + (size_t)s * NEXP * 128;
    const GAS int* IDX = (const GAS int*)(F.ws + O_IDX); const GAS unsigned char* W8 = F.ws + O_W8 + (size_t)s * T * 128;
    GAS bf16_t* xs = (GAS bf16_t*)(F.ws + O_XS16); GAS float* rsp = (GAS float*)(F.ws + O_RSP);
    unsigned lo = (unsigned)F.lane; asm volatile("" : "+v"(lo));
    const unsigned j = lo >> 3, p = lo & 7, c = lo & 15, kq = lo >> 4;
    LAS unsigned char* img = lds + F.wave * 16384;
    LAS unsigned char* wrp = img + j * 128 + ((p ^ j) << 4);
    const unsigned rdrow = (unsigned)(size_t)img + (32 * kq + c) * 128, csw = (c & 7) << 4;
    const int tlast = wk + ((T - 1 - wk) / nwk) * nwk;
    LAS float* wfl = (LAS float*)(lds + 131072); GAS float* logfp = (GAS float*)(F.ws + O_LOGFP);
    if (layer == 0) { const GAS float* wf = (const GAS float*)(F.ws + O_WF) + s * 256;
        for (int i = F.tid; i < NH * 64; i += NTHREADS) *(LAS f32x4*)(wfl + (i >> 6) * 256 + (i & 63) * 4) = *(const GAS f32x4*)(wf + (size_t)(i >> 6) * DM + (i & 63) * 4);
        __syncthreads(); }
#define V_LOADID(ID, t_, q_) do { const int tt_ = (t_) <= tlast ? (t_) : tlast; _Pragma("unroll") for (int b = 0; b < 4; ++b) ID[b] = IDX[(size_t)tt_ * 128 + (q_) * 32 + 8 * b + j]; } while (0)
#define V_LOADW(t_) do { const int tt_ = (t_) <= tlast ? (t_) : tlast; wn0 = *(const GAS u32x4*)(W8 + (size_t)tt_ * 128 + kq * 16); wn1 = *(const GAS u32x4*)(W8 + (size_t)tt_ * 128 + 64 + kq * 16); } while (0)
#define V_ISSUE(VB, ID) do { _Pragma("unroll") for (int b = 0; b < 4; ++b) VB[b] = *(const GAS u32x4*)(VN + (unsigned)(ID[b] * 128 + (int)p * 16)); } while (0)
#define V_WRITE(VB, q_) do { _Pragma("unroll") for (int b = 0; b < 4; ++b) *(LAS u32x4*)(wrp + (4 * (q_) + b) * 1024) = VB[b]; } while (0)
#define TR4(dst, va, off) asm volatile("ds_read_b64_tr_b4 %0, %1 offset:%2" : "=&v"(dst) : "v"(va), "i"(off) : "memory")
#define V_MM(cc) do { const unsigned va0 = rdrow + (((cc) << 4) ^ csw), va1 = rdrow + ((((cc) + 1) << 4) ^ csw); u32x2 t00, t01, t10, t11, t20, t21, t30, t31; \
        TR4(t00, va0, 0); TR4(t01, va0, 2048); TR4(t10, va0, 8); TR4(t11, va0, 2056); TR4(t20, va1, 0); TR4(t21, va1, 2048); TR4(t30, va1, 8); TR4(t31, va1, 2056); \
        asm volatile("s_waitcnt lgkmcnt(0)" ::: "memory"); __builtin_amdgcn_sched_barrier(0); \
        acc[2 * (cc)] = __builtin_amdgcn_mfma_scale_f32_16x16x128_f8f6f4((v8i_t){(int)t00.x, (int)t00.y, (int)t01.x, (int)t01.y, 0, 0, 0, 0}, bop, zero4, 4, 0, 0, 127, 0, 119); \
        acc[2 * (cc) + 1] = __builtin_amdgcn_mfma_scale_f32_16x16x128_f8f6f4((v8i_t){(int)t10.x, (int)t10.y, (int)t11.x, (int)t11.y, 0, 0, 0, 0}, bop, zero4, 4, 0, 0, 127, 0, 119); \
        acc[2 * (cc) + 2] = __builtin_amdgcn_mfma_scale_f32_16x16x128_f8f6f4((v8i_t){(int)t20.x, (int)t20.y, (int)t21.x, (int)t21.y, 0, 0, 0, 0}, bop, zero4, 4, 0, 0, 127, 0, 119); \
        acc[2 * (cc) + 3] = __builtin_amdgcn_mfma_scale_f32_16x16x128_f8f6f4((v8i_t){(int)t30.x, (int)t30.y, (int)t31.x, (int)t31.y, 0, 0, 0, 0}, bop, zero4, 4, 0, 0, 127, 0, 119); } while (0)
    int idA[4], idB[4]; u32x4 v0[4], v1[4], v2[4], v3[4]; u32x4 w0, w1, wn0, wn1;
    V_LOADID(idA, wk, 0); V_LOADID(idB, wk, 1); V_LOADW(wk);
    V_ISSUE(v0, idA); V_LOADID(idA, wk, 2);
    V_ISSUE(v1, idB); V_LOADID(idB, wk, 3);
    V_ISSUE(v2, idA); V_LOADID(idA, wk + nwk, 0);
    w0 = wn0; w1 = wn1;
    for (int t = wk; t < T; t += nwk) {
        V_ISSUE(v3, idB); V_LOADID(idB, t + nwk, 1); V_LOADW(t + nwk);
        GAS bf16_t* xb = xs + (size_t)t * DM + s * 256 + c * 16 + kq * 4;
        f32x4 x2; { const u32x2 w = *(const GAS u32x2*)xb; x2 = (f32x4){bf_lo(w.x), bf_hi(w.x), bf_lo(w.y), bf_hi(w.y)}; }
        V_WRITE(v0, 0);
        V_ISSUE(v0, idA); V_LOADID(idA, t + nwk, 2);
        V_WRITE(v1, 1);
        V_ISSUE(v1, idB); V_LOADID(idB, t + nwk, 3);
        V_WRITE(v2, 2);
        V_ISSUE(v2, idA); V_LOADID(idA, t + 2 * nwk, 0);
        V_WRITE(v3, 3);
        const v8i_t bop = {(int)w0.x, (int)w0.y, (int)w0.z, (int)w0.w, (int)w1.x, (int)w1.y, (int)w1.z, (int)w1.w};
        const f32x4 zero4 = {0.f, 0.f, 0.f, 0.f};
        f32x4 acc[16];
        V_MM(0); V_MM(2); V_MM(4); V_MM(6);
        f32x4 o = acc[0];
#pragma unroll
        for (int m = 1; m < 16; ++m) o = (c == (unsigned)m) ? acc[m] : o;
        x2 += o;
        if (layer == 1 && !dry) __builtin_nontemporal_store(x2, (GAS f32x4*)(F.out + (size_t)t * DM + s * 256 + c * 16 + kq * 4));
        if (layer == 0 && !dry) {
            { u32x2 ow; ow.x = cvtpk(x2[0], x2[1]); ow.y = cvtpk(x2[2], x2[3]); __builtin_nontemporal_store(ow, (GAS u32x2*)xb); }
            const float sst = wave_sum((x2[0] * x2[0] + x2[1] * x2[1]) + (x2[2] * x2[2] + x2[3] * x2[3]));
            if (lo == 0) rsp[(size_t)t * 8 + s] = sst;
        }
        if (layer == 0) {
            f32x4 gw[NH];
#pragma unroll
            for (int h = 0; h < NH; ++h) gw[h] = *(const LAS f32x4*)(wfl + h * 256 + c * 16 + kq * 4);
            __builtin_amdgcn_sched_barrier(0);
            float ph[NH];
#pragma unroll
            for (int h = 0; h < NH; ++h) ph[h] = (x2[0] * gw[h][0] + x2[1] * gw[h][1]) + (x2[2] * gw[h][2] + x2[3] * gw[h][3]);
#pragma unroll
            for (int h = 0; h < NH; ++h) ph[h] += dppf<0xB1>(ph[h]);
#pragma unroll
            for (int h = 0; h < NH; ++h) ph[h] += dppf<0x4E>(ph[h]);
#pragma unroll
            for (int h = 0; h < NH; ++h) ph[h] += dppf<0x141>(ph[h]);
#pragma unroll
            for (int h = 0; h < NH; ++h) ph[h] += dppf<0x140>(ph[h]);
            float sel = 0.f;
#pragma unroll
            for (int h = 0; h < NH; ++h) sel = (c == (unsigned)h) ? ph[h] : sel;
            sel = xsum16(sel); sel = xsum32(sel);
            if (lo < (unsigned)NH && !dry) logfp[((size_t)t * 8 + s) * NH + lo] = sel;
        }
        w0 = wn0; w1 = wn1;
    }
#undef V_LOADID
#undef V_LOADW
#undef V_ISSUE
#undef V_WRITE
#undef TR4
#undef V_MM
}
#undef F4
#undef H2F
__device__ __forceinline__ void step_logf(Frame& F) {
    const GAS float* lp = (const GAS float*)(F.ws + O_LOGFP); const GAS float* rsp = (const GAS float*)(F.ws + O_RSP); GAS float* logf = (GAS float*)(F.ws + O_LOGF);
    unsigned lo = (unsigned)F.lane; asm volatile("" : "+v"(lo));
    const unsigned h = lo & 15, g = lo >> 4; const unsigned hh = h < (unsigned)NH ? h : 0u;
    for (int t0 = F.gw * 4; t0 < T; t0 += F.ngw * 4) {
        const int t = t0 + (int)g;
        float pz[8]; f32x4 q0, q1;
#pragma unroll
        for (int s = 0; s < 8; ++s) pz[s] = lp[((size_t)t * 8 + s) * NH + hh];
        q0 = *(const GAS f32x4*)(rsp + (size_t)t * 8); q1 = *(const GAS f32x4*)(rsp + (size_t)t * 8 + 4);
        const float z0 = ((pz[0] + pz[1]) + (pz[2] + pz[3])) + ((pz[4] + pz[5]) + (pz[6] + pz[7]));
        const float r1 = rsqrtf(((q0[0] + q0[1]) + (q0[2] + q0[3]) + (q1[0] + q1[1]) + (q1[2] + q1[3])) * (1.f / DM) + EPS);
        if (h < (unsigned)NH) { const float z = z0 * r1 + F.in(I_SBF)[h];
            logf[((size_t)(t / SEQ) * NH + h) * SEQ + (t % SEQ)] = fminf(z, 0.f) - log1p_pos(fast_exp(-fabsf(z))); }
    }
}

#define XB_TMO      128
#define XB_XCNT(j)  (256  + 64 * (j))
#define XB_XSUB(j)  (1280 + 64 * (j))
#define XB_XGEN(j)  (2304 + 64 * (j))
#define XB_TOP      3328
#define XB_TOPGEN   3392
#define XCD_BAR_WORDS 3456
#define XB_SPIN_CAP (1u << 20)
__device__ __forceinline__ unsigned xb_ld(unsigned* p)              { return __hip_atomic_load(p, __ATOMIC_RELAXED, __HIP_MEMORY_SCOPE_AGENT); }
__device__ __forceinline__ unsigned xb_add(unsigned* p, unsigned v) { return __hip_atomic_fetch_add(p, v, __ATOMIC_RELAXED, __HIP_MEMORY_SCOPE_AGENT); }
__device__ __forceinline__ unsigned xb_xcc_id() { return (unsigned)__builtin_amdgcn_s_getreg((3 << 11) | 20) & 0xFu; }
#define XB_SPIN(cond, bar) do { unsigned _sp = 0; while (cond) { __builtin_amdgcn_s_sleep(1); \
    if ((++_sp & 255u) == 0u) { if (xb_ld(&(bar)[XB_TMO])) break; if (_sp > XB_SPIN_CAP) { atomicAdd(&(bar)[XB_TMO], 1u); break; } } } } while (0)
struct XcdBarrier { unsigned* bar; unsigned x; volatile LAS unsigned* st; };
__device__ __forceinline__ XcdBarrier xcd_barrier_post(unsigned* bar, volatile LAS unsigned* st) {
    XcdBarrier b; b.bar = bar; b.x = xb_xcc_id(); b.st = st;
    if (threadIdx.x == 0) (void)xb_add(&bar[XB_XCNT(b.x)], 1u);
    return b;
}
__device__ __forceinline__ void xcd_barrier_complete(unsigned* bar, unsigned x, unsigned& nloc, unsigned& nx) {
    const unsigned G = gridDim.x * gridDim.y * gridDim.z;
    unsigned sum, cnt, mine, sp = 0u;
    for (;;) {
        sum = 0u; cnt = 0u; mine = 0u;
#pragma unroll
        for (unsigned j = 0; j < 16; ++j) { const unsigned c = xb_ld(&bar[XB_XCNT(j)]); sum += c; cnt += (c > 0u) ? 1u : 0u; mine = (j == x) ? c : mine; }
        if (sum == G) break;
        __builtin_amdgcn_s_sleep(1);
        if ((++sp & 255u) == 0u) { if (xb_ld(&bar[XB_TMO])) break; if (sp > XB_SPIN_CAP) { atomicAdd(&bar[XB_TMO], 1u); break; } }
    }
    nloc = mine > 0u ? mine : 1u; nx = cnt > 0u ? cnt : 1u;
}
__device__ __forceinline__ void xcd_barrier(const XcdBarrier& b, int wave_s) {
    asm volatile("s_waitcnt vmcnt(0)" ::: "memory");
    __syncthreads();
    int ln_; asm volatile("v_mbcnt_lo_u32_b32 %0, -1, 0\n\tv_mbcnt_hi_u32_b32 %0, -1, %0" : "=v"(ln_));
    if (wave_s == 0 && ln_ == 0) {
        unsigned* bar = b.bar;
        __builtin_amdgcn_s_waitcnt(0);
        unsigned nloc = b.st[0], nx = b.st[1];
        if (nloc == 0u) { xcd_barrier_complete(bar, b.x, nloc, nx); b.st[0] = nloc; b.st[1] = nx; }
        const unsigned old = xb_add(&bar[XB_XSUB(b.x)], 1u);
        const unsigned gen = old / nloc;
        if (old + 1u == (gen + 1u) * nloc) {
            __builtin_amdgcn_fence(__ATOMIC_RELEASE, "agent");
            asm volatile("s_waitcnt vmcnt(0)" ::: "memory");
            const unsigned og = xb_add(&bar[XB_TOP], 1u);
            const unsigned tg = og / nx;
            if (og + 1u == (tg + 1u) * nx) xb_add(&bar[XB_TOPGEN], 1u);
            else XB_SPIN(xb_ld(&bar[XB_TOPGEN]) == tg, bar);
            __builtin_amdgcn_fence(__ATOMIC_ACQUIRE, "agent");
            xb_add(&bar[XB_XGEN(b.x)], 1u);
            asm volatile("s_waitcnt vmcnt(0)" ::: "memory");
        } else {
            XB_SPIN(xb_ld(&bar[XB_XGEN(b.x)]) == gen, bar);
            __builtin_amdgcn_fence(__ATOMIC_ACQUIRE, "agent");
            asm volatile("s_waitcnt vmcnt(0)" ::: "memory");
        }
    }
    __syncthreads();
}

constexpr int CONV1_SPLIT = 2 * 4608;
constexpr int BAR_LDS_OFF = 147456 - 64;
constexpr int LDS_BYTES = 147456;
enum { ST_PROLOGUE = 0, ST_G_IN0, ST_G_MKV0, ST_G_MKV1, ST_CONV, ST_G_GATE, ST_A_MEM0, ST_SCAN1, ST_SCAN2, ST_G_OUT0, ST_G_PQ0, ST_TOPK0, ST_UPASS0, ST_PRED0, ST_VPASS0,
       ST_G_L1, ST_CPREFIX, ST_A_FOX, ST_A_MEM1, ST_G_OUT1, ST_G_PQ1, ST_TOPK1, ST_UPASS1, ST_PRED1, ST_VPASS1, N_STEPS };
constexpr unsigned SYNC_AFTER = (1u << ST_PROLOGUE) | (1u << ST_G_MKV1) | (1u << ST_CONV) | (1u << ST_A_MEM0) | (1u << ST_SCAN1) | (1u << ST_SCAN2) | (1u << ST_G_OUT0) | (1u << ST_G_PQ0) |
                                (1u << ST_TOPK0) | (1u << ST_UPASS0) | (1u << ST_PRED0) | (1u << ST_VPASS0) | (1u << ST_G_L1) | (1u << ST_CPREFIX) | (1u << ST_A_MEM1) | (1u << ST_G_OUT1) | (1u << ST_G_PQ1) | (1u << ST_TOPK1) | (1u << ST_UPASS1) | (1u << ST_PRED1);
constexpr unsigned GEMM_STEPS = (1u << ST_G_IN0) | (1u << ST_G_MKV0) | (1u << ST_G_MKV1) | (1u << ST_G_GATE) | (1u << ST_G_OUT0) | (1u << ST_G_PQ0) | (1u << ST_G_L1) | (1u << ST_G_OUT1) | (1u << ST_G_PQ1);
constexpr unsigned ATTN_STEPS = (1u << ST_A_MEM0) | (1u << ST_A_FOX) | (1u << ST_A_MEM1);

struct Args { const float* in[N_IN]; float* out; unsigned char* ws; int lo, hi; };

__global__ void __launch_bounds__(NTHREADS, 2) yoco_fwd(Args args) {
    extern __shared__ __attribute__((aligned(16))) unsigned char lds[];
    volatile LAS unsigned* bst = (volatile LAS unsigned*)((LAS unsigned char*)lds + BAR_LDS_OFF);
    if (threadIdx.x == 0) { bst[0] = 0u; bst[1] = 0u; }
    __syncthreads();
    const XcdBarrier gbar = xcd_barrier_post((unsigned*)(args.ws + O_CTL), bst);
    const int G = gridDim.x;
    const int wave_s = __builtin_amdgcn_readfirstlane(threadIdx.x >> 6);
#ifndef DUP_MASK
#define DUP_MASK 0u
#endif
    for (int st = args.lo; st < args.hi; ++st) {
      const int nrep = ((DUP_MASK >> st) & 1u) ? 2 : 1;
      for (int rep = 0; rep < nrep; ++rep) {
        unsigned char* ws0 = args.ws; asm volatile("" : "+s"(ws0));
        GAS unsigned char* ws = (GAS unsigned char*)ws0;
#define LANE_ID(v) asm volatile("v_mbcnt_lo_u32_b32 %0, -1, 0\n\tv_mbcnt_hi_u32_b32 %0, -1, %0" : "=v"(v))
#define MAKE_TID(v) do { LANE_ID(v); v += wave_s * 64; } while (0)
#define MAKE_FRAME(F) Frame F; F.ws = ws; F.in_ = args.in; F.out = (GAS float*)args.out; { int t0_; MAKE_TID(t0_); F.tid = t0_; } F.lane = F.tid & 63; F.wave = wave_s; \
        F.gw = blockIdx.x * NWAVES + F.wave; F.ngw = gridDim.x * NWAVES; F.gtid = blockIdx.x * NTHREADS + F.tid; F.ngt = gridDim.x * NTHREADS
        if (st == ST_G_L1) { MAKE_FRAME(F); step_logf(F); }
        if ((GEMM_STEPS >> st) & 1u) {
            pg8::Gemm g; Epi E; E.ws = ws; E.resid = nullptr; E.outf = nullptr; E.o16 = nullptr; E.ssq = nullptr; E.gate_b = nullptr; int shift = 0;
            switch (st) {
            case ST_G_IN0:  g = {(const GAS bf16_t*)(ws + O_XS16), (const GAS bf16_t*)(ws + O_WIN0), T, NIN0, DM, DM, DM, 0}; E.mode = EM_IN0; break;
            case ST_G_MKV0: g = {(const GAS bf16_t*)(ws + O_MEMN), (const GAS bf16_t*)(ws + O_WMKV), NMROW, 1024, DM, DM, DM, 0}; E.mode = EM_MKV; E.o16 = (GAS bf16_t*)(ws + O_MKV); E.ssq = (GAS float*)(ws + O_MKSS); shift = 128; break;
            case ST_G_MKV1: g = {(const GAS bf16_t*)(ws + O_MEMN) + (size_t)NMROW * DM, (const GAS bf16_t*)(ws + O_WMKV) + (size_t)1024 * DM, NMROW, 1024, DM, DM, DM, 0}; E.mode = EM_MKV;
                            E.o16 = (GAS bf16_t*)(ws + O_MKV) + (size_t)NMROW * NL1; E.ssq = (GAS float*)(ws + O_MKSS) + NMROW * 112; shift = 144; break;
            case ST_G_GATE: g = {(const GAS bf16_t*)(ws + O_XC), (const GAS bf16_t*)(ws + O_WGATE), T, 12 * 256, 128, LRU, 128, 128}; E.mode = EM_GATE; E.gate_b = (const GAS float*)args.in[I_AGATEB]; break;
            case ST_G_OUT0: g = {(const GAS bf16_t*)(ws + O_CAT), (const GAS bf16_t*)(ws + O_WOUT0), T, DM, DM, DM, DM, 0}; E.mode = EM_RES; E.resid = (const GAS float*)args.in[I_X]; E.outf = (GAS float*)args.out; break;
            case ST_G_PQ0:  g = {(const GAS bf16_t*)(ws + O_XS16), (const GAS bf16_t*)(ws + O_WQ0), T, DM, DM, DM, DM, 0}; E.mode = EM_PQ; E.o16 = (GAS bf16_t*)(ws + O_Q16); break;
            case ST_G_L1:   g = {(const GAS bf16_t*)(ws + O_XS16), (const GAS bf16_t*)(ws + O_WL1), T, NL1, DM, DM, DM, 0}; E.mode = EM_L1; break;
            case ST_G_OUT1: g = {(const GAS bf16_t*)(ws + O_CAT), (const GAS bf16_t*)(ws + O_WOUT1), T, DM, DM, DM, DM, 0}; E.mode = EM_RES; E.resid = nullptr; break;
            default:        g = {(const GAS bf16_t*)(ws + O_XS16), (const GAS bf16_t*)(ws + O_WQ1), T, DM, DM, DM, DM, 0}; E.mode = EM_PQ; E.o16 = (GAS bf16_t*)(ws + O_Q16); break;
            }
            pg8::StaticOrder S; S.init(g.M, g.N, G, (int)((blockIdx.x + G - shift) % G));
#ifndef DIS_GEMM
            { int tg_; MAKE_TID(tg_);
              pg8::gemm_phase<Epi, false>((LAS unsigned char*)lds, g, S, E, tg_); }
#endif
            if (st == ST_G_MKV1 && blockIdx.x >= 160) { MAKE_FRAME(F); convert_tables(F, 1, 0, CONV1_SPLIT, (blockIdx.x - 160) * NWAVES + F.wave, (G - 160) * NWAVES); }
        } else if ((ATTN_STEPS >> st) & 1u) {
            const int nun = st == ST_A_FOX ? 3 : 1;
            for (int ui = 0; ui < nun; ++ui) {
                att::BlockRef r;
                if (st == ST_A_FOX) {
                    const int i = blockIdx.x, x = i & 15, bh = (i >> 4) + 16 * ui, qb = ui == 0 ? x : (ui == 1 ? 15 - x : ((x * 5 + 3) & 15));
                    const int b = bh / NH, h = bh % NH; const size_t row0 = (size_t)b * SEQ + qb * 256;
                    const GAS bf16_t* z = (const GAS bf16_t*)(ws + O_ZL1);
                    r.Q = z + row0 * NL1 + 3072 + h * 128; r.K = z + (size_t)b * SEQ * NL1 + h * 128; r.V = z + (size_t)b * SEQ * NL1 + 1536 + h * 128;
                    r.O = (GAS bf16_t*)(ws + O_CAT) + row0 * DM + h * 128;
                    const GAS float* ss = (const GAS float*)(ws + O_SSL1);
                    r.qss = ss + row0 * 112 + (12 + h) * 4; r.kss = ss + (size_t)b * SEQ * 112 + h * 4; r.cc = (const GAS float*)(ws + O_CC) + (size_t)bh * SEQ; r.gg = (const GAS float*)(ws + O_GG) + 384;
                    r.P0 = qb * 256; r.skv = SEQ;
                } else {
                    const int l = st == ST_A_MEM0 ? 0 : 1; const int i = blockIdx.x, qblk = i >> 2, h = i & 3, b = qblk >> 4; const size_t row0 = (size_t)qblk * 256;
                    r.Q = (const GAS bf16_t*)(ws + O_ZL1) + row0 * NL1 + 4608 + h * 128; r.qss = (const GAS float*)(ws + O_SSL1) + row0 * 112 + (24 + h) * 4;
                    const GAS bf16_t* kv = (const GAS bf16_t*)(ws + O_MKV) + ((size_t)l * NMROW + b * NMEM) * NL1;
                    r.K = kv + h * 128; r.V = kv + 512 + h * 128; r.kss = (const GAS float*)(ws + O_MKSS) + ((size_t)l * NMROW + b * NMEM) * 112 + h * 4;
                    r.O = (GAS bf16_t*)(ws + O_CAT) + row0 * DM + LRU + h * 128; r.cc = nullptr; r.gg = (const GAS float*)(ws + O_GG) + 128 * (1 + l);
                    r.P0 = SEQ; r.skv = NMEM;
                }
                att::Seam S;
                int tid_u; MAKE_TID(tid_u);
#ifndef DIS_ATTN
                if (st == ST_A_FOX) { att::attn_prime(r, (char*)lds, S, tid_u); att::attn_block(r, (char*)lds, S, tid_u); }
                else att::mem_attn_unit(r, (char*)lds, tid_u);
#endif
            }
        } else {
            MAKE_FRAME(F);
            switch (st) {
#ifndef DIS_MISC
            case ST_PROLOGUE: step_prologue(F, (LAS unsigned char*)lds); break;
            case ST_CONV: step_conv(F); break;
            case ST_SCAN1: step_scan1(F); break;
            case ST_SCAN2: step_scan2(F); break;
#endif
#ifndef DIS_TOPK
            case ST_TOPK0: step_topk(F, (LAS unsigned char*)lds, 0); break;
            case ST_TOPK1: step_topk(F, (LAS unsigned char*)lds, 1); break;
#endif
#ifndef DIS_GATHER
            case ST_UPASS0: step_upass(F, 0, G, (LAS unsigned char*)lds); break;
            case ST_UPASS1: step_upass(F, 1, G, (LAS unsigned char*)lds); break;
            case ST_PRED0: step_peer_reduce(F, 0); break;
            case ST_PRED1: step_peer_reduce(F, 1); break;
            case ST_VPASS0: step_vpass(F, 0, G, rep + 1 < nrep, (LAS unsigned char*)lds); break;
            case ST_VPASS1: step_vpass(F, 1, G, rep + 1 < nrep, (LAS unsigned char*)lds); break;
#endif
#ifndef DIS_MISC
            case ST_CPREFIX: step_cprefix(F, (LAS unsigned char*)lds); convert_tables(F, 1, G > 160 ? CONV1_SPLIT : 0, 2 * NEXP, F.gw, F.ngw); break;
#endif
            default: break;
            }
        }
        if (rep + 1 < nrep) xcd_barrier(gbar, wave_s);
      }
        if (((SYNC_AFTER >> st) & 1u) && st + 1 < args.hi) xcd_barrier(gbar, wave_s);
    }
}

#ifndef N_LAUNCH_MODE
#define N_LAUNCH_MODE 1
#endif
extern "C" void kernel_launch(void* const* d_in, const int* in_sizes, int n_in, void* d_out, int out_size, void* d_ws, size_t ws_size, hipStream_t stream) {
    static int grid = 0;
    if (grid == 0) {
        if (n_in != N_IN || in_sizes[0] != T * DM || out_size != T * DM || ws_size < WS_END) {
            fprintf(stderr, "kernel_launch: unexpected shapes (n_in %d, in0 %d, out %d, ws %zu, need %zu)\n", n_in, n_in > 0 ? in_sizes[0] : -1, out_size, ws_size, (size_t)WS_END); grid = -1; return; }
        int dev = 0, cus = 0, per_cu = 0;
        hipGetDevice(&dev); hipDeviceGetAttribute(&cus, hipDeviceAttributeMultiprocessorCount, dev);
        hipFuncSetAttribute((const void*)yoco_fwd, hipFuncAttributeMaxDynamicSharedMemorySize, LDS_BYTES);
        hipOccupancyMaxActiveBlocksPerMultiprocessor(&per_cu, (const void*)yoco_fwd, NTHREADS, LDS_BYTES);
        if (per_cu < 1) { fprintf(stderr, "kernel_launch: occupancy query says %d blocks per CU\n", per_cu); grid = -1; return; }
        grid = cus - cus % 8;
        (void)hipGetLastError();
    }
    if (grid < 0) return;
    Args a{};
    for (int i = 0; i < N_IN; ++i) a.in[i] = (const float*)d_in[i];
    a.out = (float*)d_out; a.ws = (unsigned char*)d_ws;
    if (hipMemsetAsync((char*)d_ws + O_CTL, 0, 65536, stream) != hipSuccess) { fprintf(stderr, "kernel_launch: memset of the barrier words failed\n"); return; }
    if (N_LAUNCH_MODE == 1) {
        a.lo = 0; a.hi = N_STEPS;
        hipLaunchKernelGGL(yoco_fwd, dim3(grid), dim3(NTHREADS), LDS_BYTES, stream, a);
        hipError_t e = hipPeekAtLastError();
        if (e != hipSuccess) fprintf(stderr, "launch failed: %s (grid %d)\n", hipGetErrorString(e), grid);
    } else {
        int lo = 0;
        for (int s = 0; s < N_STEPS; ++s) {
            if (((SYNC_AFTER >> s) & 1u) || s == N_STEPS - 1) {
                a.lo = lo; a.hi = s + 1; lo = s + 1;
                void* params[] = {&a};
                hipError_t e = hipLaunchCooperativeKernel((const void*)yoco_fwd, dim3(grid), dim3(NTHREADS), params, LDS_BYTES, stream);
                if (e != hipSuccess) { fprintf(stderr, "launch failed: %s\n", hipGetErrorString(e)); break; }
            }
        }
    }
}
```

```cpp
#include <hip/hip_runtime.h>
#include <hip/hip_cooperative_groups.h>
#include <cstdio>
#include <cstdint>
namespace cg = cooperative_groups;

#define LAS __attribute__((address_space(3)))
#define GAS __attribute__((address_space(1)))
typedef unsigned short bf16_t;
typedef short bf16x8 __attribute__((ext_vector_type(8)));
typedef short s16x4 __attribute__((ext_vector_type(4)));
typedef float f32x4 __attribute__((ext_vector_type(4)));
typedef float f32x2 __attribute__((ext_vector_type(2)));
typedef float f32x16 __attribute__((ext_vector_type(16)));
typedef unsigned u32x4 __attribute__((ext_vector_type(4)));
typedef unsigned u32x2 __attribute__((ext_vector_type(2)));
typedef _Float16 h2 __attribute__((ext_vector_type(2)));

constexpr int NB = 4, SEQ = 4096, T = NB * SEQ, DM = 2048, LRU = 1536, MEMW = 512, NMEM = 256, NH = 12, HD = 128;
constexpr int NIN0 = 3584, NL1 = 5120, NEXP = 16384, NMROW = NB * NMEM;
constexpr float EPS = 1e-6f;
constexpr int NTHREADS = 512, NWAVES = 8;

constexpr size_t MiB = 1u << 20;
constexpr size_t O_CTL = 0;
constexpr size_t O_WIN0 = 1 * MiB;
constexpr size_t O_WOUT0 = O_WIN0 + 14 * MiB;
constexpr size_t O_WL1 = O_WOUT0 + 8 * MiB;
constexpr size_t O_WOUT1 = O_WL1 + 20 * MiB;
constexpr size_t O_WQ0 = O_WOUT1 + 8 * MiB;
constexpr size_t O_WQ1 = O_WQ0 + 8 * MiB;
constexpr size_t O_WMKV = O_WQ1 + 8 * MiB;
constexpr size_t O_WGATE = O_WMKV + 8 * MiB;
constexpr size_t O_SUBK = O_WGATE + 1 * MiB;
constexpr size_t O_WF = O_SUBK + 1 * MiB;
constexpr size_t O_SMALL = O_WF + 1 * MiB;
constexpr size_t O_RS1 = O_SMALL;
constexpr size_t O_LOGF = O_SMALL + 64 * 1024;
constexpr size_t O_CC = O_LOGF + 768 * 1024;
constexpr size_t O_GG = O_CC + 768 * 1024;
constexpr size_t O_SPL = O_GG + 4096;
constexpr size_t O_TSC = O_SPL + 8192;
constexpr size_t O_ROWSS = O_SMALL + 2 * MiB;
constexpr size_t O_RSP = O_ROWSS + 2 * MiB;
constexpr size_t O_QMSS = O_RSP;
constexpr size_t O_MKSS = O_QMSS + 1 * MiB;
constexpr size_t O_SSL1 = O_MKSS + 1 * MiB;
constexpr size_t O_CARRY = O_SSL1 + 7 * MiB;
constexpr size_t O_MEMN = O_CARRY + 3 * MiB;
constexpr size_t O_MKV = O_MEMN + 8 * MiB;
constexpr size_t O_IDX = O_MKV + 20 * MiB;
constexpr size_t O_GW = O_IDX + 8 * MiB;
constexpr size_t O_TAB = O_GW + 8 * MiB;
constexpr size_t TAB_NIB = (size_t)8 * 16384 * 128, TAB_ONE = TAB_NIB + (size_t)16384 * 16 + 786432;
constexpr size_t O_XS16 = O_TAB + 128 * MiB;
constexpr size_t O_CAT = O_XS16 + 64 * MiB;
constexpr size_t O_ZX = O_CAT + 64 * MiB;
constexpr size_t O_X8 = O_ZX;
constexpr size_t O_GY = O_ZX + 48 * MiB;
constexpr size_t O_LOGFP = O_GY + 48 * MiB;
constexpr size_t O_QM = O_LOGFP;
constexpr size_t O_XC = O_QM + 16 * MiB;
constexpr size_t O_X4 = O_XC;
constexpr size_t O_SX = O_XC + 32 * MiB;
constexpr size_t O_AA = O_XC + 48 * MiB;
constexpr size_t O_PART = O_AA;
constexpr size_t O_UU = O_AA + 96 * MiB;
constexpr size_t O_W8 = O_UU;
constexpr size_t O_Q16 = O_UU + 96 * MiB;
constexpr size_t O_ZL1 = O_Q16 + 64 * MiB;
constexpr size_t WS_END = O_ZL1 + 160 * MiB;
static_assert(WS_END <= 1024 * MiB, "workspace map");

__device__ __forceinline__ unsigned cvtpk(float lo, float hi) { unsigned r; asm volatile("v_cvt_pk_bf16_f32 %0, %1, %2" : "=v"(r) : "v"(lo), "v"(hi)); return r; }
__device__ __forceinline__ float bf_lo(unsigned w) { return __uint_as_float(w << 16); }
__device__ __forceinline__ float bf_hi(unsigned w) { return __uint_as_float(w & 0xffff0000u); }
__device__ __forceinline__ float fast_exp(float x) { return __builtin_amdgcn_exp2f(x * 1.4426950408889634f); }
__device__ __forceinline__ float log1p_pos(float y) { const float ser = y * (1.f - y * (0.5f - y * (0.33333334f - 0.25f * y))); const float lg = __builtin_amdgcn_logf(1.f + y) * 0.6931471805599453f; return y < 0.03f ? ser : lg; }
__device__ __forceinline__ float one_minus_exp(float x) { const float ser = -x * (1.f + x * (0.5f + x * (0.16666667f + x * 0.041666668f))); const float big = 1.f - fast_exp(x); return x > -0.03f ? ser : big; }
__device__ __forceinline__ float sigmoidf_(float x) { return __builtin_amdgcn_rcpf(1.f + fast_exp(-x)); }
__device__ __forceinline__ float gelu_tanh(float x) { const float u = x * (1.f + 0.044715f * x * x); return x * __builtin_amdgcn_rcpf(1.f + __builtin_amdgcn_exp2f(u * (-2.f * 0.7978845608028654f * 1.4426950408889634f))); }
template <int CTRL> __device__ __forceinline__ float dppf(float v) { return __int_as_float(__builtin_amdgcn_update_dpp(0, __float_as_int(v), CTRL, 0xF, 0xF, true)); }
__device__ __forceinline__ float xsum16(float v) { auto r = __builtin_amdgcn_permlane16_swap(__float_as_uint(v), __float_as_uint(v), false, false); return __uint_as_float(r[0]) + __uint_as_float(r[1]); }
__device__ __forceinline__ float xsum32(float v) { auto r = __builtin_amdgcn_permlane32_swap(__float_as_uint(v), __float_as_uint(v), false, false); return __uint_as_float(r[0]) + __uint_as_float(r[1]); }
__device__ __forceinline__ float xmax16(float v) { auto r = __builtin_amdgcn_permlane16_swap(__float_as_uint(v), __float_as_uint(v), false, false); return fmaxf(__uint_as_float(r[0]), __uint_as_float(r[1])); }
__device__ __forceinline__ float xmax32(float v) { auto r = __builtin_amdgcn_permlane32_swap(__float_as_uint(v), __float_as_uint(v), false, false); return fmaxf(__uint_as_float(r[0]), __uint_as_float(r[1])); }
__device__ __forceinline__ float wave_sum(float v) {
    v += dppf<0xB1>(v); v += dppf<0x4E>(v); v += dppf<0x141>(v); v += dppf<0x140>(v);
    v = xsum16(v); v = xsum32(v); return v;
}
__device__ __forceinline__ float wave_max(float v) {
    v = fmaxf(v, dppf<0xB1>(v)); v = fmaxf(v, dppf<0x4E>(v)); v = fmaxf(v, dppf<0x141>(v)); v = fmaxf(v, dppf<0x140>(v));
    v = xmax16(v); v = xmax32(v); return v;
}

namespace pg8 {
constexpr int BM = 256, BK = 64, HALF = 128, HTB = HALF * BK * 2, STAGE_BYTES = 8 * HTB, NXCD = 8, WGM = 8;
__host__ __device__ __forceinline__ int lds_byte(int r, int c) { const int st = (r >> 4) * 2 + (c >> 5), rr = r & 15, cc = c & 31, ob = rr * 64 + cc * 2; return st * 1024 + (ob ^ (((ob >> 9) & 1) << 5)); }
__host__ __device__ __forceinline__ void stage_rc(int b, int& R, int& C) { const int st = b / 1024, sb = b % 1024, swz = sb ^ (((sb >> 9) & 1) << 5); R = (st >> 1) * 16 + swz / 64; C = (st & 1) * 32 + (swz % 64) / 2; }
__host__ __device__ __forceinline__ int perm32(int rho) { const int n = rho >> 4, i = rho & 15; return 8 * (i >> 2) + 4 * n + (i & 3); }

struct Unit { int pm, pn; };
struct Gemm { const GAS bf16_t* A; const GAS bf16_t* Bt; int M, N, K, lda, ldb, acol; };

struct StaticOrder {
    int nM, nN, nwg, G, c;
    __device__ void init(int M, int N, int G_, int c_) { nM = M / BM; nN = N / BM; nwg = nM * nN; G = G_; c = c_; }
    __device__ bool next(int i, Unit& u) const {
        const long L = (long)i * G + c; if (L >= nwg) return false;
        int wgid = (int)L; { const int q = nwg / NXCD, r = nwg % NXCD, xcd = wgid % NXCD, off = wgid / NXCD; wgid = (xcd < r ? xcd * (q + 1) : r * (q + 1) + (xcd - r) * q) + off; }
        const int nig = WGM * nN, gid = wgid / nig, fm = gid * WGM, gsz = (nM - fm) < WGM ? (nM - fm) : WGM;
        u.pm = fm + ((wgid % nig) % gsz); u.pn = (wgid % nig) / gsz; return true;
    }
};

typedef int v8i_t __attribute__((ext_vector_type(8)));
typedef int v4i_t __attribute__((ext_vector_type(4)));
template <class Epi, bool FP8>
__device__ __forceinline__ void gemm_phase(LAS unsigned char* lds, const Gemm g, const StaticOrder& S, const Epi& E, const int tid) {
    const int wid = __builtin_amdgcn_readfirstlane(tid >> 6), lane = tid & 63, wr = wid >> 2, wc = wid & 3, fr = lane & 15, fq = lane >> 4;
    const int K = g.K, nt = K / BK;
    unsigned voffA[2], voffB[2];
#pragma unroll
    for (int i = 0; i < 2; ++i) { int R, C; stage_rc(tid * 16 + i * 8192, R, C); const int Rb = (R & ~31) + perm32(R & 31);
        voffA[i] = (unsigned)(R * g.lda + C) * 2u; voffB[i] = (unsigned)(Rb * g.ldb + C) * 2u; }
    const size_t kstep = (size_t)(BK * 2);
    const size_t hstepA = (size_t)HALF * g.lda * 2, hstepB = (size_t)HALF * g.ldb * 2;
    const size_t tstepA = 2 * hstepA, tstepB = 2 * hstepB;
    const unsigned ldsw = (unsigned)wid * 1024u;
    const int aoff = lds_byte(wr * 64 + fr, fq * 8), boff = lds_byte(wc * 32 + fr, fq * 8);
#define PG8_SA(b, h) (((b) * 2 + (h)) * HTB)
#define PG8_SB(b, h) ((4 + (b) * 2 + (h)) * HTB)
#define PG8_STAGE(bufoff, gbase, voff) do { _Pragma("unroll") for (int _i = 0; _i < 2; ++_i) \
        __builtin_amdgcn_global_load_lds((const GAS unsigned*)((gbase) + (voff)[_i]), (LAS unsigned*)(lds + (bufoff) + ldsw + _i * 8192), 16, 0, 0); } while (0)
#define PG8_LD2(dst, off_) do { const u32x4 lo_ = *(const LAS u32x4*)(lds + (off_)), hi_ = *(const LAS u32x4*)(lds + (off_) + 1024); \
        dst = (v8i_t){(int)lo_.x, (int)lo_.y, (int)lo_.z, (int)lo_.w, (int)hi_.x, (int)hi_.y, (int)hi_.z, (int)hi_.w}; } while (0)
#define PG8_LDA(dst, b, h) do { _Pragma("unroll") for (int m = 0; m < 4; ++m) PG8_LD2(dst[m], PG8_SA(b, h) + aoff + m * 2048); } while (0)
#define PG8_LDB(dst, b, h) do { _Pragma("unroll") for (int n = 0; n < 2; ++n) PG8_LD2(dst[n], PG8_SB(b, h) + boff + n * 2048); } while (0)
#define PG8_HALF(v, k) ((k) ? __builtin_shufflevector(v, v, 4, 5, 6, 7) : __builtin_shufflevector(v, v, 0, 1, 2, 3))
#define PG8_MMA(ai, bj, At, Bt) do { __builtin_amdgcn_s_setprio(1); _Pragma("unroll") for (int m = 0; m < 4; ++m) _Pragma("unroll") for (int n = 0; n < 2; ++n) { \
        if constexpr (FP8) asm volatile("v_mfma_scale_f32_16x16x128_f8f6f4 %0, %1, %2, %0, %3, %4 op_sel_hi:[0,0,0]" : "+v"(acc[ai][bj][m][n]) : "v"(Bt[n]), "v"(At[m]), "v"(sc_w), "v"(sc_x));     \
        else { _Pragma("unroll") for (int k = 0; k < 2; ++k) { const v4i_t bh_ = PG8_HALF(Bt[n], k), ah_ = PG8_HALF(At[m], k); \
                acc[ai][bj][m][n] = __builtin_amdgcn_mfma_f32_16x16x32_bf16(__builtin_bit_cast(bf16x8, bh_), __builtin_bit_cast(bf16x8, ah_), acc[ai][bj][m][n], 0, 0, 0); } } } \
        __builtin_amdgcn_s_setprio(0); } while (0)
#define PG8_WAIT_V(n) asm volatile("s_waitcnt vmcnt(" #n ")" ::: "memory")
#define PG8_WAIT_L(n) asm volatile("s_waitcnt lgkmcnt(" #n ")" ::: "memory")
#define PG8_BAR __builtin_amdgcn_s_barrier()
#define PG8_SCHED __builtin_amdgcn_sched_barrier(0)
    Unit cur, nxt; int ui = 0;
    if (!S.next(0, cur)) return;
    f32x4 acc[2][2][4][2];
#pragma unroll
    for (int a = 0; a < 2; ++a)
#pragma unroll
        for (int b = 0; b < 2; ++b)
#pragma unroll
            for (int m = 0; m < 4; ++m)
#pragma unroll
                for (int n = 0; n < 2; ++n) acc[a][b][m][n] = (f32x4){0.f, 0.f, 0.f, 0.f};
    v8i_t At[4], B0[2], B1[2];
    const int sc_w = 121, sc_x = 127;
    const GAS char* cA = (const GAS char*)g.A + (size_t)cur.pm * tstepA + (size_t)cur.pn * g.acol * 2; const GAS char* cB = (const GAS char*)g.Bt + (size_t)cur.pn * tstepB;
    PG8_STAGE(PG8_SB(0, 0), cB, voffB); PG8_STAGE(PG8_SB(0, 1), cB + hstepB, voffB); PG8_STAGE(PG8_SA(0, 0), cA, voffA); PG8_STAGE(PG8_SA(0, 1), cA + hstepA, voffA);
    if (wr == 1) PG8_BAR;
    PG8_WAIT_V(2); PG8_BAR;
    PG8_STAGE(PG8_SB(1, 0), cB + kstep, voffB); PG8_STAGE(PG8_SA(1, 0), cA + kstep, voffA); PG8_STAGE(PG8_SB(1, 1), cB + hstepB + kstep, voffB);
    PG8_WAIT_V(6); PG8_BAR;
    for (;;) {
        const bool has_next = S.next(ui + 1, nxt);
        const GAS char* nA = has_next ? (const GAS char*)g.A + (size_t)nxt.pm * tstepA + (size_t)nxt.pn * g.acol * 2 : cA; const GAS char* nB = has_next ? (const GAS char*)g.Bt + (size_t)nxt.pn * tstepB : cB;
        for (int t = 0; t < nt; t += 2) {
            const bool last = (t == nt - 2);
            const GAS char* a1 = cA + (size_t)(t + 1) * kstep;
            const GAS char* a2 = last ? nA : cA + (size_t)(t + 2) * kstep; const GAS char* b2 = last ? nB : cB + (size_t)(t + 2) * kstep;
            const GAS char* a3 = a2 + kstep; const GAS char* b3 = b2 + kstep;
            PG8_LDB(B0, 0, 0); PG8_LDB(B1, 0, 1); PG8_SCHED; PG8_LDA(At, 0, 0); PG8_STAGE(PG8_SA(1, 1), a1 + hstepA, voffA);
            PG8_WAIT_V(8); PG8_WAIT_L(0); PG8_BAR; PG8_MMA(0, 0, At, B0); PG8_MMA(0, 1, At, B1); PG8_BAR; PG8_SCHED;
            PG8_LDA(At, 0, 1); PG8_STAGE(PG8_SB(0, 0), b2, voffB); PG8_STAGE(PG8_SB(0, 1), b2 + hstepB, voffB); PG8_STAGE(PG8_SA(0, 0), a2, voffA);
            PG8_WAIT_V(8); PG8_WAIT_L(0); PG8_BAR; PG8_MMA(1, 0, At, B0); PG8_MMA(1, 1, At, B1); PG8_BAR; PG8_SCHED;
            PG8_LDB(B0, 1, 0); PG8_LDB(B1, 1, 1); PG8_SCHED; PG8_LDA(At, 1, 0); PG8_STAGE(PG8_SA(0, 1), a2 + hstepA, voffA);
            PG8_WAIT_V(8); PG8_WAIT_L(0); PG8_BAR; PG8_MMA(0, 0, At, B0); PG8_MMA(0, 1, At, B1); PG8_BAR; PG8_SCHED;
            PG8_LDA(At, 1, 1); PG8_STAGE(PG8_SB(1, 0), b3, voffB); PG8_STAGE(PG8_SB(1, 1), b3 + hstepB, voffB); PG8_STAGE(PG8_SA(1, 0), a3, voffA);
            PG8_WAIT_V(8); PG8_WAIT_L(0); PG8_BAR; PG8_MMA(1, 0, At, B0); PG8_MMA(1, 1, At, B1); PG8_BAR; PG8_SCHED;
        }
        if (wr == 0) PG8_BAR;
        { int ln_; asm volatile("v_mbcnt_lo_u32_b32 %0, -1, 0\n\tv_mbcnt_hi_u32_b32 %0, -1, %0" : "=v"(ln_));
          E(acc, cur, wr, wc, ln_ & 15, ln_ >> 4); }
        if (!has_next) break;
#pragma unroll
        for (int a = 0; a < 2; ++a)
#pragma unroll
            for (int b = 0; b < 2; ++b)
#pragma unroll
                for (int m = 0; m < 4; ++m)
#pragma unroll
                    for (int n = 0; n < 2; ++n) acc[a][b][m][n] = (f32x4){0.f, 0.f, 0.f, 0.f};
        cur = nxt; cA = nA; cB = nB; ++ui;
        if (wr == 1) PG8_BAR;
    }
    PG8_WAIT_V(0);
    PG8_BAR;
#undef PG8_SA
#undef PG8_SB
#undef PG8_STAGE
#undef PG8_LDA
#undef PG8_LDB
#undef PG8_LD2
#undef PG8_HALF
#undef PG8_MMA
#undef PG8_WAIT_V
#undef PG8_WAIT_L
#undef PG8_BAR
#undef PG8_SCHED
}
}

enum { EM_IN0 = 0, EM_MKV = 1, EM_GATE = 2, EM_RES = 3, EM_PQ = 4, EM_L1 = 5 };
struct Epi {
    int mode;
    GAS unsigned char* ws;
    const GAS float* resid;
    GAS float* outf;
    GAS bf16_t* o16;
    GAS float* ssq;
    const GAS float* gate_b;
    typedef pg8::Unit Unit;
    __device__ __forceinline__ static void st8(GAS bf16_t* p, f32x4 v0, f32x4 v1) {
        u32x4 w; w.x = cvtpk(v0[0], v0[1]); w.y = cvtpk(v0[2], v0[3]); w.z = cvtpk(v1[0], v1[1]); w.w = cvtpk(v1[2], v1[3]); *(GAS u32x4*)p = w; }
    __device__ __forceinline__ static float sq8(f32x4 a, f32x4 b) { return (a[0] * a[0] + a[1] * a[1]) + (a[2] * a[2] + a[3] * a[3]) + (b[0] * b[0] + b[1] * b[1]) + (b[2] * b[2] + b[3] * b[3]); }
    __device__ __forceinline__ void operator()(f32x4 (&acc)[2][2][4][2], const Unit& u, int wr, int wc, int fr, int fq) const {
        const int row0 = u.pm * 256 + wr * 64 + fr;
        const int cin = wc * 32 + 8 * fq;
        if (mode == EM_IN0) {
            GAS bf16_t* base; int ld, colt; int kind;
            if (u.pn < 6) { base = (GAS bf16_t*)(ws + O_ZX); ld = LRU; colt = u.pn * 256; kind = 0; }
            else if (u.pn < 12) { base = (GAS bf16_t*)(ws + O_GY); ld = LRU; colt = (u.pn - 6) * 256; kind = 1; }
            else { base = (GAS bf16_t*)(ws + O_ZL1); ld = NL1; colt = 4608 + (u.pn - 12) * 256; kind = 2; }
            GAS float* qmss = (GAS float*)(ws + O_SSL1);
#pragma unroll
            for (int ai = 0; ai < 2; ++ai)
#pragma unroll
                for (int m = 0; m < 4; ++m) { const int row = row0 + ai * 128 + m * 16;
#pragma unroll
                    for (int bj = 0; bj < 2; ++bj) { f32x4 v0 = acc[ai][bj][m][0], v1 = acc[ai][bj][m][1];
                        if (kind == 1) {
#pragma unroll
                            for (int j = 0; j < 4; ++j) { v0[j] = gelu_tanh(v0[j]); v1[j] = gelu_tanh(v1[j]); } }
                        st8(base + (size_t)row * ld + colt + bj * 128 + cin, v0, v1);
                        if (kind == 2) { float s = sq8(v0, v1); s = xsum16(s); s = xsum32(s);
                            if (fq == 0) qmss[(size_t)row * 112 + (24 + (u.pn - 12) * 2 + bj) * 4 + wc] = s; } } }
        } else if (mode == EM_MKV) {
#pragma unroll
            for (int ai = 0; ai < 2; ++ai)
#pragma unroll
                for (int m = 0; m < 4; ++m) { const int row = row0 + ai * 128 + m * 16;
#pragma unroll
                    for (int bj = 0; bj < 2; ++bj) { const f32x4 v0 = acc[ai][bj][m][0], v1 = acc[ai][bj][m][1];
                        st8(o16 + (size_t)row * NL1 + u.pn * 256 + bj * 128 + cin, v0, v1);
                        if (u.pn < 2) { float s = sq8(v0, v1); s = xsum16(s); s = xsum32(s);
                            if (fq == 0) ssq[(size_t)row * 112 + (u.pn * 2 + bj) * 4 + wc] = s; } } }
        } else if (mode == EM_GATE) {
            const int ch = u.pn * 128 + cin;
            const GAS bf16_t* xc = (const GAS bf16_t*)(ws + O_XC); GAS _Float16* LA = (GAS _Float16*)(ws + O_AA); GAS _Float16* UH = (GAS _Float16*)(ws + O_UU);
            const GAS float* spl = (const GAS float*)(ws + O_SPL) + ch; const GAS float* gb = gate_b + u.pn * 256 + cin;
#pragma unroll
            for (int n = 0; n < 2; ++n) {
                const f32x4 sp = *(const GAS f32x4*)(spl + 4 * n), br = *(const GAS f32x4*)(gb + 4 * n), bi = *(const GAS f32x4*)(gb + 128 + 4 * n);
#pragma unroll
                for (int ai = 0; ai < 2; ++ai)
#pragma unroll
                    for (int m = 0; m < 4; ++m) { const int row = row0 + ai * 128 + m * 16;
                        const u32x2 xw = *(const GAS u32x2*)(xc + (size_t)row * LRU + ch + 4 * n);
                        const f32x4 xv = {bf_lo(xw.x), bf_hi(xw.x), bf_lo(xw.y), bf_hi(xw.y)};
                        float lav[4], uvv[4];
#pragma unroll
                        for (int j = 0; j < 4; ++j) { const float r = sigmoidf_(acc[ai][0][m][n][j] + br[j]), ig = sigmoidf_(acc[ai][1][m][n][j] + bi[j]);
                            const float la = -8.f * r * sp[j];
                            lav[j] = la; uvv[j] = __builtin_amdgcn_sqrtf(one_minus_exp(2.f * la)) * (ig * xv[j]); }
                        { const h2 l0 = {(_Float16)lav[0], (_Float16)lav[1]}, l1 = {(_Float16)lav[2], (_Float16)lav[3]}, u0 = {(_Float16)uvv[0], (_Float16)uvv[1]}, u1 = {(_Float16)uvv[2], (_Float16)uvv[3]};
                          *(GAS u32x2*)(LA + (size_t)row * LRU + ch + 4 * n) = (u32x2){__builtin_bit_cast(unsigned, l0), __builtin_bit_cast(unsigned, l1)};
                          *(GAS u32x2*)(UH + (size_t)row * LRU + ch + 4 * n) = (u32x2){__builtin_bit_cast(unsigned, u0), __builtin_bit_cast(unsigned, u1)}; } }
            }
        } else if (mode == EM_RES) {
            GAS bf16_t* xs = (GAS bf16_t*)(ws + O_XS16); GAS float* rowss = (GAS float*)(ws + O_ROWSS);
#pragma unroll
            for (int ai = 0; ai < 2; ++ai)
#pragma unroll
                for (int m = 0; m < 4; ++m) { const int row = row0 + ai * 128 + m * 16; float s = 0.f;
#pragma unroll
                    for (int bj = 0; bj < 2; ++bj) { const size_t off = (size_t)row * DM + u.pn * 256 + bj * 128 + cin;
                        f32x4 r0, r1;
                        if (resid) { r0 = *(const GAS f32x4*)(resid + off); r1 = *(const GAS f32x4*)(resid + off + 4); }
                        else { const u32x4 w = *(const GAS u32x4*)(xs + off); r0 = (f32x4){bf_lo(w.x), bf_hi(w.x), bf_lo(w.y), bf_hi(w.y)}; r1 = (f32x4){bf_lo(w.z), bf_hi(w.z), bf_lo(w.w), bf_hi(w.w)}; }
                        const f32x4 v0 = acc[ai][bj][m][0] + r0, v1 = acc[ai][bj][m][1] + r1;
                        st8(xs + off, v0, v1); s += sq8(v0, v1); }
                    s = xsum16(s); s = xsum32(s);
                    if (fq == 0) rowss[(size_t)row * 32 + u.pn * 4 + wc] = s; }
        } else if (mode == EM_PQ) {
            const GAS float* rowss = (const GAS float*)(ws + O_ROWSS);
#pragma unroll
            for (int ai = 0; ai < 2; ++ai)
#pragma unroll
                for (int m = 0; m < 4; ++m) { const int row = row0 + ai * 128 + m * 16;
                    const f32x4 p0 = *(const GAS f32x4*)(rowss + (size_t)row * 32 + fq * 8), p1 = *(const GAS f32x4*)(rowss + (size_t)row * 32 + fq * 8 + 4);
                    float s = (p0[0] + p0[1]) + (p0[2] + p0[3]) + (p1[0] + p1[1]) + (p1[2] + p1[3]); s = xsum16(s); s = xsum32(s);
                    const float r = rsqrtf(s * (1.f / DM) + EPS);
#pragma unroll
                    for (int bj = 0; bj < 2; ++bj) st8(o16 + (size_t)row * DM + u.pn * 256 + bj * 128 + cin, acc[ai][bj][m][0] * r, acc[ai][bj][m][1] * r); }
        } else {
            const GAS float* rsp = (const GAS float*)(ws + O_RSP); GAS bf16_t* zl1 = (GAS bf16_t*)(ws + O_ZL1); GAS float* ssl1 = (GAS float*)(ws + O_SSL1);
            const int slot0 = u.pn < 6 ? u.pn * 2 : (u.pn >= 12 ? 12 + (u.pn - 12) * 2 : -1);
#pragma unroll
            for (int ai = 0; ai < 2; ++ai)
#pragma unroll
                for (int m = 0; m < 4; ++m) { const int row = row0 + ai * 128 + m * 16;
                    const f32x4 q0 = *(const GAS f32x4*)(rsp + (size_t)row * 8), q1 = *(const GAS f32x4*)(rsp + (size_t)row * 8 + 4);
                    const float r = rsqrtf(((q0[0] + q0[1]) + (q0[2] + q0[3]) + (q1[0] + q1[1]) + (q1[2] + q1[3])) * (1.f / DM) + EPS);
#pragma unroll
                    for (int bj = 0; bj < 2; ++bj) { const f32x4 v0 = acc[ai][bj][m][0] * r, v1 = acc[ai][bj][m][1] * r;
                        st8(zl1 + (size_t)row * NL1 + u.pn * 256 + bj * 128 + cin, v0, v1);
                        if (slot0 >= 0) { float s = sq8(v0, v1); s = xsum16(s); s = xsum32(s);
                            if (fq == 0) ssl1[(size_t)row * 112 + (slot0 + bj) * 4 + wc] = s; } } }
        }
    }
};

namespace att {
constexpr float SCALE = 0.08838834764831845f;
constexpr int NW = 8, QBLK = 32, KVBLK = 64, QB = NW * QBLK, D = 128;
constexpr int SHM_V = KVBLK * D * 2, SHM_K = KVBLK * D * 2;
constexpr int OFF_WS = 2 * SHM_V + 2 * SHM_K;
constexpr int OFF_KS = OFF_WS + 2048;
constexpr int OFF_BS = OFF_KS + 16384;
constexpr int LDS_END = OFF_BS + 16384;
constexpr int WBIG = 1 << 28;

#define KSWZ(row, colB) ((row) * 256 + ((colB) ^ (((row) & 7) << 4)))
#define SBAR() __builtin_amdgcn_sched_barrier(0)
__device__ __forceinline__ int v_st(int k, int c) { const int kk = (k & ~0xC) | ((k & 4) << 1) | ((k & 8) >> 1); return ((kk >> 3) * 4 + (c >> 5)) * 512 + ((kk & 7) * 32 + (c & 31)) * 2; }
__device__ __forceinline__ int v_rd_base(int lane) { return ((lane & 3) << 3) | (((lane >> 2) & 3) << 6) | (((lane >> 4) & 1) << 5) | (((lane >> 5) & 1) << 8); }
constexpr int v_rd_off(int d0, int ks, int half) { return d0 * 512 + ks * 4096 + half * 2048; }
__device__ __forceinline__ int crow(int r, int hi) { return (r & 3) + 8 * (r >> 2) + 4 * hi; }
__device__ __forceinline__ bf16x8 load8(const GAS bf16_t* p) { return *(const GAS bf16x8*)p; }
__device__ __forceinline__ bf16x8 scale8(bf16x8 v, float s) { const u32x4 w = *reinterpret_cast<u32x4*>(&v); u32x4 o;
    o.x = cvtpk(bf_lo(w.x) * s, bf_hi(w.x) * s); o.y = cvtpk(bf_lo(w.y) * s, bf_hi(w.y) * s); o.z = cvtpk(bf_lo(w.z) * s, bf_hi(w.z) * s); o.w = cvtpk(bf_lo(w.w) * s, bf_hi(w.w) * s);
    return *reinterpret_cast<bf16x8*>(&o); }
__device__ __forceinline__ void mask_tile(f32x16& p0, f32x16& p1, int dq, unsigned W) {
    const float NEG = -__builtin_inff();
#pragma unroll
    for (int r = 0; r < 16; ++r) {
        const int c = (r & 3) + 8 * (r >> 2);
        if ((unsigned)(dq - c) >= W) p0[r] = NEG;
        if ((unsigned)(dq - c - 32) >= W) p1[r] = NEG;
    }
}
constexpr float THR = 8.f;
__device__ __forceinline__ void partialSM(f32x16& p0, f32x16& p1, float& m_reg, float& mn, float& alpha) {
    float pmax = p0[0]; for (int r = 1; r < 16; ++r) pmax = fmaxf(pmax, p0[r]); for (int r = 0; r < 16; ++r) pmax = fmaxf(pmax, p1[r]);
    { auto rr = __builtin_amdgcn_permlane32_swap(__float_as_uint(pmax), __float_as_uint(pmax), false, false);
      pmax = fmaxf(__uint_as_float(rr[0]), __uint_as_float(rr[1])); }
    constexpr float C2 = 1.4426950408889634f * SCALE;
    if (__builtin_expect(__all((pmax - m_reg) * SCALE <= THR), 1)) { mn = m_reg; alpha = 1.f; }
    else { mn = fmaxf(m_reg, pmax); alpha = __builtin_amdgcn_exp2f((m_reg - mn) * C2); m_reg = mn; }
    const float mnL = -mn * C2;
    for (int r = 0; r < 16; ++r) p0[r] = fmaf(p0[r], C2, mnL); for (int r = 0; r < 16; ++r) p1[r] = fmaf(p1[r], C2, mnL);
    for (int r = 0; r < 16; ++r) p0[r] = __builtin_amdgcn_exp2f(p0[r]);
}
__device__ __forceinline__ void finishSM(f32x16& p0, f32x16& p1, float alpha, float& l_reg, bf16x8& pa0, bf16x8& pa1, bf16x8& pa2, bf16x8& pa3) {
    for (int r = 0; r < 16; ++r) p1[r] = __builtin_amdgcn_exp2f(p1[r]);
    float ps = 0; for (int r = 0; r < 16; ++r) ps += p0[r]; for (int r = 0; r < 16; ++r) ps += p1[r];
    { auto rr = __builtin_amdgcn_permlane32_swap(__float_as_uint(ps), __float_as_uint(ps), false, false);
      ps = __uint_as_float(rr[0]) + __uint_as_float(rr[1]); }
    l_reg = l_reg * alpha + ps;
#define PK4(P, B_, OUT) do { unsigned a0 = cvtpk(P[B_+0], P[B_+1]), a1 = cvtpk(P[B_+2], P[B_+3]);                          \
        unsigned b0 = cvtpk(P[B_+4], P[B_+5]), b1 = cvtpk(P[B_+6], P[B_+7]);                                             \
        auto r0 = __builtin_amdgcn_permlane32_swap(a0, b0, false, false); auto r1 = __builtin_amdgcn_permlane32_swap(a1, b1, false, false); \
        u32x4 w = {r0[0], r1[0], r0[1], r1[1]}; OUT = *reinterpret_cast<bf16x8*>(&w); } while (0)
    PK4(p0, 0, pa0); PK4(p0, 8, pa1); PK4(p1, 0, pa2); PK4(p1, 8, pa3);
#undef PK4
}
template <int KB>
__device__ __forceinline__ void qkt(f32x16& p0, f32x16& p1, const char* K_lds, int r32, int hi, const bf16x8* qr, const float* bp  ) {
    { const f32x4 a = *(const f32x4*)(bp), b = *(const f32x4*)(bp + 8), c = *(const f32x4*)(bp + 16), d = *(const f32x4*)(bp + 24);
      p0 = (f32x16){a[0], a[1], a[2], a[3], b[0], b[1], b[2], b[3], c[0], c[1], c[2], c[3], d[0], d[1], d[2], d[3]}; }
    { const f32x4 a = *(const f32x4*)(bp + 32), b = *(const f32x4*)(bp + 40), c = *(const f32x4*)(bp + 48), d = *(const f32x4*)(bp + 56);
      p1 = (f32x16){a[0], a[1], a[2], a[3], b[0], b[1], b[2], b[3], c[0], c[1], c[2], c[3], d[0], d[1], d[2], d[3]}; }
    const char* kb[4];
#pragma unroll
    for (int dd = 0; dd < 4; ++dd) kb[dd] = K_lds + KB * SHM_K + KSWZ(r32, (dd * 16 + hi * 8) * 2);
#pragma unroll
    for (int d0 = 0; d0 < 8; ++d0) { const char* a = kb[d0 & 3] + (d0 >> 2) * 128;
        bf16x8 b0 = *reinterpret_cast<const bf16x8*>(a);
        bf16x8 b1 = *reinterpret_cast<const bf16x8*>(a + 32 * 256);
        p0 = __builtin_amdgcn_mfma_f32_32x32x16_bf16(b0, qr[d0], p0, 0, 0, 0);
        p1 = __builtin_amdgcn_mfma_f32_32x32x16_bf16(b1, qr[d0], p1, 0, 0, 0); }
}
template <int KB>
__device__ __forceinline__ void qkt0(f32x16& p0, f32x16& p1, const char* K_lds, int r32, int hi, const bf16x8* qr) {
    p0 = f32x16{}; p1 = f32x16{};
    const char* kb[4];
#pragma unroll
    for (int dd = 0; dd < 4; ++dd) kb[dd] = K_lds + KB * SHM_K + KSWZ(r32, (dd * 16 + hi * 8) * 2);
#pragma unroll
    for (int d0 = 0; d0 < 8; ++d0) { const char* a = kb[d0 & 3] + (d0 >> 2) * 128;
        bf16x8 b0 = *reinterpret_cast<const bf16x8*>(a);
        bf16x8 b1 = *reinterpret_cast<const bf16x8*>(a + 32 * 256);
        p0 = __builtin_amdgcn_mfma_f32_32x32x16_bf16(b0, qr[d0], p0, 0, 0, 0);
        p1 = __builtin_amdgcn_mfma_f32_32x32x16_bf16(b1, qr[d0], p1, 0, 0, 0); }
}
template <int VB>
__device__ __forceinline__ void pv_tile(f32x16* o, int vb0, bf16x8 pa0, bf16x8 pa1, bf16x8 pa2, bf16x8 pa3) {
#define TRRD(dst, off) asm volatile("ds_read_b64_tr_b16 %0, %1 offset:%2" : "=&v"(dst) : "v"(vb0), "i"(off) : "memory")
#define PV_D0(d0) do { s16x4 l0, l1, l2, l3, h0, h1, h2_, h3; constexpr int b_ = VB * SHM_V + v_rd_off(d0, 0, 0); \
        TRRD(l0, b_); TRRD(h0, b_ + 2048); TRRD(l1, b_ + 4096); TRRD(h1, b_ + 6144); TRRD(l2, b_ + 8192); TRRD(h2_, b_ + 10240); TRRD(l3, b_ + 12288); TRRD(h3, b_ + 14336); \
        asm volatile("s_waitcnt lgkmcnt(0)" ::: "memory"); SBAR();   \
        o[d0] = __builtin_amdgcn_mfma_f32_32x32x16_bf16(pa0, (bf16x8){l0[0], l0[1], l0[2], l0[3], h0[0], h0[1], h0[2], h0[3]}, o[d0], 0, 0, 0);   \
        o[d0] = __builtin_amdgcn_mfma_f32_32x32x16_bf16(pa1, (bf16x8){l1[0], l1[1], l1[2], l1[3], h1[0], h1[1], h1[2], h1[3]}, o[d0], 0, 0, 0);   \
        o[d0] = __builtin_amdgcn_mfma_f32_32x32x16_bf16(pa2, (bf16x8){l2[0], l2[1], l2[2], l2[3], h2_[0], h2_[1], h2_[2], h2_[3]}, o[d0], 0, 0, 0);   \
        o[d0] = __builtin_amdgcn_mfma_f32_32x32x16_bf16(pa3, (bf16x8){l3[0], l3[1], l3[2], l3[3], h3[0], h3[1], h3[2], h3[3]}, o[d0], 0, 0, 0); } while (0)
    PV_D0(0); PV_D0(1); PV_D0(2); PV_D0(3);
#undef PV_D0
#undef TRRD
}

struct BlockRef { const GAS bf16_t* Q; const GAS bf16_t* K; const GAS bf16_t* V; GAS bf16_t* O; const GAS float* qss; const GAS float* kss; const GAS float* cc; const GAS float* gg;
                  int P0, skv; };
constexpr int LDQ = 5120, LDK = 5120, LDO = 2048, LDSS = 112;
struct Seam { bf16x8 qr[8]; bf16x8 st_v0, st_v1, st_k0, st_k1; int jlo; };
#define ROWK(p, k0, rr) ((p) + (size_t)((k0) + (rr)) * LDK + sc)
#define VMW() asm volatile("s_waitcnt vmcnt(0)" ::: "memory")
#define VMWN(n) asm volatile("s_waitcnt vmcnt(%0)" :: "i"(n) : "memory")
#define SLOAD_H(Kp, Vp, k0) do { S.st_v0 = load8(ROWK(Vp, k0, sr)); S.st_v1 = load8(ROWK(Vp, k0, 32 + sr));              \
                         S.st_k0 = load8(ROWK(Kp, k0, sr)); S.st_k1 = load8(ROWK(Kp, k0, 32 + sr)); } while (0)
#define SWRITE_HK(bf, k0) do { *(bf16x8*)(K_lds + (bf) * SHM_K + kws) = scale8(S.st_k0, ksr[(k0)]); *(bf16x8*)(K_lds + (bf) * SHM_K + kws + 32 * 256) = scale8(S.st_k1, ksr[(k0) + 32]); } while (0)
#define SWRITE_HV(bf) do { *(bf16x8*)(V_lds + (bf) * SHM_V + vst0) = S.st_v0; *(bf16x8*)(V_lds + (bf) * SHM_V + vst1) = S.st_v1; } while (0)
#define SWRITE_H(bf, k0) do { SWRITE_HV(bf); SWRITE_HK(bf, k0); } while (0)

__device__ __forceinline__ void attn_prime(const BlockRef& cur, char* lds, Seam& S, const int tid) {
    const int wid = __builtin_amdgcn_readfirstlane(tid >> 6), lane = tid & 63, r32 = lane & 31, hi = lane >> 5;
    const int sr = tid >> 4, sc = (tid & 15) * 8, kws = KSWZ(sr, sc * 2); char* K_lds = lds + 2 * SHM_V;
    float* ks_l = (float*)(lds + OFF_KS); float* bs_l = (float*)(lds + OFF_BS); const float* ksr = ks_l + sr;
    int j_hi = (cur.P0 + QB - 1) / KVBLK + 1; if (j_hi > cur.skv / KVBLK) j_hi = cur.skv / KVBLK;
    const int nkeys = j_hi * KVBLK;
    const float c0 = cur.cc ? cur.cc[cur.P0] : 0.f;
    int jlo = 0;
    if (cur.cc) { const float thr = cur.gg[128]; const int jd = cur.P0 / KVBLK;
        const float cv = lane <= jd ? cur.cc[lane * KVBLK + KVBLK - 1] : 0.f;
        const bool keep = lane > jd || (c0 - cv > -thr);
        jlo = __ffsll((long long)__ballot(keep)) - 1; }
    S.jlo = jlo;
    for (int s = jlo * KVBLK + tid; s < nkeys; s += NTHREADS) {
        const f32x4 p = *(const GAS f32x4*)(cur.kss + (size_t)s * LDSS);
        ks_l[s] = rsqrtf(((p[0] + p[1]) + (p[2] + p[3])) * (1.f / 128.f) + EPS);
        bs_l[s] = cur.cc ? (c0 - cur.cc[s]) * (1.f / SCALE) : 0.f;
    }
    __syncthreads();
    const int qrow = wid * QBLK + r32;
    const f32x4 qp = *(const GAS f32x4*)(cur.qss + (size_t)qrow * LDSS);
    const float rq = rsqrtf(((qp[0] + qp[1]) + (qp[2] + qp[3])) * (1.f / 128.f) + EPS);
#pragma unroll
    for (int d0 = 0; d0 < 8; ++d0) {
        const u32x4 w = *(const GAS u32x4*)(cur.Q + (size_t)qrow * LDQ + d0 * 16 + hi * 8);
        const f32x4 g0 = *(const GAS f32x4*)(cur.gg + d0 * 16 + hi * 8), g1 = *(const GAS f32x4*)(cur.gg + d0 * 16 + hi * 8 + 4);
        u32x4 o; o.x = cvtpk(bf_lo(w.x) * rq * g0[0], bf_hi(w.x) * rq * g0[1]); o.y = cvtpk(bf_lo(w.y) * rq * g0[2], bf_hi(w.y) * rq * g0[3]);
        o.z = cvtpk(bf_lo(w.z) * rq * g1[0], bf_hi(w.z) * rq * g1[1]); o.w = cvtpk(bf_lo(w.w) * rq * g1[2], bf_hi(w.w) * rq * g1[3]);
        S.qr[d0] = *reinterpret_cast<bf16x8*>(&o);
    }
    SLOAD_H(cur.K, cur.V, jlo * KVBLK); VMW(); SWRITE_HK(0, jlo * KVBLK);
    __syncthreads();
}
__device__ __forceinline__ void attn_block(const BlockRef& cur, char* lds, Seam& S, const int tid) {
    const int wid = __builtin_amdgcn_readfirstlane(tid >> 6), lane = tid & 63, r32 = lane & 31, hi = lane >> 5;
    const int W = WBIG;
    int j_hi = (cur.P0 + QB - 1) / KVBLK + 1; if (j_hi > cur.skv / KVBLK) j_hi = cur.skv / KVBLK;
    const int j_lo = S.jlo; const int NT = j_hi - j_lo;
    const int qlo = cur.P0 - j_lo * KVBLK + wid * QBLK, qm = qlo + r32 - 4 * hi;
    char* V_lds = lds; char* K_lds = lds + 2 * SHM_V;
    float* ws = (float*)(lds + OFF_WS) + wid * 64; float* li_l = ws, * al_l = ws + 32;
    const float* bs_l = (const float*)(lds + OFF_BS) + j_lo * KVBLK + 4 * hi;
    float m_reg = -1e30f, l_reg = 0; f32x16 o[4] = {};
    const int sr = tid >> 4, sc = (tid & 15) * 8, vst0 = v_st(sr, sc), vst1 = v_st(32 + sr, sc), kws = KSWZ(sr, sc * 2);
    const float* ksr = (const float*)(lds + OFF_KS) + j_lo * KVBLK + sr;
    const int vb0 = (int)(uintptr_t)V_lds + v_rd_base(lane);
    const GAS bf16_t* Kh = cur.K + (size_t)j_lo * KVBLK * LDK; const GAS bf16_t* Vh = cur.V + (size_t)j_lo * KVBLK * LDK;
#define RESC(a) do { if (__any((a) < 1.f)) { if (hi == 0) al_l[r32] = (a); asm volatile("s_waitcnt lgkmcnt(0)" ::: "memory");              \
                     for (int d_ = 0; d_ < 4; ++d_) for (int r = 0; r < 16; ++r) o[d_][r] *= al_l[crow(r, hi)]; } } while (0)
#define KBASE(t) ((t) * KVBLK)
#define MASKT(P0_, P1_, t) do { const int kb_ = KBASE(t); if (kb_ + KVBLK - 1 > qlo) mask_tile(P0_, P1_, qm - kb_, (unsigned)W); } while (0)
    f32x16 pA0, pA1, pB0, pB1; float mnA, mnB, alA, alB; bf16x8 pa0, pa1, pa2, pa3;
    SWRITE_HV(0); SBAR();
    if (NT > 1) { SLOAD_H(Kh, Vh, KBASE(1)); }
    SBAR(); qkt<0>(pA0, pA1, K_lds, r32, hi, S.qr, bs_l + KBASE(0));
    MASKT(pA0, pA1, 0); partialSM(pA0, pA1, m_reg, mnA, alA);
    if (NT > 1) { VMW(); SWRITE_H(1, KBASE(1)); }
    __syncthreads();
#define HALF_STEP(PX0, PX1, mnX, alX, PY0, PY1, alY, t, KB, VB, SB) do {                                                      \
        SBAR(); qkt<KB>(PX0, PX1, K_lds, r32, hi, S.qr, bs_l + KBASE(t));                                                         \
        finishSM(PY0, PY1, alY, l_reg, pa0, pa1, pa2, pa3); SBAR();                                                           \
        if ((t) + 1 < NT) { SLOAD_H(Kh, Vh, KBASE((t) + 1)); SBAR(); }                                               \
        pv_tile<VB>(o, vb0, pa0, pa1, pa2, pa3); MASKT(PX0, PX1, (t)); partialSM(PX0, PX1, m_reg, mnX, alX);                                        \
        __syncthreads();                                                                                                      \
        if ((t) + 1 < NT) { VMW(); SWRITE_H(SB, KBASE((t) + 1)); }                                                                          \
        RESC(alX); __syncthreads(); } while (0)
    for (int t = 1; t + 1 < NT; t += 2) {
        HALF_STEP(pB0, pB1, mnB, alB, pA0, pA1, alA, t, 1, 0, 0);
        HALF_STEP(pA0, pA1, mnA, alA, pB0, pB1, alB, t + 1, 0, 1, 1);
    }
    const bool even = (NT & 1) == 0;
    if (even) { SBAR(); qkt<1>(pB0, pB1, K_lds, r32, hi, S.qr, bs_l + KBASE(NT - 1)); SBAR(); }
    finishSM(pA0, pA1, alA, l_reg, pa0, pa1, pa2, pa3); SBAR();
    pv_tile<0>(o, vb0, pa0, pa1, pa2, pa3);
    if (even) { MASKT(pB0, pB1, NT - 1); partialSM(pB0, pB1, m_reg, mnB, alB); __syncthreads(); RESC(alB);
        finishSM(pB0, pB1, alB, l_reg, pa0, pa1, pa2, pa3); SBAR(); pv_tile<1>(o, vb0, pa0, pa1, pa2, pa3); }
    SBAR();
    if (hi == 0) li_l[r32] = l_reg; asm volatile("s_waitcnt lgkmcnt(0)" ::: "memory");
    float rli[16];
#pragma unroll
    for (int r = 0; r < 16; ++r) rli[r] = __builtin_amdgcn_rcpf(li_l[crow(r, hi)]);
    GAS bf16_t* Ow = cur.O + (size_t)(wid * QBLK) * LDO;
#pragma unroll
    for (int r = 0; r < 16; ++r) { const int orow = crow(r, hi);
#pragma unroll
        for (int d0 = 0; d0 < 4; ++d0) { const float v = o[d0][r] * rli[r];
            const float vn = dppf<0xB1>(v);
            if ((r32 & 1) == 0) *(GAS unsigned*)(Ow + (size_t)orow * LDO + d0 * 32 + r32) = cvtpk(v, vn); } }
    __syncthreads();
#undef RESC
#undef KBASE
#undef MASKT
#undef HALF_STEP
}
constexpr int MOFF_K = 4 * SHM_V, MOFF_WS = MOFF_K + 4 * SHM_K, MOFF_KS = MOFF_WS + 2048;
__device__ __forceinline__ void mem_attn_unit(const BlockRef& cur, char* lds, const int tid) {
    const int wid = __builtin_amdgcn_readfirstlane(tid >> 6), lane = tid & 63, r32 = lane & 31, hi = lane >> 5;
    const int sr = tid >> 4, sc = (tid & 15) * 8, kws = KSWZ(sr, sc * 2), vst0 = v_st(sr, sc), vst1 = v_st(32 + sr, sc);
    char* V_lds = lds; char* K_lds = lds + MOFF_K; float* ks_l = (float*)(lds + MOFF_KS);
    float* ws = (float*)(lds + MOFF_WS) + wid * 64; float* li_l = ws, * al_l = ws + 32;
    float ksv = 0.f;
    if (tid < 256) { const f32x4 p = *(const GAS f32x4*)(cur.kss + (size_t)tid * LDSS); ksv = rsqrtf(((p[0] + p[1]) + (p[2] + p[3])) * (1.f / 128.f) + EPS); }
    bf16x8 kk[4][2], vv[4][2];
#pragma unroll
    for (int t = 0; t < 4; ++t) { kk[t][0] = load8(ROWK(cur.K, t * KVBLK, sr)); kk[t][1] = load8(ROWK(cur.K, t * KVBLK, 32 + sr)); vv[t][0] = load8(ROWK(cur.V, t * KVBLK, sr)); vv[t][1] = load8(ROWK(cur.V, t * KVBLK, 32 + sr)); }
    const int qrow = wid * QBLK + r32;
    const f32x4 qp = *(const GAS f32x4*)(cur.qss + (size_t)qrow * LDSS);
    u32x4 qw[8];
#pragma unroll
    for (int d0 = 0; d0 < 8; ++d0) qw[d0] = *(const GAS u32x4*)(cur.Q + (size_t)qrow * LDQ + d0 * 16 + hi * 8);
    if (tid < 256) ks_l[tid] = ksv;
    __syncthreads();
#pragma unroll
    for (int t = 0; t < 4; ++t) { *(bf16x8*)(K_lds + t * SHM_K + kws) = scale8(kk[t][0], ks_l[t * KVBLK + sr]); *(bf16x8*)(K_lds + t * SHM_K + kws + 32 * 256) = scale8(kk[t][1], ks_l[t * KVBLK + 32 + sr]);
        *(bf16x8*)(V_lds + t * SHM_V + vst0) = vv[t][0]; *(bf16x8*)(V_lds + t * SHM_V + vst1) = vv[t][1]; }
    const float rq = rsqrtf(((qp[0] + qp[1]) + (qp[2] + qp[3])) * (1.f / 128.f) + EPS);
    bf16x8 qr[8];
#pragma unroll
    for (int d0 = 0; d0 < 8; ++d0) { const u32x4 w = qw[d0];
        const f32x4 g0 = *(const GAS f32x4*)(cur.gg + d0 * 16 + hi * 8), g1 = *(const GAS f32x4*)(cur.gg + d0 * 16 + hi * 8 + 4);
        u32x4 o; o.x = cvtpk(bf_lo(w.x) * rq * g0[0], bf_hi(w.x) * rq * g0[1]); o.y = cvtpk(bf_lo(w.y) * rq * g0[2], bf_hi(w.y) * rq * g0[3]);
        o.z = cvtpk(bf_lo(w.z) * rq * g1[0], bf_hi(w.z) * rq * g1[1]); o.w = cvtpk(bf_lo(w.w) * rq * g1[2], bf_hi(w.w) * rq * g1[3]);
        qr[d0] = *reinterpret_cast<bf16x8*>(&o); }
    __syncthreads();
    const int vb0 = (int)(uintptr_t)V_lds + v_rd_base(lane);
    float m_reg = -1e30f, l_reg = 0; f32x16 o[4] = {};
#define MEM_TILE(t) do { f32x16 p0, p1; float mn, al; bf16x8 pa0, pa1, pa2, pa3; \
        qkt0<t>(p0, p1, K_lds, r32, hi, qr); partialSM(p0, p1, m_reg, mn, al); \
        if (__any(al < 1.f)) { if (hi == 0) al_l[r32] = al; asm volatile("s_waitcnt lgkmcnt(0)" ::: "memory"); for (int d_ = 0; d_ < 4; ++d_) for (int r = 0; r < 16; ++r) o[d_][r] *= al_l[crow(r, hi)]; } \
        finishSM(p0, p1, al, l_reg, pa0, pa1, pa2, pa3); SBAR(); pv_tile<t>(o, vb0, pa0, pa1, pa2, pa3); SBAR(); } while (0)
    MEM_TILE(0); MEM_TILE(1); MEM_TILE(2); MEM_TILE(3);
#undef MEM_TILE
    if (hi == 0) li_l[r32] = l_reg; asm volatile("s_waitcnt lgkmcnt(0)" ::: "memory");
    float rli[16];
#pragma unroll
    for (int r = 0; r < 16; ++r) rli[r] = __builtin_amdgcn_rcpf(li_l[crow(r, hi)]);
    GAS bf16_t* Ow = cur.O + (size_t)(wid * QBLK) * LDO;
#pragma unroll
    for (int r = 0; r < 16; ++r) { const int orow = crow(r, hi);
#pragma unroll
        for (int d0 = 0; d0 < 4; ++d0) { const float v = o[d0][r] * rli[r];
            const float vn = dppf<0xB1>(v);
            if ((r32 & 1) == 0) *(GAS unsigned*)(Ow + (size_t)orow * LDO + d0 * 32 + r32) = cvtpk(v, vn); } }
    __syncthreads();
}
#undef ROWK
#undef VMW
#undef VMWN
#undef SLOAD_H
#undef SWRITE_HK
#undef SWRITE_HV
#undef SWRITE_H
#undef KSWZ
#undef SBAR
}


struct Frame {
    GAS unsigned char* ws; const float* const* in_; GAS float* out;
    __device__ __forceinline__ const GAS float* in(int i) const { return (const GAS float*)in_[i]; }
    int tid, lane, wave, gw, ngw, gtid, ngt;
};
enum { I_X = 0, I_MEM, I_ANORM, I_AWIN, I_ACONVW, I_ACONVB, I_AGATEW, I_AGATEB, I_ALAMBDA, I_AWOUT, I_SNORM, I_SWKVF, I_SBF, I_SKNORM, I_BNORM, I_BWIN, I_BQNORM, I_BWOUT,
       I_MNORM, I_MWKV, I_MQNORM, I_MKNORM, I_PNORM, I_PWQ, I_PSUBK, I_PU, I_PV, N_IN };

struct TrItem { const GAS float* W; const GAS float* gain; GAS bf16_t* WT; int ldw, ldt, row_off, k0, n0; };
__device__ __forceinline__ void tr_load(const TrItem& d, float (&wv)[32], int lane) {
#pragma unroll
    for (int i = 0; i < 32; ++i) wv[i] = __builtin_nontemporal_load(d.W + (size_t)(d.k0 + 2 * i + (lane >> 5)) * d.ldw + d.n0 + (lane & 31));
}
__device__ __forceinline__ void tr_proc(const TrItem& d, float (&wv)[32], LAS float* scr, int lane) {
    if (d.gain) {
#pragma unroll
        for (int i = 0; i < 32; ++i) wv[i] *= d.gain[d.k0 + 2 * i + (lane >> 5)]; }
#pragma unroll
    for (int i = 0; i < 32; ++i) scr[(2 * i + (lane >> 5)) * 33 + (lane & 31)] = wv[i];
    asm volatile("s_waitcnt lgkmcnt(0)" ::: "memory");
    const int c = lane & 7;
#pragma unroll
    for (int j = 0; j < 4; ++j) { const int n = (lane >> 3) + 8 * j; const LAS float* s = scr + (8 * c) * 33 + n;
        u32x4 o; o.x = cvtpk(s[0 * 33], s[1 * 33]); o.y = cvtpk(s[2 * 33], s[3 * 33]); o.z = cvtpk(s[4 * 33], s[5 * 33]); o.w = cvtpk(s[6 * 33], s[7 * 33]);
        *(GAS u32x4*)(d.WT + (size_t)(d.row_off + d.n0 + n) * d.ldt + d.k0 + 8 * c) = o; }
    asm volatile("s_waitcnt lgkmcnt(0)" ::: "memory");
}
__device__ __forceinline__ void transpose_item_fp8(const GAS float* W, int ldw, const GAS float* gain, GAS unsigned char* WT, int ldt, LAS float* scr, int nblk, int item, int lane) {
    const int kb = item / nblk, nb = item % nblk, k0 = 64 * kb, n0 = 32 * nb;
    float wv[32];
#pragma unroll
    for (int i = 0; i < 32; ++i) wv[i] = W[(size_t)(k0 + 2 * i + (lane >> 5)) * ldw + n0 + (lane & 31)];
#pragma unroll
    for (int i = 0; i < 32; ++i) wv[i] *= gain[k0 + 2 * i + (lane >> 5)] * 64.f;
#pragma unroll
    for (int i = 0; i < 32; ++i) scr[(2 * i + (lane >> 5)) * 33 + (lane & 31)] = wv[i];
    asm volatile("s_waitcnt lgkmcnt(0)" ::: "memory");
    const int c = lane & 3;
#pragma unroll
    for (int j = 0; j < 2; ++j) { const int n = (lane >> 2) + 16 * j; const LAS float* sp = scr + (16 * c) * 33 + n; u32x4 o;
#pragma unroll
        for (int w = 0; w < 4; ++w) { int pk = __builtin_amdgcn_cvt_pk_fp8_f32(sp[(4 * w) * 33], sp[(4 * w + 1) * 33], 0, false); pk = __builtin_amdgcn_cvt_pk_fp8_f32(sp[(4 * w + 2) * 33], sp[(4 * w + 3) * 33], pk, true); o[w] = (unsigned)pk; }
        *(GAS u32x4*)(WT + (size_t)(n0 + n) * ldt + k0 + 16 * c) = o; }
    asm volatile("s_waitcnt lgkmcnt(0)" ::: "memory");
}
struct CtRow { f32x4 v[8]; GAS unsigned char* dst; int row, which; };
__device__ __forceinline__ void ct_load(Frame& F, int layer, int it, CtRow& R) {
    R.which = it & 1; R.row = it >> 1;
    const GAS float* src = F.in(R.which ? I_PV : I_PU) + ((size_t)layer * NEXP + R.row) * DM + F.lane * 4;
    R.dst = F.ws + O_TAB + (size_t)(layer * 2 + R.which) * TAB_ONE;
#pragma unroll
    for (int c = 0; c < 8; ++c) R.v[c] = __builtin_nontemporal_load((const GAS f32x4*)(src + c * 256));
}
__device__ __forceinline__ void ct_proc(Frame& F, int layer, CtRow& R) {
    const GAS float* gn = F.in(I_PNORM) + layer * DM + F.lane * 4;
    _Float16 shv = (_Float16)0.f;
#pragma unroll
    for (int c = 0; c < 8; ++c) { f32x4 x = R.v[c]; if (!R.which) x = x * *(const GAS f32x4*)(gn + c * 256);
        float amax = fmaxf(fmaxf(fabsf(x[0]), fabsf(x[1])), fmaxf(fabsf(x[2]), fabsf(x[3])));
        amax = wave_max(amax);
        const _Float16 sh = (_Float16)fmaxf(amax * (1.f / 6.f), 1e-6f);
        const float qs = __builtin_amdgcn_rcpf((float)sh);
        unsigned pk = __builtin_amdgcn_cvt_scalef32_pk_fp4_f32(0u, x[0] * qs, x[1] * qs, 1.0f, 0); pk = __builtin_amdgcn_cvt_scalef32_pk_fp4_f32(pk, x[2] * qs, x[3] * qs, 1.0f, 1);
        *(GAS unsigned short*)(R.dst + ((size_t)c * NEXP + R.row) * 128 + F.lane * 2) = (unsigned short)pk;
        shv = (F.lane == c) ? sh : shv; }
    if (F.lane < 8) *(GAS unsigned short*)(R.dst + TAB_NIB + ((size_t)R.row * 8 + F.lane) * 2) = __builtin_bit_cast(unsigned short, shv);
}
__device__ __forceinline__ void convert_tables(Frame& F, int layer, int ibeg, int iend, int wk, int nwk) {
    if (ibeg + wk >= iend) return;
    const int ilast = ibeg + wk + ((iend - 1 - ibeg - wk) / nwk) * nwk;
    CtRow A, B;
    ct_load(F, layer, ibeg + wk, A);
    for (int it = ibeg + wk; it < iend; it += 2 * nwk) {
        ct_load(F, layer, it + nwk <= ilast ? it + nwk : ilast, B);
        ct_proc(F, layer, A);
        ct_load(F, layer, it + 2 * nwk <= ilast ? it + 2 * nwk : ilast, A);
        if (it + nwk < iend) ct_proc(F, layer, B);
    }
}
__device__ __forceinline__ void norm_row_bf16(const GAS float* xrow, const GAS float* gain, GAS bf16_t* orow, int lane) {
    f32x4 v[8]; float s = 0.f;
#pragma unroll
    for (int j = 0; j < 8; ++j) { v[j] = *(const GAS f32x4*)(xrow + j * 256 + lane * 4); s += (v[j][0] * v[j][0] + v[j][1] * v[j][1]) + (v[j][2] * v[j][2] + v[j][3] * v[j][3]); }
    const float r = rsqrtf(wave_sum(s) * (1.f / DM) + EPS);
#pragma unroll
    for (int j = 0; j < 8; ++j) { f32x4 g = gain ? *(const GAS f32x4*)(gain + j * 256 + lane * 4) : (f32x4){1.f, 1.f, 1.f, 1.f};
        u32x2 o; o.x = cvtpk(v[j][0] * r * g[0], v[j][1] * r * g[1]); o.y = cvtpk(v[j][2] * r * g[2], v[j][3] * r * g[3]);
        *(GAS u32x2*)(orow + j * 256 + lane * 4) = o; }
}
__device__ __forceinline__ void step_prologue(Frame& F, LAS unsigned char* lds) {
    LAS float* scr = (LAS float*)(lds + F.wave * 16384);
    GAS unsigned char* ws = F.ws;
    constexpr int I0 = 32 * (NIN0 / 32), I1 = 32 * 64, I2 = 32 * 96, I3 = 32 * 64, I4 = 32 * 64, I5 = 32 * 64, I6 = 32 * 64, I7 = 32 * 32, I8 = 32 * 32, I9 = 12 * 16;
    constexpr int NITEMS = I0 + I1 + I2 + I3 + I4 + I5 + I6 + I7 + I8 + I9;
#define TR_DESC(D, it_) do { int r = (it_) < NITEMS ? (it_) : NITEMS - 1; int nblk; \
        if (r < I0) { D = {F.in(I_AWIN), F.in(I_ANORM), (GAS bf16_t*)(ws + O_WIN0), NIN0, DM, 0, 0, 0}; nblk = NIN0 / 32; } else { r -= I0; \
        if (r < I1) { D = {F.in(I_AWOUT), nullptr, (GAS bf16_t*)(ws + O_WOUT0), DM, DM, 0, 0, 0}; nblk = 64; } else { r -= I1; \
        if (r < I2) { D = {F.in(I_SWKVF), F.in(I_SNORM), (GAS bf16_t*)(ws + O_WL1), 3084, DM, 0, 0, 0}; nblk = 96; } else { r -= I2; \
        if (r < I3) { D = {F.in(I_BWIN), F.in(I_BNORM), (GAS bf16_t*)(ws + O_WL1), DM, DM, 3072, 0, 0}; nblk = 64; } else { r -= I3; \
        if (r < I4) { D = {F.in(I_BWOUT), nullptr, (GAS bf16_t*)(ws + O_WOUT1), DM, DM, 0, 0, 0}; nblk = 64; } else { r -= I4; \
        if (r < I5) { D = {F.in(I_PWQ), F.in(I_PNORM), (GAS bf16_t*)(ws + O_WQ0), DM, DM, 0, 0, 0}; nblk = 64; } else { r -= I5; \
        if (r < I6) { D = {F.in(I_PWQ) + (size_t)DM * DM, F.in(I_PNORM) + DM, (GAS bf16_t*)(ws + O_WQ1), DM, DM, 0, 0, 0}; nblk = 64; } else { r -= I6; \
        if (r < I7) { D = {F.in(I_MWKV), nullptr, (GAS bf16_t*)(ws + O_WMKV), 1024, DM, 0, 0, 0}; nblk = 32; } else { r -= I7; \
        if (r < I8) { D = {F.in(I_MWKV) + (size_t)DM * 1024, nullptr, (GAS bf16_t*)(ws + O_WMKV) + (size_t)1024 * DM, 1024, DM, 0, 0, 0}; nblk = 32; } else { r -= I8; \
          const int blk = r / 16; r = r % 16; D = {F.in(I_AGATEW) + (size_t)blk * 128 * 256, nullptr, (GAS bf16_t*)(ws + O_WGATE), 256, 128, blk * 256, 0, 0}; nblk = 8; } } } } } } } } } \
        D.k0 = 64 * (r / nblk); D.n0 = 32 * (r % nblk); } while (0)
    for (int it = F.gw; it < NITEMS; it += F.ngw) { float wv[32]; TrItem d; TR_DESC(d, it); tr_load(d, wv, F.lane); tr_proc(d, wv, scr, F.lane); }
#undef TR_DESC
    { const GAS float* sk = F.in(I_PSUBK); GAS bf16_t* o = (GAS bf16_t*)(ws + O_SUBK);
      for (int i = F.gtid; i < 2 * 16 * 128 * 128 / 2; i += F.ngt) *(GAS unsigned*)(o + 2 * i) = cvtpk(sk[2 * i], sk[2 * i + 1]); }
    { GAS float* wf = (GAS float*)(ws + O_WF); const GAS float* w = F.in(I_SWKVF); const GAS float* g = F.in(I_SNORM);
      for (int i = F.gtid; i < 12 * DM; i += F.ngt) { const int j = i / DM, k = i % DM; wf[i] = w[(size_t)k * 3084 + 3072 + j] * g[k]; } }
    { GAS float* spl = (GAS float*)(ws + O_SPL); const GAS float* lam = F.in(I_ALAMBDA);
      for (int i = F.gtid; i < LRU; i += F.ngt) { const float z = -lam[i]; spl[i] = fmaxf(z, 0.f) + log1p_pos(fast_exp(-fabsf(z))); } }
    if (F.gw == 0) {
        float m = 0.f; for (int d = F.lane; d < 128; d += 64) m = fmaxf(m, fabsf(F.in(I_BQNORM)[d] * F.in(I_SKNORM)[d]));
        m = wave_max(m);
        if (F.lane == 0) ((GAS float*)(ws + O_GG))[512] = 2.f * 11.3137085f * m + 30.f; }
    { GAS float* gg = (GAS float*)(ws + O_GG);
      for (int i = F.gtid; i < 384; i += F.ngt) { const int a = i / 128, d = i % 128;
          gg[a == 0 ? 384 + d : i] = a == 0 ? F.in(I_BQNORM)[d] * F.in(I_SKNORM)[d] : F.in(I_MQNORM)[(a - 1) * 128 + d] * F.in(I_MKNORM)[(a - 1) * 128 + d]; } }
    {
        const GAS float* xin = F.in(I_X) + F.lane * 4; GAS bf16_t* xo = (GAS bf16_t*)(ws + O_XS16) + F.lane * 4;
        const int mlast = F.gw + ((T - 1 - F.gw) / F.ngw) * F.ngw;
#define XN_LOAD(V, m_) do { const int mm_ = (m_) <= mlast ? (m_) : mlast; _Pragma("unroll") for (int j = 0; j < 8; ++j) V[j] = __builtin_nontemporal_load((const GAS f32x4*)(xin + (size_t)mm_ * DM + j * 256)); } while (0)
#define XN_PROC(V, m_) do { if ((m_) < T) { float s0 = 0.f; _Pragma("unroll") for (int j = 0; j < 8; ++j) s0 += (V[j][0] * V[j][0] + V[j][1] * V[j][1]) + (V[j][2] * V[j][2] + V[j][3] * V[j][3]); \
            const float r0 = rsqrtf(wave_sum(s0) * (1.f / DM) + EPS); \
            _Pragma("unroll") for (int j = 0; j < 8; ++j) { u32x2 a; a.x = cvtpk(V[j][0] * r0, V[j][1] * r0); a.y = cvtpk(V[j][2] * r0, V[j][3] * r0); *(GAS u32x2*)(xo + (size_t)(m_) * DM + j * 256) = a; } } } while (0)
        f32x4 va[8], vb[8];
        XN_LOAD(va, F.gw);
        for (int m = F.gw; m < T; m += 2 * F.ngw) { XN_LOAD(vb, m + F.ngw); XN_PROC(va, m); XN_LOAD(va, m + 2 * F.ngw); XN_PROC(vb, m + F.ngw); }
#undef XN_LOAD
#undef XN_PROC
    }
    for (int m = F.gw; m < 2 * NMROW; m += F.ngw) { const int l = m / NMROW, r = m % NMROW;
        norm_row_bf16(F.in(I_MEM) + (size_t)r * DM, F.in(I_MNORM) + l * DM, (GAS bf16_t*)(ws + O_MEMN) + (size_t)m * DM, F.lane); }
    convert_tables(F, 0, 0, 2 * NEXP, F.gw, F.ngw);
}
__device__ __forceinline__ void step_conv(Frame& F) {
    const GAS bf16_t* zx = (const GAS bf16_t*)(F.ws + O_ZX); GAS bf16_t* xc = (GAS bf16_t*)(F.ws + O_XC);
    const GAS float* cw = F.in(I_ACONVW); const GAS float* cb = F.in(I_ACONVB);
    constexpr int NIT = T * (LRU / 8);
#define CV_LOAD(W, it_) do { const int ii_ = (it_) < NIT ? (it_) : NIT - 1; const int t_ = ii_ / (LRU / 8), c8_ = (ii_ % (LRU / 8)) * 8, pos_ = t_ & (SEQ - 1); \
        _Pragma("unroll") for (int k = 0; k < 4; ++k) W[k] = (pos_ - 3 + k >= 0) ? *(const GAS u32x4*)(zx + (size_t)(t_ - 3 + k) * LRU + c8_) : (u32x4){0u, 0u, 0u, 0u}; } while (0)
#define CV_PROC(W, it_) do { if ((it_) < NIT) { const int t_ = (it_) / (LRU / 8), c8_ = ((it_) % (LRU / 8)) * 8; float a[8]; \
        { const f32x4 b0 = *(const GAS f32x4*)(cb + c8_), b1 = *(const GAS f32x4*)(cb + c8_ + 4); a[0] = b0[0]; a[1] = b0[1]; a[2] = b0[2]; a[3] = b0[3]; a[4] = b1[0]; a[5] = b1[1]; a[6] = b1[2]; a[7] = b1[3]; } \
        _Pragma("unroll") for (int k = 0; k < 4; ++k) { const f32x4 w0 = *(const GAS f32x4*)(cw + k * LRU + c8_), w1 = *(const GAS f32x4*)(cw + k * LRU + c8_ + 4); \
            a[0] = fmaf(w0[0], bf_lo(W[k].x), a[0]); a[1] = fmaf(w0[1], bf_hi(W[k].x), a[1]); a[2] = fmaf(w0[2], bf_lo(W[k].y), a[2]); a[3] = fmaf(w0[3], bf_hi(W[k].y), a[3]); \
            a[4] = fmaf(w1[0], bf_lo(W[k].z), a[4]); a[5] = fmaf(w1[1], bf_hi(W[k].z), a[5]); a[6] = fmaf(w1[2], bf_lo(W[k].w), a[6]); a[7] = fmaf(w1[3], bf_hi(W[k].w), a[7]); } \
        u32x4 o; o.x = cvtpk(a[0], a[1]); o.y = cvtpk(a[2], a[3]); o.z = cvtpk(a[4], a[5]); o.w = cvtpk(a[6], a[7]); \
        *(GAS u32x4*)(xc + (size_t)t_ * LRU + c8_) = o; } } while (0)
    u32x4 wa[4], wb[4];
    CV_LOAD(wa, F.gtid);
    for (int it = F.gtid; it < NIT; it += 2 * F.ngt) { CV_LOAD(wb, it + F.ngt); CV_PROC(wa, it); CV_LOAD(wa, it + 2 * F.ngt); CV_PROC(wb, it + F.ngt); }
#undef CV_LOAD
#undef CV_PROC
}
constexpr int SCK = 32, NCK = SEQ / SCK;
typedef _Float16 h8_t __attribute__((ext_vector_type(8)));
__device__ __forceinline__ void scan_load(const GAS _Float16* LA, const GAS _Float16* UH, size_t off, float (&a)[8], float (&u)[8]) {
    const h8_t l = *(const GAS h8_t*)(LA + off), w = *(const GAS h8_t*)(UH + off);
#pragma unroll
    for (int k = 0; k < 8; ++k) { a[k] = fast_exp((float)l[k]); u[k] = (float)w[k]; }
}
__device__ __forceinline__ void step_scan1(Frame& F) {
    const GAS _Float16* LA = (const GAS _Float16*)(F.ws + O_AA); const GAS _Float16* UH = (const GAS _Float16*)(F.ws + O_UU);
    GAS float* CA = (GAS float*)(F.ws + O_LOGFP); GAS float* CH = CA + (size_t)NB * NCK * LRU;
    if (F.tid >= 384) return;
    const int grp = F.tid / 192, th = F.tid % 192;
    for (int it = blockIdx.x * 2 + grp; it < NB * NCK; it += gridDim.x * 2) {
        const int b = it / NCK, ck = it % NCK; const size_t base = ((size_t)b * SEQ + ck * SCK) * LRU + th * 8;
        float ap[8], h[8];
#pragma unroll
        for (int k = 0; k < 8; ++k) { ap[k] = 1.f; h[k] = 0.f; }
#pragma unroll 8
        for (int i = 0; i < SCK; ++i) { float a[8], u[8]; scan_load(LA, UH, base + (size_t)i * LRU, a, u);
#pragma unroll
            for (int k = 0; k < 8; ++k) { ap[k] *= a[k]; h[k] = a[k] * h[k] + u[k]; } }
        GAS float* ca = CA + (size_t)it * LRU + th * 8; GAS float* ch = CH + (size_t)it * LRU + th * 8;
        *(GAS f32x4*)ca = (f32x4){ap[0], ap[1], ap[2], ap[3]}; *(GAS f32x4*)(ca + 4) = (f32x4){ap[4], ap[5], ap[6], ap[7]};
        *(GAS f32x4*)ch = (f32x4){h[0], h[1], h[2], h[3]}; *(GAS f32x4*)(ch + 4) = (f32x4){h[4], h[5], h[6], h[7]};
    }
}
__device__ __forceinline__ void step_scan2(Frame& F) {
    const GAS _Float16* LA = (const GAS _Float16*)(F.ws + O_AA); const GAS _Float16* UH = (const GAS _Float16*)(F.ws + O_UU);
    const GAS float* CA = (const GAS float*)(F.ws + O_LOGFP); const GAS float* CH = CA + (size_t)NB * NCK * LRU;
    const GAS bf16_t* gy = (const GAS bf16_t*)(F.ws + O_GY); GAS bf16_t* cat = (GAS bf16_t*)(F.ws + O_CAT);
    if (F.tid >= 384) return;
    const int grp = F.tid / 192, th = F.tid % 192;
    for (int it = blockIdx.x * 2 + grp; it < NB * NCK; it += gridDim.x * 2) {
        const int b = it / NCK, ck = it % NCK; const size_t base = ((size_t)b * SEQ + ck * SCK) * LRU + th * 8;
        float h[8];
#pragma unroll
        for (int k = 0; k < 8; ++k) h[k] = 0.f;
        for (int k2 = 0; k2 < ck; ++k2) { const size_t o = (size_t)(b * NCK + k2) * LRU + th * 8;
            const f32x4 a0 = *(const GAS f32x4*)(CA + o), a1 = *(const GAS f32x4*)(CA + o + 4), c0 = *(const GAS f32x4*)(CH + o), c1 = *(const GAS f32x4*)(CH + o + 4);
#pragma unroll
            for (int k = 0; k < 4; ++k) { h[k] = a0[k] * h[k] + c0[k]; h[4 + k] = a1[k] * h[4 + k] + c1[k]; } }
#pragma unroll 8
        for (int i = 0; i < SCK; ++i) { float a[8], u[8]; scan_load(LA, UH, base + (size_t)i * LRU, a, u);
            const size_t row = (size_t)b * SEQ + ck * SCK + i;
            const u32x4 g = *(const GAS u32x4*)(gy + row * LRU + th * 8); u32x4 o;
#pragma unroll
            for (int k = 0; k < 8; ++k) h[k] = a[k] * h[k] + u[k];
#pragma unroll
            for (int k = 0; k < 4; ++k) o[k] = cvtpk(h[2 * k] * bf_lo(g[k]), h[2 * k + 1] * bf_hi(g[k]));
            *(GAS u32x4*)(cat + row * DM + th * 8) = o; }
    }
}
__device__ __forceinline__ void step_cprefix(Frame& F, LAS unsigned char* lds) {
    const GAS float* lf = (const GAS float*)(F.ws + O_LOGF); GAS float* cc = (GAS float*)(F.ws + O_CC);
    LAS double* scr = (LAS double*)(lds + F.wave * 16384);
    for (int it = F.gw; it < NB * NH; it += F.ngw) {
        const GAS float* p = lf + (size_t)it * SEQ + F.lane * 64; GAS float* q = cc + (size_t)it * SEQ + F.lane * 64;
        double s = 0.0;
        for (int i = 0; i < 64; ++i) s += (double)p[i];
        scr[F.lane] = s;
        asm volatile("s_waitcnt lgkmcnt(0)" ::: "memory");
        double run = 0.0;
        for (int l = 0; l < 64; ++l) { const double v = scr[l]; if (l < F.lane) run += v; }
        for (int i = 0; i < 64; ++i) { run += (double)p[i]; q[i] = (float)run; }
        asm volatile("s_waitcnt lgkmcnt(0)" ::: "memory");
    }
}

__device__ __forceinline__ int ord_i(float f) { const int b = __float_as_int(f); return b ^ ((b >> 31) & 0x7fffffff); }
__device__ __forceinline__ float unord_f(int k) { return __int_as_float(k ^ ((k >> 31) & 0x7fffffff)); }
template <int N> __device__ __forceinline__ void bitonic_sort_desc(int (&a)[N]) {
#pragma unroll
    for (int k = 2; k <= N; k <<= 1) {
#pragma unroll
        for (int j = k >> 1; j > 0; j >>= 1) {
#pragma unroll
            for (int i = 0; i < N; ++i) { const int l = i ^ j;
                if (l > i) { const bool desc = ((i & k) == 0); const int mx = max(a[i], a[l]), mn = min(a[i], a[l]); a[i] = desc ? mx : mn; a[l] = desc ? mn : mx; } }
        }
    }
}
__device__ __forceinline__ void bitonic_merge16_desc(int (&a)[16]) {
#pragma unroll
    for (int j = 8; j > 0; j >>= 1) {
#pragma unroll
        for (int i = 0; i < 16; ++i) { const int l = i ^ j; if (l > i) { const int mx = max(a[i], a[l]), mn = min(a[i], a[l]); a[i] = mx; a[l] = mn; } }
    }
}
__device__ __forceinline__ void top16_of_64(int (&a)[64]) {
    int g[4][16];
#pragma unroll
    for (int q = 0; q < 4; ++q) {
#pragma unroll
        for (int i = 0; i < 16; ++i) g[q][i] = a[16 * q + i];
        bitonic_sort_desc<16>(g[q]); }
#pragma unroll
    for (int i = 0; i < 16; ++i) { g[0][i] = max(g[0][i], g[1][15 - i]); g[2][i] = max(g[2][i], g[3][15 - i]); }
    bitonic_merge16_desc(g[0]); bitonic_merge16_desc(g[2]);
#pragma unroll
    for (int i = 0; i < 16; ++i) g[0][i] = max(g[0][i], g[2][15 - i]);
    bitonic_merge16_desc(g[0]);
#pragma unroll
    for (int i = 0; i < 16; ++i) a[i] = g[0][i];
}
constexpr float KOFF = 64.f;
__device__ __forceinline__ void top16_of_32(int (&a)[32]) {
    int g0[16], g1[16];
#pragma unroll
    for (int i = 0; i < 16; ++i) { g0[i] = a[i]; g1[i] = a[16 + i]; }
    bitonic_sort_desc<16>(g0); bitonic_sort_desc<16>(g1);
#pragma unroll
    for (int i = 0; i < 16; ++i) g0[i] = max(g0[i], g1[15 - i]);
    bitonic_merge16_desc(g0);
#pragma unroll
    for (int i = 0; i < 16; ++i) a[i] = g0[i];
}
__device__ __forceinline__ void subkey_top16(const GAS bf16_t* qrow  , const GAS bf16_t* sk  , int r32, int hi, int (&top)[16]) {
    bf16x8 qf[8];
#pragma unroll
    for (int ks = 0; ks < 8; ++ks) qf[ks] = *(const GAS bf16x8*)(qrow + ks * 16 + hi * 8);
    unsigned loff = (unsigned)(r32 * 128 + hi * 8) * 2u; asm volatile("" : "+v"(loff));
    int key[64];
#pragma unroll
    for (int kb = 0; kb < 4; ++kb) {
        f32x16 acc;
#pragma unroll
        for (int r = 0; r < 16; ++r) acc[r] = KOFF;
#pragma unroll
        for (int ks = 0; ks < 8; ++ks) { const bf16x8 af = *(const GAS bf16x8*)((const GAS char*)(sk + kb * 32 * 128 + ks * 16) + loff);
            acc = __builtin_amdgcn_mfma_f32_32x32x16_bf16(af, qf[ks], acc, 0, 0, 0); }
#pragma unroll
        for (int r = 0; r < 16; ++r) { const int id = kb * 32 + (r & 3) + 8 * (r >> 2) + 4 * hi; key[kb * 16 + r] = (__float_as_int(acc[r]) & ~127) | (127 - id); }
        __builtin_amdgcn_sched_barrier(0);
    }
    top16_of_64(key);
#pragma unroll
    for (int i = 0; i < 16; ++i) { auto r = __builtin_amdgcn_permlane32_swap((unsigned)key[15 - i], (unsigned)key[15 - i], false, false);
        const int pk = hi ? (int)r[0] : (int)r[1]; top[i] = max(key[i], pk); }
    bitonic_merge16_desc(top);
}
__device__ __forceinline__ void step_topk(Frame& F, LAS unsigned char* lds, int layer) {
    const GAS bf16_t* q16 = (const GAS bf16_t*)(F.ws + O_Q16); const GAS bf16_t* subk = (const GAS bf16_t*)(F.ws + O_SUBK) + (size_t)layer * 16 * 128 * 128;
    GAS int* IDX = (GAS int*)(F.ws + O_IDX); GAS float* GW = (GAS float*)(F.ws + O_GW);
    LAS int* scr = (LAS int*)(lds + F.wave * 16384) + F.lane * 33;
    const int r32 = F.lane & 31, hi = F.lane >> 5;
    for (int task = F.gw; task < (T / 32) * 8; task += F.ngw) {
        const int tb = task >> 3, h = task & 7; const int tok = tb * 32 + r32;
        const GAS bf16_t* qrow = q16 + (size_t)tok * DM + h * 256;
        int ta[16], tb16[16];
        subkey_top16(qrow, subk + (size_t)(h * 2 + 0) * 128 * 128, r32, hi, ta);
        subkey_top16(qrow + 128, subk + (size_t)(h * 2 + 1) * 128 * 128, r32, hi, tb16);
        float va[16], vb[16];
#pragma unroll
        for (int i = 0; i < 16; ++i) { va[i] = __int_as_float(ta[i] & ~127); vb[i] = __int_as_float(tb16[i] & ~127) - KOFF; scr[i] = 127 - (ta[i] & 127); scr[16 + i] = 127 - (tb16[i] & 127); }
        int c2[32]; int n = 0;
#pragma unroll
        for (int i = 0; i < 16; ++i)
#pragma unroll
            for (int j = 0; j < 16; ++j) if ((i + 1) * (j + 1) <= 16) { const int k = (__float_as_int(va[i] + vb[j]) & ~255) | (255 - (i * 16 + j));
                if ((n & 1) == 0) c2[n >> 1] = k; else c2[n >> 1] = hi ? k : c2[n >> 1];
                ++n; }
#pragma unroll
        for (int i = 25; i < 32; ++i) c2[i] = (int)0x80000000;
        top16_of_32(c2);
        { int mg[16];
#pragma unroll
          for (int i = 0; i < 16; ++i) { auto r = __builtin_amdgcn_permlane32_swap((unsigned)c2[15 - i], (unsigned)c2[15 - i], false, false);
              const int pk = hi ? (int)r[0] : (int)r[1]; mg[i] = max(c2[i], pk); }
          bitonic_merge16_desc(mg);
#pragma unroll
          for (int i = 0; i < 16; ++i) c2[i] = mg[i]; }
        asm volatile("s_waitcnt lgkmcnt(0)" ::: "memory");
        float sv[16], ex[16]; int ev[16]; float Z = 0.f;
#pragma unroll
        for (int r = 0; r < 16; ++r) { const int flat = 255 - (c2[r] & 255); sv[r] = __int_as_float(c2[r] & ~255); ev[r] = scr[flat >> 4] * 128 + scr[16 + (flat & 15)]; }
#pragma unroll
        for (int r = 0; r < 16; ++r) { ex[r] = fast_exp(sv[r] - sv[0]); Z += ex[r]; }
        const float iz = 1.f / Z;
        GAS int* ip = IDX + (size_t)tok * 128 + h * 16 + hi * 8; GAS float* gp = GW + (size_t)tok * 128 + h * 16 + hi * 8;
        int eo[8]; float go[8];
#pragma unroll
        for (int j = 0; j < 8; ++j) { eo[j] = hi ? ev[8 + j] : ev[j]; go[j] = (hi ? ex[8 + j] : ex[j]) * iz; }
        *(GAS u32x4*)ip = (u32x4){(unsigned)eo[0], (unsigned)eo[1], (unsigned)eo[2], (unsigned)eo[3]}; *(GAS u32x4*)(ip + 4) = (u32x4){(unsigned)eo[4], (unsigned)eo[5], (unsigned)eo[6], (unsigned)eo[7]};
        *(GAS f32x4*)gp = (f32x4){go[0], go[1], go[2], go[3]}; *(GAS f32x4*)(gp + 4) = (f32x4){go[4], go[5], go[6], go[7]};
        asm volatile("s_waitcnt lgkmcnt(0)" ::: "memory");
    }
}
__device__ __forceinline__ h2 as_h2(unsigned w) { return __builtin_bit_cast(h2, w); }
#define F4(W, s) __builtin_amdgcn_cvt_scalef32_pk_f16_fp4((W), 1.0f, (s))
#define H2F(us) ((float)__builtin_bit_cast(_Float16, (unsigned short)(us)))
__device__ __forceinline__ float sum8(float v) { v += dppf<0xB1>(v); v += dppf<0x4E>(v); v += dppf<0x141>(v); return v; }
__device__ __forceinline__ void step_upass(Frame& F, int layer, int G, LAS unsigned char* lds) {
    typedef pg8::v8i_t v8i_t;
    const int s = blockIdx.x & 7, wk = (blockIdx.x >> 3) * NWAVES + F.wave, nwk = (G >> 3) * NWAVES;
    const GAS unsigned char* UN = F.ws + O_TAB + (size_t)(layer * 2) * TAB_ONE + (size_t)s * NEXP * 128;
    const GAS int* IDX = (const GAS int*)(F.ws + O_IDX); const GAS bf16_t* xs = (const GAS bf16_t*)(F.ws + O_XS16) + s * 256;
    GAS _Float16* part = (GAS _Float16*)(F.ws + O_PART) + (size_t)s * T * 128;
    unsigned lo = (unsigned)F.lane; asm volatile("" : "+v"(lo));
    const unsigned j = lo >> 3, p = lo & 7, c = lo & 15, kq = lo >> 4;
    LAS unsigned char* img = lds + F.wave * 16384; LAS unsigned char* xrow = lds + 131072 + F.wave * 256;
    LAS unsigned char* wrp = img + j * 128 + ((p ^ j) << 4);
    const LAS unsigned char* rd0 = img + c * 128 + ((kq ^ (c & 7)) << 4);
    const LAS unsigned char* rd1 = img + c * 128 + (((4 + kq) ^ (c & 7)) << 4);
    const int tlast = wk + ((T - 1 - wk) / nwk) * nwk;
#define U_LOADID(ID, t_, q_) do { const int tt_ = (t_) <= tlast ? (t_) : tlast; _Pragma("unroll") for (int b = 0; b < 4; ++b) ID[b] = IDX[(size_t)tt_ * 128 + (q_) * 32 + 8 * b + j]; } while (0)
#define U_LOADX(t_) do { const int tt_ = (t_) <= tlast ? (t_) : tlast; xn = *(const GAS u32x2*)(xs + (size_t)tt_ * DM + lo * 4); } while (0)
    const __amdgpu_buffer_rsrc_t urs = __builtin_amdgcn_make_buffer_rsrc((void*)(unsigned char*)UN, 0, NEXP * 128, 0x00020000);
#define U_ISSUE(UB, ID) do { _Pragma("unroll") for (int b = 0; b < 4; ++b) UB[b] = __builtin_amdgcn_raw_buffer_load_b128(urs, ID[b] * 128 + (int)p * 16, 0, 16); } while (0)
#define U_WRITE(UB, q_) do { _Pragma("unroll") for (int b = 0; b < 4; ++b) *(LAS u32x4*)(wrp + (4 * (q_) + b) * 1024) = UB[b]; } while (0)
#define U_MM(g0) do { u32x4 a0[4], a1[4]; _Pragma("unroll") for (int g = 0; g < 4; ++g) { a0[g] = *(const LAS u32x4*)(rd0 + ((g0) + g) * 2048); a1[g] = *(const LAS u32x4*)(rd1 + ((g0) + g) * 2048); } \
        _Pragma("unroll") for (int g = 0; g < 4; ++g) { \
            f32x4 c_ = __builtin_amdgcn_mfma_scale_f32_16x16x128_f8f6f4((v8i_t){(int)a0[g].x, (int)a0[g].y, (int)a0[g].z, (int)a0[g].w, 0, 0, 0, 0}, bop0, zero4, 4, 0, 0, 127, 0, 127); \
            acc[(g0) + g] = __builtin_amdgcn_mfma_scale_f32_16x16x128_f8f6f4((v8i_t){(int)a1[g].x, (int)a1[g].y, (int)a1[g].z, (int)a1[g].w, 0, 0, 0, 0}, bop1, c_, 4, 0, 0, 127, 0, 127); } } while (0)
    int idA[4], idB[4]; u32x4 u0[4], u1[4], u2[4], u3[4]; u32x2 xc, xn;
    U_LOADID(idA, wk, 0); U_LOADID(idB, wk, 1); U_LOADX(wk);
    U_ISSUE(u0, idA); U_LOADID(idA, wk, 2);
    U_ISSUE(u1, idB); U_LOADID(idB, wk, 3);
    U_ISSUE(u2, idA); U_LOADID(idA, wk + nwk, 0);
    xc = xn;
    for (int t = wk; t < T; t += nwk) {
        U_ISSUE(u3, idB); U_LOADID(idB, t + nwk, 1); U_LOADX(t + nwk);
        const float x0 = bf_lo(xc.x), x1 = bf_hi(xc.x), x2 = bf_lo(xc.y), x3 = bf_hi(xc.y);
        const float amax = wave_max(fmaxf(fmaxf(fabsf(x0), fabsf(x1)), fmaxf(fabsf(x2), fabsf(x3))));
        const float sc = fmaxf(amax, 1e-20f) * (1.f / 448.f), qs = __builtin_amdgcn_rcpf(sc);
        { int pk = __builtin_amdgcn_cvt_pk_fp8_f32(x0 * qs, x1 * qs, 0, false); pk = __builtin_amdgcn_cvt_pk_fp8_f32(x2 * qs, x3 * qs, pk, true); *(LAS int*)(xrow + lo * 4) = pk; }
        U_WRITE(u0, 0);
        U_ISSUE(u0, idA); U_LOADID(idA, t + nwk, 2);
        U_WRITE(u1, 1);
        U_ISSUE(u1, idB); U_LOADID(idB, t + nwk, 3);
        U_WRITE(u2, 2);
        U_ISSUE(u2, idA); U_LOADID(idA, t + 2 * nwk, 0);
        U_WRITE(u3, 3);
        v8i_t bop0, bop1;
        { const u32x4 b00 = *(const LAS u32x4*)(xrow + kq * 16), b01 = *(const LAS u32x4*)(xrow + 64 + kq * 16), b10 = *(const LAS u32x4*)(xrow + 128 + kq * 16), b11 = *(const LAS u32x4*)(xrow + 192 + kq * 16);
          bop0 = (v8i_t){(int)b00.x, (int)b00.y, (int)b00.z, (int)b00.w, (int)b01.x, (int)b01.y, (int)b01.z, (int)b01.w};
          bop1 = (v8i_t){(int)b10.x, (int)b10.y, (int)b10.z, (int)b10.w, (int)b11.x, (int)b11.y, (int)b11.z, (int)b11.w}; }
        const f32x4 zero4 = {0.f, 0.f, 0.f, 0.f};
        f32x4 acc[8];
        U_MM(0); U_MM(4);
        f32x4 o = acc[0];
#pragma unroll
        for (int m = 1; m < 8; ++m) o = ((c & 7) == (unsigned)m) ? acc[m] : o;
        { const h2 o0 = {(_Float16)(o[0] * sc), (_Float16)(o[1] * sc)}, o1 = {(_Float16)(o[2] * sc), (_Float16)(o[3] * sc)};
          __builtin_nontemporal_store((u32x2){__builtin_bit_cast(unsigned, o0), __builtin_bit_cast(unsigned, o1)}, (GAS u32x2*)(part + (size_t)t * 128 + 16 * (c & 7) + 4 * kq)); }
        xc = xn;
    }
#undef U_LOADID
#undef U_LOADX
#undef U_ISSUE
#undef U_WRITE
#undef U_MM
}
__device__ __forceinline__ void step_peer_reduce(Frame& F, int layer) {
    const GAS _Float16* part = (const GAS _Float16*)(F.ws + O_PART); const GAS float* GW = (const GAS float*)(F.ws + O_GW); const GAS int* IDX = (const GAS int*)(F.ws + O_IDX);
    const GAS float* rowss = (const GAS float*)(F.ws + O_ROWSS); GAS unsigned char* W8 = F.ws + O_W8;
    const GAS unsigned char* SU = F.ws + O_TAB + (size_t)(layer * 2) * TAB_ONE + TAB_NIB; const GAS unsigned char* SV = SU + TAB_ONE;
    constexpr int NIT = T * 2;
    struct SA { int id; float gw, rs; float p[8]; }; struct SB { u32x4 su, sv; };
#define RA(X, it_) do { const int ii_ = (it_) < NIT ? (it_) : NIT - 1; const size_t i_ = (size_t)ii_ * 64 + F.lane; X.id = IDX[i_]; X.gw = GW[i_]; X.rs = rowss[(size_t)(ii_ >> 1) * 32 + (F.lane & 31)]; \
        _Pragma("unroll") for (int s = 0; s < 8; ++s) X.p[s] = (float)part[(size_t)s * T * 128 + i_]; } while (0)
#define RB(Y, X) do { Y.su = *(const GAS u32x4*)(SU + (size_t)X.id * 16); Y.sv = *(const GAS u32x4*)(SV + (size_t)X.id * 16); } while (0)
#define RC(X, Y, it_) do { if ((it_) < NIT) { const size_t i_ = (size_t)(it_) * 64 + F.lane; const float r = rsqrtf(wave_sum(X.rs) * (0.5f / DM) + EPS); float d = 0.f; \
        _Pragma("unroll") for (int s = 0; s < 8; ++s) d += X.p[s] * (float)__builtin_bit_cast(_Float16, (unsigned short)(Y.su[s >> 1] >> (16 * (s & 1)))); \
        const float w = X.gw * gelu_tanh(d * r) * 256.f; \
        _Pragma("unroll") for (int s = 0; s < 8; ++s) { const float ws = w * (float)__builtin_bit_cast(_Float16, (unsigned short)(Y.sv[s >> 1] >> (16 * (s & 1)))); \
            W8[(size_t)s * T * 128 + i_] = (unsigned char)(__builtin_amdgcn_cvt_pk_fp8_f32(ws, 0.f, 0, false) & 0xff); } } } while (0)
    SA a0, a1, a2; SB b0, b1;
    RA(a0, F.gw); RA(a1, F.gw + F.ngw); RB(b0, a0);
    for (int it = F.gw; it < NIT; it += F.ngw) {
        RA(a2, it + 2 * F.ngw); RB(b1, a1);
        RC(a0, b0, it);
        a0 = a1; a1 = a2; b0 = b1;
    }
#undef RA
#undef RB
#undef RC
}
__device__ __forceinline__ void step_vpass(Frame& F, int layer, int G, bool dry, LAS unsigned char* lds) {
    typedef pg8::v8i_t v8i_t;
    const int s = blockIdx.x & 7, wk = (blockIdx.x >> 3) * NWAVES + F.wave, nwk = (G >> 3) * NWAVES;
    const GAS unsigned char* VN = F.ws + O_TAB + (size_t)(layer * 2 + 1) * TAB_ONE + (size_t)s * NEXP * 128;
    const GAS int* IDX = (const GAS int*)(F.ws + O_IDX); const GAS unsigned char* W8 = F.ws + O_W8 + (size_t)s * T * 128;
    GAS bf16_t* xs = (GAS bf16_t*)(F.ws + O_XS16); GAS float* rsp = (GAS float*)(F.ws + O_RSP);
    unsigned lo = (unsigned)F.lane; asm volatile("" : "+v"(lo));
    const unsigned j = lo >> 3, p = lo & 7, c = lo & 15, kq = lo >> 4;
    LAS unsigned char* img = lds + F.wave * 16384;
    LAS unsigned char* wrp = img + j * 128 + ((p ^ j) << 4);
    const unsigned rdrow = (unsigned)(size_t)img + (32 * kq + c) * 128, csw = (c & 7) << 4;
    const int tlast = wk + ((T - 1 - wk) / nwk) * nwk;
    LAS float* wfl = (LAS float*)(lds + 131072); GAS float* logfp = (GAS float*)(F.ws + O_LOGFP);
    if (layer == 0) { const GAS float* wf = (const GAS float*)(F.ws + O_WF) + s * 256;
        for (int i = F.tid; i < NH * 64; i += NTHREADS) *(LAS f32x4*)(wfl + (i >> 6) * 256 + (i & 63) * 4) = *(const GAS f32x4*)(wf + (size_t)(i >> 6) * DM + (i & 63) * 4);
        __syncthreads(); }
#define V_LOADID(ID, t_, q_) do { const int tt_ = (t_) <= tlast ? (t_) : tlast; _Pragma("unroll") for (int b = 0; b < 4; ++b) ID[b] = IDX[(size_t)tt_ * 128 + (q_) * 32 + 8 * b + j]; } while (0)
#define V_LOADW(t_) do { const int tt_ = (t_) <= tlast ? (t_) : tlast; wn0 = *(const GAS u32x4*)(W8 + (size_t)tt_ * 128 + kq * 16); wn1 = *(const GAS u32x4*)(W8 + (size_t)tt_ * 128 + 64 + kq * 16); } while (0)
    const __amdgpu_buffer_rsrc_t vrs = __builtin_amdgcn_make_buffer_rsrc((void*)(unsigned char*)VN, 0, NEXP * 128, 0x00020000);
#define V_ISSUE(VB, ID) do { _Pragma("unroll") for (int b = 0; b < 4; ++b) VB[b] = __builtin_amdgcn_raw_buffer_load_b128(vrs, ID[b] * 128 + (int)p * 16, 0, 16); } while (0)
#define V_WRITE(VB, q_) do { _Pragma("unroll") for (int b = 0; b < 4; ++b) *(LAS u32x4*)(wrp + (4 * (q_) + b) * 1024) = VB[b]; } while (0)
#define TR4(dst, va, off) asm volatile("ds_read_b64_tr_b4 %0, %1 offset:%2" : "=&v"(dst) : "v"(va), "i"(off) : "memory")
#define V_MM(cc) do { const unsigned va0 = rdrow + (((cc) << 4) ^ csw), va1 = rdrow + ((((cc) + 1) << 4) ^ csw); u32x2 t00, t01, t10, t11, t20, t21, t30, t31; \
        TR4(t00, va0, 0); TR4(t01, va0, 2048); TR4(t10, va0, 8); TR4(t11, va0, 2056); TR4(t20, va1, 0); TR4(t21, va1, 2048); TR4(t30, va1, 8); TR4(t31, va1, 2056); \
        asm volatile("s_waitcnt lgkmcnt(0)" ::: "memory"); __builtin_amdgcn_sched_barrier(0); \
        o = __builtin_amdgcn_mfma_scale_f32_16x16x128_f8f6f4((v8i_t){(int)t00.x, (int)t00.y, (int)t01.x, (int)t01.y, 0, 0, 0, 0}, bop, o, 4, 0, 0, 127, 0, SBV(2 * (cc))); \
        o = __builtin_amdgcn_mfma_scale_f32_16x16x128_f8f6f4((v8i_t){(int)t10.x, (int)t10.y, (int)t11.x, (int)t11.y, 0, 0, 0, 0}, bop, o, 4, 0, 0, 127, 0, SBV(2 * (cc) + 1)); \
        o = __builtin_amdgcn_mfma_scale_f32_16x16x128_f8f6f4((v8i_t){(int)t20.x, (int)t20.y, (int)t21.x, (int)t21.y, 0, 0, 0, 0}, bop, o, 4, 0, 0, 127, 0, SBV(2 * (cc) + 2)); \
        o = __builtin_amdgcn_mfma_scale_f32_16x16x128_f8f6f4((v8i_t){(int)t30.x, (int)t30.y, (int)t31.x, (int)t31.y, 0, 0, 0, 0}, bop, o, 4, 0, 0, 127, 0, SBV(2 * (cc) + 3)); } while (0)
#define SBV(nb_) ((c == (unsigned)(nb_)) ? 119 : 0)
    int idA[4], idB[4]; u32x4 v0[4], v1[4], v2[4], v3[4]; u32x4 w0, w1, wn0, wn1;
    V_LOADID(idA, wk, 0); V_LOADID(idB, wk, 1); V_LOADW(wk);
    V_ISSUE(v0, idA); V_LOADID(idA, wk, 2);
    V_ISSUE(v1, idB); V_LOADID(idB, wk, 3);
    V_ISSUE(v2, idA); V_LOADID(idA, wk + nwk, 0);
    w0 = wn0; w1 = wn1;
    for (int t = wk; t < T; t += nwk) {
        V_ISSUE(v3, idB); V_LOADID(idB, t + nwk, 1); V_LOADW(t + nwk);
        GAS bf16_t* xb = xs + (size_t)t * DM + s * 256 + c * 16 + kq * 4;
        f32x4 x2; { const u32x2 w = *(const GAS u32x2*)xb; x2 = (f32x4){bf_lo(w.x), bf_hi(w.x), bf_lo(w.y), bf_hi(w.y)}; }
        V_WRITE(v0, 0);
        V_ISSUE(v0, idA); V_LOADID(idA, t + nwk, 2);
        V_WRITE(v1, 1);
        V_ISSUE(v1, idB); V_LOADID(idB, t + nwk, 3);
        V_WRITE(v2, 2);
        V_ISSUE(v2, idA); V_LOADID(idA, t + 2 * nwk, 0);
        V_WRITE(v3, 3);
        const v8i_t bop = {(int)w0.x, (int)w0.y, (int)w0.z, (int)w0.w, (int)w1.x, (int)w1.y, (int)w1.z, (int)w1.w};
        f32x4 o = {0.f, 0.f, 0.f, 0.f};
        V_MM(0); V_MM(2); V_MM(4); V_MM(6);
        x2 += o;
        if (layer == 1 && !dry) __builtin_nontemporal_store(x2, (GAS f32x4*)(F.out + (size_t)t * DM + s * 256 + c * 16 + kq * 4));
        if (layer == 0 && !dry) {
            { u32x2 ow; ow.x = cvtpk(x2[0], x2[1]); ow.y = cvtpk(x2[2], x2[3]); __builtin_nontemporal_store(ow, (GAS u32x2*)xb); }
            const float sst = wave_sum((x2[0] * x2[0] + x2[1] * x2[1]) + (x2[2] * x2[2] + x2[3] * x2[3]));
            if (lo == 0) rsp[(size_t)t * 8 + s] = sst;
        }
        if (layer == 0) {
            f32x4 gw[NH];
#pragma unroll
            for (int h = 0; h < NH; ++h) gw[h] = *(const LAS f32x4*)(wfl + h * 256 + c * 16 + kq * 4);
            __builtin_amdgcn_sched_barrier(0);
            float ph[NH];
#pragma unroll
            for (int h = 0; h < NH; ++h) ph[h] = (x2[0] * gw[h][0] + x2[1] * gw[h][1]) + (x2[2] * gw[h][2] + x2[3] * gw[h][3]);
#pragma unroll
            for (int h = 0; h < NH; ++h) ph[h] += dppf<0xB1>(ph[h]);
#pragma unroll
            for (int h = 0; h < NH; ++h) ph[h] += dppf<0x4E>(ph[h]);
#pragma unroll
            for (int h = 0; h < NH; ++h) ph[h] += dppf<0x141>(ph[h]);
#pragma unroll
            for (int h = 0; h < NH; ++h) ph[h] += dppf<0x140>(ph[h]);
            float sel = 0.f;
#pragma unroll
            for (int h = 0; h < NH; ++h) sel = (c == (unsigned)h) ? ph[h] : sel;
            sel = xsum16(sel); sel = xsum32(sel);
            if (lo < (unsigned)NH && !dry) logfp[((size_t)t * 8 + s) * NH + lo] = sel;
        }
        w0 = wn0; w1 = wn1;
    }
#undef V_LOADID
#undef V_LOADW
#undef V_ISSUE
#undef V_WRITE
#undef TR4
#undef V_MM
#undef SBV
}
#undef F4
#undef H2F
__device__ __forceinline__ void step_logf(Frame& F) {
    const GAS float* lp = (const GAS float*)(F.ws + O_LOGFP); const GAS float* rsp = (const GAS float*)(F.ws + O_RSP); GAS float* logf = (GAS float*)(F.ws + O_LOGF);
    unsigned lo = (unsigned)F.lane; asm volatile("" : "+v"(lo));
    const unsigned h = lo & 15, g = lo >> 4; const unsigned hh = h < (unsigned)NH ? h : 0u;
    for (int t0 = F.gw * 4; t0 < T; t0 += F.ngw * 4) {
        const int t = t0 + (int)g;
        float pz[8]; f32x4 q0, q1;
#pragma unroll
        for (int s = 0; s < 8; ++s) pz[s] = lp[((size_t)t * 8 + s) * NH + hh];
        q0 = *(const GAS f32x4*)(rsp + (size_t)t * 8); q1 = *(const GAS f32x4*)(rsp + (size_t)t * 8 + 4);
        const float z0 = ((pz[0] + pz[1]) + (pz[2] + pz[3])) + ((pz[4] + pz[5]) + (pz[6] + pz[7]));
        const float r1 = rsqrtf(((q0[0] + q0[1]) + (q0[2] + q0[3]) + (q1[0] + q1[1]) + (q1[2] + q1[3])) * (1.f / DM) + EPS);
        if (h < (unsigned)NH) { const float z = z0 * r1 + F.in(I_SBF)[h];
            logf[((size_t)(t / SEQ) * NH + h) * SEQ + (t % SEQ)] = fminf(z, 0.f) - log1p_pos(fast_exp(-fabsf(z))); }
    }
}

#define XB_TMO      128
#define XB_XCNT(j)  (256  + 64 * (j))
#define XB_XSUB(j)  (1280 + 64 * (j))
#define XB_XGEN(j)  (2304 + 64 * (j))
#define XB_TOP      3328
#define XB_TOPGEN   3392
#define XCD_BAR_WORDS 3456
#define XB_SPIN_CAP (1u << 20)
__device__ __forceinline__ unsigned xb_ld(unsigned* p)              { return __hip_atomic_load(p, __ATOMIC_RELAXED, __HIP_MEMORY_SCOPE_AGENT); }
__device__ __forceinline__ unsigned xb_add(unsigned* p, unsigned v) { return __hip_atomic_fetch_add(p, v, __ATOMIC_RELAXED, __HIP_MEMORY_SCOPE_AGENT); }
__device__ __forceinline__ unsigned xb_xcc_id() { return (unsigned)__builtin_amdgcn_s_getreg((3 << 11) | 20) & 0xFu; }
#define XB_SPIN(cond, bar) do { unsigned _sp = 0; while (cond) { __builtin_amdgcn_s_sleep(1); \
    if ((++_sp & 255u) == 0u) { if (xb_ld(&(bar)[XB_TMO])) break; if (_sp > XB_SPIN_CAP) { atomicAdd(&(bar)[XB_TMO], 1u); break; } } } } while (0)
struct XcdBarrier { unsigned* bar; unsigned x; volatile LAS unsigned* st; };
__device__ __forceinline__ XcdBarrier xcd_barrier_post(unsigned* bar, volatile LAS unsigned* st) {
    XcdBarrier b; b.bar = bar; b.x = xb_xcc_id(); b.st = st;
    if (threadIdx.x == 0) (void)xb_add(&bar[XB_XCNT(b.x)], 1u);
    return b;
}
__device__ __forceinline__ void xcd_barrier_complete(unsigned* bar, unsigned x, unsigned& nloc, unsigned& nx) {
    const unsigned G = gridDim.x * gridDim.y * gridDim.z;
    unsigned sum, cnt, mine, sp = 0u;
    for (;;) {
        sum = 0u; cnt = 0u; mine = 0u;
#pragma unroll
        for (unsigned j = 0; j < 16; ++j) { const unsigned c = xb_ld(&bar[XB_XCNT(j)]); sum += c; cnt += (c > 0u) ? 1u : 0u; mine = (j == x) ? c : mine; }
        if (sum == G) break;
        __builtin_amdgcn_s_sleep(1);
        if ((++sp & 255u) == 0u) { if (xb_ld(&bar[XB_TMO])) break; if (sp > XB_SPIN_CAP) { atomicAdd(&bar[XB_TMO], 1u); break; } }
    }
    nloc = mine > 0u ? mine : 1u; nx = cnt > 0u ? cnt : 1u;
}
__device__ __forceinline__ void xcd_barrier(const XcdBarrier& b, int wave_s) {
    asm volatile("s_waitcnt vmcnt(0)" ::: "memory");
    __syncthreads();
    int ln_; asm volatile("v_mbcnt_lo_u32_b32 %0, -1, 0\n\tv_mbcnt_hi_u32_b32 %0, -1, %0" : "=v"(ln_));
    if (wave_s == 0 && ln_ == 0) {
        unsigned* bar = b.bar;
        __builtin_amdgcn_s_waitcnt(0);
        unsigned nloc = b.st[0], nx = b.st[1];
        if (nloc == 0u) { xcd_barrier_complete(bar, b.x, nloc, nx); b.st[0] = nloc; b.st[1] = nx; }
        const unsigned old = xb_add(&bar[XB_XSUB(b.x)], 1u);
        const unsigned gen = old / nloc;
        if (old + 1u == (gen + 1u) * nloc) {
            __builtin_amdgcn_fence(__ATOMIC_RELEASE, "agent");
            asm volatile("s_waitcnt vmcnt(0)" ::: "memory");
            const unsigned og = xb_add(&bar[XB_TOP], 1u);
            const unsigned tg = og / nx;
            if (og + 1u == (tg + 1u) * nx) xb_add(&bar[XB_TOPGEN], 1u);
            else XB_SPIN(xb_ld(&bar[XB_TOPGEN]) == tg, bar);
            __builtin_amdgcn_fence(__ATOMIC_ACQUIRE, "agent");
            xb_add(&bar[XB_XGEN(b.x)], 1u);
            asm volatile("s_waitcnt vmcnt(0)" ::: "memory");
        } else {
            XB_SPIN(xb_ld(&bar[XB_XGEN(b.x)]) == gen, bar);
            __builtin_amdgcn_fence(__ATOMIC_ACQUIRE, "agent");
            asm volatile("s_waitcnt vmcnt(0)" ::: "memory");
        }
    }
    __syncthreads();
}

constexpr int CONV1_SPLIT = 2 * 4608;
constexpr int BAR_LDS_OFF = 147456 - 64;
constexpr int LDS_BYTES = 147456;
enum { ST_PROLOGUE = 0, ST_G_IN0, ST_G_MKV0, ST_G_MKV1, ST_CONV, ST_G_GATE, ST_A_MEM0, ST_SCAN1, ST_SCAN2, ST_G_OUT0, ST_G_PQ0, ST_TOPK0, ST_UPASS0, ST_PRED0, ST_VPASS0,
       ST_G_L1, ST_CPREFIX, ST_A_FOX, ST_A_MEM1, ST_G_OUT1, ST_G_PQ1, ST_TOPK1, ST_UPASS1, ST_PRED1, ST_VPASS1, N_STEPS };
constexpr unsigned SYNC_AFTER = (1u << ST_PROLOGUE) | (1u << ST_G_MKV1) | (1u << ST_CONV) | (1u << ST_A_MEM0) | (1u << ST_SCAN1) | (1u << ST_SCAN2) | (1u << ST_G_OUT0) | (1u << ST_G_PQ0) |
                                (1u << ST_TOPK0) | (1u << ST_UPASS0) | (1u << ST_PRED0) | (1u << ST_VPASS0) | (1u << ST_G_L1) | (1u << ST_CPREFIX) | (1u << ST_A_MEM1) | (1u << ST_G_OUT1) | (1u << ST_G_PQ1) | (1u << ST_TOPK1) | (1u << ST_UPASS1) | (1u << ST_PRED1);
constexpr unsigned GEMM_STEPS = (1u << ST_G_IN0) | (1u << ST_G_MKV0) | (1u << ST_G_MKV1) | (1u << ST_G_GATE) | (1u << ST_G_OUT0) | (1u << ST_G_PQ0) | (1u << ST_G_L1) | (1u << ST_G_OUT1) | (1u << ST_G_PQ1);
constexpr unsigned ATTN_STEPS = (1u << ST_A_MEM0) | (1u << ST_A_FOX) | (1u << ST_A_MEM1);

struct Args { const float* in[N_IN]; float* out; unsigned char* ws; int lo, hi; };

__global__ void __launch_bounds__(NTHREADS, 2) yoco_fwd(Args args) {
    extern __shared__ __attribute__((aligned(16))) unsigned char lds[];
    volatile LAS unsigned* bst = (volatile LAS unsigned*)((LAS unsigned char*)lds + BAR_LDS_OFF);
    if (threadIdx.x == 0) { bst[0] = 0u; bst[1] = 0u; }
    __syncthreads();
    const XcdBarrier gbar = xcd_barrier_post((unsigned*)(args.ws + O_CTL), bst);
    const int G = gridDim.x;
    const int wave_s = __builtin_amdgcn_readfirstlane(threadIdx.x >> 6);
#ifndef DUP_MASK
#define DUP_MASK 0u
#endif
    for (int st = args.lo; st < args.hi; ++st) {
      const int nrep = ((DUP_MASK >> st) & 1u) ? 2 : 1;
      for (int rep = 0; rep < nrep; ++rep) {
        unsigned char* ws0 = args.ws; asm volatile("" : "+s"(ws0));
        GAS unsigned char* ws = (GAS unsigned char*)ws0;
#define LANE_ID(v) asm volatile("v_mbcnt_lo_u32_b32 %0, -1, 0\n\tv_mbcnt_hi_u32_b32 %0, -1, %0" : "=v"(v))
#define MAKE_TID(v) do { LANE_ID(v); v += wave_s * 64; } while (0)
#define MAKE_FRAME(F) Frame F; F.ws = ws; F.in_ = args.in; F.out = (GAS float*)args.out; { int t0_; MAKE_TID(t0_); F.tid = t0_; } F.lane = F.tid & 63; F.wave = wave_s; \
        F.gw = blockIdx.x * NWAVES + F.wave; F.ngw = gridDim.x * NWAVES; F.gtid = blockIdx.x * NTHREADS + F.tid; F.ngt = gridDim.x * NTHREADS
        if (st == ST_G_L1) { MAKE_FRAME(F); step_logf(F); }
        if ((GEMM_STEPS >> st) & 1u) {
            pg8::Gemm g; Epi E; E.ws = ws; E.resid = nullptr; E.outf = nullptr; E.o16 = nullptr; E.ssq = nullptr; E.gate_b = nullptr; int shift = 0;
            switch (st) {
            case ST_G_IN0:  g = {(const GAS bf16_t*)(ws + O_XS16), (const GAS bf16_t*)(ws + O_WIN0), T, NIN0, DM, DM, DM, 0}; E.mode = EM_IN0; break;
            case ST_G_MKV0: g = {(const GAS bf16_t*)(ws + O_MEMN), (const GAS bf16_t*)(ws + O_WMKV), NMROW, 1024, DM, DM, DM, 0}; E.mode = EM_MKV; E.o16 = (GAS bf16_t*)(ws + O_MKV); E.ssq = (GAS float*)(ws + O_MKSS); shift = 128; break;
            case ST_G_MKV1: g = {(const GAS bf16_t*)(ws + O_MEMN) + (size_t)NMROW * DM, (const GAS bf16_t*)(ws + O_WMKV) + (size_t)1024 * DM, NMROW, 1024, DM, DM, DM, 0}; E.mode = EM_MKV;
                            E.o16 = (GAS bf16_t*)(ws + O_MKV) + (size_t)NMROW * NL1; E.ssq = (GAS float*)(ws + O_MKSS) + NMROW * 112; shift = 144; break;
            case ST_G_GATE: g = {(const GAS bf16_t*)(ws + O_XC), (const GAS bf16_t*)(ws + O_WGATE), T, 12 * 256, 128, LRU, 128, 128}; E.mode = EM_GATE; E.gate_b = (const GAS float*)args.in[I_AGATEB]; break;
            case ST_G_OUT0: g = {(const GAS bf16_t*)(ws + O_CAT), (const GAS bf16_t*)(ws + O_WOUT0), T, DM, DM, DM, DM, 0}; E.mode = EM_RES; E.resid = (const GAS float*)args.in[I_X]; E.outf = (GAS float*)args.out; break;
            case ST_G_PQ0:  g = {(const GAS bf16_t*)(ws + O_XS16), (const GAS bf16_t*)(ws + O_WQ0), T, DM, DM, DM, DM, 0}; E.mode = EM_PQ; E.o16 = (GAS bf16_t*)(ws + O_Q16); break;
            case ST_G_L1:   g = {(const GAS bf16_t*)(ws + O_XS16), (const GAS bf16_t*)(ws + O_WL1), T, NL1, DM, DM, DM, 0}; E.mode = EM_L1; break;
            case ST_G_OUT1: g = {(const GAS bf16_t*)(ws + O_CAT), (const GAS bf16_t*)(ws + O_WOUT1), T, DM, DM, DM, DM, 0}; E.mode = EM_RES; E.resid = nullptr; break;
            default:        g = {(const GAS bf16_t*)(ws + O_XS16), (const GAS bf16_t*)(ws + O_WQ1), T, DM, DM, DM, DM, 0}; E.mode = EM_PQ; E.o16 = (GAS bf16_t*)(ws + O_Q16); break;
            }
            pg8::StaticOrder S; S.init(g.M, g.N, G, (int)((blockIdx.x + G - shift) % G));
#ifndef DIS_GEMM
            { int tg_; MAKE_TID(tg_);
              pg8::gemm_phase<Epi, false>((LAS unsigned char*)lds, g, S, E, tg_); }
#endif
            if (st == ST_G_MKV1 && blockIdx.x >= 160) { MAKE_FRAME(F); convert_tables(F, 1, 0, CONV1_SPLIT, (blockIdx.x - 160) * NWAVES + F.wave, (G - 160) * NWAVES); }
        } else if ((ATTN_STEPS >> st) & 1u) {
            const int nun = st == ST_A_FOX ? 3 : 1;
            for (int ui = 0; ui < nun; ++ui) {
                att::BlockRef r;
                if (st == ST_A_FOX) {
                    const int i = blockIdx.x, x = i & 15, bh = (i >> 4) + 16 * ui, qb = ui == 0 ? x : (ui == 1 ? 15 - x : ((x * 5 + 3) & 15));
                    const int b = bh / NH, h = bh % NH; const size_t row0 = (size_t)b * SEQ + qb * 256;
                    const GAS bf16_t* z = (const GAS bf16_t*)(ws + O_ZL1);
                    r.Q = z + row0 * NL1 + 3072 + h * 128; r.K = z + (size_t)b * SEQ * NL1 + h * 128; r.V = z + (size_t)b * SEQ * NL1 + 1536 + h * 128;
                    r.O = (GAS bf16_t*)(ws + O_CAT) + row0 * DM + h * 128;
                    const GAS float* ss = (const GAS float*)(ws + O_SSL1);
                    r.qss = ss + row0 * 112 + (12 + h) * 4; r.kss = ss + (size_t)b * SEQ * 112 + h * 4; r.cc = (const GAS float*)(ws + O_CC) + (size_t)bh * SEQ; r.gg = (const GAS float*)(ws + O_GG) + 384;
                    r.P0 = qb * 256; r.skv = SEQ;
                } else {
                    const int l = st == ST_A_MEM0 ? 0 : 1; const int i = blockIdx.x, qblk = i >> 2, h = i & 3, b = qblk >> 4; const size_t row0 = (size_t)qblk * 256;
                    r.Q = (const GAS bf16_t*)(ws + O_ZL1) + row0 * NL1 + 4608 + h * 128; r.qss = (const GAS float*)(ws + O_SSL1) + row0 * 112 + (24 + h) * 4;
                    const GAS bf16_t* kv = (const GAS bf16_t*)(ws + O_MKV) + ((size_t)l * NMROW + b * NMEM) * NL1;
                    r.K = kv + h * 128; r.V = kv + 512 + h * 128; r.kss = (const GAS float*)(ws + O_MKSS) + ((size_t)l * NMROW + b * NMEM) * 112 + h * 4;
                    r.O = (GAS bf16_t*)(ws + O_CAT) + row0 * DM + LRU + h * 128; r.cc = nullptr; r.gg = (const GAS float*)(ws + O_GG) + 128 * (1 + l);
                    r.P0 = SEQ; r.skv = NMEM;
                }
                att::Seam S;
                int tid_u; MAKE_TID(tid_u);
#ifndef DIS_ATTN
                if (st == ST_A_FOX) { att::attn_prime(r, (char*)lds, S, tid_u); att::attn_block(r, (char*)lds, S, tid_u); }
                else att::mem_attn_unit(r, (char*)lds, tid_u);
#endif
            }
        } else {
            MAKE_FRAME(F);
            switch (st) {
#ifndef DIS_MISC
            case ST_PROLOGUE: step_prologue(F, (LAS unsigned char*)lds); break;
            case ST_CONV: step_conv(F); break;
            case ST_SCAN1: step_scan1(F); break;
            case ST_SCAN2: step_scan2(F); break;
#endif
#ifndef DIS_TOPK
            case ST_TOPK0: step_topk(F, (LAS unsigned char*)lds, 0); break;
            case ST_TOPK1: step_topk(F, (LAS unsigned char*)lds, 1); break;
#endif
#ifndef DIS_GATHER
            case ST_UPASS0: step_upass(F, 0, G, (LAS unsigned char*)lds); break;
            case ST_UPASS1: step_upass(F, 1, G, (LAS unsigned char*)lds); break;
            case ST_PRED0: step_peer_reduce(F, 0); break;
            case ST_PRED1: step_peer_reduce(F, 1); break;
            case ST_VPASS0: step_vpass(F, 0, G, rep + 1 < nrep, (LAS unsigned char*)lds); break;
            case ST_VPASS1: step_vpass(F, 1, G, rep + 1 < nrep, (LAS unsigned char*)lds); break;
#endif
#ifndef DIS_MISC
            case ST_CPREFIX: step_cprefix(F, (LAS unsigned char*)lds); convert_tables(F, 1, G > 160 ? CONV1_SPLIT : 0, 2 * NEXP, F.gw, F.ngw); break;
#endif
            default: break;
            }
        }
        if (rep + 1 < nrep) xcd_barrier(gbar, wave_s);
      }
        if (((SYNC_AFTER >> st) & 1u) && st + 1 < args.hi) xcd_barrier(gbar, wave_s);
    }
}

#ifndef N_LAUNCH_MODE
#define N_LAUNCH_MODE 1
#endif
extern "C" void kernel_launch(void* const* d_in, const int* in_sizes, int n_in, void* d_out, int out_size, void* d_ws, size_t ws_size, hipStream_t stream) {
    static int grid = 0;
    if (grid == 0) {
        if (n_in != N_IN || in_sizes[0] != T * DM || out_size != T * DM || ws_size < WS_END) {
            fprintf(stderr, "kernel_launch: unexpected shapes (n_in %d, in0 %d, out %d, ws %zu, need %zu)\n", n_in, n_in > 0 ? in_sizes[0] : -1, out_size, ws_size, (size_t)WS_END); grid = -1; return; }
        int dev = 0, cus = 0, per_cu = 0;
        hipGetDevice(&dev); hipDeviceGetAttribute(&cus, hipDeviceAttributeMultiprocessorCount, dev);
        hipFuncSetAttribute((const void*)yoco_fwd, hipFuncAttributeMaxDynamicSharedMemorySize, LDS_BYTES);
        hipOccupancyMaxActiveBlocksPerMultiprocessor(&per_cu, (const void*)yoco_fwd, NTHREADS, LDS_BYTES);
        if (per_cu < 1) { fprintf(stderr, "kernel_launch: occupancy query says %d blocks per CU\n", per_cu); grid = -1; return; }
        grid = cus - cus % 8;
        (void)hipGetLastError();
    }
    if (grid < 0) return;
    Args a{};
    for (int i = 0; i < N_IN; ++i) a.in[i] = (const float*)d_in[i];
    a.out = (float*)d_out; a.ws = (unsigned char*)d_ws;
    if (hipMemsetAsync((char*)d_ws + O_CTL, 0, 65536, stream) != hipSuccess) { fprintf(stderr, "kernel_launch: memset of the barrier words failed\n"); return; }
    if (N_LAUNCH_MODE == 1) {
        a.lo = 0; a.hi = N_STEPS;
        hipLaunchKernelGGL(yoco_fwd, dim3(grid), dim3(NTHREADS), LDS_BYTES, stream, a);
        hipError_t e = hipPeekAtLastError();
        if (e != hipSuccess) fprintf(stderr, "launch failed: %s (grid %d)\n", hipGetErrorString(e), grid);
    } else {
        int lo = 0;
        for (int s = 0; s < N_STEPS; ++s) {
            if (((SYNC_AFTER >> s) & 1u) || s == N_STEPS - 1) {
                a.lo = lo; a.hi = s + 1; lo = s + 1;
                void* params[] = {&a};
                hipError_t e = hipLaunchCooperativeKernel((const void*)yoco_fwd, dim3(grid), dim3(NTHREADS), params, LDS_BYTES, stream);
                if (e != hipSuccess) { fprintf(stderr, "launch failed: %s\n", hipGetErrorString(e)); break; }
            }
        }
    }
}
```

```cpp
#include <hip/hip_runtime.h>
#include <hip/hip_cooperative_groups.h>
#include <cstdio>
#include <cstdint>
namespace cg = cooperative_groups;

#define LAS __attribute__((address_space(3)))
#define GAS __attribute__((address_space(1)))
typedef unsigned short bf16_t;
typedef short bf16x8 __attribute__((ext_vector_type(8)));
typedef short s16x4 __attribute__((ext_vector_type(4)));
typedef float f32x4 __attribute__((ext_vector_type(4)));
typedef float f32x2 __attribute__((ext_vector_type(2)));
typedef float f32x16 __attribute__((ext_vector_type(16)));
typedef unsigned u32x4 __attribute__((ext_vector_type(4)));
typedef unsigned u32x2 __attribute__((ext_vector_type(2)));
typedef _Float16 h2 __attribute__((ext_vector_type(2)));

constexpr int NB = 4, SEQ = 4096, T = NB * SEQ, DM = 2048, LRU = 1536, MEMW = 512, NMEM = 256, NH = 12, HD = 128;
constexpr int NIN0 = 3584, NL1 = 5120, NEXP = 16384, NMROW = NB * NMEM;
constexpr float EPS = 1e-6f;
constexpr int NTHREADS = 512, NWAVES = 8;

constexpr size_t MiB = 1u << 20;
constexpr size_t O_CTL = 0;
constexpr size_t O_WIN0 = 1 * MiB;
constexpr size_t O_WOUT0 = O_WIN0 + 14 * MiB;
constexpr size_t O_WL1 = O_WOUT0 + 8 * MiB;
constexpr size_t O_WOUT1 = O_WL1 + 20 * MiB;
constexpr size_t O_WQ0 = O_WOUT1 + 8 * MiB;
constexpr size_t O_WQ1 = O_WQ0 + 8 * MiB;
constexpr size_t O_WMKV = O_WQ1 + 8 * MiB;
constexpr size_t O_WGATE = O_WMKV + 8 * MiB;
constexpr size_t O_SUBK = O_WGATE + 1 * MiB;
constexpr size_t O_WF = O_SUBK + 1 * MiB;
constexpr size_t O_SMALL = O_WF + 1 * MiB;
constexpr size_t O_RS1 = O_SMALL;
constexpr size_t O_LOGF = O_SMALL + 64 * 1024;
constexpr size_t O_CC = O_LOGF + 768 * 1024;
constexpr size_t O_GG = O_CC + 768 * 1024;
constexpr size_t O_SPL = O_GG + 4096;
constexpr size_t O_TSC = O_SPL + 8192;
constexpr size_t O_ROWSS = O_SMALL + 2 * MiB;
constexpr size_t O_RSP = O_ROWSS + 2 * MiB;
constexpr size_t O_QMSS = O_RSP;
constexpr size_t O_MKSS = O_QMSS + 1 * MiB;
constexpr size_t O_SSL1 = O_MKSS + 1 * MiB;
constexpr size_t O_CARRY = O_SSL1 + 7 * MiB;
constexpr size_t O_MEMN = O_CARRY + 3 * MiB;
constexpr size_t O_MKV = O_MEMN + 8 * MiB;
constexpr size_t O_IDX = O_MKV + 20 * MiB;
constexpr size_t O_GW = O_IDX + 8 * MiB;
constexpr size_t O_TAB = O_GW + 8 * MiB;
constexpr size_t TAB_NIB = (size_t)8 * 16384 * 128, TAB_ONE = TAB_NIB + (size_t)16384 * 16 + 786432;
constexpr size_t O_XS16 = O_TAB + 128 * MiB;
constexpr size_t O_CAT = O_XS16 + 64 * MiB;
constexpr size_t O_ZX = O_CAT + 64 * MiB;
constexpr size_t O_X8 = O_ZX;
constexpr size_t O_GY = O_ZX + 48 * MiB;
constexpr size_t O_LOGFP = O_GY + 48 * MiB;
constexpr size_t O_QM = O_LOGFP;
constexpr size_t O_XC = O_QM + 16 * MiB;
constexpr size_t O_X4 = O_XC;
constexpr size_t O_SX = O_XC + 32 * MiB;
constexpr size_t O_AA = O_XC + 48 * MiB;
constexpr size_t O_PART = O_AA;
constexpr size_t O_UU = O_AA + 96 * MiB;
constexpr size_t O_W8 = O_UU;
constexpr size_t O_Q16 = O_UU + 96 * MiB;
constexpr size_t O_ZL1 = O_Q16 + 64 * MiB;
constexpr size_t WS_END = O_ZL1 + 160 * MiB;
static_assert(WS_END <= 1024 * MiB, "workspace map");

__device__ __forceinline__ unsigned cvtpk(float lo, float hi) { unsigned r; asm volatile("v_cvt_pk_bf16_f32 %0, %1, %2" : "=v"(r) : "v"(lo), "v"(hi)); return r; }
__device__ __forceinline__ float bf_lo(unsigned w) { return __uint_as_float(w << 16); }
__device__ __forceinline__ float bf_hi(unsigned w) { return __uint_as_float(w & 0xffff0000u); }
__device__ __forceinline__ float fast_exp(float x) { return __builtin_amdgcn_exp2f(x * 1.4426950408889634f); }
__device__ __forceinline__ float log1p_pos(float y) { const float ser = y * (1.f - y * (0.5f - y * (0.33333334f - 0.25f * y))); const float lg = __builtin_amdgcn_logf(1.f + y) * 0.6931471805599453f; return y < 0.03f ? ser : lg; }
__device__ __forceinline__ float one_minus_exp(float x) { const float ser = -x * (1.f + x * (0.5f + x * (0.16666667f + x * 0.041666668f))); const float big = 1.f - fast_exp(x); return x > -0.03f ? ser : big; }
__device__ __forceinline__ float sigmoidf_(float x) { return __builtin_amdgcn_rcpf(1.f + fast_exp(-x)); }
__device__ __forceinline__ float gelu_tanh(float x) { const float u = x * (1.f + 0.044715f * x * x); return x * __builtin_amdgcn_rcpf(1.f + __builtin_amdgcn_exp2f(u * (-2.f * 0.7978845608028654f * 1.4426950408889634f))); }
template <int CTRL> __device__ __forceinline__ float dppf(float v) { return __int_as_float(__builtin_amdgcn_update_dpp(0, __float_as_int(v), CTRL, 0xF, 0xF, true)); }
__device__ __forceinline__ float xsum16(float v) { auto r = __builtin_amdgcn_permlane16_swap(__float_as_uint(v), __float_as_uint(v), false, false); return __uint_as_float(r[0]) + __uint_as_float(r[1]); }
__device__ __forceinline__ float xsum32(float v) { auto r = __builtin_amdgcn_permlane32_swap(__float_as_uint(v), __float_as_uint(v), false, false); return __uint_as_float(r[0]) + __uint_as_float(r[1]); }
__device__ __forceinline__ float xmax16(float v) { auto r = __builtin_amdgcn_permlane16_swap(__float_as_uint(v), __float_as_uint(v), false, false); return fmaxf(__uint_as_float(r[0]), __uint_as_float(r[1])); }
__device__ __forceinline__ float xmax32(float v) { auto r = __builtin_amdgcn_permlane32_swap(__float_as_uint(v), __float_as_uint(v), false, false); return fmaxf(__uint_as_float(r[0]), __uint_as_float(r[1])); }
__device__ __forceinline__ float wave_sum(float v) {
    v += dppf<0xB1>(v); v += dppf<0x4E>(v); v += dppf<0x141>(v); v += dppf<0x140>(v);
    v = xsum16(v); v = xsum32(v); return v;
}
__device__ __forceinline__ float wave_max(float v) {
    v = fmaxf(v, dppf<0xB1>(v)); v = fmaxf(v, dppf<0x4E>(v)); v = fmaxf(v, dppf<0x141>(v)); v = fmaxf(v, dppf<0x140>(v));
    v = xmax16(v); v = xmax32(v); return v;
}

namespace pg8 {
constexpr int BM = 256, BK = 64, HALF = 128, HTB = HALF * BK * 2, STAGE_BYTES = 8 * HTB, NXCD = 8, WGM = 8;
__host__ __device__ __forceinline__ int lds_byte(int r, int c) { const int st = (r >> 4) * 2 + (c >> 5), rr = r & 15, cc = c & 31, ob = rr * 64 + cc * 2; return st * 1024 + (ob ^ (((ob >> 9) & 1) << 5)); }
__host__ __device__ __forceinline__ void stage_rc(int b, int& R, int& C) { const int st = b / 1024, sb = b % 1024, swz = sb ^ (((sb >> 9) & 1) << 5); R = (st >> 1) * 16 + swz / 64; C = (st & 1) * 32 + (swz % 64) / 2; }
__host__ __device__ __forceinline__ int perm32(int rho) { const int n = rho >> 4, i = rho & 15; return 8 * (i >> 2) + 4 * n + (i & 3); }

struct Unit { int pm, pn; };
struct Gemm { const GAS bf16_t* A; const GAS bf16_t* Bt; int M, N, K, lda, ldb, acol; };

struct StaticOrder {
    int nM, nN, nwg, G, c;
    __device__ void init(int M, int N, int G_, int c_) { nM = M / BM; nN = N / BM; nwg = nM * nN; G = G_; c = c_; }
    __device__ bool next(int i, Unit& u) const {
        const long L = (long)i * G + c; if (L >= nwg) return false;
        int wgid = (int)L; { const int q = nwg / NXCD, r = nwg % NXCD, xcd = wgid % NXCD, off = wgid / NXCD; wgid = (xcd < r ? xcd * (q + 1) : r * (q + 1) + (xcd - r) * q) + off; }
        const int nig = WGM * nN, gid = wgid / nig, fm = gid * WGM, gsz = (nM - fm) < WGM ? (nM - fm) : WGM;
        u.pm = fm + ((wgid % nig) % gsz); u.pn = (wgid % nig) / gsz; return true;
    }
};

typedef int v8i_t __attribute__((ext_vector_type(8)));
typedef int v4i_t __attribute__((ext_vector_type(4)));
template <class Epi, bool FP8>
__device__ __forceinline__ void gemm_phase(LAS unsigned char* lds, const Gemm g, const StaticOrder& S, const Epi& E, const int tid) {
    const int wid = __builtin_amdgcn_readfirstlane(tid >> 6), lane = tid & 63, wr = wid >> 2, wc = wid & 3, fr = lane & 15, fq = lane >> 4;
    const int K = g.K, nt = K / BK;
    unsigned voffA[2], voffB[2];
#pragma unroll
    for (int i = 0; i < 2; ++i) { int R, C; stage_rc(tid * 16 + i * 8192, R, C); const int Rb = (R & ~31) + perm32(R & 31);
        voffA[i] = (unsigned)(R * g.lda + C) * 2u; voffB[i] = (unsigned)(Rb * g.ldb + C) * 2u; }
    const size_t kstep = (size_t)(BK * 2);
    const size_t hstepA = (size_t)HALF * g.lda * 2, hstepB = (size_t)HALF * g.ldb * 2;
    const size_t tstepA = 2 * hstepA, tstepB = 2 * hstepB;
    const unsigned ldsw = (unsigned)wid * 1024u;
    const int aoff = lds_byte(wr * 64 + fr, fq * 8), boff = lds_byte(wc * 32 + fr, fq * 8);
#define PG8_SA(b, h) (((b) * 2 + (h)) * HTB)
#define PG8_SB(b, h) ((4 + (b) * 2 + (h)) * HTB)
#define PG8_STAGE(bufoff, gbase, voff) do { _Pragma("unroll") for (int _i = 0; _i < 2; ++_i) \
        __builtin_amdgcn_global_load_lds((const GAS unsigned*)((gbase) + (voff)[_i]), (LAS unsigned*)(lds + (bufoff) + ldsw + _i * 8192), 16, 0, 0); } while (0)
#define PG8_LD2(dst, off_) do { const u32x4 lo_ = *(const LAS u32x4*)(lds + (off_)), hi_ = *(const LAS u32x4*)(lds + (off_) + 1024); \
        dst = (v8i_t){(int)lo_.x, (int)lo_.y, (int)lo_.z, (int)lo_.w, (int)hi_.x, (int)hi_.y, (int)hi_.z, (int)hi_.w}; } while (0)
#define PG8_LDA(dst, b, h) do { _Pragma("unroll") for (int m = 0; m < 4; ++m) PG8_LD2(dst[m], PG8_SA(b, h) + aoff + m * 2048); } while (0)
#define PG8_LDB(dst, b, h) do { _Pragma("unroll") for (int n = 0; n < 2; ++n) PG8_LD2(dst[n], PG8_SB(b, h) + boff + n * 2048); } while (0)
#define PG8_HALF(v, k) ((k) ? __builtin_shufflevector(v, v, 4, 5, 6, 7) : __builtin_shufflevector(v, v, 0, 1, 2, 3))
#define PG8_MMA(ai, bj, At, Bt) do { __builtin_amdgcn_s_setprio(1); _Pragma("unroll") for (int m = 0; m < 4; ++m) _Pragma("unroll") for (int n = 0; n < 2; ++n) { \
        if constexpr (FP8) asm volatile("v_mfma_scale_f32_16x16x128_f8f6f4 %0, %1, %2, %0, %3, %4 op_sel_hi:[0,0,0]" : "+v"(acc[ai][bj][m][n]) : "v"(Bt[n]), "v"(At[m]), "v"(sc_w), "v"(sc_x));     \
        else { _Pragma("unroll") for (int k = 0; k < 2; ++k) { const v4i_t bh_ = PG8_HALF(Bt[n], k), ah_ = PG8_HALF(At[m], k); \
                acc[ai][bj][m][n] = __builtin_amdgcn_mfma_f32_16x16x32_bf16(__builtin_bit_cast(bf16x8, bh_), __builtin_bit_cast(bf16x8, ah_), acc[ai][bj][m][n], 0, 0, 0); } } } \
        __builtin_amdgcn_s_setprio(0); } while (0)
#define PG8_WAIT_V(n) asm volatile("s_waitcnt vmcnt(" #n ")" ::: "memory")
#define PG8_WAIT_L(n) asm volatile("s_waitcnt lgkmcnt(" #n ")" ::: "memory")
#define PG8_BAR __builtin_amdgcn_s_barrier()
#define PG8_SCHED __builtin_amdgcn_sched_barrier(0)
    Unit cur, nxt; int ui = 0;
    if (!S.next(0, cur)) return;
    f32x4 acc[2][2][4][2];
#pragma unroll
    for (int a = 0; a < 2; ++a)
#pragma unroll
        for (int b = 0; b < 2; ++b)
#pragma unroll
            for (int m = 0; m < 4; ++m)
#pragma unroll
                for (int n = 0; n < 2; ++n) acc[a][b][m][n] = (f32x4){0.f, 0.f, 0.f, 0.f};
    v8i_t At[4], B0[2], B1[2];
    const int sc_w = 121, sc_x = 127;
    const GAS char* cA = (const GAS char*)g.A + (size_t)cur.pm * tstepA + (size_t)cur.pn * g.acol * 2; const GAS char* cB = (const GAS char*)g.Bt + (size_t)cur.pn * tstepB;
    PG8_STAGE(PG8_SB(0, 0), cB, voffB); PG8_STAGE(PG8_SB(0, 1), cB + hstepB, voffB); PG8_STAGE(PG8_SA(0, 0), cA, voffA); PG8_STAGE(PG8_SA(0, 1), cA + hstepA, voffA);
    if (wr == 1) PG8_BAR;
    PG8_WAIT_V(2); PG8_BAR;
    PG8_STAGE(PG8_SB(1, 0), cB + kstep, voffB); PG8_STAGE(PG8_SA(1, 0), cA + kstep, voffA); PG8_STAGE(PG8_SB(1, 1), cB + hstepB + kstep, voffB);
    PG8_WAIT_V(6); PG8_BAR;
    for (;;) {
        const bool has_next = S.next(ui + 1, nxt);
        const GAS char* nA = has_next ? (const GAS char*)g.A + (size_t)nxt.pm * tstepA + (size_t)nxt.pn * g.acol * 2 : cA; const GAS char* nB = has_next ? (const GAS char*)g.Bt + (size_t)nxt.pn * tstepB : cB;
        for (int t = 0; t < nt; t += 2) {
            const bool last = (t == nt - 2);
            const GAS char* a1 = cA + (size_t)(t + 1) * kstep;
            const GAS char* a2 = last ? nA : cA + (size_t)(t + 2) * kstep; const GAS char* b2 = last ? nB : cB + (size_t)(t + 2) * kstep;
            const GAS char* a3 = a2 + kstep; const GAS char* b3 = b2 + kstep;
            PG8_LDB(B0, 0, 0); PG8_LDB(B1, 0, 1); PG8_SCHED; PG8_LDA(At, 0, 0); PG8_STAGE(PG8_SA(1, 1), a1 + hstepA, voffA);
            PG8_WAIT_V(8); PG8_WAIT_L(0); PG8_BAR; PG8_MMA(0, 0, At, B0); PG8_MMA(0, 1, At, B1); PG8_BAR; PG8_SCHED;
            PG8_LDA(At, 0, 1); PG8_STAGE(PG8_SB(0, 0), b2, voffB); PG8_STAGE(PG8_SB(0, 1), b2 + hstepB, voffB); PG8_STAGE(PG8_SA(0, 0), a2, voffA);
            PG8_WAIT_V(8); PG8_WAIT_L(0); PG8_BAR; PG8_MMA(1, 0, At, B0); PG8_MMA(1, 1, At, B1); PG8_BAR; PG8_SCHED;
            PG8_LDB(B0, 1, 0); PG8_LDB(B1, 1, 1); PG8_SCHED; PG8_LDA(At, 1, 0); PG8_STAGE(PG8_SA(0, 1), a2 + hstepA, voffA);
            PG8_WAIT_V(8); PG8_WAIT_L(0); PG8_BAR; PG8_MMA(0, 0, At, B0); PG8_MMA(0, 1, At, B1); PG8_BAR; PG8_SCHED;
            PG8_LDA(At, 1, 1); PG8_STAGE(PG8_SB(1, 0), b3, voffB); PG8_STAGE(PG8_SB(1, 1), b3 + hstepB, voffB); PG8_STAGE(PG8_SA(1, 0), a3, voffA);
            PG8_WAIT_V(8); PG8_WAIT_L(0); PG8_BAR; PG8_MMA(1, 0, At, B0); PG8_MMA(1, 1, At, B1); PG8_BAR; PG8_SCHED;
        }
        if (wr == 0) PG8_BAR;
        { int ln_; asm volatile("v_mbcnt_lo_u32_b32 %0, -1, 0\n\tv_mbcnt_hi_u32_b32 %0, -1, %0" : "=v"(ln_));
          E(acc, cur, wr, wc, ln_ & 15, ln_ >> 4); }
        if (!has_next) break;
#pragma unroll
        for (int a = 0; a < 2; ++a)
#pragma unroll
            for (int b = 0; b < 2; ++b)
#pragma unroll
                for (int m = 0; m < 4; ++m)
#pragma unroll
                    for (int n = 0; n < 2; ++n) acc[a][b][m][n] = (f32x4){0.f, 0.f, 0.f, 0.f};
        cur = nxt; cA = nA; cB = nB; ++ui;
        if (wr == 1) PG8_BAR;
    }
    PG8_WAIT_V(0);
    PG8_BAR;
#undef PG8_SA
#undef PG8_SB
#undef PG8_STAGE
#undef PG8_LDA
#undef PG8_LDB
#undef PG8_LD2
#undef PG8_HALF
#undef PG8_MMA
#undef PG8_WAIT_V
#undef PG8_WAIT_L
#undef PG8_BAR
#undef PG8_SCHED
}
}

enum { EM_IN0 = 0, EM_MKV = 1, EM_GATE = 2, EM_RES = 3, EM_PQ = 4, EM_L1 = 5 };
struct Epi {
    int mode;
    GAS unsigned char* ws;
    const GAS float* resid;
    GAS float* outf;
    GAS bf16_t* o16;
    GAS float* ssq;
    const GAS float* gate_b;
    typedef pg8::Unit Unit;
    __device__ __forceinline__ static void st8(GAS bf16_t* p, f32x4 v0, f32x4 v1) {
        u32x4 w; w.x = cvtpk(v0[0], v0[1]); w.y = cvtpk(v0[2], v0[3]); w.z = cvtpk(v1[0], v1[1]); w.w = cvtpk(v1[2], v1[3]); *(GAS u32x4*)p = w; }
    __device__ __forceinline__ static float sq8(f32x4 a, f32x4 b) { return (a[0] * a[0] + a[1] * a[1]) + (a[2] * a[2] + a[3] * a[3]) + (b[0] * b[0] + b[1] * b[1]) + (b[2] * b[2] + b[3] * b[3]); }
    __device__ __forceinline__ void operator()(f32x4 (&acc)[2][2][4][2], const Unit& u, int wr, int wc, int fr, int fq) const {
        const int row0 = u.pm * 256 + wr * 64 + fr;
        const int cin = wc * 32 + 8 * fq;
        if (mode == EM_IN0) {
            GAS bf16_t* base; int ld, colt; int kind;
            if (u.pn < 6) { base = (GAS bf16_t*)(ws + O_ZX); ld = LRU; colt = u.pn * 256; kind = 0; }
            else if (u.pn < 12) { base = (GAS bf16_t*)(ws + O_GY); ld = LRU; colt = (u.pn - 6) * 256; kind = 1; }
            else { base = (GAS bf16_t*)(ws + O_ZL1); ld = NL1; colt = 4608 + (u.pn - 12) * 256; kind = 2; }
            GAS float* qmss = (GAS float*)(ws + O_SSL1);
#pragma unroll
            for (int ai = 0; ai < 2; ++ai)
#pragma unroll
                for (int m = 0; m < 4; ++m) { const int row = row0 + ai * 128 + m * 16;
#pragma unroll
                    for (int bj = 0; bj < 2; ++bj) { f32x4 v0 = acc[ai][bj][m][0], v1 = acc[ai][bj][m][1];
                        if (kind == 1) {
#pragma unroll
                            for (int j = 0; j < 4; ++j) { v0[j] = gelu_tanh(v0[j]); v1[j] = gelu_tanh(v1[j]); } }
                        st8(base + (size_t)row * ld + colt + bj * 128 + cin, v0, v1);
                        if (kind == 2) { float s = sq8(v0, v1); s = xsum16(s); s = xsum32(s);
                            if (fq == 0) qmss[(size_t)row * 112 + (24 + (u.pn - 12) * 2 + bj) * 4 + wc] = s; } } }
        } else if (mode == EM_MKV) {
#pragma unroll
            for (int ai = 0; ai < 2; ++ai)
#pragma unroll
                for (int m = 0; m < 4; ++m) { const int row = row0 + ai * 128 + m * 16;
#pragma unroll
                    for (int bj = 0; bj < 2; ++bj) { const f32x4 v0 = acc[ai][bj][m][0], v1 = acc[ai][bj][m][1];
                        st8(o16 + (size_t)row * NL1 + u.pn * 256 + bj * 128 + cin, v0, v1);
                        if (u.pn < 2) { float s = sq8(v0, v1); s = xsum16(s); s = xsum32(s);
                            if (fq == 0) ssq[(size_t)row * 112 + (u.pn * 2 + bj) * 4 + wc] = s; } } }
        } else if (mode == EM_GATE) {
            const int ch = u.pn * 128 + cin;
            const GAS bf16_t* xc = (const GAS bf16_t*)(ws + O_XC); GAS _Float16* LA = (GAS _Float16*)(ws + O_AA); GAS _Float16* UH = (GAS _Float16*)(ws + O_UU);
            const GAS float* spl = (const GAS float*)(ws + O_SPL) + ch; const GAS float* gb = gate_b + u.pn * 256 + cin;
#pragma unroll
            for (int n = 0; n < 2; ++n) {
                const f32x4 sp = *(const GAS f32x4*)(spl + 4 * n), br = *(const GAS f32x4*)(gb + 4 * n), bi = *(const GAS f32x4*)(gb + 128 + 4 * n);
#pragma unroll
                for (int ai = 0; ai < 2; ++ai)
#pragma unroll
                    for (int m = 0; m < 4; ++m) { const int row = row0 + ai * 128 + m * 16;
                        const u32x2 xw = *(const GAS u32x2*)(xc + (size_t)row * LRU + ch + 4 * n);
                        const f32x4 xv = {bf_lo(xw.x), bf_hi(xw.x), bf_lo(xw.y), bf_hi(xw.y)};
                        float lav[4], uvv[4];
#pragma unroll
                        for (int j = 0; j < 4; ++j) { const float r = sigmoidf_(acc[ai][0][m][n][j] + br[j]), ig = sigmoidf_(acc[ai][1][m][n][j] + bi[j]);
                            const float la = -8.f * r * sp[j];
                            lav[j] = la; uvv[j] = __builtin_amdgcn_sqrtf(one_minus_exp(2.f * la)) * (ig * xv[j]); }
                        { const h2 l0 = {(_Float16)lav[0], (_Float16)lav[1]}, l1 = {(_Float16)lav[2], (_Float16)lav[3]}, u0 = {(_Float16)uvv[0], (_Float16)uvv[1]}, u1 = {(_Float16)uvv[2], (_Float16)uvv[3]};
                          *(GAS u32x2*)(LA + (size_t)row * LRU + ch + 4 * n) = (u32x2){__builtin_bit_cast(unsigned, l0), __builtin_bit_cast(unsigned, l1)};
                          *(GAS u32x2*)(UH + (size_t)row * LRU + ch + 4 * n) = (u32x2){__builtin_bit_cast(unsigned, u0), __builtin_bit_cast(unsigned, u1)}; } }
            }
        } else if (mode == EM_RES) {
            GAS bf16_t* xs = (GAS bf16_t*)(ws + O_XS16); GAS float* rowss = (GAS float*)(ws + O_ROWSS);
#pragma unroll
            for (int ai = 0; ai < 2; ++ai)
#pragma unroll
                for (int m = 0; m < 4; ++m) { const int row = row0 + ai * 128 + m * 16; float s = 0.f;
#pragma unroll
                    for (int bj = 0; bj < 2; ++bj) { const size_t off = (size_t)row * DM + u.pn * 256 + bj * 128 + cin;
                        f32x4 r0, r1;
                        if (resid) { r0 = *(const GAS f32x4*)(resid + off); r1 = *(const GAS f32x4*)(resid + off + 4); }
                        else { const u32x4 w = *(const GAS u32x4*)(xs + off); r0 = (f32x4){bf_lo(w.x), bf_hi(w.x), bf_lo(w.y), bf_hi(w.y)}; r1 = (f32x4){bf_lo(w.z), bf_hi(w.z), bf_lo(w.w), bf_hi(w.w)}; }
                        const f32x4 v0 = acc[ai][bj][m][0] + r0, v1 = acc[ai][bj][m][1] + r1;
                        st8(xs + off, v0, v1); s += sq8(v0, v1); }
                    s = xsum16(s); s = xsum32(s);
                    if (fq == 0) rowss[(size_t)row * 32 + u.pn * 4 + wc] = s; }
        } else if (mode == EM_PQ) {
            const GAS float* rowss = (const GAS float*)(ws + O_ROWSS);
#pragma unroll
            for (int ai = 0; ai < 2; ++ai)
#pragma unroll
                for (int m = 0; m < 4; ++m) { const int row = row0 + ai * 128 + m * 16;
                    const f32x4 p0 = *(const GAS f32x4*)(rowss + (size_t)row * 32 + fq * 8), p1 = *(const GAS f32x4*)(rowss + (size_t)row * 32 + fq * 8 + 4);
                    float s = (p0[0] + p0[1]) + (p0[2] + p0[3]) + (p1[0] + p1[1]) + (p1[2] + p1[3]); s = xsum16(s); s = xsum32(s);
                    const float r = rsqrtf(s * (1.f / DM) + EPS);
#pragma unroll
                    for (int bj = 0; bj < 2; ++bj) st8(o16 + (size_t)row * DM + u.pn * 256 + bj * 128 + cin, acc[ai][bj][m][0] * r, acc[ai][bj][m][1] * r); }
        } else {
            const GAS float* rsp = (const GAS float*)(ws + O_RSP); GAS bf16_t* zl1 = (GAS bf16_t*)(ws + O_ZL1); GAS float* ssl1 = (GAS float*)(ws + O_SSL1);
            const int slot0 = u.pn < 6 ? u.pn * 2 : (u.pn >= 12 ? 12 + (u.pn - 12) * 2 : -1);
#pragma unroll
            for (int ai = 0; ai < 2; ++ai)
#pragma unroll
                for (int m = 0; m < 4; ++m) { const int row = row0 + ai * 128 + m * 16;
                    const f32x4 q0 = *(const GAS f32x4*)(rsp + (size_t)row * 8), q1 = *(const GAS f32x4*)(rsp + (size_t)row * 8 + 4);
                    const float r = rsqrtf(((q0[0] + q0[1]) + (q0[2] + q0[3]) + (q1[0] + q1[1]) + (q1[2] + q1[3])) * (1.f / DM) + EPS);
#pragma unroll
                    for (int bj = 0; bj < 2; ++bj) { const f32x4 v0 = acc[ai][bj][m][0] * r, v1 = acc[ai][bj][m][1] * r;
                        st8(zl1 + (size_t)row * NL1 + u.pn * 256 + bj * 128 + cin, v0, v1);
                        if (slot0 >= 0) { float s = sq8(v0, v1); s = xsum16(s); s = xsum32(s);
                            if (fq == 0) ssl1[(size_t)row * 112 + (slot0 + bj) * 4 + wc] = s; } } }
        }
    }
};

namespace att {
constexpr float SCALE = 0.08838834764831845f;
constexpr int NW = 8, QBLK = 32, KVBLK = 64, QB = NW * QBLK, D = 128;
constexpr int SHM_V = KVBLK * D * 2, SHM_K = KVBLK * D * 2;
constexpr int OFF_WS = 2 * SHM_V + 2 * SHM_K;
constexpr int OFF_KS = OFF_WS + 2048;
constexpr int OFF_BS = OFF_KS + 16384;
constexpr int LDS_END = OFF_BS + 16384;
constexpr int WBIG = 1 << 28;

#define KSWZ(row, colB) ((row) * 256 + ((colB) ^ (((row) & 7) << 4)))
#define SBAR() __builtin_amdgcn_sched_barrier(0)
__device__ __forceinline__ int v_st(int k, int c) { const int kk = (k & ~0xC) | ((k & 4) << 1) | ((k & 8) >> 1); return ((kk >> 3) * 4 + (c >> 5)) * 512 + ((kk & 7) * 32 + (c & 31)) * 2; }
__device__ __forceinline__ int v_rd_base(int lane) { return ((lane & 3) << 3) | (((lane >> 2) & 3) << 6) | (((lane >> 4) & 1) << 5) | (((lane >> 5) & 1) << 8); }
constexpr int v_rd_off(int d0, int ks, int half) { return d0 * 512 + ks * 4096 + half * 2048; }
__device__ __forceinline__ int crow(int r, int hi) { return (r & 3) + 8 * (r >> 2) + 4 * hi; }
__device__ __forceinline__ bf16x8 load8(const GAS bf16_t* p) { return *(const GAS bf16x8*)p; }
__device__ __forceinline__ bf16x8 scale8(bf16x8 v, float s) { const u32x4 w = *reinterpret_cast<u32x4*>(&v); u32x4 o;
    o.x = cvtpk(bf_lo(w.x) * s, bf_hi(w.x) * s); o.y = cvtpk(bf_lo(w.y) * s, bf_hi(w.y) * s); o.z = cvtpk(bf_lo(w.z) * s, bf_hi(w.z) * s); o.w = cvtpk(bf_lo(w.w) * s, bf_hi(w.w) * s);
    return *reinterpret_cast<bf16x8*>(&o); }
__device__ __forceinline__ void mask_tile(f32x16& p0, f32x16& p1, int dq, unsigned W) {
    const float NEG = -__builtin_inff();
#pragma unroll
    for (int r = 0; r < 16; ++r) {
        const int c = (r & 3) + 8 * (r >> 2);
        if ((unsigned)(dq - c) >= W) p0[r] = NEG;
        if ((unsigned)(dq - c - 32) >= W) p1[r] = NEG;
    }
}
constexpr float THR = 8.f;
__device__ __forceinline__ void partialSM(f32x16& p0, f32x16& p1, float& m_reg, float& mn, float& alpha) {
    float pmax = p0[0]; for (int r = 1; r < 16; ++r) pmax = fmaxf(pmax, p0[r]); for (int r = 0; r < 16; ++r) pmax = fmaxf(pmax, p1[r]);
    { auto rr = __builtin_amdgcn_permlane32_swap(__float_as_uint(pmax), __float_as_uint(pmax), false, false);
      pmax = fmaxf(__uint_as_float(rr[0]), __uint_as_float(rr[1])); }
    constexpr float C2 = 1.4426950408889634f * SCALE;
    if (__builtin_expect(__all((pmax - m_reg) * SCALE <= THR), 1)) { mn = m_reg; alpha = 1.f; }
    else { mn = fmaxf(m_reg, pmax); alpha = __builtin_amdgcn_exp2f((m_reg - mn) * C2); m_reg = mn; }
    const float mnL = -mn * C2;
    for (int r = 0; r < 16; ++r) p0[r] = fmaf(p0[r], C2, mnL); for (int r = 0; r < 16; ++r) p1[r] = fmaf(p1[r], C2, mnL);
    for (int r = 0; r < 16; ++r) p0[r] = __builtin_amdgcn_exp2f(p0[r]);
}
__device__ __forceinline__ void finishSM(f32x16& p0, f32x16& p1, float alpha, float& l_reg, bf16x8& pa0, bf16x8& pa1, bf16x8& pa2, bf16x8& pa3) {
    for (int r = 0; r < 16; ++r) p1[r] = __builtin_amdgcn_exp2f(p1[r]);
    float ps = 0; for (int r = 0; r < 16; ++r) ps += p0[r]; for (int r = 0; r < 16; ++r) ps += p1[r];
    { auto rr = __builtin_amdgcn_permlane32_swap(__float_as_uint(ps), __float_as_uint(ps), false, false);
      ps = __uint_as_float(rr[0]) + __uint_as_float(rr[1]); }
    l_reg = l_reg * alpha + ps;
#define PK4(P, B_, OUT) do { unsigned a0 = cvtpk(P[B_+0], P[B_+1]), a1 = cvtpk(P[B_+2], P[B_+3]);                          \
        unsigned b0 = cvtpk(P[B_+4], P[B_+5]), b1 = cvtpk(P[B_+6], P[B_+7]);                                             \
        auto r0 = __builtin_amdgcn_permlane32_swap(a0, b0, false, false); auto r1 = __builtin_amdgcn_permlane32_swap(a1, b1, false, false); \
        u32x4 w = {r0[0], r1[0], r0[1], r1[1]}; OUT = *reinterpret_cast<bf16x8*>(&w); } while (0)
    PK4(p0, 0, pa0); PK4(p0, 8, pa1); PK4(p1, 0, pa2); PK4(p1, 8, pa3);
#undef PK4
}
template <int KB>
__device__ __forceinline__ void qkt(f32x16& p0, f32x16& p1, const char* K_lds, int r32, int hi, const bf16x8* qr, const float* bp  ) {
    { const f32x4 a = *(const f32x4*)(bp), b = *(const f32x4*)(bp + 8), c = *(const f32x4*)(bp + 16), d = *(const f32x4*)(bp + 24);
      p0 = (f32x16){a[0], a[1], a[2], a[3], b[0], b[1], b[2], b[3], c[0], c[1], c[2], c[3], d[0], d[1], d[2], d[3]}; }
    { const f32x4 a = *(const f32x4*)(bp + 32), b = *(const f32x4*)(bp + 40), c = *(const f32x4*)(bp + 48), d = *(const f32x4*)(bp + 56);
      p1 = (f32x16){a[0], a[1], a[2], a[3], b[0], b[1], b[2], b[3], c[0], c[1], c[2], c[3], d[0], d[1], d[2], d[3]}; }
    const char* kb[4];
#pragma unroll
    for (int dd = 0; dd < 4; ++dd) kb[dd] = K_lds + KB * SHM_K + KSWZ(r32, (dd * 16 + hi * 8) * 2);
#pragma unroll
    for (int d0 = 0; d0 < 8; ++d0) { const char* a = kb[d0 & 3] + (d0 >> 2) * 128;
        bf16x8 b0 = *reinterpret_cast<const bf16x8*>(a);
        bf16x8 b1 = *reinterpret_cast<const bf16x8*>(a + 32 * 256);
        p0 = __builtin_amdgcn_mfma_f32_32x32x16_bf16(b0, qr[d0], p0, 0, 0, 0);
        p1 = __builtin_amdgcn_mfma_f32_32x32x16_bf16(b1, qr[d0], p1, 0, 0, 0); }
}
template <int KB>
__device__ __forceinline__ void qkt0(f32x16& p0, f32x16& p1, const char* K_lds, int r32, int hi, const bf16x8* qr) {
    p0 = f32x16{}; p1 = f32x16{};
    const char* kb[4];
#pragma unroll
    for (int dd = 0; dd < 4; ++dd) kb[dd] = K_lds + KB * SHM_K + KSWZ(r32, (dd * 16 + hi * 8) * 2);
#pragma unroll
    for (int d0 = 0; d0 < 8; ++d0) { const char* a = kb[d0 & 3] + (d0 >> 2) * 128;
        bf16x8 b0 = *reinterpret_cast<const bf16x8*>(a);
        bf16x8 b1 = *reinterpret_cast<const bf16x8*>(a + 32 * 256);
        p0 = __builtin_amdgcn_mfma_f32_32x32x16_bf16(b0, qr[d0], p0, 0, 0, 0);
        p1 = __builtin_amdgcn_mfma_f32_32x32x16_bf16(b1, qr[d0], p1, 0, 0, 0); }
}
template <int VB>
__device__ __forceinline__ void pv_tile(f32x16* o, int vb0, bf16x8 pa0, bf16x8 pa1, bf16x8 pa2, bf16x8 pa3) {
#define TRRD(dst, off) asm volatile("ds_read_b64_tr_b16 %0, %1 offset:%2" : "=&v"(dst) : "v"(vb0), "i"(off) : "memory")
#define PV_D0(d0) do { s16x4 l0, l1, l2, l3, h0, h1, h2_, h3; constexpr int b_ = VB * SHM_V + v_rd_off(d0, 0, 0); \
        TRRD(l0, b_); TRRD(h0, b_ + 2048); TRRD(l1, b_ + 4096); TRRD(h1, b_ + 6144); TRRD(l2, b_ + 8192); TRRD(h2_, b_ + 10240); TRRD(l3, b_ + 12288); TRRD(h3, b_ + 14336); \
        asm volatile("s_waitcnt lgkmcnt(0)" ::: "memory"); SBAR();   \
        o[d0] = __builtin_amdgcn_mfma_f32_32x32x16_bf16(pa0, (bf16x8){l0[0], l0[1], l0[2], l0[3], h0[0], h0[1], h0[2], h0[3]}, o[d0], 0, 0, 0);   \
        o[d0] = __builtin_amdgcn_mfma_f32_32x32x16_bf16(pa1, (bf16x8){l1[0], l1[1], l1[2], l1[3], h1[0], h1[1], h1[2], h1[3]}, o[d0], 0, 0, 0);   \
        o[d0] = __builtin_amdgcn_mfma_f32_32x32x16_bf16(pa2, (bf16x8){l2[0], l2[1], l2[2], l2[3], h2_[0], h2_[1], h2_[2], h2_[3]}, o[d0], 0, 0, 0);   \
        o[d0] = __builtin_amdgcn_mfma_f32_32x32x16_bf16(pa3, (bf16x8){l3[0], l3[1], l3[2], l3[3], h3[0], h3[1], h3[2], h3[3]}, o[d0], 0, 0, 0); } while (0)
    PV_D0(0); PV_D0(1); PV_D0(2); PV_D0(3);
#undef PV_D0
#undef TRRD
}

struct BlockRef { const GAS bf16_t* Q; const GAS bf16_t* K; const GAS bf16_t* V; GAS bf16_t* O; const GAS float* qss; const GAS float* kss; const GAS float* cc; const GAS float* gg;
                  int P0, skv; };
constexpr int LDQ = 5120, LDK = 5120, LDO = 2048, LDSS = 112;
struct Seam { bf16x8 qr[8]; bf16x8 st_v0, st_v1, st_k0, st_k1; int jlo; };
#define ROWK(p, k0, rr) ((p) + (size_t)((k0) + (rr)) * LDK + sc)
#define VMW() asm volatile("s_waitcnt vmcnt(0)" ::: "memory")
#define VMWN(n) asm volatile("s_waitcnt vmcnt(%0)" :: "i"(n) : "memory")
#define SLOAD_H(Kp, Vp, k0) do { S.st_v0 = load8(ROWK(Vp, k0, sr)); S.st_v1 = load8(ROWK(Vp, k0, 32 + sr));              \
                         S.st_k0 = load8(ROWK(Kp, k0, sr)); S.st_k1 = load8(ROWK(Kp, k0, 32 + sr)); } while (0)
#define SWRITE_HK(bf, k0) do { *(bf16x8*)(K_lds + (bf) * SHM_K + kws) = scale8(S.st_k0, ksr[(k0)]); *(bf16x8*)(K_lds + (bf) * SHM_K + kws + 32 * 256) = scale8(S.st_k1, ksr[(k0) + 32]); } while (0)
#define SWRITE_HV(bf) do { *(bf16x8*)(V_lds + (bf) * SHM_V + vst0) = S.st_v0; *(bf16x8*)(V_lds + (bf) * SHM_V + vst1) = S.st_v1; } while (0)
#define SWRITE_H(bf, k0) do { SWRITE_HV(bf); SWRITE_HK(bf, k0); } while (0)

__device__ __forceinline__ void attn_prime(const BlockRef& cur, char* lds, Seam& S, const int tid) {
    const int wid = __builtin_amdgcn_readfirstlane(tid >> 6), lane = tid & 63, r32 = lane & 31, hi = lane >> 5;
    const int sr = tid >> 4, sc = (tid & 15) * 8, kws = KSWZ(sr, sc * 2); char* K_lds = lds + 2 * SHM_V;
    float* ks_l = (float*)(lds + OFF_KS); float* bs_l = (float*)(lds + OFF_BS); const float* ksr = ks_l + sr;
    int j_hi = (cur.P0 + QB - 1) / KVBLK + 1; if (j_hi > cur.skv / KVBLK) j_hi = cur.skv / KVBLK;
    const int nkeys = j_hi * KVBLK;
    const float c0 = cur.cc ? cur.cc[cur.P0] : 0.f;
    int jlo = 0;
    if (cur.cc) { const float thr = cur.gg[128]; const int jd = cur.P0 / KVBLK;
        const float cv = lane <= jd ? cur.cc[lane * KVBLK + KVBLK - 1] : 0.f;
        const bool keep = lane > jd || (c0 - cv > -thr);
        jlo = __ffsll((long long)__ballot(keep)) - 1; }
    S.jlo = jlo;
    for (int s = jlo * KVBLK + tid; s < nkeys; s += NTHREADS) {
        const f32x4 p = *(const GAS f32x4*)(cur.kss + (size_t)s * LDSS);
        ks_l[s] = rsqrtf(((p[0] + p[1]) + (p[2] + p[3])) * (1.f / 128.f) + EPS);
        bs_l[s] = cur.cc ? (c0 - cur.cc[s]) * (1.f / SCALE) : 0.f;
    }
    __syncthreads();
    const int qrow = wid * QBLK + r32;
    const f32x4 qp = *(const GAS f32x4*)(cur.qss + (size_t)qrow * LDSS);
    const float rq = rsqrtf(((qp[0] + qp[1]) + (qp[2] + qp[3])) * (1.f / 128.f) + EPS);
#pragma unroll
    for (int d0 = 0; d0 < 8; ++d0) {
        const u32x4 w = *(const GAS u32x4*)(cur.Q + (size_t)qrow * LDQ + d0 * 16 + hi * 8);
        const f32x4 g0 = *(const GAS f32x4*)(cur.gg + d0 * 16 + hi * 8), g1 = *(const GAS f32x4*)(cur.gg + d0 * 16 + hi * 8 + 4);
        u32x4 o; o.x = cvtpk(bf_lo(w.x) * rq * g0[0], bf_hi(w.x) * rq * g0[1]); o.y = cvtpk(bf_lo(w.y) * rq * g0[2], bf_hi(w.y) * rq * g0[3]);
        o.z = cvtpk(bf_lo(w.z) * rq * g1[0], bf_hi(w.z) * rq * g1[1]); o.w = cvtpk(bf_lo(w.w) * rq * g1[2], bf_hi(w.w) * rq * g1[3]);
        S.qr[d0] = *reinterpret_cast<bf16x8*>(&o);
    }
    SLOAD_H(cur.K, cur.V, jlo * KVBLK); VMW(); SWRITE_HK(0, jlo * KVBLK);
    __syncthreads();
}
__device__ __forceinline__ void attn_block(const BlockRef& cur, char* lds, Seam& S, const int tid) {
    const int wid = __builtin_amdgcn_readfirstlane(tid >> 6), lane = tid & 63, r32 = lane & 31, hi = lane >> 5;
    const int W = WBIG;
    int j_hi = (cur.P0 + QB - 1) / KVBLK + 1; if (j_hi > cur.skv / KVBLK) j_hi = cur.skv / KVBLK;
    const int j_lo = S.jlo; const int NT = j_hi - j_lo;
    const int qlo = cur.P0 - j_lo * KVBLK + wid * QBLK, qm = qlo + r32 - 4 * hi;
    char* V_lds = lds; char* K_lds = lds + 2 * SHM_V;
    float* ws = (float*)(lds + OFF_WS) + wid * 64; float* li_l = ws, * al_l = ws + 32;
    const float* bs_l = (const float*)(lds + OFF_BS) + j_lo * KVBLK + 4 * hi;
    float m_reg = -1e30f, l_reg = 0; f32x16 o[4] = {};
    const int sr = tid >> 4, sc = (tid & 15) * 8, vst0 = v_st(sr, sc), vst1 = v_st(32 + sr, sc), kws = KSWZ(sr, sc * 2);
    const float* ksr = (const float*)(lds + OFF_KS) + j_lo * KVBLK + sr;
    const int vb0 = (int)(uintptr_t)V_lds + v_rd_base(lane);
    const GAS bf16_t* Kh = cur.K + (size_t)j_lo * KVBLK * LDK; const GAS bf16_t* Vh = cur.V + (size_t)j_lo * KVBLK * LDK;
#define RESC(a) do { if (__any((a) < 1.f)) { if (hi == 0) al_l[r32] = (a); asm volatile("s_waitcnt lgkmcnt(0)" ::: "memory");              \
                     for (int d_ = 0; d_ < 4; ++d_) for (int r = 0; r < 16; ++r) o[d_][r] *= al_l[crow(r, hi)]; } } while (0)
#define KBASE(t) ((t) * KVBLK)
#define MASKT(P0_, P1_, t) do { const int kb_ = KBASE(t); if (kb_ + KVBLK - 1 > qlo) mask_tile(P0_, P1_, qm - kb_, (unsigned)W); } while (0)
    f32x16 pA0, pA1, pB0, pB1; float mnA, mnB, alA, alB; bf16x8 pa0, pa1, pa2, pa3;
    SWRITE_HV(0); SBAR();
    if (NT > 1) { SLOAD_H(Kh, Vh, KBASE(1)); }
    SBAR(); qkt<0>(pA0, pA1, K_lds, r32, hi, S.qr, bs_l + KBASE(0));
    MASKT(pA0, pA1, 0); partialSM(pA0, pA1, m_reg, mnA, alA);
    if (NT > 1) { VMW(); SWRITE_H(1, KBASE(1)); }
    __syncthreads();
#define HALF_STEP(PX0, PX1, mnX, alX, PY0, PY1, alY, t, KB, VB, SB) do {                                                      \
        SBAR(); qkt<KB>(PX0, PX1, K_lds, r32, hi, S.qr, bs_l + KBASE(t));                                                         \
        finishSM(PY0, PY1, alY, l_reg, pa0, pa1, pa2, pa3); SBAR();                                                           \
        if ((t) + 1 < NT) { SLOAD_H(Kh, Vh, KBASE((t) + 1)); SBAR(); }                                               \
        pv_tile<VB>(o, vb0, pa0, pa1, pa2, pa3); MASKT(PX0, PX1, (t)); partialSM(PX0, PX1, m_reg, mnX, alX);                                        \
        __syncthreads();                                                                                                      \
        if ((t) + 1 < NT) { VMW(); SWRITE_H(SB, KBASE((t) + 1)); }                                                                          \
        RESC(alX); __syncthreads(); } while (0)
    for (int t = 1; t + 1 < NT; t += 2) {
        HALF_STEP(pB0, pB1, mnB, alB, pA0, pA1, alA, t, 1, 0, 0);
        HALF_STEP(pA0, pA1, mnA, alA, pB0, pB1, alB, t + 1, 0, 1, 1);
    }
    const bool even = (NT & 1) == 0;
    if (even) { SBAR(); qkt<1>(pB0, pB1, K_lds, r32, hi, S.qr, bs_l + KBASE(NT - 1)); SBAR(); }
    finishSM(pA0, pA1, alA, l_reg, pa0, pa1, pa2, pa3); SBAR();
    pv_tile<0>(o, vb0, pa0, pa1, pa2, pa3);
    if (even) { MASKT(pB0, pB1, NT - 1); partialSM(pB0, pB1, m_reg, mnB, alB); __syncthreads(); RESC(alB);
        finishSM(pB0, pB1, alB, l_reg, pa0, pa1, pa2, pa3); SBAR(); pv_tile<1>(o, vb0, pa0, pa1, pa2, pa3); }
    SBAR();
    if (hi == 0) li_l[r32] = l_reg; asm volatile("s_waitcnt lgkmcnt(0)" ::: "memory");
    float rli[16];
#pragma unroll
    for (int r = 0; r < 16; ++r) rli[r] = __builtin_amdgcn_rcpf(li_l[crow(r, hi)]);
    GAS bf16_t* Ow = cur.O + (size_t)(wid * QBLK) * LDO;
#pragma unroll
    for (int r = 0; r < 16; ++r) { const int orow = crow(r, hi);
#pragma unroll
        for (int d0 = 0; d0 < 4; ++d0) { const float v = o[d0][r] * rli[r];
            const float vn = dppf<0xB1>(v);
            if ((r32 & 1) == 0) *(GAS unsigned*)(Ow + (size_t)orow * LDO + d0 * 32 + r32) = cvtpk(v, vn); } }
    __syncthreads();
#undef RESC
#undef KBASE
#undef MASKT
#undef HALF_STEP
}
constexpr int MOFF_K = 4 * SHM_V, MOFF_WS = MOFF_K + 4 * SHM_K, MOFF_KS = MOFF_WS + 2048;
__device__ __forceinline__ void mem_attn_unit(const BlockRef& cur, char* lds, const int tid) {
    const int wid = __builtin_amdgcn_readfirstlane(tid >> 6), lane = tid & 63, r32 = lane & 31, hi = lane >> 5;
    const int sr = tid >> 4, sc = (tid & 15) * 8, kws = KSWZ(sr, sc * 2), vst0 = v_st(sr, sc), vst1 = v_st(32 + sr, sc);
    char* V_lds = lds; char* K_lds = lds + MOFF_K; float* ks_l = (float*)(lds + MOFF_KS);
    float* ws = (float*)(lds + MOFF_WS) + wid * 64; float* li_l = ws, * al_l = ws + 32;
    float ksv = 0.f;
    if (tid < 256) { const f32x4 p = *(const GAS f32x4*)(cur.kss + (size_t)tid * LDSS); ksv = rsqrtf(((p[0] + p[1]) + (p[2] + p[3])) * (1.f / 128.f) + EPS); }
    bf16x8 kk[4][2], vv[4][2];
#pragma unroll
    for (int t = 0; t < 4; ++t) { kk[t][0] = load8(ROWK(cur.K, t * KVBLK, sr)); kk[t][1] = load8(ROWK(cur.K, t * KVBLK, 32 + sr)); vv[t][0] = load8(ROWK(cur.V, t * KVBLK, sr)); vv[t][1] = load8(ROWK(cur.V, t * KVBLK, 32 + sr)); }
    const int qrow = wid * QBLK + r32;
    const f32x4 qp = *(const GAS f32x4*)(cur.qss + (size_t)qrow * LDSS);
    u32x4 qw[8];
#pragma unroll
    for (int d0 = 0; d0 < 8; ++d0) qw[d0] = *(const GAS u32x4*)(cur.Q + (size_t)qrow * LDQ + d0 * 16 + hi * 8);
    if (tid < 256) ks_l[tid] = ksv;
    __syncthreads();
#pragma unroll
    for (int t = 0; t < 4; ++t) { *(bf16x8*)(K_lds + t * SHM_K + kws) = scale8(kk[t][0], ks_l[t * KVBLK + sr]); *(bf16x8*)(K_lds + t * SHM_K + kws + 32 * 256) = scale8(kk[t][1], ks_l[t * KVBLK + 32 + sr]);
        *(bf16x8*)(V_lds + t * SHM_V + vst0) = vv[t][0]; *(bf16x8*)(V_lds + t * SHM_V + vst1) = vv[t][1]; }
    const float rq = rsqrtf(((qp[0] + qp[1]) + (qp[2] + qp[3])) * (1.f / 128.f) + EPS);
    bf16x8 qr[8];
#pragma unroll
    for (int d0 = 0; d0 < 8; ++d0) { const u32x4 w = qw[d0];
        const f32x4 g0 = *(const GAS f32x4*)(cur.gg + d0 * 16 + hi * 8), g1 = *(const GAS f32x4*)(cur.gg + d0 * 16 + hi * 8 + 4);
        u32x4 o; o.x = cvtpk(bf_lo(w.x) * rq * g0[0], bf_hi(w.x) * rq * g0[1]); o.y = cvtpk(bf_lo(w.y) * rq * g0[2], bf_hi(w.y) * rq * g0[3]);
        o.z = cvtpk(bf_lo(w.z) * rq * g1[0], bf_hi(w.z) * rq * g1[1]); o.w = cvtpk(bf_lo(w.w) * rq * g1[2], bf_hi(w.w) * rq * g1[3]);
        qr[d0] = *reinterpret_cast<bf16x8*>(&o); }
    __syncthreads();
    const int vb0 = (int)(uintptr_t)V_lds + v_rd_base(lane);
    float m_reg = -1e30f, l_reg = 0; f32x16 o[4] = {};
#define MEM_TILE(t) do { f32x16 p0, p1; float mn, al; bf16x8 pa0, pa1, pa2, pa3; \
        qkt0<t>(p0, p1, K_lds, r32, hi, qr); partialSM(p0, p1, m_reg, mn, al); \
        if (__any(al < 1.f)) { if (hi == 0) al_l[r32] = al; asm volatile("s_waitcnt lgkmcnt(0)" ::: "memory"); for (int d_ = 0; d_ < 4; ++d_) for (int r = 0; r < 16; ++r) o[d_][r] *= al_l[crow(r, hi)]; } \
        finishSM(p0, p1, al, l_reg, pa0, pa1, pa2, pa3); SBAR(); pv_tile<t>(o, vb0, pa0, pa1, pa2, pa3); SBAR(); } while (0)
    MEM_TILE(0); MEM_TILE(1); MEM_TILE(2); MEM_TILE(3);
#undef MEM_TILE
    if (hi == 0) li_l[r32] = l_reg; asm volatile("s_waitcnt lgkmcnt(0)" ::: "memory");
    float rli[16];
#pragma unroll
    for (int r = 0; r < 16; ++r) rli[r] = __builtin_amdgcn_rcpf(li_l[crow(r, hi)]);
    GAS bf16_t* Ow = cur.O + (size_t)(wid * QBLK) * LDO;
#pragma unroll
    for (int r = 0; r < 16; ++r) { const int orow = crow(r, hi);
#pragma unroll
        for (int d0 = 0; d0 < 4; ++d0) { const float v = o[d0][r] * rli[r];
            const float vn = dppf<0xB1>(v);
            if ((r32 & 1) == 0) *(GAS unsigned*)(Ow + (size_t)orow * LDO + d0 * 32 + r32) = cvtpk(v, vn); } }
    __syncthreads();
}
#undef ROWK
#undef VMW
#undef VMWN
#undef SLOAD_H
#undef SWRITE_HK
#undef SWRITE_HV
#undef SWRITE_H
#undef KSWZ
#undef SBAR
}


struct Frame {
    GAS unsigned char* ws; const float* const* in_; GAS float* out;
    __device__ __forceinline__ const GAS float* in(int i) const { return (const GAS float*)in_[i]; }
    int tid, lane, wave, gw, ngw, gtid, ngt;
};
enum { I_X = 0, I_MEM, I_ANORM, I_AWIN, I_ACONVW, I_ACONVB, I_AGATEW, I_AGATEB, I_ALAMBDA, I_AWOUT, I_SNORM, I_SWKVF, I_SBF, I_SKNORM, I_BNORM, I_BWIN, I_BQNORM, I_BWOUT,
       I_MNORM, I_MWKV, I_MQNORM, I_MKNORM, I_PNORM, I_PWQ, I_PSUBK, I_PU, I_PV, N_IN };

struct TrItem { const GAS float* W; const GAS float* gain; GAS bf16_t* WT; int ldw, ldt, row_off, k0, n0; };
__device__ __forceinline__ void tr_load(const TrItem& d, float (&wv)[32], int lane) {
#pragma unroll
    for (int i = 0; i < 32; ++i) wv[i] = __builtin_nontemporal_load(d.W + (size_t)(d.k0 + 2 * i + (lane >> 5)) * d.ldw + d.n0 + (lane & 31));
}
__device__ __forceinline__ void tr_proc(const TrItem& d, float (&wv)[32], LAS float* scr, int lane) {
    if (d.gain) {
#pragma unroll
        for (int i = 0; i < 32; ++i) wv[i] *= d.gain[d.k0 + 2 * i + (lane >> 5)]; }
#pragma unroll
    for (int i = 0; i < 32; ++i) scr[(2 * i + (lane >> 5)) * 33 + (lane & 31)] = wv[i];
    asm volatile("s_waitcnt lgkmcnt(0)" ::: "memory");
    const int c = lane & 7;
#pragma unroll
    for (int j = 0; j < 4; ++j) { const int n = (lane >> 3) + 8 * j; const LAS float* s = scr + (8 * c) * 33 + n;
        u32x4 o; o.x = cvtpk(s[0 * 33], s[1 * 33]); o.y = cvtpk(s[2 * 33], s[3 * 33]); o.z = cvtpk(s[4 * 33], s[5 * 33]); o.w = cvtpk(s[6 * 33], s[7 * 33]);
        *(GAS u32x4*)(d.WT + (size_t)(d.row_off + d.n0 + n) * d.ldt + d.k0 + 8 * c) = o; }
    asm volatile("s_waitcnt lgkmcnt(0)" ::: "memory");
}
__device__ __forceinline__ void transpose_item_fp8(const GAS float* W, int ldw, const GAS float* gain, GAS unsigned char* WT, int ldt, LAS float* scr, int nblk, int item, int lane) {
    const int kb = item / nblk, nb = item % nblk, k0 = 64 * kb, n0 = 32 * nb;
    float wv[32];
#pragma unroll
    for (int i = 0; i < 32; ++i) wv[i] = W[(size_t)(k0 + 2 * i + (lane >> 5)) * ldw + n0 + (lane & 31)];
#pragma unroll
    for (int i = 0; i < 32; ++i) wv[i] *= gain[k0 + 2 * i + (lane >> 5)] * 64.f;
#pragma unroll
    for (int i = 0; i < 32; ++i) scr[(2 * i + (lane >> 5)) * 33 + (lane & 31)] = wv[i];
    asm volatile("s_waitcnt lgkmcnt(0)" ::: "memory");
    const int c = lane & 3;
#pragma unroll
    for (int j = 0; j < 2; ++j) { const int n = (lane >> 2) + 16 * j; const LAS float* sp = scr + (16 * c) * 33 + n; u32x4 o;
#pragma unroll
        for (int w = 0; w < 4; ++w) { int pk = __builtin_amdgcn_cvt_pk_fp8_f32(sp[(4 * w) * 33], sp[(4 * w + 1) * 33], 0, false); pk = __builtin_amdgcn_cvt_pk_fp8_f32(sp[(4 * w + 2) * 33], sp[(4 * w + 3) * 33], pk, true); o[w] = (unsigned)pk; }
        *(GAS u32x4*)(WT + (size_t)(n0 + n) * ldt + k0 + 16 * c) = o; }
    asm volatile("s_waitcnt lgkmcnt(0)" ::: "memory");
}
struct CtRow { f32x4 v[8]; GAS unsigned char* dst; int row, which; };
__device__ __forceinline__ void ct_load(Frame& F, int layer, int it, CtRow& R) {
    R.which = it & 1; R.row = it >> 1;
    const GAS float* src = F.in(R.which ? I_PV : I_PU) + ((size_t)layer * NEXP + R.row) * DM + F.lane * 4;
    R.dst = F.ws + O_TAB + (size_t)(layer * 2 + R.which) * TAB_ONE;
#pragma unroll
    for (int c = 0; c < 8; ++c) R.v[c] = __builtin_nontemporal_load((const GAS f32x4*)(src + c * 256));
}
__device__ __forceinline__ void ct_proc(Frame& F, int layer, CtRow& R, const f32x4 (&gnr)[8]) {
    _Float16 shv = (_Float16)0.f;
#pragma unroll
    for (int c = 0; c < 8; ++c) { f32x4 x = R.v[c]; if (!R.which) x = x * gnr[c];
        float amax = fmaxf(fmaxf(fabsf(x[0]), fabsf(x[1])), fmaxf(fabsf(x[2]), fabsf(x[3])));
        amax = wave_max(amax);
        const _Float16 sh = (_Float16)fmaxf(amax * (1.f / 6.f), 1e-6f);
        const float qs = __builtin_amdgcn_rcpf((float)sh);
        unsigned pk = __builtin_amdgcn_cvt_scalef32_pk_fp4_f32(0u, x[0] * qs, x[1] * qs, 1.0f, 0); pk = __builtin_amdgcn_cvt_scalef32_pk_fp4_f32(pk, x[2] * qs, x[3] * qs, 1.0f, 1);
        *(GAS unsigned short*)(R.dst + ((size_t)c * NEXP + R.row) * 128 + F.lane * 2) = (unsigned short)pk;
        shv = (F.lane == c) ? sh : shv; }
    if (F.lane < 8) *(GAS unsigned short*)(R.dst + TAB_NIB + ((size_t)R.row * 8 + F.lane) * 2) = __builtin_bit_cast(unsigned short, shv);
}
__device__ __forceinline__ void convert_tables(Frame& F, int layer, int ibeg, int iend, int wk, int nwk) {
    if (ibeg + wk >= iend) return;
    const int ilast = ibeg + wk + ((iend - 1 - ibeg - wk) / nwk) * nwk;
    CtRow A, B;
    f32x4 gnr[8];
#pragma unroll
    for (int c = 0; c < 8; ++c) gnr[c] = *(const GAS f32x4*)(F.in(I_PNORM) + layer * DM + F.lane * 4 + c * 256);
    ct_load(F, layer, ibeg + wk, A);
    for (int it = ibeg + wk; it < iend; it += 2 * nwk) {
        ct_load(F, layer, it + nwk <= ilast ? it + nwk : ilast, B);
        ct_proc(F, layer, A, gnr);
        ct_load(F, layer, it + 2 * nwk <= ilast ? it + 2 * nwk : ilast, A);
        if (it + nwk < iend) ct_proc(F, layer, B, gnr);
    }
}
__device__ __forceinline__ void norm_row_bf16(const GAS float* xrow, const GAS float* gain, GAS bf16_t* orow, int lane) {
    f32x4 v[8]; float s = 0.f;
#pragma unroll
    for (int j = 0; j < 8; ++j) { v[j] = *(const GAS f32x4*)(xrow + j * 256 + lane * 4); s += (v[j][0] * v[j][0] + v[j][1] * v[j][1]) + (v[j][2] * v[j][2] + v[j][3] * v[j][3]); }
    const float r = rsqrtf(wave_sum(s) * (1.f / DM) + EPS);
#pragma unroll
    for (int j = 0; j < 8; ++j) { f32x4 g = gain ? *(const GAS f32x4*)(gain + j * 256 + lane * 4) : (f32x4){1.f, 1.f, 1.f, 1.f};
        u32x2 o; o.x = cvtpk(v[j][0] * r * g[0], v[j][1] * r * g[1]); o.y = cvtpk(v[j][2] * r * g[2], v[j][3] * r * g[3]);
        *(GAS u32x2*)(orow + j * 256 + lane * 4) = o; }
}
__device__ __forceinline__ void step_prologue(Frame& F, LAS unsigned char* lds) {
    LAS float* scr = (LAS float*)(lds + F.wave * 16384);
    GAS unsigned char* ws = F.ws;
    constexpr int I0 = 32 * (NIN0 / 32), I1 = 32 * 64, I2 = 32 * 96, I3 = 32 * 64, I4 = 32 * 64, I5 = 32 * 64, I6 = 32 * 64, I7 = 32 * 32, I8 = 32 * 32, I9 = 12 * 16;
    constexpr int NITEMS = I0 + I1 + I2 + I3 + I4 + I5 + I6 + I7 + I8 + I9;
#define TR_DESC(D, it_) do { int r = (it_) < NITEMS ? (it_) : NITEMS - 1; int nblk; \
        if (r < I0) { D = {F.in(I_AWIN), F.in(I_ANORM), (GAS bf16_t*)(ws + O_WIN0), NIN0, DM, 0, 0, 0}; nblk = NIN0 / 32; } else { r -= I0; \
        if (r < I1) { D = {F.in(I_AWOUT), nullptr, (GAS bf16_t*)(ws + O_WOUT0), DM, DM, 0, 0, 0}; nblk = 64; } else { r -= I1; \
        if (r < I2) { D = {F.in(I_SWKVF), F.in(I_SNORM), (GAS bf16_t*)(ws + O_WL1), 3084, DM, 0, 0, 0}; nblk = 96; } else { r -= I2; \
        if (r < I3) { D = {F.in(I_BWIN), F.in(I_BNORM), (GAS bf16_t*)(ws + O_WL1), DM, DM, 3072, 0, 0}; nblk = 64; } else { r -= I3; \
        if (r < I4) { D = {F.in(I_BWOUT), nullptr, (GAS bf16_t*)(ws + O_WOUT1), DM, DM, 0, 0, 0}; nblk = 64; } else { r -= I4; \
        if (r < I5) { D = {F.in(I_PWQ), F.in(I_PNORM), (GAS bf16_t*)(ws + O_WQ0), DM, DM, 0, 0, 0}; nblk = 64; } else { r -= I5; \
        if (r < I6) { D = {F.in(I_PWQ) + (size_t)DM * DM, F.in(I_PNORM) + DM, (GAS bf16_t*)(ws + O_WQ1), DM, DM, 0, 0, 0}; nblk = 64; } else { r -= I6; \
        if (r < I7) { D = {F.in(I_MWKV), nullptr, (GAS bf16_t*)(ws + O_WMKV), 1024, DM, 0, 0, 0}; nblk = 32; } else { r -= I7; \
        if (r < I8) { D = {F.in(I_MWKV) + (size_t)DM * 1024, nullptr, (GAS bf16_t*)(ws + O_WMKV) + (size_t)1024 * DM, 1024, DM, 0, 0, 0}; nblk = 32; } else { r -= I8; \
          const int blk = r / 16; r = r % 16; D = {F.in(I_AGATEW) + (size_t)blk * 128 * 256, nullptr, (GAS bf16_t*)(ws + O_WGATE), 256, 128, blk * 256, 0, 0}; nblk = 8; } } } } } } } } } \
        D.k0 = 64 * (r / nblk); D.n0 = 32 * (r % nblk); } while (0)
    for (int it = F.gw; it < NITEMS; it += F.ngw) { float wv[32]; TrItem d; TR_DESC(d, it); tr_load(d, wv, F.lane); tr_proc(d, wv, scr, F.lane); }
#undef TR_DESC
    { const GAS float* sk = F.in(I_PSUBK); GAS bf16_t* o = (GAS bf16_t*)(ws + O_SUBK);
      for (int i = F.gtid; i < 2 * 16 * 128 * 128 / 2; i += F.ngt) *(GAS unsigned*)(o + 2 * i) = cvtpk(sk[2 * i], sk[2 * i + 1]); }
    { GAS float* wf = (GAS float*)(ws + O_WF); const GAS float* w = F.in(I_SWKVF); const GAS float* g = F.in(I_SNORM);
      for (int i = F.gtid; i < 12 * DM; i += F.ngt) { const int j = i / DM, k = i % DM; wf[i] = w[(size_t)k * 3084 + 3072 + j] * g[k]; } }
    { GAS float* spl = (GAS float*)(ws + O_SPL); const GAS float* lam = F.in(I_ALAMBDA);
      for (int i = F.gtid; i < LRU; i += F.ngt) { const float z = -lam[i]; spl[i] = fmaxf(z, 0.f) + log1p_pos(fast_exp(-fabsf(z))); } }
    if (F.gw == 0) {
        float m = 0.f; for (int d = F.lane; d < 128; d += 64) m = fmaxf(m, fabsf(F.in(I_BQNORM)[d] * F.in(I_SKNORM)[d]));
        m = wave_max(m);
        if (F.lane == 0) ((GAS float*)(ws + O_GG))[512] = 2.f * 11.3137085f * m + 30.f; }
    { GAS float* gg = (GAS float*)(ws + O_GG);
      for (int i = F.gtid; i < 384; i += F.ngt) { const int a = i / 128, d = i % 128;
          gg[a == 0 ? 384 + d : i] = a == 0 ? F.in(I_BQNORM)[d] * F.in(I_SKNORM)[d] : F.in(I_MQNORM)[(a - 1) * 128 + d] * F.in(I_MKNORM)[(a - 1) * 128 + d]; } }
    {
        const GAS float* xin = F.in(I_X) + F.lane * 4; GAS bf16_t* xo = (GAS bf16_t*)(ws + O_XS16) + F.lane * 4;
        const int mlast = F.gw + ((T - 1 - F.gw) / F.ngw) * F.ngw;
#define XN_LOAD(V, m_) do { const int mm_ = (m_) <= mlast ? (m_) : mlast; _Pragma("unroll") for (int j = 0; j < 8; ++j) V[j] = __builtin_nontemporal_load((const GAS f32x4*)(xin + (size_t)mm_ * DM + j * 256)); } while (0)
#define XN_PROC(V, m_) do { if ((m_) < T) { float s0 = 0.f; _Pragma("unroll") for (int j = 0; j < 8; ++j) s0 += (V[j][0] * V[j][0] + V[j][1] * V[j][1]) + (V[j][2] * V[j][2] + V[j][3] * V[j][3]); \
            const float r0 = rsqrtf(wave_sum(s0) * (1.f / DM) + EPS); \
            _Pragma("unroll") for (int j = 0; j < 8; ++j) { u32x2 a; a.x = cvtpk(V[j][0] * r0, V[j][1] * r0); a.y = cvtpk(V[j][2] * r0, V[j][3] * r0); *(GAS u32x2*)(xo + (size_t)(m_) * DM + j * 256) = a; } } } while (0)
        f32x4 va[8], vb[8];
        XN_LOAD(va, F.gw);
        for (int m = F.gw; m < T; m += 2 * F.ngw) { XN_LOAD(vb, m + F.ngw); XN_PROC(va, m); XN_LOAD(va, m + 2 * F.ngw); XN_PROC(vb, m + F.ngw); }
#undef XN_LOAD
#undef XN_PROC
    }
    for (int m = F.gw; m < 2 * NMROW; m += F.ngw) { const int l = m / NMROW, r = m % NMROW;
        norm_row_bf16(F.in(I_MEM) + (size_t)r * DM, F.in(I_MNORM) + l * DM, (GAS bf16_t*)(ws + O_MEMN) + (size_t)m * DM, F.lane); }
    convert_tables(F, 0, 0, 2 * NEXP, F.gw, F.ngw);
}
__device__ __forceinline__ void step_conv(Frame& F) {
    const GAS bf16_t* zx = (const GAS bf16_t*)(F.ws + O_ZX); GAS bf16_t* xc = (GAS bf16_t*)(F.ws + O_XC);
    const GAS float* cw = F.in(I_ACONVW); const GAS float* cb = F.in(I_ACONVB);
    constexpr int NIT = T * (LRU / 8);
#define CV_LOAD(W, it_) do { const int ii_ = (it_) < NIT ? (it_) : NIT - 1; const int t_ = ii_ / (LRU / 8), c8_ = (ii_ % (LRU / 8)) * 8, pos_ = t_ & (SEQ - 1); \
        _Pragma("unroll") for (int k = 0; k < 4; ++k) W[k] = (pos_ - 3 + k >= 0) ? *(const GAS u32x4*)(zx + (size_t)(t_ - 3 + k) * LRU + c8_) : (u32x4){0u, 0u, 0u, 0u}; } while (0)
#define CV_PROC(W, it_) do { if ((it_) < NIT) { const int t_ = (it_) / (LRU / 8), c8_ = ((it_) % (LRU / 8)) * 8; float a[8]; \
        { const f32x4 b0 = *(const GAS f32x4*)(cb + c8_), b1 = *(const GAS f32x4*)(cb + c8_ + 4); a[0] = b0[0]; a[1] = b0[1]; a[2] = b0[2]; a[3] = b0[3]; a[4] = b1[0]; a[5] = b1[1]; a[6] = b1[2]; a[7] = b1[3]; } \
        _Pragma("unroll") for (int k = 0; k < 4; ++k) { const f32x4 w0 = *(const GAS f32x4*)(cw + k * LRU + c8_), w1 = *(const GAS f32x4*)(cw + k * LRU + c8_ + 4); \
            a[0] = fmaf(w0[0], bf_lo(W[k].x), a[0]); a[1] = fmaf(w0[1], bf_hi(W[k].x), a[1]); a[2] = fmaf(w0[2], bf_lo(W[k].y), a[2]); a[3] = fmaf(w0[3], bf_hi(W[k].y), a[3]); \
            a[4] = fmaf(w1[0], bf_lo(W[k].z), a[4]); a[5] = fmaf(w1[1], bf_hi(W[k].z), a[5]); a[6] = fmaf(w1[2], bf_lo(W[k].w), a[6]); a[7] = fmaf(w1[3], bf_hi(W[k].w), a[7]); } \
        u32x4 o; o.x = cvtpk(a[0], a[1]); o.y = cvtpk(a[2], a[3]); o.z = cvtpk(a[4], a[5]); o.w = cvtpk(a[6], a[7]); \
        *(GAS u32x4*)(xc + (size_t)t_ * LRU + c8_) = o; } } while (0)
    u32x4 wa[4], wb[4];
    CV_LOAD(wa, F.gtid);
    for (int it = F.gtid; it < NIT; it += 2 * F.ngt) { CV_LOAD(wb, it + F.ngt); CV_PROC(wa, it); CV_LOAD(wa, it + 2 * F.ngt); CV_PROC(wb, it + F.ngt); }
#undef CV_LOAD
#undef CV_PROC
}
constexpr int SCK = 32, NCK = SEQ / SCK;
typedef _Float16 h8_t __attribute__((ext_vector_type(8)));
__device__ __forceinline__ void scan_load(const GAS _Float16* LA, const GAS _Float16* UH, size_t off, float (&a)[8], float (&u)[8]) {
    const h8_t l = *(const GAS h8_t*)(LA + off), w = *(const GAS h8_t*)(UH + off);
#pragma unroll
    for (int k = 0; k < 8; ++k) { a[k] = fast_exp((float)l[k]); u[k] = (float)w[k]; }
}
__device__ __forceinline__ void step_scan1(Frame& F) {
    const GAS _Float16* LA = (const GAS _Float16*)(F.ws + O_AA); const GAS _Float16* UH = (const GAS _Float16*)(F.ws + O_UU);
    GAS float* CA = (GAS float*)(F.ws + O_LOGFP); GAS float* CH = CA + (size_t)NB * NCK * LRU;
    if (F.tid >= 384) return;
    const int grp = F.tid / 192, th = F.tid % 192;
    for (int it = blockIdx.x * 2 + grp; it < NB * NCK; it += gridDim.x * 2) {
        const int b = it / NCK, ck = it % NCK; const size_t base = ((size_t)b * SEQ + ck * SCK) * LRU + th * 8;
        float ap[8], h[8];
#pragma unroll
        for (int k = 0; k < 8; ++k) { ap[k] = 1.f; h[k] = 0.f; }
#pragma unroll 8
        for (int i = 0; i < SCK; ++i) { float a[8], u[8]; scan_load(LA, UH, base + (size_t)i * LRU, a, u);
#pragma unroll
            for (int k = 0; k < 8; ++k) { ap[k] *= a[k]; h[k] = a[k] * h[k] + u[k]; } }
        GAS float* ca = CA + (size_t)it * LRU + th * 8; GAS float* ch = CH + (size_t)it * LRU + th * 8;
        *(GAS f32x4*)ca = (f32x4){ap[0], ap[1], ap[2], ap[3]}; *(GAS f32x4*)(ca + 4) = (f32x4){ap[4], ap[5], ap[6], ap[7]};
        *(GAS f32x4*)ch = (f32x4){h[0], h[1], h[2], h[3]}; *(GAS f32x4*)(ch + 4) = (f32x4){h[4], h[5], h[6], h[7]};
    }
}
__device__ __forceinline__ void step_scan2(Frame& F) {
    const GAS _Float16* LA = (const GAS _Float16*)(F.ws + O_AA); const GAS _Float16* UH = (const GAS _Float16*)(F.ws + O_UU);
    const GAS float* CA = (const GAS float*)(F.ws + O_LOGFP); const GAS float* CH = CA + (size_t)NB * NCK * LRU;
    const GAS bf16_t* gy = (const GAS bf16_t*)(F.ws + O_GY); GAS bf16_t* cat = (GAS bf16_t*)(F.ws + O_CAT);
    if (F.tid >= 384) return;
    const int grp = F.tid / 192, th = F.tid % 192;
    for (int it = blockIdx.x * 2 + grp; it < NB * NCK; it += gridDim.x * 2) {
        const int b = it / NCK, ck = it % NCK; const size_t base = ((size_t)b * SEQ + ck * SCK) * LRU + th * 8;
        float h[8];
#pragma unroll
        for (int k = 0; k < 8; ++k) h[k] = 0.f;
        for (int k2 = 0; k2 < ck; ++k2) { const size_t o = (size_t)(b * NCK + k2) * LRU + th * 8;
            const f32x4 a0 = *(const GAS f32x4*)(CA + o), a1 = *(const GAS f32x4*)(CA + o + 4), c0 = *(const GAS f32x4*)(CH + o), c1 = *(const GAS f32x4*)(CH + o + 4);
#pragma unroll
            for (int k = 0; k < 4; ++k) { h[k] = a0[k] * h[k] + c0[k]; h[4 + k] = a1[k] * h[4 + k] + c1[k]; } }
#pragma unroll 8
        for (int i = 0; i < SCK; ++i) { float a[8], u[8]; scan_load(LA, UH, base + (size_t)i * LRU, a, u);
            const size_t row = (size_t)b * SEQ + ck * SCK + i;
            const u32x4 g = *(const GAS u32x4*)(gy + row * LRU + th * 8); u32x4 o;
#pragma unroll
            for (int k = 0; k < 8; ++k) h[k] = a[k] * h[k] + u[k];
#pragma unroll
            for (int k = 0; k < 4; ++k) o[k] = cvtpk(h[2 * k] * bf_lo(g[k]), h[2 * k + 1] * bf_hi(g[k]));
            *(GAS u32x4*)(cat + row * DM + th * 8) = o; }
    }
}
__device__ __forceinline__ void step_cprefix(Frame& F, LAS unsigned char* lds) {
    if (blockIdx.x >= NB * NH) return;
    const GAS float* p = (const GAS float*)(F.ws + O_LOGF) + (size_t)blockIdx.x * SEQ + F.tid * 8; GAS float* q = (GAS float*)(F.ws + O_CC) + (size_t)blockIdx.x * SEQ + F.tid * 8;
    LAS double* scr = (LAS double*)lds;
    const f32x4 a = *(const GAS f32x4*)p, b = *(const GAS f32x4*)(p + 4);
    double v[8];
    v[0] = (double)a[0]; v[1] = v[0] + (double)a[1]; v[2] = v[1] + (double)a[2]; v[3] = v[2] + (double)a[3];
    v[4] = v[3] + (double)b[0]; v[5] = v[4] + (double)b[1]; v[6] = v[5] + (double)b[2]; v[7] = v[6] + (double)b[3];
    scr[F.tid] = v[7];
    __syncthreads();
    double run = 0.0;
    for (int l = 0; l < 64; ++l) { const double t = scr[F.wave * 64 + l]; if (l < F.lane) run += t; }
    if (F.lane == 63) scr[512 + F.wave] = run + v[7];
    __syncthreads();
    for (int w = 0; w < F.wave; ++w) run += scr[512 + w];
    f32x4 o0, o1;
    o0[0] = (float)(run + v[0]); o0[1] = (float)(run + v[1]); o0[2] = (float)(run + v[2]); o0[3] = (float)(run + v[3]);
    o1[0] = (float)(run + v[4]); o1[1] = (float)(run + v[5]); o1[2] = (float)(run + v[6]); o1[3] = (float)(run + v[7]);
    *(GAS f32x4*)q = o0; *(GAS f32x4*)(q + 4) = o1;
    __syncthreads();
}

__device__ __forceinline__ int ord_i(float f) { const int b = __float_as_int(f); return b ^ ((b >> 31) & 0x7fffffff); }
__device__ __forceinline__ float unord_f(int k) { return __int_as_float(k ^ ((k >> 31) & 0x7fffffff)); }
template <int N> __device__ __forceinline__ void bitonic_sort_desc(int (&a)[N]) {
#pragma unroll
    for (int k = 2; k <= N; k <<= 1) {
#pragma unroll
        for (int j = k >> 1; j > 0; j >>= 1) {
#pragma unroll
            for (int i = 0; i < N; ++i) { const int l = i ^ j;
                if (l > i) { const bool desc = ((i & k) == 0); const int mx = max(a[i], a[l]), mn = min(a[i], a[l]); a[i] = desc ? mx : mn; a[l] = desc ? mn : mx; } }
        }
    }
}
__device__ __forceinline__ void bitonic_merge16_desc(int (&a)[16]) {
#pragma unroll
    for (int j = 8; j > 0; j >>= 1) {
#pragma unroll
        for (int i = 0; i < 16; ++i) { const int l = i ^ j; if (l > i) { const int mx = max(a[i], a[l]), mn = min(a[i], a[l]); a[i] = mx; a[l] = mn; } }
    }
}
__device__ __forceinline__ void top16_of_64(int (&a)[64]) {
    int g[4][16];
#pragma unroll
    for (int q = 0; q < 4; ++q) {
#pragma unroll
        for (int i = 0; i < 16; ++i) g[q][i] = a[16 * q + i];
        bitonic_sort_desc<16>(g[q]); }
#pragma unroll
    for (int i = 0; i < 16; ++i) { g[0][i] = max(g[0][i], g[1][15 - i]); g[2][i] = max(g[2][i], g[3][15 - i]); }
    bitonic_merge16_desc(g[0]); bitonic_merge16_desc(g[2]);
#pragma unroll
    for (int i = 0; i < 16; ++i) g[0][i] = max(g[0][i], g[2][15 - i]);
    bitonic_merge16_desc(g[0]);
#pragma unroll
    for (int i = 0; i < 16; ++i) a[i] = g[0][i];
}
constexpr float KOFF = 64.f;
__device__ __forceinline__ void top16_of_32(int (&a)[32]) {
    int g0[16], g1[16];
#pragma unroll
    for (int i = 0; i < 16; ++i) { g0[i] = a[i]; g1[i] = a[16 + i]; }
    bitonic_sort_desc<16>(g0); bitonic_sort_desc<16>(g1);
#pragma unroll
    for (int i = 0; i < 16; ++i) g0[i] = max(g0[i], g1[15 - i]);
    bitonic_merge16_desc(g0);
#pragma unroll
    for (int i = 0; i < 16; ++i) a[i] = g0[i];
}
__device__ __forceinline__ void subkey_top16(const GAS bf16_t* qrow  , const GAS bf16_t* sk  , int r32, int hi, int (&top)[16]) {
    bf16x8 qf[8];
#pragma unroll
    for (int ks = 0; ks < 8; ++ks) qf[ks] = *(const GAS bf16x8*)(qrow + ks * 16 + hi * 8);
    unsigned loff = (unsigned)(r32 * 128 + hi * 8) * 2u; asm volatile("" : "+v"(loff));
    int key[64];
#pragma unroll
    for (int kb = 0; kb < 4; ++kb) {
        f32x16 acc;
#pragma unroll
        for (int r = 0; r < 16; ++r) acc[r] = KOFF;
#pragma unroll
        for (int ks = 0; ks < 8; ++ks) { const bf16x8 af = *(const GAS bf16x8*)((const GAS char*)(sk + kb * 32 * 128 + ks * 16) + loff);
            acc = __builtin_amdgcn_mfma_f32_32x32x16_bf16(af, qf[ks], acc, 0, 0, 0); }
#pragma unroll
        for (int r = 0; r < 16; ++r) { const int id = kb * 32 + (r & 3) + 8 * (r >> 2) + 4 * hi; key[kb * 16 + r] = (__float_as_int(acc[r]) & ~127) | (127 - id); }
        __builtin_amdgcn_sched_barrier(0);
    }
    top16_of_64(key);
#pragma unroll
    for (int i = 0; i < 16; ++i) { auto r = __builtin_amdgcn_permlane32_swap((unsigned)key[15 - i], (unsigned)key[15 - i], false, false);
        const int pk = hi ? (int)r[0] : (int)r[1]; top[i] = max(key[i], pk); }
    bitonic_merge16_desc(top);
}
__device__ __forceinline__ void step_topk(Frame& F, LAS unsigned char* lds, int layer) {
    const GAS bf16_t* q16 = (const GAS bf16_t*)(F.ws + O_Q16); const GAS bf16_t* subk = (const GAS bf16_t*)(F.ws + O_SUBK) + (size_t)layer * 16 * 128 * 128;
    GAS int* IDX = (GAS int*)(F.ws + O_IDX); GAS float* GW = (GAS float*)(F.ws + O_GW);
    LAS int* scr = (LAS int*)(lds + F.wave * 16384) + F.lane * 33;
    const int r32 = F.lane & 31, hi = F.lane >> 5;
    for (int task = F.gw; task < (T / 32) * 8; task += F.ngw) {
        const int tb = task >> 3, h = task & 7; const int tok = tb * 32 + r32;
        const GAS bf16_t* qrow = q16 + (size_t)tok * DM + h * 256;
        int ta[16], tb16[16];
        subkey_top16(qrow, subk + (size_t)(h * 2 + 0) * 128 * 128, r32, hi, ta);
        subkey_top16(qrow + 128, subk + (size_t)(h * 2 + 1) * 128 * 128, r32, hi, tb16);
        float va[16], vb[16];
#pragma unroll
        for (int i = 0; i < 16; ++i) { va[i] = __int_as_float(ta[i] & ~127); vb[i] = __int_as_float(tb16[i] & ~127) - KOFF; scr[i] = 127 - (ta[i] & 127); scr[16 + i] = 127 - (tb16[i] & 127); }
        int c2[32]; int n = 0;
#pragma unroll
        for (int i = 0; i < 16; ++i)
#pragma unroll
            for (int j = 0; j < 16; ++j) if ((i + 1) * (j + 1) <= 16) { const int k = (__float_as_int(va[i] + vb[j]) & ~255) | (255 - (i * 16 + j));
                if ((n & 1) == 0) c2[n >> 1] = k; else c2[n >> 1] = hi ? k : c2[n >> 1];
                ++n; }
#pragma unroll
        for (int i = 25; i < 32; ++i) c2[i] = (int)0x80000000;
        top16_of_32(c2);
        { int mg[16];
#pragma unroll
          for (int i = 0; i < 16; ++i) { auto r = __builtin_amdgcn_permlane32_swap((unsigned)c2[15 - i], (unsigned)c2[15 - i], false, false);
              const int pk = hi ? (int)r[0] : (int)r[1]; mg[i] = max(c2[i], pk); }
          bitonic_merge16_desc(mg);
#pragma unroll
          for (int i = 0; i < 16; ++i) c2[i] = mg[i]; }
        asm volatile("s_waitcnt lgkmcnt(0)" ::: "memory");
        float sv[16], ex[16]; int ev[16]; float Z = 0.f;
#pragma unroll
        for (int r = 0; r < 16; ++r) { const int flat = 255 - (c2[r] & 255); sv[r] = __int_as_float(c2[r] & ~255); ev[r] = scr[flat >> 4] * 128 + scr[16 + (flat & 15)]; }
#pragma unroll
        for (int r = 0; r < 16; ++r) { ex[r] = fast_exp(sv[r] - sv[0]); Z += ex[r]; }
        const float iz = 1.f / Z;
        GAS int* ip = IDX + (size_t)tok * 128 + h * 16 + hi * 8; GAS float* gp = GW + (size_t)tok * 128 + h * 16 + hi * 8;
        int eo[8]; float go[8];
#pragma unroll
        for (int j = 0; j < 8; ++j) { eo[j] = hi ? ev[8 + j] : ev[j]; go[j] = (hi ? ex[8 + j] : ex[j]) * iz; }
        *(GAS u32x4*)ip = (u32x4){(unsigned)eo[0], (unsigned)eo[1], (unsigned)eo[2], (unsigned)eo[3]}; *(GAS u32x4*)(ip + 4) = (u32x4){(unsigned)eo[4], (unsigned)eo[5], (unsigned)eo[6], (unsigned)eo[7]};
        *(GAS f32x4*)gp = (f32x4){go[0], go[1], go[2], go[3]}; *(GAS f32x4*)(gp + 4) = (f32x4){go[4], go[5], go[6], go[7]};
        asm volatile("s_waitcnt lgkmcnt(0)" ::: "memory");
    }
}
__device__ __forceinline__ h2 as_h2(unsigned w) { return __builtin_bit_cast(h2, w); }
#define F4(W, s) __builtin_amdgcn_cvt_scalef32_pk_f16_fp4((W), 1.0f, (s))
#define H2F(us) ((float)__builtin_bit_cast(_Float16, (unsigned short)(us)))
__device__ __forceinline__ float sum8(float v) { v += dppf<0xB1>(v); v += dppf<0x4E>(v); v += dppf<0x141>(v); return v; }
__device__ __forceinline__ void step_upass(Frame& F, int layer, int G, LAS unsigned char* lds) {
    typedef pg8::v8i_t v8i_t;
    const int s = blockIdx.x & 7, wk = (blockIdx.x >> 3) * NWAVES + F.wave, nwk = (G >> 3) * NWAVES;
    const GAS unsigned char* UN = F.ws + O_TAB + (size_t)(layer * 2) * TAB_ONE + (size_t)s * NEXP * 128;
    const GAS int* IDX = (const GAS int*)(F.ws + O_IDX); const GAS bf16_t* xs = (const GAS bf16_t*)(F.ws + O_XS16) + s * 256;
    GAS _Float16* part = (GAS _Float16*)(F.ws + O_PART) + (size_t)s * T * 128;
    unsigned lo = (unsigned)F.lane; asm volatile("" : "+v"(lo));
    const unsigned j = lo >> 3, p = lo & 7, c = lo & 15, kq = lo >> 4;
    LAS unsigned char* img = lds + F.wave * 16384; LAS unsigned char* xrow = lds + 131072 + F.wave * 256;
    LAS unsigned char* wrp = img + j * 128 + ((p ^ j) << 4);
    const LAS unsigned char* rd0 = img + c * 128 + ((kq ^ (c & 7)) << 4);
    const LAS unsigned char* rd1 = img + c * 128 + (((4 + kq) ^ (c & 7)) << 4);
    const int tlast = wk + ((T - 1 - wk) / nwk) * nwk;
#define U_LOADID(ID, t_, q_) do { const int tt_ = (t_) <= tlast ? (t_) : tlast; _Pragma("unroll") for (int b = 0; b < 4; ++b) ID[b] = IDX[(size_t)tt_ * 128 + (q_) * 32 + 8 * b + j]; } while (0)
#define U_LOADX(t_) do { const int tt_ = (t_) <= tlast ? (t_) : tlast; xn = *(const GAS u32x2*)(xs + (size_t)tt_ * DM + lo * 4); } while (0)
    const __amdgpu_buffer_rsrc_t urs = __builtin_amdgcn_make_buffer_rsrc((void*)(unsigned char*)UN, 0, NEXP * 128, 0x00020000);
#define U_ISSUE(UB, ID) do { _Pragma("unroll") for (int b = 0; b < 4; ++b) UB[b] = __builtin_amdgcn_raw_buffer_load_b128(urs, ID[b] * 128 + (int)p * 16, 0, 16); } while (0)
#define U_WRITE(UB, q_) do { _Pragma("unroll") for (int b = 0; b < 4; ++b) *(LAS u32x4*)(wrp + (4 * (q_) + b) * 1024) = UB[b]; } while (0)
#define U_MM(g0) do { u32x4 a0[4], a1[4]; _Pragma("unroll") for (int g = 0; g < 4; ++g) { a0[g] = *(const LAS u32x4*)(rd0 + ((g0) + g) * 2048); a1[g] = *(const LAS u32x4*)(rd1 + ((g0) + g) * 2048); } \
        _Pragma("unroll") for (int g = 0; g < 4; ++g) { \
            f32x4 c_ = __builtin_amdgcn_mfma_scale_f32_16x16x128_f8f6f4((v8i_t){(int)a0[g].x, (int)a0[g].y, (int)a0[g].z, (int)a0[g].w, 0, 0, 0, 0}, bop0, zero4, 4, 0, 0, 127, 0, 127); \
            acc[(g0) + g] = __builtin_amdgcn_mfma_scale_f32_16x16x128_f8f6f4((v8i_t){(int)a1[g].x, (int)a1[g].y, (int)a1[g].z, (int)a1[g].w, 0, 0, 0, 0}, bop1, c_, 4, 0, 0, 127, 0, 127); } } while (0)
    int idA[4], idB[4]; u32x4 u0[4], u1[4], u2[4], u3[4]; u32x2 xc, xn;
    U_LOADID(idA, wk, 0); U_LOADID(idB, wk, 1); U_LOADX(wk);
    U_ISSUE(u0, idA); U_LOADID(idA, wk, 2);
    U_ISSUE(u1, idB); U_LOADID(idB, wk, 3);
    U_ISSUE(u2, idA); U_LOADID(idA, wk + nwk, 0);
    xc = xn;
    for (int t = wk; t < T; t += nwk) {
        U_ISSUE(u3, idB); U_LOADID(idB, t + nwk, 1); U_LOADX(t + nwk);
        const float x0 = bf_lo(xc.x), x1 = bf_hi(xc.x), x2 = bf_lo(xc.y), x3 = bf_hi(xc.y);
        const float amax = wave_max(fmaxf(fmaxf(fabsf(x0), fabsf(x1)), fmaxf(fabsf(x2), fabsf(x3))));
        const float sc = fmaxf(amax, 1e-20f) * (1.f / 448.f), qs = __builtin_amdgcn_rcpf(sc);
        { int pk = __builtin_amdgcn_cvt_pk_fp8_f32(x0 * qs, x1 * qs, 0, false); pk = __builtin_amdgcn_cvt_pk_fp8_f32(x2 * qs, x3 * qs, pk, true); *(LAS int*)(xrow + lo * 4) = pk; }
        U_WRITE(u0, 0);
        U_ISSUE(u0, idA); U_LOADID(idA, t + nwk, 2);
        U_WRITE(u1, 1);
        U_ISSUE(u1, idB); U_LOADID(idB, t + nwk, 3);
        U_WRITE(u2, 2);
        U_ISSUE(u2, idA); U_LOADID(idA, t + 2 * nwk, 0);
        U_WRITE(u3, 3);
        v8i_t bop0, bop1;
        { const u32x4 b00 = *(const LAS u32x4*)(xrow + kq * 16), b01 = *(const LAS u32x4*)(xrow + 64 + kq * 16), b10 = *(const LAS u32x4*)(xrow + 128 + kq * 16), b11 = *(const LAS u32x4*)(xrow + 192 + kq * 16);
          bop0 = (v8i_t){(int)b00.x, (int)b00.y, (int)b00.z, (int)b00.w, (int)b01.x, (int)b01.y, (int)b01.z, (int)b01.w};
          bop1 = (v8i_t){(int)b10.x, (int)b10.y, (int)b10.z, (int)b10.w, (int)b11.x, (int)b11.y, (int)b11.z, (int)b11.w}; }
        const f32x4 zero4 = {0.f, 0.f, 0.f, 0.f};
        f32x4 acc[8];
        U_MM(0); U_MM(4);
        f32x4 o = acc[0];
#pragma unroll
        for (int m = 1; m < 8; ++m) o = ((c & 7) == (unsigned)m) ? acc[m] : o;
        { const h2 o0 = {(_Float16)(o[0] * sc), (_Float16)(o[1] * sc)}, o1 = {(_Float16)(o[2] * sc), (_Float16)(o[3] * sc)};
          __builtin_nontemporal_store((u32x2){__builtin_bit_cast(unsigned, o0), __builtin_bit_cast(unsigned, o1)}, (GAS u32x2*)(part + (size_t)t * 128 + 16 * (c & 7) + 4 * kq)); }
        xc = xn;
    }
#undef U_LOADID
#undef U_LOADX
#undef U_ISSUE
#undef U_WRITE
#undef U_MM
}
__device__ __forceinline__ void step_peer_reduce(Frame& F, int layer) {
    const GAS _Float16* part = (const GAS _Float16*)(F.ws + O_PART); const GAS float* GW = (const GAS float*)(F.ws + O_GW); const GAS int* IDX = (const GAS int*)(F.ws + O_IDX);
    const GAS float* rowss = (const GAS float*)(F.ws + O_ROWSS); GAS unsigned char* W8 = F.ws + O_W8;
    const GAS unsigned char* SU = F.ws + O_TAB + (size_t)(layer * 2) * TAB_ONE + TAB_NIB; const GAS unsigned char* SV = SU + TAB_ONE;
    constexpr int NIT = T * 2;
    struct SA { int id; float gw, rs; float p[8]; }; struct SB { u32x4 su, sv; };
#define RA(X, it_) do { const int ii_ = (it_) < NIT ? (it_) : NIT - 1; const size_t i_ = (size_t)ii_ * 64 + F.lane; X.id = IDX[i_]; X.gw = GW[i_]; X.rs = rowss[(size_t)(ii_ >> 1) * 32 + (F.lane & 31)]; \
        _Pragma("unroll") for (int s = 0; s < 8; ++s) X.p[s] = (float)part[(size_t)s * T * 128 + i_]; } while (0)
#define RB(Y, X) do { Y.su = *(const GAS u32x4*)(SU + (size_t)X.id * 16); Y.sv = *(const GAS u32x4*)(SV + (size_t)X.id * 16); } while (0)
#define RC(X, Y, it_) do { if ((it_) < NIT) { const size_t i_ = (size_t)(it_) * 64 + F.lane; const float r = rsqrtf(wave_sum(X.rs) * (0.5f / DM) + EPS); float d = 0.f; \
        _Pragma("unroll") for (int s = 0; s < 8; ++s) d += X.p[s] * (float)__builtin_bit_cast(_Float16, (unsigned short)(Y.su[s >> 1] >> (16 * (s & 1)))); \
        const float w = X.gw * gelu_tanh(d * r) * 256.f; \
        _Pragma("unroll") for (int s = 0; s < 8; ++s) { const float ws = w * (float)__builtin_bit_cast(_Float16, (unsigned short)(Y.sv[s >> 1] >> (16 * (s & 1)))); \
            W8[(size_t)s * T * 128 + i_] = (unsigned char)(__builtin_amdgcn_cvt_pk_fp8_f32(ws, 0.f, 0, false) & 0xff); } } } while (0)
    SA a0, a1, a2; SB b0, b1;
    RA(a0, F.gw); RA(a1, F.gw + F.ngw); RB(b0, a0);
    for (int it = F.gw; it < NIT; it += F.ngw) {
        RA(a2, it + 2 * F.ngw); RB(b1, a1);
        RC(a0, b0, it);
        a0 = a1; a1 = a2; b0 = b1;
    }
#undef RA
#undef RB
#undef RC
}
__device__ __forceinline__ void step_vpass(Frame& F, int layer, int G, bool dry, LAS unsigned char* lds) {
    typedef pg8::v8i_t v8i_t;
    const int s = blockIdx.x & 7, wk = (blockIdx.x >> 3) * NWAVES + F.wave, nwk = (G >> 3) * NWAVES;
    const GAS unsigned char* VN = F.ws + O_TAB + (size_t)(layer * 2 + 1) * TAB_ONE + (size_t)s * NEXP * 128;
    const GAS int* IDX = (const GAS int*)(F.ws + O_IDX); const GAS unsigned char* W8 = F.ws + O_W8 + (size_t)s * T * 128;
    GAS bf16_t* xs = (GAS bf16_t*)(F.ws + O_XS16); GAS float* rsp = (GAS float*)(F.ws + O_RSP);
    unsigned lo = (unsigned)F.lane; asm volatile("" : "+v"(lo));
    const unsigned j = lo >> 3, p = lo & 7, c = lo & 15, kq = lo >> 4;
    LAS unsigned char* img = lds + F.wave * 16384;
    LAS unsigned char* wrp = img + j * 128 + ((p ^ j) << 4);
    const unsigned rdrow = (unsigned)(size_t)img + (32 * kq + c) * 128, csw = (c & 7) << 4;
    const int tlast = wk + ((T - 1 - wk) / nwk) * nwk;
    LAS float* wfl = (LAS float*)(lds + 131072); GAS float* logfp = (GAS float*)(F.ws + O_LOGFP);
    if (layer == 0) { const GAS float* wf = (const GAS float*)(F.ws + O_WF) + s * 256;
        for (int i = F.tid; i < NH * 64; i += NTHREADS) *(LAS f32x4*)(wfl + (i >> 6) * 256 + (i & 63) * 4) = *(const GAS f32x4*)(wf + (size_t)(i >> 6) * DM + (i & 63) * 4);
        __syncthreads(); }
#define V_LOADID(ID, t_, q_) do { const int tt_ = (t_) <= tlast ? (t_) : tlast; _Pragma("unroll") for (int b = 0; b < 4; ++b) ID[b] = IDX[(size_t)tt_ * 128 + (q_) * 32 + 8 * b + j]; } while (0)
#define V_LOADW(t_) do { const int tt_ = (t_) <= tlast ? (t_) : tlast; wn0 = *(const GAS u32x4*)(W8 + (size_t)tt_ * 128 + kq * 16); wn1 = *(const GAS u32x4*)(W8 + (size_t)tt_ * 128 + 64 + kq * 16); } while (0)
    const __amdgpu_buffer_rsrc_t vrs = __builtin_amdgcn_make_buffer_rsrc((void*)(unsigned char*)VN, 0, NEXP * 128, 0x00020000);
#define V_ISSUE(VB, ID) do { _Pragma("unroll") for (int b = 0; b < 4; ++b) VB[b] = __builtin_amdgcn_raw_buffer_load_b128(vrs, ID[b] * 128 + (int)p * 16, 0, 16); } while (0)
#define V_WRITE(VB, q_) do { _Pragma("unroll") for (int b = 0; b < 4; ++b) *(LAS u32x4*)(wrp + (4 * (q_) + b) * 1024) = VB[b]; } while (0)
#define TR4(dst, va, off) asm volatile("ds_read_b64_tr_b4 %0, %1 offset:%2" : "=&v"(dst) : "v"(va), "i"(off) : "memory")
#define V_MM(cc) do { const unsigned va0 = rdrow + (((cc) << 4) ^ csw), va1 = rdrow + ((((cc) + 1) << 4) ^ csw); u32x2 t00, t01, t10, t11, t20, t21, t30, t31; \
        TR4(t00, va0, 0); TR4(t01, va0, 2048); TR4(t10, va0, 8); TR4(t11, va0, 2056); TR4(t20, va1, 0); TR4(t21, va1, 2048); TR4(t30, va1, 8); TR4(t31, va1, 2056); \
        asm volatile("s_waitcnt lgkmcnt(0)" ::: "memory"); __builtin_amdgcn_sched_barrier(0); \
        o = __builtin_amdgcn_mfma_scale_f32_16x16x128_f8f6f4((v8i_t){(int)t00.x, (int)t00.y, (int)t01.x, (int)t01.y, 0, 0, 0, 0}, bop, o, 4, 0, 0, 127, 0, SBV(2 * (cc))); \
        o = __builtin_amdgcn_mfma_scale_f32_16x16x128_f8f6f4((v8i_t){(int)t10.x, (int)t10.y, (int)t11.x, (int)t11.y, 0, 0, 0, 0}, bop, o, 4, 0, 0, 127, 0, SBV(2 * (cc) + 1)); \
        o = __builtin_amdgcn_mfma_scale_f32_16x16x128_f8f6f4((v8i_t){(int)t20.x, (int)t20.y, (int)t21.x, (int)t21.y, 0, 0, 0, 0}, bop, o, 4, 0, 0, 127, 0, SBV(2 * (cc) + 2)); \
        o = __builtin_amdgcn_mfma_scale_f32_16x16x128_f8f6f4((v8i_t){(int)t30.x, (int)t30.y, (int)t31.x, (int)t31.y, 0, 0, 0, 0}, bop, o, 4, 0, 0, 127, 0, SBV(2 * (cc) + 3)); } while (0)
#define SBV(nb_) ((c == (unsigned)(nb_)) ? 119 : 0)
    int idA[4], idB[4]; u32x4 v0[4], v1[4], v2[4], v3[4]; u32x4 w0, w1, wn0, wn1;
    V_LOADID(idA, wk, 0); V_LOADID(idB, wk, 1); V_LOADW(wk);
    V_ISSUE(v0, idA); V_LOADID(idA, wk, 2);
    V_ISSUE(v1, idB); V_LOADID(idB, wk, 3);
    V_ISSUE(v2, idA); V_LOADID(idA, wk + nwk, 0);
    w0 = wn0; w1 = wn1;
    for (int t = wk; t < T; t += nwk) {
        V_ISSUE(v3, idB); V_LOADID(idB, t + nwk, 1); V_LOADW(t + nwk);
        GAS bf16_t* xb = xs + (size_t)t * DM + s * 256 + c * 16 + kq * 4;
        f32x4 x2; { const u32x2 w = *(const GAS u32x2*)xb; x2 = (f32x4){bf_lo(w.x), bf_hi(w.x), bf_lo(w.y), bf_hi(w.y)}; }
        V_WRITE(v0, 0);
        V_ISSUE(v0, idA); V_LOADID(idA, t + nwk, 2);
        V_WRITE(v1, 1);
        V_ISSUE(v1, idB); V_LOADID(idB, t + nwk, 3);
        V_WRITE(v2, 2);
        V_ISSUE(v2, idA); V_LOADID(idA, t + 2 * nwk, 0);
        V_WRITE(v3, 3);
        const v8i_t bop = {(int)w0.x, (int)w0.y, (int)w0.z, (int)w0.w, (int)w1.x, (int)w1.y, (int)w1.z, (int)w1.w};
        f32x4 o = {0.f, 0.f, 0.f, 0.f};
        V_MM(0); V_MM(2); V_MM(4); V_MM(6);
        x2 += o;
        if (layer == 1 && !dry) __builtin_nontemporal_store(x2, (GAS f32x4*)(F.out + (size_t)t * DM + s * 256 + c * 16 + kq * 4));
        if (layer == 0 && !dry) {
            { u32x2 ow; ow.x = cvtpk(x2[0], x2[1]); ow.y = cvtpk(x2[2], x2[3]); __builtin_nontemporal_store(ow, (GAS u32x2*)xb); }
            const float sst = wave_sum((x2[0] * x2[0] + x2[1] * x2[1]) + (x2[2] * x2[2] + x2[3] * x2[3]));
            if (lo == 0) rsp[(size_t)t * 8 + s] = sst;
        }
        if (layer == 0) {
            f32x4 gw[NH];
#pragma unroll
            for (int h = 0; h < NH; ++h) gw[h] = *(const LAS f32x4*)(wfl + h * 256 + c * 16 + kq * 4);
            __builtin_amdgcn_sched_barrier(0);
            float ph[NH];
#pragma unroll
            for (int h = 0; h < NH; ++h) ph[h] = (x2[0] * gw[h][0] + x2[1] * gw[h][1]) + (x2[2] * gw[h][2] + x2[3] * gw[h][3]);
#pragma unroll
            for (int h = 0; h < NH; ++h) ph[h] += dppf<0xB1>(ph[h]);
#pragma unroll
            for (int h = 0; h < NH; ++h) ph[h] += dppf<0x4E>(ph[h]);
#pragma unroll
            for (int h = 0; h < NH; ++h) ph[h] += dppf<0x141>(ph[h]);
#pragma unroll
            for (int h = 0; h < NH; ++h) ph[h] += dppf<0x140>(ph[h]);
            float sel = 0.f;
#pragma unroll
            for (int h = 0; h < NH; ++h) sel = (c == (unsigned)h) ? ph[h] : sel;
            sel = xsum16(sel); sel = xsum32(sel);
            if (lo < (unsigned)NH && !dry) logfp[((size_t)t * 8 + s) * NH + lo] = sel;
        }
        w0 = wn0; w1 = wn1;
    }
#undef V_LOADID
#undef V_LOADW
#undef V_ISSUE
#undef V_WRITE
#undef TR4
#undef V_MM
#undef SBV
}
#undef F4
#undef H2F
__device__ __forceinline__ void step_logf(Frame& F) {
    const GAS float* lp = (const GAS float*)(F.ws + O_LOGFP); const GAS float* rsp = (const GAS float*)(F.ws + O_RSP); GAS float* logf = (GAS float*)(F.ws + O_LOGF);
    unsigned lo = (unsigned)F.lane; asm volatile("" : "+v"(lo));
    const unsigned h = lo & 15, g = lo >> 4; const unsigned hh = h < (unsigned)NH ? h : 0u;
    for (int t0 = F.gw * 4; t0 < T; t0 += F.ngw * 4) {
        const int t = t0 + (int)g;
        float pz[8]; f32x4 q0, q1;
#pragma unroll
        for (int s = 0; s < 8; ++s) pz[s] = lp[((size_t)t * 8 + s) * NH + hh];
        q0 = *(const GAS f32x4*)(rsp + (size_t)t * 8); q1 = *(const GAS f32x4*)(rsp + (size_t)t * 8 + 4);
        const float z0 = ((pz[0] + pz[1]) + (pz[2] + pz[3])) + ((pz[4] + pz[5]) + (pz[6] + pz[7]));
        const float r1 = rsqrtf(((q0[0] + q0[1]) + (q0[2] + q0[3]) + (q1[0] + q1[1]) + (q1[2] + q1[3])) * (1.f / DM) + EPS);
        if (h < (unsigned)NH) { const float z = z0 * r1 + F.in(I_SBF)[h];
            logf[((size_t)(t / SEQ) * NH + h) * SEQ + (t % SEQ)] = fminf(z, 0.f) - log1p_pos(fast_exp(-fabsf(z))); }
    }
}

#define XB_TMO      128
#define XB_XCNT(j)  (256  + 64 * (j))
#define XB_XSUB(j)  (1280 + 64 * (j))
#define XB_XGEN(j)  (2304 + 64 * (j))
#define XB_TOP      3328
#define XB_TOPGEN   3392
#define XCD_BAR_WORDS 3456
#define XB_SPIN_CAP (1u << 20)
__device__ __forceinline__ unsigned xb_ld(unsigned* p)              { return __hip_atomic_load(p, __ATOMIC_RELAXED, __HIP_MEMORY_SCOPE_AGENT); }
__device__ __forceinline__ unsigned xb_add(unsigned* p, unsigned v) { return __hip_atomic_fetch_add(p, v, __ATOMIC_RELAXED, __HIP_MEMORY_SCOPE_AGENT); }
__device__ __forceinline__ unsigned xb_xcc_id() { return (unsigned)__builtin_amdgcn_s_getreg((3 << 11) | 20) & 0xFu; }
#define XB_SPIN(cond, bar) do { unsigned _sp = 0; while (cond) { __builtin_amdgcn_s_sleep(1); \
    if ((++_sp & 255u) == 0u) { if (xb_ld(&(bar)[XB_TMO])) break; if (_sp > XB_SPIN_CAP) { atomicAdd(&(bar)[XB_TMO], 1u); break; } } } } while (0)
struct XcdBarrier { unsigned* bar; unsigned x; volatile LAS unsigned* st; };
__device__ __forceinline__ XcdBarrier xcd_barrier_post(unsigned* bar, volatile LAS unsigned* st) {
    XcdBarrier b; b.bar = bar; b.x = xb_xcc_id(); b.st = st;
    if (threadIdx.x == 0) (void)xb_add(&bar[XB_XCNT(b.x)], 1u);
    return b;
}
__device__ __forceinline__ void xcd_barrier_complete(unsigned* bar, unsigned x, unsigned& nloc, unsigned& nx) {
    const unsigned G = gridDim.x * gridDim.y * gridDim.z;
    unsigned sum, cnt, mine, sp = 0u;
    for (;;) {
        sum = 0u; cnt = 0u; mine = 0u;
#pragma unroll
        for (unsigned j = 0; j < 16; ++j) { const unsigned c = xb_ld(&bar[XB_XCNT(j)]); sum += c; cnt += (c > 0u) ? 1u : 0u; mine = (j == x) ? c : mine; }
        if (sum == G) break;
        __builtin_amdgcn_s_sleep(1);
        if ((++sp & 255u) == 0u) { if (xb_ld(&bar[XB_TMO])) break; if (sp > XB_SPIN_CAP) { atomicAdd(&bar[XB_TMO], 1u); break; } }
    }
    nloc = mine > 0u ? mine : 1u; nx = cnt > 0u ? cnt : 1u;
}
__device__ __forceinline__ void xcd_barrier(const XcdBarrier& b, int wave_s) {
    asm volatile("s_waitcnt vmcnt(0)" ::: "memory");
    __syncthreads();
    int ln_; asm volatile("v_mbcnt_lo_u32_b32 %0, -1, 0\n\tv_mbcnt_hi_u32_b32 %0, -1, %0" : "=v"(ln_));
    if (wave_s == 0 && ln_ == 0) {
        unsigned* bar = b.bar;
        __builtin_amdgcn_s_waitcnt(0);
        unsigned nloc = b.st[0], nx = b.st[1];
        if (nloc == 0u) { xcd_barrier_complete(bar, b.x, nloc, nx); b.st[0] = nloc; b.st[1] = nx; }
        const unsigned old = xb_add(&bar[XB_XSUB(b.x)], 1u);
        const unsigned gen = old / nloc;
        if (old + 1u == (gen + 1u) * nloc) {
            __builtin_amdgcn_fence(__ATOMIC_RELEASE, "agent");
            asm volatile("s_waitcnt vmcnt(0)" ::: "memory");
            const unsigned og = xb_add(&bar[XB_TOP], 1u);
            const unsigned tg = og / nx;
            if (og + 1u == (tg + 1u) * nx) xb_add(&bar[XB_TOPGEN], 1u);
            else XB_SPIN(xb_ld(&bar[XB_TOPGEN]) == tg, bar);
            __builtin_amdgcn_fence(__ATOMIC_ACQUIRE, "agent");
            xb_add(&bar[XB_XGEN(b.x)], 1u);
            asm volatile("s_waitcnt vmcnt(0)" ::: "memory");
        } else {
            XB_SPIN(xb_ld(&bar[XB_XGEN(b.x)]) == gen, bar);
            __builtin_amdgcn_fence(__ATOMIC_ACQUIRE, "agent");
            asm volatile("s_waitcnt vmcnt(0)" ::: "memory");
        }
    }
    __syncthreads();
}

constexpr int CONV1_SPLIT = 2 * 4608;
constexpr int BAR_LDS_OFF = 147456 - 64;
constexpr int LDS_BYTES = 147456;
enum { ST_PROLOGUE = 0, ST_G_IN0, ST_G_MKV0, ST_G_MKV1, ST_CONV, ST_G_GATE, ST_A_MEM0, ST_SCAN1, ST_SCAN2, ST_G_OUT0, ST_G_PQ0, ST_TOPK0, ST_UPASS0, ST_PRED0, ST_VPASS0,
       ST_G_L1, ST_CPREFIX, ST_A_FOX, ST_A_MEM1, ST_G_OUT1, ST_G_PQ1, ST_TOPK1, ST_UPASS1, ST_PRED1, ST_VPASS1, N_STEPS };
constexpr unsigned SYNC_AFTER = (1u << ST_PROLOGUE) | (1u << ST_G_MKV1) | (1u << ST_CONV) | (1u << ST_A_MEM0) | (1u << ST_SCAN1) | (1u << ST_SCAN2) | (1u << ST_G_OUT0) | (1u << ST_G_PQ0) |
                                (1u << ST_TOPK0) | (1u << ST_UPASS0) | (1u << ST_PRED0) | (1u << ST_VPASS0) | (1u << ST_G_L1) | (1u << ST_CPREFIX) | (1u << ST_A_MEM1) | (1u << ST_G_OUT1) | (1u << ST_G_PQ1) | (1u << ST_TOPK1) | (1u << ST_UPASS1) | (1u << ST_PRED1);
constexpr unsigned GEMM_STEPS = (1u << ST_G_IN0) | (1u << ST_G_MKV0) | (1u << ST_G_MKV1) | (1u << ST_G_GATE) | (1u << ST_G_OUT0) | (1u << ST_G_PQ0) | (1u << ST_G_L1) | (1u << ST_G_OUT1) | (1u << ST_G_PQ1);
constexpr unsigned ATTN_STEPS = (1u << ST_A_MEM0) | (1u << ST_A_FOX) | (1u << ST_A_MEM1);

struct Args { const float* in[N_IN]; float* out; unsigned char* ws; int lo, hi; };

__global__ void __launch_bounds__(NTHREADS, 2) yoco_fwd(Args args) {
    extern __shared__ __attribute__((aligned(16))) unsigned char lds[];
    volatile LAS unsigned* bst = (volatile LAS unsigned*)((LAS unsigned char*)lds + BAR_LDS_OFF);
    if (threadIdx.x == 0) { bst[0] = 0u; bst[1] = 0u; }
    __syncthreads();
    const XcdBarrier gbar = xcd_barrier_post((unsigned*)(args.ws + O_CTL), bst);
    const int G = gridDim.x;
    const int wave_s = __builtin_amdgcn_readfirstlane(threadIdx.x >> 6);
#ifndef DUP_MASK
#define DUP_MASK 0u
#endif
    for (int st = args.lo; st < args.hi; ++st) {
      const int nrep = ((DUP_MASK >> st) & 1u) ? 2 : 1;
      for (int rep = 0; rep < nrep; ++rep) {
        unsigned char* ws0 = args.ws; asm volatile("" : "+s"(ws0));
        GAS unsigned char* ws = (GAS unsigned char*)ws0;
#define LANE_ID(v) asm volatile("v_mbcnt_lo_u32_b32 %0, -1, 0\n\tv_mbcnt_hi_u32_b32 %0, -1, %0" : "=v"(v))
#define MAKE_TID(v) do { LANE_ID(v); v += wave_s * 64; } while (0)
#define MAKE_FRAME(F) Frame F; F.ws = ws; F.in_ = args.in; F.out = (GAS float*)args.out; { int t0_; MAKE_TID(t0_); F.tid = t0_; } F.lane = F.tid & 63; F.wave = wave_s; \
        F.gw = blockIdx.x * NWAVES + F.wave; F.ngw = gridDim.x * NWAVES; F.gtid = blockIdx.x * NTHREADS + F.tid; F.ngt = gridDim.x * NTHREADS
        if (st == ST_G_L1) { MAKE_FRAME(F); step_logf(F); }
        if ((GEMM_STEPS >> st) & 1u) {
            pg8::Gemm g; Epi E; E.ws = ws; E.resid = nullptr; E.outf = nullptr; E.o16 = nullptr; E.ssq = nullptr; E.gate_b = nullptr; int shift = 0;
            switch (st) {
            case ST_G_IN0:  g = {(const GAS bf16_t*)(ws + O_XS16), (const GAS bf16_t*)(ws + O_WIN0), T, NIN0, DM, DM, DM, 0}; E.mode = EM_IN0; break;
            case ST_G_MKV0: g = {(const GAS bf16_t*)(ws + O_MEMN), (const GAS bf16_t*)(ws + O_WMKV), NMROW, 1024, DM, DM, DM, 0}; E.mode = EM_MKV; E.o16 = (GAS bf16_t*)(ws + O_MKV); E.ssq = (GAS float*)(ws + O_MKSS); shift = 128; break;
            case ST_G_MKV1: g = {(const GAS bf16_t*)(ws + O_MEMN) + (size_t)NMROW * DM, (const GAS bf16_t*)(ws + O_WMKV) + (size_t)1024 * DM, NMROW, 1024, DM, DM, DM, 0}; E.mode = EM_MKV;
                            E.o16 = (GAS bf16_t*)(ws + O_MKV) + (size_t)NMROW * NL1; E.ssq = (GAS float*)(ws + O_MKSS) + NMROW * 112; shift = 144; break;
            case ST_G_GATE: g = {(const GAS bf16_t*)(ws + O_XC), (const GAS bf16_t*)(ws + O_WGATE), T, 12 * 256, 128, LRU, 128, 128}; E.mode = EM_GATE; E.gate_b = (const GAS float*)args.in[I_AGATEB]; break;
            case ST_G_OUT0: g = {(const GAS bf16_t*)(ws + O_CAT), (const GAS bf16_t*)(ws + O_WOUT0), T, DM, DM, DM, DM, 0}; E.mode = EM_RES; E.resid = (const GAS float*)args.in[I_X]; E.outf = (GAS float*)args.out; break;
            case ST_G_PQ0:  g = {(const GAS bf16_t*)(ws + O_XS16), (const GAS bf16_t*)(ws + O_WQ0), T, DM, DM, DM, DM, 0}; E.mode = EM_PQ; E.o16 = (GAS bf16_t*)(ws + O_Q16); break;
            case ST_G_L1:   g = {(const GAS bf16_t*)(ws + O_XS16), (const GAS bf16_t*)(ws + O_WL1), T, NL1, DM, DM, DM, 0}; E.mode = EM_L1; break;
            case ST_G_OUT1: g = {(const GAS bf16_t*)(ws + O_CAT), (const GAS bf16_t*)(ws + O_WOUT1), T, DM, DM, DM, DM, 0}; E.mode = EM_RES; E.resid = nullptr; break;
            default:        g = {(const GAS bf16_t*)(ws + O_XS16), (const GAS bf16_t*)(ws + O_WQ1), T, DM, DM, DM, DM, 0}; E.mode = EM_PQ; E.o16 = (GAS bf16_t*)(ws + O_Q16); break;
            }
            pg8::StaticOrder S; S.init(g.M, g.N, G, (int)((blockIdx.x + G - shift) % G));
#ifndef DIS_GEMM
            { int tg_; MAKE_TID(tg_);
              pg8::gemm_phase<Epi, false>((LAS unsigned char*)lds, g, S, E, tg_); }
#endif
            if (st == ST_G_MKV1 && blockIdx.x >= 160) { MAKE_FRAME(F); convert_tables(F, 1, 0, CONV1_SPLIT, (blockIdx.x - 160) * NWAVES + F.wave, (G - 160) * NWAVES); }
        } else if ((ATTN_STEPS >> st) & 1u) {
            const int nun = st == ST_A_FOX ? 3 : 1;
            for (int ui = 0; ui < nun; ++ui) {
                att::BlockRef r;
                if (st == ST_A_FOX) {
                    const int i = blockIdx.x, x = i & 15, bh = (i >> 4) + 16 * ui, qb = ui == 0 ? x : (ui == 1 ? 15 - x : ((x * 5 + 3) & 15));
                    const int b = bh / NH, h = bh % NH; const size_t row0 = (size_t)b * SEQ + qb * 256;
                    const GAS bf16_t* z = (const GAS bf16_t*)(ws + O_ZL1);
                    r.Q = z + row0 * NL1 + 3072 + h * 128; r.K = z + (size_t)b * SEQ * NL1 + h * 128; r.V = z + (size_t)b * SEQ * NL1 + 1536 + h * 128;
                    r.O = (GAS bf16_t*)(ws + O_CAT) + row0 * DM + h * 128;
                    const GAS float* ss = (const GAS float*)(ws + O_SSL1);
                    r.qss = ss + row0 * 112 + (12 + h) * 4; r.kss = ss + (size_t)b * SEQ * 112 + h * 4; r.cc = (const GAS float*)(ws + O_CC) + (size_t)bh * SEQ; r.gg = (const GAS float*)(ws + O_GG) + 384;
                    r.P0 = qb * 256; r.skv = SEQ;
                } else {
                    const int l = st == ST_A_MEM0 ? 0 : 1; const int i = blockIdx.x, qblk = i >> 2, h = i & 3, b = qblk >> 4; const size_t row0 = (size_t)qblk * 256;
                    r.Q = (const GAS bf16_t*)(ws + O_ZL1) + row0 * NL1 + 4608 + h * 128; r.qss = (const GAS float*)(ws + O_SSL1) + row0 * 112 + (24 + h) * 4;
                    const GAS bf16_t* kv = (const GAS bf16_t*)(ws + O_MKV) + ((size_t)l * NMROW + b * NMEM) * NL1;
                    r.K = kv + h * 128; r.V = kv + 512 + h * 128; r.kss = (const GAS float*)(ws + O_MKSS) + ((size_t)l * NMROW + b * NMEM) * 112 + h * 4;
                    r.O = (GAS bf16_t*)(ws + O_CAT) + row0 * DM + LRU + h * 128; r.cc = nullptr; r.gg = (const GAS float*)(ws + O_GG) + 128 * (1 + l);
                    r.P0 = SEQ; r.skv = NMEM;
                }
                att::Seam S;
                int tid_u; MAKE_TID(tid_u);
#ifndef DIS_ATTN
                if (st == ST_A_FOX) { att::attn_prime(r, (char*)lds, S, tid_u); att::attn_block(r, (char*)lds, S, tid_u); }
                else att::mem_attn_unit(r, (char*)lds, tid_u);
#endif
            }
        } else {
            MAKE_FRAME(F);
            switch (st) {
#ifndef DIS_MISC
            case ST_PROLOGUE: step_prologue(F, (LAS unsigned char*)lds); break;
            case ST_CONV: step_conv(F); break;
            case ST_SCAN1: step_scan1(F); break;
            case ST_SCAN2: step_scan2(F); break;
#endif
#ifndef DIS_TOPK
            case ST_TOPK0: step_topk(F, (LAS unsigned char*)lds, 0); break;
            case ST_TOPK1: step_topk(F, (LAS unsigned char*)lds, 1); break;
#endif
#ifndef DIS_GATHER
            case ST_UPASS0: step_upass(F, 0, G, (LAS unsigned char*)lds); break;
            case ST_UPASS1: step_upass(F, 1, G, (LAS unsigned char*)lds); break;
            case ST_PRED0: step_peer_reduce(F, 0); break;
            case ST_PRED1: step_peer_reduce(F, 1); break;
            case ST_VPASS0: step_vpass(F, 0, G, rep + 1 < nrep, (LAS unsigned char*)lds); break;
            case ST_VPASS1: step_vpass(F, 1, G, rep + 1 < nrep, (LAS unsigned char*)lds); break;
#endif
#ifndef DIS_MISC
            case ST_CPREFIX: step_cprefix(F, (LAS unsigned char*)lds); convert_tables(F, 1, G > 160 ? CONV1_SPLIT : 0, 2 * NEXP, F.gw, F.ngw); break;
#endif
            default: break;
            }
        }
        if (rep + 1 < nrep) xcd_barrier(gbar, wave_s);
      }
        if (((SYNC_AFTER >> st) & 1u) && st + 1 < args.hi) xcd_barrier(gbar, wave_s);
    }
}

#ifndef N_LAUNCH_MODE
#define N_LAUNCH_MODE 1
#endif
extern "C" void kernel_launch(void* const* d_in, const int* in_sizes, int n_in, void* d_out, int out_size, void* d_ws, size_t ws_size, hipStream_t stream) {
    static int grid = 0;
    if (grid == 0) {
        if (n_in != N_IN || in_sizes[0] != T * DM || out_size != T * DM || ws_size < WS_END) {
            fprintf(stderr, "kernel_launch: unexpected shapes (n_in %d, in0 %d, out %d, ws %zu, need %zu)\n", n_in, n_in > 0 ? in_sizes[0] : -1, out_size, ws_size, (size_t)WS_END); grid = -1; return; }
        int dev = 0, cus = 0, per_cu = 0;
        hipGetDevice(&dev); hipDeviceGetAttribute(&cus, hipDeviceAttributeMultiprocessorCount, dev);
        hipFuncSetAttribute((const void*)yoco_fwd, hipFuncAttributeMaxDynamicSharedMemorySize, LDS_BYTES);
        hipOccupancyMaxActiveBlocksPerMultiprocessor(&per_cu, (const void*)yoco_fwd, NTHREADS, LDS_BYTES);
        if (per_cu < 1) { fprintf(stderr, "kernel_launch: occupancy query says %d blocks per CU\n", per_cu); grid = -1; return; }
        grid = cus - cus % 8;
        (void)hipGetLastError();
    }
    if (grid < 0) return;
    Args a{};
    for (int i = 0; i < N_IN; ++i) a.in[i] = (const float*)d_in[i];
    a.out = (float*)d_out; a.ws = (unsigned char*)d_ws;
    if (hipMemsetAsync((char*)d_ws + O_CTL, 0, 65536, stream) != hipSuccess) { fprintf(stderr, "kernel_launch: memset of the barrier words failed\n"); return; }
    if (N_LAUNCH_MODE == 1) {
        a.lo = 0; a.hi = N_STEPS;
        hipLaunchKernelGGL(yoco_fwd, dim3(grid), dim3(NTHREADS), LDS_BYTES, stream, a);
        hipError_t e = hipPeekAtLastError();
        if (e != hipSuccess) fprintf(stderr, "launch failed: %s (grid %d)\n", hipGetErrorString(e), grid);
    } else {
        int lo = 0;
        for (int s = 0; s < N_STEPS; ++s) {
            if (((SYNC_AFTER >> s) & 1u) || s == N_STEPS - 1) {
                a.lo = lo; a.hi = s + 1; lo = s + 1;
                void* params[] = {&a};
                hipError_t e = hipLaunchCooperativeKernel((const void*)yoco_fwd, dim3(grid), dim3(NTHREADS), params, LDS_BYTES, stream);
                if (e != hipSuccess) { fprintf(stderr, "launch failed: %s\n", hipGetErrorString(e)); break; }
            }
        }
    }
}
```

```cpp
#include <hip/hip_runtime.h>
#include <hip/hip_cooperative_groups.h>
#include <cstdio>
#include <cstdint>
namespace cg = cooperative_groups;

#define LAS __attribute__((address_space(3)))
#define GAS __attribute__((address_space(1)))
typedef unsigned short bf16_t;
typedef short bf16x8 __attribute__((ext_vector_type(8)));
typedef short s16x4 __attribute__((ext_vector_type(4)));
typedef float f32x4 __attribute__((ext_vector_type(4)));
typedef float f32x2 __attribute__((ext_vector_type(2)));
typedef float f32x16 __attribute__((ext_vector_type(16)));
typedef unsigned u32x4 __attribute__((ext_vector_type(4)));
typedef unsigned u32x2 __attribute__((ext_vector_type(2)));
typedef _Float16 h2 __attribute__((ext_vector_type(2)));

constexpr int NB = 4, SEQ = 4096, T = NB * SEQ, DM = 2048, LRU = 1536, MEMW = 512, NMEM = 256, NH = 12, HD = 128;
constexpr int NIN0 = 3584, NL1 = 5120, NEXP = 16384, NMROW = NB * NMEM;
constexpr float EPS = 1e-6f;
constexpr int NTHREADS = 512, NWAVES = 8;

constexpr size_t MiB = 1u << 20;
constexpr size_t O_CTL = 0;
constexpr size_t O_WIN0 = 1 * MiB;
constexpr size_t O_WOUT0 = O_WIN0 + 14 * MiB;
constexpr size_t O_WL1 = O_WOUT0 + 8 * MiB;
constexpr size_t O_WOUT1 = O_WL1 + 20 * MiB;
constexpr size_t O_WQ0 = O_WOUT1 + 8 * MiB;
constexpr size_t O_WQ1 = O_WQ0 + 8 * MiB;
constexpr size_t O_WMKV = O_WQ1 + 8 * MiB;
constexpr size_t O_WGATE = O_WMKV + 8 * MiB;
constexpr size_t O_SUBK = O_WGATE + 1 * MiB;
constexpr size_t O_WF = O_SUBK + 1 * MiB;
constexpr size_t O_SMALL = O_WF + 1 * MiB;
constexpr size_t O_RS1 = O_SMALL;
constexpr size_t O_LOGF = O_SMALL + 64 * 1024;
constexpr size_t O_CC = O_LOGF + 768 * 1024;
constexpr size_t O_GG = O_CC + 768 * 1024;
constexpr size_t O_SPL = O_GG + 4096;
constexpr size_t O_TSC = O_SPL + 8192;
constexpr size_t O_ROWSS = O_SMALL + 2 * MiB;
constexpr size_t O_RSP = O_ROWSS + 2 * MiB;
constexpr size_t O_QMSS = O_RSP;
constexpr size_t O_MKSS = O_QMSS + 1 * MiB;
constexpr size_t O_SSL1 = O_MKSS + 1 * MiB;
constexpr size_t O_CARRY = O_SSL1 + 7 * MiB;
constexpr size_t O_MEMN = O_CARRY + 3 * MiB;
constexpr size_t O_MKV = O_MEMN + 8 * MiB;
constexpr size_t O_IDX = O_MKV + 20 * MiB;
constexpr size_t O_GW = O_IDX + 8 * MiB;
constexpr size_t O_TAB = O_GW + 8 * MiB;
constexpr size_t TAB_NIB = (size_t)8 * 16384 * 128, TAB_ONE = TAB_NIB + (size_t)16384 * 16 + 786432;
constexpr size_t O_XS16 = O_TAB + 128 * MiB;
constexpr size_t O_CAT = O_XS16 + 64 * MiB;
constexpr size_t O_ZX = O_CAT + 64 * MiB;
constexpr size_t O_X8 = O_ZX;
constexpr size_t O_GY = O_ZX + 48 * MiB;
constexpr size_t O_LOGFP = O_GY + 48 * MiB;
constexpr size_t O_QM = O_LOGFP;
constexpr size_t O_XC = O_QM + 16 * MiB;
constexpr size_t O_X4 = O_XC;
constexpr size_t O_SX = O_XC + 32 * MiB;
constexpr size_t O_AA = O_XC + 48 * MiB;
constexpr size_t O_PART = O_AA;
constexpr size_t O_UU = O_AA + 96 * MiB;
constexpr size_t O_W8 = O_UU;
constexpr size_t O_Q16 = O_UU + 96 * MiB;
constexpr size_t O_ZL1 = O_Q16 + 64 * MiB;
constexpr size_t WS_END = O_ZL1 + 160 * MiB;
static_assert(WS_END <= 1024 * MiB, "workspace map");

__device__ __forceinline__ unsigned cvtpk(float lo, float hi) { unsigned r; asm volatile("v_cvt_pk_bf16_f32 %0, %1, %2" : "=v"(r) : "v"(lo), "v"(hi)); return r; }
__device__ __forceinline__ float bf_lo(unsigned w) { return __uint_as_float(w << 16); }
__device__ __forceinline__ float bf_hi(unsigned w) { return __uint_as_float(w & 0xffff0000u); }
__device__ __forceinline__ float fast_exp(float x) { return __builtin_amdgcn_exp2f(x * 1.4426950408889634f); }
__device__ __forceinline__ float log1p_pos(float y) { const float ser = y * (1.f - y * (0.5f - y * (0.33333334f - 0.25f * y))); const float lg = __builtin_amdgcn_logf(1.f + y) * 0.6931471805599453f; return y < 0.03f ? ser : lg; }
__device__ __forceinline__ float one_minus_exp(float x) { const float ser = -x * (1.f + x * (0.5f + x * (0.16666667f + x * 0.041666668f))); const float big = 1.f - fast_exp(x); return x > -0.03f ? ser : big; }
__device__ __forceinline__ float sigmoidf_(float x) { return __builtin_amdgcn_rcpf(1.f + fast_exp(-x)); }
__device__ __forceinline__ float gelu_tanh(float x) { const float u = x * (1.f + 0.044715f * x * x); return x * __builtin_amdgcn_rcpf(1.f + __builtin_amdgcn_exp2f(u * (-2.f * 0.7978845608028654f * 1.4426950408889634f))); }
template <int CTRL> __device__ __forceinline__ float dppf(float v) { return __int_as_float(__builtin_amdgcn_update_dpp(0, __float_as_int(v), CTRL, 0xF, 0xF, true)); }
__device__ __forceinline__ float xsum16(float v) { auto r = __builtin_amdgcn_permlane16_swap(__float_as_uint(v), __float_as_uint(v), false, false); return __uint_as_float(r[0]) + __uint_as_float(r[1]); }
__device__ __forceinline__ float xsum32(float v) { auto r = __builtin_amdgcn_permlane32_swap(__float_as_uint(v), __float_as_uint(v), false, false); return __uint_as_float(r[0]) + __uint_as_float(r[1]); }
__device__ __forceinline__ float xmax16(float v) { auto r = __builtin_amdgcn_permlane16_swap(__float_as_uint(v), __float_as_uint(v), false, false); return fmaxf(__uint_as_float(r[0]), __uint_as_float(r[1])); }
__device__ __forceinline__ float xmax32(float v) { auto r = __builtin_amdgcn_permlane32_swap(__float_as_uint(v), __float_as_uint(v), false, false); return fmaxf(__uint_as_float(r[0]), __uint_as_float(r[1])); }
__device__ __forceinline__ float wave_sum(float v) {
    v += dppf<0xB1>(v); v += dppf<0x4E>(v); v += dppf<0x141>(v); v += dppf<0x140>(v);
    v = xsum16(v); v = xsum32(v); return v;
}
__device__ __forceinline__ float wave_max(float v) {
    v = fmaxf(v, dppf<0xB1>(v)); v = fmaxf(v, dppf<0x4E>(v)); v = fmaxf(v, dppf<0x141>(v)); v = fmaxf(v, dppf<0x140>(v));
    v = xmax16(v); v = xmax32(v); return v;
}

namespace pg8 {
constexpr int BM = 256, BK = 64, HALF = 128, HTB = HALF * BK * 2, STAGE_BYTES = 8 * HTB, NXCD = 8, WGM = 8;
__host__ __device__ __forceinline__ int lds_byte(int r, int c) { const int st = (r >> 4) * 2 + (c >> 5), rr = r & 15, cc = c & 31, ob = rr * 64 + cc * 2; return st * 1024 + (ob ^ (((ob >> 9) & 1) << 5)); }
__host__ __device__ __forceinline__ void stage_rc(int b, int& R, int& C) { const int st = b / 1024, sb = b % 1024, swz = sb ^ (((sb >> 9) & 1) << 5); R = (st >> 1) * 16 + swz / 64; C = (st & 1) * 32 + (swz % 64) / 2; }
__host__ __device__ __forceinline__ int perm32(int rho) { const int n = rho >> 4, i = rho & 15; return 8 * (i >> 2) + 4 * n + (i & 3); }

struct Unit { int pm, pn; };
struct Gemm { const GAS bf16_t* A; const GAS bf16_t* Bt; int M, N, K, lda, ldb, acol; };

struct StaticOrder {
    int nM, nN, nwg, G, c;
    __device__ void init(int M, int N, int G_, int c_) { nM = M / BM; nN = N / BM; nwg = nM * nN; G = G_; c = c_; }
    __device__ bool next(int i, Unit& u) const {
        const long L = (long)i * G + c; if (L >= nwg) return false;
        int wgid = (int)L; { const int q = nwg / NXCD, r = nwg % NXCD, xcd = wgid % NXCD, off = wgid / NXCD; wgid = (xcd < r ? xcd * (q + 1) : r * (q + 1) + (xcd - r) * q) + off; }
        const int nig = WGM * nN, gid = wgid / nig, fm = gid * WGM, gsz = (nM - fm) < WGM ? (nM - fm) : WGM;
        u.pm = fm + ((wgid % nig) % gsz); u.pn = (wgid % nig) / gsz; return true;
    }
};

typedef int v8i_t __attribute__((ext_vector_type(8)));
typedef int v4i_t __attribute__((ext_vector_type(4)));
template <class Epi, bool FP8>
__device__ __forceinline__ void gemm_phase(LAS unsigned char* lds, const Gemm g, const StaticOrder& S, const Epi& E, const int tid) {
    const int wid = __builtin_amdgcn_readfirstlane(tid >> 6), lane = tid & 63, wr = wid >> 2, wc = wid & 3, fr = lane & 15, fq = lane >> 4;
    const int K = g.K, nt = K / BK;
    unsigned voffA[2], voffB[2];
#pragma unroll
    for (int i = 0; i < 2; ++i) { int R, C; stage_rc(tid * 16 + i * 8192, R, C); const int Rb = (R & ~31) + perm32(R & 31);
        voffA[i] = (unsigned)(R * g.lda + C) * 2u; voffB[i] = (unsigned)(Rb * g.ldb + C) * 2u; }
    const size_t kstep = (size_t)(BK * 2);
    const size_t hstepA = (size_t)HALF * g.lda * 2, hstepB = (size_t)HALF * g.ldb * 2;
    const size_t tstepA = 2 * hstepA, tstepB = 2 * hstepB;
    const unsigned ldsw = (unsigned)wid * 1024u;
    const int aoff = lds_byte(wr * 64 + fr, fq * 8), boff = lds_byte(wc * 32 + fr, fq * 8);
#define PG8_SA(b, h) (((b) * 2 + (h)) * HTB)
#define PG8_SB(b, h) ((4 + (b) * 2 + (h)) * HTB)
#define PG8_STAGE(bufoff, gbase, voff) do { _Pragma("unroll") for (int _i = 0; _i < 2; ++_i) \
        __builtin_amdgcn_global_load_lds((const GAS unsigned*)((gbase) + (voff)[_i]), (LAS unsigned*)(lds + (bufoff) + ldsw + _i * 8192), 16, 0, 0); } while (0)
#define PG8_LD2(dst, off_) do { const u32x4 lo_ = *(const LAS u32x4*)(lds + (off_)), hi_ = *(const LAS u32x4*)(lds + (off_) + 1024); \
        dst = (v8i_t){(int)lo_.x, (int)lo_.y, (int)lo_.z, (int)lo_.w, (int)hi_.x, (int)hi_.y, (int)hi_.z, (int)hi_.w}; } while (0)
#define PG8_LDA(dst, b, h) do { _Pragma("unroll") for (int m = 0; m < 4; ++m) PG8_LD2(dst[m], PG8_SA(b, h) + aoff + m * 2048); } while (0)
#define PG8_LDB(dst, b, h) do { _Pragma("unroll") for (int n = 0; n < 2; ++n) PG8_LD2(dst[n], PG8_SB(b, h) + boff + n * 2048); } while (0)
#define PG8_HALF(v, k) ((k) ? __builtin_shufflevector(v, v, 4, 5, 6, 7) : __builtin_shufflevector(v, v, 0, 1, 2, 3))
#define PG8_MMA(ai, bj, At, Bt) do { __builtin_amdgcn_s_setprio(1); _Pragma("unroll") for (int m = 0; m < 4; ++m) _Pragma("unroll") for (int n = 0; n < 2; ++n) { \
        if constexpr (FP8) asm volatile("v_mfma_scale_f32_16x16x128_f8f6f4 %0, %1, %2, %0, %3, %4 op_sel_hi:[0,0,0]" : "+v"(acc[ai][bj][m][n]) : "v"(Bt[n]), "v"(At[m]), "v"(sc_w), "v"(sc_x));     \
        else { _Pragma("unroll") for (int k = 0; k < 2; ++k) { const v4i_t bh_ = PG8_HALF(Bt[n], k), ah_ = PG8_HALF(At[m], k); \
                acc[ai][bj][m][n] = __builtin_amdgcn_mfma_f32_16x16x32_bf16(__builtin_bit_cast(bf16x8, bh_), __builtin_bit_cast(bf16x8, ah_), acc[ai][bj][m][n], 0, 0, 0); } } } \
        __builtin_amdgcn_s_setprio(0); } while (0)
#define PG8_WAIT_V(n) asm volatile("s_waitcnt vmcnt(" #n ")" ::: "memory")
#define PG8_WAIT_L(n) asm volatile("s_waitcnt lgkmcnt(" #n ")" ::: "memory")
#define PG8_BAR __builtin_amdgcn_s_barrier()
#define PG8_SCHED __builtin_amdgcn_sched_barrier(0)
    Unit cur, nxt; int ui = 0;
    if (!S.next(0, cur)) return;
    f32x4 acc[2][2][4][2];
#pragma unroll
    for (int a = 0; a < 2; ++a)
#pragma unroll
        for (int b = 0; b < 2; ++b)
#pragma unroll
            for (int m = 0; m < 4; ++m)
#pragma unroll
                for (int n = 0; n < 2; ++n) acc[a][b][m][n] = (f32x4){0.f, 0.f, 0.f, 0.f};
    v8i_t At[4], B0[2], B1[2];
    const int sc_w = 121, sc_x = 127;
    const GAS char* cA = (const GAS char*)g.A + (size_t)cur.pm * tstepA + (size_t)cur.pn * g.acol * 2; const GAS char* cB = (const GAS char*)g.Bt + (size_t)cur.pn * tstepB;
    PG8_STAGE(PG8_SB(0, 0), cB, voffB); PG8_STAGE(PG8_SB(0, 1), cB + hstepB, voffB); PG8_STAGE(PG8_SA(0, 0), cA, voffA); PG8_STAGE(PG8_SA(0, 1), cA + hstepA, voffA);
    if (wr == 1) PG8_BAR;
    PG8_WAIT_V(2); PG8_BAR;
    PG8_STAGE(PG8_SB(1, 0), cB + kstep, voffB); PG8_STAGE(PG8_SA(1, 0), cA + kstep, voffA); PG8_STAGE(PG8_SB(1, 1), cB + hstepB + kstep, voffB);
    PG8_WAIT_V(6); PG8_BAR;
    for (;;) {
        const bool has_next = S.next(ui + 1, nxt);
        const GAS char* nA = has_next ? (const GAS char*)g.A + (size_t)nxt.pm * tstepA + (size_t)nxt.pn * g.acol * 2 : cA; const GAS char* nB = has_next ? (const GAS char*)g.Bt + (size_t)nxt.pn * tstepB : cB;
        for (int t = 0; t < nt; t += 2) {
            const bool last = (t == nt - 2);
            const GAS char* a1 = cA + (size_t)(t + 1) * kstep;
            const GAS char* a2 = last ? nA : cA + (size_t)(t + 2) * kstep; const GAS char* b2 = last ? nB : cB + (size_t)(t + 2) * kstep;
            const GAS char* a3 = a2 + kstep; const GAS char* b3 = b2 + kstep;
            PG8_LDB(B0, 0, 0); PG8_LDB(B1, 0, 1); PG8_SCHED; PG8_LDA(At, 0, 0); PG8_STAGE(PG8_SA(1, 1), a1 + hstepA, voffA);
            PG8_WAIT_V(8); PG8_WAIT_L(0); PG8_BAR; PG8_MMA(0, 0, At, B0); PG8_MMA(0, 1, At, B1); PG8_BAR; PG8_SCHED;
            PG8_LDA(At, 0, 1); PG8_STAGE(PG8_SB(0, 0), b2, voffB); PG8_STAGE(PG8_SB(0, 1), b2 + hstepB, voffB); PG8_STAGE(PG8_SA(0, 0), a2, voffA);
            PG8_WAIT_V(8); PG8_WAIT_L(0); PG8_BAR; PG8_MMA(1, 0, At, B0); PG8_MMA(1, 1, At, B1); PG8_BAR; PG8_SCHED;
            PG8_LDB(B0, 1, 0); PG8_LDB(B1, 1, 1); PG8_SCHED; PG8_LDA(At, 1, 0); PG8_STAGE(PG8_SA(0, 1), a2 + hstepA, voffA);
            PG8_WAIT_V(8); PG8_WAIT_L(0); PG8_BAR; PG8_MMA(0, 0, At, B0); PG8_MMA(0, 1, At, B1); PG8_BAR; PG8_SCHED;
            PG8_LDA(At, 1, 1); PG8_STAGE(PG8_SB(1, 0), b3, voffB); PG8_STAGE(PG8_SB(1, 1), b3 + hstepB, voffB); PG8_STAGE(PG8_SA(1, 0), a3, voffA);
            PG8_WAIT_V(8); PG8_WAIT_L(0); PG8_BAR; PG8_MMA(1, 0, At, B0); PG8_MMA(1, 1, At, B1); PG8_BAR; PG8_SCHED;
        }
        if (wr == 0) PG8_BAR;
        { int ln_; asm volatile("v_mbcnt_lo_u32_b32 %0, -1, 0\n\tv_mbcnt_hi_u32_b32 %0, -1, %0" : "=v"(ln_));
          E(acc, cur, wr, wc, ln_ & 15, ln_ >> 4); }
        if (!has_next) break;
#pragma unroll
        for (int a = 0; a < 2; ++a)
#pragma unroll
            for (int b = 0; b < 2; ++b)
#pragma unroll
                for (int m = 0; m < 4; ++m)
#pragma unroll
                    for (int n = 0; n < 2; ++n) acc[a][b][m][n] = (f32x4){0.f, 0.f, 0.f, 0.f};
        cur = nxt; cA = nA; cB = nB; ++ui;
        if (wr == 1) PG8_BAR;
    }
    PG8_WAIT_V(0);
    PG8_BAR;
#undef PG8_SA
#undef PG8_SB
#undef PG8_STAGE
#undef PG8_LDA
#undef PG8_LDB
#undef PG8_LD2
#undef PG8_HALF
#undef PG8_MMA
#undef PG8_WAIT_V
#undef PG8_WAIT_L
#undef PG8_BAR
#undef PG8_SCHED
}
}

enum { EM_IN0 = 0, EM_MKV = 1, EM_GATE = 2, EM_RES = 3, EM_PQ = 4, EM_L1 = 5 };
struct Epi {
    int mode;
    GAS unsigned char* ws;
    const GAS float* resid;
    GAS float* outf;
    GAS bf16_t* o16;
    GAS float* ssq;
    const GAS float* gate_b;
    typedef pg8::Unit Unit;
    __device__ __forceinline__ static void st8(GAS bf16_t* p, f32x4 v0, f32x4 v1) {
        u32x4 w; w.x = cvtpk(v0[0], v0[1]); w.y = cvtpk(v0[2], v0[3]); w.z = cvtpk(v1[0], v1[1]); w.w = cvtpk(v1[2], v1[3]); *(GAS u32x4*)p = w; }
    __device__ __forceinline__ static float sq8(f32x4 a, f32x4 b) { return (a[0] * a[0] + a[1] * a[1]) + (a[2] * a[2] + a[3] * a[3]) + (b[0] * b[0] + b[1] * b[1]) + (b[2] * b[2] + b[3] * b[3]); }
    __device__ __forceinline__ void operator()(f32x4 (&acc)[2][2][4][2], const Unit& u, int wr, int wc, int fr, int fq) const {
        const int row0 = u.pm * 256 + wr * 64 + fr;
        const int cin = wc * 32 + 8 * fq;
        if (mode == EM_IN0) {
            GAS bf16_t* base; int ld, colt; int kind;
            if (u.pn < 6) { base = (GAS bf16_t*)(ws + O_ZX); ld = LRU; colt = u.pn * 256; kind = 0; }
            else if (u.pn < 12) { base = (GAS bf16_t*)(ws + O_GY); ld = LRU; colt = (u.pn - 6) * 256; kind = 1; }
            else { base = (GAS bf16_t*)(ws + O_ZL1); ld = NL1; colt = 4608 + (u.pn - 12) * 256; kind = 2; }
            GAS float* qmss = (GAS float*)(ws + O_SSL1);
#pragma unroll
            for (int ai = 0; ai < 2; ++ai)
#pragma unroll
                for (int m = 0; m < 4; ++m) { const int row = row0 + ai * 128 + m * 16;
#pragma unroll
                    for (int bj = 0; bj < 2; ++bj) { f32x4 v0 = acc[ai][bj][m][0], v1 = acc[ai][bj][m][1];
                        if (kind == 1) {
#pragma unroll
                            for (int j = 0; j < 4; ++j) { v0[j] = gelu_tanh(v0[j]); v1[j] = gelu_tanh(v1[j]); } }
                        st8(base + (size_t)row * ld + colt + bj * 128 + cin, v0, v1);
                        if (kind == 2) { float s = sq8(v0, v1); s = xsum16(s); s = xsum32(s);
                            if (fq == 0) qmss[(size_t)row * 112 + (24 + (u.pn - 12) * 2 + bj) * 4 + wc] = s; } } }
        } else if (mode == EM_MKV) {
#pragma unroll
            for (int ai = 0; ai < 2; ++ai)
#pragma unroll
                for (int m = 0; m < 4; ++m) { const int row = row0 + ai * 128 + m * 16;
#pragma unroll
                    for (int bj = 0; bj < 2; ++bj) { const f32x4 v0 = acc[ai][bj][m][0], v1 = acc[ai][bj][m][1];
                        st8(o16 + (size_t)row * NL1 + u.pn * 256 + bj * 128 + cin, v0, v1);
                        if (u.pn < 2) { float s = sq8(v0, v1); s = xsum16(s); s = xsum32(s);
                            if (fq == 0) ssq[(size_t)row * 112 + (u.pn * 2 + bj) * 4 + wc] = s; } } }
        } else if (mode == EM_GATE) {
            const int ch = u.pn * 128 + cin;
            const GAS bf16_t* xc = (const GAS bf16_t*)(ws + O_XC); GAS _Float16* LA = (GAS _Float16*)(ws + O_AA); GAS _Float16* UH = (GAS _Float16*)(ws + O_UU);
            const GAS float* spl = (const GAS float*)(ws + O_SPL) + ch; const GAS float* gb = gate_b + u.pn * 256 + cin;
#pragma unroll
            for (int n = 0; n < 2; ++n) {
                const f32x4 sp = *(const GAS f32x4*)(spl + 4 * n), br = *(const GAS f32x4*)(gb + 4 * n), bi = *(const GAS f32x4*)(gb + 128 + 4 * n);
#pragma unroll
                for (int ai = 0; ai < 2; ++ai)
#pragma unroll
                    for (int m = 0; m < 4; ++m) { const int row = row0 + ai * 128 + m * 16;
                        const u32x2 xw = *(const GAS u32x2*)(xc + (size_t)row * LRU + ch + 4 * n);
                        const f32x4 xv = {bf_lo(xw.x), bf_hi(xw.x), bf_lo(xw.y), bf_hi(xw.y)};
                        float lav[4], uvv[4];
#pragma unroll
                        for (int j = 0; j < 4; ++j) { const float r = sigmoidf_(acc[ai][0][m][n][j] + br[j]), ig = sigmoidf_(acc[ai][1][m][n][j] + bi[j]);
                            const float la = -8.f * r * sp[j];
                            lav[j] = la; uvv[j] = __builtin_amdgcn_sqrtf(one_minus_exp(2.f * la)) * (ig * xv[j]); }
                        { const h2 l0 = {(_Float16)lav[0], (_Float16)lav[1]}, l1 = {(_Float16)lav[2], (_Float16)lav[3]}, u0 = {(_Float16)uvv[0], (_Float16)uvv[1]}, u1 = {(_Float16)uvv[2], (_Float16)uvv[3]};
                          *(GAS u32x2*)(LA + (size_t)row * LRU + ch + 4 * n) = (u32x2){__builtin_bit_cast(unsigned, l0), __builtin_bit_cast(unsigned, l1)};
                          *(GAS u32x2*)(UH + (size_t)row * LRU + ch + 4 * n) = (u32x2){__builtin_bit_cast(unsigned, u0), __builtin_bit_cast(unsigned, u1)}; } }
            }
        } else if (mode == EM_RES) {
            GAS bf16_t* xs = (GAS bf16_t*)(ws + O_XS16); GAS float* rowss = (GAS float*)(ws + O_ROWSS);
#pragma unroll
            for (int ai = 0; ai < 2; ++ai)
#pragma unroll
                for (int m = 0; m < 4; ++m) { const int row = row0 + ai * 128 + m * 16; float s = 0.f;
#pragma unroll
                    for (int bj = 0; bj < 2; ++bj) { const size_t off = (size_t)row * DM + u.pn * 256 + bj * 128 + cin;
                        f32x4 r0, r1;
                        if (resid) { r0 = *(const GAS f32x4*)(resid + off); r1 = *(const GAS f32x4*)(resid + off + 4); }
                        else { const u32x4 w = *(const GAS u32x4*)(xs + off); r0 = (f32x4){bf_lo(w.x), bf_hi(w.x), bf_lo(w.y), bf_hi(w.y)}; r1 = (f32x4){bf_lo(w.z), bf_hi(w.z), bf_lo(w.w), bf_hi(w.w)}; }
                        const f32x4 v0 = acc[ai][bj][m][0] + r0, v1 = acc[ai][bj][m][1] + r1;
                        st8(xs + off, v0, v1); s += sq8(v0, v1); }
                    s = xsum16(s); s = xsum32(s);
                    if (fq == 0) rowss[(size_t)row * 32 + u.pn * 4 + wc] = s; }
        } else if (mode == EM_PQ) {
            const GAS float* rowss = (const GAS float*)(ws + O_ROWSS);
#pragma unroll
            for (int ai = 0; ai < 2; ++ai)
#pragma unroll
                for (int m = 0; m < 4; ++m) { const int row = row0 + ai * 128 + m * 16;
                    const f32x4 p0 = *(const GAS f32x4*)(rowss + (size_t)row * 32 + fq * 8), p1 = *(const GAS f32x4*)(rowss + (size_t)row * 32 + fq * 8 + 4);
                    float s = (p0[0] + p0[1]) + (p0[2] + p0[3]) + (p1[0] + p1[1]) + (p1[2] + p1[3]); s = xsum16(s); s = xsum32(s);
                    const float r = rsqrtf(s * (1.f / DM) + EPS);
#pragma unroll
                    for (int bj = 0; bj < 2; ++bj) st8(o16 + (size_t)row * DM + u.pn * 256 + bj * 128 + cin, acc[ai][bj][m][0] * r, acc[ai][bj][m][1] * r); }
        } else {
            const GAS float* rsp = (const GAS float*)(ws + O_RSP); GAS bf16_t* zl1 = (GAS bf16_t*)(ws + O_ZL1); GAS float* ssl1 = (GAS float*)(ws + O_SSL1);
            const int slot0 = u.pn < 6 ? u.pn * 2 : (u.pn >= 12 ? 12 + (u.pn - 12) * 2 : -1);
#pragma unroll
            for (int ai = 0; ai < 2; ++ai)
#pragma unroll
                for (int m = 0; m < 4; ++m) { const int row = row0 + ai * 128 + m * 16;
                    const f32x4 q0 = *(const GAS f32x4*)(rsp + (size_t)row * 8), q1 = *(const GAS f32x4*)(rsp + (size_t)row * 8 + 4);
                    const float r = rsqrtf(((q0[0] + q0[1]) + (q0[2] + q0[3]) + (q1[0] + q1[1]) + (q1[2] + q1[3])) * (1.f / DM) + EPS);
#pragma unroll
                    for (int bj = 0; bj < 2; ++bj) { const f32x4 v0 = acc[ai][bj][m][0] * r, v1 = acc[ai][bj][m][1] * r;
                        st8(zl1 + (size_t)row * NL1 + u.pn * 256 + bj * 128 + cin, v0, v1);
                        if (slot0 >= 0) { float s = sq8(v0, v1); s = xsum16(s); s = xsum32(s);
                            if (fq == 0) ssl1[(size_t)row * 112 + (slot0 + bj) * 4 + wc] = s; } } }
        }
    }
};

namespace att {
constexpr float SCALE = 0.08838834764831845f;
constexpr int NW = 8, QBLK = 32, KVBLK = 64, QB = NW * QBLK, D = 128;
constexpr int SHM_V = KVBLK * D * 2, SHM_K = KVBLK * D * 2;
constexpr int OFF_WS = 2 * SHM_V + 2 * SHM_K;
constexpr int OFF_KS = OFF_WS + 2048;
constexpr int OFF_BS = OFF_KS + 16384;
constexpr int LDS_END = OFF_BS + 16384;
constexpr int WBIG = 1 << 28;

#define KSWZ(row, colB) ((row) * 256 + ((colB) ^ (((row) & 7) << 4)))
#define SBAR() __builtin_amdgcn_sched_barrier(0)
__device__ __forceinline__ int v_st(int k, int c) { const int kk = (k & ~0xC) | ((k & 4) << 1) | ((k & 8) >> 1); return ((kk >> 3) * 4 + (c >> 5)) * 512 + ((kk & 7) * 32 + (c & 31)) * 2; }
__device__ __forceinline__ int v_rd_base(int lane) { return ((lane & 3) << 3) | (((lane >> 2) & 3) << 6) | (((lane >> 4) & 1) << 5) | (((lane >> 5) & 1) << 8); }
constexpr int v_rd_off(int d0, int ks, int half) { return d0 * 512 + ks * 4096 + half * 2048; }
__device__ __forceinline__ int crow(int r, int hi) { return (r & 3) + 8 * (r >> 2) + 4 * hi; }
__device__ __forceinline__ bf16x8 load8(const GAS bf16_t* p) { return *(const GAS bf16x8*)p; }
__device__ __forceinline__ bf16x8 scale8(bf16x8 v, float s) { const u32x4 w = *reinterpret_cast<u32x4*>(&v); u32x4 o;
    o.x = cvtpk(bf_lo(w.x) * s, bf_hi(w.x) * s); o.y = cvtpk(bf_lo(w.y) * s, bf_hi(w.y) * s); o.z = cvtpk(bf_lo(w.z) * s, bf_hi(w.z) * s); o.w = cvtpk(bf_lo(w.w) * s, bf_hi(w.w) * s);
    return *reinterpret_cast<bf16x8*>(&o); }
__device__ __forceinline__ void mask_tile(f32x16& p0, f32x16& p1, int dq, unsigned W) {
    const float NEG = -__builtin_inff();
#pragma unroll
    for (int r = 0; r < 16; ++r) {
        const int c = (r & 3) + 8 * (r >> 2);
        if ((unsigned)(dq - c) >= W) p0[r] = NEG;
        if ((unsigned)(dq - c - 32) >= W) p1[r] = NEG;
    }
}
constexpr float THR = 8.f;
__device__ __forceinline__ void partialSM(f32x16& p0, f32x16& p1, float& m_reg, float& mn, float& alpha) {
    float pmax = p0[0]; for (int r = 1; r < 16; ++r) pmax = fmaxf(pmax, p0[r]); for (int r = 0; r < 16; ++r) pmax = fmaxf(pmax, p1[r]);
    { auto rr = __builtin_amdgcn_permlane32_swap(__float_as_uint(pmax), __float_as_uint(pmax), false, false);
      pmax = fmaxf(__uint_as_float(rr[0]), __uint_as_float(rr[1])); }
    constexpr float C2 = 1.4426950408889634f * SCALE;
    if (__builtin_expect(__all((pmax - m_reg) * SCALE <= THR), 1)) { mn = m_reg; alpha = 1.f; }
    else { mn = fmaxf(m_reg, pmax); alpha = __builtin_amdgcn_exp2f((m_reg - mn) * C2); m_reg = mn; }
    const float mnL = -mn * C2;
    for (int r = 0; r < 16; ++r) p0[r] = fmaf(p0[r], C2, mnL); for (int r = 0; r < 16; ++r) p1[r] = fmaf(p1[r], C2, mnL);
    for (int r = 0; r < 16; ++r) p0[r] = __builtin_amdgcn_exp2f(p0[r]);
}
__device__ __forceinline__ void finishSM(f32x16& p0, f32x16& p1, float alpha, float& l_reg, bf16x8& pa0, bf16x8& pa1, bf16x8& pa2, bf16x8& pa3) {
    for (int r = 0; r < 16; ++r) p1[r] = __builtin_amdgcn_exp2f(p1[r]);
    float ps = 0; for (int r = 0; r < 16; ++r) ps += p0[r]; for (int r = 0; r < 16; ++r) ps += p1[r];
    { auto rr = __builtin_amdgcn_permlane32_swap(__float_as_uint(ps), __float_as_uint(ps), false, false);
      ps = __uint_as_float(rr[0]) + __uint_as_float(rr[1]); }
    l_reg = l_reg * alpha + ps;
#define PK4(P, B_, OUT) do { unsigned a0 = cvtpk(P[B_+0], P[B_+1]), a1 = cvtpk(P[B_+2], P[B_+3]);                          \
        unsigned b0 = cvtpk(P[B_+4], P[B_+5]), b1 = cvtpk(P[B_+6], P[B_+7]);                                             \
        auto r0 = __builtin_amdgcn_permlane32_swap(a0, b0, false, false); auto r1 = __builtin_amdgcn_permlane32_swap(a1, b1, false, false); \
        u32x4 w = {r0[0], r1[0], r0[1], r1[1]}; OUT = *reinterpret_cast<bf16x8*>(&w); } while (0)
    PK4(p0, 0, pa0); PK4(p0, 8, pa1); PK4(p1, 0, pa2); PK4(p1, 8, pa3);
#undef PK4
}
template <int KB>
__device__ __forceinline__ void qkt(f32x16& p0, f32x16& p1, const char* K_lds, int r32, int hi, const bf16x8* qr, const float* bp  ) {
    { const f32x4 a = *(const f32x4*)(bp), b = *(const f32x4*)(bp + 8), c = *(const f32x4*)(bp + 16), d = *(const f32x4*)(bp + 24);
      p0 = (f32x16){a[0], a[1], a[2], a[3], b[0], b[1], b[2], b[3], c[0], c[1], c[2], c[3], d[0], d[1], d[2], d[3]}; }
    { const f32x4 a = *(const f32x4*)(bp + 32), b = *(const f32x4*)(bp + 40), c = *(const f32x4*)(bp + 48), d = *(const f32x4*)(bp + 56);
      p1 = (f32x16){a[0], a[1], a[2], a[3], b[0], b[1], b[2], b[3], c[0], c[1], c[2], c[3], d[0], d[1], d[2], d[3]}; }
    const char* kb[4];
#pragma unroll
    for (int dd = 0; dd < 4; ++dd) kb[dd] = K_lds + KB * SHM_K + KSWZ(r32, (dd * 16 + hi * 8) * 2);
#pragma unroll
    for (int d0 = 0; d0 < 8; ++d0) { const char* a = kb[d0 & 3] + (d0 >> 2) * 128;
        bf16x8 b0 = *reinterpret_cast<const bf16x8*>(a);
        bf16x8 b1 = *reinterpret_cast<const bf16x8*>(a + 32 * 256);
        p0 = __builtin_amdgcn_mfma_f32_32x32x16_bf16(b0, qr[d0], p0, 0, 0, 0);
        p1 = __builtin_amdgcn_mfma_f32_32x32x16_bf16(b1, qr[d0], p1, 0, 0, 0); }
}
template <int KB>
__device__ __forceinline__ void qkt0(f32x16& p0, f32x16& p1, const char* K_lds, int r32, int hi, const bf16x8* qr) {
    p0 = f32x16{}; p1 = f32x16{};
    const char* kb[4];
#pragma unroll
    for (int dd = 0; dd < 4; ++dd) kb[dd] = K_lds + KB * SHM_K + KSWZ(r32, (dd * 16 + hi * 8) * 2);
#pragma unroll
    for (int d0 = 0; d0 < 8; ++d0) { const char* a = kb[d0 & 3] + (d0 >> 2) * 128;
        bf16x8 b0 = *reinterpret_cast<const bf16x8*>(a);
        bf16x8 b1 = *reinterpret_cast<const bf16x8*>(a + 32 * 256);
        p0 = __builtin_amdgcn_mfma_f32_32x32x16_bf16(b0, qr[d0], p0, 0, 0, 0);
        p1 = __builtin_amdgcn_mfma_f32_32x32x16_bf16(b1, qr[d0], p1, 0, 0, 0); }
}
template <int VB>
__device__ __forceinline__ void pv_tile(f32x16* o, int vb0, bf16x8 pa0, bf16x8 pa1, bf16x8 pa2, bf16x8 pa3) {
#define TRRD(dst, off) asm volatile("ds_read_b64_tr_b16 %0, %1 offset:%2" : "=&v"(dst) : "v"(vb0), "i"(off) : "memory")
#define PV_D0(d0) do { s16x4 l0, l1, l2, l3, h0, h1, h2_, h3; constexpr int b_ = VB * SHM_V + v_rd_off(d0, 0, 0); \
        TRRD(l0, b_); TRRD(h0, b_ + 2048); TRRD(l1, b_ + 4096); TRRD(h1, b_ + 6144); TRRD(l2, b_ + 8192); TRRD(h2_, b_ + 10240); TRRD(l3, b_ + 12288); TRRD(h3, b_ + 14336); \
        asm volatile("s_waitcnt lgkmcnt(0)" ::: "memory"); SBAR();   \
        o[d0] = __builtin_amdgcn_mfma_f32_32x32x16_bf16(pa0, (bf16x8){l0[0], l0[1], l0[2], l0[3], h0[0], h0[1], h0[2], h0[3]}, o[d0], 0, 0, 0);   \
        o[d0] = __builtin_amdgcn_mfma_f32_32x32x16_bf16(pa1, (bf16x8){l1[0], l1[1], l1[2], l1[3], h1[0], h1[1], h1[2], h1[3]}, o[d0], 0, 0, 0);   \
        o[d0] = __builtin_amdgcn_mfma_f32_32x32x16_bf16(pa2, (bf16x8){l2[0], l2[1], l2[2], l2[3], h2_[0], h2_[1], h2_[2], h2_[3]}, o[d0], 0, 0, 0);   \
        o[d0] = __builtin_amdgcn_mfma_f32_32x32x16_bf16(pa3, (bf16x8){l3[0], l3[1], l3[2], l3[3], h3[0], h3[1], h3[2], h3[3]}, o[d0], 0, 0, 0); } while (0)
    PV_D0(0); PV_D0(1); PV_D0(2); PV_D0(3);
#undef PV_D0
#undef TRRD
}

struct BlockRef { const GAS bf16_t* Q; const GAS bf16_t* K; const GAS bf16_t* V; GAS bf16_t* O; const GAS float* qss; const GAS float* kss; const GAS float* cc; const GAS float* gg;
                  int P0, skv; };
constexpr int LDQ = 5120, LDK = 5120, LDO = 2048, LDSS = 112;
struct Seam { bf16x8 qr[8]; bf16x8 st_v0, st_v1, st_k0, st_k1; int jlo; };
#define ROWK(p, k0, rr) ((p) + (size_t)((k0) + (rr)) * LDK + sc)
#define VMW() asm volatile("s_waitcnt vmcnt(0)" ::: "memory")
#define VMWN(n) asm volatile("s_waitcnt vmcnt(%0)" :: "i"(n) : "memory")
#define SLOAD_H(Kp, Vp, k0) do { S.st_v0 = load8(ROWK(Vp, k0, sr)); S.st_v1 = load8(ROWK(Vp, k0, 32 + sr));              \
                         S.st_k0 = load8(ROWK(Kp, k0, sr)); S.st_k1 = load8(ROWK(Kp, k0, 32 + sr)); } while (0)
#define SWRITE_HK(bf, k0) do { *(bf16x8*)(K_lds + (bf) * SHM_K + kws) = scale8(S.st_k0, ksr[(k0)]); *(bf16x8*)(K_lds + (bf) * SHM_K + kws + 32 * 256) = scale8(S.st_k1, ksr[(k0) + 32]); } while (0)
#define SWRITE_HV(bf) do { *(bf16x8*)(V_lds + (bf) * SHM_V + vst0) = S.st_v0; *(bf16x8*)(V_lds + (bf) * SHM_V + vst1) = S.st_v1; } while (0)
#define SWRITE_H(bf, k0) do { SWRITE_HV(bf); SWRITE_HK(bf, k0); } while (0)

__device__ __forceinline__ void attn_prime(const BlockRef& cur, char* lds, Seam& S, const int tid) {
    const int wid = __builtin_amdgcn_readfirstlane(tid >> 6), lane = tid & 63, r32 = lane & 31, hi = lane >> 5;
    const int sr = tid >> 4, sc = (tid & 15) * 8, kws = KSWZ(sr, sc * 2); char* K_lds = lds + 2 * SHM_V;
    float* ks_l = (float*)(lds + OFF_KS); float* bs_l = (float*)(lds + OFF_BS); const float* ksr = ks_l + sr;
    int j_hi = (cur.P0 + QB - 1) / KVBLK + 1; if (j_hi > cur.skv / KVBLK) j_hi = cur.skv / KVBLK;
    const int nkeys = j_hi * KVBLK;
    const float c0 = cur.cc ? cur.cc[cur.P0] : 0.f;
    int jlo = 0;
    if (cur.cc) { const float thr = cur.gg[128]; const int jd = cur.P0 / KVBLK;
        const float cv = lane <= jd ? cur.cc[lane * KVBLK + KVBLK - 1] : 0.f;
        const bool keep = lane > jd || (c0 - cv > -thr);
        jlo = __ffsll((long long)__ballot(keep)) - 1; }
    S.jlo = jlo;
    for (int s = jlo * KVBLK + tid; s < nkeys; s += NTHREADS) {
        const f32x4 p = *(const GAS f32x4*)(cur.kss + (size_t)s * LDSS);
        ks_l[s] = rsqrtf(((p[0] + p[1]) + (p[2] + p[3])) * (1.f / 128.f) + EPS);
        bs_l[s] = cur.cc ? (c0 - cur.cc[s]) * (1.f / SCALE) : 0.f;
    }
    __syncthreads();
    const int qrow = wid * QBLK + r32;
    const f32x4 qp = *(const GAS f32x4*)(cur.qss + (size_t)qrow * LDSS);
    const float rq = rsqrtf(((qp[0] + qp[1]) + (qp[2] + qp[3])) * (1.f / 128.f) + EPS);
#pragma unroll
    for (int d0 = 0; d0 < 8; ++d0) {
        const u32x4 w = *(const GAS u32x4*)(cur.Q + (size_t)qrow * LDQ + d0 * 16 + hi * 8);
        const f32x4 g0 = *(const GAS f32x4*)(cur.gg + d0 * 16 + hi * 8), g1 = *(const GAS f32x4*)(cur.gg + d0 * 16 + hi * 8 + 4);
        u32x4 o; o.x = cvtpk(bf_lo(w.x) * rq * g0[0], bf_hi(w.x) * rq * g0[1]); o.y = cvtpk(bf_lo(w.y) * rq * g0[2], bf_hi(w.y) * rq * g0[3]);
        o.z = cvtpk(bf_lo(w.z) * rq * g1[0], bf_hi(w.z) * rq * g1[1]); o.w = cvtpk(bf_lo(w.w) * rq * g1[2], bf_hi(w.w) * rq * g1[3]);
        S.qr[d0] = *reinterpret_cast<bf16x8*>(&o);
    }
    SLOAD_H(cur.K, cur.V, jlo * KVBLK); VMW(); SWRITE_HK(0, jlo * KVBLK);
    __syncthreads();
}
__device__ __forceinline__ void attn_block(const BlockRef& cur, char* lds, Seam& S, const int tid) {
    const int wid = __builtin_amdgcn_readfirstlane(tid >> 6), lane = tid & 63, r32 = lane & 31, hi = lane >> 5;
    const int W = WBIG;
    int j_hi = (cur.P0 + QB - 1) / KVBLK + 1; if (j_hi > cur.skv / KVBLK) j_hi = cur.skv / KVBLK;
    const int j_lo = S.jlo; const int NT = j_hi - j_lo;
    const int qlo = cur.P0 - j_lo * KVBLK + wid * QBLK, qm = qlo + r32 - 4 * hi;
    char* V_lds = lds; char* K_lds = lds + 2 * SHM_V;
    float* ws = (float*)(lds + OFF_WS) + wid * 64; float* li_l = ws, * al_l = ws + 32;
    const float* bs_l = (const float*)(lds + OFF_BS) + j_lo * KVBLK + 4 * hi;
    float m_reg = -1e30f, l_reg = 0; f32x16 o[4] = {};
    const int sr = tid >> 4, sc = (tid & 15) * 8, vst0 = v_st(sr, sc), vst1 = v_st(32 + sr, sc), kws = KSWZ(sr, sc * 2);
    const float* ksr = (const float*)(lds + OFF_KS) + j_lo * KVBLK + sr;
    const int vb0 = (int)(uintptr_t)V_lds + v_rd_base(lane);
    const GAS bf16_t* Kh = cur.K + (size_t)j_lo * KVBLK * LDK; const GAS bf16_t* Vh = cur.V + (size_t)j_lo * KVBLK * LDK;
#define RESC(a) do { if (__any((a) < 1.f)) { if (hi == 0) al_l[r32] = (a); asm volatile("s_waitcnt lgkmcnt(0)" ::: "memory");              \
                     for (int d_ = 0; d_ < 4; ++d_) for (int r = 0; r < 16; ++r) o[d_][r] *= al_l[crow(r, hi)]; } } while (0)
#define KBASE(t) ((t) * KVBLK)
#define MASKT(P0_, P1_, t) do { const int kb_ = KBASE(t); if (kb_ + KVBLK - 1 > qlo) mask_tile(P0_, P1_, qm - kb_, (unsigned)W); } while (0)
    f32x16 pA0, pA1, pB0, pB1; float mnA, mnB, alA, alB; bf16x8 pa0, pa1, pa2, pa3;
    SWRITE_HV(0); SBAR();
    if (NT > 1) { SLOAD_H(Kh, Vh, KBASE(1)); }
    SBAR(); qkt<0>(pA0, pA1, K_lds, r32, hi, S.qr, bs_l + KBASE(0));
    MASKT(pA0, pA1, 0); partialSM(pA0, pA1, m_reg, mnA, alA);
    if (NT > 1) { VMW(); SWRITE_H(1, KBASE(1)); }
    __syncthreads();
#define HALF_STEP(PX0, PX1, mnX, alX, PY0, PY1, alY, t, KB, VB, SB) do {                                                      \
        SBAR(); qkt<KB>(PX0, PX1, K_lds, r32, hi, S.qr, bs_l + KBASE(t));                                                         \
        finishSM(PY0, PY1, alY, l_reg, pa0, pa1, pa2, pa3); SBAR();                                                           \
        if ((t) + 1 < NT) { SLOAD_H(Kh, Vh, KBASE((t) + 1)); SBAR(); }                                               \
        pv_tile<VB>(o, vb0, pa0, pa1, pa2, pa3); MASKT(PX0, PX1, (t)); partialSM(PX0, PX1, m_reg, mnX, alX);                                        \
        __syncthreads();                                                                                                      \
        if ((t) + 1 < NT) { VMW(); SWRITE_H(SB, KBASE((t) + 1)); }                                                                          \
        RESC(alX); __syncthreads(); } while (0)
    for (int t = 1; t + 1 < NT; t += 2) {
        HALF_STEP(pB0, pB1, mnB, alB, pA0, pA1, alA, t, 1, 0, 0);
        HALF_STEP(pA0, pA1, mnA, alA, pB0, pB1, alB, t + 1, 0, 1, 1);
    }
    const bool even = (NT & 1) == 0;
    if (even) { SBAR(); qkt<1>(pB0, pB1, K_lds, r32, hi, S.qr, bs_l + KBASE(NT - 1)); SBAR(); }
    finishSM(pA0, pA1, alA, l_reg, pa0, pa1, pa2, pa3); SBAR();
    pv_tile<0>(o, vb0, pa0, pa1, pa2, pa3);
    if (even) { MASKT(pB0, pB1, NT - 1); partialSM(pB0, pB1, m_reg, mnB, alB); __syncthreads(); RESC(alB);
        finishSM(pB0, pB1, alB, l_reg, pa0, pa1, pa2, pa3); SBAR(); pv_tile<1>(o, vb0, pa0, pa1, pa2, pa3); }
    SBAR();
    if (hi == 0) li_l[r32] = l_reg; asm volatile("s_waitcnt lgkmcnt(0)" ::: "memory");
    float rli[16];
#pragma unroll
    for (int r = 0; r < 16; ++r) rli[r] = __builtin_amdgcn_rcpf(li_l[crow(r, hi)]);
    GAS bf16_t* Ow = cur.O + (size_t)(wid * QBLK) * LDO;
#pragma unroll
    for (int r = 0; r < 16; ++r) { const int orow = crow(r, hi);
#pragma unroll
        for (int d0 = 0; d0 < 4; ++d0) { const float v = o[d0][r] * rli[r];
            const float vn = dppf<0xB1>(v);
            if ((r32 & 1) == 0) *(GAS unsigned*)(Ow + (size_t)orow * LDO + d0 * 32 + r32) = cvtpk(v, vn); } }
    __syncthreads();
#undef RESC
#undef KBASE
#undef MASKT
#undef HALF_STEP
}
constexpr int MOFF_K = 4 * SHM_V, MOFF_WS = MOFF_K + 4 * SHM_K, MOFF_KS = MOFF_WS + 2048;
__device__ __forceinline__ void mem_attn_unit(const BlockRef& cur, char* lds, const int tid) {
    const int wid = __builtin_amdgcn_readfirstlane(tid >> 6), lane = tid & 63, r32 = lane & 31, hi = lane >> 5;
    const int sr = tid >> 4, sc = (tid & 15) * 8, kws = KSWZ(sr, sc * 2), vst0 = v_st(sr, sc), vst1 = v_st(32 + sr, sc);
    char* V_lds = lds; char* K_lds = lds + MOFF_K; float* ks_l = (float*)(lds + MOFF_KS);
    float* ws = (float*)(lds + MOFF_WS) + wid * 64; float* li_l = ws, * al_l = ws + 32;
    float ksv = 0.f;
    if (tid < 256) { const f32x4 p = *(const GAS f32x4*)(cur.kss + (size_t)tid * LDSS); ksv = rsqrtf(((p[0] + p[1]) + (p[2] + p[3])) * (1.f / 128.f) + EPS); }
    bf16x8 kk[4][2], vv[4][2];
#pragma unroll
    for (int t = 0; t < 4; ++t) { kk[t][0] = load8(ROWK(cur.K, t * KVBLK, sr)); kk[t][1] = load8(ROWK(cur.K, t * KVBLK, 32 + sr)); vv[t][0] = load8(ROWK(cur.V, t * KVBLK, sr)); vv[t][1] = load8(ROWK(cur.V, t * KVBLK, 32 + sr)); }
    const int qrow = wid * QBLK + r32;
    const f32x4 qp = *(const GAS f32x4*)(cur.qss + (size_t)qrow * LDSS);
    u32x4 qw[8];
#pragma unroll
    for (int d0 = 0; d0 < 8; ++d0) qw[d0] = *(const GAS u32x4*)(cur.Q + (size_t)qrow * LDQ + d0 * 16 + hi * 8);
    if (tid < 256) ks_l[tid] = ksv;
    __syncthreads();
#pragma unroll
    for (int t = 0; t < 4; ++t) { *(bf16x8*)(K_lds + t * SHM_K + kws) = scale8(kk[t][0], ks_l[t * KVBLK + sr]); *(bf16x8*)(K_lds + t * SHM_K + kws + 32 * 256) = scale8(kk[t][1], ks_l[t * KVBLK + 32 + sr]);
        *(bf16x8*)(V_lds + t * SHM_V + vst0) = vv[t][0]; *(bf16x8*)(V_lds + t * SHM_V + vst1) = vv[t][1]; }
    const float rq = rsqrtf(((qp[0] + qp[1]) + (qp[2] + qp[3])) * (1.f / 128.f) + EPS);
    bf16x8 qr[8];
#pragma unroll
    for (int d0 = 0; d0 < 8; ++d0) { const u32x4 w = qw[d0];
        const f32x4 g0 = *(const GAS f32x4*)(cur.gg + d0 * 16 + hi * 8), g1 = *(const GAS f32x4*)(cur.gg + d0 * 16 + hi * 8 + 4);
        u32x4 o; o.x = cvtpk(bf_lo(w.x) * rq * g0[0], bf_hi(w.x) * rq * g0[1]); o.y = cvtpk(bf_lo(w.y) * rq * g0[2], bf_hi(w.y) * rq * g0[3]);
        o.z = cvtpk(bf_lo(w.z) * rq * g1[0], bf_hi(w.z) * rq * g1[1]); o.w = cvtpk(bf_lo(w.w) * rq * g1[2], bf_hi(w.w) * rq * g1[3]);
        qr[d0] = *reinterpret_cast<bf16x8*>(&o); }
    __syncthreads();
    const int vb0 = (int)(uintptr_t)V_lds + v_rd_base(lane);
    float m_reg = -1e30f, l_reg = 0; f32x16 o[4] = {};
#define MEM_TILE(t) do { f32x16 p0, p1; float mn, al; bf16x8 pa0, pa1, pa2, pa3; \
        qkt0<t>(p0, p1, K_lds, r32, hi, qr); partialSM(p0, p1, m_reg, mn, al); \
        if (__any(al < 1.f)) { if (hi == 0) al_l[r32] = al; asm volatile("s_waitcnt lgkmcnt(0)" ::: "memory"); for (int d_ = 0; d_ < 4; ++d_) for (int r = 0; r < 16; ++r) o[d_][r] *= al_l[crow(r, hi)]; } \
        finishSM(p0, p1, al, l_reg, pa0, pa1, pa2, pa3); SBAR(); pv_tile<t>(o, vb0, pa0, pa1, pa2, pa3); SBAR(); } while (0)
    MEM_TILE(0); MEM_TILE(1); MEM_TILE(2); MEM_TILE(3);
#undef MEM_TILE
    if (hi == 0) li_l[r32] = l_reg; asm volatile("s_waitcnt lgkmcnt(0)" ::: "memory");
    float rli[16];
#pragma unroll
    for (int r = 0; r < 16; ++r) rli[r] = __builtin_amdgcn_rcpf(li_l[crow(r, hi)]);
    GAS bf16_t* Ow = cur.O + (size_t)(wid * QBLK) * LDO;
#pragma unroll
    for (int r = 0; r < 16; ++r) { const int orow = crow(r, hi);
#pragma unroll
        for (int d0 = 0; d0 < 4; ++d0) { const float v = o[d0][r] * rli[r];
            const float vn = dppf<0xB1>(v);
            if ((r32 & 1) == 0) *(GAS unsigned*)(Ow + (size_t)orow * LDO + d0 * 32 + r32) = cvtpk(v, vn); } }
    __syncthreads();
}
#undef ROWK
#undef VMW
#undef VMWN
#undef SLOAD_H
#undef SWRITE_HK
#undef SWRITE_HV
#undef SWRITE_H
#undef KSWZ
#undef SBAR
}


struct Frame {
    GAS unsigned char* ws; const float* const* in_; GAS float* out;
    __device__ __forceinline__ const GAS float* in(int i) const { return (const GAS float*)in_[i]; }
    int tid, lane, wave, gw, ngw, gtid, ngt;
};
enum { I_X = 0, I_MEM, I_ANORM, I_AWIN, I_ACONVW, I_ACONVB, I_AGATEW, I_AGATEB, I_ALAMBDA, I_AWOUT, I_SNORM, I_SWKVF, I_SBF, I_SKNORM, I_BNORM, I_BWIN, I_BQNORM, I_BWOUT,
       I_MNORM, I_MWKV, I_MQNORM, I_MKNORM, I_PNORM, I_PWQ, I_PSUBK, I_PU, I_PV, N_IN };

struct TrItem { const GAS float* W; const GAS float* gain; GAS bf16_t* WT; int ldw, ldt, row_off, k0, n0; };
__device__ __forceinline__ void tr_load(const TrItem& d, float (&wv)[32], int lane) {
#pragma unroll
    for (int i = 0; i < 32; ++i) wv[i] = __builtin_nontemporal_load(d.W + (size_t)(d.k0 + 2 * i + (lane >> 5)) * d.ldw + d.n0 + (lane & 31));
}
__device__ __forceinline__ void tr_proc(const TrItem& d, float (&wv)[32], LAS float* scr, int lane) {
    if (d.gain) {
#pragma unroll
        for (int i = 0; i < 32; ++i) wv[i] *= d.gain[d.k0 + 2 * i + (lane >> 5)]; }
#pragma unroll
    for (int i = 0; i < 32; ++i) scr[(2 * i + (lane >> 5)) * 33 + (lane & 31)] = wv[i];
    asm volatile("s_waitcnt lgkmcnt(0)" ::: "memory");
    const int c = lane & 7;
#pragma unroll
    for (int j = 0; j < 4; ++j) { const int n = (lane >> 3) + 8 * j; const LAS float* s = scr + (8 * c) * 33 + n;
        u32x4 o; o.x = cvtpk(s[0 * 33], s[1 * 33]); o.y = cvtpk(s[2 * 33], s[3 * 33]); o.z = cvtpk(s[4 * 33], s[5 * 33]); o.w = cvtpk(s[6 * 33], s[7 * 33]);
        *(GAS u32x4*)(d.WT + (size_t)(d.row_off + d.n0 + n) * d.ldt + d.k0 + 8 * c) = o; }
    asm volatile("s_waitcnt lgkmcnt(0)" ::: "memory");
}
__device__ __forceinline__ void transpose_item_fp8(const GAS float* W, int ldw, const GAS float* gain, GAS unsigned char* WT, int ldt, LAS float* scr, int nblk, int item, int lane) {
    const int kb = item / nblk, nb = item % nblk, k0 = 64 * kb, n0 = 32 * nb;
    float wv[32];
#pragma unroll
    for (int i = 0; i < 32; ++i) wv[i] = W[(size_t)(k0 + 2 * i + (lane >> 5)) * ldw + n0 + (lane & 31)];
#pragma unroll
    for (int i = 0; i < 32; ++i) wv[i] *= gain[k0 + 2 * i + (lane >> 5)] * 64.f;
#pragma unroll
    for (int i = 0; i < 32; ++i) scr[(2 * i + (lane >> 5)) * 33 + (lane & 31)] = wv[i];
    asm volatile("s_waitcnt lgkmcnt(0)" ::: "memory");
    const int c = lane & 3;
#pragma unroll
    for (int j = 0; j < 2; ++j) { const int n = (lane >> 2) + 16 * j; const LAS float* sp = scr + (16 * c) * 33 + n; u32x4 o;
#pragma unroll
        for (int w = 0; w < 4; ++w) { int pk = __builtin_amdgcn_cvt_pk_fp8_f32(sp[(4 * w) * 33], sp[(4 * w + 1) * 33], 0, false); pk = __builtin_amdgcn_cvt_pk_fp8_f32(sp[(4 * w + 2) * 33], sp[(4 * w + 3) * 33], pk, true); o[w] = (unsigned)pk; }
        *(GAS u32x4*)(WT + (size_t)(n0 + n) * ldt + k0 + 16 * c) = o; }
    asm volatile("s_waitcnt lgkmcnt(0)" ::: "memory");
}
struct CtRow { f32x4 v[8]; GAS unsigned char* dst; int row, which; };
__device__ __forceinline__ void ct_load(Frame& F, int layer, int it, CtRow& R) {
    R.which = it & 1; R.row = it >> 1;
    const GAS float* src = F.in(R.which ? I_PV : I_PU) + ((size_t)layer * NEXP + R.row) * DM + F.lane * 4;
    R.dst = F.ws + O_TAB + (size_t)(layer * 2 + R.which) * TAB_ONE;
#pragma unroll
    for (int c = 0; c < 8; ++c) R.v[c] = __builtin_nontemporal_load((const GAS f32x4*)(src + c * 256));
}
__device__ __forceinline__ void ct_proc(Frame& F, int layer, CtRow& R, const f32x4 (&gnr)[8]) {
    _Float16 shv = (_Float16)0.f;
#pragma unroll
    for (int c = 0; c < 8; ++c) { f32x4 x = R.v[c]; if (!R.which) x = x * gnr[c];
        float amax = fmaxf(fmaxf(fabsf(x[0]), fabsf(x[1])), fmaxf(fabsf(x[2]), fabsf(x[3])));
        amax = wave_max(amax);
        const _Float16 sh = (_Float16)fmaxf(amax * (1.f / 6.f), 1e-6f);
        const float qs = __builtin_amdgcn_rcpf((float)sh);
        unsigned pk = __builtin_amdgcn_cvt_scalef32_pk_fp4_f32(0u, x[0] * qs, x[1] * qs, 1.0f, 0); pk = __builtin_amdgcn_cvt_scalef32_pk_fp4_f32(pk, x[2] * qs, x[3] * qs, 1.0f, 1);
        *(GAS unsigned short*)(R.dst + ((size_t)c * NEXP + R.row) * 128 + F.lane * 2) = (unsigned short)pk;
        shv = (F.lane == c) ? sh : shv; }
    if (F.lane < 8) *(GAS unsigned short*)(R.dst + TAB_NIB + ((size_t)R.row * 8 + F.lane) * 2) = __builtin_bit_cast(unsigned short, shv);
}
__device__ __forceinline__ void convert_tables(Frame& F, int layer, int ibeg, int iend, int wk, int nwk) {
    if (ibeg + wk >= iend) return;
    const int ilast = ibeg + wk + ((iend - 1 - ibeg - wk) / nwk) * nwk;
    CtRow A, B;
    f32x4 gnr[8];
#pragma unroll
    for (int c = 0; c < 8; ++c) gnr[c] = *(const GAS f32x4*)(F.in(I_PNORM) + layer * DM + F.lane * 4 + c * 256);
    ct_load(F, layer, ibeg + wk, A);
    for (int it = ibeg + wk; it < iend; it += 2 * nwk) {
        ct_load(F, layer, it + nwk <= ilast ? it + nwk : ilast, B);
        ct_proc(F, layer, A, gnr);
        ct_load(F, layer, it + 2 * nwk <= ilast ? it + 2 * nwk : ilast, A);
        if (it + nwk < iend) ct_proc(F, layer, B, gnr);
    }
}
__device__ __forceinline__ void norm_row_bf16(const GAS float* xrow, const GAS float* gain, GAS bf16_t* orow, int lane) {
    f32x4 v[8]; float s = 0.f;
#pragma unroll
    for (int j = 0; j < 8; ++j) { v[j] = *(const GAS f32x4*)(xrow + j * 256 + lane * 4); s += (v[j][0] * v[j][0] + v[j][1] * v[j][1]) + (v[j][2] * v[j][2] + v[j][3] * v[j][3]); }
    const float r = rsqrtf(wave_sum(s) * (1.f / DM) + EPS);
#pragma unroll
    for (int j = 0; j < 8; ++j) { f32x4 g = gain ? *(const GAS f32x4*)(gain + j * 256 + lane * 4) : (f32x4){1.f, 1.f, 1.f, 1.f};
        u32x2 o; o.x = cvtpk(v[j][0] * r * g[0], v[j][1] * r * g[1]); o.y = cvtpk(v[j][2] * r * g[2], v[j][3] * r * g[3]);
        *(GAS u32x2*)(orow + j * 256 + lane * 4) = o; }
}
__device__ __forceinline__ void step_prologue(Frame& F, LAS unsigned char* lds) {
    LAS float* scr = (LAS float*)(lds + F.wave * 16384);
    GAS unsigned char* ws = F.ws;
    constexpr int I0 = 32 * (NIN0 / 32), I1 = 32 * 64, I2 = 32 * 96, I3 = 32 * 64, I4 = 32 * 64, I5 = 32 * 64, I6 = 32 * 64, I7 = 32 * 32, I8 = 32 * 32, I9 = 12 * 16;
    constexpr int NITEMS = I0 + I1 + I2 + I3 + I4 + I5 + I6 + I7 + I8 + I9;
#define TR_DESC(D, it_) do { int r = (it_) < NITEMS ? (it_) : NITEMS - 1; int nblk; \
        if (r < I0) { D = {F.in(I_AWIN), F.in(I_ANORM), (GAS bf16_t*)(ws + O_WIN0), NIN0, DM, 0, 0, 0}; nblk = NIN0 / 32; } else { r -= I0; \
        if (r < I1) { D = {F.in(I_AWOUT), nullptr, (GAS bf16_t*)(ws + O_WOUT0), DM, DM, 0, 0, 0}; nblk = 64; } else { r -= I1; \
        if (r < I2) { D = {F.in(I_SWKVF), F.in(I_SNORM), (GAS bf16_t*)(ws + O_WL1), 3084, DM, 0, 0, 0}; nblk = 96; } else { r -= I2; \
        if (r < I3) { D = {F.in(I_BWIN), F.in(I_BNORM), (GAS bf16_t*)(ws + O_WL1), DM, DM, 3072, 0, 0}; nblk = 64; } else { r -= I3; \
        if (r < I4) { D = {F.in(I_BWOUT), nullptr, (GAS bf16_t*)(ws + O_WOUT1), DM, DM, 0, 0, 0}; nblk = 64; } else { r -= I4; \
        if (r < I5) { D = {F.in(I_PWQ), F.in(I_PNORM), (GAS bf16_t*)(ws + O_WQ0), DM, DM, 0, 0, 0}; nblk = 64; } else { r -= I5; \
        if (r < I6) { D = {F.in(I_PWQ) + (size_t)DM * DM, F.in(I_PNORM) + DM, (GAS bf16_t*)(ws + O_WQ1), DM, DM, 0, 0, 0}; nblk = 64; } else { r -= I6; \
        if (r < I7) { D = {F.in(I_MWKV), nullptr, (GAS bf16_t*)(ws + O_WMKV), 1024, DM, 0, 0, 0}; nblk = 32; } else { r -= I7; \
        if (r < I8) { D = {F.in(I_MWKV) + (size_t)DM * 1024, nullptr, (GAS bf16_t*)(ws + O_WMKV) + (size_t)1024 * DM, 1024, DM, 0, 0, 0}; nblk = 32; } else { r -= I8; \
          const int blk = r / 16; r = r % 16; D = {F.in(I_AGATEW) + (size_t)blk * 128 * 256, nullptr, (GAS bf16_t*)(ws + O_WGATE), 256, 128, blk * 256, 0, 0}; nblk = 8; } } } } } } } } } \
        D.k0 = 64 * (r / nblk); D.n0 = 32 * (r % nblk); } while (0)
    for (int it = F.gw; it < NITEMS; it += F.ngw) { float wv[32]; TrItem d; TR_DESC(d, it); tr_load(d, wv, F.lane); tr_proc(d, wv, scr, F.lane); }
#undef TR_DESC
    { const GAS float* sk = F.in(I_PSUBK); GAS bf16_t* o = (GAS bf16_t*)(ws + O_SUBK);
      for (int i = F.gtid; i < 2 * 16 * 128 * 128 / 2; i += F.ngt) *(GAS unsigned*)(o + 2 * i) = cvtpk(sk[2 * i], sk[2 * i + 1]); }
    { GAS float* wf = (GAS float*)(ws + O_WF); const GAS float* w = F.in(I_SWKVF); const GAS float* g = F.in(I_SNORM);
      for (int i = F.gtid; i < 12 * DM; i += F.ngt) { const int j = i / DM, k = i % DM; wf[i] = w[(size_t)k * 3084 + 3072 + j] * g[k]; } }
    { GAS float* spl = (GAS float*)(ws + O_SPL); const GAS float* lam = F.in(I_ALAMBDA);
      for (int i = F.gtid; i < LRU; i += F.ngt) { const float z = -lam[i]; spl[i] = fmaxf(z, 0.f) + log1p_pos(fast_exp(-fabsf(z))); } }
    if (F.gw == 0) {
        float m = 0.f; for (int d = F.lane; d < 128; d += 64) m = fmaxf(m, fabsf(F.in(I_BQNORM)[d] * F.in(I_SKNORM)[d]));
        m = wave_max(m);
        if (F.lane == 0) ((GAS float*)(ws + O_GG))[512] = 2.f * 11.3137085f * m + 30.f; }
    { GAS float* gg = (GAS float*)(ws + O_GG);
      for (int i = F.gtid; i < 384; i += F.ngt) { const int a = i / 128, d = i % 128;
          gg[a == 0 ? 384 + d : i] = a == 0 ? F.in(I_BQNORM)[d] * F.in(I_SKNORM)[d] : F.in(I_MQNORM)[(a - 1) * 128 + d] * F.in(I_MKNORM)[(a - 1) * 128 + d]; } }
    {
        const GAS float* xin = F.in(I_X) + F.lane * 4; GAS bf16_t* xo = (GAS bf16_t*)(ws + O_XS16) + F.lane * 4;
        const int mlast = F.gw + ((T - 1 - F.gw) / F.ngw) * F.ngw;
#define XN_LOAD(V, m_) do { const int mm_ = (m_) <= mlast ? (m_) : mlast; _Pragma("unroll") for (int j = 0; j < 8; ++j) V[j] = __builtin_nontemporal_load((const GAS f32x4*)(xin + (size_t)mm_ * DM + j * 256)); } while (0)
#define XN_PROC(V, m_) do { if ((m_) < T) { float s0 = 0.f; _Pragma("unroll") for (int j = 0; j < 8; ++j) s0 += (V[j][0] * V[j][0] + V[j][1] * V[j][1]) + (V[j][2] * V[j][2] + V[j][3] * V[j][3]); \
            const float r0 = rsqrtf(wave_sum(s0) * (1.f / DM) + EPS); \
            _Pragma("unroll") for (int j = 0; j < 8; ++j) { u32x2 a; a.x = cvtpk(V[j][0] * r0, V[j][1] * r0); a.y = cvtpk(V[j][2] * r0, V[j][3] * r0); *(GAS u32x2*)(xo + (size_t)(m_) * DM + j * 256) = a; } } } while (0)
        f32x4 va[8], vb[8];
        XN_LOAD(va, F.gw);
        for (int m = F.gw; m < T; m += 2 * F.ngw) { XN_LOAD(vb, m + F.ngw); XN_PROC(va, m); XN_LOAD(va, m + 2 * F.ngw); XN_PROC(vb, m + F.ngw); }
#undef XN_LOAD
#undef XN_PROC
    }
    for (int m = F.gw; m < 2 * NMROW; m += F.ngw) { const int l = m / NMROW, r = m % NMROW;
        norm_row_bf16(F.in(I_MEM) + (size_t)r * DM, F.in(I_MNORM) + l * DM, (GAS bf16_t*)(ws + O_MEMN) + (size_t)m * DM, F.lane); }
    convert_tables(F, 0, 0, 2 * NEXP, F.gw, F.ngw);
}
__device__ __forceinline__ void step_conv(Frame& F) {
    const GAS bf16_t* zx = (const GAS bf16_t*)(F.ws + O_ZX); GAS bf16_t* xc = (GAS bf16_t*)(F.ws + O_XC);
    const GAS float* cw = F.in(I_ACONVW); const GAS float* cb = F.in(I_ACONVB);
    constexpr int RUN = 16, NCG = LRU / 256, NU = (T / RUN) * NCG;
    unsigned lo = (unsigned)F.lane; asm volatile("" : "+v"(lo));
    struct CvU { f32x4 w[4], b; u32x2 r[RUN + 3]; };
#define CV_LOADU(U, u_) do { const int uu_ = (u_) < NU ? (u_) : NU - 1; const int cg_ = uu_ % NCG, t0_ = (uu_ / NCG) * RUN; const unsigned ch_ = cg_ * 256 + lo * 4; \
        _Pragma("unroll") for (int k = 0; k < 4; ++k) U.w[k] = *(const GAS f32x4*)(cw + k * LRU + ch_); U.b = *(const GAS f32x4*)(cb + ch_); \
        const bool first_ = (t0_ & (SEQ - 1)) == 0; \
        _Pragma("unroll") for (int i = 0; i < RUN + 3; ++i) U.r[i] = (i < 3 && first_) ? (u32x2){0u, 0u} : *(const GAS u32x2*)(zx + (size_t)(t0_ - 3 + i) * LRU + ch_); } while (0)
#define CV_PROCU(U, u_) do { if ((u_) < NU) { const int cg_ = (u_) % NCG, t0_ = ((u_) / NCG) * RUN; const unsigned ch_ = cg_ * 256 + lo * 4; \
        _Pragma("unroll") for (int i = 0; i < RUN; ++i) { f32x4 a = U.b; \
            _Pragma("unroll") for (int k = 0; k < 4; ++k) { const u32x2 q = U.r[i + k]; \
                a[0] = fmaf(U.w[k][0], bf_lo(q.x), a[0]); a[1] = fmaf(U.w[k][1], bf_hi(q.x), a[1]); a[2] = fmaf(U.w[k][2], bf_lo(q.y), a[2]); a[3] = fmaf(U.w[k][3], bf_hi(q.y), a[3]); } \
            u32x2 o; o.x = cvtpk(a[0], a[1]); o.y = cvtpk(a[2], a[3]); *(GAS u32x2*)(xc + (size_t)(t0_ + i) * LRU + ch_) = o; } } } while (0)
    CvU A, B;
    CV_LOADU(A, F.gw);
    for (int u = F.gw; u < NU; u += 2 * F.ngw) { CV_LOADU(B, u + F.ngw); CV_PROCU(A, u); CV_LOADU(A, u + 2 * F.ngw); CV_PROCU(B, u + F.ngw); }
#undef CV_LOADU
#undef CV_PROCU
}
constexpr int SCK = 32, NCK = SEQ / SCK;
typedef _Float16 h8_t __attribute__((ext_vector_type(8)));
__device__ __forceinline__ void scan_load(const GAS _Float16* LA, const GAS _Float16* UH, size_t off, float (&a)[8], float (&u)[8]) {
    const h8_t l = *(const GAS h8_t*)(LA + off), w = *(const GAS h8_t*)(UH + off);
#pragma unroll
    for (int k = 0; k < 8; ++k) { a[k] = fast_exp((float)l[k]); u[k] = (float)w[k]; }
}
__device__ __forceinline__ void step_scan1(Frame& F) {
    const GAS _Float16* LA = (const GAS _Float16*)(F.ws + O_AA); const GAS _Float16* UH = (const GAS _Float16*)(F.ws + O_UU);
    GAS float* CA = (GAS float*)(F.ws + O_LOGFP); GAS float* CH = CA + (size_t)NB * NCK * LRU;
    if (F.tid >= 384) return;
    const int grp = F.tid / 192, th = F.tid % 192;
    for (int it = blockIdx.x * 2 + grp; it < NB * NCK; it += gridDim.x * 2) {
        const int b = it / NCK, ck = it % NCK; const size_t base = ((size_t)b * SEQ + ck * SCK) * LRU + th * 8;
        float ap[8], h[8];
#pragma unroll
        for (int k = 0; k < 8; ++k) { ap[k] = 1.f; h[k] = 0.f; }
#pragma unroll 8
        for (int i = 0; i < SCK; ++i) { float a[8], u[8]; scan_load(LA, UH, base + (size_t)i * LRU, a, u);
#pragma unroll
            for (int k = 0; k < 8; ++k) { ap[k] *= a[k]; h[k] = a[k] * h[k] + u[k]; } }
        GAS float* ca = CA + (size_t)it * LRU + th * 8; GAS float* ch = CH + (size_t)it * LRU + th * 8;
        *(GAS f32x4*)ca = (f32x4){ap[0], ap[1], ap[2], ap[3]}; *(GAS f32x4*)(ca + 4) = (f32x4){ap[4], ap[5], ap[6], ap[7]};
        *(GAS f32x4*)ch = (f32x4){h[0], h[1], h[2], h[3]}; *(GAS f32x4*)(ch + 4) = (f32x4){h[4], h[5], h[6], h[7]};
    }
}
__device__ __forceinline__ void step_scan2(Frame& F) {
    const GAS _Float16* LA = (const GAS _Float16*)(F.ws + O_AA); const GAS _Float16* UH = (const GAS _Float16*)(F.ws + O_UU);
    const GAS float* CA = (const GAS float*)(F.ws + O_LOGFP); const GAS float* CH = CA + (size_t)NB * NCK * LRU;
    const GAS bf16_t* gy = (const GAS bf16_t*)(F.ws + O_GY); GAS bf16_t* cat = (GAS bf16_t*)(F.ws + O_CAT);
    if (F.tid >= 384) return;
    const int grp = F.tid / 192, th = F.tid % 192;
    for (int it = blockIdx.x * 2 + grp; it < NB * NCK; it += gridDim.x * 2) {
        const int b = it / NCK, ck = it % NCK; const size_t base = ((size_t)b * SEQ + ck * SCK) * LRU + th * 8;
        float h[8];
#pragma unroll
        for (int k = 0; k < 8; ++k) h[k] = 0.f;
        for (int k2 = 0; k2 < ck; ++k2) { const size_t o = (size_t)(b * NCK + k2) * LRU + th * 8;
            const f32x4 a0 = *(const GAS f32x4*)(CA + o), a1 = *(const GAS f32x4*)(CA + o + 4), c0 = *(const GAS f32x4*)(CH + o), c1 = *(const GAS f32x4*)(CH + o + 4);
#pragma unroll
            for (int k = 0; k < 4; ++k) { h[k] = a0[k] * h[k] + c0[k]; h[4 + k] = a1[k] * h[4 + k] + c1[k]; } }
#pragma unroll 8
        for (int i = 0; i < SCK; ++i) { float a[8], u[8]; scan_load(LA, UH, base + (size_t)i * LRU, a, u);
            const size_t row = (size_t)b * SEQ + ck * SCK + i;
            const u32x4 g = *(const GAS u32x4*)(gy + row * LRU + th * 8); u32x4 o;
#pragma unroll
            for (int k = 0; k < 8; ++k) h[k] = a[k] * h[k] + u[k];
#pragma unroll
            for (int k = 0; k < 4; ++k) o[k] = cvtpk(h[2 * k] * bf_lo(g[k]), h[2 * k + 1] * bf_hi(g[k]));
            *(GAS u32x4*)(cat + row * DM + th * 8) = o; }
    }
}
__device__ __forceinline__ void step_cprefix(Frame& F, LAS unsigned char* lds) {
    if (blockIdx.x >= NB * NH) return;
    const GAS float* p = (const GAS float*)(F.ws + O_LOGF) + (size_t)blockIdx.x * SEQ + F.tid * 8; GAS float* q = (GAS float*)(F.ws + O_CC) + (size_t)blockIdx.x * SEQ + F.tid * 8;
    LAS double* scr = (LAS double*)lds;
    const f32x4 a = *(const GAS f32x4*)p, b = *(const GAS f32x4*)(p + 4);
    double v[8];
    v[0] = (double)a[0]; v[1] = v[0] + (double)a[1]; v[2] = v[1] + (double)a[2]; v[3] = v[2] + (double)a[3];
    v[4] = v[3] + (double)b[0]; v[5] = v[4] + (double)b[1]; v[6] = v[5] + (double)b[2]; v[7] = v[6] + (double)b[3];
    scr[F.tid] = v[7];
    __syncthreads();
    double run = 0.0;
    for (int l = 0; l < 64; ++l) { const double t = scr[F.wave * 64 + l]; if (l < F.lane) run += t; }
    if (F.lane == 63) scr[512 + F.wave] = run + v[7];
    __syncthreads();
    for (int w = 0; w < F.wave; ++w) run += scr[512 + w];
    f32x4 o0, o1;
    o0[0] = (float)(run + v[0]); o0[1] = (float)(run + v[1]); o0[2] = (float)(run + v[2]); o0[3] = (float)(run + v[3]);
    o1[0] = (float)(run + v[4]); o1[1] = (float)(run + v[5]); o1[2] = (float)(run + v[6]); o1[3] = (float)(run + v[7]);
    *(GAS f32x4*)q = o0; *(GAS f32x4*)(q + 4) = o1;
    __syncthreads();
}

__device__ __forceinline__ int ord_i(float f) { const int b = __float_as_int(f); return b ^ ((b >> 31) & 0x7fffffff); }
__device__ __forceinline__ float unord_f(int k) { return __int_as_float(k ^ ((k >> 31) & 0x7fffffff)); }
template <int N> __device__ __forceinline__ void bitonic_sort_desc(int (&a)[N]) {
#pragma unroll
    for (int k = 2; k <= N; k <<= 1) {
#pragma unroll
        for (int j = k >> 1; j > 0; j >>= 1) {
#pragma unroll
            for (int i = 0; i < N; ++i) { const int l = i ^ j;
                if (l > i) { const bool desc = ((i & k) == 0); const int mx = max(a[i], a[l]), mn = min(a[i], a[l]); a[i] = desc ? mx : mn; a[l] = desc ? mn : mx; } }
        }
    }
}
__device__ __forceinline__ void bitonic_merge16_desc(int (&a)[16]) {
#pragma unroll
    for (int j = 8; j > 0; j >>= 1) {
#pragma unroll
        for (int i = 0; i < 16; ++i) { const int l = i ^ j; if (l > i) { const int mx = max(a[i], a[l]), mn = min(a[i], a[l]); a[i] = mx; a[l] = mn; } }
    }
}
__device__ __forceinline__ void top16_of_64(int (&a)[64]) {
    int g[4][16];
#pragma unroll
    for (int q = 0; q < 4; ++q) {
#pragma unroll
        for (int i = 0; i < 16; ++i) g[q][i] = a[16 * q + i];
        bitonic_sort_desc<16>(g[q]); }
#pragma unroll
    for (int i = 0; i < 16; ++i) { g[0][i] = max(g[0][i], g[1][15 - i]); g[2][i] = max(g[2][i], g[3][15 - i]); }
    bitonic_merge16_desc(g[0]); bitonic_merge16_desc(g[2]);
#pragma unroll
    for (int i = 0; i < 16; ++i) g[0][i] = max(g[0][i], g[2][15 - i]);
    bitonic_merge16_desc(g[0]);
#pragma unroll
    for (int i = 0; i < 16; ++i) a[i] = g[0][i];
}
constexpr float KOFF = 64.f;
__device__ __forceinline__ void top16_of_32(int (&a)[32]) {
    int g0[16], g1[16];
#pragma unroll
    for (int i = 0; i < 16; ++i) { g0[i] = a[i]; g1[i] = a[16 + i]; }
    bitonic_sort_desc<16>(g0); bitonic_sort_desc<16>(g1);
#pragma unroll
    for (int i = 0; i < 16; ++i) g0[i] = max(g0[i], g1[15 - i]);
    bitonic_merge16_desc(g0);
#pragma unroll
    for (int i = 0; i < 16; ++i) a[i] = g0[i];
}
__device__ __forceinline__ void subkey_top16(const GAS bf16_t* qrow  , const GAS bf16_t* sk  , int r32, int hi, int (&top)[16]) {
    bf16x8 qf[8];
#pragma unroll
    for (int ks = 0; ks < 8; ++ks) qf[ks] = *(const GAS bf16x8*)(qrow + ks * 16 + hi * 8);
    unsigned loff = (unsigned)(r32 * 128 + hi * 8) * 2u; asm volatile("" : "+v"(loff));
    int key[64];
    bf16x8 afc[8], afn[8];
#pragma unroll
    for (int ks = 0; ks < 8; ++ks) afc[ks] = *(const GAS bf16x8*)((const GAS char*)(sk + ks * 16) + loff);
#pragma unroll
    for (int kb = 0; kb < 4; ++kb) {
        if (kb < 3) {
#pragma unroll
            for (int ks = 0; ks < 8; ++ks) afn[ks] = *(const GAS bf16x8*)((const GAS char*)(sk + (kb + 1) * 32 * 128 + ks * 16) + loff); }
        f32x16 acc;
#pragma unroll
        for (int r = 0; r < 16; ++r) acc[r] = KOFF;
#pragma unroll
        for (int ks = 0; ks < 8; ++ks) acc = __builtin_amdgcn_mfma_f32_32x32x16_bf16(afc[ks], qf[ks], acc, 0, 0, 0);
#pragma unroll
        for (int ks = 0; ks < 8; ++ks) afc[ks] = afn[ks];
#pragma unroll
        for (int r = 0; r < 16; ++r) { const int id = kb * 32 + (r & 3) + 8 * (r >> 2) + 4 * hi; key[kb * 16 + r] = (__float_as_int(acc[r]) & ~127) | (127 - id); }
        __builtin_amdgcn_sched_barrier(0);
    }
    top16_of_64(key);
#pragma unroll
    for (int i = 0; i < 16; ++i) { auto r = __builtin_amdgcn_permlane32_swap((unsigned)key[15 - i], (unsigned)key[15 - i], false, false);
        const int pk = hi ? (int)r[0] : (int)r[1]; top[i] = max(key[i], pk); }
    bitonic_merge16_desc(top);
}
__device__ __forceinline__ void step_topk(Frame& F, LAS unsigned char* lds, int layer) {
    const GAS bf16_t* q16 = (const GAS bf16_t*)(F.ws + O_Q16); const GAS bf16_t* subk = (const GAS bf16_t*)(F.ws + O_SUBK) + (size_t)layer * 16 * 128 * 128;
    GAS int* IDX = (GAS int*)(F.ws + O_IDX); GAS float* GW = (GAS float*)(F.ws + O_GW);
    LAS int* scr = (LAS int*)(lds + F.wave * 16384) + F.lane * 33;
    const int r32 = F.lane & 31, hi = F.lane >> 5;
    for (int task = F.gw; task < (T / 32) * 8; task += F.ngw) {
        const int tb = task >> 3, h = task & 7; const int tok = tb * 32 + r32;
        const GAS bf16_t* qrow = q16 + (size_t)tok * DM + h * 256;
        int ta[16], tb16[16];
        subkey_top16(qrow, subk + (size_t)(h * 2 + 0) * 128 * 128, r32, hi, ta);
        subkey_top16(qrow + 128, subk + (size_t)(h * 2 + 1) * 128 * 128, r32, hi, tb16);
        float va[16], vb[16];
#pragma unroll
        for (int i = 0; i < 16; ++i) { va[i] = __int_as_float(ta[i] & ~127); vb[i] = __int_as_float(tb16[i] & ~127) - KOFF; scr[i] = 127 - (ta[i] & 127); scr[16 + i] = 127 - (tb16[i] & 127); }
        int c2[32]; int n = 0;
#pragma unroll
        for (int i = 0; i < 16; ++i)
#pragma unroll
            for (int j = 0; j < 16; ++j) if ((i + 1) * (j + 1) <= 16) { const int k = (__float_as_int(va[i] + vb[j]) & ~255) | (255 - (i * 16 + j));
                if ((n & 1) == 0) c2[n >> 1] = k; else c2[n >> 1] = hi ? k : c2[n >> 1];
                ++n; }
#pragma unroll
        for (int i = 25; i < 32; ++i) c2[i] = (int)0x80000000;
        top16_of_32(c2);
        { int mg[16];
#pragma unroll
          for (int i = 0; i < 16; ++i) { auto r = __builtin_amdgcn_permlane32_swap((unsigned)c2[15 - i], (unsigned)c2[15 - i], false, false);
              const int pk = hi ? (int)r[0] : (int)r[1]; mg[i] = max(c2[i], pk); }
          bitonic_merge16_desc(mg);
#pragma unroll
          for (int i = 0; i < 16; ++i) c2[i] = mg[i]; }
        asm volatile("s_waitcnt lgkmcnt(0)" ::: "memory");
        float sv[16], ex[16]; int ev[16]; float Z = 0.f;
#pragma unroll
        for (int r = 0; r < 16; ++r) { const int flat = 255 - (c2[r] & 255); sv[r] = __int_as_float(c2[r] & ~255); ev[r] = scr[flat >> 4] * 128 + scr[16 + (flat & 15)]; }
#pragma unroll
        for (int r = 0; r < 16; ++r) { ex[r] = fast_exp(sv[r] - sv[0]); Z += ex[r]; }
        const float iz = 1.f / Z;
        GAS int* ip = IDX + (size_t)tok * 128 + h * 16 + hi * 8; GAS float* gp = GW + (size_t)tok * 128 + h * 16 + hi * 8;
        int eo[8]; float go[8];
#pragma unroll
        for (int j = 0; j < 8; ++j) { eo[j] = hi ? ev[8 + j] : ev[j]; go[j] = (hi ? ex[8 + j] : ex[j]) * iz; }
        *(GAS u32x4*)ip = (u32x4){(unsigned)eo[0], (unsigned)eo[1], (unsigned)eo[2], (unsigned)eo[3]}; *(GAS u32x4*)(ip + 4) = (u32x4){(unsigned)eo[4], (unsigned)eo[5], (unsigned)eo[6], (unsigned)eo[7]};
        *(GAS f32x4*)gp = (f32x4){go[0], go[1], go[2], go[3]}; *(GAS f32x4*)(gp + 4) = (f32x4){go[4], go[5], go[6], go[7]};
        asm volatile("s_waitcnt lgkmcnt(0)" ::: "memory");
    }
}
__device__ __forceinline__ h2 as_h2(unsigned w) { return __builtin_bit_cast(h2, w); }
#define F4(W, s) __builtin_amdgcn_cvt_scalef32_pk_f16_fp4((W), 1.0f, (s))
#define H2F(us) ((float)__builtin_bit_cast(_Float16, (unsigned short)(us)))
__device__ __forceinline__ float sum8(float v) { v += dppf<0xB1>(v); v += dppf<0x4E>(v); v += dppf<0x141>(v); return v; }
__device__ __forceinline__ void step_upass(Frame& F, int layer, int G, LAS unsigned char* lds) {
    typedef pg8::v8i_t v8i_t;
    const int s = blockIdx.x & 7, wk = (blockIdx.x >> 3) * NWAVES + F.wave, nwk = (G >> 3) * NWAVES;
    const GAS unsigned char* UN = F.ws + O_TAB + (size_t)(layer * 2) * TAB_ONE + (size_t)s * NEXP * 128;
    const GAS int* IDX = (const GAS int*)(F.ws + O_IDX); const GAS bf16_t* xs = (const GAS bf16_t*)(F.ws + O_XS16) + s * 256;
    GAS _Float16* part = (GAS _Float16*)(F.ws + O_PART) + (size_t)s * T * 128;
    unsigned lo = (unsigned)F.lane; asm volatile("" : "+v"(lo));
    const unsigned j = lo >> 3, p = lo & 7, c = lo & 15, kq = lo >> 4;
    LAS unsigned char* img = lds + F.wave * 16384; LAS unsigned char* xrow = lds + 131072 + F.wave * 256;
    LAS unsigned char* wrp = img + j * 128 + ((p ^ j) << 4);
    const LAS unsigned char* rd0 = img + c * 128 + ((kq ^ (c & 7)) << 4);
    const LAS unsigned char* rd1 = img + c * 128 + (((4 + kq) ^ (c & 7)) << 4);
    const int tlast = wk + ((T - 1 - wk) / nwk) * nwk;
#define U_LOADID(ID, t_, q_) do { const int tt_ = (t_) <= tlast ? (t_) : tlast; _Pragma("unroll") for (int b = 0; b < 4; ++b) ID[b] = IDX[(size_t)tt_ * 128 + (q_) * 32 + 8 * b + j]; } while (0)
#define U_LOADX(t_) do { const int tt_ = (t_) <= tlast ? (t_) : tlast; xn = *(const GAS u32x2*)(xs + (size_t)tt_ * DM + lo * 4); } while (0)
    const __amdgpu_buffer_rsrc_t urs = __builtin_amdgcn_make_buffer_rsrc((void*)(unsigned char*)UN, 0, NEXP * 128, 0x00020000);
#define U_ISSUE(UB, ID) do { _Pragma("unroll") for (int b = 0; b < 4; ++b) UB[b] = __builtin_amdgcn_raw_buffer_load_b128(urs, ID[b] * 128 + (int)p * 16, 0, 16); } while (0)
#define U_WRITE(UB, q_) do { _Pragma("unroll") for (int b = 0; b < 4; ++b) *(LAS u32x4*)(wrp + (4 * (q_) + b) * 1024) = UB[b]; } while (0)
#define U_MM(g0) do { u32x4 a0[4], a1[4]; _Pragma("unroll") for (int g = 0; g < 4; ++g) { a0[g] = *(const LAS u32x4*)(rd0 + ((g0) + g) * 2048); a1[g] = *(const LAS u32x4*)(rd1 + ((g0) + g) * 2048); } \
        _Pragma("unroll") for (int g = 0; g < 4; ++g) { \
            f32x4 c_ = __builtin_amdgcn_mfma_scale_f32_16x16x128_f8f6f4((v8i_t){(int)a0[g].x, (int)a0[g].y, (int)a0[g].z, (int)a0[g].w, 0, 0, 0, 0}, bop0, zero4, 4, 0, 0, 127, 0, 127); \
            acc[(g0) + g] = __builtin_amdgcn_mfma_scale_f32_16x16x128_f8f6f4((v8i_t){(int)a1[g].x, (int)a1[g].y, (int)a1[g].z, (int)a1[g].w, 0, 0, 0, 0}, bop1, c_, 4, 0, 0, 127, 0, 127); } } while (0)
    int idA[4], idB[4]; u32x4 u0[4], u1[4], u2[4], u3[4]; u32x2 xc, xn;
    U_LOADID(idA, wk, 0); U_LOADID(idB, wk, 1); U_LOADX(wk);
    U_ISSUE(u0, idA); U_LOADID(idA, wk, 2);
    U_ISSUE(u1, idB); U_LOADID(idB, wk, 3);
    U_ISSUE(u2, idA); U_LOADID(idA, wk + nwk, 0);
    xc = xn;
    for (int t = wk; t < T; t += nwk) {
        U_ISSUE(u3, idB); U_LOADID(idB, t + nwk, 1); U_LOADX(t + nwk);
        const float x0 = bf_lo(xc.x), x1 = bf_hi(xc.x), x2 = bf_lo(xc.y), x3 = bf_hi(xc.y);
        const float amax = wave_max(fmaxf(fmaxf(fabsf(x0), fabsf(x1)), fmaxf(fabsf(x2), fabsf(x3))));
        const float sc = fmaxf(amax, 1e-20f) * (1.f / 448.f), qs = __builtin_amdgcn_rcpf(sc);
        { int pk = __builtin_amdgcn_cvt_pk_fp8_f32(x0 * qs, x1 * qs, 0, false); pk = __builtin_amdgcn_cvt_pk_fp8_f32(x2 * qs, x3 * qs, pk, true); *(LAS int*)(xrow + lo * 4) = pk; }
        U_WRITE(u0, 0);
        U_ISSUE(u0, idA); U_LOADID(idA, t + nwk, 2);
        U_WRITE(u1, 1);
        U_ISSUE(u1, idB); U_LOADID(idB, t + nwk, 3);
        U_WRITE(u2, 2);
        U_ISSUE(u2, idA); U_LOADID(idA, t + 2 * nwk, 0);
        U_WRITE(u3, 3);
        v8i_t bop0, bop1;
        { const u32x4 b00 = *(const LAS u32x4*)(xrow + kq * 16), b01 = *(const LAS u32x4*)(xrow + 64 + kq * 16), b10 = *(const LAS u32x4*)(xrow + 128 + kq * 16), b11 = *(const LAS u32x4*)(xrow + 192 + kq * 16);
          bop0 = (v8i_t){(int)b00.x, (int)b00.y, (int)b00.z, (int)b00.w, (int)b01.x, (int)b01.y, (int)b01.z, (int)b01.w};
          bop1 = (v8i_t){(int)b10.x, (int)b10.y, (int)b10.z, (int)b10.w, (int)b11.x, (int)b11.y, (int)b11.z, (int)b11.w}; }
        const f32x4 zero4 = {0.f, 0.f, 0.f, 0.f};
        f32x4 acc[8];
        U_MM(0); U_MM(4);
        f32x4 o = acc[0];
#pragma unroll
        for (int m = 1; m < 8; ++m) o = ((c & 7) == (unsigned)m) ? acc[m] : o;
        { const h2 o0 = {(_Float16)(o[0] * sc), (_Float16)(o[1] * sc)}, o1 = {(_Float16)(o[2] * sc), (_Float16)(o[3] * sc)};
          __builtin_nontemporal_store((u32x2){__builtin_bit_cast(unsigned, o0), __builtin_bit_cast(unsigned, o1)}, (GAS u32x2*)(part + (size_t)t * 128 + 16 * (c & 7) + 4 * kq)); }
        xc = xn;
    }
#undef U_LOADID
#undef U_LOADX
#undef U_ISSUE
#undef U_WRITE
#undef U_MM
}
__device__ __forceinline__ void step_peer_reduce(Frame& F, int layer) {
    const GAS _Float16* part = (const GAS _Float16*)(F.ws + O_PART); const GAS float* GW = (const GAS float*)(F.ws + O_GW); const GAS int* IDX = (const GAS int*)(F.ws + O_IDX);
    const GAS float* rowss = (const GAS float*)(F.ws + O_ROWSS); GAS unsigned char* W8 = F.ws + O_W8;
    const GAS unsigned char* SU = F.ws + O_TAB + (size_t)(layer * 2) * TAB_ONE + TAB_NIB; const GAS unsigned char* SV = SU + TAB_ONE;
    constexpr int NIT = T * 2;
    struct SA { int id; float gw, rs; float p[8]; }; struct SB { u32x4 su, sv; };
#define RA(X, it_) do { const int ii_ = (it_) < NIT ? (it_) : NIT - 1; const size_t i_ = (size_t)ii_ * 64 + F.lane; X.id = IDX[i_]; X.gw = GW[i_]; X.rs = rowss[(size_t)(ii_ >> 1) * 32 + (F.lane & 31)]; \
        _Pragma("unroll") for (int s = 0; s < 8; ++s) X.p[s] = (float)part[(size_t)s * T * 128 + i_]; } while (0)
#define RB(Y, X) do { Y.su = *(const GAS u32x4*)(SU + (size_t)X.id * 16); Y.sv = *(const GAS u32x4*)(SV + (size_t)X.id * 16); } while (0)
#define RC(X, Y, it_) do { if ((it_) < NIT) { const size_t i_ = (size_t)(it_) * 64 + F.lane; const float r = rsqrtf(wave_sum(X.rs) * (0.5f / DM) + EPS); float d = 0.f; \
        _Pragma("unroll") for (int s = 0; s < 8; ++s) d += X.p[s] * (float)__builtin_bit_cast(_Float16, (unsigned short)(Y.su[s >> 1] >> (16 * (s & 1)))); \
        const float w = X.gw * gelu_tanh(d * r) * 256.f; \
        _Pragma("unroll") for (int s = 0; s < 8; ++s) { const float ws = w * (float)__builtin_bit_cast(_Float16, (unsigned short)(Y.sv[s >> 1] >> (16 * (s & 1)))); \
            W8[(size_t)s * T * 128 + i_] = (unsigned char)(__builtin_amdgcn_cvt_pk_fp8_f32(ws, 0.f, 0, false) & 0xff); } } } while (0)
    SA a0, a1, a2; SB b0, b1;
    RA(a0, F.gw); RA(a1, F.gw + F.ngw); RB(b0, a0);
    for (int it = F.gw; it < NIT; it += F.ngw) {
        RA(a2, it + 2 * F.ngw); RB(b1, a1);
        RC(a0, b0, it);
        a0 = a1; a1 = a2; b0 = b1;
    }
#undef RA
#undef RB
#undef RC
}
__device__ __forceinline__ void step_vpass(Frame& F, int layer, int G, bool dry, LAS unsigned char* lds) {
    typedef pg8::v8i_t v8i_t;
    const int s = blockIdx.x & 7, wk = (blockIdx.x >> 3) * NWAVES + F.wave, nwk = (G >> 3) * NWAVES;
    const GAS unsigned char* VN = F.ws + O_TAB + (size_t)(layer * 2 + 1) * TAB_ONE + (size_t)s * NEXP * 128;
    const GAS int* IDX = (const GAS int*)(F.ws + O_IDX); const GAS unsigned char* W8 = F.ws + O_W8 + (size_t)s * T * 128;
    GAS bf16_t* xs = (GAS bf16_t*)(F.ws + O_XS16); GAS float* rsp = (GAS float*)(F.ws + O_RSP);
    unsigned lo = (unsigned)F.lane; asm volatile("" : "+v"(lo));
    const unsigned j = lo >> 3, p = lo & 7, c = lo & 15, kq = lo >> 4;
    LAS unsigned char* img = lds + F.wave * 16384;
    LAS unsigned char* wrp = img + j * 128 + ((p ^ j) << 4);
    const unsigned rdrow = (unsigned)(size_t)img + (32 * kq + c) * 128, csw = (c & 7) << 4;
    const int tlast = wk + ((T - 1 - wk) / nwk) * nwk;
    LAS float* wfl = (LAS float*)(lds + 131072); GAS float* logfp = (GAS float*)(F.ws + O_LOGFP);
    if (layer == 0) { const GAS float* wf = (const GAS float*)(F.ws + O_WF) + s * 256;
        for (int i = F.tid; i < NH * 64; i += NTHREADS) *(LAS f32x4*)(wfl + (i >> 6) * 256 + (i & 63) * 4) = *(const GAS f32x4*)(wf + (size_t)(i >> 6) * DM + (i & 63) * 4);
        __syncthreads(); }
#define V_LOADID(ID, t_, q_) do { const int tt_ = (t_) <= tlast ? (t_) : tlast; _Pragma("unroll") for (int b = 0; b < 4; ++b) ID[b] = IDX[(size_t)tt_ * 128 + (q_) * 32 + 8 * b + j]; } while (0)
#define V_LOADW(t_) do { const int tt_ = (t_) <= tlast ? (t_) : tlast; wn0 = *(const GAS u32x4*)(W8 + (size_t)tt_ * 128 + kq * 16); wn1 = *(const GAS u32x4*)(W8 + (size_t)tt_ * 128 + 64 + kq * 16); } while (0)
    const __amdgpu_buffer_rsrc_t vrs = __builtin_amdgcn_make_buffer_rsrc((void*)(unsigned char*)VN, 0, NEXP * 128, 0x00020000);
#define V_ISSUE(VB, ID) do { _Pragma("unroll") for (int b = 0; b < 4; ++b) VB[b] = __builtin_amdgcn_raw_buffer_load_b128(vrs, ID[b] * 128 + (int)p * 16, 0, 16); } while (0)
#define V_WRITE(VB, q_) do { _Pragma("unroll") for (int b = 0; b < 4; ++b) *(LAS u32x4*)(wrp + (4 * (q_) + b) * 1024) = VB[b]; } while (0)
#define TR4(dst, va, off) asm volatile("ds_read_b64_tr_b4 %0, %1 offset:%2" : "=&v"(dst) : "v"(va), "i"(off) : "memory")
#define V_MM(cc) do { const unsigned va0 = rdrow + (((cc) << 4) ^ csw), va1 = rdrow + ((((cc) + 1) << 4) ^ csw); u32x2 t00, t01, t10, t11, t20, t21, t30, t31; \
        TR4(t00, va0, 0); TR4(t01, va0, 2048); TR4(t10, va0, 8); TR4(t11, va0, 2056); TR4(t20, va1, 0); TR4(t21, va1, 2048); TR4(t30, va1, 8); TR4(t31, va1, 2056); \
        asm volatile("s_waitcnt lgkmcnt(0)" ::: "memory"); __builtin_amdgcn_sched_barrier(0); \
        o = __builtin_amdgcn_mfma_scale_f32_16x16x128_f8f6f4((v8i_t){(int)t00.x, (int)t00.y, (int)t01.x, (int)t01.y, 0, 0, 0, 0}, bop, o, 4, 0, 0, 127, 0, SBV(2 * (cc))); \
        o = __builtin_amdgcn_mfma_scale_f32_16x16x128_f8f6f4((v8i_t){(int)t10.x, (int)t10.y, (int)t11.x, (int)t11.y, 0, 0, 0, 0}, bop, o, 4, 0, 0, 127, 0, SBV(2 * (cc) + 1)); \
        o = __builtin_amdgcn_mfma_scale_f32_16x16x128_f8f6f4((v8i_t){(int)t20.x, (int)t20.y, (int)t21.x, (int)t21.y, 0, 0, 0, 0}, bop, o, 4, 0, 0, 127, 0, SBV(2 * (cc) + 2)); \
        o = __builtin_amdgcn_mfma_scale_f32_16x16x128_f8f6f4((v8i_t){(int)t30.x, (int)t30.y, (int)t31.x, (int)t31.y, 0, 0, 0, 0}, bop, o, 4, 0, 0, 127, 0, SBV(2 * (cc) + 3)); } while (0)
#define SBV(nb_) ((c == (unsigned)(nb_)) ? 119 : 0)
    int idA[4], idB[4]; u32x4 v0[4], v1[4], v2[4], v3[4]; u32x4 w0, w1, wn0, wn1;
    V_LOADID(idA, wk, 0); V_LOADID(idB, wk, 1); V_LOADW(wk);
    V_ISSUE(v0, idA); V_LOADID(idA, wk, 2);
    V_ISSUE(v1, idB); V_LOADID(idB, wk, 3);
    V_ISSUE(v2, idA); V_LOADID(idA, wk + nwk, 0);
    w0 = wn0; w1 = wn1;
    for (int t = wk; t < T; t += nwk) {
        V_ISSUE(v3, idB); V_LOADID(idB, t + nwk, 1); V_LOADW(t + nwk);
        GAS bf16_t* xb = xs + (size_t)t * DM + s * 256 + c * 16 + kq * 4;
        f32x4 x2; { const u32x2 w = *(const GAS u32x2*)xb; x2 = (f32x4){bf_lo(w.x), bf_hi(w.x), bf_lo(w.y), bf_hi(w.y)}; }
        V_WRITE(v0, 0);
        V_ISSUE(v0, idA); V_LOADID(idA, t + nwk, 2);
        V_WRITE(v1, 1);
        V_ISSUE(v1, idB); V_LOADID(idB, t + nwk, 3);
        V_WRITE(v2, 2);
        V_ISSUE(v2, idA); V_LOADID(idA, t + 2 * nwk, 0);
        V_WRITE(v3, 3);
        const v8i_t bop = {(int)w0.x, (int)w0.y, (int)w0.z, (int)w0.w, (int)w1.x, (int)w1.y, (int)w1.z, (int)w1.w};
        f32x4 o = {0.f, 0.f, 0.f, 0.f};
        V_MM(0); V_MM(2); V_MM(4); V_MM(6);
        x2 += o;
        if (layer == 1 && !dry) __builtin_nontemporal_store(x2, (GAS f32x4*)(F.out + (size_t)t * DM + s * 256 + c * 16 + kq * 4));
        if (layer == 0 && !dry) {
            { u32x2 ow; ow.x = cvtpk(x2[0], x2[1]); ow.y = cvtpk(x2[2], x2[3]); __builtin_nontemporal_store(ow, (GAS u32x2*)xb); }
            const float sst = wave_sum((x2[0] * x2[0] + x2[1] * x2[1]) + (x2[2] * x2[2] + x2[3] * x2[3]));
            if (lo == 0) rsp[(size_t)t * 8 + s] = sst;
        }
        if (layer == 0) {
            f32x4 gw[NH];
#pragma unroll
            for (int h = 0; h < NH; ++h) gw[h] = *(const LAS f32x4*)(wfl + h * 256 + c * 16 + kq * 4);
            __builtin_amdgcn_sched_barrier(0);
            float ph[NH];
#pragma unroll
            for (int h = 0; h < NH; ++h) ph[h] = (x2[0] * gw[h][0] + x2[1] * gw[h][1]) + (x2[2] * gw[h][2] + x2[3] * gw[h][3]);
#pragma unroll
            for (int h = 0; h < NH; ++h) ph[h] += dppf<0xB1>(ph[h]);
#pragma unroll
            for (int h = 0; h < NH; ++h) ph[h] += dppf<0x4E>(ph[h]);
#pragma unroll
            for (int h = 0; h < NH; ++h) ph[h] += dppf<0x141>(ph[h]);
#pragma unroll
            for (int h = 0; h < NH; ++h) ph[h] += dppf<0x140>(ph[h]);
            float sel = 0.f;
#pragma unroll
            for (int h = 0; h < NH; ++h) sel = (c == (unsigned)h) ? ph[h] : sel;
            sel = xsum16(sel); sel = xsum32(sel);
            if (lo < (unsigned)NH && !dry) logfp[((size_t)t * 8 + s) * NH + lo] = sel;
        }
        w0 = wn0; w1 = wn1;
    }
#undef V_LOADID
#undef V_LOADW
#undef V_ISSUE
#undef V_WRITE
#undef TR4
#undef V_MM
#undef SBV
}
#undef F4
#undef H2F
__device__ __forceinline__ void step_logf(Frame& F) {
    const GAS float* lp = (const GAS float*)(F.ws + O_LOGFP); const GAS float* rsp = (const GAS float*)(F.ws + O_RSP); GAS float* logf = (GAS float*)(F.ws + O_LOGF);
    unsigned lo = (unsigned)F.lane; asm volatile("" : "+v"(lo));
    const unsigned h = lo & 15, g = lo >> 4; const unsigned hh = h < (unsigned)NH ? h : 0u;
    for (int t0 = F.gw * 4; t0 < T; t0 += F.ngw * 4) {
        const int t = t0 + (int)g;
        float pz[8]; f32x4 q0, q1;
#pragma unroll
        for (int s = 0; s < 8; ++s) pz[s] = lp[((size_t)t * 8 + s) * NH + hh];
        q0 = *(const GAS f32x4*)(rsp + (size_t)t * 8); q1 = *(const GAS f32x4*)(rsp + (size_t)t * 8 + 4);
        const float z0 = ((pz[0] + pz[1]) + (pz[2] + pz[3])) + ((pz[4] + pz[5]) + (pz[6] + pz[7]));
        const float r1 = rsqrtf(((q0[0] + q0[1]) + (q0[2] + q0[3]) + (q1[0] + q1[1]) + (q1[2] + q1[3])) * (1.f / DM) + EPS);
        if (h < (unsigned)NH) { const float z = z0 * r1 + F.in(I_SBF)[h];
            logf[((size_t)(t / SEQ) * NH + h) * SEQ + (t % SEQ)] = fminf(z, 0.f) - log1p_pos(fast_exp(-fabsf(z))); }
    }
}

#define XB_TMO      128
#define XB_XCNT(j)  (256  + 64 * (j))
#define XB_XSUB(j)  (1280 + 64 * (j))
#define XB_XGEN(j)  (2304 + 64 * (j))
#define XB_TOP      3328
#define XB_TOPGEN   3392
#define XCD_BAR_WORDS 3456
#define XB_SPIN_CAP (1u << 20)
__device__ __forceinline__ unsigned xb_ld(unsigned* p)              { return __hip_atomic_load(p, __ATOMIC_RELAXED, __HIP_MEMORY_SCOPE_AGENT); }
__device__ __forceinline__ unsigned xb_add(unsigned* p, unsigned v) { return __hip_atomic_fetch_add(p, v, __ATOMIC_RELAXED, __HIP_MEMORY_SCOPE_AGENT); }
__device__ __forceinline__ unsigned xb_xcc_id() { return (unsigned)__builtin_amdgcn_s_getreg((3 << 11) | 20) & 0xFu; }
#define XB_SPIN(cond, bar) do { unsigned _sp = 0; while (cond) { __builtin_amdgcn_s_sleep(1); \
    if ((++_sp & 255u) == 0u) { if (xb_ld(&(bar)[XB_TMO])) break; if (_sp > XB_SPIN_CAP) { atomicAdd(&(bar)[XB_TMO], 1u); break; } } } } while (0)
struct XcdBarrier { unsigned* bar; unsigned x; volatile LAS unsigned* st; };
__device__ __forceinline__ XcdBarrier xcd_barrier_post(unsigned* bar, volatile LAS unsigned* st) {
    XcdBarrier b; b.bar = bar; b.x = xb_xcc_id(); b.st = st;
    if (threadIdx.x == 0) (void)xb_add(&bar[XB_XCNT(b.x)], 1u);
    return b;
}
__device__ __forceinline__ void xcd_barrier_complete(unsigned* bar, unsigned x, unsigned& nloc, unsigned& nx) {
    const unsigned G = gridDim.x * gridDim.y * gridDim.z;
    unsigned sum, cnt, mine, sp = 0u;
    for (;;) {
        sum = 0u; cnt = 0u; mine = 0u;
#pragma unroll
        for (unsigned j = 0; j < 16; ++j) { const unsigned c = xb_ld(&bar[XB_XCNT(j)]); sum += c; cnt += (c > 0u) ? 1u : 0u; mine = (j == x) ? c : mine; }
        if (sum == G) break;
        __builtin_amdgcn_s_sleep(1);
        if ((++sp & 255u) == 0u) { if (xb_ld(&bar[XB_TMO])) break; if (sp > XB_SPIN_CAP) { atomicAdd(&bar[XB_TMO], 1u); break; } }
    }
    nloc = mine > 0u ? mine : 1u; nx = cnt > 0u ? cnt : 1u;
}
__device__ __forceinline__ void xcd_barrier(const XcdBarrier& b, int wave_s) {
    asm volatile("s_waitcnt vmcnt(0)" ::: "memory");
    __syncthreads();
    int ln_; asm volatile("v_mbcnt_lo_u32_b32 %0, -1, 0\n\tv_mbcnt_hi_u32_b32 %0, -1, %0" : "=v"(ln_));
    if (wave_s == 0 && ln_ == 0) {
        unsigned* bar = b.bar;
        __builtin_amdgcn_s_waitcnt(0);
        unsigned nloc = b.st[0], nx = b.st[1];
        if (nloc == 0u) { xcd_barrier_complete(bar, b.x, nloc, nx); b.st[0] = nloc; b.st[1] = nx; }
        const unsigned old = xb_add(&bar[XB_XSUB(b.x)], 1u);
        const unsigned gen = old / nloc;
        if (old + 1u == (gen + 1u) * nloc) {
            __builtin_amdgcn_fence(__ATOMIC_RELEASE, "agent");
            asm volatile("s_waitcnt vmcnt(0)" ::: "memory");
            const unsigned og = xb_add(&bar[XB_TOP], 1u);
            const unsigned tg = og / nx;
            if (og + 1u == (tg + 1u) * nx) xb_add(&bar[XB_TOPGEN], 1u);
            else XB_SPIN(xb_ld(&bar[XB_TOPGEN]) == tg, bar);
            __builtin_amdgcn_fence(__ATOMIC_ACQUIRE, "agent");
            xb_add(&bar[XB_XGEN(b.x)], 1u);
            asm volatile("s_waitcnt vmcnt(0)" ::: "memory");
        } else {
            XB_SPIN(xb_ld(&bar[XB_XGEN(b.x)]) == gen, bar);
            __builtin_amdgcn_fence(__ATOMIC_ACQUIRE, "agent");
            asm volatile("s_waitcnt vmcnt(0)" ::: "memory");
        }
    }
    __syncthreads();
}

constexpr int CONV1_SPLIT = 2 * 4608;
constexpr int BAR_LDS_OFF = 147456 - 64;
constexpr int LDS_BYTES = 147456;
enum { ST_PROLOGUE = 0, ST_G_IN0, ST_G_MKV0, ST_G_MKV1, ST_CONV, ST_G_GATE, ST_A_MEM0, ST_SCAN1, ST_SCAN2, ST_G_OUT0, ST_G_PQ0, ST_TOPK0, ST_UPASS0, ST_PRED0, ST_VPASS0,
       ST_G_L1, ST_CPREFIX, ST_A_FOX, ST_A_MEM1, ST_G_OUT1, ST_G_PQ1, ST_TOPK1, ST_UPASS1, ST_PRED1, ST_VPASS1, N_STEPS };
constexpr unsigned SYNC_AFTER = (1u << ST_PROLOGUE) | (1u << ST_G_MKV1) | (1u << ST_CONV) | (1u << ST_A_MEM0) | (1u << ST_SCAN1) | (1u << ST_SCAN2) | (1u << ST_G_OUT0) | (1u << ST_G_PQ0) |
                                (1u << ST_TOPK0) | (1u << ST_UPASS0) | (1u << ST_PRED0) | (1u << ST_VPASS0) | (1u << ST_G_L1) | (1u << ST_CPREFIX) | (1u << ST_A_MEM1) | (1u << ST_G_OUT1) | (1u << ST_G_PQ1) | (1u << ST_TOPK1) | (1u << ST_UPASS1) | (1u << ST_PRED1);
constexpr unsigned GEMM_STEPS = (1u << ST_G_IN0) | (1u << ST_G_MKV0) | (1u << ST_G_MKV1) | (1u << ST_G_GATE) | (1u << ST_G_OUT0) | (1u << ST_G_PQ0) | (1u << ST_G_L1) | (1u << ST_G_OUT1) | (1u << ST_G_PQ1);
constexpr unsigned ATTN_STEPS = (1u << ST_A_MEM0) | (1u << ST_A_FOX) | (1u << ST_A_MEM1);

struct Args { const float* in[N_IN]; float* out; unsigned char* ws; int lo, hi; };

__global__ void __launch_bounds__(NTHREADS, 2) yoco_fwd(Args args) {
    extern __shared__ __attribute__((aligned(16))) unsigned char lds[];
    volatile LAS unsigned* bst = (volatile LAS unsigned*)((LAS unsigned char*)lds + BAR_LDS_OFF);
    if (threadIdx.x == 0) { bst[0] = 0u; bst[1] = 0u; }
    __syncthreads();
    const XcdBarrier gbar = xcd_barrier_post((unsigned*)(args.ws + O_CTL), bst);
    const int G = gridDim.x;
    const int wave_s = __builtin_amdgcn_readfirstlane(threadIdx.x >> 6);
#ifndef DUP_MASK
#define DUP_MASK 0u
#endif
    for (int st = args.lo; st < args.hi; ++st) {
      const int nrep = ((DUP_MASK >> st) & 1u) ? 2 : 1;
      for (int rep = 0; rep < nrep; ++rep) {
        unsigned char* ws0 = args.ws; asm volatile("" : "+s"(ws0));
        GAS unsigned char* ws = (GAS unsigned char*)ws0;
#define LANE_ID(v) asm volatile("v_mbcnt_lo_u32_b32 %0, -1, 0\n\tv_mbcnt_hi_u32_b32 %0, -1, %0" : "=v"(v))
#define MAKE_TID(v) do { LANE_ID(v); v += wave_s * 64; } while (0)
#define MAKE_FRAME(F) Frame F; F.ws = ws; F.in_ = args.in; F.out = (GAS float*)args.out; { int t0_; MAKE_TID(t0_); F.tid = t0_; } F.lane = F.tid & 63; F.wave = wave_s; \
        F.gw = blockIdx.x * NWAVES + F.wave; F.ngw = gridDim.x * NWAVES; F.gtid = blockIdx.x * NTHREADS + F.tid; F.ngt = gridDim.x * NTHREADS
        if (st == ST_G_L1) { MAKE_FRAME(F); step_logf(F); }
        if ((GEMM_STEPS >> st) & 1u) {
            pg8::Gemm g; Epi E; E.ws = ws; E.resid = nullptr; E.outf = nullptr; E.o16 = nullptr; E.ssq = nullptr; E.gate_b = nullptr; int shift = 0;
            switch (st) {
            case ST_G_IN0:  g = {(const GAS bf16_t*)(ws + O_XS16), (const GAS bf16_t*)(ws + O_WIN0), T, NIN0, DM, DM, DM, 0}; E.mode = EM_IN0; break;
            case ST_G_MKV0: g = {(const GAS bf16_t*)(ws + O_MEMN), (const GAS bf16_t*)(ws + O_WMKV), NMROW, 1024, DM, DM, DM, 0}; E.mode = EM_MKV; E.o16 = (GAS bf16_t*)(ws + O_MKV); E.ssq = (GAS float*)(ws + O_MKSS); shift = 128; break;
            case ST_G_MKV1: g = {(const GAS bf16_t*)(ws + O_MEMN) + (size_t)NMROW * DM, (const GAS bf16_t*)(ws + O_WMKV) + (size_t)1024 * DM, NMROW, 1024, DM, DM, DM, 0}; E.mode = EM_MKV;
                            E.o16 = (GAS bf16_t*)(ws + O_MKV) + (size_t)NMROW * NL1; E.ssq = (GAS float*)(ws + O_MKSS) + NMROW * 112; shift = 144; break;
            case ST_G_GATE: g = {(const GAS bf16_t*)(ws + O_XC), (const GAS bf16_t*)(ws + O_WGATE), T, 12 * 256, 128, LRU, 128, 128}; E.mode = EM_GATE; E.gate_b = (const GAS float*)args.in[I_AGATEB]; break;
            case ST_G_OUT0: g = {(const GAS bf16_t*)(ws + O_CAT), (const GAS bf16_t*)(ws + O_WOUT0), T, DM, DM, DM, DM, 0}; E.mode = EM_RES; E.resid = (const GAS float*)args.in[I_X]; E.outf = (GAS float*)args.out; break;
            case ST_G_PQ0:  g = {(const GAS bf16_t*)(ws + O_XS16), (const GAS bf16_t*)(ws + O_WQ0), T, DM, DM, DM, DM, 0}; E.mode = EM_PQ; E.o16 = (GAS bf16_t*)(ws + O_Q16); break;
            case ST_G_L1:   g = {(const GAS bf16_t*)(ws + O_XS16), (const GAS bf16_t*)(ws + O_WL1), T, NL1, DM, DM, DM, 0}; E.mode = EM_L1; break;
            case ST_G_OUT1: g = {(const GAS bf16_t*)(ws + O_CAT), (const GAS bf16_t*)(ws + O_WOUT1), T, DM, DM, DM, DM, 0}; E.mode = EM_RES; E.resid = nullptr; break;
            default:        g = {(const GAS bf16_t*)(ws + O_XS16), (const GAS bf16_t*)(ws + O_WQ1), T, DM, DM, DM, DM, 0}; E.mode = EM_PQ; E.o16 = (GAS bf16_t*)(ws + O_Q16); break;
            }
            pg8::StaticOrder S; S.init(g.M, g.N, G, (int)((blockIdx.x + G - shift) % G));
#ifndef DIS_GEMM
            { int tg_; MAKE_TID(tg_);
              pg8::gemm_phase<Epi, false>((LAS unsigned char*)lds, g, S, E, tg_); }
#endif
            if (st == ST_G_MKV1 && blockIdx.x >= 160) { MAKE_FRAME(F); convert_tables(F, 1, 0, CONV1_SPLIT, (blockIdx.x - 160) * NWAVES + F.wave, (G - 160) * NWAVES); }
        } else if ((ATTN_STEPS >> st) & 1u) {
            const int nun = st == ST_A_FOX ? 3 : 1;
            for (int ui = 0; ui < nun; ++ui) {
                att::BlockRef r;
                if (st == ST_A_FOX) {
                    const int i = blockIdx.x, x = i & 15, bh = (i >> 4) + 16 * ui, qb = ui == 0 ? x : (ui == 1 ? 15 - x : ((x * 5 + 3) & 15));
                    const int b = bh / NH, h = bh % NH; const size_t row0 = (size_t)b * SEQ + qb * 256;
                    const GAS bf16_t* z = (const GAS bf16_t*)(ws + O_ZL1);
                    r.Q = z + row0 * NL1 + 3072 + h * 128; r.K = z + (size_t)b * SEQ * NL1 + h * 128; r.V = z + (size_t)b * SEQ * NL1 + 1536 + h * 128;
                    r.O = (GAS bf16_t*)(ws + O_CAT) + row0 * DM + h * 128;
                    const GAS float* ss = (const GAS float*)(ws + O_SSL1);
                    r.qss = ss + row0 * 112 + (12 + h) * 4; r.kss = ss + (size_t)b * SEQ * 112 + h * 4; r.cc = (const GAS float*)(ws + O_CC) + (size_t)bh * SEQ; r.gg = (const GAS float*)(ws + O_GG) + 384;
                    r.P0 = qb * 256; r.skv = SEQ;
                } else {
                    const int l = st == ST_A_MEM0 ? 0 : 1; const int i = blockIdx.x, qblk = i >> 2, h = i & 3, b = qblk >> 4; const size_t row0 = (size_t)qblk * 256;
                    r.Q = (const GAS bf16_t*)(ws + O_ZL1) + row0 * NL1 + 4608 + h * 128; r.qss = (const GAS float*)(ws + O_SSL1) + row0 * 112 + (24 + h) * 4;
                    const GAS bf16_t* kv = (const GAS bf16_t*)(ws + O_MKV) + ((size_t)l * NMROW + b * NMEM) * NL1;
                    r.K = kv + h * 128; r.V = kv + 512 + h * 128; r.kss = (const GAS float*)(ws + O_MKSS) + ((size_t)l * NMROW + b * NMEM) * 112 + h * 4;
                    r.O = (GAS bf16_t*)(ws + O_CAT) + row0 * DM + LRU + h * 128; r.cc = nullptr; r.gg = (const GAS float*)(ws + O_GG) + 128 * (1 + l);
                    r.P0 = SEQ; r.skv = NMEM;
                }
                att::Seam S;
                int tid_u; MAKE_TID(tid_u);
#ifndef DIS_ATTN
                if (st == ST_A_FOX) { att::attn_prime(r, (char*)lds, S, tid_u); att::attn_block(r, (char*)lds, S, tid_u); }
                else att::mem_attn_unit(r, (char*)lds, tid_u);
#endif
            }
        } else {
            MAKE_FRAME(F);
            switch (st) {
#ifndef DIS_MISC
            case ST_PROLOGUE: step_prologue(F, (LAS unsigned char*)lds); break;
            case ST_CONV: step_conv(F); break;
            case ST_SCAN1: step_scan1(F); break;
            case ST_SCAN2: step_scan2(F); break;
#endif
#ifndef DIS_TOPK
            case ST_TOPK0: step_topk(F, (LAS unsigned char*)lds, 0); break;
            case ST_TOPK1: step_topk(F, (LAS unsigned char*)lds, 1); break;
#endif
#ifndef DIS_GATHER
            case ST_UPASS0: step_upass(F, 0, G, (LAS unsigned char*)lds); break;
            case ST_UPASS1: step_upass(F, 1, G, (LAS unsigned char*)lds); break;
            case ST_PRED0: step_peer_reduce(F, 0); break;
            case ST_PRED1: step_peer_reduce(F, 1); break;
            case ST_VPASS0: step_vpass(F, 0, G, rep + 1 < nrep, (LAS unsigned char*)lds); break;
            case ST_VPASS1: step_vpass(F, 1, G, rep + 1 < nrep, (LAS unsigned char*)lds); break;
#endif
#ifndef DIS_MISC
            case ST_CPREFIX: step_cprefix(F, (LAS unsigned char*)lds); convert_tables(F, 1, G > 160 ? CONV1_SPLIT : 0, 2 * NEXP, F.gw, F.ngw); break;
#endif
            default: break;
            }
        }
        if (rep + 1 < nrep) xcd_barrier(gbar, wave_s);
      }
        if (((SYNC_AFTER >> st) & 1u) && st + 1 < args.hi) xcd_barrier(gbar, wave_s);
    }
}

#ifndef N_LAUNCH_MODE
#define N_LAUNCH_MODE 1
#endif
extern "C" void kernel_launch(void* const* d_in, const int* in_sizes, int n_in, void* d_out, int out_size, void* d_ws, size_t ws_size, hipStream_t stream) {
    static int grid = 0;
    if (grid == 0) {
        if (n_in != N_IN || in_sizes[0] != T * DM || out_size != T * DM || ws_size < WS_END) {
            fprintf(stderr, "kernel_launch: unexpected shapes (n_in %d, in0 %d, out %d, ws %zu, need %zu)\n", n_in, n_in > 0 ? in_sizes[0] : -1, out_size, ws_size, (size_t)WS_END); grid = -1; return; }
        int dev = 0, cus = 0, per_cu = 0;
        hipGetDevice(&dev); hipDeviceGetAttribute(&cus, hipDeviceAttributeMultiprocessorCount, dev);
        hipFuncSetAttribute((const void*)yoco_fwd, hipFuncAttributeMaxDynamicSharedMemorySize, LDS_BYTES);
        hipOccupancyMaxActiveBlocksPerMultiprocessor(&per_cu, (const void*)yoco_fwd, NTHREADS, LDS_BYTES);
        if (per_cu < 1) { fprintf(stderr, "kernel_launch: occupancy query says %d blocks per CU\n", per_cu); grid = -1; return; }
        grid = cus - cus % 8;
        (void)hipGetLastError();
    }
    if (grid < 0) return;
    Args a{};
    for (int i = 0; i < N_IN; ++i) a.in[i] = (const float*)d_in[i];
    a.out = (float*)d_out; a.ws = (unsigned char*)d_ws;
    if (hipMemsetAsync((char*)d_ws + O_CTL, 0, 65536, stream) != hipSuccess) { fprintf(stderr, "kernel_launch: memset of the barrier words failed\n"); return; }
    if (N_LAUNCH_MODE == 1) {
        a.lo = 0; a.hi = N_STEPS;
        hipLaunchKernelGGL(yoco_fwd, dim3(grid), dim3(NTHREADS), LDS_BYTES, stream, a);
        hipError_t e = hipPeekAtLastError();
        if (e != hipSuccess) fprintf(stderr, "launch failed: %s (grid %d)\n", hipGetErrorString(e), grid);
    } else {
        int lo = 0;
        for (int s = 0; s < N_STEPS; ++s) {
            if (((SYNC_AFTER >> s) & 1u) || s == N_STEPS - 1) {
                a.lo = lo; a.hi = s + 1; lo = s + 1;
                void* params[] = {&a};
                hipError_t e = hipLaunchCooperativeKernel((const void*)yoco_fwd, dim3(grid), dim3(NTHREADS), params, LDS_BYTES, stream);
                if (e != hipSuccess) { fprintf(stderr, "launch failed: %s\n", hipGetErrorString(e)); break; }
            }
        }
    }
}
```

```cpp
#include <hip/hip_runtime.h>
#include <hip/hip_cooperative_groups.h>
#include <cstdio>
#include <cstdint>
namespace cg = cooperative_groups;

#define LAS __attribute__((address_space(3)))
#define GAS __attribute__((address_space(1)))
typedef unsigned short bf16_t;
typedef short bf16x8 __attribute__((ext_vector_type(8)));
typedef short s16x4 __attribute__((ext_vector_type(4)));
typedef float f32x4 __attribute__((ext_vector_type(4)));
typedef float f32x2 __attribute__((ext_vector_type(2)));
typedef float f32x16 __attribute__((ext_vector_type(16)));
typedef unsigned u32x4 __attribute__((ext_vector_type(4)));
typedef unsigned u32x2 __attribute__((ext_vector_type(2)));
typedef _Float16 h2 __attribute__((ext_vector_type(2)));

constexpr int NB = 4, SEQ = 4096, T = NB * SEQ, DM = 2048, LRU = 1536, MEMW = 512, NMEM = 256, NH = 12, HD = 128;
constexpr int NIN0 = 3584, NL1 = 5120, NEXP = 16384, NMROW = NB * NMEM;
constexpr float EPS = 1e-6f;
constexpr int NTHREADS = 512, NWAVES = 8;

constexpr size_t MiB = 1u << 20;
constexpr size_t O_CTL = 0;
constexpr size_t O_WIN0 = 1 * MiB;
constexpr size_t O_WOUT0 = O_WIN0 + 14 * MiB;
constexpr size_t O_WL1 = O_WOUT0 + 8 * MiB;
constexpr size_t O_WOUT1 = O_WL1 + 20 * MiB;
constexpr size_t O_WQ0 = O_WOUT1 + 8 * MiB;
constexpr size_t O_WQ1 = O_WQ0 + 8 * MiB;
constexpr size_t O_WMKV = O_WQ1 + 8 * MiB;
constexpr size_t O_WGATE = O_WMKV + 8 * MiB;
constexpr size_t O_SUBK = O_WGATE + 1 * MiB;
constexpr size_t O_WF = O_SUBK + 1 * MiB;
constexpr size_t O_SMALL = O_WF + 1 * MiB;
constexpr size_t O_RS1 = O_SMALL;
constexpr size_t O_LOGF = O_SMALL + 64 * 1024;
constexpr size_t O_CC = O_LOGF + 768 * 1024;
constexpr size_t O_GG = O_CC + 768 * 1024;
constexpr size_t O_SPL = O_GG + 4096;
constexpr size_t O_TSC = O_SPL + 8192;
constexpr size_t O_ROWSS = O_SMALL + 2 * MiB;
constexpr size_t O_RSP = O_ROWSS + 2 * MiB;
constexpr size_t O_QMSS = O_RSP;
constexpr size_t O_MKSS = O_QMSS + 1 * MiB;
constexpr size_t O_SSL1 = O_MKSS + 1 * MiB;
constexpr size_t O_CARRY = O_SSL1 + 7 * MiB;
constexpr size_t O_MEMN = O_CARRY + 3 * MiB;
constexpr size_t O_MKV = O_MEMN + 8 * MiB;
constexpr size_t O_IDX = O_MKV + 20 * MiB;
constexpr size_t O_GW = O_IDX + 8 * MiB;
constexpr size_t O_TAB = O_GW + 8 * MiB;
constexpr size_t TAB_NIB = (size_t)8 * 16384 * 128, TAB_ONE = TAB_NIB + (size_t)16384 * 16 + 786432;
constexpr size_t O_XS16 = O_TAB + 128 * MiB;
constexpr size_t O_CAT = O_XS16 + 64 * MiB;
constexpr size_t O_ZX = O_CAT + 64 * MiB;
constexpr size_t O_X8 = O_ZX;
constexpr size_t O_GY = O_ZX + 48 * MiB;
constexpr size_t O_LOGFP = O_GY + 48 * MiB;
constexpr size_t O_QM = O_LOGFP;
constexpr size_t O_XC = O_QM + 16 * MiB;
constexpr size_t O_X4 = O_XC;
constexpr size_t O_SX = O_XC + 32 * MiB;
constexpr size_t O_AA = O_XC + 48 * MiB;
constexpr size_t O_PART = O_AA;
constexpr size_t O_UU = O_AA + 96 * MiB;
constexpr size_t O_W8 = O_UU;
constexpr size_t O_Q16 = O_UU + 96 * MiB;
constexpr size_t O_ZL1 = O_Q16 + 64 * MiB;
constexpr size_t WS_END = O_ZL1 + 160 * MiB;
static_assert(WS_END <= 1024 * MiB, "workspace map");

__device__ __forceinline__ unsigned cvtpk(float lo, float hi) { unsigned r; asm volatile("v_cvt_pk_bf16_f32 %0, %1, %2" : "=v"(r) : "v"(lo), "v"(hi)); return r; }
__device__ __forceinline__ float bf_lo(unsigned w) { return __uint_as_float(w << 16); }
__device__ __forceinline__ float bf_hi(unsigned w) { return __uint_as_float(w & 0xffff0000u); }
__device__ __forceinline__ float fast_exp(float x) { return __builtin_amdgcn_exp2f(x * 1.4426950408889634f); }
__device__ __forceinline__ float log1p_pos(float y) { const float ser = y * (1.f - y * (0.5f - y * (0.33333334f - 0.25f * y))); const float lg = __builtin_amdgcn_logf(1.f + y) * 0.6931471805599453f; return y < 0.03f ? ser : lg; }
__device__ __forceinline__ float one_minus_exp(float x) { const float ser = -x * (1.f + x * (0.5f + x * (0.16666667f + x * 0.041666668f))); const float big = 1.f - fast_exp(x); return x > -0.03f ? ser : big; }
__device__ __forceinline__ float sigmoidf_(float x) { return __builtin_amdgcn_rcpf(1.f + fast_exp(-x)); }
__device__ __forceinline__ float gelu_tanh(float x) { const float u = x * (1.f + 0.044715f * x * x); return x * __builtin_amdgcn_rcpf(1.f + __builtin_amdgcn_exp2f(u * (-2.f * 0.7978845608028654f * 1.4426950408889634f))); }
template <int CTRL> __device__ __forceinline__ float dppf(float v) { return __int_as_float(__builtin_amdgcn_update_dpp(0, __float_as_int(v), CTRL, 0xF, 0xF, true)); }
__device__ __forceinline__ float xsum16(float v) { auto r = __builtin_amdgcn_permlane16_swap(__float_as_uint(v), __float_as_uint(v), false, false); return __uint_as_float(r[0]) + __uint_as_float(r[1]); }
__device__ __forceinline__ float xsum32(float v) { auto r = __builtin_amdgcn_permlane32_swap(__float_as_uint(v), __float_as_uint(v), false, false); return __uint_as_float(r[0]) + __uint_as_float(r[1]); }
__device__ __forceinline__ float xmax16(float v) { auto r = __builtin_amdgcn_permlane16_swap(__float_as_uint(v), __float_as_uint(v), false, false); return fmaxf(__uint_as_float(r[0]), __uint_as_float(r[1])); }
__device__ __forceinline__ float xmax32(float v) { auto r = __builtin_amdgcn_permlane32_swap(__float_as_uint(v), __float_as_uint(v), false, false); return fmaxf(__uint_as_float(r[0]), __uint_as_float(r[1])); }
__device__ __forceinline__ float wave_sum(float v) {
    v += dppf<0xB1>(v); v += dppf<0x4E>(v); v += dppf<0x141>(v); v += dppf<0x140>(v);
    v = xsum16(v); v = xsum32(v); return v;
}
__device__ __forceinline__ float wave_max(float v) {
    v = fmaxf(v, dppf<0xB1>(v)); v = fmaxf(v, dppf<0x4E>(v)); v = fmaxf(v, dppf<0x141>(v)); v = fmaxf(v, dppf<0x140>(v));
    v = xmax16(v); v = xmax32(v); return v;
}

namespace pg8 {
constexpr int BM = 256, BK = 64, HALF = 128, HTB = HALF * BK * 2, STAGE_BYTES = 8 * HTB, NXCD = 8, WGM = 8;
__host__ __device__ __forceinline__ int lds_byte(int r, int c) { const int st = (r >> 4) * 2 + (c >> 5), rr = r & 15, cc = c & 31, ob = rr * 64 + cc * 2; return st * 1024 + (ob ^ (((ob >> 9) & 1) << 5)); }
__host__ __device__ __forceinline__ void stage_rc(int b, int& R, int& C) { const int st = b / 1024, sb = b % 1024, swz = sb ^ (((sb >> 9) & 1) << 5); R = (st >> 1) * 16 + swz / 64; C = (st & 1) * 32 + (swz % 64) / 2; }
__host__ __device__ __forceinline__ int perm32(int rho) { const int n = rho >> 4, i = rho & 15; return 8 * (i >> 2) + 4 * n + (i & 3); }

struct Unit { int pm, pn; };
struct Gemm { const GAS bf16_t* A; const GAS bf16_t* Bt; int M, N, K, lda, ldb, acol; };

struct StaticOrder {
    int nM, nN, nwg, G, c;
    __device__ void init(int M, int N, int G_, int c_) { nM = M / BM; nN = N / BM; nwg = nM * nN; G = G_; c = c_; }
    __device__ bool next(int i, Unit& u) const {
        const long L = (long)i * G + c; if (L >= nwg) return false;
        int wgid = (int)L; { const int q = nwg / NXCD, r = nwg % NXCD, xcd = wgid % NXCD, off = wgid / NXCD; wgid = (xcd < r ? xcd * (q + 1) : r * (q + 1) + (xcd - r) * q) + off; }
        const int nig = WGM * nN, gid = wgid / nig, fm = gid * WGM, gsz = (nM - fm) < WGM ? (nM - fm) : WGM;
        u.pm = fm + ((wgid % nig) % gsz); u.pn = (wgid % nig) / gsz; return true;
    }
};

typedef int v8i_t __attribute__((ext_vector_type(8)));
typedef int v4i_t __attribute__((ext_vector_type(4)));
template <class Epi, bool FP8>
__device__ __forceinline__ void gemm_phase(LAS unsigned char* lds, const Gemm g, const StaticOrder& S, const Epi& E, const int tid) {
    const int wid = __builtin_amdgcn_readfirstlane(tid >> 6), lane = tid & 63, wr = wid >> 2, wc = wid & 3, fr = lane & 15, fq = lane >> 4;
    const int K = g.K, nt = K / BK;
    unsigned voffA[2], voffB[2];
#pragma unroll
    for (int i = 0; i < 2; ++i) { int R, C; stage_rc(tid * 16 + i * 8192, R, C); const int Rb = (R & ~31) + perm32(R & 31);
        voffA[i] = (unsigned)(R * g.lda + C) * 2u; voffB[i] = (unsigned)(Rb * g.ldb + C) * 2u; }
    const size_t kstep = (size_t)(BK * 2);
    const size_t hstepA = (size_t)HALF * g.lda * 2, hstepB = (size_t)HALF * g.ldb * 2;
    const size_t tstepA = 2 * hstepA, tstepB = 2 * hstepB;
    const unsigned ldsw = (unsigned)wid * 1024u;
    const int aoff = lds_byte(wr * 64 + fr, fq * 8), boff = lds_byte(wc * 32 + fr, fq * 8);
#define PG8_SA(b, h) (((b) * 2 + (h)) * HTB)
#define PG8_SB(b, h) ((4 + (b) * 2 + (h)) * HTB)
#define PG8_STAGE(bufoff, gbase, voff) do { _Pragma("unroll") for (int _i = 0; _i < 2; ++_i) \
        __builtin_amdgcn_global_load_lds((const GAS unsigned*)((gbase) + (voff)[_i]), (LAS unsigned*)(lds + (bufoff) + ldsw + _i * 8192), 16, 0, 0); } while (0)
#define PG8_LD2(dst, off_) do { const u32x4 lo_ = *(const LAS u32x4*)(lds + (off_)), hi_ = *(const LAS u32x4*)(lds + (off_) + 1024); \
        dst = (v8i_t){(int)lo_.x, (int)lo_.y, (int)lo_.z, (int)lo_.w, (int)hi_.x, (int)hi_.y, (int)hi_.z, (int)hi_.w}; } while (0)
#define PG8_LDA(dst, b, h) do { _Pragma("unroll") for (int m = 0; m < 4; ++m) PG8_LD2(dst[m], PG8_SA(b, h) + aoff + m * 2048); } while (0)
#define PG8_LDB(dst, b, h) do { _Pragma("unroll") for (int n = 0; n < 2; ++n) PG8_LD2(dst[n], PG8_SB(b, h) + boff + n * 2048); } while (0)
#define PG8_HALF(v, k) ((k) ? __builtin_shufflevector(v, v, 4, 5, 6, 7) : __builtin_shufflevector(v, v, 0, 1, 2, 3))
#define PG8_MMA(ai, bj, At, Bt) do { __builtin_amdgcn_s_setprio(1); _Pragma("unroll") for (int m = 0; m < 4; ++m) _Pragma("unroll") for (int n = 0; n < 2; ++n) { \
        if constexpr (FP8) asm volatile("v_mfma_scale_f32_16x16x128_f8f6f4 %0, %1, %2, %0, %3, %4 op_sel_hi:[0,0,0]" : "+v"(acc[ai][bj][m][n]) : "v"(Bt[n]), "v"(At[m]), "v"(sc_w), "v"(sc_x));     \
        else { _Pragma("unroll") for (int k = 0; k < 2; ++k) { const v4i_t bh_ = PG8_HALF(Bt[n], k), ah_ = PG8_HALF(At[m], k); \
                acc[ai][bj][m][n] = __builtin_amdgcn_mfma_f32_16x16x32_bf16(__builtin_bit_cast(bf16x8, bh_), __builtin_bit_cast(bf16x8, ah_), acc[ai][bj][m][n], 0, 0, 0); } } } \
        __builtin_amdgcn_s_setprio(0); } while (0)
#define PG8_WAIT_V(n) asm volatile("s_waitcnt vmcnt(" #n ")" ::: "memory")
#define PG8_WAIT_L(n) asm volatile("s_waitcnt lgkmcnt(" #n ")" ::: "memory")
#define PG8_BAR __builtin_amdgcn_s_barrier()
#define PG8_SCHED __builtin_amdgcn_sched_barrier(0)
    Unit cur, nxt; int ui = 0;
    if (!S.next(0, cur)) return;
    f32x4 acc[2][2][4][2];
#pragma unroll
    for (int a = 0; a < 2; ++a)
#pragma unroll
        for (int b = 0; b < 2; ++b)
#pragma unroll
            for (int m = 0; m < 4; ++m)
#pragma unroll
                for (int n = 0; n < 2; ++n) acc[a][b][m][n] = (f32x4){0.f, 0.f, 0.f, 0.f};
    v8i_t At[4], B0[2], B1[2];
    const int sc_w = 121, sc_x = 127;
    const GAS char* cA = (const GAS char*)g.A + (size_t)cur.pm * tstepA + (size_t)cur.pn * g.acol * 2; const GAS char* cB = (const GAS char*)g.Bt + (size_t)cur.pn * tstepB;
    PG8_STAGE(PG8_SB(0, 0), cB, voffB); PG8_STAGE(PG8_SB(0, 1), cB + hstepB, voffB); PG8_STAGE(PG8_SA(0, 0), cA, voffA); PG8_STAGE(PG8_SA(0, 1), cA + hstepA, voffA);
    if (wr == 1) PG8_BAR;
    PG8_WAIT_V(2); PG8_BAR;
    PG8_STAGE(PG8_SB(1, 0), cB + kstep, voffB); PG8_STAGE(PG8_SA(1, 0), cA + kstep, voffA); PG8_STAGE(PG8_SB(1, 1), cB + hstepB + kstep, voffB);
    PG8_WAIT_V(6); PG8_BAR;
    for (;;) {
        const bool has_next = S.next(ui + 1, nxt);
        const GAS char* nA = has_next ? (const GAS char*)g.A + (size_t)nxt.pm * tstepA + (size_t)nxt.pn * g.acol * 2 : cA; const GAS char* nB = has_next ? (const GAS char*)g.Bt + (size_t)nxt.pn * tstepB : cB;
        for (int t = 0; t < nt; t += 2) {
            const bool last = (t == nt - 2);
            const GAS char* a1 = cA + (size_t)(t + 1) * kstep;
            const GAS char* a2 = last ? nA : cA + (size_t)(t + 2) * kstep; const GAS char* b2 = last ? nB : cB + (size_t)(t + 2) * kstep;
            const GAS char* a3 = a2 + kstep; const GAS char* b3 = b2 + kstep;
            PG8_LDB(B0, 0, 0); PG8_LDB(B1, 0, 1); PG8_SCHED; PG8_LDA(At, 0, 0); PG8_STAGE(PG8_SA(1, 1), a1 + hstepA, voffA);
            PG8_WAIT_V(8); PG8_WAIT_L(0); PG8_BAR; PG8_MMA(0, 0, At, B0); PG8_MMA(0, 1, At, B1); PG8_BAR; PG8_SCHED;
            PG8_LDA(At, 0, 1); PG8_STAGE(PG8_SB(0, 0), b2, voffB); PG8_STAGE(PG8_SB(0, 1), b2 + hstepB, voffB); PG8_STAGE(PG8_SA(0, 0), a2, voffA);
            PG8_WAIT_V(8); PG8_WAIT_L(0); PG8_BAR; PG8_MMA(1, 0, At, B0); PG8_MMA(1, 1, At, B1); PG8_BAR; PG8_SCHED;
            PG8_LDB(B0, 1, 0); PG8_LDB(B1, 1, 1); PG8_SCHED; PG8_LDA(At, 1, 0); PG8_STAGE(PG8_SA(0, 1), a2 + hstepA, voffA);
            PG8_WAIT_V(8); PG8_WAIT_L(0); PG8_BAR; PG8_MMA(0, 0, At, B0); PG8_MMA(0, 1, At, B1); PG8_BAR; PG8_SCHED;
            PG8_LDA(At, 1, 1); PG8_STAGE(PG8_SB(1, 0), b3, voffB); PG8_STAGE(PG8_SB(1, 1), b3 + hstepB, voffB); PG8_STAGE(PG8_SA(1, 0), a3, voffA);
            PG8_WAIT_V(8); PG8_WAIT_L(0); PG8_BAR; PG8_MMA(1, 0, At, B0); PG8_MMA(1, 1, At, B1); PG8_BAR; PG8_SCHED;
        }
        if (wr == 0) PG8_BAR;
        { int ln_; asm volatile("v_mbcnt_lo_u32_b32 %0, -1, 0\n\tv_mbcnt_hi_u32_b32 %0, -1, %0" : "=v"(ln_));
          E(acc, cur, wr, wc, ln_ & 15, ln_ >> 4); }
        if (!has_next) break;
#pragma unroll
        for (int a = 0; a < 2; ++a)
#pragma unroll
            for (int b = 0; b < 2; ++b)
#pragma unroll
                for (int m = 0; m < 4; ++m)
#pragma unroll
                    for (int n = 0; n < 2; ++n) acc[a][b][m][n] = (f32x4){0.f, 0.f, 0.f, 0.f};
        cur = nxt; cA = nA; cB = nB; ++ui;
        if (wr == 1) PG8_BAR;
    }
    PG8_WAIT_V(0);
    PG8_BAR;
#undef PG8_SA
#undef PG8_SB
#undef PG8_STAGE
#undef PG8_LDA
#undef PG8_LDB
#undef PG8_LD2
#undef PG8_HALF
#undef PG8_MMA
#undef PG8_WAIT_V
#undef PG8_WAIT_L
#undef PG8_BAR
#undef PG8_SCHED
}
}

enum { EM_IN0 = 0, EM_MKV = 1, EM_GATE = 2, EM_RES = 3, EM_PQ = 4, EM_L1 = 5 };
struct Epi {
    int mode;
    GAS unsigned char* ws;
    const GAS float* resid;
    GAS float* outf;
    GAS bf16_t* o16;
    GAS float* ssq;
    const GAS float* gate_b;
    typedef pg8::Unit Unit;
    __device__ __forceinline__ static void st8(GAS bf16_t* p, f32x4 v0, f32x4 v1) {
        u32x4 w; w.x = cvtpk(v0[0], v0[1]); w.y = cvtpk(v0[2], v0[3]); w.z = cvtpk(v1[0], v1[1]); w.w = cvtpk(v1[2], v1[3]); *(GAS u32x4*)p = w; }
    __device__ __forceinline__ static float sq8(f32x4 a, f32x4 b) { return (a[0] * a[0] + a[1] * a[1]) + (a[2] * a[2] + a[3] * a[3]) + (b[0] * b[0] + b[1] * b[1]) + (b[2] * b[2] + b[3] * b[3]); }
    __device__ __forceinline__ void operator()(f32x4 (&acc)[2][2][4][2], const Unit& u, int wr, int wc, int fr, int fq) const {
        const int row0 = u.pm * 256 + wr * 64 + fr;
        const int cin = wc * 32 + 8 * fq;
        if (mode == EM_IN0) {
            GAS bf16_t* base; int ld, colt; int kind;
            if (u.pn < 6) { base = (GAS bf16_t*)(ws + O_ZX); ld = LRU; colt = u.pn * 256; kind = 0; }
            else if (u.pn < 12) { base = (GAS bf16_t*)(ws + O_GY); ld = LRU; colt = (u.pn - 6) * 256; kind = 1; }
            else { base = (GAS bf16_t*)(ws + O_ZL1); ld = NL1; colt = 4608 + (u.pn - 12) * 256; kind = 2; }
            GAS float* qmss = (GAS float*)(ws + O_SSL1);
#pragma unroll
            for (int ai = 0; ai < 2; ++ai)
#pragma unroll
                for (int m = 0; m < 4; ++m) { const int row = row0 + ai * 128 + m * 16;
#pragma unroll
                    for (int bj = 0; bj < 2; ++bj) { f32x4 v0 = acc[ai][bj][m][0], v1 = acc[ai][bj][m][1];
                        if (kind == 1) {
#pragma unroll
                            for (int j = 0; j < 4; ++j) { v0[j] = gelu_tanh(v0[j]); v1[j] = gelu_tanh(v1[j]); } }
                        st8(base + (size_t)row * ld + colt + bj * 128 + cin, v0, v1);
                        if (kind == 2) { float s = sq8(v0, v1); s = xsum16(s); s = xsum32(s);
                            if (fq == 0) qmss[(size_t)row * 112 + (24 + (u.pn - 12) * 2 + bj) * 4 + wc] = s; } } }
        } else if (mode == EM_MKV) {
#pragma unroll
            for (int ai = 0; ai < 2; ++ai)
#pragma unroll
                for (int m = 0; m < 4; ++m) { const int row = row0 + ai * 128 + m * 16;
#pragma unroll
                    for (int bj = 0; bj < 2; ++bj) { const f32x4 v0 = acc[ai][bj][m][0], v1 = acc[ai][bj][m][1];
                        st8(o16 + (size_t)row * NL1 + u.pn * 256 + bj * 128 + cin, v0, v1);
                        if (u.pn < 2) { float s = sq8(v0, v1); s = xsum16(s); s = xsum32(s);
                            if (fq == 0) ssq[(size_t)row * 112 + (u.pn * 2 + bj) * 4 + wc] = s; } } }
        } else if (mode == EM_GATE) {
            const int ch = u.pn * 128 + cin;
            const GAS bf16_t* xc = (const GAS bf16_t*)(ws + O_XC); GAS _Float16* LA = (GAS _Float16*)(ws + O_AA); GAS _Float16* UH = (GAS _Float16*)(ws + O_UU);
            const GAS float* spl = (const GAS float*)(ws + O_SPL) + ch; const GAS float* gb = gate_b + u.pn * 256 + cin;
#pragma unroll
            for (int n = 0; n < 2; ++n) {
                const f32x4 sp = *(const GAS f32x4*)(spl + 4 * n), br = *(const GAS f32x4*)(gb + 4 * n), bi = *(const GAS f32x4*)(gb + 128 + 4 * n);
#pragma unroll
                for (int ai = 0; ai < 2; ++ai)
#pragma unroll
                    for (int m = 0; m < 4; ++m) { const int row = row0 + ai * 128 + m * 16;
                        const u32x2 xw = *(const GAS u32x2*)(xc + (size_t)row * LRU + ch + 4 * n);
                        const f32x4 xv = {bf_lo(xw.x), bf_hi(xw.x), bf_lo(xw.y), bf_hi(xw.y)};
                        float lav[4], uvv[4];
#pragma unroll
                        for (int j = 0; j < 4; ++j) { const float r = sigmoidf_(acc[ai][0][m][n][j] + br[j]), ig = sigmoidf_(acc[ai][1][m][n][j] + bi[j]);
                            const float la = -8.f * r * sp[j];
                            lav[j] = la; uvv[j] = __builtin_amdgcn_sqrtf(one_minus_exp(2.f * la)) * (ig * xv[j]); }
                        { const h2 l0 = {(_Float16)lav[0], (_Float16)lav[1]}, l1 = {(_Float16)lav[2], (_Float16)lav[3]}, u0 = {(_Float16)uvv[0], (_Float16)uvv[1]}, u1 = {(_Float16)uvv[2], (_Float16)uvv[3]};
                          *(GAS u32x2*)(LA + (size_t)row * LRU + ch + 4 * n) = (u32x2){__builtin_bit_cast(unsigned, l0), __builtin_bit_cast(unsigned, l1)};
                          *(GAS u32x2*)(UH + (size_t)row * LRU + ch + 4 * n) = (u32x2){__builtin_bit_cast(unsigned, u0), __builtin_bit_cast(unsigned, u1)}; } }
            }
        } else if (mode == EM_RES) {
            GAS bf16_t* xs = (GAS bf16_t*)(ws + O_XS16); GAS float* rowss = (GAS float*)(ws + O_ROWSS);
#pragma unroll
            for (int ai = 0; ai < 2; ++ai)
#pragma unroll
                for (int m = 0; m < 4; ++m) { const int row = row0 + ai * 128 + m * 16; float s = 0.f;
#pragma unroll
                    for (int bj = 0; bj < 2; ++bj) { const size_t off = (size_t)row * DM + u.pn * 256 + bj * 128 + cin;
                        f32x4 r0, r1;
                        if (resid) { r0 = *(const GAS f32x4*)(resid + off); r1 = *(const GAS f32x4*)(resid + off + 4); }
                        else { const u32x4 w = *(const GAS u32x4*)(xs + off); r0 = (f32x4){bf_lo(w.x), bf_hi(w.x), bf_lo(w.y), bf_hi(w.y)}; r1 = (f32x4){bf_lo(w.z), bf_hi(w.z), bf_lo(w.w), bf_hi(w.w)}; }
                        const f32x4 v0 = acc[ai][bj][m][0] + r0, v1 = acc[ai][bj][m][1] + r1;
                        st8(xs + off, v0, v1); s += sq8(v0, v1); }
                    s = xsum16(s); s = xsum32(s);
                    if (fq == 0) rowss[(size_t)row * 32 + u.pn * 4 + wc] = s; }
        } else if (mode == EM_PQ) {
            const GAS float* rowss = (const GAS float*)(ws + O_ROWSS);
#pragma unroll
            for (int ai = 0; ai < 2; ++ai)
#pragma unroll
                for (int m = 0; m < 4; ++m) { const int row = row0 + ai * 128 + m * 16;
                    const f32x4 p0 = *(const GAS f32x4*)(rowss + (size_t)row * 32 + fq * 8), p1 = *(const GAS f32x4*)(rowss + (size_t)row * 32 + fq * 8 + 4);
                    float s = (p0[0] + p0[1]) + (p0[2] + p0[3]) + (p1[0] + p1[1]) + (p1[2] + p1[3]); s = xsum16(s); s = xsum32(s);
                    const float r = rsqrtf(s * (1.f / DM) + EPS);
#pragma unroll
                    for (int bj = 0; bj < 2; ++bj) st8(o16 + (size_t)row * DM + u.pn * 256 + bj * 128 + cin, acc[ai][bj][m][0] * r, acc[ai][bj][m][1] * r); }
        } else {
            const GAS float* rsp = (const GAS float*)(ws + O_RSP); GAS bf16_t* zl1 = (GAS bf16_t*)(ws + O_ZL1); GAS float* ssl1 = (GAS float*)(ws + O_SSL1);
            const int slot0 = u.pn < 6 ? u.pn * 2 : (u.pn >= 12 ? 12 + (u.pn - 12) * 2 : -1);
#pragma unroll
            for (int ai = 0; ai < 2; ++ai)
#pragma unroll
                for (int m = 0; m < 4; ++m) { const int row = row0 + ai * 128 + m * 16;
                    const f32x4 q0 = *(const GAS f32x4*)(rsp + (size_t)row * 8), q1 = *(const GAS f32x4*)(rsp + (size_t)row * 8 + 4);
                    const float r = rsqrtf(((q0[0] + q0[1]) + (q0[2] + q0[3]) + (q1[0] + q1[1]) + (q1[2] + q1[3])) * (1.f / DM) + EPS);
#pragma unroll
                    for (int bj = 0; bj < 2; ++bj) { const f32x4 v0 = acc[ai][bj][m][0] * r, v1 = acc[ai][bj][m][1] * r;
                        st8(zl1 + (size_t)row * NL1 + u.pn * 256 + bj * 128 + cin, v0, v1);
                        if (slot0 >= 0) { float s = sq8(v0, v1); s = xsum16(s); s = xsum32(s);
                            if (fq == 0) ssl1[(size_t)row * 112 + (slot0 + bj) * 4 + wc] = s; } } }
        }
    }
};

namespace att {
constexpr float SCALE = 0.08838834764831845f;
constexpr int NW = 8, QBLK = 32, KVBLK = 64, QB = NW * QBLK, D = 128;
constexpr int SHM_V = KVBLK * D * 2, SHM_K = KVBLK * D * 2;
constexpr int OFF_WS = 2 * SHM_V + 2 * SHM_K;
constexpr int OFF_KS = OFF_WS + 2048;
constexpr int OFF_BS = OFF_KS + 16384;
constexpr int LDS_END = OFF_BS + 16384;
constexpr int WBIG = 1 << 28;

#define KSWZ(row, colB) ((row) * 256 + ((colB) ^ (((row) & 7) << 4)))
#define SBAR() __builtin_amdgcn_sched_barrier(0)
__device__ __forceinline__ int v_st(int k, int c) { const int kk = (k & ~0xC) | ((k & 4) << 1) | ((k & 8) >> 1); return ((kk >> 3) * 4 + (c >> 5)) * 512 + ((kk & 7) * 32 + (c & 31)) * 2; }
__device__ __forceinline__ int v_rd_base(int lane) { return ((lane & 3) << 3) | (((lane >> 2) & 3) << 6) | (((lane >> 4) & 1) << 5) | (((lane >> 5) & 1) << 8); }
constexpr int v_rd_off(int d0, int ks, int half) { return d0 * 512 + ks * 4096 + half * 2048; }
__device__ __forceinline__ int crow(int r, int hi) { return (r & 3) + 8 * (r >> 2) + 4 * hi; }
__device__ __forceinline__ bf16x8 load8(const GAS bf16_t* p) { return *(const GAS bf16x8*)p; }
__device__ __forceinline__ bf16x8 scale8(bf16x8 v, float s) { const u32x4 w = *reinterpret_cast<u32x4*>(&v); u32x4 o;
    o.x = cvtpk(bf_lo(w.x) * s, bf_hi(w.x) * s); o.y = cvtpk(bf_lo(w.y) * s, bf_hi(w.y) * s); o.z = cvtpk(bf_lo(w.z) * s, bf_hi(w.z) * s); o.w = cvtpk(bf_lo(w.w) * s, bf_hi(w.w) * s);
    return *reinterpret_cast<bf16x8*>(&o); }
__device__ __forceinline__ void mask_tile(f32x16& p0, f32x16& p1, int dq, unsigned W) {
    const float NEG = -__builtin_inff();
#pragma unroll
    for (int r = 0; r < 16; ++r) {
        const int c = (r & 3) + 8 * (r >> 2);
        if ((unsigned)(dq - c) >= W) p0[r] = NEG;
        if ((unsigned)(dq - c - 32) >= W) p1[r] = NEG;
    }
}
constexpr float THR = 8.f;
__device__ __forceinline__ void partialSM(f32x16& p0, f32x16& p1, float& m_reg, float& mn, float& alpha) {
    float pmax = p0[0]; for (int r = 1; r < 16; ++r) pmax = fmaxf(pmax, p0[r]); for (int r = 0; r < 16; ++r) pmax = fmaxf(pmax, p1[r]);
    { auto rr = __builtin_amdgcn_permlane32_swap(__float_as_uint(pmax), __float_as_uint(pmax), false, false);
      pmax = fmaxf(__uint_as_float(rr[0]), __uint_as_float(rr[1])); }
    constexpr float C2 = 1.4426950408889634f * SCALE;
    if (__builtin_expect(__all((pmax - m_reg) * SCALE <= THR), 1)) { mn = m_reg; alpha = 1.f; }
    else { mn = fmaxf(m_reg, pmax); alpha = __builtin_amdgcn_exp2f((m_reg - mn) * C2); m_reg = mn; }
    const float mnL = -mn * C2;
    for (int r = 0; r < 16; ++r) p0[r] = fmaf(p0[r], C2, mnL); for (int r = 0; r < 16; ++r) p1[r] = fmaf(p1[r], C2, mnL);
    for (int r = 0; r < 16; ++r) p0[r] = __builtin_amdgcn_exp2f(p0[r]);
}
__device__ __forceinline__ void finishSM(f32x16& p0, f32x16& p1, float alpha, float& l_reg, bf16x8& pa0, bf16x8& pa1, bf16x8& pa2, bf16x8& pa3) {
    for (int r = 0; r < 16; ++r) p1[r] = __builtin_amdgcn_exp2f(p1[r]);
    float ps = 0; for (int r = 0; r < 16; ++r) ps += p0[r]; for (int r = 0; r < 16; ++r) ps += p1[r];
    { auto rr = __builtin_amdgcn_permlane32_swap(__float_as_uint(ps), __float_as_uint(ps), false, false);
      ps = __uint_as_float(rr[0]) + __uint_as_float(rr[1]); }
    l_reg = l_reg * alpha + ps;
#define PK4(P, B_, OUT) do { unsigned a0 = cvtpk(P[B_+0], P[B_+1]), a1 = cvtpk(P[B_+2], P[B_+3]);                          \
        unsigned b0 = cvtpk(P[B_+4], P[B_+5]), b1 = cvtpk(P[B_+6], P[B_+7]);                                             \
        auto r0 = __builtin_amdgcn_permlane32_swap(a0, b0, false, false); auto r1 = __builtin_amdgcn_permlane32_swap(a1, b1, false, false); \
        u32x4 w = {r0[0], r1[0], r0[1], r1[1]}; OUT = *reinterpret_cast<bf16x8*>(&w); } while (0)
    PK4(p0, 0, pa0); PK4(p0, 8, pa1); PK4(p1, 0, pa2); PK4(p1, 8, pa3);
#undef PK4
}
template <int KB>
__device__ __forceinline__ void qkt(f32x16& p0, f32x16& p1, const char* K_lds, int r32, int hi, const bf16x8* qr, const float* bp  ) {
    { const f32x4 a = *(const f32x4*)(bp), b = *(const f32x4*)(bp + 8), c = *(const f32x4*)(bp + 16), d = *(const f32x4*)(bp + 24);
      p0 = (f32x16){a[0], a[1], a[2], a[3], b[0], b[1], b[2], b[3], c[0], c[1], c[2], c[3], d[0], d[1], d[2], d[3]}; }
    { const f32x4 a = *(const f32x4*)(bp + 32), b = *(const f32x4*)(bp + 40), c = *(const f32x4*)(bp + 48), d = *(const f32x4*)(bp + 56);
      p1 = (f32x16){a[0], a[1], a[2], a[3], b[0], b[1], b[2], b[3], c[0], c[1], c[2], c[3], d[0], d[1], d[2], d[3]}; }
    const char* kb[4];
#pragma unroll
    for (int dd = 0; dd < 4; ++dd) kb[dd] = K_lds + KB * SHM_K + KSWZ(r32, (dd * 16 + hi * 8) * 2);
#pragma unroll
    for (int d0 = 0; d0 < 8; ++d0) { const char* a = kb[d0 & 3] + (d0 >> 2) * 128;
        bf16x8 b0 = *reinterpret_cast<const bf16x8*>(a);
        bf16x8 b1 = *reinterpret_cast<const bf16x8*>(a + 32 * 256);
        p0 = __builtin_amdgcn_mfma_f32_32x32x16_bf16(b0, qr[d0], p0, 0, 0, 0);
        p1 = __builtin_amdgcn_mfma_f32_32x32x16_bf16(b1, qr[d0], p1, 0, 0, 0); }
}
template <int KB>
__device__ __forceinline__ void qkt0(f32x16& p0, f32x16& p1, const char* K_lds, int r32, int hi, const bf16x8* qr) {
    p0 = f32x16{}; p1 = f32x16{};
    const char* kb[4];
#pragma unroll
    for (int dd = 0; dd < 4; ++dd) kb[dd] = K_lds + KB * SHM_K + KSWZ(r32, (dd * 16 + hi * 8) * 2);
#pragma unroll
    for (int d0 = 0; d0 < 8; ++d0) { const char* a = kb[d0 & 3] + (d0 >> 2) * 128;
        bf16x8 b0 = *reinterpret_cast<const bf16x8*>(a);
        bf16x8 b1 = *reinterpret_cast<const bf16x8*>(a + 32 * 256);
        p0 = __builtin_amdgcn_mfma_f32_32x32x16_bf16(b0, qr[d0], p0, 0, 0, 0);
        p1 = __builtin_amdgcn_mfma_f32_32x32x16_bf16(b1, qr[d0], p1, 0, 0, 0); }
}
template <int VB>
__device__ __forceinline__ void pv_tile(f32x16* o, int vb0, bf16x8 pa0, bf16x8 pa1, bf16x8 pa2, bf16x8 pa3) {
#define TRRD(dst, off) asm volatile("ds_read_b64_tr_b16 %0, %1 offset:%2" : "=&v"(dst) : "v"(vb0), "i"(off) : "memory")
#define PV_D0(d0) do { s16x4 l0, l1, l2, l3, h0, h1, h2_, h3; constexpr int b_ = VB * SHM_V + v_rd_off(d0, 0, 0); \
        TRRD(l0, b_); TRRD(h0, b_ + 2048); TRRD(l1, b_ + 4096); TRRD(h1, b_ + 6144); TRRD(l2, b_ + 8192); TRRD(h2_, b_ + 10240); TRRD(l3, b_ + 12288); TRRD(h3, b_ + 14336); \
        asm volatile("s_waitcnt lgkmcnt(0)" ::: "memory"); SBAR();   \
        o[d0] = __builtin_amdgcn_mfma_f32_32x32x16_bf16(pa0, (bf16x8){l0[0], l0[1], l0[2], l0[3], h0[0], h0[1], h0[2], h0[3]}, o[d0], 0, 0, 0);   \
        o[d0] = __builtin_amdgcn_mfma_f32_32x32x16_bf16(pa1, (bf16x8){l1[0], l1[1], l1[2], l1[3], h1[0], h1[1], h1[2], h1[3]}, o[d0], 0, 0, 0);   \
        o[d0] = __builtin_amdgcn_mfma_f32_32x32x16_bf16(pa2, (bf16x8){l2[0], l2[1], l2[2], l2[3], h2_[0], h2_[1], h2_[2], h2_[3]}, o[d0], 0, 0, 0);   \
        o[d0] = __builtin_amdgcn_mfma_f32_32x32x16_bf16(pa3, (bf16x8){l3[0], l3[1], l3[2], l3[3], h3[0], h3[1], h3[2], h3[3]}, o[d0], 0, 0, 0); } while (0)
    PV_D0(0); PV_D0(1); PV_D0(2); PV_D0(3);
#undef PV_D0
#undef TRRD
}

struct BlockRef { const GAS bf16_t* Q; const GAS bf16_t* K; const GAS bf16_t* V; GAS bf16_t* O; const GAS float* qss; const GAS float* kss; const GAS float* cc; const GAS float* gg;
                  int P0, skv; };
constexpr int LDQ = 5120, LDK = 5120, LDO = 2048, LDSS = 112;
struct Seam { bf16x8 qr[8]; bf16x8 st_v0, st_v1, st_k0, st_k1; int jlo; };
#define ROWK(p, k0, rr) ((p) + (size_t)((k0) + (rr)) * LDK + sc)
#define VMW() asm volatile("s_waitcnt vmcnt(0)" ::: "memory")
#define VMWN(n) asm volatile("s_waitcnt vmcnt(%0)" :: "i"(n) : "memory")
#define SLOAD_H(Kp, Vp, k0) do { S.st_v0 = load8(ROWK(Vp, k0, sr)); S.st_v1 = load8(ROWK(Vp, k0, 32 + sr));              \
                         S.st_k0 = load8(ROWK(Kp, k0, sr)); S.st_k1 = load8(ROWK(Kp, k0, 32 + sr)); } while (0)
#define SWRITE_HK(bf, k0) do { *(bf16x8*)(K_lds + (bf) * SHM_K + kws) = scale8(S.st_k0, ksr[(k0)]); *(bf16x8*)(K_lds + (bf) * SHM_K + kws + 32 * 256) = scale8(S.st_k1, ksr[(k0) + 32]); } while (0)
#define SWRITE_HV(bf) do { *(bf16x8*)(V_lds + (bf) * SHM_V + vst0) = S.st_v0; *(bf16x8*)(V_lds + (bf) * SHM_V + vst1) = S.st_v1; } while (0)
#define SWRITE_H(bf, k0) do { SWRITE_HV(bf); SWRITE_HK(bf, k0); } while (0)

__device__ __forceinline__ void attn_prime(const BlockRef& cur, char* lds, Seam& S, const int tid) {
    const int wid = __builtin_amdgcn_readfirstlane(tid >> 6), lane = tid & 63, r32 = lane & 31, hi = lane >> 5;
    const int sr = tid >> 4, sc = (tid & 15) * 8, kws = KSWZ(sr, sc * 2); char* K_lds = lds + 2 * SHM_V;
    float* ks_l = (float*)(lds + OFF_KS); float* bs_l = (float*)(lds + OFF_BS); const float* ksr = ks_l + sr;
    int j_hi = (cur.P0 + QB - 1) / KVBLK + 1; if (j_hi > cur.skv / KVBLK) j_hi = cur.skv / KVBLK;
    const int nkeys = j_hi * KVBLK;
    const float c0 = cur.cc ? cur.cc[cur.P0] : 0.f;
    int jlo = 0;
    if (cur.cc) { const float thr = cur.gg[128]; const int jd = cur.P0 / KVBLK;
        const float cv = lane <= jd ? cur.cc[lane * KVBLK + KVBLK - 1] : 0.f;
        const bool keep = lane > jd || (c0 - cv > -thr);
        jlo = __ffsll((long long)__ballot(keep)) - 1; }
    S.jlo = jlo;
    for (int s = jlo * KVBLK + tid; s < nkeys; s += NTHREADS) {
        const f32x4 p = *(const GAS f32x4*)(cur.kss + (size_t)s * LDSS);
        ks_l[s] = rsqrtf(((p[0] + p[1]) + (p[2] + p[3])) * (1.f / 128.f) + EPS);
        bs_l[s] = cur.cc ? (c0 - cur.cc[s]) * (1.f / SCALE) : 0.f;
    }
    __syncthreads();
    const int qrow = wid * QBLK + r32;
    const f32x4 qp = *(const GAS f32x4*)(cur.qss + (size_t)qrow * LDSS);
    const float rq = rsqrtf(((qp[0] + qp[1]) + (qp[2] + qp[3])) * (1.f / 128.f) + EPS);
#pragma unroll
    for (int d0 = 0; d0 < 8; ++d0) {
        const u32x4 w = *(const GAS u32x4*)(cur.Q + (size_t)qrow * LDQ + d0 * 16 + hi * 8);
        const f32x4 g0 = *(const GAS f32x4*)(cur.gg + d0 * 16 + hi * 8), g1 = *(const GAS f32x4*)(cur.gg + d0 * 16 + hi * 8 + 4);
        u32x4 o; o.x = cvtpk(bf_lo(w.x) * rq * g0[0], bf_hi(w.x) * rq * g0[1]); o.y = cvtpk(bf_lo(w.y) * rq * g0[2], bf_hi(w.y) * rq * g0[3]);
        o.z = cvtpk(bf_lo(w.z) * rq * g1[0], bf_hi(w.z) * rq * g1[1]); o.w = cvtpk(bf_lo(w.w) * rq * g1[2], bf_hi(w.w) * rq * g1[3]);
        S.qr[d0] = *reinterpret_cast<bf16x8*>(&o);
    }
    SLOAD_H(cur.K, cur.V, jlo * KVBLK); VMW(); SWRITE_HK(0, jlo * KVBLK);
    __syncthreads();
}
__device__ __forceinline__ void attn_block(const BlockRef& cur, char* lds, Seam& S, const int tid) {
    const int wid = __builtin_amdgcn_readfirstlane(tid >> 6), lane = tid & 63, r32 = lane & 31, hi = lane >> 5;
    const int W = WBIG;
    int j_hi = (cur.P0 + QB - 1) / KVBLK + 1; if (j_hi > cur.skv / KVBLK) j_hi = cur.skv / KVBLK;
    const int j_lo = S.jlo; const int NT = j_hi - j_lo;
    const int qlo = cur.P0 - j_lo * KVBLK + wid * QBLK, qm = qlo + r32 - 4 * hi;
    char* V_lds = lds; char* K_lds = lds + 2 * SHM_V;
    float* ws = (float*)(lds + OFF_WS) + wid * 64; float* li_l = ws, * al_l = ws + 32;
    const float* bs_l = (const float*)(lds + OFF_BS) + j_lo * KVBLK + 4 * hi;
    float m_reg = -1e30f, l_reg = 0; f32x16 o[4] = {};
    const int sr = tid >> 4, sc = (tid & 15) * 8, vst0 = v_st(sr, sc), vst1 = v_st(32 + sr, sc), kws = KSWZ(sr, sc * 2);
    const float* ksr = (const float*)(lds + OFF_KS) + j_lo * KVBLK + sr;
    const int vb0 = (int)(uintptr_t)V_lds + v_rd_base(lane);
    const GAS bf16_t* Kh = cur.K + (size_t)j_lo * KVBLK * LDK; const GAS bf16_t* Vh = cur.V + (size_t)j_lo * KVBLK * LDK;
#define RESC(a) do { if (__any((a) < 1.f)) { if (hi == 0) al_l[r32] = (a); asm volatile("s_waitcnt lgkmcnt(0)" ::: "memory");              \
                     for (int d_ = 0; d_ < 4; ++d_) for (int r = 0; r < 16; ++r) o[d_][r] *= al_l[crow(r, hi)]; } } while (0)
#define KBASE(t) ((t) * KVBLK)
#define MASKT(P0_, P1_, t) do { const int kb_ = KBASE(t); if (kb_ + KVBLK - 1 > qlo) mask_tile(P0_, P1_, qm - kb_, (unsigned)W); } while (0)
    f32x16 pA0, pA1, pB0, pB1; float mnA, mnB, alA, alB; bf16x8 pa0, pa1, pa2, pa3;
    SWRITE_HV(0); SBAR();
    if (NT > 1) { SLOAD_H(Kh, Vh, KBASE(1)); }
    SBAR(); qkt<0>(pA0, pA1, K_lds, r32, hi, S.qr, bs_l + KBASE(0));
    MASKT(pA0, pA1, 0); partialSM(pA0, pA1, m_reg, mnA, alA);
    if (NT > 1) { VMW(); SWRITE_H(1, KBASE(1)); }
    __syncthreads();
#define HALF_STEP(PX0, PX1, mnX, alX, PY0, PY1, alY, t, KB, VB, SB) do {                                                      \
        SBAR(); qkt<KB>(PX0, PX1, K_lds, r32, hi, S.qr, bs_l + KBASE(t));                                                         \
        finishSM(PY0, PY1, alY, l_reg, pa0, pa1, pa2, pa3); SBAR();                                                           \
        if ((t) + 1 < NT) { SLOAD_H(Kh, Vh, KBASE((t) + 1)); SBAR(); }                                               \
        pv_tile<VB>(o, vb0, pa0, pa1, pa2, pa3); MASKT(PX0, PX1, (t)); partialSM(PX0, PX1, m_reg, mnX, alX);                                        \
        __syncthreads();                                                                                                      \
        if ((t) + 1 < NT) { VMW(); SWRITE_H(SB, KBASE((t) + 1)); }                                                                          \
        RESC(alX); __syncthreads(); } while (0)
    for (int t = 1; t + 1 < NT; t += 2) {
        HALF_STEP(pB0, pB1, mnB, alB, pA0, pA1, alA, t, 1, 0, 0);
        HALF_STEP(pA0, pA1, mnA, alA, pB0, pB1, alB, t + 1, 0, 1, 1);
    }
    const bool even = (NT & 1) == 0;
    if (even) { SBAR(); qkt<1>(pB0, pB1, K_lds, r32, hi, S.qr, bs_l + KBASE(NT - 1)); SBAR(); }
    finishSM(pA0, pA1, alA, l_reg, pa0, pa1, pa2, pa3); SBAR();
    pv_tile<0>(o, vb0, pa0, pa1, pa2, pa3);
    if (even) { MASKT(pB0, pB1, NT - 1); partialSM(pB0, pB1, m_reg, mnB, alB); __syncthreads(); RESC(alB);
        finishSM(pB0, pB1, alB, l_reg, pa0, pa1, pa2, pa3); SBAR(); pv_tile<1>(o, vb0, pa0, pa1, pa2, pa3); }
    SBAR();
    if (hi == 0) li_l[r32] = l_reg; asm volatile("s_waitcnt lgkmcnt(0)" ::: "memory");
    float rli[16];
#pragma unroll
    for (int r = 0; r < 16; ++r) rli[r] = __builtin_amdgcn_rcpf(li_l[crow(r, hi)]);
    GAS bf16_t* Ow = cur.O + (size_t)(wid * QBLK) * LDO;
#pragma unroll
    for (int r = 0; r < 16; ++r) { const int orow = crow(r, hi);
#pragma unroll
        for (int d0 = 0; d0 < 4; ++d0) { const float v = o[d0][r] * rli[r];
            const float vn = dppf<0xB1>(v);
            if ((r32 & 1) == 0) *(GAS unsigned*)(Ow + (size_t)orow * LDO + d0 * 32 + r32) = cvtpk(v, vn); } }
    __syncthreads();
#undef RESC
#undef KBASE
#undef MASKT
#undef HALF_STEP
}
constexpr int MOFF_K = 4 * SHM_V, MOFF_WS = MOFF_K + 4 * SHM_K, MOFF_KS = MOFF_WS + 2048;
__device__ __forceinline__ void mem_attn_unit(const BlockRef& cur, char* lds, const int tid) {
    const int wid = __builtin_amdgcn_readfirstlane(tid >> 6), lane = tid & 63, r32 = lane & 31, hi = lane >> 5;
    const int sr = tid >> 4, sc = (tid & 15) * 8, kws = KSWZ(sr, sc * 2), vst0 = v_st(sr, sc), vst1 = v_st(32 + sr, sc);
    char* V_lds = lds; char* K_lds = lds + MOFF_K; float* ks_l = (float*)(lds + MOFF_KS);
    float* ws = (float*)(lds + MOFF_WS) + wid * 64; float* li_l = ws, * al_l = ws + 32;
    float ksv = 0.f;
    if (tid < 256) { const f32x4 p = *(const GAS f32x4*)(cur.kss + (size_t)tid * LDSS); ksv = rsqrtf(((p[0] + p[1]) + (p[2] + p[3])) * (1.f / 128.f) + EPS); }
    bf16x8 kk[4][2], vv[4][2];
#pragma unroll
    for (int t = 0; t < 4; ++t) { kk[t][0] = load8(ROWK(cur.K, t * KVBLK, sr)); kk[t][1] = load8(ROWK(cur.K, t * KVBLK, 32 + sr)); vv[t][0] = load8(ROWK(cur.V, t * KVBLK, sr)); vv[t][1] = load8(ROWK(cur.V, t * KVBLK, 32 + sr)); }
    const int qrow = wid * QBLK + r32;
    const f32x4 qp = *(const GAS f32x4*)(cur.qss + (size_t)qrow * LDSS);
    u32x4 qw[8];
#pragma unroll
    for (int d0 = 0; d0 < 8; ++d0) qw[d0] = *(const GAS u32x4*)(cur.Q + (size_t)qrow * LDQ + d0 * 16 + hi * 8);
    if (tid < 256) ks_l[tid] = ksv;
    __syncthreads();
#pragma unroll
    for (int t = 0; t < 4; ++t) { *(bf16x8*)(K_lds + t * SHM_K + kws) = scale8(kk[t][0], ks_l[t * KVBLK + sr]); *(bf16x8*)(K_lds + t * SHM_K + kws + 32 * 256) = scale8(kk[t][1], ks_l[t * KVBLK + 32 + sr]);
        *(bf16x8*)(V_lds + t * SHM_V + vst0) = vv[t][0]; *(bf16x8*)(V_lds + t * SHM_V + vst1) = vv[t][1]; }
    const float rq = rsqrtf(((qp[0] + qp[1]) + (qp[2] + qp[3])) * (1.f / 128.f) + EPS);
    bf16x8 qr[8];
#pragma unroll
    for (int d0 = 0; d0 < 8; ++d0) { const u32x4 w = qw[d0];
        const f32x4 g0 = *(const GAS f32x4*)(cur.gg + d0 * 16 + hi * 8), g1 = *(const GAS f32x4*)(cur.gg + d0 * 16 + hi * 8 + 4);
        u32x4 o; o.x = cvtpk(bf_lo(w.x) * rq * g0[0], bf_hi(w.x) * rq * g0[1]); o.y = cvtpk(bf_lo(w.y) * rq * g0[2], bf_hi(w.y) * rq * g0[3]);
        o.z = cvtpk(bf_lo(w.z) * rq * g1[0], bf_hi(w.z) * rq * g1[1]); o.w = cvtpk(bf_lo(w.w) * rq * g1[2], bf_hi(w.w) * rq * g1[3]);
        qr[d0] = *reinterpret_cast<bf16x8*>(&o); }
    __syncthreads();
    const int vb0 = (int)(uintptr_t)V_lds + v_rd_base(lane);
    float m_reg = -1e30f, l_reg = 0; f32x16 o[4] = {};
#define MEM_TILE(t) do { f32x16 p0, p1; float mn, al; bf16x8 pa0, pa1, pa2, pa3; \
        qkt0<t>(p0, p1, K_lds, r32, hi, qr); partialSM(p0, p1, m_reg, mn, al); \
        if (__any(al < 1.f)) { if (hi == 0) al_l[r32] = al; asm volatile("s_waitcnt lgkmcnt(0)" ::: "memory"); for (int d_ = 0; d_ < 4; ++d_) for (int r = 0; r < 16; ++r) o[d_][r] *= al_l[crow(r, hi)]; } \
        finishSM(p0, p1, al, l_reg, pa0, pa1, pa2, pa3); SBAR(); pv_tile<t>(o, vb0, pa0, pa1, pa2, pa3); SBAR(); } while (0)
    MEM_TILE(0); MEM_TILE(1); MEM_TILE(2); MEM_TILE(3);
#undef MEM_TILE
    if (hi == 0) li_l[r32] = l_reg; asm volatile("s_waitcnt lgkmcnt(0)" ::: "memory");
    float rli[16];
#pragma unroll
    for (int r = 0; r < 16; ++r) rli[r] = __builtin_amdgcn_rcpf(li_l[crow(r, hi)]);
    GAS bf16_t* Ow = cur.O + (size_t)(wid * QBLK) * LDO;
#pragma unroll
    for (int r = 0; r < 16; ++r) { const int orow = crow(r, hi);
#pragma unroll
        for (int d0 = 0; d0 < 4; ++d0) { const float v = o[d0][r] * rli[r];
            const float vn = dppf<0xB1>(v);
            if ((r32 & 1) == 0) *(GAS unsigned*)(Ow + (size_t)orow * LDO + d0 * 32 + r32) = cvtpk(v, vn); } }
    __syncthreads();
}
#undef ROWK
#undef VMW
#undef VMWN
#undef SLOAD_H
#undef SWRITE_HK
#undef SWRITE_HV
#undef SWRITE_H
#undef KSWZ
#undef SBAR
}


struct Frame {
    GAS unsigned char* ws; const float* const* in_; GAS float* out;
    __device__ __forceinline__ const GAS float* in(int i) const { return (const GAS float*)in_[i]; }
    int tid, lane, wave, gw, ngw, gtid, ngt;
};
enum { I_X = 0, I_MEM, I_ANORM, I_AWIN, I_ACONVW, I_ACONVB, I_AGATEW, I_AGATEB, I_ALAMBDA, I_AWOUT, I_SNORM, I_SWKVF, I_SBF, I_SKNORM, I_BNORM, I_BWIN, I_BQNORM, I_BWOUT,
       I_MNORM, I_MWKV, I_MQNORM, I_MKNORM, I_PNORM, I_PWQ, I_PSUBK, I_PU, I_PV, N_IN };

struct TrItem { const GAS float* W; const GAS float* gain; GAS bf16_t* WT; int ldw, ldt, row_off, k0, n0; };
__device__ __forceinline__ void tr_load(const TrItem& d, float (&wv)[32], int lane) {
#pragma unroll
    for (int i = 0; i < 32; ++i) wv[i] = __builtin_nontemporal_load(d.W + (size_t)(d.k0 + 2 * i + (lane >> 5)) * d.ldw + d.n0 + (lane & 31));
}
__device__ __forceinline__ void tr_proc(const TrItem& d, float (&wv)[32], LAS float* scr, int lane) {
    if (d.gain) {
#pragma unroll
        for (int i = 0; i < 32; ++i) wv[i] *= d.gain[d.k0 + 2 * i + (lane >> 5)]; }
#pragma unroll
    for (int i = 0; i < 32; ++i) scr[(2 * i + (lane >> 5)) * 33 + (lane & 31)] = wv[i];
    asm volatile("s_waitcnt lgkmcnt(0)" ::: "memory");
    const int c = lane & 7;
#pragma unroll
    for (int j = 0; j < 4; ++j) { const int n = (lane >> 3) + 8 * j; const LAS float* s = scr + (8 * c) * 33 + n;
        u32x4 o; o.x = cvtpk(s[0 * 33], s[1 * 33]); o.y = cvtpk(s[2 * 33], s[3 * 33]); o.z = cvtpk(s[4 * 33], s[5 * 33]); o.w = cvtpk(s[6 * 33], s[7 * 33]);
        *(GAS u32x4*)(d.WT + (size_t)(d.row_off + d.n0 + n) * d.ldt + d.k0 + 8 * c) = o; }
    asm volatile("s_waitcnt lgkmcnt(0)" ::: "memory");
}
__device__ __forceinline__ void transpose_item_fp8(const GAS float* W, int ldw, const GAS float* gain, GAS unsigned char* WT, int ldt, LAS float* scr, int nblk, int item, int lane) {
    const int kb = item / nblk, nb = item % nblk, k0 = 64 * kb, n0 = 32 * nb;
    float wv[32];
#pragma unroll
    for (int i = 0; i < 32; ++i) wv[i] = W[(size_t)(k0 + 2 * i + (lane >> 5)) * ldw + n0 + (lane & 31)];
#pragma unroll
    for (int i = 0; i < 32; ++i) wv[i] *= gain[k0 + 2 * i + (lane >> 5)] * 64.f;
#pragma unroll
    for (int i = 0; i < 32; ++i) scr[(2 * i + (lane >> 5)) * 33 + (lane & 31)] = wv[i];
    asm volatile("s_waitcnt lgkmcnt(0)" ::: "memory");
    const int c = lane & 3;
#pragma unroll
    for (int j = 0; j < 2; ++j) { const int n = (lane >> 2) + 16 * j; const LAS float* sp = scr + (16 * c) * 33 + n; u32x4 o;
#pragma unroll
        for (int w = 0; w < 4; ++w) { int pk = __builtin_amdgcn_cvt_pk_fp8_f32(sp[(4 * w) * 33], sp[(4 * w + 1) * 33], 0, false); pk = __builtin_amdgcn_cvt_pk_fp8_f32(sp[(4 * w + 2) * 33], sp[(4 * w + 3) * 33], pk, true); o[w] = (unsigned)pk; }
        *(GAS u32x4*)(WT + (size_t)(n0 + n) * ldt + k0 + 16 * c) = o; }
    asm volatile("s_waitcnt lgkmcnt(0)" ::: "memory");
}
struct CtRow { f32x4 v[8]; GAS unsigned char* dst; int row, which; };
__device__ __forceinline__ void ct_load(Frame& F, int layer, int it, CtRow& R) {
    R.which = it & 1; R.row = it >> 1;
    const GAS float* src = F.in(R.which ? I_PV : I_PU) + ((size_t)layer * NEXP + R.row) * DM + F.lane * 4;
    R.dst = F.ws + O_TAB + (size_t)(layer * 2 + R.which) * TAB_ONE;
#pragma unroll
    for (int c = 0; c < 8; ++c) R.v[c] = __builtin_nontemporal_load((const GAS f32x4*)(src + c * 256));
}
__device__ __forceinline__ void ct_proc(Frame& F, int layer, CtRow& R, const f32x4 (&gnr)[8]) {
    _Float16 shv = (_Float16)0.f;
#pragma unroll
    for (int c = 0; c < 8; ++c) { f32x4 x = R.v[c]; if (!R.which) x = x * gnr[c];
        float amax = fmaxf(fmaxf(fabsf(x[0]), fabsf(x[1])), fmaxf(fabsf(x[2]), fabsf(x[3])));
        amax = wave_max(amax);
        const _Float16 sh = (_Float16)fmaxf(amax * (1.f / 6.f), 1e-6f);
        const float qs = __builtin_amdgcn_rcpf((float)sh);
        unsigned pk = __builtin_amdgcn_cvt_scalef32_pk_fp4_f32(0u, x[0] * qs, x[1] * qs, 1.0f, 0); pk = __builtin_amdgcn_cvt_scalef32_pk_fp4_f32(pk, x[2] * qs, x[3] * qs, 1.0f, 1);
        *(GAS unsigned short*)(R.dst + ((size_t)c * NEXP + R.row) * 128 + F.lane * 2) = (unsigned short)pk;
        shv = (F.lane == c) ? sh : shv; }
    if (F.lane < 8) *(GAS unsigned short*)(R.dst + TAB_NIB + ((size_t)R.row * 8 + F.lane) * 2) = __builtin_bit_cast(unsigned short, shv);
}
__device__ __forceinline__ void convert_tables(Frame& F, int layer, int ibeg, int iend, int wk, int nwk) {
    if (ibeg + wk >= iend) return;
    const int ilast = ibeg + wk + ((iend - 1 - ibeg - wk) / nwk) * nwk;
    CtRow A, B;
    f32x4 gnr[8];
#pragma unroll
    for (int c = 0; c < 8; ++c) gnr[c] = *(const GAS f32x4*)(F.in(I_PNORM) + layer * DM + F.lane * 4 + c * 256);
    ct_load(F, layer, ibeg + wk, A);
    for (int it = ibeg + wk; it < iend; it += 2 * nwk) {
        ct_load(F, layer, it + nwk <= ilast ? it + nwk : ilast, B);
        ct_proc(F, layer, A, gnr);
        ct_load(F, layer, it + 2 * nwk <= ilast ? it + 2 * nwk : ilast, A);
        if (it + nwk < iend) ct_proc(F, layer, B, gnr);
    }
}
__device__ __forceinline__ void norm_row_bf16(const GAS float* xrow, const GAS float* gain, GAS bf16_t* orow, int lane) {
    f32x4 v[8]; float s = 0.f;
#pragma unroll
    for (int j = 0; j < 8; ++j) { v[j] = *(const GAS f32x4*)(xrow + j * 256 + lane * 4); s += (v[j][0] * v[j][0] + v[j][1] * v[j][1]) + (v[j][2] * v[j][2] + v[j][3] * v[j][3]); }
    const float r = rsqrtf(wave_sum(s) * (1.f / DM) + EPS);
#pragma unroll
    for (int j = 0; j < 8; ++j) { f32x4 g = gain ? *(const GAS f32x4*)(gain + j * 256 + lane * 4) : (f32x4){1.f, 1.f, 1.f, 1.f};
        u32x2 o; o.x = cvtpk(v[j][0] * r * g[0], v[j][1] * r * g[1]); o.y = cvtpk(v[j][2] * r * g[2], v[j][3] * r * g[3]);
        *(GAS u32x2*)(orow + j * 256 + lane * 4) = o; }
}
__device__ __forceinline__ void step_prologue(Frame& F, LAS unsigned char* lds) {
    LAS float* scr = (LAS float*)(lds + F.wave * 16384);
    GAS unsigned char* ws = F.ws;
    constexpr int I0 = 32 * (NIN0 / 32), I1 = 32 * 64, I2 = 32 * 96, I3 = 32 * 64, I4 = 32 * 64, I5 = 32 * 64, I6 = 32 * 64, I7 = 32 * 32, I8 = 32 * 32, I9 = 12 * 16;
    constexpr int NITEMS = I0 + I1 + I2 + I3 + I4 + I5 + I6 + I7 + I8 + I9;
#define TR_DESC(D, it_) do { int r = (it_) < NITEMS ? (it_) : NITEMS - 1; int nblk; \
        if (r < I0) { D = {F.in(I_AWIN), F.in(I_ANORM), (GAS bf16_t*)(ws + O_WIN0), NIN0, DM, 0, 0, 0}; nblk = NIN0 / 32; } else { r -= I0; \
        if (r < I1) { D = {F.in(I_AWOUT), nullptr, (GAS bf16_t*)(ws + O_WOUT0), DM, DM, 0, 0, 0}; nblk = 64; } else { r -= I1; \
        if (r < I2) { D = {F.in(I_SWKVF), F.in(I_SNORM), (GAS bf16_t*)(ws + O_WL1), 3084, DM, 0, 0, 0}; nblk = 96; } else { r -= I2; \
        if (r < I3) { D = {F.in(I_BWIN), F.in(I_BNORM), (GAS bf16_t*)(ws + O_WL1), DM, DM, 3072, 0, 0}; nblk = 64; } else { r -= I3; \
        if (r < I4) { D = {F.in(I_BWOUT), nullptr, (GAS bf16_t*)(ws + O_WOUT1), DM, DM, 0, 0, 0}; nblk = 64; } else { r -= I4; \
        if (r < I5) { D = {F.in(I_PWQ), F.in(I_PNORM), (GAS bf16_t*)(ws + O_WQ0), DM, DM, 0, 0, 0}; nblk = 64; } else { r -= I5; \
        if (r < I6) { D = {F.in(I_PWQ) + (size_t)DM * DM, F.in(I_PNORM) + DM, (GAS bf16_t*)(ws + O_WQ1), DM, DM, 0, 0, 0}; nblk = 64; } else { r -= I6; \
        if (r < I7) { D = {F.in(I_MWKV), nullptr, (GAS bf16_t*)(ws + O_WMKV), 1024, DM, 0, 0, 0}; nblk = 32; } else { r -= I7; \
        if (r < I8) { D = {F.in(I_MWKV) + (size_t)DM * 1024, nullptr, (GAS bf16_t*)(ws + O_WMKV) + (size_t)1024 * DM, 1024, DM, 0, 0, 0}; nblk = 32; } else { r -= I8; \
          const int blk = r / 16; r = r % 16; D = {F.in(I_AGATEW) + (size_t)blk * 128 * 256, nullptr, (GAS bf16_t*)(ws + O_WGATE), 256, 128, blk * 256, 0, 0}; nblk = 8; } } } } } } } } } \
        D.k0 = 64 * (r / nblk); D.n0 = 32 * (r % nblk); } while (0)
    for (int it = F.gw; it < NITEMS; it += F.ngw) { float wv[32]; TrItem d; TR_DESC(d, it); tr_load(d, wv, F.lane); tr_proc(d, wv, scr, F.lane); }
#undef TR_DESC
    { const GAS float* sk = F.in(I_PSUBK); GAS bf16_t* o = (GAS bf16_t*)(ws + O_SUBK);
      for (int i = F.gtid; i < 2 * 16 * 128 * 128 / 2; i += F.ngt) *(GAS unsigned*)(o + 2 * i) = cvtpk(sk[2 * i], sk[2 * i + 1]); }
    { GAS float* wf = (GAS float*)(ws + O_WF); const GAS float* w = F.in(I_SWKVF); const GAS float* g = F.in(I_SNORM);
      for (int i = F.gtid; i < 12 * DM; i += F.ngt) { const int j = i / DM, k = i % DM; wf[i] = w[(size_t)k * 3084 + 3072 + j] * g[k]; } }
    { GAS float* spl = (GAS float*)(ws + O_SPL); const GAS float* lam = F.in(I_ALAMBDA);
      for (int i = F.gtid; i < LRU; i += F.ngt) { const float z = -lam[i]; spl[i] = fmaxf(z, 0.f) + log1p_pos(fast_exp(-fabsf(z))); } }
    if (F.gw == 0) {
        float m = 0.f; for (int d = F.lane; d < 128; d += 64) m = fmaxf(m, fabsf(F.in(I_BQNORM)[d] * F.in(I_SKNORM)[d]));
        m = wave_max(m);
        if (F.lane == 0) ((GAS float*)(ws + O_GG))[512] = 2.f * 11.3137085f * m + 30.f; }
    { GAS float* gg = (GAS float*)(ws + O_GG);
      for (int i = F.gtid; i < 384; i += F.ngt) { const int a = i / 128, d = i % 128;
          gg[a == 0 ? 384 + d : i] = a == 0 ? F.in(I_BQNORM)[d] * F.in(I_SKNORM)[d] : F.in(I_MQNORM)[(a - 1) * 128 + d] * F.in(I_MKNORM)[(a - 1) * 128 + d]; } }
    {
        const GAS float* xin = F.in(I_X) + F.lane * 4; GAS bf16_t* xo = (GAS bf16_t*)(ws + O_XS16) + F.lane * 4;
        const int mlast = F.gw + ((T - 1 - F.gw) / F.ngw) * F.ngw;
#define XN_LOAD(V, m_) do { const int mm_ = (m_) <= mlast ? (m_) : mlast; _Pragma("unroll") for (int j = 0; j < 8; ++j) V[j] = __builtin_nontemporal_load((const GAS f32x4*)(xin + (size_t)mm_ * DM + j * 256)); } while (0)
#define XN_PROC(V, m_) do { if ((m_) < T) { float s0 = 0.f; _Pragma("unroll") for (int j = 0; j < 8; ++j) s0 += (V[j][0] * V[j][0] + V[j][1] * V[j][1]) + (V[j][2] * V[j][2] + V[j][3] * V[j][3]); \
            const float r0 = rsqrtf(wave_sum(s0) * (1.f / DM) + EPS); \
            _Pragma("unroll") for (int j = 0; j < 8; ++j) { u32x2 a; a.x = cvtpk(V[j][0] * r0, V[j][1] * r0); a.y = cvtpk(V[j][2] * r0, V[j][3] * r0); *(GAS u32x2*)(xo + (size_t)(m_) * DM + j * 256) = a; } } } while (0)
        f32x4 va[8], vb[8];
        XN_LOAD(va, F.gw);
        for (int m = F.gw; m < T; m += 2 * F.ngw) { XN_LOAD(vb, m + F.ngw); XN_PROC(va, m); XN_LOAD(va, m + 2 * F.ngw); XN_PROC(vb, m + F.ngw); }
#undef XN_LOAD
#undef XN_PROC
    }
    for (int m = F.gw; m < 2 * NMROW; m += F.ngw) { const int l = m / NMROW, r = m % NMROW;
        norm_row_bf16(F.in(I_MEM) + (size_t)r * DM, F.in(I_MNORM) + l * DM, (GAS bf16_t*)(ws + O_MEMN) + (size_t)m * DM, F.lane); }
    convert_tables(F, 0, 0, 2 * NEXP, F.gw, F.ngw);
}
__device__ __forceinline__ void step_conv(Frame& F) {
    const GAS bf16_t* zx = (const GAS bf16_t*)(F.ws + O_ZX); GAS bf16_t* xc = (GAS bf16_t*)(F.ws + O_XC);
    const GAS float* cw = F.in(I_ACONVW); const GAS float* cb = F.in(I_ACONVB);
    constexpr int RUN = 16, NCG = LRU / 256, NU = (T / RUN) * NCG;
    unsigned lo = (unsigned)F.lane; asm volatile("" : "+v"(lo));
    struct CvU { f32x4 w[4], b; u32x2 r[RUN + 3]; };
#define CV_LOADU(U, u_) do { const int uu_ = (u_) < NU ? (u_) : NU - 1; const int cg_ = uu_ % NCG, t0_ = (uu_ / NCG) * RUN; const unsigned ch_ = cg_ * 256 + lo * 4; \
        _Pragma("unroll") for (int k = 0; k < 4; ++k) U.w[k] = *(const GAS f32x4*)(cw + k * LRU + ch_); U.b = *(const GAS f32x4*)(cb + ch_); \
        const bool first_ = (t0_ & (SEQ - 1)) == 0; \
        _Pragma("unroll") for (int i = 0; i < RUN + 3; ++i) U.r[i] = (i < 3 && first_) ? (u32x2){0u, 0u} : *(const GAS u32x2*)(zx + (size_t)(t0_ - 3 + i) * LRU + ch_); } while (0)
#define CV_PROCU(U, u_) do { if ((u_) < NU) { const int cg_ = (u_) % NCG, t0_ = ((u_) / NCG) * RUN; const unsigned ch_ = cg_ * 256 + lo * 4; \
        _Pragma("unroll") for (int i = 0; i < RUN; ++i) { f32x4 a = U.b; \
            _Pragma("unroll") for (int k = 0; k < 4; ++k) { const u32x2 q = U.r[i + k]; \
                a[0] = fmaf(U.w[k][0], bf_lo(q.x), a[0]); a[1] = fmaf(U.w[k][1], bf_hi(q.x), a[1]); a[2] = fmaf(U.w[k][2], bf_lo(q.y), a[2]); a[3] = fmaf(U.w[k][3], bf_hi(q.y), a[3]); } \
            u32x2 o; o.x = cvtpk(a[0], a[1]); o.y = cvtpk(a[2], a[3]); *(GAS u32x2*)(xc + (size_t)(t0_ + i) * LRU + ch_) = o; } } } while (0)
    CvU A, B;
    CV_LOADU(A, F.gw);
    for (int u = F.gw; u < NU; u += 2 * F.ngw) { CV_LOADU(B, u + F.ngw); CV_PROCU(A, u); CV_LOADU(A, u + 2 * F.ngw); CV_PROCU(B, u + F.ngw); }
#undef CV_LOADU
#undef CV_PROCU
}
constexpr int SCK = 32, NCK = SEQ / SCK;
typedef _Float16 h8_t __attribute__((ext_vector_type(8)));
__device__ __forceinline__ void scan_load(const GAS _Float16* LA, const GAS _Float16* UH, size_t off, float (&a)[8], float (&u)[8]) {
    const h8_t l = *(const GAS h8_t*)(LA + off), w = *(const GAS h8_t*)(UH + off);
#pragma unroll
    for (int k = 0; k < 8; ++k) { a[k] = fast_exp((float)l[k]); u[k] = (float)w[k]; }
}
__device__ __forceinline__ void step_scan1(Frame& F) {
    const GAS _Float16* LA = (const GAS _Float16*)(F.ws + O_AA); const GAS _Float16* UH = (const GAS _Float16*)(F.ws + O_UU);
    GAS float* CA = (GAS float*)(F.ws + O_LOGFP); GAS float* CH = CA + (size_t)NB * NCK * LRU;
    if (F.tid >= 384) return;
    const int grp = F.tid / 192, th = F.tid % 192;
    for (int it = blockIdx.x * 2 + grp; it < NB * NCK; it += gridDim.x * 2) {
        const int b = it / NCK, ck = it % NCK; const size_t base = ((size_t)b * SEQ + ck * SCK) * LRU + th * 8;
        float ap[8], h[8];
#pragma unroll
        for (int k = 0; k < 8; ++k) { ap[k] = 1.f; h[k] = 0.f; }
        h8_t L[2][4], W[2][4];
#define S1_LD(bf, i0) do { _Pragma("unroll") for (int r = 0; r < 4; ++r) { L[bf][r] = *(const GAS h8_t*)(LA + base + (size_t)((i0) + r) * LRU); W[bf][r] = *(const GAS h8_t*)(UH + base + (size_t)((i0) + r) * LRU); } } while (0)
        S1_LD(0, 0);
#pragma unroll
        for (int bt = 0; bt < SCK / 4; ++bt) {
            if (bt + 1 < SCK / 4) S1_LD((bt + 1) & 1, (bt + 1) * 4);
            __builtin_amdgcn_sched_barrier(0);
#pragma unroll
            for (int r = 0; r < 4; ++r) {
#pragma unroll
                for (int k = 0; k < 8; ++k) { const float a = fast_exp((float)L[bt & 1][r][k]); ap[k] *= a; h[k] = a * h[k] + (float)W[bt & 1][r][k]; } }
            __builtin_amdgcn_sched_barrier(0);
        }
#undef S1_LD
        GAS float* ca = CA + (size_t)it * LRU + th * 8; GAS float* ch = CH + (size_t)it * LRU + th * 8;
        *(GAS f32x4*)ca = (f32x4){ap[0], ap[1], ap[2], ap[3]}; *(GAS f32x4*)(ca + 4) = (f32x4){ap[4], ap[5], ap[6], ap[7]};
        *(GAS f32x4*)ch = (f32x4){h[0], h[1], h[2], h[3]}; *(GAS f32x4*)(ch + 4) = (f32x4){h[4], h[5], h[6], h[7]};
    }
}
__device__ __forceinline__ void step_scan2(Frame& F) {
    const GAS _Float16* LA = (const GAS _Float16*)(F.ws + O_AA); const GAS _Float16* UH = (const GAS _Float16*)(F.ws + O_UU);
    const GAS float* CA = (const GAS float*)(F.ws + O_LOGFP); const GAS float* CH = CA + (size_t)NB * NCK * LRU;
    const GAS bf16_t* gy = (const GAS bf16_t*)(F.ws + O_GY); GAS bf16_t* cat = (GAS bf16_t*)(F.ws + O_CAT);
    if (F.tid >= 384) return;
    const int grp = F.tid / 192, th = F.tid % 192;
    for (int it = blockIdx.x * 2 + grp; it < NB * NCK; it += gridDim.x * 2) {
        const int b = it / NCK, ck = it % NCK; const size_t base = ((size_t)b * SEQ + ck * SCK) * LRU + th * 8;
        h8_t L[2][4], W[2][4]; u32x4 Gy[2][4];
#define S2_LD(bf, i0) do { _Pragma("unroll") for (int r = 0; r < 4; ++r) { L[bf][r] = *(const GAS h8_t*)(LA + base + (size_t)((i0) + r) * LRU); W[bf][r] = *(const GAS h8_t*)(UH + base + (size_t)((i0) + r) * LRU); \
            Gy[bf][r] = *(const GAS u32x4*)(gy + ((size_t)b * SEQ + ck * SCK + (i0) + r) * LRU + th * 8); } } while (0)
        float h[8];
#pragma unroll
        for (int k = 0; k < 8; ++k) h[k] = 0.f;
        { const GAS float* ca = CA + (size_t)(b * NCK) * LRU + th * 8; const GAS float* chh = CH + (size_t)(b * NCK) * LRU + th * 8;
          f32x4 A0[2][4], A1[2][4], C0[2][4], C1[2][4];
#define CR_LD(bf, k0) do { _Pragma("unroll") for (int r = 0; r < 4; ++r) { const int kk_ = (k0) + r < ck ? (k0) + r : (ck > 0 ? ck - 1 : 0); const size_t o_ = (size_t)kk_ * LRU; \
            A0[bf][r] = *(const GAS f32x4*)(ca + o_); A1[bf][r] = *(const GAS f32x4*)(ca + o_ + 4); C0[bf][r] = *(const GAS f32x4*)(chh + o_); C1[bf][r] = *(const GAS f32x4*)(chh + o_ + 4); } } while (0)
#define CR_DO(bf, k0) do { _Pragma("unroll") for (int r = 0; r < 4; ++r) if ((k0) + r < ck) { _Pragma("unroll") for (int k = 0; k < 4; ++k) { h[k] = A0[bf][r][k] * h[k] + C0[bf][r][k]; h[4 + k] = A1[bf][r][k] * h[4 + k] + C1[bf][r][k]; } } } while (0)
          if (ck > 0) { CR_LD(0, 0);
              for (int k0 = 0; k0 < ck; k0 += 8) { CR_LD(1, k0 + 4); __builtin_amdgcn_sched_barrier(0); CR_DO(0, k0); CR_LD(0, k0 + 8); __builtin_amdgcn_sched_barrier(0); CR_DO(1, k0 + 4); } }
#undef CR_LD
#undef CR_DO
        }
        S2_LD(0, 0);
#pragma unroll
        for (int bt = 0; bt < SCK / 4; ++bt) {
            if (bt + 1 < SCK / 4) S2_LD((bt + 1) & 1, (bt + 1) * 4);
            __builtin_amdgcn_sched_barrier(0);
#pragma unroll
            for (int r = 0; r < 4; ++r) { const size_t row = (size_t)b * SEQ + ck * SCK + bt * 4 + r; const u32x4 g = Gy[bt & 1][r]; u32x4 o;
#pragma unroll
                for (int k = 0; k < 8; ++k) h[k] = fast_exp((float)L[bt & 1][r][k]) * h[k] + (float)W[bt & 1][r][k];
#pragma unroll
                for (int k = 0; k < 4; ++k) o[k] = cvtpk(h[2 * k] * bf_lo(g[k]), h[2 * k + 1] * bf_hi(g[k]));
                *(GAS u32x4*)(cat + row * DM + th * 8) = o; }
            __builtin_amdgcn_sched_barrier(0);
        }
#undef S2_LD
    }
}
__device__ __forceinline__ void step_cprefix(Frame& F, LAS unsigned char* lds) {
    if (blockIdx.x >= NB * NH) return;
    const GAS float* p = (const GAS float*)(F.ws + O_LOGF) + (size_t)blockIdx.x * SEQ + F.tid * 8; GAS float* q = (GAS float*)(F.ws + O_CC) + (size_t)blockIdx.x * SEQ + F.tid * 8;
    LAS double* scr = (LAS double*)lds;
    const f32x4 a = *(const GAS f32x4*)p, b = *(const GAS f32x4*)(p + 4);
    double v[8];
    v[0] = (double)a[0]; v[1] = v[0] + (double)a[1]; v[2] = v[1] + (double)a[2]; v[3] = v[2] + (double)a[3];
    v[4] = v[3] + (double)b[0]; v[5] = v[4] + (double)b[1]; v[6] = v[5] + (double)b[2]; v[7] = v[6] + (double)b[3];
    scr[F.tid] = v[7];
    __syncthreads();
    double run = 0.0;
    for (int l = 0; l < 64; ++l) { const double t = scr[F.wave * 64 + l]; if (l < F.lane) run += t; }
    if (F.lane == 63) scr[512 + F.wave] = run + v[7];
    __syncthreads();
    for (int w = 0; w < F.wave; ++w) run += scr[512 + w];
    f32x4 o0, o1;
    o0[0] = (float)(run + v[0]); o0[1] = (float)(run + v[1]); o0[2] = (float)(run + v[2]); o0[3] = (float)(run + v[3]);
    o1[0] = (float)(run + v[4]); o1[1] = (float)(run + v[5]); o1[2] = (float)(run + v[6]); o1[3] = (float)(run + v[7]);
    *(GAS f32x4*)q = o0; *(GAS f32x4*)(q + 4) = o1;
    __syncthreads();
}

__device__ __forceinline__ int ord_i(float f) { const int b = __float_as_int(f); return b ^ ((b >> 31) & 0x7fffffff); }
__device__ __forceinline__ float unord_f(int k) { return __int_as_float(k ^ ((k >> 31) & 0x7fffffff)); }
template <int N> __device__ __forceinline__ void bitonic_sort_desc(int (&a)[N]) {
#pragma unroll
    for (int k = 2; k <= N; k <<= 1) {
#pragma unroll
        for (int j = k >> 1; j > 0; j >>= 1) {
#pragma unroll
            for (int i = 0; i < N; ++i) { const int l = i ^ j;
                if (l > i) { const bool desc = ((i & k) == 0); const int mx = max(a[i], a[l]), mn = min(a[i], a[l]); a[i] = desc ? mx : mn; a[l] = desc ? mn : mx; } }
        }
    }
}
__device__ __forceinline__ void bitonic_merge16_desc(int (&a)[16]) {
#pragma unroll
    for (int j = 8; j > 0; j >>= 1) {
#pragma unroll
        for (int i = 0; i < 16; ++i) { const int l = i ^ j; if (l > i) { const int mx = max(a[i], a[l]), mn = min(a[i], a[l]); a[i] = mx; a[l] = mn; } }
    }
}
__device__ __forceinline__ void top16_of_64(int (&a)[64]) {
    int g[4][16];
#pragma unroll
    for (int q = 0; q < 4; ++q) {
#pragma unroll
        for (int i = 0; i < 16; ++i) g[q][i] = a[16 * q + i];
        bitonic_sort_desc<16>(g[q]); }
#pragma unroll
    for (int i = 0; i < 16; ++i) { g[0][i] = max(g[0][i], g[1][15 - i]); g[2][i] = max(g[2][i], g[3][15 - i]); }
    bitonic_merge16_desc(g[0]); bitonic_merge16_desc(g[2]);
#pragma unroll
    for (int i = 0; i < 16; ++i) g[0][i] = max(g[0][i], g[2][15 - i]);
    bitonic_merge16_desc(g[0]);
#pragma unroll
    for (int i = 0; i < 16; ++i) a[i] = g[0][i];
}
constexpr float KOFF = 64.f;
__device__ __forceinline__ void top16_of_32(int (&a)[32]) {
    int g0[16], g1[16];
#pragma unroll
    for (int i = 0; i < 16; ++i) { g0[i] = a[i]; g1[i] = a[16 + i]; }
    bitonic_sort_desc<16>(g0); bitonic_sort_desc<16>(g1);
#pragma unroll
    for (int i = 0; i < 16; ++i) g0[i] = max(g0[i], g1[15 - i]);
    bitonic_merge16_desc(g0);
#pragma unroll
    for (int i = 0; i < 16; ++i) a[i] = g0[i];
}
__device__ __forceinline__ void subkey_top16(const GAS bf16_t* qrow  , const GAS bf16_t* sk  , int r32, int hi, int (&top)[16]) {
    bf16x8 qf[8];
#pragma unroll
    for (int ks = 0; ks < 8; ++ks) qf[ks] = *(const GAS bf16x8*)(qrow + ks * 16 + hi * 8);
    unsigned loff = (unsigned)(r32 * 128 + hi * 8) * 2u; asm volatile("" : "+v"(loff));
    int key[64];
    bf16x8 afc[8], afn[8];
#pragma unroll
    for (int ks = 0; ks < 8; ++ks) afc[ks] = *(const GAS bf16x8*)((const GAS char*)(sk + ks * 16) + loff);
#pragma unroll
    for (int kb = 0; kb < 4; ++kb) {
        if (kb < 3) {
#pragma unroll
            for (int ks = 0; ks < 8; ++ks) afn[ks] = *(const GAS bf16x8*)((const GAS char*)(sk + (kb + 1) * 32 * 128 + ks * 16) + loff); }
        f32x16 acc;
#pragma unroll
        for (int r = 0; r < 16; ++r) acc[r] = KOFF;
#pragma unroll
        for (int ks = 0; ks < 8; ++ks) acc = __builtin_amdgcn_mfma_f32_32x32x16_bf16(afc[ks], qf[ks], acc, 0, 0, 0);
#pragma unroll
        for (int ks = 0; ks < 8; ++ks) afc[ks] = afn[ks];
#pragma unroll
        for (int r = 0; r < 16; ++r) { const int id = kb * 32 + (r & 3) + 8 * (r >> 2) + 4 * hi; key[kb * 16 + r] = (__float_as_int(acc[r]) & ~127) | (127 - id); }
        __builtin_amdgcn_sched_barrier(0);
    }
    top16_of_64(key);
#pragma unroll
    for (int i = 0; i < 16; ++i) { auto r = __builtin_amdgcn_permlane32_swap((unsigned)key[15 - i], (unsigned)key[15 - i], false, false);
        const int pk = hi ? (int)r[0] : (int)r[1]; top[i] = max(key[i], pk); }
    bitonic_merge16_desc(top);
}
__device__ __forceinline__ void step_topk(Frame& F, LAS unsigned char* lds, int layer) {
    const GAS bf16_t* q16 = (const GAS bf16_t*)(F.ws + O_Q16); const GAS bf16_t* subk = (const GAS bf16_t*)(F.ws + O_SUBK) + (size_t)layer * 16 * 128 * 128;
    GAS int* IDX = (GAS int*)(F.ws + O_IDX); GAS float* GW = (GAS float*)(F.ws + O_GW);
    LAS int* scr = (LAS int*)(lds + F.wave * 16384) + F.lane * 33;
    const int r32 = F.lane & 31, hi = F.lane >> 5;
    for (int task = F.gw; task < (T / 32) * 8; task += F.ngw) {
        const int tb = task >> 3, h = task & 7; const int tok = tb * 32 + r32;
        const GAS bf16_t* qrow = q16 + (size_t)tok * DM + h * 256;
        int ta[16], tb16[16];
        subkey_top16(qrow, subk + (size_t)(h * 2 + 0) * 128 * 128, r32, hi, ta);
        subkey_top16(qrow + 128, subk + (size_t)(h * 2 + 1) * 128 * 128, r32, hi, tb16);
        float va[16], vb[16];
#pragma unroll
        for (int i = 0; i < 16; ++i) { va[i] = __int_as_float(ta[i] & ~127); vb[i] = __int_as_float(tb16[i] & ~127) - KOFF; scr[i] = 127 - (ta[i] & 127); scr[16 + i] = 127 - (tb16[i] & 127); }
        int c2[32]; int n = 0;
#pragma unroll
        for (int i = 0; i < 16; ++i)
#pragma unroll
            for (int j = 0; j < 16; ++j) if ((i + 1) * (j + 1) <= 16) { const int k = (__float_as_int(va[i] + vb[j]) & ~255) | (255 - (i * 16 + j));
                if ((n & 1) == 0) c2[n >> 1] = k; else c2[n >> 1] = hi ? k : c2[n >> 1];
                ++n; }
#pragma unroll
        for (int i = 25; i < 32; ++i) c2[i] = (int)0x80000000;
        top16_of_32(c2);
        { int mg[16];
#pragma unroll
          for (int i = 0; i < 16; ++i) { auto r = __builtin_amdgcn_permlane32_swap((unsigned)c2[15 - i], (unsigned)c2[15 - i], false, false);
              const int pk = hi ? (int)r[0] : (int)r[1]; mg[i] = max(c2[i], pk); }
          bitonic_merge16_desc(mg);
#pragma unroll
          for (int i = 0; i < 16; ++i) c2[i] = mg[i]; }
        asm volatile("s_waitcnt lgkmcnt(0)" ::: "memory");
        float sv[16], ex[16]; int ev[16]; float Z = 0.f;
#pragma unroll
        for (int r = 0; r < 16; ++r) { const int flat = 255 - (c2[r] & 255); sv[r] = __int_as_float(c2[r] & ~255); ev[r] = scr[flat >> 4] * 128 + scr[16 + (flat & 15)]; }
#pragma unroll
        for (int r = 0; r < 16; ++r) { ex[r] = fast_exp(sv[r] - sv[0]); Z += ex[r]; }
        const float iz = 1.f / Z;
        GAS int* ip = IDX + (size_t)tok * 128 + h * 16 + hi * 8; GAS float* gp = GW + (size_t)tok * 128 + h * 16 + hi * 8;
        int eo[8]; float go[8];
#pragma unroll
        for (int j = 0; j < 8; ++j) { eo[j] = hi ? ev[8 + j] : ev[j]; go[j] = (hi ? ex[8 + j] : ex[j]) * iz; }
        *(GAS u32x4*)ip = (u32x4){(unsigned)eo[0], (unsigned)eo[1], (unsigned)eo[2], (unsigned)eo[3]}; *(GAS u32x4*)(ip + 4) = (u32x4){(unsigned)eo[4], (unsigned)eo[5], (unsigned)eo[6], (unsigned)eo[7]};
        *(GAS f32x4*)gp = (f32x4){go[0], go[1], go[2], go[3]}; *(GAS f32x4*)(gp + 4) = (f32x4){go[4], go[5], go[6], go[7]};
        asm volatile("s_waitcnt lgkmcnt(0)" ::: "memory");
    }
}
__device__ __forceinline__ h2 as_h2(unsigned w) { return __builtin_bit_cast(h2, w); }
#define F4(W, s) __builtin_amdgcn_cvt_scalef32_pk_f16_fp4((W), 1.0f, (s))
#define H2F(us) ((float)__builtin_bit_cast(_Float16, (unsigned short)(us)))
__device__ __forceinline__ float sum8(float v) { v += dppf<0xB1>(v); v += dppf<0x4E>(v); v += dppf<0x141>(v); return v; }
__device__ __forceinline__ void step_upass(Frame& F, int layer, int G, LAS unsigned char* lds) {
    typedef pg8::v8i_t v8i_t;
    const int s = blockIdx.x & 7, wk = (blockIdx.x >> 3) * NWAVES + F.wave, nwk = (G >> 3) * NWAVES;
    const GAS unsigned char* UN = F.ws + O_TAB + (size_t)(layer * 2) * TAB_ONE + (size_t)s * NEXP * 128;
    const GAS int* IDX = (const GAS int*)(F.ws + O_IDX); const GAS bf16_t* xs = (const GAS bf16_t*)(F.ws + O_XS16) + s * 256;
    GAS _Float16* part = (GAS _Float16*)(F.ws + O_PART) + (size_t)s * T * 128;
    unsigned lo = (unsigned)F.lane; asm volatile("" : "+v"(lo));
    const unsigned j = lo >> 3, p = lo & 7, c = lo & 15, kq = lo >> 4;
    LAS unsigned char* img = lds + F.wave * 16384; LAS unsigned char* xrow = lds + 131072 + F.wave * 256;
    LAS unsigned char* wrp = img + j * 128 + ((p ^ j) << 4);
    const LAS unsigned char* rd0 = img + c * 128 + ((kq ^ (c & 7)) << 4);
    const LAS unsigned char* rd1 = img + c * 128 + (((4 + kq) ^ (c & 7)) << 4);
    const int tlast = wk + ((T - 1 - wk) / nwk) * nwk;
#define U_LOADID(ID, t_, q_) do { const int tt_ = (t_) <= tlast ? (t_) : tlast; _Pragma("unroll") for (int b = 0; b < 4; ++b) ID[b] = IDX[(size_t)tt_ * 128 + (q_) * 32 + 8 * b + j]; } while (0)
#define U_LOADX(t_) do { const int tt_ = (t_) <= tlast ? (t_) : tlast; xn = *(const GAS u32x2*)(xs + (size_t)tt_ * DM + lo * 4); } while (0)
    const __amdgpu_buffer_rsrc_t urs = __builtin_amdgcn_make_buffer_rsrc((void*)(unsigned char*)UN, 0, NEXP * 128, 0x00020000);
#define U_ISSUE(UB, ID) do { _Pragma("unroll") for (int b = 0; b < 4; ++b) UB[b] = __builtin_amdgcn_raw_buffer_load_b128(urs, ID[b] * 128 + (int)p * 16, 0, 16); } while (0)
#define U_WRITE(UB, q_) do { _Pragma("unroll") for (int b = 0; b < 4; ++b) *(LAS u32x4*)(wrp + (4 * (q_) + b) * 1024) = UB[b]; } while (0)
#define U_MM(g0) do { u32x4 a0[4], a1[4]; _Pragma("unroll") for (int g = 0; g < 4; ++g) { a0[g] = *(const LAS u32x4*)(rd0 + ((g0) + g) * 2048); a1[g] = *(const LAS u32x4*)(rd1 + ((g0) + g) * 2048); } \
        _Pragma("unroll") for (int g = 0; g < 4; ++g) { \
            f32x4 c_ = __builtin_amdgcn_mfma_scale_f32_16x16x128_f8f6f4((v8i_t){(int)a0[g].x, (int)a0[g].y, (int)a0[g].z, (int)a0[g].w, 0, 0, 0, 0}, bop0, zero4, 4, 0, 0, 127, 0, 127); \
            acc[(g0) + g] = __builtin_amdgcn_mfma_scale_f32_16x16x128_f8f6f4((v8i_t){(int)a1[g].x, (int)a1[g].y, (int)a1[g].z, (int)a1[g].w, 0, 0, 0, 0}, bop1, c_, 4, 0, 0, 127, 0, 127); } } while (0)
    int idA[4], idB[4]; u32x4 u0[4], u1[4], u2[4], u3[4]; u32x2 xc, xn;
    U_LOADID(idA, wk, 0); U_LOADID(idB, wk, 1); U_LOADX(wk);
    U_ISSUE(u0, idA); U_LOADID(idA, wk, 2);
    U_ISSUE(u1, idB); U_LOADID(idB, wk, 3);
    U_ISSUE(u2, idA); U_LOADID(idA, wk + nwk, 0);
    xc = xn;
    for (int t = wk; t < T; t += nwk) {
        U_ISSUE(u3, idB); U_LOADID(idB, t + nwk, 1); U_LOADX(t + nwk);
        const float x0 = bf_lo(xc.x), x1 = bf_hi(xc.x), x2 = bf_lo(xc.y), x3 = bf_hi(xc.y);
        const float amax = wave_max(fmaxf(fmaxf(fabsf(x0), fabsf(x1)), fmaxf(fabsf(x2), fabsf(x3))));
        const float sc = fmaxf(amax, 1e-20f) * (1.f / 448.f), qs = __builtin_amdgcn_rcpf(sc);
        { int pk = __builtin_amdgcn_cvt_pk_fp8_f32(x0 * qs, x1 * qs, 0, false); pk = __builtin_amdgcn_cvt_pk_fp8_f32(x2 * qs, x3 * qs, pk, true); *(LAS int*)(xrow + lo * 4) = pk; }
        U_WRITE(u0, 0);
        U_ISSUE(u0, idA); U_LOADID(idA, t + nwk, 2);
        U_WRITE(u1, 1);
        U_ISSUE(u1, idB); U_LOADID(idB, t + nwk, 3);
        U_WRITE(u2, 2);
        U_ISSUE(u2, idA); U_LOADID(idA, t + 2 * nwk, 0);
        U_WRITE(u3, 3);
        v8i_t bop0, bop1;
        { const u32x4 b00 = *(const LAS u32x4*)(xrow + kq * 16), b01 = *(const LAS u32x4*)(xrow + 64 + kq * 16), b10 = *(const LAS u32x4*)(xrow + 128 + kq * 16), b11 = *(const LAS u32x4*)(xrow + 192 + kq * 16);
          bop0 = (v8i_t){(int)b00.x, (int)b00.y, (int)b00.z, (int)b00.w, (int)b01.x, (int)b01.y, (int)b01.z, (int)b01.w};
          bop1 = (v8i_t){(int)b10.x, (int)b10.y, (int)b10.z, (int)b10.w, (int)b11.x, (int)b11.y, (int)b11.z, (int)b11.w}; }
        const f32x4 zero4 = {0.f, 0.f, 0.f, 0.f};
        f32x4 acc[8];
        U_MM(0); U_MM(4);
        f32x4 o = acc[0];
#pragma unroll
        for (int m = 1; m < 8; ++m) o = ((c & 7) == (unsigned)m) ? acc[m] : o;
        { const h2 o0 = {(_Float16)(o[0] * sc), (_Float16)(o[1] * sc)}, o1 = {(_Float16)(o[2] * sc), (_Float16)(o[3] * sc)};
          __builtin_nontemporal_store((u32x2){__builtin_bit_cast(unsigned, o0), __builtin_bit_cast(unsigned, o1)}, (GAS u32x2*)(part + (size_t)t * 128 + 16 * (c & 7) + 4 * kq)); }
        xc = xn;
    }
#undef U_LOADID
#undef U_LOADX
#undef U_ISSUE
#undef U_WRITE
#undef U_MM
}
__device__ __forceinline__ void step_peer_reduce(Frame& F, int layer) {
    const GAS _Float16* part = (const GAS _Float16*)(F.ws + O_PART); const GAS float* GW = (const GAS float*)(F.ws + O_GW); const GAS int* IDX = (const GAS int*)(F.ws + O_IDX);
    const GAS float* rowss = (const GAS float*)(F.ws + O_ROWSS); GAS unsigned char* W8 = F.ws + O_W8;
    const GAS unsigned char* SU = F.ws + O_TAB + (size_t)(layer * 2) * TAB_ONE + TAB_NIB; const GAS unsigned char* SV = SU + TAB_ONE;
    constexpr int NIT = T * 2;
    struct SA { int id; float gw, rs; float p[8]; }; struct SB { u32x4 su, sv; };
#define RA(X, it_) do { const int ii_ = (it_) < NIT ? (it_) : NIT - 1; const size_t i_ = (size_t)ii_ * 64 + F.lane; X.id = IDX[i_]; X.gw = GW[i_]; X.rs = rowss[(size_t)(ii_ >> 1) * 32 + (F.lane & 31)]; \
        _Pragma("unroll") for (int s = 0; s < 8; ++s) X.p[s] = (float)part[(size_t)s * T * 128 + i_]; } while (0)
#define RB(Y, X) do { Y.su = *(const GAS u32x4*)(SU + (size_t)X.id * 16); Y.sv = *(const GAS u32x4*)(SV + (size_t)X.id * 16); } while (0)
#define RC(X, Y, it_) do { if ((it_) < NIT) { const size_t i_ = (size_t)(it_) * 64 + F.lane; const float r = rsqrtf(wave_sum(X.rs) * (0.5f / DM) + EPS); float d = 0.f; \
        _Pragma("unroll") for (int s = 0; s < 8; ++s) d += X.p[s] * (float)__builtin_bit_cast(_Float16, (unsigned short)(Y.su[s >> 1] >> (16 * (s & 1)))); \
        const float w = X.gw * gelu_tanh(d * r) * 256.f; \
        _Pragma("unroll") for (int s = 0; s < 8; ++s) { const float ws = w * (float)__builtin_bit_cast(_Float16, (unsigned short)(Y.sv[s >> 1] >> (16 * (s & 1)))); \
            W8[(size_t)s * T * 128 + i_] = (unsigned char)(__builtin_amdgcn_cvt_pk_fp8_f32(ws, 0.f, 0, false) & 0xff); } } } while (0)
    SA a0, a1, a2; SB b0, b1;
    RA(a0, F.gw); RA(a1, F.gw + F.ngw); RB(b0, a0);
    for (int it = F.gw; it < NIT; it += F.ngw) {
        RA(a2, it + 2 * F.ngw); RB(b1, a1);
        RC(a0, b0, it);
        a0 = a1; a1 = a2; b0 = b1;
    }
#undef RA
#undef RB
#undef RC
}
__device__ __forceinline__ void step_vpass(Frame& F, int layer, int G, bool dry, LAS unsigned char* lds) {
    typedef pg8::v8i_t v8i_t;
    const int s = blockIdx.x & 7, wk = (blockIdx.x >> 3) * NWAVES + F.wave, nwk = (G >> 3) * NWAVES;
    const GAS unsigned char* VN = F.ws + O_TAB + (size_t)(layer * 2 + 1) * TAB_ONE + (size_t)s * NEXP * 128;
    const GAS int* IDX = (const GAS int*)(F.ws + O_IDX); const GAS unsigned char* W8 = F.ws + O_W8 + (size_t)s * T * 128;
    GAS bf16_t* xs = (GAS bf16_t*)(F.ws + O_XS16); GAS float* rsp = (GAS float*)(F.ws + O_RSP);
    unsigned lo = (unsigned)F.lane; asm volatile("" : "+v"(lo));
    const unsigned j = lo >> 3, p = lo & 7, c = lo & 15, kq = lo >> 4;
    LAS unsigned char* img = lds + F.wave * 16384;
    LAS unsigned char* wrp = img + j * 128 + ((p ^ j) << 4);
    const unsigned rdrow = (unsigned)(size_t)img + (32 * kq + c) * 128, csw = (c & 7) << 4;
    const int tlast = wk + ((T - 1 - wk) / nwk) * nwk;
    LAS float* wfl = (LAS float*)(lds + 131072); GAS float* logfp = (GAS float*)(F.ws + O_LOGFP);
    if (layer == 0) { const GAS float* wf = (const GAS float*)(F.ws + O_WF) + s * 256;
        for (int i = F.tid; i < NH * 64; i += NTHREADS) *(LAS f32x4*)(wfl + (i >> 6) * 256 + (i & 63) * 4) = *(const GAS f32x4*)(wf + (size_t)(i >> 6) * DM + (i & 63) * 4);
        __syncthreads(); }
#define V_LOADID(ID, t_, q_) do { const int tt_ = (t_) <= tlast ? (t_) : tlast; _Pragma("unroll") for (int b = 0; b < 4; ++b) ID[b] = IDX[(size_t)tt_ * 128 + (q_) * 32 + 8 * b + j]; } while (0)
#define V_LOADW(t_) do { const int tt_ = (t_) <= tlast ? (t_) : tlast; wn0 = *(const GAS u32x4*)(W8 + (size_t)tt_ * 128 + kq * 16); wn1 = *(const GAS u32x4*)(W8 + (size_t)tt_ * 128 + 64 + kq * 16); } while (0)
    const __amdgpu_buffer_rsrc_t vrs = __builtin_amdgcn_make_buffer_rsrc((void*)(unsigned char*)VN, 0, NEXP * 128, 0x00020000);
#define V_ISSUE(VB, ID) do { _Pragma("unroll") for (int b = 0; b < 4; ++b) VB[b] = __builtin_amdgcn_raw_buffer_load_b128(vrs, ID[b] * 128 + (int)p * 16, 0, 16); } while (0)
#define V_WRITE(VB, q_) do { _Pragma("unroll") for (int b = 0; b < 4; ++b) *(LAS u32x4*)(wrp + (4 * (q_) + b) * 1024) = VB[b]; } while (0)
#define TR4(dst, va, off) asm volatile("ds_read_b64_tr_b4 %0, %1 offset:%2" : "=&v"(dst) : "v"(va), "i"(off) : "memory")
#define V_MM(cc) do { const unsigned va0 = rdrow + (((cc) << 4) ^ csw), va1 = rdrow + ((((cc) + 1) << 4) ^ csw); u32x2 t00, t01, t10, t11, t20, t21, t30, t31; \
        TR4(t00, va0, 0); TR4(t01, va0, 2048); TR4(t10, va0, 8); TR4(t11, va0, 2056); TR4(t20, va1, 0); TR4(t21, va1, 2048); TR4(t30, va1, 8); TR4(t31, va1, 2056); \
        asm volatile("s_waitcnt lgkmcnt(0)" ::: "memory"); __builtin_amdgcn_sched_barrier(0); \
        o = __builtin_amdgcn_mfma_scale_f32_16x16x128_f8f6f4((v8i_t){(int)t00.x, (int)t00.y, (int)t01.x, (int)t01.y, 0, 0, 0, 0}, bop, o, 4, 0, 0, 127, 0, SBV(2 * (cc))); \
        o = __builtin_amdgcn_mfma_scale_f32_16x16x128_f8f6f4((v8i_t){(int)t10.x, (int)t10.y, (int)t11.x, (int)t11.y, 0, 0, 0, 0}, bop, o, 4, 0, 0, 127, 0, SBV(2 * (cc) + 1)); \
        o = __builtin_amdgcn_mfma_scale_f32_16x16x128_f8f6f4((v8i_t){(int)t20.x, (int)t20.y, (int)t21.x, (int)t21.y, 0, 0, 0, 0}, bop, o, 4, 0, 0, 127, 0, SBV(2 * (cc) + 2)); \
        o = __builtin_amdgcn_mfma_scale_f32_16x16x128_f8f6f4((v8i_t){(int)t30.x, (int)t30.y, (int)t31.x, (int)t31.y, 0, 0, 0, 0}, bop, o, 4, 0, 0, 127, 0, SBV(2 * (cc) + 3)); } while (0)
#define SBV(nb_) ((c == (unsigned)(nb_)) ? 119 : 0)
    int idA[4], idB[4]; u32x4 v0[4], v1[4], v2[4], v3[4]; u32x4 w0, w1, wn0, wn1;
    V_LOADID(idA, wk, 0); V_LOADID(idB, wk, 1); V_LOADW(wk);
    V_ISSUE(v0, idA); V_LOADID(idA, wk, 2);
    V_ISSUE(v1, idB); V_LOADID(idB, wk, 3);
    V_ISSUE(v2, idA); V_LOADID(idA, wk + nwk, 0);
    w0 = wn0; w1 = wn1;
    for (int t = wk; t < T; t += nwk) {
        V_ISSUE(v3, idB); V_LOADID(idB, t + nwk, 1); V_LOADW(t + nwk);
        GAS bf16_t* xb = xs + (size_t)t * DM + s * 256 + c * 16 + kq * 4;
        f32x4 x2; { const u32x2 w = *(const GAS u32x2*)xb; x2 = (f32x4){bf_lo(w.x), bf_hi(w.x), bf_lo(w.y), bf_hi(w.y)}; }
        V_WRITE(v0, 0);
        V_ISSUE(v0, idA); V_LOADID(idA, t + nwk, 2);
        V_WRITE(v1, 1);
        V_ISSUE(v1, idB); V_LOADID(idB, t + nwk, 3);
        V_WRITE(v2, 2);
        V_ISSUE(v2, idA); V_LOADID(idA, t + 2 * nwk, 0);
        V_WRITE(v3, 3);
        const v8i_t bop = {(int)w0.x, (int)w0.y, (int)w0.z, (int)w0.w, (int)w1.x, (int)w1.y, (int)w1.z, (int)w1.w};
        f32x4 o = {0.f, 0.f, 0.f, 0.f};
        V_MM(0); V_MM(2); V_MM(4); V_MM(6);
        x2 += o;
        if (layer == 1 && !dry) __builtin_nontemporal_store(x2, (GAS f32x4*)(F.out + (size_t)t * DM + s * 256 + c * 16 + kq * 4));
        if (layer == 0 && !dry) {
            { u32x2 ow; ow.x = cvtpk(x2[0], x2[1]); ow.y = cvtpk(x2[2], x2[3]); __builtin_nontemporal_store(ow, (GAS u32x2*)xb); }
            const float sst = wave_sum((x2[0] * x2[0] + x2[1] * x2[1]) + (x2[2] * x2[2] + x2[3] * x2[3]));
            if (lo == 0) rsp[(size_t)t * 8 + s] = sst;
        }
        if (layer == 0) {
            f32x4 gw[NH];
#pragma unroll
            for (int h = 0; h < NH; ++h) gw[h] = *(const LAS f32x4*)(wfl + h * 256 + c * 16 + kq * 4);
            __builtin_amdgcn_sched_barrier(0);
            float ph[NH];
#pragma unroll
            for (int h = 0; h < NH; ++h) ph[h] = (x2[0] * gw[h][0] + x2[1] * gw[h][1]) + (x2[2] * gw[h][2] + x2[3] * gw[h][3]);
#pragma unroll
            for (int h = 0; h < NH; ++h) ph[h] += dppf<0xB1>(ph[h]);
#pragma unroll
            for (int h = 0; h < NH; ++h) ph[h] += dppf<0x4E>(ph[h]);
#pragma unroll
            for (int h = 0; h < NH; ++h) ph[h] += dppf<0x141>(ph[h]);
#pragma unroll
            for (int h = 0; h < NH; ++h) ph[h] += dppf<0x140>(ph[h]);
            float sel = 0.f;
#pragma unroll
            for (int h = 0; h < NH; ++h) sel = (c == (unsigned)h) ? ph[h] : sel;
            sel = xsum16(sel); sel = xsum32(sel);
            if (lo < (unsigned)NH && !dry) logfp[((size_t)t * 8 + s) * NH + lo] = sel;
        }
        w0 = wn0; w1 = wn1;
    }
#undef V_LOADID
#undef V_LOADW
#undef V_ISSUE
#undef V_WRITE
#undef TR4
#undef V_MM
#undef SBV
}
#undef F4
#undef H2F
__device__ __forceinline__ void step_logf(Frame& F) {
    const GAS float* lp = (const GAS float*)(F.ws + O_LOGFP); const GAS float* rsp = (const GAS float*)(F.ws + O_RSP); GAS float* logf = (GAS float*)(F.ws + O_LOGF);
    unsigned lo = (unsigned)F.lane; asm volatile("" : "+v"(lo));
    const unsigned h = lo & 15, g = lo >> 4; const unsigned hh = h < (unsigned)NH ? h : 0u;
    for (int t0 = F.gw * 4; t0 < T; t0 += F.ngw * 4) {
        const int t = t0 + (int)g;
        float pz[8]; f32x4 q0, q1;
#pragma unroll
        for (int s = 0; s < 8; ++s) pz[s] = lp[((size_t)t * 8 + s) * NH + hh];
        q0 = *(const GAS f32x4*)(rsp + (size_t)t * 8); q1 = *(const GAS f32x4*)(rsp + (size_t)t * 8 + 4);
        const float z0 = ((pz[0] + pz[1]) + (pz[2] + pz[3])) + ((pz[4] + pz[5]) + (pz[6] + pz[7]));
        const float r1 = rsqrtf(((q0[0] + q0[1]) + (q0[2] + q0[3]) + (q1[0] + q1[1]) + (q1[2] + q1[3])) * (1.f / DM) + EPS);
        if (h < (unsigned)NH) { const float z = z0 * r1 + F.in(I_SBF)[h];
            logf[((size_t)(t / SEQ) * NH + h) * SEQ + (t % SEQ)] = fminf(z, 0.f) - log1p_pos(fast_exp(-fabsf(z))); }
    }
}

#define XB_TMO      128
#define XB_XCNT(j)  (256  + 64 * (j))
#define XB_XSUB(j)  (1280 + 64 * (j))
#define XB_XGEN(j)  (2304 + 64 * (j))
#define XB_TOP      3328
#define XB_TOPGEN   3392
#define XCD_BAR_WORDS 3456
#define XB_SPIN_CAP (1u << 20)
__device__ __forceinline__ unsigned xb_ld(unsigned* p)              { return __hip_atomic_load(p, __ATOMIC_RELAXED, __HIP_MEMORY_SCOPE_AGENT); }
__device__ __forceinline__ unsigned xb_add(unsigned* p, unsigned v) { return __hip_atomic_fetch_add(p, v, __ATOMIC_RELAXED, __HIP_MEMORY_SCOPE_AGENT); }
__device__ __forceinline__ unsigned xb_xcc_id() { return (unsigned)__builtin_amdgcn_s_getreg((3 << 11) | 20) & 0xFu; }
#define XB_SPIN(cond, bar) do { unsigned _sp = 0; while (cond) { __builtin_amdgcn_s_sleep(1); \
    if ((++_sp & 255u) == 0u) { if (xb_ld(&(bar)[XB_TMO])) break; if (_sp > XB_SPIN_CAP) { atomicAdd(&(bar)[XB_TMO], 1u); break; } } } } while (0)
struct XcdBarrier { unsigned* bar; unsigned x; volatile LAS unsigned* st; };
__device__ __forceinline__ XcdBarrier xcd_barrier_post(unsigned* bar, volatile LAS unsigned* st) {
    XcdBarrier b; b.bar = bar; b.x = xb_xcc_id(); b.st = st;
    if (threadIdx.x == 0) (void)xb_add(&bar[XB_XCNT(b.x)], 1u);
    return b;
}
__device__ __forceinline__ void xcd_barrier_complete(unsigned* bar, unsigned x, unsigned& nloc, unsigned& nx) {
    const unsigned G = gridDim.x * gridDim.y * gridDim.z;
    unsigned sum, cnt, mine, sp = 0u;
    for (;;) {
        sum = 0u; cnt = 0u; mine = 0u;
#pragma unroll
        for (unsigned j = 0; j < 16; ++j) { const unsigned c = xb_ld(&bar[XB_XCNT(j)]); sum += c; cnt += (c > 0u) ? 1u : 0u; mine = (j == x) ? c : mine; }
        if (sum == G) break;
        __builtin_amdgcn_s_sleep(1);
        if ((++sp & 255u) == 0u) { if (xb_ld(&bar[XB_TMO])) break; if (sp > XB_SPIN_CAP) { atomicAdd(&bar[XB_TMO], 1u); break; } }
    }
    nloc = mine > 0u ? mine : 1u; nx = cnt > 0u ? cnt : 1u;
}
__device__ __forceinline__ void xcd_barrier(const XcdBarrier& b, int wave_s) {
    asm volatile("s_waitcnt vmcnt(0)" ::: "memory");
    __syncthreads();
    int ln_; asm volatile("v_mbcnt_lo_u32_b32 %0, -1, 0\n\tv_mbcnt_hi_u32_b32 %0, -1, %0" : "=v"(ln_));
    if (wave_s == 0 && ln_ == 0) {
        unsigned* bar = b.bar;
        __builtin_amdgcn_s_waitcnt(0);
        unsigned nloc = b.st[0], nx = b.st[1];
        if (nloc == 0u) { xcd_barrier_complete(bar, b.x, nloc, nx); b.st[0] = nloc; b.st[1] = nx; }
        const unsigned old = xb_add(&bar[XB_XSUB(b.x)], 1u);
        const unsigned gen = old / nloc;
        if (old + 1u == (gen + 1u) * nloc) {
            __builtin_amdgcn_fence(__ATOMIC_RELEASE, "agent");
            asm volatile("s_waitcnt vmcnt(0)" ::: "memory");
            const unsigned og = xb_add(&bar[XB_TOP], 1u);
            const unsigned tg = og / nx;
            if (og + 1u == (tg + 1u) * nx) xb_add(&bar[XB_TOPGEN], 1u);
            else XB_SPIN(xb_ld(&bar[XB_TOPGEN]) == tg, bar);
            __builtin_amdgcn_fence(__ATOMIC_ACQUIRE, "agent");
            xb_add(&bar[XB_XGEN(b.x)], 1u);
            asm volatile("s_waitcnt vmcnt(0)" ::: "memory");
        } else {
            XB_SPIN(xb_ld(&bar[XB_XGEN(b.x)]) == gen, bar);
            __builtin_amdgcn_fence(__ATOMIC_ACQUIRE, "agent");
            asm volatile("s_waitcnt vmcnt(0)" ::: "memory");
        }
    }
    __syncthreads();
}

constexpr int CONV1_SPLIT = 2 * 6144;
constexpr int BAR_LDS_OFF = 147456 - 64;
constexpr int LDS_BYTES = 147456;
enum { ST_PROLOGUE = 0, ST_G_IN0, ST_G_MKV0, ST_G_MKV1, ST_CONV, ST_G_GATE, ST_A_MEM0, ST_SCAN1, ST_SCAN2, ST_G_OUT0, ST_G_PQ0, ST_TOPK0, ST_UPASS0, ST_PRED0, ST_VPASS0,
       ST_G_L1, ST_CPREFIX, ST_A_FOX, ST_A_MEM1, ST_G_OUT1, ST_G_PQ1, ST_TOPK1, ST_UPASS1, ST_PRED1, ST_VPASS1, N_STEPS };
constexpr unsigned SYNC_AFTER = (1u << ST_PROLOGUE) | (1u << ST_G_MKV1) | (1u << ST_CONV) | (1u << ST_A_MEM0) | (1u << ST_SCAN1) | (1u << ST_SCAN2) | (1u << ST_G_OUT0) | (1u << ST_G_PQ0) |
                                (1u << ST_TOPK0) | (1u << ST_UPASS0) | (1u << ST_PRED0) | (1u << ST_VPASS0) | (1u << ST_G_L1) | (1u << ST_CPREFIX) | (1u << ST_A_MEM1) | (1u << ST_G_OUT1) | (1u << ST_G_PQ1) | (1u << ST_TOPK1) | (1u << ST_UPASS1) | (1u << ST_PRED1);
constexpr unsigned GEMM_STEPS = (1u << ST_G_IN0) | (1u << ST_G_MKV0) | (1u << ST_G_MKV1) | (1u << ST_G_GATE) | (1u << ST_G_OUT0) | (1u << ST_G_PQ0) | (1u << ST_G_L1) | (1u << ST_G_OUT1) | (1u << ST_G_PQ1);
constexpr unsigned ATTN_STEPS = (1u << ST_A_MEM0) | (1u << ST_A_FOX) | (1u << ST_A_MEM1);

struct Args { const float* in[N_IN]; float* out; unsigned char* ws; int lo, hi; };

__global__ void __launch_bounds__(NTHREADS, 2) yoco_fwd(Args args) {
    extern __shared__ __attribute__((aligned(16))) unsigned char lds[];
    volatile LAS unsigned* bst = (volatile LAS unsigned*)((LAS unsigned char*)lds + BAR_LDS_OFF);
    if (threadIdx.x == 0) { bst[0] = 0u; bst[1] = 0u; }
    __syncthreads();
    const XcdBarrier gbar = xcd_barrier_post((unsigned*)(args.ws + O_CTL), bst);
    const int G = gridDim.x;
    const int wave_s = __builtin_amdgcn_readfirstlane(threadIdx.x >> 6);
#ifndef DUP_MASK
#define DUP_MASK 0u
#endif
    for (int st = args.lo; st < args.hi; ++st) {
      const int nrep = ((DUP_MASK >> st) & 1u) ? 2 : 1;
      for (int rep = 0; rep < nrep; ++rep) {
        unsigned char* ws0 = args.ws; asm volatile("" : "+s"(ws0));
        GAS unsigned char* ws = (GAS unsigned char*)ws0;
#define LANE_ID(v) asm volatile("v_mbcnt_lo_u32_b32 %0, -1, 0\n\tv_mbcnt_hi_u32_b32 %0, -1, %0" : "=v"(v))
#define MAKE_TID(v) do { LANE_ID(v); v += wave_s * 64; } while (0)
#define MAKE_FRAME(F) Frame F; F.ws = ws; F.in_ = args.in; F.out = (GAS float*)args.out; { int t0_; MAKE_TID(t0_); F.tid = t0_; } F.lane = F.tid & 63; F.wave = wave_s; \
        F.gw = blockIdx.x * NWAVES + F.wave; F.ngw = gridDim.x * NWAVES; F.gtid = blockIdx.x * NTHREADS + F.tid; F.ngt = gridDim.x * NTHREADS
        if (st == ST_G_L1) { MAKE_FRAME(F); step_logf(F); }
        if ((GEMM_STEPS >> st) & 1u) {
            pg8::Gemm g; Epi E; E.ws = ws; E.resid = nullptr; E.outf = nullptr; E.o16 = nullptr; E.ssq = nullptr; E.gate_b = nullptr; int shift = 0;
            switch (st) {
            case ST_G_IN0:  g = {(const GAS bf16_t*)(ws + O_XS16), (const GAS bf16_t*)(ws + O_WIN0), T, NIN0, DM, DM, DM, 0}; E.mode = EM_IN0; break;
            case ST_G_MKV0: g = {(const GAS bf16_t*)(ws + O_MEMN), (const GAS bf16_t*)(ws + O_WMKV), NMROW, 1024, DM, DM, DM, 0}; E.mode = EM_MKV; E.o16 = (GAS bf16_t*)(ws + O_MKV); E.ssq = (GAS float*)(ws + O_MKSS); shift = 128; break;
            case ST_G_MKV1: g = {(const GAS bf16_t*)(ws + O_MEMN) + (size_t)NMROW * DM, (const GAS bf16_t*)(ws + O_WMKV) + (size_t)1024 * DM, NMROW, 1024, DM, DM, DM, 0}; E.mode = EM_MKV;
                            E.o16 = (GAS bf16_t*)(ws + O_MKV) + (size_t)NMROW * NL1; E.ssq = (GAS float*)(ws + O_MKSS) + NMROW * 112; shift = 144; break;
            case ST_G_GATE: g = {(const GAS bf16_t*)(ws + O_XC), (const GAS bf16_t*)(ws + O_WGATE), T, 12 * 256, 128, LRU, 128, 128}; E.mode = EM_GATE; E.gate_b = (const GAS float*)args.in[I_AGATEB]; break;
            case ST_G_OUT0: g = {(const GAS bf16_t*)(ws + O_CAT), (const GAS bf16_t*)(ws + O_WOUT0), T, DM, DM, DM, DM, 0}; E.mode = EM_RES; E.resid = (const GAS float*)args.in[I_X]; E.outf = (GAS float*)args.out; break;
            case ST_G_PQ0:  g = {(const GAS bf16_t*)(ws + O_XS16), (const GAS bf16_t*)(ws + O_WQ0), T, DM, DM, DM, DM, 0}; E.mode = EM_PQ; E.o16 = (GAS bf16_t*)(ws + O_Q16); break;
            case ST_G_L1:   g = {(const GAS bf16_t*)(ws + O_XS16), (const GAS bf16_t*)(ws + O_WL1), T, NL1, DM, DM, DM, 0}; E.mode = EM_L1; break;
            case ST_G_OUT1: g = {(const GAS bf16_t*)(ws + O_CAT), (const GAS bf16_t*)(ws + O_WOUT1), T, DM, DM, DM, DM, 0}; E.mode = EM_RES; E.resid = nullptr; break;
            default:        g = {(const GAS bf16_t*)(ws + O_XS16), (const GAS bf16_t*)(ws + O_WQ1), T, DM, DM, DM, DM, 0}; E.mode = EM_PQ; E.o16 = (GAS bf16_t*)(ws + O_Q16); break;
            }
            pg8::StaticOrder S; S.init(g.M, g.N, G, (int)((blockIdx.x + G - shift) % G));
#ifndef DIS_GEMM
            { int tg_; MAKE_TID(tg_);
              pg8::gemm_phase<Epi, false>((LAS unsigned char*)lds, g, S, E, tg_); }
#endif
            if (st == ST_G_MKV1 && blockIdx.x >= 160) { MAKE_FRAME(F); convert_tables(F, 1, 0, CONV1_SPLIT, (blockIdx.x - 160) * NWAVES + F.wave, (G - 160) * NWAVES); }
        } else if ((ATTN_STEPS >> st) & 1u) {
            const int nun = st == ST_A_FOX ? 3 : 1;
            for (int ui = 0; ui < nun; ++ui) {
                att::BlockRef r;
                if (st == ST_A_FOX) {
                    const int i = blockIdx.x, x = i & 15, bh = (i >> 4) + 16 * ui, qb = ui == 0 ? x : (ui == 1 ? 15 - x : ((x * 5 + 3) & 15));
                    const int b = bh / NH, h = bh % NH; const size_t row0 = (size_t)b * SEQ + qb * 256;
                    const GAS bf16_t* z = (const GAS bf16_t*)(ws + O_ZL1);
                    r.Q = z + row0 * NL1 + 3072 + h * 128; r.K = z + (size_t)b * SEQ * NL1 + h * 128; r.V = z + (size_t)b * SEQ * NL1 + 1536 + h * 128;
                    r.O = (GAS bf16_t*)(ws + O_CAT) + row0 * DM + h * 128;
                    const GAS float* ss = (const GAS float*)(ws + O_SSL1);
                    r.qss = ss + row0 * 112 + (12 + h) * 4; r.kss = ss + (size_t)b * SEQ * 112 + h * 4; r.cc = (const GAS float*)(ws + O_CC) + (size_t)bh * SEQ; r.gg = (const GAS float*)(ws + O_GG) + 384;
                    r.P0 = qb * 256; r.skv = SEQ;
                } else {
                    const int l = st == ST_A_MEM0 ? 0 : 1; const int i = blockIdx.x, qblk = i >> 2, h = i & 3, b = qblk >> 4; const size_t row0 = (size_t)qblk * 256;
                    r.Q = (const GAS bf16_t*)(ws + O_ZL1) + row0 * NL1 + 4608 + h * 128; r.qss = (const GAS float*)(ws + O_SSL1) + row0 * 112 + (24 + h) * 4;
                    const GAS bf16_t* kv = (const GAS bf16_t*)(ws + O_MKV) + ((size_t)l * NMROW + b * NMEM) * NL1;
                    r.K = kv + h * 128; r.V = kv + 512 + h * 128; r.kss = (const GAS float*)(ws + O_MKSS) + ((size_t)l * NMROW + b * NMEM) * 112 + h * 4;
                    r.O = (GAS bf16_t*)(ws + O_CAT) + row0 * DM + LRU + h * 128; r.cc = nullptr; r.gg = (const GAS float*)(ws + O_GG) + 128 * (1 + l);
                    r.P0 = SEQ; r.skv = NMEM;
                }
                att::Seam S;
                int tid_u; MAKE_TID(tid_u);
#ifndef DIS_ATTN
                if (st == ST_A_FOX) { att::attn_prime(r, (char*)lds, S, tid_u); att::attn_block(r, (char*)lds, S, tid_u); }
                else att::mem_attn_unit(r, (char*)lds, tid_u);
#endif
            }
        } else {
            MAKE_FRAME(F);
            switch (st) {
#ifndef DIS_MISC
            case ST_PROLOGUE: step_prologue(F, (LAS unsigned char*)lds); break;
            case ST_CONV: step_conv(F); break;
            case ST_SCAN1: step_scan1(F); break;
            case ST_SCAN2: step_scan2(F); break;
#endif
#ifndef DIS_TOPK
            case ST_TOPK0: step_topk(F, (LAS unsigned char*)lds, 0); break;
            case ST_TOPK1: step_topk(F, (LAS unsigned char*)lds, 1); break;
#endif
#ifndef DIS_GATHER
            case ST_UPASS0: step_upass(F, 0, G, (LAS unsigned char*)lds); break;
            case ST_UPASS1: step_upass(F, 1, G, (LAS unsigned char*)lds); break;
            case ST_PRED0: step_peer_reduce(F, 0); break;
            case ST_PRED1: step_peer_reduce(F, 1); break;
            case ST_VPASS0: step_vpass(F, 0, G, rep + 1 < nrep, (LAS unsigned char*)lds); break;
            case ST_VPASS1: step_vpass(F, 1, G, rep + 1 < nrep, (LAS unsigned char*)lds); break;
#endif
#ifndef DIS_MISC
            case ST_CPREFIX: step_cprefix(F, (LAS unsigned char*)lds); convert_tables(F, 1, G > 160 ? CONV1_SPLIT : 0, 2 * NEXP, F.gw, F.ngw); break;
#endif
            default: break;
            }
        }
        if (rep + 1 < nrep) xcd_barrier(gbar, wave_s);
      }
        if (((SYNC_AFTER >> st) & 1u) && st + 1 < args.hi) xcd_barrier(gbar, wave_s);
    }
}

#ifndef N_LAUNCH_MODE
#define N_LAUNCH_MODE 1
#endif
extern "C" void kernel_launch(void* const* d_in, const int* in_sizes, int n_in, void* d_out, int out_size, void* d_ws, size_t ws_size, hipStream_t stream) {
    static int grid = 0;
    if (grid == 0) {
        if (n_in != N_IN || in_sizes[0] != T * DM || out_size != T * DM || ws_size < WS_END) {
            fprintf(stderr, "kernel_launch: unexpected shapes (n_in %d, in0 %d, out %d, ws %zu, need %zu)\n", n_in, n_in > 0 ? in_sizes[0] : -1, out_size, ws_size, (size_t)WS_END); grid = -1; return; }
        int dev = 0, cus = 0, per_cu = 0;
        hipGetDevice(&dev); hipDeviceGetAttribute(&cus, hipDeviceAttributeMultiprocessorCount, dev);
        hipFuncSetAttribute((const void*)yoco_fwd, hipFuncAttributeMaxDynamicSharedMemorySize, LDS_BYTES);
        hipOccupancyMaxActiveBlocksPerMultiprocessor(&per_cu, (const void*)yoco_fwd, NTHREADS, LDS_BYTES);
        if (per_cu < 1) { fprintf(stderr, "kernel_launch: occupancy query says %d blocks per CU\n", per_cu); grid = -1; return; }
        grid = cus - cus % 8;
        (void)hipGetLastError();
    }
    if (grid < 0) return;
    Args a{};
    for (int i = 0; i < N_IN; ++i) a.in[i] = (const float*)d_in[i];
    a.out = (float*)d_out; a.ws = (unsigned char*)d_ws;
    if (hipMemsetAsync((char*)d_ws + O_CTL, 0, 65536, stream) != hipSuccess) { fprintf(stderr, "kernel_launch: memset of the barrier words failed\n"); return; }
    if (N_LAUNCH_MODE == 1) {
        a.lo = 0; a.hi = N_STEPS;
        hipLaunchKernelGGL(yoco_fwd, dim3(grid), dim3(NTHREADS), LDS_BYTES, stream, a);
        hipError_t e = hipPeekAtLastError();
        if (e != hipSuccess) fprintf(stderr, "launch failed: %s (grid %d)\n", hipGetErrorString(e), grid);
    } else {
        int lo = 0;
        for (int s = 0; s < N_STEPS; ++s) {
            if (((SYNC_AFTER >> s) & 1u) || s == N_STEPS - 1) {
                a.lo = lo; a.hi = s + 1; lo = s + 1;
                void* params[] = {&a};
                hipError_t e = hipLaunchCooperativeKernel((const void*)yoco_fwd, dim3(grid), dim3(NTHREADS), params, LDS_BYTES, stream);
                if (e != hipSuccess) { fprintf(stderr, "launch failed: %s\n", hipGetErrorString(e)); break; }
            }
        }
    }
}
```

```cpp
#include <hip/hip_runtime.h>
#include <hip/hip_cooperative_groups.h>
#include <cstdio>
#include <cstdint>
namespace cg = cooperative_groups;

#define LAS __attribute__((address_space(3)))
#define GAS __attribute__((address_space(1)))
typedef unsigned short bf16_t;
typedef short bf16x8 __attribute__((ext_vector_type(8)));
typedef short s16x4 __attribute__((ext_vector_type(4)));
typedef float f32x4 __attribute__((ext_vector_type(4)));
typedef float f32x2 __attribute__((ext_vector_type(2)));
typedef float f32x16 __attribute__((ext_vector_type(16)));
typedef unsigned u32x4 __attribute__((ext_vector_type(4)));
typedef unsigned u32x2 __attribute__((ext_vector_type(2)));
typedef _Float16 h2 __attribute__((ext_vector_type(2)));

constexpr int NB = 4, SEQ = 4096, T = NB * SEQ, DM = 2048, LRU = 1536, MEMW = 512, NMEM = 256, NH = 12, HD = 128;
constexpr int NIN0 = 3584, NL1 = 5120, NEXP = 16384, NMROW = NB * NMEM;
constexpr float EPS = 1e-6f;
constexpr int NTHREADS = 512, NWAVES = 8;

constexpr size_t MiB = 1u << 20;
constexpr size_t O_CTL = 0;
constexpr size_t O_WIN0 = 1 * MiB;
constexpr size_t O_WOUT0 = O_WIN0 + 14 * MiB;
constexpr size_t O_WL1 = O_WOUT0 + 8 * MiB;
constexpr size_t O_WOUT1 = O_WL1 + 20 * MiB;
constexpr size_t O_WQ0 = O_WOUT1 + 8 * MiB;
constexpr size_t O_WQ1 = O_WQ0 + 8 * MiB;
constexpr size_t O_WMKV = O_WQ1 + 8 * MiB;
constexpr size_t O_WGATE = O_WMKV + 8 * MiB;
constexpr size_t O_SUBK = O_WGATE + 1 * MiB;
constexpr size_t O_WF = O_SUBK + 1 * MiB;
constexpr size_t O_SMALL = O_WF + 1 * MiB;
constexpr size_t O_RS1 = O_SMALL;
constexpr size_t O_LOGF = O_SMALL + 64 * 1024;
constexpr size_t O_CC = O_LOGF + 768 * 1024;
constexpr size_t O_GG = O_CC + 768 * 1024;
constexpr size_t O_SPL = O_GG + 4096;
constexpr size_t O_TSC = O_SPL + 8192;
constexpr size_t O_ROWSS = O_SMALL + 2 * MiB;
constexpr size_t O_RSP = O_ROWSS + 2 * MiB;
constexpr size_t O_QMSS = O_RSP;
constexpr size_t O_MKSS = O_QMSS + 1 * MiB;
constexpr size_t O_SSL1 = O_MKSS + 1 * MiB;
constexpr size_t O_CARRY = O_SSL1 + 7 * MiB;
constexpr size_t O_MEMN = O_CARRY + 3 * MiB;
constexpr size_t O_MKV = O_MEMN + 8 * MiB;
constexpr size_t O_IDX = O_MKV + 20 * MiB;
constexpr size_t O_GW = O_IDX + 8 * MiB;
constexpr size_t O_TAB = O_GW + 8 * MiB;
constexpr size_t TAB_NIB = (size_t)8 * 16384 * 128, TAB_ONE = TAB_NIB + (size_t)16384 * 16 + 786432;
constexpr size_t O_XS16 = O_TAB + 128 * MiB;
constexpr size_t O_CAT = O_XS16 + 64 * MiB;
constexpr size_t O_ZX = O_CAT + 64 * MiB;
constexpr size_t O_X8 = O_ZX;
constexpr size_t O_GY = O_ZX + 48 * MiB;
constexpr size_t O_LOGFP = O_GY + 48 * MiB;
constexpr size_t O_QM = O_LOGFP;
constexpr size_t O_XC = O_QM + 16 * MiB;
constexpr size_t O_X4 = O_XC;
constexpr size_t O_SX = O_XC + 32 * MiB;
constexpr size_t O_AA = O_XC + 48 * MiB;
constexpr size_t O_PART = O_AA;
constexpr size_t O_UU = O_AA + 96 * MiB;
constexpr size_t O_W8 = O_UU;
constexpr size_t O_Q16 = O_UU + 96 * MiB;
constexpr size_t O_ZL1 = O_Q16 + 64 * MiB;
constexpr size_t WS_END = O_ZL1 + 160 * MiB;
static_assert(WS_END <= 1024 * MiB, "workspace map");

__device__ __forceinline__ unsigned cvtpk(float lo, float hi) { unsigned r; asm volatile("v_cvt_pk_bf16_f32 %0, %1, %2" : "=v"(r) : "v"(lo), "v"(hi)); return r; }
__device__ __forceinline__ float bf_lo(unsigned w) { return __uint_as_float(w << 16); }
__device__ __forceinline__ float bf_hi(unsigned w) { return __uint_as_float(w & 0xffff0000u); }
__device__ __forceinline__ float fast_exp(float x) { return __builtin_amdgcn_exp2f(x * 1.4426950408889634f); }
__device__ __forceinline__ float log1p_pos(float y) { const float ser = y * (1.f - y * (0.5f - y * (0.33333334f - 0.25f * y))); const float lg = __builtin_amdgcn_logf(1.f + y) * 0.6931471805599453f; return y < 0.03f ? ser : lg; }
__device__ __forceinline__ float one_minus_exp(float x) { const float ser = -x * (1.f + x * (0.5f + x * (0.16666667f + x * 0.041666668f))); const float big = 1.f - fast_exp(x); return x > -0.03f ? ser : big; }
__device__ __forceinline__ float sigmoidf_(float x) { return __builtin_amdgcn_rcpf(1.f + fast_exp(-x)); }
__device__ __forceinline__ float gelu_tanh(float x) { const float u = x * (1.f + 0.044715f * x * x); return x * __builtin_amdgcn_rcpf(1.f + __builtin_amdgcn_exp2f(u * (-2.f * 0.7978845608028654f * 1.4426950408889634f))); }
template <int CTRL> __device__ __forceinline__ float dppf(float v) { return __int_as_float(__builtin_amdgcn_update_dpp(0, __float_as_int(v), CTRL, 0xF, 0xF, true)); }
__device__ __forceinline__ float xsum16(float v) { auto r = __builtin_amdgcn_permlane16_swap(__float_as_uint(v), __float_as_uint(v), false, false); return __uint_as_float(r[0]) + __uint_as_float(r[1]); }
__device__ __forceinline__ float xsum32(float v) { auto r = __builtin_amdgcn_permlane32_swap(__float_as_uint(v), __float_as_uint(v), false, false); return __uint_as_float(r[0]) + __uint_as_float(r[1]); }
__device__ __forceinline__ float xmax16(float v) { auto r = __builtin_amdgcn_permlane16_swap(__float_as_uint(v), __float_as_uint(v), false, false); return fmaxf(__uint_as_float(r[0]), __uint_as_float(r[1])); }
__device__ __forceinline__ float xmax32(float v) { auto r = __builtin_amdgcn_permlane32_swap(__float_as_uint(v), __float_as_uint(v), false, false); return fmaxf(__uint_as_float(r[0]), __uint_as_float(r[1])); }
__device__ __forceinline__ float wave_sum(float v) {
    v += dppf<0xB1>(v); v += dppf<0x4E>(v); v += dppf<0x141>(v); v += dppf<0x140>(v);
    v = xsum16(v); v = xsum32(v); return v;
}
__device__ __forceinline__ float wave_max(float v) {
    v = fmaxf(v, dppf<0xB1>(v)); v = fmaxf(v, dppf<0x4E>(v)); v = fmaxf(v, dppf<0x141>(v)); v = fmaxf(v, dppf<0x140>(v));
    v = xmax16(v); v = xmax32(v); return v;
}

namespace pg8 {
constexpr int BM = 256, BK = 64, HALF = 128, HTB = HALF * BK * 2, STAGE_BYTES = 8 * HTB, NXCD = 8, WGM = 8;
__host__ __device__ __forceinline__ int lds_byte(int r, int c) { const int st = (r >> 4) * 2 + (c >> 5), rr = r & 15, cc = c & 31, ob = rr * 64 + cc * 2; return st * 1024 + (ob ^ (((ob >> 9) & 1) << 5)); }
__host__ __device__ __forceinline__ void stage_rc(int b, int& R, int& C) { const int st = b / 1024, sb = b % 1024, swz = sb ^ (((sb >> 9) & 1) << 5); R = (st >> 1) * 16 + swz / 64; C = (st & 1) * 32 + (swz % 64) / 2; }
__host__ __device__ __forceinline__ int perm32(int rho) { const int n = rho >> 4, i = rho & 15; return 8 * (i >> 2) + 4 * n + (i & 3); }

struct Unit { int pm, pn; };
struct Gemm { const GAS bf16_t* A; const GAS bf16_t* Bt; int M, N, K, lda, ldb, acol; };

struct StaticOrder {
    int nM, nN, nwg, G, c;
    __device__ void init(int M, int N, int G_, int c_) { nM = M / BM; nN = N / BM; nwg = nM * nN; G = G_; c = c_; }
    __device__ bool next(int i, Unit& u) const {
        const long L = (long)i * G + c; if (L >= nwg) return false;
        int wgid = (int)L; { const int q = nwg / NXCD, r = nwg % NXCD, xcd = wgid % NXCD, off = wgid / NXCD; wgid = (xcd < r ? xcd * (q + 1) : r * (q + 1) + (xcd - r) * q) + off; }
        const int nig = WGM * nN, gid = wgid / nig, fm = gid * WGM, gsz = (nM - fm) < WGM ? (nM - fm) : WGM;
        u.pm = fm + ((wgid % nig) % gsz); u.pn = (wgid % nig) / gsz; return true;
    }
};

typedef int v8i_t __attribute__((ext_vector_type(8)));
typedef int v4i_t __attribute__((ext_vector_type(4)));
template <class Epi, bool FP8>
__device__ __forceinline__ void gemm_phase(LAS unsigned char* lds, const Gemm g, const StaticOrder& S, const Epi& E, const int tid) {
    const int wid = __builtin_amdgcn_readfirstlane(tid >> 6), lane = tid & 63, wr = wid >> 2, wc = wid & 3, fr = lane & 15, fq = lane >> 4;
    const int K = g.K, nt = K / BK;
    unsigned voffA[2], voffB[2];
#pragma unroll
    for (int i = 0; i < 2; ++i) { int R, C; stage_rc(tid * 16 + i * 8192, R, C); const int Rb = (R & ~31) + perm32(R & 31);
        voffA[i] = (unsigned)(R * g.lda + C) * 2u; voffB[i] = (unsigned)(Rb * g.ldb + C) * 2u; }
    const size_t kstep = (size_t)(BK * 2);
    const size_t hstepA = (size_t)HALF * g.lda * 2, hstepB = (size_t)HALF * g.ldb * 2;
    const size_t tstepA = 2 * hstepA, tstepB = 2 * hstepB;
    const unsigned ldsw = (unsigned)wid * 1024u;
    const int aoff = lds_byte(wr * 64 + fr, fq * 8), boff = lds_byte(wc * 32 + fr, fq * 8);
#define PG8_SA(b, h) (((b) * 2 + (h)) * HTB)
#define PG8_SB(b, h) ((4 + (b) * 2 + (h)) * HTB)
#define PG8_STAGE(bufoff, gbase, voff) do { _Pragma("unroll") for (int _i = 0; _i < 2; ++_i) \
        __builtin_amdgcn_global_load_lds((const GAS unsigned*)((gbase) + (voff)[_i]), (LAS unsigned*)(lds + (bufoff) + ldsw + _i * 8192), 16, 0, 0); } while (0)
#define PG8_LD2(dst, off_) do { const u32x4 lo_ = *(const LAS u32x4*)(lds + (off_)), hi_ = *(const LAS u32x4*)(lds + (off_) + 1024); \
        dst = (v8i_t){(int)lo_.x, (int)lo_.y, (int)lo_.z, (int)lo_.w, (int)hi_.x, (int)hi_.y, (int)hi_.z, (int)hi_.w}; } while (0)
#define PG8_LDA(dst, b, h) do { _Pragma("unroll") for (int m = 0; m < 4; ++m) PG8_LD2(dst[m], PG8_SA(b, h) + aoff + m * 2048); } while (0)
#define PG8_LDB(dst, b, h) do { _Pragma("unroll") for (int n = 0; n < 2; ++n) PG8_LD2(dst[n], PG8_SB(b, h) + boff + n * 2048); } while (0)
#define PG8_HALF(v, k) ((k) ? __builtin_shufflevector(v, v, 4, 5, 6, 7) : __builtin_shufflevector(v, v, 0, 1, 2, 3))
#define PG8_MMA(ai, bj, At, Bt) do { __builtin_amdgcn_s_setprio(1); _Pragma("unroll") for (int m = 0; m < 4; ++m) _Pragma("unroll") for (int n = 0; n < 2; ++n) { \
        if constexpr (FP8) asm volatile("v_mfma_scale_f32_16x16x128_f8f6f4 %0, %1, %2, %0, %3, %4 op_sel_hi:[0,0,0]" : "+v"(acc[ai][bj][m][n]) : "v"(Bt[n]), "v"(At[m]), "v"(sc_w), "v"(sc_x));     \
        else { _Pragma("unroll") for (int k = 0; k < 2; ++k) { const v4i_t bh_ = PG8_HALF(Bt[n], k), ah_ = PG8_HALF(At[m], k); \
                acc[ai][bj][m][n] = __builtin_amdgcn_mfma_f32_16x16x32_bf16(__builtin_bit_cast(bf16x8, bh_), __builtin_bit_cast(bf16x8, ah_), acc[ai][bj][m][n], 0, 0, 0); } } } \
        __builtin_amdgcn_s_setprio(0); } while (0)
#define PG8_WAIT_V(n) asm volatile("s_waitcnt vmcnt(" #n ")" ::: "memory")
#define PG8_WAIT_L(n) asm volatile("s_waitcnt lgkmcnt(" #n ")" ::: "memory")
#define PG8_BAR __builtin_amdgcn_s_barrier()
#define PG8_SCHED __builtin_amdgcn_sched_barrier(0)
    Unit cur, nxt; int ui = 0;
    if (!S.next(0, cur)) return;
    f32x4 acc[2][2][4][2];
#pragma unroll
    for (int a = 0; a < 2; ++a)
#pragma unroll
        for (int b = 0; b < 2; ++b)
#pragma unroll
            for (int m = 0; m < 4; ++m)
#pragma unroll
                for (int n = 0; n < 2; ++n) acc[a][b][m][n] = (f32x4){0.f, 0.f, 0.f, 0.f};
    v8i_t At[4], B0[2], B1[2];
    const int sc_w = 121, sc_x = 127;
    const GAS char* cA = (const GAS char*)g.A + (size_t)cur.pm * tstepA + (size_t)cur.pn * g.acol * 2; const GAS char* cB = (const GAS char*)g.Bt + (size_t)cur.pn * tstepB;
    PG8_STAGE(PG8_SB(0, 0), cB, voffB); PG8_STAGE(PG8_SB(0, 1), cB + hstepB, voffB); PG8_STAGE(PG8_SA(0, 0), cA, voffA); PG8_STAGE(PG8_SA(0, 1), cA + hstepA, voffA);
    if (wr == 1) PG8_BAR;
    PG8_WAIT_V(2); PG8_BAR;
    PG8_STAGE(PG8_SB(1, 0), cB + kstep, voffB); PG8_STAGE(PG8_SA(1, 0), cA + kstep, voffA); PG8_STAGE(PG8_SB(1, 1), cB + hstepB + kstep, voffB);
    PG8_WAIT_V(6); PG8_BAR;
    for (;;) {
        const bool has_next = S.next(ui + 1, nxt);
        const GAS char* nA = has_next ? (const GAS char*)g.A + (size_t)nxt.pm * tstepA + (size_t)nxt.pn * g.acol * 2 : cA; const GAS char* nB = has_next ? (const GAS char*)g.Bt + (size_t)nxt.pn * tstepB : cB;
        for (int t = 0; t < nt; t += 2) {
            const bool last = (t == nt - 2);
            const GAS char* a1 = cA + (size_t)(t + 1) * kstep;
            const GAS char* a2 = last ? nA : cA + (size_t)(t + 2) * kstep; const GAS char* b2 = last ? nB : cB + (size_t)(t + 2) * kstep;
            const GAS char* a3 = a2 + kstep; const GAS char* b3 = b2 + kstep;
            PG8_LDB(B0, 0, 0); PG8_LDB(B1, 0, 1); PG8_SCHED; PG8_LDA(At, 0, 0); PG8_STAGE(PG8_SA(1, 1), a1 + hstepA, voffA);
            PG8_WAIT_V(8); PG8_WAIT_L(0); PG8_BAR; PG8_MMA(0, 0, At, B0); PG8_MMA(0, 1, At, B1); PG8_BAR; PG8_SCHED;
            PG8_LDA(At, 0, 1); PG8_STAGE(PG8_SB(0, 0), b2, voffB); PG8_STAGE(PG8_SB(0, 1), b2 + hstepB, voffB); PG8_STAGE(PG8_SA(0, 0), a2, voffA);
            PG8_WAIT_V(8); PG8_WAIT_L(0); PG8_BAR; PG8_MMA(1, 0, At, B0); PG8_MMA(1, 1, At, B1); PG8_BAR; PG8_SCHED;
            PG8_LDB(B0, 1, 0); PG8_LDB(B1, 1, 1); PG8_SCHED; PG8_LDA(At, 1, 0); PG8_STAGE(PG8_SA(0, 1), a2 + hstepA, voffA);
            PG8_WAIT_V(8); PG8_WAIT_L(0); PG8_BAR; PG8_MMA(0, 0, At, B0); PG8_MMA(0, 1, At, B1); PG8_BAR; PG8_SCHED;
            PG8_LDA(At, 1, 1); PG8_STAGE(PG8_SB(1, 0), b3, voffB); PG8_STAGE(PG8_SB(1, 1), b3 + hstepB, voffB); PG8_STAGE(PG8_SA(1, 0), a3, voffA);
            PG8_WAIT_V(8); PG8_WAIT_L(0); PG8_BAR; PG8_MMA(1, 0, At, B0); PG8_MMA(1, 1, At, B1); PG8_BAR; PG8_SCHED;
        }
        if (wr == 0) PG8_BAR;
        { int ln_; asm volatile("v_mbcnt_lo_u32_b32 %0, -1, 0\n\tv_mbcnt_hi_u32_b32 %0, -1, %0" : "=v"(ln_));
          E(acc, cur, wr, wc, ln_ & 15, ln_ >> 4); }
        if (!has_next) break;
#pragma unroll
        for (int a = 0; a < 2; ++a)
#pragma unroll
            for (int b = 0; b < 2; ++b)
#pragma unroll
                for (int m = 0; m < 4; ++m)
#pragma unroll
                    for (int n = 0; n < 2; ++n) acc[a][b][m][n] = (f32x4){0.f, 0.f, 0.f, 0.f};
        cur = nxt; cA = nA; cB = nB; ++ui;
        if (wr == 1) PG8_BAR;
    }
    PG8_WAIT_V(0);
    PG8_BAR;
#undef PG8_SA
#undef PG8_SB
#undef PG8_STAGE
#undef PG8_LDA
#undef PG8_LDB
#undef PG8_LD2
#undef PG8_HALF
#undef PG8_MMA
#undef PG8_WAIT_V
#undef PG8_WAIT_L
#undef PG8_BAR
#undef PG8_SCHED
}
}

enum { EM_IN0 = 0, EM_MKV = 1, EM_GATE = 2, EM_RES = 3, EM_PQ = 4, EM_L1 = 5 };
struct Epi {
    int mode;
    GAS unsigned char* ws;
    const GAS float* resid;
    GAS float* outf;
    GAS bf16_t* o16;
    GAS float* ssq;
    const GAS float* gate_b;
    typedef pg8::Unit Unit;
    __device__ __forceinline__ static void st8(GAS bf16_t* p, f32x4 v0, f32x4 v1) {
        u32x4 w; w.x = cvtpk(v0[0], v0[1]); w.y = cvtpk(v0[2], v0[3]); w.z = cvtpk(v1[0], v1[1]); w.w = cvtpk(v1[2], v1[3]); *(GAS u32x4*)p = w; }
    __device__ __forceinline__ static float sq8(f32x4 a, f32x4 b) { return (a[0] * a[0] + a[1] * a[1]) + (a[2] * a[2] + a[3] * a[3]) + (b[0] * b[0] + b[1] * b[1]) + (b[2] * b[2] + b[3] * b[3]); }
    __device__ __forceinline__ void operator()(f32x4 (&acc)[2][2][4][2], const Unit& u, int wr, int wc, int fr, int fq) const {
        const int row0 = u.pm * 256 + wr * 64 + fr;
        const int cin = wc * 32 + 8 * fq;
        if (mode == EM_IN0) {
            GAS bf16_t* base; int ld, colt; int kind;
            if (u.pn < 6) { base = (GAS bf16_t*)(ws + O_ZX); ld = LRU; colt = u.pn * 256; kind = 0; }
            else if (u.pn < 12) { base = (GAS bf16_t*)(ws + O_GY); ld = LRU; colt = (u.pn - 6) * 256; kind = 1; }
            else { base = (GAS bf16_t*)(ws + O_ZL1); ld = NL1; colt = 4608 + (u.pn - 12) * 256; kind = 2; }
            GAS float* qmss = (GAS float*)(ws + O_SSL1);
#pragma unroll
            for (int ai = 0; ai < 2; ++ai)
#pragma unroll
                for (int m = 0; m < 4; ++m) { const int row = row0 + ai * 128 + m * 16;
#pragma unroll
                    for (int bj = 0; bj < 2; ++bj) { f32x4 v0 = acc[ai][bj][m][0], v1 = acc[ai][bj][m][1];
                        if (kind == 1) {
#pragma unroll
                            for (int j = 0; j < 4; ++j) { v0[j] = gelu_tanh(v0[j]); v1[j] = gelu_tanh(v1[j]); } }
                        st8(base + (size_t)row * ld + colt + bj * 128 + cin, v0, v1);
                        if (kind == 2) { float s = sq8(v0, v1); s = xsum16(s); s = xsum32(s);
                            if (fq == 0) qmss[((size_t)(24 + (u.pn - 12) * 2 + bj) * T + row) * 4 + wc] = s; } } }
        } else if (mode == EM_MKV) {
#pragma unroll
            for (int ai = 0; ai < 2; ++ai)
#pragma unroll
                for (int m = 0; m < 4; ++m) { const int row = row0 + ai * 128 + m * 16;
#pragma unroll
                    for (int bj = 0; bj < 2; ++bj) { const f32x4 v0 = acc[ai][bj][m][0], v1 = acc[ai][bj][m][1];
                        st8(o16 + (size_t)row * NL1 + u.pn * 256 + bj * 128 + cin, v0, v1);
                        if (u.pn < 2) { float s = sq8(v0, v1); s = xsum16(s); s = xsum32(s);
                            if (fq == 0) ssq[((size_t)(u.pn * 2 + bj) * NMROW + row) * 4 + wc] = s; } } }
        } else if (mode == EM_GATE) {
            const int ch = u.pn * 128 + cin;
            const GAS bf16_t* xc = (const GAS bf16_t*)(ws + O_XC); GAS _Float16* LA = (GAS _Float16*)(ws + O_AA); GAS _Float16* UH = (GAS _Float16*)(ws + O_UU);
            const GAS float* spl = (const GAS float*)(ws + O_SPL) + ch; const GAS float* gb = gate_b + u.pn * 256 + cin;
            f32x4 sp[2], br[2], bi[2];
#pragma unroll
            for (int n = 0; n < 2; ++n) { sp[n] = *(const GAS f32x4*)(spl + 4 * n); br[n] = *(const GAS f32x4*)(gb + 4 * n); bi[n] = *(const GAS f32x4*)(gb + 128 + 4 * n); }
            u32x4 xwn = *(const GAS u32x4*)(xc + (size_t)row0 * LRU + ch);
#pragma unroll
            for (int it = 0; it < 8; ++it) { const int ai = it >> 2, m = it & 3; const int row = row0 + ai * 128 + m * 16;
                const u32x4 xw = xwn;
                if (it + 1 < 8) xwn = *(const GAS u32x4*)(xc + (size_t)(row0 + ((it + 1) >> 2) * 128 + ((it + 1) & 3) * 16) * LRU + ch);
                u32x4 lw, uw;
#pragma unroll
                for (int n = 0; n < 2; ++n) { const f32x4 xv = {bf_lo(xw[2 * n]), bf_hi(xw[2 * n]), bf_lo(xw[2 * n + 1]), bf_hi(xw[2 * n + 1])};
                    float lav[4], uvv[4];
#pragma unroll
                    for (int j = 0; j < 4; ++j) { const float r = sigmoidf_(acc[ai][0][m][n][j] + br[n][j]), ig = sigmoidf_(acc[ai][1][m][n][j] + bi[n][j]);
                        const float la = -8.f * r * sp[n][j];
                        lav[j] = la; uvv[j] = __builtin_amdgcn_sqrtf(one_minus_exp(2.f * la)) * (ig * xv[j]); }
                    const h2 l0 = {(_Float16)lav[0], (_Float16)lav[1]}, l1 = {(_Float16)lav[2], (_Float16)lav[3]}, u0 = {(_Float16)uvv[0], (_Float16)uvv[1]}, u1 = {(_Float16)uvv[2], (_Float16)uvv[3]};
                    lw[2 * n] = __builtin_bit_cast(unsigned, l0); lw[2 * n + 1] = __builtin_bit_cast(unsigned, l1); uw[2 * n] = __builtin_bit_cast(unsigned, u0); uw[2 * n + 1] = __builtin_bit_cast(unsigned, u1); }
                *(GAS u32x4*)(LA + (size_t)row * LRU + ch) = lw; *(GAS u32x4*)(UH + (size_t)row * LRU + ch) = uw; }
        } else if (mode == EM_RES) {
            GAS bf16_t* xs = (GAS bf16_t*)(ws + O_XS16); GAS float* rowss = (GAS float*)(ws + O_ROWSS);
#pragma unroll
            for (int ai = 0; ai < 2; ++ai)
#pragma unroll
                for (int m = 0; m < 4; ++m) { const int row = row0 + ai * 128 + m * 16; float s = 0.f;
#pragma unroll
                    for (int bj = 0; bj < 2; ++bj) { const size_t off = (size_t)row * DM + u.pn * 256 + bj * 128 + cin;
                        f32x4 r0, r1;
                        if (resid) { r0 = *(const GAS f32x4*)(resid + off); r1 = *(const GAS f32x4*)(resid + off + 4); }
                        else { const u32x4 w = *(const GAS u32x4*)(xs + off); r0 = (f32x4){bf_lo(w.x), bf_hi(w.x), bf_lo(w.y), bf_hi(w.y)}; r1 = (f32x4){bf_lo(w.z), bf_hi(w.z), bf_lo(w.w), bf_hi(w.w)}; }
                        const f32x4 v0 = acc[ai][bj][m][0] + r0, v1 = acc[ai][bj][m][1] + r1;
                        st8(xs + off, v0, v1); s += sq8(v0, v1); }
                    s = xsum16(s); s = xsum32(s);
                    if (fq == 0) rowss[(size_t)row * 32 + u.pn * 4 + wc] = s; }
        } else if (mode == EM_PQ) {
            const GAS float* rowss = (const GAS float*)(ws + O_ROWSS);
#pragma unroll
            for (int ai = 0; ai < 2; ++ai)
#pragma unroll
                for (int m = 0; m < 4; ++m) { const int row = row0 + ai * 128 + m * 16;
                    const f32x4 p0 = *(const GAS f32x4*)(rowss + (size_t)row * 32 + fq * 8), p1 = *(const GAS f32x4*)(rowss + (size_t)row * 32 + fq * 8 + 4);
                    float s = (p0[0] + p0[1]) + (p0[2] + p0[3]) + (p1[0] + p1[1]) + (p1[2] + p1[3]); s = xsum16(s); s = xsum32(s);
                    const float r = rsqrtf(s * (1.f / DM) + EPS);
#pragma unroll
                    for (int bj = 0; bj < 2; ++bj) st8(o16 + (size_t)row * DM + u.pn * 256 + bj * 128 + cin, acc[ai][bj][m][0] * r, acc[ai][bj][m][1] * r); }
        } else {
            const GAS float* rsp = (const GAS float*)(ws + O_RSP); GAS bf16_t* zl1 = (GAS bf16_t*)(ws + O_ZL1); GAS float* ssl1 = (GAS float*)(ws + O_SSL1);
            const int slot0 = u.pn < 6 ? u.pn * 2 : (u.pn >= 12 ? 12 + (u.pn - 12) * 2 : -1);
#pragma unroll
            for (int ai = 0; ai < 2; ++ai)
#pragma unroll
                for (int m = 0; m < 4; ++m) { const int row = row0 + ai * 128 + m * 16;
                    const f32x4 q0 = *(const GAS f32x4*)(rsp + (size_t)row * 8), q1 = *(const GAS f32x4*)(rsp + (size_t)row * 8 + 4);
                    const float r = rsqrtf(((q0[0] + q0[1]) + (q0[2] + q0[3]) + (q1[0] + q1[1]) + (q1[2] + q1[3])) * (1.f / DM) + EPS);
#pragma unroll
                    for (int bj = 0; bj < 2; ++bj) { const f32x4 v0 = acc[ai][bj][m][0] * r, v1 = acc[ai][bj][m][1] * r;
                        st8(zl1 + (size_t)row * NL1 + u.pn * 256 + bj * 128 + cin, v0, v1);
                        if (slot0 >= 0) { float s = sq8(v0, v1); s = xsum16(s); s = xsum32(s);
                            if (fq == 0) ssl1[((size_t)(slot0 + bj) * T + row) * 4 + wc] = s; } } }
        }
    }
};

namespace att {
constexpr float SCALE = 0.08838834764831845f;
constexpr int NW = 8, QBLK = 32, KVBLK = 64, QB = NW * QBLK, D = 128;
constexpr int SHM_V = KVBLK * D * 2, SHM_K = KVBLK * D * 2;
constexpr int OFF_WS = 2 * SHM_V + 2 * SHM_K;
constexpr int OFF_KS = OFF_WS + 2048;
constexpr int OFF_BS = OFF_KS + 16384;
constexpr int LDS_END = OFF_BS + 16384;
constexpr int WBIG = 1 << 28;

#define KSWZ(row, colB) ((row) * 256 + ((colB) ^ (((row) & 7) << 4)))
#define SBAR() __builtin_amdgcn_sched_barrier(0)
__device__ __forceinline__ int v_st(int k, int c) { const int kk = (k & ~0xC) | ((k & 4) << 1) | ((k & 8) >> 1); return ((kk >> 3) * 4 + (c >> 5)) * 512 + ((kk & 7) * 32 + (c & 31)) * 2; }
__device__ __forceinline__ int v_rd_base(int lane) { return ((lane & 3) << 3) | (((lane >> 2) & 3) << 6) | (((lane >> 4) & 1) << 5) | (((lane >> 5) & 1) << 8); }
constexpr int v_rd_off(int d0, int ks, int half) { return d0 * 512 + ks * 4096 + half * 2048; }
__device__ __forceinline__ int crow(int r, int hi) { return (r & 3) + 8 * (r >> 2) + 4 * hi; }
__device__ __forceinline__ bf16x8 load8(const GAS bf16_t* p) { return *(const GAS bf16x8*)p; }
__device__ __forceinline__ bf16x8 scale8(bf16x8 v, float s) { const u32x4 w = *reinterpret_cast<u32x4*>(&v); u32x4 o;
    o.x = cvtpk(bf_lo(w.x) * s, bf_hi(w.x) * s); o.y = cvtpk(bf_lo(w.y) * s, bf_hi(w.y) * s); o.z = cvtpk(bf_lo(w.z) * s, bf_hi(w.z) * s); o.w = cvtpk(bf_lo(w.w) * s, bf_hi(w.w) * s);
    return *reinterpret_cast<bf16x8*>(&o); }
__device__ __forceinline__ void mask_tile(f32x16& p0, f32x16& p1, int dq, unsigned W) {
    const float NEG = -__builtin_inff();
#pragma unroll
    for (int r = 0; r < 16; ++r) {
        const int c = (r & 3) + 8 * (r >> 2);
        if ((unsigned)(dq - c) >= W) p0[r] = NEG;
        if ((unsigned)(dq - c - 32) >= W) p1[r] = NEG;
    }
}
constexpr float THR = 8.f;
__device__ __forceinline__ void partialSM(f32x16& p0, f32x16& p1, float& m_reg, float& mn, float& alpha) {
    float pmax = p0[0]; for (int r = 1; r < 16; ++r) pmax = fmaxf(pmax, p0[r]); for (int r = 0; r < 16; ++r) pmax = fmaxf(pmax, p1[r]);
    { auto rr = __builtin_amdgcn_permlane32_swap(__float_as_uint(pmax), __float_as_uint(pmax), false, false);
      pmax = fmaxf(__uint_as_float(rr[0]), __uint_as_float(rr[1])); }
    constexpr float C2 = 1.4426950408889634f * SCALE;
    if (__builtin_expect(__all((pmax - m_reg) * SCALE <= THR), 1)) { mn = m_reg; alpha = 1.f; }
    else { mn = fmaxf(m_reg, pmax); alpha = __builtin_amdgcn_exp2f((m_reg - mn) * C2); m_reg = mn; }
    const float mnL = -mn * C2;
    for (int r = 0; r < 16; ++r) p0[r] = fmaf(p0[r], C2, mnL); for (int r = 0; r < 16; ++r) p1[r] = fmaf(p1[r], C2, mnL);
    for (int r = 0; r < 16; ++r) p0[r] = __builtin_amdgcn_exp2f(p0[r]);
}
__device__ __forceinline__ void finishSM(f32x16& p0, f32x16& p1, float alpha, float& l_reg, bf16x8& pa0, bf16x8& pa1, bf16x8& pa2, bf16x8& pa3) {
    for (int r = 0; r < 16; ++r) p1[r] = __builtin_amdgcn_exp2f(p1[r]);
    float ps = 0; for (int r = 0; r < 16; ++r) ps += p0[r]; for (int r = 0; r < 16; ++r) ps += p1[r];
    { auto rr = __builtin_amdgcn_permlane32_swap(__float_as_uint(ps), __float_as_uint(ps), false, false);
      ps = __uint_as_float(rr[0]) + __uint_as_float(rr[1]); }
    l_reg = l_reg * alpha + ps;
#define PK4(P, B_, OUT) do { unsigned a0 = cvtpk(P[B_+0], P[B_+1]), a1 = cvtpk(P[B_+2], P[B_+3]);                          \
        unsigned b0 = cvtpk(P[B_+4], P[B_+5]), b1 = cvtpk(P[B_+6], P[B_+7]);                                             \
        auto r0 = __builtin_amdgcn_permlane32_swap(a0, b0, false, false); auto r1 = __builtin_amdgcn_permlane32_swap(a1, b1, false, false); \
        u32x4 w = {r0[0], r1[0], r0[1], r1[1]}; OUT = *reinterpret_cast<bf16x8*>(&w); } while (0)
    PK4(p0, 0, pa0); PK4(p0, 8, pa1); PK4(p1, 0, pa2); PK4(p1, 8, pa3);
#undef PK4
}
template <int KB>
__device__ __forceinline__ void qkt(f32x16& p0, f32x16& p1, const char* K_lds, int r32, int hi, const bf16x8* qr, const float* bp  ) {
    { const f32x4 a = *(const f32x4*)(bp), b = *(const f32x4*)(bp + 8), c = *(const f32x4*)(bp + 16), d = *(const f32x4*)(bp + 24);
      p0 = (f32x16){a[0], a[1], a[2], a[3], b[0], b[1], b[2], b[3], c[0], c[1], c[2], c[3], d[0], d[1], d[2], d[3]}; }
    { const f32x4 a = *(const f32x4*)(bp + 32), b = *(const f32x4*)(bp + 40), c = *(const f32x4*)(bp + 48), d = *(const f32x4*)(bp + 56);
      p1 = (f32x16){a[0], a[1], a[2], a[3], b[0], b[1], b[2], b[3], c[0], c[1], c[2], c[3], d[0], d[1], d[2], d[3]}; }
    const char* kb[4];
#pragma unroll
    for (int dd = 0; dd < 4; ++dd) kb[dd] = K_lds + KB * SHM_K + KSWZ(r32, (dd * 16 + hi * 8) * 2);
#pragma unroll
    for (int d0 = 0; d0 < 8; ++d0) { const char* a = kb[d0 & 3] + (d0 >> 2) * 128;
        bf16x8 b0 = *reinterpret_cast<const bf16x8*>(a);
        bf16x8 b1 = *reinterpret_cast<const bf16x8*>(a + 32 * 256);
        p0 = __builtin_amdgcn_mfma_f32_32x32x16_bf16(b0, qr[d0], p0, 0, 0, 0);
        p1 = __builtin_amdgcn_mfma_f32_32x32x16_bf16(b1, qr[d0], p1, 0, 0, 0); }
}
template <int KB>
__device__ __forceinline__ void qkt0(f32x16& p0, f32x16& p1, const char* K_lds, int r32, int hi, const bf16x8* qr) {
    p0 = f32x16{}; p1 = f32x16{};
    const char* kb[4];
#pragma unroll
    for (int dd = 0; dd < 4; ++dd) kb[dd] = K_lds + KB * SHM_K + KSWZ(r32, (dd * 16 + hi * 8) * 2);
#pragma unroll
    for (int d0 = 0; d0 < 8; ++d0) { const char* a = kb[d0 & 3] + (d0 >> 2) * 128;
        bf16x8 b0 = *reinterpret_cast<const bf16x8*>(a);
        bf16x8 b1 = *reinterpret_cast<const bf16x8*>(a + 32 * 256);
        p0 = __builtin_amdgcn_mfma_f32_32x32x16_bf16(b0, qr[d0], p0, 0, 0, 0);
        p1 = __builtin_amdgcn_mfma_f32_32x32x16_bf16(b1, qr[d0], p1, 0, 0, 0); }
}
template <int VB>
__device__ __forceinline__ void pv_tile(f32x16* o, int vb0, bf16x8 pa0, bf16x8 pa1, bf16x8 pa2, bf16x8 pa3) {
#define TRRD(dst, off) asm volatile("ds_read_b64_tr_b16 %0, %1 offset:%2" : "=&v"(dst) : "v"(vb0), "i"(off) : "memory")
#define PV_D0(d0) do { s16x4 l0, l1, l2, l3, h0, h1, h2_, h3; constexpr int b_ = VB * SHM_V + v_rd_off(d0, 0, 0); \
        TRRD(l0, b_); TRRD(h0, b_ + 2048); TRRD(l1, b_ + 4096); TRRD(h1, b_ + 6144); TRRD(l2, b_ + 8192); TRRD(h2_, b_ + 10240); TRRD(l3, b_ + 12288); TRRD(h3, b_ + 14336); \
        asm volatile("s_waitcnt lgkmcnt(0)" ::: "memory"); SBAR();   \
        o[d0] = __builtin_amdgcn_mfma_f32_32x32x16_bf16(pa0, (bf16x8){l0[0], l0[1], l0[2], l0[3], h0[0], h0[1], h0[2], h0[3]}, o[d0], 0, 0, 0);   \
        o[d0] = __builtin_amdgcn_mfma_f32_32x32x16_bf16(pa1, (bf16x8){l1[0], l1[1], l1[2], l1[3], h1[0], h1[1], h1[2], h1[3]}, o[d0], 0, 0, 0);   \
        o[d0] = __builtin_amdgcn_mfma_f32_32x32x16_bf16(pa2, (bf16x8){l2[0], l2[1], l2[2], l2[3], h2_[0], h2_[1], h2_[2], h2_[3]}, o[d0], 0, 0, 0);   \
        o[d0] = __builtin_amdgcn_mfma_f32_32x32x16_bf16(pa3, (bf16x8){l3[0], l3[1], l3[2], l3[3], h3[0], h3[1], h3[2], h3[3]}, o[d0], 0, 0, 0); } while (0)
    PV_D0(0); PV_D0(1); PV_D0(2); PV_D0(3);
#undef PV_D0
#undef TRRD
}

struct BlockRef { const GAS bf16_t* Q; const GAS bf16_t* K; const GAS bf16_t* V; GAS bf16_t* O; const GAS float* qss; const GAS float* kss; const GAS float* cc; const GAS float* gg;
                  int P0, skv; };
constexpr int LDQ = 5120, LDK = 5120, LDO = 2048, LDSS = 4;
struct Seam { bf16x8 qr[8]; bf16x8 st_v0, st_v1, st_k0, st_k1; int jlo; };
#define ROWK(p, k0, rr) ((p) + (size_t)((k0) + (rr)) * LDK + sc)
#define VMW() asm volatile("s_waitcnt vmcnt(0)" ::: "memory")
#define VMWN(n) asm volatile("s_waitcnt vmcnt(%0)" :: "i"(n) : "memory")
#define SLOAD_H(Kp, Vp, k0) do { S.st_v0 = load8(ROWK(Vp, k0, sr)); S.st_v1 = load8(ROWK(Vp, k0, 32 + sr));              \
                         S.st_k0 = load8(ROWK(Kp, k0, sr)); S.st_k1 = load8(ROWK(Kp, k0, 32 + sr)); } while (0)
#define SWRITE_HK(bf, k0) do { *(bf16x8*)(K_lds + (bf) * SHM_K + kws) = scale8(S.st_k0, ksr[(k0)]); *(bf16x8*)(K_lds + (bf) * SHM_K + kws + 32 * 256) = scale8(S.st_k1, ksr[(k0) + 32]); } while (0)
#define SWRITE_HV(bf) do { *(bf16x8*)(V_lds + (bf) * SHM_V + vst0) = S.st_v0; *(bf16x8*)(V_lds + (bf) * SHM_V + vst1) = S.st_v1; } while (0)
#define SWRITE_H(bf, k0) do { SWRITE_HV(bf); SWRITE_HK(bf, k0); } while (0)

__device__ __forceinline__ void attn_prime(const BlockRef& cur, char* lds, Seam& S, const int tid) {
    const int wid = __builtin_amdgcn_readfirstlane(tid >> 6), lane = tid & 63, r32 = lane & 31, hi = lane >> 5;
    const int sr = tid >> 4, sc = (tid & 15) * 8, kws = KSWZ(sr, sc * 2); char* K_lds = lds + 2 * SHM_V;
    float* ks_l = (float*)(lds + OFF_KS); float* bs_l = (float*)(lds + OFF_BS); const float* ksr = ks_l + sr;
    int j_hi = (cur.P0 + QB - 1) / KVBLK + 1; if (j_hi > cur.skv / KVBLK) j_hi = cur.skv / KVBLK;
    const int nkeys = j_hi * KVBLK;
    const float c0 = cur.cc ? cur.cc[cur.P0] : 0.f;
    int jlo = 0;
    if (cur.cc) { const float thr = cur.gg[128]; const int jd = cur.P0 / KVBLK;
        const float cv = lane <= jd ? cur.cc[lane * KVBLK + KVBLK - 1] : 0.f;
        const bool keep = lane > jd || (c0 - cv > -thr);
        jlo = __ffsll((long long)__ballot(keep)) - 1; }
    S.jlo = jlo;
    for (int s = jlo * KVBLK + tid; s < nkeys; s += NTHREADS) {
        const f32x4 p = *(const GAS f32x4*)(cur.kss + (size_t)s * LDSS);
        ks_l[s] = rsqrtf(((p[0] + p[1]) + (p[2] + p[3])) * (1.f / 128.f) + EPS);
        bs_l[s] = cur.cc ? (c0 - cur.cc[s]) * (1.f / SCALE) : 0.f;
    }
    __syncthreads();
    const int qrow = wid * QBLK + r32;
    const f32x4 qp = *(const GAS f32x4*)(cur.qss + (size_t)qrow * LDSS);
    const float rq = rsqrtf(((qp[0] + qp[1]) + (qp[2] + qp[3])) * (1.f / 128.f) + EPS);
#pragma unroll
    for (int d0 = 0; d0 < 8; ++d0) {
        const u32x4 w = *(const GAS u32x4*)(cur.Q + (size_t)qrow * LDQ + d0 * 16 + hi * 8);
        const f32x4 g0 = *(const GAS f32x4*)(cur.gg + d0 * 16 + hi * 8), g1 = *(const GAS f32x4*)(cur.gg + d0 * 16 + hi * 8 + 4);
        u32x4 o; o.x = cvtpk(bf_lo(w.x) * rq * g0[0], bf_hi(w.x) * rq * g0[1]); o.y = cvtpk(bf_lo(w.y) * rq * g0[2], bf_hi(w.y) * rq * g0[3]);
        o.z = cvtpk(bf_lo(w.z) * rq * g1[0], bf_hi(w.z) * rq * g1[1]); o.w = cvtpk(bf_lo(w.w) * rq * g1[2], bf_hi(w.w) * rq * g1[3]);
        S.qr[d0] = *reinterpret_cast<bf16x8*>(&o);
    }
    SLOAD_H(cur.K, cur.V, jlo * KVBLK); VMW(); SWRITE_HK(0, jlo * KVBLK);
    __syncthreads();
}
__device__ __forceinline__ void attn_block(const BlockRef& cur, char* lds, Seam& S, const int tid) {
    const int wid = __builtin_amdgcn_readfirstlane(tid >> 6), lane = tid & 63, r32 = lane & 31, hi = lane >> 5;
    const int W = WBIG;
    int j_hi = (cur.P0 + QB - 1) / KVBLK + 1; if (j_hi > cur.skv / KVBLK) j_hi = cur.skv / KVBLK;
    const int j_lo = S.jlo; const int NT = j_hi - j_lo;
    const int qlo = cur.P0 - j_lo * KVBLK + wid * QBLK, qm = qlo + r32 - 4 * hi;
    char* V_lds = lds; char* K_lds = lds + 2 * SHM_V;
    float* ws = (float*)(lds + OFF_WS) + wid * 64; float* li_l = ws, * al_l = ws + 32;
    const float* bs_l = (const float*)(lds + OFF_BS) + j_lo * KVBLK + 4 * hi;
    float m_reg = -1e30f, l_reg = 0; f32x16 o[4] = {};
    const int sr = tid >> 4, sc = (tid & 15) * 8, vst0 = v_st(sr, sc), vst1 = v_st(32 + sr, sc), kws = KSWZ(sr, sc * 2);
    const float* ksr = (const float*)(lds + OFF_KS) + j_lo * KVBLK + sr;
    const int vb0 = (int)(uintptr_t)V_lds + v_rd_base(lane);
    const GAS bf16_t* Kh = cur.K + (size_t)j_lo * KVBLK * LDK; const GAS bf16_t* Vh = cur.V + (size_t)j_lo * KVBLK * LDK;
#define RESC(a) do { if (__any((a) < 1.f)) { if (hi == 0) al_l[r32] = (a); asm volatile("s_waitcnt lgkmcnt(0)" ::: "memory");              \
                     for (int d_ = 0; d_ < 4; ++d_) for (int r = 0; r < 16; ++r) o[d_][r] *= al_l[crow(r, hi)]; } } while (0)
#define KBASE(t) ((t) * KVBLK)
#define MASKT(P0_, P1_, t) do { const int kb_ = KBASE(t); if (kb_ + KVBLK - 1 > qlo) mask_tile(P0_, P1_, qm - kb_, (unsigned)W); } while (0)
    f32x16 pA0, pA1, pB0, pB1; float mnA, mnB, alA, alB; bf16x8 pa0, pa1, pa2, pa3;
    SWRITE_HV(0); SBAR();
    if (NT > 1) { SLOAD_H(Kh, Vh, KBASE(1)); }
    SBAR(); qkt<0>(pA0, pA1, K_lds, r32, hi, S.qr, bs_l + KBASE(0));
    MASKT(pA0, pA1, 0); partialSM(pA0, pA1, m_reg, mnA, alA);
    if (NT > 1) { VMW(); SWRITE_H(1, KBASE(1)); }
    __syncthreads();
#define HALF_STEP(PX0, PX1, mnX, alX, PY0, PY1, alY, t, KB, VB, SB) do {                                                      \
        SBAR(); qkt<KB>(PX0, PX1, K_lds, r32, hi, S.qr, bs_l + KBASE(t));                                                         \
        finishSM(PY0, PY1, alY, l_reg, pa0, pa1, pa2, pa3); SBAR();                                                           \
        if ((t) + 1 < NT) { SLOAD_H(Kh, Vh, KBASE((t) + 1)); SBAR(); }                                               \
        pv_tile<VB>(o, vb0, pa0, pa1, pa2, pa3); MASKT(PX0, PX1, (t)); partialSM(PX0, PX1, m_reg, mnX, alX);                                        \
        __syncthreads();                                                                                                      \
        if ((t) + 1 < NT) { VMW(); SWRITE_H(SB, KBASE((t) + 1)); }                                                                          \
        RESC(alX); __syncthreads(); } while (0)
    for (int t = 1; t + 1 < NT; t += 2) {
        HALF_STEP(pB0, pB1, mnB, alB, pA0, pA1, alA, t, 1, 0, 0);
        HALF_STEP(pA0, pA1, mnA, alA, pB0, pB1, alB, t + 1, 0, 1, 1);
    }
    const bool even = (NT & 1) == 0;
    if (even) { SBAR(); qkt<1>(pB0, pB1, K_lds, r32, hi, S.qr, bs_l + KBASE(NT - 1)); SBAR(); }
    finishSM(pA0, pA1, alA, l_reg, pa0, pa1, pa2, pa3); SBAR();
    pv_tile<0>(o, vb0, pa0, pa1, pa2, pa3);
    if (even) { MASKT(pB0, pB1, NT - 1); partialSM(pB0, pB1, m_reg, mnB, alB); __syncthreads(); RESC(alB);
        finishSM(pB0, pB1, alB, l_reg, pa0, pa1, pa2, pa3); SBAR(); pv_tile<1>(o, vb0, pa0, pa1, pa2, pa3); }
    SBAR();
    if (hi == 0) li_l[r32] = l_reg; asm volatile("s_waitcnt lgkmcnt(0)" ::: "memory");
    float rli[16];
#pragma unroll
    for (int r = 0; r < 16; ++r) rli[r] = __builtin_amdgcn_rcpf(li_l[crow(r, hi)]);
    GAS bf16_t* Ow = cur.O + (size_t)(wid * QBLK) * LDO;
#pragma unroll
    for (int r = 0; r < 16; ++r) { const int orow = crow(r, hi);
#pragma unroll
        for (int d0 = 0; d0 < 4; ++d0) { const float v = o[d0][r] * rli[r];
            const float vn = dppf<0xB1>(v);
            if ((r32 & 1) == 0) *(GAS unsigned*)(Ow + (size_t)orow * LDO + d0 * 32 + r32) = cvtpk(v, vn); } }
    __syncthreads();
#undef RESC
#undef KBASE
#undef MASKT
#undef HALF_STEP
}
constexpr int MOFF_K = 4 * SHM_V, MOFF_WS = MOFF_K + 4 * SHM_K, MOFF_KS = MOFF_WS + 2048;
__device__ __forceinline__ void mem_attn_unit(const BlockRef& cur, char* lds, const int tid) {
    const int wid = __builtin_amdgcn_readfirstlane(tid >> 6), lane = tid & 63, r32 = lane & 31, hi = lane >> 5;
    const int sr = tid >> 4, sc = (tid & 15) * 8, kws = KSWZ(sr, sc * 2), vst0 = v_st(sr, sc), vst1 = v_st(32 + sr, sc);
    char* V_lds = lds; char* K_lds = lds + MOFF_K; float* ks_l = (float*)(lds + MOFF_KS);
    float* ws = (float*)(lds + MOFF_WS) + wid * 64; float* li_l = ws, * al_l = ws + 32;
    float ksv = 0.f;
    if (tid < 256) { const f32x4 p = *(const GAS f32x4*)(cur.kss + (size_t)tid * LDSS); ksv = rsqrtf(((p[0] + p[1]) + (p[2] + p[3])) * (1.f / 128.f) + EPS); }
    bf16x8 kk[4][2], vv[4][2];
#pragma unroll
    for (int t = 0; t < 4; ++t) { kk[t][0] = load8(ROWK(cur.K, t * KVBLK, sr)); kk[t][1] = load8(ROWK(cur.K, t * KVBLK, 32 + sr)); vv[t][0] = load8(ROWK(cur.V, t * KVBLK, sr)); vv[t][1] = load8(ROWK(cur.V, t * KVBLK, 32 + sr)); }
    const int qrow = wid * QBLK + r32;
    const f32x4 qp = *(const GAS f32x4*)(cur.qss + (size_t)qrow * LDSS);
    u32x4 qw[8];
#pragma unroll
    for (int d0 = 0; d0 < 8; ++d0) qw[d0] = *(const GAS u32x4*)(cur.Q + (size_t)qrow * LDQ + d0 * 16 + hi * 8);
    if (tid < 256) ks_l[tid] = ksv;
    __syncthreads();
#pragma unroll
    for (int t = 0; t < 4; ++t) { *(bf16x8*)(K_lds + t * SHM_K + kws) = scale8(kk[t][0], ks_l[t * KVBLK + sr]); *(bf16x8*)(K_lds + t * SHM_K + kws + 32 * 256) = scale8(kk[t][1], ks_l[t * KVBLK + 32 + sr]);
        *(bf16x8*)(V_lds + t * SHM_V + vst0) = vv[t][0]; *(bf16x8*)(V_lds + t * SHM_V + vst1) = vv[t][1]; }
    const float rq = rsqrtf(((qp[0] + qp[1]) + (qp[2] + qp[3])) * (1.f / 128.f) + EPS);
    bf16x8 qr[8];
#pragma unroll
    for (int d0 = 0; d0 < 8; ++d0) { const u32x4 w = qw[d0];
        const f32x4 g0 = *(const GAS f32x4*)(cur.gg + d0 * 16 + hi * 8), g1 = *(const GAS f32x4*)(cur.gg + d0 * 16 + hi * 8 + 4);
        u32x4 o; o.x = cvtpk(bf_lo(w.x) * rq * g0[0], bf_hi(w.x) * rq * g0[1]); o.y = cvtpk(bf_lo(w.y) * rq * g0[2], bf_hi(w.y) * rq * g0[3]);
        o.z = cvtpk(bf_lo(w.z) * rq * g1[0], bf_hi(w.z) * rq * g1[1]); o.w = cvtpk(bf_lo(w.w) * rq * g1[2], bf_hi(w.w) * rq * g1[3]);
        qr[d0] = *reinterpret_cast<bf16x8*>(&o); }
    __syncthreads();
    const int vb0 = (int)(uintptr_t)V_lds + v_rd_base(lane);
    float m_reg = -1e30f, l_reg = 0; f32x16 o[4] = {};
#define MEM_TILE(t) do { f32x16 p0, p1; float mn, al; bf16x8 pa0, pa1, pa2, pa3; \
        qkt0<t>(p0, p1, K_lds, r32, hi, qr); partialSM(p0, p1, m_reg, mn, al); \
        if (__any(al < 1.f)) { if (hi == 0) al_l[r32] = al; asm volatile("s_waitcnt lgkmcnt(0)" ::: "memory"); for (int d_ = 0; d_ < 4; ++d_) for (int r = 0; r < 16; ++r) o[d_][r] *= al_l[crow(r, hi)]; } \
        finishSM(p0, p1, al, l_reg, pa0, pa1, pa2, pa3); SBAR(); pv_tile<t>(o, vb0, pa0, pa1, pa2, pa3); SBAR(); } while (0)
    MEM_TILE(0); MEM_TILE(1); MEM_TILE(2); MEM_TILE(3);
#undef MEM_TILE
    if (hi == 0) li_l[r32] = l_reg; asm volatile("s_waitcnt lgkmcnt(0)" ::: "memory");
    float rli[16];
#pragma unroll
    for (int r = 0; r < 16; ++r) rli[r] = __builtin_amdgcn_rcpf(li_l[crow(r, hi)]);
    GAS bf16_t* Ow = cur.O + (size_t)(wid * QBLK) * LDO;
#pragma unroll
    for (int r = 0; r < 16; ++r) { const int orow = crow(r, hi);
#pragma unroll
        for (int d0 = 0; d0 < 4; ++d0) { const float v = o[d0][r] * rli[r];
            const float vn = dppf<0xB1>(v);
            if ((r32 & 1) == 0) *(GAS unsigned*)(Ow + (size_t)orow * LDO + d0 * 32 + r32) = cvtpk(v, vn); } }
    __syncthreads();
}
#undef ROWK
#undef VMW
#undef VMWN
#undef SLOAD_H
#undef SWRITE_HK
#undef SWRITE_HV
#undef SWRITE_H
#undef KSWZ
#undef SBAR
}


struct Frame {
    GAS unsigned char* ws; const float* const* in_; GAS float* out;
    __device__ __forceinline__ const GAS float* in(int i) const { return (const GAS float*)in_[i]; }
    int tid, lane, wave, gw, ngw, gtid, ngt;
};
enum { I_X = 0, I_MEM, I_ANORM, I_AWIN, I_ACONVW, I_ACONVB, I_AGATEW, I_AGATEB, I_ALAMBDA, I_AWOUT, I_SNORM, I_SWKVF, I_SBF, I_SKNORM, I_BNORM, I_BWIN, I_BQNORM, I_BWOUT,
       I_MNORM, I_MWKV, I_MQNORM, I_MKNORM, I_PNORM, I_PWQ, I_PSUBK, I_PU, I_PV, N_IN };

struct TrItem { const GAS float* W; const GAS float* gain; GAS bf16_t* WT; int ldw, ldt, row_off, k0, n0; };
__device__ __forceinline__ void tr_load(const TrItem& d, float (&wv)[32], int lane) {
#pragma unroll
    for (int i = 0; i < 32; ++i) wv[i] = __builtin_nontemporal_load(d.W + (size_t)(d.k0 + 2 * i + (lane >> 5)) * d.ldw + d.n0 + (lane & 31));
}
__device__ __forceinline__ void tr_proc(const TrItem& d, float (&wv)[32], LAS float* scr, int lane) {
    if (d.gain) {
#pragma unroll
        for (int i = 0; i < 32; ++i) wv[i] *= d.gain[d.k0 + 2 * i + (lane >> 5)]; }
#pragma unroll
    for (int i = 0; i < 32; ++i) scr[(2 * i + (lane >> 5)) * 33 + (lane & 31)] = wv[i];
    asm volatile("s_waitcnt lgkmcnt(0)" ::: "memory");
    const int c = lane & 7;
#pragma unroll
    for (int j = 0; j < 4; ++j) { const int n = (lane >> 3) + 8 * j; const LAS float* s = scr + (8 * c) * 33 + n;
        u32x4 o; o.x = cvtpk(s[0 * 33], s[1 * 33]); o.y = cvtpk(s[2 * 33], s[3 * 33]); o.z = cvtpk(s[4 * 33], s[5 * 33]); o.w = cvtpk(s[6 * 33], s[7 * 33]);
        *(GAS u32x4*)(d.WT + (size_t)(d.row_off + d.n0 + n) * d.ldt + d.k0 + 8 * c) = o; }
    asm volatile("s_waitcnt lgkmcnt(0)" ::: "memory");
}
__device__ __forceinline__ void transpose_item_fp8(const GAS float* W, int ldw, const GAS float* gain, GAS unsigned char* WT, int ldt, LAS float* scr, int nblk, int item, int lane) {
    const int kb = item / nblk, nb = item % nblk, k0 = 64 * kb, n0 = 32 * nb;
    float wv[32];
#pragma unroll
    for (int i = 0; i < 32; ++i) wv[i] = W[(size_t)(k0 + 2 * i + (lane >> 5)) * ldw + n0 + (lane & 31)];
#pragma unroll
    for (int i = 0; i < 32; ++i) wv[i] *= gain[k0 + 2 * i + (lane >> 5)] * 64.f;
#pragma unroll
    for (int i = 0; i < 32; ++i) scr[(2 * i + (lane >> 5)) * 33 + (lane & 31)] = wv[i];
    asm volatile("s_waitcnt lgkmcnt(0)" ::: "memory");
    const int c = lane & 3;
#pragma unroll
    for (int j = 0; j < 2; ++j) { const int n = (lane >> 2) + 16 * j; const LAS float* sp = scr + (16 * c) * 33 + n; u32x4 o;
#pragma unroll
        for (int w = 0; w < 4; ++w) { int pk = __builtin_amdgcn_cvt_pk_fp8_f32(sp[(4 * w) * 33], sp[(4 * w + 1) * 33], 0, false); pk = __builtin_amdgcn_cvt_pk_fp8_f32(sp[(4 * w + 2) * 33], sp[(4 * w + 3) * 33], pk, true); o[w] = (unsigned)pk; }
        *(GAS u32x4*)(WT + (size_t)(n0 + n) * ldt + k0 + 16 * c) = o; }
    asm volatile("s_waitcnt lgkmcnt(0)" ::: "memory");
}
struct CtRow { f32x4 v[8]; GAS unsigned char* dst; int row, which; };
__device__ __forceinline__ void ct_load(Frame& F, int layer, int it, CtRow& R) {
    R.which = it & 1; R.row = it >> 1;
    const GAS float* src = F.in(R.which ? I_PV : I_PU) + ((size_t)layer * NEXP + R.row) * DM + F.lane * 4;
    R.dst = F.ws + O_TAB + (size_t)(layer * 2 + R.which) * TAB_ONE;
#pragma unroll
    for (int c = 0; c < 8; ++c) R.v[c] = __builtin_nontemporal_load((const GAS f32x4*)(src + c * 256));
}
__device__ __forceinline__ void ct_proc(Frame& F, int layer, CtRow& R, const f32x4 (&gnr)[8]) {
    _Float16 shv = (_Float16)0.f;
#pragma unroll
    for (int c = 0; c < 8; ++c) { f32x4 x = R.v[c]; if (!R.which) x = x * gnr[c];
        float amax = fmaxf(fmaxf(fabsf(x[0]), fabsf(x[1])), fmaxf(fabsf(x[2]), fabsf(x[3])));
        amax = wave_max(amax);
        const _Float16 sh = (_Float16)fmaxf(amax * (1.f / 6.f), 1e-6f);
        const float qs = __builtin_amdgcn_rcpf((float)sh);
        unsigned pk = __builtin_amdgcn_cvt_scalef32_pk_fp4_f32(0u, x[0] * qs, x[1] * qs, 1.0f, 0); pk = __builtin_amdgcn_cvt_scalef32_pk_fp4_f32(pk, x[2] * qs, x[3] * qs, 1.0f, 1);
        *(GAS unsigned short*)(R.dst + ((size_t)c * NEXP + R.row) * 128 + F.lane * 2) = (unsigned short)pk;
        shv = (F.lane == c) ? sh : shv; }
    if (F.lane < 8) *(GAS unsigned short*)(F.ws + O_TAB + (size_t)(layer * 2) * TAB_ONE + TAB_NIB + (size_t)R.row * 32 + R.which * 16 + F.lane * 2) = __builtin_bit_cast(unsigned short, shv);
}
__device__ __forceinline__ void convert_tables(Frame& F, int layer, int ibeg, int iend, int wk, int nwk) {
    if (ibeg + wk >= iend) return;
    const int ilast = ibeg + wk + ((iend - 1 - ibeg - wk) / nwk) * nwk;
    CtRow A, B;
    f32x4 gnr[8];
#pragma unroll
    for (int c = 0; c < 8; ++c) gnr[c] = *(const GAS f32x4*)(F.in(I_PNORM) + layer * DM + F.lane * 4 + c * 256);
    ct_load(F, layer, ibeg + wk, A);
    for (int it = ibeg + wk; it < iend; it += 2 * nwk) {
        ct_load(F, layer, it + nwk <= ilast ? it + nwk : ilast, B);
        ct_proc(F, layer, A, gnr);
        ct_load(F, layer, it + 2 * nwk <= ilast ? it + 2 * nwk : ilast, A);
        if (it + nwk < iend) ct_proc(F, layer, B, gnr);
    }
}
__device__ __forceinline__ void norm_row_bf16(const GAS float* xrow, const GAS float* gain, GAS bf16_t* orow, int lane) {
    f32x4 v[8]; float s = 0.f;
#pragma unroll
    for (int j = 0; j < 8; ++j) { v[j] = *(const GAS f32x4*)(xrow + j * 256 + lane * 4); s += (v[j][0] * v[j][0] + v[j][1] * v[j][1]) + (v[j][2] * v[j][2] + v[j][3] * v[j][3]); }
    const float r = rsqrtf(wave_sum(s) * (1.f / DM) + EPS);
#pragma unroll
    for (int j = 0; j < 8; ++j) { f32x4 g = gain ? *(const GAS f32x4*)(gain + j * 256 + lane * 4) : (f32x4){1.f, 1.f, 1.f, 1.f};
        u32x2 o; o.x = cvtpk(v[j][0] * r * g[0], v[j][1] * r * g[1]); o.y = cvtpk(v[j][2] * r * g[2], v[j][3] * r * g[3]);
        *(GAS u32x2*)(orow + j * 256 + lane * 4) = o; }
}
__device__ __forceinline__ void step_prologue(Frame& F, LAS unsigned char* lds) {
    LAS float* scr = (LAS float*)(lds + F.wave * 16384);
    GAS unsigned char* ws = F.ws;
    constexpr int I0 = 32 * (NIN0 / 32), I1 = 32 * 64, I2 = 32 * 96, I3 = 32 * 64, I4 = 32 * 64, I5 = 32 * 64, I6 = 32 * 64, I7 = 32 * 32, I8 = 32 * 32, I9 = 12 * 16;
    constexpr int NITEMS = I0 + I1 + I2 + I3 + I4 + I5 + I6 + I7 + I8 + I9;
#define TR_DESC(D, it_) do { int r = (it_) < NITEMS ? (it_) : NITEMS - 1; int nblk; \
        if (r < I0) { D = {F.in(I_AWIN), F.in(I_ANORM), (GAS bf16_t*)(ws + O_WIN0), NIN0, DM, 0, 0, 0}; nblk = NIN0 / 32; } else { r -= I0; \
        if (r < I1) { D = {F.in(I_AWOUT), nullptr, (GAS bf16_t*)(ws + O_WOUT0), DM, DM, 0, 0, 0}; nblk = 64; } else { r -= I1; \
        if (r < I2) { D = {F.in(I_SWKVF), F.in(I_SNORM), (GAS bf16_t*)(ws + O_WL1), 3084, DM, 0, 0, 0}; nblk = 96; } else { r -= I2; \
        if (r < I3) { D = {F.in(I_BWIN), F.in(I_BNORM), (GAS bf16_t*)(ws + O_WL1), DM, DM, 3072, 0, 0}; nblk = 64; } else { r -= I3; \
        if (r < I4) { D = {F.in(I_BWOUT), nullptr, (GAS bf16_t*)(ws + O_WOUT1), DM, DM, 0, 0, 0}; nblk = 64; } else { r -= I4; \
        if (r < I5) { D = {F.in(I_PWQ), F.in(I_PNORM), (GAS bf16_t*)(ws + O_WQ0), DM, DM, 0, 0, 0}; nblk = 64; } else { r -= I5; \
        if (r < I6) { D = {F.in(I_PWQ) + (size_t)DM * DM, F.in(I_PNORM) + DM, (GAS bf16_t*)(ws + O_WQ1), DM, DM, 0, 0, 0}; nblk = 64; } else { r -= I6; \
        if (r < I7) { D = {F.in(I_MWKV), nullptr, (GAS bf16_t*)(ws + O_WMKV), 1024, DM, 0, 0, 0}; nblk = 32; } else { r -= I7; \
        if (r < I8) { D = {F.in(I_MWKV) + (size_t)DM * 1024, nullptr, (GAS bf16_t*)(ws + O_WMKV) + (size_t)1024 * DM, 1024, DM, 0, 0, 0}; nblk = 32; } else { r -= I8; \
          const int blk = r / 16; r = r % 16; D = {F.in(I_AGATEW) + (size_t)blk * 128 * 256, nullptr, (GAS bf16_t*)(ws + O_WGATE), 256, 128, blk * 256, 0, 0}; nblk = 8; } } } } } } } } } \
        D.k0 = 64 * (r / nblk); D.n0 = 32 * (r % nblk); } while (0)
    for (int it = F.gw; it < NITEMS; it += F.ngw) { float wv[32]; TrItem d; TR_DESC(d, it); tr_load(d, wv, F.lane); tr_proc(d, wv, scr, F.lane); }
#undef TR_DESC
    { const GAS float* sk = F.in(I_PSUBK); GAS bf16_t* o = (GAS bf16_t*)(ws + O_SUBK);
      for (int i = F.gtid; i < 2 * 16 * 128 * 128 / 2; i += F.ngt) { const int e = 2 * i, hs = e >> 14, key = (e >> 7) & 127, d = e & 127;
          const int dst = (hs << 14) + ((((key >> 5) * 8 + (d >> 4)) * 32 + (key & 31)) << 4) + (d & 15);
          *(GAS unsigned*)(o + dst) = cvtpk(sk[e], sk[e + 1]); } }
    { GAS float* wf = (GAS float*)(ws + O_WF); const GAS float* w = F.in(I_SWKVF); const GAS float* g = F.in(I_SNORM);
      for (int i = F.gtid; i < 12 * DM; i += F.ngt) { const int j = i / DM, k = i % DM; wf[i] = w[(size_t)k * 3084 + 3072 + j] * g[k]; } }
    { GAS float* spl = (GAS float*)(ws + O_SPL); const GAS float* lam = F.in(I_ALAMBDA);
      for (int i = F.gtid; i < LRU; i += F.ngt) { const float z = -lam[i]; spl[i] = fmaxf(z, 0.f) + log1p_pos(fast_exp(-fabsf(z))); } }
    if (F.gw == 0) {
        float m = 0.f; for (int d = F.lane; d < 128; d += 64) m = fmaxf(m, fabsf(F.in(I_BQNORM)[d] * F.in(I_SKNORM)[d]));
        m = wave_max(m);
        if (F.lane == 0) ((GAS float*)(ws + O_GG))[512] = 2.f * 11.3137085f * m + 30.f; }
    { GAS float* gg = (GAS float*)(ws + O_GG);
      for (int i = F.gtid; i < 384; i += F.ngt) { const int a = i / 128, d = i % 128;
          gg[a == 0 ? 384 + d : i] = a == 0 ? F.in(I_BQNORM)[d] * F.in(I_SKNORM)[d] : F.in(I_MQNORM)[(a - 1) * 128 + d] * F.in(I_MKNORM)[(a - 1) * 128 + d]; } }
    {
        const GAS float* xin = F.in(I_X) + F.lane * 4; GAS bf16_t* xo = (GAS bf16_t*)(ws + O_XS16) + F.lane * 4;
        const int mlast = F.gw + ((T - 1 - F.gw) / F.ngw) * F.ngw;
#define XN_LOAD(V, m_) do { const int mm_ = (m_) <= mlast ? (m_) : mlast; _Pragma("unroll") for (int j = 0; j < 8; ++j) V[j] = __builtin_nontemporal_load((const GAS f32x4*)(xin + (size_t)mm_ * DM + j * 256)); } while (0)
#define XN_PROC(V, m_) do { if ((m_) < T) { float s0 = 0.f; _Pragma("unroll") for (int j = 0; j < 8; ++j) s0 += (V[j][0] * V[j][0] + V[j][1] * V[j][1]) + (V[j][2] * V[j][2] + V[j][3] * V[j][3]); \
            const float r0 = rsqrtf(wave_sum(s0) * (1.f / DM) + EPS); \
            _Pragma("unroll") for (int j = 0; j < 8; ++j) { u32x2 a; a.x = cvtpk(V[j][0] * r0, V[j][1] * r0); a.y = cvtpk(V[j][2] * r0, V[j][3] * r0); *(GAS u32x2*)(xo + (size_t)(m_) * DM + j * 256) = a; } } } while (0)
        f32x4 va[8], vb[8];
        XN_LOAD(va, F.gw);
        for (int m = F.gw; m < T; m += 2 * F.ngw) { XN_LOAD(vb, m + F.ngw); XN_PROC(va, m); XN_LOAD(va, m + 2 * F.ngw); XN_PROC(vb, m + F.ngw); }
#undef XN_LOAD
#undef XN_PROC
    }
    for (int m = F.gw; m < 2 * NMROW; m += F.ngw) { const int l = m / NMROW, r = m % NMROW;
        norm_row_bf16(F.in(I_MEM) + (size_t)r * DM, F.in(I_MNORM) + l * DM, (GAS bf16_t*)(ws + O_MEMN) + (size_t)m * DM, F.lane); }
    convert_tables(F, 0, 0, 2 * NEXP, F.gw, F.ngw);
}
__device__ __forceinline__ void step_conv(Frame& F) {
    const GAS bf16_t* zx = (const GAS bf16_t*)(F.ws + O_ZX); GAS bf16_t* xc = (GAS bf16_t*)(F.ws + O_XC);
    const GAS float* cw = F.in(I_ACONVW); const GAS float* cb = F.in(I_ACONVB);
    constexpr int RUN = 16, NCG = LRU / 256, NU = (T / RUN) * NCG;
    unsigned lo = (unsigned)F.lane; asm volatile("" : "+v"(lo));
    struct CvU { f32x4 w[4], b; u32x2 r[RUN + 3]; };
#define CV_LOADU(U, u_) do { const int uu_ = (u_) < NU ? (u_) : NU - 1; const int cg_ = uu_ % NCG, t0_ = (uu_ / NCG) * RUN; const unsigned ch_ = cg_ * 256 + lo * 4; \
        _Pragma("unroll") for (int k = 0; k < 4; ++k) U.w[k] = *(const GAS f32x4*)(cw + k * LRU + ch_); U.b = *(const GAS f32x4*)(cb + ch_); \
        const bool first_ = (t0_ & (SEQ - 1)) == 0; \
        _Pragma("unroll") for (int i = 0; i < RUN + 3; ++i) U.r[i] = (i < 3 && first_) ? (u32x2){0u, 0u} : *(const GAS u32x2*)(zx + (size_t)(t0_ - 3 + i) * LRU + ch_); } while (0)
#define CV_PROCU(U, u_) do { if ((u_) < NU) { const int cg_ = (u_) % NCG, t0_ = ((u_) / NCG) * RUN; const unsigned ch_ = cg_ * 256 + lo * 4; \
        _Pragma("unroll") for (int i = 0; i < RUN; ++i) { f32x4 a = U.b; \
            _Pragma("unroll") for (int k = 0; k < 4; ++k) { const u32x2 q = U.r[i + k]; \
                a[0] = fmaf(U.w[k][0], bf_lo(q.x), a[0]); a[1] = fmaf(U.w[k][1], bf_hi(q.x), a[1]); a[2] = fmaf(U.w[k][2], bf_lo(q.y), a[2]); a[3] = fmaf(U.w[k][3], bf_hi(q.y), a[3]); } \
            u32x2 o; o.x = cvtpk(a[0], a[1]); o.y = cvtpk(a[2], a[3]); *(GAS u32x2*)(xc + (size_t)(t0_ + i) * LRU + ch_) = o; } } } while (0)
    CvU A, B;
    CV_LOADU(A, F.gw);
    for (int u = F.gw; u < NU; u += 2 * F.ngw) { CV_LOADU(B, u + F.ngw); CV_PROCU(A, u); CV_LOADU(A, u + 2 * F.ngw); CV_PROCU(B, u + F.ngw); }
#undef CV_LOADU
#undef CV_PROCU
}
__device__ __forceinline__ void step_conv_local(Frame& F, int G) {
    const GAS bf16_t* zx = (const GAS bf16_t*)(F.ws + O_ZX); GAS bf16_t* xc = (GAS bf16_t*)(F.ws + O_XC);
    const GAS float* cw = F.in(I_ACONVW); const GAS float* cb = F.in(I_ACONVB);
    constexpr int RUN = 16;
    pg8::StaticOrder S; S.init(T, 12 * 256, G, (int)blockIdx.x);
    unsigned lo = (unsigned)F.lane; asm volatile("" : "+v"(lo));
    const int tbk = 2 * F.wave + (int)(lo >> 5); const unsigned chl = (lo & 31) * 4;
    struct CvU { f32x4 w[4], b; u32x2 r[RUN + 3]; };
#define CVL_ADDR(i_, ok_, t0_, ch_) do { pg8::Unit un_; ok_ = S.next((i_), un_); if (ok_) { t0_ = un_.pm * 256 + tbk * RUN; ch_ = un_.pn * 128 + chl; } } while (0)
#define CVL_LOAD(U, t0_, ch_) do { _Pragma("unroll") for (int k = 0; k < 4; ++k) U.w[k] = *(const GAS f32x4*)(cw + k * LRU + ch_); U.b = *(const GAS f32x4*)(cb + ch_); \
        const bool first_ = ((t0_) & (SEQ - 1)) == 0; \
        _Pragma("unroll") for (int i = 0; i < RUN + 3; ++i) U.r[i] = (i < 3 && first_) ? (u32x2){0u, 0u} : *(const GAS u32x2*)(zx + (size_t)((t0_) - 3 + i) * LRU + ch_); } while (0)
#define CVL_PROC(U, t0_, ch_) do { _Pragma("unroll") for (int i = 0; i < RUN; ++i) { f32x4 a = U.b; \
            _Pragma("unroll") for (int k = 0; k < 4; ++k) { const u32x2 q = U.r[i + k]; \
                a[0] = fmaf(U.w[k][0], bf_lo(q.x), a[0]); a[1] = fmaf(U.w[k][1], bf_hi(q.x), a[1]); a[2] = fmaf(U.w[k][2], bf_lo(q.y), a[2]); a[3] = fmaf(U.w[k][3], bf_hi(q.y), a[3]); } \
            u32x2 o; o.x = cvtpk(a[0], a[1]); o.y = cvtpk(a[2], a[3]); *(GAS u32x2*)(xc + (size_t)((t0_) + i) * LRU + ch_) = o; } } while (0)
    CvU A, B; int ta = 0, tb = 0; unsigned ca = 0, cbb = 0; bool oka, okb;
    CVL_ADDR(0, oka, ta, ca);
    if (oka) CVL_LOAD(A, ta, ca);
    for (int i = 0; oka; i += 2) {
        CVL_ADDR(i + 1, okb, tb, cbb);
        if (okb) CVL_LOAD(B, tb, cbb);
        CVL_PROC(A, ta, ca);
        oka = false; if (okb) CVL_ADDR(i + 2, oka, ta, ca);
        if (oka) CVL_LOAD(A, ta, ca);
        if (okb) CVL_PROC(B, tb, cbb);
    }
#undef CVL_ADDR
#undef CVL_LOAD
#undef CVL_PROC
    asm volatile("s_waitcnt vmcnt(0)" ::: "memory");
    __syncthreads();
}
constexpr int SCK = 32, NCK = SEQ / SCK;
typedef _Float16 h8_t __attribute__((ext_vector_type(8)));
__device__ __forceinline__ void scan_load(const GAS _Float16* LA, const GAS _Float16* UH, size_t off, float (&a)[8], float (&u)[8]) {
    const h8_t l = *(const GAS h8_t*)(LA + off), w = *(const GAS h8_t*)(UH + off);
#pragma unroll
    for (int k = 0; k < 8; ++k) { a[k] = fast_exp((float)l[k]); u[k] = (float)w[k]; }
}
__device__ __forceinline__ void step_scan1(Frame& F) {
    const GAS _Float16* LA = (const GAS _Float16*)(F.ws + O_AA); const GAS _Float16* UH = (const GAS _Float16*)(F.ws + O_UU);
    GAS float* CA = (GAS float*)(F.ws + O_LOGFP); GAS float* CH = CA + (size_t)NB * NCK * LRU;
    if (F.tid >= 384) return;
    const int grp = F.tid / 192, th = F.tid % 192;
    for (int it = blockIdx.x * 2 + grp; it < NB * NCK; it += gridDim.x * 2) {
        const int b = it / NCK, ck = it % NCK; const size_t base = ((size_t)b * SEQ + ck * SCK) * LRU + th * 8;
        float ap[8], h[8];
#pragma unroll
        for (int k = 0; k < 8; ++k) { ap[k] = 1.f; h[k] = 0.f; }
        h8_t L[2][4], W[2][4];
#define S1_LD(bf, i0) do { _Pragma("unroll") for (int r = 0; r < 4; ++r) { L[bf][r] = *(const GAS h8_t*)(LA + base + (size_t)((i0) + r) * LRU); W[bf][r] = *(const GAS h8_t*)(UH + base + (size_t)((i0) + r) * LRU); } } while (0)
        S1_LD(0, 0);
#pragma unroll
        for (int bt = 0; bt < SCK / 4; ++bt) {
            if (bt + 1 < SCK / 4) S1_LD((bt + 1) & 1, (bt + 1) * 4);
            __builtin_amdgcn_sched_barrier(0);
#pragma unroll
            for (int r = 0; r < 4; ++r) {
#pragma unroll
                for (int k = 0; k < 8; ++k) { const float a = fast_exp((float)L[bt & 1][r][k]); ap[k] *= a; h[k] = a * h[k] + (float)W[bt & 1][r][k]; } }
            __builtin_amdgcn_sched_barrier(0);
        }
#undef S1_LD
        GAS float* ca = CA + (size_t)it * LRU + th * 8; GAS float* ch = CH + (size_t)it * LRU + th * 8;
        *(GAS f32x4*)ca = (f32x4){ap[0], ap[1], ap[2], ap[3]}; *(GAS f32x4*)(ca + 4) = (f32x4){ap[4], ap[5], ap[6], ap[7]};
        *(GAS f32x4*)ch = (f32x4){h[0], h[1], h[2], h[3]}; *(GAS f32x4*)(ch + 4) = (f32x4){h[4], h[5], h[6], h[7]};
    }
}
__device__ __forceinline__ void step_scan2(Frame& F) {
    const GAS _Float16* LA = (const GAS _Float16*)(F.ws + O_AA); const GAS _Float16* UH = (const GAS _Float16*)(F.ws + O_UU);
    const GAS float* CA = (const GAS float*)(F.ws + O_LOGFP); const GAS float* CH = CA + (size_t)NB * NCK * LRU;
    const GAS bf16_t* gy = (const GAS bf16_t*)(F.ws + O_GY); GAS bf16_t* cat = (GAS bf16_t*)(F.ws + O_CAT);
    if (F.tid >= 384) return;
    const int grp = F.tid / 192, th = F.tid % 192;
    for (int it = blockIdx.x * 2 + grp; it < NB * NCK; it += gridDim.x * 2) {
        const int b = it / NCK, ck = it % NCK; const size_t base = ((size_t)b * SEQ + ck * SCK) * LRU + th * 8;
        h8_t L[2][4], W[2][4]; u32x4 Gy[2][4];
#define S2_LD(bf, i0) do { _Pragma("unroll") for (int r = 0; r < 4; ++r) { L[bf][r] = *(const GAS h8_t*)(LA + base + (size_t)((i0) + r) * LRU); W[bf][r] = *(const GAS h8_t*)(UH + base + (size_t)((i0) + r) * LRU); \
            Gy[bf][r] = *(const GAS u32x4*)(gy + ((size_t)b * SEQ + ck * SCK + (i0) + r) * LRU + th * 8); } } while (0)
        float h[8];
#pragma unroll
        for (int k = 0; k < 8; ++k) h[k] = 0.f;
        { const GAS float* ca = CA + (size_t)(b * NCK) * LRU + th * 8; const GAS float* chh = CH + (size_t)(b * NCK) * LRU + th * 8;
          f32x4 A0[2][4], A1[2][4], C0[2][4], C1[2][4];
#define CR_LD(bf, k0) do { _Pragma("unroll") for (int r = 0; r < 4; ++r) { const int kk_ = (k0) + r < ck ? (k0) + r : (ck > 0 ? ck - 1 : 0); const size_t o_ = (size_t)kk_ * LRU; \
            A0[bf][r] = *(const GAS f32x4*)(ca + o_); A1[bf][r] = *(const GAS f32x4*)(ca + o_ + 4); C0[bf][r] = *(const GAS f32x4*)(chh + o_); C1[bf][r] = *(const GAS f32x4*)(chh + o_ + 4); } } while (0)
#define CR_DO(bf, k0) do { _Pragma("unroll") for (int r = 0; r < 4; ++r) if ((k0) + r < ck) { _Pragma("unroll") for (int k = 0; k < 4; ++k) { h[k] = A0[bf][r][k] * h[k] + C0[bf][r][k]; h[4 + k] = A1[bf][r][k] * h[4 + k] + C1[bf][r][k]; } } } while (0)
          if (ck > 0) { CR_LD(0, 0);
              for (int k0 = 0; k0 < ck; k0 += 8) { CR_LD(1, k0 + 4); __builtin_amdgcn_sched_barrier(0); CR_DO(0, k0); CR_LD(0, k0 + 8); __builtin_amdgcn_sched_barrier(0); CR_DO(1, k0 + 4); } }
#undef CR_LD
#undef CR_DO
        }
        S2_LD(0, 0);
#pragma unroll
        for (int bt = 0; bt < SCK / 4; ++bt) {
            if (bt + 1 < SCK / 4) S2_LD((bt + 1) & 1, (bt + 1) * 4);
            __builtin_amdgcn_sched_barrier(0);
#pragma unroll
            for (int r = 0; r < 4; ++r) { const size_t row = (size_t)b * SEQ + ck * SCK + bt * 4 + r; const u32x4 g = Gy[bt & 1][r]; u32x4 o;
#pragma unroll
                for (int k = 0; k < 8; ++k) h[k] = fast_exp((float)L[bt & 1][r][k]) * h[k] + (float)W[bt & 1][r][k];
#pragma unroll
                for (int k = 0; k < 4; ++k) o[k] = cvtpk(h[2 * k] * bf_lo(g[k]), h[2 * k + 1] * bf_hi(g[k]));
                *(GAS u32x4*)(cat + row * DM + th * 8) = o; }
            __builtin_amdgcn_sched_barrier(0);
        }
#undef S2_LD
    }
}
__device__ __forceinline__ void step_cprefix(Frame& F, LAS unsigned char* lds) {
    if (blockIdx.x >= NB * NH) return;
    const GAS float* p = (const GAS float*)(F.ws + O_LOGF) + (size_t)blockIdx.x * SEQ + F.tid * 8; GAS float* q = (GAS float*)(F.ws + O_CC) + (size_t)blockIdx.x * SEQ + F.tid * 8;
    LAS double* scr = (LAS double*)lds;
    const f32x4 a = *(const GAS f32x4*)p, b = *(const GAS f32x4*)(p + 4);
    double v[8];
    v[0] = (double)a[0]; v[1] = v[0] + (double)a[1]; v[2] = v[1] + (double)a[2]; v[3] = v[2] + (double)a[3];
    v[4] = v[3] + (double)b[0]; v[5] = v[4] + (double)b[1]; v[6] = v[5] + (double)b[2]; v[7] = v[6] + (double)b[3];
    scr[F.tid] = v[7];
    __syncthreads();
    double run = 0.0;
    for (int l = 0; l < 64; ++l) { const double t = scr[F.wave * 64 + l]; if (l < F.lane) run += t; }
    if (F.lane == 63) scr[512 + F.wave] = run + v[7];
    __syncthreads();
    for (int w = 0; w < F.wave; ++w) run += scr[512 + w];
    f32x4 o0, o1;
    o0[0] = (float)(run + v[0]); o0[1] = (float)(run + v[1]); o0[2] = (float)(run + v[2]); o0[3] = (float)(run + v[3]);
    o1[0] = (float)(run + v[4]); o1[1] = (float)(run + v[5]); o1[2] = (float)(run + v[6]); o1[3] = (float)(run + v[7]);
    *(GAS f32x4*)q = o0; *(GAS f32x4*)(q + 4) = o1;
    __syncthreads();
}

__device__ __forceinline__ int ord_i(float f) { const int b = __float_as_int(f); return b ^ ((b >> 31) & 0x7fffffff); }
__device__ __forceinline__ float unord_f(int k) { return __int_as_float(k ^ ((k >> 31) & 0x7fffffff)); }
template <int N> __device__ __forceinline__ void bitonic_sort_desc(int (&a)[N]) {
#pragma unroll
    for (int k = 2; k <= N; k <<= 1) {
#pragma unroll
        for (int j = k >> 1; j > 0; j >>= 1) {
#pragma unroll
            for (int i = 0; i < N; ++i) { const int l = i ^ j;
                if (l > i) { const bool desc = ((i & k) == 0); const int mx = max(a[i], a[l]), mn = min(a[i], a[l]); a[i] = desc ? mx : mn; a[l] = desc ? mn : mx; } }
        }
    }
}
__device__ __forceinline__ void sort16_desc(int (&a)[16]) {
    constexpr int P[60][2] = {{0,13},{1,12},{2,15},{3,14},{4,8},{5,6},{7,11},{9,10}, {0,5},{1,7},{2,9},{3,4},{6,13},{8,14},{10,15},{11,12}, {0,1},{2,3},{4,5},{6,8},{7,9},{10,11},{12,13},{14,15},
        {0,2},{1,3},{4,10},{5,11},{6,7},{8,9},{12,14},{13,15}, {1,2},{3,12},{4,6},{5,7},{8,10},{9,11},{13,14}, {1,4},{2,6},{5,8},{7,10},{9,13},{11,14}, {2,4},{3,6},{9,12},{11,13},
        {3,5},{6,8},{7,9},{10,12}, {3,4},{5,6},{7,8},{9,10},{11,12}, {6,7},{8,9}};
#pragma unroll
    for (int c = 0; c < 60; ++c) { const int i = P[c][0], j = P[c][1]; const int mx = max(a[i], a[j]), mn = min(a[i], a[j]); a[i] = mx; a[j] = mn; }
}
__device__ __forceinline__ void bitonic_merge16_desc(int (&a)[16]) {
#pragma unroll
    for (int j = 8; j > 0; j >>= 1) {
#pragma unroll
        for (int i = 0; i < 16; ++i) { const int l = i ^ j; if (l > i) { const int mx = max(a[i], a[l]), mn = min(a[i], a[l]); a[i] = mx; a[l] = mn; } }
    }
}
__device__ __forceinline__ void top16_of_64(int (&a)[64]) {
    int g[4][16];
#pragma unroll
    for (int q = 0; q < 4; ++q) {
#pragma unroll
        for (int i = 0; i < 16; ++i) g[q][i] = a[16 * q + i];
        sort16_desc(g[q]); }
#pragma unroll
    for (int i = 0; i < 16; ++i) { g[0][i] = max(g[0][i], g[1][15 - i]); g[2][i] = max(g[2][i], g[3][15 - i]); }
    bitonic_merge16_desc(g[0]); bitonic_merge16_desc(g[2]);
#pragma unroll
    for (int i = 0; i < 16; ++i) g[0][i] = max(g[0][i], g[2][15 - i]);
    bitonic_merge16_desc(g[0]);
#pragma unroll
    for (int i = 0; i < 16; ++i) a[i] = g[0][i];
}
constexpr float KOFF = 64.f;
__device__ __forceinline__ void top16_of_32(int (&a)[32]) {
    int g0[16], g1[16];
#pragma unroll
    for (int i = 0; i < 16; ++i) { g0[i] = a[i]; g1[i] = a[16 + i]; }
    sort16_desc(g0); sort16_desc(g1);
#pragma unroll
    for (int i = 0; i < 16; ++i) g0[i] = max(g0[i], g1[15 - i]);
    bitonic_merge16_desc(g0);
#pragma unroll
    for (int i = 0; i < 16; ++i) a[i] = g0[i];
}
__device__ __forceinline__ void subkey_top16(const GAS bf16_t* qrow  , const GAS bf16_t* sk  , int r32, int hi, int (&top)[16]) {
    bf16x8 qf[8];
#pragma unroll
    for (int ks = 0; ks < 8; ++ks) qf[ks] = *(const GAS bf16x8*)(qrow + ks * 16 + hi * 8);
    unsigned loff = (unsigned)(r32 * 16 + hi * 8) * 2u; asm volatile("" : "+v"(loff));
    int key[64];
    bf16x8 afc[8], afn[8];
#pragma unroll
    for (int ks = 0; ks < 8; ++ks) afc[ks] = *(const GAS bf16x8*)((const GAS char*)(sk + ks * 512) + loff);
#pragma unroll
    for (int kb = 0; kb < 4; ++kb) {
        if (kb < 3) {
#pragma unroll
            for (int ks = 0; ks < 8; ++ks) afn[ks] = *(const GAS bf16x8*)((const GAS char*)(sk + ((kb + 1) * 8 + ks) * 512) + loff); }
        f32x16 acc;
#pragma unroll
        for (int r = 0; r < 16; ++r) acc[r] = KOFF;
#pragma unroll
        for (int ks = 0; ks < 8; ++ks) acc = __builtin_amdgcn_mfma_f32_32x32x16_bf16(afc[ks], qf[ks], acc, 0, 0, 0);
#pragma unroll
        for (int ks = 0; ks < 8; ++ks) afc[ks] = afn[ks];
#pragma unroll
        for (int r = 0; r < 16; ++r) { const int id = kb * 32 + (r & 3) + 8 * (r >> 2) + 4 * hi; key[kb * 16 + r] = (__float_as_int(acc[r]) & ~127) | (127 - id); }
        __builtin_amdgcn_sched_barrier(0);
    }
    top16_of_64(key);
#pragma unroll
    for (int i = 0; i < 16; ++i) { auto r = __builtin_amdgcn_permlane32_swap((unsigned)key[15 - i], (unsigned)key[15 - i], false, false);
        const int pk = hi ? (int)r[0] : (int)r[1]; top[i] = max(key[i], pk); }
    bitonic_merge16_desc(top);
}
__device__ __forceinline__ void subkey_top16_lds(const GAS bf16_t* qrow, const LAS unsigned char* tb, int r32, int hi, int (&top)[16]) {
    bf16x8 qf[8];
#pragma unroll
    for (int ks = 0; ks < 8; ++ks) qf[ks] = *(const GAS bf16x8*)(qrow + ks * 16 + hi * 8);
    unsigned loff = (unsigned)(r32 * 16 + hi * 8) * 2u; asm volatile("" : "+v"(loff));
    int key[64];
#pragma unroll
    for (int kb = 0; kb < 4; ++kb) {
        bf16x8 af[8];
#pragma unroll
        for (int ks = 0; ks < 8; ++ks) af[ks] = *(const LAS bf16x8*)(tb + (kb * 8 + ks) * 1024 + loff);
        f32x16 acc;
#pragma unroll
        for (int r = 0; r < 16; ++r) acc[r] = KOFF;
#pragma unroll
        for (int ks = 0; ks < 8; ++ks) acc = __builtin_amdgcn_mfma_f32_32x32x16_bf16(af[ks], qf[ks], acc, 0, 0, 0);
#pragma unroll
        for (int r = 0; r < 16; ++r) { const int id = kb * 32 + (r & 3) + 8 * (r >> 2) + 4 * hi; key[kb * 16 + r] = (__float_as_int(acc[r]) & ~127) | (127 - id); }
        __builtin_amdgcn_sched_barrier(0);
    }
    top16_of_64(key);
#pragma unroll
    for (int i = 0; i < 16; ++i) { auto r = __builtin_amdgcn_permlane32_swap((unsigned)key[15 - i], (unsigned)key[15 - i], false, false);
        const int pk = hi ? (int)r[0] : (int)r[1]; top[i] = max(key[i], pk); }
    bitonic_merge16_desc(top);
}
__device__ __forceinline__ void step_topk(Frame& F, LAS unsigned char* lds, int layer, int G) {
    pg8::StaticOrder SO; SO.init(T, DM, G, (int)blockIdx.x);
    LAS unsigned char* tab = lds + 69632;
    const GAS bf16_t* q16 = (const GAS bf16_t*)(F.ws + O_Q16); const GAS bf16_t* subk = (const GAS bf16_t*)(F.ws + O_SUBK) + (size_t)layer * 16 * 128 * 128;
    GAS int* IDX = (GAS int*)(F.ws + O_IDX); GAS float* GW = (GAS float*)(F.ws + O_GW);
    LAS int* scr = (LAS int*)(lds + F.wave * 8448) + F.lane * 33;
    const int r32 = F.lane & 31, hi = F.lane >> 5;
    for (int ui = 0; ; ++ui) {
        pg8::Unit un; if (!SO.next(ui, un)) break;
        const int tb = un.pm * 8 + F.wave, h = un.pn; const int tok = tb * 32 + r32;
        __syncthreads();
        { const GAS unsigned char* src = (const GAS unsigned char*)(subk + (size_t)(h * 2) * 128 * 128);
#pragma unroll
          for (int i = 0; i < 8; ++i) *(LAS u32x4*)(tab + (i * NTHREADS + F.tid) * 16) = *(const GAS u32x4*)(src + (i * NTHREADS + F.tid) * 16); }
        __syncthreads();
        const GAS bf16_t* qrow = q16 + (size_t)tok * DM + h * 256;
        int ta[16], tb16[16];
        subkey_top16_lds(qrow, tab, r32, hi, ta);
        subkey_top16_lds(qrow + 128, tab + 32768, r32, hi, tb16);
        float va[16], vb[16];
#pragma unroll
        for (int i = 0; i < 16; ++i) { va[i] = __int_as_float(ta[i] & ~127); vb[i] = __int_as_float(tb16[i] & ~127) - KOFF; scr[i] = 127 - (ta[i] & 127); scr[16 + i] = 127 - (tb16[i] & 127); }
        int c2[32]; int n = 0;
#pragma unroll
        for (int i = 0; i < 16; ++i)
#pragma unroll
            for (int j = 0; j < 16; ++j) if ((i + 1) * (j + 1) <= 16) { const int k = (__float_as_int(va[i] + vb[j]) & ~255) | (255 - (i * 16 + j));
                if ((n & 1) == 0) c2[n >> 1] = k; else c2[n >> 1] = hi ? k : c2[n >> 1];
                ++n; }
#pragma unroll
        for (int i = 25; i < 32; ++i) c2[i] = (int)0x80000000;
        top16_of_32(c2);
        { int mg[16];
#pragma unroll
          for (int i = 0; i < 16; ++i) { auto r = __builtin_amdgcn_permlane32_swap((unsigned)c2[15 - i], (unsigned)c2[15 - i], false, false);
              const int pk = hi ? (int)r[0] : (int)r[1]; mg[i] = max(c2[i], pk); }
          bitonic_merge16_desc(mg);
#pragma unroll
          for (int i = 0; i < 16; ++i) c2[i] = mg[i]; }
        asm volatile("s_waitcnt lgkmcnt(0)" ::: "memory");
        float sv[16], ex[16]; int ev[16]; float Z = 0.f;
#pragma unroll
        for (int r = 0; r < 16; ++r) { const int flat = 255 - (c2[r] & 255); sv[r] = __int_as_float(c2[r] & ~255); ev[r] = scr[flat >> 4] * 128 + scr[16 + (flat & 15)]; }
#pragma unroll
        for (int r = 0; r < 16; ++r) { ex[r] = fast_exp(sv[r] - sv[0]); Z += ex[r]; }
        const float iz = 1.f / Z;
        GAS int* ip = IDX + (size_t)tok * 128 + h * 16 + hi * 8; GAS float* gp = GW + (size_t)tok * 128 + h * 16 + hi * 8;
        int eo[8]; float go[8];
#pragma unroll
        for (int j = 0; j < 8; ++j) { eo[j] = hi ? ev[8 + j] : ev[j]; go[j] = (hi ? ex[8 + j] : ex[j]) * iz; }
        *(GAS u32x4*)ip = (u32x4){(unsigned)eo[0], (unsigned)eo[1], (unsigned)eo[2], (unsigned)eo[3]}; *(GAS u32x4*)(ip + 4) = (u32x4){(unsigned)eo[4], (unsigned)eo[5], (unsigned)eo[6], (unsigned)eo[7]};
        *(GAS f32x4*)gp = (f32x4){go[0], go[1], go[2], go[3]}; *(GAS f32x4*)(gp + 4) = (f32x4){go[4], go[5], go[6], go[7]};
        asm volatile("s_waitcnt lgkmcnt(0)" ::: "memory");
    }
}
__device__ __forceinline__ h2 as_h2(unsigned w) { return __builtin_bit_cast(h2, w); }
#define F4(W, s) __builtin_amdgcn_cvt_scalef32_pk_f16_fp4((W), 1.0f, (s))
#define H2F(us) ((float)__builtin_bit_cast(_Float16, (unsigned short)(us)))
__device__ __forceinline__ float sum8(float v) { v += dppf<0xB1>(v); v += dppf<0x4E>(v); v += dppf<0x141>(v); return v; }
__device__ __forceinline__ void step_upass(Frame& F, int layer, int G, LAS unsigned char* lds) {
    typedef pg8::v8i_t v8i_t;
    const int s = blockIdx.x & 7, wk = (blockIdx.x >> 3) * NWAVES + F.wave, nwk = (G >> 3) * NWAVES;
    const GAS unsigned char* UN = F.ws + O_TAB + (size_t)(layer * 2) * TAB_ONE + (size_t)s * NEXP * 128;
    const GAS int* IDX = (const GAS int*)(F.ws + O_IDX); const GAS bf16_t* xs = (const GAS bf16_t*)(F.ws + O_XS16) + s * 256;
    GAS _Float16* part = (GAS _Float16*)(F.ws + O_PART) + (size_t)s * T * 128;
    unsigned lo = (unsigned)F.lane; asm volatile("" : "+v"(lo));
    const unsigned j = lo >> 3, p = lo & 7, c = lo & 15, kq = lo >> 4;
    LAS unsigned char* img = lds + F.wave * 16384; LAS unsigned char* xrow = lds + 131072 + F.wave * 256;
    LAS unsigned char* wrp = img + j * 128 + ((p ^ j) << 4);
    const LAS unsigned char* rd0 = img + c * 128 + ((kq ^ (c & 7)) << 4);
    const LAS unsigned char* rd1 = img + c * 128 + (((4 + kq) ^ (c & 7)) << 4);
    const int tlast = wk + ((T - 1 - wk) / nwk) * nwk;
#define U_LOADID(ID, t_, q_) do { const int tt_ = (t_) <= tlast ? (t_) : tlast; _Pragma("unroll") for (int b = 0; b < 4; ++b) ID[b] = IDX[(size_t)tt_ * 128 + (q_) * 32 + 8 * b + j]; } while (0)
#define U_LOADX(t_) do { const int tt_ = (t_) <= tlast ? (t_) : tlast; xn = *(const GAS u32x2*)(xs + (size_t)tt_ * DM + lo * 4); } while (0)
    const __amdgpu_buffer_rsrc_t urs = __builtin_amdgcn_make_buffer_rsrc((void*)(unsigned char*)UN, 0, NEXP * 128, 0x00020000);
#define U_ISSUE(UB, ID) do { _Pragma("unroll") for (int b = 0; b < 4; ++b) UB[b] = __builtin_amdgcn_raw_buffer_load_b128(urs, ID[b] * 128 + (int)p * 16, 0, 16); } while (0)
#define U_WRITE(UB, q_) do { _Pragma("unroll") for (int b = 0; b < 4; ++b) *(LAS u32x4*)(wrp + (4 * (q_) + b) * 1024) = UB[b]; } while (0)
#define U_MM(g0) do { u32x4 a0[4], a1[4]; _Pragma("unroll") for (int g = 0; g < 4; ++g) { a0[g] = *(const LAS u32x4*)(rd0 + ((g0) + g) * 2048); a1[g] = *(const LAS u32x4*)(rd1 + ((g0) + g) * 2048); } \
        _Pragma("unroll") for (int g = 0; g < 4; ++g) { \
            f32x4 c_ = __builtin_amdgcn_mfma_scale_f32_16x16x128_f8f6f4((v8i_t){(int)a0[g].x, (int)a0[g].y, (int)a0[g].z, (int)a0[g].w, 0, 0, 0, 0}, bop0, zero4, 4, 0, 0, 127, 0, 127); \
            acc[(g0) + g] = __builtin_amdgcn_mfma_scale_f32_16x16x128_f8f6f4((v8i_t){(int)a1[g].x, (int)a1[g].y, (int)a1[g].z, (int)a1[g].w, 0, 0, 0, 0}, bop1, c_, 4, 0, 0, 127, 0, 127); } } while (0)
    int idA[4], idB[4]; u32x4 u0[4], u1[4], u2[4], u3[4]; u32x2 xc, xn;
    U_LOADID(idA, wk, 0); U_LOADID(idB, wk, 1); U_LOADX(wk);
    U_ISSUE(u0, idA); U_LOADID(idA, wk, 2);
    U_ISSUE(u1, idB); U_LOADID(idB, wk, 3);
    U_ISSUE(u2, idA); U_LOADID(idA, wk + nwk, 0);
    xc = xn;
    for (int t = wk; t < T; t += nwk) {
        U_ISSUE(u3, idB); U_LOADID(idB, t + nwk, 1); U_LOADX(t + nwk);
        const float x0 = bf_lo(xc.x), x1 = bf_hi(xc.x), x2 = bf_lo(xc.y), x3 = bf_hi(xc.y);
        const float amax = wave_max(fmaxf(fmaxf(fabsf(x0), fabsf(x1)), fmaxf(fabsf(x2), fabsf(x3))));
        const float sc = fmaxf(amax, 1e-20f) * (1.f / 448.f), qs = __builtin_amdgcn_rcpf(sc);
        { int pk = __builtin_amdgcn_cvt_pk_fp8_f32(x0 * qs, x1 * qs, 0, false); pk = __builtin_amdgcn_cvt_pk_fp8_f32(x2 * qs, x3 * qs, pk, true); *(LAS int*)(xrow + lo * 4) = pk; }
        U_WRITE(u0, 0);
        U_ISSUE(u0, idA); U_LOADID(idA, t + nwk, 2);
        U_WRITE(u1, 1);
        U_ISSUE(u1, idB); U_LOADID(idB, t + nwk, 3);
        U_WRITE(u2, 2);
        U_ISSUE(u2, idA); U_LOADID(idA, t + 2 * nwk, 0);
        U_WRITE(u3, 3);
        v8i_t bop0, bop1;
        { const u32x4 b00 = *(const LAS u32x4*)(xrow + kq * 16), b01 = *(const LAS u32x4*)(xrow + 64 + kq * 16), b10 = *(const LAS u32x4*)(xrow + 128 + kq * 16), b11 = *(const LAS u32x4*)(xrow + 192 + kq * 16);
          bop0 = (v8i_t){(int)b00.x, (int)b00.y, (int)b00.z, (int)b00.w, (int)b01.x, (int)b01.y, (int)b01.z, (int)b01.w};
          bop1 = (v8i_t){(int)b10.x, (int)b10.y, (int)b10.z, (int)b10.w, (int)b11.x, (int)b11.y, (int)b11.z, (int)b11.w}; }
        const f32x4 zero4 = {0.f, 0.f, 0.f, 0.f};
        f32x4 acc[8];
        U_MM(0); U_MM(4);
        f32x4 o = acc[0];
#pragma unroll
        for (int m = 1; m < 8; ++m) o = ((c & 7) == (unsigned)m) ? acc[m] : o;
        { const h2 o0 = {(_Float16)(o[0] * sc), (_Float16)(o[1] * sc)}, o1 = {(_Float16)(o[2] * sc), (_Float16)(o[3] * sc)};
          __builtin_nontemporal_store((u32x2){__builtin_bit_cast(unsigned, o0), __builtin_bit_cast(unsigned, o1)}, (GAS u32x2*)(part + (size_t)t * 128 + 16 * (c & 7) + 4 * kq)); }
        xc = xn;
    }
#undef U_LOADID
#undef U_LOADX
#undef U_ISSUE
#undef U_WRITE
#undef U_MM
}
__device__ __forceinline__ void step_peer_reduce(Frame& F, int layer) {
    const GAS _Float16* part = (const GAS _Float16*)(F.ws + O_PART); const GAS float* GW = (const GAS float*)(F.ws + O_GW); const GAS int* IDX = (const GAS int*)(F.ws + O_IDX);
    const GAS float* rowss = (const GAS float*)(F.ws + O_ROWSS); GAS unsigned char* W8 = F.ws + O_W8;
    const GAS unsigned char* SU = F.ws + O_TAB + (size_t)(layer * 2) * TAB_ONE + TAB_NIB; const GAS unsigned char* SV = SU + TAB_ONE;
    constexpr int NIT = T * 2;
    struct SA { int id; float gw, rs; float p[8]; }; struct SB { u32x4 su, sv; };
#define RA(X, it_) do { const int ii_ = (it_) < NIT ? (it_) : NIT - 1; const size_t i_ = (size_t)ii_ * 64 + F.lane; X.id = IDX[i_]; X.gw = GW[i_]; X.rs = rowss[(size_t)(ii_ >> 1) * 32 + (F.lane & 31)]; \
        _Pragma("unroll") for (int s = 0; s < 8; ++s) X.p[s] = (float)part[(size_t)s * T * 128 + i_]; } while (0)
#define RB(Y, X) do { Y.su = *(const GAS u32x4*)(SU + (size_t)X.id * 32); Y.sv = *(const GAS u32x4*)(SU + (size_t)X.id * 32 + 16); } while (0)
#define RC(X, Y, it_) do { if ((it_) < NIT) { const size_t i_ = (size_t)(it_) * 64 + F.lane; const float r = rsqrtf(wave_sum(X.rs) * (0.5f / DM) + EPS); float d = 0.f; \
        _Pragma("unroll") for (int s = 0; s < 8; ++s) d += X.p[s] * (float)__builtin_bit_cast(_Float16, (unsigned short)(Y.su[s >> 1] >> (16 * (s & 1)))); \
        const float w = X.gw * gelu_tanh(d * r) * 256.f; \
        _Pragma("unroll") for (int s = 0; s < 8; ++s) { const float ws = w * (float)__builtin_bit_cast(_Float16, (unsigned short)(Y.sv[s >> 1] >> (16 * (s & 1)))); \
            W8[(size_t)s * T * 128 + i_] = (unsigned char)(__builtin_amdgcn_cvt_pk_fp8_f32(ws, 0.f, 0, false) & 0xff); } } } while (0)
    SA a0, a1, a2; SB b0, b1;
    RA(a0, F.gw); RA(a1, F.gw + F.ngw); RB(b0, a0);
    for (int it = F.gw; it < NIT; it += F.ngw) {
        RA(a2, it + 2 * F.ngw); RB(b1, a1);
        RC(a0, b0, it);
        a0 = a1; a1 = a2; b0 = b1;
    }
#undef RA
#undef RB
#undef RC
}
__device__ __forceinline__ void step_vpass(Frame& F, int layer, int G, bool dry, LAS unsigned char* lds) {
    typedef pg8::v8i_t v8i_t;
    const int s = blockIdx.x & 7, wk = (blockIdx.x >> 3) * NWAVES + F.wave, nwk = (G >> 3) * NWAVES;
    const GAS unsigned char* VN = F.ws + O_TAB + (size_t)(layer * 2 + 1) * TAB_ONE + (size_t)s * NEXP * 128;
    const GAS int* IDX = (const GAS int*)(F.ws + O_IDX); const GAS unsigned char* W8 = F.ws + O_W8 + (size_t)s * T * 128;
    GAS bf16_t* xs = (GAS bf16_t*)(F.ws + O_XS16); GAS float* rsp = (GAS float*)(F.ws + O_RSP);
    unsigned lo = (unsigned)F.lane; asm volatile("" : "+v"(lo));
    const unsigned j = lo >> 3, p = lo & 7, c = lo & 15, kq = lo >> 4;
    LAS unsigned char* img = lds + F.wave * 16384;
    LAS unsigned char* wrp = img + j * 128 + ((p ^ j) << 4);
    const unsigned rdrow = (unsigned)(size_t)img + (32 * kq + c) * 128, csw = (c & 7) << 4;
    const int tlast = wk + ((T - 1 - wk) / nwk) * nwk;
    LAS float* wfl = (LAS float*)(lds + 131072); GAS float* logfp = (GAS float*)(F.ws + O_LOGFP);
    if (layer == 0) { const GAS float* wf = (const GAS float*)(F.ws + O_WF) + s * 256;
        for (int i = F.tid; i < NH * 64; i += NTHREADS) *(LAS f32x4*)(wfl + (i >> 6) * 256 + (i & 63) * 4) = *(const GAS f32x4*)(wf + (size_t)(i >> 6) * DM + (i & 63) * 4);
        __syncthreads(); }
#define V_LOADID(ID, t_, q_) do { const int tt_ = (t_) <= tlast ? (t_) : tlast; _Pragma("unroll") for (int b = 0; b < 4; ++b) ID[b] = IDX[(size_t)tt_ * 128 + (q_) * 32 + 8 * b + j]; } while (0)
#define V_LOADW(t_) do { const int tt_ = (t_) <= tlast ? (t_) : tlast; wn0 = *(const GAS u32x4*)(W8 + (size_t)tt_ * 128 + kq * 16); wn1 = *(const GAS u32x4*)(W8 + (size_t)tt_ * 128 + 64 + kq * 16); } while (0)
    const __amdgpu_buffer_rsrc_t vrs = __builtin_amdgcn_make_buffer_rsrc((void*)(unsigned char*)VN, 0, NEXP * 128, 0x00020000);
#define V_ISSUE(VB, ID) do { _Pragma("unroll") for (int b = 0; b < 4; ++b) VB[b] = __builtin_amdgcn_raw_buffer_load_b128(vrs, ID[b] * 128 + (int)p * 16, 0, 16); } while (0)
#define V_WRITE(VB, q_) do { _Pragma("unroll") for (int b = 0; b < 4; ++b) *(LAS u32x4*)(wrp + (4 * (q_) + b) * 1024) = VB[b]; } while (0)
#define TR4(dst, va, off) asm volatile("ds_read_b64_tr_b4 %0, %1 offset:%2" : "=&v"(dst) : "v"(va), "i"(off) : "memory")
#define V_MM(cc) do { const unsigned va0 = rdrow + (((cc) << 4) ^ csw), va1 = rdrow + ((((cc) + 1) << 4) ^ csw); u32x2 t00, t01, t10, t11, t20, t21, t30, t31; \
        TR4(t00, va0, 0); TR4(t01, va0, 2048); TR4(t10, va0, 8); TR4(t11, va0, 2056); TR4(t20, va1, 0); TR4(t21, va1, 2048); TR4(t30, va1, 8); TR4(t31, va1, 2056); \
        asm volatile("s_waitcnt lgkmcnt(0)" ::: "memory"); __builtin_amdgcn_sched_barrier(0); \
        o = __builtin_amdgcn_mfma_scale_f32_16x16x128_f8f6f4((v8i_t){(int)t00.x, (int)t00.y, (int)t01.x, (int)t01.y, 0, 0, 0, 0}, bop, o, 4, 0, 0, 127, 0, SBV(2 * (cc))); \
        o = __builtin_amdgcn_mfma_scale_f32_16x16x128_f8f6f4((v8i_t){(int)t10.x, (int)t10.y, (int)t11.x, (int)t11.y, 0, 0, 0, 0}, bop, o, 4, 0, 0, 127, 0, SBV(2 * (cc) + 1)); \
        o = __builtin_amdgcn_mfma_scale_f32_16x16x128_f8f6f4((v8i_t){(int)t20.x, (int)t20.y, (int)t21.x, (int)t21.y, 0, 0, 0, 0}, bop, o, 4, 0, 0, 127, 0, SBV(2 * (cc) + 2)); \
        o = __builtin_amdgcn_mfma_scale_f32_16x16x128_f8f6f4((v8i_t){(int)t30.x, (int)t30.y, (int)t31.x, (int)t31.y, 0, 0, 0, 0}, bop, o, 4, 0, 0, 127, 0, SBV(2 * (cc) + 3)); } while (0)
#define SBV(nb_) ((c == (unsigned)(nb_)) ? 119 : 0)
    int idA[4], idB[4]; u32x4 v0[4], v1[4], v2[4], v3[4]; u32x4 w0, w1, wn0, wn1;
    V_LOADID(idA, wk, 0); V_LOADID(idB, wk, 1); V_LOADW(wk);
    V_ISSUE(v0, idA); V_LOADID(idA, wk, 2);
    V_ISSUE(v1, idB); V_LOADID(idB, wk, 3);
    V_ISSUE(v2, idA); V_LOADID(idA, wk + nwk, 0);
    w0 = wn0; w1 = wn1;
    for (int t = wk; t < T; t += nwk) {
        V_ISSUE(v3, idB); V_LOADID(idB, t + nwk, 1); V_LOADW(t + nwk);
        GAS bf16_t* xb = xs + (size_t)t * DM + s * 256 + c * 16 + kq * 4;
        f32x4 x2; { const u32x2 w = *(const GAS u32x2*)xb; x2 = (f32x4){bf_lo(w.x), bf_hi(w.x), bf_lo(w.y), bf_hi(w.y)}; }
        V_WRITE(v0, 0);
        V_ISSUE(v0, idA); V_LOADID(idA, t + nwk, 2);
        V_WRITE(v1, 1);
        V_ISSUE(v1, idB); V_LOADID(idB, t + nwk, 3);
        V_WRITE(v2, 2);
        V_ISSUE(v2, idA); V_LOADID(idA, t + 2 * nwk, 0);
        V_WRITE(v3, 3);
        const v8i_t bop = {(int)w0.x, (int)w0.y, (int)w0.z, (int)w0.w, (int)w1.x, (int)w1.y, (int)w1.z, (int)w1.w};
        f32x4 o = {0.f, 0.f, 0.f, 0.f};
        V_MM(0); V_MM(2); V_MM(4); V_MM(6);
        x2 += o;
        if (layer == 1 && !dry) __builtin_nontemporal_store(x2, (GAS f32x4*)(F.out + (size_t)t * DM + s * 256 + c * 16 + kq * 4));
        if (layer == 0 && !dry) {
            { u32x2 ow; ow.x = cvtpk(x2[0], x2[1]); ow.y = cvtpk(x2[2], x2[3]); __builtin_nontemporal_store(ow, (GAS u32x2*)xb); }
            const float sst = wave_sum((x2[0] * x2[0] + x2[1] * x2[1]) + (x2[2] * x2[2] + x2[3] * x2[3]));
            if (lo == 0) rsp[(size_t)t * 8 + s] = sst;
        }
        if (layer == 0) {
            f32x4 gw[NH];
#pragma unroll
            for (int h = 0; h < NH; ++h) gw[h] = *(const LAS f32x4*)(wfl + h * 256 + c * 16 + kq * 4);
            __builtin_amdgcn_sched_barrier(0);
            float ph[NH];
#pragma unroll
            for (int h = 0; h < NH; ++h) ph[h] = (x2[0] * gw[h][0] + x2[1] * gw[h][1]) + (x2[2] * gw[h][2] + x2[3] * gw[h][3]);
#pragma unroll
            for (int h = 0; h < NH; ++h) ph[h] += dppf<0xB1>(ph[h]);
#pragma unroll
            for (int h = 0; h < NH; ++h) ph[h] += dppf<0x4E>(ph[h]);
#pragma unroll
            for (int h = 0; h < NH; ++h) ph[h] += dppf<0x141>(ph[h]);
#pragma unroll
            for (int h = 0; h < NH; ++h) ph[h] += dppf<0x140>(ph[h]);
            float sel = 0.f;
#pragma unroll
            for (int h = 0; h < NH; ++h) sel = (c == (unsigned)h) ? ph[h] : sel;
            sel = xsum16(sel); sel = xsum32(sel);
            if (lo < (unsigned)NH && !dry) logfp[((size_t)t * 8 + s) * NH + lo] = sel;
        }
        w0 = wn0; w1 = wn1;
    }
#undef V_LOADID
#undef V_LOADW
#undef V_ISSUE
#undef V_WRITE
#undef TR4
#undef V_MM
#undef SBV
}
#undef F4
#undef H2F
__device__ __forceinline__ void step_logf(Frame& F) {
    const GAS float* lp = (const GAS float*)(F.ws + O_LOGFP); const GAS float* rsp = (const GAS float*)(F.ws + O_RSP); GAS float* logf = (GAS float*)(F.ws + O_LOGF);
    unsigned lo = (unsigned)F.lane; asm volatile("" : "+v"(lo));
    const unsigned h = lo & 15, g = lo >> 4; const unsigned hh = h < (unsigned)NH ? h : 0u;
    for (int t0 = F.gw * 4; t0 < T; t0 += F.ngw * 4) {
        const int t = t0 + (int)g;
        float pz[8]; f32x4 q0, q1;
#pragma unroll
        for (int s = 0; s < 8; ++s) pz[s] = lp[((size_t)t * 8 + s) * NH + hh];
        q0 = *(const GAS f32x4*)(rsp + (size_t)t * 8); q1 = *(const GAS f32x4*)(rsp + (size_t)t * 8 + 4);
        const float z0 = ((pz[0] + pz[1]) + (pz[2] + pz[3])) + ((pz[4] + pz[5]) + (pz[6] + pz[7]));
        const float r1 = rsqrtf(((q0[0] + q0[1]) + (q0[2] + q0[3]) + (q1[0] + q1[1]) + (q1[2] + q1[3])) * (1.f / DM) + EPS);
        if (h < (unsigned)NH) { const float z = z0 * r1 + F.in(I_SBF)[h];
            logf[((size_t)(t / SEQ) * NH + h) * SEQ + (t % SEQ)] = fminf(z, 0.f) - log1p_pos(fast_exp(-fabsf(z))); }
    }
}

#define XB_TMO      128
#define XB_XCNT(j)  (256  + 64 * (j))
#define XB_XSUB(j)  (1280 + 64 * (j))
#define XB_XGEN(j)  (2304 + 64 * (j))
#define XB_TOP      3328
#define XB_TOPGEN   3392
#define XCD_BAR_WORDS 3456
#define XB_SPIN_CAP (1u << 20)
__device__ __forceinline__ unsigned xb_ld(unsigned* p)              { return __hip_atomic_load(p, __ATOMIC_RELAXED, __HIP_MEMORY_SCOPE_AGENT); }
__device__ __forceinline__ unsigned xb_add(unsigned* p, unsigned v) { return __hip_atomic_fetch_add(p, v, __ATOMIC_RELAXED, __HIP_MEMORY_SCOPE_AGENT); }
__device__ __forceinline__ unsigned xb_xcc_id() { return (unsigned)__builtin_amdgcn_s_getreg((3 << 11) | 20) & 0xFu; }
#define XB_SPIN(cond, bar) do { unsigned _sp = 0; while (cond) { __builtin_amdgcn_s_sleep(1); \
    if ((++_sp & 255u) == 0u) { if (xb_ld(&(bar)[XB_TMO])) break; if (_sp > XB_SPIN_CAP) { atomicAdd(&(bar)[XB_TMO], 1u); break; } } } } while (0)
struct XcdBarrier { unsigned* bar; unsigned x; volatile LAS unsigned* st; };
__device__ __forceinline__ XcdBarrier xcd_barrier_post(unsigned* bar, volatile LAS unsigned* st) {
    XcdBarrier b; b.bar = bar; b.x = xb_xcc_id(); b.st = st;
    if (threadIdx.x == 0) (void)xb_add(&bar[XB_XCNT(b.x)], 1u);
    return b;
}
__device__ __forceinline__ void xcd_barrier_complete(unsigned* bar, unsigned x, unsigned& nloc, unsigned& nx) {
    const unsigned G = gridDim.x * gridDim.y * gridDim.z;
    unsigned sum, cnt, mine, sp = 0u;
    for (;;) {
        sum = 0u; cnt = 0u; mine = 0u;
#pragma unroll
        for (unsigned j = 0; j < 16; ++j) { const unsigned c = xb_ld(&bar[XB_XCNT(j)]); sum += c; cnt += (c > 0u) ? 1u : 0u; mine = (j == x) ? c : mine; }
        if (sum == G) break;
        __builtin_amdgcn_s_sleep(1);
        if ((++sp & 255u) == 0u) { if (xb_ld(&bar[XB_TMO])) break; if (sp > XB_SPIN_CAP) { atomicAdd(&bar[XB_TMO], 1u); break; } }
    }
    nloc = mine > 0u ? mine : 1u; nx = cnt > 0u ? cnt : 1u;
}
__device__ __forceinline__ void xcd_barrier(const XcdBarrier& b, int wave_s) {
    asm volatile("s_waitcnt vmcnt(0)" ::: "memory");
    __syncthreads();
    int ln_; asm volatile("v_mbcnt_lo_u32_b32 %0, -1, 0\n\tv_mbcnt_hi_u32_b32 %0, -1, %0" : "=v"(ln_));
    if (wave_s == 0 && ln_ == 0) {
        unsigned* bar = b.bar;
        __builtin_amdgcn_s_waitcnt(0);
        unsigned nloc = b.st[0], nx = b.st[1];
        if (nloc == 0u) { xcd_barrier_complete(bar, b.x, nloc, nx); b.st[0] = nloc; b.st[1] = nx; }
        const unsigned old = xb_add(&bar[XB_XSUB(b.x)], 1u);
        const unsigned gen = old / nloc;
        if (old + 1u == (gen + 1u) * nloc) {
            __builtin_amdgcn_fence(__ATOMIC_RELEASE, "agent");
            asm volatile("s_waitcnt vmcnt(0)" ::: "memory");
            const unsigned og = xb_add(&bar[XB_TOP], 1u);
            const unsigned tg = og / nx;
            if (og + 1u == (tg + 1u) * nx) xb_add(&bar[XB_TOPGEN], 1u);
            else XB_SPIN(xb_ld(&bar[XB_TOPGEN]) == tg, bar);
            __builtin_amdgcn_fence(__ATOMIC_ACQUIRE, "agent");
            asm volatile("s_waitcnt vmcnt(0)" ::: "memory");
            xb_add(&bar[XB_XGEN(b.x)], 1u);
            asm volatile("s_waitcnt vmcnt(0)" ::: "memory");
        } else {
            XB_SPIN(xb_ld(&bar[XB_XGEN(b.x)]) == gen, bar);
            asm volatile("buffer_inv sc0" ::: "memory");
            asm volatile("s_waitcnt vmcnt(0)" ::: "memory");
        }
    }
    __syncthreads();
}

constexpr int CONV1_SPLIT = 2 * 7680;
constexpr int BAR_LDS_OFF = 147456 - 64;
constexpr int LDS_BYTES = 147456;
enum { ST_PROLOGUE = 0, ST_G_IN0, ST_G_MKV0, ST_G_MKV1, ST_CONV, ST_G_GATE, ST_A_MEM0, ST_SCAN1, ST_SCAN2, ST_G_OUT0, ST_G_PQ0, ST_TOPK0, ST_UPASS0, ST_PRED0, ST_VPASS0,
       ST_G_L1, ST_CPREFIX, ST_A_FOX, ST_A_MEM1, ST_G_OUT1, ST_G_PQ1, ST_TOPK1, ST_UPASS1, ST_PRED1, ST_VPASS1, N_STEPS };
constexpr unsigned SYNC_AFTER = (1u << ST_PROLOGUE) | (1u << ST_G_MKV1) | (1u << ST_A_MEM0) | (1u << ST_SCAN1) | (1u << ST_SCAN2) | (1u << ST_G_OUT0) | (1u << ST_G_PQ0) |
                                (1u << ST_TOPK0) | (1u << ST_UPASS0) | (1u << ST_PRED0) | (1u << ST_VPASS0) | (1u << ST_G_L1) | (1u << ST_CPREFIX) | (1u << ST_A_MEM1) | (1u << ST_G_OUT1) | (1u << ST_G_PQ1) | (1u << ST_TOPK1) | (1u << ST_UPASS1) | (1u << ST_PRED1);
constexpr unsigned GEMM_STEPS = (1u << ST_G_IN0) | (1u << ST_G_MKV0) | (1u << ST_G_MKV1) | (1u << ST_G_GATE) | (1u << ST_G_OUT0) | (1u << ST_G_PQ0) | (1u << ST_G_L1) | (1u << ST_G_OUT1) | (1u << ST_G_PQ1);
constexpr unsigned ATTN_STEPS = (1u << ST_A_MEM0) | (1u << ST_A_FOX) | (1u << ST_A_MEM1);

struct Args { const float* in[N_IN]; float* out; unsigned char* ws; int lo, hi; };

__global__ void __launch_bounds__(NTHREADS, 2) yoco_fwd(Args args) {
    extern __shared__ __attribute__((aligned(16))) unsigned char lds[];
    volatile LAS unsigned* bst = (volatile LAS unsigned*)((LAS unsigned char*)lds + BAR_LDS_OFF);
    if (threadIdx.x == 0) { bst[0] = 0u; bst[1] = 0u; }
    __syncthreads();
    const XcdBarrier gbar = xcd_barrier_post((unsigned*)(args.ws + O_CTL), bst);
    const int G = gridDim.x;
    const int wave_s = __builtin_amdgcn_readfirstlane(threadIdx.x >> 6);
#ifndef DUP_MASK
#define DUP_MASK 0u
#endif
    for (int st = args.lo; st < args.hi; ++st) {
      const int nrep = ((DUP_MASK >> st) & 1u) ? 2 : 1;
      for (int rep = 0; rep < nrep; ++rep) {
        unsigned char* ws0 = args.ws; asm volatile("" : "+s"(ws0));
        GAS unsigned char* ws = (GAS unsigned char*)ws0;
#define LANE_ID(v) asm volatile("v_mbcnt_lo_u32_b32 %0, -1, 0\n\tv_mbcnt_hi_u32_b32 %0, -1, %0" : "=v"(v))
#define MAKE_TID(v) do { LANE_ID(v); v += wave_s * 64; } while (0)
#define MAKE_FRAME(F) Frame F; F.ws = ws; F.in_ = args.in; F.out = (GAS float*)args.out; { int t0_; MAKE_TID(t0_); F.tid = t0_; } F.lane = F.tid & 63; F.wave = wave_s; \
        F.gw = blockIdx.x * NWAVES + F.wave; F.ngw = gridDim.x * NWAVES; F.gtid = blockIdx.x * NTHREADS + F.tid; F.ngt = gridDim.x * NTHREADS
        if (st == ST_G_L1) { MAKE_FRAME(F); step_logf(F); }
        if ((GEMM_STEPS >> st) & 1u) {
            pg8::Gemm g; Epi E; E.ws = ws; E.resid = nullptr; E.outf = nullptr; E.o16 = nullptr; E.ssq = nullptr; E.gate_b = nullptr; int shift = 0;
            switch (st) {
            case ST_G_IN0:  g = {(const GAS bf16_t*)(ws + O_XS16), (const GAS bf16_t*)(ws + O_WIN0), T, NIN0, DM, DM, DM, 0}; E.mode = EM_IN0; break;
            case ST_G_MKV0: g = {(const GAS bf16_t*)(ws + O_MEMN), (const GAS bf16_t*)(ws + O_WMKV), NMROW, 1024, DM, DM, DM, 0}; E.mode = EM_MKV; E.o16 = (GAS bf16_t*)(ws + O_MKV); E.ssq = (GAS float*)(ws + O_MKSS); shift = 128; break;
            case ST_G_MKV1: g = {(const GAS bf16_t*)(ws + O_MEMN) + (size_t)NMROW * DM, (const GAS bf16_t*)(ws + O_WMKV) + (size_t)1024 * DM, NMROW, 1024, DM, DM, DM, 0}; E.mode = EM_MKV;
                            E.o16 = (GAS bf16_t*)(ws + O_MKV) + (size_t)NMROW * NL1; E.ssq = (GAS float*)(ws + O_MKSS) + (size_t)4 * NMROW * 4; shift = 144; break;
            case ST_G_GATE: g = {(const GAS bf16_t*)(ws + O_XC), (const GAS bf16_t*)(ws + O_WGATE), T, 12 * 256, 128, LRU, 128, 128}; E.mode = EM_GATE; E.gate_b = (const GAS float*)args.in[I_AGATEB]; break;
            case ST_G_OUT0: g = {(const GAS bf16_t*)(ws + O_CAT), (const GAS bf16_t*)(ws + O_WOUT0), T, DM, DM, DM, DM, 0}; E.mode = EM_RES; E.resid = (const GAS float*)args.in[I_X]; E.outf = (GAS float*)args.out; break;
            case ST_G_PQ0:  g = {(const GAS bf16_t*)(ws + O_XS16), (const GAS bf16_t*)(ws + O_WQ0), T, DM, DM, DM, DM, 0}; E.mode = EM_PQ; E.o16 = (GAS bf16_t*)(ws + O_Q16); break;
            case ST_G_L1:   g = {(const GAS bf16_t*)(ws + O_XS16), (const GAS bf16_t*)(ws + O_WL1), T, NL1, DM, DM, DM, 0}; E.mode = EM_L1; break;
            case ST_G_OUT1: g = {(const GAS bf16_t*)(ws + O_CAT), (const GAS bf16_t*)(ws + O_WOUT1), T, DM, DM, DM, DM, 0}; E.mode = EM_RES; E.resid = nullptr; break;
            default:        g = {(const GAS bf16_t*)(ws + O_XS16), (const GAS bf16_t*)(ws + O_WQ1), T, DM, DM, DM, DM, 0}; E.mode = EM_PQ; E.o16 = (GAS bf16_t*)(ws + O_Q16); break;
            }
            pg8::StaticOrder S; S.init(g.M, g.N, G, (int)((blockIdx.x + G - shift) % G));
#ifndef DIS_GEMM
            { int tg_; MAKE_TID(tg_);
              pg8::gemm_phase<Epi, false>((LAS unsigned char*)lds, g, S, E, tg_); }
#endif
            if (st == ST_G_MKV1 && blockIdx.x >= 160) { MAKE_FRAME(F); convert_tables(F, 1, 0, CONV1_SPLIT, (blockIdx.x - 160) * NWAVES + F.wave, (G - 160) * NWAVES); }
        } else if ((ATTN_STEPS >> st) & 1u) {
            const int nun = st == ST_A_FOX ? 3 : 1;
            for (int ui = 0; ui < nun; ++ui) {
                att::BlockRef r;
                if (st == ST_A_FOX) {
                    const int i = blockIdx.x, x = i & 15, bh = (i >> 4) + 16 * ui, qb = ui == 0 ? x : (ui == 1 ? 15 - x : ((x * 5 + 3) & 15));
                    const int b = bh / NH, h = bh % NH; const size_t row0 = (size_t)b * SEQ + qb * 256;
                    const GAS bf16_t* z = (const GAS bf16_t*)(ws + O_ZL1);
                    r.Q = z + row0 * NL1 + 3072 + h * 128; r.K = z + (size_t)b * SEQ * NL1 + h * 128; r.V = z + (size_t)b * SEQ * NL1 + 1536 + h * 128;
                    r.O = (GAS bf16_t*)(ws + O_CAT) + row0 * DM + h * 128;
                    const GAS float* ss = (const GAS float*)(ws + O_SSL1);
                    r.qss = ss + ((size_t)(12 + h) * T + row0) * 4; r.kss = ss + ((size_t)h * T + (size_t)b * SEQ) * 4; r.cc = (const GAS float*)(ws + O_CC) + (size_t)bh * SEQ; r.gg = (const GAS float*)(ws + O_GG) + 384;
                    r.P0 = qb * 256; r.skv = SEQ;
                } else {
                    const int l = st == ST_A_MEM0 ? 0 : 1; const int i = blockIdx.x, qblk = i >> 2, h = i & 3, b = qblk >> 4; const size_t row0 = (size_t)qblk * 256;
                    r.Q = (const GAS bf16_t*)(ws + O_ZL1) + row0 * NL1 + 4608 + h * 128; r.qss = (const GAS float*)(ws + O_SSL1) + ((size_t)(24 + h) * T + row0) * 4;
                    const GAS bf16_t* kv = (const GAS bf16_t*)(ws + O_MKV) + ((size_t)l * NMROW + b * NMEM) * NL1;
                    r.K = kv + h * 128; r.V = kv + 512 + h * 128; r.kss = (const GAS float*)(ws + O_MKSS) + ((size_t)(l * 4 + h) * NMROW + b * NMEM) * 4;
                    r.O = (GAS bf16_t*)(ws + O_CAT) + row0 * DM + LRU + h * 128; r.cc = nullptr; r.gg = (const GAS float*)(ws + O_GG) + 128 * (1 + l);
                    r.P0 = SEQ; r.skv = NMEM;
                }
                att::Seam S;
                int tid_u; MAKE_TID(tid_u);
#ifndef DIS_ATTN
                if (st == ST_A_FOX) { att::attn_prime(r, (char*)lds, S, tid_u); att::attn_block(r, (char*)lds, S, tid_u); }
                else att::mem_attn_unit(r, (char*)lds, tid_u);
#endif
            }
        } else {
            MAKE_FRAME(F);
            switch (st) {
#ifndef DIS_MISC
            case ST_PROLOGUE: step_prologue(F, (LAS unsigned char*)lds); break;
            case ST_CONV: step_conv_local(F, G); break;
            case ST_SCAN1: step_scan1(F); break;
            case ST_SCAN2: step_scan2(F); break;
#endif
#ifndef DIS_TOPK
            case ST_TOPK0: step_topk(F, (LAS unsigned char*)lds, 0, G); break;
            case ST_TOPK1: step_topk(F, (LAS unsigned char*)lds, 1, G); break;
#endif
#ifndef DIS_GATHER
            case ST_UPASS0: step_upass(F, 0, G, (LAS unsigned char*)lds); break;
            case ST_UPASS1: step_upass(F, 1, G, (LAS unsigned char*)lds); break;
            case ST_PRED0: step_peer_reduce(F, 0); break;
            case ST_PRED1: step_peer_reduce(F, 1); break;
            case ST_VPASS0: step_vpass(F, 0, G, rep + 1 < nrep, (LAS unsigned char*)lds); break;
            case ST_VPASS1: step_vpass(F, 1, G, rep + 1 < nrep, (LAS unsigned char*)lds); break;
#endif
#ifndef DIS_MISC
            case ST_CPREFIX: step_cprefix(F, (LAS unsigned char*)lds); convert_tables(F, 1, G > 160 ? CONV1_SPLIT : 0, 2 * NEXP, F.gw, F.ngw); break;
#endif
            default: break;
            }
        }
        if (rep + 1 < nrep) xcd_barrier(gbar, wave_s);
      }
        if (((SYNC_AFTER >> st) & 1u) && st + 1 < args.hi) xcd_barrier(gbar, wave_s);
    }
}

#ifndef N_LAUNCH_MODE
#define N_LAUNCH_MODE 1
#endif
extern "C" void kernel_launch(void* const* d_in, const int* in_sizes, int n_in, void* d_out, int out_size, void* d_ws, size_t ws_size, hipStream_t stream) {
    static int grid = 0;
    if (grid == 0) {
        if (n_in != N_IN || in_sizes[0] != T * DM || out_size != T * DM || ws_size < WS_END) {
            fprintf(stderr, "kernel_launch: unexpected shapes (n_in %d, in0 %d, out %d, ws %zu, need %zu)\n", n_in, n_in > 0 ? in_sizes[0] : -1, out_size, ws_size, (size_t)WS_END); grid = -1; return; }
        int dev = 0, cus = 0, per_cu = 0;
        hipGetDevice(&dev); hipDeviceGetAttribute(&cus, hipDeviceAttributeMultiprocessorCount, dev);
        hipFuncSetAttribute((const void*)yoco_fwd, hipFuncAttributeMaxDynamicSharedMemorySize, LDS_BYTES);
        hipOccupancyMaxActiveBlocksPerMultiprocessor(&per_cu, (const void*)yoco_fwd, NTHREADS, LDS_BYTES);
        if (per_cu < 1) { fprintf(stderr, "kernel_launch: occupancy query says %d blocks per CU\n", per_cu); grid = -1; return; }
        grid = cus - cus % 8;
        (void)hipGetLastError();
    }
    if (grid < 0) return;
    Args a{};
    for (int i = 0; i < N_IN; ++i) a.in[i] = (const float*)d_in[i];
    a.out = (float*)d_out; a.ws = (unsigned char*)d_ws;
    if (hipMemsetAsync((char*)d_ws + O_CTL, 0, 65536, stream) != hipSuccess) { fprintf(stderr, "kernel_launch: memset of the barrier words failed\n"); return; }
    if (N_LAUNCH_MODE == 1) {
        a.lo = 0; a.hi = N_STEPS;
        hipLaunchKernelGGL(yoco_fwd, dim3(grid), dim3(NTHREADS), LDS_BYTES, stream, a);
        hipError_t e = hipPeekAtLastError();
        if (e != hipSuccess) fprintf(stderr, "launch failed: %s (grid %d)\n", hipGetErrorString(e), grid);
    } else {
        int lo = 0;
        for (int s = 0; s < N_STEPS; ++s) {
            if (((SYNC_AFTER >> s) & 1u) || s == N_STEPS - 1) {
                a.lo = lo; a.hi = s + 1; lo = s + 1;
                void* params[] = {&a};
                hipError_t e = hipLaunchCooperativeKernel((const void*)yoco_fwd, dim3(grid), dim3(NTHREADS), params, LDS_BYTES, stream);
                if (e != hipSuccess) { fprintf(stderr, "launch failed: %s\n", hipGetErrorString(e)); break; }
            }
        }
    }
}
```
